# Optimizing an MI355X kernel written in HIP

```python
import math
import jax
import jax.numpy as jnp
from jax import lax
import numpy as np

D_MODEL = 1024
BATCH = 8
SEQ = 4096
DEPTH = 2

HEAD_DIM = 64
Q_BLOCK = 128

A_HEADS = 4
A_PATTERNS = ((128, 1), (512, 4), (2048, 16))
A_GROUPS = 3
A_WIDTH = A_HEADS * HEAD_DIM

B_HEADS = 4
B_WIDTH = B_HEADS * HEAD_DIM
IDX_HEADS = 4
IDX_DIM = 64
TOPK_MAX = 256

C_HEADS = 4
C_WIDTH = C_HEADS * HEAD_DIM
C_LORA_W = 32
C_LORA_A = 32
C_LORA_G = 64
C_LORA_V = 16
C_IN = 3 * C_WIDTH + C_LORA_W + C_LORA_A + C_LORA_G
C_GN_EPS = 64e-5

D_HEADS = 4
D_INNER = D_HEADS * HEAD_DIM
D_GROUPS = 2
D_STATE = 64
D_CONV = 4
D_CHUNK = 128
D_XBC = D_INNER + 2 * D_GROUPS * D_STATE
D_NORM_EPS = 1e-5

N_BRANCH = 4
BRANCH_WIDTH = 256

N_EXPERT_GROUPS = 4
EXPERTS_PER_GROUP = 8
N_EXPERTS = N_EXPERT_GROUPS * EXPERTS_PER_GROUP
TOP_K_EXPERTS = 2
D_EXPERT = 512
MOE_BLOCK = 128

LN_EPS = 1e-5
DEEPNORM_ALPHA = (2 * DEPTH) ** 0.25
DEEPNORM_BETA = (8 * DEPTH) ** -0.25

IN_SEGMENTS = (
    ('a_qkv', 3 * A_GROUPS * A_WIDTH),
    ('b_qkv', 3 * B_WIDTH),
    ('b_idx_q', IDX_HEADS * IDX_DIM),
    ('b_idx_k', IDX_DIM),
    ('b_idx_w', IDX_HEADS),
    ('c_in', C_IN),
    ('d_z', D_INNER),
    ('d_xbc', D_XBC),
    ('d_dt', D_HEADS),
    ('gates', N_BRANCH * D_MODEL),
)
IN_WIDTH = sum(size for _, size in IN_SEGMENTS)

kernel_name = 'hybrid_gated_dilated_dsa_rwkv7_ssd_hiermoe'


def _split(x, sizes):
    out, off = [], 0
    for s in sizes:
        out.append(x[..., off:off + s])
        off += s
    return out


def layer_norm(x, g, b):
    xf = x.astype(jnp.float32)
    mu = jnp.mean(xf, axis=-1, keepdims=True)
    var = jnp.mean(jnp.square(xf - mu), axis=-1, keepdims=True)
    return ((xf - mu) * lax.rsqrt(var + LN_EPS) * g + b).astype(x.dtype)


def dilated_window_attention(qs, ks, vs):
    b, T = qs[0].shape[:2]
    scale = HEAD_DIM ** -0.5
    kps = [jnp.pad(k, ((0, 0), (w, 0), (0, 0), (0, 0))) for k, (w, _) in zip(ks, A_PATTERNS)]
    vps = [jnp.pad(v, ((0, 0), (w, 0), (0, 0), (0, 0))) for v, (w, _) in zip(vs, A_PATTERNS)]

    def block(i):
        start = i * Q_BLOCK
        outs, lses = [], []
        for q, kp, vp, (win, dil) in zip(qs, kps, vps, A_PATTERNS):
            nq, nk, span = Q_BLOCK // dil, win // dil, (win + Q_BLOCK) // dil
            qb = lax.dynamic_slice_in_dim(q, start, Q_BLOCK, axis=1).reshape(b, nq, dil, A_HEADS, HEAD_DIM)
            kb = lax.dynamic_slice_in_dim(kp, start, win + Q_BLOCK, axis=1).reshape(b, span, dil, A_HEADS, HEAD_DIM)
            vb = lax.dynamic_slice_in_dim(vp, start, win + Q_BLOCK, axis=1).reshape(b, span, dil, A_HEADS, HEAD_DIM)
            s = jnp.einsum('barhe,bcrhe->brhac', qb, kb).astype(jnp.float32) * scale
            a_idx = jnp.arange(nq)[:, None]
            c_idx = jnp.arange(span)[None, :]
            band = (c_idx >= a_idx) & (c_idx <= a_idx + nk)
            key_pos = start - win + jnp.arange(span)[None, :] * dil + jnp.arange(dil)[:, None]
            ok = band[None, :, :] & (key_pos >= 0)[:, None, :]
            s = jnp.where(ok[None, :, None], s, -jnp.inf)
            lse = jax.nn.logsumexp(s, axis=-1)
            p = jnp.exp(s - lse[..., None]).astype(vb.dtype)
            o = jnp.einsum('brhac,bcrhe->barhe', p, vb).reshape(b, Q_BLOCK, A_HEADS, HEAD_DIM)
            outs.append(o)
            lses.append(lse.transpose(0, 3, 1, 2).reshape(b, Q_BLOCK, A_HEADS))
        mix = jax.nn.softmax(jnp.stack(lses), axis=0)
        out = mix[0][..., None].astype(outs[0].dtype) * outs[0]
        for g in range(1, A_GROUPS):
            out = out + mix[g][..., None].astype(outs[g].dtype) * outs[g]
        return out

    out = lax.map(block, jnp.arange(T // Q_BLOCK))
    return out.transpose(1, 0, 2, 3, 4).reshape(b, T, A_WIDTH)


def indexer_sparse_attention(q, k, v, iq, ik, iw):
    b, T = q.shape[:2]
    top_k = min(TOPK_MAX, T // 4)
    scale = HEAD_DIM ** -0.5
    key_pos = jnp.arange(T)
    gather = jax.vmap(lambda arr, idx: arr[idx])

    def block(i):
        start = i * Q_BLOCK
        t = start + jnp.arange(Q_BLOCK)
        qi = lax.dynamic_slice_in_dim(iq, start, Q_BLOCK, axis=1)
        wi = lax.dynamic_slice_in_dim(iw, start, Q_BLOCK, axis=1).astype(jnp.float32)
        logits = jnp.einsum('bqhd,bsd->bqhs', qi, ik).astype(jnp.float32) * IDX_DIM ** -0.5
        score = jnp.einsum('bqhs,bqh->bqs', jax.nn.relu(logits), wi) * IDX_HEADS ** -0.5
        score = jnp.where((key_pos[None, :] <= t[:, None])[None], score, -jnp.inf)
        _, sel = lax.top_k(score, top_k)
        valid = sel <= t[None, :, None]
        kg = gather(k, sel)
        vg = gather(v, sel)
        qb = lax.dynamic_slice_in_dim(q, start, Q_BLOCK, axis=1)
        s = jnp.einsum('bqhe,bqjhe->bhqj', qb, kg).astype(jnp.float32) * scale
        s = jnp.where(valid[:, None], s, -jnp.inf)
        p = jax.nn.softmax(s, axis=-1).astype(vg.dtype)
        return jnp.einsum('bhqj,bqjhe->bqhe', p, vg)

    out = lax.map(block, jnp.arange(T // Q_BLOCK))
    return out.transpose(1, 0, 2, 3, 4).reshape(b, T, B_WIDTH)


def token_shift(x):
    return jnp.pad(x, ((0, 0), (1, 0), (0, 0)))[:, :-1]


def wkv7_scan(r, w, k, v, a, bb):
    b, T, H, N = r.shape

    def step(state, inp):
        rt, wt, kt, vt, at, bt = inp
        sa = jnp.einsum('bhij,bhj->bhi', state, at)
        state = state * wt[:, :, None, :] + sa[..., None] * bt[:, :, None, :] + vt[..., None] * kt[:, :, None, :]
        return state, jnp.einsum('bhij,bhj->bhi', state, rt)

    seq_major = tuple(jnp.moveaxis(t.astype(jnp.float32), 1, 0) for t in (r, w, k, v, a, bb))
    _, y = lax.scan(step, jnp.zeros((b, H, N, N), jnp.float32), seq_major)
    return jnp.moveaxis(y, 0, 1)


def rwkv7_time_mix(pc, mu, w0, w2, a0, a2, g2, k_k, k_a, r_k, gn_w, gn_b, v_first, v_lora):
    b, T, _ = pc.shape
    pc = pc + (token_shift(pc) - pc) * mu
    r, k, v, xw, xa, xg = _split(pc, (C_WIDTH, C_WIDTH, C_WIDTH, C_LORA_W, C_LORA_A, C_LORA_G))
    w = -jax.nn.softplus(-(w0 + jnp.tanh(xw) @ w2)) - 0.5
    a = jax.nn.sigmoid(a0 + xa @ a2)
    g = jax.nn.sigmoid(xg) @ g2
    if v_lora is not None:
        v0, v1, v2 = v_lora
        v = v + (v_first - v) * jax.nn.sigmoid(v0 + (v @ v1) @ v2)
    heads = lambda t: t.astype(jnp.float32).reshape(b, T, C_HEADS, HEAD_DIM)
    kk = heads(k * k_k)
    kk = kk / jnp.maximum(jnp.linalg.norm(kk, axis=-1, keepdims=True), 1e-12)
    k_mod = heads(k * (1.0 + (a - 1.0) * k_a))
    r_h, v_h, a_h = heads(r), heads(v), heads(a)
    decay = jnp.exp(-jnp.exp(heads(w)))
    y = wkv7_scan(r_h, decay, k_mod, v_h, -kk, kk * a_h)
    y_mu = jnp.mean(y, axis=-1, keepdims=True)
    y_var = jnp.mean(jnp.square(y - y_mu), axis=-1, keepdims=True)
    y = ((y - y_mu) * lax.rsqrt(y_var + C_GN_EPS)).reshape(b, T, C_WIDTH) * gn_w + gn_b
    bonus = jnp.sum(r_h * k_mod * r_k, axis=-1, keepdims=True) * v_h
    o = (y + bonus.reshape(b, T, C_WIDTH)) * g
    return o.astype(pc.dtype), v


def ssd_chunked(x, a, bm, cm):
    b, T, H, P = x.shape
    nc = T // D_CHUNK
    x = x.reshape(b, nc, D_CHUNK, H, P)
    bm = bm.reshape(b, nc, D_CHUNK, H, -1)
    cm = cm.reshape(b, nc, D_CHUNK, H, -1)
    a_cs = jnp.cumsum(a.reshape(b, nc, D_CHUNK, H).transpose(0, 3, 1, 2), axis=-1)
    seg = a_cs[..., :, None] - a_cs[..., None, :]
    causal = jnp.tril(jnp.ones((D_CHUNK, D_CHUNK), dtype=bool))
    decay_ls = jnp.exp(jnp.where(causal, seg, -jnp.inf))
    scores = jnp.einsum('bclhn,bcshn->bhcls', cm, bm) * decay_ls
    y_diag = jnp.einsum('bhcls,bcshp->bclhp', scores, x)
    decay_to_end = jnp.exp(a_cs[..., -1:] - a_cs)
    chunk_states = jnp.einsum('bclhn,bhcl,bclhp->bchpn', bm, decay_to_end, x)
    chunk_decay = jnp.exp(a_cs[..., -1])

    def step(state, inp):
        st, dc = inp
        return state * dc[..., None, None] + st, state

    _, states_in = lax.scan(step, jnp.zeros((b, H, P, bm.shape[-1]), jnp.float32),
                            (jnp.moveaxis(chunk_states, 1, 0), jnp.moveaxis(chunk_decay, 2, 0)))
    states_in = jnp.moveaxis(states_in, 0, 1)
    y_off = jnp.einsum('bclhn,bchpn,bhcl->bclhp', cm, states_in, jnp.exp(a_cs))
    return (y_diag + y_off).reshape(b, T, H, P)


def mamba2_mixer(z, xbc, dt_raw, conv_w, conv_b, dt_bias, a_log, d_skip, norm_w):
    b, T, _ = z.shape
    xbc = lax.conv_general_dilated(xbc, conv_w[:, None, :], window_strides=(1,),
                                   padding=[(D_CONV - 1, 0)],
                                   dimension_numbers=('NWC', 'WIO', 'NWC'),
                                   feature_group_count=D_XBC)
    xbc = jax.nn.silu(xbc + conv_b).astype(jnp.float32)
    heads_per_group = D_HEADS // D_GROUPS
    xs = xbc[..., :D_INNER].reshape(b, T, D_HEADS, HEAD_DIM)
    bm = xbc[..., D_INNER:D_INNER + D_GROUPS * D_STATE].reshape(b, T, D_GROUPS, D_STATE)
    cm = xbc[..., D_INNER + D_GROUPS * D_STATE:].reshape(b, T, D_GROUPS, D_STATE)
    bm = jnp.repeat(bm, heads_per_group, axis=2)
    cm = jnp.repeat(cm, heads_per_group, axis=2)
    dt = jax.nn.softplus(dt_raw.astype(jnp.float32) + dt_bias.astype(jnp.float32))
    a = -jnp.exp(a_log.astype(jnp.float32))
    y = ssd_chunked(xs * dt[..., None], dt * a, bm, cm) + d_skip.astype(jnp.float32)[:, None] * xs
    y = y.reshape(b, T, D_INNER) * jax.nn.silu(z.astype(jnp.float32))
    y = y.reshape(b, T, D_GROUPS, D_INNER // D_GROUPS)
    y = y * lax.rsqrt(jnp.mean(jnp.square(y), axis=-1, keepdims=True) + D_NORM_EPS)
    return (y.reshape(b, T, D_INNER) * norm_w).astype(z.dtype)


def grouped_expert_ffn(x2d, expert, gate, w_gate, w_up, w_down):
    m, dm = x2d.shape
    n_assign = m * TOP_K_EXPERTS
    flat_e = expert.reshape(-1)
    flat_tok = jnp.arange(n_assign) // TOP_K_EXPERTS
    flat_gate = gate.reshape(-1)
    order = jnp.argsort(flat_e)
    se, stok, sgate = flat_e[order], flat_tok[order], flat_gate[order]
    counts = jnp.bincount(flat_e, length=N_EXPERTS)
    padded = (counts + MOE_BLOCK - 1) // MOE_BLOCK * MOE_BLOCK
    pad_end = jnp.cumsum(padded)
    pad_start = pad_end - padded
    start = jnp.cumsum(counts) - counts
    dest = pad_start[se] + jnp.arange(n_assign) - start[se]
    cap = (n_assign + N_EXPERTS * (MOE_BLOCK - 1) + MOE_BLOCK - 1) // MOE_BLOCK * MOE_BLOCK
    n_blocks = cap // MOE_BLOCK
    buf_tok = jnp.full((cap,), m, dtype=jnp.int32).at[dest].set(stok)
    x_ext = jnp.concatenate([x2d, jnp.zeros((1, dm), x2d.dtype)], axis=0)
    xb = x_ext[buf_tok].reshape(n_blocks, MOE_BLOCK, dm)
    blk_expert = jnp.minimum(jnp.searchsorted(pad_end, jnp.arange(n_blocks) * MOE_BLOCK, side='right'),
                             N_EXPERTS - 1)

    def expert_block(args):
        xblk, e = args
        h = jax.nn.silu(xblk @ w_gate[e]) * (xblk @ w_up[e])
        return h @ w_down[e]

    yb = lax.map(expert_block, (xb, blk_expert)).reshape(cap, dm)
    y = yb[dest] * sgate[:, None]
    return jnp.zeros_like(x2d).at[stok].add(y)


def hierarchical_moe(x2d, wg, bg, we, be, w_gate, w_up, w_down):
    m = x2d.shape[0]
    xf = x2d.astype(jnp.float32)
    p_group = jax.nn.softmax(xf @ wg.astype(jnp.float32) + bg.astype(jnp.float32), axis=-1)
    pg_top, g_sel = lax.top_k(p_group, 1)
    logits_e = (xf @ we.astype(jnp.float32) + be.astype(jnp.float32)).reshape(m, N_EXPERT_GROUPS, EXPERTS_PER_GROUP)
    logits_e = logits_e[jnp.arange(m), g_sel[:, 0]]
    pe_top, e_sel = lax.top_k(jax.nn.softmax(logits_e, axis=-1), TOP_K_EXPERTS)
    gate = pg_top * pe_top / jnp.sum(pe_top, axis=-1, keepdims=True)
    expert = g_sel * EXPERTS_PER_GROUP + e_sel
    return grouped_expert_ffn(x2d, expert, gate.astype(x2d.dtype), w_gate, w_up, w_down)


def setup_inputs(seed: int = 0) -> dict:
    key = jax.random.key(seed)
    ks = iter(jax.random.split(key, 48))
    L = DEPTH

    def nrm(shape, scale):
        return jax.random.normal(next(ks), shape, jnp.float32) * scale

    def unif(shape, lo, hi):
        return jax.random.uniform(next(ks), shape, jnp.float32, minval=lo, maxval=hi)

    dt = jnp.exp(unif((L, D_HEADS), math.log(1e-3), math.log(1e-1)))
    return {
        'x': nrm((BATCH, SEQ, D_MODEL), 1.0),
        'w_in': nrm((L, D_MODEL, IN_WIDTH), D_MODEL ** -0.5),
        'c_mu': unif((L, C_IN), 0.0, 1.0),
        'c_w0': unif((L, C_WIDTH), -6.0, -1.0),
        'c_w2': nrm((L, C_LORA_W, C_WIDTH), 0.1),
        'c_a0': nrm((L, C_WIDTH), 0.1),
        'c_a2': nrm((L, C_LORA_A, C_WIDTH), C_LORA_A ** -0.5),
        'c_g2': nrm((L, C_LORA_G, C_WIDTH), C_LORA_G ** -0.5),
        'c_kk': 0.85 + nrm((L, C_WIDTH), 0.02),
        'c_ka': 1.0 + nrm((L, C_WIDTH), 0.02),
        'c_rk': nrm((L, C_HEADS, HEAD_DIM), 0.1),
        'c_gn_w': 1.0 + nrm((L, C_WIDTH), 0.02),
        'c_gn_b': nrm((L, C_WIDTH), 0.02),
        'c_v0': nrm((L - 1, C_WIDTH), 0.1),
        'c_v1': nrm((L - 1, C_WIDTH, C_LORA_V), C_WIDTH ** -0.5),
        'c_v2': nrm((L - 1, C_LORA_V, C_WIDTH), C_LORA_V ** -0.5),
        'd_conv_w': nrm((L, D_CONV, D_XBC), D_CONV ** -0.5),
        'd_conv_b': nrm((L, D_XBC), 0.02),
        'd_dt_bias': dt + jnp.log(-jnp.expm1(-dt)),
        'd_a_log': jnp.log(unif((L, D_HEADS), 1.0, 16.0)),
        'd_skip': 1.0 + nrm((L, D_HEADS), 0.02),
        'd_norm_w': 1.0 + nrm((L, D_INNER), 0.02),
        'w_branch': nrm((L, N_BRANCH, BRANCH_WIDTH, D_MODEL), BRANCH_WIDTH ** -0.5),
        'w_out': nrm((L, D_MODEL, D_MODEL), D_MODEL ** -0.5 * DEEPNORM_BETA),
        'ln1_g': 1.0 + nrm((L, D_MODEL), 0.02),
        'ln1_b': nrm((L, D_MODEL), 0.02),
        'r_group': nrm((L, D_MODEL, N_EXPERT_GROUPS), D_MODEL ** -0.5),
        'r_group_b': nrm((L, N_EXPERT_GROUPS), 0.01),
        'r_expert': nrm((L, D_MODEL, N_EXPERTS), D_MODEL ** -0.5),
        'r_expert_b': nrm((L, N_EXPERTS), 0.01),
        'e_gate': nrm((L, N_EXPERTS, D_MODEL, D_EXPERT), D_MODEL ** -0.5),
        'e_up': nrm((L, N_EXPERTS, D_MODEL, D_EXPERT), D_MODEL ** -0.5),
        'e_down': nrm((L, N_EXPERTS, D_EXPERT, D_MODEL), D_EXPERT ** -0.5 * DEEPNORM_BETA),
        'ln2_g': 1.0 + nrm((L, D_MODEL), 0.02),
        'ln2_b': nrm((L, D_MODEL), 0.02),
    }


def reference(x, w_in, c_mu, c_w0, c_w2, c_a0, c_a2, c_g2, c_kk, c_ka, c_rk, c_gn_w, c_gn_b,
              c_v0, c_v1, c_v2, d_conv_w, d_conv_b, d_dt_bias, d_a_log, d_skip, d_norm_w,
              w_branch, w_out, ln1_g, ln1_b, r_group, r_group_b, r_expert, r_expert_b,
              e_gate, e_up, e_down, ln2_g, ln2_b):
    b, T, _ = x.shape
    v_first = None
    for l in range(DEPTH):
        seg, off = {}, 0
        for name, size in IN_SEGMENTS:
            seg[name] = x @ w_in[l, :, off:off + size]
            off += size

        a_qkv = seg['a_qkv'].reshape(b, T, 3, A_GROUPS, A_HEADS, HEAD_DIM)
        o_a = dilated_window_attention([a_qkv[:, :, 0, g] for g in range(A_GROUPS)],
                                       [a_qkv[:, :, 1, g] for g in range(A_GROUPS)],
                                       [a_qkv[:, :, 2, g] for g in range(A_GROUPS)])

        b_qkv = seg['b_qkv'].reshape(b, T, 3, B_HEADS, HEAD_DIM)
        o_b = indexer_sparse_attention(b_qkv[:, :, 0], b_qkv[:, :, 1], b_qkv[:, :, 2],
                                       seg['b_idx_q'].reshape(b, T, IDX_HEADS, IDX_DIM),
                                       seg['b_idx_k'], seg['b_idx_w'])

        v_lora = None if l == 0 else (c_v0[l - 1], c_v1[l - 1], c_v2[l - 1])
        o_c, v_c = rwkv7_time_mix(seg['c_in'], c_mu[l], c_w0[l], c_w2[l], c_a0[l], c_a2[l], c_g2[l],
                                  c_kk[l], c_ka[l], c_rk[l], c_gn_w[l], c_gn_b[l], v_first, v_lora)
        if l == 0:
            v_first = v_c

        o_d = mamba2_mixer(seg['d_z'], seg['d_xbc'], seg['d_dt'], d_conv_w[l], d_conv_b[l],
                           d_dt_bias[l], d_a_log[l], d_skip[l], d_norm_w[l])

        gates = jax.nn.sigmoid(seg['gates'].reshape(b, T, N_BRANCH, D_MODEL))
        merged = jnp.zeros_like(x)
        for n, o_n in enumerate((o_a, o_b, o_c, o_d)):
            merged = merged + gates[:, :, n] * (o_n @ w_branch[l, n])
        x = layer_norm(DEEPNORM_ALPHA * x + merged @ w_out[l], ln1_g[l], ln1_b[l])

        y = hierarchical_moe(x.reshape(b * T, D_MODEL), r_group[l], r_group_b[l], r_expert[l],
                             r_expert_b[l], e_gate[l], e_up[l], e_down[l])
        x = layer_norm(DEEPNORM_ALPHA * x + y.reshape(b, T, D_MODEL), ln2_g[l], ln2_b[l])
    return x
```

```cpp
#include <hip/hip_runtime.h>
#include <cstdio>
#include <cstdint>

#ifndef N_LAUNCH_MODE
#define N_LAUNCH_MODE 0
#endif

namespace pg8 {
#define PG8_LAS __attribute__((address_space(3)))
typedef unsigned short bf16_t;
typedef short bf16x8 __attribute__((ext_vector_type(8)));
typedef float f32x4 __attribute__((ext_vector_type(4)));
typedef unsigned u32x4 __attribute__((ext_vector_type(4)));
constexpr int BM = 256, BK = 64, HALF = 128, HTB = HALF * BK * 2, STAGE_BYTES = 8 * HTB, NXCD = 8, WGM = 8;

__host__ __device__ __forceinline__ int lds_byte(int r, int c) { const int st = (r >> 4) * 2 + (c >> 5), rr = r & 15, cc = c & 31, ob = rr * 64 + cc * 2; return st * 1024 + (ob ^ (((ob >> 9) & 1) << 5)); }
__host__ __device__ __forceinline__ void stage_rc(int b, int& R, int& C) { const int st = b / 1024, sb = b % 1024, swz = sb ^ (((sb >> 9) & 1) << 5); R = (st >> 1) * 16 + swz / 64; C = (st & 1) * 32 + (swz % 64) / 2; }
__host__ __device__ __forceinline__ int perm32(int rho) { const int n = rho >> 4, i = rho & 15; return 8 * (i >> 2) + 4 * n + (i & 3); }

struct Unit { int pm, pn, aux; size_t aoff, boff; };
struct Gemm { const bf16_t* A; const bf16_t* Bt; int lda, ldb, K; };

__device__ __forceinline__ void tile_of(int L, int nM, int nN, int& pm, int& pn) {
    const int nwg = nM * nN; int wgid = L;
    { const int q = nwg / NXCD, r = nwg % NXCD, xcd = wgid % NXCD, off = wgid / NXCD; wgid = (xcd < r ? xcd * (q + 1) : r * (q + 1) + (xcd - r) * q) + off; }
    const int nig = WGM * nN, gid = wgid / nig, fm = gid * WGM, gsz = (nM - fm) < WGM ? (nM - fm) : WGM;
    pm = fm + ((wgid % nig) % gsz); pn = (wgid % nig) / gsz;
}
struct StaticOrder {
    int nM, nN, nwg, G, c, lda, ldb;
    __device__ void init(int M, int N, int G_, int c_, int lda_, int ldb_) { nM = M / BM; nN = N / BM; nwg = nM * nN; G = G_; c = c_; lda = lda_; ldb = ldb_; }
    __device__ bool next(int i, Unit& u) const {
        const long L = (long)i * G + c; if (L >= nwg) return false;
        tile_of((int)L, nM, nN, u.pm, u.pn); u.aux = 0;
        u.aoff = (size_t)u.pm * BM * lda * 2; u.boff = (size_t)u.pn * BM * ldb * 2; return true;
    }
};

__device__ __forceinline__ unsigned cvt_pk_bf16(float lo, float hi) { unsigned r; asm volatile("v_cvt_pk_bf16_f32 %0, %1, %2" : "=v"(r) : "v"(lo), "v"(hi)); return r; }

template <class Epi, class Sched, bool ALIGN_EPI = true, bool SP2 = true>
__device__ __forceinline__ void gemm_phase(PG8_LAS unsigned char* lds, const Gemm g, const Sched& S, const Epi& E) {
    const int tid = threadIdx.x, wid = __builtin_amdgcn_readfirstlane(tid >> 6), lane = tid & 63, wr = wid >> 2, wc = wid & 3, fr = lane & 15, fq = lane >> 4;
    const int K = g.K, nt = K / BK;
    unsigned voffA[2], voffB[2];
#pragma unroll
    for (int i = 0; i < 2; ++i) { int R, C; stage_rc(tid * 16 + i * 8192, R, C); const int Rb = Epi::PERM ? ((R & ~31) + perm32(R & 31)) : R;
        voffA[i] = (unsigned)(R * g.lda + C) * 2u; voffB[i] = (unsigned)(Rb * g.ldb + C) * 2u; }
    const size_t kstep = (size_t)(BK * 2);
    const size_t hstepA = (size_t)HALF * g.lda * 2, hstepB = (size_t)HALF * g.ldb * 2;
    const unsigned ldsw = (unsigned)wid * 1024u;
    const int aoff = lds_byte(wr * 64 + fr, fq * 8), boff = lds_byte(wc * 32 + fr, fq * 8);
#define PG8_SA(b, h) (((b) * 2 + (h)) * HTB)
#define PG8_SB(b, h) ((4 + (b) * 2 + (h)) * HTB)
#define PG8_STAGE(bufoff, gbase, voff) do { _Pragma("unroll") for (int _i = 0; _i < 2; ++_i) \
        __builtin_amdgcn_global_load_lds((const unsigned*)((const char*)(gbase) + (voff)[_i]), (PG8_LAS unsigned*)(lds + (bufoff) + ldsw + _i * 8192), 16, 0, 0); } while (0)
#define PG8_LDA(dst, b, h) do { _Pragma("unroll") for (int m = 0; m < 4; ++m) _Pragma("unroll") for (int k = 0; k < 2; ++k) dst[m][k] = *(const PG8_LAS bf16x8*)(lds + PG8_SA(b, h) + aoff + m * 2048 + k * 1024); } while (0)
#define PG8_LDB(dst, b, h) do { _Pragma("unroll") for (int n = 0; n < 2; ++n) _Pragma("unroll") for (int k = 0; k < 2; ++k) dst[n][k] = *(const PG8_LAS bf16x8*)(lds + PG8_SB(b, h) + boff + n * 2048 + k * 1024); } while (0)
#define PG8_MMA(ai, bj, At, Bt) do { __builtin_amdgcn_s_setprio(1); _Pragma("unroll") for (int m = 0; m < 4; ++m) _Pragma("unroll") for (int n = 0; n < 2; ++n) _Pragma("unroll") for (int k = 0; k < 2; ++k) \
        acc[ai][bj][m][n] = __builtin_amdgcn_mfma_f32_16x16x32_bf16(Bt[n][k], At[m][k], acc[ai][bj][m][n], 0, 0, 0); __builtin_amdgcn_s_setprio(0); } while (0)
#define PG8_WAIT_V(n) asm volatile("s_waitcnt vmcnt(" #n ")" ::: "memory")
#define PG8_WAIT_L(n) asm volatile("s_waitcnt lgkmcnt(" #n ")" ::: "memory")
#define PG8_BAR __builtin_amdgcn_s_barrier()
#define PG8_SCHED __builtin_amdgcn_sched_barrier(0)
    Unit cur, nxt; int ui = 0;
    if (!S.next(0, cur)) return;
    f32x4 acc[2][2][4][2];
#pragma unroll
    for (int a = 0; a < 2; ++a)
#pragma unroll
        for (int b = 0; b < 2; ++b)
#pragma unroll
            for (int m = 0; m < 4; ++m)
#pragma unroll
                for (int n = 0; n < 2; ++n) acc[a][b][m][n] = (f32x4){0.f, 0.f, 0.f, 0.f};
    bf16x8 At[4][2], B0[2][2], B1[2][2];
    const char* cA = (const char*)g.A + cur.aoff; const char* cB = (const char*)g.Bt + cur.boff;
    if constexpr (SP2) {
        PG8_STAGE(PG8_SB(0, 0), cB, voffB); PG8_STAGE(PG8_SB(0, 1), cB + hstepB, voffB); PG8_STAGE(PG8_SA(0, 0), cA, voffA); PG8_STAGE(PG8_SA(0, 1), cA + hstepA, voffA);
        if (wr == 1) PG8_BAR;
        PG8_WAIT_V(2); PG8_BAR;
        PG8_STAGE(PG8_SB(1, 0), cB + kstep, voffB); PG8_STAGE(PG8_SA(1, 0), cA + kstep, voffA); PG8_STAGE(PG8_SB(1, 1), cB + hstepB + kstep, voffB);
        PG8_WAIT_V(6); PG8_BAR;
    } else {
        PG8_STAGE(PG8_SB(0, 0), cB, voffB); PG8_STAGE(PG8_SA(0, 0), cA, voffA); PG8_STAGE(PG8_SB(0, 1), cB + hstepB, voffB); PG8_STAGE(PG8_SA(0, 1), cA + hstepA, voffA);
        if (wr == 1) PG8_BAR;
        PG8_WAIT_V(4); PG8_BAR;
        PG8_STAGE(PG8_SB(1, 0), cB + kstep, voffB); PG8_STAGE(PG8_SA(1, 0), cA + kstep, voffA); PG8_STAGE(PG8_SB(1, 1), cB + hstepB + kstep, voffB);
        PG8_WAIT_V(6); PG8_BAR;
    }
    for (;;) {
        const bool has_next = S.next(ui + 1, nxt);
        const char* nA = has_next ? (const char*)g.A + nxt.aoff : cA; const char* nB = has_next ? (const char*)g.Bt + nxt.boff : cB;
        for (int t = 0; t < nt; t += 2) {
            const bool last = (t == nt - 2);
            const char* a1 = cA + (size_t)(t + 1) * kstep;
            const char* a2 = last ? nA : cA + (size_t)(t + 2) * kstep; const char* b2 = last ? nB : cB + (size_t)(t + 2) * kstep;
            const char* a3 = a2 + kstep; const char* b3 = b2 + kstep;
            if constexpr (SP2) {
            PG8_LDB(B0, 0, 0); PG8_LDB(B1, 0, 1); PG8_SCHED; PG8_LDA(At, 0, 0); PG8_STAGE(PG8_SA(1, 1), a1 + hstepA, voffA);
            PG8_WAIT_V(8); PG8_WAIT_L(0); PG8_BAR; PG8_MMA(0, 0, At, B0); PG8_MMA(0, 1, At, B1); PG8_BAR; PG8_SCHED;
            PG8_LDA(At, 0, 1); PG8_STAGE(PG8_SB(0, 0), b2, voffB); PG8_STAGE(PG8_SB(0, 1), b2 + hstepB, voffB); PG8_STAGE(PG8_SA(0, 0), a2, voffA);
            PG8_WAIT_V(8); PG8_WAIT_L(0); PG8_BAR; PG8_MMA(1, 0, At, B0); PG8_MMA(1, 1, At, B1); PG8_BAR; PG8_SCHED;
            PG8_LDB(B0, 1, 0); PG8_LDB(B1, 1, 1); PG8_SCHED; PG8_LDA(At, 1, 0); PG8_STAGE(PG8_SA(0, 1), a2 + hstepA, voffA);
            PG8_WAIT_V(8); PG8_WAIT_L(0); PG8_BAR; PG8_MMA(0, 0, At, B0); PG8_MMA(0, 1, At, B1); PG8_BAR; PG8_SCHED;
            PG8_LDA(At, 1, 1); PG8_STAGE(PG8_SB(1, 0), b3, voffB); PG8_STAGE(PG8_SB(1, 1), b3 + hstepB, voffB); PG8_STAGE(PG8_SA(1, 0), a3, voffA);
            PG8_WAIT_V(8); PG8_WAIT_L(0); PG8_BAR; PG8_MMA(1, 0, At, B0); PG8_MMA(1, 1, At, B1); PG8_BAR; PG8_SCHED;
            } else {
            PG8_LDB(B0, 0, 0); PG8_SCHED; PG8_LDA(At, 0, 0); PG8_STAGE(PG8_SA(1, 1), a1 + hstepA, voffA);
            PG8_WAIT_L(8); PG8_BAR; PG8_WAIT_L(0); PG8_MMA(0, 0, At, B0); PG8_BAR; PG8_SCHED;
            PG8_LDB(B1, 0, 1); PG8_STAGE(PG8_SB(0, 0), b2, voffB);
            PG8_BAR; PG8_WAIT_L(0); PG8_MMA(0, 1, At, B1); PG8_BAR;
            PG8_LDA(At, 0, 1); PG8_STAGE(PG8_SA(0, 0), a2, voffA);
            PG8_BAR; PG8_WAIT_L(0); PG8_MMA(1, 0, At, B0); PG8_BAR; PG8_SCHED;
            PG8_STAGE(PG8_SB(0, 1), b2 + hstepB, voffB);
            PG8_WAIT_V(6); PG8_BAR; PG8_MMA(1, 1, At, B1); PG8_BAR;
            PG8_LDB(B0, 1, 0); PG8_SCHED; PG8_LDA(At, 1, 0); PG8_STAGE(PG8_SA(0, 1), a2 + hstepA, voffA);
            PG8_WAIT_L(8); PG8_BAR; PG8_WAIT_L(0); PG8_MMA(0, 0, At, B0); PG8_BAR; PG8_SCHED;
            PG8_LDB(B1, 1, 1); PG8_STAGE(PG8_SB(1, 0), b3, voffB);
            PG8_BAR; PG8_WAIT_L(0); PG8_MMA(0, 1, At, B1); PG8_BAR;
            PG8_LDA(At, 1, 1); PG8_STAGE(PG8_SA(1, 0), a3, voffA);
            PG8_BAR; PG8_WAIT_L(0); PG8_MMA(1, 0, At, B0); PG8_BAR; PG8_SCHED;
            PG8_STAGE(PG8_SB(1, 1), b3 + hstepB, voffB);
            PG8_WAIT_V(6); PG8_BAR; PG8_MMA(1, 1, At, B1); PG8_BAR;
            }
        }
        if constexpr (ALIGN_EPI) { if (wr == 0) PG8_BAR; }
        E(acc, cur, wr, wc, fr, fq);
        if (!has_next) break;
#pragma unroll
        for (int a = 0; a < 2; ++a)
#pragma unroll
            for (int b = 0; b < 2; ++b)
#pragma unroll
                for (int m = 0; m < 4; ++m)
#pragma unroll
                    for (int n = 0; n < 2; ++n) acc[a][b][m][n] = (f32x4){0.f, 0.f, 0.f, 0.f};
        cur = nxt; cA = nA; cB = nB; ++ui;
        if constexpr (ALIGN_EPI) { if (wr == 1) PG8_BAR; }
    }
    PG8_WAIT_V(0);
    if constexpr (!ALIGN_EPI) { if (wr == 0) PG8_BAR; }
    PG8_BAR;
#undef PG8_SA
#undef PG8_SB
#undef PG8_STAGE
#undef PG8_LDA
#undef PG8_LDB
#undef PG8_MMA
#undef PG8_WAIT_V
#undef PG8_WAIT_L
#undef PG8_BAR
#undef PG8_SCHED
}
}

#define LAS __attribute__((address_space(3)))
typedef unsigned short bf16;
typedef float f32x4 __attribute__((ext_vector_type(4)));
typedef unsigned u32x4 __attribute__((ext_vector_type(4)));
typedef unsigned u32x2 __attribute__((ext_vector_type(2)));

constexpr int NB = 8, T = 4096, D = 1024, M = NB * T, NL = 2;
constexpr int INW = 9160;
constexpr int PP = 5120;
constexpr int C_AQ = 0, C_AK = 768, C_AV = 1536, C_BQ = 2304, C_BK = 2560, C_BV = 2816, C_IQ = 3072, C_IK = 3328, C_C = 3392, C_DZ = 4288, C_DX = 4544, C_IW = 5056, C_DT = 5060, C_END = 5064;
constexpr int NEXP = 32, DEXP = 512;
constexpr int CAP = 73728;
constexpr float LN_EPS = 1e-5f;
constexpr float ALPHA = 1.4142135623730951f;

constexpr size_t MiB = 1u << 20;
constexpr size_t WS_CTL = 0, CTL_BYTES = 1 * MiB;
constexpr size_t WS_WINT = 2 * MiB;
constexpr size_t WS_WGT = 22 * MiB;
constexpr size_t WS_WBRT = 38 * MiB;
constexpr size_t WS_WOUTT = 42 * MiB;
constexpr size_t WS_WRT = 46 * MiB;
constexpr size_t WS_ROUTE = 47 * MiB;
constexpr size_t WS_XB = 48 * MiB;
constexpr size_t WS_O = 112 * MiB;
constexpr size_t WS_VF = 176 * MiB;
constexpr size_t WS_P = 192 * MiB;
constexpr size_t WS_GS = 192 * MiB;
constexpr size_t WS_MERGED = 448 * MiB;
constexpr size_t WS_XS = 192 * MiB;
constexpr size_t WS_H = 336 * MiB;
constexpr size_t WS_WGU = 408 * MiB;
constexpr size_t WS_WD = 472 * MiB;
constexpr size_t WS_END = 512 * MiB;
constexpr int CW_CNT = 64;

constexpr int RING_BYTES = 131072, MISC_OFF = RING_BYTES, LDS_BYTES = 147456;
constexpr int NWAVES = 8, NTHR = 512;

__device__ __forceinline__ float bf2f(bf16 v) { return __uint_as_float(((unsigned)v) << 16); }
__device__ __forceinline__ unsigned f2bf(float f) { unsigned u = __float_as_uint(f); return (u + 0x7fffu + ((u >> 16) & 1u)) >> 16; }
__device__ __forceinline__ unsigned pk2(float lo, float hi) { return f2bf(lo) | (f2bf(hi) << 16); }
__device__ __forceinline__ float wave_sum(float v) {
#pragma unroll
    for (int o = 1; o < 64; o <<= 1) v += __shfl_xor(v, o);
    return v;
}
__device__ __forceinline__ float wave_max(float v) {
#pragma unroll
    for (int o = 1; o < 64; o <<= 1) v = fmaxf(v, __shfl_xor(v, o));
    return v;
}
__device__ __forceinline__ float sigmoidf_(float x) { return 1.f / (1.f + __expf(-x)); }
__device__ __forceinline__ float softplusf_(float x) { return x > 20.f ? x : log1pf(__expf(x)); }
__device__ __forceinline__ float siluf_(float x) { return x / (1.f + __expf(-x)); }

struct Args { const float* in[35]; float* out; unsigned char* ws; int ph_lo, ph_hi; };
enum { I_X = 0, I_WIN, I_CMU, I_CW0, I_CW2, I_CA0, I_CA2, I_CG2, I_CKK, I_CKA, I_CRK, I_CGNW, I_CGNB, I_CV0, I_CV1, I_CV2, I_DCW, I_DCB, I_DDTB, I_DALOG, I_DSKIP, I_DNW,
       I_WBR, I_WOUT, I_LN1G, I_LN1B, I_RG, I_RGB, I_RE, I_REB, I_EG, I_EU, I_ED, I_LN2G, I_LN2B };

__device__ __forceinline__ void transpose_item(const float* W, int ldn, int c0, int ncols, bf16* dst, int dld, int r0, int dk0, int kb, int nb, LAS float* scr, int lane) {
    const int k0 = 64 * kb, n0 = 32 * nb;
    const bool okn = (n0 + (lane & 31)) < ncols;
#pragma unroll 8
    for (int i = 0; i < 32; ++i) { const int kk = 2 * i + (lane >> 5); scr[kk * 33 + (lane & 31)] = okn ? W[(size_t)(k0 + kk) * ldn + c0 + n0 + (lane & 31)] : 0.f; }
    asm volatile("s_waitcnt lgkmcnt(0)" ::: "memory");
    const int c = lane & 7;
#pragma unroll
    for (int j = 0; j < 4; ++j) { const int n = (lane >> 3) + 8 * j; const LAS float* s = scr + (8 * c) * 33 + n;
        u32x4 o; o.x = pk2(s[0 * 33], s[1 * 33]); o.y = pk2(s[2 * 33], s[3 * 33]); o.z = pk2(s[4 * 33], s[5 * 33]); o.w = pk2(s[6 * 33], s[7 * 33]);
        if (n0 + n < ncols) *(u32x4*)(dst + (size_t)(r0 + n0 + n) * dld + dk0 + k0 + 8 * c) = o; }
    asm volatile("s_waitcnt lgkmcnt(0)" ::: "memory");
}

struct EpiStoreBf16 {
    static constexpr bool PERM = true;
    bf16* O; int ldc; int act; int ncols;
    __device__ __forceinline__ void operator()(const pg8::f32x4 (&acc)[2][2][4][2], const pg8::Unit& u, int wr, int wc, int fr, int fq) const {
        const int row0 = u.pm * 256 + wr * 64 + fr; const int col0 = u.pn * 256 + wc * 32 + 8 * fq;
#pragma unroll
        for (int ai = 0; ai < 2; ++ai)
#pragma unroll
            for (int m = 0; m < 4; ++m) { bf16* rowp = O + (size_t)(row0 + ai * 128 + m * 16) * ldc + col0;
#pragma unroll
                for (int bj = 0; bj < 2; ++bj) { pg8::f32x4 v0 = acc[ai][bj][m][0], v1 = acc[ai][bj][m][1];
                    if (act == 1) {
#pragma unroll
                        for (int j = 0; j < 4; ++j) { v0[j] = sigmoidf_(v0[j]); v1[j] = sigmoidf_(v1[j]); } }
                    u32x4 w; w.x = pg8::cvt_pk_bf16(v0[0], v0[1]); w.y = pg8::cvt_pk_bf16(v0[2], v0[3]); w.z = pg8::cvt_pk_bf16(v1[0], v1[1]); w.w = pg8::cvt_pk_bf16(v1[2], v1[3]);
                    if (col0 + bj * 128 < ncols) *(u32x4*)(rowp + bj * 128) = w; } }
    }
};
struct EpiBranch {
    static constexpr bool PERM = true;
    const bf16* GS; bf16* MG;
    __device__ __forceinline__ void operator()(const pg8::f32x4 (&acc)[2][2][4][2], const pg8::Unit& u, int wr, int wc, int fr, int fq) const {
        const int row0 = u.pm * 256 + wr * 64 + fr; const int col0 = u.pn * 256 + wc * 32 + 8 * fq; const int n = u.aux;
#pragma unroll
        for (int ai = 0; ai < 2; ++ai)
#pragma unroll
            for (int m = 0; m < 4; ++m) { const size_t r = (size_t)(row0 + ai * 128 + m * 16);
#pragma unroll
                for (int bj = 0; bj < 2; ++bj) {
                    const u32x4 gv = *(const u32x4*)(GS + r * 4096 + n * 1024 + col0 + bj * 128);
                    bf16* mp = MG + r * 1024 + col0 + bj * 128;
                    float v[8];
#pragma unroll
                    for (int j = 0; j < 4; ++j) { v[j] = acc[ai][bj][m][0][j]; v[4 + j] = acc[ai][bj][m][1][j]; }
                    const unsigned gw[4] = {gv.x, gv.y, gv.z, gv.w};
#pragma unroll
                    for (int j = 0; j < 4; ++j) { v[2 * j] *= __uint_as_float(gw[j] << 16); v[2 * j + 1] *= __uint_as_float(gw[j] & 0xffff0000u); }
                    if (n != 0) { const u32x4 ov = *(const u32x4*)mp; const unsigned ow[4] = {ov.x, ov.y, ov.z, ov.w};
#pragma unroll
                        for (int j = 0; j < 4; ++j) { v[2 * j] += __uint_as_float(ow[j] << 16); v[2 * j + 1] += __uint_as_float(ow[j] & 0xffff0000u); } }
                    u32x4 w; w.x = pg8::cvt_pk_bf16(v[0], v[1]); w.y = pg8::cvt_pk_bf16(v[2], v[3]); w.z = pg8::cvt_pk_bf16(v[4], v[5]); w.w = pg8::cvt_pk_bf16(v[6], v[7]);
                    *(u32x4*)mp = w; asm volatile("" ::: "memory"); } }
    }
};
struct EpiResid {
    static constexpr bool PERM = false;
    float* X;
    __device__ __forceinline__ void operator()(const pg8::f32x4 (&acc)[2][2][4][2], const pg8::Unit& u, int wr, int wc, int fr, int fq) const {
        const int row0 = u.pm * 256 + wr * 64 + fr, col0 = u.pn * 256 + wc * 32 + 4 * fq;
#pragma unroll
        for (int ai = 0; ai < 2; ++ai)
#pragma unroll
            for (int m = 0; m < 4; ++m) { float* rowp = X + (size_t)(row0 + ai * 128 + m * 16) * D + col0;
#pragma unroll
                for (int bj = 0; bj < 2; ++bj)
#pragma unroll
                    for (int n = 0; n < 2; ++n) { pg8::f32x4* p = (pg8::f32x4*)(rowp + bj * 128 + n * 16); *p = *p * ALPHA + acc[ai][bj][m][n]; } }
    }
};
struct EpiSwiglu {
    static constexpr bool PERM = true;
    bf16* H;
    __device__ __forceinline__ void operator()(const pg8::f32x4 (&acc)[2][2][4][2], const pg8::Unit& u, int wr, int wc, int fr, int fq) const {
        const int row0 = u.pm * 256 + wr * 64 + fr; const int col0 = u.pn * 128 + wc * 32 + 8 * fq;
#pragma unroll
        for (int ai = 0; ai < 2; ++ai)
#pragma unroll
            for (int m = 0; m < 4; ++m) { bf16* rowp = H + (size_t)(row0 + ai * 128 + m * 16) * DEXP + col0;
                float v[8];
#pragma unroll
                for (int j = 0; j < 4; ++j) { v[j] = siluf_(acc[ai][0][m][0][j]) * acc[ai][1][m][0][j]; v[4 + j] = siluf_(acc[ai][0][m][1][j]) * acc[ai][1][m][1][j]; }
                u32x4 w; w.x = pg8::cvt_pk_bf16(v[0], v[1]); w.y = pg8::cvt_pk_bf16(v[2], v[3]); w.z = pg8::cvt_pk_bf16(v[4], v[5]); w.w = pg8::cvt_pk_bf16(v[6], v[7]);
                *(u32x4*)rowp = w; }
    }
};

struct BranchOrder {
    int nM, nN, G, c;
    __device__ bool next(int i, pg8::Unit& u) const {
        const int tl = (i >> 2) * G + c; if (tl >= nM * nN) return false;
        pg8::tile_of(tl, nM, nN, u.pm, u.pn); u.aux = i & 3;
        u.aoff = ((size_t)u.pm * 256 * 1024 + (size_t)u.aux * 256) * 2; u.boff = ((size_t)u.pn * 256 * 1024 + (size_t)u.aux * 256) * 2; return true;
    }
};
struct MoeOrder {
    const volatile LAS int* tb; int G, c; size_t a_rowbytes, b_expbytes, b_tilebytes;
    __device__ bool next(int i, pg8::Unit& u) const {
        const int L = i * G + c; const int total = __builtin_amdgcn_readfirstlane(tb[32]) * 4; if (L >= total) return false;
        int e = 0;
#pragma unroll 1
        for (int k = 0; k < 32; ++k) if (L >= tb[k + 1] * 4) e = k + 1;
        const int nte = tb[e + 1] - tb[e]; const int r = L - tb[e] * 4; const int ct = r / nte, rt = r % nte;
        u.pm = __builtin_amdgcn_readfirstlane(tb[33 + e] + rt); u.pn = __builtin_amdgcn_readfirstlane(ct); u.aux = __builtin_amdgcn_readfirstlane(e);
        u.aoff = (size_t)u.pm * 256 * a_rowbytes; u.boff = (size_t)u.aux * b_expbytes + (size_t)u.pn * b_tilebytes; return true;
    }
};

template <int SP>
__device__ __forceinline__ void phase_body(const Args& args, const int l, LAS unsigned char* lds) {
    const int tid = threadIdx.x, lane = tid & 63, wave = __builtin_amdgcn_readfirstlane(tid >> 6);
    const int G = gridDim.x, bid = blockIdx.x;
    const int gw = bid * NWAVES + wave, NGW = G * NWAVES;
    unsigned char* ws = args.ws;
    int* ctl = (int*)(ws + WS_CTL);
    bf16* XB = (bf16*)(ws + WS_XB); bf16* OB = (bf16*)(ws + WS_O); bf16* VF = (bf16*)(ws + WS_VF); bf16* P = (bf16*)(ws + WS_P);
    bf16* GS = (bf16*)(ws + WS_GS); bf16* MG = (bf16*)(ws + WS_MERGED); bf16* XS = (bf16*)(ws + WS_XS); bf16* HB = (bf16*)(ws + WS_H);
    bf16* WGU = (bf16*)(ws + WS_WGU); bf16* WD = (bf16*)(ws + WS_WD);
    float* X = args.out;
    int* tok_e = (int*)(ws + WS_ROUTE); float* tok_g = (float*)(ws + WS_ROUTE + 256 * 1024); int* tok_rank = (int*)(ws + WS_ROUTE + 512 * 1024); int* tok_slot = (int*)(ws + WS_ROUTE + 768 * 1024);
    (void)ctl; (void)XB; (void)OB; (void)VF; (void)P; (void)GS; (void)MG; (void)XS; (void)HB; (void)WGU; (void)WD; (void)X; (void)tok_e; (void)tok_g; (void)tok_rank; (void)tok_slot; (void)gw; (void)NGW; (void)lane;
    {
        bf16* WinT = (bf16*)(ws + WS_WINT) + (size_t)l * 5120 * 1024; bf16* WgT = (bf16*)(ws + WS_WGT) + (size_t)l * 4096 * 1024;
        bf16* WbrT = (bf16*)(ws + WS_WBRT) + (size_t)l * 1024 * 1024; bf16* WoutT = (bf16*)(ws + WS_WOUTT) + (size_t)l * 1024 * 1024;
        float* WrT = (float*)(ws + WS_WRT) + (size_t)l * 36 * 1024;
        int* cnt = ctl + CW_CNT + l * 64;

        if constexpr (SP == -1) {
            LAS float* scr = (LAS float*)(lds + wave * 16384);
            for (int ll = 0; ll < NL; ++ll) {
                const float* W = args.in[I_WIN] + (size_t)ll * 1024 * INW;
                bf16* wi = (bf16*)(ws + WS_WINT) + (size_t)ll * 5120 * 1024; bf16* wg = (bf16*)(ws + WS_WGT) + (size_t)ll * 4096 * 1024;
                const int sc0[5] = {0, 3396, 3392, 5060, 5064}, snc[5] = {3392, 1664, 4, 4, 4096}, sr0[5] = {0, 3392, 5056, 5060, 0};
                for (int sgi = 0; sgi < 5; ++sgi) {
                    const int nbn = (snc[sgi] + 31) / 32, nit = 16 * nbn;
                    for (int it = gw; it < nit; it += NGW) transpose_item(W, INW, sc0[sgi], snc[sgi], sgi == 4 ? wg : wi, 1024, sr0[sgi], 0, it / nbn, it % nbn, scr, lane);
                }
                for (int i = gw * 64 + lane; i < 56 * 1024 / 8; i += NGW * 64) ((u32x4*)(wi + (size_t)5064 * 1024))[i] = (u32x4){0u, 0u, 0u, 0u};
                for (int n = 0; n < 4; ++n) { const float* Wb = args.in[I_WBR] + ((size_t)ll * 4 + n) * 256 * 1024;
                    for (int it = gw; it < 4 * 32; it += NGW) transpose_item(Wb, 1024, 0, 1024, (bf16*)(ws + WS_WBRT) + (size_t)ll * 1024 * 1024, 1024, 0, n * 256, it / 32, it % 32, scr, lane); }
                { const float* Wo = args.in[I_WOUT] + (size_t)ll * 1024 * 1024;
                    for (int it = gw; it < 16 * 32; it += NGW) transpose_item(Wo, 1024, 0, 1024, (bf16*)(ws + WS_WOUTT) + (size_t)ll * 1024 * 1024, 1024, 0, 0, it / 32, it % 32, scr, lane); }
                { float* wr = (float*)(ws + WS_WRT) + (size_t)ll * 36 * 1024; const float* rg = args.in[I_RG] + (size_t)ll * 1024 * 4; const float* re = args.in[I_RE] + (size_t)ll * 1024 * 32;
                    for (int i = gw * 64 + lane; i < 36 * 1024; i += NGW * 64) { const int o = i / 1024, k = i % 1024; wr[i] = o < 4 ? rg[k * 4 + o] : re[k * 32 + (o - 4)]; } }
            }
            for (int m = gw; m < M; m += NGW) {
                const f32x4* xr = (const f32x4*)(args.in[I_X] + (size_t)m * D) + lane;
#pragma unroll
                for (int j = 0; j < 4; ++j) { const f32x4 v = xr[64 * j]; ((f32x4*)(X + (size_t)m * D))[lane + 64 * j] = v;
                    u32x2 w; w.x = pk2(v[0], v[1]); w.y = pk2(v[2], v[3]); ((u32x2*)(XB + (size_t)m * D))[lane + 64 * j] = w; }
            }
        }
        else if constexpr (SP == 0) {
            pg8::Gemm g{XB, WinT, 1024, 1024, 1024}; pg8::StaticOrder S; S.init(M, PP, G, bid, 1024, 1024);
            EpiStoreBf16 E{P, PP, 0, PP};
            pg8::gemm_phase<EpiStoreBf16, pg8::StaticOrder>(lds, g, S, E);
        }
        else if constexpr (SP == 1) {
            for (int wv = gw; wv < (M / 64) * 4; wv += NGW) {
                const int h = wv & 3, m = (wv >> 2) * 64 + lane, t = m % T, b = m / T;
                float o[64]; float mx = -INFINITY, den = 0.f;
#pragma unroll
                for (int d = 0; d < 64; ++d) o[d] = 0.f;
                for (int gI = 0; gI < 3; ++gI) {
                    const int dil = gI == 0 ? 1 : (gI == 1 ? 4 : 16);
                    float q[64];
                    { const u32x4* qp = (const u32x4*)(P + (size_t)m * PP + C_AQ + gI * 256 + h * 64);
#pragma unroll
                        for (int c8 = 0; c8 < 8; ++c8) { const u32x4 v = qp[c8]; const unsigned w4[4] = {v.x, v.y, v.z, v.w};
#pragma unroll
                            for (int j = 0; j < 4; ++j) { q[c8 * 8 + 2 * j] = __uint_as_float(w4[j] << 16) * 0.125f; q[c8 * 8 + 2 * j + 1] = __uint_as_float(w4[j] & 0xffff0000u) * 0.125f; } } }
                    for (int j = 0; j <= 128; ++j) {
                        const int pos = t - j * dil; if (pos < 0) break;
                        const bf16* kr = P + (size_t)(b * T + pos) * PP + C_AK + gI * 256 + h * 64;
                        float s = 0.f;
#pragma unroll
                        for (int c8 = 0; c8 < 8; ++c8) { const u32x4 v = ((const u32x4*)kr)[c8]; const unsigned w4[4] = {v.x, v.y, v.z, v.w};
#pragma unroll
                            for (int jj = 0; jj < 4; ++jj) { s += q[c8 * 8 + 2 * jj] * __uint_as_float(w4[jj] << 16); s += q[c8 * 8 + 2 * jj + 1] * __uint_as_float(w4[jj] & 0xffff0000u); } }
                        const float mn = fmaxf(mx, s), corr = __expf(mx - mn), p = __expf(s - mn); mx = mn; den = den * corr + p;
                        const bf16* vr = kr + 768;
#pragma unroll
                        for (int c8 = 0; c8 < 8; ++c8) { const u32x4 v = ((const u32x4*)vr)[c8]; const unsigned w4[4] = {v.x, v.y, v.z, v.w};
#pragma unroll
                            for (int jj = 0; jj < 4; ++jj) { o[c8 * 8 + 2 * jj] = o[c8 * 8 + 2 * jj] * corr + p * __uint_as_float(w4[jj] << 16); o[c8 * 8 + 2 * jj + 1] = o[c8 * 8 + 2 * jj + 1] * corr + p * __uint_as_float(w4[jj] & 0xffff0000u); } }
                    }
                }
                const float inv = 1.f / den; u32x4* op = (u32x4*)(OB + (size_t)m * 1024 + 0 + h * 64);
#pragma unroll
                for (int c8 = 0; c8 < 8; ++c8) { u32x4 w; w.x = pk2(o[c8 * 8] * inv, o[c8 * 8 + 1] * inv); w.y = pk2(o[c8 * 8 + 2] * inv, o[c8 * 8 + 3] * inv); w.z = pk2(o[c8 * 8 + 4] * inv, o[c8 * 8 + 5] * inv); w.w = pk2(o[c8 * 8 + 6] * inv, o[c8 * 8 + 7] * inv); op[c8] = w; }
            }
        }
        else if constexpr (SP == 2) {
            LAS unsigned* sc = (LAS unsigned*)(lds + wave * 16384);
            LAS float* qi = (LAS float*)(lds + 131072 + wave * 1536);
            LAS unsigned short* sel = (LAS unsigned short*)(lds + wave * 16384);
            (void)sel;
            for (int it = 0; it < 16; ++it) {
                const int bb = it >> 1, tblk = (it & 1) ? (511 - (bid & 255)) : (bid & 255);
                if (bid >= 256) break;
                const int t = tblk * 8 + wave, m = bb * T + t;
                const bf16* prow = P + (size_t)m * PP;
                for (int i = lane; i < 256; i += 64) qi[i] = bf2f(prow[C_IQ + i]) * 0.125f;
                float wq[4];
#pragma unroll
                for (int hh = 0; hh < 4; ++hh) wq[hh] = bf2f(prow[C_IW + hh]) * 0.5f;
                asm volatile("s_waitcnt lgkmcnt(0)" ::: "memory");
                const int nblk = (t >> 6) + 1;
                for (int kb = 0; kb < nblk; ++kb) {
                    const int key = kb * 64 + lane; unsigned ok = 0u;
                    if (key <= t) {
                        const u32x4* kr = (const u32x4*)(P + (size_t)(bb * T + key) * PP + C_IK);
                        float lg[4] = {0.f, 0.f, 0.f, 0.f};
#pragma unroll
                        for (int c8 = 0; c8 < 8; ++c8) { const u32x4 v = kr[c8]; const unsigned w4[4] = {v.x, v.y, v.z, v.w};
#pragma unroll
                            for (int jj = 0; jj < 4; ++jj) { const float k0 = __uint_as_float(w4[jj] << 16), k1 = __uint_as_float(w4[jj] & 0xffff0000u);
#pragma unroll
                                for (int hh = 0; hh < 4; ++hh) { lg[hh] += qi[hh * 64 + c8 * 8 + 2 * jj] * k0; lg[hh] += qi[hh * 64 + c8 * 8 + 2 * jj + 1] * k1; } } }
                        float s = 0.f;
#pragma unroll
                        for (int hh = 0; hh < 4; ++hh) s += wq[hh] * fmaxf(lg[hh], 0.f);
                        const unsigned u = __float_as_uint(s); ok = (u & 0x80000000u) ? ~u : (u | 0x80000000u);
                        if (ok == 0u) ok = 1u;
                    }
                    sc[key] = ok;
                }
                asm volatile("s_waitcnt lgkmcnt(0)" ::: "memory");
                unsigned thr = 0u; int need = 1 << 30;
                if (t + 1 > 256) {
                    unsigned prefix = 0u;
                    for (int bit = 31; bit >= 0; --bit) {
                        const unsigned cand = prefix | (1u << bit); int c = 0;
                        for (int kb = 0; kb < nblk; ++kb) c += __popcll(__ballot(sc[kb * 64 + lane] >= cand));
                        if (c >= 256) prefix = cand;
                    }
                    thr = prefix; int cgt = 0;
                    for (int kb = 0; kb < nblk; ++kb) cgt += __popcll(__ballot(sc[kb * 64 + lane] > thr));
                    need = 256 - cgt;
                }
                LAS unsigned short* sl = (LAS unsigned short*)(qi + 256);
                int base = 0, beq = 0;
                const unsigned long long lt = (1ull << lane) - 1ull;
                for (int kb = 0; kb < nblk; ++kb) {
                    const unsigned v = sc[kb * 64 + lane]; const bool valid = v != 0u;
                    const bool eq = valid && v == thr; const unsigned long long beqm = __ballot(eq);
                    const bool take = valid && (v > thr || (eq && (beq + __popcll(beqm & lt)) < need));
                    const unsigned long long bt = __ballot(take);
                    if (take) sl[base + __popcll(bt & lt)] = (unsigned short)(kb * 64 + lane);
                    base += __popcll(bt); beq += __popcll(beqm);
                }
                const int nsel = base;
                for (int i = lane; i < 256; i += 64) qi[i] = bf2f(prow[C_BQ + i]) * 0.125f;
                asm volatile("s_waitcnt lgkmcnt(0)" ::: "memory");
                LAS float* ps = (LAS float*)(lds + wave * 16384);
                float sv[4][4]; float mxh[4] = {-INFINITY, -INFINITY, -INFINITY, -INFINITY};
#pragma unroll
                for (int r = 0; r < 4; ++r) {
                    const int si = r * 64 + lane;
#pragma unroll
                    for (int hh = 0; hh < 4; ++hh) sv[r][hh] = -INFINITY;
                    if (si < nsel) {
                        const int key = sl[si]; const u32x4* kr = (const u32x4*)(P + (size_t)(bb * T + key) * PP + C_BK);
#pragma unroll
                        for (int hh = 0; hh < 4; ++hh) { float s = 0.f;
#pragma unroll
                            for (int c8 = 0; c8 < 8; ++c8) { const u32x4 v = kr[hh * 8 + c8]; const unsigned w4[4] = {v.x, v.y, v.z, v.w};
#pragma unroll
                                for (int jj = 0; jj < 4; ++jj) { s += qi[hh * 64 + c8 * 8 + 2 * jj] * __uint_as_float(w4[jj] << 16); s += qi[hh * 64 + c8 * 8 + 2 * jj + 1] * __uint_as_float(w4[jj] & 0xffff0000u); } }
                            sv[r][hh] = s; mxh[hh] = fmaxf(mxh[hh], s); }
                    }
                }
                float den[4];
#pragma unroll
                for (int hh = 0; hh < 4; ++hh) { mxh[hh] = wave_max(mxh[hh]); float e = 0.f;
#pragma unroll
                    for (int r = 0; r < 4; ++r) { sv[r][hh] = __expf(sv[r][hh] - mxh[hh]); e += sv[r][hh]; }
                    den[hh] = 1.f / wave_sum(e); }
                asm volatile("s_waitcnt lgkmcnt(0)" ::: "memory");
#pragma unroll
                for (int r = 0; r < 4; ++r) { const int si = r * 64 + lane; if (si < nsel) *(LAS f32x4*)(ps + si * 4) = (f32x4){sv[r][0] * den[0], sv[r][1] * den[1], sv[r][2] * den[2], sv[r][3] * den[3]}; }
                asm volatile("s_waitcnt lgkmcnt(0)" ::: "memory");
                float oa[4] = {0.f, 0.f, 0.f, 0.f}; const int hh = lane >> 4;
                for (int si = 0; si < nsel; ++si) {
                    const int key = sl[si]; const float p = ps[si * 4 + hh];
                    const u32x2 v = *(const u32x2*)(P + (size_t)(bb * T + key) * PP + C_BV + lane * 4);
                    oa[0] += p * __uint_as_float(v.x << 16); oa[1] += p * __uint_as_float(v.x & 0xffff0000u); oa[2] += p * __uint_as_float(v.y << 16); oa[3] += p * __uint_as_float(v.y & 0xffff0000u);
                }
                u32x2 w; w.x = pk2(oa[0], oa[1]); w.y = pk2(oa[2], oa[3]);
                *(u32x2*)(OB + (size_t)m * 1024 + 256 + lane * 4) = w;
                asm volatile("s_waitcnt lgkmcnt(0)" ::: "memory");
            }
        }
        else if constexpr (SP == 3) {
            if (bid < 32) {
                const int b = bid >> 2, h = bid & 3;
                LAS float* LW2 = (LAS float*)lds;
                LAS float* LA2 = LW2 + 32 * 64;
                LAS float* LG2 = LA2 + 32 * 64;
                LAS float* LV1 = LG2 + 64 * 64;
                LAS float* LV2 = LV1 + 256 * 16;
                LAS float* BR = LV2 + 16 * 64;
                LAS float* BD = BR + 2048; LAS float* BK_ = BD + 2048; LAS float* BA = BK_ + 2048; LAS float* BB = BA + 2048; LAS float* BV = BB + 2048; LAS float* BG = BV + 2048; LAS float* BY = BG + 2048;
                LAS float* BBON = BY + 2048;
                LAS float* SCR = BBON + 32;
                const float* cw2 = args.in[I_CW2] + (size_t)l * 32 * 256; const float* ca2 = args.in[I_CA2] + (size_t)l * 32 * 256; const float* cg2 = args.in[I_CG2] + (size_t)l * 64 * 256;
                for (int i = tid; i < 32 * 64; i += NTHR) { LW2[i] = cw2[(i >> 6) * 256 + h * 64 + (i & 63)]; LA2[i] = ca2[(i >> 6) * 256 + h * 64 + (i & 63)]; }
                for (int i = tid; i < 64 * 64; i += NTHR) LG2[i] = cg2[(i >> 6) * 256 + h * 64 + (i & 63)];
                if (l > 0) { const float* cv1 = args.in[I_CV1] + (size_t)(l - 1) * 256 * 16; const float* cv2 = args.in[I_CV2] + (size_t)(l - 1) * 16 * 256;
                    for (int i = tid; i < 256 * 16; i += NTHR) LV1[i] = cv1[i];
                    for (int i = tid; i < 16 * 64; i += NTHR) LV2[i] = cv2[(i >> 6) * 256 + h * 64 + (i & 63)]; }
                const int c = h * 64 + lane;
                const float* mu = args.in[I_CMU] + (size_t)l * 896;
                const float mu_r = mu[c], mu_k = mu[256 + c], mu_v = mu[512 + c], mu_x = mu[768 + lane], mu_g = mu[832 + lane];
                const float w0 = args.in[I_CW0][l * 256 + c], a0 = args.in[I_CA0][l * 256 + c], kkc = args.in[I_CKK][l * 256 + c], kac = args.in[I_CKA][l * 256 + c], rkc = args.in[I_CRK][l * 256 + c];
                const float gnw = args.in[I_CGNW][l * 256 + c], gnb = args.in[I_CGNB][l * 256 + c];
                const float v0c = l > 0 ? args.in[I_CV0][(l - 1) * 256 + c] : 0.f;
                float muv4[4];
#pragma unroll
                for (int jj = 0; jj < 4; ++jj) muv4[jj] = mu[512 + lane + 64 * jj];
                float S[64];
#pragma unroll
                for (int j = 0; j < 64; ++j) S[j] = 0.f;
                __syncthreads();
                LAS float* scr = SCR + wave * 160;
                for (int t0 = 0; t0 < T; t0 += 32) {
                    for (int q = 0; q < 4; ++q) {
                        const int tt = wave + 8 * q, t = t0 + tt; const size_t m = (size_t)b * T + t;
                        const bf16* row = P + m * PP + C_C; const bf16* prw = row - PP; const bool hp = t > 0;
#define XS_(col, muv) ({ const float cur_ = bf2f(row[col]); const float prv_ = hp ? bf2f(prw[col]) : 0.f; cur_ + (prv_ - cur_) * (muv); })
                        const float r = XS_(c, mu_r), k = XS_(256 + c, mu_k); float v = XS_(512 + c, mu_v);
                        const float xx = XS_(768 + lane, mu_x);
                        const float xg = XS_(832 + lane, mu_g);
                        scr[lane] = lane < 32 ? tanhf(xx) : xx; scr[64 + lane] = sigmoidf_(xg);
                        float vq[16];
                        if (l > 0) {
#pragma unroll
                            for (int qq = 0; qq < 16; ++qq) vq[qq] = 0.f;
#pragma unroll
                            for (int jj = 0; jj < 4; ++jj) { const float vf = XS_(512 + lane + 64 * jj, muv4[jj]);
#pragma unroll
                                for (int qq = 0; qq < 16; ++qq) vq[qq] += vf * LV1[(lane + 64 * jj) * 16 + qq]; }
#pragma unroll
                            for (int qq = 0; qq < 16; ++qq) vq[qq] = wave_sum(vq[qq]);
                        }
#undef XS_
                        asm volatile("s_waitcnt lgkmcnt(0)" ::: "memory");
                        float wsum = w0, asum = a0, gsum = 0.f;
#pragma unroll 8
                        for (int mm = 0; mm < 32; ++mm) { wsum += scr[mm] * LW2[mm * 64 + lane]; asum += scr[32 + mm] * LA2[mm * 64 + lane]; }
#pragma unroll 8
                        for (int mm = 0; mm < 64; ++mm) gsum += scr[64 + mm] * LG2[mm * 64 + lane];
                        if (l > 0) { float vl = v0c;
#pragma unroll
                            for (int qq = 0; qq < 16; ++qq) vl += vq[qq] * LV2[qq * 64 + lane];
                            const float vf = bf2f(VF[m * 256 + c]); v = v + (vf - v) * sigmoidf_(vl); }
                        else VF[m * 256 + c] = (bf16)f2bf(v);
                        const float wlog = -softplusf_(-wsum) - 0.5f, asig = sigmoidf_(asum);
                        float kk = k * kkc; const float n2 = wave_sum(kk * kk); kk = kk / fmaxf(sqrtf(n2), 1e-12f);
                        const float kmod = k * (1.f + (asig - 1.f) * kac);
                        const float dec = __expf(-__expf(wlog));
                        const float bon = wave_sum(r * kmod * rkc);
                        BR[tt * 64 + lane] = r; BD[tt * 64 + lane] = dec; BK_[tt * 64 + lane] = kmod; BA[tt * 64 + lane] = -kk; BB[tt * 64 + lane] = kk * asig; BV[tt * 64 + lane] = v; BG[tt * 64 + lane] = gsum;
                        if (lane == 0) BBON[tt] = bon;
                        asm volatile("s_waitcnt lgkmcnt(0)" ::: "memory");
                    }
                    __syncthreads();
                    if (wave == 0) {
                        for (int tt = 0; tt < 32; ++tt) {
                            const float vi = BV[tt * 64 + lane]; float sa = 0.f;
#pragma unroll
                            for (int j4 = 0; j4 < 16; ++j4) { const f32x4 a = *(const LAS f32x4*)(BA + tt * 64 + j4 * 4);
                                sa += S[j4 * 4] * a[0]; sa += S[j4 * 4 + 1] * a[1]; sa += S[j4 * 4 + 2] * a[2]; sa += S[j4 * 4 + 3] * a[3]; }
                            float y = 0.f;
#pragma unroll
                            for (int j4 = 0; j4 < 16; ++j4) { const f32x4 dd = *(const LAS f32x4*)(BD + tt * 64 + j4 * 4), bv = *(const LAS f32x4*)(BB + tt * 64 + j4 * 4), kv = *(const LAS f32x4*)(BK_ + tt * 64 + j4 * 4), rv = *(const LAS f32x4*)(BR + tt * 64 + j4 * 4);
#pragma unroll
                                for (int e = 0; e < 4; ++e) { float s = S[j4 * 4 + e] * dd[e]; s += sa * bv[e]; s += vi * kv[e]; S[j4 * 4 + e] = s; y += s * rv[e]; } }
                            BY[tt * 64 + lane] = y;
                        }
                    }
                    __syncthreads();
                    for (int q = 0; q < 4; ++q) {
                        const int tt = wave + 8 * q; const size_t m = (size_t)b * T + t0 + tt;
                        const float y = BY[tt * 64 + lane]; const float mean = wave_sum(y) * (1.f / 64.f); const float dy = y - mean; const float var = wave_sum(dy * dy) * (1.f / 64.f);
                        const float yn = dy * rsqrtf(var + 64e-5f) * gnw + gnb;
                        const float o = (yn + BBON[tt] * BV[tt * 64 + lane]) * BG[tt * 64 + lane];
                        OB[m * 1024 + 512 + c] = (bf16)f2bf(o);
                    }
                    __syncthreads();
                }
            } else if (bid < 48) {
                const int b = (bid - 32) >> 1, gI = (bid - 32) & 1;
                LAS float* XSb = (LAS float*)lds;
                LAS float* Bm = XSb + 32 * 128;
                LAS float* Cm = Bm + 32 * 64;
                LAS float* DTb = Cm + 32 * 64;
                LAS float* DAb = DTb + 64;
                LAS float* Yd = DAb + 64;
                const float* cwp = args.in[I_DCW] + (size_t)l * 4 * 512; const float* cbp = args.in[I_DCB] + (size_t)l * 512;
                const int cc = tid & 255, sub = tid >> 8;
                const int col = cc < 128 ? (gI * 128 + cc) : (cc < 192 ? (256 + gI * 64 + (cc - 128)) : (384 + gI * 64 + (cc - 192)));
                const float cw0 = cwp[col], cw1 = cwp[512 + col], cw2 = cwp[1024 + col], cw3 = cwp[1536 + col], cb = cbp[col];
                float Hs[64];
#pragma unroll
                for (int j = 0; j < 64; ++j) Hs[j] = 0.f;
                const int hsc = gI * 2 + (wave & 1);
                const float Ah = -__expf(args.in[I_DALOG][l * 4 + hsc]), Dsk = args.in[I_DSKIP][l * 4 + hsc];
                for (int t0 = 0; t0 < T; t0 += 32) {
                    for (int q = 0; q < 16; ++q) {
                        const int tt = q * 2 + sub, t = t0 + tt; const size_t m = (size_t)b * T + t;
                        const bf16* xp = P + m * PP + C_DX + col;
                        float a = cb + cw3 * bf2f(xp[0]);
                        if (t >= 1) a += cw2 * bf2f(xp[-PP]);
                        if (t >= 2) a += cw1 * bf2f(xp[-2 * PP]);
                        if (t >= 3) a += cw0 * bf2f(xp[-3 * PP]);
                        a = siluf_(a);
                        if (cc < 128) XSb[tt * 128 + cc] = a; else if (cc < 192) Bm[tt * 64 + cc - 128] = a; else Cm[tt * 64 + cc - 192] = a;
                        if (cc < 2) { const int hh = gI * 2 + cc; const float dt = softplusf_(bf2f(P[m * PP + C_DT + hh]) + args.in[I_DDTB][l * 4 + hh]);
                            DTb[tt * 2 + cc] = dt; DAb[tt * 2 + cc] = __expf(-dt * __expf(args.in[I_DALOG][l * 4 + hh])); }
                    }
                    __syncthreads();
                    if (wave < 2) {
                        for (int tt = 0; tt < 32; ++tt) {
                            const float x = XSb[tt * 128 + wave * 64 + lane], dt = DTb[tt * 2 + wave], da = DAb[tt * 2 + wave]; const float xdt = x * dt; float y = Dsk * x;
#pragma unroll
                            for (int j4 = 0; j4 < 16; ++j4) { const f32x4 bv = *(const LAS f32x4*)(Bm + tt * 64 + j4 * 4), cv = *(const LAS f32x4*)(Cm + tt * 64 + j4 * 4);
#pragma unroll
                                for (int e = 0; e < 4; ++e) { const float s = Hs[j4 * 4 + e] * da + xdt * bv[e]; Hs[j4 * 4 + e] = s; y += s * cv[e]; } }
                            Yd[tt * 128 + wave * 64 + lane] = y;
                        }
                    }
                    (void)Ah;
                    __syncthreads();
                    for (int q = 0; q < 4; ++q) {
                        const int tt = wave + 8 * q; const size_t m = (size_t)b * T + t0 + tt;
                        const int c0 = gI * 128 + lane, c1 = c0 + 64;
                        const float z0 = bf2f(P[m * PP + C_DZ + c0]), z1 = bf2f(P[m * PP + C_DZ + c1]);
                        const float y0 = Yd[tt * 128 + lane] * siluf_(z0), y1 = Yd[tt * 128 + 64 + lane] * siluf_(z1);
                        const float ss = wave_sum(y0 * y0 + y1 * y1); const float rs = rsqrtf(ss * (1.f / 128.f) + 1e-5f);
                        OB[m * 1024 + 768 + c0] = (bf16)f2bf(y0 * rs * args.in[I_DNW][l * 256 + c0]);
                        OB[m * 1024 + 768 + c1] = (bf16)f2bf(y1 * rs * args.in[I_DNW][l * 256 + c1]);
                    }
                    __syncthreads();
                }
            }
        }
        else if constexpr (SP == 4) {
            pg8::Gemm g{XB, WgT, 1024, 1024, 1024}; pg8::StaticOrder S; S.init(M, 4096, G, bid, 1024, 1024);
            EpiStoreBf16 E{GS, 4096, 1, 4096};
            pg8::gemm_phase<EpiStoreBf16, pg8::StaticOrder>(lds, g, S, E);
        }
        else if constexpr (SP == 5) {
            pg8::Gemm g{OB, WbrT, 1024, 1024, 256}; BranchOrder S{M / 256, 4, G, bid};
            EpiBranch E{GS, MG};
            pg8::gemm_phase<EpiBranch, BranchOrder>(lds, g, S, E);
        }
        else if constexpr (SP == 6) {
            pg8::Gemm g{MG, WoutT, 1024, 1024, 1024}; pg8::StaticOrder S; S.init(M, 1024, G, bid, 1024, 1024);
            EpiResid E{X};
            pg8::gemm_phase<EpiResid, pg8::StaticOrder>(lds, g, S, E);
        }
        else if constexpr (SP == 7) {
            const float* g1 = args.in[I_LN1G] + l * 1024; const float* b1 = args.in[I_LN1B] + l * 1024;
            const float* rgb = args.in[I_RGB] + l * 4; const float* reb = args.in[I_REB] + l * 32;
            for (int m = gw; m < M; m += NGW) {
                f32x4 v[4]; float s = 0.f; f32x4* xr = (f32x4*)(X + (size_t)m * D) + lane;
#pragma unroll
                for (int j = 0; j < 4; ++j) { v[j] = xr[64 * j]; s += (v[j][0] + v[j][1]) + (v[j][2] + v[j][3]); }
                const float mean = wave_sum(s) * (1.f / D); float s2 = 0.f;
#pragma unroll
                for (int j = 0; j < 4; ++j) { v[j] = v[j] - mean; s2 += (v[j][0] * v[j][0] + v[j][1] * v[j][1]) + (v[j][2] * v[j][2] + v[j][3] * v[j][3]); }
                const float rstd = rsqrtf(wave_sum(s2) * (1.f / D) + LN_EPS);
#pragma unroll
                for (int j = 0; j < 4; ++j) { const f32x4 gg = ((const f32x4*)g1)[lane + 64 * j], bb = ((const f32x4*)b1)[lane + 64 * j]; v[j] = v[j] * rstd * gg + bb; xr[64 * j] = v[j];
                    u32x2 w; w.x = pk2(v[j][0], v[j][1]); w.y = pk2(v[j][2], v[j][3]); ((u32x2*)(XB + (size_t)m * D))[lane + 64 * j] = w; }
                float mylg = 0.f;
#pragma unroll 1
                for (int o = 0; o < 36; ++o) { float a = 0.f;
#pragma unroll
                    for (int j = 0; j < 4; ++j) { const f32x4 wv = ((const f32x4*)(WrT + o * 1024))[lane + 64 * j]; a += v[j][0] * wv[0] + v[j][1] * wv[1] + v[j][2] * wv[2] + v[j][3] * wv[3]; }
                    a = wave_sum(a); mylg = (lane == o) ? a : mylg; }
                mylg += lane < 4 ? rgb[lane & 3] : (lane < 36 ? reb[(lane - 4) & 31] : 0.f);
                float gl[4]; float gm = -INFINITY; int gs = 0;
#pragma unroll
                for (int o = 0; o < 4; ++o) { gl[o] = __shfl(mylg, o); if (gl[o] > gm) { gm = gl[o]; gs = o; } }
                float gden = 0.f;
#pragma unroll
                for (int o = 0; o < 4; ++o) gden += __expf(gl[o] - gm);
                const float pg = 1.f / gden;
                float el[8];
#pragma unroll
                for (int o = 0; o < 8; ++o) el[o] = __shfl(mylg, 4 + gs * 8 + o);
                int e1 = 0; float m1 = el[0];
#pragma unroll
                for (int o = 1; o < 8; ++o) if (el[o] > m1) { m1 = el[o]; e1 = o; }
                int e2 = -1; float m2 = -INFINITY;
#pragma unroll
                for (int o = 0; o < 8; ++o) if (o != e1 && el[o] > m2) { m2 = el[o]; e2 = o; }
                const float r2 = __expf(m2 - m1); const float ga = pg / (1.f + r2), gb = pg * r2 / (1.f + r2);
                if (lane == 0) {
                    const int E1 = gs * 8 + e1, E2 = gs * 8 + e2;
                    tok_e[m * 2] = E1; tok_e[m * 2 + 1] = E2; tok_g[m * 2] = ga; tok_g[m * 2 + 1] = gb;
                    tok_rank[m * 2] = atomicAdd(&cnt[E1], 1); tok_rank[m * 2 + 1] = atomicAdd(&cnt[E2], 1);
                }
            }
            LAS float* scr = (LAS float*)(lds + wave * 16384);
            const float* eg = args.in[I_EG] + (size_t)l * NEXP * 1024 * 512; const float* eu = args.in[I_EU] + (size_t)l * NEXP * 1024 * 512; const float* ed = args.in[I_ED] + (size_t)l * NEXP * 512 * 1024;
            for (int it = gw; it < NEXP * 2 * 4 * 64; it += NGW) {
                const int e = it / 512, r = it % 512, half = r / 256, ct = (r % 256) / 64, q = r % 64, kb = q / 4, nb = q % 4;
                const float* W = (half ? eu : eg) + (size_t)e * 1024 * 512;
                transpose_item(W, 512, ct * 128, 128, WGU + (size_t)e * 1024 * 1024, 1024, ct * 256 + half * 128, 0, kb, nb, scr, lane);
            }
            for (int it = gw; it < NEXP * 8 * 32; it += NGW) {
                const int e = it / 256, q = it % 256, kb = q / 32, nb = q % 32;
                transpose_item(ed + (size_t)e * 512 * 1024, 1024, 0, 1024, WD + (size_t)e * 1024 * 512, 512, 0, 0, kb, nb, scr, lane);
            }
        }
        else if constexpr (SP == 8 || SP == 9 || SP == 10) {
            volatile LAS int* tb = (volatile LAS int*)(lds + MISC_OFF);
            if (tid == 0) { int acc = 0; for (int e = 0; e < 32; ++e) { const int c = __hip_atomic_load(&cnt[e], __ATOMIC_RELAXED, __HIP_MEMORY_SCOPE_AGENT); tb[e] = acc; tb[33 + e] = acc; acc += (c + 255) >> 8; } tb[32] = acc; }
            __syncthreads();
            if constexpr (SP == 8) {
                for (int m = gw; m < M; m += NGW) {
#pragma unroll
                    for (int k = 0; k < 2; ++k) { const int e = tok_e[m * 2 + k]; const int slot = tb[33 + e] * 256 + tok_rank[m * 2 + k];
                        const u32x4* src = (const u32x4*)(XB + (size_t)m * D); u32x4* dst = (u32x4*)(XS + (size_t)slot * D);
                        dst[lane] = src[lane]; dst[lane + 64] = src[lane + 64];
                        if (lane == 0) tok_slot[m * 2 + k] = slot; }
                }
            } else if constexpr (SP == 9) {
                pg8::Gemm g{XS, WGU, 1024, 1024, 1024}; MoeOrder S{tb, G, bid, (size_t)1024 * 2, (size_t)1024 * 1024 * 2, (size_t)256 * 1024 * 2};
                EpiSwiglu E{HB};
                pg8::gemm_phase<EpiSwiglu, MoeOrder>(lds, g, S, E);
            } else {
                pg8::Gemm g{HB, WD, 512, 512, 512}; MoeOrder S{tb, G, bid, (size_t)512 * 2, (size_t)1024 * 512 * 2, (size_t)256 * 512 * 2};
                EpiStoreBf16 E{XS, 1024, 0, 1024};
                pg8::gemm_phase<EpiStoreBf16, MoeOrder>(lds, g, S, E);
            }
        }
        else if constexpr (SP == 11) {
            const float* g2 = args.in[I_LN2G] + l * 1024; const float* b2 = args.in[I_LN2B] + l * 1024;
            for (int m = gw; m < M; m += NGW) {
                const int s1 = tok_slot[m * 2], s2i = tok_slot[m * 2 + 1]; const float ga = tok_g[m * 2], gb = tok_g[m * 2 + 1];
                f32x4 v[4]; float s = 0.f; f32x4* xr = (f32x4*)(X + (size_t)m * D) + lane;
#pragma unroll
                for (int j = 0; j < 4; ++j) { v[j] = xr[64 * j] * ALPHA;
                    const u32x2 y1 = ((const u32x2*)(XS + (size_t)s1 * D))[lane + 64 * j], y2 = ((const u32x2*)(XS + (size_t)s2i * D))[lane + 64 * j];
                    v[j][0] += ga * __uint_as_float(y1.x << 16) + gb * __uint_as_float(y2.x << 16); v[j][1] += ga * __uint_as_float(y1.x & 0xffff0000u) + gb * __uint_as_float(y2.x & 0xffff0000u);
                    v[j][2] += ga * __uint_as_float(y1.y << 16) + gb * __uint_as_float(y2.y << 16); v[j][3] += ga * __uint_as_float(y1.y & 0xffff0000u) + gb * __uint_as_float(y2.y & 0xffff0000u);
                    s += (v[j][0] + v[j][1]) + (v[j][2] + v[j][3]); }
                const float mean = wave_sum(s) * (1.f / D); float s2 = 0.f;
#pragma unroll
                for (int j = 0; j < 4; ++j) { v[j] = v[j] - mean; s2 += (v[j][0] * v[j][0] + v[j][1] * v[j][1]) + (v[j][2] * v[j][2] + v[j][3] * v[j][3]); }
                const float rstd = rsqrtf(wave_sum(s2) * (1.f / D) + LN_EPS);
#pragma unroll
                for (int j = 0; j < 4; ++j) { const f32x4 gg = ((const f32x4*)g2)[lane + 64 * j], bb = ((const f32x4*)b2)[lane + 64 * j]; v[j] = v[j] * rstd * gg + bb; xr[64 * j] = v[j];
                    u32x2 w; w.x = pk2(v[j][0], v[j][1]); w.y = pk2(v[j][2], v[j][3]); ((u32x2*)(XB + (size_t)m * D))[lane + 64 * j] = w; }
            }
        }
    }
}

template <int SP>
__global__ void __launch_bounds__(NTHR, 2) k_phase(Args args, int l) {
    extern __shared__ __attribute__((aligned(16))) unsigned char lds_raw[];
    phase_body<SP>(args, l, (LAS unsigned char*)lds_raw);
}

template <int SP> static void launch_phase(const Args& a, int l, int grid, hipStream_t stream) {
    static bool attr = false;
    if (!attr) { (void)hipFuncSetAttribute((const void*)k_phase<SP>, hipFuncAttributeMaxDynamicSharedMemorySize, LDS_BYTES); attr = true; }
    hipLaunchKernelGGL(k_phase<SP>, dim3(grid), dim3(NTHR), LDS_BYTES, stream, a, l);
}

extern "C" void kernel_launch(void* const* d_in, const int* in_sizes, int n_in, void* d_out, int out_size, void* d_ws, size_t ws_size, hipStream_t stream) {
    static int grid = 0;
    if (grid == 0) {
        if (n_in != 35 || out_size != M * D || ws_size < WS_END) { fprintf(stderr, "kernel_launch: unexpected problem (n_in %d out %d ws %zu)\n", n_in, out_size, ws_size); grid = -1; return; }
        int dev = 0, cus = 0;
        (void)hipGetDevice(&dev); (void)hipDeviceGetAttribute(&cus, hipDeviceAttributeMultiprocessorCount, dev);
        grid = cus;
    }
    if (grid < 0) return;
    (void)hipMemsetAsync((char*)d_ws + WS_CTL, 0, CTL_BYTES, stream);
    Args a{};
    for (int i = 0; i < 35; ++i) a.in[i] = (const float*)d_in[i];
    a.out = (float*)d_out; a.ws = (unsigned char*)d_ws;
    launch_phase<-1>(a, 0, grid, stream);
    for (int l = 0; l < NL; ++l) {
        launch_phase<0>(a, l, grid, stream); launch_phase<1>(a, l, grid, stream); launch_phase<2>(a, l, grid, stream); launch_phase<3>(a, l, grid, stream);
        launch_phase<4>(a, l, grid, stream); launch_phase<5>(a, l, grid, stream); launch_phase<6>(a, l, grid, stream); launch_phase<7>(a, l, grid, stream);
        launch_phase<8>(a, l, grid, stream); launch_phase<9>(a, l, grid, stream); launch_phase<10>(a, l, grid, stream); launch_phase<11>(a, l, grid, stream);
    }
}
```

```cpp
#include <hip/hip_runtime.h>
#include <cstdio>
#include <cstdint>
#include <hip/hip_cooperative_groups.h>

#ifndef N_LAUNCH_MODE
#define N_LAUNCH_MODE 1
#endif

namespace pg8 {
#define PG8_LAS __attribute__((address_space(3)))
typedef unsigned short bf16_t;
typedef short bf16x8 __attribute__((ext_vector_type(8)));
typedef float f32x4 __attribute__((ext_vector_type(4)));
typedef unsigned u32x4 __attribute__((ext_vector_type(4)));
constexpr int BM = 256, BK = 64, HALF = 128, HTB = HALF * BK * 2, STAGE_BYTES = 8 * HTB, NXCD = 8, WGM = 8;

__host__ __device__ __forceinline__ int lds_byte(int r, int c) { const int st = (r >> 4) * 2 + (c >> 5), rr = r & 15, cc = c & 31, ob = rr * 64 + cc * 2; return st * 1024 + (ob ^ (((ob >> 9) & 1) << 5)); }
__host__ __device__ __forceinline__ void stage_rc(int b, int& R, int& C) { const int st = b / 1024, sb = b % 1024, swz = sb ^ (((sb >> 9) & 1) << 5); R = (st >> 1) * 16 + swz / 64; C = (st & 1) * 32 + (swz % 64) / 2; }
__host__ __device__ __forceinline__ int perm32(int rho) { const int n = rho >> 4, i = rho & 15; return 8 * (i >> 2) + 4 * n + (i & 3); }

struct Unit { int pm, pn, aux; size_t aoff, boff; };
struct Gemm { const bf16_t* A; const bf16_t* Bt; int lda, ldb, K; };

__device__ __forceinline__ void tile_of(int L, int nM, int nN, int& pm, int& pn) {
    const int nwg = nM * nN; int wgid = L;
    { const int q = nwg / NXCD, r = nwg % NXCD, xcd = wgid % NXCD, off = wgid / NXCD; wgid = (xcd < r ? xcd * (q + 1) : r * (q + 1) + (xcd - r) * q) + off; }
    const int nig = WGM * nN, gid = wgid / nig, fm = gid * WGM, gsz = (nM - fm) < WGM ? (nM - fm) : WGM;
    pm = fm + ((wgid % nig) % gsz); pn = (wgid % nig) / gsz;
}
struct StaticOrder {
    int nM, nN, nwg, G, c, lda, ldb;
    __device__ void init(int M, int N, int G_, int c_, int lda_, int ldb_) { nM = M / BM; nN = N / BM; nwg = nM * nN; G = G_; c = c_; lda = lda_; ldb = ldb_; }
    __device__ bool next(int i, Unit& u) const {
        const long L = (long)i * G + c; if (L >= nwg) return false;
        tile_of((int)L, nM, nN, u.pm, u.pn); u.aux = 0;
        u.aoff = (size_t)u.pm * BM * lda * 2; u.boff = (size_t)u.pn * BM * ldb * 2; return true;
    }
};

__device__ __forceinline__ unsigned cvt_pk_bf16(float lo, float hi) { unsigned r; asm volatile("v_cvt_pk_bf16_f32 %0, %1, %2" : "=v"(r) : "v"(lo), "v"(hi)); return r; }

template <class Epi, class Sched, bool ALIGN_EPI = true, bool SP2 = true>
__device__ __forceinline__ void gemm_phase(PG8_LAS unsigned char* lds, const Gemm g, const Sched& S, const Epi& E) {
    int tid_ = threadIdx.x; asm volatile("" : "+v"(tid_));
    const int tid = tid_, wid = __builtin_amdgcn_readfirstlane(tid >> 6), lane = tid & 63, wr = wid >> 2, wc = wid & 3, fr = lane & 15, fq = lane >> 4;
    const int K = g.K, nt = K / BK;
    unsigned voffA[2], voffB[2];
#pragma unroll
    for (int i = 0; i < 2; ++i) { int R, C; stage_rc(tid * 16 + i * 8192, R, C); const int Rb = Epi::PERM ? ((R & ~31) + perm32(R & 31)) : R;
        voffA[i] = (unsigned)(R * g.lda + C) * 2u; voffB[i] = (unsigned)(Rb * g.ldb + C) * 2u; }
    const size_t kstep = (size_t)(BK * 2);
    const size_t hstepA = (size_t)HALF * g.lda * 2, hstepB = (size_t)HALF * g.ldb * 2;
    const unsigned ldsw = (unsigned)wid * 1024u;
    const int aoff = lds_byte(wr * 64 + fr, fq * 8), boff = lds_byte(wc * 32 + fr, fq * 8);
#define PG8_SA(b, h) (((b) * 2 + (h)) * HTB)
#define PG8_SB(b, h) ((4 + (b) * 2 + (h)) * HTB)
#define PG8_STAGE(bufoff, gbase, voff) do { _Pragma("unroll") for (int _i = 0; _i < 2; ++_i) \
        __builtin_amdgcn_global_load_lds((const unsigned*)((const char*)(gbase) + (voff)[_i]), (PG8_LAS unsigned*)(lds + (bufoff) + ldsw + _i * 8192), 16, 0, 0); } while (0)
#define PG8_LDA(dst, b, h) do { _Pragma("unroll") for (int m = 0; m < 4; ++m) _Pragma("unroll") for (int k = 0; k < 2; ++k) dst[m][k] = *(const PG8_LAS bf16x8*)(lds + PG8_SA(b, h) + aoff + m * 2048 + k * 1024); } while (0)
#define PG8_LDB(dst, b, h) do { _Pragma("unroll") for (int n = 0; n < 2; ++n) _Pragma("unroll") for (int k = 0; k < 2; ++k) dst[n][k] = *(const PG8_LAS bf16x8*)(lds + PG8_SB(b, h) + boff + n * 2048 + k * 1024); } while (0)
#define PG8_MMA(ai, bj, At, Bt) do { __builtin_amdgcn_s_setprio(1); _Pragma("unroll") for (int m = 0; m < 4; ++m) _Pragma("unroll") for (int n = 0; n < 2; ++n) _Pragma("unroll") for (int k = 0; k < 2; ++k) \
        acc[ai][bj][m][n] = __builtin_amdgcn_mfma_f32_16x16x32_bf16(Bt[n][k], At[m][k], acc[ai][bj][m][n], 0, 0, 0); __builtin_amdgcn_s_setprio(0); } while (0)
#define PG8_WAIT_V(n) asm volatile("s_waitcnt vmcnt(" #n ")" ::: "memory")
#define PG8_WAIT_L(n) asm volatile("s_waitcnt lgkmcnt(" #n ")" ::: "memory")
#define PG8_BAR __builtin_amdgcn_s_barrier()
#define PG8_SCHED __builtin_amdgcn_sched_barrier(0)
    Unit cur, nxt; int ui = 0;
    if (!S.next(0, cur)) return;
    f32x4 acc[2][2][4][2];
#pragma unroll
    for (int a = 0; a < 2; ++a)
#pragma unroll
        for (int b = 0; b < 2; ++b)
#pragma unroll
            for (int m = 0; m < 4; ++m)
#pragma unroll
                for (int n = 0; n < 2; ++n) acc[a][b][m][n] = (f32x4){0.f, 0.f, 0.f, 0.f};
    bf16x8 At[4][2], B0[2][2], B1[2][2];
    const char* cA = (const char*)g.A + cur.aoff; const char* cB = (const char*)g.Bt + cur.boff;
    if constexpr (SP2) {
        PG8_STAGE(PG8_SB(0, 0), cB, voffB); PG8_STAGE(PG8_SB(0, 1), cB + hstepB, voffB); PG8_STAGE(PG8_SA(0, 0), cA, voffA); PG8_STAGE(PG8_SA(0, 1), cA + hstepA, voffA);
        if (wr == 1) PG8_BAR;
        PG8_WAIT_V(2); PG8_BAR;
        PG8_STAGE(PG8_SB(1, 0), cB + kstep, voffB); PG8_STAGE(PG8_SA(1, 0), cA + kstep, voffA); PG8_STAGE(PG8_SB(1, 1), cB + hstepB + kstep, voffB);
        PG8_WAIT_V(6); PG8_BAR;
    } else {
        PG8_STAGE(PG8_SB(0, 0), cB, voffB); PG8_STAGE(PG8_SA(0, 0), cA, voffA); PG8_STAGE(PG8_SB(0, 1), cB + hstepB, voffB); PG8_STAGE(PG8_SA(0, 1), cA + hstepA, voffA);
        if (wr == 1) PG8_BAR;
        PG8_WAIT_V(4); PG8_BAR;
        PG8_STAGE(PG8_SB(1, 0), cB + kstep, voffB); PG8_STAGE(PG8_SA(1, 0), cA + kstep, voffA); PG8_STAGE(PG8_SB(1, 1), cB + hstepB + kstep, voffB);
        PG8_WAIT_V(6); PG8_BAR;
    }
    for (;;) {
        const bool has_next = S.next(ui + 1, nxt);
        const char* nA = has_next ? (const char*)g.A + nxt.aoff : cA; const char* nB = has_next ? (const char*)g.Bt + nxt.boff : cB;
        for (int t = 0; t < nt; t += 2) {
            const bool last = (t == nt - 2);
            const char* a1 = cA + (size_t)(t + 1) * kstep;
            const char* a2 = last ? nA : cA + (size_t)(t + 2) * kstep; const char* b2 = last ? nB : cB + (size_t)(t + 2) * kstep;
            const char* a3 = a2 + kstep; const char* b3 = b2 + kstep;
            if constexpr (SP2) {
            PG8_LDB(B0, 0, 0); PG8_LDB(B1, 0, 1); PG8_SCHED; PG8_LDA(At, 0, 0); PG8_STAGE(PG8_SA(1, 1), a1 + hstepA, voffA);
            PG8_WAIT_V(8); PG8_WAIT_L(0); PG8_BAR; PG8_MMA(0, 0, At, B0); PG8_MMA(0, 1, At, B1); PG8_BAR; PG8_SCHED;
            PG8_LDA(At, 0, 1); PG8_STAGE(PG8_SB(0, 0), b2, voffB); PG8_STAGE(PG8_SB(0, 1), b2 + hstepB, voffB); PG8_STAGE(PG8_SA(0, 0), a2, voffA);
            PG8_WAIT_V(8); PG8_WAIT_L(0); PG8_BAR; PG8_MMA(1, 0, At, B0); PG8_MMA(1, 1, At, B1); PG8_BAR; PG8_SCHED;
            PG8_LDB(B0, 1, 0); PG8_LDB(B1, 1, 1); PG8_SCHED; PG8_LDA(At, 1, 0); PG8_STAGE(PG8_SA(0, 1), a2 + hstepA, voffA);
            PG8_WAIT_V(8); PG8_WAIT_L(0); PG8_BAR; PG8_MMA(0, 0, At, B0); PG8_MMA(0, 1, At, B1); PG8_BAR; PG8_SCHED;
            PG8_LDA(At, 1, 1); PG8_STAGE(PG8_SB(1, 0), b3, voffB); PG8_STAGE(PG8_SB(1, 1), b3 + hstepB, voffB); PG8_STAGE(PG8_SA(1, 0), a3, voffA);
            PG8_WAIT_V(8); PG8_WAIT_L(0); PG8_BAR; PG8_MMA(1, 0, At, B0); PG8_MMA(1, 1, At, B1); PG8_BAR; PG8_SCHED;
            } else {
            PG8_LDB(B0, 0, 0); PG8_SCHED; PG8_LDA(At, 0, 0); PG8_STAGE(PG8_SA(1, 1), a1 + hstepA, voffA);
            PG8_WAIT_L(8); PG8_BAR; PG8_WAIT_L(0); PG8_MMA(0, 0, At, B0); PG8_BAR; PG8_SCHED;
            PG8_LDB(B1, 0, 1); PG8_STAGE(PG8_SB(0, 0), b2, voffB);
            PG8_BAR; PG8_WAIT_L(0); PG8_MMA(0, 1, At, B1); PG8_BAR;
            PG8_LDA(At, 0, 1); PG8_STAGE(PG8_SA(0, 0), a2, voffA);
            PG8_BAR; PG8_WAIT_L(0); PG8_MMA(1, 0, At, B0); PG8_BAR; PG8_SCHED;
            PG8_STAGE(PG8_SB(0, 1), b2 + hstepB, voffB);
            PG8_WAIT_V(6); PG8_BAR; PG8_MMA(1, 1, At, B1); PG8_BAR;
            PG8_LDB(B0, 1, 0); PG8_SCHED; PG8_LDA(At, 1, 0); PG8_STAGE(PG8_SA(0, 1), a2 + hstepA, voffA);
            PG8_WAIT_L(8); PG8_BAR; PG8_WAIT_L(0); PG8_MMA(0, 0, At, B0); PG8_BAR; PG8_SCHED;
            PG8_LDB(B1, 1, 1); PG8_STAGE(PG8_SB(1, 0), b3, voffB);
            PG8_BAR; PG8_WAIT_L(0); PG8_MMA(0, 1, At, B1); PG8_BAR;
            PG8_LDA(At, 1, 1); PG8_STAGE(PG8_SA(1, 0), a3, voffA);
            PG8_BAR; PG8_WAIT_L(0); PG8_MMA(1, 0, At, B0); PG8_BAR; PG8_SCHED;
            PG8_STAGE(PG8_SB(1, 1), b3 + hstepB, voffB);
            PG8_WAIT_V(6); PG8_BAR; PG8_MMA(1, 1, At, B1); PG8_BAR;
            }
        }
        if constexpr (ALIGN_EPI) { if (wr == 0) PG8_BAR; }
        E(acc, cur, wr, wc, fr, fq);
        if (!has_next) break;
#pragma unroll
        for (int a = 0; a < 2; ++a)
#pragma unroll
            for (int b = 0; b < 2; ++b)
#pragma unroll
                for (int m = 0; m < 4; ++m)
#pragma unroll
                    for (int n = 0; n < 2; ++n) acc[a][b][m][n] = (f32x4){0.f, 0.f, 0.f, 0.f};
        cur = nxt; cA = nA; cB = nB; ++ui;
        if constexpr (ALIGN_EPI) { if (wr == 1) PG8_BAR; }
    }
    PG8_WAIT_V(0);
    if constexpr (!ALIGN_EPI) { if (wr == 0) PG8_BAR; }
    PG8_BAR;
#undef PG8_SA
#undef PG8_SB
#undef PG8_STAGE
#undef PG8_LDA
#undef PG8_LDB
#undef PG8_MMA
#undef PG8_WAIT_V
#undef PG8_WAIT_L
#undef PG8_BAR
#undef PG8_SCHED
}
}

#define LAS __attribute__((address_space(3)))
typedef unsigned short bf16;
typedef float f32x4 __attribute__((ext_vector_type(4)));
typedef unsigned u32x4 __attribute__((ext_vector_type(4)));
typedef unsigned u32x2 __attribute__((ext_vector_type(2)));

constexpr int NB = 8, T = 4096, D = 1024, M = NB * T, NL = 2;
constexpr int INW = 9160;
constexpr int PP = 5120;
constexpr int C_AQ = 0, C_AK = 768, C_AV = 1536, C_BQ = 2304, C_BK = 2560, C_BV = 2816, C_IQ = 3072, C_IK = 3328, C_C = 3392, C_DZ = 4288, C_DX = 4544, C_IW = 5056, C_DT = 5060, C_END = 5064;
constexpr int NEXP = 32, DEXP = 512;
constexpr int CAP = 73728;
constexpr float LN_EPS = 1e-5f;
constexpr float ALPHA = 1.4142135623730951f;

constexpr size_t MiB = 1u << 20;
constexpr size_t WS_CTL = 0, CTL_BYTES = 1 * MiB;
constexpr size_t WS_WINT = 2 * MiB;
constexpr size_t WS_WGT = 22 * MiB;
constexpr size_t WS_WBRT = 38 * MiB;
constexpr size_t WS_WOUTT = 42 * MiB;
constexpr size_t WS_WRT = 46 * MiB;
constexpr size_t WS_ROUTE = 47 * MiB;
constexpr size_t WS_XB = 48 * MiB;
constexpr size_t WS_O = 112 * MiB;
constexpr size_t WS_VF = 176 * MiB;
constexpr size_t WS_P = 192 * MiB;
constexpr size_t WS_GS = 192 * MiB;
constexpr size_t WS_MERGED = 448 * MiB;
constexpr size_t WS_XS = 192 * MiB;
constexpr size_t WS_H = 336 * MiB;
constexpr size_t WS_WGU = 408 * MiB;
constexpr size_t WS_WD = 472 * MiB;
constexpr size_t WS_END = 512 * MiB;
constexpr int CW_CNT = 64;

constexpr int RING_BYTES = 131072, MISC_OFF = RING_BYTES, LDS_BYTES = 147456;
constexpr int NWAVES = 8, NTHR = 512;

__device__ __forceinline__ float bf2f(bf16 v) { return __uint_as_float(((unsigned)v) << 16); }
__device__ __forceinline__ unsigned f2bf(float f) { unsigned u = __float_as_uint(f); return (u + 0x7fffu + ((u >> 16) & 1u)) >> 16; }
__device__ __forceinline__ unsigned pk2(float lo, float hi) { return f2bf(lo) | (f2bf(hi) << 16); }
__device__ __forceinline__ float wave_sum(float v) {
#pragma unroll
    for (int o = 1; o < 64; o <<= 1) v += __shfl_xor(v, o);
    return v;
}
__device__ __forceinline__ float wave_max(float v) {
#pragma unroll
    for (int o = 1; o < 64; o <<= 1) v = fmaxf(v, __shfl_xor(v, o));
    return v;
}
__device__ __forceinline__ float sigmoidf_(float x) { return 1.f / (1.f + __expf(-x)); }
__device__ __forceinline__ float softplusf_(float x) { return x > 20.f ? x : log1pf(__expf(x)); }
__device__ __forceinline__ float siluf_(float x) { return x / (1.f + __expf(-x)); }

struct Args { const float* in[35]; float* out; unsigned char* ws; int ph_lo, ph_hi; };
enum { I_X = 0, I_WIN, I_CMU, I_CW0, I_CW2, I_CA0, I_CA2, I_CG2, I_CKK, I_CKA, I_CRK, I_CGNW, I_CGNB, I_CV0, I_CV1, I_CV2, I_DCW, I_DCB, I_DDTB, I_DALOG, I_DSKIP, I_DNW,
       I_WBR, I_WOUT, I_LN1G, I_LN1B, I_RG, I_RGB, I_RE, I_REB, I_EG, I_EU, I_ED, I_LN2G, I_LN2B };

__device__ __forceinline__ void transpose_item(const float* W, int ldn, int c0, int ncols, bf16* dst, int dld, int r0, int dk0, int kb, int nb, LAS float* scr, int lane) {
    const int k0 = 64 * kb, n0 = 32 * nb;
    const bool okn = (n0 + (lane & 31)) < ncols;
#pragma unroll 8
    for (int i = 0; i < 32; ++i) { const int kk = 2 * i + (lane >> 5); scr[kk * 33 + (lane & 31)] = okn ? W[(size_t)(k0 + kk) * ldn + c0 + n0 + (lane & 31)] : 0.f; }
    asm volatile("s_waitcnt lgkmcnt(0)" ::: "memory");
    const int c = lane & 7;
#pragma unroll
    for (int j = 0; j < 4; ++j) { const int n = (lane >> 3) + 8 * j; const LAS float* s = scr + (8 * c) * 33 + n;
        u32x4 o; o.x = pk2(s[0 * 33], s[1 * 33]); o.y = pk2(s[2 * 33], s[3 * 33]); o.z = pk2(s[4 * 33], s[5 * 33]); o.w = pk2(s[6 * 33], s[7 * 33]);
        if (n0 + n < ncols) *(u32x4*)(dst + (size_t)(r0 + n0 + n) * dld + dk0 + k0 + 8 * c) = o; }
    asm volatile("s_waitcnt lgkmcnt(0)" ::: "memory");
}

struct EpiStoreBf16 {
    static constexpr bool PERM = true;
    bf16* O; int ldc; int act; int ncols;
    __device__ __forceinline__ void operator()(const pg8::f32x4 (&acc)[2][2][4][2], const pg8::Unit& u, int wr, int wc, int fr, int fq) const {
        const int row0 = u.pm * 256 + wr * 64 + fr; const int col0 = u.pn * 256 + wc * 32 + 8 * fq;
#pragma unroll
        for (int ai = 0; ai < 2; ++ai)
#pragma unroll
            for (int m = 0; m < 4; ++m) { bf16* rowp = O + (size_t)(row0 + ai * 128 + m * 16) * ldc + col0;
#pragma unroll
                for (int bj = 0; bj < 2; ++bj) { pg8::f32x4 v0 = acc[ai][bj][m][0], v1 = acc[ai][bj][m][1];
                    if (act == 1) {
#pragma unroll
                        for (int j = 0; j < 4; ++j) { v0[j] = sigmoidf_(v0[j]); v1[j] = sigmoidf_(v1[j]); } }
                    u32x4 w; w.x = pg8::cvt_pk_bf16(v0[0], v0[1]); w.y = pg8::cvt_pk_bf16(v0[2], v0[3]); w.z = pg8::cvt_pk_bf16(v1[0], v1[1]); w.w = pg8::cvt_pk_bf16(v1[2], v1[3]);
                    if (col0 + bj * 128 < ncols) *(u32x4*)(rowp + bj * 128) = w; } }
    }
};
struct EpiBranch {
    static constexpr bool PERM = true;
    const bf16* GS; bf16* MG;
    __device__ __forceinline__ void operator()(const pg8::f32x4 (&acc)[2][2][4][2], const pg8::Unit& u, int wr, int wc, int fr, int fq) const {
        const int row0 = u.pm * 256 + wr * 64 + fr; const int col0 = u.pn * 256 + wc * 32 + 8 * fq; const int n = u.aux;
#pragma unroll
        for (int ai = 0; ai < 2; ++ai)
#pragma unroll
            for (int m = 0; m < 4; ++m) { const size_t r = (size_t)(row0 + ai * 128 + m * 16);
#pragma unroll
                for (int bj = 0; bj < 2; ++bj) {
                    const u32x4 gv = *(const u32x4*)(GS + r * 4096 + n * 1024 + col0 + bj * 128);
                    bf16* mp = MG + r * 1024 + col0 + bj * 128;
                    float v[8];
#pragma unroll
                    for (int j = 0; j < 4; ++j) { v[j] = acc[ai][bj][m][0][j]; v[4 + j] = acc[ai][bj][m][1][j]; }
                    const unsigned gw[4] = {gv.x, gv.y, gv.z, gv.w};
#pragma unroll
                    for (int j = 0; j < 4; ++j) { v[2 * j] *= __uint_as_float(gw[j] << 16); v[2 * j + 1] *= __uint_as_float(gw[j] & 0xffff0000u); }
                    if (n != 0) { const u32x4 ov = *(const u32x4*)mp; const unsigned ow[4] = {ov.x, ov.y, ov.z, ov.w};
#pragma unroll
                        for (int j = 0; j < 4; ++j) { v[2 * j] += __uint_as_float(ow[j] << 16); v[2 * j + 1] += __uint_as_float(ow[j] & 0xffff0000u); } }
                    u32x4 w; w.x = pg8::cvt_pk_bf16(v[0], v[1]); w.y = pg8::cvt_pk_bf16(v[2], v[3]); w.z = pg8::cvt_pk_bf16(v[4], v[5]); w.w = pg8::cvt_pk_bf16(v[6], v[7]);
                    *(u32x4*)mp = w; asm volatile("" ::: "memory"); } }
    }
};
struct EpiResid {
    static constexpr bool PERM = false;
    float* X;
    __device__ __forceinline__ void operator()(const pg8::f32x4 (&acc)[2][2][4][2], const pg8::Unit& u, int wr, int wc, int fr, int fq) const {
        const int row0 = u.pm * 256 + wr * 64 + fr, col0 = u.pn * 256 + wc * 32 + 4 * fq;
#pragma unroll
        for (int ai = 0; ai < 2; ++ai)
#pragma unroll
            for (int m = 0; m < 4; ++m) { float* rowp = X + (size_t)(row0 + ai * 128 + m * 16) * D + col0;
#pragma unroll
                for (int bj = 0; bj < 2; ++bj)
#pragma unroll
                    for (int n = 0; n < 2; ++n) { pg8::f32x4* p = (pg8::f32x4*)(rowp + bj * 128 + n * 16); *p = *p * ALPHA + acc[ai][bj][m][n]; } }
    }
};
struct EpiSwiglu {
    static constexpr bool PERM = true;
    bf16* H;
    __device__ __forceinline__ void operator()(const pg8::f32x4 (&acc)[2][2][4][2], const pg8::Unit& u, int wr, int wc, int fr, int fq) const {
        const int row0 = u.pm * 256 + wr * 64 + fr; const int col0 = u.pn * 128 + wc * 32 + 8 * fq;
#pragma unroll
        for (int ai = 0; ai < 2; ++ai)
#pragma unroll
            for (int m = 0; m < 4; ++m) { bf16* rowp = H + (size_t)(row0 + ai * 128 + m * 16) * DEXP + col0;
                float v[8];
#pragma unroll
                for (int j = 0; j < 4; ++j) { v[j] = siluf_(acc[ai][0][m][0][j]) * acc[ai][1][m][0][j]; v[4 + j] = siluf_(acc[ai][0][m][1][j]) * acc[ai][1][m][1][j]; }
                u32x4 w; w.x = pg8::cvt_pk_bf16(v[0], v[1]); w.y = pg8::cvt_pk_bf16(v[2], v[3]); w.z = pg8::cvt_pk_bf16(v[4], v[5]); w.w = pg8::cvt_pk_bf16(v[6], v[7]);
                *(u32x4*)rowp = w; }
    }
};

struct BranchOrder {
    int nM, nN, G, c;
    __device__ bool next(int i, pg8::Unit& u) const {
        const int tl = (i >> 2) * G + c; if (tl >= nM * nN) return false;
        pg8::tile_of(tl, nM, nN, u.pm, u.pn); u.aux = i & 3;
        u.aoff = ((size_t)u.pm * 256 * 1024 + (size_t)u.aux * 256) * 2; u.boff = ((size_t)u.pn * 256 * 1024 + (size_t)u.aux * 256) * 2; return true;
    }
};
struct MoeOrder {
    const volatile LAS int* tb; int G, c; size_t a_rowbytes, b_expbytes, b_tilebytes;
    __device__ bool next(int i, pg8::Unit& u) const {
        const int L = i * G + c; const int total = __builtin_amdgcn_readfirstlane(tb[32]) * 4; if (L >= total) return false;
        int e = 0;
#pragma unroll 1
        for (int k = 0; k < 32; ++k) if (L >= tb[k + 1] * 4) e = k + 1;
        const int nte = tb[e + 1] - tb[e]; const int r = L - tb[e] * 4; const int ct = r / nte, rt = r % nte;
        u.pm = __builtin_amdgcn_readfirstlane(tb[33 + e] + rt); u.pn = __builtin_amdgcn_readfirstlane(ct); u.aux = __builtin_amdgcn_readfirstlane(e);
        u.aoff = (size_t)u.pm * 256 * a_rowbytes; u.boff = (size_t)u.aux * b_expbytes + (size_t)u.pn * b_tilebytes; return true;
    }
};

constexpr int PTR_OFF = LDS_BYTES - 512;
__device__ __forceinline__ void ptr_table_fill(const Args& args, LAS unsigned char* lds) {
    if (threadIdx.x == 0) {
        volatile LAS unsigned long long* t = (volatile LAS unsigned long long*)(lds + PTR_OFF);
#define PT_(i) t[i] = (unsigned long long)args.in[i];
        PT_(0) PT_(1) PT_(2) PT_(3) PT_(4) PT_(5) PT_(6) PT_(7) PT_(8) PT_(9) PT_(10) PT_(11) PT_(12) PT_(13) PT_(14) PT_(15) PT_(16) PT_(17) PT_(18) PT_(19)
        PT_(20) PT_(21) PT_(22) PT_(23) PT_(24) PT_(25) PT_(26) PT_(27) PT_(28) PT_(29) PT_(30) PT_(31) PT_(32) PT_(33) PT_(34)
#undef PT_
        t[35] = (unsigned long long)args.out; t[36] = (unsigned long long)args.ws;
    }
    __syncthreads();
}
__device__ __forceinline__ unsigned long long ldptr(LAS unsigned char* lds, int i) {
    unsigned a = (unsigned)(PTR_OFF + 8 * i); asm volatile("" : "+v"(a));
    const volatile LAS unsigned* t = (const volatile LAS unsigned*)(lds + a);
    const unsigned lo = __builtin_amdgcn_readfirstlane(t[0]), hi = __builtin_amdgcn_readfirstlane(t[1]);
    return ((unsigned long long)hi << 32) | lo;
}
#define INP(i) ((const float*)ldptr(lds, (i)))
template <int SP>
__device__ __forceinline__ void phase_body(const int l_in, LAS unsigned char* lds) {
    int tid_ = threadIdx.x, bid_ = blockIdx.x, l_ = l_in; asm volatile("" : "+v"(tid_), "+s"(bid_), "+s"(l_));
    const int tid = tid_, lane = tid & 63, wave = __builtin_amdgcn_readfirstlane(tid >> 6), l = l_;
    const int G = gridDim.x, bid = bid_;
    const int gw = bid * NWAVES + wave, NGW = G * NWAVES;
    unsigned char* ws = (unsigned char*)ldptr(lds, 36);
    int* ctl = (int*)(ws + WS_CTL);
    bf16* XB = (bf16*)(ws + WS_XB); bf16* OB = (bf16*)(ws + WS_O); bf16* VF = (bf16*)(ws + WS_VF); bf16* P = (bf16*)(ws + WS_P);
    bf16* GS = (bf16*)(ws + WS_GS); bf16* MG = (bf16*)(ws + WS_MERGED); bf16* XS = (bf16*)(ws + WS_XS); bf16* HB = (bf16*)(ws + WS_H);
    bf16* WGU = (bf16*)(ws + WS_WGU); bf16* WD = (bf16*)(ws + WS_WD);
    float* X = (float*)ldptr(lds, 35);
    int* tok_e = (int*)(ws + WS_ROUTE); float* tok_g = (float*)(ws + WS_ROUTE + 256 * 1024); int* tok_rank = (int*)(ws + WS_ROUTE + 512 * 1024); int* tok_slot = (int*)(ws + WS_ROUTE + 768 * 1024);
    (void)ctl; (void)XB; (void)OB; (void)VF; (void)P; (void)GS; (void)MG; (void)XS; (void)HB; (void)WGU; (void)WD; (void)X; (void)tok_e; (void)tok_g; (void)tok_rank; (void)tok_slot; (void)gw; (void)NGW; (void)lane;
    {
        bf16* WinT = (bf16*)(ws + WS_WINT) + (size_t)l * 5120 * 1024; bf16* WgT = (bf16*)(ws + WS_WGT) + (size_t)l * 4096 * 1024;
        bf16* WbrT = (bf16*)(ws + WS_WBRT) + (size_t)l * 1024 * 1024; bf16* WoutT = (bf16*)(ws + WS_WOUTT) + (size_t)l * 1024 * 1024;
        float* WrT = (float*)(ws + WS_WRT) + (size_t)l * 36 * 1024;
        int* cnt = ctl + CW_CNT + l * 64;

        if constexpr (SP == -1) {
            LAS float* scr = (LAS float*)(lds + wave * 16384);
#pragma unroll 1
            for (int job = 0; job < NL * 11; ++job) {
                const int ll = job / 11, jk = job % 11;
                if (jk < 5) {
                    const float* W = INP(I_WIN) + (size_t)ll * 1024 * INW;
                    const int sc0 = jk == 0 ? 0 : (jk == 1 ? 3396 : (jk == 2 ? 3392 : (jk == 3 ? 5060 : 5064)));
                    const int snc = jk == 0 ? 3392 : (jk == 1 ? 1664 : (jk == 4 ? 4096 : 4));
                    const int sr0 = jk == 0 ? 0 : (jk == 1 ? 3392 : (jk == 2 ? 5056 : (jk == 3 ? 5060 : 0)));
                    bf16* dst = jk == 4 ? (bf16*)(ws + WS_WGT) + (size_t)ll * 4096 * 1024 : (bf16*)(ws + WS_WINT) + (size_t)ll * 5120 * 1024;
                    const int nbn = (snc + 31) / 32, nit = 16 * nbn;
#pragma unroll 1
                    for (int it = gw; it < nit; it += NGW) transpose_item(W, INW, sc0, snc, dst, 1024, sr0, 0, it / nbn, it % nbn, scr, lane);
                } else if (jk < 9) {
                    const int n = jk - 5; const float* Wb = INP(I_WBR) + ((size_t)ll * 4 + n) * 256 * 1024;
#pragma unroll 1
                    for (int it = gw; it < 4 * 32; it += NGW) transpose_item(Wb, 1024, 0, 1024, (bf16*)(ws + WS_WBRT) + (size_t)ll * 1024 * 1024, 1024, 0, n * 256, it / 32, it % 32, scr, lane);
                } else if (jk == 9) {
                    const float* Wo = INP(I_WOUT) + (size_t)ll * 1024 * 1024;
#pragma unroll 1
                    for (int it = gw; it < 16 * 32; it += NGW) transpose_item(Wo, 1024, 0, 1024, (bf16*)(ws + WS_WOUTT) + (size_t)ll * 1024 * 1024, 1024, 0, 0, it / 32, it % 32, scr, lane);
                } else {
                    bf16* wi = (bf16*)(ws + WS_WINT) + (size_t)ll * 5120 * 1024;
#pragma unroll 1
                    for (int i = gw * 64 + lane; i < 56 * 1024 / 8; i += NGW * 64) ((u32x4*)(wi + (size_t)5064 * 1024))[i] = (u32x4){0u, 0u, 0u, 0u};
                    float* wr = (float*)(ws + WS_WRT) + (size_t)ll * 36 * 1024; const float* rg = INP(I_RG) + (size_t)ll * 1024 * 4; const float* re = INP(I_RE) + (size_t)ll * 1024 * 32;
#pragma unroll 1
                    for (int i = gw * 64 + lane; i < 36 * 1024; i += NGW * 64) { const int o = i / 1024, k = i % 1024; wr[i] = o < 4 ? rg[k * 4 + o] : re[k * 32 + (o - 4)]; }
                }
            }
            for (int m = gw; m < M; m += NGW) {
                const f32x4* xr = (const f32x4*)(INP(I_X) + (size_t)m * D) + lane;
#pragma unroll
                for (int j = 0; j < 4; ++j) { const f32x4 v = xr[64 * j]; ((f32x4*)(X + (size_t)m * D))[lane + 64 * j] = v;
                    u32x2 w; w.x = pk2(v[0], v[1]); w.y = pk2(v[2], v[3]); ((u32x2*)(XB + (size_t)m * D))[lane + 64 * j] = w; }
            }
        }
        else if constexpr (SP == 0) {
            pg8::Gemm g{XB, WinT, 1024, 1024, 1024}; pg8::StaticOrder S; S.init(M, PP, G, bid, 1024, 1024);
            EpiStoreBf16 E{P, PP, 0, PP};
            pg8::gemm_phase<EpiStoreBf16, pg8::StaticOrder>(lds, g, S, E);
        }
        else if constexpr (SP == 1) {
            for (int wv = gw; wv < (M / 64) * 4; wv += NGW) {
                const int h = wv & 3, m = (wv >> 2) * 64 + lane, t = m % T, b = m / T;
                float o[64]; float mx = -INFINITY, den = 0.f;
#pragma unroll
                for (int d = 0; d < 64; ++d) o[d] = 0.f;
                for (int gI = 0; gI < 3; ++gI) {
                    const int dil = gI == 0 ? 1 : (gI == 1 ? 4 : 16);
                    float q[64];
                    { const u32x4* qp = (const u32x4*)(P + (size_t)m * PP + C_AQ + gI * 256 + h * 64);
#pragma unroll
                        for (int c8 = 0; c8 < 8; ++c8) { const u32x4 v = qp[c8]; const unsigned w4[4] = {v.x, v.y, v.z, v.w};
#pragma unroll
                            for (int j = 0; j < 4; ++j) { q[c8 * 8 + 2 * j] = __uint_as_float(w4[j] << 16) * 0.125f; q[c8 * 8 + 2 * j + 1] = __uint_as_float(w4[j] & 0xffff0000u) * 0.125f; } } }
                    for (int j = 0; j <= 128; ++j) {
                        const int pos = t - j * dil; if (pos < 0) break;
                        const bf16* kr = P + (size_t)(b * T + pos) * PP + C_AK + gI * 256 + h * 64;
                        float s = 0.f;
#pragma unroll
                        for (int c8 = 0; c8 < 8; ++c8) { const u32x4 v = ((const u32x4*)kr)[c8]; const unsigned w4[4] = {v.x, v.y, v.z, v.w};
#pragma unroll
                            for (int jj = 0; jj < 4; ++jj) { s += q[c8 * 8 + 2 * jj] * __uint_as_float(w4[jj] << 16); s += q[c8 * 8 + 2 * jj + 1] * __uint_as_float(w4[jj] & 0xffff0000u); } }
                        const float mn = fmaxf(mx, s), corr = __expf(mx - mn), p = __expf(s - mn); mx = mn; den = den * corr + p;
                        const bf16* vr = kr + 768;
#pragma unroll
                        for (int c8 = 0; c8 < 8; ++c8) { const u32x4 v = ((const u32x4*)vr)[c8]; const unsigned w4[4] = {v.x, v.y, v.z, v.w};
#pragma unroll
                            for (int jj = 0; jj < 4; ++jj) { o[c8 * 8 + 2 * jj] = o[c8 * 8 + 2 * jj] * corr + p * __uint_as_float(w4[jj] << 16); o[c8 * 8 + 2 * jj + 1] = o[c8 * 8 + 2 * jj + 1] * corr + p * __uint_as_float(w4[jj] & 0xffff0000u); } }
                    }
                }
                const float inv = 1.f / den; u32x4* op = (u32x4*)(OB + (size_t)m * 1024 + 0 + h * 64);
#pragma unroll
                for (int c8 = 0; c8 < 8; ++c8) { u32x4 w; w.x = pk2(o[c8 * 8] * inv, o[c8 * 8 + 1] * inv); w.y = pk2(o[c8 * 8 + 2] * inv, o[c8 * 8 + 3] * inv); w.z = pk2(o[c8 * 8 + 4] * inv, o[c8 * 8 + 5] * inv); w.w = pk2(o[c8 * 8 + 6] * inv, o[c8 * 8 + 7] * inv); op[c8] = w; }
            }
        }
        else if constexpr (SP == 2) {
            LAS unsigned* sc = (LAS unsigned*)(lds + wave * 16384);
            LAS float* qi = (LAS float*)(lds + 131072 + wave * 1536);
            LAS unsigned short* sel = (LAS unsigned short*)(lds + wave * 16384);
            (void)sel;
            for (int it = 0; it < 16; ++it) {
                const int bb = it >> 1, tblk = (it & 1) ? (511 - (bid & 255)) : (bid & 255);
                if (bid >= 256) break;
                const int t = tblk * 8 + wave, m = bb * T + t;
                const bf16* prow = P + (size_t)m * PP;
                for (int i = lane; i < 256; i += 64) qi[i] = bf2f(prow[C_IQ + i]) * 0.125f;
                float wq[4];
#pragma unroll
                for (int hh = 0; hh < 4; ++hh) wq[hh] = bf2f(prow[C_IW + hh]) * 0.5f;
                asm volatile("s_waitcnt lgkmcnt(0)" ::: "memory");
                const int nblk = (t >> 6) + 1;
                for (int kb = 0; kb < nblk; ++kb) {
                    const int key = kb * 64 + lane; unsigned ok = 0u;
                    if (key <= t) {
                        const u32x4* kr = (const u32x4*)(P + (size_t)(bb * T + key) * PP + C_IK);
                        float lg[4] = {0.f, 0.f, 0.f, 0.f};
#pragma unroll
                        for (int c8 = 0; c8 < 8; ++c8) { const u32x4 v = kr[c8]; const unsigned w4[4] = {v.x, v.y, v.z, v.w};
#pragma unroll
                            for (int jj = 0; jj < 4; ++jj) { const float k0 = __uint_as_float(w4[jj] << 16), k1 = __uint_as_float(w4[jj] & 0xffff0000u);
#pragma unroll
                                for (int hh = 0; hh < 4; ++hh) { lg[hh] += qi[hh * 64 + c8 * 8 + 2 * jj] * k0; lg[hh] += qi[hh * 64 + c8 * 8 + 2 * jj + 1] * k1; } } }
                        float s = 0.f;
#pragma unroll
                        for (int hh = 0; hh < 4; ++hh) s += wq[hh] * fmaxf(lg[hh], 0.f);
                        const unsigned u = __float_as_uint(s); ok = (u & 0x80000000u) ? ~u : (u | 0x80000000u);
                        if (ok == 0u) ok = 1u;
                    }
                    sc[key] = ok;
                }
                asm volatile("s_waitcnt lgkmcnt(0)" ::: "memory");
                unsigned thr = 0u; int need = 1 << 30;
                if (t + 1 > 256) {
                    unsigned prefix = 0u;
                    for (int bit = 31; bit >= 0; --bit) {
                        const unsigned cand = prefix | (1u << bit); int c = 0;
                        for (int kb = 0; kb < nblk; ++kb) c += __popcll(__ballot(sc[kb * 64 + lane] >= cand));
                        if (c >= 256) prefix = cand;
                    }
                    thr = prefix; int cgt = 0;
                    for (int kb = 0; kb < nblk; ++kb) cgt += __popcll(__ballot(sc[kb * 64 + lane] > thr));
                    need = 256 - cgt;
                }
                LAS unsigned short* sl = (LAS unsigned short*)(qi + 256);
                int base = 0, beq = 0;
                const unsigned long long lt = (1ull << lane) - 1ull;
                for (int kb = 0; kb < nblk; ++kb) {
                    const unsigned v = sc[kb * 64 + lane]; const bool valid = v != 0u;
                    const bool eq = valid && v == thr; const unsigned long long beqm = __ballot(eq);
                    const bool take = valid && (v > thr || (eq && (beq + __popcll(beqm & lt)) < need));
                    const unsigned long long bt = __ballot(take);
                    if (take) sl[base + __popcll(bt & lt)] = (unsigned short)(kb * 64 + lane);
                    base += __popcll(bt); beq += __popcll(beqm);
                }
                const int nsel = base;
                for (int i = lane; i < 256; i += 64) qi[i] = bf2f(prow[C_BQ + i]) * 0.125f;
                asm volatile("s_waitcnt lgkmcnt(0)" ::: "memory");
                LAS float* ps = (LAS float*)(lds + wave * 16384);
                float sv[4][4]; float mxh[4] = {-INFINITY, -INFINITY, -INFINITY, -INFINITY};
#pragma unroll
                for (int r = 0; r < 4; ++r) {
                    const int si = r * 64 + lane;
#pragma unroll
                    for (int hh = 0; hh < 4; ++hh) sv[r][hh] = -INFINITY;
                    if (si < nsel) {
                        const int key = sl[si]; const u32x4* kr = (const u32x4*)(P + (size_t)(bb * T + key) * PP + C_BK);
#pragma unroll
                        for (int hh = 0; hh < 4; ++hh) { float s = 0.f;
#pragma unroll
                            for (int c8 = 0; c8 < 8; ++c8) { const u32x4 v = kr[hh * 8 + c8]; const unsigned w4[4] = {v.x, v.y, v.z, v.w};
#pragma unroll
                                for (int jj = 0; jj < 4; ++jj) { s += qi[hh * 64 + c8 * 8 + 2 * jj] * __uint_as_float(w4[jj] << 16); s += qi[hh * 64 + c8 * 8 + 2 * jj + 1] * __uint_as_float(w4[jj] & 0xffff0000u); } }
                            sv[r][hh] = s; mxh[hh] = fmaxf(mxh[hh], s); }
                    }
                }
                float den[4];
#pragma unroll
                for (int hh = 0; hh < 4; ++hh) { mxh[hh] = wave_max(mxh[hh]); float e = 0.f;
#pragma unroll
                    for (int r = 0; r < 4; ++r) { sv[r][hh] = __expf(sv[r][hh] - mxh[hh]); e += sv[r][hh]; }
                    den[hh] = 1.f / wave_sum(e); }
                asm volatile("s_waitcnt lgkmcnt(0)" ::: "memory");
#pragma unroll
                for (int r = 0; r < 4; ++r) { const int si = r * 64 + lane; if (si < nsel) *(LAS f32x4*)(ps + si * 4) = (f32x4){sv[r][0] * den[0], sv[r][1] * den[1], sv[r][2] * den[2], sv[r][3] * den[3]}; }
                asm volatile("s_waitcnt lgkmcnt(0)" ::: "memory");
                float oa[4] = {0.f, 0.f, 0.f, 0.f}; const int hh = lane >> 4;
                for (int si = 0; si < nsel; ++si) {
                    const int key = sl[si]; const float p = ps[si * 4 + hh];
                    const u32x2 v = *(const u32x2*)(P + (size_t)(bb * T + key) * PP + C_BV + lane * 4);
                    oa[0] += p * __uint_as_float(v.x << 16); oa[1] += p * __uint_as_float(v.x & 0xffff0000u); oa[2] += p * __uint_as_float(v.y << 16); oa[3] += p * __uint_as_float(v.y & 0xffff0000u);
                }
                u32x2 w; w.x = pk2(oa[0], oa[1]); w.y = pk2(oa[2], oa[3]);
                *(u32x2*)(OB + (size_t)m * 1024 + 256 + lane * 4) = w;
                asm volatile("s_waitcnt lgkmcnt(0)" ::: "memory");
            }
        }
        else if constexpr (SP == 3) {
            if (bid < 32) {
                const int b = bid >> 2, h = bid & 3;
                LAS float* LW2 = (LAS float*)lds;
                LAS float* LA2 = LW2 + 32 * 64;
                LAS float* LG2 = LA2 + 32 * 64;
                LAS float* LV1 = LG2 + 64 * 64;
                LAS float* LV2 = LV1 + 256 * 16;
                LAS float* BR = LV2 + 16 * 64;
                LAS float* BD = BR + 2048; LAS float* BK_ = BD + 2048; LAS float* BA = BK_ + 2048; LAS float* BB = BA + 2048; LAS float* BV = BB + 2048; LAS float* BG = BV + 2048; LAS float* BY = BG + 2048;
                LAS float* BBON = BY + 2048;
                LAS float* SCR = BBON + 32;
                const float* cw2 = INP(I_CW2) + (size_t)l * 32 * 256; const float* ca2 = INP(I_CA2) + (size_t)l * 32 * 256; const float* cg2 = INP(I_CG2) + (size_t)l * 64 * 256;
                for (int i = tid; i < 32 * 64; i += NTHR) { LW2[i] = cw2[(i >> 6) * 256 + h * 64 + (i & 63)]; LA2[i] = ca2[(i >> 6) * 256 + h * 64 + (i & 63)]; }
                for (int i = tid; i < 64 * 64; i += NTHR) LG2[i] = cg2[(i >> 6) * 256 + h * 64 + (i & 63)];
                if (l > 0) { const float* cv1 = INP(I_CV1) + (size_t)(l - 1) * 256 * 16; const float* cv2 = INP(I_CV2) + (size_t)(l - 1) * 16 * 256;
                    for (int i = tid; i < 256 * 16; i += NTHR) LV1[i] = cv1[i];
                    for (int i = tid; i < 16 * 64; i += NTHR) LV2[i] = cv2[(i >> 6) * 256 + h * 64 + (i & 63)]; }
                const int c = h * 64 + lane;
                const float* mu = INP(I_CMU) + (size_t)l * 896;
                const float mu_r = mu[c], mu_k = mu[256 + c], mu_v = mu[512 + c], mu_x = mu[768 + lane], mu_g = mu[832 + lane];
                const float w0 = INP(I_CW0)[l * 256 + c], a0 = INP(I_CA0)[l * 256 + c], kkc = INP(I_CKK)[l * 256 + c], kac = INP(I_CKA)[l * 256 + c], rkc = INP(I_CRK)[l * 256 + c];
                const float gnw = INP(I_CGNW)[l * 256 + c], gnb = INP(I_CGNB)[l * 256 + c];
                const float v0c = l > 0 ? INP(I_CV0)[(l - 1) * 256 + c] : 0.f;
                float muv4[4];
#pragma unroll
                for (int jj = 0; jj < 4; ++jj) muv4[jj] = mu[512 + lane + 64 * jj];
                float S[64];
#pragma unroll
                for (int j = 0; j < 64; ++j) S[j] = 0.f;
                __syncthreads();
                LAS float* scr = SCR + wave * 160;
                for (int t0 = 0; t0 < T; t0 += 32) {
                    for (int q = 0; q < 4; ++q) {
                        const int tt = wave + 8 * q, t = t0 + tt; const size_t m = (size_t)b * T + t;
                        const bf16* row = P + m * PP + C_C; const bf16* prw = row - PP; const bool hp = t > 0;
#define XS_(col, muv) ({ const float cur_ = bf2f(row[col]); const float prv_ = hp ? bf2f(prw[col]) : 0.f; cur_ + (prv_ - cur_) * (muv); })
                        const float r = XS_(c, mu_r), k = XS_(256 + c, mu_k); float v = XS_(512 + c, mu_v);
                        const float xx = XS_(768 + lane, mu_x);
                        const float xg = XS_(832 + lane, mu_g);
                        scr[lane] = lane < 32 ? tanhf(xx) : xx; scr[64 + lane] = sigmoidf_(xg);
                        float vq[16];
                        if (l > 0) {
#pragma unroll
                            for (int qq = 0; qq < 16; ++qq) vq[qq] = 0.f;
#pragma unroll
                            for (int jj = 0; jj < 4; ++jj) { const float vf = XS_(512 + lane + 64 * jj, muv4[jj]);
#pragma unroll
                                for (int qq = 0; qq < 16; ++qq) vq[qq] += vf * LV1[(lane + 64 * jj) * 16 + qq]; }
#pragma unroll
                            for (int qq = 0; qq < 16; ++qq) vq[qq] = wave_sum(vq[qq]);
                        }
#undef XS_
                        asm volatile("s_waitcnt lgkmcnt(0)" ::: "memory");
                        float wsum = w0, asum = a0, gsum = 0.f;
#pragma unroll 8
                        for (int mm = 0; mm < 32; ++mm) { wsum += scr[mm] * LW2[mm * 64 + lane]; asum += scr[32 + mm] * LA2[mm * 64 + lane]; }
#pragma unroll 8
                        for (int mm = 0; mm < 64; ++mm) gsum += scr[64 + mm] * LG2[mm * 64 + lane];
                        if (l > 0) { float vl = v0c;
#pragma unroll
                            for (int qq = 0; qq < 16; ++qq) vl += vq[qq] * LV2[qq * 64 + lane];
                            const float vf = bf2f(VF[m * 256 + c]); v = v + (vf - v) * sigmoidf_(vl); }
                        else VF[m * 256 + c] = (bf16)f2bf(v);
                        const float wlog = -softplusf_(-wsum) - 0.5f, asig = sigmoidf_(asum);
                        float kk = k * kkc; const float n2 = wave_sum(kk * kk); kk = kk / fmaxf(sqrtf(n2), 1e-12f);
                        const float kmod = k * (1.f + (asig - 1.f) * kac);
                        const float dec = __expf(-__expf(wlog));
                        const float bon = wave_sum(r * kmod * rkc);
                        BR[tt * 64 + lane] = r; BD[tt * 64 + lane] = dec; BK_[tt * 64 + lane] = kmod; BA[tt * 64 + lane] = -kk; BB[tt * 64 + lane] = kk * asig; BV[tt * 64 + lane] = v; BG[tt * 64 + lane] = gsum;
                        if (lane == 0) BBON[tt] = bon;
                        asm volatile("s_waitcnt lgkmcnt(0)" ::: "memory");
                    }
                    __syncthreads();
                    if (wave == 0) {
                        for (int tt = 0; tt < 32; ++tt) {
                            const float vi = BV[tt * 64 + lane]; float sa = 0.f;
#pragma unroll
                            for (int j4 = 0; j4 < 16; ++j4) { const f32x4 a = *(const LAS f32x4*)(BA + tt * 64 + j4 * 4);
                                sa += S[j4 * 4] * a[0]; sa += S[j4 * 4 + 1] * a[1]; sa += S[j4 * 4 + 2] * a[2]; sa += S[j4 * 4 + 3] * a[3]; }
                            float y = 0.f;
#pragma unroll
                            for (int j4 = 0; j4 < 16; ++j4) { const f32x4 dd = *(const LAS f32x4*)(BD + tt * 64 + j4 * 4), bv = *(const LAS f32x4*)(BB + tt * 64 + j4 * 4), kv = *(const LAS f32x4*)(BK_ + tt * 64 + j4 * 4), rv = *(const LAS f32x4*)(BR + tt * 64 + j4 * 4);
#pragma unroll
                                for (int e = 0; e < 4; ++e) { float s = S[j4 * 4 + e] * dd[e]; s += sa * bv[e]; s += vi * kv[e]; S[j4 * 4 + e] = s; y += s * rv[e]; } }
                            BY[tt * 64 + lane] = y;
                        }
                    }
                    __syncthreads();
                    for (int q = 0; q < 4; ++q) {
                        const int tt = wave + 8 * q; const size_t m = (size_t)b * T + t0 + tt;
                        const float y = BY[tt * 64 + lane]; const float mean = wave_sum(y) * (1.f / 64.f); const float dy = y - mean; const float var = wave_sum(dy * dy) * (1.f / 64.f);
                        const float yn = dy * rsqrtf(var + 64e-5f) * gnw + gnb;
                        const float o = (yn + BBON[tt] * BV[tt * 64 + lane]) * BG[tt * 64 + lane];
                        OB[m * 1024 + 512 + c] = (bf16)f2bf(o);
                    }
                    __syncthreads();
                }
            } else if (bid < 48) {
                const int b = (bid - 32) >> 1, gI = (bid - 32) & 1;
                LAS float* XSb = (LAS float*)lds;
                LAS float* Bm = XSb + 32 * 128;
                LAS float* Cm = Bm + 32 * 64;
                LAS float* DTb = Cm + 32 * 64;
                LAS float* DAb = DTb + 64;
                LAS float* Yd = DAb + 64;
                const float* cwp = INP(I_DCW) + (size_t)l * 4 * 512; const float* cbp = INP(I_DCB) + (size_t)l * 512;
                const int cc = tid & 255, sub = tid >> 8;
                const int col = cc < 128 ? (gI * 128 + cc) : (cc < 192 ? (256 + gI * 64 + (cc - 128)) : (384 + gI * 64 + (cc - 192)));
                const float cw0 = cwp[col], cw1 = cwp[512 + col], cw2 = cwp[1024 + col], cw3 = cwp[1536 + col], cb = cbp[col];
                float Hs[64];
#pragma unroll
                for (int j = 0; j < 64; ++j) Hs[j] = 0.f;
                const int hsc = gI * 2 + (wave & 1);
                const float Ah = -__expf(INP(I_DALOG)[l * 4 + hsc]), Dsk = INP(I_DSKIP)[l * 4 + hsc];
                for (int t0 = 0; t0 < T; t0 += 32) {
                    for (int q = 0; q < 16; ++q) {
                        const int tt = q * 2 + sub, t = t0 + tt; const size_t m = (size_t)b * T + t;
                        const bf16* xp = P + m * PP + C_DX + col;
                        float a = cb + cw3 * bf2f(xp[0]);
                        if (t >= 1) a += cw2 * bf2f(xp[-PP]);
                        if (t >= 2) a += cw1 * bf2f(xp[-2 * PP]);
                        if (t >= 3) a += cw0 * bf2f(xp[-3 * PP]);
                        a = siluf_(a);
                        if (cc < 128) XSb[tt * 128 + cc] = a; else if (cc < 192) Bm[tt * 64 + cc - 128] = a; else Cm[tt * 64 + cc - 192] = a;
                        if (cc < 2) { const int hh = gI * 2 + cc; const float dt = softplusf_(bf2f(P[m * PP + C_DT + hh]) + INP(I_DDTB)[l * 4 + hh]);
                            DTb[tt * 2 + cc] = dt; DAb[tt * 2 + cc] = __expf(-dt * __expf(INP(I_DALOG)[l * 4 + hh])); }
                    }
                    __syncthreads();
                    if (wave < 2) {
                        for (int tt = 0; tt < 32; ++tt) {
                            const float x = XSb[tt * 128 + wave * 64 + lane], dt = DTb[tt * 2 + wave], da = DAb[tt * 2 + wave]; const float xdt = x * dt; float y = Dsk * x;
#pragma unroll
                            for (int j4 = 0; j4 < 16; ++j4) { const f32x4 bv = *(const LAS f32x4*)(Bm + tt * 64 + j4 * 4), cv = *(const LAS f32x4*)(Cm + tt * 64 + j4 * 4);
#pragma unroll
                                for (int e = 0; e < 4; ++e) { const float s = Hs[j4 * 4 + e] * da + xdt * bv[e]; Hs[j4 * 4 + e] = s; y += s * cv[e]; } }
                            Yd[tt * 128 + wave * 64 + lane] = y;
                        }
                    }
                    (void)Ah;
                    __syncthreads();
                    for (int q = 0; q < 4; ++q) {
                        const int tt = wave + 8 * q; const size_t m = (size_t)b * T + t0 + tt;
                        const int c0 = gI * 128 + lane, c1 = c0 + 64;
                        const float z0 = bf2f(P[m * PP + C_DZ + c0]), z1 = bf2f(P[m * PP + C_DZ + c1]);
                        const float y0 = Yd[tt * 128 + lane] * siluf_(z0), y1 = Yd[tt * 128 + 64 + lane] * siluf_(z1);
                        const float ss = wave_sum(y0 * y0 + y1 * y1); const float rs = rsqrtf(ss * (1.f / 128.f) + 1e-5f);
                        OB[m * 1024 + 768 + c0] = (bf16)f2bf(y0 * rs * INP(I_DNW)[l * 256 + c0]);
                        OB[m * 1024 + 768 + c1] = (bf16)f2bf(y1 * rs * INP(I_DNW)[l * 256 + c1]);
                    }
                    __syncthreads();
                }
            }
        }
        else if constexpr (SP == 4) {
            pg8::Gemm g{XB, WgT, 1024, 1024, 1024}; pg8::StaticOrder S; S.init(M, 4096, G, bid, 1024, 1024);
            EpiStoreBf16 E{GS, 4096, 1, 4096};
            pg8::gemm_phase<EpiStoreBf16, pg8::StaticOrder>(lds, g, S, E);
        }
        else if constexpr (SP == 5) {
            pg8::Gemm g{OB, WbrT, 1024, 1024, 256}; BranchOrder S{M / 256, 4, G, bid};
            EpiBranch E{GS, MG};
            pg8::gemm_phase<EpiBranch, BranchOrder>(lds, g, S, E);
        }
        else if constexpr (SP == 6) {
            pg8::Gemm g{MG, WoutT, 1024, 1024, 1024}; pg8::StaticOrder S; S.init(M, 1024, G, bid, 1024, 1024);
            EpiResid E{X};
            pg8::gemm_phase<EpiResid, pg8::StaticOrder>(lds, g, S, E);
        }
        else if constexpr (SP == 7) {
            const float* g1 = INP(I_LN1G) + l * 1024; const float* b1 = INP(I_LN1B) + l * 1024;
            const float* rgb = INP(I_RGB) + l * 4; const float* reb = INP(I_REB) + l * 32;
            for (int m = gw; m < M; m += NGW) {
                f32x4 v[4]; float s = 0.f; f32x4* xr = (f32x4*)(X + (size_t)m * D) + lane;
#pragma unroll
                for (int j = 0; j < 4; ++j) { v[j] = xr[64 * j]; s += (v[j][0] + v[j][1]) + (v[j][2] + v[j][3]); }
                const float mean = wave_sum(s) * (1.f / D); float s2 = 0.f;
#pragma unroll
                for (int j = 0; j < 4; ++j) { v[j] = v[j] - mean; s2 += (v[j][0] * v[j][0] + v[j][1] * v[j][1]) + (v[j][2] * v[j][2] + v[j][3] * v[j][3]); }
                const float rstd = rsqrtf(wave_sum(s2) * (1.f / D) + LN_EPS);
#pragma unroll
                for (int j = 0; j < 4; ++j) { const f32x4 gg = ((const f32x4*)g1)[lane + 64 * j], bb = ((const f32x4*)b1)[lane + 64 * j]; v[j] = v[j] * rstd * gg + bb; xr[64 * j] = v[j];
                    u32x2 w; w.x = pk2(v[j][0], v[j][1]); w.y = pk2(v[j][2], v[j][3]); ((u32x2*)(XB + (size_t)m * D))[lane + 64 * j] = w; }
                float mylg = 0.f;
#pragma unroll 1
                for (int o = 0; o < 36; ++o) { float a = 0.f;
#pragma unroll
                    for (int j = 0; j < 4; ++j) { const f32x4 wv = ((const f32x4*)(WrT + o * 1024))[lane + 64 * j]; a += v[j][0] * wv[0] + v[j][1] * wv[1] + v[j][2] * wv[2] + v[j][3] * wv[3]; }
                    a = wave_sum(a); mylg = (lane == o) ? a : mylg; }
                mylg += lane < 4 ? rgb[lane & 3] : (lane < 36 ? reb[(lane - 4) & 31] : 0.f);
                float gl[4]; float gm = -INFINITY; int gs = 0;
#pragma unroll
                for (int o = 0; o < 4; ++o) { gl[o] = __shfl(mylg, o); if (gl[o] > gm) { gm = gl[o]; gs = o; } }
                float gden = 0.f;
#pragma unroll
                for (int o = 0; o < 4; ++o) gden += __expf(gl[o] - gm);
                const float pg = 1.f / gden;
                float el[8];
#pragma unroll
                for (int o = 0; o < 8; ++o) el[o] = __shfl(mylg, 4 + gs * 8 + o);
                int e1 = 0; float m1 = el[0];
#pragma unroll
                for (int o = 1; o < 8; ++o) if (el[o] > m1) { m1 = el[o]; e1 = o; }
                int e2 = -1; float m2 = -INFINITY;
#pragma unroll
                for (int o = 0; o < 8; ++o) if (o != e1 && el[o] > m2) { m2 = el[o]; e2 = o; }
                const float r2 = __expf(m2 - m1); const float ga = pg / (1.f + r2), gb = pg * r2 / (1.f + r2);
                if (lane == 0) {
                    const int E1 = gs * 8 + e1, E2 = gs * 8 + e2;
                    tok_e[m * 2] = E1; tok_e[m * 2 + 1] = E2; tok_g[m * 2] = ga; tok_g[m * 2 + 1] = gb;
                    tok_rank[m * 2] = atomicAdd(&cnt[E1], 1); tok_rank[m * 2 + 1] = atomicAdd(&cnt[E2], 1);
                }
            }
            LAS float* scr = (LAS float*)(lds + wave * 16384);
            const float* eg = INP(I_EG) + (size_t)l * NEXP * 1024 * 512; const float* eu = INP(I_EU) + (size_t)l * NEXP * 1024 * 512; const float* ed = INP(I_ED) + (size_t)l * NEXP * 512 * 1024;
            for (int it = gw; it < NEXP * 2 * 4 * 64; it += NGW) {
                const int e = it / 512, r = it % 512, half = r / 256, ct = (r % 256) / 64, q = r % 64, kb = q / 4, nb = q % 4;
                const float* W = (half ? eu : eg) + (size_t)e * 1024 * 512;
                transpose_item(W, 512, ct * 128, 128, WGU + (size_t)e * 1024 * 1024, 1024, ct * 256 + half * 128, 0, kb, nb, scr, lane);
            }
            for (int it = gw; it < NEXP * 8 * 32; it += NGW) {
                const int e = it / 256, q = it % 256, kb = q / 32, nb = q % 32;
                transpose_item(ed + (size_t)e * 512 * 1024, 1024, 0, 1024, WD + (size_t)e * 1024 * 512, 512, 0, 0, kb, nb, scr, lane);
            }
        }
        else if constexpr (SP == 8 || SP == 9 || SP == 10) {
            volatile LAS int* tb = (volatile LAS int*)(lds + MISC_OFF);
            if (tid == 0) { int acc = 0; for (int e = 0; e < 32; ++e) { const int c = __hip_atomic_load(&cnt[e], __ATOMIC_RELAXED, __HIP_MEMORY_SCOPE_AGENT); tb[e] = acc; tb[33 + e] = acc; acc += (c + 255) >> 8; } tb[32] = acc; }
            __syncthreads();
            if constexpr (SP == 8) {
                for (int m = gw; m < M; m += NGW) {
#pragma unroll
                    for (int k = 0; k < 2; ++k) { const int e = tok_e[m * 2 + k]; const int slot = tb[33 + e] * 256 + tok_rank[m * 2 + k];
                        const u32x4* src = (const u32x4*)(XB + (size_t)m * D); u32x4* dst = (u32x4*)(XS + (size_t)slot * D);
                        dst[lane] = src[lane]; dst[lane + 64] = src[lane + 64];
                        if (lane == 0) tok_slot[m * 2 + k] = slot; }
                }
            } else if constexpr (SP == 9) {
                pg8::Gemm g{XS, WGU, 1024, 1024, 1024}; MoeOrder S{tb, G, bid, (size_t)1024 * 2, (size_t)1024 * 1024 * 2, (size_t)256 * 1024 * 2};
                EpiSwiglu E{HB};
                pg8::gemm_phase<EpiSwiglu, MoeOrder>(lds, g, S, E);
            } else {
                pg8::Gemm g{HB, WD, 512, 512, 512}; MoeOrder S{tb, G, bid, (size_t)512 * 2, (size_t)1024 * 512 * 2, (size_t)256 * 512 * 2};
                EpiStoreBf16 E{XS, 1024, 0, 1024};
                pg8::gemm_phase<EpiStoreBf16, MoeOrder>(lds, g, S, E);
            }
        }
        else if constexpr (SP == 11) {
            const float* g2 = INP(I_LN2G) + l * 1024; const float* b2 = INP(I_LN2B) + l * 1024;
            for (int m = gw; m < M; m += NGW) {
                const int s1 = tok_slot[m * 2], s2i = tok_slot[m * 2 + 1]; const float ga = tok_g[m * 2], gb = tok_g[m * 2 + 1];
                f32x4 v[4]; float s = 0.f; f32x4* xr = (f32x4*)(X + (size_t)m * D) + lane;
#pragma unroll
                for (int j = 0; j < 4; ++j) { v[j] = xr[64 * j] * ALPHA;
                    const u32x2 y1 = ((const u32x2*)(XS + (size_t)s1 * D))[lane + 64 * j], y2 = ((const u32x2*)(XS + (size_t)s2i * D))[lane + 64 * j];
                    v[j][0] += ga * __uint_as_float(y1.x << 16) + gb * __uint_as_float(y2.x << 16); v[j][1] += ga * __uint_as_float(y1.x & 0xffff0000u) + gb * __uint_as_float(y2.x & 0xffff0000u);
                    v[j][2] += ga * __uint_as_float(y1.y << 16) + gb * __uint_as_float(y2.y << 16); v[j][3] += ga * __uint_as_float(y1.y & 0xffff0000u) + gb * __uint_as_float(y2.y & 0xffff0000u);
                    s += (v[j][0] + v[j][1]) + (v[j][2] + v[j][3]); }
                const float mean = wave_sum(s) * (1.f / D); float s2 = 0.f;
#pragma unroll
                for (int j = 0; j < 4; ++j) { v[j] = v[j] - mean; s2 += (v[j][0] * v[j][0] + v[j][1] * v[j][1]) + (v[j][2] * v[j][2] + v[j][3] * v[j][3]); }
                const float rstd = rsqrtf(wave_sum(s2) * (1.f / D) + LN_EPS);
#pragma unroll
                for (int j = 0; j < 4; ++j) { const f32x4 gg = ((const f32x4*)g2)[lane + 64 * j], bb = ((const f32x4*)b2)[lane + 64 * j]; v[j] = v[j] * rstd * gg + bb; xr[64 * j] = v[j];
                    u32x2 w; w.x = pk2(v[j][0], v[j][1]); w.y = pk2(v[j][2], v[j][3]); ((u32x2*)(XB + (size_t)m * D))[lane + 64 * j] = w; }
            }
        }
    }
}

template <int SP>
__global__ void __launch_bounds__(NTHR, 2) k_phase(Args args, int l) {
    extern __shared__ __attribute__((aligned(16))) unsigned char lds_raw[];
    ptr_table_fill(args, (LAS unsigned char*)lds_raw);
    phase_body<SP>(l, (LAS unsigned char*)lds_raw);
}


namespace cg = cooperative_groups;
__global__ void __launch_bounds__(NTHR, 2) fwd_all(Args args) {
    extern __shared__ __attribute__((aligned(16))) unsigned char lds_raw[];
    LAS unsigned char* lds = (LAS unsigned char*)lds_raw;
    cg::grid_group grid = cg::this_grid();
    ptr_table_fill(args, lds);
    phase_body<-1>(0, lds); grid.sync();
#pragma unroll 1
    for (int l = 0; l < NL; ++l) {
        phase_body<0>(l, lds); grid.sync();
        phase_body<1>(l, lds); __syncthreads(); phase_body<2>(l, lds); __syncthreads(); phase_body<3>(l, lds); grid.sync();
        phase_body<4>(l, lds); grid.sync();
        phase_body<5>(l, lds); grid.sync();
        phase_body<6>(l, lds); grid.sync();
        phase_body<7>(l, lds); grid.sync();
        phase_body<8>(l, lds); grid.sync();
        phase_body<9>(l, lds); grid.sync();
        phase_body<10>(l, lds); grid.sync();
        phase_body<11>(l, lds); grid.sync();
    }
}

template <int SP> static void launch_phase(const Args& a, int l, int grid, hipStream_t stream) {
    static bool attr = false;
    if (!attr) { (void)hipFuncSetAttribute((const void*)k_phase<SP>, hipFuncAttributeMaxDynamicSharedMemorySize, LDS_BYTES); attr = true; }
    hipLaunchKernelGGL(k_phase<SP>, dim3(grid), dim3(NTHR), LDS_BYTES, stream, a, l);
}

extern "C" void kernel_launch(void* const* d_in, const int* in_sizes, int n_in, void* d_out, int out_size, void* d_ws, size_t ws_size, hipStream_t stream) {
    static int grid = 0;
    if (grid == 0) {
        if (n_in != 35 || out_size != M * D || ws_size < WS_END) { fprintf(stderr, "kernel_launch: unexpected problem (n_in %d out %d ws %zu)\n", n_in, out_size, ws_size); grid = -1; return; }
        int dev = 0, cus = 0, per_cu = 0;
        (void)hipGetDevice(&dev); (void)hipDeviceGetAttribute(&cus, hipDeviceAttributeMultiprocessorCount, dev);
#if N_LAUNCH_MODE == 1
        (void)hipFuncSetAttribute((const void*)fwd_all, hipFuncAttributeMaxDynamicSharedMemorySize, LDS_BYTES);
        if (hipOccupancyMaxActiveBlocksPerMultiprocessor(&per_cu, (const void*)fwd_all, NTHR, LDS_BYTES) != hipSuccess || per_cu < 1) { fprintf(stderr, "kernel_launch: occupancy query says %d blocks/CU\n", per_cu); grid = -1; return; }
#endif
        (void)per_cu;
        grid = cus;
        if (grid != 256) { fprintf(stderr, "kernel_launch: built for 256 CUs, found %d\n", cus); grid = -1; return; }
    }
    if (grid < 0) return;
    (void)hipMemsetAsync((char*)d_ws + WS_CTL, 0, CTL_BYTES, stream);
    Args a{};
    for (int i = 0; i < 35; ++i) a.in[i] = (const float*)d_in[i];
    a.out = (float*)d_out; a.ws = (unsigned char*)d_ws;
#if N_LAUNCH_MODE == 1
    void* kargs[] = {(void*)&a};
    hipError_t e = hipLaunchCooperativeKernel((const void*)fwd_all, dim3(grid), dim3(NTHR), kargs, LDS_BYTES, stream);
    if (e != hipSuccess) fprintf(stderr, "cooperative launch failed: %s\n", hipGetErrorString(e));
#else
    launch_phase<-1>(a, 0, grid, stream);
    for (int l = 0; l < NL; ++l) {
        launch_phase<0>(a, l, grid, stream); launch_phase<1>(a, l, grid, stream); launch_phase<2>(a, l, grid, stream); launch_phase<3>(a, l, grid, stream);
        launch_phase<4>(a, l, grid, stream); launch_phase<5>(a, l, grid, stream); launch_phase<6>(a, l, grid, stream); launch_phase<7>(a, l, grid, stream);
        launch_phase<8>(a, l, grid, stream); launch_phase<9>(a, l, grid, stream); launch_phase<10>(a, l, grid, stream); launch_phase<11>(a, l, grid, stream);
    }
#endif
}
```

```cpp
#include <hip/hip_runtime.h>
#include <cstdio>
#include <cstdint>
#include <hip/hip_cooperative_groups.h>

#ifndef PROBE_REPS
#define PROBE_REPS 0x111
#endif
#ifndef N_LAUNCH_MODE
#define N_LAUNCH_MODE 1
#endif

namespace pg8 {
#define PG8_LAS __attribute__((address_space(3)))
typedef unsigned short bf16_t;
typedef short bf16x8 __attribute__((ext_vector_type(8)));
typedef float f32x4 __attribute__((ext_vector_type(4)));
typedef unsigned u32x4 __attribute__((ext_vector_type(4)));
constexpr int BM = 256, BK = 64, HALF = 128, HTB = HALF * BK * 2, STAGE_BYTES = 8 * HTB, NXCD = 8, WGM = 8;

__host__ __device__ __forceinline__ int lds_byte(int r, int c) { const int st = (r >> 4) * 2 + (c >> 5), rr = r & 15, cc = c & 31, ob = rr * 64 + cc * 2; return st * 1024 + (ob ^ (((ob >> 9) & 1) << 5)); }
__host__ __device__ __forceinline__ void stage_rc(int b, int& R, int& C) { const int st = b / 1024, sb = b % 1024, swz = sb ^ (((sb >> 9) & 1) << 5); R = (st >> 1) * 16 + swz / 64; C = (st & 1) * 32 + (swz % 64) / 2; }
__host__ __device__ __forceinline__ int perm32(int rho) { const int n = rho >> 4, i = rho & 15; return 8 * (i >> 2) + 4 * n + (i & 3); }

struct Unit { int pm, pn, aux; size_t aoff, boff; };
struct Gemm { const bf16_t* A; const bf16_t* Bt; int lda, ldb, K; };

__device__ __forceinline__ void tile_of(int L, int nM, int nN, int& pm, int& pn) {
    const int nwg = nM * nN; int wgid = L;
    { const int q = nwg / NXCD, r = nwg % NXCD, xcd = wgid % NXCD, off = wgid / NXCD; wgid = (xcd < r ? xcd * (q + 1) : r * (q + 1) + (xcd - r) * q) + off; }
    const int nig = WGM * nN, gid = wgid / nig, fm = gid * WGM, gsz = (nM - fm) < WGM ? (nM - fm) : WGM;
    pm = fm + ((wgid % nig) % gsz); pn = (wgid % nig) / gsz;
}
struct StaticOrder {
    int nM, nN, nwg, G, c, lda, ldb;
    __device__ void init(int M, int N, int G_, int c_, int lda_, int ldb_) { nM = M / BM; nN = N / BM; nwg = nM * nN; G = G_; c = c_; lda = lda_; ldb = ldb_; }
    __device__ bool next(int i, Unit& u) const {
        const long L = (long)i * G + c; if (L >= nwg) return false;
        tile_of((int)L, nM, nN, u.pm, u.pn); u.aux = 0;
        u.aoff = (size_t)u.pm * BM * lda * 2; u.boff = (size_t)u.pn * BM * ldb * 2; return true;
    }
};

__device__ __forceinline__ unsigned cvt_pk_bf16(float lo, float hi) { unsigned r; asm volatile("v_cvt_pk_bf16_f32 %0, %1, %2" : "=v"(r) : "v"(lo), "v"(hi)); return r; }

template <class Epi, class Sched, bool ALIGN_EPI = true, bool SP2 = true>
__device__ __forceinline__ void gemm_phase(PG8_LAS unsigned char* lds, const Gemm g, const Sched& S, const Epi& E) {
    int tid_ = threadIdx.x; asm volatile("" : "+v"(tid_));
    const int tid = tid_, wid = __builtin_amdgcn_readfirstlane(tid >> 6), lane = tid & 63, wr = wid >> 2, wc = wid & 3, fr = lane & 15, fq = lane >> 4;
    const int K = g.K, nt = K / BK;
    unsigned voffA[2], voffB[2];
#pragma unroll
    for (int i = 0; i < 2; ++i) { int R, C; stage_rc(tid * 16 + i * 8192, R, C); const int Rb = Epi::PERM ? ((R & ~31) + perm32(R & 31)) : R;
        voffA[i] = (unsigned)(R * g.lda + C) * 2u; voffB[i] = (unsigned)(Rb * g.ldb + C) * 2u; }
    const size_t kstep = (size_t)(BK * 2);
    const size_t hstepA = (size_t)HALF * g.lda * 2, hstepB = (size_t)HALF * g.ldb * 2;
    const unsigned ldsw = (unsigned)wid * 1024u;
    const int aoff = lds_byte(wr * 64 + fr, fq * 8), boff = lds_byte(wc * 32 + fr, fq * 8);
#define PG8_SA(b, h) (((b) * 2 + (h)) * HTB)
#define PG8_SB(b, h) ((4 + (b) * 2 + (h)) * HTB)
#define PG8_STAGE(bufoff, gbase, voff) do { _Pragma("unroll") for (int _i = 0; _i < 2; ++_i) \
        __builtin_amdgcn_global_load_lds((const unsigned*)((const char*)(gbase) + (voff)[_i]), (PG8_LAS unsigned*)(lds + (bufoff) + ldsw + _i * 8192), 16, 0, 0); } while (0)
#define PG8_LDA(dst, b, h) do { _Pragma("unroll") for (int m = 0; m < 4; ++m) _Pragma("unroll") for (int k = 0; k < 2; ++k) dst[m][k] = *(const PG8_LAS bf16x8*)(lds + PG8_SA(b, h) + aoff + m * 2048 + k * 1024); } while (0)
#define PG8_LDB(dst, b, h) do { _Pragma("unroll") for (int n = 0; n < 2; ++n) _Pragma("unroll") for (int k = 0; k < 2; ++k) dst[n][k] = *(const PG8_LAS bf16x8*)(lds + PG8_SB(b, h) + boff + n * 2048 + k * 1024); } while (0)
#define PG8_MMA(ai, bj, At, Bt) do { __builtin_amdgcn_s_setprio(1); _Pragma("unroll") for (int m = 0; m < 4; ++m) _Pragma("unroll") for (int n = 0; n < 2; ++n) _Pragma("unroll") for (int k = 0; k < 2; ++k) \
        acc[ai][bj][m][n] = __builtin_amdgcn_mfma_f32_16x16x32_bf16(Bt[n][k], At[m][k], acc[ai][bj][m][n], 0, 0, 0); __builtin_amdgcn_s_setprio(0); } while (0)
#define PG8_WAIT_V(n) asm volatile("s_waitcnt vmcnt(" #n ")" ::: "memory")
#define PG8_WAIT_L(n) asm volatile("s_waitcnt lgkmcnt(" #n ")" ::: "memory")
#define PG8_BAR __builtin_amdgcn_s_barrier()
#define PG8_SCHED __builtin_amdgcn_sched_barrier(0)
    Unit cur, nxt; int ui = 0;
    if (!S.next(0, cur)) return;
    f32x4 acc[2][2][4][2];
#pragma unroll
    for (int a = 0; a < 2; ++a)
#pragma unroll
        for (int b = 0; b < 2; ++b)
#pragma unroll
            for (int m = 0; m < 4; ++m)
#pragma unroll
                for (int n = 0; n < 2; ++n) acc[a][b][m][n] = (f32x4){0.f, 0.f, 0.f, 0.f};
    bf16x8 At[4][2], B0[2][2], B1[2][2];
    const char* cA = (const char*)g.A + cur.aoff; const char* cB = (const char*)g.Bt + cur.boff;
    if constexpr (SP2) {
        PG8_STAGE(PG8_SB(0, 0), cB, voffB); PG8_STAGE(PG8_SB(0, 1), cB + hstepB, voffB); PG8_STAGE(PG8_SA(0, 0), cA, voffA); PG8_STAGE(PG8_SA(0, 1), cA + hstepA, voffA);
        if (wr == 1) PG8_BAR;
        PG8_WAIT_V(2); PG8_BAR;
        PG8_STAGE(PG8_SB(1, 0), cB + kstep, voffB); PG8_STAGE(PG8_SA(1, 0), cA + kstep, voffA); PG8_STAGE(PG8_SB(1, 1), cB + hstepB + kstep, voffB);
        PG8_WAIT_V(6); PG8_BAR;
    } else {
        PG8_STAGE(PG8_SB(0, 0), cB, voffB); PG8_STAGE(PG8_SA(0, 0), cA, voffA); PG8_STAGE(PG8_SB(0, 1), cB + hstepB, voffB); PG8_STAGE(PG8_SA(0, 1), cA + hstepA, voffA);
        if (wr == 1) PG8_BAR;
        PG8_WAIT_V(4); PG8_BAR;
        PG8_STAGE(PG8_SB(1, 0), cB + kstep, voffB); PG8_STAGE(PG8_SA(1, 0), cA + kstep, voffA); PG8_STAGE(PG8_SB(1, 1), cB + hstepB + kstep, voffB);
        PG8_WAIT_V(6); PG8_BAR;
    }
    for (;;) {
        const bool has_next = S.next(ui + 1, nxt);
        const char* nA = has_next ? (const char*)g.A + nxt.aoff : cA; const char* nB = has_next ? (const char*)g.Bt + nxt.boff : cB;
        for (int t = 0; t < nt; t += 2) {
            const bool last = (t == nt - 2);
            const char* a1 = cA + (size_t)(t + 1) * kstep;
            const char* a2 = last ? nA : cA + (size_t)(t + 2) * kstep; const char* b2 = last ? nB : cB + (size_t)(t + 2) * kstep;
            const char* a3 = a2 + kstep; const char* b3 = b2 + kstep;
            if constexpr (SP2) {
            PG8_LDB(B0, 0, 0); PG8_LDB(B1, 0, 1); PG8_SCHED; PG8_LDA(At, 0, 0); PG8_STAGE(PG8_SA(1, 1), a1 + hstepA, voffA);
            PG8_WAIT_V(8); PG8_WAIT_L(0); PG8_BAR; PG8_MMA(0, 0, At, B0); PG8_MMA(0, 1, At, B1); PG8_BAR; PG8_SCHED;
            PG8_LDA(At, 0, 1); PG8_STAGE(PG8_SB(0, 0), b2, voffB); PG8_STAGE(PG8_SB(0, 1), b2 + hstepB, voffB); PG8_STAGE(PG8_SA(0, 0), a2, voffA);
            PG8_WAIT_V(8); PG8_WAIT_L(0); PG8_BAR; PG8_MMA(1, 0, At, B0); PG8_MMA(1, 1, At, B1); PG8_BAR; PG8_SCHED;
            PG8_LDB(B0, 1, 0); PG8_LDB(B1, 1, 1); PG8_SCHED; PG8_LDA(At, 1, 0); PG8_STAGE(PG8_SA(0, 1), a2 + hstepA, voffA);
            PG8_WAIT_V(8); PG8_WAIT_L(0); PG8_BAR; PG8_MMA(0, 0, At, B0); PG8_MMA(0, 1, At, B1); PG8_BAR; PG8_SCHED;
            PG8_LDA(At, 1, 1); PG8_STAGE(PG8_SB(1, 0), b3, voffB); PG8_STAGE(PG8_SB(1, 1), b3 + hstepB, voffB); PG8_STAGE(PG8_SA(1, 0), a3, voffA);
            PG8_WAIT_V(8); PG8_WAIT_L(0); PG8_BAR; PG8_MMA(1, 0, At, B0); PG8_MMA(1, 1, At, B1); PG8_BAR; PG8_SCHED;
            } else {
            PG8_LDB(B0, 0, 0); PG8_SCHED; PG8_LDA(At, 0, 0); PG8_STAGE(PG8_SA(1, 1), a1 + hstepA, voffA);
            PG8_WAIT_L(8); PG8_BAR; PG8_WAIT_L(0); PG8_MMA(0, 0, At, B0); PG8_BAR; PG8_SCHED;
            PG8_LDB(B1, 0, 1); PG8_STAGE(PG8_SB(0, 0), b2, voffB);
            PG8_BAR; PG8_WAIT_L(0); PG8_MMA(0, 1, At, B1); PG8_BAR;
            PG8_LDA(At, 0, 1); PG8_STAGE(PG8_SA(0, 0), a2, voffA);
            PG8_BAR; PG8_WAIT_L(0); PG8_MMA(1, 0, At, B0); PG8_BAR; PG8_SCHED;
            PG8_STAGE(PG8_SB(0, 1), b2 + hstepB, voffB);
            PG8_WAIT_V(6); PG8_BAR; PG8_MMA(1, 1, At, B1); PG8_BAR;
            PG8_LDB(B0, 1, 0); PG8_SCHED; PG8_LDA(At, 1, 0); PG8_STAGE(PG8_SA(0, 1), a2 + hstepA, voffA);
            PG8_WAIT_L(8); PG8_BAR; PG8_WAIT_L(0); PG8_MMA(0, 0, At, B0); PG8_BAR; PG8_SCHED;
            PG8_LDB(B1, 1, 1); PG8_STAGE(PG8_SB(1, 0), b3, voffB);
            PG8_BAR; PG8_WAIT_L(0); PG8_MMA(0, 1, At, B1); PG8_BAR;
            PG8_LDA(At, 1, 1); PG8_STAGE(PG8_SA(1, 0), a3, voffA);
            PG8_BAR; PG8_WAIT_L(0); PG8_MMA(1, 0, At, B0); PG8_BAR; PG8_SCHED;
            PG8_STAGE(PG8_SB(1, 1), b3 + hstepB, voffB);
            PG8_WAIT_V(6); PG8_BAR; PG8_MMA(1, 1, At, B1); PG8_BAR;
            }
        }
        if constexpr (ALIGN_EPI) { if (wr == 0) PG8_BAR; }
        E(acc, cur, wr, wc, fr, fq);
        if (!has_next) break;
#pragma unroll
        for (int a = 0; a < 2; ++a)
#pragma unroll
            for (int b = 0; b < 2; ++b)
#pragma unroll
                for (int m = 0; m < 4; ++m)
#pragma unroll
                    for (int n = 0; n < 2; ++n) acc[a][b][m][n] = (f32x4){0.f, 0.f, 0.f, 0.f};
        cur = nxt; cA = nA; cB = nB; ++ui;
        if constexpr (ALIGN_EPI) { if (wr == 1) PG8_BAR; }
    }
    PG8_WAIT_V(0);
    if constexpr (!ALIGN_EPI) { if (wr == 0) PG8_BAR; }
    PG8_BAR;
#undef PG8_SA
#undef PG8_SB
#undef PG8_STAGE
#undef PG8_LDA
#undef PG8_LDB
#undef PG8_MMA
#undef PG8_WAIT_V
#undef PG8_WAIT_L
#undef PG8_BAR
#undef PG8_SCHED
}
}

#define LAS __attribute__((address_space(3)))
typedef unsigned short bf16;
typedef float f32x4 __attribute__((ext_vector_type(4)));
typedef unsigned u32x4 __attribute__((ext_vector_type(4)));
typedef unsigned u32x2 __attribute__((ext_vector_type(2)));

constexpr int NB = 8, T = 4096, D = 1024, M = NB * T, NL = 2;
constexpr int INW = 9160;
constexpr int PP = 5120;
constexpr int C_AQ = 0, C_AK = 768, C_AV = 1536, C_BQ = 2304, C_BK = 2560, C_BV = 2816, C_IQ = 3072, C_IK = 3328, C_C = 3392, C_DZ = 4288, C_DX = 4544, C_IW = 5056, C_DT = 5060, C_END = 5064;
constexpr int NEXP = 32, DEXP = 512;
constexpr int CAP = 73728;
constexpr float LN_EPS = 1e-5f;
constexpr float ALPHA = 1.4142135623730951f;

constexpr size_t MiB = 1u << 20;
constexpr size_t WS_CTL = 0, CTL_BYTES = 1 * MiB;
constexpr size_t WS_WINT = 2 * MiB;
constexpr size_t WS_WGT = 22 * MiB;
constexpr size_t WS_WBRT = 38 * MiB;
constexpr size_t WS_WOUTT = 42 * MiB;
constexpr size_t WS_WRT = 46 * MiB;
constexpr size_t WS_ROUTE = 47 * MiB;
constexpr size_t WS_XB = 48 * MiB;
constexpr size_t WS_O = 112 * MiB;
constexpr size_t WS_VF = 176 * MiB;
constexpr size_t WS_P = 192 * MiB;
constexpr size_t WS_GS = 192 * MiB;
constexpr size_t WS_MERGED = 448 * MiB;
constexpr size_t WS_XS = 192 * MiB;
constexpr size_t WS_H = 336 * MiB;
constexpr size_t WS_WGU = 408 * MiB;
constexpr size_t WS_WD = 472 * MiB;
constexpr size_t WS_RW = 512 * MiB;
constexpr size_t WS_END = 544 * MiB;
constexpr int CW_CNT = 64, CW_BAR = 4096;

constexpr int RING_BYTES = 131072, MISC_OFF = RING_BYTES, LDS_BYTES = 147456;
constexpr int NWAVES = 8, NTHR = 512;

__device__ __forceinline__ float bf2f(bf16 v) { return __uint_as_float(((unsigned)v) << 16); }
__device__ __forceinline__ unsigned f2bf(float f) { unsigned u = __float_as_uint(f); return (u + 0x7fffu + ((u >> 16) & 1u)) >> 16; }
__device__ __forceinline__ unsigned pk2(float lo, float hi) { return f2bf(lo) | (f2bf(hi) << 16); }
__device__ __forceinline__ float wave_sum(float v) {
#pragma unroll
    for (int o = 1; o < 64; o <<= 1) v += __shfl_xor(v, o);
    return v;
}
__device__ __forceinline__ float wave_max(float v) {
#pragma unroll
    for (int o = 1; o < 64; o <<= 1) v = fmaxf(v, __shfl_xor(v, o));
    return v;
}
__device__ __forceinline__ float sigmoidf_(float x) { return 1.f / (1.f + __expf(-x)); }
__device__ __forceinline__ float softplusf_(float x) { return x > 20.f ? x : log1pf(__expf(x)); }
__device__ __forceinline__ float siluf_(float x) { return x / (1.f + __expf(-x)); }

struct Args { const float* in[35]; float* out; unsigned char* ws; int ph_lo, ph_hi; };
enum { I_X = 0, I_WIN, I_CMU, I_CW0, I_CW2, I_CA0, I_CA2, I_CG2, I_CKK, I_CKA, I_CRK, I_CGNW, I_CGNB, I_CV0, I_CV1, I_CV2, I_DCW, I_DCB, I_DDTB, I_DALOG, I_DSKIP, I_DNW,
       I_WBR, I_WOUT, I_LN1G, I_LN1B, I_RG, I_RGB, I_RE, I_REB, I_EG, I_EU, I_ED, I_LN2G, I_LN2B };

__device__ __forceinline__ void transpose_item(const float* W, int ldn, int c0, int ncols, bf16* dst, int dld, int r0, int dk0, int kb, int nb, LAS float* scr, int lane) {
    const int k0 = 64 * kb, n0 = 32 * nb;
    const bool okn = (n0 + (lane & 31)) < ncols;
#pragma unroll 8
    for (int i = 0; i < 32; ++i) { const int kk = 2 * i + (lane >> 5); scr[kk * 33 + (lane & 31)] = okn ? W[(size_t)(k0 + kk) * ldn + c0 + n0 + (lane & 31)] : 0.f; }
    asm volatile("s_waitcnt lgkmcnt(0)" ::: "memory");
    const int c = lane & 7;
#pragma unroll
    for (int j = 0; j < 4; ++j) { const int n = (lane >> 3) + 8 * j; const LAS float* s = scr + (8 * c) * 33 + n;
        u32x4 o; o.x = pk2(s[0 * 33], s[1 * 33]); o.y = pk2(s[2 * 33], s[3 * 33]); o.z = pk2(s[4 * 33], s[5 * 33]); o.w = pk2(s[6 * 33], s[7 * 33]);
        if (n0 + n < ncols) *(u32x4*)(dst + (size_t)(r0 + n0 + n) * dld + dk0 + k0 + 8 * c) = o; }
    asm volatile("s_waitcnt lgkmcnt(0)" ::: "memory");
}

struct EpiStoreBf16 {
    static constexpr bool PERM = true;
    bf16* O; int ldc; int act; int ncols;
    __device__ __forceinline__ void operator()(const pg8::f32x4 (&acc)[2][2][4][2], const pg8::Unit& u, int wr, int wc, int fr, int fq) const {
        const int row0 = u.pm * 256 + wr * 64 + fr; const int col0 = u.pn * 256 + wc * 32 + 8 * fq;
#pragma unroll
        for (int ai = 0; ai < 2; ++ai)
#pragma unroll
            for (int m = 0; m < 4; ++m) { bf16* rowp = O + (size_t)(row0 + ai * 128 + m * 16) * ldc + col0;
#pragma unroll
                for (int bj = 0; bj < 2; ++bj) { pg8::f32x4 v0 = acc[ai][bj][m][0], v1 = acc[ai][bj][m][1];
                    if (act == 1) {
#pragma unroll
                        for (int j = 0; j < 4; ++j) { v0[j] = sigmoidf_(v0[j]); v1[j] = sigmoidf_(v1[j]); } }
                    u32x4 w; w.x = pg8::cvt_pk_bf16(v0[0], v0[1]); w.y = pg8::cvt_pk_bf16(v0[2], v0[3]); w.z = pg8::cvt_pk_bf16(v1[0], v1[1]); w.w = pg8::cvt_pk_bf16(v1[2], v1[3]);
                    if (col0 + bj * 128 < ncols) *(u32x4*)(rowp + bj * 128) = w; } }
    }
};
struct EpiBranch {
    static constexpr bool PERM = true;
    const bf16* GS; bf16* MG;
    __device__ __forceinline__ void operator()(const pg8::f32x4 (&acc)[2][2][4][2], const pg8::Unit& u, int wr, int wc, int fr, int fq) const {
        const int n = u.aux;
        const bf16* gbase = GS + (size_t)(u.pm * 256 + wr * 64 + fr) * 4096 + n * 1024 + u.pn * 256 + wc * 32 + 8 * fq;
        bf16* mbase = MG + (size_t)(u.pm * 256 + wr * 64 + fr) * 1024 + u.pn * 256 + wc * 32 + 8 * fq;
#pragma unroll
        for (int ai = 0; ai < 2; ++ai)
#pragma unroll
            for (int m = 0; m < 4; ++m) {
#pragma unroll
                for (int bj = 0; bj < 2; ++bj) {
                    const u32x4 gv = *(const u32x4*)(gbase + (size_t)(ai * 128 + m * 16) * 4096 + bj * 128);
                    bf16* mp = mbase + (size_t)(ai * 128 + m * 16) * 1024 + bj * 128;
                    u32x4 ov = (u32x4){0u, 0u, 0u, 0u}; if (n != 0) ov = *(const u32x4*)mp;
                    const pg8::f32x4 a0 = acc[ai][bj][m][0], a1 = acc[ai][bj][m][1];
                    u32x4 w;
                    w.x = pg8::cvt_pk_bf16(a0[0] * __uint_as_float(gv.x << 16) + __uint_as_float(ov.x << 16), a0[1] * __uint_as_float(gv.x & 0xffff0000u) + __uint_as_float(ov.x & 0xffff0000u));
                    w.y = pg8::cvt_pk_bf16(a0[2] * __uint_as_float(gv.y << 16) + __uint_as_float(ov.y << 16), a0[3] * __uint_as_float(gv.y & 0xffff0000u) + __uint_as_float(ov.y & 0xffff0000u));
                    w.z = pg8::cvt_pk_bf16(a1[0] * __uint_as_float(gv.z << 16) + __uint_as_float(ov.z << 16), a1[1] * __uint_as_float(gv.z & 0xffff0000u) + __uint_as_float(ov.z & 0xffff0000u));
                    w.w = pg8::cvt_pk_bf16(a1[2] * __uint_as_float(gv.w << 16) + __uint_as_float(ov.w << 16), a1[3] * __uint_as_float(gv.w & 0xffff0000u) + __uint_as_float(ov.w & 0xffff0000u));
                    *(u32x4*)mp = w; asm volatile("" ::: "memory"); } }
    }
};
struct EpiResid {
    static constexpr bool PERM = false;
    float* X;
    __device__ __forceinline__ void operator()(const pg8::f32x4 (&acc)[2][2][4][2], const pg8::Unit& u, int wr, int wc, int fr, int fq) const {
        const int row0 = u.pm * 256 + wr * 64 + fr, col0 = u.pn * 256 + wc * 32 + 4 * fq;
#pragma unroll
        for (int ai = 0; ai < 2; ++ai)
#pragma unroll
            for (int m = 0; m < 4; ++m) { float* rowp = X + (size_t)(row0 + ai * 128 + m * 16) * D + col0;
#pragma unroll
                for (int bj = 0; bj < 2; ++bj)
#pragma unroll
                    for (int n = 0; n < 2; ++n) { pg8::f32x4* p = (pg8::f32x4*)(rowp + bj * 128 + n * 16); *p = *p * ALPHA + acc[ai][bj][m][n]; } }
    }
};
struct EpiSwiglu {
    static constexpr bool PERM = true;
    bf16* H;
    __device__ __forceinline__ void operator()(const pg8::f32x4 (&acc)[2][2][4][2], const pg8::Unit& u, int wr, int wc, int fr, int fq) const {
        const int row0 = u.pm * 256 + wr * 64 + fr; const int col0 = u.pn * 128 + wc * 32 + 8 * fq;
#pragma unroll
        for (int ai = 0; ai < 2; ++ai)
#pragma unroll
            for (int m = 0; m < 4; ++m) { bf16* rowp = H + (size_t)(row0 + ai * 128 + m * 16) * DEXP + col0;
                float v[8];
#pragma unroll
                for (int j = 0; j < 4; ++j) { v[j] = siluf_(acc[ai][0][m][0][j]) * acc[ai][1][m][0][j]; v[4 + j] = siluf_(acc[ai][0][m][1][j]) * acc[ai][1][m][1][j]; }
                u32x4 w; w.x = pg8::cvt_pk_bf16(v[0], v[1]); w.y = pg8::cvt_pk_bf16(v[2], v[3]); w.z = pg8::cvt_pk_bf16(v[4], v[5]); w.w = pg8::cvt_pk_bf16(v[6], v[7]);
                *(u32x4*)rowp = w; }
    }
};

struct BranchOrder {
    int nM, nN, G, c;
    __device__ bool next(int i, pg8::Unit& u) const {
        const int tl = (i >> 2) * G + c; if (tl >= nM * nN) return false;
        pg8::tile_of(tl, nM, nN, u.pm, u.pn); u.aux = i & 3;
        u.aoff = ((size_t)u.pm * 256 * 1024 + (size_t)u.aux * 256) * 2; u.boff = ((size_t)u.pn * 256 * 1024 + (size_t)u.aux * 256) * 2; return true;
    }
};
struct MoeOrder {
    const volatile LAS int* tb; int G, c; size_t a_rowbytes, b_expbytes, b_tilebytes;
    __device__ bool next(int i, pg8::Unit& u) const {
        const int L = i * G + c; const int total = __builtin_amdgcn_readfirstlane(tb[32]) * 4; if (L >= total) return false;
        int e = 0;
#pragma unroll 1
        for (int k = 0; k < 32; ++k) if (L >= tb[k + 1] * 4) e = k + 1;
        const int nte = tb[e + 1] - tb[e]; const int r = L - tb[e] * 4; const int ct = r / nte, rt = r % nte;
        u.pm = __builtin_amdgcn_readfirstlane(tb[33 + e] + rt); u.pn = __builtin_amdgcn_readfirstlane(ct); u.aux = __builtin_amdgcn_readfirstlane(e);
        u.aoff = (size_t)u.pm * 256 * a_rowbytes; u.boff = (size_t)u.aux * b_expbytes + (size_t)u.pn * b_tilebytes; return true;
    }
};

constexpr int PTR_OFF = LDS_BYTES - 512;
__device__ __forceinline__ void ptr_table_fill(const Args& args, LAS unsigned char* lds) {
    if (threadIdx.x == 0) {
        volatile LAS unsigned long long* t = (volatile LAS unsigned long long*)(lds + PTR_OFF);
#define PT_(i) t[i] = (unsigned long long)args.in[i];
        PT_(0) PT_(1) PT_(2) PT_(3) PT_(4) PT_(5) PT_(6) PT_(7) PT_(8) PT_(9) PT_(10) PT_(11) PT_(12) PT_(13) PT_(14) PT_(15) PT_(16) PT_(17) PT_(18) PT_(19)
        PT_(20) PT_(21) PT_(22) PT_(23) PT_(24) PT_(25) PT_(26) PT_(27) PT_(28) PT_(29) PT_(30) PT_(31) PT_(32) PT_(33) PT_(34)
#undef PT_
        t[35] = (unsigned long long)args.out; t[36] = (unsigned long long)args.ws; t[37] = 0ull;
    }
    __syncthreads();
}
__device__ __forceinline__ unsigned long long ldptr(LAS unsigned char* lds, int i) {
    unsigned a = (unsigned)(PTR_OFF + 8 * i); asm volatile("" : "+v"(a));
    const volatile LAS unsigned* t = (const volatile LAS unsigned*)(lds + a);
    const unsigned lo = __builtin_amdgcn_readfirstlane(t[0]), hi = __builtin_amdgcn_readfirstlane(t[1]);
    return ((unsigned long long)hi << 32) | lo;
}
#define INP(i) ((const float*)ldptr(lds, (i)))
namespace rw {
typedef short bf16x8 __attribute__((ext_vector_type(8)));
typedef float f4 __attribute__((ext_vector_type(4)));
constexpr int LS = 72;
constexpr int MB = 64 * LS * 2;
constexpr int O_AHN = 0, O_RHN = MB, O_BCN = 2 * MB, O_KCN = 3 * MB, O_AHT = 4 * MB, O_BTT = 5 * MB, O_KTT = 6 * MB, O_VT = 7 * MB, O_STT = 8 * MB,
              O_MAK = 9 * MB, O_MRB = 10 * MB, O_MRK = 11 * MB, O_TINV = 12 * MB, O_MABF = 13 * MB, O_GAM = 13 * MB + 16384, O_CT = O_GAM + 256, O_BON = O_CT + 4608, O_END = O_BON + 256;
constexpr int O_MVT = O_BCN, O_A2N = O_AHN, O_UT = O_KCN, O_YF = O_AHT;
constexpr int O_TAB = O_MAK, O_SCR = O_TAB + 26624, O_TOT = O_SCR + 8 * 1024, O_CUM = O_TOT + 2048;
static_assert(O_CUM + 16384 <= O_GAM && O_END <= LDS_BYTES - 576, "rwkv LDS map");

__device__ __forceinline__ bf16x8 ldfrag(const LAS unsigned char* lds, int off, int r0, int ks, int lane) {
    return *(const LAS bf16x8*)(lds + off + ((r0 + (lane & 15)) * LS + ks * 32 + (lane >> 4) * 8) * 2);
}
__device__ __forceinline__ void mm64(f4 (&acc)[2], const LAS unsigned char* lds, int offA, int offBt, int w, int lane) {
    const int tr = w >> 1; const bf16x8 a0 = ldfrag(lds, offA, tr * 16, 0, lane), a1 = ldfrag(lds, offA, tr * 16, 1, lane);
#pragma unroll
    for (int c = 0; c < 2; ++c) { const int tc = (w & 1) * 2 + c; const bf16x8 b0 = ldfrag(lds, offBt, tc * 16, 0, lane), b1 = ldfrag(lds, offBt, tc * 16, 1, lane);
        acc[c] = __builtin_amdgcn_mfma_f32_16x16x32_bf16(a0, b0, acc[c], 0, 0, 0); acc[c] = __builtin_amdgcn_mfma_f32_16x16x32_bf16(a1, b1, acc[c], 0, 0, 0); }
}
__device__ __forceinline__ void storeT(LAS unsigned char* lds, int off, const f4 (&acc)[2], int w, int lane) {
#pragma unroll
    for (int c = 0; c < 2; ++c) { const int col = ((w & 1) * 2 + c) * 16 + (lane & 15), row = (w >> 1) * 16 + 4 * (lane >> 4);
        u32x2 v; v.x = pk2(acc[c][0], acc[c][1]); v.y = pk2(acc[c][2], acc[c][3]); *(LAS u32x2*)(lds + off + (col * LS + row) * 2) = v; }
}
template <int MASK  >
__device__ __forceinline__ void storeN(LAS unsigned char* lds, int off, const f4 (&acc)[2], int w, int lane) {
#pragma unroll
    for (int c = 0; c < 2; ++c) { const int col = ((w & 1) * 2 + c) * 16 + (lane & 15), row = (w >> 1) * 16 + 4 * (lane >> 4);
#pragma unroll
        for (int e = 0; e < 4; ++e) { float x = acc[c][e]; if (MASK == 1) x = (col < row + e) ? x : 0.f; if (MASK == 2) x = (col <= row + e) ? x : 0.f;
            *(LAS bf16*)(lds + off + ((row + e) * LS + col) * 2) = (bf16)f2bf(x); } }
}
#define RW_ZERO(a) do { a[0] = (f4){0.f, 0.f, 0.f, 0.f}; a[1] = (f4){0.f, 0.f, 0.f, 0.f}; } while (0)

__device__ __forceinline__ void build_ct(LAS unsigned char* lds0, const int l, const int h, const int lane, const int wave) {
    LAS unsigned char* const& lds = lds0; const int c = h * 64 + lane;
    const float* mu = INP(I_CMU) + (size_t)l * 896;
    if (wave == 0) { LAS float* ct = (LAS float*)(lds0 + O_CT);
        ct[0 * 64 + lane] = mu[c]; ct[1 * 64 + lane] = mu[256 + c]; ct[2 * 64 + lane] = mu[512 + c]; ct[3 * 64 + lane] = mu[768 + lane]; ct[4 * 64 + lane] = mu[832 + lane];
        ct[5 * 64 + lane] = INP(I_CW0)[l * 256 + c]; ct[6 * 64 + lane] = INP(I_CA0)[l * 256 + c]; ct[7 * 64 + lane] = INP(I_CKK)[l * 256 + c]; ct[8 * 64 + lane] = INP(I_CKA)[l * 256 + c];
        ct[9 * 64 + lane] = INP(I_CRK)[l * 256 + c]; ct[10 * 64 + lane] = INP(I_CGNW)[l * 256 + c]; ct[11 * 64 + lane] = INP(I_CGNB)[l * 256 + c]; ct[12 * 64 + lane] = l > 0 ? INP(I_CV0)[(l - 1) * 256 + c] : 0.f;
        ct[13 * 64 + lane] = mu[512 + lane]; ct[14 * 64 + lane] = mu[512 + lane + 64]; ct[15 * 64 + lane] = mu[512 + lane + 128]; ct[16 * 64 + lane] = mu[512 + lane + 192]; }
}
template <int MODE>
__device__ __forceinline__ void chunk(LAS unsigned char* lds0, const int l, const int b, const int h, const int t0, unsigned char* gz, const bf16* P, bf16* VF, bf16* OB, const int tid0) {
    const int c = h * 64 + (tid0 & 63);
    {
        unsigned lb_ = 0u; int tid_l = tid0; asm volatile("" : "+v"(lb_), "+v"(tid_l));
        const int tid = tid_l, lane = tid & 63, wave = __builtin_amdgcn_readfirstlane(tid >> 6);
        LAS unsigned char* lds = lds0 + lb_;
        LAS bf16* TAB = (LAS bf16*)(lds + O_TAB);
        LAS float* scr = (LAS float*)(lds + O_SCR + wave * 1024);
        LAS float* CUM = (LAS float*)(lds + O_CUM);
        LAS float* TOT = (LAS float*)(lds + O_TOT);
        LAS float* GAM = (LAS float*)(lds + O_GAM);
        LAS float* MABF = (LAS float*)(lds + O_MABF);
        LAS float* YF = (LAS float*)(lds + O_YF);
        LAS float* BON = (LAS float*)(lds + O_BON);
        const LAS float* CT = (const LAS float*)(lds + O_CT);
#define CTV(k) CT[(k) * 64 + lane]
        { const float* cw2 = INP(I_CW2) + (size_t)l * 32 * 256; const float* ca2 = INP(I_CA2) + (size_t)l * 32 * 256; const float* cg2 = INP(I_CG2) + (size_t)l * 64 * 256;
          float tw[4], ta[4], tg[8];
#pragma unroll
          for (int u = 0; u < 4; ++u) { const int i = tid + u * NTHR; tw[u] = cw2[(i >> 6) * 256 + h * 64 + (i & 63)]; ta[u] = ca2[(i >> 6) * 256 + h * 64 + (i & 63)]; }
#pragma unroll
          for (int u = 0; u < 8; ++u) { const int i = tid + u * NTHR; tg[u] = cg2[(i >> 6) * 256 + h * 64 + (i & 63)]; }
          float t2[2], t1[8];
          if (l > 0) { const float* cv1 = INP(I_CV1) + (size_t)(l - 1) * 256 * 16; const float* cv2 = INP(I_CV2) + (size_t)(l - 1) * 16 * 256;
#pragma unroll
            for (int u = 0; u < 2; ++u) { const int i = tid + u * NTHR; t2[u] = cv2[(i >> 6) * 256 + h * 64 + (i & 63)]; }
#pragma unroll
            for (int u = 0; u < 8; ++u) t1[u] = cv1[tid + u * NTHR]; }
#pragma unroll
          for (int u = 0; u < 4; ++u) { TAB[tid + u * NTHR] = (bf16)f2bf(tw[u]); TAB[2048 + tid + u * NTHR] = (bf16)f2bf(ta[u]); }
#pragma unroll
          for (int u = 0; u < 8; ++u) TAB[4096 + tid + u * NTHR] = (bf16)f2bf(tg[u]);
          if (l > 0) {
#pragma unroll
            for (int u = 0; u < 2; ++u) TAB[8192 + tid + u * NTHR] = (bf16)f2bf(t2[u]);
#pragma unroll
            for (int u = 0; u < 8; ++u) TAB[9216 + tid + u * NTHR] = (bf16)f2bf(t1[u]); } }
        if (MODE == 3) { const u32x4 sv = ((const u32x4*)gz)[tid]; *(LAS u32x4*)(lds + O_STT + ((tid >> 3) * LS + (tid & 7) * 8) * 2) = sv; }
        float Xr[9];
#pragma unroll
        for (int j = 0; j < 9; ++j) { const int t = t0 + wave * 8 - 1 + j; Xr[j] = t >= 0 ? bf2f(P[((size_t)b * T + t) * PP + C_C + 768 + lane]) : 0.f; }
        __syncthreads();
        { float run = 0.f;
#pragma unroll
            for (int q = 0; q < 8; ++q) {
                const float xx = Xr[q + 1] + (Xr[q] - Xr[q + 1]) * CTV(3);
                scr[lane] = tanhf(xx);
                asm volatile("s_waitcnt lgkmcnt(0)" ::: "memory");
                float wsum = CTV(5);
#pragma unroll 8
                for (int mm = 0; mm < 32; ++mm) wsum += scr[mm] * bf2f(TAB[mm * 64 + lane]);
                run += -__expf(-softplusf_(-wsum) - 0.5f); CUM[(wave * 8 + q) * 64 + lane] = run;
                asm volatile("s_waitcnt lgkmcnt(0)" ::: "memory");
            }
            TOT[wave * 64 + lane] = run; }
        __syncthreads();
        float offs = 0.f, cumL = 0.f;
#pragma unroll
        for (int w2 = 0; w2 < 8; ++w2) { const float tw = TOT[w2 * 64 + lane]; offs += (w2 < wave) ? tw : 0.f; cumL += tw; }
        if (wave == 0) GAM[lane] = __expf(cumL);
#define LO_(x) __uint_as_float((x) << 16)
#define HI_(x) __uint_as_float((x) & 0xffff0000u)
#define RAW_LOAD(rk, vx, gg, v4a, v4b, vfv, tok) do { const int t_ = (tok); const bool ok_ = t_ >= 0; const size_t m_ = (size_t)b * T + (ok_ ? t_ : 0); const bf16* row_ = P + m_ * PP + C_C; \
            rk = ok_ ? ((unsigned)row_[c] | ((unsigned)row_[256 + c] << 16)) : 0u; vx = ok_ ? ((unsigned)row_[512 + c] | ((unsigned)row_[768 + lane] << 16)) : 0u; gg = ok_ ? (unsigned)row_[832 + lane] : 0u; \
            if (l > 0) { v4a = ok_ ? ((unsigned)row_[512 + lane] | ((unsigned)row_[512 + lane + 64] << 16)) : 0u; v4b = ok_ ? ((unsigned)row_[512 + lane + 128] | ((unsigned)row_[512 + lane + 192] << 16)) : 0u; vfv = (unsigned)VF[m_ * 256 + c]; } } while (0)
        unsigned pRK, pVX, pGG, pVa = 0u, pVb = 0u, pVF = 0u, cRK, cVX, cGG, cVa = 0u, cVb = 0u, cVF = 0u;
        RAW_LOAD(pRK, pVX, pGG, pVa, pVb, pVF, t0 + wave * 8 - 1); RAW_LOAD(cRK, cVX, cGG, cVa, cVb, cVF, t0 + wave * 8);
#pragma unroll 1
        for (int q = 0; q < 8; ++q) {
            const int tt = wave * 8 + q; const size_t m = (size_t)b * T + t0 + tt;
            unsigned nRK, nVX, nGG, nVa = 0u, nVb = 0u, nVF = 0u;
            RAW_LOAD(nRK, nVX, nGG, nVa, nVb, nVF, (q < 7) ? (t0 + tt + 1) : (t0 + tt));
            const float r = LO_(cRK) + (LO_(pRK) - LO_(cRK)) * CTV(0), k = HI_(cRK) + (HI_(pRK) - HI_(cRK)) * CTV(1); float v = LO_(cVX) + (LO_(pVX) - LO_(cVX)) * CTV(2);
            const float xx = HI_(cVX) + (HI_(pVX) - HI_(cVX)) * CTV(3), xg = LO_(cGG) + (LO_(pGG) - LO_(cGG)) * CTV(4);
            scr[lane] = lane < 32 ? tanhf(xx) : xx; scr[64 + lane] = sigmoidf_(xg);
            LAS bf16* vsc = (LAS bf16*)(scr + 128);
            if (l > 0) {
                vsc[lane] = (bf16)f2bf(LO_(cVa) + (LO_(pVa) - LO_(cVa)) * CTV(13)); vsc[lane + 64] = (bf16)f2bf(HI_(cVa) + (HI_(pVa) - HI_(cVa)) * CTV(14));
                vsc[lane + 128] = (bf16)f2bf(LO_(cVb) + (LO_(pVb) - LO_(cVb)) * CTV(15)); vsc[lane + 192] = (bf16)f2bf(HI_(cVb) + (HI_(pVb) - HI_(cVb)) * CTV(16));
            }
            asm volatile("s_waitcnt lgkmcnt(0)" ::: "memory");
            float wsum = CTV(5), asum = CTV(6), gsum = 0.f;
#pragma unroll 8
            for (int mm = 0; mm < 32; ++mm) { wsum += scr[mm] * bf2f(TAB[mm * 64 + lane]); asum += scr[32 + mm] * bf2f(TAB[2048 + mm * 64 + lane]); }
#pragma unroll 8
            for (int mm = 0; mm < 64; ++mm) gsum += scr[64 + mm] * bf2f(TAB[4096 + mm * 64 + lane]);
            if (l > 0) {
                const int qq = lane & 15, part = lane >> 4; float s = 0.f;
#pragma unroll 8
                for (int cc = 0; cc < 64; ++cc) s += bf2f(vsc[part * 64 + cc]) * bf2f(TAB[9216 + (part * 64 + cc) * 16 + qq]);
                s += __shfl_xor(s, 16); s += __shfl_xor(s, 32);
                float vl = CTV(12);
#pragma unroll
                for (int q2 = 0; q2 < 16; ++q2) vl += __shfl(s, q2) * bf2f(TAB[8192 + q2 * 64 + lane]);
                const float vf = LO_(cVF); v = v + (vf - v) * sigmoidf_(vl);
            } else if (MODE == 3) VF[m * 256 + c] = (bf16)f2bf(v);
            const float wlog = -softplusf_(-wsum) - 0.5f, asig = sigmoidf_(asum), lw = -__expf(wlog);
            float kk = k * CTV(7); const float n2 = wave_sum(kk * kk); kk = kk / fmaxf(sqrtf(n2), 1e-12f);
            const float kmod = k * (1.f + (asig - 1.f) * CTV(8));
            const float bon = wave_sum(r * kmod * CTV(9));
            const float cum = offs + CUM[tt * 64 + lane], cumx = cum - lw;
            const float ah = -kk * __expf(cumx), rh = r * __expf(cum), ei = __expf(-cum), bb = kk * asig, bc = bb * ei, kc = kmod * ei, ee = __expf(cumL - cum), bt = bb * ee, kt = kmod * ee;
            const int no = (tt * LS + lane) * 2, to = (lane * LS + tt) * 2;
            *(LAS bf16*)(lds + O_AHN + no) = (bf16)f2bf(ah); *(LAS bf16*)(lds + O_RHN + no) = (bf16)f2bf(rh);
            *(LAS bf16*)(lds + O_BCN + no) = (bf16)f2bf(bc); *(LAS bf16*)(lds + O_KCN + no) = (bf16)f2bf(kc); if (MODE == 3) OB[m * 1024 + 512 + c] = (bf16)f2bf(gsum);
            *(LAS bf16*)(lds + O_AHT + to) = (bf16)f2bf(ah); *(LAS bf16*)(lds + O_BTT + to) = (bf16)f2bf(bt);
            *(LAS bf16*)(lds + O_KTT + to) = (bf16)f2bf(kt); *(LAS bf16*)(lds + O_VT + to) = (bf16)f2bf(v);
            if (MODE == 3 && lane == 0) BON[tt] = bon;
            asm volatile("s_waitcnt lgkmcnt(0)" ::: "memory");
            pRK = cRK; pVX = cVX; pGG = cGG; pVa = cVa; pVb = cVb; cRK = nRK; cVX = nVX; cGG = nGG; cVa = nVa; cVb = nVb; cVF = nVF;
        }
#undef RAW_LOAD
        __syncthreads();
        { f4 acc[2];
            RW_ZERO(acc); mm64(acc, lds, O_AHN, O_BCN, wave, lane);
#pragma unroll
            for (int cI = 0; cI < 2; ++cI) { const int col = ((wave & 1) * 2 + cI) * 16 + (lane & 15), row = (wave >> 1) * 16 + 4 * (lane >> 4);
#pragma unroll
                for (int e = 0; e < 4; ++e) MABF[(row + e) * 64 + col] = (col < row + e) ? acc[cI][e] : 0.f; }
            RW_ZERO(acc); mm64(acc, lds, O_AHN, O_KCN, wave, lane); storeN<1>(lds, O_MAK, acc, wave, lane);
            if (MODE == 3) { f4 accb[2]; RW_ZERO(accb); mm64(accb, lds, O_RHN, O_BCN, wave, lane); f4 accc[2]; RW_ZERO(accc); mm64(accc, lds, O_RHN, O_KCN, wave, lane);
                storeN<2>(lds, O_MRB, accb, wave, lane); storeN<2>(lds, O_MRK, accc, wave, lane); }
        }
        __syncthreads();
        if (wave == 0) {
            float x[64]; x[0] = 0.f;
#pragma unroll
            for (int i = 1; i < 64; ++i) { float s = MABF[i * 64 + lane];
#pragma unroll
                for (int j4 = 0; j4 < (i + 3) / 4; ++j4) { const f4 m4 = *(const LAS f4*)(MABF + i * 64 + j4 * 4);
#pragma unroll
                    for (int e = 0; e < 4; ++e) if (j4 * 4 + e < i && j4 * 4 + e >= 1) s += m4[e] * x[j4 * 4 + e]; }
                x[i] = s; }
#pragma unroll
            for (int i = 0; i < 64; ++i) *(LAS bf16*)(lds + O_TINV + (i * LS + lane) * 2) = (bf16)f2bf(x[i]);
            asm volatile("s_waitcnt lgkmcnt(0)" ::: "memory");
            *(LAS bf16*)(lds + O_TINV + (lane * LS + lane) * 2) = (bf16)0x3F80;
        }
        __syncthreads();
        { f4 acc[2]; RW_ZERO(acc); mm64(acc, lds, O_MAK, O_VT, wave, lane); storeT(lds, O_MVT, acc, wave, lane); }
        __syncthreads();
        if (MODE == 1) {
            { f4 acc[2]; RW_ZERO(acc); mm64(acc, lds, O_TINV, O_AHT, wave, lane); storeT(lds, O_UT, acc, wave, lane); }
            { f4 acc[2]; RW_ZERO(acc); mm64(acc, lds, O_TINV, O_MVT, wave, lane); storeT(lds, O_MAK, acc, wave, lane); }
            __syncthreads();
            { f4 acc[2]; RW_ZERO(acc); mm64(acc, lds, O_BTT, O_UT, wave, lane);
#pragma unroll
              for (int cI = 0; cI < 2; ++cI) { const int col = ((wave & 1) * 2 + cI) * 16 + (lane & 15), row = (wave >> 1) * 16 + 4 * (lane >> 4);
#pragma unroll
                  for (int e = 0; e < 4; ++e) if (col == row + e) acc[cI][e] += GAM[col]; }
              storeN<0>(lds, O_AHN, acc, wave, lane); }
            { f4 acc[2]; RW_ZERO(acc); mm64(acc, lds, O_BTT, O_MAK, wave, lane); mm64(acc, lds, O_KTT, O_VT, wave, lane); storeT(lds, O_RHN, acc, wave, lane); }
            __syncthreads();
            ((u32x4*)gz)[tid] = *(const LAS u32x4*)(lds + O_AHN + ((tid >> 3) * LS + (tid & 7) * 8) * 2);
            ((u32x4*)(gz + 8192))[tid] = *(const LAS u32x4*)(lds + O_RHN + ((tid >> 3) * LS + (tid & 7) * 8) * 2);
        } else {
            { f4 acc[2]; RW_ZERO(acc); mm64(acc, lds, O_TINV, O_AHT, wave, lane); storeN<0>(lds, O_A2N, acc, wave, lane); }
            __syncthreads();
            { f4 acc[2]; RW_ZERO(acc); mm64(acc, lds, O_TINV, O_MVT, wave, lane); mm64(acc, lds, O_A2N, O_STT, wave, lane); storeT(lds, O_UT, acc, wave, lane); }
            __syncthreads();
            f4 yacc[2]; RW_ZERO(yacc);
            mm64(yacc, lds, O_RHN, O_STT, wave, lane); mm64(yacc, lds, O_MRB, O_UT, wave, lane); mm64(yacc, lds, O_MRK, O_VT, wave, lane);
            __syncthreads();
#pragma unroll
            for (int cI = 0; cI < 2; ++cI) { const int col = ((wave & 1) * 2 + cI) * 16 + (lane & 15), row = (wave >> 1) * 16 + 4 * (lane >> 4);
#pragma unroll
                for (int e = 0; e < 4; ++e) YF[(row + e) * 64 + col] = yacc[cI][e]; }
            __syncthreads();
            { unsigned gcur = (unsigned)OB[((size_t)b * T + t0 + wave * 8) * 1024 + 512 + c];
#pragma unroll 1
            for (int q = 0; q < 8; ++q) {
                const int tt = wave * 8 + q; const size_t m = (size_t)b * T + t0 + tt;
                const unsigned gnxt = (unsigned)OB[(m + (q < 7 ? 1 : 0)) * 1024 + 512 + c];
                const float y = YF[tt * 64 + lane]; const float mean = wave_sum(y) * (1.f / 64.f); const float dy = y - mean; const float var = wave_sum(dy * dy) * (1.f / 64.f);
                const float yn = dy * rsqrtf(var + 64e-5f) * CTV(10) + CTV(11);
                const float vv = bf2f(*(const LAS bf16*)(lds + O_VT + (lane * LS + tt) * 2)), gg = LO_(gcur);
                OB[m * 1024 + 512 + c] = (bf16)f2bf((yn + BON[tt] * vv) * gg);
                gcur = gnxt;
            } }
        }
        __syncthreads();
#undef CTV
#undef LO_
#undef HI_
    }
}

__device__ __forceinline__ void carry(LAS unsigned char* lds0, unsigned char* gzc  , const int tid0) {
    f4 stacc[2]; RW_ZERO(stacc);
    { unsigned lb_ = 0u; asm volatile("" : "+v"(lb_)); LAS unsigned char* lds = lds0 + lb_; for (int i = tid0; i < MB / 4; i += NTHR) ((LAS unsigned*)(lds + O_STT))[i] = 0u; }
    u32x4 gnx = ((const u32x4*)gzc)[tid0];
#pragma unroll 1
    for (int cI = 0; cI < T / 64; ++cI) {
        unsigned lb_ = 0u; int tid_l = tid0; asm volatile("" : "+v"(lb_), "+v"(tid_l));
        LAS unsigned char* lds = lds0 + lb_; const int tid = tid_l, lane = tid & 63, wave = __builtin_amdgcn_readfirstlane(tid >> 6);
        unsigned char* rec = gzc + (size_t)cI * 16384;
        const int io = ((tid >> 3) * LS + (tid & 7) * 8) * 2;
        *(LAS u32x4*)(lds + O_AHN + io) = gnx;
        u32x2 zv[2];
#pragma unroll
        for (int k = 0; k < 2; ++k) { const int col = ((wave & 1) * 2 + k) * 16 + (lane & 15), row = (wave >> 1) * 16 + 4 * (lane >> 4); zv[k] = *(const u32x2*)(rec + 8192 + (col * 64 + row) * 2); }
        if (cI + 1 < T / 64) gnx = ((const u32x4*)(rec + 16384))[tid];
        __syncthreads();
        ((u32x4*)rec)[tid] = *(const LAS u32x4*)(lds + O_STT + io);
        f4 acc[2];
#pragma unroll
        for (int k = 0; k < 2; ++k) acc[k] = (f4){__uint_as_float(zv[k].x << 16), __uint_as_float(zv[k].x & 0xffff0000u), __uint_as_float(zv[k].y << 16), __uint_as_float(zv[k].y & 0xffff0000u)};
        mm64(acc, lds, O_AHN, O_STT, wave, lane);
        __syncthreads();
        storeT(lds, O_STT, acc, wave, lane);
    }
}
}

namespace mb {
using rw::LS; using rw::MB; using rw::f4; using rw::mm64; using rw::storeN; using rw::bf16x8;
constexpr int O_CN = 0, O_BN = MB, O_BT = 2 * MB, O_XT0 = 3 * MB, O_XW0 = 5 * MB, O_CS0 = 7 * MB, O_HN0 = 9 * MB, O_SC0 = 11 * MB, O_SM = 13 * MB, O_YF = O_XW0;
static_assert(O_SM + 2048 <= LDS_BYTES - 576, "mamba LDS map");
__device__ __forceinline__ void chain(LAS unsigned char* lds0, const int l, const int b, const int gI, const bf16* P, bf16* OB, const int tid0, const int lane0, const int wave0) {
    const int tid = tid0, lane = lane0, wave = wave0;
    LAS unsigned char* const& lds = lds0;
    const float* cwp = INP(I_DCW) + (size_t)l * 4 * 512; const float* cbp = INP(I_DCB) + (size_t)l * 512;
    const int cc = tid & 255, sub = tid >> 8;
    const int col = cc < 128 ? (gI * 128 + cc) : (cc < 192 ? (256 + gI * 64 + (cc - 128)) : (384 + gI * 64 + (cc - 192)));
    const float cw0 = cwp[col], cw1 = cwp[512 + col], cw2 = cwp[1024 + col], cw3 = cwp[1536 + col], cb = cbp[col];
    f4 hacc[2][2];
#pragma unroll
    for (int hh = 0; hh < 2; ++hh) { hacc[hh][0] = (f4){0.f, 0.f, 0.f, 0.f}; hacc[hh][1] = (f4){0.f, 0.f, 0.f, 0.f}; }
    for (int i = tid; i < 2 * MB / 4; i += NTHR) ((LAS unsigned*)(lds0 + O_HN0))[i] = 0u;
    const float dtb0 = INP(I_DDTB)[l * 4 + gI * 2], dtb1 = INP(I_DDTB)[l * 4 + gI * 2 + 1];
    const float nA0 = -__expf(INP(I_DALOG)[l * 4 + gI * 2]), nA1 = -__expf(INP(I_DALOG)[l * 4 + gI * 2 + 1]);
    const float dsk0 = INP(I_DSKIP)[l * 4 + gI * 2], dsk1 = INP(I_DSKIP)[l * 4 + gI * 2 + 1];
    const float nw0 = INP(I_DNW)[l * 256 + gI * 128 + lane], nw1 = INP(I_DNW)[l * 256 + gI * 128 + 64 + lane];
#pragma unroll 1
    for (int t0 = 0; t0 < T; t0 += 64) {
        unsigned lb_ = 0u; int tid_l = tid0; asm volatile("" : "+v"(lb_), "+v"(tid_l));
        const int tid = tid_l, lane = tid & 63, wave = __builtin_amdgcn_readfirstlane(tid >> 6);
        LAS unsigned char* lds = lds0 + lb_;
        LAS float* SM = (LAS float*)(lds + O_SM);
        LAS float* YF = (LAS float*)(lds + O_YF);
        if (wave < 2) {
            const size_t m = (size_t)b * T + t0 + lane;
            const float dt = softplusf_(bf2f(P[m * PP + C_DT + gI * 2 + wave]) + (wave == 0 ? dtb0 : dtb1));
            float cs = dt * (wave == 0 ? nA0 : nA1);
#pragma unroll
            for (int o = 1; o < 64; o <<= 1) { const float y = __shfl_up(cs, o); if (lane >= o) cs += y; }
            const float cL = __shfl(cs, 63);
            SM[wave * 64 + lane] = dt; SM[128 + wave * 64 + lane] = cs; SM[256 + wave * 64 + lane] = __expf(cL - cs) * dt; SM[384 + wave * 64 + lane] = __expf(cs);
        }
        __syncthreads();
        { float h0, h1, h2, cur[8], nxt[8];
          { const int tb = t0 + sub * 32; h0 = tb >= 3 ? bf2f(P[((size_t)b * T + tb - 3) * PP + C_DX + col]) : 0.f; h1 = tb >= 2 ? bf2f(P[((size_t)b * T + tb - 2) * PP + C_DX + col]) : 0.f; h2 = tb >= 1 ? bf2f(P[((size_t)b * T + tb - 1) * PP + C_DX + col]) : 0.f;
#pragma unroll
            for (int j = 0; j < 8; ++j) cur[j] = bf2f(P[((size_t)b * T + tb + j) * PP + C_DX + col]); }
#pragma unroll 1
          for (int g8 = 0; g8 < 4; ++g8) {
            const int tb = t0 + sub * 32 + g8 * 8 + (g8 < 3 ? 8 : 0);
#pragma unroll
            for (int j = 0; j < 8; ++j) nxt[j] = bf2f(P[((size_t)b * T + tb + j) * PP + C_DX + col]);
#pragma unroll
            for (int j = 0; j < 8; ++j) {
                const int tt = sub * 32 + g8 * 8 + j;
                const float a = siluf_(cb + cw3 * cur[j] + cw2 * h2 + cw1 * h1 + cw0 * h0);
                h0 = h1; h1 = h2; h2 = cur[j];
                if (cc < 128) { const int hh = cc >> 6, p = cc & 63;
                    *(LAS bf16*)(lds + O_XT0 + hh * MB + (p * LS + tt) * 2) = (bf16)f2bf(a); *(LAS bf16*)(lds + O_XW0 + hh * MB + (p * LS + tt) * 2) = (bf16)f2bf(a * SM[256 + hh * 64 + tt]); }
                else if (cc < 192) { const int n = cc - 128; *(LAS bf16*)(lds + O_BN + (tt * LS + n) * 2) = (bf16)f2bf(a); *(LAS bf16*)(lds + O_BT + (n * LS + tt) * 2) = (bf16)f2bf(a); }
                else { const int n = cc - 192; *(LAS bf16*)(lds + O_CN + (tt * LS + n) * 2) = (bf16)f2bf(a);
                    *(LAS bf16*)(lds + O_CS0 + (tt * LS + n) * 2) = (bf16)f2bf(a * SM[384 + tt]); *(LAS bf16*)(lds + O_CS0 + MB + (tt * LS + n) * 2) = (bf16)f2bf(a * SM[384 + 64 + tt]); }
            }
#pragma unroll
            for (int j = 0; j < 8; ++j) cur[j] = nxt[j];
          } }
        __syncthreads();
        { f4 acc[2]; acc[0] = (f4){0.f, 0.f, 0.f, 0.f}; acc[1] = (f4){0.f, 0.f, 0.f, 0.f}; mm64(acc, lds, O_CN, O_BN, wave, lane);
#pragma unroll
            for (int hh = 0; hh < 2; ++hh) { f4 sc[2];
#pragma unroll
                for (int cI = 0; cI < 2; ++cI) { const int s = ((wave & 1) * 2 + cI) * 16 + (lane & 15), row = (wave >> 1) * 16 + 4 * (lane >> 4);
                    const float cs = SM[128 + hh * 64 + s], ds = SM[hh * 64 + s];
#pragma unroll
                    for (int e = 0; e < 4; ++e) { const float ct = SM[128 + hh * 64 + row + e]; sc[cI][e] = (s <= row + e) ? acc[cI][e] * __expf(ct - cs) * ds : 0.f; } }
                storeN<0>(lds, O_SC0 + hh * MB, sc, wave, lane); } }
        __syncthreads();
        f4 yacc[2][2];
#pragma unroll
        for (int hh = 0; hh < 2; ++hh) {
            yacc[hh][0] = (f4){0.f, 0.f, 0.f, 0.f}; yacc[hh][1] = (f4){0.f, 0.f, 0.f, 0.f};
            mm64(yacc[hh], lds, O_SC0 + hh * MB, O_XT0 + hh * MB, wave, lane); mm64(yacc[hh], lds, O_CS0 + hh * MB, O_HN0 + hh * MB, wave, lane);
            const float gL = SM[384 + hh * 64 + 63]; hacc[hh][0] = hacc[hh][0] * gL; hacc[hh][1] = hacc[hh][1] * gL;
            mm64(hacc[hh], lds, O_XW0 + hh * MB, O_BT, wave, lane);
        }
        __syncthreads();
#pragma unroll
        for (int hh = 0; hh < 2; ++hh) {
#pragma unroll
            for (int cI = 0; cI < 2; ++cI) { const int colp = ((wave & 1) * 2 + cI) * 16 + (lane & 15), row = (wave >> 1) * 16 + 4 * (lane >> 4);
#pragma unroll
                for (int e = 0; e < 4; ++e) YF[(row + e) * 128 + hh * 64 + colp] = yacc[hh][cI][e]; }
            storeN<0>(lds, O_HN0 + hh * MB, hacc[hh], wave, lane);
        }
        __syncthreads();
#pragma unroll
        for (int q = 0; q < 8; ++q) {
            const int tt = wave * 8 + q; const size_t m = (size_t)b * T + t0 + tt;
            const float x0 = bf2f(*(const LAS bf16*)(lds + O_XT0 + (lane * LS + tt) * 2)), x1 = bf2f(*(const LAS bf16*)(lds + O_XT0 + MB + (lane * LS + tt) * 2));
            const int c0 = gI * 128 + lane, c1 = c0 + 64;
            const float z0 = bf2f(P[m * PP + C_DZ + c0]), z1 = bf2f(P[m * PP + C_DZ + c1]);
            const float y0 = (YF[tt * 128 + lane] + dsk0 * x0) * siluf_(z0), y1 = (YF[tt * 128 + 64 + lane] + dsk1 * x1) * siluf_(z1);
            const float ss = wave_sum(y0 * y0 + y1 * y1); const float rs = rsqrtf(ss * (1.f / 128.f) + 1e-5f);
            OB[m * 1024 + 768 + c0] = (bf16)f2bf(y0 * rs * nw0); OB[m * 1024 + 768 + c1] = (bf16)f2bf(y1 * rs * nw1);
        }
        __syncthreads();
    }
}
}

template <int SP>
__device__ __forceinline__ void phase_body(const int l_in, LAS unsigned char* lds) {
    int tid_ = threadIdx.x, bid_ = blockIdx.x, l_ = l_in, G_ = gridDim.x; asm volatile("" : "+v"(tid_), "+s"(bid_), "+s"(l_), "+s"(G_));
    const int tid = tid_, lane = tid & 63, wave = __builtin_amdgcn_readfirstlane(tid >> 6), l = l_;
    const int G = G_, bid = bid_;
    const int gw = bid * NWAVES + wave, NGW = G * NWAVES;
    unsigned char* ws = (unsigned char*)ldptr(lds, 36);
    int* ctl = (int*)(ws + WS_CTL);
    bf16* XB = (bf16*)(ws + WS_XB); bf16* OB = (bf16*)(ws + WS_O); bf16* VF = (bf16*)(ws + WS_VF); bf16* P = (bf16*)(ws + WS_P);
    bf16* GS = (bf16*)(ws + WS_GS); bf16* MG = (bf16*)(ws + WS_MERGED); bf16* XS = (bf16*)(ws + WS_XS); bf16* HB = (bf16*)(ws + WS_H);
    bf16* WGU = (bf16*)(ws + WS_WGU); bf16* WD = (bf16*)(ws + WS_WD);
    float* X = (float*)ldptr(lds, 35);
    int* tok_e = (int*)(ws + WS_ROUTE); float* tok_g = (float*)(ws + WS_ROUTE + 256 * 1024); int* tok_rank = (int*)(ws + WS_ROUTE + 512 * 1024); int* tok_slot = (int*)(ws + WS_ROUTE + 768 * 1024);
    (void)ctl; (void)XB; (void)OB; (void)VF; (void)P; (void)GS; (void)MG; (void)XS; (void)HB; (void)WGU; (void)WD; (void)X; (void)tok_e; (void)tok_g; (void)tok_rank; (void)tok_slot; (void)gw; (void)NGW; (void)lane;
    {
        bf16* WinT = (bf16*)(ws + WS_WINT) + (size_t)l * 5120 * 1024; bf16* WgT = (bf16*)(ws + WS_WGT) + (size_t)l * 4096 * 1024;
        bf16* WbrT = (bf16*)(ws + WS_WBRT) + (size_t)l * 1024 * 1024; bf16* WoutT = (bf16*)(ws + WS_WOUTT) + (size_t)l * 1024 * 1024;
        float* WrT = (float*)(ws + WS_WRT) + (size_t)l * 36 * 1024;
        int* cnt = ctl + CW_CNT + l * 64;

        if constexpr (SP == -1) {
            LAS float* scr = (LAS float*)(lds + wave * 16384);
#pragma unroll 1
            for (int job = 0; job < NL * 11; ++job) {
                const int ll = job / 11, jk = job % 11;
                if (jk < 5) {
                    const float* W = INP(I_WIN) + (size_t)ll * 1024 * INW;
                    const int sc0 = jk == 0 ? 0 : (jk == 1 ? 3396 : (jk == 2 ? 3392 : (jk == 3 ? 5060 : 5064)));
                    const int snc = jk == 0 ? 3392 : (jk == 1 ? 1664 : (jk == 4 ? 4096 : 4));
                    const int sr0 = jk == 0 ? 0 : (jk == 1 ? 3392 : (jk == 2 ? 5056 : (jk == 3 ? 5060 : 0)));
                    bf16* dst = jk == 4 ? (bf16*)(ws + WS_WGT) + (size_t)ll * 4096 * 1024 : (bf16*)(ws + WS_WINT) + (size_t)ll * 5120 * 1024;
                    const int nbn = (snc + 31) / 32, nit = 16 * nbn;
#pragma unroll 1
                    for (int it = gw; it < nit; it += NGW) transpose_item(W, INW, sc0, snc, dst, 1024, sr0, 0, it / nbn, it % nbn, scr, lane);
                } else if (jk < 9) {
                    const int n = jk - 5; const float* Wb = INP(I_WBR) + ((size_t)ll * 4 + n) * 256 * 1024;
#pragma unroll 1
                    for (int it = gw; it < 4 * 32; it += NGW) transpose_item(Wb, 1024, 0, 1024, (bf16*)(ws + WS_WBRT) + (size_t)ll * 1024 * 1024, 1024, 0, n * 256, it / 32, it % 32, scr, lane);
                } else if (jk == 9) {
                    const float* Wo = INP(I_WOUT) + (size_t)ll * 1024 * 1024;
#pragma unroll 1
                    for (int it = gw; it < 16 * 32; it += NGW) transpose_item(Wo, 1024, 0, 1024, (bf16*)(ws + WS_WOUTT) + (size_t)ll * 1024 * 1024, 1024, 0, 0, it / 32, it % 32, scr, lane);
                } else {
                    bf16* wi = (bf16*)(ws + WS_WINT) + (size_t)ll * 5120 * 1024;
#pragma unroll 1
                    for (int i = gw * 64 + lane; i < 56 * 1024 / 8; i += NGW * 64) ((u32x4*)(wi + (size_t)5064 * 1024))[i] = (u32x4){0u, 0u, 0u, 0u};
                    float* wr = (float*)(ws + WS_WRT) + (size_t)ll * 36 * 1024; const float* rg = INP(I_RG) + (size_t)ll * 1024 * 4; const float* re = INP(I_RE) + (size_t)ll * 1024 * 32;
#pragma unroll 1
                    for (int i = gw * 64 + lane; i < 36 * 1024; i += NGW * 64) { const int o = i / 1024, k = i % 1024; wr[i] = o < 4 ? rg[k * 4 + o] : re[k * 32 + (o - 4)]; }
                }
            }
            for (int m = gw; m < M; m += NGW) {
                const f32x4* xr = (const f32x4*)(INP(I_X) + (size_t)m * D) + lane;
#pragma unroll
                for (int j = 0; j < 4; ++j) { const f32x4 v = xr[64 * j]; ((f32x4*)(X + (size_t)m * D))[lane + 64 * j] = v;
                    u32x2 w; w.x = pk2(v[0], v[1]); w.y = pk2(v[2], v[3]); ((u32x2*)(XB + (size_t)m * D))[lane + 64 * j] = w; }
            }
        }
        else if constexpr (SP == 0) {
            pg8::Gemm g{XB, WinT, 1024, 1024, 1024}; pg8::StaticOrder S; S.init(M, PP, G, bid, 1024, 1024);
            EpiStoreBf16 E{P, PP, 0, PP};
            pg8::gemm_phase<EpiStoreBf16, pg8::StaticOrder>(lds, g, S, E);
        }
        else if constexpr (SP == 1) {
            for (int wv = gw; wv < (M / 64) * 4; wv += NGW) {
                const int h = wv & 3, m = (wv >> 2) * 64 + lane, t = m % T, b = m / T;
                float o[64]; float mx = -INFINITY, den = 0.f;
#pragma unroll
                for (int d = 0; d < 64; ++d) o[d] = 0.f;
                for (int gI = 0; gI < 3; ++gI) {
                    const int dil = gI == 0 ? 1 : (gI == 1 ? 4 : 16);
                    float q[64];
                    { const u32x4* qp = (const u32x4*)(P + (size_t)m * PP + C_AQ + gI * 256 + h * 64);
#pragma unroll
                        for (int c8 = 0; c8 < 8; ++c8) { const u32x4 v = qp[c8]; const unsigned w4[4] = {v.x, v.y, v.z, v.w};
#pragma unroll
                            for (int j = 0; j < 4; ++j) { q[c8 * 8 + 2 * j] = __uint_as_float(w4[j] << 16) * 0.125f; q[c8 * 8 + 2 * j + 1] = __uint_as_float(w4[j] & 0xffff0000u) * 0.125f; } } }
                    for (int j = 0; j <= 128; ++j) {
                        const int pos = t - j * dil; if (pos < 0) break;
                        const bf16* kr = P + (size_t)(b * T + pos) * PP + C_AK + gI * 256 + h * 64;
                        float s = 0.f;
#pragma unroll
                        for (int c8 = 0; c8 < 8; ++c8) { const u32x4 v = ((const u32x4*)kr)[c8]; const unsigned w4[4] = {v.x, v.y, v.z, v.w};
#pragma unroll
                            for (int jj = 0; jj < 4; ++jj) { s += q[c8 * 8 + 2 * jj] * __uint_as_float(w4[jj] << 16); s += q[c8 * 8 + 2 * jj + 1] * __uint_as_float(w4[jj] & 0xffff0000u); } }
                        const float mn = fmaxf(mx, s), corr = __expf(mx - mn), p = __expf(s - mn); mx = mn; den = den * corr + p;
                        const bf16* vr = kr + 768;
#pragma unroll
                        for (int c8 = 0; c8 < 8; ++c8) { const u32x4 v = ((const u32x4*)vr)[c8]; const unsigned w4[4] = {v.x, v.y, v.z, v.w};
#pragma unroll
                            for (int jj = 0; jj < 4; ++jj) { o[c8 * 8 + 2 * jj] = o[c8 * 8 + 2 * jj] * corr + p * __uint_as_float(w4[jj] << 16); o[c8 * 8 + 2 * jj + 1] = o[c8 * 8 + 2 * jj + 1] * corr + p * __uint_as_float(w4[jj] & 0xffff0000u); } }
                    }
                }
                const float inv = 1.f / den; u32x4* op = (u32x4*)(OB + (size_t)m * 1024 + 0 + h * 64);
#pragma unroll
                for (int c8 = 0; c8 < 8; ++c8) { u32x4 w; w.x = pk2(o[c8 * 8] * inv, o[c8 * 8 + 1] * inv); w.y = pk2(o[c8 * 8 + 2] * inv, o[c8 * 8 + 3] * inv); w.z = pk2(o[c8 * 8 + 4] * inv, o[c8 * 8 + 5] * inv); w.w = pk2(o[c8 * 8 + 6] * inv, o[c8 * 8 + 7] * inv); op[c8] = w; }
            }
        }
        else if constexpr (SP == 2) {
            LAS unsigned* sc = (LAS unsigned*)(lds + wave * 16384);
            LAS float* qi = (LAS float*)(lds + 131072 + wave * 1536);
            LAS unsigned short* sel = (LAS unsigned short*)(lds + wave * 16384);
            (void)sel;
            for (int it = 0; it < 16; ++it) {
                const int bb = it >> 1, tblk = (it & 1) ? (511 - (bid & 255)) : (bid & 255);
                if (bid >= 256) break;
                const int t = tblk * 8 + wave, m = bb * T + t;
                const bf16* prow = P + (size_t)m * PP;
                for (int i = lane; i < 256; i += 64) qi[i] = bf2f(prow[C_IQ + i]) * 0.125f;
                float wq[4];
#pragma unroll
                for (int hh = 0; hh < 4; ++hh) wq[hh] = bf2f(prow[C_IW + hh]) * 0.5f;
                asm volatile("s_waitcnt lgkmcnt(0)" ::: "memory");
                const int nblk = (t >> 6) + 1;
                for (int kb = 0; kb < nblk; ++kb) {
                    const int key = kb * 64 + lane; unsigned ok = 0u;
                    if (key <= t) {
                        const u32x4* kr = (const u32x4*)(P + (size_t)(bb * T + key) * PP + C_IK);
                        float lg[4] = {0.f, 0.f, 0.f, 0.f};
#pragma unroll
                        for (int c8 = 0; c8 < 8; ++c8) { const u32x4 v = kr[c8]; const unsigned w4[4] = {v.x, v.y, v.z, v.w};
#pragma unroll
                            for (int jj = 0; jj < 4; ++jj) { const float k0 = __uint_as_float(w4[jj] << 16), k1 = __uint_as_float(w4[jj] & 0xffff0000u);
#pragma unroll
                                for (int hh = 0; hh < 4; ++hh) { lg[hh] += qi[hh * 64 + c8 * 8 + 2 * jj] * k0; lg[hh] += qi[hh * 64 + c8 * 8 + 2 * jj + 1] * k1; } } }
                        float s = 0.f;
#pragma unroll
                        for (int hh = 0; hh < 4; ++hh) s += wq[hh] * fmaxf(lg[hh], 0.f);
                        const unsigned u = __float_as_uint(s); ok = (u & 0x80000000u) ? ~u : (u | 0x80000000u);
                        if (ok == 0u) ok = 1u;
                    }
                    sc[key] = ok;
                }
                asm volatile("s_waitcnt lgkmcnt(0)" ::: "memory");
                unsigned thr = 0u; int need = 1 << 30;
                if (t + 1 > 256) {
                    unsigned prefix = 0u;
                    for (int bit = 31; bit >= 0; --bit) {
                        const unsigned cand = prefix | (1u << bit); int c = 0;
                        for (int kb = 0; kb < nblk; ++kb) c += __popcll(__ballot(sc[kb * 64 + lane] >= cand));
                        if (c >= 256) prefix = cand;
                    }
                    thr = prefix; int cgt = 0;
                    for (int kb = 0; kb < nblk; ++kb) cgt += __popcll(__ballot(sc[kb * 64 + lane] > thr));
                    need = 256 - cgt;
                }
                LAS unsigned short* sl = (LAS unsigned short*)(qi + 256);
                int base = 0, beq = 0;
                const unsigned long long lt = (1ull << lane) - 1ull;
                for (int kb = 0; kb < nblk; ++kb) {
                    const unsigned v = sc[kb * 64 + lane]; const bool valid = v != 0u;
                    const bool eq = valid && v == thr; const unsigned long long beqm = __ballot(eq);
                    const bool take = valid && (v > thr || (eq && (beq + __popcll(beqm & lt)) < need));
                    const unsigned long long bt = __ballot(take);
                    if (take) sl[base + __popcll(bt & lt)] = (unsigned short)(kb * 64 + lane);
                    base += __popcll(bt); beq += __popcll(beqm);
                }
                const int nsel = base;
                for (int i = lane; i < 256; i += 64) qi[i] = bf2f(prow[C_BQ + i]) * 0.125f;
                asm volatile("s_waitcnt lgkmcnt(0)" ::: "memory");
                LAS float* ps = (LAS float*)(lds + wave * 16384);
                float sv[4][4]; float mxh[4] = {-INFINITY, -INFINITY, -INFINITY, -INFINITY};
#pragma unroll
                for (int r = 0; r < 4; ++r) {
                    const int si = r * 64 + lane;
#pragma unroll
                    for (int hh = 0; hh < 4; ++hh) sv[r][hh] = -INFINITY;
                    if (si < nsel) {
                        const int key = sl[si]; const u32x4* kr = (const u32x4*)(P + (size_t)(bb * T + key) * PP + C_BK);
#pragma unroll
                        for (int hh = 0; hh < 4; ++hh) { float s = 0.f;
#pragma unroll
                            for (int c8 = 0; c8 < 8; ++c8) { const u32x4 v = kr[hh * 8 + c8]; const unsigned w4[4] = {v.x, v.y, v.z, v.w};
#pragma unroll
                                for (int jj = 0; jj < 4; ++jj) { s += qi[hh * 64 + c8 * 8 + 2 * jj] * __uint_as_float(w4[jj] << 16); s += qi[hh * 64 + c8 * 8 + 2 * jj + 1] * __uint_as_float(w4[jj] & 0xffff0000u); } }
                            sv[r][hh] = s; mxh[hh] = fmaxf(mxh[hh], s); }
                    }
                }
                float den[4];
#pragma unroll
                for (int hh = 0; hh < 4; ++hh) { mxh[hh] = wave_max(mxh[hh]); float e = 0.f;
#pragma unroll
                    for (int r = 0; r < 4; ++r) { sv[r][hh] = __expf(sv[r][hh] - mxh[hh]); e += sv[r][hh]; }
                    den[hh] = 1.f / wave_sum(e); }
                asm volatile("s_waitcnt lgkmcnt(0)" ::: "memory");
#pragma unroll
                for (int r = 0; r < 4; ++r) { const int si = r * 64 + lane; if (si < nsel) *(LAS f32x4*)(ps + si * 4) = (f32x4){sv[r][0] * den[0], sv[r][1] * den[1], sv[r][2] * den[2], sv[r][3] * den[3]}; }
                asm volatile("s_waitcnt lgkmcnt(0)" ::: "memory");
                float oa[4] = {0.f, 0.f, 0.f, 0.f}; const int hh = lane >> 4;
                for (int si = 0; si < nsel; ++si) {
                    const int key = sl[si]; const float p = ps[si * 4 + hh];
                    const u32x2 v = *(const u32x2*)(P + (size_t)(bb * T + key) * PP + C_BV + lane * 4);
                    oa[0] += p * __uint_as_float(v.x << 16); oa[1] += p * __uint_as_float(v.x & 0xffff0000u); oa[2] += p * __uint_as_float(v.y << 16); oa[3] += p * __uint_as_float(v.y & 0xffff0000u);
                }
                u32x2 w; w.x = pk2(oa[0], oa[1]); w.y = pk2(oa[2], oa[3]);
                *(u32x2*)(OB + (size_t)m * 1024 + 256 + lane * 4) = w;
                asm volatile("s_waitcnt lgkmcnt(0)" ::: "memory");
            }
        }
        else if constexpr (SP == 3) {
            unsigned char* GZ = ws + WS_RW;
            if (bid < 16) {
                mb::chain(lds, l, bid >> 1, bid & 1, P, OB, tid, lane, wave);
            } else {
                const int h = (bid - 16) & 3, k = (bid - 16) >> 2;
                rw::build_ct(lds, l, h, lane, wave); __syncthreads();
#pragma unroll 1
                for (int idx = k; idx < 512; idx += 60) { const int b = idx >> 6, cI = idx & 63;
                    rw::chunk<1>(lds, l, b, h, cI * 64, GZ + ((size_t)((b * 4 + h) * 64 + cI)) * 16384, P, VF, OB, tid); }
            }
        }
        else if constexpr (SP == 12) {
            if (bid < 32) rw::carry(lds, ws + WS_RW + (size_t)bid * 64 * 16384, tid);
        }
        else if constexpr (SP == 13) {
            unsigned char* GZ = ws + WS_RW;
            const int h = bid & 3, k = bid >> 2;
            rw::build_ct(lds, l, h, lane, wave); __syncthreads();
#pragma unroll 1
            for (int idx = k; idx < 512; idx += (G >> 2)) { const int b = idx >> 6, cI = idx & 63;
                rw::chunk<3>(lds, l, b, h, cI * 64, GZ + ((size_t)((b * 4 + h) * 64 + cI)) * 16384, P, VF, OB, tid); }
        }
        else if constexpr (SP == 4) {
            pg8::Gemm g{XB, WgT, 1024, 1024, 1024}; pg8::StaticOrder S; S.init(M, 4096, G, bid, 1024, 1024);
            EpiStoreBf16 E{GS, 4096, 1, 4096};
            pg8::gemm_phase<EpiStoreBf16, pg8::StaticOrder>(lds, g, S, E);
        }
        else if constexpr (SP == 5) {
            pg8::Gemm g{OB, WbrT, 1024, 1024, 256}; BranchOrder S{M / 256, 4, G, bid};
            EpiBranch E{GS, MG};
            pg8::gemm_phase<EpiBranch, BranchOrder>(lds, g, S, E);
        }
        else if constexpr (SP == 6) {
            pg8::Gemm g{MG, WoutT, 1024, 1024, 1024}; pg8::StaticOrder S; S.init(M, 1024, G, bid, 1024, 1024);
            EpiResid E{X};
            pg8::gemm_phase<EpiResid, pg8::StaticOrder>(lds, g, S, E);
        }
        else if constexpr (SP == 7) {
            const float* g1 = INP(I_LN1G) + l * 1024; const float* b1 = INP(I_LN1B) + l * 1024;
            const float* rgb = INP(I_RGB) + l * 4; const float* reb = INP(I_REB) + l * 32;
            for (int m = gw; m < M; m += NGW) {
                f32x4 v[4]; float s = 0.f; f32x4* xr = (f32x4*)(X + (size_t)m * D) + lane;
#pragma unroll
                for (int j = 0; j < 4; ++j) { v[j] = xr[64 * j]; s += (v[j][0] + v[j][1]) + (v[j][2] + v[j][3]); }
                const float mean = wave_sum(s) * (1.f / D); float s2 = 0.f;
#pragma unroll
                for (int j = 0; j < 4; ++j) { v[j] = v[j] - mean; s2 += (v[j][0] * v[j][0] + v[j][1] * v[j][1]) + (v[j][2] * v[j][2] + v[j][3] * v[j][3]); }
                const float rstd = rsqrtf(wave_sum(s2) * (1.f / D) + LN_EPS);
#pragma unroll
                for (int j = 0; j < 4; ++j) { const f32x4 gg = ((const f32x4*)g1)[lane + 64 * j], bb = ((const f32x4*)b1)[lane + 64 * j]; v[j] = v[j] * rstd * gg + bb; xr[64 * j] = v[j];
                    u32x2 w; w.x = pk2(v[j][0], v[j][1]); w.y = pk2(v[j][2], v[j][3]); ((u32x2*)(XB + (size_t)m * D))[lane + 64 * j] = w; }
                float mylg = 0.f;
#pragma unroll 1
                for (int o = 0; o < 36; ++o) { float a = 0.f;
#pragma unroll
                    for (int j = 0; j < 4; ++j) { const f32x4 wv = ((const f32x4*)(WrT + o * 1024))[lane + 64 * j]; a += v[j][0] * wv[0] + v[j][1] * wv[1] + v[j][2] * wv[2] + v[j][3] * wv[3]; }
                    a = wave_sum(a); mylg = (lane == o) ? a : mylg; }
                mylg += lane < 4 ? rgb[lane & 3] : (lane < 36 ? reb[(lane - 4) & 31] : 0.f);
                float gl[4]; float gm = -INFINITY; int gs = 0;
#pragma unroll
                for (int o = 0; o < 4; ++o) { gl[o] = __shfl(mylg, o); if (gl[o] > gm) { gm = gl[o]; gs = o; } }
                float gden = 0.f;
#pragma unroll
                for (int o = 0; o < 4; ++o) gden += __expf(gl[o] - gm);
                const float pg = 1.f / gden;
                float el[8];
#pragma unroll
                for (int o = 0; o < 8; ++o) el[o] = __shfl(mylg, 4 + gs * 8 + o);
                int e1 = 0; float m1 = el[0];
#pragma unroll
                for (int o = 1; o < 8; ++o) if (el[o] > m1) { m1 = el[o]; e1 = o; }
                int e2 = -1; float m2 = -INFINITY;
#pragma unroll
                for (int o = 0; o < 8; ++o) if (o != e1 && el[o] > m2) { m2 = el[o]; e2 = o; }
                const float r2 = __expf(m2 - m1); const float ga = pg / (1.f + r2), gb = pg * r2 / (1.f + r2);
                if (lane == 0) {
                    const int E1 = gs * 8 + e1, E2 = gs * 8 + e2;
                    tok_e[m * 2] = E1; tok_e[m * 2 + 1] = E2; tok_g[m * 2] = ga; tok_g[m * 2 + 1] = gb;
                    tok_rank[m * 2] = atomicAdd(&cnt[E1], 1); tok_rank[m * 2 + 1] = atomicAdd(&cnt[E2], 1);
                }
            }
            LAS float* scr = (LAS float*)(lds + wave * 16384);
            const float* eg = INP(I_EG) + (size_t)l * NEXP * 1024 * 512; const float* eu = INP(I_EU) + (size_t)l * NEXP * 1024 * 512; const float* ed = INP(I_ED) + (size_t)l * NEXP * 512 * 1024;
            for (int it = gw; it < NEXP * 2 * 4 * 64; it += NGW) {
                const int e = it / 512, r = it % 512, half = r / 256, ct = (r % 256) / 64, q = r % 64, kb = q / 4, nb = q % 4;
                const float* W = (half ? eu : eg) + (size_t)e * 1024 * 512;
                transpose_item(W, 512, ct * 128, 128, WGU + (size_t)e * 1024 * 1024, 1024, ct * 256 + half * 128, 0, kb, nb, scr, lane);
            }
            for (int it = gw; it < NEXP * 8 * 32; it += NGW) {
                const int e = it / 256, q = it % 256, kb = q / 32, nb = q % 32;
                transpose_item(ed + (size_t)e * 512 * 1024, 1024, 0, 1024, WD + (size_t)e * 1024 * 512, 512, 0, 0, kb, nb, scr, lane);
            }
        }
        else if constexpr (SP == 8 || SP == 9 || SP == 10) {
            unsigned tbo = MISC_OFF; asm volatile("" : "+v"(tbo));
            volatile LAS int* tb = (volatile LAS int*)(lds + tbo);
            if (tid == 0) { int acc = 0; for (int e = 0; e < 32; ++e) { const int c = __hip_atomic_load(&cnt[e], __ATOMIC_RELAXED, __HIP_MEMORY_SCOPE_AGENT); tb[e] = acc; tb[33 + e] = acc; acc += (c + 255) >> 8; } tb[32] = acc; }
            __syncthreads();
            if constexpr (SP == 8) {
                for (int m = gw; m < M; m += NGW) {
#pragma unroll
                    for (int k = 0; k < 2; ++k) { const int e = tok_e[m * 2 + k]; const int slot = tb[33 + e] * 256 + tok_rank[m * 2 + k];
                        const u32x4* src = (const u32x4*)(XB + (size_t)m * D); u32x4* dst = (u32x4*)(XS + (size_t)slot * D);
                        dst[lane] = src[lane]; dst[lane + 64] = src[lane + 64];
                        if (lane == 0) tok_slot[m * 2 + k] = slot; }
                }
            } else if constexpr (SP == 9) {
                pg8::Gemm g{XS, WGU, 1024, 1024, 1024}; MoeOrder S{tb, G, bid, (size_t)1024 * 2, (size_t)1024 * 1024 * 2, (size_t)256 * 1024 * 2};
                EpiSwiglu E{HB};
                pg8::gemm_phase<EpiSwiglu, MoeOrder>(lds, g, S, E);
            } else {
                pg8::Gemm g{HB, WD, 512, 512, 512}; MoeOrder S{tb, G, bid, (size_t)512 * 2, (size_t)1024 * 512 * 2, (size_t)256 * 512 * 2};
                EpiStoreBf16 E{XS, 1024, 0, 1024};
                pg8::gemm_phase<EpiStoreBf16, MoeOrder>(lds, g, S, E);
            }
        }
        else if constexpr (SP == 11) {
            const float* g2 = INP(I_LN2G) + l * 1024; const float* b2 = INP(I_LN2B) + l * 1024;
            for (int m = gw; m < M; m += NGW) {
                const int s1 = tok_slot[m * 2], s2i = tok_slot[m * 2 + 1]; const float ga = tok_g[m * 2], gb = tok_g[m * 2 + 1];
                f32x4 v[4]; float s = 0.f; f32x4* xr = (f32x4*)(X + (size_t)m * D) + lane;
#pragma unroll
                for (int j = 0; j < 4; ++j) { v[j] = xr[64 * j] * ALPHA;
                    const u32x2 y1 = ((const u32x2*)(XS + (size_t)s1 * D))[lane + 64 * j], y2 = ((const u32x2*)(XS + (size_t)s2i * D))[lane + 64 * j];
                    v[j][0] += ga * __uint_as_float(y1.x << 16) + gb * __uint_as_float(y2.x << 16); v[j][1] += ga * __uint_as_float(y1.x & 0xffff0000u) + gb * __uint_as_float(y2.x & 0xffff0000u);
                    v[j][2] += ga * __uint_as_float(y1.y << 16) + gb * __uint_as_float(y2.y << 16); v[j][3] += ga * __uint_as_float(y1.y & 0xffff0000u) + gb * __uint_as_float(y2.y & 0xffff0000u);
                    s += (v[j][0] + v[j][1]) + (v[j][2] + v[j][3]); }
                const float mean = wave_sum(s) * (1.f / D); float s2 = 0.f;
#pragma unroll
                for (int j = 0; j < 4; ++j) { v[j] = v[j] - mean; s2 += (v[j][0] * v[j][0] + v[j][1] * v[j][1]) + (v[j][2] * v[j][2] + v[j][3] * v[j][3]); }
                const float rstd = rsqrtf(wave_sum(s2) * (1.f / D) + LN_EPS);
#pragma unroll
                for (int j = 0; j < 4; ++j) { const f32x4 gg = ((const f32x4*)g2)[lane + 64 * j], bb = ((const f32x4*)b2)[lane + 64 * j]; v[j] = v[j] * rstd * gg + bb; xr[64 * j] = v[j];
                    u32x2 w; w.x = pk2(v[j][0], v[j][1]); w.y = pk2(v[j][2], v[j][3]); ((u32x2*)(XB + (size_t)m * D))[lane + 64 * j] = w; }
            }
        }
    }
}

template <int SP>
__global__ void __launch_bounds__(NTHR, 2) k_phase(Args args, int l) {
    extern __shared__ __attribute__((aligned(16))) unsigned char lds_raw[];
    ptr_table_fill(args, (LAS unsigned char*)lds_raw);
    phase_body<SP>(l, (LAS unsigned char*)lds_raw);
}


#define XB_TMO      128
#define XB_XCNT(j)  (256  + 64 * (j))
#define XB_XSUB(j)  (1280 + 64 * (j))
#define XB_XGEN(j)  (2304 + 64 * (j))
#define XB_TOP      3328
#define XB_TOPGEN   3392
#define XCD_BAR_WORDS 3456
#define XB_SPIN_CAP (1u << 22)
__device__ __forceinline__ unsigned xb_ld(unsigned* p)              { return __hip_atomic_load(p, __ATOMIC_RELAXED, __HIP_MEMORY_SCOPE_AGENT); }
__device__ __forceinline__ unsigned xb_add(unsigned* p, unsigned v) { return __hip_atomic_fetch_add(p, v, __ATOMIC_RELAXED, __HIP_MEMORY_SCOPE_AGENT); }
__device__ __forceinline__ unsigned xb_xcc_id() { return (unsigned)__builtin_amdgcn_s_getreg((3 << 11) | 20) & 0xFu; }
#define XB_SPIN(cond, bar) do { unsigned _sp = 0; while (cond) { __builtin_amdgcn_s_sleep(1); \
    if ((++_sp & 255u) == 0u) { if (xb_ld(&(bar)[XB_TMO])) break; if (_sp > XB_SPIN_CAP) { atomicAdd(&(bar)[XB_TMO], 1u); break; } } } } while (0)
__device__ __forceinline__ void xcd_barrier_complete(unsigned* bar, unsigned x, unsigned& nloc, unsigned& nx) {
    const unsigned G = gridDim.x;
    unsigned sum, cnt, mine, sp = 0u;
    for (;;) {
        sum = 0u; cnt = 0u; mine = 0u;
#pragma unroll
        for (unsigned j = 0; j < 16; ++j) { const unsigned c = xb_ld(&bar[XB_XCNT(j)]); sum += c; cnt += (c > 0u) ? 1u : 0u; mine = (j == x) ? c : mine; }
        if (sum == G) break;
        __builtin_amdgcn_s_sleep(1);
        if ((++sp & 255u) == 0u) { if (xb_ld(&bar[XB_TMO])) break; if (sp > XB_SPIN_CAP) { atomicAdd(&bar[XB_TMO], 1u); break; } }
    }
    nloc = mine > 0u ? mine : 1u; nx = cnt > 0u ? cnt : 1u;
}
__device__ __forceinline__ void xcd_barrier(unsigned* bar, LAS unsigned char* lds) {
    asm volatile("s_waitcnt vmcnt(0)" ::: "memory");
    __syncthreads();
    int tid_ = threadIdx.x; asm volatile("" : "+v"(tid_));
    if (tid_ == 0) {
        unsigned so = (unsigned)(LDS_BYTES - 576); asm volatile("" : "+v"(so));
        volatile LAS unsigned* st = (volatile LAS unsigned*)(lds + so);
        __builtin_amdgcn_s_waitcnt(0);
        const unsigned x = xb_xcc_id();
        unsigned nloc = st[0], nx = st[1];
        if (nloc == 0u) { xcd_barrier_complete(bar, x, nloc, nx); st[0] = nloc; st[1] = nx; }
        const unsigned old = xb_add(&bar[XB_XSUB(x)], 1u);
        const unsigned gen = old / nloc;
        if (old + 1u == (gen + 1u) * nloc) {
            __builtin_amdgcn_fence(__ATOMIC_RELEASE, "agent");
            asm volatile("s_waitcnt vmcnt(0)" ::: "memory");
            const unsigned og = xb_add(&bar[XB_TOP], 1u);
            const unsigned tg = og / nx;
            if (og + 1u == (tg + 1u) * nx) xb_add(&bar[XB_TOPGEN], 1u);
            else XB_SPIN(xb_ld(&bar[XB_TOPGEN]) == tg, bar);
            __builtin_amdgcn_fence(__ATOMIC_ACQUIRE, "agent");
            xb_add(&bar[XB_XGEN(x)], 1u);
            asm volatile("s_waitcnt vmcnt(0)" ::: "memory");
        } else {
            XB_SPIN(xb_ld(&bar[XB_XGEN(x)]) == gen, bar);
            __builtin_amdgcn_fence(__ATOMIC_ACQUIRE, "agent");
            asm volatile("s_waitcnt vmcnt(0)" ::: "memory");
        }
    }
    __syncthreads();
}
namespace cg = cooperative_groups;
__global__ void __launch_bounds__(NTHR, 2) fwd_all(Args args) {
    extern __shared__ __attribute__((aligned(16))) unsigned char lds_raw[];
    LAS unsigned char* lds = (LAS unsigned char*)lds_raw;
    unsigned* bar = (unsigned*)(args.ws + WS_CTL) + CW_BAR;
    if (threadIdx.x == 0) { ((volatile LAS unsigned*)(lds + LDS_BYTES - 576))[0] = 0u; ((volatile LAS unsigned*)(lds + LDS_BYTES - 576))[1] = 0u; (void)xb_add(&bar[XB_XCNT(xb_xcc_id())], 1u); }
    ptr_table_fill(args, lds);
    const int reps = args.ph_lo;
    phase_body<-1>(0, lds);
    cg::this_grid().sync();
#define GRID_BAR() do { unsigned* bar_ = (unsigned*)ldptr(lds, 36) + CW_BAR; xcd_barrier(bar_, lds); } while (0)
    { constexpr int l = 0;
        phase_body<0>(l, lds); GRID_BAR();
#pragma unroll 1
        for (int r = 0; r < (reps & 15); ++r) { phase_body<1>(l, lds); __syncthreads(); }
#pragma unroll 1
        for (int r = 0; r < ((reps >> 4) & 15); ++r) { phase_body<2>(l, lds); __syncthreads(); }
#pragma unroll 1
        for (int r = 0; r < ((reps >> 8) & 15); ++r) { phase_body<3>(l, lds); __syncthreads(); }
        GRID_BAR();
        phase_body<12>(l, lds); GRID_BAR();
        phase_body<13>(l, lds); GRID_BAR();
        phase_body<4>(l, lds); GRID_BAR();
        phase_body<5>(l, lds); GRID_BAR();
        phase_body<6>(l, lds); GRID_BAR();
        phase_body<7>(l, lds); GRID_BAR();
        phase_body<8>(l, lds); GRID_BAR();
        phase_body<9>(l, lds); GRID_BAR();
        phase_body<10>(l, lds); GRID_BAR();
        phase_body<11>(l, lds); GRID_BAR();
    }
    { constexpr int l = 1;
        phase_body<0>(l, lds); GRID_BAR();
#pragma unroll 1
        for (int r = 0; r < (reps & 15); ++r) { phase_body<1>(l, lds); __syncthreads(); }
#pragma unroll 1
        for (int r = 0; r < ((reps >> 4) & 15); ++r) { phase_body<2>(l, lds); __syncthreads(); }
#pragma unroll 1
        for (int r = 0; r < ((reps >> 8) & 15); ++r) { phase_body<3>(l, lds); __syncthreads(); }
        GRID_BAR();
        phase_body<12>(l, lds); GRID_BAR();
        phase_body<13>(l, lds); GRID_BAR();
        phase_body<4>(l, lds); GRID_BAR();
        phase_body<5>(l, lds); GRID_BAR();
        phase_body<6>(l, lds); GRID_BAR();
        phase_body<7>(l, lds); GRID_BAR();
        phase_body<8>(l, lds); GRID_BAR();
        phase_body<9>(l, lds); GRID_BAR();
        phase_body<10>(l, lds); GRID_BAR();
        phase_body<11>(l, lds); GRID_BAR();
    }
#undef GRID_BAR
}

template <int SP> static void launch_phase(const Args& a, int l, int grid, hipStream_t stream) {
    static bool attr = false;
    if (!attr) { (void)hipFuncSetAttribute((const void*)k_phase<SP>, hipFuncAttributeMaxDynamicSharedMemorySize, LDS_BYTES); attr = true; }
    hipLaunchKernelGGL(k_phase<SP>, dim3(grid), dim3(NTHR), LDS_BYTES, stream, a, l);
}

extern "C" void kernel_launch(void* const* d_in, const int* in_sizes, int n_in, void* d_out, int out_size, void* d_ws, size_t ws_size, hipStream_t stream) {
    static int grid = 0;
    if (grid == 0) {
        if (n_in != 35 || out_size != M * D || ws_size < WS_END) { fprintf(stderr, "kernel_launch: unexpected problem (n_in %d out %d ws %zu)\n", n_in, out_size, ws_size); grid = -1; return; }
        int dev = 0, cus = 0, per_cu = 0;
        (void)hipGetDevice(&dev); (void)hipDeviceGetAttribute(&cus, hipDeviceAttributeMultiprocessorCount, dev);
#if N_LAUNCH_MODE == 1
        (void)hipFuncSetAttribute((const void*)fwd_all, hipFuncAttributeMaxDynamicSharedMemorySize, LDS_BYTES);
        if (hipOccupancyMaxActiveBlocksPerMultiprocessor(&per_cu, (const void*)fwd_all, NTHR, LDS_BYTES) != hipSuccess || per_cu < 1) { fprintf(stderr, "kernel_launch: occupancy query says %d blocks/CU\n", per_cu); grid = -1; return; }
#endif
        (void)per_cu;
        grid = cus;
        if (grid != 256) { fprintf(stderr, "kernel_launch: built for 256 CUs, found %d\n", cus); grid = -1; return; }
    }
    if (grid < 0) return;
    (void)hipMemsetAsync((char*)d_ws + WS_CTL, 0, CTL_BYTES, stream);
    Args a{};
    for (int i = 0; i < 35; ++i) a.in[i] = (const float*)d_in[i];
    a.out = (float*)d_out; a.ws = (unsigned char*)d_ws;
#if N_LAUNCH_MODE == 1
    a.ph_lo = PROBE_REPS;
    void* kargs[] = {(void*)&a};
    hipError_t e = hipLaunchCooperativeKernel((const void*)fwd_all, dim3(grid), dim3(NTHR), kargs, LDS_BYTES, stream);
    if (e != hipSuccess) fprintf(stderr, "cooperative launch failed: %s\n", hipGetErrorString(e));
#else
    launch_phase<-1>(a, 0, grid, stream);
    for (int l = 0; l < NL; ++l) {
        launch_phase<0>(a, l, grid, stream); launch_phase<1>(a, l, grid, stream); launch_phase<2>(a, l, grid, stream); launch_phase<3>(a, l, grid, stream); launch_phase<12>(a, l, grid, stream); launch_phase<13>(a, l, grid, stream);
        launch_phase<4>(a, l, grid, stream); launch_phase<5>(a, l, grid, stream); launch_phase<6>(a, l, grid, stream); launch_phase<7>(a, l, grid, stream);
        launch_phase<8>(a, l, grid, stream); launch_phase<9>(a, l, grid, stream); launch_phase<10>(a, l, grid, stream); launch_phase<11>(a, l, grid, stream);
    }
#endif
}
```

```cpp
#include <hip/hip_runtime.h>
#include <cstdio>
#include <cstdint>
#include <hip/hip_cooperative_groups.h>

#ifndef PROBE_REPS
#define PROBE_REPS 0x111
#endif
#ifndef N_LAUNCH_MODE
#define N_LAUNCH_MODE 1
#endif

namespace pg8 {
#define PG8_LAS __attribute__((address_space(3)))
typedef unsigned short bf16_t;
typedef short bf16x8 __attribute__((ext_vector_type(8)));
typedef float f32x4 __attribute__((ext_vector_type(4)));
typedef unsigned u32x4 __attribute__((ext_vector_type(4)));
constexpr int BM = 256, BK = 64, HALF = 128, HTB = HALF * BK * 2, STAGE_BYTES = 8 * HTB, NXCD = 8, WGM = 8;

__host__ __device__ __forceinline__ int lds_byte(int r, int c) { const int st = (r >> 4) * 2 + (c >> 5), rr = r & 15, cc = c & 31, ob = rr * 64 + cc * 2; return st * 1024 + (ob ^ (((ob >> 9) & 1) << 5)); }
__host__ __device__ __forceinline__ void stage_rc(int b, int& R, int& C) { const int st = b / 1024, sb = b % 1024, swz = sb ^ (((sb >> 9) & 1) << 5); R = (st >> 1) * 16 + swz / 64; C = (st & 1) * 32 + (swz % 64) / 2; }
__host__ __device__ __forceinline__ int perm32(int rho) { const int n = rho >> 4, i = rho & 15; return 8 * (i >> 2) + 4 * n + (i & 3); }

struct Unit { int pm, pn, aux; size_t aoff, boff; };
struct Gemm { const bf16_t* A; const bf16_t* Bt; int lda, ldb, K; };

__device__ __forceinline__ void tile_of(int L, int nM, int nN, int& pm, int& pn) {
    const int nwg = nM * nN; int wgid = L;
    { const int q = nwg / NXCD, r = nwg % NXCD, xcd = wgid % NXCD, off = wgid / NXCD; wgid = (xcd < r ? xcd * (q + 1) : r * (q + 1) + (xcd - r) * q) + off; }
    const int nig = WGM * nN, gid = wgid / nig, fm = gid * WGM, gsz = (nM - fm) < WGM ? (nM - fm) : WGM;
    pm = fm + ((wgid % nig) % gsz); pn = (wgid % nig) / gsz;
}
struct StaticOrder {
    int nM, nN, nwg, G, c, lda, ldb;
    __device__ void init(int M, int N, int G_, int c_, int lda_, int ldb_) { nM = M / BM; nN = N / BM; nwg = nM * nN; G = G_; c = c_; lda = lda_; ldb = ldb_; }
    __device__ bool next(int i, Unit& u) const {
        const long L = (long)i * G + c; if (L >= nwg) return false;
        tile_of((int)L, nM, nN, u.pm, u.pn); u.aux = 0;
        u.aoff = (size_t)u.pm * BM * lda * 2; u.boff = (size_t)u.pn * BM * ldb * 2; return true;
    }
};

__device__ __forceinline__ unsigned cvt_pk_bf16(float lo, float hi) { unsigned r; asm volatile("v_cvt_pk_bf16_f32 %0, %1, %2" : "=v"(r) : "v"(lo), "v"(hi)); return r; }

template <class Epi, class Sched, bool ALIGN_EPI = true, bool SP2 = true>
__device__ __forceinline__ void gemm_phase(PG8_LAS unsigned char* lds, const Gemm g, const Sched& S, const Epi& E) {
    int tid_ = threadIdx.x; asm volatile("" : "+v"(tid_));
    const int tid = tid_, wid = __builtin_amdgcn_readfirstlane(tid >> 6), lane = tid & 63, wr = wid >> 2, wc = wid & 3, fr = lane & 15, fq = lane >> 4;
    const int K = g.K, nt = K / BK;
    unsigned voffA[2], voffB[2];
#pragma unroll
    for (int i = 0; i < 2; ++i) { int R, C; stage_rc(tid * 16 + i * 8192, R, C); const int Rb = Epi::PERM ? ((R & ~31) + perm32(R & 31)) : R;
        voffA[i] = (unsigned)(R * g.lda + C) * 2u; voffB[i] = (unsigned)(Rb * g.ldb + C) * 2u; }
    const size_t kstep = (size_t)(BK * 2);
    const size_t hstepA = (size_t)HALF * g.lda * 2, hstepB = (size_t)HALF * g.ldb * 2;
    const unsigned ldsw = (unsigned)wid * 1024u;
    const int aoff = lds_byte(wr * 64 + fr, fq * 8), boff = lds_byte(wc * 32 + fr, fq * 8);
#define PG8_SA(b, h) (((b) * 2 + (h)) * HTB)
#define PG8_SB(b, h) ((4 + (b) * 2 + (h)) * HTB)
#define PG8_STAGE(bufoff, gbase, voff) do { _Pragma("unroll") for (int _i = 0; _i < 2; ++_i) \
        __builtin_amdgcn_global_load_lds((const unsigned*)((const char*)(gbase) + (voff)[_i]), (PG8_LAS unsigned*)(lds + (bufoff) + ldsw + _i * 8192), 16, 0, 0); } while (0)
#define PG8_LDA(dst, b, h) do { _Pragma("unroll") for (int m = 0; m < 4; ++m) _Pragma("unroll") for (int k = 0; k < 2; ++k) dst[m][k] = *(const PG8_LAS bf16x8*)(lds + PG8_SA(b, h) + aoff + m * 2048 + k * 1024); } while (0)
#define PG8_LDB(dst, b, h) do { _Pragma("unroll") for (int n = 0; n < 2; ++n) _Pragma("unroll") for (int k = 0; k < 2; ++k) dst[n][k] = *(const PG8_LAS bf16x8*)(lds + PG8_SB(b, h) + boff + n * 2048 + k * 1024); } while (0)
#define PG8_MMA(ai, bj, At, Bt) do { __builtin_amdgcn_s_setprio(1); _Pragma("unroll") for (int m = 0; m < 4; ++m) _Pragma("unroll") for (int n = 0; n < 2; ++n) _Pragma("unroll") for (int k = 0; k < 2; ++k) \
        acc[ai][bj][m][n] = __builtin_amdgcn_mfma_f32_16x16x32_bf16(Bt[n][k], At[m][k], acc[ai][bj][m][n], 0, 0, 0); __builtin_amdgcn_s_setprio(0); } while (0)
#define PG8_WAIT_V(n) asm volatile("s_waitcnt vmcnt(" #n ")" ::: "memory")
#define PG8_WAIT_L(n) asm volatile("s_waitcnt lgkmcnt(" #n ")" ::: "memory")
#define PG8_BAR __builtin_amdgcn_s_barrier()
#define PG8_SCHED __builtin_amdgcn_sched_barrier(0)
    Unit cur, nxt; int ui = 0;
    if (!S.next(0, cur)) return;
    f32x4 acc[2][2][4][2];
#pragma unroll
    for (int a = 0; a < 2; ++a)
#pragma unroll
        for (int b = 0; b < 2; ++b)
#pragma unroll
            for (int m = 0; m < 4; ++m)
#pragma unroll
                for (int n = 0; n < 2; ++n) acc[a][b][m][n] = (f32x4){0.f, 0.f, 0.f, 0.f};
    bf16x8 At[4][2], B0[2][2], B1[2][2];
    const char* cA = (const char*)g.A + cur.aoff; const char* cB = (const char*)g.Bt + cur.boff;
    if constexpr (SP2) {
        PG8_STAGE(PG8_SB(0, 0), cB, voffB); PG8_STAGE(PG8_SB(0, 1), cB + hstepB, voffB); PG8_STAGE(PG8_SA(0, 0), cA, voffA); PG8_STAGE(PG8_SA(0, 1), cA + hstepA, voffA);
        if (wr == 1) PG8_BAR;
        PG8_WAIT_V(2); PG8_BAR;
        PG8_STAGE(PG8_SB(1, 0), cB + kstep, voffB); PG8_STAGE(PG8_SA(1, 0), cA + kstep, voffA); PG8_STAGE(PG8_SB(1, 1), cB + hstepB + kstep, voffB);
        PG8_WAIT_V(6); PG8_BAR;
    } else {
        PG8_STAGE(PG8_SB(0, 0), cB, voffB); PG8_STAGE(PG8_SA(0, 0), cA, voffA); PG8_STAGE(PG8_SB(0, 1), cB + hstepB, voffB); PG8_STAGE(PG8_SA(0, 1), cA + hstepA, voffA);
        if (wr == 1) PG8_BAR;
        PG8_WAIT_V(4); PG8_BAR;
        PG8_STAGE(PG8_SB(1, 0), cB + kstep, voffB); PG8_STAGE(PG8_SA(1, 0), cA + kstep, voffA); PG8_STAGE(PG8_SB(1, 1), cB + hstepB + kstep, voffB);
        PG8_WAIT_V(6); PG8_BAR;
    }
    for (;;) {
        const bool has_next = S.next(ui + 1, nxt);
        const char* nA = has_next ? (const char*)g.A + nxt.aoff : cA; const char* nB = has_next ? (const char*)g.Bt + nxt.boff : cB;
        for (int t = 0; t < nt; t += 2) {
            const bool last = (t == nt - 2);
            const char* a1 = cA + (size_t)(t + 1) * kstep;
            const char* a2 = last ? nA : cA + (size_t)(t + 2) * kstep; const char* b2 = last ? nB : cB + (size_t)(t + 2) * kstep;
            const char* a3 = a2 + kstep; const char* b3 = b2 + kstep;
            if constexpr (SP2) {
            PG8_LDB(B0, 0, 0); PG8_LDB(B1, 0, 1); PG8_SCHED; PG8_LDA(At, 0, 0); PG8_STAGE(PG8_SA(1, 1), a1 + hstepA, voffA);
            PG8_WAIT_V(8); PG8_WAIT_L(0); PG8_BAR; PG8_MMA(0, 0, At, B0); PG8_MMA(0, 1, At, B1); PG8_BAR; PG8_SCHED;
            PG8_LDA(At, 0, 1); PG8_STAGE(PG8_SB(0, 0), b2, voffB); PG8_STAGE(PG8_SB(0, 1), b2 + hstepB, voffB); PG8_STAGE(PG8_SA(0, 0), a2, voffA);
            PG8_WAIT_V(8); PG8_WAIT_L(0); PG8_BAR; PG8_MMA(1, 0, At, B0); PG8_MMA(1, 1, At, B1); PG8_BAR; PG8_SCHED;
            PG8_LDB(B0, 1, 0); PG8_LDB(B1, 1, 1); PG8_SCHED; PG8_LDA(At, 1, 0); PG8_STAGE(PG8_SA(0, 1), a2 + hstepA, voffA);
            PG8_WAIT_V(8); PG8_WAIT_L(0); PG8_BAR; PG8_MMA(0, 0, At, B0); PG8_MMA(0, 1, At, B1); PG8_BAR; PG8_SCHED;
            PG8_LDA(At, 1, 1); PG8_STAGE(PG8_SB(1, 0), b3, voffB); PG8_STAGE(PG8_SB(1, 1), b3 + hstepB, voffB); PG8_STAGE(PG8_SA(1, 0), a3, voffA);
            PG8_WAIT_V(8); PG8_WAIT_L(0); PG8_BAR; PG8_MMA(1, 0, At, B0); PG8_MMA(1, 1, At, B1); PG8_BAR; PG8_SCHED;
            } else {
            PG8_LDB(B0, 0, 0); PG8_SCHED; PG8_LDA(At, 0, 0); PG8_STAGE(PG8_SA(1, 1), a1 + hstepA, voffA);
            PG8_WAIT_L(8); PG8_BAR; PG8_WAIT_L(0); PG8_MMA(0, 0, At, B0); PG8_BAR; PG8_SCHED;
            PG8_LDB(B1, 0, 1); PG8_STAGE(PG8_SB(0, 0), b2, voffB);
            PG8_BAR; PG8_WAIT_L(0); PG8_MMA(0, 1, At, B1); PG8_BAR;
            PG8_LDA(At, 0, 1); PG8_STAGE(PG8_SA(0, 0), a2, voffA);
            PG8_BAR; PG8_WAIT_L(0); PG8_MMA(1, 0, At, B0); PG8_BAR; PG8_SCHED;
            PG8_STAGE(PG8_SB(0, 1), b2 + hstepB, voffB);
            PG8_WAIT_V(6); PG8_BAR; PG8_MMA(1, 1, At, B1); PG8_BAR;
            PG8_LDB(B0, 1, 0); PG8_SCHED; PG8_LDA(At, 1, 0); PG8_STAGE(PG8_SA(0, 1), a2 + hstepA, voffA);
            PG8_WAIT_L(8); PG8_BAR; PG8_WAIT_L(0); PG8_MMA(0, 0, At, B0); PG8_BAR; PG8_SCHED;
            PG8_LDB(B1, 1, 1); PG8_STAGE(PG8_SB(1, 0), b3, voffB);
            PG8_BAR; PG8_WAIT_L(0); PG8_MMA(0, 1, At, B1); PG8_BAR;
            PG8_LDA(At, 1, 1); PG8_STAGE(PG8_SA(1, 0), a3, voffA);
            PG8_BAR; PG8_WAIT_L(0); PG8_MMA(1, 0, At, B0); PG8_BAR; PG8_SCHED;
            PG8_STAGE(PG8_SB(1, 1), b3 + hstepB, voffB);
            PG8_WAIT_V(6); PG8_BAR; PG8_MMA(1, 1, At, B1); PG8_BAR;
            }
        }
        if constexpr (ALIGN_EPI) { if (wr == 0) PG8_BAR; }
        E(acc, cur, wr, wc, fr, fq);
        if (!has_next) break;
#pragma unroll
        for (int a = 0; a < 2; ++a)
#pragma unroll
            for (int b = 0; b < 2; ++b)
#pragma unroll
                for (int m = 0; m < 4; ++m)
#pragma unroll
                    for (int n = 0; n < 2; ++n) acc[a][b][m][n] = (f32x4){0.f, 0.f, 0.f, 0.f};
        cur = nxt; cA = nA; cB = nB; ++ui;
        if constexpr (ALIGN_EPI) { if (wr == 1) PG8_BAR; }
    }
    PG8_WAIT_V(0);
    if constexpr (!ALIGN_EPI) { if (wr == 0) PG8_BAR; }
    PG8_BAR;
#undef PG8_SA
#undef PG8_SB
#undef PG8_STAGE
#undef PG8_LDA
#undef PG8_LDB
#undef PG8_MMA
#undef PG8_WAIT_V
#undef PG8_WAIT_L
#undef PG8_BAR
#undef PG8_SCHED
}
}

#define LAS __attribute__((address_space(3)))
typedef unsigned short bf16;
typedef float f32x4 __attribute__((ext_vector_type(4)));
typedef unsigned u32x4 __attribute__((ext_vector_type(4)));
typedef unsigned u32x2 __attribute__((ext_vector_type(2)));

constexpr int NB = 8, T = 4096, D = 1024, M = NB * T, NL = 2;
constexpr int INW = 9160;
constexpr int PP = 5120;
constexpr int C_AQ = 0, C_AK = 768, C_AV = 1536, C_BQ = 2304, C_BK = 2560, C_BV = 2816, C_IQ = 3072, C_IK = 3328, C_C = 3392, C_DZ = 4288, C_DX = 4544, C_IW = 5056, C_DT = 5060, C_END = 5064;
constexpr int NEXP = 32, DEXP = 512;
constexpr int CAP = 73728;
constexpr float LN_EPS = 1e-5f;
constexpr float ALPHA = 1.4142135623730951f;

constexpr size_t MiB = 1u << 20;
constexpr size_t WS_CTL = 0, CTL_BYTES = 1 * MiB;
constexpr size_t WS_WINT = 2 * MiB;
constexpr size_t WS_WGT = 22 * MiB;
constexpr size_t WS_WBRT = 38 * MiB;
constexpr size_t WS_WOUTT = 42 * MiB;
constexpr size_t WS_WRT = 46 * MiB;
constexpr size_t WS_ROUTE = 47 * MiB;
constexpr size_t WS_XB = 48 * MiB;
constexpr size_t WS_O = 112 * MiB;
constexpr size_t WS_VF = 176 * MiB;
constexpr size_t WS_P = 192 * MiB;
constexpr size_t WS_GS = 192 * MiB;
constexpr size_t WS_MERGED = 448 * MiB;
constexpr size_t WS_XS = 192 * MiB;
constexpr size_t WS_H = 336 * MiB;
constexpr size_t WS_WGU = 408 * MiB;
constexpr size_t WS_WD = 472 * MiB;
constexpr size_t WS_RW = 512 * MiB;
constexpr size_t WS_END = 544 * MiB;
constexpr int CW_CNT = 64, CW_BAR = 4096;

constexpr int RING_BYTES = 131072, MISC_OFF = RING_BYTES, LDS_BYTES = 147456;
constexpr int NWAVES = 8, NTHR = 512;

__device__ __forceinline__ float bf2f(bf16 v) { return __uint_as_float(((unsigned)v) << 16); }
__device__ __forceinline__ unsigned f2bf(float f) { unsigned u = __float_as_uint(f); return (u + 0x7fffu + ((u >> 16) & 1u)) >> 16; }
__device__ __forceinline__ unsigned pk2(float lo, float hi) { return f2bf(lo) | (f2bf(hi) << 16); }
__device__ __forceinline__ float wave_sum(float v) {
#pragma unroll
    for (int o = 1; o < 64; o <<= 1) v += __shfl_xor(v, o);
    return v;
}
__device__ __forceinline__ float wave_max(float v) {
#pragma unroll
    for (int o = 1; o < 64; o <<= 1) v = fmaxf(v, __shfl_xor(v, o));
    return v;
}
__device__ __forceinline__ float sigmoidf_(float x) { return 1.f / (1.f + __expf(-x)); }
__device__ __forceinline__ float softplusf_(float x) { return x > 20.f ? x : log1pf(__expf(x)); }
__device__ __forceinline__ float siluf_(float x) { return x / (1.f + __expf(-x)); }

struct Args { const float* in[35]; float* out; unsigned char* ws; int ph_lo, ph_hi; };
enum { I_X = 0, I_WIN, I_CMU, I_CW0, I_CW2, I_CA0, I_CA2, I_CG2, I_CKK, I_CKA, I_CRK, I_CGNW, I_CGNB, I_CV0, I_CV1, I_CV2, I_DCW, I_DCB, I_DDTB, I_DALOG, I_DSKIP, I_DNW,
       I_WBR, I_WOUT, I_LN1G, I_LN1B, I_RG, I_RGB, I_RE, I_REB, I_EG, I_EU, I_ED, I_LN2G, I_LN2B };

__device__ __forceinline__ void transpose_item(const float* W, int ldn, int c0, int ncols, bf16* dst, int dld, int r0, int dk0, int kb, int nb, LAS float* scr, int lane) {
    const int k0 = 64 * kb, n0 = 32 * nb;
    const bool okn = (n0 + (lane & 31)) < ncols;
#pragma unroll 8
    for (int i = 0; i < 32; ++i) { const int kk = 2 * i + (lane >> 5); scr[kk * 33 + (lane & 31)] = okn ? W[(size_t)(k0 + kk) * ldn + c0 + n0 + (lane & 31)] : 0.f; }
    asm volatile("s_waitcnt lgkmcnt(0)" ::: "memory");
    const int c = lane & 7;
#pragma unroll
    for (int j = 0; j < 4; ++j) { const int n = (lane >> 3) + 8 * j; const LAS float* s = scr + (8 * c) * 33 + n;
        u32x4 o; o.x = pk2(s[0 * 33], s[1 * 33]); o.y = pk2(s[2 * 33], s[3 * 33]); o.z = pk2(s[4 * 33], s[5 * 33]); o.w = pk2(s[6 * 33], s[7 * 33]);
        if (n0 + n < ncols) *(u32x4*)(dst + (size_t)(r0 + n0 + n) * dld + dk0 + k0 + 8 * c) = o; }
    asm volatile("s_waitcnt lgkmcnt(0)" ::: "memory");
}

struct EpiStoreBf16 {
    static constexpr bool PERM = true;
    bf16* O; int ldc; int act; int ncols;
    __device__ __forceinline__ void operator()(const pg8::f32x4 (&acc)[2][2][4][2], const pg8::Unit& u, int wr, int wc, int fr, int fq) const {
        const int row0 = u.pm * 256 + wr * 64 + fr; const int col0 = u.pn * 256 + wc * 32 + 8 * fq;
#pragma unroll
        for (int ai = 0; ai < 2; ++ai)
#pragma unroll
            for (int m = 0; m < 4; ++m) { bf16* rowp = O + (size_t)(row0 + ai * 128 + m * 16) * ldc + col0;
#pragma unroll
                for (int bj = 0; bj < 2; ++bj) { pg8::f32x4 v0 = acc[ai][bj][m][0], v1 = acc[ai][bj][m][1];
                    if (act == 1) {
#pragma unroll
                        for (int j = 0; j < 4; ++j) { v0[j] = sigmoidf_(v0[j]); v1[j] = sigmoidf_(v1[j]); } }
                    u32x4 w; w.x = pg8::cvt_pk_bf16(v0[0], v0[1]); w.y = pg8::cvt_pk_bf16(v0[2], v0[3]); w.z = pg8::cvt_pk_bf16(v1[0], v1[1]); w.w = pg8::cvt_pk_bf16(v1[2], v1[3]);
                    if (col0 + bj * 128 < ncols) *(u32x4*)(rowp + bj * 128) = w; } }
    }
};
struct EpiBranch {
    static constexpr bool PERM = true;
    const bf16* GS; bf16* MG;
    __device__ __forceinline__ void operator()(const pg8::f32x4 (&acc)[2][2][4][2], const pg8::Unit& u, int wr, int wc, int fr, int fq) const {
        const int n = u.aux;
        const bf16* gbase = GS + (size_t)(u.pm * 256 + wr * 64 + fr) * 4096 + n * 1024 + u.pn * 256 + wc * 32 + 8 * fq;
        bf16* mbase = MG + (size_t)(u.pm * 256 + wr * 64 + fr) * 1024 + u.pn * 256 + wc * 32 + 8 * fq;
#pragma unroll
        for (int ai = 0; ai < 2; ++ai)
#pragma unroll
            for (int m = 0; m < 4; ++m) {
#pragma unroll
                for (int bj = 0; bj < 2; ++bj) {
                    const u32x4 gv = *(const u32x4*)(gbase + (size_t)(ai * 128 + m * 16) * 4096 + bj * 128);
                    bf16* mp = mbase + (size_t)(ai * 128 + m * 16) * 1024 + bj * 128;
                    u32x4 ov = (u32x4){0u, 0u, 0u, 0u}; if (n != 0) ov = *(const u32x4*)mp;
                    const pg8::f32x4 a0 = acc[ai][bj][m][0], a1 = acc[ai][bj][m][1];
                    u32x4 w;
                    w.x = pg8::cvt_pk_bf16(a0[0] * __uint_as_float(gv.x << 16) + __uint_as_float(ov.x << 16), a0[1] * __uint_as_float(gv.x & 0xffff0000u) + __uint_as_float(ov.x & 0xffff0000u));
                    w.y = pg8::cvt_pk_bf16(a0[2] * __uint_as_float(gv.y << 16) + __uint_as_float(ov.y << 16), a0[3] * __uint_as_float(gv.y & 0xffff0000u) + __uint_as_float(ov.y & 0xffff0000u));
                    w.z = pg8::cvt_pk_bf16(a1[0] * __uint_as_float(gv.z << 16) + __uint_as_float(ov.z << 16), a1[1] * __uint_as_float(gv.z & 0xffff0000u) + __uint_as_float(ov.z & 0xffff0000u));
                    w.w = pg8::cvt_pk_bf16(a1[2] * __uint_as_float(gv.w << 16) + __uint_as_float(ov.w << 16), a1[3] * __uint_as_float(gv.w & 0xffff0000u) + __uint_as_float(ov.w & 0xffff0000u));
                    *(u32x4*)mp = w; asm volatile("" ::: "memory"); } }
    }
};
struct EpiResid {
    static constexpr bool PERM = false;
    float* X;
    __device__ __forceinline__ void operator()(const pg8::f32x4 (&acc)[2][2][4][2], const pg8::Unit& u, int wr, int wc, int fr, int fq) const {
        const int row0 = u.pm * 256 + wr * 64 + fr, col0 = u.pn * 256 + wc * 32 + 4 * fq;
#pragma unroll
        for (int ai = 0; ai < 2; ++ai)
#pragma unroll
            for (int m = 0; m < 4; ++m) { float* rowp = X + (size_t)(row0 + ai * 128 + m * 16) * D + col0;
#pragma unroll
                for (int bj = 0; bj < 2; ++bj)
#pragma unroll
                    for (int n = 0; n < 2; ++n) { pg8::f32x4* p = (pg8::f32x4*)(rowp + bj * 128 + n * 16); *p = *p * ALPHA + acc[ai][bj][m][n]; } }
    }
};
struct EpiSwiglu {
    static constexpr bool PERM = true;
    bf16* H;
    __device__ __forceinline__ void operator()(const pg8::f32x4 (&acc)[2][2][4][2], const pg8::Unit& u, int wr, int wc, int fr, int fq) const {
        const int row0 = u.pm * 256 + wr * 64 + fr; const int col0 = u.pn * 128 + wc * 32 + 8 * fq;
#pragma unroll
        for (int ai = 0; ai < 2; ++ai)
#pragma unroll
            for (int m = 0; m < 4; ++m) { bf16* rowp = H + (size_t)(row0 + ai * 128 + m * 16) * DEXP + col0;
                float v[8];
#pragma unroll
                for (int j = 0; j < 4; ++j) { v[j] = siluf_(acc[ai][0][m][0][j]) * acc[ai][1][m][0][j]; v[4 + j] = siluf_(acc[ai][0][m][1][j]) * acc[ai][1][m][1][j]; }
                u32x4 w; w.x = pg8::cvt_pk_bf16(v[0], v[1]); w.y = pg8::cvt_pk_bf16(v[2], v[3]); w.z = pg8::cvt_pk_bf16(v[4], v[5]); w.w = pg8::cvt_pk_bf16(v[6], v[7]);
                *(u32x4*)rowp = w; }
    }
};

struct BranchOrder {
    int nM, nN, G, c;
    __device__ bool next(int i, pg8::Unit& u) const {
        const int tl = (i >> 2) * G + c; if (tl >= nM * nN) return false;
        pg8::tile_of(tl, nM, nN, u.pm, u.pn); u.aux = i & 3;
        u.aoff = ((size_t)u.pm * 256 * 1024 + (size_t)u.aux * 256) * 2; u.boff = ((size_t)u.pn * 256 * 1024 + (size_t)u.aux * 256) * 2; return true;
    }
};
struct MoeOrder {
    const volatile LAS int* tb; int G, c; size_t a_rowbytes, b_expbytes, b_tilebytes;
    __device__ bool next(int i, pg8::Unit& u) const {
        const int L = i * G + c; const int total = __builtin_amdgcn_readfirstlane(tb[32]) * 4; if (L >= total) return false;
        int e = 0;
#pragma unroll 1
        for (int k = 0; k < 32; ++k) if (L >= tb[k + 1] * 4) e = k + 1;
        const int nte = tb[e + 1] - tb[e]; const int r = L - tb[e] * 4; const int ct = r / nte, rt = r % nte;
        u.pm = __builtin_amdgcn_readfirstlane(tb[33 + e] + rt); u.pn = __builtin_amdgcn_readfirstlane(ct); u.aux = __builtin_amdgcn_readfirstlane(e);
        u.aoff = (size_t)u.pm * 256 * a_rowbytes; u.boff = (size_t)u.aux * b_expbytes + (size_t)u.pn * b_tilebytes; return true;
    }
};

constexpr int PTR_OFF = LDS_BYTES - 512;
__device__ __forceinline__ void ptr_table_fill(const Args& args, LAS unsigned char* lds) {
    if (threadIdx.x == 0) {
        volatile LAS unsigned long long* t = (volatile LAS unsigned long long*)(lds + PTR_OFF);
#define PT_(i) t[i] = (unsigned long long)args.in[i];
        PT_(0) PT_(1) PT_(2) PT_(3) PT_(4) PT_(5) PT_(6) PT_(7) PT_(8) PT_(9) PT_(10) PT_(11) PT_(12) PT_(13) PT_(14) PT_(15) PT_(16) PT_(17) PT_(18) PT_(19)
        PT_(20) PT_(21) PT_(22) PT_(23) PT_(24) PT_(25) PT_(26) PT_(27) PT_(28) PT_(29) PT_(30) PT_(31) PT_(32) PT_(33) PT_(34)
#undef PT_
        t[35] = (unsigned long long)args.out; t[36] = (unsigned long long)args.ws; t[37] = 0ull;
    }
    __syncthreads();
}
__device__ __forceinline__ unsigned long long ldptr(LAS unsigned char* lds, int i) {
    unsigned a = (unsigned)(PTR_OFF + 8 * i); asm volatile("" : "+v"(a));
    const volatile LAS unsigned* t = (const volatile LAS unsigned*)(lds + a);
    const unsigned lo = __builtin_amdgcn_readfirstlane(t[0]), hi = __builtin_amdgcn_readfirstlane(t[1]);
    return ((unsigned long long)hi << 32) | lo;
}
#define INP(i) ((const float*)ldptr(lds, (i)))
namespace rw {
typedef short bf16x8 __attribute__((ext_vector_type(8)));
typedef float f4 __attribute__((ext_vector_type(4)));
constexpr int LS = 72;
constexpr int MB = 64 * LS * 2;
constexpr int O_AHN = 0, O_RHN = MB, O_BCN = 2 * MB, O_KCN = 3 * MB, O_AHT = 4 * MB, O_BTT = 5 * MB, O_KTT = 6 * MB, O_VT = 7 * MB, O_STT = 8 * MB,
              O_MAK = 9 * MB, O_MRB = 10 * MB, O_MRK = 11 * MB, O_TINV = 12 * MB, O_MABF = 13 * MB, O_GAM = 13 * MB + 16384, O_CT = O_GAM + 256, O_BON = O_CT + 4608, O_END = O_BON + 256;
constexpr int O_MVT = O_BCN, O_A2N = O_AHN, O_UT = O_KCN, O_YF = O_AHT;
constexpr int O_TAB = O_MAK, O_SCR = O_TAB + 26624, O_TOT = O_SCR + 8 * 1024, O_CUM = O_TOT + 2048;
static_assert(O_CUM + 16384 <= O_GAM && O_END <= LDS_BYTES - 576, "rwkv LDS map");

__device__ __forceinline__ bf16x8 ldfrag(const LAS unsigned char* lds, int off, int r0, int ks, int lane) {
    return *(const LAS bf16x8*)(lds + off + ((r0 + (lane & 15)) * LS + ks * 32 + (lane >> 4) * 8) * 2);
}
__device__ __forceinline__ void mm64(f4 (&acc)[2], const LAS unsigned char* lds, int offA, int offBt, int w, int lane) {
    const int tr = w >> 1; const bf16x8 a0 = ldfrag(lds, offA, tr * 16, 0, lane), a1 = ldfrag(lds, offA, tr * 16, 1, lane);
#pragma unroll
    for (int c = 0; c < 2; ++c) { const int tc = (w & 1) * 2 + c; const bf16x8 b0 = ldfrag(lds, offBt, tc * 16, 0, lane), b1 = ldfrag(lds, offBt, tc * 16, 1, lane);
        acc[c] = __builtin_amdgcn_mfma_f32_16x16x32_bf16(a0, b0, acc[c], 0, 0, 0); acc[c] = __builtin_amdgcn_mfma_f32_16x16x32_bf16(a1, b1, acc[c], 0, 0, 0); }
}
__device__ __forceinline__ void storeT(LAS unsigned char* lds, int off, const f4 (&acc)[2], int w, int lane) {
#pragma unroll
    for (int c = 0; c < 2; ++c) { const int col = ((w & 1) * 2 + c) * 16 + (lane & 15), row = (w >> 1) * 16 + 4 * (lane >> 4);
        u32x2 v; v.x = pk2(acc[c][0], acc[c][1]); v.y = pk2(acc[c][2], acc[c][3]); *(LAS u32x2*)(lds + off + (col * LS + row) * 2) = v; }
}
template <int MASK  >
__device__ __forceinline__ void storeN(LAS unsigned char* lds, int off, const f4 (&acc)[2], int w, int lane) {
#pragma unroll
    for (int c = 0; c < 2; ++c) { const int col = ((w & 1) * 2 + c) * 16 + (lane & 15), row = (w >> 1) * 16 + 4 * (lane >> 4);
#pragma unroll
        for (int e = 0; e < 4; ++e) { float x = acc[c][e]; if (MASK == 1) x = (col < row + e) ? x : 0.f; if (MASK == 2) x = (col <= row + e) ? x : 0.f;
            *(LAS bf16*)(lds + off + ((row + e) * LS + col) * 2) = (bf16)f2bf(x); } }
}
#define RW_ZERO(a) do { a[0] = (f4){0.f, 0.f, 0.f, 0.f}; a[1] = (f4){0.f, 0.f, 0.f, 0.f}; } while (0)

__device__ __forceinline__ void build_ct(LAS unsigned char* lds0, const int l, const int h, const int lane, const int wave) {
    LAS unsigned char* const& lds = lds0; const int c = h * 64 + lane;
    const float* mu = INP(I_CMU) + (size_t)l * 896;
    if (wave == 0) { LAS float* ct = (LAS float*)(lds0 + O_CT);
        ct[0 * 64 + lane] = mu[c]; ct[1 * 64 + lane] = mu[256 + c]; ct[2 * 64 + lane] = mu[512 + c]; ct[3 * 64 + lane] = mu[768 + lane]; ct[4 * 64 + lane] = mu[832 + lane];
        ct[5 * 64 + lane] = INP(I_CW0)[l * 256 + c]; ct[6 * 64 + lane] = INP(I_CA0)[l * 256 + c]; ct[7 * 64 + lane] = INP(I_CKK)[l * 256 + c]; ct[8 * 64 + lane] = INP(I_CKA)[l * 256 + c];
        ct[9 * 64 + lane] = INP(I_CRK)[l * 256 + c]; ct[10 * 64 + lane] = INP(I_CGNW)[l * 256 + c]; ct[11 * 64 + lane] = INP(I_CGNB)[l * 256 + c]; ct[12 * 64 + lane] = l > 0 ? INP(I_CV0)[(l - 1) * 256 + c] : 0.f;
        ct[13 * 64 + lane] = mu[512 + lane]; ct[14 * 64 + lane] = mu[512 + lane + 64]; ct[15 * 64 + lane] = mu[512 + lane + 128]; ct[16 * 64 + lane] = mu[512 + lane + 192]; }
}
template <int MODE>
__device__ __forceinline__ void chunk(LAS unsigned char* lds0, const int l, const int b, const int h, const int t0, unsigned char* gz, const bf16* P, bf16* VF, bf16* OB, const int tid0) {
    const int c = h * 64 + (tid0 & 63);
    {
        unsigned lb_ = 0u; int tid_l = tid0; asm volatile("" : "+v"(lb_), "+v"(tid_l));
        const int tid = tid_l, lane = tid & 63, wave = __builtin_amdgcn_readfirstlane(tid >> 6);
        LAS unsigned char* lds = lds0 + lb_;
        LAS bf16* TAB = (LAS bf16*)(lds + O_TAB);
        LAS float* scr = (LAS float*)(lds + O_SCR + wave * 1024);
        LAS float* CUM = (LAS float*)(lds + O_CUM);
        LAS float* TOT = (LAS float*)(lds + O_TOT);
        LAS float* GAM = (LAS float*)(lds + O_GAM);
        LAS float* MABF = (LAS float*)(lds + O_MABF);
        LAS float* YF = (LAS float*)(lds + O_YF);
        LAS float* BON = (LAS float*)(lds + O_BON);
        const LAS float* CT = (const LAS float*)(lds + O_CT);
#define CTV(k) CT[(k) * 64 + lane]
        { const float* cw2 = INP(I_CW2) + (size_t)l * 32 * 256; const float* ca2 = INP(I_CA2) + (size_t)l * 32 * 256; const float* cg2 = INP(I_CG2) + (size_t)l * 64 * 256;
          float tw[4], ta[4], tg[8];
#pragma unroll
          for (int u = 0; u < 4; ++u) { const int i = tid + u * NTHR; tw[u] = cw2[(i >> 6) * 256 + h * 64 + (i & 63)]; ta[u] = ca2[(i >> 6) * 256 + h * 64 + (i & 63)]; }
#pragma unroll
          for (int u = 0; u < 8; ++u) { const int i = tid + u * NTHR; tg[u] = cg2[(i >> 6) * 256 + h * 64 + (i & 63)]; }
          float t2[2], t1[8];
          if (l > 0) { const float* cv1 = INP(I_CV1) + (size_t)(l - 1) * 256 * 16; const float* cv2 = INP(I_CV2) + (size_t)(l - 1) * 16 * 256;
#pragma unroll
            for (int u = 0; u < 2; ++u) { const int i = tid + u * NTHR; t2[u] = cv2[(i >> 6) * 256 + h * 64 + (i & 63)]; }
#pragma unroll
            for (int u = 0; u < 8; ++u) t1[u] = cv1[tid + u * NTHR]; }
#pragma unroll
          for (int u = 0; u < 4; ++u) { TAB[tid + u * NTHR] = (bf16)f2bf(tw[u]); TAB[2048 + tid + u * NTHR] = (bf16)f2bf(ta[u]); }
#pragma unroll
          for (int u = 0; u < 8; ++u) TAB[4096 + tid + u * NTHR] = (bf16)f2bf(tg[u]);
          if (l > 0) {
#pragma unroll
            for (int u = 0; u < 2; ++u) TAB[8192 + tid + u * NTHR] = (bf16)f2bf(t2[u]);
#pragma unroll
            for (int u = 0; u < 8; ++u) TAB[9216 + tid + u * NTHR] = (bf16)f2bf(t1[u]); } }
        if (MODE == 3) { const u32x4 sv = ((const u32x4*)gz)[tid]; *(LAS u32x4*)(lds + O_STT + ((tid >> 3) * LS + (tid & 7) * 8) * 2) = sv; }
        float Xr[9];
#pragma unroll
        for (int j = 0; j < 9; ++j) { const int t = t0 + wave * 8 - 1 + j; Xr[j] = t >= 0 ? bf2f(P[((size_t)b * T + t) * PP + C_C + 768 + lane]) : 0.f; }
        __syncthreads();
        { float run = 0.f;
#pragma unroll
            for (int q = 0; q < 8; ++q) {
                const float xx = Xr[q + 1] + (Xr[q] - Xr[q + 1]) * CTV(3);
                scr[lane] = tanhf(xx);
                asm volatile("s_waitcnt lgkmcnt(0)" ::: "memory");
                float wsum = CTV(5);
#pragma unroll 8
                for (int mm = 0; mm < 32; ++mm) wsum += scr[mm] * bf2f(TAB[mm * 64 + lane]);
                run += -__expf(-softplusf_(-wsum) - 0.5f); CUM[(wave * 8 + q) * 64 + lane] = run;
                asm volatile("s_waitcnt lgkmcnt(0)" ::: "memory");
            }
            TOT[wave * 64 + lane] = run; }
        __syncthreads();
        float offs = 0.f, cumL = 0.f;
#pragma unroll
        for (int w2 = 0; w2 < 8; ++w2) { const float tw = TOT[w2 * 64 + lane]; offs += (w2 < wave) ? tw : 0.f; cumL += tw; }
        if (wave == 0) GAM[lane] = __expf(cumL);
#define LO_(x) __uint_as_float((x) << 16)
#define HI_(x) __uint_as_float((x) & 0xffff0000u)
#define RAW_LOAD(rk, vx, gg, v4a, v4b, vfv, tok) do { const int t_ = (tok); const bool ok_ = t_ >= 0; const size_t m_ = (size_t)b * T + (ok_ ? t_ : 0); const bf16* row_ = P + m_ * PP + C_C; \
            rk = ok_ ? ((unsigned)row_[c] | ((unsigned)row_[256 + c] << 16)) : 0u; vx = ok_ ? ((unsigned)row_[512 + c] | ((unsigned)row_[768 + lane] << 16)) : 0u; gg = ok_ ? (unsigned)row_[832 + lane] : 0u; \
            if (l > 0) { v4a = ok_ ? ((unsigned)row_[512 + lane] | ((unsigned)row_[512 + lane + 64] << 16)) : 0u; v4b = ok_ ? ((unsigned)row_[512 + lane + 128] | ((unsigned)row_[512 + lane + 192] << 16)) : 0u; vfv = (unsigned)VF[m_ * 256 + c]; } } while (0)
        unsigned pRK, pVX, pGG, pVa = 0u, pVb = 0u, pVF = 0u, cRK, cVX, cGG, cVa = 0u, cVb = 0u, cVF = 0u;
        RAW_LOAD(pRK, pVX, pGG, pVa, pVb, pVF, t0 + wave * 8 - 1); RAW_LOAD(cRK, cVX, cGG, cVa, cVb, cVF, t0 + wave * 8);
#pragma unroll 1
        for (int q = 0; q < 8; ++q) {
            const int tt = wave * 8 + q; const size_t m = (size_t)b * T + t0 + tt;
            unsigned nRK, nVX, nGG, nVa = 0u, nVb = 0u, nVF = 0u;
            RAW_LOAD(nRK, nVX, nGG, nVa, nVb, nVF, (q < 7) ? (t0 + tt + 1) : (t0 + tt));
            const float r = LO_(cRK) + (LO_(pRK) - LO_(cRK)) * CTV(0), k = HI_(cRK) + (HI_(pRK) - HI_(cRK)) * CTV(1); float v = LO_(cVX) + (LO_(pVX) - LO_(cVX)) * CTV(2);
            const float xx = HI_(cVX) + (HI_(pVX) - HI_(cVX)) * CTV(3), xg = LO_(cGG) + (LO_(pGG) - LO_(cGG)) * CTV(4);
            scr[lane] = lane < 32 ? tanhf(xx) : xx; scr[64 + lane] = sigmoidf_(xg);
            LAS bf16* vsc = (LAS bf16*)(scr + 128);
            if (l > 0) {
                vsc[lane] = (bf16)f2bf(LO_(cVa) + (LO_(pVa) - LO_(cVa)) * CTV(13)); vsc[lane + 64] = (bf16)f2bf(HI_(cVa) + (HI_(pVa) - HI_(cVa)) * CTV(14));
                vsc[lane + 128] = (bf16)f2bf(LO_(cVb) + (LO_(pVb) - LO_(cVb)) * CTV(15)); vsc[lane + 192] = (bf16)f2bf(HI_(cVb) + (HI_(pVb) - HI_(cVb)) * CTV(16));
            }
            asm volatile("s_waitcnt lgkmcnt(0)" ::: "memory");
            float wsum = CTV(5), asum = CTV(6), gsum = 0.f;
#pragma unroll 8
            for (int mm = 0; mm < 32; ++mm) { wsum += scr[mm] * bf2f(TAB[mm * 64 + lane]); asum += scr[32 + mm] * bf2f(TAB[2048 + mm * 64 + lane]); }
#pragma unroll 8
            for (int mm = 0; mm < 64; ++mm) gsum += scr[64 + mm] * bf2f(TAB[4096 + mm * 64 + lane]);
            if (l > 0) {
                const int qq = lane & 15, part = lane >> 4; float s = 0.f;
#pragma unroll 8
                for (int cc = 0; cc < 64; ++cc) s += bf2f(vsc[part * 64 + cc]) * bf2f(TAB[9216 + (part * 64 + cc) * 16 + qq]);
                s += __shfl_xor(s, 16); s += __shfl_xor(s, 32);
                float vl = CTV(12);
#pragma unroll
                for (int q2 = 0; q2 < 16; ++q2) vl += __shfl(s, q2) * bf2f(TAB[8192 + q2 * 64 + lane]);
                const float vf = LO_(cVF); v = v + (vf - v) * sigmoidf_(vl);
            } else if (MODE == 3) VF[m * 256 + c] = (bf16)f2bf(v);
            const float wlog = -softplusf_(-wsum) - 0.5f, asig = sigmoidf_(asum), lw = -__expf(wlog);
            float kk = k * CTV(7); const float n2 = wave_sum(kk * kk); kk = kk / fmaxf(sqrtf(n2), 1e-12f);
            const float kmod = k * (1.f + (asig - 1.f) * CTV(8));
            const float bon = wave_sum(r * kmod * CTV(9));
            const float cum = offs + CUM[tt * 64 + lane], cumx = cum - lw;
            const float ah = -kk * __expf(cumx), rh = r * __expf(cum), ei = __expf(-cum), bb = kk * asig, bc = bb * ei, kc = kmod * ei, ee = __expf(cumL - cum), bt = bb * ee, kt = kmod * ee;
            const int no = (tt * LS + lane) * 2, to = (lane * LS + tt) * 2;
            *(LAS bf16*)(lds + O_AHN + no) = (bf16)f2bf(ah); *(LAS bf16*)(lds + O_RHN + no) = (bf16)f2bf(rh);
            *(LAS bf16*)(lds + O_BCN + no) = (bf16)f2bf(bc); *(LAS bf16*)(lds + O_KCN + no) = (bf16)f2bf(kc); if (MODE == 3) OB[m * 1024 + 512 + c] = (bf16)f2bf(gsum);
            *(LAS bf16*)(lds + O_AHT + to) = (bf16)f2bf(ah); *(LAS bf16*)(lds + O_BTT + to) = (bf16)f2bf(bt);
            *(LAS bf16*)(lds + O_KTT + to) = (bf16)f2bf(kt); *(LAS bf16*)(lds + O_VT + to) = (bf16)f2bf(v);
            if (MODE == 3 && lane == 0) BON[tt] = bon;
            asm volatile("s_waitcnt lgkmcnt(0)" ::: "memory");
            pRK = cRK; pVX = cVX; pGG = cGG; pVa = cVa; pVb = cVb; cRK = nRK; cVX = nVX; cGG = nGG; cVa = nVa; cVb = nVb; cVF = nVF;
        }
#undef RAW_LOAD
        __syncthreads();
        { f4 acc[2];
            RW_ZERO(acc); mm64(acc, lds, O_AHN, O_BCN, wave, lane);
#pragma unroll
            for (int cI = 0; cI < 2; ++cI) { const int col = ((wave & 1) * 2 + cI) * 16 + (lane & 15), row = (wave >> 1) * 16 + 4 * (lane >> 4);
#pragma unroll
                for (int e = 0; e < 4; ++e) MABF[(row + e) * 64 + col] = (col < row + e) ? acc[cI][e] : 0.f; }
            RW_ZERO(acc); mm64(acc, lds, O_AHN, O_KCN, wave, lane); storeN<1>(lds, O_MAK, acc, wave, lane);
            if (MODE == 3) { f4 accb[2]; RW_ZERO(accb); mm64(accb, lds, O_RHN, O_BCN, wave, lane); f4 accc[2]; RW_ZERO(accc); mm64(accc, lds, O_RHN, O_KCN, wave, lane);
                storeN<2>(lds, O_MRB, accb, wave, lane); storeN<2>(lds, O_MRK, accc, wave, lane); }
        }
        __syncthreads();
        if (wave == 0) {
            float x[64]; x[0] = 0.f;
#pragma unroll
            for (int i = 1; i < 64; ++i) { float s = MABF[i * 64 + lane];
#pragma unroll
                for (int j4 = 0; j4 < (i + 3) / 4; ++j4) { const f4 m4 = *(const LAS f4*)(MABF + i * 64 + j4 * 4);
#pragma unroll
                    for (int e = 0; e < 4; ++e) if (j4 * 4 + e < i && j4 * 4 + e >= 1) s += m4[e] * x[j4 * 4 + e]; }
                x[i] = s; }
#pragma unroll
            for (int i = 0; i < 64; ++i) *(LAS bf16*)(lds + O_TINV + (i * LS + lane) * 2) = (bf16)f2bf(x[i]);
            asm volatile("s_waitcnt lgkmcnt(0)" ::: "memory");
            *(LAS bf16*)(lds + O_TINV + (lane * LS + lane) * 2) = (bf16)0x3F80;
        }
        __syncthreads();
        { f4 acc[2]; RW_ZERO(acc); mm64(acc, lds, O_MAK, O_VT, wave, lane); storeT(lds, O_MVT, acc, wave, lane); }
        __syncthreads();
        if (MODE == 1) {
            { f4 acc[2]; RW_ZERO(acc); mm64(acc, lds, O_TINV, O_AHT, wave, lane); storeT(lds, O_UT, acc, wave, lane); }
            { f4 acc[2]; RW_ZERO(acc); mm64(acc, lds, O_TINV, O_MVT, wave, lane); storeT(lds, O_MAK, acc, wave, lane); }
            __syncthreads();
            { f4 acc[2]; RW_ZERO(acc); mm64(acc, lds, O_BTT, O_UT, wave, lane);
#pragma unroll
              for (int cI = 0; cI < 2; ++cI) { const int col = ((wave & 1) * 2 + cI) * 16 + (lane & 15), row = (wave >> 1) * 16 + 4 * (lane >> 4);
#pragma unroll
                  for (int e = 0; e < 4; ++e) if (col == row + e) acc[cI][e] += GAM[col]; }
              storeN<0>(lds, O_AHN, acc, wave, lane); }
            { f4 acc[2]; RW_ZERO(acc); mm64(acc, lds, O_BTT, O_MAK, wave, lane); mm64(acc, lds, O_KTT, O_VT, wave, lane); storeT(lds, O_RHN, acc, wave, lane); }
            __syncthreads();
            ((u32x4*)gz)[tid] = *(const LAS u32x4*)(lds + O_AHN + ((tid >> 3) * LS + (tid & 7) * 8) * 2);
            ((u32x4*)(gz + 8192))[tid] = *(const LAS u32x4*)(lds + O_RHN + ((tid >> 3) * LS + (tid & 7) * 8) * 2);
        } else {
            { f4 acc[2]; RW_ZERO(acc); mm64(acc, lds, O_TINV, O_AHT, wave, lane); storeN<0>(lds, O_A2N, acc, wave, lane); }
            __syncthreads();
            { f4 acc[2]; RW_ZERO(acc); mm64(acc, lds, O_TINV, O_MVT, wave, lane); mm64(acc, lds, O_A2N, O_STT, wave, lane); storeT(lds, O_UT, acc, wave, lane); }
            __syncthreads();
            f4 yacc[2]; RW_ZERO(yacc);
            mm64(yacc, lds, O_RHN, O_STT, wave, lane); mm64(yacc, lds, O_MRB, O_UT, wave, lane); mm64(yacc, lds, O_MRK, O_VT, wave, lane);
            __syncthreads();
#pragma unroll
            for (int cI = 0; cI < 2; ++cI) { const int col = ((wave & 1) * 2 + cI) * 16 + (lane & 15), row = (wave >> 1) * 16 + 4 * (lane >> 4);
#pragma unroll
                for (int e = 0; e < 4; ++e) YF[(row + e) * 64 + col] = yacc[cI][e]; }
            __syncthreads();
            { unsigned gcur = (unsigned)OB[((size_t)b * T + t0 + wave * 8) * 1024 + 512 + c];
#pragma unroll 1
            for (int q = 0; q < 8; ++q) {
                const int tt = wave * 8 + q; const size_t m = (size_t)b * T + t0 + tt;
                const unsigned gnxt = (unsigned)OB[(m + (q < 7 ? 1 : 0)) * 1024 + 512 + c];
                const float y = YF[tt * 64 + lane]; const float mean = wave_sum(y) * (1.f / 64.f); const float dy = y - mean; const float var = wave_sum(dy * dy) * (1.f / 64.f);
                const float yn = dy * rsqrtf(var + 64e-5f) * CTV(10) + CTV(11);
                const float vv = bf2f(*(const LAS bf16*)(lds + O_VT + (lane * LS + tt) * 2)), gg = LO_(gcur);
                OB[m * 1024 + 512 + c] = (bf16)f2bf((yn + BON[tt] * vv) * gg);
                gcur = gnxt;
            } }
        }
        __syncthreads();
#undef CTV
#undef LO_
#undef HI_
    }
}

__device__ __forceinline__ void carry(LAS unsigned char* lds0, unsigned char* gzc  , const int tid0) {
    f4 stacc[2]; RW_ZERO(stacc);
    { unsigned lb_ = 0u; asm volatile("" : "+v"(lb_)); LAS unsigned char* lds = lds0 + lb_; for (int i = tid0; i < MB / 4; i += NTHR) ((LAS unsigned*)(lds + O_STT))[i] = 0u; }
    u32x4 gnx = ((const u32x4*)gzc)[tid0];
#pragma unroll 1
    for (int cI = 0; cI < T / 64; ++cI) {
        unsigned lb_ = 0u; int tid_l = tid0; asm volatile("" : "+v"(lb_), "+v"(tid_l));
        LAS unsigned char* lds = lds0 + lb_; const int tid = tid_l, lane = tid & 63, wave = __builtin_amdgcn_readfirstlane(tid >> 6);
        unsigned char* rec = gzc + (size_t)cI * 16384;
        const int io = ((tid >> 3) * LS + (tid & 7) * 8) * 2;
        *(LAS u32x4*)(lds + O_AHN + io) = gnx;
        u32x2 zv[2];
#pragma unroll
        for (int k = 0; k < 2; ++k) { const int col = ((wave & 1) * 2 + k) * 16 + (lane & 15), row = (wave >> 1) * 16 + 4 * (lane >> 4); zv[k] = *(const u32x2*)(rec + 8192 + (col * 64 + row) * 2); }
        if (cI + 1 < T / 64) gnx = ((const u32x4*)(rec + 16384))[tid];
        __syncthreads();
        ((u32x4*)rec)[tid] = *(const LAS u32x4*)(lds + O_STT + io);
        f4 acc[2];
#pragma unroll
        for (int k = 0; k < 2; ++k) acc[k] = (f4){__uint_as_float(zv[k].x << 16), __uint_as_float(zv[k].x & 0xffff0000u), __uint_as_float(zv[k].y << 16), __uint_as_float(zv[k].y & 0xffff0000u)};
        mm64(acc, lds, O_AHN, O_STT, wave, lane);
        __syncthreads();
        storeT(lds, O_STT, acc, wave, lane);
    }
}
}

namespace mb {
using rw::LS; using rw::MB; using rw::f4; using rw::mm64; using rw::storeN; using rw::bf16x8;
constexpr int O_CN = 0, O_BN = MB, O_BT = 2 * MB, O_XT0 = 3 * MB, O_XW0 = 5 * MB, O_CS0 = 7 * MB, O_HN0 = 9 * MB, O_SC0 = 11 * MB, O_SM = 13 * MB, O_YF = O_XW0;
static_assert(O_SM + 2048 <= LDS_BYTES - 576, "mamba LDS map");
__device__ __forceinline__ void chain(LAS unsigned char* lds0, const int l, const int b, const int gI, const bf16* P, bf16* OB, const int tid0, const int lane0, const int wave0) {
    const int tid = tid0, lane = lane0, wave = wave0;
    LAS unsigned char* const& lds = lds0;
    const float* cwp = INP(I_DCW) + (size_t)l * 4 * 512; const float* cbp = INP(I_DCB) + (size_t)l * 512;
    const int cc = tid & 255, sub = tid >> 8;
    const int col = cc < 128 ? (gI * 128 + cc) : (cc < 192 ? (256 + gI * 64 + (cc - 128)) : (384 + gI * 64 + (cc - 192)));
    const float cw0 = cwp[col], cw1 = cwp[512 + col], cw2 = cwp[1024 + col], cw3 = cwp[1536 + col], cb = cbp[col];
    f4 hacc[2][2];
#pragma unroll
    for (int hh = 0; hh < 2; ++hh) { hacc[hh][0] = (f4){0.f, 0.f, 0.f, 0.f}; hacc[hh][1] = (f4){0.f, 0.f, 0.f, 0.f}; }
    for (int i = tid; i < 2 * MB / 4; i += NTHR) ((LAS unsigned*)(lds0 + O_HN0))[i] = 0u;
    const float dtb0 = INP(I_DDTB)[l * 4 + gI * 2], dtb1 = INP(I_DDTB)[l * 4 + gI * 2 + 1];
    const float nA0 = -__expf(INP(I_DALOG)[l * 4 + gI * 2]), nA1 = -__expf(INP(I_DALOG)[l * 4 + gI * 2 + 1]);
    const float dsk0 = INP(I_DSKIP)[l * 4 + gI * 2], dsk1 = INP(I_DSKIP)[l * 4 + gI * 2 + 1];
    const float nw0 = INP(I_DNW)[l * 256 + gI * 128 + lane], nw1 = INP(I_DNW)[l * 256 + gI * 128 + 64 + lane];
#pragma unroll 1
    for (int t0 = 0; t0 < T; t0 += 64) {
        unsigned lb_ = 0u; int tid_l = tid0; asm volatile("" : "+v"(lb_), "+v"(tid_l));
        const int tid = tid_l, lane = tid & 63, wave = __builtin_amdgcn_readfirstlane(tid >> 6);
        LAS unsigned char* lds = lds0 + lb_;
        LAS float* SM = (LAS float*)(lds + O_SM);
        LAS float* YF = (LAS float*)(lds + O_YF);
        if (wave < 2) {
            const size_t m = (size_t)b * T + t0 + lane;
            const float dt = softplusf_(bf2f(P[m * PP + C_DT + gI * 2 + wave]) + (wave == 0 ? dtb0 : dtb1));
            float cs = dt * (wave == 0 ? nA0 : nA1);
#pragma unroll
            for (int o = 1; o < 64; o <<= 1) { const float y = __shfl_up(cs, o); if (lane >= o) cs += y; }
            const float cL = __shfl(cs, 63);
            SM[wave * 64 + lane] = dt; SM[128 + wave * 64 + lane] = cs; SM[256 + wave * 64 + lane] = __expf(cL - cs) * dt; SM[384 + wave * 64 + lane] = __expf(cs);
        }
        __syncthreads();
        { float h0, h1, h2, cur[8], nxt[8];
          { const int tb = t0 + sub * 32; h0 = tb >= 3 ? bf2f(P[((size_t)b * T + tb - 3) * PP + C_DX + col]) : 0.f; h1 = tb >= 2 ? bf2f(P[((size_t)b * T + tb - 2) * PP + C_DX + col]) : 0.f; h2 = tb >= 1 ? bf2f(P[((size_t)b * T + tb - 1) * PP + C_DX + col]) : 0.f;
#pragma unroll
            for (int j = 0; j < 8; ++j) cur[j] = bf2f(P[((size_t)b * T + tb + j) * PP + C_DX + col]); }
#pragma unroll 1
          for (int g8 = 0; g8 < 4; ++g8) {
            const int tb = t0 + sub * 32 + g8 * 8 + (g8 < 3 ? 8 : 0);
#pragma unroll
            for (int j = 0; j < 8; ++j) nxt[j] = bf2f(P[((size_t)b * T + tb + j) * PP + C_DX + col]);
#pragma unroll
            for (int j = 0; j < 8; ++j) {
                const int tt = sub * 32 + g8 * 8 + j;
                const float a = siluf_(cb + cw3 * cur[j] + cw2 * h2 + cw1 * h1 + cw0 * h0);
                h0 = h1; h1 = h2; h2 = cur[j];
                if (cc < 128) { const int hh = cc >> 6, p = cc & 63;
                    *(LAS bf16*)(lds + O_XT0 + hh * MB + (p * LS + tt) * 2) = (bf16)f2bf(a); *(LAS bf16*)(lds + O_XW0 + hh * MB + (p * LS + tt) * 2) = (bf16)f2bf(a * SM[256 + hh * 64 + tt]); }
                else if (cc < 192) { const int n = cc - 128; *(LAS bf16*)(lds + O_BN + (tt * LS + n) * 2) = (bf16)f2bf(a); *(LAS bf16*)(lds + O_BT + (n * LS + tt) * 2) = (bf16)f2bf(a); }
                else { const int n = cc - 192; *(LAS bf16*)(lds + O_CN + (tt * LS + n) * 2) = (bf16)f2bf(a);
                    *(LAS bf16*)(lds + O_CS0 + (tt * LS + n) * 2) = (bf16)f2bf(a * SM[384 + tt]); *(LAS bf16*)(lds + O_CS0 + MB + (tt * LS + n) * 2) = (bf16)f2bf(a * SM[384 + 64 + tt]); }
            }
#pragma unroll
            for (int j = 0; j < 8; ++j) cur[j] = nxt[j];
          } }
        __syncthreads();
        { f4 acc[2]; acc[0] = (f4){0.f, 0.f, 0.f, 0.f}; acc[1] = (f4){0.f, 0.f, 0.f, 0.f}; mm64(acc, lds, O_CN, O_BN, wave, lane);
#pragma unroll
            for (int hh = 0; hh < 2; ++hh) { f4 sc[2];
#pragma unroll
                for (int cI = 0; cI < 2; ++cI) { const int s = ((wave & 1) * 2 + cI) * 16 + (lane & 15), row = (wave >> 1) * 16 + 4 * (lane >> 4);
                    const float cs = SM[128 + hh * 64 + s], ds = SM[hh * 64 + s];
#pragma unroll
                    for (int e = 0; e < 4; ++e) { const float ct = SM[128 + hh * 64 + row + e]; sc[cI][e] = (s <= row + e) ? acc[cI][e] * __expf(ct - cs) * ds : 0.f; } }
                storeN<0>(lds, O_SC0 + hh * MB, sc, wave, lane); } }
        __syncthreads();
        f4 yacc[2][2];
#pragma unroll
        for (int hh = 0; hh < 2; ++hh) {
            yacc[hh][0] = (f4){0.f, 0.f, 0.f, 0.f}; yacc[hh][1] = (f4){0.f, 0.f, 0.f, 0.f};
            mm64(yacc[hh], lds, O_SC0 + hh * MB, O_XT0 + hh * MB, wave, lane); mm64(yacc[hh], lds, O_CS0 + hh * MB, O_HN0 + hh * MB, wave, lane);
            const float gL = SM[384 + hh * 64 + 63]; hacc[hh][0] = hacc[hh][0] * gL; hacc[hh][1] = hacc[hh][1] * gL;
            mm64(hacc[hh], lds, O_XW0 + hh * MB, O_BT, wave, lane);
        }
        __syncthreads();
#pragma unroll
        for (int hh = 0; hh < 2; ++hh) {
#pragma unroll
            for (int cI = 0; cI < 2; ++cI) { const int colp = ((wave & 1) * 2 + cI) * 16 + (lane & 15), row = (wave >> 1) * 16 + 4 * (lane >> 4);
#pragma unroll
                for (int e = 0; e < 4; ++e) YF[(row + e) * 128 + hh * 64 + colp] = yacc[hh][cI][e]; }
            storeN<0>(lds, O_HN0 + hh * MB, hacc[hh], wave, lane);
        }
        __syncthreads();
#pragma unroll
        for (int q = 0; q < 8; ++q) {
            const int tt = wave * 8 + q; const size_t m = (size_t)b * T + t0 + tt;
            const float x0 = bf2f(*(const LAS bf16*)(lds + O_XT0 + (lane * LS + tt) * 2)), x1 = bf2f(*(const LAS bf16*)(lds + O_XT0 + MB + (lane * LS + tt) * 2));
            const int c0 = gI * 128 + lane, c1 = c0 + 64;
            const float z0 = bf2f(P[m * PP + C_DZ + c0]), z1 = bf2f(P[m * PP + C_DZ + c1]);
            const float y0 = (YF[tt * 128 + lane] + dsk0 * x0) * siluf_(z0), y1 = (YF[tt * 128 + 64 + lane] + dsk1 * x1) * siluf_(z1);
            const float ss = wave_sum(y0 * y0 + y1 * y1); const float rs = rsqrtf(ss * (1.f / 128.f) + 1e-5f);
            OB[m * 1024 + 768 + c0] = (bf16)f2bf(y0 * rs * nw0); OB[m * 1024 + 768 + c1] = (bf16)f2bf(y1 * rs * nw1);
        }
        __syncthreads();
    }
}
}

namespace bsp {
typedef short bf16x8 __attribute__((ext_vector_type(8)));
typedef float f4 __attribute__((ext_vector_type(4)));
constexpr int HS = 129;
constexpr int O_HIST = 0;
constexpr int O_V = 66048;
constexpr int VS = 264;
constexpr int O_FLAG = O_V + 32 * VS * 2;
__device__ __forceinline__ unsigned okey(float s) { const unsigned u = __float_as_uint(s); return (u & 0x80000000u) ? ~u : (u | 0x80000000u); }

__device__ __forceinline__ f4 idx_tile(const bf16* Pb, const int kt, const bf16x8 (&qi)[4][2], const float (&wq)[4], const int lane) {
    const bf16* kr = Pb + (size_t)(kt * 16 + (lane & 15)) * PP + C_IK + (lane >> 4) * 8;
    const bf16x8 a0 = *(const bf16x8*)kr, a1 = *(const bf16x8*)(kr + 32);
    f4 s = (f4){0.f, 0.f, 0.f, 0.f};
#pragma unroll
    for (int h = 0; h < 4; ++h) { f4 t = (f4){0.f, 0.f, 0.f, 0.f};
        t = __builtin_amdgcn_mfma_f32_16x16x32_bf16(a0, qi[h][0], t, 0, 0, 0); t = __builtin_amdgcn_mfma_f32_16x16x32_bf16(a1, qi[h][1], t, 0, 0, 0);
#pragma unroll
        for (int e = 0; e < 4; ++e) s[e] += wq[h] * fmaxf(t[e], 0.f); }
    return s;
}

__device__ __forceinline__ void item(LAS unsigned char* lds0, const int bb, const int qb, const bf16* P, bf16* OB, const int tid0) {
    unsigned lb_ = 0u; int tid_l = tid0; asm volatile("" : "+v"(lb_), "+v"(tid_l));
    LAS unsigned char* lds = lds0 + lb_; const int tid = tid_l, lane = tid & 63, wave = __builtin_amdgcn_readfirstlane(tid >> 6);
    const bf16* Pb = P + (size_t)bb * T * PP;
    const int ql = wave * 16 + (lane & 15), tq = qb * 128 + ql, g = lane >> 4;
    const bf16* prow = Pb + (size_t)tq * PP;
    bf16x8 qi[4][2]; float wq[4];
#pragma unroll
    for (int h = 0; h < 4; ++h) { qi[h][0] = *(const bf16x8*)(prow + C_IQ + h * 64 + g * 8); qi[h][1] = *(const bf16x8*)(prow + C_IQ + h * 64 + 32 + g * 8); wq[h] = bf2f(prow[C_IW + h]) * 0.0625f; }
    LAS unsigned* hist = (LAS unsigned*)(lds + O_HIST) + ql * HS;
    const int nkt = (qb + 1) * 8;
    unsigned prefix = 0u; int needk = 256;
    const bool all_sel = (qb == 0) || false;
#pragma unroll 1
    for (int pass = 0; pass < 3; ++pass) {
        for (int i = lane; i < 16 * HS; i += 64) ((LAS unsigned*)(lds + O_HIST) + wave * 16 * HS)[i] = 0u;
        asm volatile("s_waitcnt lgkmcnt(0)" ::: "memory");
        const int shp = 32 - 8 * pass, shb = 24 - 8 * pass;
#pragma unroll 2
        for (int kt = 0; kt < nkt; ++kt) {
            const f4 s = idx_tile(Pb, kt, qi, wq, lane);
#pragma unroll
            for (int e = 0; e < 4; ++e) { const int key = kt * 16 + 4 * g + e; const unsigned k32 = okey(s[e]);
                const bool in = key <= tq && (pass == 0 || (k32 >> shp) == prefix);
                if (in) { const unsigned bin = (k32 >> shb) & 255u; __hip_atomic_fetch_add(hist + (bin >> 1), (bin & 1u) ? 0x10000u : 1u, __ATOMIC_RELAXED, __HIP_MEMORY_SCOPE_WORKGROUP); } }
        }
        asm volatile("s_waitcnt lgkmcnt(0)" ::: "memory");
        int cum = 0; unsigned bsel = 0u; int above = 0;
        for (int wd = 127; wd >= 0; --wd) { const unsigned v = hist[wd]; const int hi = (int)(v >> 16), lo = (int)(v & 0xffffu);
            if (cum + hi >= needk) { bsel = (unsigned)(2 * wd + 1); above = cum; break; } cum += hi;
            if (cum + lo >= needk) { bsel = (unsigned)(2 * wd); above = cum; break; } cum += lo; }
        prefix = (prefix << 8) | bsel; needk -= above;
        asm volatile("s_waitcnt lgkmcnt(0)" ::: "memory");
    }
    unsigned thr = prefix; int cidx = 1 << 20;
    bool tie = false;
    if (tq < 256) thr = 0u;
    else { const unsigned v = hist[(prefix & 255u) >> 1]; const int ceq = (prefix & 1u) ? (int)(v >> 16) : (int)(v & 0xffffu); tie = needk < ceq; }
    if (__any(tie)) {
        int cbin = 0, rem = needk;
#pragma unroll 1
        for (int ip = 0; ip < 2; ++ip) {
            for (int i = g; i < HS; i += 4) hist[i] = 0u;
            asm volatile("s_waitcnt lgkmcnt(0)" ::: "memory");
#pragma unroll 1
            for (int kt = 0; kt < nkt; ++kt) {
                const f4 s = idx_tile(Pb, kt, qi, wq, lane);
#pragma unroll
                for (int e = 0; e < 4; ++e) { const int key = kt * 16 + 4 * g + e; const unsigned k32 = okey(s[e]);
                    const bool in = tie && key <= tq && (k32 >> 8) == prefix && (ip == 0 || (key >> 4) == cbin);
                    if (in) { const unsigned bin = ip == 0 ? (unsigned)(key >> 4) : (unsigned)(key & 15); __hip_atomic_fetch_add(hist + (bin >> 1), (bin & 1u) ? 0x10000u : 1u, __ATOMIC_RELAXED, __HIP_MEMORY_SCOPE_WORKGROUP); } }
            }
            asm volatile("s_waitcnt lgkmcnt(0)" ::: "memory");
            int cum = 0, bs = 0, below = 0;
            for (int wd = 0; wd < 128; ++wd) { const unsigned vv = hist[wd]; const int lo = (int)(vv & 0xffffu), hi = (int)(vv >> 16);
                if (cum + lo >= rem) { bs = 2 * wd; below = cum; break; } cum += lo;
                if (cum + hi >= rem) { bs = 2 * wd + 1; below = cum; break; } cum += hi; }
            if (ip == 0) { cbin = bs; rem -= below; } else if (tie) cidx = cbin * 16 + bs;
            asm volatile("s_waitcnt lgkmcnt(0)" ::: "memory");
        }
    }
    (void)all_sel;
    __syncthreads();
    bf16x8 qa[4][2];
#pragma unroll
    for (int h = 0; h < 4; ++h) { qa[h][0] = *(const bf16x8*)(prow + C_BQ + h * 64 + g * 8); qa[h][1] = *(const bf16x8*)(prow + C_BQ + h * 64 + 32 + g * 8); }
    f4 oacc[4][4]; float mrun[4], lrun[4];
#pragma unroll
    for (int h = 0; h < 4; ++h) { mrun[h] = -INFINITY; lrun[h] = 0.f;
#pragma unroll
        for (int dt = 0; dt < 4; ++dt) oacc[h][dt] = (f4){0.f, 0.f, 0.f, 0.f}; }
    LAS bf16* VL = (LAS bf16*)(lds + O_V);
    const int nst = (qb + 1) * 4;
    const int vkey = tid >> 4, vch = tid & 15;
    u32x4 vpre0 = *(const u32x4*)(Pb + (size_t)vkey * PP + C_BV + vch * 8), vpre1 = *(const u32x4*)(Pb + (size_t)vkey * PP + C_BV + 128 + vch * 8);
#pragma unroll 1
    for (int st = 0; st < nst; ++st) {
        const int key0 = st * 32;
        __syncthreads();
        *(LAS u32x4*)(VL + vkey * VS + vch * 8) = vpre0; *(LAS u32x4*)(VL + vkey * VS + 128 + vch * 8) = vpre1;
        if (st + 1 < nst) { vpre0 = *(const u32x4*)(Pb + (size_t)(key0 + 32 + vkey) * PP + C_BV + vch * 8); vpre1 = *(const u32x4*)(Pb + (size_t)(key0 + 32 + vkey) * PP + C_BV + 128 + vch * 8); }
        __syncthreads();
        bool sel[2][4];
#pragma unroll
        for (int k2 = 0; k2 < 2; ++k2) { const f4 s = idx_tile(Pb, st * 2 + k2, qi, wq, lane);
#pragma unroll
            for (int e = 0; e < 4; ++e) { const int key = key0 + k2 * 16 + 4 * g + e; const unsigned k24 = okey(s[e]) >> 8;
                sel[k2][e] = key <= tq && (k24 > thr || (k24 == thr && key <= cidx)); } }
#pragma unroll
        for (int h = 0; h < 4; ++h) {
            f4 sc[2];
#pragma unroll
            for (int k2 = 0; k2 < 2; ++k2) { const bf16* kr = Pb + (size_t)(key0 + k2 * 16 + (lane & 15)) * PP + C_BK + h * 64 + g * 8;
                const bf16x8 a0 = *(const bf16x8*)kr, a1 = *(const bf16x8*)(kr + 32);
                f4 t = (f4){0.f, 0.f, 0.f, 0.f};
                t = __builtin_amdgcn_mfma_f32_16x16x32_bf16(a0, qa[h][0], t, 0, 0, 0); t = __builtin_amdgcn_mfma_f32_16x16x32_bf16(a1, qa[h][1], t, 0, 0, 0);
#pragma unroll
                for (int e = 0; e < 4; ++e) sc[k2][e] = sel[k2][e] ? t[e] * 0.125f : -INFINITY; }
            float mx = fmaxf(fmaxf(fmaxf(sc[0][0], sc[0][1]), fmaxf(sc[0][2], sc[0][3])), fmaxf(fmaxf(sc[1][0], sc[1][1]), fmaxf(sc[1][2], sc[1][3])));
            mx = fmaxf(mx, __shfl_xor(mx, 16)); mx = fmaxf(mx, __shfl_xor(mx, 32));
            const float mnew = fmaxf(mrun[h], mx), msafe = (mnew == -INFINITY) ? 0.f : mnew;
            const float corr = __expf(mrun[h] - msafe); mrun[h] = mnew;
            float p[8]; float ps = 0.f;
#pragma unroll
            for (int e = 0; e < 4; ++e) { p[e] = __expf(sc[0][e] - msafe); p[4 + e] = __expf(sc[1][e] - msafe); ps += p[e] + p[4 + e]; }
            lrun[h] = lrun[h] * corr + ps;
            bf16x8 pb;
#pragma unroll
            for (int e = 0; e < 8; ++e) pb[e] = (short)f2bf(p[e]);
#pragma unroll
            for (int dt = 0; dt < 4; ++dt) {
                bf16x8 vf;
                const LAS bf16* vb = VL + (4 * g) * VS + h * 64 + dt * 16 + (lane & 15);
#pragma unroll
                for (int e = 0; e < 4; ++e) { vf[e] = (short)vb[e * VS]; vf[4 + e] = (short)vb[(16 + e) * VS]; }
                oacc[h][dt] = oacc[h][dt] * corr;
                oacc[h][dt] = __builtin_amdgcn_mfma_f32_16x16x32_bf16(vf, pb, oacc[h][dt], 0, 0, 0);
            }
        }
    }
    const size_t m = (size_t)bb * T + tq;
#pragma unroll
    for (int h = 0; h < 4; ++h) { float l = lrun[h]; l += __shfl_xor(l, 16); l += __shfl_xor(l, 32); const float inv = 1.f / l;
#pragma unroll
        for (int dt = 0; dt < 4; ++dt) { u32x2 w; w.x = pk2(oacc[h][dt][0] * inv, oacc[h][dt][1] * inv); w.y = pk2(oacc[h][dt][2] * inv, oacc[h][dt][3] * inv);
            *(u32x2*)(OB + m * 1024 + 256 + h * 64 + dt * 16 + 4 * g) = w; } }
    __syncthreads();
}
}

namespace awin {
typedef short bf16x8 __attribute__((ext_vector_type(8)));
typedef float f4 __attribute__((ext_vector_type(4)));
constexpr int EXS = 66;
constexpr int O_EX = 0;
constexpr int VSW = 72;
constexpr int O_VW = 101376;
__device__ __forceinline__ void item(LAS unsigned char* lds0, const int bb, const int blk, const int h, const bf16* P, bf16* OB, const int tid0) {
    unsigned lb_ = 0u; int tid_l = tid0; asm volatile("" : "+v"(lb_), "+v"(tid_l));
    LAS unsigned char* lds = lds0 + lb_; const int tid = tid_l, lane = tid & 63, wave = __builtin_amdgcn_readfirstlane(tid >> 6);
    const bf16* Pb = P + (size_t)bb * T * PP; const int start = blk * 128, g = lane >> 4, ln = lane & 15;
    LAS float* EX = (LAS float*)(lds + O_EX);
    LAS bf16* VW = (LAS bf16*)(lds + O_VW + wave * 4608);
#pragma unroll 1
    for (int s4 = 0; s4 < 4; ++s4) {
        const int st = wave * 4 + s4;
        const int grp = st < 8 ? 0 : (st < 16 ? 1 : 2);
        const int dil = grp == 0 ? 1 : (grp == 1 ? 4 : 16), win = grp == 0 ? 128 : (grp == 1 ? 512 : 2048);
        const int r = grp == 0 ? 0 : (grp == 1 ? ((st - 8) >> 1) : (st - 16)), a0 = grp == 0 ? 16 * st : (grp == 1 ? ((st - 8) & 1) * 16 : 0), nqc = grp == 0 ? 128 : (grp == 1 ? 32 : 8);
        const int a = a0 + ln; const bool qok = a < nqc; const int ql = (qok ? a : (nqc - 1)) * dil + r, tq = start + ql;
        const bf16* qp = Pb + (size_t)tq * PP + C_AQ + grp * 256 + h * 64 + g * 8;
        const bf16x8 q0 = *(const bf16x8*)qp, q1 = *(const bf16x8*)(qp + 32);
        bf16x8 kf[10][2];
#pragma unroll
        for (int kt = 0; kt < 10; ++kt) { int pos = start - win + (a0 + 16 * kt + ln) * dil + r; pos = pos < 0 ? 0 : (pos > T - 1 ? T - 1 : pos);
            const bf16* kp = Pb + (size_t)pos * PP + C_AK + grp * 256 + h * 64 + g * 8; kf[kt][0] = *(const bf16x8*)kp; kf[kt][1] = *(const bf16x8*)(kp + 32); }
        f4 sc[10]; float mx = -INFINITY;
#pragma unroll
        for (int kt = 0; kt < 10; ++kt) { f4 t = (f4){0.f, 0.f, 0.f, 0.f};
            t = __builtin_amdgcn_mfma_f32_16x16x32_bf16(kf[kt][0], q0, t, 0, 0, 0); t = __builtin_amdgcn_mfma_f32_16x16x32_bf16(kf[kt][1], q1, t, 0, 0, 0);
#pragma unroll
            for (int e = 0; e < 4; ++e) { const int c = a0 + 16 * kt + 4 * g + e; const int pos = start - win + c * dil + r;
                const bool ok = qok && c >= a && c <= a + 128 && pos >= 0;
                sc[kt][e] = ok ? t[e] * 0.125f : -INFINITY; mx = fmaxf(mx, sc[kt][e]); } }
        mx = fmaxf(mx, __shfl_xor(mx, 16)); mx = fmaxf(mx, __shfl_xor(mx, 32));
        const float msafe = (mx == -INFINITY) ? 0.f : mx; float lsum = 0.f;
#pragma unroll
        for (int kt = 0; kt < 10; ++kt)
#pragma unroll
            for (int e = 0; e < 4; ++e) { sc[kt][e] = __expf(sc[kt][e] - msafe); lsum += sc[kt][e]; }
        lsum += __shfl_xor(lsum, 16); lsum += __shfl_xor(lsum, 32);
        f4 oacc[4];
#pragma unroll
        for (int dt = 0; dt < 4; ++dt) oacc[dt] = (f4){0.f, 0.f, 0.f, 0.f};
#pragma unroll
        for (int s5 = 0; s5 < 5; ++s5) {
            int pos = start - win + (a0 + 32 * s5 + (lane >> 1)) * dil + r; pos = pos < 0 ? 0 : (pos > T - 1 ? T - 1 : pos);
            const u32x4* vp = (const u32x4*)(Pb + (size_t)pos * PP + C_AV + grp * 256 + h * 64 + (lane & 1) * 32);
            const u32x4 v0 = vp[0], v1 = vp[1], v2 = vp[2], v3 = vp[3];
            LAS u32x4* vd = (LAS u32x4*)(VW + (lane >> 1) * VSW + (lane & 1) * 32);
            asm volatile("s_waitcnt lgkmcnt(0)" ::: "memory");
            vd[0] = v0; vd[1] = v1; vd[2] = v2; vd[3] = v3;
            asm volatile("s_waitcnt lgkmcnt(0)" ::: "memory");
            bf16x8 pb;
#pragma unroll
            for (int e = 0; e < 4; ++e) { pb[e] = (short)f2bf(sc[2 * s5][e]); pb[4 + e] = (short)f2bf(sc[2 * s5 + 1][e]); }
#pragma unroll
            for (int dt = 0; dt < 4; ++dt) { bf16x8 vf; const LAS bf16* vb = VW + (4 * g) * VSW + dt * 16 + ln;
#pragma unroll
                for (int e = 0; e < 4; ++e) { vf[e] = (short)vb[e * VSW]; vf[4 + e] = (short)vb[(16 + e) * VSW]; }
                oacc[dt] = __builtin_amdgcn_mfma_f32_16x16x32_bf16(vf, pb, oacc[dt], 0, 0, 0); }
        }
        if (qok) { LAS float* ex = EX + (grp * 128 + ql) * EXS;
#pragma unroll
            for (int dt = 0; dt < 4; ++dt) { ex[dt * 16 + 4 * g + 0] = oacc[dt][0]; ex[dt * 16 + 4 * g + 1] = oacc[dt][1]; ex[dt * 16 + 4 * g + 2] = oacc[dt][2]; ex[dt * 16 + 4 * g + 3] = oacc[dt][3]; }
            if (g == 0) { ex[64] = mx; ex[65] = lsum; } }
    }
    __syncthreads();
    { const int ql = tid >> 2, d0 = (tid & 3) * 16;
      const LAS float* e0 = EX + (0 * 128 + ql) * EXS; const LAS float* e1 = EX + (1 * 128 + ql) * EXS; const LAS float* e2 = EX + (2 * 128 + ql) * EXS;
      const float m0 = e0[64], m1 = e1[64], m2 = e2[64], M = fmaxf(m0, fmaxf(m1, m2));
      const float w0 = __expf(m0 - M), w1 = __expf(m1 - M), w2 = __expf(m2 - M); const float inv = 1.f / (w0 * e0[65] + w1 * e1[65] + w2 * e2[65]);
      unsigned pk[8];
#pragma unroll
      for (int j = 0; j < 8; ++j) { const float x0 = (w0 * e0[d0 + 2 * j] + w1 * e1[d0 + 2 * j] + w2 * e2[d0 + 2 * j]) * inv, x1 = (w0 * e0[d0 + 2 * j + 1] + w1 * e1[d0 + 2 * j + 1] + w2 * e2[d0 + 2 * j + 1]) * inv; pk[j] = pk2(x0, x1); }
      u32x4* op = (u32x4*)(OB + ((size_t)bb * T + start + ql) * 1024 + h * 64 + d0);
      op[0] = (u32x4){pk[0], pk[1], pk[2], pk[3]}; op[1] = (u32x4){pk[4], pk[5], pk[6], pk[7]}; }
    __syncthreads();
}
}

template <int SP>
__device__ __forceinline__ void phase_body(const int l_in, LAS unsigned char* lds) {
    int tid_ = threadIdx.x, bid_ = blockIdx.x, l_ = l_in, G_ = gridDim.x; asm volatile("" : "+v"(tid_), "+s"(bid_), "+s"(l_), "+s"(G_));
    const int tid = tid_, lane = tid & 63, wave = __builtin_amdgcn_readfirstlane(tid >> 6), l = l_;
    const int G = G_, bid = bid_;
    const int gw = bid * NWAVES + wave, NGW = G * NWAVES;
    unsigned char* ws = (unsigned char*)ldptr(lds, 36);
    int* ctl = (int*)(ws + WS_CTL);
    bf16* XB = (bf16*)(ws + WS_XB); bf16* OB = (bf16*)(ws + WS_O); bf16* VF = (bf16*)(ws + WS_VF); bf16* P = (bf16*)(ws + WS_P);
    bf16* GS = (bf16*)(ws + WS_GS); bf16* MG = (bf16*)(ws + WS_MERGED); bf16* XS = (bf16*)(ws + WS_XS); bf16* HB = (bf16*)(ws + WS_H);
    bf16* WGU = (bf16*)(ws + WS_WGU); bf16* WD = (bf16*)(ws + WS_WD);
    float* X = (float*)ldptr(lds, 35);
    int* tok_e = (int*)(ws + WS_ROUTE); float* tok_g = (float*)(ws + WS_ROUTE + 256 * 1024); int* tok_rank = (int*)(ws + WS_ROUTE + 512 * 1024); int* tok_slot = (int*)(ws + WS_ROUTE + 768 * 1024);
    (void)ctl; (void)XB; (void)OB; (void)VF; (void)P; (void)GS; (void)MG; (void)XS; (void)HB; (void)WGU; (void)WD; (void)X; (void)tok_e; (void)tok_g; (void)tok_rank; (void)tok_slot; (void)gw; (void)NGW; (void)lane;
    {
        bf16* WinT = (bf16*)(ws + WS_WINT) + (size_t)l * 5120 * 1024; bf16* WgT = (bf16*)(ws + WS_WGT) + (size_t)l * 4096 * 1024;
        bf16* WbrT = (bf16*)(ws + WS_WBRT) + (size_t)l * 1024 * 1024; bf16* WoutT = (bf16*)(ws + WS_WOUTT) + (size_t)l * 1024 * 1024;
        float* WrT = (float*)(ws + WS_WRT) + (size_t)l * 36 * 1024;
        int* cnt = ctl + CW_CNT + l * 64;

        if constexpr (SP == -1) {
            LAS float* scr = (LAS float*)(lds + wave * 16384);
#pragma unroll 1
            for (int job = 0; job < NL * 11; ++job) {
                const int ll = job / 11, jk = job % 11;
                if (jk < 5) {
                    const float* W = INP(I_WIN) + (size_t)ll * 1024 * INW;
                    const int sc0 = jk == 0 ? 0 : (jk == 1 ? 3396 : (jk == 2 ? 3392 : (jk == 3 ? 5060 : 5064)));
                    const int snc = jk == 0 ? 3392 : (jk == 1 ? 1664 : (jk == 4 ? 4096 : 4));
                    const int sr0 = jk == 0 ? 0 : (jk == 1 ? 3392 : (jk == 2 ? 5056 : (jk == 3 ? 5060 : 0)));
                    bf16* dst = jk == 4 ? (bf16*)(ws + WS_WGT) + (size_t)ll * 4096 * 1024 : (bf16*)(ws + WS_WINT) + (size_t)ll * 5120 * 1024;
                    const int nbn = (snc + 31) / 32, nit = 16 * nbn;
#pragma unroll 1
                    for (int it = gw; it < nit; it += NGW) transpose_item(W, INW, sc0, snc, dst, 1024, sr0, 0, it / nbn, it % nbn, scr, lane);
                } else if (jk < 9) {
                    const int n = jk - 5; const float* Wb = INP(I_WBR) + ((size_t)ll * 4 + n) * 256 * 1024;
#pragma unroll 1
                    for (int it = gw; it < 4 * 32; it += NGW) transpose_item(Wb, 1024, 0, 1024, (bf16*)(ws + WS_WBRT) + (size_t)ll * 1024 * 1024, 1024, 0, n * 256, it / 32, it % 32, scr, lane);
                } else if (jk == 9) {
                    const float* Wo = INP(I_WOUT) + (size_t)ll * 1024 * 1024;
#pragma unroll 1
                    for (int it = gw; it < 16 * 32; it += NGW) transpose_item(Wo, 1024, 0, 1024, (bf16*)(ws + WS_WOUTT) + (size_t)ll * 1024 * 1024, 1024, 0, 0, it / 32, it % 32, scr, lane);
                } else {
                    bf16* wi = (bf16*)(ws + WS_WINT) + (size_t)ll * 5120 * 1024;
#pragma unroll 1
                    for (int i = gw * 64 + lane; i < 56 * 1024 / 8; i += NGW * 64) ((u32x4*)(wi + (size_t)5064 * 1024))[i] = (u32x4){0u, 0u, 0u, 0u};
                    float* wr = (float*)(ws + WS_WRT) + (size_t)ll * 36 * 1024; const float* rg = INP(I_RG) + (size_t)ll * 1024 * 4; const float* re = INP(I_RE) + (size_t)ll * 1024 * 32;
#pragma unroll 1
                    for (int i = gw * 64 + lane; i < 36 * 1024; i += NGW * 64) { const int o = i / 1024, k = i % 1024; wr[i] = o < 4 ? rg[k * 4 + o] : re[k * 32 + (o - 4)]; }
                }
            }
            for (int m = gw; m < M; m += NGW) {
                const f32x4* xr = (const f32x4*)(INP(I_X) + (size_t)m * D) + lane;
#pragma unroll
                for (int j = 0; j < 4; ++j) { const f32x4 v = xr[64 * j]; ((f32x4*)(X + (size_t)m * D))[lane + 64 * j] = v;
                    u32x2 w; w.x = pk2(v[0], v[1]); w.y = pk2(v[2], v[3]); ((u32x2*)(XB + (size_t)m * D))[lane + 64 * j] = w; }
            }
        }
        else if constexpr (SP == 0) {
            pg8::Gemm g{XB, WinT, 1024, 1024, 1024}; pg8::StaticOrder S; S.init(M, PP, G, bid, 1024, 1024);
            EpiStoreBf16 E{P, PP, 0, PP};
            pg8::gemm_phase<EpiStoreBf16, pg8::StaticOrder>(lds, g, S, E);
        }
        else if constexpr (SP == 1) {
#pragma unroll 1
            for (int it = bid; it < NB * 32 * 4; it += G) awin::item(lds, it >> 7, (it >> 2) & 31, it & 3, P, OB, tid);
        }
        else if constexpr (SP == 2) {
#pragma unroll 1
            for (int it = bid; it < NB * 32; it += G) bsp::item(lds, it >> 5, 31 - (it & 31), P, OB, tid);
        }
        else if constexpr (SP == 3) {
            unsigned char* GZ = ws + WS_RW;
            if (bid < 16) {
                mb::chain(lds, l, bid >> 1, bid & 1, P, OB, tid, lane, wave);
            } else {
                const int h = (bid - 16) & 3, k = (bid - 16) >> 2;
                rw::build_ct(lds, l, h, lane, wave); __syncthreads();
#pragma unroll 1
                for (int idx = k; idx < 512; idx += 60) { const int b = idx >> 6, cI = idx & 63;
                    rw::chunk<1>(lds, l, b, h, cI * 64, GZ + ((size_t)((b * 4 + h) * 64 + cI)) * 16384, P, VF, OB, tid); }
            }
        }
        else if constexpr (SP == 12) {
            if (bid < 32) rw::carry(lds, ws + WS_RW + (size_t)bid * 64 * 16384, tid);
        }
        else if constexpr (SP == 13) {
            unsigned char* GZ = ws + WS_RW;
            const int h = bid & 3, k = bid >> 2;
            rw::build_ct(lds, l, h, lane, wave); __syncthreads();
#pragma unroll 1
            for (int idx = k; idx < 512; idx += (G >> 2)) { const int b = idx >> 6, cI = idx & 63;
                rw::chunk<3>(lds, l, b, h, cI * 64, GZ + ((size_t)((b * 4 + h) * 64 + cI)) * 16384, P, VF, OB, tid); }
        }
        else if constexpr (SP == 4) {
            pg8::Gemm g{XB, WgT, 1024, 1024, 1024}; pg8::StaticOrder S; S.init(M, 4096, G, bid, 1024, 1024);
            EpiStoreBf16 E{GS, 4096, 1, 4096};
            pg8::gemm_phase<EpiStoreBf16, pg8::StaticOrder>(lds, g, S, E);
        }
        else if constexpr (SP == 5) {
            pg8::Gemm g{OB, WbrT, 1024, 1024, 256}; BranchOrder S{M / 256, 4, G, bid};
            EpiBranch E{GS, MG};
            pg8::gemm_phase<EpiBranch, BranchOrder>(lds, g, S, E);
        }
        else if constexpr (SP == 6) {
            pg8::Gemm g{MG, WoutT, 1024, 1024, 1024}; pg8::StaticOrder S; S.init(M, 1024, G, bid, 1024, 1024);
            EpiResid E{X};
            pg8::gemm_phase<EpiResid, pg8::StaticOrder>(lds, g, S, E);
        }
        else if constexpr (SP == 7) {
            const float* g1 = INP(I_LN1G) + l * 1024; const float* b1 = INP(I_LN1B) + l * 1024;
            const float* rgb = INP(I_RGB) + l * 4; const float* reb = INP(I_REB) + l * 32;
            for (int m = gw; m < M; m += NGW) {
                f32x4 v[4]; float s = 0.f; f32x4* xr = (f32x4*)(X + (size_t)m * D) + lane;
#pragma unroll
                for (int j = 0; j < 4; ++j) { v[j] = xr[64 * j]; s += (v[j][0] + v[j][1]) + (v[j][2] + v[j][3]); }
                const float mean = wave_sum(s) * (1.f / D); float s2 = 0.f;
#pragma unroll
                for (int j = 0; j < 4; ++j) { v[j] = v[j] - mean; s2 += (v[j][0] * v[j][0] + v[j][1] * v[j][1]) + (v[j][2] * v[j][2] + v[j][3] * v[j][3]); }
                const float rstd = rsqrtf(wave_sum(s2) * (1.f / D) + LN_EPS);
#pragma unroll
                for (int j = 0; j < 4; ++j) { const f32x4 gg = ((const f32x4*)g1)[lane + 64 * j], bb = ((const f32x4*)b1)[lane + 64 * j]; v[j] = v[j] * rstd * gg + bb; xr[64 * j] = v[j];
                    u32x2 w; w.x = pk2(v[j][0], v[j][1]); w.y = pk2(v[j][2], v[j][3]); ((u32x2*)(XB + (size_t)m * D))[lane + 64 * j] = w; }
                float mylg = 0.f;
#pragma unroll 1
                for (int o = 0; o < 36; ++o) { float a = 0.f;
#pragma unroll
                    for (int j = 0; j < 4; ++j) { const f32x4 wv = ((const f32x4*)(WrT + o * 1024))[lane + 64 * j]; a += v[j][0] * wv[0] + v[j][1] * wv[1] + v[j][2] * wv[2] + v[j][3] * wv[3]; }
                    a = wave_sum(a); mylg = (lane == o) ? a : mylg; }
                mylg += lane < 4 ? rgb[lane & 3] : (lane < 36 ? reb[(lane - 4) & 31] : 0.f);
                float gl[4]; float gm = -INFINITY; int gs = 0;
#pragma unroll
                for (int o = 0; o < 4; ++o) { gl[o] = __shfl(mylg, o); if (gl[o] > gm) { gm = gl[o]; gs = o; } }
                float gden = 0.f;
#pragma unroll
                for (int o = 0; o < 4; ++o) gden += __expf(gl[o] - gm);
                const float pg = 1.f / gden;
                float el[8];
#pragma unroll
                for (int o = 0; o < 8; ++o) el[o] = __shfl(mylg, 4 + gs * 8 + o);
                int e1 = 0; float m1 = el[0];
#pragma unroll
                for (int o = 1; o < 8; ++o) if (el[o] > m1) { m1 = el[o]; e1 = o; }
                int e2 = -1; float m2 = -INFINITY;
#pragma unroll
                for (int o = 0; o < 8; ++o) if (o != e1 && el[o] > m2) { m2 = el[o]; e2 = o; }
                const float r2 = __expf(m2 - m1); const float ga = pg / (1.f + r2), gb = pg * r2 / (1.f + r2);
                if (lane == 0) {
                    const int E1 = gs * 8 + e1, E2 = gs * 8 + e2;
                    tok_e[m * 2] = E1; tok_e[m * 2 + 1] = E2; tok_g[m * 2] = ga; tok_g[m * 2 + 1] = gb;
                    tok_rank[m * 2] = atomicAdd(&cnt[E1], 1); tok_rank[m * 2 + 1] = atomicAdd(&cnt[E2], 1);
                }
            }
            LAS float* scr = (LAS float*)(lds + wave * 16384);
            const float* eg = INP(I_EG) + (size_t)l * NEXP * 1024 * 512; const float* eu = INP(I_EU) + (size_t)l * NEXP * 1024 * 512; const float* ed = INP(I_ED) + (size_t)l * NEXP * 512 * 1024;
            for (int it = gw; it < NEXP * 2 * 4 * 64; it += NGW) {
                const int e = it / 512, r = it % 512, half = r / 256, ct = (r % 256) / 64, q = r % 64, kb = q / 4, nb = q % 4;
                const float* W = (half ? eu : eg) + (size_t)e * 1024 * 512;
                transpose_item(W, 512, ct * 128, 128, WGU + (size_t)e * 1024 * 1024, 1024, ct * 256 + half * 128, 0, kb, nb, scr, lane);
            }
            for (int it = gw; it < NEXP * 8 * 32; it += NGW) {
                const int e = it / 256, q = it % 256, kb = q / 32, nb = q % 32;
                transpose_item(ed + (size_t)e * 512 * 1024, 1024, 0, 1024, WD + (size_t)e * 1024 * 512, 512, 0, 0, kb, nb, scr, lane);
            }
        }
        else if constexpr (SP == 8 || SP == 9 || SP == 10) {
            unsigned tbo = MISC_OFF; asm volatile("" : "+v"(tbo));
            volatile LAS int* tb = (volatile LAS int*)(lds + tbo);
            if (tid == 0) { int acc = 0; for (int e = 0; e < 32; ++e) { const int c = __hip_atomic_load(&cnt[e], __ATOMIC_RELAXED, __HIP_MEMORY_SCOPE_AGENT); tb[e] = acc; tb[33 + e] = acc; acc += (c + 255) >> 8; } tb[32] = acc; }
            __syncthreads();
            if constexpr (SP == 8) {
                for (int m = gw; m < M; m += NGW) {
#pragma unroll
                    for (int k = 0; k < 2; ++k) { const int e = tok_e[m * 2 + k]; const int slot = tb[33 + e] * 256 + tok_rank[m * 2 + k];
                        const u32x4* src = (const u32x4*)(XB + (size_t)m * D); u32x4* dst = (u32x4*)(XS + (size_t)slot * D);
                        dst[lane] = src[lane]; dst[lane + 64] = src[lane + 64];
                        if (lane == 0) tok_slot[m * 2 + k] = slot; }
                }
            } else if constexpr (SP == 9) {
                pg8::Gemm g{XS, WGU, 1024, 1024, 1024}; MoeOrder S{tb, G, bid, (size_t)1024 * 2, (size_t)1024 * 1024 * 2, (size_t)256 * 1024 * 2};
                EpiSwiglu E{HB};
                pg8::gemm_phase<EpiSwiglu, MoeOrder>(lds, g, S, E);
            } else {
                pg8::Gemm g{HB, WD, 512, 512, 512}; MoeOrder S{tb, G, bid, (size_t)512 * 2, (size_t)1024 * 512 * 2, (size_t)256 * 512 * 2};
                EpiStoreBf16 E{XS, 1024, 0, 1024};
                pg8::gemm_phase<EpiStoreBf16, MoeOrder>(lds, g, S, E);
            }
        }
        else if constexpr (SP == 11) {
            const float* g2 = INP(I_LN2G) + l * 1024; const float* b2 = INP(I_LN2B) + l * 1024;
            for (int m = gw; m < M; m += NGW) {
                const int s1 = tok_slot[m * 2], s2i = tok_slot[m * 2 + 1]; const float ga = tok_g[m * 2], gb = tok_g[m * 2 + 1];
                f32x4 v[4]; float s = 0.f; f32x4* xr = (f32x4*)(X + (size_t)m * D) + lane;
#pragma unroll
                for (int j = 0; j < 4; ++j) { v[j] = xr[64 * j] * ALPHA;
                    const u32x2 y1 = ((const u32x2*)(XS + (size_t)s1 * D))[lane + 64 * j], y2 = ((const u32x2*)(XS + (size_t)s2i * D))[lane + 64 * j];
                    v[j][0] += ga * __uint_as_float(y1.x << 16) + gb * __uint_as_float(y2.x << 16); v[j][1] += ga * __uint_as_float(y1.x & 0xffff0000u) + gb * __uint_as_float(y2.x & 0xffff0000u);
                    v[j][2] += ga * __uint_as_float(y1.y << 16) + gb * __uint_as_float(y2.y << 16); v[j][3] += ga * __uint_as_float(y1.y & 0xffff0000u) + gb * __uint_as_float(y2.y & 0xffff0000u);
                    s += (v[j][0] + v[j][1]) + (v[j][2] + v[j][3]); }
                const float mean = wave_sum(s) * (1.f / D); float s2 = 0.f;
#pragma unroll
                for (int j = 0; j < 4; ++j) { v[j] = v[j] - mean; s2 += (v[j][0] * v[j][0] + v[j][1] * v[j][1]) + (v[j][2] * v[j][2] + v[j][3] * v[j][3]); }
                const float rstd = rsqrtf(wave_sum(s2) * (1.f / D) + LN_EPS);
#pragma unroll
                for (int j = 0; j < 4; ++j) { const f32x4 gg = ((const f32x4*)g2)[lane + 64 * j], bb = ((const f32x4*)b2)[lane + 64 * j]; v[j] = v[j] * rstd * gg + bb; xr[64 * j] = v[j];
                    u32x2 w; w.x = pk2(v[j][0], v[j][1]); w.y = pk2(v[j][2], v[j][3]); ((u32x2*)(XB + (size_t)m * D))[lane + 64 * j] = w; }
            }
        }
    }
}

template <int SP>
__global__ void __launch_bounds__(NTHR, 2) k_phase(Args args, int l) {
    extern __shared__ __attribute__((aligned(16))) unsigned char lds_raw[];
    ptr_table_fill(args, (LAS unsigned char*)lds_raw);
    phase_body<SP>(l, (LAS unsigned char*)lds_raw);
}


#define XB_TMO      128
#define XB_XCNT(j)  (256  + 64 * (j))
#define XB_XSUB(j)  (1280 + 64 * (j))
#define XB_XGEN(j)  (2304 + 64 * (j))
#define XB_TOP      3328
#define XB_TOPGEN   3392
#define XCD_BAR_WORDS 3456
#define XB_SPIN_CAP (1u << 22)
__device__ __forceinline__ unsigned xb_ld(unsigned* p)              { return __hip_atomic_load(p, __ATOMIC_RELAXED, __HIP_MEMORY_SCOPE_AGENT); }
__device__ __forceinline__ unsigned xb_add(unsigned* p, unsigned v) { return __hip_atomic_fetch_add(p, v, __ATOMIC_RELAXED, __HIP_MEMORY_SCOPE_AGENT); }
__device__ __forceinline__ unsigned xb_xcc_id() { return (unsigned)__builtin_amdgcn_s_getreg((3 << 11) | 20) & 0xFu; }
#define XB_SPIN(cond, bar) do { unsigned _sp = 0; while (cond) { __builtin_amdgcn_s_sleep(1); \
    if ((++_sp & 255u) == 0u) { if (xb_ld(&(bar)[XB_TMO])) break; if (_sp > XB_SPIN_CAP) { atomicAdd(&(bar)[XB_TMO], 1u); break; } } } } while (0)
__device__ __forceinline__ void xcd_barrier_complete(unsigned* bar, unsigned x, unsigned& nloc, unsigned& nx) {
    const unsigned G = gridDim.x;
    unsigned sum, cnt, mine, sp = 0u;
    for (;;) {
        sum = 0u; cnt = 0u; mine = 0u;
#pragma unroll
        for (unsigned j = 0; j < 16; ++j) { const unsigned c = xb_ld(&bar[XB_XCNT(j)]); sum += c; cnt += (c > 0u) ? 1u : 0u; mine = (j == x) ? c : mine; }
        if (sum == G) break;
        __builtin_amdgcn_s_sleep(1);
        if ((++sp & 255u) == 0u) { if (xb_ld(&bar[XB_TMO])) break; if (sp > XB_SPIN_CAP) { atomicAdd(&bar[XB_TMO], 1u); break; } }
    }
    nloc = mine > 0u ? mine : 1u; nx = cnt > 0u ? cnt : 1u;
}
__device__ __forceinline__ void xcd_barrier(unsigned* bar, LAS unsigned char* lds) {
    asm volatile("s_waitcnt vmcnt(0)" ::: "memory");
    __syncthreads();
    int tid_ = threadIdx.x; asm volatile("" : "+v"(tid_));
    if (tid_ == 0) {
        unsigned so = (unsigned)(LDS_BYTES - 576); asm volatile("" : "+v"(so));
        volatile LAS unsigned* st = (volatile LAS unsigned*)(lds + so);
        __builtin_amdgcn_s_waitcnt(0);
        const unsigned x = xb_xcc_id();
        unsigned nloc = st[0], nx = st[1];
        if (nloc == 0u) { xcd_barrier_complete(bar, x, nloc, nx); st[0] = nloc; st[1] = nx; }
        const unsigned old = xb_add(&bar[XB_XSUB(x)], 1u);
        const unsigned gen = old / nloc;
        if (old + 1u == (gen + 1u) * nloc) {
            __builtin_amdgcn_fence(__ATOMIC_RELEASE, "agent");
            asm volatile("s_waitcnt vmcnt(0)" ::: "memory");
            const unsigned og = xb_add(&bar[XB_TOP], 1u);
            const unsigned tg = og / nx;
            if (og + 1u == (tg + 1u) * nx) xb_add(&bar[XB_TOPGEN], 1u);
            else XB_SPIN(xb_ld(&bar[XB_TOPGEN]) == tg, bar);
            __builtin_amdgcn_fence(__ATOMIC_ACQUIRE, "agent");
            xb_add(&bar[XB_XGEN(x)], 1u);
            asm volatile("s_waitcnt vmcnt(0)" ::: "memory");
        } else {
            XB_SPIN(xb_ld(&bar[XB_XGEN(x)]) == gen, bar);
            __builtin_amdgcn_fence(__ATOMIC_ACQUIRE, "agent");
            asm volatile("s_waitcnt vmcnt(0)" ::: "memory");
        }
    }
    __syncthreads();
}
namespace cg = cooperative_groups;
__global__ void __launch_bounds__(NTHR, 2) fwd_all(Args args) {
    extern __shared__ __attribute__((aligned(16))) unsigned char lds_raw[];
    LAS unsigned char* lds = (LAS unsigned char*)lds_raw;
    unsigned* bar = (unsigned*)(args.ws + WS_CTL) + CW_BAR;
    if (threadIdx.x == 0) { ((volatile LAS unsigned*)(lds + LDS_BYTES - 576))[0] = 0u; ((volatile LAS unsigned*)(lds + LDS_BYTES - 576))[1] = 0u; (void)xb_add(&bar[XB_XCNT(xb_xcc_id())], 1u); }
    ptr_table_fill(args, lds);
    const int reps = args.ph_lo;
    phase_body<-1>(0, lds);
    cg::this_grid().sync();
#define GRID_BAR() do { unsigned* bar_ = (unsigned*)ldptr(lds, 36) + CW_BAR; xcd_barrier(bar_, lds); } while (0)
    { constexpr int l = 0;
        phase_body<0>(l, lds); GRID_BAR();
#pragma unroll 1
        for (int r = 0; r < (reps & 15); ++r) { phase_body<1>(l, lds); __syncthreads(); }
#pragma unroll 1
        for (int r = 0; r < ((reps >> 4) & 15); ++r) { phase_body<2>(l, lds); __syncthreads(); }
#pragma unroll 1
        for (int r = 0; r < ((reps >> 8) & 15); ++r) { phase_body<3>(l, lds); __syncthreads(); }
        GRID_BAR();
        phase_body<12>(l, lds); GRID_BAR();
        phase_body<13>(l, lds); GRID_BAR();
        phase_body<4>(l, lds); GRID_BAR();
        phase_body<5>(l, lds); GRID_BAR();
        phase_body<6>(l, lds); GRID_BAR();
        phase_body<7>(l, lds); GRID_BAR();
        phase_body<8>(l, lds); GRID_BAR();
        phase_body<9>(l, lds); GRID_BAR();
        phase_body<10>(l, lds); GRID_BAR();
        phase_body<11>(l, lds); GRID_BAR();
    }
    { constexpr int l = 1;
        phase_body<0>(l, lds); GRID_BAR();
#pragma unroll 1
        for (int r = 0; r < (reps & 15); ++r) { phase_body<1>(l, lds); __syncthreads(); }
#pragma unroll 1
        for (int r = 0; r < ((reps >> 4) & 15); ++r) { phase_body<2>(l, lds); __syncthreads(); }
#pragma unroll 1
        for (int r = 0; r < ((reps >> 8) & 15); ++r) { phase_body<3>(l, lds); __syncthreads(); }
        GRID_BAR();
        phase_body<12>(l, lds); GRID_BAR();
        phase_body<13>(l, lds); GRID_BAR();
        phase_body<4>(l, lds); GRID_BAR();
        phase_body<5>(l, lds); GRID_BAR();
        phase_body<6>(l, lds); GRID_BAR();
        phase_body<7>(l, lds); GRID_BAR();
        phase_body<8>(l, lds); GRID_BAR();
        phase_body<9>(l, lds); GRID_BAR();
        phase_body<10>(l, lds); GRID_BAR();
        phase_body<11>(l, lds); GRID_BAR();
    }
#undef GRID_BAR
}

template <int SP> static void launch_phase(const Args& a, int l, int grid, hipStream_t stream) {
    static bool attr = false;
    if (!attr) { (void)hipFuncSetAttribute((const void*)k_phase<SP>, hipFuncAttributeMaxDynamicSharedMemorySize, LDS_BYTES); attr = true; }
    hipLaunchKernelGGL(k_phase<SP>, dim3(grid), dim3(NTHR), LDS_BYTES, stream, a, l);
}

extern "C" void kernel_launch(void* const* d_in, const int* in_sizes, int n_in, void* d_out, int out_size, void* d_ws, size_t ws_size, hipStream_t stream) {
    static int grid = 0;
    if (grid == 0) {
        if (n_in != 35 || out_size != M * D || ws_size < WS_END) { fprintf(stderr, "kernel_launch: unexpected problem (n_in %d out %d ws %zu)\n", n_in, out_size, ws_size); grid = -1; return; }
        int dev = 0, cus = 0, per_cu = 0;
        (void)hipGetDevice(&dev); (void)hipDeviceGetAttribute(&cus, hipDeviceAttributeMultiprocessorCount, dev);
#if N_LAUNCH_MODE == 1
        (void)hipFuncSetAttribute((const void*)fwd_all, hipFuncAttributeMaxDynamicSharedMemorySize, LDS_BYTES);
        if (hipOccupancyMaxActiveBlocksPerMultiprocessor(&per_cu, (const void*)fwd_all, NTHR, LDS_BYTES) != hipSuccess || per_cu < 1) { fprintf(stderr, "kernel_launch: occupancy query says %d blocks/CU\n", per_cu); grid = -1; return; }
#endif
        (void)per_cu;
        grid = cus;
        if (grid != 256) { fprintf(stderr, "kernel_launch: built for 256 CUs, found %d\n", cus); grid = -1; return; }
    }
    if (grid < 0) return;
    (void)hipMemsetAsync((char*)d_ws + WS_CTL, 0, CTL_BYTES, stream);
    Args a{};
    for (int i = 0; i < 35; ++i) a.in[i] = (const float*)d_in[i];
    a.out = (float*)d_out; a.ws = (unsigned char*)d_ws;
#if N_LAUNCH_MODE == 1
    a.ph_lo = PROBE_REPS;
    void* kargs[] = {(void*)&a};
    hipError_t e = hipLaunchCooperativeKernel((const void*)fwd_all, dim3(grid), dim3(NTHR), kargs, LDS_BYTES, stream);
    if (e != hipSuccess) fprintf(stderr, "cooperative launch failed: %s\n", hipGetErrorString(e));
#else
    launch_phase<-1>(a, 0, grid, stream);
    for (int l = 0; l < NL; ++l) {
        launch_phase<0>(a, l, grid, stream); launch_phase<1>(a, l, grid, stream); launch_phase<2>(a, l, grid, stream); launch_phase<3>(a, l, grid, stream); launch_phase<12>(a, l, grid, stream); launch_phase<13>(a, l, grid, stream);
        launch_phase<4>(a, l, grid, stream); launch_phase<5>(a, l, grid, stream); launch_phase<6>(a, l, grid, stream); launch_phase<7>(a, l, grid, stream);
        launch_phase<8>(a, l, grid, stream); launch_phase<9>(a, l, grid, stream); launch_phase<10>(a, l, grid, stream); launch_phase<11>(a, l, grid, stream);
    }
#endif
}
```

```cpp
#include <hip/hip_runtime.h>
#include <cstdio>
#include <cstdint>
#include <hip/hip_cooperative_groups.h>

#ifndef PROBE_REPS
#define PROBE_REPS -100
#endif
#ifndef N_LAUNCH_MODE
#define N_LAUNCH_MODE 1
#endif

namespace pg8 {
#define PG8_LAS __attribute__((address_space(3)))
typedef unsigned short bf16_t;
typedef short bf16x8 __attribute__((ext_vector_type(8)));
typedef float f32x4 __attribute__((ext_vector_type(4)));
typedef unsigned u32x4 __attribute__((ext_vector_type(4)));
constexpr int BM = 256, BK = 64, HALF = 128, HTB = HALF * BK * 2, STAGE_BYTES = 8 * HTB, NXCD = 8, WGM = 8;

__host__ __device__ __forceinline__ int lds_byte(int r, int c) { const int st = (r >> 4) * 2 + (c >> 5), rr = r & 15, cc = c & 31, ob = rr * 64 + cc * 2; return st * 1024 + (ob ^ (((ob >> 9) & 1) << 5)); }
__host__ __device__ __forceinline__ void stage_rc(int b, int& R, int& C) { const int st = b / 1024, sb = b % 1024, swz = sb ^ (((sb >> 9) & 1) << 5); R = (st >> 1) * 16 + swz / 64; C = (st & 1) * 32 + (swz % 64) / 2; }
__host__ __device__ __forceinline__ int perm32(int rho) { const int n = rho >> 4, i = rho & 15; return 8 * (i >> 2) + 4 * n + (i & 3); }

struct Unit { int pm, pn, aux; size_t aoff, boff; };
struct Gemm { const bf16_t* A; const bf16_t* Bt; int lda, ldb, K; };

__device__ __forceinline__ void tile_of(int L, int nM, int nN, int& pm, int& pn) {
    const int nwg = nM * nN; int wgid = L;
    { const int q = nwg / NXCD, r = nwg % NXCD, xcd = wgid % NXCD, off = wgid / NXCD; wgid = (xcd < r ? xcd * (q + 1) : r * (q + 1) + (xcd - r) * q) + off; }
    const int nig = WGM * nN, gid = wgid / nig, fm = gid * WGM, gsz = (nM - fm) < WGM ? (nM - fm) : WGM;
    pm = fm + ((wgid % nig) % gsz); pn = (wgid % nig) / gsz;
}
struct StaticOrder {
    int nM, nN, nwg, G, c, lda, ldb;
    __device__ void init(int M, int N, int G_, int c_, int lda_, int ldb_) { nM = M / BM; nN = N / BM; nwg = nM * nN; G = G_; c = c_; lda = lda_; ldb = ldb_; }
    __device__ bool next(int i, Unit& u) const {
        const long L = (long)i * G + c; if (L >= nwg) return false;
        tile_of((int)L, nM, nN, u.pm, u.pn); u.aux = 0;
        u.aoff = (size_t)u.pm * BM * lda * 2; u.boff = (size_t)u.pn * BM * ldb * 2; return true;
    }
};

__device__ __forceinline__ unsigned cvt_pk_bf16(float lo, float hi) { unsigned r; asm volatile("v_cvt_pk_bf16_f32 %0, %1, %2" : "=v"(r) : "v"(lo), "v"(hi)); return r; }

template <class Epi, class Sched, bool ALIGN_EPI = true, bool SP2 = true>
__device__ __forceinline__ void gemm_phase(PG8_LAS unsigned char* lds, const Gemm g, const Sched& S, const Epi& E) {
    int tid_ = threadIdx.x; asm volatile("" : "+v"(tid_));
    const int tid = tid_, wid = __builtin_amdgcn_readfirstlane(tid >> 6), lane = tid & 63, wr = wid >> 2, wc = wid & 3, fr = lane & 15, fq = lane >> 4;
    const int K = g.K, nt = K / BK;
    unsigned voffA[2], voffB[2];
#pragma unroll
    for (int i = 0; i < 2; ++i) { int R, C; stage_rc(tid * 16 + i * 8192, R, C); const int Rb = Epi::PERM ? ((R & ~31) + perm32(R & 31)) : R;
        voffA[i] = (unsigned)(R * g.lda + C) * 2u; voffB[i] = (unsigned)(Rb * g.ldb + C) * 2u; }
    const size_t kstep = (size_t)(BK * 2);
    const size_t hstepA = (size_t)HALF * g.lda * 2, hstepB = (size_t)HALF * g.ldb * 2;
    const unsigned ldsw = (unsigned)wid * 1024u;
    const int aoff = lds_byte(wr * 64 + fr, fq * 8), boff = lds_byte(wc * 32 + fr, fq * 8);
#define PG8_SA(b, h) (((b) * 2 + (h)) * HTB)
#define PG8_SB(b, h) ((4 + (b) * 2 + (h)) * HTB)
#define PG8_STAGE(bufoff, gbase, voff) do { _Pragma("unroll") for (int _i = 0; _i < 2; ++_i) \
        __builtin_amdgcn_global_load_lds((const unsigned*)((const char*)(gbase) + (voff)[_i]), (PG8_LAS unsigned*)(lds + (bufoff) + ldsw + _i * 8192), 16, 0, 0); } while (0)
#define PG8_LDA(dst, b, h) do { _Pragma("unroll") for (int m = 0; m < 4; ++m) _Pragma("unroll") for (int k = 0; k < 2; ++k) dst[m][k] = *(const PG8_LAS bf16x8*)(lds + PG8_SA(b, h) + aoff + m * 2048 + k * 1024); } while (0)
#define PG8_LDB(dst, b, h) do { _Pragma("unroll") for (int n = 0; n < 2; ++n) _Pragma("unroll") for (int k = 0; k < 2; ++k) dst[n][k] = *(const PG8_LAS bf16x8*)(lds + PG8_SB(b, h) + boff + n * 2048 + k * 1024); } while (0)
#define PG8_MMA(ai, bj, At, Bt) do { __builtin_amdgcn_s_setprio(1); _Pragma("unroll") for (int m = 0; m < 4; ++m) _Pragma("unroll") for (int n = 0; n < 2; ++n) _Pragma("unroll") for (int k = 0; k < 2; ++k) \
        acc[ai][bj][m][n] = __builtin_amdgcn_mfma_f32_16x16x32_bf16(Bt[n][k], At[m][k], acc[ai][bj][m][n], 0, 0, 0); __builtin_amdgcn_s_setprio(0); } while (0)
#define PG8_WAIT_V(n) asm volatile("s_waitcnt vmcnt(" #n ")" ::: "memory")
#define PG8_WAIT_L(n) asm volatile("s_waitcnt lgkmcnt(" #n ")" ::: "memory")
#define PG8_BAR __builtin_amdgcn_s_barrier()
#define PG8_SCHED __builtin_amdgcn_sched_barrier(0)
    Unit cur, nxt; int ui = 0;
    if (!S.next(0, cur)) return;
    f32x4 acc[2][2][4][2];
#pragma unroll
    for (int a = 0; a < 2; ++a)
#pragma unroll
        for (int b = 0; b < 2; ++b)
#pragma unroll
            for (int m = 0; m < 4; ++m)
#pragma unroll
                for (int n = 0; n < 2; ++n) acc[a][b][m][n] = (f32x4){0.f, 0.f, 0.f, 0.f};
    bf16x8 At[4][2], B0[2][2], B1[2][2];
    const char* cA = (const char*)g.A + cur.aoff; const char* cB = (const char*)g.Bt + cur.boff;
    if constexpr (SP2) {
        PG8_STAGE(PG8_SB(0, 0), cB, voffB); PG8_STAGE(PG8_SB(0, 1), cB + hstepB, voffB); PG8_STAGE(PG8_SA(0, 0), cA, voffA); PG8_STAGE(PG8_SA(0, 1), cA + hstepA, voffA);
        if (wr == 1) PG8_BAR;
        PG8_WAIT_V(2); PG8_BAR;
        PG8_STAGE(PG8_SB(1, 0), cB + kstep, voffB); PG8_STAGE(PG8_SA(1, 0), cA + kstep, voffA); PG8_STAGE(PG8_SB(1, 1), cB + hstepB + kstep, voffB);
        PG8_WAIT_V(6); PG8_BAR;
    } else {
        PG8_STAGE(PG8_SB(0, 0), cB, voffB); PG8_STAGE(PG8_SA(0, 0), cA, voffA); PG8_STAGE(PG8_SB(0, 1), cB + hstepB, voffB); PG8_STAGE(PG8_SA(0, 1), cA + hstepA, voffA);
        if (wr == 1) PG8_BAR;
        PG8_WAIT_V(4); PG8_BAR;
        PG8_STAGE(PG8_SB(1, 0), cB + kstep, voffB); PG8_STAGE(PG8_SA(1, 0), cA + kstep, voffA); PG8_STAGE(PG8_SB(1, 1), cB + hstepB + kstep, voffB);
        PG8_WAIT_V(6); PG8_BAR;
    }
    for (;;) {
        const bool has_next = S.next(ui + 1, nxt);
        const char* nA = has_next ? (const char*)g.A + nxt.aoff : cA; const char* nB = has_next ? (const char*)g.Bt + nxt.boff : cB;
#pragma unroll 1
        for (int t = 0; t < nt; t += 2) {
            const bool last = (t == nt - 2);
            const char* a1 = cA + (size_t)(t + 1) * kstep;
            const char* a2 = last ? nA : cA + (size_t)(t + 2) * kstep; const char* b2 = last ? nB : cB + (size_t)(t + 2) * kstep;
            const char* a3 = a2 + kstep; const char* b3 = b2 + kstep;
            if constexpr (SP2) {
            PG8_LDB(B0, 0, 0); PG8_LDB(B1, 0, 1); PG8_SCHED; PG8_LDA(At, 0, 0); PG8_STAGE(PG8_SA(1, 1), a1 + hstepA, voffA);
            PG8_WAIT_V(8); PG8_WAIT_L(0); PG8_BAR; PG8_MMA(0, 0, At, B0); PG8_MMA(0, 1, At, B1); PG8_BAR; PG8_SCHED;
            PG8_LDA(At, 0, 1); PG8_STAGE(PG8_SB(0, 0), b2, voffB); PG8_STAGE(PG8_SB(0, 1), b2 + hstepB, voffB); PG8_STAGE(PG8_SA(0, 0), a2, voffA);
            PG8_WAIT_V(8); PG8_WAIT_L(0); PG8_BAR; PG8_MMA(1, 0, At, B0); PG8_MMA(1, 1, At, B1); PG8_BAR; PG8_SCHED;
            PG8_LDB(B0, 1, 0); PG8_LDB(B1, 1, 1); PG8_SCHED; PG8_LDA(At, 1, 0); PG8_STAGE(PG8_SA(0, 1), a2 + hstepA, voffA);
            PG8_WAIT_V(8); PG8_WAIT_L(0); PG8_BAR; PG8_MMA(0, 0, At, B0); PG8_MMA(0, 1, At, B1); PG8_BAR; PG8_SCHED;
            PG8_LDA(At, 1, 1); PG8_STAGE(PG8_SB(1, 0), b3, voffB); PG8_STAGE(PG8_SB(1, 1), b3 + hstepB, voffB); PG8_STAGE(PG8_SA(1, 0), a3, voffA);
            PG8_WAIT_V(8); PG8_WAIT_L(0); PG8_BAR; PG8_MMA(1, 0, At, B0); PG8_MMA(1, 1, At, B1); PG8_BAR; PG8_SCHED;
            } else {
            PG8_LDB(B0, 0, 0); PG8_SCHED; PG8_LDA(At, 0, 0); PG8_STAGE(PG8_SA(1, 1), a1 + hstepA, voffA);
            PG8_WAIT_L(8); PG8_BAR; PG8_WAIT_L(0); PG8_MMA(0, 0, At, B0); PG8_BAR; PG8_SCHED;
            PG8_LDB(B1, 0, 1); PG8_STAGE(PG8_SB(0, 0), b2, voffB);
            PG8_BAR; PG8_WAIT_L(0); PG8_MMA(0, 1, At, B1); PG8_BAR;
            PG8_LDA(At, 0, 1); PG8_STAGE(PG8_SA(0, 0), a2, voffA);
            PG8_BAR; PG8_WAIT_L(0); PG8_MMA(1, 0, At, B0); PG8_BAR; PG8_SCHED;
            PG8_STAGE(PG8_SB(0, 1), b2 + hstepB, voffB);
            PG8_WAIT_V(6); PG8_BAR; PG8_MMA(1, 1, At, B1); PG8_BAR;
            PG8_LDB(B0, 1, 0); PG8_SCHED; PG8_LDA(At, 1, 0); PG8_STAGE(PG8_SA(0, 1), a2 + hstepA, voffA);
            PG8_WAIT_L(8); PG8_BAR; PG8_WAIT_L(0); PG8_MMA(0, 0, At, B0); PG8_BAR; PG8_SCHED;
            PG8_LDB(B1, 1, 1); PG8_STAGE(PG8_SB(1, 0), b3, voffB);
            PG8_BAR; PG8_WAIT_L(0); PG8_MMA(0, 1, At, B1); PG8_BAR;
            PG8_LDA(At, 1, 1); PG8_STAGE(PG8_SA(1, 0), a3, voffA);
            PG8_BAR; PG8_WAIT_L(0); PG8_MMA(1, 0, At, B0); PG8_BAR; PG8_SCHED;
            PG8_STAGE(PG8_SB(1, 1), b3 + hstepB, voffB);
            PG8_WAIT_V(6); PG8_BAR; PG8_MMA(1, 1, At, B1); PG8_BAR;
            }
        }
        if constexpr (ALIGN_EPI) { if (wr == 0) PG8_BAR; }
        E(acc, cur, wr, wc, fr, fq);
        if (!has_next) break;
#pragma unroll
        for (int a = 0; a < 2; ++a)
#pragma unroll
            for (int b = 0; b < 2; ++b)
#pragma unroll
                for (int m = 0; m < 4; ++m)
#pragma unroll
                    for (int n = 0; n < 2; ++n) acc[a][b][m][n] = (f32x4){0.f, 0.f, 0.f, 0.f};
        cur = nxt; cA = nA; cB = nB; ++ui;
        if constexpr (ALIGN_EPI) { if (wr == 1) PG8_BAR; }
    }
    PG8_WAIT_V(0);
    if constexpr (!ALIGN_EPI) { if (wr == 0) PG8_BAR; }
    PG8_BAR;
#undef PG8_SA
#undef PG8_SB
#undef PG8_STAGE
#undef PG8_LDA
#undef PG8_LDB
#undef PG8_MMA
#undef PG8_WAIT_V
#undef PG8_WAIT_L
#undef PG8_BAR
#undef PG8_SCHED
}
}

#define LAS __attribute__((address_space(3)))
typedef unsigned short bf16;
typedef float f32x4 __attribute__((ext_vector_type(4)));
typedef unsigned u32x4 __attribute__((ext_vector_type(4)));
typedef unsigned u32x2 __attribute__((ext_vector_type(2)));

constexpr int NB = 8, T = 4096, D = 1024, M = NB * T, NL = 2;
constexpr int INW = 9160;
constexpr int PP = 5120;
constexpr int C_AQ = 0, C_AK = 768, C_AV = 1536, C_BQ = 2304, C_BK = 2560, C_BV = 2816, C_IQ = 3072, C_IK = 3328, C_C = 3392, C_DZ = 4288, C_DX = 4544, C_IW = 5056, C_DT = 5060, C_END = 5064;
constexpr int NEXP = 32, DEXP = 512;
constexpr int CAP = 73728;
constexpr float LN_EPS = 1e-5f;
constexpr float ALPHA = 1.4142135623730951f;

constexpr size_t MiB = 1u << 20;
constexpr size_t WS_CTL = 0, CTL_BYTES = 1 * MiB;
constexpr size_t WS_WINT = 2 * MiB;
constexpr size_t WS_WGT = 22 * MiB;
constexpr size_t WS_WBRT = 38 * MiB;
constexpr size_t WS_WOUTT = 42 * MiB;
constexpr size_t WS_WRT = 46 * MiB;
constexpr size_t WS_ROUTE = 47 * MiB;
constexpr size_t WS_XB = 48 * MiB;
constexpr size_t WS_O = 112 * MiB;
constexpr size_t WS_VF = 176 * MiB;
constexpr size_t WS_P = 192 * MiB;
constexpr size_t WS_GS = 192 * MiB;
constexpr size_t WS_MERGED = 448 * MiB;
constexpr size_t WS_XS = 192 * MiB;
constexpr size_t WS_H = 336 * MiB;
constexpr size_t WS_WGU = 408 * MiB;
constexpr size_t WS_WD = 472 * MiB;
constexpr size_t WS_RW = 512 * MiB;
constexpr size_t WS_END = 544 * MiB;
constexpr int CW_CNT = 64, CW_Q = 256, CW_BAR = 4096;

constexpr int RING_BYTES = 131072, MISC_OFF = RING_BYTES, LDS_BYTES = 147456;
constexpr int NWAVES = 8, NTHR = 512;

__device__ __forceinline__ float bf2f(bf16 v) { return __uint_as_float(((unsigned)v) << 16); }
__device__ __forceinline__ unsigned f2bf(float f) { unsigned u = __float_as_uint(f); return (u + 0x7fffu + ((u >> 16) & 1u)) >> 16; }
__device__ __forceinline__ unsigned pk2(float lo, float hi) { return f2bf(lo) | (f2bf(hi) << 16); }
__device__ __forceinline__ float wave_sum(float v) {
#pragma unroll
    for (int o = 1; o < 64; o <<= 1) v += __shfl_xor(v, o);
    return v;
}
__device__ __forceinline__ float wave_max(float v) {
#pragma unroll
    for (int o = 1; o < 64; o <<= 1) v = fmaxf(v, __shfl_xor(v, o));
    return v;
}
__device__ __forceinline__ float sigmoidf_(float x) { return 1.f / (1.f + __expf(-x)); }
__device__ __forceinline__ float softplusf_(float x) { return x > 20.f ? x : log1pf(__expf(x)); }
__device__ __forceinline__ float siluf_(float x) { return x / (1.f + __expf(-x)); }

struct Args { const float* in[35]; float* out; unsigned char* ws; int ph_lo, ph_hi; };
enum { I_X = 0, I_WIN, I_CMU, I_CW0, I_CW2, I_CA0, I_CA2, I_CG2, I_CKK, I_CKA, I_CRK, I_CGNW, I_CGNB, I_CV0, I_CV1, I_CV2, I_DCW, I_DCB, I_DDTB, I_DALOG, I_DSKIP, I_DNW,
       I_WBR, I_WOUT, I_LN1G, I_LN1B, I_RG, I_RGB, I_RE, I_REB, I_EG, I_EU, I_ED, I_LN2G, I_LN2B };

__device__ __forceinline__ void transpose_item(const float* W, int ldn, int c0, int ncols, bf16* dst, int dld, int r0, int dk0, int kb, int nb, LAS float* scr, int lane) {
    const int k0 = 64 * kb, n0 = 32 * nb;
    const bool okn = (n0 + (lane & 31)) < ncols;
#pragma unroll 8
    for (int i = 0; i < 32; ++i) { const int kk = 2 * i + (lane >> 5); scr[kk * 33 + (lane & 31)] = okn ? W[(size_t)(k0 + kk) * ldn + c0 + n0 + (lane & 31)] : 0.f; }
    asm volatile("s_waitcnt lgkmcnt(0)" ::: "memory");
    const int c = lane & 7;
#pragma unroll
    for (int j = 0; j < 4; ++j) { const int n = (lane >> 3) + 8 * j; const LAS float* s = scr + (8 * c) * 33 + n;
        u32x4 o; o.x = pk2(s[0 * 33], s[1 * 33]); o.y = pk2(s[2 * 33], s[3 * 33]); o.z = pk2(s[4 * 33], s[5 * 33]); o.w = pk2(s[6 * 33], s[7 * 33]);
        if (n0 + n < ncols) *(u32x4*)(dst + (size_t)(r0 + n0 + n) * dld + dk0 + k0 + 8 * c) = o; }
    asm volatile("s_waitcnt lgkmcnt(0)" ::: "memory");
}

struct EpiStoreBf16 {
    static constexpr bool PERM = true;
    bf16* O; int ldc; int act; int ncols;
    __device__ __forceinline__ void operator()(const pg8::f32x4 (&acc)[2][2][4][2], const pg8::Unit& u, int wr, int wc, int fr, int fq) const {
        const int row0 = u.pm * 256 + wr * 64 + fr; const int col0 = u.pn * 256 + wc * 32 + 8 * fq;
#pragma unroll
        for (int ai = 0; ai < 2; ++ai)
#pragma unroll
            for (int m = 0; m < 4; ++m) { bf16* rowp = O + (size_t)(row0 + ai * 128 + m * 16) * ldc + col0;
#pragma unroll
                for (int bj = 0; bj < 2; ++bj) { pg8::f32x4 v0 = acc[ai][bj][m][0], v1 = acc[ai][bj][m][1];
                    if (act == 1) {
#pragma unroll
                        for (int j = 0; j < 4; ++j) { v0[j] = sigmoidf_(v0[j]); v1[j] = sigmoidf_(v1[j]); } }
                    u32x4 w; w.x = pg8::cvt_pk_bf16(v0[0], v0[1]); w.y = pg8::cvt_pk_bf16(v0[2], v0[3]); w.z = pg8::cvt_pk_bf16(v1[0], v1[1]); w.w = pg8::cvt_pk_bf16(v1[2], v1[3]);
                    if (col0 + bj * 128 < ncols) *(u32x4*)(rowp + bj * 128) = w; } }
    }
};
struct EpiBranch {
    static constexpr bool PERM = true;
    const bf16* GS; bf16* MG;
    __device__ __forceinline__ void operator()(const pg8::f32x4 (&acc)[2][2][4][2], const pg8::Unit& u, int wr, int wc, int fr, int fq) const {
        const int n = u.aux;
        const bf16* gbase = GS + (size_t)(u.pm * 256 + wr * 64 + fr) * 4096 + n * 1024 + u.pn * 256 + wc * 32 + 8 * fq;
        bf16* mbase = MG + (size_t)(u.pm * 256 + wr * 64 + fr) * 1024 + u.pn * 256 + wc * 32 + 8 * fq;
#pragma unroll
        for (int ai = 0; ai < 2; ++ai)
#pragma unroll
            for (int m = 0; m < 4; ++m) {
#pragma unroll
                for (int bj = 0; bj < 2; ++bj) {
                    const u32x4 gv = *(const u32x4*)(gbase + (size_t)(ai * 128 + m * 16) * 4096 + bj * 128);
                    bf16* mp = mbase + (size_t)(ai * 128 + m * 16) * 1024 + bj * 128;
                    u32x4 ov = (u32x4){0u, 0u, 0u, 0u}; if (n != 0) ov = *(const u32x4*)mp;
                    const pg8::f32x4 a0 = acc[ai][bj][m][0], a1 = acc[ai][bj][m][1];
                    u32x4 w;
                    w.x = pg8::cvt_pk_bf16(a0[0] * __uint_as_float(gv.x << 16) + __uint_as_float(ov.x << 16), a0[1] * __uint_as_float(gv.x & 0xffff0000u) + __uint_as_float(ov.x & 0xffff0000u));
                    w.y = pg8::cvt_pk_bf16(a0[2] * __uint_as_float(gv.y << 16) + __uint_as_float(ov.y << 16), a0[3] * __uint_as_float(gv.y & 0xffff0000u) + __uint_as_float(ov.y & 0xffff0000u));
                    w.z = pg8::cvt_pk_bf16(a1[0] * __uint_as_float(gv.z << 16) + __uint_as_float(ov.z << 16), a1[1] * __uint_as_float(gv.z & 0xffff0000u) + __uint_as_float(ov.z & 0xffff0000u));
                    w.w = pg8::cvt_pk_bf16(a1[2] * __uint_as_float(gv.w << 16) + __uint_as_float(ov.w << 16), a1[3] * __uint_as_float(gv.w & 0xffff0000u) + __uint_as_float(ov.w & 0xffff0000u));
                    *(u32x4*)mp = w; asm volatile("" ::: "memory"); } }
    }
};
struct EpiResid {
    static constexpr bool PERM = false;
    float* X;
    __device__ __forceinline__ void operator()(const pg8::f32x4 (&acc)[2][2][4][2], const pg8::Unit& u, int wr, int wc, int fr, int fq) const {
        const int row0 = u.pm * 256 + wr * 64 + fr, col0 = u.pn * 256 + wc * 32 + 4 * fq;
#pragma unroll
        for (int ai = 0; ai < 2; ++ai)
#pragma unroll
            for (int m = 0; m < 4; ++m) { float* rowp = X + (size_t)(row0 + ai * 128 + m * 16) * D + col0;
#pragma unroll
                for (int bj = 0; bj < 2; ++bj)
#pragma unroll
                    for (int n = 0; n < 2; ++n) { pg8::f32x4* p = (pg8::f32x4*)(rowp + bj * 128 + n * 16); *p = *p * ALPHA + acc[ai][bj][m][n]; } }
    }
};
struct EpiSwiglu {
    static constexpr bool PERM = true;
    bf16* H;
    __device__ __forceinline__ void operator()(const pg8::f32x4 (&acc)[2][2][4][2], const pg8::Unit& u, int wr, int wc, int fr, int fq) const {
        const int row0 = u.pm * 256 + wr * 64 + fr; const int col0 = u.pn * 128 + wc * 32 + 8 * fq;
#pragma unroll
        for (int ai = 0; ai < 2; ++ai)
#pragma unroll
            for (int m = 0; m < 4; ++m) { bf16* rowp = H + (size_t)(row0 + ai * 128 + m * 16) * DEXP + col0;
                float v[8];
#pragma unroll
                for (int j = 0; j < 4; ++j) { v[j] = siluf_(acc[ai][0][m][0][j]) * acc[ai][1][m][0][j]; v[4 + j] = siluf_(acc[ai][0][m][1][j]) * acc[ai][1][m][1][j]; }
                u32x4 w; w.x = pg8::cvt_pk_bf16(v[0], v[1]); w.y = pg8::cvt_pk_bf16(v[2], v[3]); w.z = pg8::cvt_pk_bf16(v[4], v[5]); w.w = pg8::cvt_pk_bf16(v[6], v[7]);
                *(u32x4*)rowp = w; }
    }
};

struct BranchOrder {
    int nM, nN, G, c;
    __device__ bool next(int i, pg8::Unit& u) const {
        const int tl = (i >> 2) * G + c; if (tl >= nM * nN) return false;
        pg8::tile_of(tl, nM, nN, u.pm, u.pn); u.aux = i & 3;
        u.aoff = ((size_t)u.pm * 256 * 1024 + (size_t)u.aux * 256) * 2; u.boff = ((size_t)u.pn * 256 * 1024 + (size_t)u.aux * 256) * 2; return true;
    }
};
struct MoeOrder {
    const volatile LAS int* tb; int G, c; size_t a_rowbytes, b_expbytes, b_tilebytes;
    __device__ bool next(int i, pg8::Unit& u) const {
        const int L = i * G + c; const int total = __builtin_amdgcn_readfirstlane(tb[32]) * 4; if (L >= total) return false;
        int e = 0;
#pragma unroll 1
        for (int k = 0; k < 32; ++k) if (L >= tb[k + 1] * 4) e = k + 1;
        const int nte = tb[e + 1] - tb[e]; const int r = L - tb[e] * 4; const int ct = r / nte, rt = r % nte;
        u.pm = __builtin_amdgcn_readfirstlane(tb[33 + e] + rt); u.pn = __builtin_amdgcn_readfirstlane(ct); u.aux = __builtin_amdgcn_readfirstlane(e);
        u.aoff = (size_t)u.pm * 256 * a_rowbytes; u.boff = (size_t)u.aux * b_expbytes + (size_t)u.pn * b_tilebytes; return true;
    }
};

constexpr int PTR_OFF = LDS_BYTES - 512;
__device__ __forceinline__ void ptr_table_fill(const Args& args, LAS unsigned char* lds) {
    if (threadIdx.x == 0) {
        volatile LAS unsigned long long* t = (volatile LAS unsigned long long*)(lds + PTR_OFF);
#define PT_(i) t[i] = (unsigned long long)args.in[i];
        PT_(0) PT_(1) PT_(2) PT_(3) PT_(4) PT_(5) PT_(6) PT_(7) PT_(8) PT_(9) PT_(10) PT_(11) PT_(12) PT_(13) PT_(14) PT_(15) PT_(16) PT_(17) PT_(18) PT_(19)
        PT_(20) PT_(21) PT_(22) PT_(23) PT_(24) PT_(25) PT_(26) PT_(27) PT_(28) PT_(29) PT_(30) PT_(31) PT_(32) PT_(33) PT_(34)
#undef PT_
        t[35] = (unsigned long long)args.out; t[36] = (unsigned long long)args.ws; t[37] = (unsigned long long)(unsigned)args.ph_lo;
    }
    __syncthreads();
}
__device__ __forceinline__ unsigned long long ldptr(LAS unsigned char* lds, int i) {
    unsigned a = (unsigned)(PTR_OFF + 8 * i); asm volatile("" : "+v"(a));
    const volatile LAS unsigned* t = (const volatile LAS unsigned*)(lds + a);
    const unsigned lo = __builtin_amdgcn_readfirstlane(t[0]), hi = __builtin_amdgcn_readfirstlane(t[1]);
    return ((unsigned long long)hi << 32) | lo;
}
#define INP(i) ((const float*)ldptr(lds, (i)))
namespace rw {
typedef short bf16x8 __attribute__((ext_vector_type(8)));
typedef float f4 __attribute__((ext_vector_type(4)));
constexpr int LS = 72;
constexpr int MB = 64 * LS * 2;
constexpr int O_AHN = 0, O_RHN = MB, O_BCN = 2 * MB, O_KCN = 3 * MB, O_AHT = 4 * MB, O_BTT = 5 * MB, O_KTT = 6 * MB, O_VT = 7 * MB, O_STT = 8 * MB,
              O_MAK = 9 * MB, O_MRB = 10 * MB, O_MRK = 11 * MB, O_TINV = 12 * MB, O_MABF = 13 * MB, O_GAM = 13 * MB + 16384, O_CT = O_GAM + 256, O_BON = O_CT + 4608, O_END = O_BON + 256;
constexpr int O_MVT = O_BCN, O_A2N = O_AHN, O_UT = O_KCN, O_YF = O_AHT;
constexpr int O_TAB = O_MAK, O_SCR = O_TAB + 26624, O_TOT = O_SCR + 8 * 1024, O_CUM = O_TOT + 2048;
static_assert(O_CUM + 16384 <= O_GAM && O_END <= LDS_BYTES - 576, "rwkv LDS map");

__device__ __forceinline__ bf16x8 ldfrag(const LAS unsigned char* lds, int off, int r0, int ks, int lane) {
    return *(const LAS bf16x8*)(lds + off + ((r0 + (lane & 15)) * LS + ks * 32 + (lane >> 4) * 8) * 2);
}
__device__ __forceinline__ void mm64(f4 (&acc)[2], const LAS unsigned char* lds, int offA, int offBt, int w, int lane) {
    const int tr = w >> 1; const bf16x8 a0 = ldfrag(lds, offA, tr * 16, 0, lane), a1 = ldfrag(lds, offA, tr * 16, 1, lane);
#pragma unroll
    for (int c = 0; c < 2; ++c) { const int tc = (w & 1) * 2 + c; const bf16x8 b0 = ldfrag(lds, offBt, tc * 16, 0, lane), b1 = ldfrag(lds, offBt, tc * 16, 1, lane);
        acc[c] = __builtin_amdgcn_mfma_f32_16x16x32_bf16(a0, b0, acc[c], 0, 0, 0); acc[c] = __builtin_amdgcn_mfma_f32_16x16x32_bf16(a1, b1, acc[c], 0, 0, 0); }
}
__device__ __forceinline__ void storeT(LAS unsigned char* lds, int off, const f4 (&acc)[2], int w, int lane) {
#pragma unroll
    for (int c = 0; c < 2; ++c) { const int col = ((w & 1) * 2 + c) * 16 + (lane & 15), row = (w >> 1) * 16 + 4 * (lane >> 4);
        u32x2 v; v.x = pk2(acc[c][0], acc[c][1]); v.y = pk2(acc[c][2], acc[c][3]); *(LAS u32x2*)(lds + off + (col * LS + row) * 2) = v; }
}
template <int MASK  >
__device__ __forceinline__ void storeN(LAS unsigned char* lds, int off, const f4 (&acc)[2], int w, int lane) {
#pragma unroll
    for (int c = 0; c < 2; ++c) { const int col = ((w & 1) * 2 + c) * 16 + (lane & 15), row = (w >> 1) * 16 + 4 * (lane >> 4);
#pragma unroll
        for (int e = 0; e < 4; ++e) { float x = acc[c][e]; if (MASK == 1) x = (col < row + e) ? x : 0.f; if (MASK == 2) x = (col <= row + e) ? x : 0.f;
            *(LAS bf16*)(lds + off + ((row + e) * LS + col) * 2) = (bf16)f2bf(x); } }
}
#define RW_ZERO(a) do { a[0] = (f4){0.f, 0.f, 0.f, 0.f}; a[1] = (f4){0.f, 0.f, 0.f, 0.f}; } while (0)

__device__ __forceinline__ void build_ct(LAS unsigned char* lds0, const int l, const int h, const int lane, const int wave) {
    LAS unsigned char* const& lds = lds0; const int c = h * 64 + lane;
    const float* mu = INP(I_CMU) + (size_t)l * 896;
    if (wave == 0) { LAS float* ct = (LAS float*)(lds0 + O_CT);
        ct[0 * 64 + lane] = mu[c]; ct[1 * 64 + lane] = mu[256 + c]; ct[2 * 64 + lane] = mu[512 + c]; ct[3 * 64 + lane] = mu[768 + lane]; ct[4 * 64 + lane] = mu[832 + lane];
        ct[5 * 64 + lane] = INP(I_CW0)[l * 256 + c]; ct[6 * 64 + lane] = INP(I_CA0)[l * 256 + c]; ct[7 * 64 + lane] = INP(I_CKK)[l * 256 + c]; ct[8 * 64 + lane] = INP(I_CKA)[l * 256 + c];
        ct[9 * 64 + lane] = INP(I_CRK)[l * 256 + c]; ct[10 * 64 + lane] = INP(I_CGNW)[l * 256 + c]; ct[11 * 64 + lane] = INP(I_CGNB)[l * 256 + c]; ct[12 * 64 + lane] = l > 0 ? INP(I_CV0)[(l - 1) * 256 + c] : 0.f;
        ct[13 * 64 + lane] = mu[512 + lane]; ct[14 * 64 + lane] = mu[512 + lane + 64]; ct[15 * 64 + lane] = mu[512 + lane + 128]; ct[16 * 64 + lane] = mu[512 + lane + 192]; }
}
template <int MODE>
__device__ __forceinline__ void chunk(LAS unsigned char* lds0, const int l, const int b, const int h, const int t0, unsigned char* gz, const bf16* P, bf16* VF, bf16* OB, const int tid0) {
    const int c = h * 64 + (tid0 & 63);
    {
        unsigned lb_ = 0u; int tid_l = tid0; asm volatile("" : "+v"(lb_), "+v"(tid_l));
        const int tid = tid_l, lane = tid & 63, wave = __builtin_amdgcn_readfirstlane(tid >> 6);
        LAS unsigned char* lds = lds0 + lb_;
        LAS bf16* TAB = (LAS bf16*)(lds + O_TAB);
        LAS float* scr = (LAS float*)(lds + O_SCR + wave * 1024);
        LAS float* CUM = (LAS float*)(lds + O_CUM);
        LAS float* TOT = (LAS float*)(lds + O_TOT);
        LAS float* GAM = (LAS float*)(lds + O_GAM);
        LAS float* MABF = (LAS float*)(lds + O_MABF);
        LAS float* YF = (LAS float*)(lds + O_YF);
        LAS float* BON = (LAS float*)(lds + O_BON);
        const LAS float* CT = (const LAS float*)(lds + O_CT);
#define CTV(k) CT[(k) * 64 + lane]
        { const float* cw2 = INP(I_CW2) + (size_t)l * 32 * 256; const float* ca2 = INP(I_CA2) + (size_t)l * 32 * 256; const float* cg2 = INP(I_CG2) + (size_t)l * 64 * 256;
          float tw[4], ta[4], tg[8];
#pragma unroll
          for (int u = 0; u < 4; ++u) { const int i = tid + u * NTHR; tw[u] = cw2[(i >> 6) * 256 + h * 64 + (i & 63)]; ta[u] = ca2[(i >> 6) * 256 + h * 64 + (i & 63)]; }
#pragma unroll
          for (int u = 0; u < 8; ++u) { const int i = tid + u * NTHR; tg[u] = cg2[(i >> 6) * 256 + h * 64 + (i & 63)]; }
          float t2[2], t1[8];
          if (l > 0) { const float* cv1 = INP(I_CV1) + (size_t)(l - 1) * 256 * 16; const float* cv2 = INP(I_CV2) + (size_t)(l - 1) * 16 * 256;
#pragma unroll
            for (int u = 0; u < 2; ++u) { const int i = tid + u * NTHR; t2[u] = cv2[(i >> 6) * 256 + h * 64 + (i & 63)]; }
#pragma unroll
            for (int u = 0; u < 8; ++u) t1[u] = cv1[tid + u * NTHR]; }
#pragma unroll
          for (int u = 0; u < 4; ++u) { TAB[tid + u * NTHR] = (bf16)f2bf(tw[u]); TAB[2048 + tid + u * NTHR] = (bf16)f2bf(ta[u]); }
#pragma unroll
          for (int u = 0; u < 8; ++u) TAB[4096 + tid + u * NTHR] = (bf16)f2bf(tg[u]);
          if (l > 0) {
#pragma unroll
            for (int u = 0; u < 2; ++u) TAB[8192 + tid + u * NTHR] = (bf16)f2bf(t2[u]);
#pragma unroll
            for (int u = 0; u < 8; ++u) TAB[9216 + tid + u * NTHR] = (bf16)f2bf(t1[u]); } }
        if (MODE == 3) { const u32x4 sv = ((const u32x4*)gz)[tid]; *(LAS u32x4*)(lds + O_STT + ((tid >> 3) * LS + (tid & 7) * 8) * 2) = sv; }
        float Xr[9];
#pragma unroll
        for (int j = 0; j < 9; ++j) { const int t = t0 + wave * 8 - 1 + j; Xr[j] = t >= 0 ? bf2f(P[((size_t)b * T + t) * PP + C_C + 768 + lane]) : 0.f; }
        __syncthreads();
        { float run = 0.f;
#pragma unroll
            for (int q = 0; q < 8; ++q) {
                const float xx = Xr[q + 1] + (Xr[q] - Xr[q + 1]) * CTV(3);
                scr[lane] = tanhf(xx);
                asm volatile("s_waitcnt lgkmcnt(0)" ::: "memory");
                float wsum = CTV(5);
#pragma unroll 8
                for (int mm = 0; mm < 32; ++mm) wsum += scr[mm] * bf2f(TAB[mm * 64 + lane]);
                run += -__expf(-softplusf_(-wsum) - 0.5f); CUM[(wave * 8 + q) * 64 + lane] = run;
                asm volatile("s_waitcnt lgkmcnt(0)" ::: "memory");
            }
            TOT[wave * 64 + lane] = run; }
        __syncthreads();
        float offs = 0.f, cumL = 0.f;
#pragma unroll
        for (int w2 = 0; w2 < 8; ++w2) { const float tw = TOT[w2 * 64 + lane]; offs += (w2 < wave) ? tw : 0.f; cumL += tw; }
        if (wave == 0) GAM[lane] = __expf(cumL);
#define LO_(x) __uint_as_float((x) << 16)
#define HI_(x) __uint_as_float((x) & 0xffff0000u)
#define RAW_LOAD(rk, vx, gg, v4a, v4b, vfv, tok) do { const int t_ = (tok); const bool ok_ = t_ >= 0; const size_t m_ = (size_t)b * T + (ok_ ? t_ : 0); const bf16* row_ = P + m_ * PP + C_C; \
            rk = ok_ ? ((unsigned)row_[c] | ((unsigned)row_[256 + c] << 16)) : 0u; vx = ok_ ? ((unsigned)row_[512 + c] | ((unsigned)row_[768 + lane] << 16)) : 0u; gg = ok_ ? (unsigned)row_[832 + lane] : 0u; \
            if (l > 0) { v4a = ok_ ? ((unsigned)row_[512 + lane] | ((unsigned)row_[512 + lane + 64] << 16)) : 0u; v4b = ok_ ? ((unsigned)row_[512 + lane + 128] | ((unsigned)row_[512 + lane + 192] << 16)) : 0u; vfv = (unsigned)VF[m_ * 256 + c]; } } while (0)
        unsigned pRK, pVX, pGG, pVa = 0u, pVb = 0u, pVF = 0u, cRK, cVX, cGG, cVa = 0u, cVb = 0u, cVF = 0u;
        RAW_LOAD(pRK, pVX, pGG, pVa, pVb, pVF, t0 + wave * 8 - 1); RAW_LOAD(cRK, cVX, cGG, cVa, cVb, cVF, t0 + wave * 8);
#pragma unroll 1
        for (int q = 0; q < 8; ++q) {
            const int tt = wave * 8 + q; const size_t m = (size_t)b * T + t0 + tt;
            unsigned nRK, nVX, nGG, nVa = 0u, nVb = 0u, nVF = 0u;
            RAW_LOAD(nRK, nVX, nGG, nVa, nVb, nVF, (q < 7) ? (t0 + tt + 1) : (t0 + tt));
            const float r = LO_(cRK) + (LO_(pRK) - LO_(cRK)) * CTV(0), k = HI_(cRK) + (HI_(pRK) - HI_(cRK)) * CTV(1); float v = LO_(cVX) + (LO_(pVX) - LO_(cVX)) * CTV(2);
            const float xx = HI_(cVX) + (HI_(pVX) - HI_(cVX)) * CTV(3), xg = LO_(cGG) + (LO_(pGG) - LO_(cGG)) * CTV(4);
            scr[lane] = lane < 32 ? tanhf(xx) : xx; scr[64 + lane] = sigmoidf_(xg);
            LAS bf16* vsc = (LAS bf16*)(scr + 128);
            if (l > 0) {
                vsc[lane] = (bf16)f2bf(LO_(cVa) + (LO_(pVa) - LO_(cVa)) * CTV(13)); vsc[lane + 64] = (bf16)f2bf(HI_(cVa) + (HI_(pVa) - HI_(cVa)) * CTV(14));
                vsc[lane + 128] = (bf16)f2bf(LO_(cVb) + (LO_(pVb) - LO_(cVb)) * CTV(15)); vsc[lane + 192] = (bf16)f2bf(HI_(cVb) + (HI_(pVb) - HI_(cVb)) * CTV(16));
            }
            asm volatile("s_waitcnt lgkmcnt(0)" ::: "memory");
            float wsum = CTV(5), asum = CTV(6), gsum = 0.f;
#pragma unroll 8
            for (int mm = 0; mm < 32; ++mm) { wsum += scr[mm] * bf2f(TAB[mm * 64 + lane]); asum += scr[32 + mm] * bf2f(TAB[2048 + mm * 64 + lane]); }
#pragma unroll 8
            for (int mm = 0; mm < 64; ++mm) gsum += scr[64 + mm] * bf2f(TAB[4096 + mm * 64 + lane]);
            if (l > 0) {
                const int qq = lane & 15, part = lane >> 4; float s = 0.f;
#pragma unroll 8
                for (int cc = 0; cc < 64; ++cc) s += bf2f(vsc[part * 64 + cc]) * bf2f(TAB[9216 + (part * 64 + cc) * 16 + qq]);
                s += __shfl_xor(s, 16); s += __shfl_xor(s, 32);
                float vl = CTV(12);
#pragma unroll
                for (int q2 = 0; q2 < 16; ++q2) vl += __shfl(s, q2) * bf2f(TAB[8192 + q2 * 64 + lane]);
                const float vf = LO_(cVF); v = v + (vf - v) * sigmoidf_(vl);
            } else if (MODE == 3) VF[m * 256 + c] = (bf16)f2bf(v);
            const float wlog = -softplusf_(-wsum) - 0.5f, asig = sigmoidf_(asum), lw = -__expf(wlog);
            float kk = k * CTV(7); const float n2 = wave_sum(kk * kk); kk = kk / fmaxf(sqrtf(n2), 1e-12f);
            const float kmod = k * (1.f + (asig - 1.f) * CTV(8));
            const float bon = wave_sum(r * kmod * CTV(9));
            const float cum = offs + CUM[tt * 64 + lane], cumx = cum - lw;
            const float ah = -kk * __expf(cumx), rh = r * __expf(cum), ei = __expf(-cum), bb = kk * asig, bc = bb * ei, kc = kmod * ei, ee = __expf(cumL - cum), bt = bb * ee, kt = kmod * ee;
            const int no = (tt * LS + lane) * 2, to = (lane * LS + tt) * 2;
            *(LAS bf16*)(lds + O_AHN + no) = (bf16)f2bf(ah); *(LAS bf16*)(lds + O_RHN + no) = (bf16)f2bf(rh);
            *(LAS bf16*)(lds + O_BCN + no) = (bf16)f2bf(bc); *(LAS bf16*)(lds + O_KCN + no) = (bf16)f2bf(kc); if (MODE == 3) OB[m * 1024 + 512 + c] = (bf16)f2bf(gsum);
            *(LAS bf16*)(lds + O_AHT + to) = (bf16)f2bf(ah); *(LAS bf16*)(lds + O_BTT + to) = (bf16)f2bf(bt);
            *(LAS bf16*)(lds + O_KTT + to) = (bf16)f2bf(kt); *(LAS bf16*)(lds + O_VT + to) = (bf16)f2bf(v);
            if (MODE == 3 && lane == 0) BON[tt] = bon;
            asm volatile("s_waitcnt lgkmcnt(0)" ::: "memory");
            pRK = cRK; pVX = cVX; pGG = cGG; pVa = cVa; pVb = cVb; cRK = nRK; cVX = nVX; cGG = nGG; cVa = nVa; cVb = nVb; cVF = nVF;
        }
#undef RAW_LOAD
        __syncthreads();
        { f4 acc[2];
            RW_ZERO(acc); mm64(acc, lds, O_AHN, O_BCN, wave, lane);
#pragma unroll
            for (int cI = 0; cI < 2; ++cI) { const int col = ((wave & 1) * 2 + cI) * 16 + (lane & 15), row = (wave >> 1) * 16 + 4 * (lane >> 4);
#pragma unroll
                for (int e = 0; e < 4; ++e) MABF[(row + e) * 64 + col] = (col < row + e) ? acc[cI][e] : 0.f; }
            RW_ZERO(acc); mm64(acc, lds, O_AHN, O_KCN, wave, lane); storeN<1>(lds, O_MAK, acc, wave, lane);
            if (MODE == 3) { f4 accb[2]; RW_ZERO(accb); mm64(accb, lds, O_RHN, O_BCN, wave, lane); f4 accc[2]; RW_ZERO(accc); mm64(accc, lds, O_RHN, O_KCN, wave, lane);
                storeN<2>(lds, O_MRB, accb, wave, lane); storeN<2>(lds, O_MRK, accc, wave, lane); }
        }
        __syncthreads();
        if (wave == 0) {
            float x[64]; x[0] = 0.f;
#pragma unroll
            for (int i = 1; i < 64; ++i) { float s = MABF[i * 64 + lane];
#pragma unroll
                for (int j4 = 0; j4 < (i + 3) / 4; ++j4) { const f4 m4 = *(const LAS f4*)(MABF + i * 64 + j4 * 4);
#pragma unroll
                    for (int e = 0; e < 4; ++e) if (j4 * 4 + e < i && j4 * 4 + e >= 1) s += m4[e] * x[j4 * 4 + e]; }
                x[i] = s; }
#pragma unroll
            for (int i = 0; i < 64; ++i) *(LAS bf16*)(lds + O_TINV + (i * LS + lane) * 2) = (bf16)f2bf(x[i]);
            asm volatile("s_waitcnt lgkmcnt(0)" ::: "memory");
            *(LAS bf16*)(lds + O_TINV + (lane * LS + lane) * 2) = (bf16)0x3F80;
        }
        __syncthreads();
        { f4 acc[2]; RW_ZERO(acc); mm64(acc, lds, O_MAK, O_VT, wave, lane); storeT(lds, O_MVT, acc, wave, lane); }
        __syncthreads();
        if (MODE == 1) {
            { f4 acc[2]; RW_ZERO(acc); mm64(acc, lds, O_TINV, O_AHT, wave, lane); storeT(lds, O_UT, acc, wave, lane); }
            { f4 acc[2]; RW_ZERO(acc); mm64(acc, lds, O_TINV, O_MVT, wave, lane); storeT(lds, O_MAK, acc, wave, lane); }
            __syncthreads();
            { f4 acc[2]; RW_ZERO(acc); mm64(acc, lds, O_BTT, O_UT, wave, lane);
#pragma unroll
              for (int cI = 0; cI < 2; ++cI) { const int col = ((wave & 1) * 2 + cI) * 16 + (lane & 15), row = (wave >> 1) * 16 + 4 * (lane >> 4);
#pragma unroll
                  for (int e = 0; e < 4; ++e) if (col == row + e) acc[cI][e] += GAM[col]; }
              storeN<0>(lds, O_AHN, acc, wave, lane); }
            { f4 acc[2]; RW_ZERO(acc); mm64(acc, lds, O_BTT, O_MAK, wave, lane); mm64(acc, lds, O_KTT, O_VT, wave, lane); storeT(lds, O_RHN, acc, wave, lane); }
            __syncthreads();
            ((u32x4*)gz)[tid] = *(const LAS u32x4*)(lds + O_AHN + ((tid >> 3) * LS + (tid & 7) * 8) * 2);
            ((u32x4*)(gz + 8192))[tid] = *(const LAS u32x4*)(lds + O_RHN + ((tid >> 3) * LS + (tid & 7) * 8) * 2);
        } else {
            { f4 acc[2]; RW_ZERO(acc); mm64(acc, lds, O_TINV, O_AHT, wave, lane); storeN<0>(lds, O_A2N, acc, wave, lane); }
            __syncthreads();
            { f4 acc[2]; RW_ZERO(acc); mm64(acc, lds, O_TINV, O_MVT, wave, lane); mm64(acc, lds, O_A2N, O_STT, wave, lane); storeT(lds, O_UT, acc, wave, lane); }
            __syncthreads();
            f4 yacc[2]; RW_ZERO(yacc);
            mm64(yacc, lds, O_RHN, O_STT, wave, lane); mm64(yacc, lds, O_MRB, O_UT, wave, lane); mm64(yacc, lds, O_MRK, O_VT, wave, lane);
            __syncthreads();
#pragma unroll
            for (int cI = 0; cI < 2; ++cI) { const int col = ((wave & 1) * 2 + cI) * 16 + (lane & 15), row = (wave >> 1) * 16 + 4 * (lane >> 4);
#pragma unroll
                for (int e = 0; e < 4; ++e) YF[(row + e) * 64 + col] = yacc[cI][e]; }
            __syncthreads();
            { unsigned gcur = (unsigned)OB[((size_t)b * T + t0 + wave * 8) * 1024 + 512 + c];
#pragma unroll 1
            for (int q = 0; q < 8; ++q) {
                const int tt = wave * 8 + q; const size_t m = (size_t)b * T + t0 + tt;
                const unsigned gnxt = (unsigned)OB[(m + (q < 7 ? 1 : 0)) * 1024 + 512 + c];
                const float y = YF[tt * 64 + lane]; const float mean = wave_sum(y) * (1.f / 64.f); const float dy = y - mean; const float var = wave_sum(dy * dy) * (1.f / 64.f);
                const float yn = dy * rsqrtf(var + 64e-5f) * CTV(10) + CTV(11);
                const float vv = bf2f(*(const LAS bf16*)(lds + O_VT + (lane * LS + tt) * 2)), gg = LO_(gcur);
                OB[m * 1024 + 512 + c] = (bf16)f2bf((yn + BON[tt] * vv) * gg);
                gcur = gnxt;
            } }
        }
        __syncthreads();
#undef CTV
#undef LO_
#undef HI_
    }
}

__device__ __forceinline__ void carry(LAS unsigned char* lds0, unsigned char* gzc  , const int tid0) {
    f4 stacc[2]; RW_ZERO(stacc);
    { unsigned lb_ = 0u; asm volatile("" : "+v"(lb_)); LAS unsigned char* lds = lds0 + lb_; for (int i = tid0; i < MB / 4; i += NTHR) ((LAS unsigned*)(lds + O_STT))[i] = 0u; }
    u32x4 gnx = ((const u32x4*)gzc)[tid0];
#pragma unroll 1
    for (int cI = 0; cI < T / 64; ++cI) {
        unsigned lb_ = 0u; int tid_l = tid0; asm volatile("" : "+v"(lb_), "+v"(tid_l));
        LAS unsigned char* lds = lds0 + lb_; const int tid = tid_l, lane = tid & 63, wave = __builtin_amdgcn_readfirstlane(tid >> 6);
        unsigned char* rec = gzc + (size_t)cI * 16384;
        const int io = ((tid >> 3) * LS + (tid & 7) * 8) * 2;
        *(LAS u32x4*)(lds + O_AHN + io) = gnx;
        u32x2 zv[2];
#pragma unroll
        for (int k = 0; k < 2; ++k) { const int col = ((wave & 1) * 2 + k) * 16 + (lane & 15), row = (wave >> 1) * 16 + 4 * (lane >> 4); zv[k] = *(const u32x2*)(rec + 8192 + (col * 64 + row) * 2); }
        if (cI + 1 < T / 64) gnx = ((const u32x4*)(rec + 16384))[tid];
        __syncthreads();
        ((u32x4*)rec)[tid] = *(const LAS u32x4*)(lds + O_STT + io);
        f4 acc[2];
#pragma unroll
        for (int k = 0; k < 2; ++k) acc[k] = (f4){__uint_as_float(zv[k].x << 16), __uint_as_float(zv[k].x & 0xffff0000u), __uint_as_float(zv[k].y << 16), __uint_as_float(zv[k].y & 0xffff0000u)};
        mm64(acc, lds, O_AHN, O_STT, wave, lane);
        __syncthreads();
        storeT(lds, O_STT, acc, wave, lane);
    }
}
}

namespace mb {
using rw::LS; using rw::MB; using rw::f4; using rw::mm64; using rw::storeN; using rw::bf16x8;
constexpr int O_CN = 0, O_BN = MB, O_BT = 2 * MB, O_XT0 = 3 * MB, O_XW0 = 5 * MB, O_CS0 = 7 * MB, O_HN0 = 9 * MB, O_SC0 = 11 * MB, O_SM = 13 * MB, O_YF = O_XW0;
static_assert(O_SM + 2048 <= LDS_BYTES - 576, "mamba LDS map");
__device__ __forceinline__ void chain(LAS unsigned char* lds0, const int l, const int b, const int gI, const bf16* P, bf16* OB, const int tid0, const int lane0, const int wave0) {
    const int tid = tid0, lane = lane0, wave = wave0;
    LAS unsigned char* const& lds = lds0;
    const float* cwp = INP(I_DCW) + (size_t)l * 4 * 512; const float* cbp = INP(I_DCB) + (size_t)l * 512;
    const int cc = tid & 255, sub = tid >> 8;
    const int col = cc < 128 ? (gI * 128 + cc) : (cc < 192 ? (256 + gI * 64 + (cc - 128)) : (384 + gI * 64 + (cc - 192)));
    const float cw0 = cwp[col], cw1 = cwp[512 + col], cw2 = cwp[1024 + col], cw3 = cwp[1536 + col], cb = cbp[col];
    f4 hacc[2][2];
#pragma unroll
    for (int hh = 0; hh < 2; ++hh) { hacc[hh][0] = (f4){0.f, 0.f, 0.f, 0.f}; hacc[hh][1] = (f4){0.f, 0.f, 0.f, 0.f}; }
    for (int i = tid; i < 2 * MB / 4; i += NTHR) ((LAS unsigned*)(lds0 + O_HN0))[i] = 0u;
    const float dtb0 = INP(I_DDTB)[l * 4 + gI * 2], dtb1 = INP(I_DDTB)[l * 4 + gI * 2 + 1];
    const float nA0 = -__expf(INP(I_DALOG)[l * 4 + gI * 2]), nA1 = -__expf(INP(I_DALOG)[l * 4 + gI * 2 + 1]);
    const float dsk0 = INP(I_DSKIP)[l * 4 + gI * 2], dsk1 = INP(I_DSKIP)[l * 4 + gI * 2 + 1];
    const float nw0 = INP(I_DNW)[l * 256 + gI * 128 + lane], nw1 = INP(I_DNW)[l * 256 + gI * 128 + 64 + lane];
#pragma unroll 1
    for (int t0 = 0; t0 < T; t0 += 64) {
        unsigned lb_ = 0u; int tid_l = tid0; asm volatile("" : "+v"(lb_), "+v"(tid_l));
        const int tid = tid_l, lane = tid & 63, wave = __builtin_amdgcn_readfirstlane(tid >> 6);
        LAS unsigned char* lds = lds0 + lb_;
        LAS float* SM = (LAS float*)(lds + O_SM);
        LAS float* YF = (LAS float*)(lds + O_YF);
        if (wave < 2) {
            const size_t m = (size_t)b * T + t0 + lane;
            const float dt = softplusf_(bf2f(P[m * PP + C_DT + gI * 2 + wave]) + (wave == 0 ? dtb0 : dtb1));
            float cs = dt * (wave == 0 ? nA0 : nA1);
#pragma unroll
            for (int o = 1; o < 64; o <<= 1) { const float y = __shfl_up(cs, o); if (lane >= o) cs += y; }
            const float cL = __shfl(cs, 63);
            SM[wave * 64 + lane] = dt; SM[128 + wave * 64 + lane] = cs; SM[256 + wave * 64 + lane] = __expf(cL - cs) * dt; SM[384 + wave * 64 + lane] = __expf(cs);
        }
        __syncthreads();
        { float h0, h1, h2, cur[8], nxt[8];
          { const int tb = t0 + sub * 32; h0 = tb >= 3 ? bf2f(P[((size_t)b * T + tb - 3) * PP + C_DX + col]) : 0.f; h1 = tb >= 2 ? bf2f(P[((size_t)b * T + tb - 2) * PP + C_DX + col]) : 0.f; h2 = tb >= 1 ? bf2f(P[((size_t)b * T + tb - 1) * PP + C_DX + col]) : 0.f;
#pragma unroll
            for (int j = 0; j < 8; ++j) cur[j] = bf2f(P[((size_t)b * T + tb + j) * PP + C_DX + col]); }
#pragma unroll 1
          for (int g8 = 0; g8 < 4; ++g8) {
            const int tb = t0 + sub * 32 + g8 * 8 + (g8 < 3 ? 8 : 0);
#pragma unroll
            for (int j = 0; j < 8; ++j) nxt[j] = bf2f(P[((size_t)b * T + tb + j) * PP + C_DX + col]);
#pragma unroll
            for (int j = 0; j < 8; ++j) {
                const int tt = sub * 32 + g8 * 8 + j;
                const float a = siluf_(cb + cw3 * cur[j] + cw2 * h2 + cw1 * h1 + cw0 * h0);
                h0 = h1; h1 = h2; h2 = cur[j];
                if (cc < 128) { const int hh = cc >> 6, p = cc & 63;
                    *(LAS bf16*)(lds + O_XT0 + hh * MB + (p * LS + tt) * 2) = (bf16)f2bf(a); *(LAS bf16*)(lds + O_XW0 + hh * MB + (p * LS + tt) * 2) = (bf16)f2bf(a * SM[256 + hh * 64 + tt]); }
                else if (cc < 192) { const int n = cc - 128; *(LAS bf16*)(lds + O_BN + (tt * LS + n) * 2) = (bf16)f2bf(a); *(LAS bf16*)(lds + O_BT + (n * LS + tt) * 2) = (bf16)f2bf(a); }
                else { const int n = cc - 192; *(LAS bf16*)(lds + O_CN + (tt * LS + n) * 2) = (bf16)f2bf(a);
                    *(LAS bf16*)(lds + O_CS0 + (tt * LS + n) * 2) = (bf16)f2bf(a * SM[384 + tt]); *(LAS bf16*)(lds + O_CS0 + MB + (tt * LS + n) * 2) = (bf16)f2bf(a * SM[384 + 64 + tt]); }
            }
#pragma unroll
            for (int j = 0; j < 8; ++j) cur[j] = nxt[j];
          } }
        __syncthreads();
        { f4 acc[2]; acc[0] = (f4){0.f, 0.f, 0.f, 0.f}; acc[1] = (f4){0.f, 0.f, 0.f, 0.f}; mm64(acc, lds, O_CN, O_BN, wave, lane);
#pragma unroll
            for (int hh = 0; hh < 2; ++hh) { f4 sc[2];
#pragma unroll
                for (int cI = 0; cI < 2; ++cI) { const int s = ((wave & 1) * 2 + cI) * 16 + (lane & 15), row = (wave >> 1) * 16 + 4 * (lane >> 4);
                    const float cs = SM[128 + hh * 64 + s], ds = SM[hh * 64 + s];
#pragma unroll
                    for (int e = 0; e < 4; ++e) { const float ct = SM[128 + hh * 64 + row + e]; sc[cI][e] = (s <= row + e) ? acc[cI][e] * __expf(ct - cs) * ds : 0.f; } }
                storeN<0>(lds, O_SC0 + hh * MB, sc, wave, lane); } }
        __syncthreads();
        f4 yacc[2][2];
#pragma unroll
        for (int hh = 0; hh < 2; ++hh) {
            yacc[hh][0] = (f4){0.f, 0.f, 0.f, 0.f}; yacc[hh][1] = (f4){0.f, 0.f, 0.f, 0.f};
            mm64(yacc[hh], lds, O_SC0 + hh * MB, O_XT0 + hh * MB, wave, lane); mm64(yacc[hh], lds, O_CS0 + hh * MB, O_HN0 + hh * MB, wave, lane);
            const float gL = SM[384 + hh * 64 + 63]; hacc[hh][0] = hacc[hh][0] * gL; hacc[hh][1] = hacc[hh][1] * gL;
            mm64(hacc[hh], lds, O_XW0 + hh * MB, O_BT, wave, lane);
        }
        __syncthreads();
#pragma unroll
        for (int hh = 0; hh < 2; ++hh) {
#pragma unroll
            for (int cI = 0; cI < 2; ++cI) { const int colp = ((wave & 1) * 2 + cI) * 16 + (lane & 15), row = (wave >> 1) * 16 + 4 * (lane >> 4);
#pragma unroll
                for (int e = 0; e < 4; ++e) YF[(row + e) * 128 + hh * 64 + colp] = yacc[hh][cI][e]; }
            storeN<0>(lds, O_HN0 + hh * MB, hacc[hh], wave, lane);
        }
        __syncthreads();
#pragma unroll
        for (int q = 0; q < 8; ++q) {
            const int tt = wave * 8 + q; const size_t m = (size_t)b * T + t0 + tt;
            const float x0 = bf2f(*(const LAS bf16*)(lds + O_XT0 + (lane * LS + tt) * 2)), x1 = bf2f(*(const LAS bf16*)(lds + O_XT0 + MB + (lane * LS + tt) * 2));
            const int c0 = gI * 128 + lane, c1 = c0 + 64;
            const float z0 = bf2f(P[m * PP + C_DZ + c0]), z1 = bf2f(P[m * PP + C_DZ + c1]);
            const float y0 = (YF[tt * 128 + lane] + dsk0 * x0) * siluf_(z0), y1 = (YF[tt * 128 + 64 + lane] + dsk1 * x1) * siluf_(z1);
            const float ss = wave_sum(y0 * y0 + y1 * y1); const float rs = rsqrtf(ss * (1.f / 128.f) + 1e-5f);
            OB[m * 1024 + 768 + c0] = (bf16)f2bf(y0 * rs * nw0); OB[m * 1024 + 768 + c1] = (bf16)f2bf(y1 * rs * nw1);
        }
        __syncthreads();
    }
}
}

namespace bsp {
typedef short bf16x8 __attribute__((ext_vector_type(8)));
typedef float f4 __attribute__((ext_vector_type(4)));
constexpr int HS = 129;
constexpr int O_HIST = 0;
constexpr int O_V = 66048;
constexpr int VS = 264;
constexpr int O_FLAG = O_V + 32 * VS * 2;
__device__ __forceinline__ unsigned okey(float s) { const float gq = s * __builtin_amdgcn_rcpf(1.f + fabsf(s)); int q = (int)((gq + 1.f) * 8388608.f); q = q < 1 ? 1 : (q > 16777215 ? 16777215 : q); return (unsigned)q << 8; }

__device__ __forceinline__ f4 idx_tile(const bf16* Pb, const int kt, const bf16x8 (&qi)[4][2], const float (&wq)[4], const int lane) {
    const bf16* kr = Pb + (size_t)(kt * 16 + (lane & 15)) * PP + C_IK + (lane >> 4) * 8;
    const bf16x8 a0 = *(const bf16x8*)kr, a1 = *(const bf16x8*)(kr + 32);
    f4 s = (f4){0.f, 0.f, 0.f, 0.f};
#pragma unroll
    for (int h = 0; h < 4; ++h) { f4 t = (f4){0.f, 0.f, 0.f, 0.f};
        t = __builtin_amdgcn_mfma_f32_16x16x32_bf16(a0, qi[h][0], t, 0, 0, 0); t = __builtin_amdgcn_mfma_f32_16x16x32_bf16(a1, qi[h][1], t, 0, 0, 0);
#pragma unroll
        for (int e = 0; e < 4; ++e) s[e] += wq[h] * fmaxf(t[e], 0.f); }
    return s;
}

__device__ __forceinline__ void item(LAS unsigned char* lds0, const int bb, const int qb, const bf16* P, bf16* OB, const int tid0, const int pm) {
    unsigned lb_ = 0u; int tid_l = tid0; asm volatile("" : "+v"(lb_), "+v"(tid_l));
    LAS unsigned char* lds = lds0 + lb_; const int tid = tid_l, lane = tid & 63, wave = __builtin_amdgcn_readfirstlane(tid >> 6);
    const bf16* Pb = P + (size_t)bb * T * PP;
    const int ql = wave * 16 + (lane & 15), tq = qb * 128 + ql, g = lane >> 4;
    const bf16* prow = Pb + (size_t)tq * PP;
    bf16x8 qi[4][2]; float wq[4];
#pragma unroll
    for (int h = 0; h < 4; ++h) { qi[h][0] = *(const bf16x8*)(prow + C_IQ + h * 64 + g * 8); qi[h][1] = *(const bf16x8*)(prow + C_IQ + h * 64 + 32 + g * 8); wq[h] = bf2f(prow[C_IW + h]) * 0.0625f; }
    LAS unsigned* hist = (LAS unsigned*)(lds + O_HIST) + ql * HS;
    const int nkt = (qb + 1) * 8;
    unsigned prefix = 0u; int needk = 256;
#pragma unroll 1
    for (int rr = 0; rr < (pm == 102 ? 2 : 1); ++rr) { prefix = 0u; needk = 256;
#pragma unroll 1
    for (int pass = 0; pass < 3; ++pass) {
        for (int i = lane; i < 16 * HS; i += 64) ((LAS unsigned*)(lds + O_HIST) + wave * 16 * HS)[i] = 0u;
        asm volatile("s_waitcnt lgkmcnt(0)" ::: "memory");
        const int shp = 32 - 8 * pass, shb = 24 - 8 * pass;
#pragma unroll 1
        for (int kt4 = 0; kt4 < nkt; kt4 += 4) {
            bf16x8 ka[4][2];
#pragma unroll
            for (int u = 0; u < 4; ++u) { const bf16* kr = Pb + (size_t)((kt4 + u) * 16 + (lane & 15)) * PP + C_IK + g * 8; ka[u][0] = *(const bf16x8*)kr; ka[u][1] = *(const bf16x8*)(kr + 32); }
#pragma unroll
            for (int u = 0; u < 4; ++u) {
                f4 s = (f4){0.f, 0.f, 0.f, 0.f};
#pragma unroll
                for (int h = 0; h < 4; ++h) { f4 t = (f4){0.f, 0.f, 0.f, 0.f};
                    t = __builtin_amdgcn_mfma_f32_16x16x32_bf16(ka[u][0], qi[h][0], t, 0, 0, 0); t = __builtin_amdgcn_mfma_f32_16x16x32_bf16(ka[u][1], qi[h][1], t, 0, 0, 0);
#pragma unroll
                    for (int e = 0; e < 4; ++e) s[e] += wq[h] * fmaxf(t[e], 0.f); }
#pragma unroll
                for (int e = 0; e < 4; ++e) { const int key = (kt4 + u) * 16 + 4 * g + e; const unsigned k32 = okey(s[e]);
                    const bool in = key <= tq && (pass == 0 || (k32 >> shp) == prefix);
                    if (in) { const unsigned bin = (k32 >> shb) & 255u; __hip_atomic_fetch_add(hist + (bin >> 1), (bin & 1u) ? 0x10000u : 1u, __ATOMIC_RELAXED, __HIP_MEMORY_SCOPE_WORKGROUP); } }
            }
        }
        asm volatile("s_waitcnt lgkmcnt(0)" ::: "memory");
        int cum = 0; unsigned bsel = 0u; int above = 0;
        for (int wd = 127; wd >= 0; --wd) { const unsigned v = hist[wd]; const int hi = (int)(v >> 16), lo = (int)(v & 0xffffu);
            if (cum + hi >= needk) { bsel = (unsigned)(2 * wd + 1); above = cum; break; } cum += hi;
            if (cum + lo >= needk) { bsel = (unsigned)(2 * wd); above = cum; break; } cum += lo; }
        prefix = (prefix << 8) | bsel; needk -= above;
        asm volatile("s_waitcnt lgkmcnt(0)" ::: "memory");
    }
    }
    unsigned thr = prefix; int cidx = 1 << 20;
    bool tie = false;
    if (tq < 256) thr = 0u;
    else { const unsigned v = hist[(prefix & 255u) >> 1]; const int ceq = (prefix & 1u) ? (int)(v >> 16) : (int)(v & 0xffffu); tie = needk < ceq; }
    if (__any(tie)) {
        int cbin = 0, rem = needk;
#pragma unroll 1
        for (int ip = 0; ip < 2; ++ip) {
            for (int i = g; i < HS; i += 4) hist[i] = 0u;
            asm volatile("s_waitcnt lgkmcnt(0)" ::: "memory");
#pragma unroll 1
            for (int kt = 0; kt < nkt; ++kt) {
                const f4 s = idx_tile(Pb, kt, qi, wq, lane);
#pragma unroll
                for (int e = 0; e < 4; ++e) { const int key = kt * 16 + 4 * g + e; const unsigned k32 = okey(s[e]);
                    const bool in = tie && key <= tq && (k32 >> 8) == prefix && (ip == 0 || (key >> 4) == cbin);
                    if (in) { const unsigned bin = ip == 0 ? (unsigned)(key >> 4) : (unsigned)(key & 15); __hip_atomic_fetch_add(hist + (bin >> 1), (bin & 1u) ? 0x10000u : 1u, __ATOMIC_RELAXED, __HIP_MEMORY_SCOPE_WORKGROUP); } }
            }
            asm volatile("s_waitcnt lgkmcnt(0)" ::: "memory");
            int cum = 0, bs = 0, below = 0;
            for (int wd = 0; wd < 128; ++wd) { const unsigned vv = hist[wd]; const int lo = (int)(vv & 0xffffu), hi = (int)(vv >> 16);
                if (cum + lo >= rem) { bs = 2 * wd; below = cum; break; } cum += lo;
                if (cum + hi >= rem) { bs = 2 * wd + 1; below = cum; break; } cum += hi; }
            if (ip == 0) { cbin = bs; rem -= below; } else if (tie) cidx = cbin * 16 + bs;
            asm volatile("s_waitcnt lgkmcnt(0)" ::: "memory");
        }
    }
    __syncthreads();
    bf16x8 qa[4][2];
#pragma unroll
    for (int h = 0; h < 4; ++h) { qa[h][0] = *(const bf16x8*)(prow + C_BQ + h * 64 + g * 8); qa[h][1] = *(const bf16x8*)(prow + C_BQ + h * 64 + 32 + g * 8); }
    f4 oacc[4][4]; float mrun[4], lrun[4];
#pragma unroll
    for (int h = 0; h < 4; ++h) { mrun[h] = -INFINITY; lrun[h] = 0.f;
#pragma unroll
        for (int dt = 0; dt < 4; ++dt) oacc[h][dt] = (f4){0.f, 0.f, 0.f, 0.f}; }
    LAS bf16* VL = (LAS bf16*)(lds + O_V);
#pragma unroll 1
    for (int rr = 0; rr < (pm == 103 ? 2 : 1); ++rr) {
#pragma unroll
    for (int h = 0; h < 4; ++h) { mrun[h] = -INFINITY; lrun[h] = 0.f;
#pragma unroll
        for (int dt = 0; dt < 4; ++dt) oacc[h][dt] = (f4){0.f, 0.f, 0.f, 0.f}; }
    const int nst = (qb + 1) * 4;
    const int vkey = tid >> 4, vch = tid & 15;
    u32x4 vpre0 = *(const u32x4*)(Pb + (size_t)vkey * PP + C_BV + vch * 8), vpre1 = *(const u32x4*)(Pb + (size_t)vkey * PP + C_BV + 128 + vch * 8);
#pragma unroll 1
    for (int st = 0; st < nst; ++st) {
        const int key0 = st * 32;
        __syncthreads();
        *(LAS u32x4*)(VL + vkey * VS + vch * 8) = vpre0; *(LAS u32x4*)(VL + vkey * VS + 128 + vch * 8) = vpre1;
        if (st + 1 < nst) { vpre0 = *(const u32x4*)(Pb + (size_t)(key0 + 32 + vkey) * PP + C_BV + vch * 8); vpre1 = *(const u32x4*)(Pb + (size_t)(key0 + 32 + vkey) * PP + C_BV + 128 + vch * 8); }
        __syncthreads();
        bool sel[2][4];
#pragma unroll
        for (int k2 = 0; k2 < 2; ++k2) { const f4 s = idx_tile(Pb, st * 2 + k2, qi, wq, lane);
#pragma unroll
            for (int e = 0; e < 4; ++e) { const int key = key0 + k2 * 16 + 4 * g + e; const unsigned k24 = okey(s[e]) >> 8;
                sel[k2][e] = key <= tq && (k24 > thr || (k24 == thr && key <= cidx)); } }
#pragma unroll
        for (int h = 0; h < 4; ++h) {
            f4 sc[2];
#pragma unroll
            for (int k2 = 0; k2 < 2; ++k2) { const bf16* kr = Pb + (size_t)(key0 + k2 * 16 + (lane & 15)) * PP + C_BK + h * 64 + g * 8;
                const bf16x8 a0 = *(const bf16x8*)kr, a1 = *(const bf16x8*)(kr + 32);
                f4 t = (f4){0.f, 0.f, 0.f, 0.f};
                t = __builtin_amdgcn_mfma_f32_16x16x32_bf16(a0, qa[h][0], t, 0, 0, 0); t = __builtin_amdgcn_mfma_f32_16x16x32_bf16(a1, qa[h][1], t, 0, 0, 0);
#pragma unroll
                for (int e = 0; e < 4; ++e) sc[k2][e] = sel[k2][e] ? t[e] * 0.125f : -INFINITY; }
            float mx = fmaxf(fmaxf(fmaxf(sc[0][0], sc[0][1]), fmaxf(sc[0][2], sc[0][3])), fmaxf(fmaxf(sc[1][0], sc[1][1]), fmaxf(sc[1][2], sc[1][3])));
            mx = fmaxf(mx, __shfl_xor(mx, 16)); mx = fmaxf(mx, __shfl_xor(mx, 32));
            const float mnew = fmaxf(mrun[h], mx), msafe = (mnew == -INFINITY) ? 0.f : mnew;
            const float corr = __expf(mrun[h] - msafe); mrun[h] = mnew;
            float p[8]; float ps = 0.f;
#pragma unroll
            for (int e = 0; e < 4; ++e) { p[e] = __expf(sc[0][e] - msafe); p[4 + e] = __expf(sc[1][e] - msafe); ps += p[e] + p[4 + e]; }
            lrun[h] = lrun[h] * corr + ps;
            bf16x8 pb;
#pragma unroll
            for (int e = 0; e < 8; ++e) pb[e] = (short)f2bf(p[e]);
#pragma unroll
            for (int dt = 0; dt < 4; ++dt) {
                bf16x8 vf;
                const LAS bf16* vb = VL + (4 * g) * VS + h * 64 + dt * 16 + (lane & 15);
#pragma unroll
                for (int e = 0; e < 4; ++e) { vf[e] = (short)vb[e * VS]; vf[4 + e] = (short)vb[(16 + e) * VS]; }
                oacc[h][dt] = oacc[h][dt] * corr;
                oacc[h][dt] = __builtin_amdgcn_mfma_f32_16x16x32_bf16(vf, pb, oacc[h][dt], 0, 0, 0);
            }
        }
    }
    }
    const size_t m = (size_t)bb * T + tq;
#pragma unroll
    for (int h = 0; h < 4; ++h) { float l = lrun[h]; l += __shfl_xor(l, 16); l += __shfl_xor(l, 32); const float inv = 1.f / l;
#pragma unroll
        for (int dt = 0; dt < 4; ++dt) { u32x2 w; w.x = pk2(oacc[h][dt][0] * inv, oacc[h][dt][1] * inv); w.y = pk2(oacc[h][dt][2] * inv, oacc[h][dt][3] * inv);
            *(u32x2*)(OB + m * 1024 + 256 + h * 64 + dt * 16 + 4 * g) = w; } }
    __syncthreads();
}
}

namespace awin {
typedef short bf16x8 __attribute__((ext_vector_type(8)));
typedef float f4 __attribute__((ext_vector_type(4)));
constexpr int EXS = 66;
constexpr int O_EX = 0;
constexpr int VSW = 72;
constexpr int O_VW = 101376;
__device__ __forceinline__ void item(LAS unsigned char* lds0, const int bb, const int blk, const int h, const bf16* P, bf16* OB, const int tid0) {
    unsigned lb_ = 0u; int tid_l = tid0; asm volatile("" : "+v"(lb_), "+v"(tid_l));
    LAS unsigned char* lds = lds0 + lb_; const int tid = tid_l, lane = tid & 63, wave = __builtin_amdgcn_readfirstlane(tid >> 6);
    const bf16* Pb = P + (size_t)bb * T * PP; const int start = blk * 128, g = lane >> 4, ln = lane & 15;
    LAS float* EX = (LAS float*)(lds + O_EX);
    LAS bf16* VW = (LAS bf16*)(lds + O_VW + wave * 4608);
#pragma unroll 1
    for (int s4 = 0; s4 < 4; ++s4) {
        const int st = wave * 4 + s4;
        const int grp = st < 8 ? 0 : (st < 16 ? 1 : 2);
        const int dil = grp == 0 ? 1 : (grp == 1 ? 4 : 16), win = grp == 0 ? 128 : (grp == 1 ? 512 : 2048);
        const int r = grp == 0 ? 0 : (grp == 1 ? ((st - 8) >> 1) : (st - 16)), a0 = grp == 0 ? 16 * st : (grp == 1 ? ((st - 8) & 1) * 16 : 0), nqc = grp == 0 ? 128 : (grp == 1 ? 32 : 8);
        const int a = a0 + ln; const bool qok = a < nqc; const int ql = (qok ? a : (nqc - 1)) * dil + r, tq = start + ql;
        const bf16* qp = Pb + (size_t)tq * PP + C_AQ + grp * 256 + h * 64 + g * 8;
        const bf16x8 q0 = *(const bf16x8*)qp, q1 = *(const bf16x8*)(qp + 32);
        bf16x8 kf[10][2];
#pragma unroll
        for (int kt = 0; kt < 10; ++kt) { int pos = start - win + (a0 + 16 * kt + ln) * dil + r; pos = pos < 0 ? 0 : (pos > T - 1 ? T - 1 : pos);
            const bf16* kp = Pb + (size_t)pos * PP + C_AK + grp * 256 + h * 64 + g * 8; kf[kt][0] = *(const bf16x8*)kp; kf[kt][1] = *(const bf16x8*)(kp + 32); }
        f4 sc[10]; float mx = -INFINITY;
#pragma unroll
        for (int kt = 0; kt < 10; ++kt) { f4 t = (f4){0.f, 0.f, 0.f, 0.f};
            t = __builtin_amdgcn_mfma_f32_16x16x32_bf16(kf[kt][0], q0, t, 0, 0, 0); t = __builtin_amdgcn_mfma_f32_16x16x32_bf16(kf[kt][1], q1, t, 0, 0, 0);
#pragma unroll
            for (int e = 0; e < 4; ++e) { const int c = a0 + 16 * kt + 4 * g + e; const int pos = start - win + c * dil + r;
                const bool ok = qok && c >= a && c <= a + 128 && pos >= 0;
                sc[kt][e] = ok ? t[e] * 0.125f : -INFINITY; mx = fmaxf(mx, sc[kt][e]); } }
        mx = fmaxf(mx, __shfl_xor(mx, 16)); mx = fmaxf(mx, __shfl_xor(mx, 32));
        const float msafe = (mx == -INFINITY) ? 0.f : mx; float lsum = 0.f;
#pragma unroll
        for (int kt = 0; kt < 10; ++kt)
#pragma unroll
            for (int e = 0; e < 4; ++e) { sc[kt][e] = __expf(sc[kt][e] - msafe); lsum += sc[kt][e]; }
        lsum += __shfl_xor(lsum, 16); lsum += __shfl_xor(lsum, 32);
        f4 oacc[4];
#pragma unroll
        for (int dt = 0; dt < 4; ++dt) oacc[dt] = (f4){0.f, 0.f, 0.f, 0.f};
#pragma unroll
        for (int s5 = 0; s5 < 5; ++s5) {
            int pos = start - win + (a0 + 32 * s5 + (lane >> 1)) * dil + r; pos = pos < 0 ? 0 : (pos > T - 1 ? T - 1 : pos);
            const u32x4* vp = (const u32x4*)(Pb + (size_t)pos * PP + C_AV + grp * 256 + h * 64 + (lane & 1) * 32);
            const u32x4 v0 = vp[0], v1 = vp[1], v2 = vp[2], v3 = vp[3];
            LAS u32x4* vd = (LAS u32x4*)(VW + (lane >> 1) * VSW + (lane & 1) * 32);
            asm volatile("s_waitcnt lgkmcnt(0)" ::: "memory");
            vd[0] = v0; vd[1] = v1; vd[2] = v2; vd[3] = v3;
            asm volatile("s_waitcnt lgkmcnt(0)" ::: "memory");
            bf16x8 pb;
#pragma unroll
            for (int e = 0; e < 4; ++e) { pb[e] = (short)f2bf(sc[2 * s5][e]); pb[4 + e] = (short)f2bf(sc[2 * s5 + 1][e]); }
#pragma unroll
            for (int dt = 0; dt < 4; ++dt) { bf16x8 vf; const LAS bf16* vb = VW + (4 * g) * VSW + dt * 16 + ln;
#pragma unroll
                for (int e = 0; e < 4; ++e) { vf[e] = (short)vb[e * VSW]; vf[4 + e] = (short)vb[(16 + e) * VSW]; }
                oacc[dt] = __builtin_amdgcn_mfma_f32_16x16x32_bf16(vf, pb, oacc[dt], 0, 0, 0); }
        }
        if (qok) { LAS float* ex = EX + (grp * 128 + ql) * EXS;
#pragma unroll
            for (int dt = 0; dt < 4; ++dt) { ex[dt * 16 + 4 * g + 0] = oacc[dt][0]; ex[dt * 16 + 4 * g + 1] = oacc[dt][1]; ex[dt * 16 + 4 * g + 2] = oacc[dt][2]; ex[dt * 16 + 4 * g + 3] = oacc[dt][3]; }
            if (g == 0) { ex[64] = mx; ex[65] = lsum; } }
    }
    __syncthreads();
    { const int ql = tid >> 2, d0 = (tid & 3) * 16;
      const LAS float* e0 = EX + (0 * 128 + ql) * EXS; const LAS float* e1 = EX + (1 * 128 + ql) * EXS; const LAS float* e2 = EX + (2 * 128 + ql) * EXS;
      const float m0 = e0[64], m1 = e1[64], m2 = e2[64], M = fmaxf(m0, fmaxf(m1, m2));
      const float w0 = __expf(m0 - M), w1 = __expf(m1 - M), w2 = __expf(m2 - M); const float inv = 1.f / (w0 * e0[65] + w1 * e1[65] + w2 * e2[65]);
      unsigned pk[8];
#pragma unroll
      for (int j = 0; j < 8; ++j) { const float x0 = (w0 * e0[d0 + 2 * j] + w1 * e1[d0 + 2 * j] + w2 * e2[d0 + 2 * j]) * inv, x1 = (w0 * e0[d0 + 2 * j + 1] + w1 * e1[d0 + 2 * j + 1] + w2 * e2[d0 + 2 * j + 1]) * inv; pk[j] = pk2(x0, x1); }
      u32x4* op = (u32x4*)(OB + ((size_t)bb * T + start + ql) * 1024 + h * 64 + d0);
      op[0] = (u32x4){pk[0], pk[1], pk[2], pk[3]}; op[1] = (u32x4){pk[4], pk[5], pk[6], pk[7]}; }
    __syncthreads();
}
}

template <int SP>
__device__ __forceinline__ void phase_body(const int l_in, LAS unsigned char* lds) {
    int tid_ = threadIdx.x, bid_ = blockIdx.x, l_ = l_in, G_ = gridDim.x; asm volatile("" : "+v"(tid_), "+s"(bid_), "+s"(l_), "+s"(G_));
    const int tid = tid_, lane = tid & 63, wave = __builtin_amdgcn_readfirstlane(tid >> 6), l = l_;
    const int G = G_, bid = bid_;
    const int gw = bid * NWAVES + wave, NGW = G * NWAVES;
    unsigned char* ws = (unsigned char*)ldptr(lds, 36);
    int* ctl = (int*)(ws + WS_CTL);
    bf16* XB = (bf16*)(ws + WS_XB); bf16* OB = (bf16*)(ws + WS_O); bf16* VF = (bf16*)(ws + WS_VF); bf16* P = (bf16*)(ws + WS_P);
    bf16* GS = (bf16*)(ws + WS_GS); bf16* MG = (bf16*)(ws + WS_MERGED); bf16* XS = (bf16*)(ws + WS_XS); bf16* HB = (bf16*)(ws + WS_H);
    bf16* WGU = (bf16*)(ws + WS_WGU); bf16* WD = (bf16*)(ws + WS_WD);
    float* X = (float*)ldptr(lds, 35);
    int* tok_e = (int*)(ws + WS_ROUTE); float* tok_g = (float*)(ws + WS_ROUTE + 256 * 1024); int* tok_rank = (int*)(ws + WS_ROUTE + 512 * 1024); int* tok_slot = (int*)(ws + WS_ROUTE + 768 * 1024);
    (void)ctl; (void)XB; (void)OB; (void)VF; (void)P; (void)GS; (void)MG; (void)XS; (void)HB; (void)WGU; (void)WD; (void)X; (void)tok_e; (void)tok_g; (void)tok_rank; (void)tok_slot; (void)gw; (void)NGW; (void)lane;
    {
        bf16* WinT = (bf16*)(ws + WS_WINT) + (size_t)l * 5120 * 1024; bf16* WgT = (bf16*)(ws + WS_WGT) + (size_t)l * 4096 * 1024;
        bf16* WbrT = (bf16*)(ws + WS_WBRT) + (size_t)l * 1024 * 1024; bf16* WoutT = (bf16*)(ws + WS_WOUTT) + (size_t)l * 1024 * 1024;
        float* WrT = (float*)(ws + WS_WRT) + (size_t)l * 36 * 1024;
        int* cnt = ctl + CW_CNT + l * 64;

        if constexpr (SP == -1) {
            LAS float* scr = (LAS float*)(lds + wave * 16384);
#pragma unroll 1
            for (int job = 0; job < NL * 11; ++job) {
                const int ll = job / 11, jk = job % 11;
                if (jk < 5) {
                    const float* W = INP(I_WIN) + (size_t)ll * 1024 * INW;
                    const int sc0 = jk == 0 ? 0 : (jk == 1 ? 3396 : (jk == 2 ? 3392 : (jk == 3 ? 5060 : 5064)));
                    const int snc = jk == 0 ? 3392 : (jk == 1 ? 1664 : (jk == 4 ? 4096 : 4));
                    const int sr0 = jk == 0 ? 0 : (jk == 1 ? 3392 : (jk == 2 ? 5056 : (jk == 3 ? 5060 : 0)));
                    bf16* dst = jk == 4 ? (bf16*)(ws + WS_WGT) + (size_t)ll * 4096 * 1024 : (bf16*)(ws + WS_WINT) + (size_t)ll * 5120 * 1024;
                    const int nbn = (snc + 31) / 32, nit = 16 * nbn;
#pragma unroll 1
                    for (int it = gw; it < nit; it += NGW) transpose_item(W, INW, sc0, snc, dst, 1024, sr0, 0, it / nbn, it % nbn, scr, lane);
                } else if (jk < 9) {
                    const int n = jk - 5; const float* Wb = INP(I_WBR) + ((size_t)ll * 4 + n) * 256 * 1024;
#pragma unroll 1
                    for (int it = gw; it < 4 * 32; it += NGW) transpose_item(Wb, 1024, 0, 1024, (bf16*)(ws + WS_WBRT) + (size_t)ll * 1024 * 1024, 1024, 0, n * 256, it / 32, it % 32, scr, lane);
                } else if (jk == 9) {
                    const float* Wo = INP(I_WOUT) + (size_t)ll * 1024 * 1024;
#pragma unroll 1
                    for (int it = gw; it < 16 * 32; it += NGW) transpose_item(Wo, 1024, 0, 1024, (bf16*)(ws + WS_WOUTT) + (size_t)ll * 1024 * 1024, 1024, 0, 0, it / 32, it % 32, scr, lane);
                } else {
                    bf16* wi = (bf16*)(ws + WS_WINT) + (size_t)ll * 5120 * 1024;
#pragma unroll 1
                    for (int i = gw * 64 + lane; i < 56 * 1024 / 8; i += NGW * 64) ((u32x4*)(wi + (size_t)5064 * 1024))[i] = (u32x4){0u, 0u, 0u, 0u};
                    float* wr = (float*)(ws + WS_WRT) + (size_t)ll * 36 * 1024; const float* rg = INP(I_RG) + (size_t)ll * 1024 * 4; const float* re = INP(I_RE) + (size_t)ll * 1024 * 32;
#pragma unroll 1
                    for (int i = gw * 64 + lane; i < 36 * 1024; i += NGW * 64) { const int o = i / 1024, k = i % 1024; wr[i] = o < 4 ? rg[k * 4 + o] : re[k * 32 + (o - 4)]; }
                }
            }
            for (int m = gw; m < M; m += NGW) {
                const f32x4* xr = (const f32x4*)(INP(I_X) + (size_t)m * D) + lane;
#pragma unroll
                for (int j = 0; j < 4; ++j) { const f32x4 v = xr[64 * j]; ((f32x4*)(X + (size_t)m * D))[lane + 64 * j] = v;
                    u32x2 w; w.x = pk2(v[0], v[1]); w.y = pk2(v[2], v[3]); ((u32x2*)(XB + (size_t)m * D))[lane + 64 * j] = w; }
            }
        }
        else if constexpr (SP == 0) {
            pg8::Gemm g{XB, WinT, 1024, 1024, 1024}; pg8::StaticOrder S; S.init(M, PP, G, bid, 1024, 1024);
            EpiStoreBf16 E{P, PP, 0, PP};
            pg8::gemm_phase<EpiStoreBf16, pg8::StaticOrder>(lds, g, S, E);
        }
        else if constexpr (SP == 1) {
#pragma unroll 1
            for (int it = bid; it < NB * 32 * 4; it += G) awin::item(lds, it >> 7, (it >> 2) & 31, it & 3, P, OB, tid);
        }
        else if constexpr (SP == 2) {
#pragma unroll 1
            for (int it = bid; it < NB * 32; it += G) bsp::item(lds, it >> 5, 31 - (it & 31), P, OB, tid, (int)(unsigned)ldptr(lds, 37));
        }
        else if constexpr (SP == 3) {
            unsigned char* GZ = ws + WS_RW;
            if (bid < 16) {
                mb::chain(lds, l, bid >> 1, bid & 1, P, OB, tid, lane, wave);
            } else {
                const int h = (bid - 16) & 3, k = (bid - 16) >> 2;
                rw::build_ct(lds, l, h, lane, wave); __syncthreads();
#pragma unroll 1
                for (int idx = k; idx < 512; idx += 60) { const int b = idx >> 6, cI = idx & 63;
                    rw::chunk<1>(lds, l, b, h, cI * 64, GZ + ((size_t)((b * 4 + h) * 64 + cI)) * 16384, P, VF, OB, tid); }
            }
        }
        else if constexpr (SP == 12) {
            if (bid < 32) rw::carry(lds, ws + WS_RW + (size_t)bid * 64 * 16384, tid);
        }
        else if constexpr (SP == 13) {
            unsigned char* GZ = ws + WS_RW;
            const int h = bid & 3, k = bid >> 2;
            rw::build_ct(lds, l, h, lane, wave); __syncthreads();
#pragma unroll 1
            for (int idx = k; idx < 512; idx += (G >> 2)) { const int b = idx >> 6, cI = idx & 63;
                rw::chunk<3>(lds, l, b, h, cI * 64, GZ + ((size_t)((b * 4 + h) * 64 + cI)) * 16384, P, VF, OB, tid); }
        }
        else if constexpr (SP == 15) {
            unsigned char* GZ = ws + WS_RW;
            int* qctr = ctl + CW_Q + l * 64;
            unsigned so = (unsigned)(LDS_BYTES - 584); asm volatile("" : "+v"(so));
            volatile LAS int* slot = (volatile LAS int*)(lds + so);
            int cur_h = -1;
#pragma unroll 1
            for (;;) {
                __syncthreads();
                if (tid == 0) *slot = atomicAdd(qctr, 1);
                __syncthreads();
                const int it = __builtin_amdgcn_readfirstlane(*slot);
                if (it >= 3344) break;
                if (it < 16) { mb::chain(lds, l, it >> 1, it & 1, P, OB, tid, lane, wave); }
                else if (it < 272) { const int j = it - 16; bsp::item(lds, j & 7, 31 - (j >> 3), P, OB, tid, (int)(unsigned)ldptr(lds, 37)); }
                else if (it < 2320) { const int j = it - 272, h = j >> 9, idx = j & 511, b = idx >> 6, cI = idx & 63;
                    if (h != cur_h) { rw::build_ct(lds, l, h, lane, wave); cur_h = h; __syncthreads(); }
                    rw::chunk<1>(lds, l, b, h, cI * 64, GZ + ((size_t)((b * 4 + h) * 64 + cI)) * 16384, P, VF, OB, tid); }
                else { const int j = it - 2320; awin::item(lds, j >> 7, (j >> 2) & 31, j & 3, P, OB, tid); }
            }
        }
        else if constexpr (SP == 4) {
            pg8::Gemm g{XB, WgT, 1024, 1024, 1024}; pg8::StaticOrder S; S.init(M, 4096, G, bid, 1024, 1024);
            EpiStoreBf16 E{GS, 4096, 1, 4096};
            pg8::gemm_phase<EpiStoreBf16, pg8::StaticOrder>(lds, g, S, E);
        }
        else if constexpr (SP == 5) {
            pg8::Gemm g{OB, WbrT, 1024, 1024, 256}; BranchOrder S{M / 256, 4, G, bid};
            EpiBranch E{GS, MG};
            pg8::gemm_phase<EpiBranch, BranchOrder>(lds, g, S, E);
        }
        else if constexpr (SP == 6) {
            pg8::Gemm g{MG, WoutT, 1024, 1024, 1024}; pg8::StaticOrder S; S.init(M, 1024, G, bid, 1024, 1024);
            EpiResid E{X};
            pg8::gemm_phase<EpiResid, pg8::StaticOrder>(lds, g, S, E);
        }
        else if constexpr (SP == 7) {
            const float* g1 = INP(I_LN1G) + l * 1024; const float* b1 = INP(I_LN1B) + l * 1024;
            const float* rgb = INP(I_RGB) + l * 4; const float* reb = INP(I_REB) + l * 32;
            for (int m = gw; m < M; m += NGW) {
                f32x4 v[4]; float s = 0.f; f32x4* xr = (f32x4*)(X + (size_t)m * D) + lane;
#pragma unroll
                for (int j = 0; j < 4; ++j) { v[j] = xr[64 * j]; s += (v[j][0] + v[j][1]) + (v[j][2] + v[j][3]); }
                const float mean = wave_sum(s) * (1.f / D); float s2 = 0.f;
#pragma unroll
                for (int j = 0; j < 4; ++j) { v[j] = v[j] - mean; s2 += (v[j][0] * v[j][0] + v[j][1] * v[j][1]) + (v[j][2] * v[j][2] + v[j][3] * v[j][3]); }
                const float rstd = rsqrtf(wave_sum(s2) * (1.f / D) + LN_EPS);
#pragma unroll
                for (int j = 0; j < 4; ++j) { const f32x4 gg = ((const f32x4*)g1)[lane + 64 * j], bb = ((const f32x4*)b1)[lane + 64 * j]; v[j] = v[j] * rstd * gg + bb; xr[64 * j] = v[j];
                    u32x2 w; w.x = pk2(v[j][0], v[j][1]); w.y = pk2(v[j][2], v[j][3]); ((u32x2*)(XB + (size_t)m * D))[lane + 64 * j] = w; }
                float mylg = 0.f;
#pragma unroll 1
                for (int o = 0; o < 36; ++o) { float a = 0.f;
#pragma unroll
                    for (int j = 0; j < 4; ++j) { const f32x4 wv = ((const f32x4*)(WrT + o * 1024))[lane + 64 * j]; a += v[j][0] * wv[0] + v[j][1] * wv[1] + v[j][2] * wv[2] + v[j][3] * wv[3]; }
                    a = wave_sum(a); mylg = (lane == o) ? a : mylg; }
                mylg += lane < 4 ? rgb[lane & 3] : (lane < 36 ? reb[(lane - 4) & 31] : 0.f);
                float gl[4]; float gm = -INFINITY; int gs = 0;
#pragma unroll
                for (int o = 0; o < 4; ++o) { gl[o] = __shfl(mylg, o); if (gl[o] > gm) { gm = gl[o]; gs = o; } }
                float gden = 0.f;
#pragma unroll
                for (int o = 0; o < 4; ++o) gden += __expf(gl[o] - gm);
                const float pg = 1.f / gden;
                float el[8];
#pragma unroll
                for (int o = 0; o < 8; ++o) el[o] = __shfl(mylg, 4 + gs * 8 + o);
                int e1 = 0; float m1 = el[0];
#pragma unroll
                for (int o = 1; o < 8; ++o) if (el[o] > m1) { m1 = el[o]; e1 = o; }
                int e2 = -1; float m2 = -INFINITY;
#pragma unroll
                for (int o = 0; o < 8; ++o) if (o != e1 && el[o] > m2) { m2 = el[o]; e2 = o; }
                const float r2 = __expf(m2 - m1); const float ga = pg / (1.f + r2), gb = pg * r2 / (1.f + r2);
                if (lane == 0) {
                    const int E1 = gs * 8 + e1, E2 = gs * 8 + e2;
                    tok_e[m * 2] = E1; tok_e[m * 2 + 1] = E2; tok_g[m * 2] = ga; tok_g[m * 2 + 1] = gb;
                    tok_rank[m * 2] = atomicAdd(&cnt[E1], 1); tok_rank[m * 2 + 1] = atomicAdd(&cnt[E2], 1);
                }
            }
        }
        else if constexpr (SP == 14) {
            LAS float* scr = (LAS float*)(lds + wave * 16384);
            const float* eg = INP(I_EG) + (size_t)l * NEXP * 1024 * 512; const float* eu = INP(I_EU) + (size_t)l * NEXP * 1024 * 512; const float* ed = INP(I_ED) + (size_t)l * NEXP * 512 * 1024;
            for (int it = gw; it < NEXP * 2 * 4 * 64; it += NGW) {
                const int e = it / 512, r = it % 512, half = r / 256, ct = (r % 256) / 64, q = r % 64, kb = q / 4, nb = q % 4;
                const float* W = (half ? eu : eg) + (size_t)e * 1024 * 512;
                transpose_item(W, 512, ct * 128, 128, WGU + (size_t)e * 1024 * 1024, 1024, ct * 256 + half * 128, 0, kb, nb, scr, lane);
            }
            for (int it = gw; it < NEXP * 8 * 32; it += NGW) {
                const int e = it / 256, q = it % 256, kb = q / 32, nb = q % 32;
                transpose_item(ed + (size_t)e * 512 * 1024, 1024, 0, 1024, WD + (size_t)e * 1024 * 512, 512, 0, 0, kb, nb, scr, lane);
            }
        }
        else if constexpr (SP == 8 || SP == 9 || SP == 10) {
            unsigned tbo = MISC_OFF; asm volatile("" : "+v"(tbo));
            volatile LAS int* tb = (volatile LAS int*)(lds + tbo);
            if (tid == 0) { int acc = 0; for (int e = 0; e < 32; ++e) { const int c = __hip_atomic_load(&cnt[e], __ATOMIC_RELAXED, __HIP_MEMORY_SCOPE_AGENT); tb[e] = acc; tb[33 + e] = acc; acc += (c + 255) >> 8; } tb[32] = acc; }
            __syncthreads();
            if constexpr (SP == 8) {
                for (int m = gw; m < M; m += NGW) {
#pragma unroll
                    for (int k = 0; k < 2; ++k) { const int e = tok_e[m * 2 + k]; const int slot = tb[33 + e] * 256 + tok_rank[m * 2 + k];
                        const u32x4* src = (const u32x4*)(XB + (size_t)m * D); u32x4* dst = (u32x4*)(XS + (size_t)slot * D);
                        dst[lane] = src[lane]; dst[lane + 64] = src[lane + 64];
                        if (lane == 0) tok_slot[m * 2 + k] = slot; }
                }
            } else if constexpr (SP == 9) {
                pg8::Gemm g{XS, WGU, 1024, 1024, 1024}; MoeOrder S{tb, G, bid, (size_t)1024 * 2, (size_t)1024 * 1024 * 2, (size_t)256 * 1024 * 2};
                EpiSwiglu E{HB};
                pg8::gemm_phase<EpiSwiglu, MoeOrder>(lds, g, S, E);
            } else {
                pg8::Gemm g{HB, WD, 512, 512, 512}; MoeOrder S{tb, G, bid, (size_t)512 * 2, (size_t)1024 * 512 * 2, (size_t)256 * 512 * 2};
                EpiStoreBf16 E{XS, 1024, 0, 1024};
                pg8::gemm_phase<EpiStoreBf16, MoeOrder>(lds, g, S, E);
            }
        }
        else if constexpr (SP == 11) {
            const float* g2 = INP(I_LN2G) + l * 1024; const float* b2 = INP(I_LN2B) + l * 1024;
            for (int m = gw; m < M; m += NGW) {
                const int s1 = tok_slot[m * 2], s2i = tok_slot[m * 2 + 1]; const float ga = tok_g[m * 2], gb = tok_g[m * 2 + 1];
                f32x4 v[4]; float s = 0.f; f32x4* xr = (f32x4*)(X + (size_t)m * D) + lane;
#pragma unroll
                for (int j = 0; j < 4; ++j) { v[j] = xr[64 * j] * ALPHA;
                    const u32x2 y1 = ((const u32x2*)(XS + (size_t)s1 * D))[lane + 64 * j], y2 = ((const u32x2*)(XS + (size_t)s2i * D))[lane + 64 * j];
                    v[j][0] += ga * __uint_as_float(y1.x << 16) + gb * __uint_as_float(y2.x << 16); v[j][1] += ga * __uint_as_float(y1.x & 0xffff0000u) + gb * __uint_as_float(y2.x & 0xffff0000u);
                    v[j][2] += ga * __uint_as_float(y1.y << 16) + gb * __uint_as_float(y2.y << 16); v[j][3] += ga * __uint_as_float(y1.y & 0xffff0000u) + gb * __uint_as_float(y2.y & 0xffff0000u);
                    s += (v[j][0] + v[j][1]) + (v[j][2] + v[j][3]); }
                const float mean = wave_sum(s) * (1.f / D); float s2 = 0.f;
#pragma unroll
                for (int j = 0; j < 4; ++j) { v[j] = v[j] - mean; s2 += (v[j][0] * v[j][0] + v[j][1] * v[j][1]) + (v[j][2] * v[j][2] + v[j][3] * v[j][3]); }
                const float rstd = rsqrtf(wave_sum(s2) * (1.f / D) + LN_EPS);
#pragma unroll
                for (int j = 0; j < 4; ++j) { const f32x4 gg = ((const f32x4*)g2)[lane + 64 * j], bb = ((const f32x4*)b2)[lane + 64 * j]; v[j] = v[j] * rstd * gg + bb; xr[64 * j] = v[j];
                    u32x2 w; w.x = pk2(v[j][0], v[j][1]); w.y = pk2(v[j][2], v[j][3]); ((u32x2*)(XB + (size_t)m * D))[lane + 64 * j] = w; }
            }
        }
    }
}

template <int SP>
__global__ void __launch_bounds__(NTHR, 2) k_phase(Args args, int l) {
    extern __shared__ __attribute__((aligned(16))) unsigned char lds_raw[];
    ptr_table_fill(args, (LAS unsigned char*)lds_raw);
    phase_body<SP>(l, (LAS unsigned char*)lds_raw);
}


#define XB_TMO      128
#define XB_XCNT(j)  (256  + 64 * (j))
#define XB_XSUB(j)  (1280 + 64 * (j))
#define XB_XGEN(j)  (2304 + 64 * (j))
#define XB_TOP      3328
#define XB_TOPGEN   3392
#define XCD_BAR_WORDS 3456
#define XB_SPIN_CAP (1u << 22)
__device__ __forceinline__ unsigned xb_ld(unsigned* p)              { return __hip_atomic_load(p, __ATOMIC_RELAXED, __HIP_MEMORY_SCOPE_AGENT); }
__device__ __forceinline__ unsigned xb_add(unsigned* p, unsigned v) { return __hip_atomic_fetch_add(p, v, __ATOMIC_RELAXED, __HIP_MEMORY_SCOPE_AGENT); }
__device__ __forceinline__ unsigned xb_xcc_id() { return (unsigned)__builtin_amdgcn_s_getreg((3 << 11) | 20) & 0xFu; }
#define XB_SPIN(cond, bar) do { unsigned _sp = 0; while (cond) { __builtin_amdgcn_s_sleep(1); \
    if ((++_sp & 255u) == 0u) { if (xb_ld(&(bar)[XB_TMO])) break; if (_sp > XB_SPIN_CAP) { atomicAdd(&(bar)[XB_TMO], 1u); break; } } } } while (0)
__device__ __forceinline__ void xcd_barrier_complete(unsigned* bar, unsigned x, unsigned& nloc, unsigned& nx) {
    const unsigned G = gridDim.x;
    unsigned sum, cnt, mine, sp = 0u;
    for (;;) {
        sum = 0u; cnt = 0u; mine = 0u;
#pragma unroll
        for (unsigned j = 0; j < 16; ++j) { const unsigned c = xb_ld(&bar[XB_XCNT(j)]); sum += c; cnt += (c > 0u) ? 1u : 0u; mine = (j == x) ? c : mine; }
        if (sum == G) break;
        __builtin_amdgcn_s_sleep(1);
        if ((++sp & 255u) == 0u) { if (xb_ld(&bar[XB_TMO])) break; if (sp > XB_SPIN_CAP) { atomicAdd(&bar[XB_TMO], 1u); break; } }
    }
    nloc = mine > 0u ? mine : 1u; nx = cnt > 0u ? cnt : 1u;
}
__device__ __forceinline__ void xcd_barrier(unsigned* bar, LAS unsigned char* lds) {
    asm volatile("s_waitcnt vmcnt(0)" ::: "memory");
    __syncthreads();
    int tid_ = threadIdx.x; asm volatile("" : "+v"(tid_));
    if (tid_ == 0) {
        unsigned so = (unsigned)(LDS_BYTES - 576); asm volatile("" : "+v"(so));
        volatile LAS unsigned* st = (volatile LAS unsigned*)(lds + so);
        __builtin_amdgcn_s_waitcnt(0);
        const unsigned x = xb_xcc_id();
        unsigned nloc = st[0], nx = st[1];
        if (nloc == 0u) { xcd_barrier_complete(bar, x, nloc, nx); st[0] = nloc; st[1] = nx; }
        const unsigned old = xb_add(&bar[XB_XSUB(x)], 1u);
        const unsigned gen = old / nloc;
        if (old + 1u == (gen + 1u) * nloc) {
            __builtin_amdgcn_fence(__ATOMIC_RELEASE, "agent");
            asm volatile("s_waitcnt vmcnt(0)" ::: "memory");
            const unsigned og = xb_add(&bar[XB_TOP], 1u);
            const unsigned tg = og / nx;
            if (og + 1u == (tg + 1u) * nx) xb_add(&bar[XB_TOPGEN], 1u);
            else XB_SPIN(xb_ld(&bar[XB_TOPGEN]) == tg, bar);
            __builtin_amdgcn_fence(__ATOMIC_ACQUIRE, "agent");
            xb_add(&bar[XB_XGEN(x)], 1u);
            asm volatile("s_waitcnt vmcnt(0)" ::: "memory");
        } else {
            XB_SPIN(xb_ld(&bar[XB_XGEN(x)]) == gen, bar);
            __builtin_amdgcn_fence(__ATOMIC_ACQUIRE, "agent");
            asm volatile("s_waitcnt vmcnt(0)" ::: "memory");
        }
    }
    __syncthreads();
}
namespace cg = cooperative_groups;
__global__ void __launch_bounds__(NTHR, 2) fwd_all(Args args) {
    extern __shared__ __attribute__((aligned(16))) unsigned char lds_raw[];
    LAS unsigned char* lds = (LAS unsigned char*)lds_raw;
    unsigned* bar = (unsigned*)(args.ws + WS_CTL) + CW_BAR;
    if (threadIdx.x == 0) { ((volatile LAS unsigned*)(lds + LDS_BYTES - 576))[0] = 0u; ((volatile LAS unsigned*)(lds + LDS_BYTES - 576))[1] = 0u; (void)xb_add(&bar[XB_XCNT(xb_xcc_id())], 1u); }
    ptr_table_fill(args, lds);
    const int probe = args.ph_lo;
    { constexpr int l = 0;
#pragma unroll 1
      for (int r_ = 0; r_ < ((probe == -1) ? 2 : 1); ++r_) { phase_body<-1>(l, lds); __syncthreads(); } }
    cg::this_grid().sync();
#define GRID_BAR() do { unsigned* bar_ = (unsigned*)ldptr(lds, 36) + CW_BAR; xcd_barrier(bar_, lds); } while (0)
#define RUN(SP) do { _Pragma("unroll 1") for (int r_ = 0; r_ < ((probe == (SP)) ? 2 : 1); ++r_) { phase_body<SP>(l, lds); __syncthreads(); } } while (0)
#define ONCE(SP) do { phase_body<SP>(l, lds); __syncthreads(); } while (0)
#define LAYER() \
        RUN(0); GRID_BAR(); \
        ONCE(15); GRID_BAR(); \
        ONCE(12); GRID_BAR(); \
        RUN(13); GRID_BAR(); \
        RUN(4); GRID_BAR(); \
        RUN(5); GRID_BAR(); \
        ONCE(6); GRID_BAR(); \
        ONCE(7); RUN(14); GRID_BAR(); \
        RUN(8); GRID_BAR(); \
        RUN(9); GRID_BAR(); \
        RUN(10); GRID_BAR(); \
        ONCE(11); GRID_BAR();
    { constexpr int l = 0; LAYER() }
    { constexpr int l = 1; LAYER() }
#undef LAYER
#undef RUN
#undef ONCE
#undef GRID_BAR
}

template <int SP> static void launch_phase(const Args& a, int l, int grid, hipStream_t stream) {
    static bool attr = false;
    if (!attr) { (void)hipFuncSetAttribute((const void*)k_phase<SP>, hipFuncAttributeMaxDynamicSharedMemorySize, LDS_BYTES); attr = true; }
    hipLaunchKernelGGL(k_phase<SP>, dim3(grid), dim3(NTHR), LDS_BYTES, stream, a, l);
}

extern "C" void kernel_launch(void* const* d_in, const int* in_sizes, int n_in, void* d_out, int out_size, void* d_ws, size_t ws_size, hipStream_t stream) {
    static int grid = 0;
    if (grid == 0) {
        if (n_in != 35 || out_size != M * D || ws_size < WS_END) { fprintf(stderr, "kernel_launch: unexpected problem (n_in %d out %d ws %zu)\n", n_in, out_size, ws_size); grid = -1; return; }
        int dev = 0, cus = 0, per_cu = 0;
        (void)hipGetDevice(&dev); (void)hipDeviceGetAttribute(&cus, hipDeviceAttributeMultiprocessorCount, dev);
#if N_LAUNCH_MODE == 1
        (void)hipFuncSetAttribute((const void*)fwd_all, hipFuncAttributeMaxDynamicSharedMemorySize, LDS_BYTES);
        if (hipOccupancyMaxActiveBlocksPerMultiprocessor(&per_cu, (const void*)fwd_all, NTHR, LDS_BYTES) != hipSuccess || per_cu < 1) { fprintf(stderr, "kernel_launch: occupancy query says %d blocks/CU\n", per_cu); grid = -1; return; }
#endif
        (void)per_cu;
        grid = cus;
        if (grid != 256) { fprintf(stderr, "kernel_launch: built for 256 CUs, found %d\n", cus); grid = -1; return; }
    }
    if (grid < 0) return;
    (void)hipMemsetAsync((char*)d_ws + WS_CTL, 0, CTL_BYTES, stream);
    Args a{};
    for (int i = 0; i < 35; ++i) a.in[i] = (const float*)d_in[i];
    a.out = (float*)d_out; a.ws = (unsigned char*)d_ws;
#if N_LAUNCH_MODE == 1
    a.ph_lo = PROBE_REPS;
    void* kargs[] = {(void*)&a};
    hipError_t e = hipLaunchCooperativeKernel((const void*)fwd_all, dim3(grid), dim3(NTHR), kargs, LDS_BYTES, stream);
    if (e != hipSuccess) fprintf(stderr, "cooperative launch failed: %s\n", hipGetErrorString(e));
#else
    launch_phase<-1>(a, 0, grid, stream);
    for (int l = 0; l < NL; ++l) {
        launch_phase<0>(a, l, grid, stream); launch_phase<15>(a, l, grid, stream); launch_phase<12>(a, l, grid, stream); launch_phase<13>(a, l, grid, stream);
        launch_phase<4>(a, l, grid, stream); launch_phase<5>(a, l, grid, stream); launch_phase<6>(a, l, grid, stream); launch_phase<7>(a, l, grid, stream); launch_phase<14>(a, l, grid, stream);
        launch_phase<8>(a, l, grid, stream); launch_phase<9>(a, l, grid, stream); launch_phase<10>(a, l, grid, stream); launch_phase<11>(a, l, grid, stream);
    }
#endif
}
```

```cpp
#include <hip/hip_runtime.h>
#include <cstdio>
#include <cstdint>
#include <hip/hip_cooperative_groups.h>

#ifndef PROBE_REPS
#define PROBE_REPS -100
#endif
#ifndef N_LAUNCH_MODE
#define N_LAUNCH_MODE 1
#endif

namespace pg8 {
#define PG8_LAS __attribute__((address_space(3)))
typedef unsigned short bf16_t;
typedef short bf16x8 __attribute__((ext_vector_type(8)));
typedef float f32x4 __attribute__((ext_vector_type(4)));
typedef unsigned u32x4 __attribute__((ext_vector_type(4)));
constexpr int BM = 256, BK = 64, HALF = 128, HTB = HALF * BK * 2, STAGE_BYTES = 8 * HTB, NXCD = 8, WGM = 8;

__host__ __device__ __forceinline__ int lds_byte(int r, int c) { const int st = (r >> 4) * 2 + (c >> 5), rr = r & 15, cc = c & 31, ob = rr * 64 + cc * 2; return st * 1024 + (ob ^ (((ob >> 9) & 1) << 5)); }
__host__ __device__ __forceinline__ void stage_rc(int b, int& R, int& C) { const int st = b / 1024, sb = b % 1024, swz = sb ^ (((sb >> 9) & 1) << 5); R = (st >> 1) * 16 + swz / 64; C = (st & 1) * 32 + (swz % 64) / 2; }
__host__ __device__ __forceinline__ int perm32(int rho) { const int n = rho >> 4, i = rho & 15; return 8 * (i >> 2) + 4 * n + (i & 3); }

struct Unit { int pm, pn, aux; size_t aoff, boff; };
struct Gemm { const bf16_t* A; const bf16_t* Bt; int lda, ldb, K; };

__device__ __forceinline__ void tile_of(int L, int nM, int nN, int& pm, int& pn) {
    const int nwg = nM * nN; int wgid = L;
    { const int q = nwg / NXCD, r = nwg % NXCD, xcd = wgid % NXCD, off = wgid / NXCD; wgid = (xcd < r ? xcd * (q + 1) : r * (q + 1) + (xcd - r) * q) + off; }
    const int nig = WGM * nN, gid = wgid / nig, fm = gid * WGM, gsz = (nM - fm) < WGM ? (nM - fm) : WGM;
    pm = fm + ((wgid % nig) % gsz); pn = (wgid % nig) / gsz;
}
struct StaticOrder {
    int nM, nN, nwg, G, c, lda, ldb;
    __device__ void init(int M, int N, int G_, int c_, int lda_, int ldb_) { nM = M / BM; nN = N / BM; nwg = nM * nN; G = G_; c = c_; lda = lda_; ldb = ldb_; }
    __device__ bool next(int i, Unit& u) const {
        const long L = (long)i * G + c; if (L >= nwg) return false;
        tile_of((int)L, nM, nN, u.pm, u.pn); u.aux = 0;
        u.aoff = (size_t)u.pm * BM * lda * 2; u.boff = (size_t)u.pn * BM * ldb * 2; return true;
    }
};

__device__ __forceinline__ unsigned cvt_pk_bf16(float lo, float hi) { unsigned r; asm volatile("v_cvt_pk_bf16_f32 %0, %1, %2" : "=v"(r) : "v"(lo), "v"(hi)); return r; }

template <class Epi, class Sched, bool ALIGN_EPI = true, bool SP2 = true>
__device__ __forceinline__ void gemm_phase(PG8_LAS unsigned char* lds, const Gemm g, const Sched& S, const Epi& E) {
    int tid_ = threadIdx.x; asm volatile("" : "+v"(tid_));
    const int tid = tid_, wid = __builtin_amdgcn_readfirstlane(tid >> 6), lane = tid & 63, wr = wid >> 2, wc = wid & 3, fr = lane & 15, fq = lane >> 4;
    const int K = g.K, nt = K / BK;
    unsigned voffA[2], voffB[2];
#pragma unroll
    for (int i = 0; i < 2; ++i) { int R, C; stage_rc(tid * 16 + i * 8192, R, C); const int Rb = Epi::PERM ? ((R & ~31) + perm32(R & 31)) : R;
        voffA[i] = (unsigned)(R * g.lda + C) * 2u; voffB[i] = (unsigned)(Rb * g.ldb + C) * 2u; }
    const size_t kstep = (size_t)(BK * 2);
    const size_t hstepA = (size_t)HALF * g.lda * 2, hstepB = (size_t)HALF * g.ldb * 2;
    const unsigned ldsw = (unsigned)wid * 1024u;
    const int aoff = lds_byte(wr * 64 + fr, fq * 8), boff = lds_byte(wc * 32 + fr, fq * 8);
#define PG8_SA(b, h) (((b) * 2 + (h)) * HTB)
#define PG8_SB(b, h) ((4 + (b) * 2 + (h)) * HTB)
#define PG8_STAGE(bufoff, gbase, voff) do { _Pragma("unroll") for (int _i = 0; _i < 2; ++_i) \
        __builtin_amdgcn_global_load_lds((const unsigned*)((const char*)(gbase) + (voff)[_i]), (PG8_LAS unsigned*)(lds + (bufoff) + ldsw + _i * 8192), 16, 0, 0); } while (0)
#define PG8_LDA(dst, b, h) do { _Pragma("unroll") for (int m = 0; m < 4; ++m) _Pragma("unroll") for (int k = 0; k < 2; ++k) dst[m][k] = *(const PG8_LAS bf16x8*)(lds + PG8_SA(b, h) + aoff + m * 2048 + k * 1024); } while (0)
#define PG8_LDB(dst, b, h) do { _Pragma("unroll") for (int n = 0; n < 2; ++n) _Pragma("unroll") for (int k = 0; k < 2; ++k) dst[n][k] = *(const PG8_LAS bf16x8*)(lds + PG8_SB(b, h) + boff + n * 2048 + k * 1024); } while (0)
#define PG8_MMA(ai, bj, At, Bt) do { __builtin_amdgcn_s_setprio(1); _Pragma("unroll") for (int m = 0; m < 4; ++m) _Pragma("unroll") for (int n = 0; n < 2; ++n) _Pragma("unroll") for (int k = 0; k < 2; ++k) \
        acc[ai][bj][m][n] = __builtin_amdgcn_mfma_f32_16x16x32_bf16(Bt[n][k], At[m][k], acc[ai][bj][m][n], 0, 0, 0); __builtin_amdgcn_s_setprio(0); } while (0)
#define PG8_WAIT_V(n) asm volatile("s_waitcnt vmcnt(" #n ")" ::: "memory")
#define PG8_WAIT_L(n) asm volatile("s_waitcnt lgkmcnt(" #n ")" ::: "memory")
#define PG8_BAR __builtin_amdgcn_s_barrier()
#define PG8_SCHED __builtin_amdgcn_sched_barrier(0)
    Unit cur, nxt; int ui = 0;
    if (!S.next(0, cur)) return;
    f32x4 acc[2][2][4][2];
#pragma unroll
    for (int a = 0; a < 2; ++a)
#pragma unroll
        for (int b = 0; b < 2; ++b)
#pragma unroll
            for (int m = 0; m < 4; ++m)
#pragma unroll
                for (int n = 0; n < 2; ++n) acc[a][b][m][n] = (f32x4){0.f, 0.f, 0.f, 0.f};
    bf16x8 At[4][2], B0[2][2], B1[2][2];
    const char* cA = (const char*)g.A + cur.aoff; const char* cB = (const char*)g.Bt + cur.boff;
    if constexpr (SP2) {
        PG8_STAGE(PG8_SB(0, 0), cB, voffB); PG8_STAGE(PG8_SB(0, 1), cB + hstepB, voffB); PG8_STAGE(PG8_SA(0, 0), cA, voffA); PG8_STAGE(PG8_SA(0, 1), cA + hstepA, voffA);
        if (wr == 1) PG8_BAR;
        PG8_WAIT_V(2); PG8_BAR;
        PG8_STAGE(PG8_SB(1, 0), cB + kstep, voffB); PG8_STAGE(PG8_SA(1, 0), cA + kstep, voffA); PG8_STAGE(PG8_SB(1, 1), cB + hstepB + kstep, voffB);
        PG8_WAIT_V(6); PG8_BAR;
    } else {
        PG8_STAGE(PG8_SB(0, 0), cB, voffB); PG8_STAGE(PG8_SA(0, 0), cA, voffA); PG8_STAGE(PG8_SB(0, 1), cB + hstepB, voffB); PG8_STAGE(PG8_SA(0, 1), cA + hstepA, voffA);
        if (wr == 1) PG8_BAR;
        PG8_WAIT_V(4); PG8_BAR;
        PG8_STAGE(PG8_SB(1, 0), cB + kstep, voffB); PG8_STAGE(PG8_SA(1, 0), cA + kstep, voffA); PG8_STAGE(PG8_SB(1, 1), cB + hstepB + kstep, voffB);
        PG8_WAIT_V(6); PG8_BAR;
    }
    for (;;) {
        const bool has_next = S.next(ui + 1, nxt);
        const char* nA = has_next ? (const char*)g.A + nxt.aoff : cA; const char* nB = has_next ? (const char*)g.Bt + nxt.boff : cB;
#pragma unroll 1
        for (int t = 0; t < nt; t += 2) {
            const bool last = (t == nt - 2);
            const char* a1 = cA + (size_t)(t + 1) * kstep;
            const char* a2 = last ? nA : cA + (size_t)(t + 2) * kstep; const char* b2 = last ? nB : cB + (size_t)(t + 2) * kstep;
            const char* a3 = a2 + kstep; const char* b3 = b2 + kstep;
            if constexpr (SP2) {
            PG8_LDB(B0, 0, 0); PG8_LDB(B1, 0, 1); PG8_SCHED; PG8_LDA(At, 0, 0); PG8_STAGE(PG8_SA(1, 1), a1 + hstepA, voffA);
            PG8_WAIT_V(8); PG8_WAIT_L(0); PG8_BAR; PG8_MMA(0, 0, At, B0); PG8_MMA(0, 1, At, B1); PG8_BAR; PG8_SCHED;
            PG8_LDA(At, 0, 1); PG8_STAGE(PG8_SB(0, 0), b2, voffB); PG8_STAGE(PG8_SB(0, 1), b2 + hstepB, voffB); PG8_STAGE(PG8_SA(0, 0), a2, voffA);
            PG8_WAIT_V(8); PG8_WAIT_L(0); PG8_BAR; PG8_MMA(1, 0, At, B0); PG8_MMA(1, 1, At, B1); PG8_BAR; PG8_SCHED;
            PG8_LDB(B0, 1, 0); PG8_LDB(B1, 1, 1); PG8_SCHED; PG8_LDA(At, 1, 0); PG8_STAGE(PG8_SA(0, 1), a2 + hstepA, voffA);
            PG8_WAIT_V(8); PG8_WAIT_L(0); PG8_BAR; PG8_MMA(0, 0, At, B0); PG8_MMA(0, 1, At, B1); PG8_BAR; PG8_SCHED;
            PG8_LDA(At, 1, 1); PG8_STAGE(PG8_SB(1, 0), b3, voffB); PG8_STAGE(PG8_SB(1, 1), b3 + hstepB, voffB); PG8_STAGE(PG8_SA(1, 0), a3, voffA);
            PG8_WAIT_V(8); PG8_WAIT_L(0); PG8_BAR; PG8_MMA(1, 0, At, B0); PG8_MMA(1, 1, At, B1); PG8_BAR; PG8_SCHED;
            } else {
            PG8_LDB(B0, 0, 0); PG8_SCHED; PG8_LDA(At, 0, 0); PG8_STAGE(PG8_SA(1, 1), a1 + hstepA, voffA);
            PG8_WAIT_L(8); PG8_BAR; PG8_WAIT_L(0); PG8_MMA(0, 0, At, B0); PG8_BAR; PG8_SCHED;
            PG8_LDB(B1, 0, 1); PG8_STAGE(PG8_SB(0, 0), b2, voffB);
            PG8_BAR; PG8_WAIT_L(0); PG8_MMA(0, 1, At, B1); PG8_BAR;
            PG8_LDA(At, 0, 1); PG8_STAGE(PG8_SA(0, 0), a2, voffA);
            PG8_BAR; PG8_WAIT_L(0); PG8_MMA(1, 0, At, B0); PG8_BAR; PG8_SCHED;
            PG8_STAGE(PG8_SB(0, 1), b2 + hstepB, voffB);
            PG8_WAIT_V(6); PG8_BAR; PG8_MMA(1, 1, At, B1); PG8_BAR;
            PG8_LDB(B0, 1, 0); PG8_SCHED; PG8_LDA(At, 1, 0); PG8_STAGE(PG8_SA(0, 1), a2 + hstepA, voffA);
            PG8_WAIT_L(8); PG8_BAR; PG8_WAIT_L(0); PG8_MMA(0, 0, At, B0); PG8_BAR; PG8_SCHED;
            PG8_LDB(B1, 1, 1); PG8_STAGE(PG8_SB(1, 0), b3, voffB);
            PG8_BAR; PG8_WAIT_L(0); PG8_MMA(0, 1, At, B1); PG8_BAR;
            PG8_LDA(At, 1, 1); PG8_STAGE(PG8_SA(1, 0), a3, voffA);
            PG8_BAR; PG8_WAIT_L(0); PG8_MMA(1, 0, At, B0); PG8_BAR; PG8_SCHED;
            PG8_STAGE(PG8_SB(1, 1), b3 + hstepB, voffB);
            PG8_WAIT_V(6); PG8_BAR; PG8_MMA(1, 1, At, B1); PG8_BAR;
            }
        }
        if constexpr (ALIGN_EPI) { if (wr == 0) PG8_BAR; }
        E(acc, cur, wr, wc, fr, fq);
        if (!has_next) break;
#pragma unroll
        for (int a = 0; a < 2; ++a)
#pragma unroll
            for (int b = 0; b < 2; ++b)
#pragma unroll
                for (int m = 0; m < 4; ++m)
#pragma unroll
                    for (int n = 0; n < 2; ++n) acc[a][b][m][n] = (f32x4){0.f, 0.f, 0.f, 0.f};
        cur = nxt; cA = nA; cB = nB; ++ui;
        if constexpr (ALIGN_EPI) { if (wr == 1) PG8_BAR; }
    }
    PG8_WAIT_V(0);
    if constexpr (!ALIGN_EPI) { if (wr == 0) PG8_BAR; }
    PG8_BAR;
#undef PG8_SA
#undef PG8_SB
#undef PG8_STAGE
#undef PG8_LDA
#undef PG8_LDB
#undef PG8_MMA
#undef PG8_WAIT_V
#undef PG8_WAIT_L
#undef PG8_BAR
#undef PG8_SCHED
}
}

#define LAS __attribute__((address_space(3)))
typedef unsigned short bf16;
typedef float f32x4 __attribute__((ext_vector_type(4)));
typedef unsigned u32x4 __attribute__((ext_vector_type(4)));
typedef unsigned u32x2 __attribute__((ext_vector_type(2)));

constexpr int NB = 8, T = 4096, D = 1024, M = NB * T, NL = 2;
constexpr int INW = 9160;
constexpr int PP = 5120;
constexpr int C_AQ = 0, C_AK = 768, C_AV = 1536, C_BQ = 2304, C_BK = 2560, C_BV = 2816, C_IQ = 3072, C_IK = 3328, C_C = 3392, C_DZ = 4288, C_DX = 4544, C_IW = 5056, C_DT = 5060, C_END = 5064;
constexpr int NEXP = 32, DEXP = 512;
constexpr int CAP = 73728;
constexpr float LN_EPS = 1e-5f;
constexpr float ALPHA = 1.4142135623730951f;

constexpr size_t MiB = 1u << 20;
constexpr size_t WS_CTL = 0, CTL_BYTES = 1 * MiB;
constexpr size_t WS_WINT = 2 * MiB;
constexpr size_t WS_WGT = 22 * MiB;
constexpr size_t WS_WBRT = 38 * MiB;
constexpr size_t WS_WOUTT = 42 * MiB;
constexpr size_t WS_WRT = 46 * MiB;
constexpr size_t WS_ROUTE = 47 * MiB;
constexpr size_t WS_XB = 48 * MiB;
constexpr size_t WS_O = 112 * MiB;
constexpr size_t WS_VF = 176 * MiB;
constexpr size_t WS_P = 192 * MiB;
constexpr size_t WS_GS = 192 * MiB;
constexpr size_t WS_MERGED = 448 * MiB;
constexpr size_t WS_XS = 192 * MiB;
constexpr size_t WS_H = 336 * MiB;
constexpr size_t WS_WGU = 408 * MiB;
constexpr size_t WS_WD = 472 * MiB;
constexpr size_t WS_RW = 512 * MiB;
constexpr size_t WS_RW2 = 544 * MiB;
constexpr size_t WS_BONG = 46 * MiB + 512 * 1024;
constexpr size_t WS_END = 592 * MiB;
constexpr int CW_CNT = 64, CW_Q = 256, CW_BAR = 4096;

constexpr int RING_BYTES = 131072, MISC_OFF = RING_BYTES, LDS_BYTES = 147456;
constexpr int NWAVES = 8, NTHR = 512;

__device__ __forceinline__ float bf2f(bf16 v) { return __uint_as_float(((unsigned)v) << 16); }
__device__ __forceinline__ unsigned f2bf(float f) { unsigned u = __float_as_uint(f); return (u + 0x7fffu + ((u >> 16) & 1u)) >> 16; }
__device__ __forceinline__ unsigned pk2(float lo, float hi) { return f2bf(lo) | (f2bf(hi) << 16); }
__device__ __forceinline__ float wave_sum(float v) {
#pragma unroll
    for (int o = 1; o < 64; o <<= 1) v += __shfl_xor(v, o);
    return v;
}
__device__ __forceinline__ float wave_max(float v) {
#pragma unroll
    for (int o = 1; o < 64; o <<= 1) v = fmaxf(v, __shfl_xor(v, o));
    return v;
}
__device__ __forceinline__ float sigmoidf_(float x) { return 1.f / (1.f + __expf(-x)); }
__device__ __forceinline__ float softplusf_(float x) { return x > 20.f ? x : log1pf(__expf(x)); }
__device__ __forceinline__ float siluf_(float x) { return x / (1.f + __expf(-x)); }

struct Args { const float* in[35]; float* out; unsigned char* ws; int ph_lo, ph_hi; };
enum { I_X = 0, I_WIN, I_CMU, I_CW0, I_CW2, I_CA0, I_CA2, I_CG2, I_CKK, I_CKA, I_CRK, I_CGNW, I_CGNB, I_CV0, I_CV1, I_CV2, I_DCW, I_DCB, I_DDTB, I_DALOG, I_DSKIP, I_DNW,
       I_WBR, I_WOUT, I_LN1G, I_LN1B, I_RG, I_RGB, I_RE, I_REB, I_EG, I_EU, I_ED, I_LN2G, I_LN2B };

__device__ __forceinline__ void transpose_item(const float* W, int ldn, int c0, int ncols, bf16* dst, int dld, int r0, int dk0, int kb, int nb, LAS float* scr, int lane) {
    const int k0 = 64 * kb, n0 = 32 * nb;
    const bool okn = (n0 + (lane & 31)) < ncols;
#pragma unroll 8
    for (int i = 0; i < 32; ++i) { const int kk = 2 * i + (lane >> 5); scr[kk * 33 + (lane & 31)] = okn ? W[(size_t)(k0 + kk) * ldn + c0 + n0 + (lane & 31)] : 0.f; }
    asm volatile("s_waitcnt lgkmcnt(0)" ::: "memory");
    const int c = lane & 7;
#pragma unroll
    for (int j = 0; j < 4; ++j) { const int n = (lane >> 3) + 8 * j; const LAS float* s = scr + (8 * c) * 33 + n;
        u32x4 o; o.x = pk2(s[0 * 33], s[1 * 33]); o.y = pk2(s[2 * 33], s[3 * 33]); o.z = pk2(s[4 * 33], s[5 * 33]); o.w = pk2(s[6 * 33], s[7 * 33]);
        if (n0 + n < ncols) *(u32x4*)(dst + (size_t)(r0 + n0 + n) * dld + dk0 + k0 + 8 * c) = o; }
    asm volatile("s_waitcnt lgkmcnt(0)" ::: "memory");
}

struct EpiStoreBf16 {
    static constexpr bool PERM = true;
    bf16* O; int ldc; int act; int ncols;
    __device__ __forceinline__ void operator()(const pg8::f32x4 (&acc)[2][2][4][2], const pg8::Unit& u, int wr, int wc, int fr, int fq) const {
        const int row0 = u.pm * 256 + wr * 64 + fr; const int col0 = u.pn * 256 + wc * 32 + 8 * fq;
#pragma unroll
        for (int ai = 0; ai < 2; ++ai)
#pragma unroll
            for (int m = 0; m < 4; ++m) { bf16* rowp = O + (size_t)(row0 + ai * 128 + m * 16) * ldc + col0;
#pragma unroll
                for (int bj = 0; bj < 2; ++bj) { pg8::f32x4 v0 = acc[ai][bj][m][0], v1 = acc[ai][bj][m][1];
                    if (act == 1) {
#pragma unroll
                        for (int j = 0; j < 4; ++j) { v0[j] = sigmoidf_(v0[j]); v1[j] = sigmoidf_(v1[j]); } }
                    u32x4 w; w.x = pg8::cvt_pk_bf16(v0[0], v0[1]); w.y = pg8::cvt_pk_bf16(v0[2], v0[3]); w.z = pg8::cvt_pk_bf16(v1[0], v1[1]); w.w = pg8::cvt_pk_bf16(v1[2], v1[3]);
                    if (col0 + bj * 128 < ncols) *(u32x4*)(rowp + bj * 128) = w; } }
    }
};
struct EpiBranch {
    static constexpr bool PERM = true;
    const bf16* GS; bf16* MG;
    __device__ __forceinline__ void operator()(const pg8::f32x4 (&acc)[2][2][4][2], const pg8::Unit& u, int wr, int wc, int fr, int fq) const {
        const int n = u.aux;
        const bf16* gbase = GS + (size_t)(u.pm * 256 + wr * 64 + fr) * 4096 + n * 1024 + u.pn * 256 + wc * 32 + 8 * fq;
        bf16* mbase = MG + (size_t)(u.pm * 256 + wr * 64 + fr) * 1024 + u.pn * 256 + wc * 32 + 8 * fq;
#pragma unroll
        for (int ai = 0; ai < 2; ++ai)
#pragma unroll
            for (int m = 0; m < 4; ++m) {
#pragma unroll
                for (int bj = 0; bj < 2; ++bj) {
                    const u32x4 gv = *(const u32x4*)(gbase + (size_t)(ai * 128 + m * 16) * 4096 + bj * 128);
                    bf16* mp = mbase + (size_t)(ai * 128 + m * 16) * 1024 + bj * 128;
                    u32x4 ov = (u32x4){0u, 0u, 0u, 0u}; if (n != 0) ov = *(const u32x4*)mp;
                    const pg8::f32x4 a0 = acc[ai][bj][m][0], a1 = acc[ai][bj][m][1];
                    u32x4 w;
                    w.x = pg8::cvt_pk_bf16(a0[0] * __uint_as_float(gv.x << 16) + __uint_as_float(ov.x << 16), a0[1] * __uint_as_float(gv.x & 0xffff0000u) + __uint_as_float(ov.x & 0xffff0000u));
                    w.y = pg8::cvt_pk_bf16(a0[2] * __uint_as_float(gv.y << 16) + __uint_as_float(ov.y << 16), a0[3] * __uint_as_float(gv.y & 0xffff0000u) + __uint_as_float(ov.y & 0xffff0000u));
                    w.z = pg8::cvt_pk_bf16(a1[0] * __uint_as_float(gv.z << 16) + __uint_as_float(ov.z << 16), a1[1] * __uint_as_float(gv.z & 0xffff0000u) + __uint_as_float(ov.z & 0xffff0000u));
                    w.w = pg8::cvt_pk_bf16(a1[2] * __uint_as_float(gv.w << 16) + __uint_as_float(ov.w << 16), a1[3] * __uint_as_float(gv.w & 0xffff0000u) + __uint_as_float(ov.w & 0xffff0000u));
                    *(u32x4*)mp = w; asm volatile("" ::: "memory"); } }
    }
};
struct EpiResid {
    static constexpr bool PERM = false;
    float* X;
    __device__ __forceinline__ void operator()(const pg8::f32x4 (&acc)[2][2][4][2], const pg8::Unit& u, int wr, int wc, int fr, int fq) const {
        const int row0 = u.pm * 256 + wr * 64 + fr, col0 = u.pn * 256 + wc * 32 + 4 * fq;
#pragma unroll
        for (int ai = 0; ai < 2; ++ai)
#pragma unroll
            for (int m = 0; m < 4; ++m) { float* rowp = X + (size_t)(row0 + ai * 128 + m * 16) * D + col0;
#pragma unroll
                for (int bj = 0; bj < 2; ++bj)
#pragma unroll
                    for (int n = 0; n < 2; ++n) { pg8::f32x4* p = (pg8::f32x4*)(rowp + bj * 128 + n * 16); *p = *p * ALPHA + acc[ai][bj][m][n]; } }
    }
};
struct EpiSwiglu {
    static constexpr bool PERM = true;
    bf16* H;
    __device__ __forceinline__ void operator()(const pg8::f32x4 (&acc)[2][2][4][2], const pg8::Unit& u, int wr, int wc, int fr, int fq) const {
        const int row0 = u.pm * 256 + wr * 64 + fr; const int col0 = u.pn * 128 + wc * 32 + 8 * fq;
#pragma unroll
        for (int ai = 0; ai < 2; ++ai)
#pragma unroll
            for (int m = 0; m < 4; ++m) { bf16* rowp = H + (size_t)(row0 + ai * 128 + m * 16) * DEXP + col0;
                float v[8];
#pragma unroll
                for (int j = 0; j < 4; ++j) { v[j] = siluf_(acc[ai][0][m][0][j]) * acc[ai][1][m][0][j]; v[4 + j] = siluf_(acc[ai][0][m][1][j]) * acc[ai][1][m][1][j]; }
                u32x4 w; w.x = pg8::cvt_pk_bf16(v[0], v[1]); w.y = pg8::cvt_pk_bf16(v[2], v[3]); w.z = pg8::cvt_pk_bf16(v[4], v[5]); w.w = pg8::cvt_pk_bf16(v[6], v[7]);
                *(u32x4*)rowp = w; }
    }
};

struct BranchOrder {
    int nM, nN, G, c;
    __device__ bool next(int i, pg8::Unit& u) const {
        const int tl = (i >> 2) * G + c; if (tl >= nM * nN) return false;
        pg8::tile_of(tl, nM, nN, u.pm, u.pn); u.aux = i & 3;
        u.aoff = ((size_t)u.pm * 256 * 1024 + (size_t)u.aux * 256) * 2; u.boff = ((size_t)u.pn * 256 * 1024 + (size_t)u.aux * 256) * 2; return true;
    }
};
struct MoeOrder {
    const volatile LAS int* tb; int G, c; size_t a_rowbytes, b_expbytes, b_tilebytes;
    __device__ bool next(int i, pg8::Unit& u) const {
        const int L = i * G + c; const int total = __builtin_amdgcn_readfirstlane(tb[32]) * 4; if (L >= total) return false;
        int e = 0;
#pragma unroll 1
        for (int k = 0; k < 32; ++k) if (L >= tb[k + 1] * 4) e = k + 1;
        const int nte = tb[e + 1] - tb[e]; const int r = L - tb[e] * 4; const int ct = r / nte, rt = r % nte;
        u.pm = __builtin_amdgcn_readfirstlane(tb[33 + e] + rt); u.pn = __builtin_amdgcn_readfirstlane(ct); u.aux = __builtin_amdgcn_readfirstlane(e);
        u.aoff = (size_t)u.pm * 256 * a_rowbytes; u.boff = (size_t)u.aux * b_expbytes + (size_t)u.pn * b_tilebytes; return true;
    }
};

constexpr int PTR_OFF = LDS_BYTES - 512;
__device__ __forceinline__ void ptr_table_fill(const Args& args, LAS unsigned char* lds) {
    if (threadIdx.x == 0) {
        volatile LAS unsigned long long* t = (volatile LAS unsigned long long*)(lds + PTR_OFF);
#define PT_(i) t[i] = (unsigned long long)args.in[i];
        PT_(0) PT_(1) PT_(2) PT_(3) PT_(4) PT_(5) PT_(6) PT_(7) PT_(8) PT_(9) PT_(10) PT_(11) PT_(12) PT_(13) PT_(14) PT_(15) PT_(16) PT_(17) PT_(18) PT_(19)
        PT_(20) PT_(21) PT_(22) PT_(23) PT_(24) PT_(25) PT_(26) PT_(27) PT_(28) PT_(29) PT_(30) PT_(31) PT_(32) PT_(33) PT_(34)
#undef PT_
        t[35] = (unsigned long long)args.out; t[36] = (unsigned long long)args.ws; t[37] = (unsigned long long)(unsigned)args.ph_lo;
    }
    __syncthreads();
}
__device__ __forceinline__ unsigned long long ldptr(LAS unsigned char* lds, int i) {
    unsigned a = (unsigned)(PTR_OFF + 8 * i); asm volatile("" : "+v"(a));
    const volatile LAS unsigned* t = (const volatile LAS unsigned*)(lds + a);
    const unsigned lo = __builtin_amdgcn_readfirstlane(t[0]), hi = __builtin_amdgcn_readfirstlane(t[1]);
    return ((unsigned long long)hi << 32) | lo;
}
#define INP(i) ((const float*)ldptr(lds, (i)))
namespace rw {
typedef short bf16x8 __attribute__((ext_vector_type(8)));
typedef float f4 __attribute__((ext_vector_type(4)));
constexpr int LS = 72;
constexpr int MB = 64 * LS * 2;
constexpr int O_AHN = 0, O_RHN = MB, O_BCN = 2 * MB, O_KCN = 3 * MB, O_AHT = 4 * MB, O_BTT = 5 * MB, O_KTT = 6 * MB, O_VT = 7 * MB, O_STT = 8 * MB,
              O_MAK = 9 * MB, O_MRB = 10 * MB, O_MRK = 11 * MB, O_TINV = 12 * MB, O_MABF = 13 * MB, O_GAM = 13 * MB + 16384, O_CT = O_GAM + 256, O_BON = O_CT + 4608, O_END = O_BON + 256;
constexpr int O_MVT = O_BCN, O_A2N = O_AHN, O_UT = O_KCN, O_YF = O_AHT;
constexpr int O_TAB = O_MAK, O_SCR = O_TAB + 26624, O_TOT = O_SCR + 8 * 1024, O_CUM = O_TOT + 2048;
static_assert(O_CUM + 16384 <= O_GAM && O_END <= LDS_BYTES - 576, "rwkv LDS map");

__device__ __forceinline__ bf16x8 ldfrag(const LAS unsigned char* lds, int off, int r0, int ks, int lane) {
    return *(const LAS bf16x8*)(lds + off + ((r0 + (lane & 15)) * LS + ks * 32 + (lane >> 4) * 8) * 2);
}
__device__ __forceinline__ void mm64(f4 (&acc)[2], const LAS unsigned char* lds, int offA, int offBt, int w, int lane) {
    const int tr = w >> 1; const bf16x8 a0 = ldfrag(lds, offA, tr * 16, 0, lane), a1 = ldfrag(lds, offA, tr * 16, 1, lane);
#pragma unroll
    for (int c = 0; c < 2; ++c) { const int tc = (w & 1) * 2 + c; const bf16x8 b0 = ldfrag(lds, offBt, tc * 16, 0, lane), b1 = ldfrag(lds, offBt, tc * 16, 1, lane);
        acc[c] = __builtin_amdgcn_mfma_f32_16x16x32_bf16(a0, b0, acc[c], 0, 0, 0); acc[c] = __builtin_amdgcn_mfma_f32_16x16x32_bf16(a1, b1, acc[c], 0, 0, 0); }
}
__device__ __forceinline__ void storeT(LAS unsigned char* lds, int off, const f4 (&acc)[2], int w, int lane) {
#pragma unroll
    for (int c = 0; c < 2; ++c) { const int col = ((w & 1) * 2 + c) * 16 + (lane & 15), row = (w >> 1) * 16 + 4 * (lane >> 4);
        u32x2 v; v.x = pk2(acc[c][0], acc[c][1]); v.y = pk2(acc[c][2], acc[c][3]); *(LAS u32x2*)(lds + off + (col * LS + row) * 2) = v; }
}
template <int MASK  >
__device__ __forceinline__ void storeN(LAS unsigned char* lds, int off, const f4 (&acc)[2], int w, int lane) {
#pragma unroll
    for (int c = 0; c < 2; ++c) { const int col = ((w & 1) * 2 + c) * 16 + (lane & 15), row = (w >> 1) * 16 + 4 * (lane >> 4);
#pragma unroll
        for (int e = 0; e < 4; ++e) { float x = acc[c][e]; if (MASK == 1) x = (col < row + e) ? x : 0.f; if (MASK == 2) x = (col <= row + e) ? x : 0.f;
            *(LAS bf16*)(lds + off + ((row + e) * LS + col) * 2) = (bf16)f2bf(x); } }
}
#define RW_ZERO(a) do { a[0] = (f4){0.f, 0.f, 0.f, 0.f}; a[1] = (f4){0.f, 0.f, 0.f, 0.f}; } while (0)

__device__ __forceinline__ void build_ct(LAS unsigned char* lds0, const int l, const int h, const int lane, const int wave) {
    LAS unsigned char* const& lds = lds0; const int c = h * 64 + lane;
    const float* mu = INP(I_CMU) + (size_t)l * 896;
    if (wave == 0) { LAS float* ct = (LAS float*)(lds0 + O_CT);
        ct[0 * 64 + lane] = mu[c]; ct[1 * 64 + lane] = mu[256 + c]; ct[2 * 64 + lane] = mu[512 + c]; ct[3 * 64 + lane] = mu[768 + lane]; ct[4 * 64 + lane] = mu[832 + lane];
        ct[5 * 64 + lane] = INP(I_CW0)[l * 256 + c]; ct[6 * 64 + lane] = INP(I_CA0)[l * 256 + c]; ct[7 * 64 + lane] = INP(I_CKK)[l * 256 + c]; ct[8 * 64 + lane] = INP(I_CKA)[l * 256 + c];
        ct[9 * 64 + lane] = INP(I_CRK)[l * 256 + c]; ct[10 * 64 + lane] = INP(I_CGNW)[l * 256 + c]; ct[11 * 64 + lane] = INP(I_CGNB)[l * 256 + c]; ct[12 * 64 + lane] = l > 0 ? INP(I_CV0)[(l - 1) * 256 + c] : 0.f;
        ct[13 * 64 + lane] = mu[512 + lane]; ct[14 * 64 + lane] = mu[512 + lane + 64]; ct[15 * 64 + lane] = mu[512 + lane + 128]; ct[16 * 64 + lane] = mu[512 + lane + 192]; }
}
template <int MODE>
__device__ __forceinline__ void chunk(LAS unsigned char* lds0, const int l, const int b, const int h, const int t0, unsigned char* gz, unsigned char* gz2, float* bong, const bf16* P, bf16* VF, bf16* OB, const int tid0) {
    const int c = h * 64 + (tid0 & 63);
    {
        unsigned lb_ = 0u; int tid_l = tid0; asm volatile("" : "+v"(lb_), "+v"(tid_l));
        const int tid = tid_l, lane = tid & 63, wave = __builtin_amdgcn_readfirstlane(tid >> 6);
        LAS unsigned char* lds = lds0 + lb_;
        LAS bf16* TAB = (LAS bf16*)(lds + O_TAB);
        LAS float* scr = (LAS float*)(lds + O_SCR + wave * 1024);
        LAS float* CUM = (LAS float*)(lds + O_CUM);
        LAS float* TOT = (LAS float*)(lds + O_TOT);
        LAS float* GAM = (LAS float*)(lds + O_GAM);
        LAS float* MABF = (LAS float*)(lds + O_MABF);
        LAS float* YF = (LAS float*)(lds + O_YF);
        LAS float* BON = (LAS float*)(lds + O_BON);
        const LAS float* CT = (const LAS float*)(lds + O_CT);
#define CTV(k) CT[(k) * 64 + lane]
        { const float* cw2 = INP(I_CW2) + (size_t)l * 32 * 256; const float* ca2 = INP(I_CA2) + (size_t)l * 32 * 256; const float* cg2 = INP(I_CG2) + (size_t)l * 64 * 256;
          float tw[4], ta[4], tg[8];
#pragma unroll
          for (int u = 0; u < 4; ++u) { const int i = tid + u * NTHR; tw[u] = cw2[(i >> 6) * 256 + h * 64 + (i & 63)]; ta[u] = ca2[(i >> 6) * 256 + h * 64 + (i & 63)]; }
#pragma unroll
          for (int u = 0; u < 8; ++u) { const int i = tid + u * NTHR; tg[u] = cg2[(i >> 6) * 256 + h * 64 + (i & 63)]; }
          float t2[2], t1[8];
          if (l > 0) { const float* cv1 = INP(I_CV1) + (size_t)(l - 1) * 256 * 16; const float* cv2 = INP(I_CV2) + (size_t)(l - 1) * 16 * 256;
#pragma unroll
            for (int u = 0; u < 2; ++u) { const int i = tid + u * NTHR; t2[u] = cv2[(i >> 6) * 256 + h * 64 + (i & 63)]; }
#pragma unroll
            for (int u = 0; u < 8; ++u) t1[u] = cv1[tid + u * NTHR]; }
#pragma unroll
          for (int u = 0; u < 4; ++u) { TAB[tid + u * NTHR] = (bf16)f2bf(tw[u]); TAB[2048 + tid + u * NTHR] = (bf16)f2bf(ta[u]); }
#pragma unroll
          for (int u = 0; u < 8; ++u) TAB[4096 + tid + u * NTHR] = (bf16)f2bf(tg[u]);
          if (l > 0) {
#pragma unroll
            for (int u = 0; u < 2; ++u) TAB[8192 + tid + u * NTHR] = (bf16)f2bf(t2[u]);
#pragma unroll
            for (int u = 0; u < 8; ++u) TAB[9216 + tid + u * NTHR] = (bf16)f2bf(t1[u]); } }
        if (MODE == 3) { const u32x4 sv = ((const u32x4*)gz)[tid]; *(LAS u32x4*)(lds + O_STT + ((tid >> 3) * LS + (tid & 7) * 8) * 2) = sv; }
        float Xr[9];
#pragma unroll
        for (int j = 0; j < 9; ++j) { const int t = t0 + wave * 8 - 1 + j; Xr[j] = t >= 0 ? bf2f(P[((size_t)b * T + t) * PP + C_C + 768 + lane]) : 0.f; }
        __syncthreads();
        { float run = 0.f;
#pragma unroll
            for (int q = 0; q < 8; ++q) {
                const float xx = Xr[q + 1] + (Xr[q] - Xr[q + 1]) * CTV(3);
                scr[lane] = tanhf(xx);
                asm volatile("s_waitcnt lgkmcnt(0)" ::: "memory");
                float wsum = CTV(5); { float w1 = 0.f, w2_ = 0.f, w3 = 0.f;
#pragma unroll 4
                for (int mm = 0; mm < 32; mm += 4) { wsum += scr[mm] * bf2f(TAB[mm * 64 + lane]); w1 += scr[mm + 1] * bf2f(TAB[(mm + 1) * 64 + lane]); w2_ += scr[mm + 2] * bf2f(TAB[(mm + 2) * 64 + lane]); w3 += scr[mm + 3] * bf2f(TAB[(mm + 3) * 64 + lane]); }
                wsum = (wsum + w1) + (w2_ + w3); }
                run += -__expf(-softplusf_(-wsum) - 0.5f); CUM[(wave * 8 + q) * 64 + lane] = run;
                asm volatile("s_waitcnt lgkmcnt(0)" ::: "memory");
            }
            TOT[wave * 64 + lane] = run; }
        __syncthreads();
        float offs = 0.f, cumL = 0.f;
#pragma unroll
        for (int w2 = 0; w2 < 8; ++w2) { const float tw = TOT[w2 * 64 + lane]; offs += (w2 < wave) ? tw : 0.f; cumL += tw; }
        if (wave == 0) GAM[lane] = __expf(cumL);
#define LO_(x) __uint_as_float((x) << 16)
#define HI_(x) __uint_as_float((x) & 0xffff0000u)
#define RAW_LOAD(rk, vx, gg, v4a, v4b, vfv, tok) do { const int t_ = (tok); const bool ok_ = t_ >= 0; const size_t m_ = (size_t)b * T + (ok_ ? t_ : 0); const bf16* row_ = P + m_ * PP + C_C; \
            rk = ok_ ? ((unsigned)row_[c] | ((unsigned)row_[256 + c] << 16)) : 0u; vx = ok_ ? ((unsigned)row_[512 + c] | ((unsigned)row_[768 + lane] << 16)) : 0u; gg = ok_ ? (unsigned)row_[832 + lane] : 0u; \
            if (l > 0) { v4a = ok_ ? ((unsigned)row_[512 + lane] | ((unsigned)row_[512 + lane + 64] << 16)) : 0u; v4b = ok_ ? ((unsigned)row_[512 + lane + 128] | ((unsigned)row_[512 + lane + 192] << 16)) : 0u; vfv = (unsigned)VF[m_ * 256 + c]; } } while (0)
        unsigned pRK, pVX, pGG, pVa = 0u, pVb = 0u, pVF = 0u, cRK, cVX, cGG, cVa = 0u, cVb = 0u, cVF = 0u;
        RAW_LOAD(pRK, pVX, pGG, pVa, pVb, pVF, t0 + wave * 8 - 1); RAW_LOAD(cRK, cVX, cGG, cVa, cVb, cVF, t0 + wave * 8);
#pragma unroll 1
        for (int q = 0; q < 8; ++q) {
            const int tt = wave * 8 + q; const size_t m = (size_t)b * T + t0 + tt;
            unsigned nRK, nVX, nGG, nVa = 0u, nVb = 0u, nVF = 0u;
            RAW_LOAD(nRK, nVX, nGG, nVa, nVb, nVF, (q < 7) ? (t0 + tt + 1) : (t0 + tt));
            const float r = LO_(cRK) + (LO_(pRK) - LO_(cRK)) * CTV(0), k = HI_(cRK) + (HI_(pRK) - HI_(cRK)) * CTV(1); float v = LO_(cVX) + (LO_(pVX) - LO_(cVX)) * CTV(2);
            const float xx = HI_(cVX) + (HI_(pVX) - HI_(cVX)) * CTV(3), xg = LO_(cGG) + (LO_(pGG) - LO_(cGG)) * CTV(4);
            scr[lane] = lane < 32 ? tanhf(xx) : xx; scr[64 + lane] = sigmoidf_(xg);
            LAS bf16* vsc = (LAS bf16*)(scr + 128);
            if (l > 0) {
                vsc[lane] = (bf16)f2bf(LO_(cVa) + (LO_(pVa) - LO_(cVa)) * CTV(13)); vsc[lane + 64] = (bf16)f2bf(HI_(cVa) + (HI_(pVa) - HI_(cVa)) * CTV(14));
                vsc[lane + 128] = (bf16)f2bf(LO_(cVb) + (LO_(pVb) - LO_(cVb)) * CTV(15)); vsc[lane + 192] = (bf16)f2bf(HI_(cVb) + (HI_(pVb) - HI_(cVb)) * CTV(16));
            }
            asm volatile("s_waitcnt lgkmcnt(0)" ::: "memory");
            float wsum = CTV(5), asum = CTV(6), gsum = 0.f; { float w1 = 0.f, a1 = 0.f, g1 = 0.f, g2_ = 0.f, g3 = 0.f;
#pragma unroll 4
            for (int mm = 0; mm < 32; mm += 2) { wsum += scr[mm] * bf2f(TAB[mm * 64 + lane]); w1 += scr[mm + 1] * bf2f(TAB[(mm + 1) * 64 + lane]);
                asum += scr[32 + mm] * bf2f(TAB[2048 + mm * 64 + lane]); a1 += scr[33 + mm] * bf2f(TAB[2048 + (mm + 1) * 64 + lane]); }
#pragma unroll 4
            for (int mm = 0; mm < 64; mm += 4) { gsum += scr[64 + mm] * bf2f(TAB[4096 + mm * 64 + lane]); g1 += scr[65 + mm] * bf2f(TAB[4096 + (mm + 1) * 64 + lane]);
                g2_ += scr[66 + mm] * bf2f(TAB[4096 + (mm + 2) * 64 + lane]); g3 += scr[67 + mm] * bf2f(TAB[4096 + (mm + 3) * 64 + lane]); }
            wsum += w1; asum += a1; gsum = (gsum + g1) + (g2_ + g3); }
            if (l > 0) {
                const int qq = lane & 15, part = lane >> 4; float s = 0.f; { float s1 = 0.f, s2 = 0.f, s3 = 0.f;
#pragma unroll 4
                for (int cc = 0; cc < 64; cc += 4) { s += bf2f(vsc[part * 64 + cc]) * bf2f(TAB[9216 + (part * 64 + cc) * 16 + qq]); s1 += bf2f(vsc[part * 64 + cc + 1]) * bf2f(TAB[9216 + (part * 64 + cc + 1) * 16 + qq]);
                    s2 += bf2f(vsc[part * 64 + cc + 2]) * bf2f(TAB[9216 + (part * 64 + cc + 2) * 16 + qq]); s3 += bf2f(vsc[part * 64 + cc + 3]) * bf2f(TAB[9216 + (part * 64 + cc + 3) * 16 + qq]); }
                s = (s + s1) + (s2 + s3); }
                s += __shfl_xor(s, 16); s += __shfl_xor(s, 32);
                float vl = CTV(12);
#pragma unroll
                for (int q2 = 0; q2 < 16; ++q2) vl += __shfl(s, q2) * bf2f(TAB[8192 + q2 * 64 + lane]);
                const float vf = LO_(cVF); v = v + (vf - v) * sigmoidf_(vl);
            }
            VF[m * 256 + c] = (bf16)f2bf(v);
            const float wlog = -softplusf_(-wsum) - 0.5f, asig = sigmoidf_(asum), lw = -__expf(wlog);
            float kk = k * CTV(7); const float n2 = wave_sum(kk * kk); kk = kk / fmaxf(sqrtf(n2), 1e-12f);
            const float kmod = k * (1.f + (asig - 1.f) * CTV(8));
            const float bon = wave_sum(r * kmod * CTV(9));
            const float cum = offs + CUM[tt * 64 + lane], cumx = cum - lw;
            const float ah = -kk * __expf(cumx), rh = r * __expf(cum), ei = __expf(-cum), bb = kk * asig, bc = bb * ei, kc = kmod * ei, ee = __expf(cumL - cum), bt = bb * ee, kt = kmod * ee;
            const int no = (tt * LS + lane) * 2, to = (lane * LS + tt) * 2;
            *(LAS bf16*)(lds + O_AHN + no) = (bf16)f2bf(ah); *(LAS bf16*)(lds + O_RHN + no) = (bf16)f2bf(rh);
            *(LAS bf16*)(lds + O_BCN + no) = (bf16)f2bf(bc); *(LAS bf16*)(lds + O_KCN + no) = (bf16)f2bf(kc); ((bf16*)(gz2 + 16384))[tt * 64 + lane] = (bf16)f2bf(gsum);
            *(LAS bf16*)(lds + O_AHT + to) = (bf16)f2bf(ah); *(LAS bf16*)(lds + O_BTT + to) = (bf16)f2bf(bt);
            *(LAS bf16*)(lds + O_KTT + to) = (bf16)f2bf(kt); *(LAS bf16*)(lds + O_VT + to) = (bf16)f2bf(v);
            if (lane == 0) bong[tt] = bon;
            asm volatile("s_waitcnt lgkmcnt(0)" ::: "memory");
            pRK = cRK; pVX = cVX; pGG = cGG; pVa = cVa; pVb = cVb; cRK = nRK; cVX = nVX; cGG = nGG; cVa = nVa; cVb = nVb; cVF = nVF;
        }
#undef RAW_LOAD
        __syncthreads();
        { f4 acc[2];
            RW_ZERO(acc); mm64(acc, lds, O_AHN, O_BCN, wave, lane);
#pragma unroll
            for (int cI = 0; cI < 2; ++cI) { const int col = ((wave & 1) * 2 + cI) * 16 + (lane & 15), row = (wave >> 1) * 16 + 4 * (lane >> 4);
#pragma unroll
                for (int e = 0; e < 4; ++e) MABF[(row + e) * 64 + col] = (col < row + e) ? acc[cI][e] : 0.f; }
            RW_ZERO(acc); mm64(acc, lds, O_AHN, O_KCN, wave, lane); storeN<1>(lds, O_MAK, acc, wave, lane);
            { f4 accb[2]; RW_ZERO(accb); mm64(accb, lds, O_RHN, O_BCN, wave, lane); f4 accc[2]; RW_ZERO(accc); mm64(accc, lds, O_RHN, O_KCN, wave, lane);
                storeN<2>(lds, O_MRB, accb, wave, lane); storeN<2>(lds, O_MRK, accc, wave, lane); }
        }
        __syncthreads();
        if (wave == 0) {
            float x[64]; x[0] = 0.f;
#pragma unroll
            for (int i = 1; i < 64; ++i) { float s4[4] = {MABF[i * 64 + lane], 0.f, 0.f, 0.f};
#pragma unroll
                for (int j4 = 0; j4 < (i + 3) / 4; ++j4) { const f4 m4 = *(const LAS f4*)(MABF + i * 64 + j4 * 4);
#pragma unroll
                    for (int e = 0; e < 4; ++e) if (j4 * 4 + e < i && j4 * 4 + e >= 1) s4[e] += m4[e] * x[j4 * 4 + e]; }
                x[i] = (s4[0] + s4[1]) + (s4[2] + s4[3]); }
#pragma unroll
            for (int i = 0; i < 64; ++i) *(LAS bf16*)(lds + O_TINV + (i * LS + lane) * 2) = (bf16)f2bf(x[i]);
            asm volatile("s_waitcnt lgkmcnt(0)" ::: "memory");
            *(LAS bf16*)(lds + O_TINV + (lane * LS + lane) * 2) = (bf16)0x3F80;
        }
        __syncthreads();
        { f4 acc[2]; RW_ZERO(acc); mm64(acc, lds, O_MAK, O_VT, wave, lane); storeT(lds, O_MVT, acc, wave, lane); }
        __syncthreads();
        if (MODE == 1) {
            { f4 acc[2]; RW_ZERO(acc); mm64(acc, lds, O_TINV, O_AHT, wave, lane); storeT(lds, O_UT, acc, wave, lane); }
            { f4 acc[2]; RW_ZERO(acc); mm64(acc, lds, O_TINV, O_MVT, wave, lane); storeT(lds, O_MAK, acc, wave, lane); }
            __syncthreads();
            f4 agm[2], azm[2], ar2[2], ay0[2];
            RW_ZERO(agm); mm64(agm, lds, O_BTT, O_UT, wave, lane);
#pragma unroll
            for (int cI = 0; cI < 2; ++cI) { const int col = ((wave & 1) * 2 + cI) * 16 + (lane & 15), row = (wave >> 1) * 16 + 4 * (lane >> 4);
#pragma unroll
                for (int e = 0; e < 4; ++e) if (col == row + e) agm[cI][e] += GAM[col]; }
            RW_ZERO(azm); mm64(azm, lds, O_BTT, O_MAK, wave, lane); mm64(azm, lds, O_KTT, O_VT, wave, lane);
            RW_ZERO(ar2); mm64(ar2, lds, O_MRB, O_UT, wave, lane);
#pragma unroll
            for (int cI = 0; cI < 2; ++cI) { const int col = ((wave & 1) * 2 + cI) * 16 + (lane & 15), row = (wave >> 1) * 16 + 4 * (lane >> 4);
#pragma unroll
                for (int e = 0; e < 4; ++e) ar2[cI][e] += bf2f(*(const LAS bf16*)(lds + O_RHN + ((row + e) * LS + col) * 2)); }
            RW_ZERO(ay0); mm64(ay0, lds, O_MRB, O_MAK, wave, lane); mm64(ay0, lds, O_MRK, O_VT, wave, lane);
            __syncthreads();
            storeN<0>(lds, O_AHN, agm, wave, lane); storeT(lds, O_RHN, azm, wave, lane); storeN<0>(lds, O_BCN, ar2, wave, lane); storeT(lds, O_KCN, ay0, wave, lane);
            __syncthreads();
            { const int io = ((tid >> 3) * LS + (tid & 7) * 8) * 2;
              ((u32x4*)gz)[tid] = *(const LAS u32x4*)(lds + O_AHN + io); ((u32x4*)(gz + 8192))[tid] = *(const LAS u32x4*)(lds + O_RHN + io);
              ((u32x4*)gz2)[tid] = *(const LAS u32x4*)(lds + O_BCN + io); ((u32x4*)(gz2 + 8192))[tid] = *(const LAS u32x4*)(lds + O_KCN + io); }
        } else {
            { f4 acc[2]; RW_ZERO(acc); mm64(acc, lds, O_TINV, O_AHT, wave, lane); storeN<0>(lds, O_A2N, acc, wave, lane); }
            __syncthreads();
            { f4 acc[2]; RW_ZERO(acc); mm64(acc, lds, O_TINV, O_MVT, wave, lane); mm64(acc, lds, O_A2N, O_STT, wave, lane); storeT(lds, O_UT, acc, wave, lane); }
            __syncthreads();
            f4 yacc[2]; RW_ZERO(yacc);
            mm64(yacc, lds, O_RHN, O_STT, wave, lane); mm64(yacc, lds, O_MRB, O_UT, wave, lane); mm64(yacc, lds, O_MRK, O_VT, wave, lane);
            __syncthreads();
#pragma unroll
            for (int cI = 0; cI < 2; ++cI) { const int col = ((wave & 1) * 2 + cI) * 16 + (lane & 15), row = (wave >> 1) * 16 + 4 * (lane >> 4);
#pragma unroll
                for (int e = 0; e < 4; ++e) YF[(row + e) * 64 + col] = yacc[cI][e]; }
            __syncthreads();
            { unsigned gcur = (unsigned)OB[((size_t)b * T + t0 + wave * 8) * 1024 + 512 + c];
#pragma unroll 1
            for (int q = 0; q < 8; ++q) {
                const int tt = wave * 8 + q; const size_t m = (size_t)b * T + t0 + tt;
                const unsigned gnxt = (unsigned)OB[(m + (q < 7 ? 1 : 0)) * 1024 + 512 + c];
                const float y = YF[tt * 64 + lane]; const float mean = wave_sum(y) * (1.f / 64.f); const float dy = y - mean; const float var = wave_sum(dy * dy) * (1.f / 64.f);
                const float yn = dy * rsqrtf(var + 64e-5f) * CTV(10) + CTV(11);
                const float vv = bf2f(*(const LAS bf16*)(lds + O_VT + (lane * LS + tt) * 2)), gg = LO_(gcur);
                OB[m * 1024 + 512 + c] = (bf16)f2bf((yn + BON[tt] * vv) * gg);
                gcur = gnxt;
            } }
        }
        __syncthreads();
#undef CTV
#undef LO_
#undef HI_
    }
}

__device__ __forceinline__ void chunk_out(LAS unsigned char* lds0, const int b, const int h, const int t0, const unsigned char* gz, const unsigned char* gz2, const float* bong, const bf16* VF, bf16* OB, const int tid0) {
    unsigned lb_ = 0u; int tid_l = tid0; asm volatile("" : "+v"(lb_), "+v"(tid_l));
    LAS unsigned char* lds = lds0 + lb_; const int tid = tid_l, lane = tid & 63, wave = __builtin_amdgcn_readfirstlane(tid >> 6);
    const int c = h * 64 + lane;
    const LAS float* CT = (const LAS float*)(lds + O_CT);
    LAS float* YF = (LAS float*)(lds + O_YF);
    const int io = ((tid >> 3) * LS + (tid & 7) * 8) * 2;
    const u32x4 sv = ((const u32x4*)gz)[tid], rv = ((const u32x4*)gz2)[tid];
    u32x2 yv[2];
#pragma unroll
    for (int k = 0; k < 2; ++k) { const int col = ((wave & 1) * 2 + k) * 16 + (lane & 15), row = (wave >> 1) * 16 + 4 * (lane >> 4); yv[k] = *(const u32x2*)(gz2 + 8192 + (col * 64 + row) * 2); }
    float gq[8], vq[8], bq[8];
#pragma unroll
    for (int q = 0; q < 8; ++q) { const int tt = wave * 8 + q; const size_t m = (size_t)b * T + t0 + tt;
        gq[q] = bf2f(((const bf16*)(gz2 + 16384))[tt * 64 + lane]); vq[q] = bf2f(VF[m * 256 + c]); bq[q] = bong[tt]; }
    *(LAS u32x4*)(lds + O_STT + io) = sv; *(LAS u32x4*)(lds + O_AHN + io) = rv;
    __syncthreads();
    f4 acc[2];
#pragma unroll
    for (int k = 0; k < 2; ++k) acc[k] = (f4){__uint_as_float(yv[k].x << 16), __uint_as_float(yv[k].x & 0xffff0000u), __uint_as_float(yv[k].y << 16), __uint_as_float(yv[k].y & 0xffff0000u)};
    mm64(acc, lds, O_AHN, O_STT, wave, lane);
#pragma unroll
    for (int cI = 0; cI < 2; ++cI) { const int col = ((wave & 1) * 2 + cI) * 16 + (lane & 15), row = (wave >> 1) * 16 + 4 * (lane >> 4);
#pragma unroll
        for (int e = 0; e < 4; ++e) YF[(row + e) * 64 + col] = acc[cI][e]; }
    __syncthreads();
#pragma unroll
    for (int q = 0; q < 8; ++q) { const int tt = wave * 8 + q; const size_t m = (size_t)b * T + t0 + tt;
        const float y = YF[tt * 64 + lane]; const float mean = wave_sum(y) * (1.f / 64.f); const float dy = y - mean; const float var = wave_sum(dy * dy) * (1.f / 64.f);
        const float yn = dy * rsqrtf(var + 64e-5f) * CT[10 * 64 + lane] + CT[11 * 64 + lane];
        OB[m * 1024 + 512 + c] = (bf16)f2bf((yn + bq[q] * vq[q]) * gq[q]); }
    __syncthreads();
}

__device__ __forceinline__ void carry(LAS unsigned char* lds0, unsigned char* gzc  , const int tid0) {
    f4 stacc[2]; RW_ZERO(stacc);
    { unsigned lb_ = 0u; asm volatile("" : "+v"(lb_)); LAS unsigned char* lds = lds0 + lb_; for (int i = tid0; i < MB / 4; i += NTHR) ((LAS unsigned*)(lds + O_STT))[i] = 0u; }
    u32x4 gnx = ((const u32x4*)gzc)[tid0];
    u32x2 znx[2];
    { const int lane = tid0 & 63, wave = tid0 >> 6;
#pragma unroll
      for (int k = 0; k < 2; ++k) { const int col = ((wave & 1) * 2 + k) * 16 + (lane & 15), row = (wave >> 1) * 16 + 4 * (lane >> 4); znx[k] = *(const u32x2*)(gzc + 8192 + (col * 64 + row) * 2); } }
#pragma unroll 1
    for (int cI = 0; cI < T / 64; ++cI) {
        unsigned lb_ = 0u; int tid_l = tid0; asm volatile("" : "+v"(lb_), "+v"(tid_l));
        LAS unsigned char* lds = lds0 + lb_; const int tid = tid_l, lane = tid & 63, wave = __builtin_amdgcn_readfirstlane(tid >> 6);
        unsigned char* rec = gzc + (size_t)cI * 16384;
        const int io = ((tid >> 3) * LS + (tid & 7) * 8) * 2;
        *(LAS u32x4*)(lds + O_AHN + io) = gnx;
        u32x2 zv[2]; zv[0] = znx[0]; zv[1] = znx[1];
        if (cI + 1 < T / 64) { gnx = ((const u32x4*)(rec + 16384))[tid];
#pragma unroll
            for (int k = 0; k < 2; ++k) { const int col = ((wave & 1) * 2 + k) * 16 + (lane & 15), row = (wave >> 1) * 16 + 4 * (lane >> 4); znx[k] = *(const u32x2*)(rec + 16384 + 8192 + (col * 64 + row) * 2); } }
        __syncthreads();
        ((u32x4*)rec)[tid] = *(const LAS u32x4*)(lds + O_STT + io);
        f4 acc[2];
#pragma unroll
        for (int k = 0; k < 2; ++k) acc[k] = (f4){__uint_as_float(zv[k].x << 16), __uint_as_float(zv[k].x & 0xffff0000u), __uint_as_float(zv[k].y << 16), __uint_as_float(zv[k].y & 0xffff0000u)};
        mm64(acc, lds, O_AHN, O_STT, wave, lane);
        __syncthreads();
        storeT(lds, O_STT, acc, wave, lane);
    }
}
}

namespace mb {
using rw::LS; using rw::MB; using rw::f4; using rw::mm64; using rw::storeN; using rw::bf16x8;
constexpr int O_CN = 0, O_BN = MB, O_BT = 2 * MB, O_XT0 = 3 * MB, O_XW0 = 5 * MB, O_CS0 = 7 * MB, O_HN0 = 9 * MB, O_SC0 = 11 * MB, O_SM = 13 * MB, O_YF = O_XW0;
static_assert(O_SM + 2048 <= LDS_BYTES - 576, "mamba LDS map");
__device__ __forceinline__ void chain(LAS unsigned char* lds0, const int l, const int b, const int gI, const bf16* P, bf16* OB, const int tid0, const int lane0, const int wave0) {
    const int tid = tid0, lane = lane0, wave = wave0;
    LAS unsigned char* const& lds = lds0;
    const float* cwp = INP(I_DCW) + (size_t)l * 4 * 512; const float* cbp = INP(I_DCB) + (size_t)l * 512;
    const int cc = tid & 255, sub = tid >> 8;
    const int col = cc < 128 ? (gI * 128 + cc) : (cc < 192 ? (256 + gI * 64 + (cc - 128)) : (384 + gI * 64 + (cc - 192)));
    const float cw0 = cwp[col], cw1 = cwp[512 + col], cw2 = cwp[1024 + col], cw3 = cwp[1536 + col], cb = cbp[col];
    f4 hacc[2][2];
#pragma unroll
    for (int hh = 0; hh < 2; ++hh) { hacc[hh][0] = (f4){0.f, 0.f, 0.f, 0.f}; hacc[hh][1] = (f4){0.f, 0.f, 0.f, 0.f}; }
    for (int i = tid; i < 2 * MB / 4; i += NTHR) ((LAS unsigned*)(lds0 + O_HN0))[i] = 0u;
    const float dtb0 = INP(I_DDTB)[l * 4 + gI * 2], dtb1 = INP(I_DDTB)[l * 4 + gI * 2 + 1];
    const float nA0 = -__expf(INP(I_DALOG)[l * 4 + gI * 2]), nA1 = -__expf(INP(I_DALOG)[l * 4 + gI * 2 + 1]);
    const float dsk0 = INP(I_DSKIP)[l * 4 + gI * 2], dsk1 = INP(I_DSKIP)[l * 4 + gI * 2 + 1];
    const float nw0 = INP(I_DNW)[l * 256 + gI * 128 + lane], nw1 = INP(I_DNW)[l * 256 + gI * 128 + 64 + lane];
#pragma unroll 1
    for (int t0 = 0; t0 < T; t0 += 64) {
        unsigned lb_ = 0u; int tid_l = tid0; asm volatile("" : "+v"(lb_), "+v"(tid_l));
        const int tid = tid_l, lane = tid & 63, wave = __builtin_amdgcn_readfirstlane(tid >> 6);
        LAS unsigned char* lds = lds0 + lb_;
        LAS float* SM = (LAS float*)(lds + O_SM);
        LAS float* YF = (LAS float*)(lds + O_YF);
        if (wave < 2) {
            const size_t m = (size_t)b * T + t0 + lane;
            const float dt = softplusf_(bf2f(P[m * PP + C_DT + gI * 2 + wave]) + (wave == 0 ? dtb0 : dtb1));
            float cs = dt * (wave == 0 ? nA0 : nA1);
#pragma unroll
            for (int o = 1; o < 64; o <<= 1) { const float y = __shfl_up(cs, o); if (lane >= o) cs += y; }
            const float cL = __shfl(cs, 63);
            SM[wave * 64 + lane] = dt; SM[128 + wave * 64 + lane] = cs; SM[256 + wave * 64 + lane] = __expf(cL - cs) * dt; SM[384 + wave * 64 + lane] = __expf(cs);
        }
        __syncthreads();
        { float h0, h1, h2, cur[8], nxt[8];
          { const int tb = t0 + sub * 32; h0 = tb >= 3 ? bf2f(P[((size_t)b * T + tb - 3) * PP + C_DX + col]) : 0.f; h1 = tb >= 2 ? bf2f(P[((size_t)b * T + tb - 2) * PP + C_DX + col]) : 0.f; h2 = tb >= 1 ? bf2f(P[((size_t)b * T + tb - 1) * PP + C_DX + col]) : 0.f;
#pragma unroll
            for (int j = 0; j < 8; ++j) cur[j] = bf2f(P[((size_t)b * T + tb + j) * PP + C_DX + col]); }
#pragma unroll 1
          for (int g8 = 0; g8 < 4; ++g8) {
            const int tb = t0 + sub * 32 + g8 * 8 + (g8 < 3 ? 8 : 0);
#pragma unroll
            for (int j = 0; j < 8; ++j) nxt[j] = bf2f(P[((size_t)b * T + tb + j) * PP + C_DX + col]);
#pragma unroll
            for (int j = 0; j < 8; ++j) {
                const int tt = sub * 32 + g8 * 8 + j;
                const float a = siluf_(cb + cw3 * cur[j] + cw2 * h2 + cw1 * h1 + cw0 * h0);
                h0 = h1; h1 = h2; h2 = cur[j];
                if (cc < 128) { const int hh = cc >> 6, p = cc & 63;
                    *(LAS bf16*)(lds + O_XT0 + hh * MB + (p * LS + tt) * 2) = (bf16)f2bf(a); *(LAS bf16*)(lds + O_XW0 + hh * MB + (p * LS + tt) * 2) = (bf16)f2bf(a * SM[256 + hh * 64 + tt]); }
                else if (cc < 192) { const int n = cc - 128; *(LAS bf16*)(lds + O_BN + (tt * LS + n) * 2) = (bf16)f2bf(a); *(LAS bf16*)(lds + O_BT + (n * LS + tt) * 2) = (bf16)f2bf(a); }
                else { const int n = cc - 192; *(LAS bf16*)(lds + O_CN + (tt * LS + n) * 2) = (bf16)f2bf(a);
                    *(LAS bf16*)(lds + O_CS0 + (tt * LS + n) * 2) = (bf16)f2bf(a * SM[384 + tt]); *(LAS bf16*)(lds + O_CS0 + MB + (tt * LS + n) * 2) = (bf16)f2bf(a * SM[384 + 64 + tt]); }
            }
#pragma unroll
            for (int j = 0; j < 8; ++j) cur[j] = nxt[j];
          } }
        __syncthreads();
        { f4 acc[2]; acc[0] = (f4){0.f, 0.f, 0.f, 0.f}; acc[1] = (f4){0.f, 0.f, 0.f, 0.f}; mm64(acc, lds, O_CN, O_BN, wave, lane);
#pragma unroll
            for (int hh = 0; hh < 2; ++hh) { f4 sc[2];
#pragma unroll
                for (int cI = 0; cI < 2; ++cI) { const int s = ((wave & 1) * 2 + cI) * 16 + (lane & 15), row = (wave >> 1) * 16 + 4 * (lane >> 4);
                    const float cs = SM[128 + hh * 64 + s], ds = SM[hh * 64 + s];
#pragma unroll
                    for (int e = 0; e < 4; ++e) { const float ct = SM[128 + hh * 64 + row + e]; sc[cI][e] = (s <= row + e) ? acc[cI][e] * __expf(ct - cs) * ds : 0.f; } }
                storeN<0>(lds, O_SC0 + hh * MB, sc, wave, lane); } }
        __syncthreads();
        f4 yacc[2][2];
#pragma unroll
        for (int hh = 0; hh < 2; ++hh) {
            yacc[hh][0] = (f4){0.f, 0.f, 0.f, 0.f}; yacc[hh][1] = (f4){0.f, 0.f, 0.f, 0.f};
            mm64(yacc[hh], lds, O_SC0 + hh * MB, O_XT0 + hh * MB, wave, lane); mm64(yacc[hh], lds, O_CS0 + hh * MB, O_HN0 + hh * MB, wave, lane);
            const float gL = SM[384 + hh * 64 + 63]; hacc[hh][0] = hacc[hh][0] * gL; hacc[hh][1] = hacc[hh][1] * gL;
            mm64(hacc[hh], lds, O_XW0 + hh * MB, O_BT, wave, lane);
        }
        __syncthreads();
#pragma unroll
        for (int hh = 0; hh < 2; ++hh) {
#pragma unroll
            for (int cI = 0; cI < 2; ++cI) { const int colp = ((wave & 1) * 2 + cI) * 16 + (lane & 15), row = (wave >> 1) * 16 + 4 * (lane >> 4);
#pragma unroll
                for (int e = 0; e < 4; ++e) YF[(row + e) * 128 + hh * 64 + colp] = yacc[hh][cI][e]; }
            storeN<0>(lds, O_HN0 + hh * MB, hacc[hh], wave, lane);
        }
        __syncthreads();
#pragma unroll
        for (int q = 0; q < 8; ++q) {
            const int tt = wave * 8 + q; const size_t m = (size_t)b * T + t0 + tt;
            const float x0 = bf2f(*(const LAS bf16*)(lds + O_XT0 + (lane * LS + tt) * 2)), x1 = bf2f(*(const LAS bf16*)(lds + O_XT0 + MB + (lane * LS + tt) * 2));
            const int c0 = gI * 128 + lane, c1 = c0 + 64;
            const float z0 = bf2f(P[m * PP + C_DZ + c0]), z1 = bf2f(P[m * PP + C_DZ + c1]);
            const float y0 = (YF[tt * 128 + lane] + dsk0 * x0) * siluf_(z0), y1 = (YF[tt * 128 + 64 + lane] + dsk1 * x1) * siluf_(z1);
            const float ss = wave_sum(y0 * y0 + y1 * y1); const float rs = rsqrtf(ss * (1.f / 128.f) + 1e-5f);
            OB[m * 1024 + 768 + c0] = (bf16)f2bf(y0 * rs * nw0); OB[m * 1024 + 768 + c1] = (bf16)f2bf(y1 * rs * nw1);
        }
        __syncthreads();
    }
}
}

namespace bsp {
typedef short bf16x8 __attribute__((ext_vector_type(8)));
typedef float f4 __attribute__((ext_vector_type(4)));
constexpr int HS = 129;
constexpr int O_HIST = 0;
constexpr int O_V = 66048;
constexpr int VS = 272;
constexpr int O_FLAG = O_V + 2 * 32 * VS * 2;
__device__ __forceinline__ unsigned okey(float s) { int q = (int)(s * 262144.f + 8388608.f); q = q < 1 ? 1 : (q > 16777215 ? 16777215 : q); return (unsigned)q << 8; }
__device__ __forceinline__ f4 idx_tile(const bf16* Pb, const int kt, const bf16x8 (&qi)[4][2], const float (&wq)[4], const int lane) {
    const bf16* kr = Pb + (size_t)(kt * 16 + (lane & 15)) * PP + C_IK + (lane >> 4) * 8;
    const bf16x8 a0 = *(const bf16x8*)kr, a1 = *(const bf16x8*)(kr + 32);
    f4 s = (f4){0.f, 0.f, 0.f, 0.f};
#pragma unroll
    for (int h = 0; h < 4; ++h) { f4 t = (f4){0.f, 0.f, 0.f, 0.f};
        t = __builtin_amdgcn_mfma_f32_16x16x32_bf16(a0, qi[h][0], t, 0, 0, 0); t = __builtin_amdgcn_mfma_f32_16x16x32_bf16(a1, qi[h][1], t, 0, 0, 0);
#pragma unroll
        for (int e = 0; e < 4; ++e) s[e] += wq[h] * fmaxf(t[e], 0.f); }
    return s;
}

__device__ __forceinline__ void item(LAS unsigned char* lds0, const int bb, const int qb, const bf16* P, bf16* OB, const int tid0, const int pm) {
    unsigned lb_ = 0u; int tid_l = tid0; asm volatile("" : "+v"(lb_), "+v"(tid_l));
    LAS unsigned char* lds = lds0 + lb_; const int tid = tid_l, lane = tid & 63, wave = __builtin_amdgcn_readfirstlane(tid >> 6);
    const bf16* Pb = P + (size_t)bb * T * PP;
    const int ql = wave * 16 + (lane & 15), tq = qb * 128 + ql, g = lane >> 4;
    const bf16* prow = Pb + (size_t)tq * PP;
    bf16x8 qi[4][2]; float wq[4];
#pragma unroll
    for (int h = 0; h < 4; ++h) { qi[h][0] = *(const bf16x8*)(prow + C_IQ + h * 64 + g * 8); qi[h][1] = *(const bf16x8*)(prow + C_IQ + h * 64 + 32 + g * 8); wq[h] = bf2f(prow[C_IW + h]) * 0.0625f; }
    LAS unsigned* hist = (LAS unsigned*)(lds + O_HIST) + ql * HS;
    const int nkt = (qb + 1) * 8;
    unsigned prefix = 0u; int needk = 256;
#pragma unroll 1
    for (int rr = 0; rr < (pm == 102 ? 2 : 1); ++rr) { prefix = 0u; needk = 256;
#pragma unroll 1
    for (int pass = 0; pass < 3; ++pass) {
        for (int i = lane; i < 16 * HS; i += 64) ((LAS unsigned*)(lds + O_HIST) + wave * 16 * HS)[i] = 0u;
        asm volatile("s_waitcnt lgkmcnt(0)" ::: "memory");
        const int shp = 32 - 8 * pass, shb = 24 - 8 * pass;
#pragma unroll 1
        for (int kt4 = 0; kt4 < nkt; kt4 += 4) {
            bf16x8 ka[4][2];
#pragma unroll
            for (int u = 0; u < 4; ++u) { const bf16* kr = Pb + (size_t)((kt4 + u) * 16 + (lane & 15)) * PP + C_IK + g * 8; ka[u][0] = *(const bf16x8*)kr; ka[u][1] = *(const bf16x8*)(kr + 32); }
#pragma unroll
            for (int u = 0; u < 4; ++u) {
                f4 s = (f4){0.f, 0.f, 0.f, 0.f};
#pragma unroll
                for (int h = 0; h < 4; ++h) { f4 t = (f4){0.f, 0.f, 0.f, 0.f};
                    t = __builtin_amdgcn_mfma_f32_16x16x32_bf16(ka[u][0], qi[h][0], t, 0, 0, 0); t = __builtin_amdgcn_mfma_f32_16x16x32_bf16(ka[u][1], qi[h][1], t, 0, 0, 0);
#pragma unroll
                    for (int e = 0; e < 4; ++e) s[e] += wq[h] * fmaxf(t[e], 0.f); }
#pragma unroll
                for (int e = 0; e < 4; ++e) { const int key = (kt4 + u) * 16 + 4 * g + e; const unsigned k32 = okey(s[e]);
                    const bool in = key <= tq && (pass == 0 || (k32 >> shp) == prefix);
                    if (in) { const unsigned bin = (k32 >> shb) & 255u; __hip_atomic_fetch_add(hist + (bin >> 1), (bin & 1u) ? 0x10000u : 1u, __ATOMIC_RELAXED, __HIP_MEMORY_SCOPE_WORKGROUP); } }
            }
        }
        asm volatile("s_waitcnt lgkmcnt(0)" ::: "memory");
        int cum = 0; unsigned bsel = 0u; int above = 0;
        for (int wd = 127; wd >= 0; --wd) { const unsigned v = hist[wd]; const int hi = (int)(v >> 16), lo = (int)(v & 0xffffu);
            if (cum + hi >= needk) { bsel = (unsigned)(2 * wd + 1); above = cum; break; } cum += hi;
            if (cum + lo >= needk) { bsel = (unsigned)(2 * wd); above = cum; break; } cum += lo; }
        prefix = (prefix << 8) | bsel; needk -= above;
        asm volatile("s_waitcnt lgkmcnt(0)" ::: "memory");
    }
    }
    unsigned thr = prefix; int cidx = 1 << 20;
    bool tie = false;
    if (tq < 256) thr = 0u;
    else { const unsigned v = hist[(prefix & 255u) >> 1]; const int ceq = (prefix & 1u) ? (int)(v >> 16) : (int)(v & 0xffffu); tie = needk < ceq; }
    if (__any(tie)) {
        int cbin = 0, rem = needk;
#pragma unroll 1
        for (int ip = 0; ip < 2; ++ip) {
            for (int i = g; i < HS; i += 4) hist[i] = 0u;
            asm volatile("s_waitcnt lgkmcnt(0)" ::: "memory");
#pragma unroll 1
            for (int kt = 0; kt < nkt; ++kt) {
                const f4 s = idx_tile(Pb, kt, qi, wq, lane);
#pragma unroll
                for (int e = 0; e < 4; ++e) { const int key = kt * 16 + 4 * g + e; const unsigned k32 = okey(s[e]);
                    const bool in = tie && key <= tq && (k32 >> 8) == prefix && (ip == 0 || (key >> 4) == cbin);
                    if (in) { const unsigned bin = ip == 0 ? (unsigned)(key >> 4) : (unsigned)(key & 15); __hip_atomic_fetch_add(hist + (bin >> 1), (bin & 1u) ? 0x10000u : 1u, __ATOMIC_RELAXED, __HIP_MEMORY_SCOPE_WORKGROUP); } }
            }
            asm volatile("s_waitcnt lgkmcnt(0)" ::: "memory");
            int cum = 0, bs = 0, below = 0;
            for (int wd = 0; wd < 128; ++wd) { const unsigned vv = hist[wd]; const int lo = (int)(vv & 0xffffu), hi = (int)(vv >> 16);
                if (cum + lo >= rem) { bs = 2 * wd; below = cum; break; } cum += lo;
                if (cum + hi >= rem) { bs = 2 * wd + 1; below = cum; break; } cum += hi; }
            if (ip == 0) { cbin = bs; rem -= below; } else if (tie) cidx = cbin * 16 + bs;
            asm volatile("s_waitcnt lgkmcnt(0)" ::: "memory");
        }
    }
    __syncthreads();
#pragma unroll
    for (int h = 0; h < 4; ++h) { *(LAS bf16x8*)(lds + O_HIST + wave * 8192 + ((h * 2 + 0) * 64 + lane) * 16) = qi[h][0]; *(LAS bf16x8*)(lds + O_HIST + wave * 8192 + ((h * 2 + 1) * 64 + lane) * 16) = qi[h][1]; }
    bf16x8 qa[4][2];
#pragma unroll
    for (int h = 0; h < 4; ++h) { qa[h][0] = *(const bf16x8*)(prow + C_BQ + h * 64 + g * 8); qa[h][1] = *(const bf16x8*)(prow + C_BQ + h * 64 + 32 + g * 8); }
    f4 oacc[4][4]; float mrun[4], lrun[4];
#pragma unroll
    for (int h = 0; h < 4; ++h) { mrun[h] = -INFINITY; lrun[h] = 0.f;
#pragma unroll
        for (int dt = 0; dt < 4; ++dt) oacc[h][dt] = (f4){0.f, 0.f, 0.f, 0.f}; }
#pragma unroll 1
    for (int rr = 0; rr < (pm == 103 ? 2 : 1); ++rr) {
#pragma unroll
    for (int h = 0; h < 4; ++h) { mrun[h] = -INFINITY; lrun[h] = 0.f;
#pragma unroll
        for (int dt = 0; dt < 4; ++dt) oacc[h][dt] = (f4){0.f, 0.f, 0.f, 0.f}; }
    const int nst = (qb + 1) * 4;
    const int vkey = tid >> 4, vch = tid & 15;
    u32x4 vpre0 = *(const u32x4*)(Pb + (size_t)vkey * PP + C_BV + vch * 8), vpre1 = *(const u32x4*)(Pb + (size_t)vkey * PP + C_BV + 128 + vch * 8);
    const unsigned vrd = (unsigned)(unsigned long)lds + (unsigned)(O_V + (4 * g + ((lane >> 2) & 3)) * (VS * 2) + (lane & 3) * 8);
#pragma unroll 1
    for (int st = 0; st < nst; ++st) {
        const int key0 = st * 32; const unsigned vbuf = (unsigned)(st & 1) * (32 * VS * 2);
        unsigned qio = (unsigned)(O_HIST + wave * 8192 + lane * 16); asm volatile("" : "+v"(qio));
        { LAS bf16* VL = (LAS bf16*)(lds + O_V + vbuf); *(LAS u32x4*)(VL + vkey * VS + vch * 8) = vpre0; *(LAS u32x4*)(VL + vkey * VS + 128 + vch * 8) = vpre1; }
        bf16x8 kq[4][2][2], ki[2][2];
#pragma unroll
        for (int k2 = 0; k2 < 2; ++k2) { const bf16* kr = Pb + (size_t)(key0 + k2 * 16 + (lane & 15)) * PP;
            ki[k2][0] = *(const bf16x8*)(kr + C_IK + g * 8); ki[k2][1] = *(const bf16x8*)(kr + C_IK + 32 + g * 8);
#pragma unroll
            for (int h = 0; h < 2; ++h) { kq[h][k2][0] = *(const bf16x8*)(kr + C_BK + h * 64 + g * 8); kq[h][k2][1] = *(const bf16x8*)(kr + C_BK + h * 64 + 32 + g * 8); } }
        __syncthreads();
        bool sel[2][4];
#pragma unroll
        for (int k2 = 0; k2 < 2; ++k2) { f4 s = (f4){0.f, 0.f, 0.f, 0.f};
#pragma unroll
            for (int h = 0; h < 4; ++h) { f4 t = (f4){0.f, 0.f, 0.f, 0.f};
                const bf16x8 qh0 = *(const LAS bf16x8*)(lds + qio + ((h * 2 + 0) * 64) * 16), qh1 = *(const LAS bf16x8*)(lds + qio + ((h * 2 + 1) * 64) * 16);
                t = __builtin_amdgcn_mfma_f32_16x16x32_bf16(ki[k2][0], qh0, t, 0, 0, 0); t = __builtin_amdgcn_mfma_f32_16x16x32_bf16(ki[k2][1], qh1, t, 0, 0, 0);
#pragma unroll
                for (int e = 0; e < 4; ++e) s[e] += wq[h] * fmaxf(t[e], 0.f); }
#pragma unroll
            for (int e = 0; e < 4; ++e) { const int key = key0 + k2 * 16 + 4 * g + e; const unsigned k24 = okey(s[e]) >> 8;
                sel[k2][e] = key <= tq && (k24 > thr || (k24 == thr && key <= cidx)); } }
#pragma unroll
        for (int h = 0; h < 4; ++h) {
            if (h == 2 && st + 1 < nst) { vpre0 = *(const u32x4*)(Pb + (size_t)(key0 + 32 + vkey) * PP + C_BV + vch * 8); vpre1 = *(const u32x4*)(Pb + (size_t)(key0 + 32 + vkey) * PP + C_BV + 128 + vch * 8); }
            if (h + 2 < 4) {
                asm volatile("" ::: "memory");
#pragma unroll
                for (int k2 = 0; k2 < 2; ++k2) { const bf16* kr = Pb + (size_t)(key0 + k2 * 16 + (lane & 15)) * PP + C_BK + (h + 2) * 64 + g * 8; kq[h + 2][k2][0] = *(const bf16x8*)kr; kq[h + 2][k2][1] = *(const bf16x8*)(kr + 32); }
                asm volatile("" ::: "memory");
            }
            f4 sc[2];
#pragma unroll
            for (int k2 = 0; k2 < 2; ++k2) { f4 t = (f4){0.f, 0.f, 0.f, 0.f};
                t = __builtin_amdgcn_mfma_f32_16x16x32_bf16(kq[h][k2][0], qa[h][0], t, 0, 0, 0); t = __builtin_amdgcn_mfma_f32_16x16x32_bf16(kq[h][k2][1], qa[h][1], t, 0, 0, 0);
#pragma unroll
                for (int e = 0; e < 4; ++e) sc[k2][e] = sel[k2][e] ? t[e] * 0.125f : -INFINITY; }
            float mx = fmaxf(fmaxf(fmaxf(sc[0][0], sc[0][1]), fmaxf(sc[0][2], sc[0][3])), fmaxf(fmaxf(sc[1][0], sc[1][1]), fmaxf(sc[1][2], sc[1][3])));
            mx = fmaxf(mx, __shfl_xor(mx, 16)); mx = fmaxf(mx, __shfl_xor(mx, 32));
            const float mnew = fmaxf(mrun[h], mx), msafe = (mnew == -INFINITY) ? 0.f : mnew;
            const float corr = __expf(mrun[h] - msafe); mrun[h] = mnew;
            float p[8]; float ps = 0.f;
#pragma unroll
            for (int e = 0; e < 4; ++e) { p[e] = __expf(sc[0][e] - msafe); p[4 + e] = __expf(sc[1][e] - msafe); ps += p[e] + p[4 + e]; }
            lrun[h] = lrun[h] * corr + ps;
            union { bf16x8 v; unsigned u[4]; } pb;
            pb.u[0] = pg8::cvt_pk_bf16(p[0], p[1]); pb.u[1] = pg8::cvt_pk_bf16(p[2], p[3]); pb.u[2] = pg8::cvt_pk_bf16(p[4], p[5]); pb.u[3] = pg8::cvt_pk_bf16(p[6], p[7]);
            union { bf16x8 v; u32x2 h2[2]; } vf[4];
            const unsigned va = vrd + vbuf + (unsigned)(h * 128);
            asm volatile("ds_read_b64_tr_b16 %0, %8\n\tds_read_b64_tr_b16 %1, %8 offset:%9\n\tds_read_b64_tr_b16 %2, %8 offset:32\n\tds_read_b64_tr_b16 %3, %8 offset:%10\n\t"
                         "ds_read_b64_tr_b16 %4, %8 offset:64\n\tds_read_b64_tr_b16 %5, %8 offset:%11\n\tds_read_b64_tr_b16 %6, %8 offset:96\n\tds_read_b64_tr_b16 %7, %8 offset:%12\n\ts_waitcnt lgkmcnt(0)"
                         : "=&v"(vf[0].h2[0]), "=&v"(vf[0].h2[1]), "=&v"(vf[1].h2[0]), "=&v"(vf[1].h2[1]), "=&v"(vf[2].h2[0]), "=&v"(vf[2].h2[1]), "=&v"(vf[3].h2[0]), "=&v"(vf[3].h2[1])
                         : "v"(va), "i"(16 * VS * 2), "i"(16 * VS * 2 + 32), "i"(16 * VS * 2 + 64), "i"(16 * VS * 2 + 96) : "memory");
            __builtin_amdgcn_sched_barrier(0);
#pragma unroll
            for (int dt = 0; dt < 4; ++dt) { oacc[h][dt] = oacc[h][dt] * corr; oacc[h][dt] = __builtin_amdgcn_mfma_f32_16x16x32_bf16(vf[dt].v, pb.v, oacc[h][dt], 0, 0, 0); }
        }
    }
    __syncthreads();
    }
    const size_t m = (size_t)bb * T + tq;
#pragma unroll
    for (int h = 0; h < 4; ++h) { float l = lrun[h]; l += __shfl_xor(l, 16); l += __shfl_xor(l, 32); const float inv = 1.f / l;
#pragma unroll
        for (int dt = 0; dt < 4; ++dt) { u32x2 w; w.x = pk2(oacc[h][dt][0] * inv, oacc[h][dt][1] * inv); w.y = pk2(oacc[h][dt][2] * inv, oacc[h][dt][3] * inv);
            *(u32x2*)(OB + m * 1024 + 256 + h * 64 + dt * 16 + 4 * g) = w; } }
    __syncthreads();
}
}

namespace awin {
typedef short bf16x8 __attribute__((ext_vector_type(8)));
typedef float f4 __attribute__((ext_vector_type(4)));
constexpr int EXS = 66;
constexpr int O_EX = 0;
constexpr int VSW = 72;
constexpr int O_VW = 101376;
__device__ __forceinline__ void item(LAS unsigned char* lds0, const int bb, const int blk, const int h, const bf16* P, bf16* OB, const int tid0) {
    unsigned lb_ = 0u; int tid_l = tid0; asm volatile("" : "+v"(lb_), "+v"(tid_l));
    LAS unsigned char* lds = lds0 + lb_; const int tid = tid_l, lane = tid & 63, wave = __builtin_amdgcn_readfirstlane(tid >> 6);
    const bf16* Pb = P + (size_t)bb * T * PP; const int start = blk * 128, g = lane >> 4, ln = lane & 15;
    LAS float* EX = (LAS float*)(lds + O_EX);
    LAS bf16* VW = (LAS bf16*)(lds + O_VW + wave * 4608);
#pragma unroll 1
    for (int s4 = 0; s4 < 4; ++s4) {
        const int st = wave * 4 + s4;
        const int grp = st < 8 ? 0 : (st < 16 ? 1 : 2);
        const int dil = grp == 0 ? 1 : (grp == 1 ? 4 : 16), win = grp == 0 ? 128 : (grp == 1 ? 512 : 2048);
        const int r = grp == 0 ? 0 : (grp == 1 ? ((st - 8) >> 1) : (st - 16)), a0 = grp == 0 ? 16 * st : (grp == 1 ? ((st - 8) & 1) * 16 : 0), nqc = grp == 0 ? 128 : (grp == 1 ? 32 : 8);
        const int a = a0 + ln; const bool qok = a < nqc; const int ql = (qok ? a : (nqc - 1)) * dil + r, tq = start + ql;
        const bf16* qp = Pb + (size_t)tq * PP + C_AQ + grp * 256 + h * 64 + g * 8;
        const bf16x8 q0 = *(const bf16x8*)qp, q1 = *(const bf16x8*)(qp + 32);
        bf16x8 kf[10][2];
#pragma unroll
        for (int kt = 0; kt < 10; ++kt) { int pos = start - win + (a0 + 16 * kt + ln) * dil + r; pos = pos < 0 ? 0 : (pos > T - 1 ? T - 1 : pos);
            const bf16* kp = Pb + (size_t)pos * PP + C_AK + grp * 256 + h * 64 + g * 8; kf[kt][0] = *(const bf16x8*)kp; kf[kt][1] = *(const bf16x8*)(kp + 32); }
        f4 sc[10]; float mx = -INFINITY;
#pragma unroll
        for (int kt = 0; kt < 10; ++kt) { f4 t = (f4){0.f, 0.f, 0.f, 0.f};
            t = __builtin_amdgcn_mfma_f32_16x16x32_bf16(kf[kt][0], q0, t, 0, 0, 0); t = __builtin_amdgcn_mfma_f32_16x16x32_bf16(kf[kt][1], q1, t, 0, 0, 0);
#pragma unroll
            for (int e = 0; e < 4; ++e) { const int c = a0 + 16 * kt + 4 * g + e; const int pos = start - win + c * dil + r;
                const bool ok = qok && c >= a && c <= a + 128 && pos >= 0;
                sc[kt][e] = ok ? t[e] * 0.125f : -INFINITY; mx = fmaxf(mx, sc[kt][e]); } }
        mx = fmaxf(mx, __shfl_xor(mx, 16)); mx = fmaxf(mx, __shfl_xor(mx, 32));
        const float msafe = (mx == -INFINITY) ? 0.f : mx; float lsum = 0.f;
#pragma unroll
        for (int kt = 0; kt < 10; ++kt)
#pragma unroll
            for (int e = 0; e < 4; ++e) { sc[kt][e] = __expf(sc[kt][e] - msafe); lsum += sc[kt][e]; }
        lsum += __shfl_xor(lsum, 16); lsum += __shfl_xor(lsum, 32);
        f4 oacc[4];
#pragma unroll
        for (int dt = 0; dt < 4; ++dt) oacc[dt] = (f4){0.f, 0.f, 0.f, 0.f};
#pragma unroll
        for (int s5 = 0; s5 < 5; ++s5) {
            int pos = start - win + (a0 + 32 * s5 + (lane >> 1)) * dil + r; pos = pos < 0 ? 0 : (pos > T - 1 ? T - 1 : pos);
            const u32x4* vp = (const u32x4*)(Pb + (size_t)pos * PP + C_AV + grp * 256 + h * 64 + (lane & 1) * 32);
            const u32x4 v0 = vp[0], v1 = vp[1], v2 = vp[2], v3 = vp[3];
            LAS u32x4* vd = (LAS u32x4*)(VW + (lane >> 1) * VSW + (lane & 1) * 32);
            asm volatile("s_waitcnt lgkmcnt(0)" ::: "memory");
            vd[0] = v0; vd[1] = v1; vd[2] = v2; vd[3] = v3;
            asm volatile("s_waitcnt lgkmcnt(0)" ::: "memory");
            bf16x8 pb;
#pragma unroll
            for (int e = 0; e < 4; ++e) { pb[e] = (short)f2bf(sc[2 * s5][e]); pb[4 + e] = (short)f2bf(sc[2 * s5 + 1][e]); }
#pragma unroll
            for (int dt = 0; dt < 4; ++dt) { bf16x8 vf; const LAS bf16* vb = VW + (4 * g) * VSW + dt * 16 + ln;
#pragma unroll
                for (int e = 0; e < 4; ++e) { vf[e] = (short)vb[e * VSW]; vf[4 + e] = (short)vb[(16 + e) * VSW]; }
                oacc[dt] = __builtin_amdgcn_mfma_f32_16x16x32_bf16(vf, pb, oacc[dt], 0, 0, 0); }
        }
        if (qok) { LAS float* ex = EX + (grp * 128 + ql) * EXS;
#pragma unroll
            for (int dt = 0; dt < 4; ++dt) { ex[dt * 16 + 4 * g + 0] = oacc[dt][0]; ex[dt * 16 + 4 * g + 1] = oacc[dt][1]; ex[dt * 16 + 4 * g + 2] = oacc[dt][2]; ex[dt * 16 + 4 * g + 3] = oacc[dt][3]; }
            if (g == 0) { ex[64] = mx; ex[65] = lsum; } }
    }
    __syncthreads();
    { const int ql = tid >> 2, d0 = (tid & 3) * 16;
      const LAS float* e0 = EX + (0 * 128 + ql) * EXS; const LAS float* e1 = EX + (1 * 128 + ql) * EXS; const LAS float* e2 = EX + (2 * 128 + ql) * EXS;
      const float m0 = e0[64], m1 = e1[64], m2 = e2[64], M = fmaxf(m0, fmaxf(m1, m2));
      const float w0 = __expf(m0 - M), w1 = __expf(m1 - M), w2 = __expf(m2 - M); const float inv = 1.f / (w0 * e0[65] + w1 * e1[65] + w2 * e2[65]);
      unsigned pk[8];
#pragma unroll
      for (int j = 0; j < 8; ++j) { const float x0 = (w0 * e0[d0 + 2 * j] + w1 * e1[d0 + 2 * j] + w2 * e2[d0 + 2 * j]) * inv, x1 = (w0 * e0[d0 + 2 * j + 1] + w1 * e1[d0 + 2 * j + 1] + w2 * e2[d0 + 2 * j + 1]) * inv; pk[j] = pk2(x0, x1); }
      u32x4* op = (u32x4*)(OB + ((size_t)bb * T + start + ql) * 1024 + h * 64 + d0);
      op[0] = (u32x4){pk[0], pk[1], pk[2], pk[3]}; op[1] = (u32x4){pk[4], pk[5], pk[6], pk[7]}; }
    __syncthreads();
}
}

template <int SP>
__device__ __forceinline__ void phase_body(const int l_in, LAS unsigned char* lds) {
    int tid_ = threadIdx.x, bid_ = blockIdx.x, l_ = l_in, G_ = gridDim.x; asm volatile("" : "+v"(tid_), "+s"(bid_), "+s"(l_), "+s"(G_));
    const int tid = tid_, lane = tid & 63, wave = __builtin_amdgcn_readfirstlane(tid >> 6), l = l_;
    const int G = G_, bid = bid_;
    const int gw = bid * NWAVES + wave, NGW = G * NWAVES;
    unsigned char* ws = (unsigned char*)ldptr(lds, 36);
    int* ctl = (int*)(ws + WS_CTL);
    bf16* XB = (bf16*)(ws + WS_XB); bf16* OB = (bf16*)(ws + WS_O); bf16* VF = (bf16*)(ws + WS_VF); bf16* P = (bf16*)(ws + WS_P);
    bf16* GS = (bf16*)(ws + WS_GS); bf16* MG = (bf16*)(ws + WS_MERGED); bf16* XS = (bf16*)(ws + WS_XS); bf16* HB = (bf16*)(ws + WS_H);
    bf16* WGU = (bf16*)(ws + WS_WGU); bf16* WD = (bf16*)(ws + WS_WD);
    float* X = (float*)ldptr(lds, 35);
    int* tok_e = (int*)(ws + WS_ROUTE); float* tok_g = (float*)(ws + WS_ROUTE + 256 * 1024); int* tok_rank = (int*)(ws + WS_ROUTE + 512 * 1024); int* tok_slot = (int*)(ws + WS_ROUTE + 768 * 1024);
    (void)ctl; (void)XB; (void)OB; (void)VF; (void)P; (void)GS; (void)MG; (void)XS; (void)HB; (void)WGU; (void)WD; (void)X; (void)tok_e; (void)tok_g; (void)tok_rank; (void)tok_slot; (void)gw; (void)NGW; (void)lane;
    {
        bf16* WinT = (bf16*)(ws + WS_WINT) + (size_t)l * 5120 * 1024; bf16* WgT = (bf16*)(ws + WS_WGT) + (size_t)l * 4096 * 1024;
        bf16* WbrT = (bf16*)(ws + WS_WBRT) + (size_t)l * 1024 * 1024; bf16* WoutT = (bf16*)(ws + WS_WOUTT) + (size_t)l * 1024 * 1024;
        float* WrT = (float*)(ws + WS_WRT) + (size_t)l * 36 * 1024;
        int* cnt = ctl + CW_CNT + l * 64;

        if constexpr (SP == -1) {
            LAS float* scr = (LAS float*)(lds + wave * 16384);
#pragma unroll 1
            for (int job = 0; job < NL * 11; ++job) {
                const int ll = job / 11, jk = job % 11;
                if (jk < 5) {
                    const float* W = INP(I_WIN) + (size_t)ll * 1024 * INW;
                    const int sc0 = jk == 0 ? 0 : (jk == 1 ? 3396 : (jk == 2 ? 3392 : (jk == 3 ? 5060 : 5064)));
                    const int snc = jk == 0 ? 3392 : (jk == 1 ? 1664 : (jk == 4 ? 4096 : 4));
                    const int sr0 = jk == 0 ? 0 : (jk == 1 ? 3392 : (jk == 2 ? 5056 : (jk == 3 ? 5060 : 0)));
                    bf16* dst = jk == 4 ? (bf16*)(ws + WS_WGT) + (size_t)ll * 4096 * 1024 : (bf16*)(ws + WS_WINT) + (size_t)ll * 5120 * 1024;
                    const int nbn = (snc + 31) / 32, nit = 16 * nbn;
#pragma unroll 1
                    for (int it = gw; it < nit; it += NGW) transpose_item(W, INW, sc0, snc, dst, 1024, sr0, 0, it / nbn, it % nbn, scr, lane);
                } else if (jk < 9) {
                    const int n = jk - 5; const float* Wb = INP(I_WBR) + ((size_t)ll * 4 + n) * 256 * 1024;
#pragma unroll 1
                    for (int it = gw; it < 4 * 32; it += NGW) transpose_item(Wb, 1024, 0, 1024, (bf16*)(ws + WS_WBRT) + (size_t)ll * 1024 * 1024, 1024, 0, n * 256, it / 32, it % 32, scr, lane);
                } else if (jk == 9) {
                    const float* Wo = INP(I_WOUT) + (size_t)ll * 1024 * 1024;
#pragma unroll 1
                    for (int it = gw; it < 16 * 32; it += NGW) transpose_item(Wo, 1024, 0, 1024, (bf16*)(ws + WS_WOUTT) + (size_t)ll * 1024 * 1024, 1024, 0, 0, it / 32, it % 32, scr, lane);
                } else {
                    bf16* wi = (bf16*)(ws + WS_WINT) + (size_t)ll * 5120 * 1024;
#pragma unroll 1
                    for (int i = gw * 64 + lane; i < 56 * 1024 / 8; i += NGW * 64) ((u32x4*)(wi + (size_t)5064 * 1024))[i] = (u32x4){0u, 0u, 0u, 0u};
                    float* wr = (float*)(ws + WS_WRT) + (size_t)ll * 36 * 1024; const float* rg = INP(I_RG) + (size_t)ll * 1024 * 4; const float* re = INP(I_RE) + (size_t)ll * 1024 * 32;
#pragma unroll 1
                    for (int i = gw * 64 + lane; i < 36 * 1024; i += NGW * 64) { const int o = i / 1024, k = i % 1024; wr[i] = o < 4 ? rg[k * 4 + o] : re[k * 32 + (o - 4)]; }
                }
            }
            for (int m = gw; m < M; m += NGW) {
                const f32x4* xr = (const f32x4*)(INP(I_X) + (size_t)m * D) + lane;
#pragma unroll
                for (int j = 0; j < 4; ++j) { const f32x4 v = xr[64 * j]; ((f32x4*)(X + (size_t)m * D))[lane + 64 * j] = v;
                    u32x2 w; w.x = pk2(v[0], v[1]); w.y = pk2(v[2], v[3]); ((u32x2*)(XB + (size_t)m * D))[lane + 64 * j] = w; }
            }
        }
        else if constexpr (SP == 0) {
            pg8::Gemm g{XB, WinT, 1024, 1024, 1024}; pg8::StaticOrder S; S.init(M, PP, G, bid, 1024, 1024);
            EpiStoreBf16 E{P, PP, 0, PP};
            pg8::gemm_phase<EpiStoreBf16, pg8::StaticOrder>(lds, g, S, E);
        }
        else if constexpr (SP == 12) {
            if (bid < 32) rw::carry(lds, ws + WS_RW + (size_t)bid * 64 * 16384, tid);
        }
        else if constexpr (SP == 13) {
            unsigned char* GZ = ws + WS_RW;
            const int h = bid & 3, k = bid >> 2;
            rw::build_ct(lds, l, h, lane, wave); __syncthreads();
#pragma unroll 1
            for (int idx = k; idx < 512; idx += (G >> 2)) { const int b = idx >> 6, cI = idx & 63; const size_t ci_ = (size_t)((b * 4 + h) * 64 + cI);
                rw::chunk_out(lds, b, h, cI * 64, GZ + ci_ * 16384, ws + WS_RW2 + ci_ * 24576, (const float*)(ws + WS_BONG) + ci_ * 64, VF, OB, tid); }
        }
        else if constexpr (SP == 15) {
            unsigned char* GZ = ws + WS_RW;
            int* qctr = ctl + CW_Q + l * 64;
            unsigned so = (unsigned)(LDS_BYTES - 584); asm volatile("" : "+v"(so));
            volatile LAS int* slot = (volatile LAS int*)(lds + so);
            int cur_h = -1;
#pragma unroll 1
            for (;;) {
                int tid = threadIdx.x; asm volatile("" : "+v"(tid));
                const int lane = tid & 63, wave = __builtin_amdgcn_readfirstlane(tid >> 6);
                __syncthreads();
                if (tid == 0) *slot = atomicAdd(qctr, 1);
                __syncthreads();
                const int it = __builtin_amdgcn_readfirstlane(*slot);
                if (it >= 3344) break;
                if (it < 16) { mb::chain(lds, l, it >> 1, it & 1, P, OB, tid, lane, wave); }
                else if (it < 272) { const int j = it - 16; bsp::item(lds, j & 7, 31 - (j >> 3), P, OB, tid, (int)(unsigned)ldptr(lds, 37)); }
                else if (it < 2320) { const int j = it - 272, h = j >> 9, idx = j & 511, b = idx >> 6, cI = idx & 63;
                    if (h != cur_h) { rw::build_ct(lds, l, h, lane, wave); cur_h = h; __syncthreads(); }
                    { const size_t ci_ = (size_t)((b * 4 + h) * 64 + cI); rw::chunk<1>(lds, l, b, h, cI * 64, GZ + ci_ * 16384, ws + WS_RW2 + ci_ * 24576, (float*)(ws + WS_BONG) + ci_ * 64, P, VF, OB, tid); } }
                else { const int j = it - 2320; awin::item(lds, j >> 7, (j >> 2) & 31, j & 3, P, OB, tid); }
            }
        }
        else if constexpr (SP == 4) {
            pg8::Gemm g{XB, WgT, 1024, 1024, 1024}; pg8::StaticOrder S; S.init(M, 4096, G, bid, 1024, 1024);
            EpiStoreBf16 E{GS, 4096, 1, 4096};
            pg8::gemm_phase<EpiStoreBf16, pg8::StaticOrder>(lds, g, S, E);
        }
        else if constexpr (SP == 5) {
            pg8::Gemm g{OB, WbrT, 1024, 1024, 256}; BranchOrder S{M / 256, 4, G, bid};
            EpiBranch E{GS, MG};
            pg8::gemm_phase<EpiBranch, BranchOrder>(lds, g, S, E);
        }
        else if constexpr (SP == 6) {
            pg8::Gemm g{MG, WoutT, 1024, 1024, 1024}; pg8::StaticOrder S; S.init(M, 1024, G, bid, 1024, 1024);
            EpiResid E{X};
            pg8::gemm_phase<EpiResid, pg8::StaticOrder>(lds, g, S, E);
        }
        else if constexpr (SP == 7) {
            const float* g1 = INP(I_LN1G) + l * 1024; const float* b1 = INP(I_LN1B) + l * 1024;
            const float* rgb = INP(I_RGB) + l * 4; const float* reb = INP(I_REB) + l * 32;
            for (int m = gw; m < M; m += NGW) {
                f32x4 v[4]; float s = 0.f; f32x4* xr = (f32x4*)(X + (size_t)m * D) + lane;
#pragma unroll
                for (int j = 0; j < 4; ++j) { v[j] = xr[64 * j]; s += (v[j][0] + v[j][1]) + (v[j][2] + v[j][3]); }
                const float mean = wave_sum(s) * (1.f / D); float s2 = 0.f;
#pragma unroll
                for (int j = 0; j < 4; ++j) { v[j] = v[j] - mean; s2 += (v[j][0] * v[j][0] + v[j][1] * v[j][1]) + (v[j][2] * v[j][2] + v[j][3] * v[j][3]); }
                const float rstd = rsqrtf(wave_sum(s2) * (1.f / D) + LN_EPS);
#pragma unroll
                for (int j = 0; j < 4; ++j) { const f32x4 gg = ((const f32x4*)g1)[lane + 64 * j], bb = ((const f32x4*)b1)[lane + 64 * j]; v[j] = v[j] * rstd * gg + bb; xr[64 * j] = v[j];
                    u32x2 w; w.x = pk2(v[j][0], v[j][1]); w.y = pk2(v[j][2], v[j][3]); ((u32x2*)(XB + (size_t)m * D))[lane + 64 * j] = w; }
                float mylg = 0.f;
#pragma unroll 1
                for (int o4 = 0; o4 < 36; o4 += 4) { float a4[4];
#pragma unroll
                    for (int u = 0; u < 4; ++u) { float a = 0.f;
#pragma unroll
                        for (int j = 0; j < 4; ++j) { const f32x4 wv = ((const f32x4*)(WrT + (o4 + u) * 1024))[lane + 64 * j]; a += v[j][0] * wv[0] + v[j][1] * wv[1] + v[j][2] * wv[2] + v[j][3] * wv[3]; }
                        a4[u] = a; }
#pragma unroll
                    for (int sft = 1; sft < 64; sft <<= 1) {
#pragma unroll
                        for (int u = 0; u < 4; ++u) a4[u] += __shfl_xor(a4[u], sft); }
#pragma unroll
                    for (int u = 0; u < 4; ++u) mylg = (lane == o4 + u) ? a4[u] : mylg; }
                mylg += lane < 4 ? rgb[lane & 3] : (lane < 36 ? reb[(lane - 4) & 31] : 0.f);
                float gl[4]; float gm = -INFINITY; int gs = 0;
#pragma unroll
                for (int o = 0; o < 4; ++o) { gl[o] = __shfl(mylg, o); if (gl[o] > gm) { gm = gl[o]; gs = o; } }
                float gden = 0.f;
#pragma unroll
                for (int o = 0; o < 4; ++o) gden += __expf(gl[o] - gm);
                const float pg = 1.f / gden;
                float el[8];
#pragma unroll
                for (int o = 0; o < 8; ++o) el[o] = __shfl(mylg, 4 + gs * 8 + o);
                int e1 = 0; float m1 = el[0];
#pragma unroll
                for (int o = 1; o < 8; ++o) if (el[o] > m1) { m1 = el[o]; e1 = o; }
                int e2 = -1; float m2 = -INFINITY;
#pragma unroll
                for (int o = 0; o < 8; ++o) if (o != e1 && el[o] > m2) { m2 = el[o]; e2 = o; }
                const float r2 = __expf(m2 - m1); const float ga = pg / (1.f + r2), gb = pg * r2 / (1.f + r2);
                if (lane == 0) {
                    const int E1 = gs * 8 + e1, E2 = gs * 8 + e2;
                    tok_e[m * 2] = E1; tok_e[m * 2 + 1] = E2; tok_g[m * 2] = ga; tok_g[m * 2 + 1] = gb;
                    tok_rank[m * 2] = atomicAdd(&cnt[E1], 1); tok_rank[m * 2 + 1] = atomicAdd(&cnt[E2], 1);
                }
            }
        }
        else if constexpr (SP == 14) {
            LAS float* scr = (LAS float*)(lds + wave * 16384);
            const float* eg = INP(I_EG) + (size_t)l * NEXP * 1024 * 512; const float* eu = INP(I_EU) + (size_t)l * NEXP * 1024 * 512; const float* ed = INP(I_ED) + (size_t)l * NEXP * 512 * 1024;
            for (int it = gw; it < NEXP * 2 * 4 * 64; it += NGW) {
                const int e = it / 512, r = it % 512, half = r / 256, ct = (r % 256) / 64, q = r % 64, kb = q / 4, nb = q % 4;
                const float* W = (half ? eu : eg) + (size_t)e * 1024 * 512;
                transpose_item(W, 512, ct * 128, 128, WGU + (size_t)e * 1024 * 1024, 1024, ct * 256 + half * 128, 0, kb, nb, scr, lane);
            }
            for (int it = gw; it < NEXP * 8 * 32; it += NGW) {
                const int e = it / 256, q = it % 256, kb = q / 32, nb = q % 32;
                transpose_item(ed + (size_t)e * 512 * 1024, 1024, 0, 1024, WD + (size_t)e * 1024 * 512, 512, 0, 0, kb, nb, scr, lane);
            }
        }
        else if constexpr (SP == 8 || SP == 9 || SP == 10) {
            unsigned tbo = MISC_OFF; asm volatile("" : "+v"(tbo));
            volatile LAS int* tb = (volatile LAS int*)(lds + tbo);
            if (tid == 0) { int acc = 0; for (int e = 0; e < 32; ++e) { const int c = __hip_atomic_load(&cnt[e], __ATOMIC_RELAXED, __HIP_MEMORY_SCOPE_AGENT); tb[e] = acc; tb[33 + e] = acc; acc += (c + 255) >> 8; } tb[32] = acc; }
            __syncthreads();
            if constexpr (SP == 8) {
                for (int m = gw; m < M; m += NGW) {
#pragma unroll
                    for (int k = 0; k < 2; ++k) { const int e = tok_e[m * 2 + k]; const int slot = tb[33 + e] * 256 + tok_rank[m * 2 + k];
                        const u32x4* src = (const u32x4*)(XB + (size_t)m * D); u32x4* dst = (u32x4*)(XS + (size_t)slot * D);
                        dst[lane] = src[lane]; dst[lane + 64] = src[lane + 64];
                        if (lane == 0) tok_slot[m * 2 + k] = slot; }
                }
            } else if constexpr (SP == 9) {
                pg8::Gemm g{XS, WGU, 1024, 1024, 1024}; MoeOrder S{tb, G, bid, (size_t)1024 * 2, (size_t)1024 * 1024 * 2, (size_t)256 * 1024 * 2};
                EpiSwiglu E{HB};
                pg8::gemm_phase<EpiSwiglu, MoeOrder>(lds, g, S, E);
            } else {
                pg8::Gemm g{HB, WD, 512, 512, 512}; MoeOrder S{tb, G, bid, (size_t)512 * 2, (size_t)1024 * 512 * 2, (size_t)256 * 512 * 2};
                EpiStoreBf16 E{XS, 1024, 0, 1024};
                pg8::gemm_phase<EpiStoreBf16, MoeOrder>(lds, g, S, E);
            }
        }
        else if constexpr (SP == 11) {
            const float* g2 = INP(I_LN2G) + l * 1024; const float* b2 = INP(I_LN2B) + l * 1024;
            for (int m = gw; m < M; m += NGW) {
                const int s1 = tok_slot[m * 2], s2i = tok_slot[m * 2 + 1]; const float ga = tok_g[m * 2], gb = tok_g[m * 2 + 1];
                f32x4 v[4]; float s = 0.f; f32x4* xr = (f32x4*)(X + (size_t)m * D) + lane;
#pragma unroll
                for (int j = 0; j < 4; ++j) { v[j] = xr[64 * j] * ALPHA;
                    const u32x2 y1 = ((const u32x2*)(XS + (size_t)s1 * D))[lane + 64 * j], y2 = ((const u32x2*)(XS + (size_t)s2i * D))[lane + 64 * j];
                    v[j][0] += ga * __uint_as_float(y1.x << 16) + gb * __uint_as_float(y2.x << 16); v[j][1] += ga * __uint_as_float(y1.x & 0xffff0000u) + gb * __uint_as_float(y2.x & 0xffff0000u);
                    v[j][2] += ga * __uint_as_float(y1.y << 16) + gb * __uint_as_float(y2.y << 16); v[j][3] += ga * __uint_as_float(y1.y & 0xffff0000u) + gb * __uint_as_float(y2.y & 0xffff0000u);
                    s += (v[j][0] + v[j][1]) + (v[j][2] + v[j][3]); }
                const float mean = wave_sum(s) * (1.f / D); float s2 = 0.f;
#pragma unroll
                for (int j = 0; j < 4; ++j) { v[j] = v[j] - mean; s2 += (v[j][0] * v[j][0] + v[j][1] * v[j][1]) + (v[j][2] * v[j][2] + v[j][3] * v[j][3]); }
                const float rstd = rsqrtf(wave_sum(s2) * (1.f / D) + LN_EPS);
#pragma unroll
                for (int j = 0; j < 4; ++j) { const f32x4 gg = ((const f32x4*)g2)[lane + 64 * j], bb = ((const f32x4*)b2)[lane + 64 * j]; v[j] = v[j] * rstd * gg + bb; xr[64 * j] = v[j];
                    u32x2 w; w.x = pk2(v[j][0], v[j][1]); w.y = pk2(v[j][2], v[j][3]); ((u32x2*)(XB + (size_t)m * D))[lane + 64 * j] = w; }
            }
        }
    }
}

template <int SP>
__global__ void __launch_bounds__(NTHR, 2) k_phase(Args args, int l) {
    extern __shared__ __attribute__((aligned(16))) unsigned char lds_raw[];
    ptr_table_fill(args, (LAS unsigned char*)lds_raw);
    phase_body<SP>(l, (LAS unsigned char*)lds_raw);
}


#define XB_TMO      128
#define XB_XCNT(j)  (256  + 64 * (j))
#define XB_XSUB(j)  (1280 + 64 * (j))
#define XB_XGEN(j)  (2304 + 64 * (j))
#define XB_TOP      3328
#define XB_TOPGEN   3392
#define XCD_BAR_WORDS 3456
#define XB_SPIN_CAP (1u << 22)
__device__ __forceinline__ unsigned xb_ld(unsigned* p)              { return __hip_atomic_load(p, __ATOMIC_RELAXED, __HIP_MEMORY_SCOPE_AGENT); }
__device__ __forceinline__ unsigned xb_add(unsigned* p, unsigned v) { return __hip_atomic_fetch_add(p, v, __ATOMIC_RELAXED, __HIP_MEMORY_SCOPE_AGENT); }
__device__ __forceinline__ unsigned xb_xcc_id() { return (unsigned)__builtin_amdgcn_s_getreg((3 << 11) | 20) & 0xFu; }
#define XB_SPIN(cond, bar) do { unsigned _sp = 0; while (cond) { __builtin_amdgcn_s_sleep(1); \
    if ((++_sp & 255u) == 0u) { if (xb_ld(&(bar)[XB_TMO])) break; if (_sp > XB_SPIN_CAP) { atomicAdd(&(bar)[XB_TMO], 1u); break; } } } } while (0)
__device__ __forceinline__ void xcd_barrier_complete(unsigned* bar, unsigned x, unsigned& nloc, unsigned& nx) {
    const unsigned G = gridDim.x;
    unsigned sum, cnt, mine, sp = 0u;
    for (;;) {
        sum = 0u; cnt = 0u; mine = 0u;
#pragma unroll
        for (unsigned j = 0; j < 16; ++j) { const unsigned c = xb_ld(&bar[XB_XCNT(j)]); sum += c; cnt += (c > 0u) ? 1u : 0u; mine = (j == x) ? c : mine; }
        if (sum == G) break;
        __builtin_amdgcn_s_sleep(1);
        if ((++sp & 255u) == 0u) { if (xb_ld(&bar[XB_TMO])) break; if (sp > XB_SPIN_CAP) { atomicAdd(&bar[XB_TMO], 1u); break; } }
    }
    nloc = mine > 0u ? mine : 1u; nx = cnt > 0u ? cnt : 1u;
}
__device__ __forceinline__ void xcd_barrier(unsigned* bar, LAS unsigned char* lds) {
    asm volatile("s_waitcnt vmcnt(0)" ::: "memory");
    __syncthreads();
    int tid_ = threadIdx.x; asm volatile("" : "+v"(tid_));
    if (tid_ == 0) {
        unsigned so = (unsigned)(LDS_BYTES - 576); asm volatile("" : "+v"(so));
        volatile LAS unsigned* st = (volatile LAS unsigned*)(lds + so);
        __builtin_amdgcn_s_waitcnt(0);
        const unsigned x = xb_xcc_id();
        unsigned nloc = st[0], nx = st[1];
        if (nloc == 0u) { xcd_barrier_complete(bar, x, nloc, nx); st[0] = nloc; st[1] = nx; }
        const unsigned old = xb_add(&bar[XB_XSUB(x)], 1u);
        const unsigned gen = old / nloc;
        if (old + 1u == (gen + 1u) * nloc) {
            __builtin_amdgcn_fence(__ATOMIC_RELEASE, "agent");
            asm volatile("s_waitcnt vmcnt(0)" ::: "memory");
            const unsigned og = xb_add(&bar[XB_TOP], 1u);
            const unsigned tg = og / nx;
            if (og + 1u == (tg + 1u) * nx) xb_add(&bar[XB_TOPGEN], 1u);
            else XB_SPIN(xb_ld(&bar[XB_TOPGEN]) == tg, bar);
            __builtin_amdgcn_fence(__ATOMIC_ACQUIRE, "agent");
            xb_add(&bar[XB_XGEN(x)], 1u);
            asm volatile("s_waitcnt vmcnt(0)" ::: "memory");
        } else {
            XB_SPIN(xb_ld(&bar[XB_XGEN(x)]) == gen, bar);
            __builtin_amdgcn_fence(__ATOMIC_ACQUIRE, "agent");
            asm volatile("s_waitcnt vmcnt(0)" ::: "memory");
        }
    }
    __syncthreads();
}
namespace cg = cooperative_groups;
__global__ void __launch_bounds__(NTHR, 2) fwd_all(Args args) {
    extern __shared__ __attribute__((aligned(16))) unsigned char lds_raw[];
    LAS unsigned char* lds = (LAS unsigned char*)lds_raw;
    unsigned* bar = (unsigned*)(args.ws + WS_CTL) + CW_BAR;
    if (threadIdx.x == 0) { ((volatile LAS unsigned*)(lds + LDS_BYTES - 576))[0] = 0u; ((volatile LAS unsigned*)(lds + LDS_BYTES - 576))[1] = 0u; (void)xb_add(&bar[XB_XCNT(xb_xcc_id())], 1u); }
    ptr_table_fill(args, lds);
    const int probe = args.ph_lo;
    { constexpr int l = 0;
#pragma unroll 1
      for (int r_ = 0; r_ < ((probe == -1) ? 2 : 1); ++r_) { phase_body<-1>(l, lds); __syncthreads(); } }
    cg::this_grid().sync();
#define GRID_BAR() do { unsigned* bar_ = (unsigned*)ldptr(lds, 36) + CW_BAR; xcd_barrier(bar_, lds); } while (0)
#define RUN(SP) do { _Pragma("unroll 1") for (int r_ = 0; r_ < ((probe == (SP)) ? 2 : 1); ++r_) { phase_body<SP>(l, lds); __syncthreads(); } } while (0)
#define ONCE(SP) do { phase_body<SP>(l, lds); __syncthreads(); } while (0)
#define LAYER() \
        RUN(0); GRID_BAR(); \
        ONCE(15); GRID_BAR(); \
        ONCE(12); GRID_BAR(); \
        RUN(13); GRID_BAR(); \
        RUN(4); GRID_BAR(); \
        RUN(5); GRID_BAR(); \
        ONCE(6); GRID_BAR(); \
        ONCE(7); RUN(14); GRID_BAR(); \
        RUN(8); GRID_BAR(); \
        RUN(9); GRID_BAR(); \
        RUN(10); GRID_BAR(); \
        ONCE(11); GRID_BAR();
    { constexpr int l = 0; LAYER() }
    { constexpr int l = 1; LAYER() }
#undef LAYER
#undef RUN
#undef ONCE
#undef GRID_BAR
}

template <int SP> static void launch_phase(const Args& a, int l, int grid, hipStream_t stream) {
    static bool attr = false;
    if (!attr) { (void)hipFuncSetAttribute((const void*)k_phase<SP>, hipFuncAttributeMaxDynamicSharedMemorySize, LDS_BYTES); attr = true; }
    hipLaunchKernelGGL(k_phase<SP>, dim3(grid), dim3(NTHR), LDS_BYTES, stream, a, l);
}

extern "C" void kernel_launch(void* const* d_in, const int* in_sizes, int n_in, void* d_out, int out_size, void* d_ws, size_t ws_size, hipStream_t stream) {
    static int grid = 0;
    if (grid == 0) {
        if (n_in != 35 || out_size != M * D || ws_size < WS_END) { fprintf(stderr, "kernel_launch: unexpected problem (n_in %d out %d ws %zu)\n", n_in, out_size, ws_size); grid = -1; return; }
        int dev = 0, cus = 0, per_cu = 0;
        (void)hipGetDevice(&dev); (void)hipDeviceGetAttribute(&cus, hipDeviceAttributeMultiprocessorCount, dev);
#if N_LAUNCH_MODE == 1
        (void)hipFuncSetAttribute((const void*)fwd_all, hipFuncAttributeMaxDynamicSharedMemorySize, LDS_BYTES);
        if (hipOccupancyMaxActiveBlocksPerMultiprocessor(&per_cu, (const void*)fwd_all, NTHR, LDS_BYTES) != hipSuccess || per_cu < 1) { fprintf(stderr, "kernel_launch: occupancy query says %d blocks/CU\n", per_cu); grid = -1; return; }
#endif
        (void)per_cu;
        grid = cus;
        if (grid != 256) { fprintf(stderr, "kernel_launch: built for 256 CUs, found %d\n", cus); grid = -1; return; }
    }
    if (grid < 0) return;
    (void)hipMemsetAsync((char*)d_ws + WS_CTL, 0, CTL_BYTES, stream);
    Args a{};
    for (int i = 0; i < 35; ++i) a.in[i] = (const float*)d_in[i];
    a.out = (float*)d_out; a.ws = (unsigned char*)d_ws;
#if N_LAUNCH_MODE == 1
    a.ph_lo = PROBE_REPS;
    void* kargs[] = {(void*)&a};
    hipError_t e = hipLaunchCooperativeKernel((const void*)fwd_all, dim3(grid), dim3(NTHR), kargs, LDS_BYTES, stream);
    if (e != hipSuccess) fprintf(stderr, "cooperative launch failed: %s\n", hipGetErrorString(e));
#else
    launch_phase<-1>(a, 0, grid, stream);
    for (int l = 0; l < NL; ++l) {
        launch_phase<0>(a, l, grid, stream); launch_phase<15>(a, l, grid, stream); launch_phase<12>(a, l, grid, stream); launch_phase<13>(a, l, grid, stream);
        launch_phase<4>(a, l, grid, stream); launch_phase<5>(a, l, grid, stream); launch_phase<6>(a, l, grid, stream); launch_phase<7>(a, l, grid, stream); launch_phase<14>(a, l, grid, stream);
        launch_phase<8>(a, l, grid, stream); launch_phase<9>(a, l, grid, stream); launch_phase<10>(a, l, grid, stream); launch_phase<11>(a, l, grid, stream);
    }
#endif
}
```

```cpp
#include <hip/hip_runtime.h>
#include <cstdio>
#include <cstdint>
#include <hip/hip_cooperative_groups.h>

#ifndef PROBE_REPS
#define PROBE_REPS -100
#endif
#ifndef N_LAUNCH_MODE
#define N_LAUNCH_MODE 1
#endif

namespace pg8 {
#define PG8_LAS __attribute__((address_space(3)))
typedef unsigned short bf16_t;
typedef short bf16x8 __attribute__((ext_vector_type(8)));
typedef float f32x4 __attribute__((ext_vector_type(4)));
typedef unsigned u32x4 __attribute__((ext_vector_type(4)));
constexpr int BM = 256, BK = 64, HALF = 128, HTB = HALF * BK * 2, STAGE_BYTES = 8 * HTB, NXCD = 8, WGM = 8;

__host__ __device__ __forceinline__ int lds_byte(int r, int c) { const int st = (r >> 4) * 2 + (c >> 5), rr = r & 15, cc = c & 31, ob = rr * 64 + cc * 2; return st * 1024 + (ob ^ (((ob >> 9) & 1) << 5)); }
__host__ __device__ __forceinline__ void stage_rc(int b, int& R, int& C) { const int st = b / 1024, sb = b % 1024, swz = sb ^ (((sb >> 9) & 1) << 5); R = (st >> 1) * 16 + swz / 64; C = (st & 1) * 32 + (swz % 64) / 2; }
__host__ __device__ __forceinline__ int perm32(int rho) { const int n = rho >> 4, i = rho & 15; return 8 * (i >> 2) + 4 * n + (i & 3); }

struct Unit { int pm, pn, aux; size_t aoff, boff; };
struct Gemm { const bf16_t* A; const bf16_t* Bt; int lda, ldb, K; };

__device__ __forceinline__ void tile_of(int L, int nM, int nN, int& pm, int& pn) {
    const int nwg = nM * nN; int wgid = L;
    { const int q = nwg / NXCD, r = nwg % NXCD, xcd = wgid % NXCD, off = wgid / NXCD; wgid = (xcd < r ? xcd * (q + 1) : r * (q + 1) + (xcd - r) * q) + off; }
    const int nig = WGM * nN, gid = wgid / nig, fm = gid * WGM, gsz = (nM - fm) < WGM ? (nM - fm) : WGM;
    pm = fm + ((wgid % nig) % gsz); pn = (wgid % nig) / gsz;
}
struct StaticOrder {
    int nM, nN, nwg, G, c, lda, ldb;
    __device__ void init(int M, int N, int G_, int c_, int lda_, int ldb_) { nM = M / BM; nN = N / BM; nwg = nM * nN; G = G_; c = c_; lda = lda_; ldb = ldb_; }
    __device__ bool next(int i, Unit& u) const {
        const long L = (long)i * G + c; if (L >= nwg) return false;
        tile_of((int)L, nM, nN, u.pm, u.pn); u.aux = 0;
        u.aoff = (size_t)u.pm * BM * lda * 2; u.boff = (size_t)u.pn * BM * ldb * 2; return true;
    }
};

__device__ __forceinline__ unsigned cvt_pk_bf16(float lo, float hi) { unsigned r; asm volatile("v_cvt_pk_bf16_f32 %0, %1, %2" : "=v"(r) : "v"(lo), "v"(hi)); return r; }

template <class Epi, class Sched, bool ALIGN_EPI = true, bool SP2 = true>
__device__ __forceinline__ void gemm_phase(PG8_LAS unsigned char* lds, const Gemm g, const Sched& S, const Epi& E) {
    int tid_ = threadIdx.x; asm volatile("" : "+v"(tid_));
    const int tid = tid_, wid = __builtin_amdgcn_readfirstlane(tid >> 6), lane = tid & 63, wr = wid >> 2, wc = wid & 3, fr = lane & 15, fq = lane >> 4;
    const int K = g.K, nt = K / BK;
    unsigned voffA[2], voffB[2];
#pragma unroll
    for (int i = 0; i < 2; ++i) { int R, C; stage_rc(tid * 16 + i * 8192, R, C); const int Rb = Epi::PERM ? ((R & ~31) + perm32(R & 31)) : R;
        voffA[i] = (unsigned)(R * g.lda + C) * 2u; voffB[i] = (unsigned)(Rb * g.ldb + C) * 2u; }
    const size_t kstep = (size_t)(BK * 2);
    const size_t hstepA = (size_t)HALF * g.lda * 2, hstepB = (size_t)HALF * g.ldb * 2;
    const unsigned ldsw = (unsigned)wid * 1024u;
    const int aoff = lds_byte(wr * 64 + fr, fq * 8), boff = lds_byte(wc * 32 + fr, fq * 8);
#define PG8_SA(b, h) (((b) * 2 + (h)) * HTB)
#define PG8_SB(b, h) ((4 + (b) * 2 + (h)) * HTB)
#define PG8_STAGE(bufoff, gbase, voff) do { _Pragma("unroll") for (int _i = 0; _i < 2; ++_i) \
        __builtin_amdgcn_global_load_lds((const unsigned*)((const char*)(gbase) + (voff)[_i]), (PG8_LAS unsigned*)(lds + (bufoff) + ldsw + _i * 8192), 16, 0, 0); } while (0)
#define PG8_LDA(dst, b, h) do { _Pragma("unroll") for (int m = 0; m < 4; ++m) _Pragma("unroll") for (int k = 0; k < 2; ++k) dst[m][k] = *(const PG8_LAS bf16x8*)(lds + PG8_SA(b, h) + aoff + m * 2048 + k * 1024); } while (0)
#define PG8_LDB(dst, b, h) do { _Pragma("unroll") for (int n = 0; n < 2; ++n) _Pragma("unroll") for (int k = 0; k < 2; ++k) dst[n][k] = *(const PG8_LAS bf16x8*)(lds + PG8_SB(b, h) + boff + n * 2048 + k * 1024); } while (0)
#define PG8_MMA(ai, bj, At, Bt) do { __builtin_amdgcn_s_setprio(1); _Pragma("unroll") for (int m = 0; m < 4; ++m) _Pragma("unroll") for (int n = 0; n < 2; ++n) _Pragma("unroll") for (int k = 0; k < 2; ++k) \
        acc[ai][bj][m][n] = __builtin_amdgcn_mfma_f32_16x16x32_bf16(Bt[n][k], At[m][k], acc[ai][bj][m][n], 0, 0, 0); __builtin_amdgcn_s_setprio(0); } while (0)
#define PG8_WAIT_V(n) asm volatile("s_waitcnt vmcnt(" #n ")" ::: "memory")
#define PG8_WAIT_L(n) asm volatile("s_waitcnt lgkmcnt(" #n ")" ::: "memory")
#define PG8_BAR __builtin_amdgcn_s_barrier()
#define PG8_SCHED __builtin_amdgcn_sched_barrier(0)
    Unit cur, nxt; int ui = 0;
    if (!S.next(0, cur)) return;
    f32x4 acc[2][2][4][2];
#pragma unroll
    for (int a = 0; a < 2; ++a)
#pragma unroll
        for (int b = 0; b < 2; ++b)
#pragma unroll
            for (int m = 0; m < 4; ++m)
#pragma unroll
                for (int n = 0; n < 2; ++n) acc[a][b][m][n] = (f32x4){0.f, 0.f, 0.f, 0.f};
    bf16x8 At[4][2], B0[2][2], B1[2][2];
    const char* cA = (const char*)g.A + cur.aoff; const char* cB = (const char*)g.Bt + cur.boff;
    if constexpr (SP2) {
        PG8_STAGE(PG8_SB(0, 0), cB, voffB); PG8_STAGE(PG8_SB(0, 1), cB + hstepB, voffB); PG8_STAGE(PG8_SA(0, 0), cA, voffA); PG8_STAGE(PG8_SA(0, 1), cA + hstepA, voffA);
        if (wr == 1) PG8_BAR;
        PG8_WAIT_V(2); PG8_BAR;
        PG8_STAGE(PG8_SB(1, 0), cB + kstep, voffB); PG8_STAGE(PG8_SA(1, 0), cA + kstep, voffA); PG8_STAGE(PG8_SB(1, 1), cB + hstepB + kstep, voffB);
        PG8_WAIT_V(6); PG8_BAR;
    } else {
        PG8_STAGE(PG8_SB(0, 0), cB, voffB); PG8_STAGE(PG8_SA(0, 0), cA, voffA); PG8_STAGE(PG8_SB(0, 1), cB + hstepB, voffB); PG8_STAGE(PG8_SA(0, 1), cA + hstepA, voffA);
        if (wr == 1) PG8_BAR;
        PG8_WAIT_V(4); PG8_BAR;
        PG8_STAGE(PG8_SB(1, 0), cB + kstep, voffB); PG8_STAGE(PG8_SA(1, 0), cA + kstep, voffA); PG8_STAGE(PG8_SB(1, 1), cB + hstepB + kstep, voffB);
        PG8_WAIT_V(6); PG8_BAR;
    }
    for (;;) {
        const bool has_next = S.next(ui + 1, nxt);
        const char* nA = has_next ? (const char*)g.A + nxt.aoff : cA; const char* nB = has_next ? (const char*)g.Bt + nxt.boff : cB;
#pragma unroll 1
        for (int t = 0; t < nt; t += 2) {
            const bool last = (t == nt - 2);
            const char* a1 = cA + (size_t)(t + 1) * kstep;
            const char* a2 = last ? nA : cA + (size_t)(t + 2) * kstep; const char* b2 = last ? nB : cB + (size_t)(t + 2) * kstep;
            const char* a3 = a2 + kstep; const char* b3 = b2 + kstep;
            if constexpr (SP2) {
            PG8_LDB(B0, 0, 0); PG8_LDB(B1, 0, 1); PG8_SCHED; PG8_LDA(At, 0, 0); PG8_STAGE(PG8_SA(1, 1), a1 + hstepA, voffA);
            PG8_WAIT_V(8); PG8_WAIT_L(0); PG8_BAR; PG8_MMA(0, 0, At, B0); PG8_MMA(0, 1, At, B1); PG8_BAR; PG8_SCHED;
            PG8_LDA(At, 0, 1); PG8_STAGE(PG8_SB(0, 0), b2, voffB); PG8_STAGE(PG8_SB(0, 1), b2 + hstepB, voffB); PG8_STAGE(PG8_SA(0, 0), a2, voffA);
            PG8_WAIT_V(8); PG8_WAIT_L(0); PG8_BAR; PG8_MMA(1, 0, At, B0); PG8_MMA(1, 1, At, B1); PG8_BAR; PG8_SCHED;
            PG8_LDB(B0, 1, 0); PG8_LDB(B1, 1, 1); PG8_SCHED; PG8_LDA(At, 1, 0); PG8_STAGE(PG8_SA(0, 1), a2 + hstepA, voffA);
            PG8_WAIT_V(8); PG8_WAIT_L(0); PG8_BAR; PG8_MMA(0, 0, At, B0); PG8_MMA(0, 1, At, B1); PG8_BAR; PG8_SCHED;
            PG8_LDA(At, 1, 1); PG8_STAGE(PG8_SB(1, 0), b3, voffB); PG8_STAGE(PG8_SB(1, 1), b3 + hstepB, voffB); PG8_STAGE(PG8_SA(1, 0), a3, voffA);
            PG8_WAIT_V(8); PG8_WAIT_L(0); PG8_BAR; PG8_MMA(1, 0, At, B0); PG8_MMA(1, 1, At, B1); PG8_BAR; PG8_SCHED;
            } else {
            PG8_LDB(B0, 0, 0); PG8_SCHED; PG8_LDA(At, 0, 0); PG8_STAGE(PG8_SA(1, 1), a1 + hstepA, voffA);
            PG8_WAIT_L(8); PG8_BAR; PG8_WAIT_L(0); PG8_MMA(0, 0, At, B0); PG8_BAR; PG8_SCHED;
            PG8_LDB(B1, 0, 1); PG8_STAGE(PG8_SB(0, 0), b2, voffB);
            PG8_BAR; PG8_WAIT_L(0); PG8_MMA(0, 1, At, B1); PG8_BAR;
            PG8_LDA(At, 0, 1); PG8_STAGE(PG8_SA(0, 0), a2, voffA);
            PG8_BAR; PG8_WAIT_L(0); PG8_MMA(1, 0, At, B0); PG8_BAR; PG8_SCHED;
            PG8_STAGE(PG8_SB(0, 1), b2 + hstepB, voffB);
            PG8_WAIT_V(6); PG8_BAR; PG8_MMA(1, 1, At, B1); PG8_BAR;
            PG8_LDB(B0, 1, 0); PG8_SCHED; PG8_LDA(At, 1, 0); PG8_STAGE(PG8_SA(0, 1), a2 + hstepA, voffA);
            PG8_WAIT_L(8); PG8_BAR; PG8_WAIT_L(0); PG8_MMA(0, 0, At, B0); PG8_BAR; PG8_SCHED;
            PG8_LDB(B1, 1, 1); PG8_STAGE(PG8_SB(1, 0), b3, voffB);
            PG8_BAR; PG8_WAIT_L(0); PG8_MMA(0, 1, At, B1); PG8_BAR;
            PG8_LDA(At, 1, 1); PG8_STAGE(PG8_SA(1, 0), a3, voffA);
            PG8_BAR; PG8_WAIT_L(0); PG8_MMA(1, 0, At, B0); PG8_BAR; PG8_SCHED;
            PG8_STAGE(PG8_SB(1, 1), b3 + hstepB, voffB);
            PG8_WAIT_V(6); PG8_BAR; PG8_MMA(1, 1, At, B1); PG8_BAR;
            }
        }
        if constexpr (ALIGN_EPI) { if (wr == 0) PG8_BAR; }
        E(acc, cur, wr, wc, fr, fq);
        if (!has_next) break;
#pragma unroll
        for (int a = 0; a < 2; ++a)
#pragma unroll
            for (int b = 0; b < 2; ++b)
#pragma unroll
                for (int m = 0; m < 4; ++m)
#pragma unroll
                    for (int n = 0; n < 2; ++n) acc[a][b][m][n] = (f32x4){0.f, 0.f, 0.f, 0.f};
        cur = nxt; cA = nA; cB = nB; ++ui;
        if constexpr (ALIGN_EPI) { if (wr == 1) PG8_BAR; }
    }
    PG8_WAIT_V(0);
    if constexpr (!ALIGN_EPI) { if (wr == 0) PG8_BAR; }
    PG8_BAR;
#undef PG8_SA
#undef PG8_SB
#undef PG8_STAGE
#undef PG8_LDA
#undef PG8_LDB
#undef PG8_MMA
#undef PG8_WAIT_V
#undef PG8_WAIT_L
#undef PG8_BAR
#undef PG8_SCHED
}
}

#define LAS __attribute__((address_space(3)))
typedef unsigned short bf16;
typedef float f32x4 __attribute__((ext_vector_type(4)));
typedef unsigned u32x4 __attribute__((ext_vector_type(4)));
typedef unsigned u32x2 __attribute__((ext_vector_type(2)));

constexpr int NB = 8, T = 4096, D = 1024, M = NB * T, NL = 2;
constexpr int INW = 9160;
constexpr int PP = 5120;
constexpr int C_AQ = 0, C_AK = 768, C_AV = 1536, C_BQ = 2304, C_BK = 2560, C_BV = 2816, C_IQ = 3072, C_IK = 3328, C_C = 3392, C_DZ = 4288, C_DX = 4544, C_IW = 5056, C_DT = 5060, C_END = 5064;
constexpr int NEXP = 32, DEXP = 512;
constexpr int CAP = 73728;
constexpr float LN_EPS = 1e-5f;
constexpr float ALPHA = 1.4142135623730951f;

constexpr size_t MiB = 1u << 20;
constexpr size_t WS_CTL = 0, CTL_BYTES = 1 * MiB;
constexpr size_t WS_WINT = 2 * MiB;
constexpr size_t WS_WGT = 22 * MiB;
constexpr size_t WS_WBRT = 38 * MiB;
constexpr size_t WS_WOUTT = 42 * MiB;
constexpr size_t WS_WRT = 46 * MiB;
constexpr size_t WS_ROUTE = 47 * MiB;
constexpr size_t WS_XB = 48 * MiB;
constexpr size_t WS_O = 112 * MiB;
constexpr size_t WS_VF = 176 * MiB;
constexpr size_t WS_P = 192 * MiB;
constexpr size_t WS_GS = 192 * MiB;
constexpr size_t WS_MERGED = 448 * MiB;
constexpr size_t WS_XS = 192 * MiB;
constexpr size_t WS_H = 336 * MiB;
constexpr size_t WS_WGU = 408 * MiB;
constexpr size_t WS_WD = 472 * MiB;
constexpr size_t WS_RW = 512 * MiB;
constexpr size_t WS_RW2 = 544 * MiB;
constexpr size_t WS_BONG = 46 * MiB + 512 * 1024;
constexpr size_t WS_END = 592 * MiB;
constexpr int CW_CNT = 64, CW_Q = 256, CW_BAR = 4096;

constexpr int RING_BYTES = 131072, MISC_OFF = RING_BYTES, LDS_BYTES = 147456;
constexpr int NWAVES = 8, NTHR = 512;

__device__ __forceinline__ float bf2f(bf16 v) { return __uint_as_float(((unsigned)v) << 16); }
__device__ __forceinline__ unsigned f2bf(float f) { unsigned u = __float_as_uint(f); return (u + 0x7fffu + ((u >> 16) & 1u)) >> 16; }
__device__ __forceinline__ unsigned pk2(float lo, float hi) { return f2bf(lo) | (f2bf(hi) << 16); }
__device__ __forceinline__ float wave_sum(float v) {
#pragma unroll
    for (int o = 1; o < 64; o <<= 1) v += __shfl_xor(v, o);
    return v;
}
__device__ __forceinline__ float wave_max(float v) {
#pragma unroll
    for (int o = 1; o < 64; o <<= 1) v = fmaxf(v, __shfl_xor(v, o));
    return v;
}
__device__ __forceinline__ float sigmoidf_(float x) { return 1.f / (1.f + __expf(-x)); }
__device__ __forceinline__ float softplusf_(float x) { return x > 20.f ? x : log1pf(__expf(x)); }
__device__ __forceinline__ float siluf_(float x) { return x / (1.f + __expf(-x)); }

struct Args { const float* in[35]; float* out; unsigned char* ws; int ph_lo, ph_hi; };
enum { I_X = 0, I_WIN, I_CMU, I_CW0, I_CW2, I_CA0, I_CA2, I_CG2, I_CKK, I_CKA, I_CRK, I_CGNW, I_CGNB, I_CV0, I_CV1, I_CV2, I_DCW, I_DCB, I_DDTB, I_DALOG, I_DSKIP, I_DNW,
       I_WBR, I_WOUT, I_LN1G, I_LN1B, I_RG, I_RGB, I_RE, I_REB, I_EG, I_EU, I_ED, I_LN2G, I_LN2B };

__device__ __forceinline__ void transpose_item(const float* W, int ldn, int c0, int ncols, bf16* dst, int dld, int r0, int dk0, int kb, int nb, LAS float* scr, int lane) {
    const int k0 = 64 * kb, n0 = 32 * nb;
    const bool okn = (n0 + (lane & 31)) < ncols;
    float tv[32];
#pragma unroll
    for (int i = 0; i < 32; ++i) { const int kk = 2 * i + (lane >> 5); tv[i] = okn ? W[(size_t)(k0 + kk) * ldn + c0 + n0 + (lane & 31)] : 0.f; }
#pragma unroll
    for (int i = 0; i < 32; ++i) { const int kk = 2 * i + (lane >> 5); scr[kk * 33 + (lane & 31)] = tv[i]; }
    asm volatile("s_waitcnt lgkmcnt(0)" ::: "memory");
    const int c = lane & 7;
#pragma unroll
    for (int j = 0; j < 4; ++j) { const int n = (lane >> 3) + 8 * j; const LAS float* s = scr + (8 * c) * 33 + n;
        u32x4 o; o.x = pk2(s[0 * 33], s[1 * 33]); o.y = pk2(s[2 * 33], s[3 * 33]); o.z = pk2(s[4 * 33], s[5 * 33]); o.w = pk2(s[6 * 33], s[7 * 33]);
        if (n0 + n < ncols) *(u32x4*)(dst + (size_t)(r0 + n0 + n) * dld + dk0 + k0 + 8 * c) = o; }
    asm volatile("s_waitcnt lgkmcnt(0)" ::: "memory");
}

struct EpiStoreBf16 {
    static constexpr bool PERM = true;
    bf16* O; int ldc; int act; int ncols;
    __device__ __forceinline__ void operator()(const pg8::f32x4 (&acc)[2][2][4][2], const pg8::Unit& u, int wr, int wc, int fr, int fq) const {
        const int row0 = u.pm * 256 + wr * 64 + fr; const int col0 = u.pn * 256 + wc * 32 + 8 * fq;
#pragma unroll
        for (int ai = 0; ai < 2; ++ai)
#pragma unroll
            for (int m = 0; m < 4; ++m) { bf16* rowp = O + (size_t)(row0 + ai * 128 + m * 16) * ldc + col0;
#pragma unroll
                for (int bj = 0; bj < 2; ++bj) { pg8::f32x4 v0 = acc[ai][bj][m][0], v1 = acc[ai][bj][m][1];
                    if (act == 1) {
#pragma unroll
                        for (int j = 0; j < 4; ++j) { v0[j] = sigmoidf_(v0[j]); v1[j] = sigmoidf_(v1[j]); } }
                    u32x4 w; w.x = pg8::cvt_pk_bf16(v0[0], v0[1]); w.y = pg8::cvt_pk_bf16(v0[2], v0[3]); w.z = pg8::cvt_pk_bf16(v1[0], v1[1]); w.w = pg8::cvt_pk_bf16(v1[2], v1[3]);
                    if (col0 + bj * 128 < ncols) *(u32x4*)(rowp + bj * 128) = w; } }
    }
};
struct EpiBranch {
    static constexpr bool PERM = true;
    const bf16* GS; bf16* MG;
    __device__ __forceinline__ void operator()(const pg8::f32x4 (&acc)[2][2][4][2], const pg8::Unit& u, int wr, int wc, int fr, int fq) const {
        const int n = u.aux;
        const bf16* gbase = GS + (size_t)(u.pm * 256 + wr * 64 + fr) * 4096 + n * 1024 + u.pn * 256 + wc * 32 + 8 * fq;
        bf16* mbase = MG + (size_t)(u.pm * 256 + wr * 64 + fr) * 1024 + u.pn * 256 + wc * 32 + 8 * fq;
#pragma unroll
        for (int ai = 0; ai < 2; ++ai)
#pragma unroll
            for (int m = 0; m < 4; ++m) {
#pragma unroll
                for (int bj = 0; bj < 2; ++bj) {
                    const u32x4 gv = *(const u32x4*)(gbase + (size_t)(ai * 128 + m * 16) * 4096 + bj * 128);
                    bf16* mp = mbase + (size_t)(ai * 128 + m * 16) * 1024 + bj * 128;
                    u32x4 ov = (u32x4){0u, 0u, 0u, 0u}; if (n != 0) ov = *(const u32x4*)mp;
                    const pg8::f32x4 a0 = acc[ai][bj][m][0], a1 = acc[ai][bj][m][1];
                    u32x4 w;
                    w.x = pg8::cvt_pk_bf16(a0[0] * __uint_as_float(gv.x << 16) + __uint_as_float(ov.x << 16), a0[1] * __uint_as_float(gv.x & 0xffff0000u) + __uint_as_float(ov.x & 0xffff0000u));
                    w.y = pg8::cvt_pk_bf16(a0[2] * __uint_as_float(gv.y << 16) + __uint_as_float(ov.y << 16), a0[3] * __uint_as_float(gv.y & 0xffff0000u) + __uint_as_float(ov.y & 0xffff0000u));
                    w.z = pg8::cvt_pk_bf16(a1[0] * __uint_as_float(gv.z << 16) + __uint_as_float(ov.z << 16), a1[1] * __uint_as_float(gv.z & 0xffff0000u) + __uint_as_float(ov.z & 0xffff0000u));
                    w.w = pg8::cvt_pk_bf16(a1[2] * __uint_as_float(gv.w << 16) + __uint_as_float(ov.w << 16), a1[3] * __uint_as_float(gv.w & 0xffff0000u) + __uint_as_float(ov.w & 0xffff0000u));
                    *(u32x4*)mp = w; asm volatile("" ::: "memory"); } }
    }
};
struct EpiResid {
    static constexpr bool PERM = false;
    float* X;
    __device__ __forceinline__ void operator()(const pg8::f32x4 (&acc)[2][2][4][2], const pg8::Unit& u, int wr, int wc, int fr, int fq) const {
        const int row0 = u.pm * 256 + wr * 64 + fr, col0 = u.pn * 256 + wc * 32 + 4 * fq;
#pragma unroll
        for (int ai = 0; ai < 2; ++ai)
#pragma unroll
            for (int m = 0; m < 4; ++m) { float* rowp = X + (size_t)(row0 + ai * 128 + m * 16) * D + col0;
#pragma unroll
                for (int bj = 0; bj < 2; ++bj)
#pragma unroll
                    for (int n = 0; n < 2; ++n) { pg8::f32x4* p = (pg8::f32x4*)(rowp + bj * 128 + n * 16); *p = *p * ALPHA + acc[ai][bj][m][n]; } }
    }
};
struct EpiSwiglu {
    static constexpr bool PERM = true;
    bf16* H;
    __device__ __forceinline__ void operator()(const pg8::f32x4 (&acc)[2][2][4][2], const pg8::Unit& u, int wr, int wc, int fr, int fq) const {
        const int row0 = u.pm * 256 + wr * 64 + fr; const int col0 = u.pn * 128 + wc * 32 + 8 * fq;
#pragma unroll
        for (int ai = 0; ai < 2; ++ai)
#pragma unroll
            for (int m = 0; m < 4; ++m) { bf16* rowp = H + (size_t)(row0 + ai * 128 + m * 16) * DEXP + col0;
                float v[8];
#pragma unroll
                for (int j = 0; j < 4; ++j) { v[j] = siluf_(acc[ai][0][m][0][j]) * acc[ai][1][m][0][j]; v[4 + j] = siluf_(acc[ai][0][m][1][j]) * acc[ai][1][m][1][j]; }
                u32x4 w; w.x = pg8::cvt_pk_bf16(v[0], v[1]); w.y = pg8::cvt_pk_bf16(v[2], v[3]); w.z = pg8::cvt_pk_bf16(v[4], v[5]); w.w = pg8::cvt_pk_bf16(v[6], v[7]);
                *(u32x4*)rowp = w; }
    }
};

struct BranchOrder {
    int nM, nN, G, c;
    __device__ bool next(int i, pg8::Unit& u) const {
        const int tl = (i >> 2) * G + c; if (tl >= nM * nN) return false;
        pg8::tile_of(tl, nM, nN, u.pm, u.pn); u.aux = i & 3;
        u.aoff = ((size_t)u.pm * 256 * 1024 + (size_t)u.aux * 256) * 2; u.boff = ((size_t)u.pn * 256 * 1024 + (size_t)u.aux * 256) * 2; return true;
    }
};
struct MoeOrder {
    const volatile LAS int* tb; int G, c; size_t a_rowbytes, b_expbytes, b_tilebytes;
    __device__ bool next(int i, pg8::Unit& u) const {
        const int L = i * G + c; const int total = __builtin_amdgcn_readfirstlane(tb[32]) * 4; if (L >= total) return false;
        int e = 0;
#pragma unroll 1
        for (int k = 0; k < 32; ++k) if (L >= tb[k + 1] * 4) e = k + 1;
        const int nte = tb[e + 1] - tb[e]; const int r = L - tb[e] * 4; const int ct = r / nte, rt = r % nte;
        u.pm = __builtin_amdgcn_readfirstlane(tb[33 + e] + rt); u.pn = __builtin_amdgcn_readfirstlane(ct); u.aux = __builtin_amdgcn_readfirstlane(e);
        u.aoff = (size_t)u.pm * 256 * a_rowbytes; u.boff = (size_t)u.aux * b_expbytes + (size_t)u.pn * b_tilebytes; return true;
    }
};

constexpr int PTR_OFF = LDS_BYTES - 512;
__device__ __forceinline__ void ptr_table_fill(const Args& args, LAS unsigned char* lds) {
    if (threadIdx.x == 0) {
        volatile LAS unsigned long long* t = (volatile LAS unsigned long long*)(lds + PTR_OFF);
#define PT_(i) t[i] = (unsigned long long)args.in[i];
        PT_(0) PT_(1) PT_(2) PT_(3) PT_(4) PT_(5) PT_(6) PT_(7) PT_(8) PT_(9) PT_(10) PT_(11) PT_(12) PT_(13) PT_(14) PT_(15) PT_(16) PT_(17) PT_(18) PT_(19)
        PT_(20) PT_(21) PT_(22) PT_(23) PT_(24) PT_(25) PT_(26) PT_(27) PT_(28) PT_(29) PT_(30) PT_(31) PT_(32) PT_(33) PT_(34)
#undef PT_
        t[35] = (unsigned long long)args.out; t[36] = (unsigned long long)args.ws; t[37] = (unsigned long long)(unsigned)args.ph_lo;
    }
    __syncthreads();
}
__device__ __forceinline__ unsigned long long ldptr(LAS unsigned char* lds, int i) {
    unsigned a = (unsigned)(PTR_OFF + 8 * i); asm volatile("" : "+v"(a));
    const volatile LAS unsigned* t = (const volatile LAS unsigned*)(lds + a);
    const unsigned lo = __builtin_amdgcn_readfirstlane(t[0]), hi = __builtin_amdgcn_readfirstlane(t[1]);
    return ((unsigned long long)hi << 32) | lo;
}
__device__ __forceinline__ void* gptr(unsigned long long v) { return (void*)(__attribute__((address_space(1))) void*)v; }
#define INP(i) ((const float*)gptr(ldptr(lds, (i))))
namespace rw {
typedef short bf16x8 __attribute__((ext_vector_type(8)));
typedef float f4 __attribute__((ext_vector_type(4)));
constexpr int LS = 72;
constexpr int MB = 64 * LS * 2;
constexpr int O_AHN = 0, O_RHN = MB, O_BCN = 2 * MB, O_KCN = 3 * MB, O_AHT = 4 * MB, O_BTT = 5 * MB, O_KTT = 6 * MB, O_VT = 7 * MB, O_STT = 8 * MB,
              O_MAK = 9 * MB, O_MRB = 10 * MB, O_MRK = 11 * MB, O_TINV = 12 * MB, O_MABF = 13 * MB, O_GAM = 13 * MB + 16384, O_CT = O_GAM + 256, O_BON = O_CT + 4608, O_END = O_BON + 256;
constexpr int O_MVT = O_BCN, O_A2N = O_AHN, O_UT = O_KCN, O_YF = O_AHT;
constexpr int O_TAB = O_MAK, O_SCR = O_TAB + 26624, O_TOT = O_SCR + 8 * 1024, O_CUM = O_TOT + 2048;
static_assert(O_CUM + 16384 <= O_GAM && O_END <= LDS_BYTES - 576, "rwkv LDS map");

__device__ __forceinline__ bf16x8 ldfrag(const LAS unsigned char* lds, int off, int r0, int ks, int lane) {
    return *(const LAS bf16x8*)(lds + off + ((r0 + (lane & 15)) * LS + ks * 32 + (lane >> 4) * 8) * 2);
}
__device__ __forceinline__ void mm64(f4 (&acc)[2], const LAS unsigned char* lds, int offA, int offBt, int w, int lane) {
    const int tr = w >> 1; const bf16x8 a0 = ldfrag(lds, offA, tr * 16, 0, lane), a1 = ldfrag(lds, offA, tr * 16, 1, lane);
#pragma unroll
    for (int c = 0; c < 2; ++c) { const int tc = (w & 1) * 2 + c; const bf16x8 b0 = ldfrag(lds, offBt, tc * 16, 0, lane), b1 = ldfrag(lds, offBt, tc * 16, 1, lane);
        acc[c] = __builtin_amdgcn_mfma_f32_16x16x32_bf16(a0, b0, acc[c], 0, 0, 0); acc[c] = __builtin_amdgcn_mfma_f32_16x16x32_bf16(a1, b1, acc[c], 0, 0, 0); }
}
__device__ __forceinline__ void storeT(LAS unsigned char* lds, int off, const f4 (&acc)[2], int w, int lane) {
#pragma unroll
    for (int c = 0; c < 2; ++c) { const int col = ((w & 1) * 2 + c) * 16 + (lane & 15), row = (w >> 1) * 16 + 4 * (lane >> 4);
        u32x2 v; v.x = pk2(acc[c][0], acc[c][1]); v.y = pk2(acc[c][2], acc[c][3]); *(LAS u32x2*)(lds + off + (col * LS + row) * 2) = v; }
}
template <int MASK  >
__device__ __forceinline__ void storeN(LAS unsigned char* lds, int off, const f4 (&acc)[2], int w, int lane) {
#pragma unroll
    for (int c = 0; c < 2; ++c) { const int col = ((w & 1) * 2 + c) * 16 + (lane & 15), row = (w >> 1) * 16 + 4 * (lane >> 4);
#pragma unroll
        for (int e = 0; e < 4; ++e) { float x = acc[c][e]; if (MASK == 1) x = (col < row + e) ? x : 0.f; if (MASK == 2) x = (col <= row + e) ? x : 0.f;
            *(LAS bf16*)(lds + off + ((row + e) * LS + col) * 2) = (bf16)f2bf(x); } }
}
typedef __bf16 bf2v __attribute__((ext_vector_type(2)));
__device__ __forceinline__ float dot2(unsigned x, unsigned y, float c) { return __builtin_amdgcn_fdot2_f32_bf16(__builtin_bit_cast(bf2v, x), __builtin_bit_cast(bf2v, y), c, false); }
#define RW_ZERO(a) do { a[0] = (f4){0.f, 0.f, 0.f, 0.f}; a[1] = (f4){0.f, 0.f, 0.f, 0.f}; } while (0)

__device__ __forceinline__ void build_ct(LAS unsigned char* lds0, const int l, const int h, const int lane, const int wave) {
    LAS unsigned char* const& lds = lds0; const int c = h * 64 + lane;
    const float* mu = INP(I_CMU) + (size_t)l * 896;
    if (wave == 0) { LAS float* ct = (LAS float*)(lds0 + O_CT);
        ct[0 * 64 + lane] = mu[c]; ct[1 * 64 + lane] = mu[256 + c]; ct[2 * 64 + lane] = mu[512 + c]; ct[3 * 64 + lane] = mu[768 + lane]; ct[4 * 64 + lane] = mu[832 + lane];
        ct[5 * 64 + lane] = INP(I_CW0)[l * 256 + c]; ct[6 * 64 + lane] = INP(I_CA0)[l * 256 + c]; ct[7 * 64 + lane] = INP(I_CKK)[l * 256 + c]; ct[8 * 64 + lane] = INP(I_CKA)[l * 256 + c];
        ct[9 * 64 + lane] = INP(I_CRK)[l * 256 + c]; ct[10 * 64 + lane] = INP(I_CGNW)[l * 256 + c]; ct[11 * 64 + lane] = INP(I_CGNB)[l * 256 + c]; ct[12 * 64 + lane] = l > 0 ? INP(I_CV0)[(l - 1) * 256 + c] : 0.f;
        ct[13 * 64 + lane] = mu[512 + lane]; ct[14 * 64 + lane] = mu[512 + lane + 64]; ct[15 * 64 + lane] = mu[512 + lane + 128]; ct[16 * 64 + lane] = mu[512 + lane + 192]; }
}
template <int MODE>
__device__ __forceinline__ void chunk(LAS unsigned char* lds0, const int l, const int b, const int h, const int t0, unsigned char* gz, unsigned char* gz2, float* bong, const bf16* P, bf16* VF, bf16* OB, const int tid0) {
    const int c = h * 64 + (tid0 & 63);
    {
        unsigned lb_ = 0u; int tid_l = tid0; asm volatile("" : "+v"(lb_), "+v"(tid_l));
        const int tid = tid_l, lane = tid & 63, wave = __builtin_amdgcn_readfirstlane(tid >> 6);
        LAS unsigned char* lds = lds0 + lb_;
        LAS bf16* TAB = (LAS bf16*)(lds + O_TAB); const LAS unsigned* TABW = (const LAS unsigned*)(lds + O_TAB);
        LAS bf16* scr = (LAS bf16*)(lds + O_SCR + wave * 1024);
        LAS float* CUM = (LAS float*)(lds + O_CUM);
        LAS float* TOT = (LAS float*)(lds + O_TOT);
        LAS float* GAM = (LAS float*)(lds + O_GAM);
        LAS float* MABF = (LAS float*)(lds + O_MABF);
        LAS float* YF = (LAS float*)(lds + O_YF);
        LAS float* BON = (LAS float*)(lds + O_BON);
        const LAS float* CT = (const LAS float*)(lds + O_CT);
#define CTV(k) CT[(k) * 64 + lane]
        { const float* cw2 = INP(I_CW2) + (size_t)l * 32 * 256; const float* ca2 = INP(I_CA2) + (size_t)l * 32 * 256; const float* cg2 = INP(I_CG2) + (size_t)l * 64 * 256;
          float tw[4], ta[4], tg[8];
#pragma unroll
          for (int u = 0; u < 4; ++u) { const int i = tid + u * NTHR; tw[u] = cw2[(i >> 6) * 256 + h * 64 + (i & 63)]; ta[u] = ca2[(i >> 6) * 256 + h * 64 + (i & 63)]; }
#pragma unroll
          for (int u = 0; u < 8; ++u) { const int i = tid + u * NTHR; tg[u] = cg2[(i >> 6) * 256 + h * 64 + (i & 63)]; }
          float t2[2], t1[8];
          if (l > 0) { const float* cv1 = INP(I_CV1) + (size_t)(l - 1) * 256 * 16; const float* cv2 = INP(I_CV2) + (size_t)(l - 1) * 16 * 256;
#pragma unroll
            for (int u = 0; u < 2; ++u) { const int i = tid + u * NTHR; t2[u] = cv2[(i >> 6) * 256 + h * 64 + (i & 63)]; }
#pragma unroll
            for (int u = 0; u < 8; ++u) t1[u] = cv1[tid + u * NTHR]; }
#define PIX(i) ((((i) >> 7) * 64 + ((i) & 63)) * 2 + (((i) >> 6) & 1))
#pragma unroll
          for (int u = 0; u < 4; ++u) { const int i = tid + u * NTHR; TAB[PIX(i)] = (bf16)f2bf(tw[u]); TAB[2048 + PIX(i)] = (bf16)f2bf(ta[u]); }
#pragma unroll
          for (int u = 0; u < 8; ++u) { const int i = tid + u * NTHR; TAB[4096 + PIX(i)] = (bf16)f2bf(tg[u]); }
          if (l > 0) {
#pragma unroll
            for (int u = 0; u < 2; ++u) { const int i = tid + u * NTHR; TAB[8192 + PIX(i)] = (bf16)f2bf(t2[u]); }
#pragma unroll
            for (int u = 0; u < 8; ++u) { const int i = tid + u * NTHR; const int cc = i >> 4, qq = i & 15; TAB[9216 + ((cc >> 1) * 16 + qq) * 2 + (cc & 1)] = (bf16)f2bf(t1[u]); } } }
#undef PIX
        float Xr[9];
#pragma unroll
        for (int j = 0; j < 9; ++j) { const int t = t0 + wave * 8 - 1 + j; Xr[j] = t >= 0 ? bf2f(P[((size_t)b * T + t) * PP + C_C + 768 + lane]) : 0.f; }
        __syncthreads();
        { float run = 0.f;
#pragma unroll
            for (int q = 0; q < 8; ++q) {
                const float xx = Xr[q + 1] + (Xr[q] - Xr[q + 1]) * CTV(3);
                scr[lane] = (bf16)f2bf(tanhf(xx));
                asm volatile("s_waitcnt lgkmcnt(0)" ::: "memory");
                float wsum = CTV(5); { float w1 = 0.f; const LAS unsigned* sw = (const LAS unsigned*)scr;
#pragma unroll
                for (int p = 0; p < 16; p += 2) { wsum = dot2(sw[p], TABW[p * 64 + lane], wsum); w1 = dot2(sw[p + 1], TABW[(p + 1) * 64 + lane], w1); }
                wsum += w1; }
                run += -__expf(-softplusf_(-wsum) - 0.5f); CUM[(wave * 8 + q) * 64 + lane] = run;
                asm volatile("s_waitcnt lgkmcnt(0)" ::: "memory");
            }
            TOT[wave * 64 + lane] = run; }
        __syncthreads();
        float offs = 0.f, cumL = 0.f;
#pragma unroll
        for (int w2 = 0; w2 < 8; ++w2) { const float tw = TOT[w2 * 64 + lane]; offs += (w2 < wave) ? tw : 0.f; cumL += tw; }
        if (wave == 0) GAM[lane] = __expf(cumL);
#define LO_(x) __uint_as_float((x) << 16)
#define HI_(x) __uint_as_float((x) & 0xffff0000u)
#define RAW_LOAD(rk, vx, gg, v4a, v4b, vfv, tok) do { const int t_ = (tok); const bool ok_ = t_ >= 0; const size_t m_ = (size_t)b * T + (ok_ ? t_ : 0); const bf16* row_ = P + m_ * PP + C_C; \
            rk = ok_ ? ((unsigned)row_[c] | ((unsigned)row_[256 + c] << 16)) : 0u; vx = ok_ ? ((unsigned)row_[512 + c] | ((unsigned)row_[768 + lane] << 16)) : 0u; gg = ok_ ? (unsigned)row_[832 + lane] : 0u; \
            if (l > 0) { v4a = ok_ ? ((unsigned)row_[512 + lane] | ((unsigned)row_[512 + lane + 64] << 16)) : 0u; v4b = ok_ ? ((unsigned)row_[512 + lane + 128] | ((unsigned)row_[512 + lane + 192] << 16)) : 0u; vfv = (unsigned)VF[m_ * 256 + c]; } } while (0)
        unsigned pRK, pVX, pGG, pVa = 0u, pVb = 0u, pVF = 0u, cRK, cVX, cGG, cVa = 0u, cVb = 0u, cVF = 0u;
        RAW_LOAD(pRK, pVX, pGG, pVa, pVb, pVF, t0 + wave * 8 - 1); RAW_LOAD(cRK, cVX, cGG, cVa, cVb, cVF, t0 + wave * 8);
#pragma unroll 1
        for (int q = 0; q < 8; ++q) {
            const int tt = wave * 8 + q; const size_t m = (size_t)b * T + t0 + tt;
            unsigned nRK, nVX, nGG, nVa = 0u, nVb = 0u, nVF = 0u;
            RAW_LOAD(nRK, nVX, nGG, nVa, nVb, nVF, (q < 7) ? (t0 + tt + 1) : (t0 + tt));
            const float r = LO_(cRK) + (LO_(pRK) - LO_(cRK)) * CTV(0), k = HI_(cRK) + (HI_(pRK) - HI_(cRK)) * CTV(1); float v = LO_(cVX) + (LO_(pVX) - LO_(cVX)) * CTV(2);
            const float xx = HI_(cVX) + (HI_(pVX) - HI_(cVX)) * CTV(3), xg = LO_(cGG) + (LO_(pGG) - LO_(cGG)) * CTV(4);
            scr[lane] = (bf16)f2bf(lane < 32 ? tanhf(xx) : xx); scr[64 + lane] = (bf16)f2bf(sigmoidf_(xg));
            LAS bf16* vsc = scr + 128;
            if (l > 0) {
                vsc[lane] = (bf16)f2bf(LO_(cVa) + (LO_(pVa) - LO_(cVa)) * CTV(13)); vsc[lane + 64] = (bf16)f2bf(HI_(cVa) + (HI_(pVa) - HI_(cVa)) * CTV(14));
                vsc[lane + 128] = (bf16)f2bf(LO_(cVb) + (LO_(pVb) - LO_(cVb)) * CTV(15)); vsc[lane + 192] = (bf16)f2bf(HI_(cVb) + (HI_(pVb) - HI_(cVb)) * CTV(16));
            }
            asm volatile("s_waitcnt lgkmcnt(0)" ::: "memory");
            float wsum = CTV(5), asum = CTV(6), gsum = 0.f; { float w1 = 0.f, a1 = 0.f, g1 = 0.f; const LAS unsigned* sw = (const LAS unsigned*)scr;
#pragma unroll
            for (int p = 0; p < 16; p += 2) { wsum = dot2(sw[p], TABW[p * 64 + lane], wsum); w1 = dot2(sw[p + 1], TABW[(p + 1) * 64 + lane], w1);
                asum = dot2(sw[16 + p], TABW[1024 + p * 64 + lane], asum); a1 = dot2(sw[17 + p], TABW[1024 + (p + 1) * 64 + lane], a1); }
#pragma unroll
            for (int p = 0; p < 32; p += 2) { gsum = dot2(sw[32 + p], TABW[2048 + p * 64 + lane], gsum); g1 = dot2(sw[33 + p], TABW[2048 + (p + 1) * 64 + lane], g1); }
            wsum += w1; asum += a1; gsum += g1; }
            if (l > 0) {
                const int qq = lane & 15, part = lane >> 4; float s = 0.f; { float s1 = 0.f; const LAS unsigned* sv = (const LAS unsigned*)vsc;
#pragma unroll
                for (int p = 0; p < 32; p += 2) { s = dot2(sv[part * 32 + p], TABW[4608 + (part * 32 + p) * 16 + qq], s); s1 = dot2(sv[part * 32 + p + 1], TABW[4608 + (part * 32 + p + 1) * 16 + qq], s1); }
                s += s1; }
                s += __shfl_xor(s, 16); s += __shfl_xor(s, 32);
                float vl = CTV(12);
#pragma unroll
                for (int q2 = 0; q2 < 16; ++q2) vl += __shfl(s, q2) * bf2f(TAB[8192 + ((q2 >> 1) * 64 + lane) * 2 + (q2 & 1)]);
                const float vf = LO_(cVF); v = v + (vf - v) * sigmoidf_(vl);
            }
            VF[m * 256 + c] = (bf16)f2bf(v);
            const float wlog = -softplusf_(-wsum) - 0.5f, asig = sigmoidf_(asum), lw = -__expf(wlog);
            float kk = k * CTV(7); const float n2 = wave_sum(kk * kk); kk = kk / fmaxf(sqrtf(n2), 1e-12f);
            const float kmod = k * (1.f + (asig - 1.f) * CTV(8));
            const float bon = wave_sum(r * kmod * CTV(9));
            const float cum = offs + CUM[tt * 64 + lane], cumx = cum - lw;
            const float ah = -kk * __expf(cumx), rh = r * __expf(cum), ei = __expf(-cum), bb = kk * asig, bc = bb * ei, kc = kmod * ei, ee = __expf(cumL - cum), bt = bb * ee, kt = kmod * ee;
            const int no = (tt * LS + lane) * 2, to = (lane * LS + tt) * 2;
            *(LAS bf16*)(lds + O_AHN + no) = (bf16)f2bf(ah); *(LAS bf16*)(lds + O_RHN + no) = (bf16)f2bf(rh);
            *(LAS bf16*)(lds + O_BCN + no) = (bf16)f2bf(bc); *(LAS bf16*)(lds + O_KCN + no) = (bf16)f2bf(kc); ((bf16*)(gz2 + 16384))[tt * 64 + lane] = (bf16)f2bf(gsum);
            *(LAS bf16*)(lds + O_AHT + to) = (bf16)f2bf(ah); *(LAS bf16*)(lds + O_BTT + to) = (bf16)f2bf(bt);
            *(LAS bf16*)(lds + O_KTT + to) = (bf16)f2bf(kt); *(LAS bf16*)(lds + O_VT + to) = (bf16)f2bf(v);
            if (lane == 0) bong[tt] = bon;
            asm volatile("s_waitcnt lgkmcnt(0)" ::: "memory");
            pRK = cRK; pVX = cVX; pGG = cGG; pVa = cVa; pVb = cVb; cRK = nRK; cVX = nVX; cGG = nGG; cVa = nVa; cVb = nVb; cVF = nVF;
        }
#undef RAW_LOAD
        __syncthreads();
        { f4 acc[2];
            RW_ZERO(acc); mm64(acc, lds, O_AHN, O_BCN, wave, lane);
#pragma unroll
            for (int cI = 0; cI < 2; ++cI) { const int col = ((wave & 1) * 2 + cI) * 16 + (lane & 15), row = (wave >> 1) * 16 + 4 * (lane >> 4);
#pragma unroll
                for (int e = 0; e < 4; ++e) MABF[(row + e) * 64 + col] = (col < row + e) ? acc[cI][e] : 0.f; }
            RW_ZERO(acc); mm64(acc, lds, O_AHN, O_KCN, wave, lane); storeN<1>(lds, O_MAK, acc, wave, lane);
            { f4 accb[2]; RW_ZERO(accb); mm64(accb, lds, O_RHN, O_BCN, wave, lane); f4 accc[2]; RW_ZERO(accc); mm64(accc, lds, O_RHN, O_KCN, wave, lane);
                storeN<2>(lds, O_MRB, accb, wave, lane); storeN<2>(lds, O_MRK, accc, wave, lane); }
        }
        __syncthreads();
        if (wave == 0) {
            float x[64]; x[0] = 0.f;
#pragma unroll
            for (int i = 1; i < 64; ++i) { float s4[4] = {MABF[i * 64 + lane], 0.f, 0.f, 0.f};
#pragma unroll
                for (int j4 = 0; j4 < (i + 3) / 4; ++j4) { const f4 m4 = *(const LAS f4*)(MABF + i * 64 + j4 * 4);
#pragma unroll
                    for (int e = 0; e < 4; ++e) if (j4 * 4 + e < i && j4 * 4 + e >= 1) s4[e] += m4[e] * x[j4 * 4 + e]; }
                x[i] = (s4[0] + s4[1]) + (s4[2] + s4[3]); }
#pragma unroll
            for (int i = 0; i < 64; ++i) *(LAS bf16*)(lds + O_TINV + (i * LS + lane) * 2) = (bf16)f2bf(x[i]);
            asm volatile("s_waitcnt lgkmcnt(0)" ::: "memory");
            *(LAS bf16*)(lds + O_TINV + (lane * LS + lane) * 2) = (bf16)0x3F80;
        }
        __syncthreads();
        { f4 acc[2]; RW_ZERO(acc); mm64(acc, lds, O_MAK, O_VT, wave, lane); storeT(lds, O_MVT, acc, wave, lane); }
        __syncthreads();
        if (MODE == 1) {
            { f4 acc[2]; RW_ZERO(acc); mm64(acc, lds, O_TINV, O_AHT, wave, lane); storeT(lds, O_UT, acc, wave, lane); }
            { f4 acc[2]; RW_ZERO(acc); mm64(acc, lds, O_TINV, O_MVT, wave, lane); storeT(lds, O_MAK, acc, wave, lane); }
            __syncthreads();
            f4 agm[2], azm[2], ar2[2], ay0[2];
            RW_ZERO(agm); mm64(agm, lds, O_BTT, O_UT, wave, lane);
#pragma unroll
            for (int cI = 0; cI < 2; ++cI) { const int col = ((wave & 1) * 2 + cI) * 16 + (lane & 15), row = (wave >> 1) * 16 + 4 * (lane >> 4);
#pragma unroll
                for (int e = 0; e < 4; ++e) if (col == row + e) agm[cI][e] += GAM[col]; }
            RW_ZERO(azm); mm64(azm, lds, O_BTT, O_MAK, wave, lane); mm64(azm, lds, O_KTT, O_VT, wave, lane);
            RW_ZERO(ar2); mm64(ar2, lds, O_MRB, O_UT, wave, lane);
#pragma unroll
            for (int cI = 0; cI < 2; ++cI) { const int col = ((wave & 1) * 2 + cI) * 16 + (lane & 15), row = (wave >> 1) * 16 + 4 * (lane >> 4);
#pragma unroll
                for (int e = 0; e < 4; ++e) ar2[cI][e] += bf2f(*(const LAS bf16*)(lds + O_RHN + ((row + e) * LS + col) * 2)); }
            RW_ZERO(ay0); mm64(ay0, lds, O_MRB, O_MAK, wave, lane); mm64(ay0, lds, O_MRK, O_VT, wave, lane);
            __syncthreads();
            storeN<0>(lds, O_AHN, agm, wave, lane); storeT(lds, O_RHN, azm, wave, lane); storeN<0>(lds, O_BCN, ar2, wave, lane); storeT(lds, O_KCN, ay0, wave, lane);
            __syncthreads();
            { const int io = ((tid >> 3) * LS + (tid & 7) * 8) * 2;
              ((u32x4*)gz)[tid] = *(const LAS u32x4*)(lds + O_AHN + io); ((u32x4*)(gz + 8192))[tid] = *(const LAS u32x4*)(lds + O_RHN + io);
              ((u32x4*)gz2)[tid] = *(const LAS u32x4*)(lds + O_BCN + io); ((u32x4*)(gz2 + 8192))[tid] = *(const LAS u32x4*)(lds + O_KCN + io); }
        } else {
            { f4 acc[2]; RW_ZERO(acc); mm64(acc, lds, O_TINV, O_AHT, wave, lane); storeN<0>(lds, O_A2N, acc, wave, lane); }
            __syncthreads();
            { f4 acc[2]; RW_ZERO(acc); mm64(acc, lds, O_TINV, O_MVT, wave, lane); mm64(acc, lds, O_A2N, O_STT, wave, lane); storeT(lds, O_UT, acc, wave, lane); }
            __syncthreads();
            f4 yacc[2]; RW_ZERO(yacc);
            mm64(yacc, lds, O_RHN, O_STT, wave, lane); mm64(yacc, lds, O_MRB, O_UT, wave, lane); mm64(yacc, lds, O_MRK, O_VT, wave, lane);
            __syncthreads();
#pragma unroll
            for (int cI = 0; cI < 2; ++cI) { const int col = ((wave & 1) * 2 + cI) * 16 + (lane & 15), row = (wave >> 1) * 16 + 4 * (lane >> 4);
#pragma unroll
                for (int e = 0; e < 4; ++e) YF[(row + e) * 64 + col] = yacc[cI][e]; }
            __syncthreads();
            { unsigned gcur = (unsigned)OB[((size_t)b * T + t0 + wave * 8) * 1024 + 512 + c];
#pragma unroll 1
            for (int q = 0; q < 8; ++q) {
                const int tt = wave * 8 + q; const size_t m = (size_t)b * T + t0 + tt;
                const unsigned gnxt = (unsigned)OB[(m + (q < 7 ? 1 : 0)) * 1024 + 512 + c];
                const float y = YF[tt * 64 + lane]; const float mean = wave_sum(y) * (1.f / 64.f); const float dy = y - mean; const float var = wave_sum(dy * dy) * (1.f / 64.f);
                const float yn = dy * rsqrtf(var + 64e-5f) * CTV(10) + CTV(11);
                const float vv = bf2f(*(const LAS bf16*)(lds + O_VT + (lane * LS + tt) * 2)), gg = LO_(gcur);
                OB[m * 1024 + 512 + c] = (bf16)f2bf((yn + BON[tt] * vv) * gg);
                gcur = gnxt;
            } }
        }
        __syncthreads();
#undef CTV
#undef LO_
#undef HI_
    }
}

__device__ __forceinline__ void chunk_out(LAS unsigned char* lds0, const int b, const int h, const int t0, const unsigned char* gz, const unsigned char* gz2, const float* bong, const bf16* VF, bf16* OB, const int tid0) {
    unsigned lb_ = 0u; int tid_l = tid0; asm volatile("" : "+v"(lb_), "+v"(tid_l));
    LAS unsigned char* lds = lds0 + lb_; const int tid = tid_l, lane = tid & 63, wave = __builtin_amdgcn_readfirstlane(tid >> 6);
    const int c = h * 64 + lane;
    const LAS float* CT = (const LAS float*)(lds + O_CT);
    LAS float* YF = (LAS float*)(lds + O_YF);
    const int io = ((tid >> 3) * LS + (tid & 7) * 8) * 2;
    const u32x4 sv = ((const u32x4*)gz)[tid], rv = ((const u32x4*)gz2)[tid];
    u32x2 yv[2];
#pragma unroll
    for (int k = 0; k < 2; ++k) { const int col = ((wave & 1) * 2 + k) * 16 + (lane & 15), row = (wave >> 1) * 16 + 4 * (lane >> 4); yv[k] = *(const u32x2*)(gz2 + 8192 + (col * 64 + row) * 2); }
    float gq[8], vq[8], bq[8];
#pragma unroll
    for (int q = 0; q < 8; ++q) { const int tt = wave * 8 + q; const size_t m = (size_t)b * T + t0 + tt;
        gq[q] = bf2f(((const bf16*)(gz2 + 16384))[tt * 64 + lane]); vq[q] = bf2f(VF[m * 256 + c]); bq[q] = bong[tt]; }
    *(LAS u32x4*)(lds + O_STT + io) = sv; *(LAS u32x4*)(lds + O_AHN + io) = rv;
    __syncthreads();
    f4 acc[2];
#pragma unroll
    for (int k = 0; k < 2; ++k) acc[k] = (f4){__uint_as_float(yv[k].x << 16), __uint_as_float(yv[k].x & 0xffff0000u), __uint_as_float(yv[k].y << 16), __uint_as_float(yv[k].y & 0xffff0000u)};
    mm64(acc, lds, O_AHN, O_STT, wave, lane);
#pragma unroll
    for (int cI = 0; cI < 2; ++cI) { const int col = ((wave & 1) * 2 + cI) * 16 + (lane & 15), row = (wave >> 1) * 16 + 4 * (lane >> 4);
#pragma unroll
        for (int e = 0; e < 4; ++e) YF[(row + e) * 64 + col] = acc[cI][e]; }
    __syncthreads();
#pragma unroll
    for (int q = 0; q < 8; ++q) { const int tt = wave * 8 + q; const size_t m = (size_t)b * T + t0 + tt;
        const float y = YF[tt * 64 + lane]; const float mean = wave_sum(y) * (1.f / 64.f); const float dy = y - mean; const float var = wave_sum(dy * dy) * (1.f / 64.f);
        const float yn = dy * rsqrtf(var + 64e-5f) * CT[10 * 64 + lane] + CT[11 * 64 + lane];
        OB[m * 1024 + 512 + c] = (bf16)f2bf((yn + bq[q] * vq[q]) * gq[q]); }
    __syncthreads();
}

__device__ __forceinline__ void carry(LAS unsigned char* lds0, unsigned char* gzc  , const int tid0) {
    f4 stacc[2]; RW_ZERO(stacc);
    { unsigned lb_ = 0u; asm volatile("" : "+v"(lb_)); LAS unsigned char* lds = lds0 + lb_; for (int i = tid0; i < MB / 4; i += NTHR) ((LAS unsigned*)(lds + O_STT))[i] = 0u; }
    u32x4 gnx = ((const u32x4*)gzc)[tid0];
    u32x2 znx[2];
    { const int lane = tid0 & 63, wave = tid0 >> 6;
#pragma unroll
      for (int k = 0; k < 2; ++k) { const int col = ((wave & 1) * 2 + k) * 16 + (lane & 15), row = (wave >> 1) * 16 + 4 * (lane >> 4); znx[k] = *(const u32x2*)(gzc + 8192 + (col * 64 + row) * 2); } }
#pragma unroll 1
    for (int cI = 0; cI < T / 64; ++cI) {
        unsigned lb_ = 0u; int tid_l = tid0; asm volatile("" : "+v"(lb_), "+v"(tid_l));
        LAS unsigned char* lds = lds0 + lb_; const int tid = tid_l, lane = tid & 63, wave = __builtin_amdgcn_readfirstlane(tid >> 6);
        unsigned char* rec = gzc + (size_t)cI * 16384;
        const int io = ((tid >> 3) * LS + (tid & 7) * 8) * 2;
        *(LAS u32x4*)(lds + O_AHN + io) = gnx;
        u32x2 zv[2]; zv[0] = znx[0]; zv[1] = znx[1];
        if (cI + 1 < T / 64) { gnx = ((const u32x4*)(rec + 16384))[tid];
#pragma unroll
            for (int k = 0; k < 2; ++k) { const int col = ((wave & 1) * 2 + k) * 16 + (lane & 15), row = (wave >> 1) * 16 + 4 * (lane >> 4); znx[k] = *(const u32x2*)(rec + 16384 + 8192 + (col * 64 + row) * 2); } }
        __syncthreads();
        ((u32x4*)rec)[tid] = *(const LAS u32x4*)(lds + O_STT + io);
        f4 acc[2];
#pragma unroll
        for (int k = 0; k < 2; ++k) acc[k] = (f4){__uint_as_float(zv[k].x << 16), __uint_as_float(zv[k].x & 0xffff0000u), __uint_as_float(zv[k].y << 16), __uint_as_float(zv[k].y & 0xffff0000u)};
        mm64(acc, lds, O_AHN, O_STT, wave, lane);
        __syncthreads();
        storeT(lds, O_STT, acc, wave, lane);
    }
}
}

namespace mb {
using rw::LS; using rw::MB; using rw::f4; using rw::mm64; using rw::storeN; using rw::bf16x8;
constexpr int O_CN = 0, O_BN = MB, O_BT = 2 * MB, O_XT0 = 3 * MB, O_XW0 = 5 * MB, O_CS0 = 7 * MB, O_HN0 = 9 * MB, O_SC0 = 11 * MB, O_SM = 13 * MB, O_YF = O_XW0;
static_assert(O_SM + 2048 <= LDS_BYTES - 576, "mamba LDS map");
__device__ __forceinline__ void chain(LAS unsigned char* lds0, const int l, const int b, const int gI, const bf16* P, bf16* OB, const int tid0, const int lane0, const int wave0) {
    const int tid = tid0, lane = lane0, wave = wave0;
    LAS unsigned char* const& lds = lds0;
    const float* cwp = INP(I_DCW) + (size_t)l * 4 * 512; const float* cbp = INP(I_DCB) + (size_t)l * 512;
    const int cc = tid & 255, sub = tid >> 8;
    const int col = cc < 128 ? (gI * 128 + cc) : (cc < 192 ? (256 + gI * 64 + (cc - 128)) : (384 + gI * 64 + (cc - 192)));
    const float cw0 = cwp[col], cw1 = cwp[512 + col], cw2 = cwp[1024 + col], cw3 = cwp[1536 + col], cb = cbp[col];
    f4 hacc[2][2];
#pragma unroll
    for (int hh = 0; hh < 2; ++hh) { hacc[hh][0] = (f4){0.f, 0.f, 0.f, 0.f}; hacc[hh][1] = (f4){0.f, 0.f, 0.f, 0.f}; }
    for (int i = tid; i < 2 * MB / 4; i += NTHR) ((LAS unsigned*)(lds0 + O_HN0))[i] = 0u;
    const float dtb0 = INP(I_DDTB)[l * 4 + gI * 2], dtb1 = INP(I_DDTB)[l * 4 + gI * 2 + 1];
    const float nA0 = -__expf(INP(I_DALOG)[l * 4 + gI * 2]), nA1 = -__expf(INP(I_DALOG)[l * 4 + gI * 2 + 1]);
    const float dsk0 = INP(I_DSKIP)[l * 4 + gI * 2], dsk1 = INP(I_DSKIP)[l * 4 + gI * 2 + 1];
    const float nw0 = INP(I_DNW)[l * 256 + gI * 128 + lane], nw1 = INP(I_DNW)[l * 256 + gI * 128 + 64 + lane];
#pragma unroll 1
    for (int t0 = 0; t0 < T; t0 += 64) {
        unsigned lb_ = 0u; int tid_l = tid0; asm volatile("" : "+v"(lb_), "+v"(tid_l));
        const int tid = tid_l, lane = tid & 63, wave = __builtin_amdgcn_readfirstlane(tid >> 6);
        LAS unsigned char* lds = lds0 + lb_;
        LAS float* SM = (LAS float*)(lds + O_SM);
        LAS float* YF = (LAS float*)(lds + O_YF);
        if (wave < 2) {
            const size_t m = (size_t)b * T + t0 + lane;
            const float dt = softplusf_(bf2f(P[m * PP + C_DT + gI * 2 + wave]) + (wave == 0 ? dtb0 : dtb1));
            float cs = dt * (wave == 0 ? nA0 : nA1);
#pragma unroll
            for (int o = 1; o < 64; o <<= 1) { const float y = __shfl_up(cs, o); if (lane >= o) cs += y; }
            const float cL = __shfl(cs, 63);
            SM[wave * 64 + lane] = dt; SM[128 + wave * 64 + lane] = cs; SM[256 + wave * 64 + lane] = __expf(cL - cs) * dt; SM[384 + wave * 64 + lane] = __expf(cs);
        }
        __syncthreads();
        { float h0, h1, h2, cur[8], nxt[8];
          { const int tb = t0 + sub * 32; h0 = tb >= 3 ? bf2f(P[((size_t)b * T + tb - 3) * PP + C_DX + col]) : 0.f; h1 = tb >= 2 ? bf2f(P[((size_t)b * T + tb - 2) * PP + C_DX + col]) : 0.f; h2 = tb >= 1 ? bf2f(P[((size_t)b * T + tb - 1) * PP + C_DX + col]) : 0.f;
#pragma unroll
            for (int j = 0; j < 8; ++j) cur[j] = bf2f(P[((size_t)b * T + tb + j) * PP + C_DX + col]); }
#pragma unroll 1
          for (int g8 = 0; g8 < 4; ++g8) {
            const int tb = t0 + sub * 32 + g8 * 8 + (g8 < 3 ? 8 : 0);
#pragma unroll
            for (int j = 0; j < 8; ++j) nxt[j] = bf2f(P[((size_t)b * T + tb + j) * PP + C_DX + col]);
#pragma unroll
            for (int j = 0; j < 8; ++j) {
                const int tt = sub * 32 + g8 * 8 + j;
                const float a = siluf_(cb + cw3 * cur[j] + cw2 * h2 + cw1 * h1 + cw0 * h0);
                h0 = h1; h1 = h2; h2 = cur[j];
                if (cc < 128) { const int hh = cc >> 6, p = cc & 63;
                    *(LAS bf16*)(lds + O_XT0 + hh * MB + (p * LS + tt) * 2) = (bf16)f2bf(a); *(LAS bf16*)(lds + O_XW0 + hh * MB + (p * LS + tt) * 2) = (bf16)f2bf(a * SM[256 + hh * 64 + tt]); }
                else if (cc < 192) { const int n = cc - 128; *(LAS bf16*)(lds + O_BN + (tt * LS + n) * 2) = (bf16)f2bf(a); *(LAS bf16*)(lds + O_BT + (n * LS + tt) * 2) = (bf16)f2bf(a); }
                else { const int n = cc - 192; *(LAS bf16*)(lds + O_CN + (tt * LS + n) * 2) = (bf16)f2bf(a);
                    *(LAS bf16*)(lds + O_CS0 + (tt * LS + n) * 2) = (bf16)f2bf(a * SM[384 + tt]); *(LAS bf16*)(lds + O_CS0 + MB + (tt * LS + n) * 2) = (bf16)f2bf(a * SM[384 + 64 + tt]); }
            }
#pragma unroll
            for (int j = 0; j < 8; ++j) cur[j] = nxt[j];
          } }
        __syncthreads();
        { f4 acc[2]; acc[0] = (f4){0.f, 0.f, 0.f, 0.f}; acc[1] = (f4){0.f, 0.f, 0.f, 0.f}; mm64(acc, lds, O_CN, O_BN, wave, lane);
#pragma unroll
            for (int hh = 0; hh < 2; ++hh) { f4 sc[2];
#pragma unroll
                for (int cI = 0; cI < 2; ++cI) { const int s = ((wave & 1) * 2 + cI) * 16 + (lane & 15), row = (wave >> 1) * 16 + 4 * (lane >> 4);
                    const float cs = SM[128 + hh * 64 + s], ds = SM[hh * 64 + s];
#pragma unroll
                    for (int e = 0; e < 4; ++e) { const float ct = SM[128 + hh * 64 + row + e]; sc[cI][e] = (s <= row + e) ? acc[cI][e] * __expf(ct - cs) * ds : 0.f; } }
                storeN<0>(lds, O_SC0 + hh * MB, sc, wave, lane); } }
        __syncthreads();
        f4 yacc[2][2];
#pragma unroll
        for (int hh = 0; hh < 2; ++hh) {
            yacc[hh][0] = (f4){0.f, 0.f, 0.f, 0.f}; yacc[hh][1] = (f4){0.f, 0.f, 0.f, 0.f};
            mm64(yacc[hh], lds, O_SC0 + hh * MB, O_XT0 + hh * MB, wave, lane); mm64(yacc[hh], lds, O_CS0 + hh * MB, O_HN0 + hh * MB, wave, lane);
            const float gL = SM[384 + hh * 64 + 63]; hacc[hh][0] = hacc[hh][0] * gL; hacc[hh][1] = hacc[hh][1] * gL;
            mm64(hacc[hh], lds, O_XW0 + hh * MB, O_BT, wave, lane);
        }
        __syncthreads();
#pragma unroll
        for (int hh = 0; hh < 2; ++hh) {
#pragma unroll
            for (int cI = 0; cI < 2; ++cI) { const int colp = ((wave & 1) * 2 + cI) * 16 + (lane & 15), row = (wave >> 1) * 16 + 4 * (lane >> 4);
#pragma unroll
                for (int e = 0; e < 4; ++e) YF[(row + e) * 128 + hh * 64 + colp] = yacc[hh][cI][e]; }
            storeN<0>(lds, O_HN0 + hh * MB, hacc[hh], wave, lane);
        }
        __syncthreads();
#pragma unroll
        for (int q = 0; q < 8; ++q) {
            const int tt = wave * 8 + q; const size_t m = (size_t)b * T + t0 + tt;
            const float x0 = bf2f(*(const LAS bf16*)(lds + O_XT0 + (lane * LS + tt) * 2)), x1 = bf2f(*(const LAS bf16*)(lds + O_XT0 + MB + (lane * LS + tt) * 2));
            const int c0 = gI * 128 + lane, c1 = c0 + 64;
            const float z0 = bf2f(P[m * PP + C_DZ + c0]), z1 = bf2f(P[m * PP + C_DZ + c1]);
            const float y0 = (YF[tt * 128 + lane] + dsk0 * x0) * siluf_(z0), y1 = (YF[tt * 128 + 64 + lane] + dsk1 * x1) * siluf_(z1);
            const float ss = wave_sum(y0 * y0 + y1 * y1); const float rs = rsqrtf(ss * (1.f / 128.f) + 1e-5f);
            OB[m * 1024 + 768 + c0] = (bf16)f2bf(y0 * rs * nw0); OB[m * 1024 + 768 + c1] = (bf16)f2bf(y1 * rs * nw1);
        }
        __syncthreads();
    }
}
}

namespace bsp {
typedef short bf16x8 __attribute__((ext_vector_type(8)));
typedef float f4 __attribute__((ext_vector_type(4)));
constexpr int HS = 129;
constexpr int O_HIST = 0;
constexpr int O_V = 66048;
constexpr int VS = 272;
constexpr int O_FLAG = O_V + 2 * 32 * VS * 2;
__device__ __forceinline__ unsigned okey(float s) { int q = (int)(s * 262144.f + 8388608.f); q = q < 1 ? 1 : (q > 16777215 ? 16777215 : q); return (unsigned)q << 8; }
__device__ __forceinline__ f4 idx_tile(const bf16* Pb, const int kt, const bf16x8 (&qi)[4][2], const float (&wq)[4], const int lane) {
    const bf16* kr = Pb + (size_t)(kt * 16 + (lane & 15)) * PP + C_IK + (lane >> 4) * 8;
    const bf16x8 a0 = *(const bf16x8*)kr, a1 = *(const bf16x8*)(kr + 32);
    f4 s = (f4){0.f, 0.f, 0.f, 0.f};
#pragma unroll
    for (int h = 0; h < 4; ++h) { f4 t = (f4){0.f, 0.f, 0.f, 0.f};
        t = __builtin_amdgcn_mfma_f32_16x16x32_bf16(a0, qi[h][0], t, 0, 0, 0); t = __builtin_amdgcn_mfma_f32_16x16x32_bf16(a1, qi[h][1], t, 0, 0, 0);
#pragma unroll
        for (int e = 0; e < 4; ++e) s[e] += wq[h] * fmaxf(t[e], 0.f); }
    return s;
}

__device__ __forceinline__ void item(LAS unsigned char* lds0, const int bb, const int qb, const bf16* P, bf16* OB, const int tid0, const int pm) {
    unsigned lb_ = 0u; int tid_l = tid0; asm volatile("" : "+v"(lb_), "+v"(tid_l));
    LAS unsigned char* lds = lds0 + lb_; const int tid = tid_l, lane = tid & 63, wave = __builtin_amdgcn_readfirstlane(tid >> 6);
    const bf16* Pb = P + (size_t)bb * T * PP;
    const int ql = wave * 16 + (lane & 15), tq = qb * 128 + ql, g = lane >> 4;
    const bf16* prow = Pb + (size_t)tq * PP;
    bf16x8 qi[4][2]; float wq[4];
#pragma unroll
    for (int h = 0; h < 4; ++h) { qi[h][0] = *(const bf16x8*)(prow + C_IQ + h * 64 + g * 8); qi[h][1] = *(const bf16x8*)(prow + C_IQ + h * 64 + 32 + g * 8); wq[h] = bf2f(prow[C_IW + h]) * 0.0625f; }
    LAS unsigned* hist = (LAS unsigned*)(lds + O_HIST) + ql * HS;
    const int nkt = (qb + 1) * 8;
    unsigned prefix = 0u; int needk = 256;
#pragma unroll 1
    for (int rr = 0; rr < (pm == 102 ? 2 : 1); ++rr) { prefix = 0u; needk = 256;
#pragma unroll 1
    for (int pass = 0; pass < 3; ++pass) {
        for (int i = lane; i < 16 * HS; i += 64) ((LAS unsigned*)(lds + O_HIST) + wave * 16 * HS)[i] = 0u;
        asm volatile("s_waitcnt lgkmcnt(0)" ::: "memory");
        const int shp = 32 - 8 * pass, shb = 24 - 8 * pass;
        bf16x8 ka[4][2], kn[4][2];
#pragma unroll
        for (int u = 0; u < 4; ++u) { const bf16* kr = Pb + (size_t)(u * 16 + (lane & 15)) * PP + C_IK + g * 8; ka[u][0] = *(const bf16x8*)kr; ka[u][1] = *(const bf16x8*)(kr + 32); }
#pragma unroll 1
        for (int kt4 = 0; kt4 < nkt; kt4 += 4) {
            { const int ktn = (kt4 + 4 < nkt) ? kt4 + 4 : kt4;
#pragma unroll
              for (int u = 0; u < 4; ++u) { const bf16* kr = Pb + (size_t)((ktn + u) * 16 + (lane & 15)) * PP + C_IK + g * 8; kn[u][0] = *(const bf16x8*)kr; kn[u][1] = *(const bf16x8*)(kr + 32); } }
#pragma unroll
            for (int u = 0; u < 4; ++u) {
                f4 s = (f4){0.f, 0.f, 0.f, 0.f};
#pragma unroll
                for (int h = 0; h < 4; ++h) { f4 t = (f4){0.f, 0.f, 0.f, 0.f};
                    t = __builtin_amdgcn_mfma_f32_16x16x32_bf16(ka[u][0], qi[h][0], t, 0, 0, 0); t = __builtin_amdgcn_mfma_f32_16x16x32_bf16(ka[u][1], qi[h][1], t, 0, 0, 0);
#pragma unroll
                    for (int e = 0; e < 4; ++e) s[e] += wq[h] * fmaxf(t[e], 0.f); }
#pragma unroll
                for (int e = 0; e < 4; ++e) { const int key = (kt4 + u) * 16 + 4 * g + e; const unsigned k32 = okey(s[e]);
                    const bool in = key <= tq && (pass == 0 || (k32 >> shp) == prefix);
                    if (in) { const unsigned bin = (k32 >> shb) & 255u; __hip_atomic_fetch_add(hist + (bin >> 1), (bin & 1u) ? 0x10000u : 1u, __ATOMIC_RELAXED, __HIP_MEMORY_SCOPE_WORKGROUP); } }
            }
#pragma unroll
            for (int u = 0; u < 4; ++u) { ka[u][0] = kn[u][0]; ka[u][1] = kn[u][1]; }
        }
        asm volatile("s_waitcnt lgkmcnt(0)" ::: "memory");
        int cum = 0; unsigned bsel = 0u; int above = 0;
        for (int wd = 127; wd >= 0; --wd) { const unsigned v = hist[wd]; const int hi = (int)(v >> 16), lo = (int)(v & 0xffffu);
            if (cum + hi >= needk) { bsel = (unsigned)(2 * wd + 1); above = cum; break; } cum += hi;
            if (cum + lo >= needk) { bsel = (unsigned)(2 * wd); above = cum; break; } cum += lo; }
        prefix = (prefix << 8) | bsel; needk -= above;
        asm volatile("s_waitcnt lgkmcnt(0)" ::: "memory");
    }
    }
    unsigned thr = prefix; int cidx = 1 << 20;
    bool tie = false;
    if (tq < 256) thr = 0u;
    else { const unsigned v = hist[(prefix & 255u) >> 1]; const int ceq = (prefix & 1u) ? (int)(v >> 16) : (int)(v & 0xffffu); tie = needk < ceq; }
    if (__any(tie)) {
        int cbin = 0, rem = needk;
#pragma unroll 1
        for (int ip = 0; ip < 2; ++ip) {
            for (int i = g; i < HS; i += 4) hist[i] = 0u;
            asm volatile("s_waitcnt lgkmcnt(0)" ::: "memory");
#pragma unroll 1
            for (int kt = 0; kt < nkt; ++kt) {
                const f4 s = idx_tile(Pb, kt, qi, wq, lane);
#pragma unroll
                for (int e = 0; e < 4; ++e) { const int key = kt * 16 + 4 * g + e; const unsigned k32 = okey(s[e]);
                    const bool in = tie && key <= tq && (k32 >> 8) == prefix && (ip == 0 || (key >> 4) == cbin);
                    if (in) { const unsigned bin = ip == 0 ? (unsigned)(key >> 4) : (unsigned)(key & 15); __hip_atomic_fetch_add(hist + (bin >> 1), (bin & 1u) ? 0x10000u : 1u, __ATOMIC_RELAXED, __HIP_MEMORY_SCOPE_WORKGROUP); } }
            }
            asm volatile("s_waitcnt lgkmcnt(0)" ::: "memory");
            int cum = 0, bs = 0, below = 0;
            for (int wd = 0; wd < 128; ++wd) { const unsigned vv = hist[wd]; const int lo = (int)(vv & 0xffffu), hi = (int)(vv >> 16);
                if (cum + lo >= rem) { bs = 2 * wd; below = cum; break; } cum += lo;
                if (cum + hi >= rem) { bs = 2 * wd + 1; below = cum; break; } cum += hi; }
            if (ip == 0) { cbin = bs; rem -= below; } else if (tie) cidx = cbin * 16 + bs;
            asm volatile("s_waitcnt lgkmcnt(0)" ::: "memory");
        }
    }
    __syncthreads();
#pragma unroll
    for (int h = 0; h < 4; ++h) { *(LAS bf16x8*)(lds + O_HIST + wave * 8192 + ((h * 2 + 0) * 64 + lane) * 16) = qi[h][0]; *(LAS bf16x8*)(lds + O_HIST + wave * 8192 + ((h * 2 + 1) * 64 + lane) * 16) = qi[h][1]; }
    bf16x8 qa[4][2];
#pragma unroll
    for (int h = 0; h < 4; ++h) { qa[h][0] = *(const bf16x8*)(prow + C_BQ + h * 64 + g * 8); qa[h][1] = *(const bf16x8*)(prow + C_BQ + h * 64 + 32 + g * 8); }
    f4 oacc[4][4]; float mrun[4], lrun[4];
#pragma unroll
    for (int h = 0; h < 4; ++h) { mrun[h] = -INFINITY; lrun[h] = 0.f;
#pragma unroll
        for (int dt = 0; dt < 4; ++dt) oacc[h][dt] = (f4){0.f, 0.f, 0.f, 0.f}; }
#pragma unroll 1
    for (int rr = 0; rr < (pm == 103 ? 2 : 1); ++rr) {
#pragma unroll
    for (int h = 0; h < 4; ++h) { mrun[h] = -INFINITY; lrun[h] = 0.f;
#pragma unroll
        for (int dt = 0; dt < 4; ++dt) oacc[h][dt] = (f4){0.f, 0.f, 0.f, 0.f}; }
    const int nst = (qb + 1) * 4;
    const int vkey = tid >> 4, vch = tid & 15;
    u32x4 vpre0 = *(const u32x4*)(Pb + (size_t)vkey * PP + C_BV + vch * 8), vpre1 = *(const u32x4*)(Pb + (size_t)vkey * PP + C_BV + 128 + vch * 8);
    const unsigned vrd = (unsigned)(unsigned long)lds + (unsigned)(O_V + (4 * g + ((lane >> 2) & 3)) * (VS * 2) + (lane & 3) * 8);
#pragma unroll 1
    for (int st = 0; st < nst; ++st) {
        const int key0 = st * 32; const unsigned vbuf = (unsigned)(st & 1) * (32 * VS * 2);
        unsigned qio = (unsigned)(O_HIST + wave * 8192 + lane * 16); asm volatile("" : "+v"(qio));
        { LAS bf16* VL = (LAS bf16*)(lds + O_V + vbuf); *(LAS u32x4*)(VL + vkey * VS + vch * 8) = vpre0; *(LAS u32x4*)(VL + vkey * VS + 128 + vch * 8) = vpre1; }
        bf16x8 kq[4][2][2], ki[2][2];
#pragma unroll
        for (int k2 = 0; k2 < 2; ++k2) { const bf16* kr = Pb + (size_t)(key0 + k2 * 16 + (lane & 15)) * PP;
            ki[k2][0] = *(const bf16x8*)(kr + C_IK + g * 8); ki[k2][1] = *(const bf16x8*)(kr + C_IK + 32 + g * 8);
#pragma unroll
            for (int h = 0; h < 2; ++h) { kq[h][k2][0] = *(const bf16x8*)(kr + C_BK + h * 64 + g * 8); kq[h][k2][1] = *(const bf16x8*)(kr + C_BK + h * 64 + 32 + g * 8); } }
        __syncthreads();
        bool sel[2][4];
#pragma unroll
        for (int k2 = 0; k2 < 2; ++k2) { f4 s = (f4){0.f, 0.f, 0.f, 0.f};
#pragma unroll
            for (int h = 0; h < 4; ++h) { f4 t = (f4){0.f, 0.f, 0.f, 0.f};
                const bf16x8 qh0 = *(const LAS bf16x8*)(lds + qio + ((h * 2 + 0) * 64) * 16), qh1 = *(const LAS bf16x8*)(lds + qio + ((h * 2 + 1) * 64) * 16);
                t = __builtin_amdgcn_mfma_f32_16x16x32_bf16(ki[k2][0], qh0, t, 0, 0, 0); t = __builtin_amdgcn_mfma_f32_16x16x32_bf16(ki[k2][1], qh1, t, 0, 0, 0);
#pragma unroll
                for (int e = 0; e < 4; ++e) s[e] += wq[h] * fmaxf(t[e], 0.f); }
#pragma unroll
            for (int e = 0; e < 4; ++e) { const int key = key0 + k2 * 16 + 4 * g + e; const unsigned k24 = okey(s[e]) >> 8;
                sel[k2][e] = key <= tq && (k24 > thr || (k24 == thr && key <= cidx)); } }
#pragma unroll
        for (int h = 0; h < 4; ++h) {
            if (h == 2 && st + 1 < nst) { vpre0 = *(const u32x4*)(Pb + (size_t)(key0 + 32 + vkey) * PP + C_BV + vch * 8); vpre1 = *(const u32x4*)(Pb + (size_t)(key0 + 32 + vkey) * PP + C_BV + 128 + vch * 8); }
            if (h + 2 < 4) {
                asm volatile("" ::: "memory");
#pragma unroll
                for (int k2 = 0; k2 < 2; ++k2) { const bf16* kr = Pb + (size_t)(key0 + k2 * 16 + (lane & 15)) * PP + C_BK + (h + 2) * 64 + g * 8; kq[h + 2][k2][0] = *(const bf16x8*)kr; kq[h + 2][k2][1] = *(const bf16x8*)(kr + 32); }
                asm volatile("" ::: "memory");
            }
            f4 sc[2];
#pragma unroll
            for (int k2 = 0; k2 < 2; ++k2) { f4 t = (f4){0.f, 0.f, 0.f, 0.f};
                t = __builtin_amdgcn_mfma_f32_16x16x32_bf16(kq[h][k2][0], qa[h][0], t, 0, 0, 0); t = __builtin_amdgcn_mfma_f32_16x16x32_bf16(kq[h][k2][1], qa[h][1], t, 0, 0, 0);
#pragma unroll
                for (int e = 0; e < 4; ++e) sc[k2][e] = sel[k2][e] ? t[e] * 0.125f : -INFINITY; }
            float mx = fmaxf(fmaxf(fmaxf(sc[0][0], sc[0][1]), fmaxf(sc[0][2], sc[0][3])), fmaxf(fmaxf(sc[1][0], sc[1][1]), fmaxf(sc[1][2], sc[1][3])));
            mx = fmaxf(mx, __shfl_xor(mx, 16)); mx = fmaxf(mx, __shfl_xor(mx, 32));
            const float mnew = fmaxf(mrun[h], mx), msafe = (mnew == -INFINITY) ? 0.f : mnew;
            const float corr = __expf(mrun[h] - msafe); mrun[h] = mnew;
            float p[8]; float ps = 0.f;
#pragma unroll
            for (int e = 0; e < 4; ++e) { p[e] = __expf(sc[0][e] - msafe); p[4 + e] = __expf(sc[1][e] - msafe); ps += p[e] + p[4 + e]; }
            lrun[h] = lrun[h] * corr + ps;
            union { bf16x8 v; unsigned u[4]; } pb;
            pb.u[0] = pg8::cvt_pk_bf16(p[0], p[1]); pb.u[1] = pg8::cvt_pk_bf16(p[2], p[3]); pb.u[2] = pg8::cvt_pk_bf16(p[4], p[5]); pb.u[3] = pg8::cvt_pk_bf16(p[6], p[7]);
            union { bf16x8 v; u32x2 h2[2]; } vf[4];
            const unsigned va = vrd + vbuf + (unsigned)(h * 128);
            asm volatile("ds_read_b64_tr_b16 %0, %8\n\tds_read_b64_tr_b16 %1, %8 offset:%9\n\tds_read_b64_tr_b16 %2, %8 offset:32\n\tds_read_b64_tr_b16 %3, %8 offset:%10\n\t"
                         "ds_read_b64_tr_b16 %4, %8 offset:64\n\tds_read_b64_tr_b16 %5, %8 offset:%11\n\tds_read_b64_tr_b16 %6, %8 offset:96\n\tds_read_b64_tr_b16 %7, %8 offset:%12\n\ts_waitcnt lgkmcnt(0)"
                         : "=&v"(vf[0].h2[0]), "=&v"(vf[0].h2[1]), "=&v"(vf[1].h2[0]), "=&v"(vf[1].h2[1]), "=&v"(vf[2].h2[0]), "=&v"(vf[2].h2[1]), "=&v"(vf[3].h2[0]), "=&v"(vf[3].h2[1])
                         : "v"(va), "i"(16 * VS * 2), "i"(16 * VS * 2 + 32), "i"(16 * VS * 2 + 64), "i"(16 * VS * 2 + 96) : "memory");
            __builtin_amdgcn_sched_barrier(0);
#pragma unroll
            for (int dt = 0; dt < 4; ++dt) { oacc[h][dt] = oacc[h][dt] * corr; oacc[h][dt] = __builtin_amdgcn_mfma_f32_16x16x32_bf16(vf[dt].v, pb.v, oacc[h][dt], 0, 0, 0); }
        }
    }
    __syncthreads();
    }
    const size_t m = (size_t)bb * T + tq;
#pragma unroll
    for (int h = 0; h < 4; ++h) { float l = lrun[h]; l += __shfl_xor(l, 16); l += __shfl_xor(l, 32); const float inv = 1.f / l;
#pragma unroll
        for (int dt = 0; dt < 4; ++dt) { u32x2 w; w.x = pk2(oacc[h][dt][0] * inv, oacc[h][dt][1] * inv); w.y = pk2(oacc[h][dt][2] * inv, oacc[h][dt][3] * inv);
            *(u32x2*)(OB + m * 1024 + 256 + h * 64 + dt * 16 + 4 * g) = w; } }
    __syncthreads();
}
}

namespace awin {
typedef short bf16x8 __attribute__((ext_vector_type(8)));
typedef float f4 __attribute__((ext_vector_type(4)));
constexpr int EXS = 66;
constexpr int O_EX = 0;
constexpr int VSW = 72;
constexpr int O_VW = 101376;
__device__ __forceinline__ void item(LAS unsigned char* lds0, const int bb, const int blk, const int h, const bf16* P, bf16* OB, const int tid0) {
    unsigned lb_ = 0u; int tid_l = tid0; asm volatile("" : "+v"(lb_), "+v"(tid_l));
    LAS unsigned char* lds = lds0 + lb_; const int tid = tid_l, lane = tid & 63, wave = __builtin_amdgcn_readfirstlane(tid >> 6);
    const bf16* Pb = P + (size_t)bb * T * PP; const int start = blk * 128, g = lane >> 4, ln = lane & 15;
    LAS float* EX = (LAS float*)(lds + O_EX);
    LAS bf16* VW = (LAS bf16*)(lds + O_VW + wave * 4608);
#pragma unroll 1
    for (int s4 = 0; s4 < 4; ++s4) {
        const int st = wave * 4 + s4;
        const int grp = st < 8 ? 0 : (st < 16 ? 1 : 2);
        const int dil = grp == 0 ? 1 : (grp == 1 ? 4 : 16), win = grp == 0 ? 128 : (grp == 1 ? 512 : 2048);
        const int r = grp == 0 ? 0 : (grp == 1 ? ((st - 8) >> 1) : (st - 16)), a0 = grp == 0 ? 16 * st : (grp == 1 ? ((st - 8) & 1) * 16 : 0), nqc = grp == 0 ? 128 : (grp == 1 ? 32 : 8);
        const int a = a0 + ln; const bool qok = a < nqc; const int ql = (qok ? a : (nqc - 1)) * dil + r, tq = start + ql;
        const bf16* qp = Pb + (size_t)tq * PP + C_AQ + grp * 256 + h * 64 + g * 8;
        const bf16x8 q0 = *(const bf16x8*)qp, q1 = *(const bf16x8*)(qp + 32);
        bf16x8 kf[10][2];
#pragma unroll
        for (int kt = 0; kt < 10; ++kt) { int pos = start - win + (a0 + 16 * kt + ln) * dil + r; pos = pos < 0 ? 0 : (pos > T - 1 ? T - 1 : pos);
            const bf16* kp = Pb + (size_t)pos * PP + C_AK + grp * 256 + h * 64 + g * 8; kf[kt][0] = *(const bf16x8*)kp; kf[kt][1] = *(const bf16x8*)(kp + 32); }
        f4 sc[10]; float mx = -INFINITY;
#pragma unroll
        for (int kt = 0; kt < 10; ++kt) { f4 t = (f4){0.f, 0.f, 0.f, 0.f};
            t = __builtin_amdgcn_mfma_f32_16x16x32_bf16(kf[kt][0], q0, t, 0, 0, 0); t = __builtin_amdgcn_mfma_f32_16x16x32_bf16(kf[kt][1], q1, t, 0, 0, 0);
#pragma unroll
            for (int e = 0; e < 4; ++e) { const int c = a0 + 16 * kt + 4 * g + e; const int pos = start - win + c * dil + r;
                const bool ok = qok && c >= a && c <= a + 128 && pos >= 0;
                sc[kt][e] = ok ? t[e] * 0.125f : -INFINITY; mx = fmaxf(mx, sc[kt][e]); } }
        mx = fmaxf(mx, __shfl_xor(mx, 16)); mx = fmaxf(mx, __shfl_xor(mx, 32));
        const float msafe = (mx == -INFINITY) ? 0.f : mx; float lsum = 0.f;
#pragma unroll
        for (int kt = 0; kt < 10; ++kt)
#pragma unroll
            for (int e = 0; e < 4; ++e) { sc[kt][e] = __expf(sc[kt][e] - msafe); lsum += sc[kt][e]; }
        lsum += __shfl_xor(lsum, 16); lsum += __shfl_xor(lsum, 32);
        f4 oacc[4];
#pragma unroll
        for (int dt = 0; dt < 4; ++dt) oacc[dt] = (f4){0.f, 0.f, 0.f, 0.f};
#pragma unroll
        for (int s5 = 0; s5 < 5; ++s5) {
            int pos = start - win + (a0 + 32 * s5 + (lane >> 1)) * dil + r; pos = pos < 0 ? 0 : (pos > T - 1 ? T - 1 : pos);
            const u32x4* vp = (const u32x4*)(Pb + (size_t)pos * PP + C_AV + grp * 256 + h * 64 + (lane & 1) * 32);
            const u32x4 v0 = vp[0], v1 = vp[1], v2 = vp[2], v3 = vp[3];
            LAS u32x4* vd = (LAS u32x4*)(VW + (lane >> 1) * VSW + (lane & 1) * 32);
            asm volatile("s_waitcnt lgkmcnt(0)" ::: "memory");
            vd[0] = v0; vd[1] = v1; vd[2] = v2; vd[3] = v3;
            asm volatile("s_waitcnt lgkmcnt(0)" ::: "memory");
            bf16x8 pb;
#pragma unroll
            for (int e = 0; e < 4; ++e) { pb[e] = (short)f2bf(sc[2 * s5][e]); pb[4 + e] = (short)f2bf(sc[2 * s5 + 1][e]); }
#pragma unroll
            for (int dt = 0; dt < 4; ++dt) { bf16x8 vf; const LAS bf16* vb = VW + (4 * g) * VSW + dt * 16 + ln;
#pragma unroll
                for (int e = 0; e < 4; ++e) { vf[e] = (short)vb[e * VSW]; vf[4 + e] = (short)vb[(16 + e) * VSW]; }
                oacc[dt] = __builtin_amdgcn_mfma_f32_16x16x32_bf16(vf, pb, oacc[dt], 0, 0, 0); }
        }
        if (qok) { LAS float* ex = EX + (grp * 128 + ql) * EXS;
#pragma unroll
            for (int dt = 0; dt < 4; ++dt) { ex[dt * 16 + 4 * g + 0] = oacc[dt][0]; ex[dt * 16 + 4 * g + 1] = oacc[dt][1]; ex[dt * 16 + 4 * g + 2] = oacc[dt][2]; ex[dt * 16 + 4 * g + 3] = oacc[dt][3]; }
            if (g == 0) { ex[64] = mx; ex[65] = lsum; } }
    }
    __syncthreads();
    { const int ql = tid >> 2, d0 = (tid & 3) * 16;
      const LAS float* e0 = EX + (0 * 128 + ql) * EXS; const LAS float* e1 = EX + (1 * 128 + ql) * EXS; const LAS float* e2 = EX + (2 * 128 + ql) * EXS;
      const float m0 = e0[64], m1 = e1[64], m2 = e2[64], M = fmaxf(m0, fmaxf(m1, m2));
      const float w0 = __expf(m0 - M), w1 = __expf(m1 - M), w2 = __expf(m2 - M); const float inv = 1.f / (w0 * e0[65] + w1 * e1[65] + w2 * e2[65]);
      unsigned pk[8];
#pragma unroll
      for (int j = 0; j < 8; ++j) { const float x0 = (w0 * e0[d0 + 2 * j] + w1 * e1[d0 + 2 * j] + w2 * e2[d0 + 2 * j]) * inv, x1 = (w0 * e0[d0 + 2 * j + 1] + w1 * e1[d0 + 2 * j + 1] + w2 * e2[d0 + 2 * j + 1]) * inv; pk[j] = pk2(x0, x1); }
      u32x4* op = (u32x4*)(OB + ((size_t)bb * T + start + ql) * 1024 + h * 64 + d0);
      op[0] = (u32x4){pk[0], pk[1], pk[2], pk[3]}; op[1] = (u32x4){pk[4], pk[5], pk[6], pk[7]}; }
    __syncthreads();
}
}

template <int SP>
__device__ __forceinline__ void phase_body(const int l_in, LAS unsigned char* lds) {
    int tid_ = threadIdx.x, bid_ = blockIdx.x, l_ = l_in, G_ = gridDim.x; asm volatile("" : "+v"(tid_), "+s"(bid_), "+s"(l_), "+s"(G_));
    const int tid = tid_, lane = tid & 63, wave = __builtin_amdgcn_readfirstlane(tid >> 6), l = l_;
    const int G = G_, bid = bid_;
    const int gw = bid * NWAVES + wave, NGW = G * NWAVES;
    unsigned char* ws = (unsigned char*)gptr(ldptr(lds, 36));
    int* ctl = (int*)(ws + WS_CTL);
    bf16* XB = (bf16*)(ws + WS_XB); bf16* OB = (bf16*)(ws + WS_O); bf16* VF = (bf16*)(ws + WS_VF); bf16* P = (bf16*)(ws + WS_P);
    bf16* GS = (bf16*)(ws + WS_GS); bf16* MG = (bf16*)(ws + WS_MERGED); bf16* XS = (bf16*)(ws + WS_XS); bf16* HB = (bf16*)(ws + WS_H);
    bf16* WGU = (bf16*)(ws + WS_WGU); bf16* WD = (bf16*)(ws + WS_WD);
    float* X = (float*)gptr(ldptr(lds, 35));
    int* tok_e = (int*)(ws + WS_ROUTE); float* tok_g = (float*)(ws + WS_ROUTE + 256 * 1024); int* tok_rank = (int*)(ws + WS_ROUTE + 512 * 1024); int* tok_slot = (int*)(ws + WS_ROUTE + 768 * 1024);
    (void)ctl; (void)XB; (void)OB; (void)VF; (void)P; (void)GS; (void)MG; (void)XS; (void)HB; (void)WGU; (void)WD; (void)X; (void)tok_e; (void)tok_g; (void)tok_rank; (void)tok_slot; (void)gw; (void)NGW; (void)lane;
    {
        bf16* WinT = (bf16*)(ws + WS_WINT) + (size_t)l * 5120 * 1024; bf16* WgT = (bf16*)(ws + WS_WGT) + (size_t)l * 4096 * 1024;
        bf16* WbrT = (bf16*)(ws + WS_WBRT) + (size_t)l * 1024 * 1024; bf16* WoutT = (bf16*)(ws + WS_WOUTT) + (size_t)l * 1024 * 1024;
        float* WrT = (float*)(ws + WS_WRT) + (size_t)l * 36 * 1024;
        int* cnt = ctl + CW_CNT + l * 64;

        if constexpr (SP == -1) {
            LAS float* scr = (LAS float*)(lds + wave * 16384);
#pragma unroll 1
            for (int job = 0; job < NL * 11; ++job) {
                const int ll = job / 11, jk = job % 11;
                if (jk < 5) {
                    const float* W = INP(I_WIN) + (size_t)ll * 1024 * INW;
                    const int sc0 = jk == 0 ? 0 : (jk == 1 ? 3396 : (jk == 2 ? 3392 : (jk == 3 ? 5060 : 5064)));
                    const int snc = jk == 0 ? 3392 : (jk == 1 ? 1664 : (jk == 4 ? 4096 : 4));
                    const int sr0 = jk == 0 ? 0 : (jk == 1 ? 3392 : (jk == 2 ? 5056 : (jk == 3 ? 5060 : 0)));
                    bf16* dst = jk == 4 ? (bf16*)(ws + WS_WGT) + (size_t)ll * 4096 * 1024 : (bf16*)(ws + WS_WINT) + (size_t)ll * 5120 * 1024;
                    const int nbn = (snc + 31) / 32, nit = 16 * nbn;
#pragma unroll 1
                    for (int it = gw; it < nit; it += NGW) transpose_item(W, INW, sc0, snc, dst, 1024, sr0, 0, it / nbn, it % nbn, scr, lane);
                } else if (jk < 9) {
                    const int n = jk - 5; const float* Wb = INP(I_WBR) + ((size_t)ll * 4 + n) * 256 * 1024;
#pragma unroll 1
                    for (int it = gw; it < 4 * 32; it += NGW) transpose_item(Wb, 1024, 0, 1024, (bf16*)(ws + WS_WBRT) + (size_t)ll * 1024 * 1024, 1024, 0, n * 256, it / 32, it % 32, scr, lane);
                } else if (jk == 9) {
                    const float* Wo = INP(I_WOUT) + (size_t)ll * 1024 * 1024;
#pragma unroll 1
                    for (int it = gw; it < 16 * 32; it += NGW) transpose_item(Wo, 1024, 0, 1024, (bf16*)(ws + WS_WOUTT) + (size_t)ll * 1024 * 1024, 1024, 0, 0, it / 32, it % 32, scr, lane);
                } else {
                    bf16* wi = (bf16*)(ws + WS_WINT) + (size_t)ll * 5120 * 1024;
#pragma unroll 1
                    for (int i = gw * 64 + lane; i < 56 * 1024 / 8; i += NGW * 64) ((u32x4*)(wi + (size_t)5064 * 1024))[i] = (u32x4){0u, 0u, 0u, 0u};
                    float* wr = (float*)(ws + WS_WRT) + (size_t)ll * 36 * 1024; const float* rg = INP(I_RG) + (size_t)ll * 1024 * 4; const float* re = INP(I_RE) + (size_t)ll * 1024 * 32;
#pragma unroll 1
                    for (int i = gw * 64 + lane; i < 36 * 1024; i += NGW * 64) { const int o = i / 1024, k = i % 1024; wr[i] = o < 4 ? rg[k * 4 + o] : re[k * 32 + (o - 4)]; }
                }
            }
            for (int m = gw; m < M; m += NGW) {
                const f32x4* xr = (const f32x4*)(INP(I_X) + (size_t)m * D) + lane;
#pragma unroll
                for (int j = 0; j < 4; ++j) { const f32x4 v = xr[64 * j]; ((f32x4*)(X + (size_t)m * D))[lane + 64 * j] = v;
                    u32x2 w; w.x = pk2(v[0], v[1]); w.y = pk2(v[2], v[3]); ((u32x2*)(XB + (size_t)m * D))[lane + 64 * j] = w; }
            }
        }
        else if constexpr (SP == 0) {
            pg8::Gemm g{XB, WinT, 1024, 1024, 1024}; pg8::StaticOrder S; S.init(M, PP, G, bid, 1024, 1024);
            EpiStoreBf16 E{P, PP, 0, PP};
            pg8::gemm_phase<EpiStoreBf16, pg8::StaticOrder>(lds, g, S, E);
        }
        else if constexpr (SP == 12) {
            if (bid < 32) rw::carry(lds, ws + WS_RW + (size_t)bid * 64 * 16384, tid);
        }
        else if constexpr (SP == 13) {
            unsigned char* GZ = ws + WS_RW;
            const int h = bid & 3, k = bid >> 2;
            rw::build_ct(lds, l, h, lane, wave); __syncthreads();
#pragma unroll 1
            for (int idx = k; idx < 512; idx += (G >> 2)) { const int b = idx >> 6, cI = idx & 63; const size_t ci_ = (size_t)((b * 4 + h) * 64 + cI);
                rw::chunk_out(lds, b, h, cI * 64, GZ + ci_ * 16384, ws + WS_RW2 + ci_ * 24576, (const float*)(ws + WS_BONG) + ci_ * 64, VF, OB, tid); }
        }
        else if constexpr (SP == 15) {
            unsigned char* GZ = ws + WS_RW;
            int* qctr = ctl + CW_Q + l * 64;
            int cur_h = -1;
#pragma unroll 1
            for (;;) {
                unsigned so = (unsigned)(LDS_BYTES - 584); asm volatile("" : "+v"(so));
                volatile LAS int* slot = (volatile LAS int*)(lds + so);
                int tid = threadIdx.x; asm volatile("" : "+v"(tid));
                const int lane = tid & 63, wave = __builtin_amdgcn_readfirstlane(tid >> 6);
                __syncthreads();
                if (tid == 0) *slot = atomicAdd(qctr, 1);
                __syncthreads();
                const int it = __builtin_amdgcn_readfirstlane(*slot);
                if (it >= 3344) break;
                if (it < 16) { mb::chain(lds, l, it >> 1, it & 1, P, OB, tid, lane, wave); }
                else if (it < 272) { const int j = it - 16; bsp::item(lds, j & 7, 31 - (j >> 3), P, OB, tid, (int)(unsigned)ldptr(lds, 37)); }
                else if (it < 2320) { const int j = it - 272, h = j >> 9, idx = j & 511, b = idx >> 6, cI = idx & 63;
                    if (h != cur_h) { rw::build_ct(lds, l, h, lane, wave); cur_h = h; __syncthreads(); }
                    { const size_t ci_ = (size_t)((b * 4 + h) * 64 + cI); rw::chunk<1>(lds, l, b, h, cI * 64, GZ + ci_ * 16384, ws + WS_RW2 + ci_ * 24576, (float*)(ws + WS_BONG) + ci_ * 64, P, VF, OB, tid); } }
                else { const int j = it - 2320; awin::item(lds, j >> 7, (j >> 2) & 31, j & 3, P, OB, tid); }
            }
        }
        else if constexpr (SP == 4) {
            pg8::Gemm g{XB, WgT, 1024, 1024, 1024}; pg8::StaticOrder S; S.init(M, 4096, G, bid, 1024, 1024);
            EpiStoreBf16 E{GS, 4096, 1, 4096};
            pg8::gemm_phase<EpiStoreBf16, pg8::StaticOrder>(lds, g, S, E);
        }
        else if constexpr (SP == 5) {
            pg8::Gemm g{OB, WbrT, 1024, 1024, 256}; BranchOrder S{M / 256, 4, G, bid};
            EpiBranch E{GS, MG};
            pg8::gemm_phase<EpiBranch, BranchOrder>(lds, g, S, E);
        }
        else if constexpr (SP == 6) {
            pg8::Gemm g{MG, WoutT, 1024, 1024, 1024}; pg8::StaticOrder S; S.init(M, 1024, G, bid, 1024, 1024);
            EpiResid E{X};
            pg8::gemm_phase<EpiResid, pg8::StaticOrder>(lds, g, S, E);
        }
        else if constexpr (SP == 7) {
            const float* g1 = INP(I_LN1G) + l * 1024; const float* b1 = INP(I_LN1B) + l * 1024;
            const float* rgb = INP(I_RGB) + l * 4; const float* reb = INP(I_REB) + l * 32;
            f32x4 vn[4];
#pragma unroll
            for (int j = 0; j < 4; ++j) vn[j] = ((const f32x4*)(X + (size_t)gw * D))[lane + 64 * j];
#pragma unroll 1
            for (int m = gw; m < M; m += NGW) {
                f32x4 v[4]; float s = 0.f; f32x4* xr = (f32x4*)(X + (size_t)m * D) + lane;
#pragma unroll
                for (int j = 0; j < 4; ++j) { v[j] = vn[j]; s += (v[j][0] + v[j][1]) + (v[j][2] + v[j][3]); }
                { const int mnx = (m + NGW < M) ? m + NGW : m;
#pragma unroll
                  for (int j = 0; j < 4; ++j) vn[j] = ((const f32x4*)(X + (size_t)mnx * D))[lane + 64 * j]; }
                const float mean = wave_sum(s) * (1.f / D); float s2 = 0.f;
#pragma unroll
                for (int j = 0; j < 4; ++j) { v[j] = v[j] - mean; s2 += (v[j][0] * v[j][0] + v[j][1] * v[j][1]) + (v[j][2] * v[j][2] + v[j][3] * v[j][3]); }
                const float rstd = rsqrtf(wave_sum(s2) * (1.f / D) + LN_EPS);
#pragma unroll
                for (int j = 0; j < 4; ++j) { const f32x4 gg = ((const f32x4*)g1)[lane + 64 * j], bb = ((const f32x4*)b1)[lane + 64 * j]; v[j] = v[j] * rstd * gg + bb; xr[64 * j] = v[j];
                    u32x2 w; w.x = pk2(v[j][0], v[j][1]); w.y = pk2(v[j][2], v[j][3]); ((u32x2*)(XB + (size_t)m * D))[lane + 64 * j] = w; }
                float mylg = 0.f;
#pragma unroll 1
                for (int o4 = 0; o4 < 36; o4 += 4) { float a4[4];
#pragma unroll
                    for (int u = 0; u < 4; ++u) { float a = 0.f;
#pragma unroll
                        for (int j = 0; j < 4; ++j) { const f32x4 wv = ((const f32x4*)(WrT + (o4 + u) * 1024))[lane + 64 * j]; a += v[j][0] * wv[0] + v[j][1] * wv[1] + v[j][2] * wv[2] + v[j][3] * wv[3]; }
                        a4[u] = a; }
#pragma unroll
                    for (int sft = 1; sft < 64; sft <<= 1) {
#pragma unroll
                        for (int u = 0; u < 4; ++u) a4[u] += __shfl_xor(a4[u], sft); }
#pragma unroll
                    for (int u = 0; u < 4; ++u) mylg = (lane == o4 + u) ? a4[u] : mylg; }
                mylg += lane < 4 ? rgb[lane & 3] : (lane < 36 ? reb[(lane - 4) & 31] : 0.f);
                float gl[4]; float gm = -INFINITY; int gs = 0;
#pragma unroll
                for (int o = 0; o < 4; ++o) { gl[o] = __shfl(mylg, o); if (gl[o] > gm) { gm = gl[o]; gs = o; } }
                float gden = 0.f;
#pragma unroll
                for (int o = 0; o < 4; ++o) gden += __expf(gl[o] - gm);
                const float pg = 1.f / gden;
                float el[8];
#pragma unroll
                for (int o = 0; o < 8; ++o) el[o] = __shfl(mylg, 4 + gs * 8 + o);
                int e1 = 0; float m1 = el[0];
#pragma unroll
                for (int o = 1; o < 8; ++o) if (el[o] > m1) { m1 = el[o]; e1 = o; }
                int e2 = -1; float m2 = -INFINITY;
#pragma unroll
                for (int o = 0; o < 8; ++o) if (o != e1 && el[o] > m2) { m2 = el[o]; e2 = o; }
                const float r2 = __expf(m2 - m1); const float ga = pg / (1.f + r2), gb = pg * r2 / (1.f + r2);
                if (lane == 0) {
                    const int E1 = gs * 8 + e1, E2 = gs * 8 + e2;
                    tok_e[m * 2] = E1; tok_e[m * 2 + 1] = E2; tok_g[m * 2] = ga; tok_g[m * 2 + 1] = gb;
                    tok_rank[m * 2] = atomicAdd(&cnt[E1], 1); tok_rank[m * 2 + 1] = atomicAdd(&cnt[E2], 1);
                }
            }
        }
        else if constexpr (SP == 14) {
            LAS float* scr = (LAS float*)(lds + wave * 16384);
            const float* eg = INP(I_EG) + (size_t)l * NEXP * 1024 * 512; const float* eu = INP(I_EU) + (size_t)l * NEXP * 1024 * 512; const float* ed = INP(I_ED) + (size_t)l * NEXP * 512 * 1024;
            for (int it = gw; it < NEXP * 2 * 4 * 64; it += NGW) {
                const int e = it / 512, r = it % 512, half = r / 256, ct = (r % 256) / 64, q = r % 64, kb = q / 4, nb = q % 4;
                const float* W = (half ? eu : eg) + (size_t)e * 1024 * 512;
                transpose_item(W, 512, ct * 128, 128, WGU + (size_t)e * 1024 * 1024, 1024, ct * 256 + half * 128, 0, kb, nb, scr, lane);
            }
            for (int it = gw; it < NEXP * 8 * 32; it += NGW) {
                const int e = it / 256, q = it % 256, kb = q / 32, nb = q % 32;
                transpose_item(ed + (size_t)e * 512 * 1024, 1024, 0, 1024, WD + (size_t)e * 1024 * 512, 512, 0, 0, kb, nb, scr, lane);
            }
        }
        else if constexpr (SP == 8 || SP == 9 || SP == 10) {
            unsigned tbo = MISC_OFF; asm volatile("" : "+v"(tbo));
            volatile LAS int* tb = (volatile LAS int*)(lds + tbo);
            if (tid == 0) { int acc = 0; for (int e = 0; e < 32; ++e) { const int c = __hip_atomic_load(&cnt[e], __ATOMIC_RELAXED, __HIP_MEMORY_SCOPE_AGENT); tb[e] = acc; tb[33 + e] = acc; acc += (c + 255) >> 8; } tb[32] = acc; }
            __syncthreads();
            if constexpr (SP == 8) {
                for (int m = gw; m < M; m += NGW) {
#pragma unroll
                    for (int k = 0; k < 2; ++k) { const int e = tok_e[m * 2 + k]; const int slot = tb[33 + e] * 256 + tok_rank[m * 2 + k];
                        const u32x4* src = (const u32x4*)(XB + (size_t)m * D); u32x4* dst = (u32x4*)(XS + (size_t)slot * D);
                        dst[lane] = src[lane]; dst[lane + 64] = src[lane + 64];
                        if (lane == 0) tok_slot[m * 2 + k] = slot; }
                }
            } else if constexpr (SP == 9) {
                pg8::Gemm g{XS, WGU, 1024, 1024, 1024}; MoeOrder S{tb, G, bid, (size_t)1024 * 2, (size_t)1024 * 1024 * 2, (size_t)256 * 1024 * 2};
                EpiSwiglu E{HB};
                pg8::gemm_phase<EpiSwiglu, MoeOrder>(lds, g, S, E);
            } else {
                pg8::Gemm g{HB, WD, 512, 512, 512}; MoeOrder S{tb, G, bid, (size_t)512 * 2, (size_t)1024 * 512 * 2, (size_t)256 * 512 * 2};
                EpiStoreBf16 E{XS, 1024, 0, 1024};
                pg8::gemm_phase<EpiStoreBf16, MoeOrder>(lds, g, S, E);
            }
        }
        else if constexpr (SP == 11) {
            const float* g2 = INP(I_LN2G) + l * 1024; const float* b2 = INP(I_LN2B) + l * 1024;
            f32x4 xn[4]; u32x2 y1n[4], y2n[4]; float gan, gbn;
#define LN2_LOAD(mm) do { const int s1_ = tok_slot[(mm) * 2], s2_ = tok_slot[(mm) * 2 + 1]; gan = tok_g[(mm) * 2]; gbn = tok_g[(mm) * 2 + 1]; \
                _Pragma("unroll") for (int j = 0; j < 4; ++j) { xn[j] = ((const f32x4*)(X + (size_t)(mm) * D))[lane + 64 * j]; y1n[j] = ((const u32x2*)(XS + (size_t)s1_ * D))[lane + 64 * j]; y2n[j] = ((const u32x2*)(XS + (size_t)s2_ * D))[lane + 64 * j]; } } while (0)
            LN2_LOAD(gw);
#pragma unroll 1
            for (int m = gw; m < M; m += NGW) {
                const float ga = gan, gb = gbn;
                f32x4 v[4]; float s = 0.f; f32x4* xr = (f32x4*)(X + (size_t)m * D) + lane;
                u32x2 y1c[4], y2c[4];
#pragma unroll
                for (int j = 0; j < 4; ++j) { v[j] = xn[j] * ALPHA; y1c[j] = y1n[j]; y2c[j] = y2n[j]; }
                { const int mnx = (m + NGW < M) ? m + NGW : m; LN2_LOAD(mnx); }
#pragma unroll
                for (int j = 0; j < 4; ++j) { const u32x2 y1 = y1c[j], y2 = y2c[j];
                    v[j][0] += ga * __uint_as_float(y1.x << 16) + gb * __uint_as_float(y2.x << 16); v[j][1] += ga * __uint_as_float(y1.x & 0xffff0000u) + gb * __uint_as_float(y2.x & 0xffff0000u);
                    v[j][2] += ga * __uint_as_float(y1.y << 16) + gb * __uint_as_float(y2.y << 16); v[j][3] += ga * __uint_as_float(y1.y & 0xffff0000u) + gb * __uint_as_float(y2.y & 0xffff0000u);
                    s += (v[j][0] + v[j][1]) + (v[j][2] + v[j][3]); }
                const float mean = wave_sum(s) * (1.f / D); float s2 = 0.f;
#pragma unroll
                for (int j = 0; j < 4; ++j) { v[j] = v[j] - mean; s2 += (v[j][0] * v[j][0] + v[j][1] * v[j][1]) + (v[j][2] * v[j][2] + v[j][3] * v[j][3]); }
                const float rstd = rsqrtf(wave_sum(s2) * (1.f / D) + LN_EPS);
#pragma unroll
                for (int j = 0; j < 4; ++j) { const f32x4 gg = ((const f32x4*)g2)[lane + 64 * j], bb = ((const f32x4*)b2)[lane + 64 * j]; v[j] = v[j] * rstd * gg + bb; xr[64 * j] = v[j];
                    u32x2 w; w.x = pk2(v[j][0], v[j][1]); w.y = pk2(v[j][2], v[j][3]); ((u32x2*)(XB + (size_t)m * D))[lane + 64 * j] = w; }
            }
        }
    }
}

template <int SP>
__global__ void __launch_bounds__(NTHR, 2) k_phase(Args args, int l) {
    extern __shared__ __attribute__((aligned(16))) unsigned char lds_raw[];
    ptr_table_fill(args, (LAS unsigned char*)lds_raw);
    phase_body<SP>(l, (LAS unsigned char*)lds_raw);
}


#define XB_TMO      128
#define XB_XCNT(j)  (256  + 64 * (j))
#define XB_XSUB(j)  (1280 + 64 * (j))
#define XB_XGEN(j)  (2304 + 64 * (j))
#define XB_TOP      3328
#define XB_TOPGEN   3392
#define XCD_BAR_WORDS 3456
#define XB_SPIN_CAP (1u << 22)
__device__ __forceinline__ unsigned xb_ld(unsigned* p)              { return __hip_atomic_load(p, __ATOMIC_RELAXED, __HIP_MEMORY_SCOPE_AGENT); }
__device__ __forceinline__ unsigned xb_add(unsigned* p, unsigned v) { return __hip_atomic_fetch_add(p, v, __ATOMIC_RELAXED, __HIP_MEMORY_SCOPE_AGENT); }
__device__ __forceinline__ unsigned xb_xcc_id() { return (unsigned)__builtin_amdgcn_s_getreg((3 << 11) | 20) & 0xFu; }
#define XB_SPIN(cond, bar) do { unsigned _sp = 0; while (cond) { __builtin_amdgcn_s_sleep(1); \
    if ((++_sp & 255u) == 0u) { if (xb_ld(&(bar)[XB_TMO])) break; if (_sp > XB_SPIN_CAP) { atomicAdd(&(bar)[XB_TMO], 1u); break; } } } } while (0)
__device__ __forceinline__ void xcd_barrier_complete(unsigned* bar, unsigned x, unsigned& nloc, unsigned& nx) {
    const unsigned G = gridDim.x;
    unsigned sum, cnt, mine, sp = 0u;
    for (;;) {
        sum = 0u; cnt = 0u; mine = 0u;
#pragma unroll
        for (unsigned j = 0; j < 16; ++j) { const unsigned c = xb_ld(&bar[XB_XCNT(j)]); sum += c; cnt += (c > 0u) ? 1u : 0u; mine = (j == x) ? c : mine; }
        if (sum == G) break;
        __builtin_amdgcn_s_sleep(1);
        if ((++sp & 255u) == 0u) { if (xb_ld(&bar[XB_TMO])) break; if (sp > XB_SPIN_CAP) { atomicAdd(&bar[XB_TMO], 1u); break; } }
    }
    nloc = mine > 0u ? mine : 1u; nx = cnt > 0u ? cnt : 1u;
}
__device__ __forceinline__ void xcd_barrier(unsigned* bar, LAS unsigned char* lds) {
    asm volatile("s_waitcnt vmcnt(0)" ::: "memory");
    __syncthreads();
    int tid_ = threadIdx.x; asm volatile("" : "+v"(tid_));
    if (tid_ == 0) {
        unsigned so = (unsigned)(LDS_BYTES - 576); asm volatile("" : "+v"(so));
        volatile LAS unsigned* st = (volatile LAS unsigned*)(lds + so);
        __builtin_amdgcn_s_waitcnt(0);
        const unsigned x = xb_xcc_id();
        unsigned nloc = st[0], nx = st[1];
        if (nloc == 0u) { xcd_barrier_complete(bar, x, nloc, nx); st[0] = nloc; st[1] = nx; }
        const unsigned old = xb_add(&bar[XB_XSUB(x)], 1u);
        const unsigned gen = old / nloc;
        if (old + 1u == (gen + 1u) * nloc) {
            __builtin_amdgcn_fence(__ATOMIC_RELEASE, "agent");
            asm volatile("s_waitcnt vmcnt(0)" ::: "memory");
            const unsigned og = xb_add(&bar[XB_TOP], 1u);
            const unsigned tg = og / nx;
            if (og + 1u == (tg + 1u) * nx) xb_add(&bar[XB_TOPGEN], 1u);
            else XB_SPIN(xb_ld(&bar[XB_TOPGEN]) == tg, bar);
            __builtin_amdgcn_fence(__ATOMIC_ACQUIRE, "agent");
            xb_add(&bar[XB_XGEN(x)], 1u);
            asm volatile("s_waitcnt vmcnt(0)" ::: "memory");
        } else {
            XB_SPIN(xb_ld(&bar[XB_XGEN(x)]) == gen, bar);
            __builtin_amdgcn_fence(__ATOMIC_ACQUIRE, "agent");
            asm volatile("s_waitcnt vmcnt(0)" ::: "memory");
        }
    }
    __syncthreads();
}
namespace cg = cooperative_groups;
__global__ void __launch_bounds__(NTHR, 2) fwd_all(Args args) {
    extern __shared__ __attribute__((aligned(16))) unsigned char lds_raw[];
    LAS unsigned char* lds = (LAS unsigned char*)lds_raw;
    unsigned* bar = (unsigned*)(args.ws + WS_CTL) + CW_BAR;
    if (threadIdx.x == 0) { ((volatile LAS unsigned*)(lds + LDS_BYTES - 576))[0] = 0u; ((volatile LAS unsigned*)(lds + LDS_BYTES - 576))[1] = 0u; (void)xb_add(&bar[XB_XCNT(xb_xcc_id())], 1u); }
    ptr_table_fill(args, lds);
    const int probe = args.ph_lo;
    { constexpr int l = 0;
#pragma unroll 1
      for (int r_ = 0; r_ < ((probe == -1) ? 2 : 1); ++r_) { phase_body<-1>(l, lds); __syncthreads(); } }
    cg::this_grid().sync();
#define GRID_BAR() do { unsigned* bar_ = (unsigned*)gptr(ldptr(lds, 36)) + CW_BAR; xcd_barrier(bar_, lds); } while (0)
#define RUN(SP) do { _Pragma("unroll 1") for (int r_ = 0; r_ < ((probe == (SP)) ? 2 : 1); ++r_) { phase_body<SP>(l, lds); __syncthreads(); } } while (0)
#define ONCE(SP) do { phase_body<SP>(l, lds); __syncthreads(); } while (0)
#define LAYER() \
        RUN(0); GRID_BAR(); \
        ONCE(15); GRID_BAR(); \
        ONCE(12); GRID_BAR(); \
        RUN(13); GRID_BAR(); \
        RUN(4); GRID_BAR(); \
        RUN(5); GRID_BAR(); \
        ONCE(6); GRID_BAR(); \
        ONCE(7); RUN(14); GRID_BAR(); \
        RUN(8); GRID_BAR(); \
        RUN(9); GRID_BAR(); \
        RUN(10); GRID_BAR(); \
        ONCE(11); GRID_BAR();
    { constexpr int l = 0; LAYER() }
    { constexpr int l = 1; LAYER() }
#undef LAYER
#undef RUN
#undef ONCE
#undef GRID_BAR
}

template <int SP> static void launch_phase(const Args& a, int l, int grid, hipStream_t stream) {
    static bool attr = false;
    if (!attr) { (void)hipFuncSetAttribute((const void*)k_phase<SP>, hipFuncAttributeMaxDynamicSharedMemorySize, LDS_BYTES); attr = true; }
    hipLaunchKernelGGL(k_phase<SP>, dim3(grid), dim3(NTHR), LDS_BYTES, stream, a, l);
}

extern "C" void kernel_launch(void* const* d_in, const int* in_sizes, int n_in, void* d_out, int out_size, void* d_ws, size_t ws_size, hipStream_t stream) {
    static int grid = 0;
    if (grid == 0) {
        if (n_in != 35 || out_size != M * D || ws_size < WS_END) { fprintf(stderr, "kernel_launch: unexpected problem (n_in %d out %d ws %zu)\n", n_in, out_size, ws_size); grid = -1; return; }
        int dev = 0, cus = 0, per_cu = 0;
        (void)hipGetDevice(&dev); (void)hipDeviceGetAttribute(&cus, hipDeviceAttributeMultiprocessorCount, dev);
#if N_LAUNCH_MODE == 1
        (void)hipFuncSetAttribute((const void*)fwd_all, hipFuncAttributeMaxDynamicSharedMemorySize, LDS_BYTES);
        if (hipOccupancyMaxActiveBlocksPerMultiprocessor(&per_cu, (const void*)fwd_all, NTHR, LDS_BYTES) != hipSuccess || per_cu < 1) { fprintf(stderr, "kernel_launch: occupancy query says %d blocks/CU\n", per_cu); grid = -1; return; }
#endif
        (void)per_cu;
        grid = cus;
        if (grid != 256) { fprintf(stderr, "kernel_launch: built for 256 CUs, found %d\n", cus); grid = -1; return; }
    }
    if (grid < 0) return;
    (void)hipMemsetAsync((char*)d_ws + WS_CTL, 0, CTL_BYTES, stream);
    Args a{};
    for (int i = 0; i < 35; ++i) a.in[i] = (const float*)d_in[i];
    a.out = (float*)d_out; a.ws = (unsigned char*)d_ws;
#if N_LAUNCH_MODE == 1
    a.ph_lo = PROBE_REPS;
    void* kargs[] = {(void*)&a};
    hipError_t e = hipLaunchCooperativeKernel((const void*)fwd_all, dim3(grid), dim3(NTHR), kargs, LDS_BYTES, stream);
    if (e != hipSuccess) fprintf(stderr, "cooperative launch failed: %s\n", hipGetErrorString(e));
#else
    launch_phase<-1>(a, 0, grid, stream);
    for (int l = 0; l < NL; ++l) {
        launch_phase<0>(a, l, grid, stream); launch_phase<15>(a, l, grid, stream); launch_phase<12>(a, l, grid, stream); launch_phase<13>(a, l, grid, stream);
        launch_phase<4>(a, l, grid, stream); launch_phase<5>(a, l, grid, stream); launch_phase<6>(a, l, grid, stream); launch_phase<7>(a, l, grid, stream); launch_phase<14>(a, l, grid, stream);
        launch_phase<8>(a, l, grid, stream); launch_phase<9>(a, l, grid, stream); launch_phase<10>(a, l, grid, stream); launch_phase<11>(a, l, grid, stream);
    }
#endif
}
```

```cpp
#include <hip/hip_runtime.h>
#include <cstdio>
#include <cstdint>
#include <hip/hip_cooperative_groups.h>

#ifndef PROBE_REPS
#define PROBE_REPS -100
#endif
#ifndef N_LAUNCH_MODE
#define N_LAUNCH_MODE 1
#endif

namespace pg8 {
#define PG8_LAS __attribute__((address_space(3)))
typedef unsigned short bf16_t;
typedef short bf16x8 __attribute__((ext_vector_type(8)));
typedef float f32x4 __attribute__((ext_vector_type(4)));
typedef unsigned u32x4 __attribute__((ext_vector_type(4)));
constexpr int BM = 256, BK = 64, HALF = 128, HTB = HALF * BK * 2, STAGE_BYTES = 8 * HTB, NXCD = 8, WGM = 8;

__host__ __device__ __forceinline__ int lds_byte(int r, int c) { const int st = (r >> 4) * 2 + (c >> 5), rr = r & 15, cc = c & 31, ob = rr * 64 + cc * 2; return st * 1024 + (ob ^ (((ob >> 9) & 1) << 5)); }
__host__ __device__ __forceinline__ void stage_rc(int b, int& R, int& C) { const int st = b / 1024, sb = b % 1024, swz = sb ^ (((sb >> 9) & 1) << 5); R = (st >> 1) * 16 + swz / 64; C = (st & 1) * 32 + (swz % 64) / 2; }
__host__ __device__ __forceinline__ int perm32(int rho) { const int n = rho >> 4, i = rho & 15; return 8 * (i >> 2) + 4 * n + (i & 3); }

struct Unit { int pm, pn, aux; size_t aoff, boff; };
struct Gemm { const bf16_t* A; const bf16_t* Bt; int lda, ldb, K; };

__device__ __forceinline__ void tile_of(int L, int nM, int nN, int& pm, int& pn) {
    const int nwg = nM * nN; int wgid = L;
    { const int q = nwg / NXCD, r = nwg % NXCD, xcd = wgid % NXCD, off = wgid / NXCD; wgid = (xcd < r ? xcd * (q + 1) : r * (q + 1) + (xcd - r) * q) + off; }
    const int nig = WGM * nN, gid = wgid / nig, fm = gid * WGM, gsz = (nM - fm) < WGM ? (nM - fm) : WGM;
    pm = fm + ((wgid % nig) % gsz); pn = (wgid % nig) / gsz;
}
struct StaticOrder {
    int nM, nN, nwg, G, c, lda, ldb;
    __device__ void init(int M, int N, int G_, int c_, int lda_, int ldb_) { nM = M / BM; nN = N / BM; nwg = nM * nN; G = G_; c = c_; lda = lda_; ldb = ldb_; }
    __device__ bool next(int i, Unit& u) const {
        const long L = (long)i * G + c; if (L >= nwg) return false;
        tile_of((int)L, nM, nN, u.pm, u.pn); u.aux = 0;
        u.aoff = (size_t)u.pm * BM * lda * 2; u.boff = (size_t)u.pn * BM * ldb * 2; return true;
    }
};

__device__ __forceinline__ unsigned cvt_pk_bf16(float lo, float hi) { unsigned r; asm volatile("v_cvt_pk_bf16_f32 %0, %1, %2" : "=v"(r) : "v"(lo), "v"(hi)); return r; }

template <class Epi, class Sched, bool ALIGN_EPI = true, bool SP2 = true>
__device__ __forceinline__ void gemm_phase(PG8_LAS unsigned char* lds, const Gemm g, const Sched& S, const Epi& E) {
    int tid_ = threadIdx.x; asm volatile("" : "+v"(tid_));
    const int tid = tid_, wid = __builtin_amdgcn_readfirstlane(tid >> 6), lane = tid & 63, wr = wid >> 2, wc = wid & 3, fr = lane & 15, fq = lane >> 4;
    const int K = g.K, nt = K / BK;
    unsigned voffA[2], voffB[2];
#pragma unroll
    for (int i = 0; i < 2; ++i) { int R, C; stage_rc(tid * 16 + i * 8192, R, C); const int Rb = Epi::PERM ? ((R & ~31) + perm32(R & 31)) : R;
        voffA[i] = (unsigned)(R * g.lda + C) * 2u; voffB[i] = (unsigned)(Rb * g.ldb + C) * 2u; }
    const size_t kstep = (size_t)(BK * 2);
    const size_t hstepA = (size_t)HALF * g.lda * 2, hstepB = (size_t)HALF * g.ldb * 2;
    const unsigned ldsw = (unsigned)wid * 1024u;
    const int aoff = lds_byte(wr * 64 + fr, fq * 8), boff = lds_byte(wc * 32 + fr, fq * 8);
#define PG8_SA(b, h) (((b) * 2 + (h)) * HTB)
#define PG8_SB(b, h) ((4 + (b) * 2 + (h)) * HTB)
#define PG8_STAGE(bufoff, gbase, voff) do { _Pragma("unroll") for (int _i = 0; _i < 2; ++_i) \
        __builtin_amdgcn_global_load_lds((const unsigned*)((const char*)(gbase) + (voff)[_i]), (PG8_LAS unsigned*)(lds + (bufoff) + ldsw + _i * 8192), 16, 0, 0); } while (0)
#define PG8_LDA(dst, b, h) do { _Pragma("unroll") for (int m = 0; m < 4; ++m) _Pragma("unroll") for (int k = 0; k < 2; ++k) dst[m][k] = *(const PG8_LAS bf16x8*)(lds + PG8_SA(b, h) + aoff + m * 2048 + k * 1024); } while (0)
#define PG8_LDB(dst, b, h) do { _Pragma("unroll") for (int n = 0; n < 2; ++n) _Pragma("unroll") for (int k = 0; k < 2; ++k) dst[n][k] = *(const PG8_LAS bf16x8*)(lds + PG8_SB(b, h) + boff + n * 2048 + k * 1024); } while (0)
#define PG8_MMA(ai, bj, At, Bt) do { __builtin_amdgcn_s_setprio(1); _Pragma("unroll") for (int m = 0; m < 4; ++m) _Pragma("unroll") for (int n = 0; n < 2; ++n) _Pragma("unroll") for (int k = 0; k < 2; ++k) \
        acc[ai][bj][m][n] = __builtin_amdgcn_mfma_f32_16x16x32_bf16(Bt[n][k], At[m][k], acc[ai][bj][m][n], 0, 0, 0); __builtin_amdgcn_s_setprio(0); } while (0)
#define PG8_WAIT_V(n) asm volatile("s_waitcnt vmcnt(" #n ")" ::: "memory")
#define PG8_WAIT_L(n) asm volatile("s_waitcnt lgkmcnt(" #n ")" ::: "memory")
#define PG8_BAR __builtin_amdgcn_s_barrier()
#define PG8_SCHED __builtin_amdgcn_sched_barrier(0)
    Unit cur, nxt; int ui = 0;
    if (!S.next(0, cur)) return;
    f32x4 acc[2][2][4][2];
#pragma unroll
    for (int a = 0; a < 2; ++a)
#pragma unroll
        for (int b = 0; b < 2; ++b)
#pragma unroll
            for (int m = 0; m < 4; ++m)
#pragma unroll
                for (int n = 0; n < 2; ++n) acc[a][b][m][n] = (f32x4){0.f, 0.f, 0.f, 0.f};
    bf16x8 At[4][2], B0[2][2], B1[2][2];
    const char* cA = (const char*)g.A + cur.aoff; const char* cB = (const char*)g.Bt + cur.boff;
    if constexpr (SP2) {
        PG8_STAGE(PG8_SB(0, 0), cB, voffB); PG8_STAGE(PG8_SB(0, 1), cB + hstepB, voffB); PG8_STAGE(PG8_SA(0, 0), cA, voffA); PG8_STAGE(PG8_SA(0, 1), cA + hstepA, voffA);
        if (wr == 1) PG8_BAR;
        PG8_WAIT_V(2); PG8_BAR;
        PG8_STAGE(PG8_SB(1, 0), cB + kstep, voffB); PG8_STAGE(PG8_SA(1, 0), cA + kstep, voffA); PG8_STAGE(PG8_SB(1, 1), cB + hstepB + kstep, voffB);
        PG8_WAIT_V(6); PG8_BAR;
    } else {
        PG8_STAGE(PG8_SB(0, 0), cB, voffB); PG8_STAGE(PG8_SA(0, 0), cA, voffA); PG8_STAGE(PG8_SB(0, 1), cB + hstepB, voffB); PG8_STAGE(PG8_SA(0, 1), cA + hstepA, voffA);
        if (wr == 1) PG8_BAR;
        PG8_WAIT_V(4); PG8_BAR;
        PG8_STAGE(PG8_SB(1, 0), cB + kstep, voffB); PG8_STAGE(PG8_SA(1, 0), cA + kstep, voffA); PG8_STAGE(PG8_SB(1, 1), cB + hstepB + kstep, voffB);
        PG8_WAIT_V(6); PG8_BAR;
    }
    for (;;) {
        const bool has_next = S.next(ui + 1, nxt);
        const char* nA = has_next ? (const char*)g.A + nxt.aoff : cA; const char* nB = has_next ? (const char*)g.Bt + nxt.boff : cB;
#pragma unroll 1
        for (int t = 0; t < nt; t += 2) {
            const bool last = (t == nt - 2);
            const char* a1 = cA + (size_t)(t + 1) * kstep;
            const char* a2 = last ? nA : cA + (size_t)(t + 2) * kstep; const char* b2 = last ? nB : cB + (size_t)(t + 2) * kstep;
            const char* a3 = a2 + kstep; const char* b3 = b2 + kstep;
            if constexpr (SP2) {
            PG8_LDB(B0, 0, 0); PG8_LDB(B1, 0, 1); PG8_SCHED; PG8_LDA(At, 0, 0); PG8_STAGE(PG8_SA(1, 1), a1 + hstepA, voffA);
            PG8_WAIT_V(8); PG8_WAIT_L(0); PG8_BAR; PG8_MMA(0, 0, At, B0); PG8_MMA(0, 1, At, B1); PG8_BAR; PG8_SCHED;
            PG8_LDA(At, 0, 1); PG8_STAGE(PG8_SB(0, 0), b2, voffB); PG8_STAGE(PG8_SB(0, 1), b2 + hstepB, voffB); PG8_STAGE(PG8_SA(0, 0), a2, voffA);
            PG8_WAIT_V(8); PG8_WAIT_L(0); PG8_BAR; PG8_MMA(1, 0, At, B0); PG8_MMA(1, 1, At, B1); PG8_BAR; PG8_SCHED;
            PG8_LDB(B0, 1, 0); PG8_LDB(B1, 1, 1); PG8_SCHED; PG8_LDA(At, 1, 0); PG8_STAGE(PG8_SA(0, 1), a2 + hstepA, voffA);
            PG8_WAIT_V(8); PG8_WAIT_L(0); PG8_BAR; PG8_MMA(0, 0, At, B0); PG8_MMA(0, 1, At, B1); PG8_BAR; PG8_SCHED;
            PG8_LDA(At, 1, 1); PG8_STAGE(PG8_SB(1, 0), b3, voffB); PG8_STAGE(PG8_SB(1, 1), b3 + hstepB, voffB); PG8_STAGE(PG8_SA(1, 0), a3, voffA);
            PG8_WAIT_V(8); PG8_WAIT_L(0); PG8_BAR; PG8_MMA(1, 0, At, B0); PG8_MMA(1, 1, At, B1); PG8_BAR; PG8_SCHED;
            } else {
            PG8_LDB(B0, 0, 0); PG8_SCHED; PG8_LDA(At, 0, 0); PG8_STAGE(PG8_SA(1, 1), a1 + hstepA, voffA);
            PG8_WAIT_L(8); PG8_BAR; PG8_WAIT_L(0); PG8_MMA(0, 0, At, B0); PG8_BAR; PG8_SCHED;
            PG8_LDB(B1, 0, 1); PG8_STAGE(PG8_SB(0, 0), b2, voffB);
            PG8_BAR; PG8_WAIT_L(0); PG8_MMA(0, 1, At, B1); PG8_BAR;
            PG8_LDA(At, 0, 1); PG8_STAGE(PG8_SA(0, 0), a2, voffA);
            PG8_BAR; PG8_WAIT_L(0); PG8_MMA(1, 0, At, B0); PG8_BAR; PG8_SCHED;
            PG8_STAGE(PG8_SB(0, 1), b2 + hstepB, voffB);
            PG8_WAIT_V(6); PG8_BAR; PG8_MMA(1, 1, At, B1); PG8_BAR;
            PG8_LDB(B0, 1, 0); PG8_SCHED; PG8_LDA(At, 1, 0); PG8_STAGE(PG8_SA(0, 1), a2 + hstepA, voffA);
            PG8_WAIT_L(8); PG8_BAR; PG8_WAIT_L(0); PG8_MMA(0, 0, At, B0); PG8_BAR; PG8_SCHED;
            PG8_LDB(B1, 1, 1); PG8_STAGE(PG8_SB(1, 0), b3, voffB);
            PG8_BAR; PG8_WAIT_L(0); PG8_MMA(0, 1, At, B1); PG8_BAR;
            PG8_LDA(At, 1, 1); PG8_STAGE(PG8_SA(1, 0), a3, voffA);
            PG8_BAR; PG8_WAIT_L(0); PG8_MMA(1, 0, At, B0); PG8_BAR; PG8_SCHED;
            PG8_STAGE(PG8_SB(1, 1), b3 + hstepB, voffB);
            PG8_WAIT_V(6); PG8_BAR; PG8_MMA(1, 1, At, B1); PG8_BAR;
            }
        }
        if constexpr (ALIGN_EPI) { if (wr == 0) PG8_BAR; }
        E(acc, cur, wr, wc, fr, fq);
        if (!has_next) break;
#pragma unroll
        for (int a = 0; a < 2; ++a)
#pragma unroll
            for (int b = 0; b < 2; ++b)
#pragma unroll
                for (int m = 0; m < 4; ++m)
#pragma unroll
                    for (int n = 0; n < 2; ++n) acc[a][b][m][n] = (f32x4){0.f, 0.f, 0.f, 0.f};
        cur = nxt; cA = nA; cB = nB; ++ui;
        if constexpr (ALIGN_EPI) { if (wr == 1) PG8_BAR; }
    }
    PG8_WAIT_V(0);
    if constexpr (!ALIGN_EPI) { if (wr == 0) PG8_BAR; }
    PG8_BAR;
#undef PG8_SA
#undef PG8_SB
#undef PG8_STAGE
#undef PG8_LDA
#undef PG8_LDB
#undef PG8_MMA
#undef PG8_WAIT_V
#undef PG8_WAIT_L
#undef PG8_BAR
#undef PG8_SCHED
}
}

#define LAS __attribute__((address_space(3)))
typedef unsigned short bf16;
typedef float f32x4 __attribute__((ext_vector_type(4)));
typedef unsigned u32x4 __attribute__((ext_vector_type(4)));
typedef unsigned u32x2 __attribute__((ext_vector_type(2)));

constexpr int NB = 8, T = 4096, D = 1024, M = NB * T, NL = 2;
constexpr int INW = 9160;
constexpr int PP = 5120;
constexpr int C_AQ = 0, C_AK = 768, C_AV = 1536, C_BQ = 2304, C_BK = 2560, C_BV = 2816, C_IQ = 3072, C_IK = 3328, C_C = 3392, C_DZ = 4288, C_DX = 4544, C_IW = 5056, C_DT = 5060, C_END = 5064;
constexpr int NEXP = 32, DEXP = 512;
constexpr int CAP = 73728;
constexpr float LN_EPS = 1e-5f;
constexpr float ALPHA = 1.4142135623730951f;

constexpr size_t MiB = 1u << 20;
constexpr size_t WS_CTL = 0, CTL_BYTES = 1 * MiB;
constexpr size_t WS_WINT = 2 * MiB;
constexpr size_t WS_WGT = 22 * MiB;
constexpr size_t WS_WBRT = 38 * MiB;
constexpr size_t WS_WOUTT = 42 * MiB;
constexpr size_t WS_WRT = 46 * MiB;
constexpr size_t WS_ROUTE = 47 * MiB;
constexpr size_t WS_XB = 48 * MiB;
constexpr size_t WS_O = 112 * MiB;
constexpr size_t WS_VF = 176 * MiB;
constexpr size_t WS_P = 192 * MiB;
constexpr size_t WS_GS = 192 * MiB;
constexpr size_t WS_MERGED = 448 * MiB;
constexpr size_t WS_XS = 192 * MiB;
constexpr size_t WS_H = 336 * MiB;
constexpr size_t WS_WGU = 408 * MiB;
constexpr size_t WS_WD = 472 * MiB;
constexpr size_t WS_RW = 512 * MiB;
constexpr size_t WS_RW2 = 544 * MiB;
constexpr size_t WS_BONG = 46 * MiB + 512 * 1024;
constexpr size_t WS_END = 592 * MiB;
constexpr int CW_CNT = 64, CW_Q = 256, CW_BAR = 4096;

constexpr int RING_BYTES = 131072, MISC_OFF = RING_BYTES, LDS_BYTES = 147456;
constexpr int NWAVES = 8, NTHR = 512;

__device__ __forceinline__ float bf2f(bf16 v) { return __uint_as_float(((unsigned)v) << 16); }
__device__ __forceinline__ unsigned f2bf(float f) { unsigned u = __float_as_uint(f); return (u + 0x7fffu + ((u >> 16) & 1u)) >> 16; }
__device__ __forceinline__ unsigned pk2(float lo, float hi) { return f2bf(lo) | (f2bf(hi) << 16); }
__device__ __forceinline__ float wave_sum(float v) {
#pragma unroll
    for (int o = 1; o < 64; o <<= 1) v += __shfl_xor(v, o);
    return v;
}
__device__ __forceinline__ float wave_max(float v) {
#pragma unroll
    for (int o = 1; o < 64; o <<= 1) v = fmaxf(v, __shfl_xor(v, o));
    return v;
}
__device__ __forceinline__ float sigmoidf_(float x) { return 1.f / (1.f + __expf(-x)); }
__device__ __forceinline__ float softplusf_(float x) { return x > 20.f ? x : log1pf(__expf(x)); }
__device__ __forceinline__ float siluf_(float x) { return x / (1.f + __expf(-x)); }

struct Args { const float* in[35]; float* out; unsigned char* ws; int ph_lo, ph_hi; };
enum { I_X = 0, I_WIN, I_CMU, I_CW0, I_CW2, I_CA0, I_CA2, I_CG2, I_CKK, I_CKA, I_CRK, I_CGNW, I_CGNB, I_CV0, I_CV1, I_CV2, I_DCW, I_DCB, I_DDTB, I_DALOG, I_DSKIP, I_DNW,
       I_WBR, I_WOUT, I_LN1G, I_LN1B, I_RG, I_RGB, I_RE, I_REB, I_EG, I_EU, I_ED, I_LN2G, I_LN2B };

__device__ __forceinline__ void transpose_item(const float* W, int ldn, int c0, int ncols, bf16* dst, int dld, int r0, int dk0, int kb, int nb, LAS float* scr, int lane) {
    const int k0 = 64 * kb, n0 = 32 * nb;
    const bool okn = (n0 + (lane & 31)) < ncols;
    float tv[32];
#pragma unroll
    for (int i = 0; i < 32; ++i) { const int kk = 2 * i + (lane >> 5); tv[i] = okn ? W[(size_t)(k0 + kk) * ldn + c0 + n0 + (lane & 31)] : 0.f; }
#pragma unroll
    for (int i = 0; i < 32; ++i) { const int kk = 2 * i + (lane >> 5); scr[kk * 33 + (lane & 31)] = tv[i]; }
    asm volatile("s_waitcnt lgkmcnt(0)" ::: "memory");
    const int c = lane & 7;
#pragma unroll
    for (int j = 0; j < 4; ++j) { const int n = (lane >> 3) + 8 * j; const LAS float* s = scr + (8 * c) * 33 + n;
        u32x4 o; o.x = pk2(s[0 * 33], s[1 * 33]); o.y = pk2(s[2 * 33], s[3 * 33]); o.z = pk2(s[4 * 33], s[5 * 33]); o.w = pk2(s[6 * 33], s[7 * 33]);
        if (n0 + n < ncols) *(u32x4*)(dst + (size_t)(r0 + n0 + n) * dld + dk0 + k0 + 8 * c) = o; }
    asm volatile("s_waitcnt lgkmcnt(0)" ::: "memory");
}

struct EpiStoreBf16 {
    static constexpr bool PERM = true;
    bf16* O; int ldc; int act; int ncols;
    __device__ __forceinline__ void operator()(const pg8::f32x4 (&acc)[2][2][4][2], const pg8::Unit& u, int wr, int wc, int fr, int fq) const {
        const int row0 = u.pm * 256 + wr * 64 + fr; const int col0 = u.pn * 256 + wc * 32 + 8 * fq;
#pragma unroll
        for (int ai = 0; ai < 2; ++ai)
#pragma unroll
            for (int m = 0; m < 4; ++m) { bf16* rowp = O + (size_t)(row0 + ai * 128 + m * 16) * ldc + col0;
#pragma unroll
                for (int bj = 0; bj < 2; ++bj) { pg8::f32x4 v0 = acc[ai][bj][m][0], v1 = acc[ai][bj][m][1];
                    if (act == 1) {
#pragma unroll
                        for (int j = 0; j < 4; ++j) { v0[j] = sigmoidf_(v0[j]); v1[j] = sigmoidf_(v1[j]); } }
                    u32x4 w; w.x = pg8::cvt_pk_bf16(v0[0], v0[1]); w.y = pg8::cvt_pk_bf16(v0[2], v0[3]); w.z = pg8::cvt_pk_bf16(v1[0], v1[1]); w.w = pg8::cvt_pk_bf16(v1[2], v1[3]);
                    if (col0 + bj * 128 < ncols) *(u32x4*)(rowp + bj * 128) = w; } }
    }
};
struct EpiBranch {
    static constexpr bool PERM = true;
    const bf16* GS; bf16* MG;
    __device__ __forceinline__ void operator()(const pg8::f32x4 (&acc)[2][2][4][2], const pg8::Unit& u, int wr, int wc, int fr, int fq) const {
        const int n = u.aux;
        const bf16* gbase = GS + (size_t)(u.pm * 256 + wr * 64 + fr) * 4096 + n * 1024 + u.pn * 256 + wc * 32 + 8 * fq;
        bf16* mbase = MG + (size_t)(u.pm * 256 + wr * 64 + fr) * 1024 + u.pn * 256 + wc * 32 + 8 * fq;
#pragma unroll
        for (int ai = 0; ai < 2; ++ai)
#pragma unroll
            for (int m = 0; m < 4; ++m) {
#pragma unroll
                for (int bj = 0; bj < 2; ++bj) {
                    const u32x4 gv = *(const u32x4*)(gbase + (size_t)(ai * 128 + m * 16) * 4096 + bj * 128);
                    bf16* mp = mbase + (size_t)(ai * 128 + m * 16) * 1024 + bj * 128;
                    u32x4 ov = (u32x4){0u, 0u, 0u, 0u}; if (n != 0) ov = *(const u32x4*)mp;
                    const pg8::f32x4 a0 = acc[ai][bj][m][0], a1 = acc[ai][bj][m][1];
                    u32x4 w;
                    w.x = pg8::cvt_pk_bf16(a0[0] * __uint_as_float(gv.x << 16) + __uint_as_float(ov.x << 16), a0[1] * __uint_as_float(gv.x & 0xffff0000u) + __uint_as_float(ov.x & 0xffff0000u));
                    w.y = pg8::cvt_pk_bf16(a0[2] * __uint_as_float(gv.y << 16) + __uint_as_float(ov.y << 16), a0[3] * __uint_as_float(gv.y & 0xffff0000u) + __uint_as_float(ov.y & 0xffff0000u));
                    w.z = pg8::cvt_pk_bf16(a1[0] * __uint_as_float(gv.z << 16) + __uint_as_float(ov.z << 16), a1[1] * __uint_as_float(gv.z & 0xffff0000u) + __uint_as_float(ov.z & 0xffff0000u));
                    w.w = pg8::cvt_pk_bf16(a1[2] * __uint_as_float(gv.w << 16) + __uint_as_float(ov.w << 16), a1[3] * __uint_as_float(gv.w & 0xffff0000u) + __uint_as_float(ov.w & 0xffff0000u));
                    *(u32x4*)mp = w; asm volatile("" ::: "memory"); } }
    }
};
struct EpiResid {
    static constexpr bool PERM = false;
    float* X;
    __device__ __forceinline__ void operator()(const pg8::f32x4 (&acc)[2][2][4][2], const pg8::Unit& u, int wr, int wc, int fr, int fq) const {
        const int row0 = u.pm * 256 + wr * 64 + fr, col0 = u.pn * 256 + wc * 32 + 4 * fq;
#pragma unroll
        for (int ai = 0; ai < 2; ++ai)
#pragma unroll
            for (int m = 0; m < 4; ++m) { float* rowp = X + (size_t)(row0 + ai * 128 + m * 16) * D + col0;
#pragma unroll
                for (int bj = 0; bj < 2; ++bj)
#pragma unroll
                    for (int n = 0; n < 2; ++n) { pg8::f32x4* p = (pg8::f32x4*)(rowp + bj * 128 + n * 16); *p = *p * ALPHA + acc[ai][bj][m][n]; } }
    }
};
struct EpiSwiglu {
    static constexpr bool PERM = true;
    bf16* H;
    __device__ __forceinline__ void operator()(const pg8::f32x4 (&acc)[2][2][4][2], const pg8::Unit& u, int wr, int wc, int fr, int fq) const {
        const int row0 = u.pm * 256 + wr * 64 + fr; const int col0 = u.pn * 128 + wc * 32 + 8 * fq;
#pragma unroll
        for (int ai = 0; ai < 2; ++ai)
#pragma unroll
            for (int m = 0; m < 4; ++m) { bf16* rowp = H + (size_t)(row0 + ai * 128 + m * 16) * DEXP + col0;
                float v[8];
#pragma unroll
                for (int j = 0; j < 4; ++j) { v[j] = siluf_(acc[ai][0][m][0][j]) * acc[ai][1][m][0][j]; v[4 + j] = siluf_(acc[ai][0][m][1][j]) * acc[ai][1][m][1][j]; }
                u32x4 w; w.x = pg8::cvt_pk_bf16(v[0], v[1]); w.y = pg8::cvt_pk_bf16(v[2], v[3]); w.z = pg8::cvt_pk_bf16(v[4], v[5]); w.w = pg8::cvt_pk_bf16(v[6], v[7]);
                *(u32x4*)rowp = w; }
    }
};

struct BranchOrder {
    int nM, nN, G, c;
    __device__ bool next(int i, pg8::Unit& u) const {
        const int tl = (i >> 2) * G + c; if (tl >= nM * nN) return false;
        pg8::tile_of(tl, nM, nN, u.pm, u.pn); u.aux = i & 3;
        u.aoff = ((size_t)u.pm * 256 * 1024 + (size_t)u.aux * 256) * 2; u.boff = ((size_t)u.pn * 256 * 1024 + (size_t)u.aux * 256) * 2; return true;
    }
};
struct MoeOrder {
    const volatile LAS int* tb; int G, c; size_t a_rowbytes, b_expbytes, b_tilebytes;
    __device__ bool next(int i, pg8::Unit& u) const {
        const int L = i * G + c; const int total = __builtin_amdgcn_readfirstlane(tb[32]) * 4; if (L >= total) return false;
        int e = 0;
#pragma unroll 1
        for (int k = 0; k < 32; ++k) if (L >= tb[k + 1] * 4) e = k + 1;
        const int nte = tb[e + 1] - tb[e]; const int r = L - tb[e] * 4; const int ct = r / nte, rt = r % nte;
        u.pm = __builtin_amdgcn_readfirstlane(tb[33 + e] + rt); u.pn = __builtin_amdgcn_readfirstlane(ct); u.aux = __builtin_amdgcn_readfirstlane(e);
        u.aoff = (size_t)u.pm * 256 * a_rowbytes; u.boff = (size_t)u.aux * b_expbytes + (size_t)u.pn * b_tilebytes; return true;
    }
};

constexpr int PTR_OFF = LDS_BYTES - 512;
__device__ __forceinline__ void ptr_table_fill(const Args& args, LAS unsigned char* lds) {
    if (threadIdx.x == 0) {
        volatile LAS unsigned long long* t = (volatile LAS unsigned long long*)(lds + PTR_OFF);
#define PT_(i) t[i] = (unsigned long long)args.in[i];
        PT_(0) PT_(1) PT_(2) PT_(3) PT_(4) PT_(5) PT_(6) PT_(7) PT_(8) PT_(9) PT_(10) PT_(11) PT_(12) PT_(13) PT_(14) PT_(15) PT_(16) PT_(17) PT_(18) PT_(19)
        PT_(20) PT_(21) PT_(22) PT_(23) PT_(24) PT_(25) PT_(26) PT_(27) PT_(28) PT_(29) PT_(30) PT_(31) PT_(32) PT_(33) PT_(34)
#undef PT_
        t[35] = (unsigned long long)args.out; t[36] = (unsigned long long)args.ws; t[37] = (unsigned long long)(unsigned)args.ph_lo;
    }
    __syncthreads();
}
__device__ __forceinline__ unsigned long long ldptr(LAS unsigned char* lds, int i) {
    unsigned a = (unsigned)(PTR_OFF + 8 * i); asm volatile("" : "+v"(a));
    const volatile LAS unsigned* t = (const volatile LAS unsigned*)(lds + a);
    const unsigned lo = __builtin_amdgcn_readfirstlane(t[0]), hi = __builtin_amdgcn_readfirstlane(t[1]);
    return ((unsigned long long)hi << 32) | lo;
}
__device__ __forceinline__ void* gptr(unsigned long long v) { return (void*)(__attribute__((address_space(1))) void*)v; }
#define INP(i) ((const float*)gptr(ldptr(lds, (i))))
namespace rw {
typedef short bf16x8 __attribute__((ext_vector_type(8)));
typedef float f4 __attribute__((ext_vector_type(4)));
constexpr int LS = 72;
constexpr int MB = 64 * LS * 2;
constexpr int O_AHN = 0, O_RHN = MB, O_BCN = 2 * MB, O_KCN = 3 * MB, O_AHT = 4 * MB, O_BTT = 5 * MB, O_KTT = 6 * MB, O_VT = 7 * MB, O_STT = 8 * MB,
              O_MAK = 9 * MB, O_MRB = 10 * MB, O_MRK = 11 * MB, O_TINV = 12 * MB, O_MABF = 13 * MB, O_GAM = 13 * MB + 16384, O_CT = O_GAM + 256, O_BON = O_CT + 4608, O_END = O_BON + 256;
constexpr int O_MVT = O_BCN, O_A2N = O_AHN, O_UT = O_KCN, O_YF = O_AHT;
constexpr int O_TAB = O_MAK, O_SCR = O_TAB + 26624, O_TOT = O_SCR + 8 * 1024, O_CUM = O_TOT + 2048;
static_assert(O_CUM + 16384 <= O_GAM && O_END <= LDS_BYTES - 576, "rwkv LDS map");

__device__ __forceinline__ bf16x8 ldfrag(const LAS unsigned char* lds, int off, int r0, int ks, int lane) {
    return *(const LAS bf16x8*)(lds + off + ((r0 + (lane & 15)) * LS + ks * 32 + (lane >> 4) * 8) * 2);
}
__device__ __forceinline__ void mm64(f4 (&acc)[2], const LAS unsigned char* lds, int offA, int offBt, int w, int lane) {
    const int tr = w >> 1; const bf16x8 a0 = ldfrag(lds, offA, tr * 16, 0, lane), a1 = ldfrag(lds, offA, tr * 16, 1, lane);
#pragma unroll
    for (int c = 0; c < 2; ++c) { const int tc = (w & 1) * 2 + c; const bf16x8 b0 = ldfrag(lds, offBt, tc * 16, 0, lane), b1 = ldfrag(lds, offBt, tc * 16, 1, lane);
        acc[c] = __builtin_amdgcn_mfma_f32_16x16x32_bf16(a0, b0, acc[c], 0, 0, 0); acc[c] = __builtin_amdgcn_mfma_f32_16x16x32_bf16(a1, b1, acc[c], 0, 0, 0); }
}
__device__ __forceinline__ void storeT(LAS unsigned char* lds, int off, const f4 (&acc)[2], int w, int lane) {
#pragma unroll
    for (int c = 0; c < 2; ++c) { const int col = ((w & 1) * 2 + c) * 16 + (lane & 15), row = (w >> 1) * 16 + 4 * (lane >> 4);
        u32x2 v; v.x = pk2(acc[c][0], acc[c][1]); v.y = pk2(acc[c][2], acc[c][3]); *(LAS u32x2*)(lds + off + (col * LS + row) * 2) = v; }
}
template <int MASK  >
__device__ __forceinline__ void storeN(LAS unsigned char* lds, int off, const f4 (&acc)[2], int w, int lane) {
#pragma unroll
    for (int c = 0; c < 2; ++c) { const int col = ((w & 1) * 2 + c) * 16 + (lane & 15), row = (w >> 1) * 16 + 4 * (lane >> 4);
#pragma unroll
        for (int e = 0; e < 4; ++e) { float x = acc[c][e]; if (MASK == 1) x = (col < row + e) ? x : 0.f; if (MASK == 2) x = (col <= row + e) ? x : 0.f;
            *(LAS bf16*)(lds + off + ((row + e) * LS + col) * 2) = (bf16)f2bf(x); } }
}
typedef __bf16 bf2v __attribute__((ext_vector_type(2)));
__device__ __forceinline__ float dot2(unsigned x, unsigned y, float c) { return __builtin_amdgcn_fdot2_f32_bf16(__builtin_bit_cast(bf2v, x), __builtin_bit_cast(bf2v, y), c, false); }
#define RW_ZERO(a) do { a[0] = (f4){0.f, 0.f, 0.f, 0.f}; a[1] = (f4){0.f, 0.f, 0.f, 0.f}; } while (0)

__device__ __forceinline__ void build_ct(LAS unsigned char* lds0, const int l, const int h, const int lane, const int wave) {
    LAS unsigned char* const& lds = lds0; const int c = h * 64 + lane;
    const float* mu = INP(I_CMU) + (size_t)l * 896;
    if (wave == 0) { LAS float* ct = (LAS float*)(lds0 + O_CT);
        ct[0 * 64 + lane] = mu[c]; ct[1 * 64 + lane] = mu[256 + c]; ct[2 * 64 + lane] = mu[512 + c]; ct[3 * 64 + lane] = mu[768 + lane]; ct[4 * 64 + lane] = mu[832 + lane];
        ct[5 * 64 + lane] = INP(I_CW0)[l * 256 + c]; ct[6 * 64 + lane] = INP(I_CA0)[l * 256 + c]; ct[7 * 64 + lane] = INP(I_CKK)[l * 256 + c]; ct[8 * 64 + lane] = INP(I_CKA)[l * 256 + c];
        ct[9 * 64 + lane] = INP(I_CRK)[l * 256 + c]; ct[10 * 64 + lane] = INP(I_CGNW)[l * 256 + c]; ct[11 * 64 + lane] = INP(I_CGNB)[l * 256 + c]; ct[12 * 64 + lane] = l > 0 ? INP(I_CV0)[(l - 1) * 256 + c] : 0.f;
        ct[13 * 64 + lane] = mu[512 + lane]; ct[14 * 64 + lane] = mu[512 + lane + 64]; ct[15 * 64 + lane] = mu[512 + lane + 128]; ct[16 * 64 + lane] = mu[512 + lane + 192]; }
}
template <int MODE>
__device__ __forceinline__ void chunk(LAS unsigned char* lds0, const int l, const int b, const int h, const int t0, unsigned char* gz, unsigned char* gz2, float* bong, const bf16* P, bf16* VF, bf16* OB, const int tid0) {
    const int c = h * 64 + (tid0 & 63);
    {
        unsigned lb_ = 0u; int tid_l = tid0; asm volatile("" : "+v"(lb_), "+v"(tid_l));
        const int tid = tid_l, lane = tid & 63, wave = __builtin_amdgcn_readfirstlane(tid >> 6);
        LAS unsigned char* lds = lds0 + lb_;
        LAS bf16* TAB = (LAS bf16*)(lds + O_TAB); const LAS unsigned* TABW = (const LAS unsigned*)(lds + O_TAB);
        LAS bf16* scr = (LAS bf16*)(lds + O_SCR + wave * 1024);
        LAS float* CUM = (LAS float*)(lds + O_CUM);
        LAS float* TOT = (LAS float*)(lds + O_TOT);
        LAS float* GAM = (LAS float*)(lds + O_GAM);
        LAS float* MABF = (LAS float*)(lds + O_MABF);
        LAS float* YF = (LAS float*)(lds + O_YF);
        LAS float* BON = (LAS float*)(lds + O_BON);
        const LAS float* CT = (const LAS float*)(lds + O_CT);
#define CTV(k) CT[(k) * 64 + lane]
        { const float* cw2 = INP(I_CW2) + (size_t)l * 32 * 256; const float* ca2 = INP(I_CA2) + (size_t)l * 32 * 256; const float* cg2 = INP(I_CG2) + (size_t)l * 64 * 256;
          float tw[4], ta[4], tg[8];
#pragma unroll
          for (int u = 0; u < 4; ++u) { const int i = tid + u * NTHR; tw[u] = cw2[(i >> 6) * 256 + h * 64 + (i & 63)]; ta[u] = ca2[(i >> 6) * 256 + h * 64 + (i & 63)]; }
#pragma unroll
          for (int u = 0; u < 8; ++u) { const int i = tid + u * NTHR; tg[u] = cg2[(i >> 6) * 256 + h * 64 + (i & 63)]; }
          float t2[2], t1[8];
          if (l > 0) { const float* cv1 = INP(I_CV1) + (size_t)(l - 1) * 256 * 16; const float* cv2 = INP(I_CV2) + (size_t)(l - 1) * 16 * 256;
#pragma unroll
            for (int u = 0; u < 2; ++u) { const int i = tid + u * NTHR; t2[u] = cv2[(i >> 6) * 256 + h * 64 + (i & 63)]; }
#pragma unroll
            for (int u = 0; u < 8; ++u) t1[u] = cv1[tid + u * NTHR]; }
#define PIX(i) ((((i) >> 7) * 64 + ((i) & 63)) * 2 + (((i) >> 6) & 1))
#pragma unroll
          for (int u = 0; u < 4; ++u) { const int i = tid + u * NTHR; TAB[PIX(i)] = (bf16)f2bf(tw[u]); TAB[2048 + PIX(i)] = (bf16)f2bf(ta[u]); }
#pragma unroll
          for (int u = 0; u < 8; ++u) { const int i = tid + u * NTHR; TAB[4096 + PIX(i)] = (bf16)f2bf(tg[u]); }
          if (l > 0) {
#pragma unroll
            for (int u = 0; u < 2; ++u) { const int i = tid + u * NTHR; TAB[8192 + PIX(i)] = (bf16)f2bf(t2[u]); }
#pragma unroll
            for (int u = 0; u < 8; ++u) { const int i = tid + u * NTHR; const int cc = i >> 4, qq = i & 15; TAB[9216 + ((cc >> 1) * 16 + qq) * 2 + (cc & 1)] = (bf16)f2bf(t1[u]); } } }
#undef PIX
        float Xr[9];
#pragma unroll
        for (int j = 0; j < 9; ++j) { const int t = t0 + wave * 8 - 1 + j; Xr[j] = t >= 0 ? bf2f(P[((size_t)b * T + t) * PP + C_C + 768 + lane]) : 0.f; }
        __syncthreads();
        { float run = 0.f;
#pragma unroll
            for (int q = 0; q < 8; ++q) {
                const float xx = Xr[q + 1] + (Xr[q] - Xr[q + 1]) * CTV(3);
                scr[lane] = (bf16)f2bf(tanhf(xx));
                asm volatile("s_waitcnt lgkmcnt(0)" ::: "memory");
                float wsum = CTV(5); { float w1 = 0.f; const LAS unsigned* sw = (const LAS unsigned*)scr;
#pragma unroll
                for (int p = 0; p < 16; p += 2) { wsum = dot2(sw[p], TABW[p * 64 + lane], wsum); w1 = dot2(sw[p + 1], TABW[(p + 1) * 64 + lane], w1); }
                wsum += w1; }
                run += -__expf(-softplusf_(-wsum) - 0.5f); CUM[(wave * 8 + q) * 64 + lane] = run;
                asm volatile("s_waitcnt lgkmcnt(0)" ::: "memory");
            }
            TOT[wave * 64 + lane] = run; }
        __syncthreads();
        float offs = 0.f, cumL = 0.f;
#pragma unroll
        for (int w2 = 0; w2 < 8; ++w2) { const float tw = TOT[w2 * 64 + lane]; offs += (w2 < wave) ? tw : 0.f; cumL += tw; }
        if (wave == 0) GAM[lane] = __expf(cumL);
#define LO_(x) __uint_as_float((x) << 16)
#define HI_(x) __uint_as_float((x) & 0xffff0000u)
#define RAW_LOAD(rk, vx, gg, v4a, v4b, vfv, tok) do { const int t_ = (tok); const bool ok_ = t_ >= 0; const size_t m_ = (size_t)b * T + (ok_ ? t_ : 0); const bf16* row_ = P + m_ * PP + C_C; \
            rk = ok_ ? ((unsigned)row_[c] | ((unsigned)row_[256 + c] << 16)) : 0u; vx = ok_ ? ((unsigned)row_[512 + c] | ((unsigned)row_[768 + lane] << 16)) : 0u; gg = ok_ ? (unsigned)row_[832 + lane] : 0u; \
            if (l > 0) { v4a = ok_ ? ((unsigned)row_[512 + lane] | ((unsigned)row_[512 + lane + 64] << 16)) : 0u; v4b = ok_ ? ((unsigned)row_[512 + lane + 128] | ((unsigned)row_[512 + lane + 192] << 16)) : 0u; vfv = (unsigned)VF[m_ * 256 + c]; } } while (0)
        unsigned pRK, pVX, pGG, pVa = 0u, pVb = 0u, pVF = 0u, cRK, cVX, cGG, cVa = 0u, cVb = 0u, cVF = 0u;
        RAW_LOAD(pRK, pVX, pGG, pVa, pVb, pVF, t0 + wave * 8 - 1); RAW_LOAD(cRK, cVX, cGG, cVa, cVb, cVF, t0 + wave * 8);
#pragma unroll 1
        for (int q = 0; q < 8; ++q) {
            const int tt = wave * 8 + q; const size_t m = (size_t)b * T + t0 + tt;
            unsigned nRK, nVX, nGG, nVa = 0u, nVb = 0u, nVF = 0u;
            RAW_LOAD(nRK, nVX, nGG, nVa, nVb, nVF, (q < 7) ? (t0 + tt + 1) : (t0 + tt));
            const float r = LO_(cRK) + (LO_(pRK) - LO_(cRK)) * CTV(0), k = HI_(cRK) + (HI_(pRK) - HI_(cRK)) * CTV(1); float v = LO_(cVX) + (LO_(pVX) - LO_(cVX)) * CTV(2);
            const float xx = HI_(cVX) + (HI_(pVX) - HI_(cVX)) * CTV(3), xg = LO_(cGG) + (LO_(pGG) - LO_(cGG)) * CTV(4);
            scr[lane] = (bf16)f2bf(lane < 32 ? tanhf(xx) : xx); scr[64 + lane] = (bf16)f2bf(sigmoidf_(xg));
            LAS bf16* vsc = scr + 128;
            if (l > 0) {
                vsc[lane] = (bf16)f2bf(LO_(cVa) + (LO_(pVa) - LO_(cVa)) * CTV(13)); vsc[lane + 64] = (bf16)f2bf(HI_(cVa) + (HI_(pVa) - HI_(cVa)) * CTV(14));
                vsc[lane + 128] = (bf16)f2bf(LO_(cVb) + (LO_(pVb) - LO_(cVb)) * CTV(15)); vsc[lane + 192] = (bf16)f2bf(HI_(cVb) + (HI_(pVb) - HI_(cVb)) * CTV(16));
            }
            asm volatile("s_waitcnt lgkmcnt(0)" ::: "memory");
            float wsum = CTV(5), asum = CTV(6), gsum = 0.f; { float w1 = 0.f, a1 = 0.f, g1 = 0.f; const LAS unsigned* sw = (const LAS unsigned*)scr;
#pragma unroll
            for (int p = 0; p < 16; p += 2) { wsum = dot2(sw[p], TABW[p * 64 + lane], wsum); w1 = dot2(sw[p + 1], TABW[(p + 1) * 64 + lane], w1);
                asum = dot2(sw[16 + p], TABW[1024 + p * 64 + lane], asum); a1 = dot2(sw[17 + p], TABW[1024 + (p + 1) * 64 + lane], a1); }
#pragma unroll
            for (int p = 0; p < 32; p += 2) { gsum = dot2(sw[32 + p], TABW[2048 + p * 64 + lane], gsum); g1 = dot2(sw[33 + p], TABW[2048 + (p + 1) * 64 + lane], g1); }
            wsum += w1; asum += a1; gsum += g1; }
            if (l > 0) {
                const int qq = lane & 15, part = lane >> 4; float s = 0.f; { float s1 = 0.f; const LAS unsigned* sv = (const LAS unsigned*)vsc;
#pragma unroll
                for (int p = 0; p < 32; p += 2) { s = dot2(sv[part * 32 + p], TABW[4608 + (part * 32 + p) * 16 + qq], s); s1 = dot2(sv[part * 32 + p + 1], TABW[4608 + (part * 32 + p + 1) * 16 + qq], s1); }
                s += s1; }
                s += __shfl_xor(s, 16); s += __shfl_xor(s, 32);
                float vl = CTV(12);
#pragma unroll
                for (int q2 = 0; q2 < 16; ++q2) vl += __shfl(s, q2) * bf2f(TAB[8192 + ((q2 >> 1) * 64 + lane) * 2 + (q2 & 1)]);
                const float vf = LO_(cVF); v = v + (vf - v) * sigmoidf_(vl);
            }
            VF[m * 256 + c] = (bf16)f2bf(v);
            const float wlog = -softplusf_(-wsum) - 0.5f, asig = sigmoidf_(asum), lw = -__expf(wlog);
            float kk = k * CTV(7); const float n2 = wave_sum(kk * kk); kk = kk / fmaxf(sqrtf(n2), 1e-12f);
            const float kmod = k * (1.f + (asig - 1.f) * CTV(8));
            const float bon = wave_sum(r * kmod * CTV(9));
            const float cum = offs + CUM[tt * 64 + lane], cumx = cum - lw;
            const float ah = -kk * __expf(cumx), rh = r * __expf(cum), ei = __expf(-cum), bb = kk * asig, bc = bb * ei, kc = kmod * ei, ee = __expf(cumL - cum), bt = bb * ee, kt = kmod * ee;
            const int no = (tt * LS + lane) * 2, to = (lane * LS + tt) * 2;
            *(LAS bf16*)(lds + O_AHN + no) = (bf16)f2bf(ah); *(LAS bf16*)(lds + O_RHN + no) = (bf16)f2bf(rh);
            *(LAS bf16*)(lds + O_BCN + no) = (bf16)f2bf(bc); *(LAS bf16*)(lds + O_KCN + no) = (bf16)f2bf(kc); ((bf16*)(gz2 + 16384))[tt * 64 + lane] = (bf16)f2bf(gsum);
            *(LAS bf16*)(lds + O_AHT + to) = (bf16)f2bf(ah); *(LAS bf16*)(lds + O_BTT + to) = (bf16)f2bf(bt);
            *(LAS bf16*)(lds + O_KTT + to) = (bf16)f2bf(kt); *(LAS bf16*)(lds + O_VT + to) = (bf16)f2bf(v);
            if (lane == 0) bong[tt] = bon;
            asm volatile("s_waitcnt lgkmcnt(0)" ::: "memory");
            pRK = cRK; pVX = cVX; pGG = cGG; pVa = cVa; pVb = cVb; cRK = nRK; cVX = nVX; cGG = nGG; cVa = nVa; cVb = nVb; cVF = nVF;
        }
#undef RAW_LOAD
        __syncthreads();
        { f4 acc[2];
            RW_ZERO(acc); mm64(acc, lds, O_AHN, O_BCN, wave, lane);
#pragma unroll
            for (int cI = 0; cI < 2; ++cI) { const int col = ((wave & 1) * 2 + cI) * 16 + (lane & 15), row = (wave >> 1) * 16 + 4 * (lane >> 4);
#pragma unroll
                for (int e = 0; e < 4; ++e) MABF[(row + e) * 64 + col] = (col < row + e) ? acc[cI][e] : 0.f; }
            RW_ZERO(acc); mm64(acc, lds, O_AHN, O_KCN, wave, lane); storeN<1>(lds, O_MAK, acc, wave, lane);
            { f4 accb[2]; RW_ZERO(accb); mm64(accb, lds, O_RHN, O_BCN, wave, lane); f4 accc[2]; RW_ZERO(accc); mm64(accc, lds, O_RHN, O_KCN, wave, lane);
                storeN<2>(lds, O_MRB, accb, wave, lane); storeN<2>(lds, O_MRK, accc, wave, lane); }
        }
        __syncthreads();
        {
            const int cS = wave * 8 + (lane >> 3), tS = lane & 7;
            float xs[8];
#pragma unroll
            for (int k = 0; k < 8; ++k) xs[k] = 0.f;
#pragma unroll
            for (int i = 1; i < 64; ++i) {
                float part = 0.f;
#pragma unroll
                for (int k = 0; k < (i + 7) / 8; ++k) { const float mv = MABF[i * 64 + tS + 8 * k]; part += ((tS + 8 * k) < i ? mv : 0.f) * xs[k]; }
                part += __builtin_bit_cast(float, __builtin_amdgcn_update_dpp(0, __builtin_bit_cast(int, part), 0xB1, 0xF, 0xF, true));
                part += __builtin_bit_cast(float, __builtin_amdgcn_update_dpp(0, __builtin_bit_cast(int, part), 0x4E, 0xF, 0xF, true));
                part += __builtin_bit_cast(float, __builtin_amdgcn_update_dpp(0, __builtin_bit_cast(int, part), 0x141, 0xF, 0xF, true));
                const float xi = MABF[i * 64 + cS] + part;
                xs[i >> 3] = (tS == (i & 7)) ? xi : xs[i >> 3];
            }
#pragma unroll
            for (int k = 0; k < 8; ++k) { const int i = tS + 8 * k; *(LAS bf16*)(lds + O_TINV + (i * LS + cS) * 2) = (bf16)f2bf(i == cS ? 1.f : xs[k]); }
        }
        __syncthreads();
        { f4 acc[2]; RW_ZERO(acc); mm64(acc, lds, O_MAK, O_VT, wave, lane); storeT(lds, O_MVT, acc, wave, lane); }
        __syncthreads();
        if (MODE == 1) {
            { f4 acc[2]; RW_ZERO(acc); mm64(acc, lds, O_TINV, O_AHT, wave, lane); storeT(lds, O_UT, acc, wave, lane); }
            { f4 acc[2]; RW_ZERO(acc); mm64(acc, lds, O_TINV, O_MVT, wave, lane); storeT(lds, O_MAK, acc, wave, lane); }
            __syncthreads();
            f4 agm[2], azm[2], ar2[2], ay0[2];
            RW_ZERO(agm); mm64(agm, lds, O_BTT, O_UT, wave, lane);
#pragma unroll
            for (int cI = 0; cI < 2; ++cI) { const int col = ((wave & 1) * 2 + cI) * 16 + (lane & 15), row = (wave >> 1) * 16 + 4 * (lane >> 4);
#pragma unroll
                for (int e = 0; e < 4; ++e) if (col == row + e) agm[cI][e] += GAM[col]; }
            RW_ZERO(azm); mm64(azm, lds, O_BTT, O_MAK, wave, lane); mm64(azm, lds, O_KTT, O_VT, wave, lane);
            RW_ZERO(ar2); mm64(ar2, lds, O_MRB, O_UT, wave, lane);
#pragma unroll
            for (int cI = 0; cI < 2; ++cI) { const int col = ((wave & 1) * 2 + cI) * 16 + (lane & 15), row = (wave >> 1) * 16 + 4 * (lane >> 4);
#pragma unroll
                for (int e = 0; e < 4; ++e) ar2[cI][e] += bf2f(*(const LAS bf16*)(lds + O_RHN + ((row + e) * LS + col) * 2)); }
            RW_ZERO(ay0); mm64(ay0, lds, O_MRB, O_MAK, wave, lane); mm64(ay0, lds, O_MRK, O_VT, wave, lane);
            __syncthreads();
            storeN<0>(lds, O_AHN, agm, wave, lane); storeT(lds, O_RHN, azm, wave, lane); storeN<0>(lds, O_BCN, ar2, wave, lane); storeT(lds, O_KCN, ay0, wave, lane);
            __syncthreads();
            { const int io = ((tid >> 3) * LS + (tid & 7) * 8) * 2;
              ((u32x4*)gz)[tid] = *(const LAS u32x4*)(lds + O_AHN + io); ((u32x4*)(gz + 8192))[tid] = *(const LAS u32x4*)(lds + O_RHN + io);
              ((u32x4*)gz2)[tid] = *(const LAS u32x4*)(lds + O_BCN + io); ((u32x4*)(gz2 + 8192))[tid] = *(const LAS u32x4*)(lds + O_KCN + io); }
        } else {
            { f4 acc[2]; RW_ZERO(acc); mm64(acc, lds, O_TINV, O_AHT, wave, lane); storeN<0>(lds, O_A2N, acc, wave, lane); }
            __syncthreads();
            { f4 acc[2]; RW_ZERO(acc); mm64(acc, lds, O_TINV, O_MVT, wave, lane); mm64(acc, lds, O_A2N, O_STT, wave, lane); storeT(lds, O_UT, acc, wave, lane); }
            __syncthreads();
            f4 yacc[2]; RW_ZERO(yacc);
            mm64(yacc, lds, O_RHN, O_STT, wave, lane); mm64(yacc, lds, O_MRB, O_UT, wave, lane); mm64(yacc, lds, O_MRK, O_VT, wave, lane);
            __syncthreads();
#pragma unroll
            for (int cI = 0; cI < 2; ++cI) { const int col = ((wave & 1) * 2 + cI) * 16 + (lane & 15), row = (wave >> 1) * 16 + 4 * (lane >> 4);
#pragma unroll
                for (int e = 0; e < 4; ++e) YF[(row + e) * 64 + col] = yacc[cI][e]; }
            __syncthreads();
            { unsigned gcur = (unsigned)OB[((size_t)b * T + t0 + wave * 8) * 1024 + 512 + c];
#pragma unroll 1
            for (int q = 0; q < 8; ++q) {
                const int tt = wave * 8 + q; const size_t m = (size_t)b * T + t0 + tt;
                const unsigned gnxt = (unsigned)OB[(m + (q < 7 ? 1 : 0)) * 1024 + 512 + c];
                const float y = YF[tt * 64 + lane]; const float mean = wave_sum(y) * (1.f / 64.f); const float dy = y - mean; const float var = wave_sum(dy * dy) * (1.f / 64.f);
                const float yn = dy * rsqrtf(var + 64e-5f) * CTV(10) + CTV(11);
                const float vv = bf2f(*(const LAS bf16*)(lds + O_VT + (lane * LS + tt) * 2)), gg = LO_(gcur);
                OB[m * 1024 + 512 + c] = (bf16)f2bf((yn + BON[tt] * vv) * gg);
                gcur = gnxt;
            } }
        }
        __syncthreads();
#undef CTV
#undef LO_
#undef HI_
    }
}

__device__ __forceinline__ void chunk_out(LAS unsigned char* lds0, const int b, const int h, const int t0, const unsigned char* gz, const unsigned char* gz2, const float* bong, const bf16* VF, bf16* OB, const int tid0) {
    unsigned lb_ = 0u; int tid_l = tid0; asm volatile("" : "+v"(lb_), "+v"(tid_l));
    LAS unsigned char* lds = lds0 + lb_; const int tid = tid_l, lane = tid & 63, wave = __builtin_amdgcn_readfirstlane(tid >> 6);
    const int c = h * 64 + lane;
    const LAS float* CT = (const LAS float*)(lds + O_CT);
    LAS float* YF = (LAS float*)(lds + O_YF);
    const int io = ((tid >> 3) * LS + (tid & 7) * 8) * 2;
    const u32x4 sv = ((const u32x4*)gz)[tid], rv = ((const u32x4*)gz2)[tid];
    u32x2 yv[2];
#pragma unroll
    for (int k = 0; k < 2; ++k) { const int col = ((wave & 1) * 2 + k) * 16 + (lane & 15), row = (wave >> 1) * 16 + 4 * (lane >> 4); yv[k] = *(const u32x2*)(gz2 + 8192 + (col * 64 + row) * 2); }
    float gq[8], vq[8], bq[8];
#pragma unroll
    for (int q = 0; q < 8; ++q) { const int tt = wave * 8 + q; const size_t m = (size_t)b * T + t0 + tt;
        gq[q] = bf2f(((const bf16*)(gz2 + 16384))[tt * 64 + lane]); vq[q] = bf2f(VF[m * 256 + c]); bq[q] = bong[tt]; }
    *(LAS u32x4*)(lds + O_STT + io) = sv; *(LAS u32x4*)(lds + O_AHN + io) = rv;
    __syncthreads();
    f4 acc[2];
#pragma unroll
    for (int k = 0; k < 2; ++k) acc[k] = (f4){__uint_as_float(yv[k].x << 16), __uint_as_float(yv[k].x & 0xffff0000u), __uint_as_float(yv[k].y << 16), __uint_as_float(yv[k].y & 0xffff0000u)};
    mm64(acc, lds, O_AHN, O_STT, wave, lane);
#pragma unroll
    for (int cI = 0; cI < 2; ++cI) { const int col = ((wave & 1) * 2 + cI) * 16 + (lane & 15), row = (wave >> 1) * 16 + 4 * (lane >> 4);
#pragma unroll
        for (int e = 0; e < 4; ++e) YF[(row + e) * 64 + col] = acc[cI][e]; }
    __syncthreads();
#pragma unroll
    for (int q = 0; q < 8; ++q) { const int tt = wave * 8 + q; const size_t m = (size_t)b * T + t0 + tt;
        const float y = YF[tt * 64 + lane]; const float mean = wave_sum(y) * (1.f / 64.f); const float dy = y - mean; const float var = wave_sum(dy * dy) * (1.f / 64.f);
        const float yn = dy * rsqrtf(var + 64e-5f) * CT[10 * 64 + lane] + CT[11 * 64 + lane];
        OB[m * 1024 + 512 + c] = (bf16)f2bf((yn + bq[q] * vq[q]) * gq[q]); }
    __syncthreads();
}

__device__ __forceinline__ void carry(LAS unsigned char* lds0, unsigned char* gzc  , const int tid0) {
    f4 stacc[2]; RW_ZERO(stacc);
    { unsigned lb_ = 0u; asm volatile("" : "+v"(lb_)); LAS unsigned char* lds = lds0 + lb_; for (int i = tid0; i < MB / 4; i += NTHR) ((LAS unsigned*)(lds + O_STT))[i] = 0u; }
    u32x4 gnx = ((const u32x4*)gzc)[tid0];
    u32x2 znx[2];
    { const int lane = tid0 & 63, wave = tid0 >> 6;
#pragma unroll
      for (int k = 0; k < 2; ++k) { const int col = ((wave & 1) * 2 + k) * 16 + (lane & 15), row = (wave >> 1) * 16 + 4 * (lane >> 4); znx[k] = *(const u32x2*)(gzc + 8192 + (col * 64 + row) * 2); } }
#pragma unroll 1
    for (int cI = 0; cI < T / 64; ++cI) {
        unsigned lb_ = 0u; int tid_l = tid0; asm volatile("" : "+v"(lb_), "+v"(tid_l));
        LAS unsigned char* lds = lds0 + lb_; const int tid = tid_l, lane = tid & 63, wave = __builtin_amdgcn_readfirstlane(tid >> 6);
        unsigned char* rec = gzc + (size_t)cI * 16384;
        const int io = ((tid >> 3) * LS + (tid & 7) * 8) * 2;
        *(LAS u32x4*)(lds + O_AHN + io) = gnx;
        u32x2 zv[2]; zv[0] = znx[0]; zv[1] = znx[1];
        if (cI + 1 < T / 64) { gnx = ((const u32x4*)(rec + 16384))[tid];
#pragma unroll
            for (int k = 0; k < 2; ++k) { const int col = ((wave & 1) * 2 + k) * 16 + (lane & 15), row = (wave >> 1) * 16 + 4 * (lane >> 4); znx[k] = *(const u32x2*)(rec + 16384 + 8192 + (col * 64 + row) * 2); } }
        __syncthreads();
        ((u32x4*)rec)[tid] = *(const LAS u32x4*)(lds + O_STT + io);
        f4 acc[2];
#pragma unroll
        for (int k = 0; k < 2; ++k) acc[k] = (f4){__uint_as_float(zv[k].x << 16), __uint_as_float(zv[k].x & 0xffff0000u), __uint_as_float(zv[k].y << 16), __uint_as_float(zv[k].y & 0xffff0000u)};
        mm64(acc, lds, O_AHN, O_STT, wave, lane);
        __syncthreads();
        storeT(lds, O_STT, acc, wave, lane);
    }
}
}

namespace mb {
using rw::LS; using rw::MB; using rw::f4; using rw::mm64; using rw::storeN; using rw::bf16x8;
constexpr int O_CN = 0, O_BN = MB, O_BT = 2 * MB, O_XT0 = 3 * MB, O_XW0 = 5 * MB, O_CS0 = 7 * MB, O_HN0 = 9 * MB, O_SC0 = 11 * MB, O_SM = 13 * MB, O_YF = O_XW0;
static_assert(O_SM + 2048 <= LDS_BYTES - 576, "mamba LDS map");
__device__ __forceinline__ void chain(LAS unsigned char* lds0, const int l, const int b, const int gI, const bf16* P, bf16* OB, const int tid0, const int lane0, const int wave0) {
    const int tid = tid0, lane = lane0, wave = wave0;
    LAS unsigned char* const& lds = lds0;
    const float* cwp = INP(I_DCW) + (size_t)l * 4 * 512; const float* cbp = INP(I_DCB) + (size_t)l * 512;
    const int cc = tid & 255, sub = tid >> 8;
    const int col = cc < 128 ? (gI * 128 + cc) : (cc < 192 ? (256 + gI * 64 + (cc - 128)) : (384 + gI * 64 + (cc - 192)));
    const float cw0 = cwp[col], cw1 = cwp[512 + col], cw2 = cwp[1024 + col], cw3 = cwp[1536 + col], cb = cbp[col];
    f4 hacc[2][2];
#pragma unroll
    for (int hh = 0; hh < 2; ++hh) { hacc[hh][0] = (f4){0.f, 0.f, 0.f, 0.f}; hacc[hh][1] = (f4){0.f, 0.f, 0.f, 0.f}; }
    for (int i = tid; i < 2 * MB / 4; i += NTHR) ((LAS unsigned*)(lds0 + O_HN0))[i] = 0u;
    const float dtb0 = INP(I_DDTB)[l * 4 + gI * 2], dtb1 = INP(I_DDTB)[l * 4 + gI * 2 + 1];
    const float nA0 = -__expf(INP(I_DALOG)[l * 4 + gI * 2]), nA1 = -__expf(INP(I_DALOG)[l * 4 + gI * 2 + 1]);
    const float dsk0 = INP(I_DSKIP)[l * 4 + gI * 2], dsk1 = INP(I_DSKIP)[l * 4 + gI * 2 + 1];
    const float nw0 = INP(I_DNW)[l * 256 + gI * 128 + lane], nw1 = INP(I_DNW)[l * 256 + gI * 128 + 64 + lane];
#pragma unroll 1
    for (int t0 = 0; t0 < T; t0 += 64) {
        unsigned lb_ = 0u; int tid_l = tid0; asm volatile("" : "+v"(lb_), "+v"(tid_l));
        const int tid = tid_l, lane = tid & 63, wave = __builtin_amdgcn_readfirstlane(tid >> 6);
        LAS unsigned char* lds = lds0 + lb_;
        LAS float* SM = (LAS float*)(lds + O_SM);
        LAS float* YF = (LAS float*)(lds + O_YF);
        if (wave < 2) {
            const size_t m = (size_t)b * T + t0 + lane;
            const float dt = softplusf_(bf2f(P[m * PP + C_DT + gI * 2 + wave]) + (wave == 0 ? dtb0 : dtb1));
            float cs = dt * (wave == 0 ? nA0 : nA1);
#pragma unroll
            for (int o = 1; o < 64; o <<= 1) { const float y = __shfl_up(cs, o); if (lane >= o) cs += y; }
            const float cL = __shfl(cs, 63);
            SM[wave * 64 + lane] = dt; SM[128 + wave * 64 + lane] = cs; SM[256 + wave * 64 + lane] = __expf(cL - cs) * dt; SM[384 + wave * 64 + lane] = __expf(cs);
        }
        __syncthreads();
        { float h0, h1, h2, cur[8], nxt[8];
          { const int tb = t0 + sub * 32; h0 = tb >= 3 ? bf2f(P[((size_t)b * T + tb - 3) * PP + C_DX + col]) : 0.f; h1 = tb >= 2 ? bf2f(P[((size_t)b * T + tb - 2) * PP + C_DX + col]) : 0.f; h2 = tb >= 1 ? bf2f(P[((size_t)b * T + tb - 1) * PP + C_DX + col]) : 0.f;
#pragma unroll
            for (int j = 0; j < 8; ++j) cur[j] = bf2f(P[((size_t)b * T + tb + j) * PP + C_DX + col]); }
#pragma unroll 1
          for (int g8 = 0; g8 < 4; ++g8) {
            const int tb = t0 + sub * 32 + g8 * 8 + (g8 < 3 ? 8 : 0);
#pragma unroll
            for (int j = 0; j < 8; ++j) nxt[j] = bf2f(P[((size_t)b * T + tb + j) * PP + C_DX + col]);
#pragma unroll
            for (int j = 0; j < 8; ++j) {
                const int tt = sub * 32 + g8 * 8 + j;
                const float a = siluf_(cb + cw3 * cur[j] + cw2 * h2 + cw1 * h1 + cw0 * h0);
                h0 = h1; h1 = h2; h2 = cur[j];
                if (cc < 128) { const int hh = cc >> 6, p = cc & 63;
                    *(LAS bf16*)(lds + O_XT0 + hh * MB + (p * LS + tt) * 2) = (bf16)f2bf(a); *(LAS bf16*)(lds + O_XW0 + hh * MB + (p * LS + tt) * 2) = (bf16)f2bf(a * SM[256 + hh * 64 + tt]); }
                else if (cc < 192) { const int n = cc - 128; *(LAS bf16*)(lds + O_BN + (tt * LS + n) * 2) = (bf16)f2bf(a); *(LAS bf16*)(lds + O_BT + (n * LS + tt) * 2) = (bf16)f2bf(a); }
                else { const int n = cc - 192; *(LAS bf16*)(lds + O_CN + (tt * LS + n) * 2) = (bf16)f2bf(a);
                    *(LAS bf16*)(lds + O_CS0 + (tt * LS + n) * 2) = (bf16)f2bf(a * SM[384 + tt]); *(LAS bf16*)(lds + O_CS0 + MB + (tt * LS + n) * 2) = (bf16)f2bf(a * SM[384 + 64 + tt]); }
            }
#pragma unroll
            for (int j = 0; j < 8; ++j) cur[j] = nxt[j];
          } }
        __syncthreads();
        { f4 acc[2]; acc[0] = (f4){0.f, 0.f, 0.f, 0.f}; acc[1] = (f4){0.f, 0.f, 0.f, 0.f}; mm64(acc, lds, O_CN, O_BN, wave, lane);
#pragma unroll
            for (int hh = 0; hh < 2; ++hh) { f4 sc[2];
#pragma unroll
                for (int cI = 0; cI < 2; ++cI) { const int s = ((wave & 1) * 2 + cI) * 16 + (lane & 15), row = (wave >> 1) * 16 + 4 * (lane >> 4);
                    const float cs = SM[128 + hh * 64 + s], ds = SM[hh * 64 + s];
#pragma unroll
                    for (int e = 0; e < 4; ++e) { const float ct = SM[128 + hh * 64 + row + e]; sc[cI][e] = (s <= row + e) ? acc[cI][e] * __expf(ct - cs) * ds : 0.f; } }
                storeN<0>(lds, O_SC0 + hh * MB, sc, wave, lane); } }
        __syncthreads();
        f4 yacc[2][2];
#pragma unroll
        for (int hh = 0; hh < 2; ++hh) {
            yacc[hh][0] = (f4){0.f, 0.f, 0.f, 0.f}; yacc[hh][1] = (f4){0.f, 0.f, 0.f, 0.f};
            mm64(yacc[hh], lds, O_SC0 + hh * MB, O_XT0 + hh * MB, wave, lane); mm64(yacc[hh], lds, O_CS0 + hh * MB, O_HN0 + hh * MB, wave, lane);
            const float gL = SM[384 + hh * 64 + 63]; hacc[hh][0] = hacc[hh][0] * gL; hacc[hh][1] = hacc[hh][1] * gL;
            mm64(hacc[hh], lds, O_XW0 + hh * MB, O_BT, wave, lane);
        }
        __syncthreads();
#pragma unroll
        for (int hh = 0; hh < 2; ++hh) {
#pragma unroll
            for (int cI = 0; cI < 2; ++cI) { const int colp = ((wave & 1) * 2 + cI) * 16 + (lane & 15), row = (wave >> 1) * 16 + 4 * (lane >> 4);
#pragma unroll
                for (int e = 0; e < 4; ++e) YF[(row + e) * 128 + hh * 64 + colp] = yacc[hh][cI][e]; }
            storeN<0>(lds, O_HN0 + hh * MB, hacc[hh], wave, lane);
        }
        __syncthreads();
#pragma unroll
        for (int q = 0; q < 8; ++q) {
            const int tt = wave * 8 + q; const size_t m = (size_t)b * T + t0 + tt;
            const float x0 = bf2f(*(const LAS bf16*)(lds + O_XT0 + (lane * LS + tt) * 2)), x1 = bf2f(*(const LAS bf16*)(lds + O_XT0 + MB + (lane * LS + tt) * 2));
            const int c0 = gI * 128 + lane, c1 = c0 + 64;
            const float z0 = bf2f(P[m * PP + C_DZ + c0]), z1 = bf2f(P[m * PP + C_DZ + c1]);
            const float y0 = (YF[tt * 128 + lane] + dsk0 * x0) * siluf_(z0), y1 = (YF[tt * 128 + 64 + lane] + dsk1 * x1) * siluf_(z1);
            const float ss = wave_sum(y0 * y0 + y1 * y1); const float rs = rsqrtf(ss * (1.f / 128.f) + 1e-5f);
            OB[m * 1024 + 768 + c0] = (bf16)f2bf(y0 * rs * nw0); OB[m * 1024 + 768 + c1] = (bf16)f2bf(y1 * rs * nw1);
        }
        __syncthreads();
    }
}
}

namespace bsp {
typedef short bf16x8 __attribute__((ext_vector_type(8)));
typedef float f4 __attribute__((ext_vector_type(4)));
constexpr int HS = 129;
constexpr int O_HIST = 0;
constexpr int O_V = 66048;
constexpr int VS = 272;
constexpr int O_KB = O_V + 2 * 32 * VS * 2;
constexpr int KBUF = 20480;
static_assert(O_KB + 2 * KBUF <= LDS_BYTES - 600, "mixer B LDS map");
__device__ __forceinline__ unsigned okey(float s) { int q = (int)(s * 262144.f + 8388608.f); q = q < 1 ? 1 : (q > 16777215 ? 16777215 : q); return (unsigned)q << 8; }
__device__ __forceinline__ f4 idx_tile(const bf16* Pb, const int kt, const bf16x8 (&qi)[4][2], const float (&wq)[4], const int lane) {
    const bf16* kr = Pb + (size_t)(kt * 16 + (lane & 15)) * PP + C_IK + (lane >> 4) * 8;
    const bf16x8 a0 = *(const bf16x8*)kr, a1 = *(const bf16x8*)(kr + 32);
    f4 s = (f4){0.f, 0.f, 0.f, 0.f};
#pragma unroll
    for (int h = 0; h < 4; ++h) { f4 t = (f4){0.f, 0.f, 0.f, 0.f};
        t = __builtin_amdgcn_mfma_f32_16x16x32_bf16(a0, qi[h][0], t, 0, 0, 0); t = __builtin_amdgcn_mfma_f32_16x16x32_bf16(a1, qi[h][1], t, 0, 0, 0);
#pragma unroll
        for (int e = 0; e < 4; ++e) s[e] += wq[h] * fmaxf(t[e], 0.f); }
    return s;
}

__device__ __forceinline__ void item(LAS unsigned char* lds0, const int bb, const int qb, const bf16* P, bf16* OB, const int tid0, const int pm) {
    unsigned lb_ = 0u; int tid_l = tid0; asm volatile("" : "+v"(lb_), "+v"(tid_l));
    LAS unsigned char* lds = lds0 + lb_; const int tid = tid_l, lane = tid & 63, wave = __builtin_amdgcn_readfirstlane(tid >> 6);
    const bf16* Pb = P + (size_t)bb * T * PP;
    const int ql = wave * 16 + (lane & 15), tq = qb * 128 + ql, g = lane >> 4;
    const bf16* prow = Pb + (size_t)tq * PP;
    bf16x8 qi[4][2]; float wq[4];
#pragma unroll
    for (int h = 0; h < 4; ++h) { qi[h][0] = *(const bf16x8*)(prow + C_IQ + h * 64 + g * 8); qi[h][1] = *(const bf16x8*)(prow + C_IQ + h * 64 + 32 + g * 8); wq[h] = bf2f(prow[C_IW + h]) * 0.0625f; }
    LAS unsigned* hist = (LAS unsigned*)(lds + O_HIST) + ql * HS;
    const int nkt = (qb + 1) * 8;
    unsigned prefix = 0u; int needk = 256;
#pragma unroll 1
    for (int rr = 0; rr < (pm == 102 ? 2 : 1); ++rr) { prefix = 0u; needk = 256;
#pragma unroll 1
    for (int pass = 0; pass < 3; ++pass) {
        for (int i = lane; i < 16 * HS; i += 64) ((LAS unsigned*)(lds + O_HIST) + wave * 16 * HS)[i] = 0u;
        asm volatile("s_waitcnt lgkmcnt(0)" ::: "memory");
        const int shp = 32 - 8 * pass, shb = 24 - 8 * pass;
        float flo = 0.f, fhi = 0.f;
        if (pass > 0) { const float stepw = (pass == 1) ? 65536.f : 256.f; flo = ((float)prefix * stepw - 2.f) * (1.f / 262144.f) - 32.f; fhi = (((float)prefix + 1.f) * stepw + 2.f) * (1.f / 262144.f) - 32.f; }
        bf16x8 ka[4][2], kn[4][2];
#pragma unroll
        for (int u = 0; u < 4; ++u) { const bf16* kr = Pb + (size_t)(u * 16 + (lane & 15)) * PP + C_IK + g * 8; ka[u][0] = *(const bf16x8*)kr; ka[u][1] = *(const bf16x8*)(kr + 32); }
#pragma unroll 1
        for (int kt4 = 0; kt4 < nkt; kt4 += 4) {
            { const int ktn = (kt4 + 4 < nkt) ? kt4 + 4 : kt4;
#pragma unroll
              for (int u = 0; u < 4; ++u) { const bf16* kr = Pb + (size_t)((ktn + u) * 16 + (lane & 15)) * PP + C_IK + g * 8; kn[u][0] = *(const bf16x8*)kr; kn[u][1] = *(const bf16x8*)(kr + 32); } }
#pragma unroll
            for (int u = 0; u < 4; ++u) {
                f4 s = (f4){0.f, 0.f, 0.f, 0.f};
#pragma unroll
                for (int h = 0; h < 4; ++h) { f4 t = (f4){0.f, 0.f, 0.f, 0.f};
                    t = __builtin_amdgcn_mfma_f32_16x16x32_bf16(ka[u][0], qi[h][0], t, 0, 0, 0); t = __builtin_amdgcn_mfma_f32_16x16x32_bf16(ka[u][1], qi[h][1], t, 0, 0, 0);
#pragma unroll
                    for (int e = 0; e < 4; ++e) s[e] += wq[h] * fmaxf(t[e], 0.f); }
                if (pass == 0) {
#pragma unroll
                    for (int e = 0; e < 4; ++e) { const int key = (kt4 + u) * 16 + 4 * g + e;
                        if (key <= tq) { const unsigned bin = okey(s[e]) >> 24; __hip_atomic_fetch_add(hist + (bin >> 1), (bin & 1u) ? 0x10000u : 1u, __ATOMIC_RELAXED, __HIP_MEMORY_SCOPE_WORKGROUP); } }
                } else {
#pragma unroll
                    for (int e = 0; e < 4; ++e) { const int key = (kt4 + u) * 16 + 4 * g + e;
                        if (s[e] >= flo && s[e] <= fhi && key <= tq) { const unsigned k32 = okey(s[e]);
                            if ((k32 >> shp) == prefix) { const unsigned bin = (k32 >> shb) & 255u; __hip_atomic_fetch_add(hist + (bin >> 1), (bin & 1u) ? 0x10000u : 1u, __ATOMIC_RELAXED, __HIP_MEMORY_SCOPE_WORKGROUP); } } }
                }
            }
#pragma unroll
            for (int u = 0; u < 4; ++u) { ka[u][0] = kn[u][0]; ka[u][1] = kn[u][1]; }
        }
        asm volatile("s_waitcnt lgkmcnt(0)" ::: "memory");
        int cum = 0; unsigned bsel = 0u; int above = 0;
        for (int wd = 127; wd >= 0; --wd) { const unsigned v = hist[wd]; const int hi = (int)(v >> 16), lo = (int)(v & 0xffffu);
            if (cum + hi >= needk) { bsel = (unsigned)(2 * wd + 1); above = cum; break; } cum += hi;
            if (cum + lo >= needk) { bsel = (unsigned)(2 * wd); above = cum; break; } cum += lo; }
        prefix = (prefix << 8) | bsel; needk -= above;
        asm volatile("s_waitcnt lgkmcnt(0)" ::: "memory");
    }
    }
    unsigned thr = prefix; int cidx = 1 << 20;
    bool tie = false;
    if (tq < 256) thr = 0u;
    else { const unsigned v = hist[(prefix & 255u) >> 1]; const int ceq = (prefix & 1u) ? (int)(v >> 16) : (int)(v & 0xffffu); tie = needk < ceq; }
    if (__any(tie)) {
        int cbin = 0, rem = needk;
#pragma unroll 1
        for (int ip = 0; ip < 2; ++ip) {
            for (int i = g; i < HS; i += 4) hist[i] = 0u;
            asm volatile("s_waitcnt lgkmcnt(0)" ::: "memory");
#pragma unroll 1
            for (int kt = 0; kt < nkt; ++kt) {
                const f4 s = idx_tile(Pb, kt, qi, wq, lane);
#pragma unroll
                for (int e = 0; e < 4; ++e) { const int key = kt * 16 + 4 * g + e; const unsigned k32 = okey(s[e]);
                    const bool in = tie && key <= tq && (k32 >> 8) == prefix && (ip == 0 || (key >> 4) == cbin);
                    if (in) { const unsigned bin = ip == 0 ? (unsigned)(key >> 4) : (unsigned)(key & 15); __hip_atomic_fetch_add(hist + (bin >> 1), (bin & 1u) ? 0x10000u : 1u, __ATOMIC_RELAXED, __HIP_MEMORY_SCOPE_WORKGROUP); } }
            }
            asm volatile("s_waitcnt lgkmcnt(0)" ::: "memory");
            int cum = 0, bs = 0, below = 0;
            for (int wd = 0; wd < 128; ++wd) { const unsigned vv = hist[wd]; const int lo = (int)(vv & 0xffffu), hi = (int)(vv >> 16);
                if (cum + lo >= rem) { bs = 2 * wd; below = cum; break; } cum += lo;
                if (cum + hi >= rem) { bs = 2 * wd + 1; below = cum; break; } cum += hi; }
            if (ip == 0) { cbin = bs; rem -= below; } else if (tie) cidx = cbin * 16 + bs;
            asm volatile("s_waitcnt lgkmcnt(0)" ::: "memory");
        }
    }
    __syncthreads();
#pragma unroll
    for (int h = 0; h < 4; ++h) { *(LAS bf16x8*)(lds + O_HIST + wave * 8192 + ((h * 2 + 0) * 64 + lane) * 16) = qi[h][0]; *(LAS bf16x8*)(lds + O_HIST + wave * 8192 + ((h * 2 + 1) * 64 + lane) * 16) = qi[h][1]; }
    bf16x8 qa[4][2];
#pragma unroll
    for (int h = 0; h < 4; ++h) { qa[h][0] = *(const bf16x8*)(prow + C_BQ + h * 64 + g * 8); qa[h][1] = *(const bf16x8*)(prow + C_BQ + h * 64 + 32 + g * 8); }
    f4 oacc[4][4]; float mrun[4], lrun[4];
#pragma unroll
    for (int h = 0; h < 4; ++h) { mrun[h] = -INFINITY; lrun[h] = 0.f;
#pragma unroll
        for (int dt = 0; dt < 4; ++dt) oacc[h][dt] = (f4){0.f, 0.f, 0.f, 0.f}; }
#pragma unroll 1
    for (int rr = 0; rr < (pm == 103 ? 2 : 1); ++rr) {
#pragma unroll
    for (int h = 0; h < 4; ++h) { mrun[h] = -INFINITY; lrun[h] = 0.f;
#pragma unroll
        for (int dt = 0; dt < 4; ++dt) oacc[h][dt] = (f4){0.f, 0.f, 0.f, 0.f}; }
    const int nst = (qb + 1) * 4;
    const int vkey = tid >> 4, vch = tid & 15;
    u32x4 vpre0 = *(const u32x4*)(Pb + (size_t)vkey * PP + C_BV + vch * 8), vpre1 = *(const u32x4*)(Pb + (size_t)vkey * PP + C_BV + 128 + vch * 8);
    const unsigned vrd = (unsigned)(unsigned long)lds + (unsigned)(O_V + (4 * g + ((lane >> 2) & 3)) * (VS * 2) + (lane & 3) * 8);
    __syncthreads();
    {   const unsigned kb = (unsigned)O_KB;
#pragma unroll
        for (int jj = 0; jj < 3; ++jj) { const int j = wave + 8 * jj;
            if (j < 16) { const int S = j * 64 + lane, r = S >> 5, p = S & 31;
                __builtin_amdgcn_global_load_lds((const unsigned*)(Pb + (size_t)r * PP + C_BK + ((p ^ (r & 15)) << 3)), (LAS unsigned*)(lds + kb + j * 1024), 16, 0, 0); }
            else if (j < 20) { const int S = (j - 16) * 64 + lane, r = S >> 3, p = S & 7;
                __builtin_amdgcn_global_load_lds((const unsigned*)(Pb + (size_t)r * PP + C_IK + ((p ^ (r & 7)) << 3)), (LAS unsigned*)(lds + kb + 16384 + (j - 16) * 1024), 16, 0, 0); } } }
#pragma unroll 1
    for (int st = 0; st < nst; ++st) {
        const int key0 = st * 32; const unsigned vbuf = (unsigned)(st & 1) * (32 * VS * 2);
        unsigned qio = (unsigned)(O_HIST + wave * 8192 + lane * 16); asm volatile("" : "+v"(qio));
        { LAS bf16* VL = (LAS bf16*)(lds + O_V + vbuf); *(LAS u32x4*)(VL + vkey * VS + vch * 8) = vpre0; *(LAS u32x4*)(VL + vkey * VS + 128 + vch * 8) = vpre1; }
        __syncthreads();
        if (st + 1 < nst) {
            const int kn0 = key0 + 32; const unsigned kb = (unsigned)(O_KB + ((st + 1) & 1) * KBUF);
#pragma unroll
            for (int jj = 0; jj < 3; ++jj) { const int j = wave + 8 * jj;
                if (j < 16) { const int S = j * 64 + lane, r = S >> 5, p = S & 31;
                    __builtin_amdgcn_global_load_lds((const unsigned*)(Pb + (size_t)(kn0 + r) * PP + C_BK + ((p ^ (r & 15)) << 3)), (LAS unsigned*)(lds + kb + j * 1024), 16, 0, 0); }
                else if (j < 20) { const int S = (j - 16) * 64 + lane, r = S >> 3, p = S & 7;
                    __builtin_amdgcn_global_load_lds((const unsigned*)(Pb + (size_t)(kn0 + r) * PP + C_IK + ((p ^ (r & 7)) << 3)), (LAS unsigned*)(lds + kb + 16384 + (j - 16) * 1024), 16, 0, 0); } }
        }
        const unsigned kbc = (unsigned)(O_KB + (st & 1) * KBUF);
#define KQ_(h, k2, ks) (*(const LAS bf16x8*)(lds + kbc + (k2 * 16 + (lane & 15)) * 512 + ((((h) * 8 + (ks) * 4 + g) ^ (lane & 15)) << 4)))
#define KI_(k2, ks) (*(const LAS bf16x8*)(lds + kbc + 16384 + (k2 * 16 + (lane & 15)) * 128 + ((((ks) * 4 + g) ^ (lane & 7)) << 4)))
        bool sel[2][4];
#pragma unroll
        for (int k2 = 0; k2 < 2; ++k2) { f4 s = (f4){0.f, 0.f, 0.f, 0.f};
#pragma unroll
            for (int h = 0; h < 4; ++h) { f4 t = (f4){0.f, 0.f, 0.f, 0.f};
                const bf16x8 qh0 = *(const LAS bf16x8*)(lds + qio + ((h * 2 + 0) * 64) * 16), qh1 = *(const LAS bf16x8*)(lds + qio + ((h * 2 + 1) * 64) * 16);
                t = __builtin_amdgcn_mfma_f32_16x16x32_bf16(KI_(k2, 0), qh0, t, 0, 0, 0); t = __builtin_amdgcn_mfma_f32_16x16x32_bf16(KI_(k2, 1), qh1, t, 0, 0, 0);
#pragma unroll
                for (int e = 0; e < 4; ++e) s[e] += wq[h] * fmaxf(t[e], 0.f); }
#pragma unroll
            for (int e = 0; e < 4; ++e) { const int key = key0 + k2 * 16 + 4 * g + e; const unsigned k24 = okey(s[e]) >> 8;
                sel[k2][e] = key <= tq && (k24 > thr || (k24 == thr && key <= cidx)); } }
#pragma unroll
        for (int h = 0; h < 4; ++h) {
            if (h == 2 && st + 1 < nst) { vpre0 = *(const u32x4*)(Pb + (size_t)(key0 + 32 + vkey) * PP + C_BV + vch * 8); vpre1 = *(const u32x4*)(Pb + (size_t)(key0 + 32 + vkey) * PP + C_BV + 128 + vch * 8); }
            f4 sc[2];
#pragma unroll
            for (int k2 = 0; k2 < 2; ++k2) { f4 t = (f4){0.f, 0.f, 0.f, 0.f};
                t = __builtin_amdgcn_mfma_f32_16x16x32_bf16(KQ_(h, k2, 0), qa[h][0], t, 0, 0, 0); t = __builtin_amdgcn_mfma_f32_16x16x32_bf16(KQ_(h, k2, 1), qa[h][1], t, 0, 0, 0);
#pragma unroll
                for (int e = 0; e < 4; ++e) sc[k2][e] = sel[k2][e] ? t[e] * 0.125f : -INFINITY; }
            float mx = fmaxf(fmaxf(fmaxf(sc[0][0], sc[0][1]), fmaxf(sc[0][2], sc[0][3])), fmaxf(fmaxf(sc[1][0], sc[1][1]), fmaxf(sc[1][2], sc[1][3])));
            mx = fmaxf(mx, __shfl_xor(mx, 16)); mx = fmaxf(mx, __shfl_xor(mx, 32));
            const float mnew = fmaxf(mrun[h], mx), msafe = (mnew == -INFINITY) ? 0.f : mnew;
            const float corr = __expf(mrun[h] - msafe); mrun[h] = mnew;
            float p[8]; float ps = 0.f;
#pragma unroll
            for (int e = 0; e < 4; ++e) { p[e] = __expf(sc[0][e] - msafe); p[4 + e] = __expf(sc[1][e] - msafe); ps += p[e] + p[4 + e]; }
            lrun[h] = lrun[h] * corr + ps;
            union { bf16x8 v; unsigned u[4]; } pb;
            pb.u[0] = pg8::cvt_pk_bf16(p[0], p[1]); pb.u[1] = pg8::cvt_pk_bf16(p[2], p[3]); pb.u[2] = pg8::cvt_pk_bf16(p[4], p[5]); pb.u[3] = pg8::cvt_pk_bf16(p[6], p[7]);
            union { bf16x8 v; u32x2 h2[2]; } vf[4];
            const unsigned va = vrd + vbuf + (unsigned)(h * 128);
            asm volatile("ds_read_b64_tr_b16 %0, %8\n\tds_read_b64_tr_b16 %1, %8 offset:%9\n\tds_read_b64_tr_b16 %2, %8 offset:32\n\tds_read_b64_tr_b16 %3, %8 offset:%10\n\t"
                         "ds_read_b64_tr_b16 %4, %8 offset:64\n\tds_read_b64_tr_b16 %5, %8 offset:%11\n\tds_read_b64_tr_b16 %6, %8 offset:96\n\tds_read_b64_tr_b16 %7, %8 offset:%12\n\ts_waitcnt lgkmcnt(0)"
                         : "=&v"(vf[0].h2[0]), "=&v"(vf[0].h2[1]), "=&v"(vf[1].h2[0]), "=&v"(vf[1].h2[1]), "=&v"(vf[2].h2[0]), "=&v"(vf[2].h2[1]), "=&v"(vf[3].h2[0]), "=&v"(vf[3].h2[1])
                         : "v"(va), "i"(16 * VS * 2), "i"(16 * VS * 2 + 32), "i"(16 * VS * 2 + 64), "i"(16 * VS * 2 + 96) : "memory");
            __builtin_amdgcn_sched_barrier(0);
#pragma unroll
            for (int dt = 0; dt < 4; ++dt) { oacc[h][dt] = oacc[h][dt] * corr; oacc[h][dt] = __builtin_amdgcn_mfma_f32_16x16x32_bf16(vf[dt].v, pb.v, oacc[h][dt], 0, 0, 0); }
        }
    }
    __syncthreads();
    }
#undef KQ_
#undef KI_
    const size_t m = (size_t)bb * T + tq;
#pragma unroll
    for (int h = 0; h < 4; ++h) { float l = lrun[h]; l += __shfl_xor(l, 16); l += __shfl_xor(l, 32); const float inv = 1.f / l;
#pragma unroll
        for (int dt = 0; dt < 4; ++dt) { u32x2 w; w.x = pk2(oacc[h][dt][0] * inv, oacc[h][dt][1] * inv); w.y = pk2(oacc[h][dt][2] * inv, oacc[h][dt][3] * inv);
            *(u32x2*)(OB + m * 1024 + 256 + h * 64 + dt * 16 + 4 * g) = w; } }
    __syncthreads();
}
}

namespace awin {
typedef short bf16x8 __attribute__((ext_vector_type(8)));
typedef float f4 __attribute__((ext_vector_type(4)));
constexpr int EXS = 66;
constexpr int O_EX = 0;
constexpr int VSW = 72;
constexpr int O_VW = 101376;
__device__ __forceinline__ void item(LAS unsigned char* lds0, const int bb, const int blk, const int h, const bf16* P, bf16* OB, const int tid0) {
    unsigned lb_ = 0u; int tid_l = tid0; asm volatile("" : "+v"(lb_), "+v"(tid_l));
    LAS unsigned char* lds = lds0 + lb_; const int tid = tid_l, lane = tid & 63, wave = __builtin_amdgcn_readfirstlane(tid >> 6);
    const bf16* Pb = P + (size_t)bb * T * PP; const int start = blk * 128, g = lane >> 4, ln = lane & 15;
    LAS float* EX = (LAS float*)(lds + O_EX);
    LAS bf16* VW = (LAS bf16*)(lds + O_VW + wave * 4608);
#pragma unroll 1
    for (int s4 = 0; s4 < 4; ++s4) {
        const int st = wave * 4 + s4;
        const int grp = st < 8 ? 0 : (st < 16 ? 1 : 2);
        const int dil = grp == 0 ? 1 : (grp == 1 ? 4 : 16), win = grp == 0 ? 128 : (grp == 1 ? 512 : 2048);
        const int r = grp == 0 ? 0 : (grp == 1 ? ((st - 8) >> 1) : (st - 16)), a0 = grp == 0 ? 16 * st : (grp == 1 ? ((st - 8) & 1) * 16 : 0), nqc = grp == 0 ? 128 : (grp == 1 ? 32 : 8);
        const int a = a0 + ln; const bool qok = a < nqc; const int ql = (qok ? a : (nqc - 1)) * dil + r, tq = start + ql;
        const bf16* qp = Pb + (size_t)tq * PP + C_AQ + grp * 256 + h * 64 + g * 8;
        const bf16x8 q0 = *(const bf16x8*)qp, q1 = *(const bf16x8*)(qp + 32);
        bf16x8 kf[10][2];
#pragma unroll
        for (int kt = 0; kt < 10; ++kt) { int pos = start - win + (a0 + 16 * kt + ln) * dil + r; pos = pos < 0 ? 0 : (pos > T - 1 ? T - 1 : pos);
            const bf16* kp = Pb + (size_t)pos * PP + C_AK + grp * 256 + h * 64 + g * 8; kf[kt][0] = *(const bf16x8*)kp; kf[kt][1] = *(const bf16x8*)(kp + 32); }
        f4 sc[10]; float mx = -INFINITY;
#pragma unroll
        for (int kt = 0; kt < 10; ++kt) { f4 t = (f4){0.f, 0.f, 0.f, 0.f};
            t = __builtin_amdgcn_mfma_f32_16x16x32_bf16(kf[kt][0], q0, t, 0, 0, 0); t = __builtin_amdgcn_mfma_f32_16x16x32_bf16(kf[kt][1], q1, t, 0, 0, 0);
#pragma unroll
            for (int e = 0; e < 4; ++e) { const int c = a0 + 16 * kt + 4 * g + e; const int pos = start - win + c * dil + r;
                const bool ok = qok && c >= a && c <= a + 128 && pos >= 0;
                sc[kt][e] = ok ? t[e] * 0.125f : -INFINITY; mx = fmaxf(mx, sc[kt][e]); } }
        mx = fmaxf(mx, __shfl_xor(mx, 16)); mx = fmaxf(mx, __shfl_xor(mx, 32));
        const float msafe = (mx == -INFINITY) ? 0.f : mx; float lsum = 0.f;
#pragma unroll
        for (int kt = 0; kt < 10; ++kt)
#pragma unroll
            for (int e = 0; e < 4; ++e) { sc[kt][e] = __expf(sc[kt][e] - msafe); lsum += sc[kt][e]; }
        lsum += __shfl_xor(lsum, 16); lsum += __shfl_xor(lsum, 32);
        f4 oacc[4];
#pragma unroll
        for (int dt = 0; dt < 4; ++dt) oacc[dt] = (f4){0.f, 0.f, 0.f, 0.f};
#pragma unroll
        for (int s5 = 0; s5 < 5; ++s5) {
            int pos = start - win + (a0 + 32 * s5 + (lane >> 1)) * dil + r; pos = pos < 0 ? 0 : (pos > T - 1 ? T - 1 : pos);
            const u32x4* vp = (const u32x4*)(Pb + (size_t)pos * PP + C_AV + grp * 256 + h * 64 + (lane & 1) * 32);
            const u32x4 v0 = vp[0], v1 = vp[1], v2 = vp[2], v3 = vp[3];
            LAS u32x4* vd = (LAS u32x4*)(VW + (lane >> 1) * VSW + (lane & 1) * 32);
            asm volatile("s_waitcnt lgkmcnt(0)" ::: "memory");
            vd[0] = v0; vd[1] = v1; vd[2] = v2; vd[3] = v3;
            asm volatile("s_waitcnt lgkmcnt(0)" ::: "memory");
            bf16x8 pb;
#pragma unroll
            for (int e = 0; e < 4; ++e) { pb[e] = (short)f2bf(sc[2 * s5][e]); pb[4 + e] = (short)f2bf(sc[2 * s5 + 1][e]); }
#pragma unroll
            for (int dt = 0; dt < 4; ++dt) { bf16x8 vf; const LAS bf16* vb = VW + (4 * g) * VSW + dt * 16 + ln;
#pragma unroll
                for (int e = 0; e < 4; ++e) { vf[e] = (short)vb[e * VSW]; vf[4 + e] = (short)vb[(16 + e) * VSW]; }
                oacc[dt] = __builtin_amdgcn_mfma_f32_16x16x32_bf16(vf, pb, oacc[dt], 0, 0, 0); }
        }
        if (qok) { LAS float* ex = EX + (grp * 128 + ql) * EXS;
#pragma unroll
            for (int dt = 0; dt < 4; ++dt) { ex[dt * 16 + 4 * g + 0] = oacc[dt][0]; ex[dt * 16 + 4 * g + 1] = oacc[dt][1]; ex[dt * 16 + 4 * g + 2] = oacc[dt][2]; ex[dt * 16 + 4 * g + 3] = oacc[dt][3]; }
            if (g == 0) { ex[64] = mx; ex[65] = lsum; } }
    }
    __syncthreads();
    { const int ql = tid >> 2, d0 = (tid & 3) * 16;
      const LAS float* e0 = EX + (0 * 128 + ql) * EXS; const LAS float* e1 = EX + (1 * 128 + ql) * EXS; const LAS float* e2 = EX + (2 * 128 + ql) * EXS;
      const float m0 = e0[64], m1 = e1[64], m2 = e2[64], M = fmaxf(m0, fmaxf(m1, m2));
      const float w0 = __expf(m0 - M), w1 = __expf(m1 - M), w2 = __expf(m2 - M); const float inv = 1.f / (w0 * e0[65] + w1 * e1[65] + w2 * e2[65]);
      unsigned pk[8];
#pragma unroll
      for (int j = 0; j < 8; ++j) { const float x0 = (w0 * e0[d0 + 2 * j] + w1 * e1[d0 + 2 * j] + w2 * e2[d0 + 2 * j]) * inv, x1 = (w0 * e0[d0 + 2 * j + 1] + w1 * e1[d0 + 2 * j + 1] + w2 * e2[d0 + 2 * j + 1]) * inv; pk[j] = pk2(x0, x1); }
      u32x4* op = (u32x4*)(OB + ((size_t)bb * T + start + ql) * 1024 + h * 64 + d0);
      op[0] = (u32x4){pk[0], pk[1], pk[2], pk[3]}; op[1] = (u32x4){pk[4], pk[5], pk[6], pk[7]}; }
    __syncthreads();
}
}

template <int SP>
__device__ __forceinline__ void phase_body(const int l_in, LAS unsigned char* lds) {
    int tid_ = threadIdx.x, bid_ = blockIdx.x, l_ = l_in, G_ = gridDim.x; asm volatile("" : "+v"(tid_), "+s"(bid_), "+s"(l_), "+s"(G_));
    const int tid = tid_, lane = tid & 63, wave = __builtin_amdgcn_readfirstlane(tid >> 6), l = l_;
    const int G = G_, bid = bid_;
    const int gw = bid * NWAVES + wave, NGW = G * NWAVES;
    unsigned char* ws = (unsigned char*)gptr(ldptr(lds, 36));
    int* ctl = (int*)(ws + WS_CTL);
    bf16* XB = (bf16*)(ws + WS_XB); bf16* OB = (bf16*)(ws + WS_O); bf16* VF = (bf16*)(ws + WS_VF); bf16* P = (bf16*)(ws + WS_P);
    bf16* GS = (bf16*)(ws + WS_GS); bf16* MG = (bf16*)(ws + WS_MERGED); bf16* XS = (bf16*)(ws + WS_XS); bf16* HB = (bf16*)(ws + WS_H);
    bf16* WGU = (bf16*)(ws + WS_WGU); bf16* WD = (bf16*)(ws + WS_WD);
    float* X = (float*)gptr(ldptr(lds, 35));
    int* tok_e = (int*)(ws + WS_ROUTE); float* tok_g = (float*)(ws + WS_ROUTE + 256 * 1024); int* tok_rank = (int*)(ws + WS_ROUTE + 512 * 1024); int* tok_slot = (int*)(ws + WS_ROUTE + 768 * 1024);
    (void)ctl; (void)XB; (void)OB; (void)VF; (void)P; (void)GS; (void)MG; (void)XS; (void)HB; (void)WGU; (void)WD; (void)X; (void)tok_e; (void)tok_g; (void)tok_rank; (void)tok_slot; (void)gw; (void)NGW; (void)lane;
    {
        bf16* WinT = (bf16*)(ws + WS_WINT) + (size_t)l * 5120 * 1024; bf16* WgT = (bf16*)(ws + WS_WGT) + (size_t)l * 4096 * 1024;
        bf16* WbrT = (bf16*)(ws + WS_WBRT) + (size_t)l * 1024 * 1024; bf16* WoutT = (bf16*)(ws + WS_WOUTT) + (size_t)l * 1024 * 1024;
        float* WrT = (float*)(ws + WS_WRT) + (size_t)l * 36 * 1024;
        int* cnt = ctl + CW_CNT + l * 64;

        if constexpr (SP == -1) {
            LAS float* scr = (LAS float*)(lds + wave * 16384);
#pragma unroll 1
            for (int job = 0; job < NL * 11; ++job) {
                const int ll = job / 11, jk = job % 11;
                if (jk < 5) {
                    const float* W = INP(I_WIN) + (size_t)ll * 1024 * INW;
                    const int sc0 = jk == 0 ? 0 : (jk == 1 ? 3396 : (jk == 2 ? 3392 : (jk == 3 ? 5060 : 5064)));
                    const int snc = jk == 0 ? 3392 : (jk == 1 ? 1664 : (jk == 4 ? 4096 : 4));
                    const int sr0 = jk == 0 ? 0 : (jk == 1 ? 3392 : (jk == 2 ? 5056 : (jk == 3 ? 5060 : 0)));
                    bf16* dst = jk == 4 ? (bf16*)(ws + WS_WGT) + (size_t)ll * 4096 * 1024 : (bf16*)(ws + WS_WINT) + (size_t)ll * 5120 * 1024;
                    const int nbn = (snc + 31) / 32, nit = 16 * nbn;
#pragma unroll 1
                    for (int it = gw; it < nit; it += NGW) transpose_item(W, INW, sc0, snc, dst, 1024, sr0, 0, it / nbn, it % nbn, scr, lane);
                } else if (jk < 9) {
                    const int n = jk - 5; const float* Wb = INP(I_WBR) + ((size_t)ll * 4 + n) * 256 * 1024;
#pragma unroll 1
                    for (int it = gw; it < 4 * 32; it += NGW) transpose_item(Wb, 1024, 0, 1024, (bf16*)(ws + WS_WBRT) + (size_t)ll * 1024 * 1024, 1024, 0, n * 256, it / 32, it % 32, scr, lane);
                } else if (jk == 9) {
                    const float* Wo = INP(I_WOUT) + (size_t)ll * 1024 * 1024;
#pragma unroll 1
                    for (int it = gw; it < 16 * 32; it += NGW) transpose_item(Wo, 1024, 0, 1024, (bf16*)(ws + WS_WOUTT) + (size_t)ll * 1024 * 1024, 1024, 0, 0, it / 32, it % 32, scr, lane);
                } else {
                    bf16* wi = (bf16*)(ws + WS_WINT) + (size_t)ll * 5120 * 1024;
#pragma unroll 1
                    for (int i = gw * 64 + lane; i < 56 * 1024 / 8; i += NGW * 64) ((u32x4*)(wi + (size_t)5064 * 1024))[i] = (u32x4){0u, 0u, 0u, 0u};
                    float* wr = (float*)(ws + WS_WRT) + (size_t)ll * 36 * 1024; const float* rg = INP(I_RG) + (size_t)ll * 1024 * 4; const float* re = INP(I_RE) + (size_t)ll * 1024 * 32;
#pragma unroll 1
                    for (int i = gw * 64 + lane; i < 36 * 1024; i += NGW * 64) { const int o = i / 1024, k = i % 1024; wr[i] = o < 4 ? rg[k * 4 + o] : re[k * 32 + (o - 4)]; }
                }
            }
            for (int m = gw; m < M; m += NGW) {
                const f32x4* xr = (const f32x4*)(INP(I_X) + (size_t)m * D) + lane;
#pragma unroll
                for (int j = 0; j < 4; ++j) { const f32x4 v = xr[64 * j]; ((f32x4*)(X + (size_t)m * D))[lane + 64 * j] = v;
                    u32x2 w; w.x = pk2(v[0], v[1]); w.y = pk2(v[2], v[3]); ((u32x2*)(XB + (size_t)m * D))[lane + 64 * j] = w; }
            }
        }
        else if constexpr (SP == 0) {
            pg8::Gemm g{XB, WinT, 1024, 1024, 1024}; pg8::StaticOrder S; S.init(M, PP, G, bid, 1024, 1024);
            EpiStoreBf16 E{P, PP, 0, PP};
            pg8::gemm_phase<EpiStoreBf16, pg8::StaticOrder>(lds, g, S, E);
        }
        else if constexpr (SP == 12) {
            if (bid < 32) rw::carry(lds, ws + WS_RW + (size_t)bid * 64 * 16384, tid);
        }
        else if constexpr (SP == 13) {
            unsigned char* GZ = ws + WS_RW;
            const int h = bid & 3, k = bid >> 2;
            rw::build_ct(lds, l, h, lane, wave); __syncthreads();
#pragma unroll 1
            for (int idx = k; idx < 512; idx += (G >> 2)) { const int b = idx >> 6, cI = idx & 63; const size_t ci_ = (size_t)((b * 4 + h) * 64 + cI);
                rw::chunk_out(lds, b, h, cI * 64, GZ + ci_ * 16384, ws + WS_RW2 + ci_ * 24576, (const float*)(ws + WS_BONG) + ci_ * 64, VF, OB, tid); }
        }
        else if constexpr (SP == 15) {
            unsigned char* GZ = ws + WS_RW;
            int* qctr = ctl + CW_Q + l * 64;
            int cur_h = -1;
#pragma unroll 1
            for (;;) {
                unsigned so = (unsigned)(LDS_BYTES - 584); asm volatile("" : "+v"(so));
                volatile LAS int* slot = (volatile LAS int*)(lds + so);
                int tid = threadIdx.x; asm volatile("" : "+v"(tid));
                const int lane = tid & 63, wave = __builtin_amdgcn_readfirstlane(tid >> 6);
                __syncthreads();
                if (tid == 0) *slot = atomicAdd(qctr, 1);
                __syncthreads();
                const int it = __builtin_amdgcn_readfirstlane(*slot);
                if (it >= 3344) break;
                if (it < 16) { mb::chain(lds, l, it >> 1, it & 1, P, OB, tid, lane, wave); }
                else if (it < 272) { const int j = it - 16; bsp::item(lds, j & 7, 31 - (j >> 3), P, OB, tid, (int)(unsigned)ldptr(lds, 37)); }
                else if (it < 2320) { const int j = it - 272, h = j >> 9, idx = j & 511, b = idx >> 6, cI = idx & 63;
                    if (h != cur_h) { rw::build_ct(lds, l, h, lane, wave); cur_h = h; __syncthreads(); }
                    { const size_t ci_ = (size_t)((b * 4 + h) * 64 + cI); rw::chunk<1>(lds, l, b, h, cI * 64, GZ + ci_ * 16384, ws + WS_RW2 + ci_ * 24576, (float*)(ws + WS_BONG) + ci_ * 64, P, VF, OB, tid); } }
                else { const int j = it - 2320; awin::item(lds, j >> 7, (j >> 2) & 31, j & 3, P, OB, tid); }
            }
        }
        else if constexpr (SP == 4) {
            pg8::Gemm g{XB, WgT, 1024, 1024, 1024}; pg8::StaticOrder S; S.init(M, 4096, G, bid, 1024, 1024);
            EpiStoreBf16 E{GS, 4096, 1, 4096};
            pg8::gemm_phase<EpiStoreBf16, pg8::StaticOrder>(lds, g, S, E);
        }
        else if constexpr (SP == 5) {
            pg8::Gemm g{OB, WbrT, 1024, 1024, 256}; BranchOrder S{M / 256, 4, G, bid};
            EpiBranch E{GS, MG};
            pg8::gemm_phase<EpiBranch, BranchOrder>(lds, g, S, E);
        }
        else if constexpr (SP == 6) {
            pg8::Gemm g{MG, WoutT, 1024, 1024, 1024}; pg8::StaticOrder S; S.init(M, 1024, G, bid, 1024, 1024);
            EpiResid E{X};
            pg8::gemm_phase<EpiResid, pg8::StaticOrder>(lds, g, S, E);
        }
        else if constexpr (SP == 7) {
            const float* g1 = INP(I_LN1G) + l * 1024; const float* b1 = INP(I_LN1B) + l * 1024;
            const float* rgb = INP(I_RGB) + l * 4; const float* reb = INP(I_REB) + l * 32;
            f32x4 vn[4];
#pragma unroll
            for (int j = 0; j < 4; ++j) vn[j] = ((const f32x4*)(X + (size_t)gw * D))[lane + 64 * j];
#pragma unroll 1
            for (int m = gw; m < M; m += NGW) {
                f32x4 v[4]; float s = 0.f; f32x4* xr = (f32x4*)(X + (size_t)m * D) + lane;
#pragma unroll
                for (int j = 0; j < 4; ++j) { v[j] = vn[j]; s += (v[j][0] + v[j][1]) + (v[j][2] + v[j][3]); }
                { const int mnx = (m + NGW < M) ? m + NGW : m;
#pragma unroll
                  for (int j = 0; j < 4; ++j) vn[j] = ((const f32x4*)(X + (size_t)mnx * D))[lane + 64 * j]; }
                const float mean = wave_sum(s) * (1.f / D); float s2 = 0.f;
#pragma unroll
                for (int j = 0; j < 4; ++j) { v[j] = v[j] - mean; s2 += (v[j][0] * v[j][0] + v[j][1] * v[j][1]) + (v[j][2] * v[j][2] + v[j][3] * v[j][3]); }
                const float rstd = rsqrtf(wave_sum(s2) * (1.f / D) + LN_EPS);
#pragma unroll
                for (int j = 0; j < 4; ++j) { const f32x4 gg = ((const f32x4*)g1)[lane + 64 * j], bb = ((const f32x4*)b1)[lane + 64 * j]; v[j] = v[j] * rstd * gg + bb; xr[64 * j] = v[j];
                    u32x2 w; w.x = pk2(v[j][0], v[j][1]); w.y = pk2(v[j][2], v[j][3]); ((u32x2*)(XB + (size_t)m * D))[lane + 64 * j] = w; }
                float mylg = 0.f;
#pragma unroll 1
                for (int o4 = 0; o4 < 36; o4 += 4) { float a4[4];
#pragma unroll
                    for (int u = 0; u < 4; ++u) { float a = 0.f;
#pragma unroll
                        for (int j = 0; j < 4; ++j) { const f32x4 wv = ((const f32x4*)(WrT + (o4 + u) * 1024))[lane + 64 * j]; a += v[j][0] * wv[0] + v[j][1] * wv[1] + v[j][2] * wv[2] + v[j][3] * wv[3]; }
                        a4[u] = a; }
#pragma unroll
                    for (int sft = 1; sft < 64; sft <<= 1) {
#pragma unroll
                        for (int u = 0; u < 4; ++u) a4[u] += __shfl_xor(a4[u], sft); }
#pragma unroll
                    for (int u = 0; u < 4; ++u) mylg = (lane == o4 + u) ? a4[u] : mylg; }
                mylg += lane < 4 ? rgb[lane & 3] : (lane < 36 ? reb[(lane - 4) & 31] : 0.f);
                float gl[4]; float gm = -INFINITY; int gs = 0;
#pragma unroll
                for (int o = 0; o < 4; ++o) { gl[o] = __shfl(mylg, o); if (gl[o] > gm) { gm = gl[o]; gs = o; } }
                float gden = 0.f;
#pragma unroll
                for (int o = 0; o < 4; ++o) gden += __expf(gl[o] - gm);
                const float pg = 1.f / gden;
                float el[8];
#pragma unroll
                for (int o = 0; o < 8; ++o) el[o] = __shfl(mylg, 4 + gs * 8 + o);
                int e1 = 0; float m1 = el[0];
#pragma unroll
                for (int o = 1; o < 8; ++o) if (el[o] > m1) { m1 = el[o]; e1 = o; }
                int e2 = -1; float m2 = -INFINITY;
#pragma unroll
                for (int o = 0; o < 8; ++o) if (o != e1 && el[o] > m2) { m2 = el[o]; e2 = o; }
                const float r2 = __expf(m2 - m1); const float ga = pg / (1.f + r2), gb = pg * r2 / (1.f + r2);
                if (lane == 0) {
                    const int E1 = gs * 8 + e1, E2 = gs * 8 + e2;
                    tok_e[m * 2] = E1; tok_e[m * 2 + 1] = E2; tok_g[m * 2] = ga; tok_g[m * 2 + 1] = gb;
                    tok_rank[m * 2] = atomicAdd(&cnt[E1], 1); tok_rank[m * 2 + 1] = atomicAdd(&cnt[E2], 1);
                }
            }
        }
        else if constexpr (SP == 14) {
            LAS float* scr = (LAS float*)(lds + wave * 16384);
            const float* eg = INP(I_EG) + (size_t)l * NEXP * 1024 * 512; const float* eu = INP(I_EU) + (size_t)l * NEXP * 1024 * 512; const float* ed = INP(I_ED) + (size_t)l * NEXP * 512 * 1024;
            for (int it = gw; it < NEXP * 2 * 4 * 64; it += NGW) {
                const int e = it / 512, r = it % 512, half = r / 256, ct = (r % 256) / 64, q = r % 64, kb = q / 4, nb = q % 4;
                const float* W = (half ? eu : eg) + (size_t)e * 1024 * 512;
                transpose_item(W, 512, ct * 128, 128, WGU + (size_t)e * 1024 * 1024, 1024, ct * 256 + half * 128, 0, kb, nb, scr, lane);
            }
            for (int it = gw; it < NEXP * 8 * 32; it += NGW) {
                const int e = it / 256, q = it % 256, kb = q / 32, nb = q % 32;
                transpose_item(ed + (size_t)e * 512 * 1024, 1024, 0, 1024, WD + (size_t)e * 1024 * 512, 512, 0, 0, kb, nb, scr, lane);
            }
        }
        else if constexpr (SP == 8 || SP == 9 || SP == 10) {
            unsigned tbo = MISC_OFF; asm volatile("" : "+v"(tbo));
            volatile LAS int* tb = (volatile LAS int*)(lds + tbo);
            if (tid == 0) { int acc = 0; for (int e = 0; e < 32; ++e) { const int c = __hip_atomic_load(&cnt[e], __ATOMIC_RELAXED, __HIP_MEMORY_SCOPE_AGENT); tb[e] = acc; tb[33 + e] = acc; acc += (c + 255) >> 8; } tb[32] = acc; }
            __syncthreads();
            if constexpr (SP == 8) {
                for (int m = gw; m < M; m += NGW) {
#pragma unroll
                    for (int k = 0; k < 2; ++k) { const int e = tok_e[m * 2 + k]; const int slot = tb[33 + e] * 256 + tok_rank[m * 2 + k];
                        const u32x4* src = (const u32x4*)(XB + (size_t)m * D); u32x4* dst = (u32x4*)(XS + (size_t)slot * D);
                        dst[lane] = src[lane]; dst[lane + 64] = src[lane + 64];
                        if (lane == 0) tok_slot[m * 2 + k] = slot; }
                }
            } else if constexpr (SP == 9) {
                pg8::Gemm g{XS, WGU, 1024, 1024, 1024}; MoeOrder S{tb, G, bid, (size_t)1024 * 2, (size_t)1024 * 1024 * 2, (size_t)256 * 1024 * 2};
                EpiSwiglu E{HB};
                pg8::gemm_phase<EpiSwiglu, MoeOrder>(lds, g, S, E);
            } else {
                pg8::Gemm g{HB, WD, 512, 512, 512}; MoeOrder S{tb, G, bid, (size_t)512 * 2, (size_t)1024 * 512 * 2, (size_t)256 * 512 * 2};
                EpiStoreBf16 E{XS, 1024, 0, 1024};
                pg8::gemm_phase<EpiStoreBf16, MoeOrder>(lds, g, S, E);
            }
        }
        else if constexpr (SP == 11) {
            const float* g2 = INP(I_LN2G) + l * 1024; const float* b2 = INP(I_LN2B) + l * 1024;
            f32x4 xn[4]; u32x2 y1n[4], y2n[4]; float gan, gbn;
#define LN2_LOAD(mm) do { const int s1_ = tok_slot[(mm) * 2], s2_ = tok_slot[(mm) * 2 + 1]; gan = tok_g[(mm) * 2]; gbn = tok_g[(mm) * 2 + 1]; \
                _Pragma("unroll") for (int j = 0; j < 4; ++j) { xn[j] = ((const f32x4*)(X + (size_t)(mm) * D))[lane + 64 * j]; y1n[j] = ((const u32x2*)(XS + (size_t)s1_ * D))[lane + 64 * j]; y2n[j] = ((const u32x2*)(XS + (size_t)s2_ * D))[lane + 64 * j]; } } while (0)
            LN2_LOAD(gw);
#pragma unroll 1
            for (int m = gw; m < M; m += NGW) {
                const float ga = gan, gb = gbn;
                f32x4 v[4]; float s = 0.f; f32x4* xr = (f32x4*)(X + (size_t)m * D) + lane;
                u32x2 y1c[4], y2c[4];
#pragma unroll
                for (int j = 0; j < 4; ++j) { v[j] = xn[j] * ALPHA; y1c[j] = y1n[j]; y2c[j] = y2n[j]; }
                { const int mnx = (m + NGW < M) ? m + NGW : m; LN2_LOAD(mnx); }
#pragma unroll
                for (int j = 0; j < 4; ++j) { const u32x2 y1 = y1c[j], y2 = y2c[j];
                    v[j][0] += ga * __uint_as_float(y1.x << 16) + gb * __uint_as_float(y2.x << 16); v[j][1] += ga * __uint_as_float(y1.x & 0xffff0000u) + gb * __uint_as_float(y2.x & 0xffff0000u);
                    v[j][2] += ga * __uint_as_float(y1.y << 16) + gb * __uint_as_float(y2.y << 16); v[j][3] += ga * __uint_as_float(y1.y & 0xffff0000u) + gb * __uint_as_float(y2.y & 0xffff0000u);
                    s += (v[j][0] + v[j][1]) + (v[j][2] + v[j][3]); }
                const float mean = wave_sum(s) * (1.f / D); float s2 = 0.f;
#pragma unroll
                for (int j = 0; j < 4; ++j) { v[j] = v[j] - mean; s2 += (v[j][0] * v[j][0] + v[j][1] * v[j][1]) + (v[j][2] * v[j][2] + v[j][3] * v[j][3]); }
                const float rstd = rsqrtf(wave_sum(s2) * (1.f / D) + LN_EPS);
#pragma unroll
                for (int j = 0; j < 4; ++j) { const f32x4 gg = ((const f32x4*)g2)[lane + 64 * j], bb = ((const f32x4*)b2)[lane + 64 * j]; v[j] = v[j] * rstd * gg + bb; xr[64 * j] = v[j];
                    u32x2 w; w.x = pk2(v[j][0], v[j][1]); w.y = pk2(v[j][2], v[j][3]); ((u32x2*)(XB + (size_t)m * D))[lane + 64 * j] = w; }
            }
        }
    }
}

template <int SP>
__global__ void __launch_bounds__(NTHR, 2) k_phase(Args args, int l) {
    extern __shared__ __attribute__((aligned(16))) unsigned char lds_raw[];
    ptr_table_fill(args, (LAS unsigned char*)lds_raw);
    phase_body<SP>(l, (LAS unsigned char*)lds_raw);
}


#define XB_TMO      128
#define XB_XCNT(j)  (256  + 64 * (j))
#define XB_XSUB(j)  (1280 + 64 * (j))
#define XB_XGEN(j)  (2304 + 64 * (j))
#define XB_TOP      3328
#define XB_TOPGEN   3392
#define XCD_BAR_WORDS 3456
#define XB_SPIN_CAP (1u << 22)
__device__ __forceinline__ unsigned xb_ld(unsigned* p)              { return __hip_atomic_load(p, __ATOMIC_RELAXED, __HIP_MEMORY_SCOPE_AGENT); }
__device__ __forceinline__ unsigned xb_add(unsigned* p, unsigned v) { return __hip_atomic_fetch_add(p, v, __ATOMIC_RELAXED, __HIP_MEMORY_SCOPE_AGENT); }
__device__ __forceinline__ unsigned xb_xcc_id() { return (unsigned)__builtin_amdgcn_s_getreg((3 << 11) | 20) & 0xFu; }
#define XB_SPIN(cond, bar) do { unsigned _sp = 0; while (cond) { __builtin_amdgcn_s_sleep(1); \
    if ((++_sp & 255u) == 0u) { if (xb_ld(&(bar)[XB_TMO])) break; if (_sp > XB_SPIN_CAP) { atomicAdd(&(bar)[XB_TMO], 1u); break; } } } } while (0)
__device__ __forceinline__ void xcd_barrier_complete(unsigned* bar, unsigned x, unsigned& nloc, unsigned& nx) {
    const unsigned G = gridDim.x;
    unsigned sum, cnt, mine, sp = 0u;
    for (;;) {
        sum = 0u; cnt = 0u; mine = 0u;
#pragma unroll
        for (unsigned j = 0; j < 16; ++j) { const unsigned c = xb_ld(&bar[XB_XCNT(j)]); sum += c; cnt += (c > 0u) ? 1u : 0u; mine = (j == x) ? c : mine; }
        if (sum == G) break;
        __builtin_amdgcn_s_sleep(1);
        if ((++sp & 255u) == 0u) { if (xb_ld(&bar[XB_TMO])) break; if (sp > XB_SPIN_CAP) { atomicAdd(&bar[XB_TMO], 1u); break; } }
    }
    nloc = mine > 0u ? mine : 1u; nx = cnt > 0u ? cnt : 1u;
}
__device__ __forceinline__ void xcd_barrier(unsigned* bar, LAS unsigned char* lds) {
    asm volatile("s_waitcnt vmcnt(0)" ::: "memory");
    __syncthreads();
    int tid_ = threadIdx.x; asm volatile("" : "+v"(tid_));
    if (tid_ == 0) {
        unsigned so = (unsigned)(LDS_BYTES - 576); asm volatile("" : "+v"(so));
        volatile LAS unsigned* st = (volatile LAS unsigned*)(lds + so);
        __builtin_amdgcn_s_waitcnt(0);
        const unsigned x = xb_xcc_id();
        unsigned nloc = st[0], nx = st[1];
        if (nloc == 0u) { xcd_barrier_complete(bar, x, nloc, nx); st[0] = nloc; st[1] = nx; }
        const unsigned old = xb_add(&bar[XB_XSUB(x)], 1u);
        const unsigned gen = old / nloc;
        if (old + 1u == (gen + 1u) * nloc) {
            __builtin_amdgcn_fence(__ATOMIC_RELEASE, "agent");
            asm volatile("s_waitcnt vmcnt(0)" ::: "memory");
            const unsigned og = xb_add(&bar[XB_TOP], 1u);
            const unsigned tg = og / nx;
            if (og + 1u == (tg + 1u) * nx) xb_add(&bar[XB_TOPGEN], 1u);
            else XB_SPIN(xb_ld(&bar[XB_TOPGEN]) == tg, bar);
            __builtin_amdgcn_fence(__ATOMIC_ACQUIRE, "agent");
            xb_add(&bar[XB_XGEN(x)], 1u);
            asm volatile("s_waitcnt vmcnt(0)" ::: "memory");
        } else {
            XB_SPIN(xb_ld(&bar[XB_XGEN(x)]) == gen, bar);
            __builtin_amdgcn_fence(__ATOMIC_ACQUIRE, "agent");
            asm volatile("s_waitcnt vmcnt(0)" ::: "memory");
        }
    }
    __syncthreads();
}
namespace cg = cooperative_groups;
__global__ void __launch_bounds__(NTHR, 2) fwd_all(Args args) {
    extern __shared__ __attribute__((aligned(16))) unsigned char lds_raw[];
    LAS unsigned char* lds = (LAS unsigned char*)lds_raw;
    unsigned* bar = (unsigned*)(args.ws + WS_CTL) + CW_BAR;
    if (threadIdx.x == 0) { ((volatile LAS unsigned*)(lds + LDS_BYTES - 576))[0] = 0u; ((volatile LAS unsigned*)(lds + LDS_BYTES - 576))[1] = 0u; (void)xb_add(&bar[XB_XCNT(xb_xcc_id())], 1u); }
    ptr_table_fill(args, lds);
    const int probe = args.ph_lo;
    { constexpr int l = 0;
#pragma unroll 1
      for (int r_ = 0; r_ < ((probe == -1) ? 2 : 1); ++r_) { phase_body<-1>(l, lds); __syncthreads(); } }
    cg::this_grid().sync();
#define GRID_BAR() do { unsigned* bar_ = (unsigned*)gptr(ldptr(lds, 36)) + CW_BAR; xcd_barrier(bar_, lds); } while (0)
#define RUN(SP) do { _Pragma("unroll 1") for (int r_ = 0; r_ < ((probe == (SP)) ? 2 : 1); ++r_) { phase_body<SP>(l, lds); __syncthreads(); } } while (0)
#define ONCE(SP) do { phase_body<SP>(l, lds); __syncthreads(); } while (0)
#define LAYER() \
        RUN(0); GRID_BAR(); \
        ONCE(15); GRID_BAR(); \
        ONCE(12); GRID_BAR(); \
        RUN(13); GRID_BAR(); \
        RUN(4); GRID_BAR(); \
        RUN(5); GRID_BAR(); \
        ONCE(6); GRID_BAR(); \
        ONCE(7); RUN(14); GRID_BAR(); \
        RUN(8); GRID_BAR(); \
        RUN(9); GRID_BAR(); \
        RUN(10); GRID_BAR(); \
        ONCE(11); GRID_BAR();
    { constexpr int l = 0; LAYER() }
    { constexpr int l = 1; LAYER() }
#undef LAYER
#undef RUN
#undef ONCE
#undef GRID_BAR
}

template <int SP> static void launch_phase(const Args& a, int l, int grid, hipStream_t stream) {
    static bool attr = false;
    if (!attr) { (void)hipFuncSetAttribute((const void*)k_phase<SP>, hipFuncAttributeMaxDynamicSharedMemorySize, LDS_BYTES); attr = true; }
    hipLaunchKernelGGL(k_phase<SP>, dim3(grid), dim3(NTHR), LDS_BYTES, stream, a, l);
}

extern "C" void kernel_launch(void* const* d_in, const int* in_sizes, int n_in, void* d_out, int out_size, void* d_ws, size_t ws_size, hipStream_t stream) {
    static int grid = 0;
    if (grid == 0) {
        if (n_in != 35 || out_size != M * D || ws_size < WS_END) { fprintf(stderr, "kernel_launch: unexpected problem (n_in %d out %d ws %zu)\n", n_in, out_size, ws_size); grid = -1; return; }
        int dev = 0, cus = 0, per_cu = 0;
        (void)hipGetDevice(&dev); (void)hipDeviceGetAttribute(&cus, hipDeviceAttributeMultiprocessorCount, dev);
#if N_LAUNCH_MODE == 1
        (void)hipFuncSetAttribute((const void*)fwd_all, hipFuncAttributeMaxDynamicSharedMemorySize, LDS_BYTES);
        if (hipOccupancyMaxActiveBlocksPerMultiprocessor(&per_cu, (const void*)fwd_all, NTHR, LDS_BYTES) != hipSuccess || per_cu < 1) { fprintf(stderr, "kernel_launch: occupancy query says %d blocks/CU\n", per_cu); grid = -1; return; }
#endif
        (void)per_cu;
        grid = cus;
        if (grid != 256) { fprintf(stderr, "kernel_launch: built for 256 CUs, found %d\n", cus); grid = -1; return; }
    }
    if (grid < 0) return;
    (void)hipMemsetAsync((char*)d_ws + WS_CTL, 0, CTL_BYTES, stream);
    Args a{};
    for (int i = 0; i < 35; ++i) a.in[i] = (const float*)d_in[i];
    a.out = (float*)d_out; a.ws = (unsigned char*)d_ws;
#if N_LAUNCH_MODE == 1
    a.ph_lo = PROBE_REPS;
    void* kargs[] = {(void*)&a};
    hipError_t e = hipLaunchCooperativeKernel((const void*)fwd_all, dim3(grid), dim3(NTHR), kargs, LDS_BYTES, stream);
    if (e != hipSuccess) fprintf(stderr, "cooperative launch failed: %s\n", hipGetErrorString(e));
#else
    launch_phase<-1>(a, 0, grid, stream);
    for (int l = 0; l < NL; ++l) {
        launch_phase<0>(a, l, grid, stream); launch_phase<15>(a, l, grid, stream); launch_phase<12>(a, l, grid, stream); launch_phase<13>(a, l, grid, stream);
        launch_phase<4>(a, l, grid, stream); launch_phase<5>(a, l, grid, stream); launch_phase<6>(a, l, grid, stream); launch_phase<7>(a, l, grid, stream); launch_phase<14>(a, l, grid, stream);
        launch_phase<8>(a, l, grid, stream); launch_phase<9>(a, l, grid, stream); launch_phase<10>(a, l, grid, stream); launch_phase<11>(a, l, grid, stream);
    }
#endif
}
```

```cpp
#include <hip/hip_runtime.h>
#include <cstdio>
#include <cstdint>
#include <hip/hip_cooperative_groups.h>

#ifndef PROBE_REPS
#define PROBE_REPS -100
#endif
#ifndef N_LAUNCH_MODE
#define N_LAUNCH_MODE 1
#endif

namespace pg8 {
#define PG8_LAS __attribute__((address_space(3)))
typedef unsigned short bf16_t;
typedef short bf16x8 __attribute__((ext_vector_type(8)));
typedef float f32x4 __attribute__((ext_vector_type(4)));
typedef unsigned u32x4 __attribute__((ext_vector_type(4)));
constexpr int BM = 256, BK = 64, HALF = 128, HTB = HALF * BK * 2, STAGE_BYTES = 8 * HTB, NXCD = 8, WGM = 8;

__host__ __device__ __forceinline__ int lds_byte(int r, int c) { const int st = (r >> 4) * 2 + (c >> 5), rr = r & 15, cc = c & 31, ob = rr * 64 + cc * 2; return st * 1024 + (ob ^ (((ob >> 9) & 1) << 5)); }
__host__ __device__ __forceinline__ void stage_rc(int b, int& R, int& C) { const int st = b / 1024, sb = b % 1024, swz = sb ^ (((sb >> 9) & 1) << 5); R = (st >> 1) * 16 + swz / 64; C = (st & 1) * 32 + (swz % 64) / 2; }
__host__ __device__ __forceinline__ int perm32(int rho) { const int n = rho >> 4, i = rho & 15; return 8 * (i >> 2) + 4 * n + (i & 3); }

struct Unit { int pm, pn, aux; size_t aoff, boff; };
struct Gemm { const bf16_t* A; const bf16_t* Bt; int lda, ldb, K; };

__device__ __forceinline__ void tile_of(int L, int nM, int nN, int& pm, int& pn) {
    const int nwg = nM * nN; int wgid = L;
    { const int q = nwg / NXCD, r = nwg % NXCD, xcd = wgid % NXCD, off = wgid / NXCD; wgid = (xcd < r ? xcd * (q + 1) : r * (q + 1) + (xcd - r) * q) + off; }
    const int nig = WGM * nN, gid = wgid / nig, fm = gid * WGM, gsz = (nM - fm) < WGM ? (nM - fm) : WGM;
    pm = fm + ((wgid % nig) % gsz); pn = (wgid % nig) / gsz;
}
struct StaticOrder {
    int nM, nN, nwg, G, c, lda, ldb;
    __device__ void init(int M, int N, int G_, int c_, int lda_, int ldb_) { nM = M / BM; nN = N / BM; nwg = nM * nN; G = G_; c = c_; lda = lda_; ldb = ldb_; }
    __device__ bool next(int i, Unit& u) const {
        const long L = (long)i * G + c; if (L >= nwg) return false;
        tile_of((int)L, nM, nN, u.pm, u.pn); u.aux = 0;
        u.aoff = (size_t)u.pm * BM * lda * 2; u.boff = (size_t)u.pn * BM * ldb * 2; return true;
    }
};

__device__ __forceinline__ unsigned cvt_pk_bf16(float lo, float hi) { unsigned r; asm volatile("s_nop 1\n\tv_cvt_pk_bf16_f32 %0, %1, %2" : "=v"(r) : "v"(lo), "v"(hi)); return r; }
__device__ __forceinline__ void epi_mfma_settle() { asm volatile("s_nop 11" ::: "memory"); }

template <class Epi, class Sched, bool ALIGN_EPI = true, bool SP2 = true>
__device__ __forceinline__ void gemm_phase(PG8_LAS unsigned char* lds, const Gemm g, const Sched& S, const Epi& E) {
    int tid_ = threadIdx.x; asm volatile("" : "+v"(tid_));
    const int tid = tid_, wid = __builtin_amdgcn_readfirstlane(tid >> 6), lane = tid & 63, wr = wid >> 2, wc = wid & 3, fr = lane & 15, fq = lane >> 4;
    const int K = g.K, nt = K / BK;
    unsigned voffA[2], voffB[2];
#pragma unroll
    for (int i = 0; i < 2; ++i) { int R, C; stage_rc(tid * 16 + i * 8192, R, C); const int Rb = Epi::PERM ? ((R & ~31) + perm32(R & 31)) : R;
        voffA[i] = (unsigned)(R * g.lda + C) * 2u; voffB[i] = (unsigned)(Rb * g.ldb + C) * 2u; }
    const size_t kstep = (size_t)(BK * 2);
    const size_t hstepA = (size_t)HALF * g.lda * 2, hstepB = (size_t)HALF * g.ldb * 2;
    const unsigned ldsw = (unsigned)wid * 1024u;
    const int aoff = lds_byte(wr * 64 + fr, fq * 8), boff = lds_byte(wc * 32 + fr, fq * 8);
#define PG8_SA(b, h) (((b) * 2 + (h)) * HTB)
#define PG8_SB(b, h) ((4 + (b) * 2 + (h)) * HTB)
#define PG8_STAGE(bufoff, gbase, voff) do { _Pragma("unroll") for (int _i = 0; _i < 2; ++_i) \
        __builtin_amdgcn_global_load_lds((const unsigned*)((const char*)(gbase) + (voff)[_i]), (PG8_LAS unsigned*)(lds + (bufoff) + ldsw + _i * 8192), 16, 0, 0); } while (0)
#define PG8_LDA(dst, b, h) do { _Pragma("unroll") for (int m = 0; m < 4; ++m) _Pragma("unroll") for (int k = 0; k < 2; ++k) dst[m][k] = *(const PG8_LAS bf16x8*)(lds + PG8_SA(b, h) + aoff + m * 2048 + k * 1024); } while (0)
#define PG8_LDB(dst, b, h) do { _Pragma("unroll") for (int n = 0; n < 2; ++n) _Pragma("unroll") for (int k = 0; k < 2; ++k) dst[n][k] = *(const PG8_LAS bf16x8*)(lds + PG8_SB(b, h) + boff + n * 2048 + k * 1024); } while (0)
#define PG8_MMA(ai, bj, At, Bt) do { __builtin_amdgcn_s_setprio(1); _Pragma("unroll") for (int m = 0; m < 4; ++m) _Pragma("unroll") for (int n = 0; n < 2; ++n) _Pragma("unroll") for (int k = 0; k < 2; ++k) \
        acc[ai][bj][m][n] = __builtin_amdgcn_mfma_f32_16x16x32_bf16(Bt[n][k], At[m][k], acc[ai][bj][m][n], 0, 0, 0); __builtin_amdgcn_s_setprio(0); } while (0)
#define PG8_WAIT_V(n) asm volatile("s_waitcnt vmcnt(" #n ")" ::: "memory")
#define PG8_WAIT_L(n) asm volatile("s_waitcnt lgkmcnt(" #n ")" ::: "memory")
#define PG8_BAR __builtin_amdgcn_s_barrier()
#define PG8_SCHED __builtin_amdgcn_sched_barrier(0)
    Unit cur, nxt; int ui = 0;
    if (!S.next(0, cur)) return;
    f32x4 acc[2][2][4][2];
#pragma unroll
    for (int a = 0; a < 2; ++a)
#pragma unroll
        for (int b = 0; b < 2; ++b)
#pragma unroll
            for (int m = 0; m < 4; ++m)
#pragma unroll
                for (int n = 0; n < 2; ++n) acc[a][b][m][n] = (f32x4){0.f, 0.f, 0.f, 0.f};
    bf16x8 At[4][2], B0[2][2], B1[2][2];
    const char* cA = (const char*)g.A + cur.aoff; const char* cB = (const char*)g.Bt + cur.boff;
    if constexpr (SP2) {
        PG8_STAGE(PG8_SB(0, 0), cB, voffB); PG8_STAGE(PG8_SB(0, 1), cB + hstepB, voffB); PG8_STAGE(PG8_SA(0, 0), cA, voffA); PG8_STAGE(PG8_SA(0, 1), cA + hstepA, voffA);
        if (wr == 1) PG8_BAR;
        PG8_WAIT_V(2); PG8_BAR;
        PG8_STAGE(PG8_SB(1, 0), cB + kstep, voffB); PG8_STAGE(PG8_SA(1, 0), cA + kstep, voffA); PG8_STAGE(PG8_SB(1, 1), cB + hstepB + kstep, voffB);
        PG8_WAIT_V(6); PG8_BAR;
    } else {
        PG8_STAGE(PG8_SB(0, 0), cB, voffB); PG8_STAGE(PG8_SA(0, 0), cA, voffA); PG8_STAGE(PG8_SB(0, 1), cB + hstepB, voffB); PG8_STAGE(PG8_SA(0, 1), cA + hstepA, voffA);
        if (wr == 1) PG8_BAR;
        PG8_WAIT_V(4); PG8_BAR;
        PG8_STAGE(PG8_SB(1, 0), cB + kstep, voffB); PG8_STAGE(PG8_SA(1, 0), cA + kstep, voffA); PG8_STAGE(PG8_SB(1, 1), cB + hstepB + kstep, voffB);
        PG8_WAIT_V(6); PG8_BAR;
    }
    for (;;) {
        const bool has_next = S.next(ui + 1, nxt);
        const char* nA = has_next ? (const char*)g.A + nxt.aoff : cA; const char* nB = has_next ? (const char*)g.Bt + nxt.boff : cB;
#pragma unroll 1
        for (int t = 0; t < nt; t += 2) {
            const bool last = (t == nt - 2);
            const char* a1 = cA + (size_t)(t + 1) * kstep;
            const char* a2 = last ? nA : cA + (size_t)(t + 2) * kstep; const char* b2 = last ? nB : cB + (size_t)(t + 2) * kstep;
            const char* a3 = a2 + kstep; const char* b3 = b2 + kstep;
            if constexpr (SP2) {
            PG8_LDB(B0, 0, 0); PG8_LDB(B1, 0, 1); PG8_SCHED; PG8_LDA(At, 0, 0); PG8_STAGE(PG8_SA(1, 1), a1 + hstepA, voffA);
            PG8_WAIT_V(8); PG8_WAIT_L(0); PG8_BAR; PG8_MMA(0, 0, At, B0); PG8_MMA(0, 1, At, B1); PG8_BAR; PG8_SCHED;
            PG8_LDA(At, 0, 1); PG8_STAGE(PG8_SB(0, 0), b2, voffB); PG8_STAGE(PG8_SB(0, 1), b2 + hstepB, voffB); PG8_STAGE(PG8_SA(0, 0), a2, voffA);
            PG8_WAIT_V(8); PG8_WAIT_L(0); PG8_BAR; PG8_MMA(1, 0, At, B0); PG8_MMA(1, 1, At, B1); PG8_BAR; PG8_SCHED;
            PG8_LDB(B0, 1, 0); PG8_LDB(B1, 1, 1); PG8_SCHED; PG8_LDA(At, 1, 0); PG8_STAGE(PG8_SA(0, 1), a2 + hstepA, voffA);
            PG8_WAIT_V(8); PG8_WAIT_L(0); PG8_BAR; PG8_MMA(0, 0, At, B0); PG8_MMA(0, 1, At, B1); PG8_BAR; PG8_SCHED;
            PG8_LDA(At, 1, 1); PG8_STAGE(PG8_SB(1, 0), b3, voffB); PG8_STAGE(PG8_SB(1, 1), b3 + hstepB, voffB); PG8_STAGE(PG8_SA(1, 0), a3, voffA);
            PG8_WAIT_V(8); PG8_WAIT_L(0); PG8_BAR; PG8_MMA(1, 0, At, B0); PG8_MMA(1, 1, At, B1); PG8_BAR; PG8_SCHED;
            } else {
            PG8_LDB(B0, 0, 0); PG8_SCHED; PG8_LDA(At, 0, 0); PG8_STAGE(PG8_SA(1, 1), a1 + hstepA, voffA);
            PG8_WAIT_L(8); PG8_BAR; PG8_WAIT_L(0); PG8_MMA(0, 0, At, B0); PG8_BAR; PG8_SCHED;
            PG8_LDB(B1, 0, 1); PG8_STAGE(PG8_SB(0, 0), b2, voffB);
            PG8_BAR; PG8_WAIT_L(0); PG8_MMA(0, 1, At, B1); PG8_BAR;
            PG8_LDA(At, 0, 1); PG8_STAGE(PG8_SA(0, 0), a2, voffA);
            PG8_BAR; PG8_WAIT_L(0); PG8_MMA(1, 0, At, B0); PG8_BAR; PG8_SCHED;
            PG8_STAGE(PG8_SB(0, 1), b2 + hstepB, voffB);
            PG8_WAIT_V(6); PG8_BAR; PG8_MMA(1, 1, At, B1); PG8_BAR;
            PG8_LDB(B0, 1, 0); PG8_SCHED; PG8_LDA(At, 1, 0); PG8_STAGE(PG8_SA(0, 1), a2 + hstepA, voffA);
            PG8_WAIT_L(8); PG8_BAR; PG8_WAIT_L(0); PG8_MMA(0, 0, At, B0); PG8_BAR; PG8_SCHED;
            PG8_LDB(B1, 1, 1); PG8_STAGE(PG8_SB(1, 0), b3, voffB);
            PG8_BAR; PG8_WAIT_L(0); PG8_MMA(0, 1, At, B1); PG8_BAR;
            PG8_LDA(At, 1, 1); PG8_STAGE(PG8_SA(1, 0), a3, voffA);
            PG8_BAR; PG8_WAIT_L(0); PG8_MMA(1, 0, At, B0); PG8_BAR; PG8_SCHED;
            PG8_STAGE(PG8_SB(1, 1), b3 + hstepB, voffB);
            PG8_WAIT_V(6); PG8_BAR; PG8_MMA(1, 1, At, B1); PG8_BAR;
            }
        }
        if constexpr (ALIGN_EPI) { if (wr == 0) PG8_BAR; }
        E(acc, cur, wr, wc, fr, fq);
        if (!has_next) break;
#pragma unroll
        for (int a = 0; a < 2; ++a)
#pragma unroll
            for (int b = 0; b < 2; ++b)
#pragma unroll
                for (int m = 0; m < 4; ++m)
#pragma unroll
                    for (int n = 0; n < 2; ++n) acc[a][b][m][n] = (f32x4){0.f, 0.f, 0.f, 0.f};
        cur = nxt; cA = nA; cB = nB; ++ui;
        if constexpr (ALIGN_EPI) { if (wr == 1) PG8_BAR; }
    }
    PG8_WAIT_V(0);
    if constexpr (!ALIGN_EPI) { if (wr == 0) PG8_BAR; }
    PG8_BAR;
#undef PG8_SA
#undef PG8_SB
#undef PG8_STAGE
#undef PG8_LDA
#undef PG8_LDB
#undef PG8_MMA
#undef PG8_WAIT_V
#undef PG8_WAIT_L
#undef PG8_BAR
#undef PG8_SCHED
}
}

#define LAS __attribute__((address_space(3)))
typedef unsigned short bf16;
typedef float f32x4 __attribute__((ext_vector_type(4)));
typedef unsigned u32x4 __attribute__((ext_vector_type(4)));
typedef unsigned u32x2 __attribute__((ext_vector_type(2)));

constexpr int NB = 8, T = 4096, D = 1024, M = NB * T, NL = 2;
constexpr int INW = 9160;
constexpr int PP = 5120;
constexpr int C_AQ = 0, C_AK = 768, C_AV = 1536, C_BQ = 2304, C_BK = 2560, C_BV = 2816, C_IQ = 3072, C_IK = 3328, C_C = 3392, C_DZ = 4288, C_DX = 4544, C_IW = 5056, C_DT = 5060, C_END = 5064;
constexpr int NEXP = 32, DEXP = 512;
constexpr int CAP = 73728;
constexpr float LN_EPS = 1e-5f;
constexpr float ALPHA = 1.4142135623730951f;

constexpr size_t MiB = 1u << 20;
constexpr size_t WS_CTL = 0, CTL_BYTES = 1 * MiB;
constexpr size_t WS_WINT = 2 * MiB;
constexpr size_t WS_WGT = 22 * MiB;
constexpr size_t WS_WBRT = 38 * MiB;
constexpr size_t WS_WOUTT = 42 * MiB;
constexpr size_t WS_WRT = 46 * MiB;
constexpr size_t WS_ROUTE = 47 * MiB;
constexpr size_t WS_XB = 48 * MiB;
constexpr size_t WS_O = 112 * MiB;
constexpr size_t WS_VF = 176 * MiB;
constexpr size_t WS_P = 192 * MiB;
constexpr size_t WS_GS = 192 * MiB;
constexpr size_t WS_MERGED = 448 * MiB;
constexpr size_t WS_XS = 192 * MiB;
constexpr size_t WS_H = 336 * MiB;
constexpr size_t WS_WGU = 408 * MiB;
constexpr size_t WS_WD = 472 * MiB;
constexpr size_t WS_RW = 512 * MiB;
constexpr size_t WS_RW2 = 544 * MiB;
constexpr size_t WS_BONG = 46 * MiB + 512 * 1024;
constexpr size_t WS_END = 592 * MiB;
constexpr int CW_CNT = 64, CW_Q = 256, CW_BAR = 4096;

constexpr int RING_BYTES = 131072, MISC_OFF = RING_BYTES, LDS_BYTES = 147456;
constexpr int NWAVES = 8, NTHR = 512;

__device__ __forceinline__ float bf2f(bf16 v) { return __uint_as_float(((unsigned)v) << 16); }
__device__ __forceinline__ unsigned f2bf(float f) { unsigned u = __float_as_uint(f); return (u + 0x7fffu + ((u >> 16) & 1u)) >> 16; }
__device__ __forceinline__ unsigned pk2(float lo, float hi) { return f2bf(lo) | (f2bf(hi) << 16); }
#define DPP_ADD(v, ctrl) v += __builtin_bit_cast(float, __builtin_amdgcn_update_dpp(0, __builtin_bit_cast(int, v), ctrl, 0xF, 0xF, true))
#define DPP_MAX(v, ctrl) v = fmaxf(v, __builtin_bit_cast(float, __builtin_amdgcn_update_dpp(0, __builtin_bit_cast(int, v), ctrl, 0xF, 0xF, true)))
__device__ __forceinline__ float wave_sum(float v) {
    DPP_ADD(v, 0xB1); DPP_ADD(v, 0x4E); DPP_ADD(v, 0x141); DPP_ADD(v, 0x140);
    v += __shfl_xor(v, 16); v += __shfl_xor(v, 32);
    return v;
}
__device__ __forceinline__ float wave_max(float v) {
    DPP_MAX(v, 0xB1); DPP_MAX(v, 0x4E); DPP_MAX(v, 0x141); DPP_MAX(v, 0x140);
    v = fmaxf(v, __shfl_xor(v, 16)); v = fmaxf(v, __shfl_xor(v, 32));
    return v;
}
__device__ __forceinline__ float sigmoid_div_(float x) { return 1.f / (1.f + __expf(-x)); }
__device__ __forceinline__ float sigmoidf_(float x) { return __builtin_amdgcn_rcpf(1.f + __expf(-x)); }
__device__ __forceinline__ float softplusf_(float x) { return x > 20.f ? x : __logf(1.f + __expf(x)); }
__device__ __forceinline__ float tanhf_(float x) { const float e = __expf(-2.f * fabsf(x)); const float t = (1.f - e) * __builtin_amdgcn_rcpf(1.f + e); return x < 0.f ? -t : t; }
__device__ __forceinline__ float siluf_(float x) { return x * __builtin_amdgcn_rcpf(1.f + __expf(-x)); }

struct Args { const float* in[35]; float* out; unsigned char* ws; int ph_lo, ph_hi; };
enum { I_X = 0, I_WIN, I_CMU, I_CW0, I_CW2, I_CA0, I_CA2, I_CG2, I_CKK, I_CKA, I_CRK, I_CGNW, I_CGNB, I_CV0, I_CV1, I_CV2, I_DCW, I_DCB, I_DDTB, I_DALOG, I_DSKIP, I_DNW,
       I_WBR, I_WOUT, I_LN1G, I_LN1B, I_RG, I_RGB, I_RE, I_REB, I_EG, I_EU, I_ED, I_LN2G, I_LN2B };

__device__ __forceinline__ void transpose_item(const float* W, int ldn, int c0, int ncols, bf16* dst, int dld, int r0, int dk0, int kb, int nb, LAS float* scr, int lane) {
    const int k0 = 64 * kb, n0 = 32 * nb;
    const bool okn = (n0 + (lane & 31)) < ncols;
    float tv[32];
#pragma unroll
    for (int i = 0; i < 32; ++i) { const int kk = 2 * i + (lane >> 5); tv[i] = okn ? W[(size_t)(k0 + kk) * ldn + c0 + n0 + (lane & 31)] : 0.f; }
#pragma unroll
    for (int i = 0; i < 32; ++i) { const int kk = 2 * i + (lane >> 5); scr[kk * 33 + (lane & 31)] = tv[i]; }
    asm volatile("s_waitcnt lgkmcnt(0)" ::: "memory");
    const int c = lane & 7;
#pragma unroll
    for (int j = 0; j < 4; ++j) { const int n = (lane >> 3) + 8 * j; const LAS float* s = scr + (8 * c) * 33 + n;
        u32x4 o; o.x = pk2(s[0 * 33], s[1 * 33]); o.y = pk2(s[2 * 33], s[3 * 33]); o.z = pk2(s[4 * 33], s[5 * 33]); o.w = pk2(s[6 * 33], s[7 * 33]);
        if (n0 + n < ncols) *(u32x4*)(dst + (size_t)(r0 + n0 + n) * dld + dk0 + k0 + 8 * c) = o; }
    asm volatile("s_waitcnt lgkmcnt(0)" ::: "memory");
}

struct EpiStoreBf16 {
    static constexpr bool PERM = true;
    bf16* O; int ldc; int act; int ncols;
    __device__ __forceinline__ void operator()(const pg8::f32x4 (&acc)[2][2][4][2], const pg8::Unit& u, int wr, int wc, int fr, int fq) const {
        pg8::epi_mfma_settle();
        const int row0 = u.pm * 256 + wr * 64 + fr; const int col0 = u.pn * 256 + wc * 32 + 8 * fq;
#pragma unroll
        for (int ai = 0; ai < 2; ++ai)
#pragma unroll
            for (int m = 0; m < 4; ++m) { bf16* rowp = O + (size_t)(row0 + ai * 128 + m * 16) * ldc + col0;
#pragma unroll
                for (int bj = 0; bj < 2; ++bj) { pg8::f32x4 v0 = acc[ai][bj][m][0], v1 = acc[ai][bj][m][1];
                    if (act == 1) {
#pragma unroll
                        for (int j = 0; j < 4; ++j) { v0[j] = sigmoidf_(v0[j]); v1[j] = sigmoidf_(v1[j]); } }
                    u32x4 w; w.x = pg8::cvt_pk_bf16(v0[0], v0[1]); w.y = pg8::cvt_pk_bf16(v0[2], v0[3]); w.z = pg8::cvt_pk_bf16(v1[0], v1[1]); w.w = pg8::cvt_pk_bf16(v1[2], v1[3]);
                    if (col0 + bj * 128 < ncols) *(u32x4*)(rowp + bj * 128) = w; } }
    }
};
struct EpiBranch {
    static constexpr bool PERM = true;
    const bf16* GS; bf16* MG;
    __device__ __forceinline__ void operator()(const pg8::f32x4 (&acc)[2][2][4][2], const pg8::Unit& u, int wr, int wc, int fr, int fq) const {
        pg8::epi_mfma_settle();
        const int n = u.aux;
        const bf16* gbase = GS + (size_t)(u.pm * 256 + wr * 64 + fr) * 4096 + n * 1024 + u.pn * 256 + wc * 32 + 8 * fq;
        bf16* mbase = MG + (size_t)(u.pm * 256 + wr * 64 + fr) * 1024 + u.pn * 256 + wc * 32 + 8 * fq;
#pragma unroll
        for (int ai = 0; ai < 2; ++ai)
#pragma unroll
            for (int m = 0; m < 4; ++m) {
#pragma unroll
                for (int bj = 0; bj < 2; ++bj) {
                    const u32x4 gv = *(const u32x4*)(gbase + (size_t)(ai * 128 + m * 16) * 4096 + bj * 128);
                    bf16* mp = mbase + (size_t)(ai * 128 + m * 16) * 1024 + bj * 128;
                    u32x4 ov = (u32x4){0u, 0u, 0u, 0u}; if (n != 0) ov = *(const u32x4*)mp;
                    const pg8::f32x4 a0 = acc[ai][bj][m][0], a1 = acc[ai][bj][m][1];
                    u32x4 w;
                    w.x = pg8::cvt_pk_bf16(a0[0] * __uint_as_float(gv.x << 16) + __uint_as_float(ov.x << 16), a0[1] * __uint_as_float(gv.x & 0xffff0000u) + __uint_as_float(ov.x & 0xffff0000u));
                    w.y = pg8::cvt_pk_bf16(a0[2] * __uint_as_float(gv.y << 16) + __uint_as_float(ov.y << 16), a0[3] * __uint_as_float(gv.y & 0xffff0000u) + __uint_as_float(ov.y & 0xffff0000u));
                    w.z = pg8::cvt_pk_bf16(a1[0] * __uint_as_float(gv.z << 16) + __uint_as_float(ov.z << 16), a1[1] * __uint_as_float(gv.z & 0xffff0000u) + __uint_as_float(ov.z & 0xffff0000u));
                    w.w = pg8::cvt_pk_bf16(a1[2] * __uint_as_float(gv.w << 16) + __uint_as_float(ov.w << 16), a1[3] * __uint_as_float(gv.w & 0xffff0000u) + __uint_as_float(ov.w & 0xffff0000u));
                    *(u32x4*)mp = w; asm volatile("" ::: "memory"); } }
    }
};
struct EpiResid {
    static constexpr bool PERM = false;
    float* X;
    __device__ __forceinline__ void operator()(const pg8::f32x4 (&acc)[2][2][4][2], const pg8::Unit& u, int wr, int wc, int fr, int fq) const {
        pg8::epi_mfma_settle();
        const int row0 = u.pm * 256 + wr * 64 + fr, col0 = u.pn * 256 + wc * 32 + 4 * fq;
#pragma unroll
        for (int ai = 0; ai < 2; ++ai)
#pragma unroll
            for (int m = 0; m < 4; ++m) { float* rowp = X + (size_t)(row0 + ai * 128 + m * 16) * D + col0;
#pragma unroll
                for (int bj = 0; bj < 2; ++bj)
#pragma unroll
                    for (int n = 0; n < 2; ++n) { pg8::f32x4* p = (pg8::f32x4*)(rowp + bj * 128 + n * 16); *p = *p * ALPHA + acc[ai][bj][m][n]; } }
    }
};
struct EpiSwiglu {
    static constexpr bool PERM = true;
    bf16* H;
    __device__ __forceinline__ void operator()(const pg8::f32x4 (&acc)[2][2][4][2], const pg8::Unit& u, int wr, int wc, int fr, int fq) const {
        pg8::epi_mfma_settle();
        const int row0 = u.pm * 256 + wr * 64 + fr; const int col0 = u.pn * 128 + wc * 32 + 8 * fq;
#pragma unroll
        for (int ai = 0; ai < 2; ++ai)
#pragma unroll
            for (int m = 0; m < 4; ++m) { bf16* rowp = H + (size_t)(row0 + ai * 128 + m * 16) * DEXP + col0;
                float v[8];
#pragma unroll
                for (int j = 0; j < 4; ++j) { v[j] = siluf_(acc[ai][0][m][0][j]) * acc[ai][1][m][0][j]; v[4 + j] = siluf_(acc[ai][0][m][1][j]) * acc[ai][1][m][1][j]; }
                u32x4 w; w.x = pg8::cvt_pk_bf16(v[0], v[1]); w.y = pg8::cvt_pk_bf16(v[2], v[3]); w.z = pg8::cvt_pk_bf16(v[4], v[5]); w.w = pg8::cvt_pk_bf16(v[6], v[7]);
                *(u32x4*)rowp = w; }
    }
};

struct SkewOrder {
    int nM, nN, nwg, c, lda, ldb;
    __device__ bool next(int i, pg8::Unit& u) const {
        long L;
        if (i < 5) L = (long)i * 256 + c; else { if (c < 32) return false; L = 1280 + (long)(i - 5) * 224 + (c - 32); }
        if (L >= nwg) return false;
        pg8::tile_of((int)L, nM, nN, u.pm, u.pn); u.aux = 0;
        u.aoff = (size_t)u.pm * 256 * lda * 2; u.boff = (size_t)u.pn * 256 * ldb * 2; return true;
    }
};
struct BranchOrder {
    int nM, nN, G, c;
    __device__ bool next(int i, pg8::Unit& u) const {
        const int tl = (i >> 2) * G + c; if (tl >= nM * nN) return false;
        pg8::tile_of(tl, nM, nN, u.pm, u.pn); u.aux = i & 3;
        u.aoff = ((size_t)u.pm * 256 * 1024 + (size_t)u.aux * 256) * 2; u.boff = ((size_t)u.pn * 256 * 1024 + (size_t)u.aux * 256) * 2; return true;
    }
};
struct MoeOrder {
    const volatile LAS int* tb; int G, c; size_t a_rowbytes, b_expbytes, b_tilebytes;
    __device__ bool next(int i, pg8::Unit& u) const {
        const int L = i * G + c; const int total = __builtin_amdgcn_readfirstlane(tb[32]) * 4; if (L >= total) return false;
        int e = 0;
#pragma unroll 1
        for (int k = 0; k < 32; ++k) if (L >= tb[k + 1] * 4) e = k + 1;
        const int nte = tb[e + 1] - tb[e]; const int r = L - tb[e] * 4; const int ct = r / nte, rt = r % nte;
        u.pm = __builtin_amdgcn_readfirstlane(tb[33 + e] + rt); u.pn = __builtin_amdgcn_readfirstlane(ct); u.aux = __builtin_amdgcn_readfirstlane(e);
        u.aoff = (size_t)u.pm * 256 * a_rowbytes; u.boff = (size_t)u.aux * b_expbytes + (size_t)u.pn * b_tilebytes; return true;
    }
};

constexpr int PTR_OFF = LDS_BYTES - 512;
__device__ __forceinline__ void ptr_table_fill(const Args& args, LAS unsigned char* lds) {
    if (threadIdx.x == 0) {
        volatile LAS unsigned long long* t = (volatile LAS unsigned long long*)(lds + PTR_OFF);
#define PT_(i) t[i] = (unsigned long long)args.in[i];
        PT_(0) PT_(1) PT_(2) PT_(3) PT_(4) PT_(5) PT_(6) PT_(7) PT_(8) PT_(9) PT_(10) PT_(11) PT_(12) PT_(13) PT_(14) PT_(15) PT_(16) PT_(17) PT_(18) PT_(19)
        PT_(20) PT_(21) PT_(22) PT_(23) PT_(24) PT_(25) PT_(26) PT_(27) PT_(28) PT_(29) PT_(30) PT_(31) PT_(32) PT_(33) PT_(34)
#undef PT_
        t[35] = (unsigned long long)args.out; t[36] = (unsigned long long)args.ws; t[37] = (unsigned long long)(unsigned)args.ph_lo;
    }
    __syncthreads();
}
__device__ __forceinline__ unsigned long long ldptr(LAS unsigned char* lds, int i) {
    unsigned a = (unsigned)(PTR_OFF + 8 * i); asm volatile("" : "+v"(a));
    const volatile LAS unsigned* t = (const volatile LAS unsigned*)(lds + a);
    const unsigned lo = __builtin_amdgcn_readfirstlane(t[0]), hi = __builtin_amdgcn_readfirstlane(t[1]);
    return ((unsigned long long)hi << 32) | lo;
}
__device__ __forceinline__ void* gptr(unsigned long long v) { return (void*)(__attribute__((address_space(1))) void*)v; }
#define INP(i) ((const float*)gptr(ldptr(lds, (i))))
namespace rw {
typedef short bf16x8 __attribute__((ext_vector_type(8)));
typedef float f4 __attribute__((ext_vector_type(4)));
constexpr int LS = 72;
constexpr int MB = 64 * LS * 2;
constexpr int O_AHN = 0, O_RHN = MB, O_BCN = 2 * MB, O_KCN = 3 * MB, O_AHT = 4 * MB, O_BTT = 5 * MB, O_KTT = 6 * MB, O_VT = 7 * MB, O_STT = 8 * MB,
              O_MAK = 9 * MB, O_MRB = 10 * MB, O_MRK = 11 * MB, O_TINV = 12 * MB, O_MABF = 13 * MB, O_GAM = 13 * MB + 16384, O_CT = O_GAM + 256, O_BON = O_CT + 4608, O_END = O_BON + 256;
constexpr int O_MVT = O_BCN, O_A2N = O_AHN, O_UT = O_KCN, O_YF = O_AHT;
constexpr int O_TAB = O_MAK, O_SCR = O_TAB + 26624, O_TOT = O_SCR + 8 * 1024, O_CUM = O_TOT + 2048;
static_assert(O_CUM + 16384 <= O_GAM && O_END <= LDS_BYTES - 576, "rwkv LDS map");

__device__ __forceinline__ bf16x8 ldfrag(const LAS unsigned char* lds, int off, int r0, int ks, int lane) {
    return *(const LAS bf16x8*)(lds + off + ((r0 + (lane & 15)) * LS + ks * 32 + (lane >> 4) * 8) * 2);
}
__device__ __forceinline__ void mm64(f4 (&acc)[2], const LAS unsigned char* lds, int offA, int offBt, int w, int lane) {
    const int tr = w >> 1; const bf16x8 a0 = ldfrag(lds, offA, tr * 16, 0, lane), a1 = ldfrag(lds, offA, tr * 16, 1, lane);
#pragma unroll
    for (int c = 0; c < 2; ++c) { const int tc = (w & 1) * 2 + c; const bf16x8 b0 = ldfrag(lds, offBt, tc * 16, 0, lane), b1 = ldfrag(lds, offBt, tc * 16, 1, lane);
        acc[c] = __builtin_amdgcn_mfma_f32_16x16x32_bf16(a0, b0, acc[c], 0, 0, 0); acc[c] = __builtin_amdgcn_mfma_f32_16x16x32_bf16(a1, b1, acc[c], 0, 0, 0); }
}
__device__ __forceinline__ void storeT(LAS unsigned char* lds, int off, const f4 (&acc)[2], int w, int lane) {
#pragma unroll
    for (int c = 0; c < 2; ++c) { const int col = ((w & 1) * 2 + c) * 16 + (lane & 15), row = (w >> 1) * 16 + 4 * (lane >> 4);
        u32x2 v; v.x = pk2(acc[c][0], acc[c][1]); v.y = pk2(acc[c][2], acc[c][3]); *(LAS u32x2*)(lds + off + (col * LS + row) * 2) = v; }
}
template <int MASK  >
__device__ __forceinline__ void storeN(LAS unsigned char* lds, int off, const f4 (&acc)[2], int w, int lane) {
#pragma unroll
    for (int c = 0; c < 2; ++c) { const int col = ((w & 1) * 2 + c) * 16 + (lane & 15), row = (w >> 1) * 16 + 4 * (lane >> 4);
#pragma unroll
        for (int e = 0; e < 4; ++e) { float x = acc[c][e]; if (MASK == 1) x = (col < row + e) ? x : 0.f; if (MASK == 2) x = (col <= row + e) ? x : 0.f;
            *(LAS bf16*)(lds + off + ((row + e) * LS + col) * 2) = (bf16)f2bf(x); } }
}
typedef __bf16 bf2v __attribute__((ext_vector_type(2)));
__device__ __forceinline__ float dot2(unsigned x, unsigned y, float c) { return __builtin_amdgcn_fdot2_f32_bf16(__builtin_bit_cast(bf2v, x), __builtin_bit_cast(bf2v, y), c, false); }
#define RW_ZERO(a) do { a[0] = (f4){0.f, 0.f, 0.f, 0.f}; a[1] = (f4){0.f, 0.f, 0.f, 0.f}; } while (0)

__device__ __forceinline__ void build_ct(LAS unsigned char* lds0, const int l, const int h, const int lane, const int wave) {
    LAS unsigned char* const& lds = lds0; const int c = h * 64 + lane;
    const float* mu = INP(I_CMU) + (size_t)l * 896;
    if (wave == 0) { LAS float* ct = (LAS float*)(lds0 + O_CT);
        ct[0 * 64 + lane] = mu[c]; ct[1 * 64 + lane] = mu[256 + c]; ct[2 * 64 + lane] = mu[512 + c]; ct[3 * 64 + lane] = mu[768 + lane]; ct[4 * 64 + lane] = mu[832 + lane];
        ct[5 * 64 + lane] = INP(I_CW0)[l * 256 + c]; ct[6 * 64 + lane] = INP(I_CA0)[l * 256 + c]; ct[7 * 64 + lane] = INP(I_CKK)[l * 256 + c]; ct[8 * 64 + lane] = INP(I_CKA)[l * 256 + c];
        ct[9 * 64 + lane] = INP(I_CRK)[l * 256 + c]; ct[10 * 64 + lane] = INP(I_CGNW)[l * 256 + c]; ct[11 * 64 + lane] = INP(I_CGNB)[l * 256 + c]; ct[12 * 64 + lane] = l > 0 ? INP(I_CV0)[(l - 1) * 256 + c] : 0.f;
        ct[13 * 64 + lane] = mu[512 + lane]; ct[14 * 64 + lane] = mu[512 + lane + 64]; ct[15 * 64 + lane] = mu[512 + lane + 128]; ct[16 * 64 + lane] = mu[512 + lane + 192]; }
}
template <int MODE>
__device__ __forceinline__ void chunk(LAS unsigned char* lds0, const int l, const int b, const int h, const int t0, unsigned char* gz, unsigned char* gz2, float* bong, const bf16* P, bf16* VF, bf16* OB, const int tid0) {
    const int c = h * 64 + (tid0 & 63);
    {
        unsigned lb_ = 0u; int tid_l = tid0; asm volatile("" : "+v"(lb_), "+v"(tid_l));
        const int tid = tid_l, lane = tid & 63, wave = __builtin_amdgcn_readfirstlane(tid >> 6);
        LAS unsigned char* lds = lds0 + lb_;
        LAS bf16* TAB = (LAS bf16*)(lds + O_TAB); const LAS unsigned* TABW = (const LAS unsigned*)(lds + O_TAB);
        LAS bf16* scr = (LAS bf16*)(lds + O_SCR + wave * 1024);
        LAS float* CUM = (LAS float*)(lds + O_CUM);
        LAS float* TOT = (LAS float*)(lds + O_TOT);
        LAS float* GAM = (LAS float*)(lds + O_GAM);
        LAS float* MABF = (LAS float*)(lds + O_MABF);
        LAS float* YF = (LAS float*)(lds + O_YF);
        LAS float* BON = (LAS float*)(lds + O_BON);
        const LAS float* CT = (const LAS float*)(lds + O_CT);
#define CTV(k) CT[(k) * 64 + lane]
        { const float* cw2 = INP(I_CW2) + (size_t)l * 32 * 256; const float* ca2 = INP(I_CA2) + (size_t)l * 32 * 256; const float* cg2 = INP(I_CG2) + (size_t)l * 64 * 256;
          float tw[4], ta[4], tg[8];
#pragma unroll
          for (int u = 0; u < 4; ++u) { const int i = tid + u * NTHR; tw[u] = cw2[(i >> 6) * 256 + h * 64 + (i & 63)]; ta[u] = ca2[(i >> 6) * 256 + h * 64 + (i & 63)]; }
#pragma unroll
          for (int u = 0; u < 8; ++u) { const int i = tid + u * NTHR; tg[u] = cg2[(i >> 6) * 256 + h * 64 + (i & 63)]; }
          float t2[2], t1[8];
          if (l > 0) { const float* cv1 = INP(I_CV1) + (size_t)(l - 1) * 256 * 16; const float* cv2 = INP(I_CV2) + (size_t)(l - 1) * 16 * 256;
#pragma unroll
            for (int u = 0; u < 2; ++u) { const int i = tid + u * NTHR; t2[u] = cv2[(i >> 6) * 256 + h * 64 + (i & 63)]; }
#pragma unroll
            for (int u = 0; u < 8; ++u) t1[u] = cv1[tid + u * NTHR]; }
#define PIX(i) ((((i) >> 7) * 64 + ((i) & 63)) * 2 + (((i) >> 6) & 1))
#pragma unroll
          for (int u = 0; u < 4; ++u) { const int i = tid + u * NTHR; TAB[PIX(i)] = (bf16)f2bf(tw[u]); TAB[2048 + PIX(i)] = (bf16)f2bf(ta[u]); }
#pragma unroll
          for (int u = 0; u < 8; ++u) { const int i = tid + u * NTHR; TAB[4096 + PIX(i)] = (bf16)f2bf(tg[u]); }
          if (l > 0) {
#pragma unroll
            for (int u = 0; u < 2; ++u) { const int i = tid + u * NTHR; TAB[8192 + PIX(i)] = (bf16)f2bf(t2[u]); }
#pragma unroll
            for (int u = 0; u < 8; ++u) { const int i = tid + u * NTHR; const int cc = i >> 4, qq = i & 15; TAB[9216 + ((cc >> 1) * 16 + qq) * 2 + (cc & 1)] = (bf16)f2bf(t1[u]); } } }
#undef PIX
        float Xr[9];
#pragma unroll
        for (int j = 0; j < 9; ++j) { const int t = t0 + wave * 8 - 1 + j; Xr[j] = t >= 0 ? bf2f(P[((size_t)b * T + t) * PP + C_C + 768 + lane]) : 0.f; }
        __syncthreads();
        { float run = 0.f;
#pragma unroll
            for (int q = 0; q < 8; ++q) {
                const float xx = Xr[q + 1] + (Xr[q] - Xr[q + 1]) * CTV(3);
                scr[lane] = (bf16)f2bf(tanhf_(xx));
                asm volatile("s_waitcnt lgkmcnt(0)" ::: "memory");
                float wsum = CTV(5); { float w1 = 0.f; const LAS unsigned* sw = (const LAS unsigned*)scr;
#pragma unroll
                for (int p = 0; p < 16; p += 2) { wsum = dot2(sw[p], TABW[p * 64 + lane], wsum); w1 = dot2(sw[p + 1], TABW[(p + 1) * 64 + lane], w1); }
                wsum += w1; }
                run += -__expf(-softplusf_(-wsum) - 0.5f); CUM[(wave * 8 + q) * 64 + lane] = run;
                asm volatile("s_waitcnt lgkmcnt(0)" ::: "memory");
            }
            TOT[wave * 64 + lane] = run; }
        __syncthreads();
        float offs = 0.f, cumL = 0.f;
#pragma unroll
        for (int w2 = 0; w2 < 8; ++w2) { const float tw = TOT[w2 * 64 + lane]; offs += (w2 < wave) ? tw : 0.f; cumL += tw; }
        if (wave == 0) GAM[lane] = __expf(cumL);
#define LO_(x) __uint_as_float((x) << 16)
#define HI_(x) __uint_as_float((x) & 0xffff0000u)
#define RAW_LOAD(rk, vx, gg, v4a, v4b, vfv, tok) do { const int t_ = (tok); const bool ok_ = t_ >= 0; const size_t m_ = (size_t)b * T + (ok_ ? t_ : 0); const bf16* row_ = P + m_ * PP + C_C; \
            rk = ok_ ? ((unsigned)row_[c] | ((unsigned)row_[256 + c] << 16)) : 0u; vx = ok_ ? ((unsigned)row_[512 + c] | ((unsigned)row_[768 + lane] << 16)) : 0u; gg = ok_ ? (unsigned)row_[832 + lane] : 0u; \
            if (l > 0) { v4a = ok_ ? ((unsigned)row_[512 + lane] | ((unsigned)row_[512 + lane + 64] << 16)) : 0u; v4b = ok_ ? ((unsigned)row_[512 + lane + 128] | ((unsigned)row_[512 + lane + 192] << 16)) : 0u; vfv = (unsigned)VF[m_ * 256 + c]; } } while (0)
        unsigned pRK, pVX, pGG, pVa = 0u, pVb = 0u, pVF = 0u, cRK, cVX, cGG, cVa = 0u, cVb = 0u, cVF = 0u;
        RAW_LOAD(pRK, pVX, pGG, pVa, pVb, pVF, t0 + wave * 8 - 1); RAW_LOAD(cRK, cVX, cGG, cVa, cVb, cVF, t0 + wave * 8);
#pragma unroll 1
        for (int q = 0; q < 8; ++q) {
            const int tt = wave * 8 + q; const size_t m = (size_t)b * T + t0 + tt;
            unsigned nRK, nVX, nGG, nVa = 0u, nVb = 0u, nVF = 0u;
            RAW_LOAD(nRK, nVX, nGG, nVa, nVb, nVF, (q < 7) ? (t0 + tt + 1) : (t0 + tt));
            const float r = LO_(cRK) + (LO_(pRK) - LO_(cRK)) * CTV(0), k = HI_(cRK) + (HI_(pRK) - HI_(cRK)) * CTV(1); float v = LO_(cVX) + (LO_(pVX) - LO_(cVX)) * CTV(2);
            const float xx = HI_(cVX) + (HI_(pVX) - HI_(cVX)) * CTV(3), xg = LO_(cGG) + (LO_(pGG) - LO_(cGG)) * CTV(4);
            scr[lane] = (bf16)f2bf(lane < 32 ? tanhf_(xx) : xx); scr[64 + lane] = (bf16)f2bf(sigmoidf_(xg));
            LAS bf16* vsc = scr + 128;
            if (l > 0) {
                vsc[lane] = (bf16)f2bf(LO_(cVa) + (LO_(pVa) - LO_(cVa)) * CTV(13)); vsc[lane + 64] = (bf16)f2bf(HI_(cVa) + (HI_(pVa) - HI_(cVa)) * CTV(14));
                vsc[lane + 128] = (bf16)f2bf(LO_(cVb) + (LO_(pVb) - LO_(cVb)) * CTV(15)); vsc[lane + 192] = (bf16)f2bf(HI_(cVb) + (HI_(pVb) - HI_(cVb)) * CTV(16));
            }
            asm volatile("s_waitcnt lgkmcnt(0)" ::: "memory");
            float wsum = CTV(5), asum = CTV(6), gsum = 0.f; { float w1 = 0.f, a1 = 0.f, g1 = 0.f; const LAS unsigned* sw = (const LAS unsigned*)scr;
#pragma unroll
            for (int p = 0; p < 16; p += 2) { wsum = dot2(sw[p], TABW[p * 64 + lane], wsum); w1 = dot2(sw[p + 1], TABW[(p + 1) * 64 + lane], w1);
                asum = dot2(sw[16 + p], TABW[1024 + p * 64 + lane], asum); a1 = dot2(sw[17 + p], TABW[1024 + (p + 1) * 64 + lane], a1); }
#pragma unroll
            for (int p = 0; p < 32; p += 2) { gsum = dot2(sw[32 + p], TABW[2048 + p * 64 + lane], gsum); g1 = dot2(sw[33 + p], TABW[2048 + (p + 1) * 64 + lane], g1); }
            wsum += w1; asum += a1; gsum += g1; }
            if (l > 0) {
                const int qq = lane & 15, part = lane >> 4; float s = 0.f; { float s1 = 0.f; const LAS unsigned* sv = (const LAS unsigned*)vsc;
#pragma unroll
                for (int p = 0; p < 32; p += 2) { s = dot2(sv[part * 32 + p], TABW[4608 + (part * 32 + p) * 16 + qq], s); s1 = dot2(sv[part * 32 + p + 1], TABW[4608 + (part * 32 + p + 1) * 16 + qq], s1); }
                s += s1; }
                s += __shfl_xor(s, 16); s += __shfl_xor(s, 32);
                float vl = CTV(12);
#pragma unroll
                for (int q2 = 0; q2 < 16; ++q2) vl += __shfl(s, q2) * bf2f(TAB[8192 + ((q2 >> 1) * 64 + lane) * 2 + (q2 & 1)]);
                const float vf = LO_(cVF); v = v + (vf - v) * sigmoidf_(vl);
            }
            VF[m * 256 + c] = (bf16)f2bf(v);
            const float wlog = -softplusf_(-wsum) - 0.5f, asig = sigmoidf_(asum), lw = -__expf(wlog);
            float kk = k * CTV(7); const float n2 = wave_sum(kk * kk); kk = kk * __builtin_amdgcn_rsqf(fmaxf(n2, 1e-24f));
            const float kmod = k * (1.f + (asig - 1.f) * CTV(8));
            const float bon = wave_sum(r * kmod * CTV(9));
            const float cum = offs + CUM[tt * 64 + lane], cumx = cum - lw;
            const float ah = -kk * __expf(cumx), rh = r * __expf(cum), ei = __expf(-cum), bb = kk * asig, bc = bb * ei, kc = kmod * ei, ee = __expf(cumL - cum), bt = bb * ee, kt = kmod * ee;
            const int no = (tt * LS + lane) * 2, to = (lane * LS + tt) * 2;
            *(LAS bf16*)(lds + O_AHN + no) = (bf16)f2bf(ah); *(LAS bf16*)(lds + O_RHN + no) = (bf16)f2bf(rh);
            *(LAS bf16*)(lds + O_BCN + no) = (bf16)f2bf(bc); *(LAS bf16*)(lds + O_KCN + no) = (bf16)f2bf(kc); ((bf16*)(gz2 + 16384))[tt * 64 + lane] = (bf16)f2bf(gsum);
            *(LAS bf16*)(lds + O_AHT + to) = (bf16)f2bf(ah); *(LAS bf16*)(lds + O_BTT + to) = (bf16)f2bf(bt);
            *(LAS bf16*)(lds + O_KTT + to) = (bf16)f2bf(kt); *(LAS bf16*)(lds + O_VT + to) = (bf16)f2bf(v);
            if (lane == 0) bong[tt] = bon;
            asm volatile("s_waitcnt lgkmcnt(0)" ::: "memory");
            pRK = cRK; pVX = cVX; pGG = cGG; pVa = cVa; pVb = cVb; cRK = nRK; cVX = nVX; cGG = nGG; cVa = nVa; cVb = nVb; cVF = nVF;
        }
#undef RAW_LOAD
        __syncthreads();
        { f4 acc[2];
            RW_ZERO(acc); mm64(acc, lds, O_AHN, O_BCN, wave, lane);
#pragma unroll
            for (int cI = 0; cI < 2; ++cI) { const int col = ((wave & 1) * 2 + cI) * 16 + (lane & 15), row = (wave >> 1) * 16 + 4 * (lane >> 4);
#pragma unroll
                for (int e = 0; e < 4; ++e) MABF[(row + e) * 64 + col] = (col < row + e) ? acc[cI][e] : 0.f; }
            RW_ZERO(acc); mm64(acc, lds, O_AHN, O_KCN, wave, lane); storeN<1>(lds, O_MAK, acc, wave, lane);
            { f4 accb[2]; RW_ZERO(accb); mm64(accb, lds, O_RHN, O_BCN, wave, lane); f4 accc[2]; RW_ZERO(accc); mm64(accc, lds, O_RHN, O_KCN, wave, lane);
                storeN<2>(lds, O_MRB, accb, wave, lane); storeN<2>(lds, O_MRK, accc, wave, lane); }
        }
        __syncthreads();
        {
            const int cS = wave * 8 + (lane >> 3), tS = lane & 7;
            float xs[8];
#pragma unroll
            for (int k = 0; k < 8; ++k) xs[k] = 0.f;
#pragma unroll
            for (int i = 1; i < 64; ++i) {
                float part = 0.f;
#pragma unroll
                for (int k = 0; k < (i + 7) / 8; ++k) { const float mv = MABF[i * 64 + tS + 8 * k]; part += ((tS + 8 * k) < i ? mv : 0.f) * xs[k]; }
                part += __builtin_bit_cast(float, __builtin_amdgcn_update_dpp(0, __builtin_bit_cast(int, part), 0xB1, 0xF, 0xF, true));
                part += __builtin_bit_cast(float, __builtin_amdgcn_update_dpp(0, __builtin_bit_cast(int, part), 0x4E, 0xF, 0xF, true));
                part += __builtin_bit_cast(float, __builtin_amdgcn_update_dpp(0, __builtin_bit_cast(int, part), 0x141, 0xF, 0xF, true));
                const float xi = MABF[i * 64 + cS] + part;
                xs[i >> 3] = (tS == (i & 7)) ? xi : xs[i >> 3];
            }
#pragma unroll
            for (int k = 0; k < 8; ++k) { const int i = tS + 8 * k; *(LAS bf16*)(lds + O_TINV + (i * LS + cS) * 2) = (bf16)f2bf(i == cS ? 1.f : xs[k]); }
        }
        __syncthreads();
        { f4 acc[2]; RW_ZERO(acc); mm64(acc, lds, O_MAK, O_VT, wave, lane); storeT(lds, O_MVT, acc, wave, lane); }
        __syncthreads();
        if (MODE == 1) {
            { f4 acc[2]; RW_ZERO(acc); mm64(acc, lds, O_TINV, O_AHT, wave, lane); storeT(lds, O_UT, acc, wave, lane); }
            { f4 acc[2]; RW_ZERO(acc); mm64(acc, lds, O_TINV, O_MVT, wave, lane); storeT(lds, O_MAK, acc, wave, lane); }
            __syncthreads();
            f4 agm[2], azm[2], ar2[2], ay0[2];
            RW_ZERO(agm); mm64(agm, lds, O_BTT, O_UT, wave, lane);
#pragma unroll
            for (int cI = 0; cI < 2; ++cI) { const int col = ((wave & 1) * 2 + cI) * 16 + (lane & 15), row = (wave >> 1) * 16 + 4 * (lane >> 4);
#pragma unroll
                for (int e = 0; e < 4; ++e) if (col == row + e) agm[cI][e] += GAM[col]; }
            RW_ZERO(azm); mm64(azm, lds, O_BTT, O_MAK, wave, lane); mm64(azm, lds, O_KTT, O_VT, wave, lane);
            RW_ZERO(ar2); mm64(ar2, lds, O_MRB, O_UT, wave, lane);
#pragma unroll
            for (int cI = 0; cI < 2; ++cI) { const int col = ((wave & 1) * 2 + cI) * 16 + (lane & 15), row = (wave >> 1) * 16 + 4 * (lane >> 4);
#pragma unroll
                for (int e = 0; e < 4; ++e) ar2[cI][e] += bf2f(*(const LAS bf16*)(lds + O_RHN + ((row + e) * LS + col) * 2)); }
            RW_ZERO(ay0); mm64(ay0, lds, O_MRB, O_MAK, wave, lane); mm64(ay0, lds, O_MRK, O_VT, wave, lane);
            __syncthreads();
            storeN<0>(lds, O_AHN, agm, wave, lane); storeT(lds, O_RHN, azm, wave, lane); storeN<0>(lds, O_BCN, ar2, wave, lane); storeT(lds, O_KCN, ay0, wave, lane);
            __syncthreads();
            { const int io = ((tid >> 3) * LS + (tid & 7) * 8) * 2;
              ((u32x4*)gz)[tid] = *(const LAS u32x4*)(lds + O_AHN + io); ((u32x4*)(gz + 8192))[tid] = *(const LAS u32x4*)(lds + O_RHN + io);
              ((u32x4*)gz2)[tid] = *(const LAS u32x4*)(lds + O_BCN + io); ((u32x4*)(gz2 + 8192))[tid] = *(const LAS u32x4*)(lds + O_KCN + io); }
        } else {
            { f4 acc[2]; RW_ZERO(acc); mm64(acc, lds, O_TINV, O_AHT, wave, lane); storeN<0>(lds, O_A2N, acc, wave, lane); }
            __syncthreads();
            { f4 acc[2]; RW_ZERO(acc); mm64(acc, lds, O_TINV, O_MVT, wave, lane); mm64(acc, lds, O_A2N, O_STT, wave, lane); storeT(lds, O_UT, acc, wave, lane); }
            __syncthreads();
            f4 yacc[2]; RW_ZERO(yacc);
            mm64(yacc, lds, O_RHN, O_STT, wave, lane); mm64(yacc, lds, O_MRB, O_UT, wave, lane); mm64(yacc, lds, O_MRK, O_VT, wave, lane);
            __syncthreads();
#pragma unroll
            for (int cI = 0; cI < 2; ++cI) { const int col = ((wave & 1) * 2 + cI) * 16 + (lane & 15), row = (wave >> 1) * 16 + 4 * (lane >> 4);
#pragma unroll
                for (int e = 0; e < 4; ++e) YF[(row + e) * 64 + col] = yacc[cI][e]; }
            __syncthreads();
            { unsigned gcur = (unsigned)OB[((size_t)b * T + t0 + wave * 8) * 1024 + 512 + c];
#pragma unroll 1
            for (int q = 0; q < 8; ++q) {
                const int tt = wave * 8 + q; const size_t m = (size_t)b * T + t0 + tt;
                const unsigned gnxt = (unsigned)OB[(m + (q < 7 ? 1 : 0)) * 1024 + 512 + c];
                const float y = YF[tt * 64 + lane]; const float mean = wave_sum(y) * (1.f / 64.f); const float dy = y - mean; const float var = wave_sum(dy * dy) * (1.f / 64.f);
                const float yn = dy * rsqrtf(var + 64e-5f) * CTV(10) + CTV(11);
                const float vv = bf2f(*(const LAS bf16*)(lds + O_VT + (lane * LS + tt) * 2)), gg = LO_(gcur);
                OB[m * 1024 + 512 + c] = (bf16)f2bf((yn + BON[tt] * vv) * gg);
                gcur = gnxt;
            } }
        }
        __syncthreads();
#undef CTV
#undef LO_
#undef HI_
    }
}

__device__ __forceinline__ void chunk_out(LAS unsigned char* lds0, const int b, const int h, const int t0, const unsigned char* gz, const unsigned char* gz2, const float* bong, const bf16* VF, bf16* OB, const int tid0) {
    unsigned lb_ = 0u; int tid_l = tid0; asm volatile("" : "+v"(lb_), "+v"(tid_l));
    LAS unsigned char* lds = lds0 + lb_; const int tid = tid_l, lane = tid & 63, wave = __builtin_amdgcn_readfirstlane(tid >> 6);
    const int c = h * 64 + lane;
    const LAS float* CT = (const LAS float*)(lds + O_CT);
    LAS float* YF = (LAS float*)(lds + O_YF);
    const int io = ((tid >> 3) * LS + (tid & 7) * 8) * 2;
    const u32x4 sv = ((const u32x4*)gz)[tid], rv = ((const u32x4*)gz2)[tid];
    u32x2 yv[2];
#pragma unroll
    for (int k = 0; k < 2; ++k) { const int col = ((wave & 1) * 2 + k) * 16 + (lane & 15), row = (wave >> 1) * 16 + 4 * (lane >> 4); yv[k] = *(const u32x2*)(gz2 + 8192 + (col * 64 + row) * 2); }
    float gq[8], vq[8], bq[8];
#pragma unroll
    for (int q = 0; q < 8; ++q) { const int tt = wave * 8 + q; const size_t m = (size_t)b * T + t0 + tt;
        gq[q] = bf2f(((const bf16*)(gz2 + 16384))[tt * 64 + lane]); vq[q] = bf2f(VF[m * 256 + c]); bq[q] = bong[tt]; }
    *(LAS u32x4*)(lds + O_STT + io) = sv; *(LAS u32x4*)(lds + O_AHN + io) = rv;
    __syncthreads();
    f4 acc[2];
#pragma unroll
    for (int k = 0; k < 2; ++k) acc[k] = (f4){__uint_as_float(yv[k].x << 16), __uint_as_float(yv[k].x & 0xffff0000u), __uint_as_float(yv[k].y << 16), __uint_as_float(yv[k].y & 0xffff0000u)};
    mm64(acc, lds, O_AHN, O_STT, wave, lane);
#pragma unroll
    for (int cI = 0; cI < 2; ++cI) { const int col = ((wave & 1) * 2 + cI) * 16 + (lane & 15), row = (wave >> 1) * 16 + 4 * (lane >> 4);
#pragma unroll
        for (int e = 0; e < 4; ++e) YF[(row + e) * 64 + col] = acc[cI][e]; }
    __syncthreads();
#pragma unroll
    for (int q = 0; q < 8; ++q) { const int tt = wave * 8 + q; const size_t m = (size_t)b * T + t0 + tt;
        const float y = YF[tt * 64 + lane]; const float mean = wave_sum(y) * (1.f / 64.f); const float dy = y - mean; const float var = wave_sum(dy * dy) * (1.f / 64.f);
        const float yn = dy * rsqrtf(var + 64e-5f) * CT[10 * 64 + lane] + CT[11 * 64 + lane];
        OB[m * 1024 + 512 + c] = (bf16)f2bf((yn + bq[q] * vq[q]) * gq[q]); }
    __syncthreads();
}

__device__ __forceinline__ void carry(LAS unsigned char* lds0, unsigned char* gzc  , const int tid0) {
    f4 stacc[2]; RW_ZERO(stacc);
    { unsigned lb_ = 0u; asm volatile("" : "+v"(lb_)); LAS unsigned char* lds = lds0 + lb_; for (int i = tid0; i < MB / 4; i += NTHR) ((LAS unsigned*)(lds + O_STT))[i] = 0u; }
    u32x4 gnx = ((const u32x4*)gzc)[tid0];
    u32x2 znx[2];
    { const int lane = tid0 & 63, wave = tid0 >> 6;
#pragma unroll
      for (int k = 0; k < 2; ++k) { const int col = ((wave & 1) * 2 + k) * 16 + (lane & 15), row = (wave >> 1) * 16 + 4 * (lane >> 4); znx[k] = *(const u32x2*)(gzc + 8192 + (col * 64 + row) * 2); } }
#pragma unroll 1
    for (int cI = 0; cI < T / 64; ++cI) {
        unsigned lb_ = 0u; int tid_l = tid0; asm volatile("" : "+v"(lb_), "+v"(tid_l));
        LAS unsigned char* lds = lds0 + lb_; const int tid = tid_l, lane = tid & 63, wave = __builtin_amdgcn_readfirstlane(tid >> 6);
        unsigned char* rec = gzc + (size_t)cI * 16384;
        const int io = ((tid >> 3) * LS + (tid & 7) * 8) * 2;
        *(LAS u32x4*)(lds + O_AHN + io) = gnx;
        u32x2 zv[2]; zv[0] = znx[0]; zv[1] = znx[1];
        if (cI + 1 < T / 64) { gnx = ((const u32x4*)(rec + 16384))[tid];
#pragma unroll
            for (int k = 0; k < 2; ++k) { const int col = ((wave & 1) * 2 + k) * 16 + (lane & 15), row = (wave >> 1) * 16 + 4 * (lane >> 4); znx[k] = *(const u32x2*)(rec + 16384 + 8192 + (col * 64 + row) * 2); } }
        __syncthreads();
        ((u32x4*)rec)[tid] = *(const LAS u32x4*)(lds + O_STT + io);
        f4 acc[2];
#pragma unroll
        for (int k = 0; k < 2; ++k) acc[k] = (f4){__uint_as_float(zv[k].x << 16), __uint_as_float(zv[k].x & 0xffff0000u), __uint_as_float(zv[k].y << 16), __uint_as_float(zv[k].y & 0xffff0000u)};
        mm64(acc, lds, O_AHN, O_STT, wave, lane);
        __syncthreads();
        storeT(lds, O_STT, acc, wave, lane);
    }
}
}

namespace mb {
using rw::LS; using rw::MB; using rw::f4; using rw::mm64; using rw::storeN; using rw::bf16x8;
constexpr int O_CN = 0, O_BN = MB, O_BT = 2 * MB, O_XT0 = 3 * MB, O_XW0 = 5 * MB, O_CS0 = 7 * MB, O_HN0 = 9 * MB, O_SC0 = 11 * MB, O_SM = 13 * MB, O_YF = O_XW0;
static_assert(O_SM + 2048 <= LDS_BYTES - 576, "mamba LDS map");
__device__ __forceinline__ void chain(LAS unsigned char* lds0, const int l, const int b, const int gI, const bf16* P, bf16* OB, const int tid0, const int lane0, const int wave0) {
    const int tid = tid0, lane = lane0, wave = wave0;
    LAS unsigned char* const& lds = lds0;
    const float* cwp = INP(I_DCW) + (size_t)l * 4 * 512; const float* cbp = INP(I_DCB) + (size_t)l * 512;
    const int cc = tid & 255, sub = tid >> 8;
    const int col = cc < 128 ? (gI * 128 + cc) : (cc < 192 ? (256 + gI * 64 + (cc - 128)) : (384 + gI * 64 + (cc - 192)));
    const float cw0 = cwp[col], cw1 = cwp[512 + col], cw2 = cwp[1024 + col], cw3 = cwp[1536 + col], cb = cbp[col];
    f4 hacc[2][2];
#pragma unroll
    for (int hh = 0; hh < 2; ++hh) { hacc[hh][0] = (f4){0.f, 0.f, 0.f, 0.f}; hacc[hh][1] = (f4){0.f, 0.f, 0.f, 0.f}; }
    for (int i = tid; i < 2 * MB / 4; i += NTHR) ((LAS unsigned*)(lds0 + O_HN0))[i] = 0u;
    const float dtb0 = INP(I_DDTB)[l * 4 + gI * 2], dtb1 = INP(I_DDTB)[l * 4 + gI * 2 + 1];
    const float nA0 = -__expf(INP(I_DALOG)[l * 4 + gI * 2]), nA1 = -__expf(INP(I_DALOG)[l * 4 + gI * 2 + 1]);
    const float dsk0 = INP(I_DSKIP)[l * 4 + gI * 2], dsk1 = INP(I_DSKIP)[l * 4 + gI * 2 + 1];
    const float nw0 = INP(I_DNW)[l * 256 + gI * 128 + lane], nw1 = INP(I_DNW)[l * 256 + gI * 128 + 64 + lane];
#pragma unroll 1
    for (int t0 = 0; t0 < T; t0 += 64) {
        unsigned lb_ = 0u; int tid_l = tid0; asm volatile("" : "+v"(lb_), "+v"(tid_l));
        const int tid = tid_l, lane = tid & 63, wave = __builtin_amdgcn_readfirstlane(tid >> 6);
        LAS unsigned char* lds = lds0 + lb_;
        LAS float* SM = (LAS float*)(lds + O_SM);
        LAS float* YF = (LAS float*)(lds + O_YF);
        if (wave < 2) {
            const size_t m = (size_t)b * T + t0 + lane;
            const float dt = softplusf_(bf2f(P[m * PP + C_DT + gI * 2 + wave]) + (wave == 0 ? dtb0 : dtb1));
            float cs = dt * (wave == 0 ? nA0 : nA1);
#pragma unroll
            for (int o = 1; o < 64; o <<= 1) { const float y = __shfl_up(cs, o); if (lane >= o) cs += y; }
            const float cL = __shfl(cs, 63);
            SM[wave * 64 + lane] = dt; SM[128 + wave * 64 + lane] = cs; SM[256 + wave * 64 + lane] = __expf(cL - cs) * dt; SM[384 + wave * 64 + lane] = __expf(cs);
        }
        __syncthreads();
        { float h0, h1, h2, cur[8], nxt[8];
          { const int tb = t0 + sub * 32; h0 = tb >= 3 ? bf2f(P[((size_t)b * T + tb - 3) * PP + C_DX + col]) : 0.f; h1 = tb >= 2 ? bf2f(P[((size_t)b * T + tb - 2) * PP + C_DX + col]) : 0.f; h2 = tb >= 1 ? bf2f(P[((size_t)b * T + tb - 1) * PP + C_DX + col]) : 0.f;
#pragma unroll
            for (int j = 0; j < 8; ++j) cur[j] = bf2f(P[((size_t)b * T + tb + j) * PP + C_DX + col]); }
#pragma unroll 1
          for (int g8 = 0; g8 < 4; ++g8) {
            const int tb = t0 + sub * 32 + g8 * 8 + (g8 < 3 ? 8 : 0);
#pragma unroll
            for (int j = 0; j < 8; ++j) nxt[j] = bf2f(P[((size_t)b * T + tb + j) * PP + C_DX + col]);
#pragma unroll
            for (int j = 0; j < 8; ++j) {
                const int tt = sub * 32 + g8 * 8 + j;
                const float a = siluf_(cb + cw3 * cur[j] + cw2 * h2 + cw1 * h1 + cw0 * h0);
                h0 = h1; h1 = h2; h2 = cur[j];
                if (cc < 128) { const int hh = cc >> 6, p = cc & 63;
                    *(LAS bf16*)(lds + O_XT0 + hh * MB + (p * LS + tt) * 2) = (bf16)f2bf(a); *(LAS bf16*)(lds + O_XW0 + hh * MB + (p * LS + tt) * 2) = (bf16)f2bf(a * SM[256 + hh * 64 + tt]); }
                else if (cc < 192) { const int n = cc - 128; *(LAS bf16*)(lds + O_BN + (tt * LS + n) * 2) = (bf16)f2bf(a); *(LAS bf16*)(lds + O_BT + (n * LS + tt) * 2) = (bf16)f2bf(a); }
                else { const int n = cc - 192; *(LAS bf16*)(lds + O_CN + (tt * LS + n) * 2) = (bf16)f2bf(a);
                    *(LAS bf16*)(lds + O_CS0 + (tt * LS + n) * 2) = (bf16)f2bf(a * SM[384 + tt]); *(LAS bf16*)(lds + O_CS0 + MB + (tt * LS + n) * 2) = (bf16)f2bf(a * SM[384 + 64 + tt]); }
            }
#pragma unroll
            for (int j = 0; j < 8; ++j) cur[j] = nxt[j];
          } }
        __syncthreads();
        { f4 acc[2]; acc[0] = (f4){0.f, 0.f, 0.f, 0.f}; acc[1] = (f4){0.f, 0.f, 0.f, 0.f}; mm64(acc, lds, O_CN, O_BN, wave, lane);
#pragma unroll
            for (int hh = 0; hh < 2; ++hh) { f4 sc[2];
#pragma unroll
                for (int cI = 0; cI < 2; ++cI) { const int s = ((wave & 1) * 2 + cI) * 16 + (lane & 15), row = (wave >> 1) * 16 + 4 * (lane >> 4);
                    const float cs = SM[128 + hh * 64 + s], ds = SM[hh * 64 + s];
#pragma unroll
                    for (int e = 0; e < 4; ++e) { const float ct = SM[128 + hh * 64 + row + e]; sc[cI][e] = (s <= row + e) ? acc[cI][e] * __expf(ct - cs) * ds : 0.f; } }
                storeN<0>(lds, O_SC0 + hh * MB, sc, wave, lane); } }
        __syncthreads();
        f4 yacc[2][2];
#pragma unroll
        for (int hh = 0; hh < 2; ++hh) {
            yacc[hh][0] = (f4){0.f, 0.f, 0.f, 0.f}; yacc[hh][1] = (f4){0.f, 0.f, 0.f, 0.f};
            mm64(yacc[hh], lds, O_SC0 + hh * MB, O_XT0 + hh * MB, wave, lane); mm64(yacc[hh], lds, O_CS0 + hh * MB, O_HN0 + hh * MB, wave, lane);
            const float gL = SM[384 + hh * 64 + 63]; hacc[hh][0] = hacc[hh][0] * gL; hacc[hh][1] = hacc[hh][1] * gL;
            mm64(hacc[hh], lds, O_XW0 + hh * MB, O_BT, wave, lane);
        }
        __syncthreads();
#pragma unroll
        for (int hh = 0; hh < 2; ++hh) {
#pragma unroll
            for (int cI = 0; cI < 2; ++cI) { const int colp = ((wave & 1) * 2 + cI) * 16 + (lane & 15), row = (wave >> 1) * 16 + 4 * (lane >> 4);
#pragma unroll
                for (int e = 0; e < 4; ++e) YF[(row + e) * 128 + hh * 64 + colp] = yacc[hh][cI][e]; }
            storeN<0>(lds, O_HN0 + hh * MB, hacc[hh], wave, lane);
        }
        __syncthreads();
#pragma unroll
        for (int q = 0; q < 8; ++q) {
            const int tt = wave * 8 + q; const size_t m = (size_t)b * T + t0 + tt;
            const float x0 = bf2f(*(const LAS bf16*)(lds + O_XT0 + (lane * LS + tt) * 2)), x1 = bf2f(*(const LAS bf16*)(lds + O_XT0 + MB + (lane * LS + tt) * 2));
            const int c0 = gI * 128 + lane, c1 = c0 + 64;
            const float z0 = bf2f(P[m * PP + C_DZ + c0]), z1 = bf2f(P[m * PP + C_DZ + c1]);
            const float y0 = (YF[tt * 128 + lane] + dsk0 * x0) * siluf_(z0), y1 = (YF[tt * 128 + 64 + lane] + dsk1 * x1) * siluf_(z1);
            const float ss = wave_sum(y0 * y0 + y1 * y1); const float rs = rsqrtf(ss * (1.f / 128.f) + 1e-5f);
            OB[m * 1024 + 768 + c0] = (bf16)f2bf(y0 * rs * nw0); OB[m * 1024 + 768 + c1] = (bf16)f2bf(y1 * rs * nw1);
        }
        __syncthreads();
    }
}
}

namespace bsp {
typedef short bf16x8 __attribute__((ext_vector_type(8)));
typedef float f4 __attribute__((ext_vector_type(4)));
constexpr int HS = 129;
constexpr int O_HIST = 0;
constexpr int O_V = 66048;
constexpr int VS = 272;
constexpr int O_KB = O_V + 2 * 32 * VS * 2;
constexpr int KBUF = 20480;
static_assert(O_KB + 2 * KBUF <= LDS_BYTES - 600, "mixer B LDS map");
__device__ __forceinline__ unsigned okey(float s) { int q = (int)(s * 262144.f + 8388608.f); q = q < 1 ? 1 : (q > 16777215 ? 16777215 : q); return (unsigned)q << 8; }
__device__ __forceinline__ f4 idx_tile(const bf16* Pb, const int kt, const bf16x8 (&qi)[4][2], const float (&wq)[4], const int lane) {
    const bf16* kr = Pb + (size_t)(kt * 16 + (lane & 15)) * PP + C_IK + (lane >> 4) * 8;
    const bf16x8 a0 = *(const bf16x8*)kr, a1 = *(const bf16x8*)(kr + 32);
    f4 s = (f4){0.f, 0.f, 0.f, 0.f};
#pragma unroll
    for (int h = 0; h < 4; ++h) { f4 t = (f4){0.f, 0.f, 0.f, 0.f};
        t = __builtin_amdgcn_mfma_f32_16x16x32_bf16(a0, qi[h][0], t, 0, 0, 0); t = __builtin_amdgcn_mfma_f32_16x16x32_bf16(a1, qi[h][1], t, 0, 0, 0);
#pragma unroll
        for (int e = 0; e < 4; ++e) s[e] += wq[h] * fmaxf(t[e], 0.f); }
    return s;
}

__device__ __forceinline__ void item(LAS unsigned char* lds0, const int bb, const int qb, const bf16* P, bf16* OB, const int tid0, const int pm) {
    unsigned lb_ = 0u; int tid_l = tid0; asm volatile("" : "+v"(lb_), "+v"(tid_l));
    LAS unsigned char* lds = lds0 + lb_; const int tid = tid_l, lane = tid & 63, wave = __builtin_amdgcn_readfirstlane(tid >> 6);
    const bf16* Pb = P + (size_t)bb * T * PP;
    const int ql = wave * 16 + (lane & 15), tq = qb * 128 + ql, g = lane >> 4;
    const bf16* prow = Pb + (size_t)tq * PP;
    bf16x8 qi[4][2]; float wq[4];
#pragma unroll
    for (int h = 0; h < 4; ++h) { qi[h][0] = *(const bf16x8*)(prow + C_IQ + h * 64 + g * 8); qi[h][1] = *(const bf16x8*)(prow + C_IQ + h * 64 + 32 + g * 8); wq[h] = bf2f(prow[C_IW + h]) * 0.0625f; }
    LAS unsigned* hist = (LAS unsigned*)(lds + O_HIST) + ql * HS;
    const int nkt = (qb + 1) * 8;
    unsigned prefix = 0u; int needk = 256;
#pragma unroll 1
    for (int rr = 0; rr < (pm == 102 ? 2 : 1); ++rr) { prefix = 0u; needk = 256;
#pragma unroll 1
    for (int pass = 0; pass < 3; ++pass) {
        for (int i = lane; i < 16 * HS; i += 64) ((LAS unsigned*)(lds + O_HIST) + wave * 16 * HS)[i] = 0u;
        asm volatile("s_waitcnt lgkmcnt(0)" ::: "memory");
        const int shp = 32 - 8 * pass, shb = 24 - 8 * pass;
        float flo = 0.f, fhi = 0.f;
        if (pass > 0) { const float stepw = (pass == 1) ? 65536.f : 256.f; flo = ((float)prefix * stepw - 2.f) * (1.f / 262144.f) - 32.f; fhi = (((float)prefix + 1.f) * stepw + 2.f) * (1.f / 262144.f) - 32.f; }
        bf16x8 ka[4][2], kn[4][2];
#pragma unroll
        for (int u = 0; u < 4; ++u) { const bf16* kr = Pb + (size_t)(u * 16 + (lane & 15)) * PP + C_IK + g * 8; ka[u][0] = *(const bf16x8*)kr; ka[u][1] = *(const bf16x8*)(kr + 32); }
#pragma unroll 1
        for (int kt4 = 0; kt4 < nkt; kt4 += 4) {
            { const int ktn = (kt4 + 4 < nkt) ? kt4 + 4 : kt4;
#pragma unroll
              for (int u = 0; u < 4; ++u) { const bf16* kr = Pb + (size_t)((ktn + u) * 16 + (lane & 15)) * PP + C_IK + g * 8; kn[u][0] = *(const bf16x8*)kr; kn[u][1] = *(const bf16x8*)(kr + 32); } }
#pragma unroll
            for (int u = 0; u < 4; ++u) {
                f4 s = (f4){0.f, 0.f, 0.f, 0.f};
#pragma unroll
                for (int h = 0; h < 4; ++h) { f4 t = (f4){0.f, 0.f, 0.f, 0.f};
                    t = __builtin_amdgcn_mfma_f32_16x16x32_bf16(ka[u][0], qi[h][0], t, 0, 0, 0); t = __builtin_amdgcn_mfma_f32_16x16x32_bf16(ka[u][1], qi[h][1], t, 0, 0, 0);
#pragma unroll
                    for (int e = 0; e < 4; ++e) s[e] += wq[h] * fmaxf(t[e], 0.f); }
                if (pass == 0) {
#pragma unroll
                    for (int e = 0; e < 4; ++e) { const int key = (kt4 + u) * 16 + 4 * g + e;
                        if (key <= tq) { const unsigned bin = okey(s[e]) >> 24; __hip_atomic_fetch_add(hist + (bin >> 1), (bin & 1u) ? 0x10000u : 1u, __ATOMIC_RELAXED, __HIP_MEMORY_SCOPE_WORKGROUP); } }
                } else {
#pragma unroll
                    for (int e = 0; e < 4; ++e) { const int key = (kt4 + u) * 16 + 4 * g + e;
                        if (s[e] >= flo && s[e] <= fhi && key <= tq) { const unsigned k32 = okey(s[e]);
                            if ((k32 >> shp) == prefix) { const unsigned bin = (k32 >> shb) & 255u; __hip_atomic_fetch_add(hist + (bin >> 1), (bin & 1u) ? 0x10000u : 1u, __ATOMIC_RELAXED, __HIP_MEMORY_SCOPE_WORKGROUP); } } }
                }
            }
#pragma unroll
            for (int u = 0; u < 4; ++u) { ka[u][0] = kn[u][0]; ka[u][1] = kn[u][1]; }
        }
        asm volatile("s_waitcnt lgkmcnt(0)" ::: "memory");
        int cum = 0; unsigned bsel = 0u; int above = 0;
        for (int wd = 127; wd >= 0; --wd) { const unsigned v = hist[wd]; const int hi = (int)(v >> 16), lo = (int)(v & 0xffffu);
            if (cum + hi >= needk) { bsel = (unsigned)(2 * wd + 1); above = cum; break; } cum += hi;
            if (cum + lo >= needk) { bsel = (unsigned)(2 * wd); above = cum; break; } cum += lo; }
        prefix = (prefix << 8) | bsel; needk -= above;
        asm volatile("s_waitcnt lgkmcnt(0)" ::: "memory");
    }
    }
    unsigned thr = prefix; int cidx = 1 << 20;
    bool tie = false;
    if (tq < 256) thr = 0u;
    else { const unsigned v = hist[(prefix & 255u) >> 1]; const int ceq = (prefix & 1u) ? (int)(v >> 16) : (int)(v & 0xffffu); tie = needk < ceq; }
    if (__any(tie)) {
        int cbin = 0, rem = needk;
#pragma unroll 1
        for (int ip = 0; ip < 2; ++ip) {
            for (int i = g; i < HS; i += 4) hist[i] = 0u;
            asm volatile("s_waitcnt lgkmcnt(0)" ::: "memory");
#pragma unroll 1
            for (int kt = 0; kt < nkt; ++kt) {
                const f4 s = idx_tile(Pb, kt, qi, wq, lane);
#pragma unroll
                for (int e = 0; e < 4; ++e) { const int key = kt * 16 + 4 * g + e; const unsigned k32 = okey(s[e]);
                    const bool in = tie && key <= tq && (k32 >> 8) == prefix && (ip == 0 || (key >> 4) == cbin);
                    if (in) { const unsigned bin = ip == 0 ? (unsigned)(key >> 4) : (unsigned)(key & 15); __hip_atomic_fetch_add(hist + (bin >> 1), (bin & 1u) ? 0x10000u : 1u, __ATOMIC_RELAXED, __HIP_MEMORY_SCOPE_WORKGROUP); } }
            }
            asm volatile("s_waitcnt lgkmcnt(0)" ::: "memory");
            int cum = 0, bs = 0, below = 0;
            for (int wd = 0; wd < 128; ++wd) { const unsigned vv = hist[wd]; const int lo = (int)(vv & 0xffffu), hi = (int)(vv >> 16);
                if (cum + lo >= rem) { bs = 2 * wd; below = cum; break; } cum += lo;
                if (cum + hi >= rem) { bs = 2 * wd + 1; below = cum; break; } cum += hi; }
            if (ip == 0) { cbin = bs; rem -= below; } else if (tie) cidx = cbin * 16 + bs;
            asm volatile("s_waitcnt lgkmcnt(0)" ::: "memory");
        }
    }
    __syncthreads();
#pragma unroll
    for (int h = 0; h < 4; ++h) { *(LAS bf16x8*)(lds + O_HIST + wave * 8192 + ((h * 2 + 0) * 64 + lane) * 16) = qi[h][0]; *(LAS bf16x8*)(lds + O_HIST + wave * 8192 + ((h * 2 + 1) * 64 + lane) * 16) = qi[h][1]; }
    bf16x8 qa[4][2];
#pragma unroll
    for (int h = 0; h < 4; ++h) { qa[h][0] = *(const bf16x8*)(prow + C_BQ + h * 64 + g * 8); qa[h][1] = *(const bf16x8*)(prow + C_BQ + h * 64 + 32 + g * 8); }
    f4 oacc[4][4]; float mrun[4], lrun[4];
#pragma unroll
    for (int h = 0; h < 4; ++h) { mrun[h] = -INFINITY; lrun[h] = 0.f;
#pragma unroll
        for (int dt = 0; dt < 4; ++dt) oacc[h][dt] = (f4){0.f, 0.f, 0.f, 0.f}; }
#pragma unroll 1
    for (int rr = 0; rr < (pm == 103 ? 2 : 1); ++rr) {
#pragma unroll
    for (int h = 0; h < 4; ++h) { mrun[h] = -INFINITY; lrun[h] = 0.f;
#pragma unroll
        for (int dt = 0; dt < 4; ++dt) oacc[h][dt] = (f4){0.f, 0.f, 0.f, 0.f}; }
    const int nst = (qb + 1) * 4;
    const int vkey = tid >> 4, vch = tid & 15;
    u32x4 vpre0 = *(const u32x4*)(Pb + (size_t)vkey * PP + C_BV + vch * 8), vpre1 = *(const u32x4*)(Pb + (size_t)vkey * PP + C_BV + 128 + vch * 8);
    const unsigned vrd = (unsigned)(unsigned long)lds + (unsigned)(O_V + (4 * g + ((lane >> 2) & 3)) * (VS * 2) + (lane & 3) * 8);
    __syncthreads();
    {   const unsigned kb = (unsigned)O_KB;
#pragma unroll
        for (int jj = 0; jj < 3; ++jj) { const int j = wave + 8 * jj;
            if (j < 16) { const int S = j * 64 + lane, r = S >> 5, p = S & 31;
                __builtin_amdgcn_global_load_lds((const unsigned*)(Pb + (size_t)r * PP + C_BK + ((p ^ (r & 15)) << 3)), (LAS unsigned*)(lds + kb + j * 1024), 16, 0, 0); }
            else if (j < 20) { const int S = (j - 16) * 64 + lane, r = S >> 3, p = S & 7;
                __builtin_amdgcn_global_load_lds((const unsigned*)(Pb + (size_t)r * PP + C_IK + ((p ^ (r & 7)) << 3)), (LAS unsigned*)(lds + kb + 16384 + (j - 16) * 1024), 16, 0, 0); } } }
#pragma unroll 1
    for (int st = 0; st < nst; ++st) {
        const int key0 = st * 32; const unsigned vbuf = (unsigned)(st & 1) * (32 * VS * 2);
        unsigned qio = (unsigned)(O_HIST + wave * 8192 + lane * 16); asm volatile("" : "+v"(qio));
        { LAS bf16* VL = (LAS bf16*)(lds + O_V + vbuf); *(LAS u32x4*)(VL + vkey * VS + vch * 8) = vpre0; *(LAS u32x4*)(VL + vkey * VS + 128 + vch * 8) = vpre1; }
        asm volatile("s_waitcnt vmcnt(0)" ::: "memory");
        __syncthreads();
        if (st + 1 < nst) {
            const int kn0 = key0 + 32; const unsigned kb = (unsigned)(O_KB + ((st + 1) & 1) * KBUF);
#pragma unroll
            for (int jj = 0; jj < 3; ++jj) { const int j = wave + 8 * jj;
                if (j < 16) { const int S = j * 64 + lane, r = S >> 5, p = S & 31;
                    __builtin_amdgcn_global_load_lds((const unsigned*)(Pb + (size_t)(kn0 + r) * PP + C_BK + ((p ^ (r & 15)) << 3)), (LAS unsigned*)(lds + kb + j * 1024), 16, 0, 0); }
                else if (j < 20) { const int S = (j - 16) * 64 + lane, r = S >> 3, p = S & 7;
                    __builtin_amdgcn_global_load_lds((const unsigned*)(Pb + (size_t)(kn0 + r) * PP + C_IK + ((p ^ (r & 7)) << 3)), (LAS unsigned*)(lds + kb + 16384 + (j - 16) * 1024), 16, 0, 0); } }
        }
        const unsigned kbc = (unsigned)(O_KB + (st & 1) * KBUF);
#define KQ_(h, k2, ks) (*(const LAS bf16x8*)(lds + kbc + (k2 * 16 + (lane & 15)) * 512 + ((((h) * 8 + (ks) * 4 + g) ^ (lane & 15)) << 4)))
#define KI_(k2, ks) (*(const LAS bf16x8*)(lds + kbc + 16384 + (k2 * 16 + (lane & 15)) * 128 + ((((ks) * 4 + g) ^ (lane & 7)) << 4)))
        bool sel[2][4];
#pragma unroll
        for (int k2 = 0; k2 < 2; ++k2) { f4 s = (f4){0.f, 0.f, 0.f, 0.f};
#pragma unroll
            for (int h = 0; h < 4; ++h) { f4 t = (f4){0.f, 0.f, 0.f, 0.f};
                const bf16x8 qh0 = *(const LAS bf16x8*)(lds + qio + ((h * 2 + 0) * 64) * 16), qh1 = *(const LAS bf16x8*)(lds + qio + ((h * 2 + 1) * 64) * 16);
                t = __builtin_amdgcn_mfma_f32_16x16x32_bf16(KI_(k2, 0), qh0, t, 0, 0, 0); t = __builtin_amdgcn_mfma_f32_16x16x32_bf16(KI_(k2, 1), qh1, t, 0, 0, 0);
#pragma unroll
                for (int e = 0; e < 4; ++e) s[e] += wq[h] * fmaxf(t[e], 0.f); }
#pragma unroll
            for (int e = 0; e < 4; ++e) { const int key = key0 + k2 * 16 + 4 * g + e; const unsigned k24 = okey(s[e]) >> 8;
                sel[k2][e] = key <= tq && (k24 > thr || (k24 == thr && key <= cidx)); } }
#pragma unroll
        for (int h = 0; h < 4; ++h) {
            if (h == 2 && st + 1 < nst) { vpre0 = *(const u32x4*)(Pb + (size_t)(key0 + 32 + vkey) * PP + C_BV + vch * 8); vpre1 = *(const u32x4*)(Pb + (size_t)(key0 + 32 + vkey) * PP + C_BV + 128 + vch * 8); }
            f4 sc[2];
#pragma unroll
            for (int k2 = 0; k2 < 2; ++k2) { f4 t = (f4){0.f, 0.f, 0.f, 0.f};
                t = __builtin_amdgcn_mfma_f32_16x16x32_bf16(KQ_(h, k2, 0), qa[h][0], t, 0, 0, 0); t = __builtin_amdgcn_mfma_f32_16x16x32_bf16(KQ_(h, k2, 1), qa[h][1], t, 0, 0, 0);
#pragma unroll
                for (int e = 0; e < 4; ++e) sc[k2][e] = sel[k2][e] ? t[e] * 0.125f : -INFINITY; }
            float mx = fmaxf(fmaxf(fmaxf(sc[0][0], sc[0][1]), fmaxf(sc[0][2], sc[0][3])), fmaxf(fmaxf(sc[1][0], sc[1][1]), fmaxf(sc[1][2], sc[1][3])));
            mx = fmaxf(mx, __shfl_xor(mx, 16)); mx = fmaxf(mx, __shfl_xor(mx, 32));
            const float mnew = fmaxf(mrun[h], mx), msafe = (mnew == -INFINITY) ? 0.f : mnew;
            const float corr = __expf(mrun[h] - msafe); mrun[h] = mnew;
            float p[8]; float ps = 0.f;
#pragma unroll
            for (int e = 0; e < 4; ++e) { p[e] = __expf(sc[0][e] - msafe); p[4 + e] = __expf(sc[1][e] - msafe); ps += p[e] + p[4 + e]; }
            lrun[h] = lrun[h] * corr + ps;
            union { bf16x8 v; unsigned u[4]; } pb;
            pb.u[0] = pg8::cvt_pk_bf16(p[0], p[1]); pb.u[1] = pg8::cvt_pk_bf16(p[2], p[3]); pb.u[2] = pg8::cvt_pk_bf16(p[4], p[5]); pb.u[3] = pg8::cvt_pk_bf16(p[6], p[7]);
            union { bf16x8 v; u32x2 h2[2]; } vf[4];
            const unsigned va = vrd + vbuf + (unsigned)(h * 128);
            asm volatile("ds_read_b64_tr_b16 %0, %8\n\tds_read_b64_tr_b16 %1, %8 offset:%9\n\tds_read_b64_tr_b16 %2, %8 offset:32\n\tds_read_b64_tr_b16 %3, %8 offset:%10\n\t"
                         "ds_read_b64_tr_b16 %4, %8 offset:64\n\tds_read_b64_tr_b16 %5, %8 offset:%11\n\tds_read_b64_tr_b16 %6, %8 offset:96\n\tds_read_b64_tr_b16 %7, %8 offset:%12\n\ts_waitcnt lgkmcnt(0)"
                         : "=&v"(vf[0].h2[0]), "=&v"(vf[0].h2[1]), "=&v"(vf[1].h2[0]), "=&v"(vf[1].h2[1]), "=&v"(vf[2].h2[0]), "=&v"(vf[2].h2[1]), "=&v"(vf[3].h2[0]), "=&v"(vf[3].h2[1])
                         : "v"(va), "i"(16 * VS * 2), "i"(16 * VS * 2 + 32), "i"(16 * VS * 2 + 64), "i"(16 * VS * 2 + 96) : "memory");
            __builtin_amdgcn_sched_barrier(0);
#pragma unroll
            for (int dt = 0; dt < 4; ++dt) { oacc[h][dt] = oacc[h][dt] * corr; oacc[h][dt] = __builtin_amdgcn_mfma_f32_16x16x32_bf16(vf[dt].v, pb.v, oacc[h][dt], 0, 0, 0); }
        }
    }
    __syncthreads();
    }
#undef KQ_
#undef KI_
    const size_t m = (size_t)bb * T + tq;
#pragma unroll
    for (int h = 0; h < 4; ++h) { float l = lrun[h]; l += __shfl_xor(l, 16); l += __shfl_xor(l, 32); const float inv = 1.f / l;
#pragma unroll
        for (int dt = 0; dt < 4; ++dt) { u32x2 w; w.x = pk2(oacc[h][dt][0] * inv, oacc[h][dt][1] * inv); w.y = pk2(oacc[h][dt][2] * inv, oacc[h][dt][3] * inv);
            *(u32x2*)(OB + m * 1024 + 256 + h * 64 + dt * 16 + 4 * g) = w; } }
    __syncthreads();
}
}

namespace awin {
typedef short bf16x8 __attribute__((ext_vector_type(8)));
typedef float f4 __attribute__((ext_vector_type(4)));
constexpr int EXS = 66;
constexpr int O_EX = 0;
constexpr int VSW = 72;
constexpr int O_VW = 101376;
__device__ __forceinline__ void item(LAS unsigned char* lds0, const int bb, const int blk, const int h, const bf16* P, bf16* OB, const int tid0) {
    unsigned lb_ = 0u; int tid_l = tid0; asm volatile("" : "+v"(lb_), "+v"(tid_l));
    LAS unsigned char* lds = lds0 + lb_; const int tid = tid_l, lane = tid & 63, wave = __builtin_amdgcn_readfirstlane(tid >> 6);
    const bf16* Pb = P + (size_t)bb * T * PP; const int start = blk * 128, g = lane >> 4, ln = lane & 15;
    LAS float* EX = (LAS float*)(lds + O_EX);
    LAS bf16* VW = (LAS bf16*)(lds + O_VW + wave * 4608);
#pragma unroll 1
    for (int s4 = 0; s4 < 4; ++s4) {
        const int st = wave * 4 + s4;
        const int grp = st < 8 ? 0 : (st < 16 ? 1 : 2);
        const int dil = grp == 0 ? 1 : (grp == 1 ? 4 : 16), win = grp == 0 ? 128 : (grp == 1 ? 512 : 2048);
        const int r = grp == 0 ? 0 : (grp == 1 ? ((st - 8) >> 1) : (st - 16)), a0 = grp == 0 ? 16 * st : (grp == 1 ? ((st - 8) & 1) * 16 : 0), nqc = grp == 0 ? 128 : (grp == 1 ? 32 : 8);
        const int a = a0 + ln; const bool qok = a < nqc; const int ql = (qok ? a : (nqc - 1)) * dil + r, tq = start + ql;
        const bf16* qp = Pb + (size_t)tq * PP + C_AQ + grp * 256 + h * 64 + g * 8;
        const bf16x8 q0 = *(const bf16x8*)qp, q1 = *(const bf16x8*)(qp + 32);
        bf16x8 kf[10][2];
#pragma unroll
        for (int kt = 0; kt < 10; ++kt) { int pos = start - win + (a0 + 16 * kt + ln) * dil + r; pos = pos < 0 ? 0 : (pos > T - 1 ? T - 1 : pos);
            const bf16* kp = Pb + (size_t)pos * PP + C_AK + grp * 256 + h * 64 + g * 8; kf[kt][0] = *(const bf16x8*)kp; kf[kt][1] = *(const bf16x8*)(kp + 32); }
        f4 sc[10]; float mx = -INFINITY;
#pragma unroll
        for (int kt = 0; kt < 10; ++kt) { f4 t = (f4){0.f, 0.f, 0.f, 0.f};
            t = __builtin_amdgcn_mfma_f32_16x16x32_bf16(kf[kt][0], q0, t, 0, 0, 0); t = __builtin_amdgcn_mfma_f32_16x16x32_bf16(kf[kt][1], q1, t, 0, 0, 0);
#pragma unroll
            for (int e = 0; e < 4; ++e) { const int c = a0 + 16 * kt + 4 * g + e; const int pos = start - win + c * dil + r;
                const bool ok = qok && c >= a && c <= a + 128 && pos >= 0;
                sc[kt][e] = ok ? t[e] * 0.125f : -INFINITY; mx = fmaxf(mx, sc[kt][e]); } }
        mx = fmaxf(mx, __shfl_xor(mx, 16)); mx = fmaxf(mx, __shfl_xor(mx, 32));
        const float msafe = (mx == -INFINITY) ? 0.f : mx; float lsum = 0.f;
#pragma unroll
        for (int kt = 0; kt < 10; ++kt)
#pragma unroll
            for (int e = 0; e < 4; ++e) { sc[kt][e] = __expf(sc[kt][e] - msafe); lsum += sc[kt][e]; }
        lsum += __shfl_xor(lsum, 16); lsum += __shfl_xor(lsum, 32);
        f4 oacc[4];
#pragma unroll
        for (int dt = 0; dt < 4; ++dt) oacc[dt] = (f4){0.f, 0.f, 0.f, 0.f};
#pragma unroll
        for (int s5 = 0; s5 < 5; ++s5) {
            int pos = start - win + (a0 + 32 * s5 + (lane >> 1)) * dil + r; pos = pos < 0 ? 0 : (pos > T - 1 ? T - 1 : pos);
            const u32x4* vp = (const u32x4*)(Pb + (size_t)pos * PP + C_AV + grp * 256 + h * 64 + (lane & 1) * 32);
            const u32x4 v0 = vp[0], v1 = vp[1], v2 = vp[2], v3 = vp[3];
            LAS u32x4* vd = (LAS u32x4*)(VW + (lane >> 1) * VSW + (lane & 1) * 32);
            asm volatile("s_waitcnt lgkmcnt(0)" ::: "memory");
            vd[0] = v0; vd[1] = v1; vd[2] = v2; vd[3] = v3;
            asm volatile("s_waitcnt lgkmcnt(0)" ::: "memory");
            bf16x8 pb;
#pragma unroll
            for (int e = 0; e < 4; ++e) { pb[e] = (short)f2bf(sc[2 * s5][e]); pb[4 + e] = (short)f2bf(sc[2 * s5 + 1][e]); }
#pragma unroll
            for (int dt = 0; dt < 4; ++dt) { bf16x8 vf; const LAS bf16* vb = VW + (4 * g) * VSW + dt * 16 + ln;
#pragma unroll
                for (int e = 0; e < 4; ++e) { vf[e] = (short)vb[e * VSW]; vf[4 + e] = (short)vb[(16 + e) * VSW]; }
                oacc[dt] = __builtin_amdgcn_mfma_f32_16x16x32_bf16(vf, pb, oacc[dt], 0, 0, 0); }
        }
        if (qok) { LAS float* ex = EX + (grp * 128 + ql) * EXS;
#pragma unroll
            for (int dt = 0; dt < 4; ++dt) { ex[dt * 16 + 4 * g + 0] = oacc[dt][0]; ex[dt * 16 + 4 * g + 1] = oacc[dt][1]; ex[dt * 16 + 4 * g + 2] = oacc[dt][2]; ex[dt * 16 + 4 * g + 3] = oacc[dt][3]; }
            if (g == 0) { ex[64] = mx; ex[65] = lsum; } }
    }
    __syncthreads();
    { const int ql = tid >> 2, d0 = (tid & 3) * 16;
      const LAS float* e0 = EX + (0 * 128 + ql) * EXS; const LAS float* e1 = EX + (1 * 128 + ql) * EXS; const LAS float* e2 = EX + (2 * 128 + ql) * EXS;
      const float m0 = e0[64], m1 = e1[64], m2 = e2[64], M = fmaxf(m0, fmaxf(m1, m2));
      const float w0 = __expf(m0 - M), w1 = __expf(m1 - M), w2 = __expf(m2 - M); const float inv = 1.f / (w0 * e0[65] + w1 * e1[65] + w2 * e2[65]);
      unsigned pk[8];
#pragma unroll
      for (int j = 0; j < 8; ++j) { const float x0 = (w0 * e0[d0 + 2 * j] + w1 * e1[d0 + 2 * j] + w2 * e2[d0 + 2 * j]) * inv, x1 = (w0 * e0[d0 + 2 * j + 1] + w1 * e1[d0 + 2 * j + 1] + w2 * e2[d0 + 2 * j + 1]) * inv; pk[j] = pk2(x0, x1); }
      u32x4* op = (u32x4*)(OB + ((size_t)bb * T + start + ql) * 1024 + h * 64 + d0);
      op[0] = (u32x4){pk[0], pk[1], pk[2], pk[3]}; op[1] = (u32x4){pk[4], pk[5], pk[6], pk[7]}; }
    __syncthreads();
}
}

template <int SP>
__device__ __forceinline__ void phase_body(const int l_in, LAS unsigned char* lds) {
    int tid_ = threadIdx.x, bid_ = blockIdx.x, l_ = l_in, G_ = gridDim.x; asm volatile("" : "+v"(tid_), "+s"(bid_), "+s"(l_), "+s"(G_));
    const int tid = tid_, lane = tid & 63, wave = __builtin_amdgcn_readfirstlane(tid >> 6), l = l_;
    const int G = G_, bid = bid_;
    const int gw = bid * NWAVES + wave, NGW = G * NWAVES;
    unsigned char* ws = (unsigned char*)gptr(ldptr(lds, 36));
    int* ctl = (int*)(ws + WS_CTL);
    bf16* XB = (bf16*)(ws + WS_XB); bf16* OB = (bf16*)(ws + WS_O); bf16* VF = (bf16*)(ws + WS_VF); bf16* P = (bf16*)(ws + WS_P);
    bf16* GS = (bf16*)(ws + WS_GS); bf16* MG = (bf16*)(ws + WS_MERGED); bf16* XS = (bf16*)(ws + WS_XS); bf16* HB = (bf16*)(ws + WS_H);
    bf16* WGU = (bf16*)(ws + WS_WGU); bf16* WD = (bf16*)(ws + WS_WD);
    float* X = (float*)gptr(ldptr(lds, 35));
    int* tok_e = (int*)(ws + WS_ROUTE); float* tok_g = (float*)(ws + WS_ROUTE + 256 * 1024); int* tok_rank = (int*)(ws + WS_ROUTE + 512 * 1024); int* tok_slot = (int*)(ws + WS_ROUTE + 768 * 1024);
    (void)ctl; (void)XB; (void)OB; (void)VF; (void)P; (void)GS; (void)MG; (void)XS; (void)HB; (void)WGU; (void)WD; (void)X; (void)tok_e; (void)tok_g; (void)tok_rank; (void)tok_slot; (void)gw; (void)NGW; (void)lane;
    {
        bf16* WinT = (bf16*)(ws + WS_WINT) + (size_t)l * 5120 * 1024; bf16* WgT = (bf16*)(ws + WS_WGT) + (size_t)l * 4096 * 1024;
        bf16* WbrT = (bf16*)(ws + WS_WBRT) + (size_t)l * 1024 * 1024; bf16* WoutT = (bf16*)(ws + WS_WOUTT) + (size_t)l * 1024 * 1024;
        float* WrT = (float*)(ws + WS_WRT) + (size_t)l * 36 * 1024;
        int* cnt = ctl + CW_CNT + l * 64;

        if constexpr (SP == -1) {
            LAS float* scr = (LAS float*)(lds + wave * 16384);
#pragma unroll 1
            for (int job = 0; job < NL * 11; ++job) {
                const int ll = job / 11, jk = job % 11;
                if (jk < 5) {
                    const float* W = INP(I_WIN) + (size_t)ll * 1024 * INW;
                    const int sc0 = jk == 0 ? 0 : (jk == 1 ? 3396 : (jk == 2 ? 3392 : (jk == 3 ? 5060 : 5064)));
                    const int snc = jk == 0 ? 3392 : (jk == 1 ? 1664 : (jk == 4 ? 4096 : 4));
                    const int sr0 = jk == 0 ? 0 : (jk == 1 ? 3392 : (jk == 2 ? 5056 : (jk == 3 ? 5060 : 0)));
                    bf16* dst = jk == 4 ? (bf16*)(ws + WS_WGT) + (size_t)ll * 4096 * 1024 : (bf16*)(ws + WS_WINT) + (size_t)ll * 5120 * 1024;
                    const int nbn = (snc + 31) / 32, nit = 16 * nbn;
#pragma unroll 1
                    for (int it = gw; it < nit; it += NGW) transpose_item(W, INW, sc0, snc, dst, 1024, sr0, 0, it / nbn, it % nbn, scr, lane);
                } else if (jk < 9) {
                    const int n = jk - 5; const float* Wb = INP(I_WBR) + ((size_t)ll * 4 + n) * 256 * 1024;
#pragma unroll 1
                    for (int it = gw; it < 4 * 32; it += NGW) transpose_item(Wb, 1024, 0, 1024, (bf16*)(ws + WS_WBRT) + (size_t)ll * 1024 * 1024, 1024, 0, n * 256, it / 32, it % 32, scr, lane);
                } else if (jk == 9) {
                    const float* Wo = INP(I_WOUT) + (size_t)ll * 1024 * 1024;
#pragma unroll 1
                    for (int it = gw; it < 16 * 32; it += NGW) transpose_item(Wo, 1024, 0, 1024, (bf16*)(ws + WS_WOUTT) + (size_t)ll * 1024 * 1024, 1024, 0, 0, it / 32, it % 32, scr, lane);
                } else {
                    bf16* wi = (bf16*)(ws + WS_WINT) + (size_t)ll * 5120 * 1024;
#pragma unroll 1
                    for (int i = gw * 64 + lane; i < 56 * 1024 / 8; i += NGW * 64) ((u32x4*)(wi + (size_t)5064 * 1024))[i] = (u32x4){0u, 0u, 0u, 0u};
                    float* wr = (float*)(ws + WS_WRT) + (size_t)ll * 36 * 1024; const float* rg = INP(I_RG) + (size_t)ll * 1024 * 4; const float* re = INP(I_RE) + (size_t)ll * 1024 * 32;
#pragma unroll 1
                    for (int i = gw * 64 + lane; i < 36 * 1024; i += NGW * 64) { const int o = i / 1024, k = i % 1024; wr[i] = o < 4 ? rg[k * 4 + o] : re[k * 32 + (o - 4)]; }
                }
            }
            for (int m = gw; m < M; m += NGW) {
                const f32x4* xr = (const f32x4*)(INP(I_X) + (size_t)m * D) + lane;
#pragma unroll
                for (int j = 0; j < 4; ++j) { const f32x4 v = xr[64 * j]; ((f32x4*)(X + (size_t)m * D))[lane + 64 * j] = v;
                    u32x2 w; w.x = pk2(v[0], v[1]); w.y = pk2(v[2], v[3]); ((u32x2*)(XB + (size_t)m * D))[lane + 64 * j] = w; }
            }
        }
        else if constexpr (SP == 0) {
            pg8::Gemm g{XB, WinT, 1024, 1024, 1024}; pg8::StaticOrder S; S.init(M, PP, G, bid, 1024, 1024);
            EpiStoreBf16 E{P, PP, 0, PP};
            pg8::gemm_phase<EpiStoreBf16, pg8::StaticOrder>(lds, g, S, E);
        }
        else if constexpr (SP == 12) {
            if (bid < 32) rw::carry(lds, ws + WS_RW + (size_t)bid * 64 * 16384, tid);
        }
        else if constexpr (SP == 13) {
            unsigned char* GZ = ws + WS_RW;
            const int h = bid & 3, k = bid >> 2;
            rw::build_ct(lds, l, h, lane, wave); __syncthreads();
#pragma unroll 1
            for (int idx = k; idx < 512; idx += (G >> 2)) { const int b = idx >> 6, cI = idx & 63; const size_t ci_ = (size_t)((b * 4 + h) * 64 + cI);
                rw::chunk_out(lds, b, h, cI * 64, GZ + ci_ * 16384, ws + WS_RW2 + ci_ * 24576, (const float*)(ws + WS_BONG) + ci_ * 64, VF, OB, tid); }
        }
        else if constexpr (SP == 15) {
            unsigned char* GZ = ws + WS_RW;
            int* qctr = ctl + CW_Q + l * 64;
            int cur_h = -1;
#pragma unroll 1
            for (;;) {
                unsigned so = (unsigned)(LDS_BYTES - 584); asm volatile("" : "+v"(so));
                volatile LAS int* slot = (volatile LAS int*)(lds + so);
                int tid = threadIdx.x; asm volatile("" : "+v"(tid));
                const int lane = tid & 63, wave = __builtin_amdgcn_readfirstlane(tid >> 6);
                __syncthreads();
                if (tid == 0) *slot = atomicAdd(qctr, 1);
                __syncthreads();
                const int it = __builtin_amdgcn_readfirstlane(*slot);
                if (it >= 3344) break;
                if (it < 16) { mb::chain(lds, l, it >> 1, it & 1, P, OB, tid, lane, wave); }
                else if (it < 272) { const int j = it - 16; bsp::item(lds, j & 7, 31 - (j >> 3), P, OB, tid, (int)(unsigned)ldptr(lds, 37)); }
                else if (it < 2320) { const int j = it - 272, h = j >> 9, idx = j & 511, b = idx >> 6, cI = idx & 63;
                    if (h != cur_h) { rw::build_ct(lds, l, h, lane, wave); cur_h = h; __syncthreads(); }
                    { const size_t ci_ = (size_t)((b * 4 + h) * 64 + cI); rw::chunk<1>(lds, l, b, h, cI * 64, GZ + ci_ * 16384, ws + WS_RW2 + ci_ * 24576, (float*)(ws + WS_BONG) + ci_ * 64, P, VF, OB, tid); } }
                else { const int j = it - 2320; awin::item(lds, j >> 7, (j >> 2) & 31, j & 3, P, OB, tid); }
            }
        }
        else if constexpr (SP == 4) {
            if (bid < 32) { rw::carry(lds, ws + WS_RW + (size_t)bid * 64 * 16384, tid); __syncthreads(); }
            pg8::Gemm g{XB, WgT, 1024, 1024, 1024}; SkewOrder S{M / 256, 16, (M / 256) * 16, bid, 1024, 1024};
            EpiStoreBf16 E{GS, 4096, 1, 4096};
            pg8::gemm_phase<EpiStoreBf16, SkewOrder>(lds, g, S, E);
        }
        else if constexpr (SP == 5) {
            pg8::Gemm g{OB, WbrT, 1024, 1024, 256}; BranchOrder S{M / 256, 4, G, bid};
            EpiBranch E{GS, MG};
            pg8::gemm_phase<EpiBranch, BranchOrder>(lds, g, S, E);
        }
        else if constexpr (SP == 6) {
            pg8::Gemm g{MG, WoutT, 1024, 1024, 1024}; pg8::StaticOrder S; S.init(M, 1024, G, bid, 1024, 1024);
            EpiResid E{X};
            pg8::gemm_phase<EpiResid, pg8::StaticOrder>(lds, g, S, E);
        }
        else if constexpr (SP == 7) {
            const float* g1 = INP(I_LN1G) + l * 1024; const float* b1 = INP(I_LN1B) + l * 1024;
            const float* rgb = INP(I_RGB) + l * 4; const float* reb = INP(I_REB) + l * 32;
            f32x4 vn[4];
#pragma unroll
            for (int j = 0; j < 4; ++j) vn[j] = ((const f32x4*)(X + (size_t)gw * D))[lane + 64 * j];
#pragma unroll 1
            for (int m = gw; m < M; m += NGW) {
                f32x4 v[4]; float s = 0.f; f32x4* xr = (f32x4*)(X + (size_t)m * D) + lane;
#pragma unroll
                for (int j = 0; j < 4; ++j) { v[j] = vn[j]; s += (v[j][0] + v[j][1]) + (v[j][2] + v[j][3]); }
                { const int mnx = (m + NGW < M) ? m + NGW : m;
#pragma unroll
                  for (int j = 0; j < 4; ++j) vn[j] = ((const f32x4*)(X + (size_t)mnx * D))[lane + 64 * j]; }
                const float mean = wave_sum(s) * (1.f / D); float s2 = 0.f;
#pragma unroll
                for (int j = 0; j < 4; ++j) { v[j] = v[j] - mean; s2 += (v[j][0] * v[j][0] + v[j][1] * v[j][1]) + (v[j][2] * v[j][2] + v[j][3] * v[j][3]); }
                const float rstd = rsqrtf(wave_sum(s2) * (1.f / D) + LN_EPS);
#pragma unroll
                for (int j = 0; j < 4; ++j) { const f32x4 gg = ((const f32x4*)g1)[lane + 64 * j], bb = ((const f32x4*)b1)[lane + 64 * j]; v[j] = v[j] * rstd * gg + bb; xr[64 * j] = v[j];
                    u32x2 w; w.x = pk2(v[j][0], v[j][1]); w.y = pk2(v[j][2], v[j][3]); ((u32x2*)(XB + (size_t)m * D))[lane + 64 * j] = w; }
                float mylg = 0.f;
#pragma unroll 1
                for (int o4 = 0; o4 < 36; o4 += 4) { float a4[4];
#pragma unroll
                    for (int u = 0; u < 4; ++u) { float a = 0.f;
#pragma unroll
                        for (int j = 0; j < 4; ++j) { const f32x4 wv = ((const f32x4*)(WrT + (o4 + u) * 1024))[lane + 64 * j]; a += v[j][0] * wv[0] + v[j][1] * wv[1] + v[j][2] * wv[2] + v[j][3] * wv[3]; }
                        a4[u] = a; }
#pragma unroll
                    for (int sft = 1; sft < 64; sft <<= 1) {
#pragma unroll
                        for (int u = 0; u < 4; ++u) a4[u] += __shfl_xor(a4[u], sft); }
#pragma unroll
                    for (int u = 0; u < 4; ++u) mylg = (lane == o4 + u) ? a4[u] : mylg; }
                mylg += lane < 4 ? rgb[lane & 3] : (lane < 36 ? reb[(lane - 4) & 31] : 0.f);
                float gl[4]; float gm = -INFINITY; int gs = 0;
#pragma unroll
                for (int o = 0; o < 4; ++o) { gl[o] = __shfl(mylg, o); if (gl[o] > gm) { gm = gl[o]; gs = o; } }
                float gden = 0.f;
#pragma unroll
                for (int o = 0; o < 4; ++o) gden += __expf(gl[o] - gm);
                const float pg = 1.f / gden;
                float el[8];
#pragma unroll
                for (int o = 0; o < 8; ++o) el[o] = __shfl(mylg, 4 + gs * 8 + o);
                int e1 = 0; float m1 = el[0];
#pragma unroll
                for (int o = 1; o < 8; ++o) if (el[o] > m1) { m1 = el[o]; e1 = o; }
                int e2 = -1; float m2 = -INFINITY;
#pragma unroll
                for (int o = 0; o < 8; ++o) if (o != e1 && el[o] > m2) { m2 = el[o]; e2 = o; }
                const float r2 = __expf(m2 - m1); const float ga = pg / (1.f + r2), gb = pg * r2 / (1.f + r2);
                if (lane == 0) {
                    const int E1 = gs * 8 + e1, E2 = gs * 8 + e2;
                    tok_e[m * 2] = E1; tok_e[m * 2 + 1] = E2; tok_g[m * 2] = ga; tok_g[m * 2 + 1] = gb;
                    tok_rank[m * 2] = atomicAdd(&cnt[E1], 1); tok_rank[m * 2 + 1] = atomicAdd(&cnt[E2], 1);
                }
            }
        }
        else if constexpr (SP == 14) {
            LAS float* scr = (LAS float*)(lds + wave * 16384);
            const float* eg = INP(I_EG) + (size_t)l * NEXP * 1024 * 512; const float* eu = INP(I_EU) + (size_t)l * NEXP * 1024 * 512; const float* ed = INP(I_ED) + (size_t)l * NEXP * 512 * 1024;
            for (int it = gw; it < NEXP * 2 * 4 * 64; it += NGW) {
                const int e = it / 512, r = it % 512, half = r / 256, ct = (r % 256) / 64, q = r % 64, kb = q / 4, nb = q % 4;
                const float* W = (half ? eu : eg) + (size_t)e * 1024 * 512;
                transpose_item(W, 512, ct * 128, 128, WGU + (size_t)e * 1024 * 1024, 1024, ct * 256 + half * 128, 0, kb, nb, scr, lane);
            }
            for (int it = gw; it < NEXP * 8 * 32; it += NGW) {
                const int e = it / 256, q = it % 256, kb = q / 32, nb = q % 32;
                transpose_item(ed + (size_t)e * 512 * 1024, 1024, 0, 1024, WD + (size_t)e * 1024 * 512, 512, 0, 0, kb, nb, scr, lane);
            }
        }
        else if constexpr (SP == 8 || SP == 9 || SP == 10) {
            unsigned tbo = MISC_OFF; asm volatile("" : "+v"(tbo));
            volatile LAS int* tb = (volatile LAS int*)(lds + tbo);
            if (tid == 0) { int acc = 0; for (int e = 0; e < 32; ++e) { const int c = __hip_atomic_load(&cnt[e], __ATOMIC_RELAXED, __HIP_MEMORY_SCOPE_AGENT); tb[e] = acc; tb[33 + e] = acc; acc += (c + 255) >> 8; } tb[32] = acc; }
            __syncthreads();
            if constexpr (SP == 8) {
                for (int m = gw; m < M; m += NGW) {
#pragma unroll
                    for (int k = 0; k < 2; ++k) { const int e = tok_e[m * 2 + k]; const int slot = tb[33 + e] * 256 + tok_rank[m * 2 + k];
                        const u32x4* src = (const u32x4*)(XB + (size_t)m * D); u32x4* dst = (u32x4*)(XS + (size_t)slot * D);
                        dst[lane] = src[lane]; dst[lane + 64] = src[lane + 64];
                        if (lane == 0) tok_slot[m * 2 + k] = slot; }
                }
            } else if constexpr (SP == 9) {
                pg8::Gemm g{XS, WGU, 1024, 1024, 1024}; MoeOrder S{tb, G, bid, (size_t)1024 * 2, (size_t)1024 * 1024 * 2, (size_t)256 * 1024 * 2};
                EpiSwiglu E{HB};
                pg8::gemm_phase<EpiSwiglu, MoeOrder>(lds, g, S, E);
            } else {
                pg8::Gemm g{HB, WD, 512, 512, 512}; MoeOrder S{tb, G, bid, (size_t)512 * 2, (size_t)1024 * 512 * 2, (size_t)256 * 512 * 2};
                EpiStoreBf16 E{XS, 1024, 0, 1024};
                pg8::gemm_phase<EpiStoreBf16, MoeOrder>(lds, g, S, E);
            }
        }
        else if constexpr (SP == 11) {
            const float* g2 = INP(I_LN2G) + l * 1024; const float* b2 = INP(I_LN2B) + l * 1024;
            f32x4 xn[4]; u32x2 y1n[4], y2n[4]; float gan, gbn;
#define LN2_LOAD(mm) do { const int s1_ = tok_slot[(mm) * 2], s2_ = tok_slot[(mm) * 2 + 1]; gan = tok_g[(mm) * 2]; gbn = tok_g[(mm) * 2 + 1]; \
                _Pragma("unroll") for (int j = 0; j < 4; ++j) { xn[j] = ((const f32x4*)(X + (size_t)(mm) * D))[lane + 64 * j]; y1n[j] = ((const u32x2*)(XS + (size_t)s1_ * D))[lane + 64 * j]; y2n[j] = ((const u32x2*)(XS + (size_t)s2_ * D))[lane + 64 * j]; } } while (0)
            LN2_LOAD(gw);
#pragma unroll 1
            for (int m = gw; m < M; m += NGW) {
                const float ga = gan, gb = gbn;
                f32x4 v[4]; float s = 0.f; f32x4* xr = (f32x4*)(X + (size_t)m * D) + lane;
                u32x2 y1c[4], y2c[4];
#pragma unroll
                for (int j = 0; j < 4; ++j) { v[j] = xn[j] * ALPHA; y1c[j] = y1n[j]; y2c[j] = y2n[j]; }
                { const int mnx = (m + NGW < M) ? m + NGW : m; LN2_LOAD(mnx); }
#pragma unroll
                for (int j = 0; j < 4; ++j) { const u32x2 y1 = y1c[j], y2 = y2c[j];
                    v[j][0] += ga * __uint_as_float(y1.x << 16) + gb * __uint_as_float(y2.x << 16); v[j][1] += ga * __uint_as_float(y1.x & 0xffff0000u) + gb * __uint_as_float(y2.x & 0xffff0000u);
                    v[j][2] += ga * __uint_as_float(y1.y << 16) + gb * __uint_as_float(y2.y << 16); v[j][3] += ga * __uint_as_float(y1.y & 0xffff0000u) + gb * __uint_as_float(y2.y & 0xffff0000u);
                    s += (v[j][0] + v[j][1]) + (v[j][2] + v[j][3]); }
                const float mean = wave_sum(s) * (1.f / D); float s2 = 0.f;
#pragma unroll
                for (int j = 0; j < 4; ++j) { v[j] = v[j] - mean; s2 += (v[j][0] * v[j][0] + v[j][1] * v[j][1]) + (v[j][2] * v[j][2] + v[j][3] * v[j][3]); }
                const float rstd = rsqrtf(wave_sum(s2) * (1.f / D) + LN_EPS);
#pragma unroll
                for (int j = 0; j < 4; ++j) { const f32x4 gg = ((const f32x4*)g2)[lane + 64 * j], bb = ((const f32x4*)b2)[lane + 64 * j]; v[j] = v[j] * rstd * gg + bb; xr[64 * j] = v[j];
                    u32x2 w; w.x = pk2(v[j][0], v[j][1]); w.y = pk2(v[j][2], v[j][3]); ((u32x2*)(XB + (size_t)m * D))[lane + 64 * j] = w; }
            }
        }
    }
}

template <int SP>
__global__ void __launch_bounds__(NTHR, 2) k_phase(Args args, int l) {
    extern __shared__ __attribute__((aligned(16))) unsigned char lds_raw[];
    ptr_table_fill(args, (LAS unsigned char*)lds_raw);
    phase_body<SP>(l, (LAS unsigned char*)lds_raw);
}


#define XB_TMO      128
#define XB_XCNT(j)  (256  + 64 * (j))
#define XB_XSUB(j)  (1280 + 64 * (j))
#define XB_XGEN(j)  (2304 + 64 * (j))
#define XB_TOP      3328
#define XB_TOPGEN   3392
#define XCD_BAR_WORDS 3456
#define XB_SPIN_CAP (1u << 22)
__device__ __forceinline__ unsigned xb_ld(unsigned* p)              { return __hip_atomic_load(p, __ATOMIC_RELAXED, __HIP_MEMORY_SCOPE_AGENT); }
__device__ __forceinline__ unsigned xb_add(unsigned* p, unsigned v) { return __hip_atomic_fetch_add(p, v, __ATOMIC_RELAXED, __HIP_MEMORY_SCOPE_AGENT); }
__device__ __forceinline__ unsigned xb_xcc_id() { return (unsigned)__builtin_amdgcn_s_getreg((3 << 11) | 20) & 0xFu; }
#define XB_SPIN(cond, bar) do { unsigned _sp = 0; while (cond) { __builtin_amdgcn_s_sleep(1); \
    if ((++_sp & 255u) == 0u) { if (xb_ld(&(bar)[XB_TMO])) break; if (_sp > XB_SPIN_CAP) { atomicAdd(&(bar)[XB_TMO], 1u); break; } } } } while (0)
__device__ __forceinline__ void xcd_barrier_complete(unsigned* bar, unsigned x, unsigned& nloc, unsigned& nx) {
    const unsigned G = gridDim.x;
    unsigned sum, cnt, mine, sp = 0u;
    for (;;) {
        sum = 0u; cnt = 0u; mine = 0u;
#pragma unroll
        for (unsigned j = 0; j < 16; ++j) { const unsigned c = xb_ld(&bar[XB_XCNT(j)]); sum += c; cnt += (c > 0u) ? 1u : 0u; mine = (j == x) ? c : mine; }
        if (sum == G) break;
        __builtin_amdgcn_s_sleep(1);
        if ((++sp & 255u) == 0u) { if (xb_ld(&bar[XB_TMO])) break; if (sp > XB_SPIN_CAP) { atomicAdd(&bar[XB_TMO], 1u); break; } }
    }
    nloc = mine > 0u ? mine : 1u; nx = cnt > 0u ? cnt : 1u;
}
__device__ __forceinline__ void xcd_barrier(unsigned* bar, LAS unsigned char* lds) {
    asm volatile("s_waitcnt vmcnt(0)" ::: "memory");
    __syncthreads();
    int tid_ = threadIdx.x; asm volatile("" : "+v"(tid_));
    if (tid_ == 0) {
        unsigned so = (unsigned)(LDS_BYTES - 576); asm volatile("" : "+v"(so));
        volatile LAS unsigned* st = (volatile LAS unsigned*)(lds + so);
        __builtin_amdgcn_s_waitcnt(0);
        const unsigned x = xb_xcc_id();
        unsigned nloc = st[0], nx = st[1];
        if (nloc == 0u) { xcd_barrier_complete(bar, x, nloc, nx); st[0] = nloc; st[1] = nx; }
        const unsigned old = xb_add(&bar[XB_XSUB(x)], 1u);
        const unsigned gen = old / nloc;
        if (old + 1u == (gen + 1u) * nloc) {
            __builtin_amdgcn_fence(__ATOMIC_RELEASE, "agent");
            asm volatile("s_waitcnt vmcnt(0)" ::: "memory");
            const unsigned og = xb_add(&bar[XB_TOP], 1u);
            const unsigned tg = og / nx;
            if (og + 1u == (tg + 1u) * nx) xb_add(&bar[XB_TOPGEN], 1u);
            else XB_SPIN(xb_ld(&bar[XB_TOPGEN]) == tg, bar);
            __builtin_amdgcn_fence(__ATOMIC_ACQUIRE, "agent");
            xb_add(&bar[XB_XGEN(x)], 1u);
            asm volatile("s_waitcnt vmcnt(0)" ::: "memory");
        } else {
            XB_SPIN(xb_ld(&bar[XB_XGEN(x)]) == gen, bar);
            __builtin_amdgcn_fence(__ATOMIC_ACQUIRE, "agent");
            asm volatile("s_waitcnt vmcnt(0)" ::: "memory");
        }
    }
    __syncthreads();
}
namespace cg = cooperative_groups;
__global__ void __launch_bounds__(NTHR, 2) fwd_all(Args args) {
    extern __shared__ __attribute__((aligned(16))) unsigned char lds_raw[];
    LAS unsigned char* lds = (LAS unsigned char*)lds_raw;
    unsigned* bar = (unsigned*)(args.ws + WS_CTL) + CW_BAR;
    if (threadIdx.x == 0) { ((volatile LAS unsigned*)(lds + LDS_BYTES - 576))[0] = 0u; ((volatile LAS unsigned*)(lds + LDS_BYTES - 576))[1] = 0u; (void)xb_add(&bar[XB_XCNT(xb_xcc_id())], 1u); }
    ptr_table_fill(args, lds);
    const int probe = args.ph_lo;
    { constexpr int l = 0;
#pragma unroll 1
      for (int r_ = 0; r_ < ((probe == -1) ? 2 : 1); ++r_) { phase_body<-1>(l, lds); __syncthreads(); } }
    cg::this_grid().sync();
#define GRID_BAR() do { unsigned* bar_ = (unsigned*)gptr(ldptr(lds, 36)) + CW_BAR; xcd_barrier(bar_, lds); } while (0)
#define RUN(SP) do { _Pragma("unroll 1") for (int r_ = 0; r_ < ((probe == (SP)) ? 2 : 1); ++r_) { phase_body<SP>(l, lds); __syncthreads(); } } while (0)
#define ONCE(SP) do { phase_body<SP>(l, lds); __syncthreads(); } while (0)
#define LAYER() \
        RUN(0); GRID_BAR(); \
        ONCE(15); GRID_BAR(); \
        ONCE(4); GRID_BAR(); \
        RUN(13); GRID_BAR(); \
        RUN(5); GRID_BAR(); \
        ONCE(6); GRID_BAR(); \
        ONCE(7); RUN(14); GRID_BAR(); \
        RUN(8); GRID_BAR(); \
        RUN(9); GRID_BAR(); \
        RUN(10); GRID_BAR(); \
        ONCE(11); GRID_BAR();
    { constexpr int l = 0; LAYER() }
    { constexpr int l = 1; LAYER() }
#undef LAYER
#undef RUN
#undef ONCE
#undef GRID_BAR
}

template <int SP> static void launch_phase(const Args& a, int l, int grid, hipStream_t stream) {
    static bool attr = false;
    if (!attr) { (void)hipFuncSetAttribute((const void*)k_phase<SP>, hipFuncAttributeMaxDynamicSharedMemorySize, LDS_BYTES); attr = true; }
    hipLaunchKernelGGL(k_phase<SP>, dim3(grid), dim3(NTHR), LDS_BYTES, stream, a, l);
}

extern "C" void kernel_launch(void* const* d_in, const int* in_sizes, int n_in, void* d_out, int out_size, void* d_ws, size_t ws_size, hipStream_t stream) {
    static int grid = 0;
    if (grid == 0) {
        if (n_in != 35 || out_size != M * D || ws_size < WS_END) { fprintf(stderr, "kernel_launch: unexpected problem (n_in %d out %d ws %zu)\n", n_in, out_size, ws_size); grid = -1; return; }
        int dev = 0, cus = 0, per_cu = 0;
        (void)hipGetDevice(&dev); (void)hipDeviceGetAttribute(&cus, hipDeviceAttributeMultiprocessorCount, dev);
#if N_LAUNCH_MODE == 1
        (void)hipFuncSetAttribute((const void*)fwd_all, hipFuncAttributeMaxDynamicSharedMemorySize, LDS_BYTES);
        if (hipOccupancyMaxActiveBlocksPerMultiprocessor(&per_cu, (const void*)fwd_all, NTHR, LDS_BYTES) != hipSuccess || per_cu < 1) { fprintf(stderr, "kernel_launch: occupancy query says %d blocks/CU\n", per_cu); grid = -1; return; }
#endif
        (void)per_cu;
        grid = cus;
        if (grid != 256) { fprintf(stderr, "kernel_launch: built for 256 CUs, found %d\n", cus); grid = -1; return; }
    }
    if (grid < 0) return;
    (void)hipMemsetAsync((char*)d_ws + WS_CTL, 0, CTL_BYTES, stream);
    Args a{};
    for (int i = 0; i < 35; ++i) a.in[i] = (const float*)d_in[i];
    a.out = (float*)d_out; a.ws = (unsigned char*)d_ws;
#if N_LAUNCH_MODE == 1
    a.ph_lo = PROBE_REPS;
    void* kargs[] = {(void*)&a};
    hipError_t e = hipLaunchCooperativeKernel((const void*)fwd_all, dim3(grid), dim3(NTHR), kargs, LDS_BYTES, stream);
    if (e != hipSuccess) fprintf(stderr, "cooperative launch failed: %s\n", hipGetErrorString(e));
#else
    launch_phase<-1>(a, 0, grid, stream);
    for (int l = 0; l < NL; ++l) {
        launch_phase<0>(a, l, grid, stream); launch_phase<15>(a, l, grid, stream); launch_phase<4>(a, l, grid, stream); launch_phase<13>(a, l, grid, stream);
        launch_phase<5>(a, l, grid, stream); launch_phase<6>(a, l, grid, stream); launch_phase<7>(a, l, grid, stream); launch_phase<14>(a, l, grid, stream);
        launch_phase<8>(a, l, grid, stream); launch_phase<9>(a, l, grid, stream); launch_phase<10>(a, l, grid, stream); launch_phase<11>(a, l, grid, stream);
    }
#endif
}
```

```cpp
#include <hip/hip_runtime.h>
#include <cstdio>
#include <cstdint>
#include <hip/hip_cooperative_groups.h>

#ifndef PROBE_REPS
#define PROBE_REPS -100
#endif
#ifndef N_LAUNCH_MODE
#define N_LAUNCH_MODE 1
#endif

namespace pg8 {
#define PG8_LAS __attribute__((address_space(3)))
typedef unsigned short bf16_t;
typedef short bf16x8 __attribute__((ext_vector_type(8)));
typedef float f32x4 __attribute__((ext_vector_type(4)));
typedef unsigned u32x4 __attribute__((ext_vector_type(4)));
constexpr int BM = 256, BK = 64, HALF = 128, HTB = HALF * BK * 2, STAGE_BYTES = 8 * HTB, NXCD = 8, WGM = 8;

__host__ __device__ __forceinline__ int lds_byte(int r, int c) { const int st = (r >> 4) * 2 + (c >> 5), rr = r & 15, cc = c & 31, ob = rr * 64 + cc * 2; return st * 1024 + (ob ^ (((ob >> 9) & 1) << 5)); }
__host__ __device__ __forceinline__ void stage_rc(int b, int& R, int& C) { const int st = b / 1024, sb = b % 1024, swz = sb ^ (((sb >> 9) & 1) << 5); R = (st >> 1) * 16 + swz / 64; C = (st & 1) * 32 + (swz % 64) / 2; }
__host__ __device__ __forceinline__ int perm32(int rho) { const int n = rho >> 4, i = rho & 15; return 8 * (i >> 2) + 4 * n + (i & 3); }

struct Unit { int pm, pn, aux; size_t aoff, boff; };
struct Gemm { const bf16_t* A; const bf16_t* Bt; int lda, ldb, K; };

__device__ __forceinline__ void tile_of(int L, int nM, int nN, int& pm, int& pn) {
    const int nwg = nM * nN; int wgid = L;
    { const int q = nwg / NXCD, r = nwg % NXCD, xcd = wgid % NXCD, off = wgid / NXCD; wgid = (xcd < r ? xcd * (q + 1) : r * (q + 1) + (xcd - r) * q) + off; }
    const int nig = WGM * nN, gid = wgid / nig, fm = gid * WGM, gsz = (nM - fm) < WGM ? (nM - fm) : WGM;
    pm = fm + ((wgid % nig) % gsz); pn = (wgid % nig) / gsz;
}
struct StaticOrder {
    int nM, nN, nwg, G, c, lda, ldb;
    __device__ void init(int M, int N, int G_, int c_, int lda_, int ldb_) { nM = M / BM; nN = N / BM; nwg = nM * nN; G = G_; c = c_; lda = lda_; ldb = ldb_; }
    __device__ bool next(int i, Unit& u) const {
        const long L = (long)i * G + c; if (L >= nwg) return false;
        tile_of((int)L, nM, nN, u.pm, u.pn); u.aux = 0;
        u.aoff = (size_t)u.pm * BM * lda * 2; u.boff = (size_t)u.pn * BM * ldb * 2; return true;
    }
};

__device__ __forceinline__ unsigned cvt_pk_bf16(float lo, float hi) { unsigned r; asm volatile("s_nop 1\n\tv_cvt_pk_bf16_f32 %0, %1, %2" : "=v"(r) : "v"(lo), "v"(hi)); return r; }
__device__ __forceinline__ void epi_mfma_settle(const f32x4 (&acc)[2][2][4][2]) {
    asm volatile("s_nop 11" :: "v"(acc[1][0][0][0]), "v"(acc[1][0][0][1]), "v"(acc[1][0][1][0]), "v"(acc[1][0][1][1]), "v"(acc[1][0][2][0]), "v"(acc[1][0][2][1]), "v"(acc[1][0][3][0]), "v"(acc[1][0][3][1]),
                                "v"(acc[1][1][0][0]), "v"(acc[1][1][0][1]), "v"(acc[1][1][1][0]), "v"(acc[1][1][1][1]), "v"(acc[1][1][2][0]), "v"(acc[1][1][2][1]), "v"(acc[1][1][3][0]), "v"(acc[1][1][3][1]) : "memory"); }

template <class Epi, class Sched, bool ALIGN_EPI = true, bool SP2 = true>
__device__ __forceinline__ void gemm_phase(PG8_LAS unsigned char* lds, const Gemm g, const Sched& S, const Epi& E) {
    int tid_ = threadIdx.x; asm volatile("" : "+v"(tid_));
    const int tid = tid_, wid = __builtin_amdgcn_readfirstlane(tid >> 6), lane = tid & 63, wr = wid >> 2, wc = wid & 3, fr = lane & 15, fq = lane >> 4;
    const int K = g.K, nt = K / BK;
    unsigned voffA[2], voffB[2];
#pragma unroll
    for (int i = 0; i < 2; ++i) { int R, C; stage_rc(tid * 16 + i * 8192, R, C); const int Rb = Epi::PERM ? ((R & ~31) + perm32(R & 31)) : R;
        voffA[i] = (unsigned)(R * g.lda + C) * 2u; voffB[i] = (unsigned)(Rb * g.ldb + C) * 2u; }
    const size_t kstep = (size_t)(BK * 2);
    const size_t hstepA = (size_t)HALF * g.lda * 2, hstepB = (size_t)HALF * g.ldb * 2;
    const unsigned ldsw = (unsigned)wid * 1024u;
    const int aoff = lds_byte(wr * 64 + fr, fq * 8), boff = lds_byte(wc * 32 + fr, fq * 8);
#define PG8_SA(b, h) (((b) * 2 + (h)) * HTB)
#define PG8_SB(b, h) ((4 + (b) * 2 + (h)) * HTB)
#define PG8_STAGE(bufoff, gbase, voff) do { _Pragma("unroll") for (int _i = 0; _i < 2; ++_i) \
        __builtin_amdgcn_global_load_lds((const unsigned*)((const char*)(gbase) + (voff)[_i]), (PG8_LAS unsigned*)(lds + (bufoff) + ldsw + _i * 8192), 16, 0, 0); } while (0)
#define PG8_LDA(dst, b, h) do { _Pragma("unroll") for (int m = 0; m < 4; ++m) _Pragma("unroll") for (int k = 0; k < 2; ++k) dst[m][k] = *(const PG8_LAS bf16x8*)(lds + PG8_SA(b, h) + aoff + m * 2048 + k * 1024); } while (0)
#define PG8_LDB(dst, b, h) do { _Pragma("unroll") for (int n = 0; n < 2; ++n) _Pragma("unroll") for (int k = 0; k < 2; ++k) dst[n][k] = *(const PG8_LAS bf16x8*)(lds + PG8_SB(b, h) + boff + n * 2048 + k * 1024); } while (0)
#define PG8_MMA(ai, bj, At, Bt) do { __builtin_amdgcn_s_setprio(1); _Pragma("unroll") for (int m = 0; m < 4; ++m) _Pragma("unroll") for (int n = 0; n < 2; ++n) _Pragma("unroll") for (int k = 0; k < 2; ++k) \
        acc[ai][bj][m][n] = __builtin_amdgcn_mfma_f32_16x16x32_bf16(Bt[n][k], At[m][k], acc[ai][bj][m][n], 0, 0, 0); __builtin_amdgcn_s_setprio(0); } while (0)
#define PG8_WAIT_V(n) asm volatile("s_waitcnt vmcnt(" #n ")" ::: "memory")
#define PG8_WAIT_L(n) asm volatile("s_waitcnt lgkmcnt(" #n ")" ::: "memory")
#define PG8_BAR __builtin_amdgcn_s_barrier()
#define PG8_SCHED __builtin_amdgcn_sched_barrier(0)
    Unit cur, nxt; int ui = 0;
    if (!S.next(0, cur)) return;
    f32x4 acc[2][2][4][2];
#pragma unroll
    for (int a = 0; a < 2; ++a)
#pragma unroll
        for (int b = 0; b < 2; ++b)
#pragma unroll
            for (int m = 0; m < 4; ++m)
#pragma unroll
                for (int n = 0; n < 2; ++n) acc[a][b][m][n] = (f32x4){0.f, 0.f, 0.f, 0.f};
    bf16x8 At[4][2], B0[2][2], B1[2][2];
    const char* cA = (const char*)g.A + cur.aoff; const char* cB = (const char*)g.Bt + cur.boff;
    if constexpr (SP2) {
        PG8_STAGE(PG8_SB(0, 0), cB, voffB); PG8_STAGE(PG8_SB(0, 1), cB + hstepB, voffB); PG8_STAGE(PG8_SA(0, 0), cA, voffA); PG8_STAGE(PG8_SA(0, 1), cA + hstepA, voffA);
        if (wr == 1) PG8_BAR;
        PG8_WAIT_V(2); PG8_BAR;
        PG8_STAGE(PG8_SB(1, 0), cB + kstep, voffB); PG8_STAGE(PG8_SA(1, 0), cA + kstep, voffA); PG8_STAGE(PG8_SB(1, 1), cB + hstepB + kstep, voffB);
        PG8_WAIT_V(6); PG8_BAR;
    } else {
        PG8_STAGE(PG8_SB(0, 0), cB, voffB); PG8_STAGE(PG8_SA(0, 0), cA, voffA); PG8_STAGE(PG8_SB(0, 1), cB + hstepB, voffB); PG8_STAGE(PG8_SA(0, 1), cA + hstepA, voffA);
        if (wr == 1) PG8_BAR;
        PG8_WAIT_V(4); PG8_BAR;
        PG8_STAGE(PG8_SB(1, 0), cB + kstep, voffB); PG8_STAGE(PG8_SA(1, 0), cA + kstep, voffA); PG8_STAGE(PG8_SB(1, 1), cB + hstepB + kstep, voffB);
        PG8_WAIT_V(6); PG8_BAR;
    }
    for (;;) {
        const bool has_next = S.next(ui + 1, nxt);
        const char* nA = has_next ? (const char*)g.A + nxt.aoff : cA; const char* nB = has_next ? (const char*)g.Bt + nxt.boff : cB;
#pragma unroll 1
        for (int t = 0; t < nt; t += 2) {
            const bool last = (t == nt - 2);
            const char* a1 = cA + (size_t)(t + 1) * kstep;
            const char* a2 = last ? nA : cA + (size_t)(t + 2) * kstep; const char* b2 = last ? nB : cB + (size_t)(t + 2) * kstep;
            const char* a3 = a2 + kstep; const char* b3 = b2 + kstep;
            if constexpr (SP2) {
            PG8_LDB(B0, 0, 0); PG8_LDB(B1, 0, 1); PG8_SCHED; PG8_LDA(At, 0, 0); PG8_STAGE(PG8_SA(1, 1), a1 + hstepA, voffA);
            PG8_WAIT_V(8); PG8_WAIT_L(0); PG8_BAR; PG8_MMA(0, 0, At, B0); PG8_MMA(0, 1, At, B1); PG8_BAR; PG8_SCHED;
            PG8_LDA(At, 0, 1); PG8_STAGE(PG8_SB(0, 0), b2, voffB); PG8_STAGE(PG8_SB(0, 1), b2 + hstepB, voffB); PG8_STAGE(PG8_SA(0, 0), a2, voffA);
            PG8_WAIT_V(8); PG8_WAIT_L(0); PG8_BAR; PG8_MMA(1, 0, At, B0); PG8_MMA(1, 1, At, B1); PG8_BAR; PG8_SCHED;
            PG8_LDB(B0, 1, 0); PG8_LDB(B1, 1, 1); PG8_SCHED; PG8_LDA(At, 1, 0); PG8_STAGE(PG8_SA(0, 1), a2 + hstepA, voffA);
            PG8_WAIT_V(8); PG8_WAIT_L(0); PG8_BAR; PG8_MMA(0, 0, At, B0); PG8_MMA(0, 1, At, B1); PG8_BAR; PG8_SCHED;
            PG8_LDA(At, 1, 1); PG8_STAGE(PG8_SB(1, 0), b3, voffB); PG8_STAGE(PG8_SB(1, 1), b3 + hstepB, voffB); PG8_STAGE(PG8_SA(1, 0), a3, voffA);
            PG8_WAIT_V(8); PG8_WAIT_L(0); PG8_BAR; PG8_MMA(1, 0, At, B0); PG8_MMA(1, 1, At, B1); PG8_BAR; PG8_SCHED;
            } else {
            PG8_LDB(B0, 0, 0); PG8_SCHED; PG8_LDA(At, 0, 0); PG8_STAGE(PG8_SA(1, 1), a1 + hstepA, voffA);
            PG8_WAIT_L(8); PG8_BAR; PG8_WAIT_L(0); PG8_MMA(0, 0, At, B0); PG8_BAR; PG8_SCHED;
            PG8_LDB(B1, 0, 1); PG8_STAGE(PG8_SB(0, 0), b2, voffB);
            PG8_BAR; PG8_WAIT_L(0); PG8_MMA(0, 1, At, B1); PG8_BAR;
            PG8_LDA(At, 0, 1); PG8_STAGE(PG8_SA(0, 0), a2, voffA);
            PG8_BAR; PG8_WAIT_L(0); PG8_MMA(1, 0, At, B0); PG8_BAR; PG8_SCHED;
            PG8_STAGE(PG8_SB(0, 1), b2 + hstepB, voffB);
            PG8_WAIT_V(6); PG8_BAR; PG8_MMA(1, 1, At, B1); PG8_BAR;
            PG8_LDB(B0, 1, 0); PG8_SCHED; PG8_LDA(At, 1, 0); PG8_STAGE(PG8_SA(0, 1), a2 + hstepA, voffA);
            PG8_WAIT_L(8); PG8_BAR; PG8_WAIT_L(0); PG8_MMA(0, 0, At, B0); PG8_BAR; PG8_SCHED;
            PG8_LDB(B1, 1, 1); PG8_STAGE(PG8_SB(1, 0), b3, voffB);
            PG8_BAR; PG8_WAIT_L(0); PG8_MMA(0, 1, At, B1); PG8_BAR;
            PG8_LDA(At, 1, 1); PG8_STAGE(PG8_SA(1, 0), a3, voffA);
            PG8_BAR; PG8_WAIT_L(0); PG8_MMA(1, 0, At, B0); PG8_BAR; PG8_SCHED;
            PG8_STAGE(PG8_SB(1, 1), b3 + hstepB, voffB);
            PG8_WAIT_V(6); PG8_BAR; PG8_MMA(1, 1, At, B1); PG8_BAR;
            }
        }
        if constexpr (ALIGN_EPI) { if (wr == 0) PG8_BAR; }
        E(acc, cur, wr, wc, fr, fq);
        if (!has_next) break;
#pragma unroll
        for (int a = 0; a < 2; ++a)
#pragma unroll
            for (int b = 0; b < 2; ++b)
#pragma unroll
                for (int m = 0; m < 4; ++m)
#pragma unroll
                    for (int n = 0; n < 2; ++n) acc[a][b][m][n] = (f32x4){0.f, 0.f, 0.f, 0.f};
        cur = nxt; cA = nA; cB = nB; ++ui;
        if constexpr (ALIGN_EPI) { if (wr == 1) PG8_BAR; }
    }
    PG8_WAIT_V(0);
    if constexpr (!ALIGN_EPI) { if (wr == 0) PG8_BAR; }
    PG8_BAR;
#undef PG8_SA
#undef PG8_SB
#undef PG8_STAGE
#undef PG8_LDA
#undef PG8_LDB
#undef PG8_MMA
#undef PG8_WAIT_V
#undef PG8_WAIT_L
#undef PG8_BAR
#undef PG8_SCHED
}
}

#define LAS __attribute__((address_space(3)))
typedef unsigned short bf16;
typedef float f32x4 __attribute__((ext_vector_type(4)));
typedef unsigned u32x4 __attribute__((ext_vector_type(4)));
typedef unsigned u32x2 __attribute__((ext_vector_type(2)));

constexpr int NB = 8, T = 4096, D = 1024, M = NB * T, NL = 2;
constexpr int INW = 9160;
constexpr int PP = 5120;
constexpr int C_AQ = 0, C_AK = 768, C_AV = 1536, C_BQ = 2304, C_BK = 2560, C_BV = 2816, C_IQ = 3072, C_IK = 3328, C_C = 3392, C_DZ = 4288, C_DX = 4544, C_IW = 5056, C_DT = 5060, C_END = 5064;
constexpr int NEXP = 32, DEXP = 512;
constexpr int CAP = 73728;
constexpr float LN_EPS = 1e-5f;
constexpr float ALPHA = 1.4142135623730951f;

constexpr size_t MiB = 1u << 20;
constexpr size_t WS_CTL = 0, CTL_BYTES = 1 * MiB;
constexpr size_t WS_WINT = 2 * MiB;
constexpr size_t WS_WGT = 22 * MiB;
constexpr size_t WS_WBRT = 38 * MiB;
constexpr size_t WS_WOUTT = 42 * MiB;
constexpr size_t WS_WRT = 46 * MiB;
constexpr size_t WS_ROUTE = 47 * MiB;
constexpr size_t WS_XB = 48 * MiB;
constexpr size_t WS_O = 112 * MiB;
constexpr size_t WS_VF = 176 * MiB;
constexpr size_t WS_P = 192 * MiB;
constexpr size_t WS_GS = 192 * MiB;
constexpr size_t WS_MERGED = 448 * MiB;
constexpr size_t WS_XS = 192 * MiB;
constexpr size_t WS_H = 336 * MiB;
constexpr size_t WS_WGU = 408 * MiB;
constexpr size_t WS_WD = 472 * MiB;
constexpr size_t WS_RW = 512 * MiB;
constexpr size_t WS_RW2 = 544 * MiB;
constexpr size_t WS_BONG = 46 * MiB + 512 * 1024;
constexpr size_t WS_END = 592 * MiB;
constexpr int CW_CNT = 64, CW_Q = 256, CW_BAR = 4096;

constexpr int RING_BYTES = 131072, MISC_OFF = RING_BYTES, LDS_BYTES = 147456;
constexpr int NWAVES = 8, NTHR = 512;

__device__ __forceinline__ float bf2f(bf16 v) { return __uint_as_float(((unsigned)v) << 16); }
__device__ __forceinline__ unsigned pk2(float lo, float hi) { unsigned r; asm volatile("s_nop 1\n\tv_cvt_pk_bf16_f32 %0, %1, %2" : "=v"(r) : "v"(lo), "v"(hi)); return r; }
__device__ __forceinline__ unsigned f2bf(float f) { unsigned u = __float_as_uint(f); return (u + 0x7fffu + ((u >> 16) & 1u)) >> 16; }
#define DPP_ADD(v, ctrl) v += __builtin_bit_cast(float, __builtin_amdgcn_update_dpp(0, __builtin_bit_cast(int, v), ctrl, 0xF, 0xF, true))
#define DPP_MAX(v, ctrl) v = fmaxf(v, __builtin_bit_cast(float, __builtin_amdgcn_update_dpp(0, __builtin_bit_cast(int, v), ctrl, 0xF, 0xF, true)))
__device__ __forceinline__ float wave_sum(float v) {
    DPP_ADD(v, 0xB1); DPP_ADD(v, 0x4E); DPP_ADD(v, 0x141); DPP_ADD(v, 0x140);
    v += __shfl_xor(v, 16); v += __shfl_xor(v, 32);
    return v;
}
__device__ __forceinline__ float wave_max(float v) {
    DPP_MAX(v, 0xB1); DPP_MAX(v, 0x4E); DPP_MAX(v, 0x141); DPP_MAX(v, 0x140);
    v = fmaxf(v, __shfl_xor(v, 16)); v = fmaxf(v, __shfl_xor(v, 32));
    return v;
}
__device__ __forceinline__ float sigmoid_div_(float x) { return 1.f / (1.f + __expf(-x)); }
__device__ __forceinline__ float sigmoidf_(float x) { return __builtin_amdgcn_rcpf(1.f + __expf(-x)); }
__device__ __forceinline__ float softplusf_(float x) { return x > 20.f ? x : __logf(1.f + __expf(x)); }
__device__ __forceinline__ float tanhf_(float x) { const float e = __expf(-2.f * fabsf(x)); const float t = (1.f - e) * __builtin_amdgcn_rcpf(1.f + e); return x < 0.f ? -t : t; }
__device__ __forceinline__ float siluf_(float x) { return x * __builtin_amdgcn_rcpf(1.f + __expf(-x)); }

struct Args { const float* in[35]; float* out; unsigned char* ws; int ph_lo, ph_hi; };
enum { I_X = 0, I_WIN, I_CMU, I_CW0, I_CW2, I_CA0, I_CA2, I_CG2, I_CKK, I_CKA, I_CRK, I_CGNW, I_CGNB, I_CV0, I_CV1, I_CV2, I_DCW, I_DCB, I_DDTB, I_DALOG, I_DSKIP, I_DNW,
       I_WBR, I_WOUT, I_LN1G, I_LN1B, I_RG, I_RGB, I_RE, I_REB, I_EG, I_EU, I_ED, I_LN2G, I_LN2B };

__device__ __forceinline__ void transpose_item(const float* W, int ldn, int c0, int ncols, bf16* dst, int dld, int r0, int dk0, int kb, int nb, LAS float* scr, int lane) {
    const int k0 = 64 * kb, n0 = 32 * nb;
    const bool okn = (n0 + (lane & 31)) < ncols;
    float tv[32];
#pragma unroll
    for (int i = 0; i < 32; ++i) { const int kk = 2 * i + (lane >> 5); tv[i] = okn ? W[(size_t)(k0 + kk) * ldn + c0 + n0 + (lane & 31)] : 0.f; }
#pragma unroll
    for (int i = 0; i < 32; ++i) { const int kk = 2 * i + (lane >> 5); scr[kk * 33 + (lane & 31)] = tv[i]; }
    asm volatile("s_waitcnt lgkmcnt(0)" ::: "memory");
    const int c = lane & 7;
#pragma unroll
    for (int j = 0; j < 4; ++j) { const int n = (lane >> 3) + 8 * j; const LAS float* s = scr + (8 * c) * 33 + n;
        u32x4 o; o.x = pk2(s[0 * 33], s[1 * 33]); o.y = pk2(s[2 * 33], s[3 * 33]); o.z = pk2(s[4 * 33], s[5 * 33]); o.w = pk2(s[6 * 33], s[7 * 33]);
        if (n0 + n < ncols) *(u32x4*)(dst + (size_t)(r0 + n0 + n) * dld + dk0 + k0 + 8 * c) = o; }
    asm volatile("s_waitcnt lgkmcnt(0)" ::: "memory");
}

struct EpiStoreBf16 {
    static constexpr bool PERM = true;
    bf16* O; int ldc; int act; int ncols;
    __device__ __forceinline__ void operator()(const pg8::f32x4 (&acc)[2][2][4][2], const pg8::Unit& u, int wr, int wc, int fr, int fq) const {
        pg8::epi_mfma_settle(acc);
        const int row0 = u.pm * 256 + wr * 64 + fr; const int col0 = u.pn * 256 + wc * 32 + 8 * fq;
#pragma unroll
        for (int ai = 0; ai < 2; ++ai)
#pragma unroll
            for (int m = 0; m < 4; ++m) { bf16* rowp = O + (size_t)(row0 + ai * 128 + m * 16) * ldc + col0;
#pragma unroll
                for (int bj = 0; bj < 2; ++bj) { pg8::f32x4 v0 = acc[ai][bj][m][0], v1 = acc[ai][bj][m][1];
                    if (act == 1) {
#pragma unroll
                        for (int j = 0; j < 4; ++j) { v0[j] = sigmoidf_(v0[j]); v1[j] = sigmoidf_(v1[j]); } }
                    u32x4 w; w.x = pg8::cvt_pk_bf16(v0[0], v0[1]); w.y = pg8::cvt_pk_bf16(v0[2], v0[3]); w.z = pg8::cvt_pk_bf16(v1[0], v1[1]); w.w = pg8::cvt_pk_bf16(v1[2], v1[3]);
                    if (col0 + bj * 128 < ncols) *(u32x4*)(rowp + bj * 128) = w; } }
    }
};
struct EpiBranch {
    static constexpr bool PERM = true;
    const bf16* GS; bf16* MG;
    __device__ __forceinline__ void operator()(const pg8::f32x4 (&acc)[2][2][4][2], const pg8::Unit& u, int wr, int wc, int fr, int fq) const {
        pg8::epi_mfma_settle(acc);
        const int n = u.aux;
        const bf16* gbase = GS + (size_t)(u.pm * 256 + wr * 64 + fr) * 4096 + n * 1024 + u.pn * 256 + wc * 32 + 8 * fq;
        bf16* mbase = MG + (size_t)(u.pm * 256 + wr * 64 + fr) * 1024 + u.pn * 256 + wc * 32 + 8 * fq;
#pragma unroll
        for (int ai = 0; ai < 2; ++ai)
#pragma unroll
            for (int m = 0; m < 4; ++m) {
#pragma unroll
                for (int bj = 0; bj < 2; ++bj) {
                    const u32x4 gv = *(const u32x4*)(gbase + (size_t)(ai * 128 + m * 16) * 4096 + bj * 128);
                    bf16* mp = mbase + (size_t)(ai * 128 + m * 16) * 1024 + bj * 128;
                    u32x4 ov = (u32x4){0u, 0u, 0u, 0u}; if (n != 0) ov = *(const u32x4*)mp;
                    const pg8::f32x4 a0 = acc[ai][bj][m][0], a1 = acc[ai][bj][m][1];
                    u32x4 w;
                    w.x = pg8::cvt_pk_bf16(a0[0] * __uint_as_float(gv.x << 16) + __uint_as_float(ov.x << 16), a0[1] * __uint_as_float(gv.x & 0xffff0000u) + __uint_as_float(ov.x & 0xffff0000u));
                    w.y = pg8::cvt_pk_bf16(a0[2] * __uint_as_float(gv.y << 16) + __uint_as_float(ov.y << 16), a0[3] * __uint_as_float(gv.y & 0xffff0000u) + __uint_as_float(ov.y & 0xffff0000u));
                    w.z = pg8::cvt_pk_bf16(a1[0] * __uint_as_float(gv.z << 16) + __uint_as_float(ov.z << 16), a1[1] * __uint_as_float(gv.z & 0xffff0000u) + __uint_as_float(ov.z & 0xffff0000u));
                    w.w = pg8::cvt_pk_bf16(a1[2] * __uint_as_float(gv.w << 16) + __uint_as_float(ov.w << 16), a1[3] * __uint_as_float(gv.w & 0xffff0000u) + __uint_as_float(ov.w & 0xffff0000u));
                    *(u32x4*)mp = w; asm volatile("" ::: "memory"); } }
    }
};
struct EpiResid {
    static constexpr bool PERM = false;
    float* X;
    __device__ __forceinline__ void operator()(const pg8::f32x4 (&acc)[2][2][4][2], const pg8::Unit& u, int wr, int wc, int fr, int fq) const {
        pg8::epi_mfma_settle(acc);
        const int row0 = u.pm * 256 + wr * 64 + fr, col0 = u.pn * 256 + wc * 32 + 4 * fq;
#pragma unroll
        for (int ai = 0; ai < 2; ++ai)
#pragma unroll
            for (int m = 0; m < 4; ++m) { float* rowp = X + (size_t)(row0 + ai * 128 + m * 16) * D + col0;
#pragma unroll
                for (int bj = 0; bj < 2; ++bj)
#pragma unroll
                    for (int n = 0; n < 2; ++n) { pg8::f32x4* p = (pg8::f32x4*)(rowp + bj * 128 + n * 16); *p = *p * ALPHA + acc[ai][bj][m][n]; } }
    }
};
struct EpiSwiglu {
    static constexpr bool PERM = true;
    bf16* H;
    __device__ __forceinline__ void operator()(const pg8::f32x4 (&acc)[2][2][4][2], const pg8::Unit& u, int wr, int wc, int fr, int fq) const {
        pg8::epi_mfma_settle(acc);
        const int row0 = u.pm * 256 + wr * 64 + fr; const int col0 = u.pn * 128 + wc * 32 + 8 * fq;
#pragma unroll
        for (int ai = 0; ai < 2; ++ai)
#pragma unroll
            for (int m = 0; m < 4; ++m) { bf16* rowp = H + (size_t)(row0 + ai * 128 + m * 16) * DEXP + col0;
                float v[8];
#pragma unroll
                for (int j = 0; j < 4; ++j) { v[j] = siluf_(acc[ai][0][m][0][j]) * acc[ai][1][m][0][j]; v[4 + j] = siluf_(acc[ai][0][m][1][j]) * acc[ai][1][m][1][j]; }
                u32x4 w; w.x = pg8::cvt_pk_bf16(v[0], v[1]); w.y = pg8::cvt_pk_bf16(v[2], v[3]); w.z = pg8::cvt_pk_bf16(v[4], v[5]); w.w = pg8::cvt_pk_bf16(v[6], v[7]);
                *(u32x4*)rowp = w; }
    }
};

struct SkewOrder {
    int nM, nN, nwg, c, lda, ldb;
    __device__ bool next(int i, pg8::Unit& u) const {
        long L;
        if (i < 5) L = (long)i * 256 + c; else { if (c < 32) return false; L = 1280 + (long)(i - 5) * 224 + (c - 32); }
        if (L >= nwg) return false;
        pg8::tile_of((int)L, nM, nN, u.pm, u.pn); u.aux = 0;
        u.aoff = (size_t)u.pm * 256 * lda * 2; u.boff = (size_t)u.pn * 256 * ldb * 2; return true;
    }
};
struct BranchOrder {
    int nM, nN, G, c;
    __device__ bool next(int i, pg8::Unit& u) const {
        const int tl = (i >> 2) * G + c; if (tl >= nM * nN) return false;
        pg8::tile_of(tl, nM, nN, u.pm, u.pn); u.aux = i & 3;
        u.aoff = ((size_t)u.pm * 256 * 1024 + (size_t)u.aux * 256) * 2; u.boff = ((size_t)u.pn * 256 * 1024 + (size_t)u.aux * 256) * 2; return true;
    }
};
struct MoeOrder {
    const volatile LAS int* tb; int G, c; size_t a_rowbytes, b_expbytes, b_tilebytes;
    __device__ bool next(int i, pg8::Unit& u) const {
        const int L = i * G + c; const int total = __builtin_amdgcn_readfirstlane(tb[32]) * 4; if (L >= total) return false;
        int e = 0;
#pragma unroll 1
        for (int k = 0; k < 32; ++k) if (L >= tb[k + 1] * 4) e = k + 1;
        const int nte = tb[e + 1] - tb[e]; const int r = L - tb[e] * 4; const int ct = r / nte, rt = r % nte;
        u.pm = __builtin_amdgcn_readfirstlane(tb[33 + e] + rt); u.pn = __builtin_amdgcn_readfirstlane(ct); u.aux = __builtin_amdgcn_readfirstlane(e);
        u.aoff = (size_t)u.pm * 256 * a_rowbytes; u.boff = (size_t)u.aux * b_expbytes + (size_t)u.pn * b_tilebytes; return true;
    }
};

constexpr int PTR_OFF = LDS_BYTES - 512;
__device__ __forceinline__ void ptr_table_fill(const Args& args, LAS unsigned char* lds) {
    if (threadIdx.x == 0) {
        volatile LAS unsigned long long* t = (volatile LAS unsigned long long*)(lds + PTR_OFF);
#define PT_(i) t[i] = (unsigned long long)args.in[i];
        PT_(0) PT_(1) PT_(2) PT_(3) PT_(4) PT_(5) PT_(6) PT_(7) PT_(8) PT_(9) PT_(10) PT_(11) PT_(12) PT_(13) PT_(14) PT_(15) PT_(16) PT_(17) PT_(18) PT_(19)
        PT_(20) PT_(21) PT_(22) PT_(23) PT_(24) PT_(25) PT_(26) PT_(27) PT_(28) PT_(29) PT_(30) PT_(31) PT_(32) PT_(33) PT_(34)
#undef PT_
        t[35] = (unsigned long long)args.out; t[36] = (unsigned long long)args.ws; t[37] = (unsigned long long)(unsigned)args.ph_lo;
    }
    __syncthreads();
}
__device__ __forceinline__ unsigned long long ldptr(LAS unsigned char* lds, int i) {
    unsigned a = (unsigned)(PTR_OFF + 8 * i); asm volatile("" : "+v"(a));
    const volatile LAS unsigned* t = (const volatile LAS unsigned*)(lds + a);
    const unsigned lo = __builtin_amdgcn_readfirstlane(t[0]), hi = __builtin_amdgcn_readfirstlane(t[1]);
    return ((unsigned long long)hi << 32) | lo;
}
__device__ __forceinline__ void* gptr(unsigned long long v) { return (void*)(__attribute__((address_space(1))) void*)v; }
#define INP(i) ((const float*)gptr(ldptr(lds, (i))))
namespace rw {
typedef short bf16x8 __attribute__((ext_vector_type(8)));
typedef float f4 __attribute__((ext_vector_type(4)));
constexpr int LS = 72;
constexpr int MB = 64 * LS * 2;
constexpr int O_AHN = 0, O_RHN = MB, O_BCN = 2 * MB, O_KCN = 3 * MB, O_AHT = 4 * MB, O_BTT = 5 * MB, O_KTT = 6 * MB, O_VT = 7 * MB, O_STT = 8 * MB,
              O_MAK = 9 * MB, O_MRB = 10 * MB, O_MRK = 11 * MB, O_TINV = 12 * MB, O_MABF = 13 * MB, O_GAM = 13 * MB + 16384, O_CT = O_GAM + 256, O_BON = O_CT + 4608, O_END = O_BON + 256;
constexpr int O_MVT = O_BCN, O_A2N = O_AHN, O_UT = O_KCN, O_YF = O_AHT;
constexpr int O_TAB = O_MAK, O_SCR = O_TAB + 26624, O_TOT = O_SCR + 8 * 1024, O_CUM = O_TOT + 2048;
static_assert(O_CUM + 16384 <= O_GAM && O_END <= LDS_BYTES - 576, "rwkv LDS map");

__device__ __forceinline__ bf16x8 ldfrag(const LAS unsigned char* lds, int off, int r0, int ks, int lane) {
    return *(const LAS bf16x8*)(lds + off + ((r0 + (lane & 15)) * LS + ks * 32 + (lane >> 4) * 8) * 2);
}
__device__ __forceinline__ void mm64(f4 (&acc)[2], const LAS unsigned char* lds, int offA, int offBt, int w, int lane) {
    const int tr = w >> 1; const bf16x8 a0 = ldfrag(lds, offA, tr * 16, 0, lane), a1 = ldfrag(lds, offA, tr * 16, 1, lane);
#pragma unroll
    for (int c = 0; c < 2; ++c) { const int tc = (w & 1) * 2 + c; const bf16x8 b0 = ldfrag(lds, offBt, tc * 16, 0, lane), b1 = ldfrag(lds, offBt, tc * 16, 1, lane);
        acc[c] = __builtin_amdgcn_mfma_f32_16x16x32_bf16(a0, b0, acc[c], 0, 0, 0); acc[c] = __builtin_amdgcn_mfma_f32_16x16x32_bf16(a1, b1, acc[c], 0, 0, 0); }
}
__device__ __forceinline__ void storeT(LAS unsigned char* lds, int off, const f4 (&acc)[2], int w, int lane) {
    asm volatile("s_nop 11" :: "v"(acc[0]), "v"(acc[1]));
#pragma unroll
    for (int c = 0; c < 2; ++c) { const int col = ((w & 1) * 2 + c) * 16 + (lane & 15), row = (w >> 1) * 16 + 4 * (lane >> 4);
        u32x2 v; v.x = pk2(acc[c][0], acc[c][1]); v.y = pk2(acc[c][2], acc[c][3]); *(LAS u32x2*)(lds + off + (col * LS + row) * 2) = v; }
}
template <int MASK  >
__device__ __forceinline__ void storeN(LAS unsigned char* lds, int off, const f4 (&acc)[2], int w, int lane) {
    asm volatile("s_nop 11" :: "v"(acc[0]), "v"(acc[1]));
#pragma unroll
    for (int c = 0; c < 2; ++c) { const int col = ((w & 1) * 2 + c) * 16 + (lane & 15), row = (w >> 1) * 16 + 4 * (lane >> 4);
#pragma unroll
        for (int e = 0; e < 4; ++e) { float x = acc[c][e]; if (MASK == 1) x = (col < row + e) ? x : 0.f; if (MASK == 2) x = (col <= row + e) ? x : 0.f;
            *(LAS bf16*)(lds + off + ((row + e) * LS + col) * 2) = (bf16)f2bf(x); } }
}
typedef __bf16 bf2v __attribute__((ext_vector_type(2)));
__device__ __forceinline__ float dot2(unsigned x, unsigned y, float c) { return __builtin_amdgcn_fdot2_f32_bf16(__builtin_bit_cast(bf2v, x), __builtin_bit_cast(bf2v, y), c, false); }
#define RW_ZERO(a) do { a[0] = (f4){0.f, 0.f, 0.f, 0.f}; a[1] = (f4){0.f, 0.f, 0.f, 0.f}; } while (0)

__device__ __forceinline__ void build_ct(LAS unsigned char* lds0, const int l, const int h, const int lane, const int wave) {
    LAS unsigned char* const& lds = lds0; const int c = h * 64 + lane;
    const float* mu = INP(I_CMU) + (size_t)l * 896;
    if (wave == 0) { LAS float* ct = (LAS float*)(lds0 + O_CT);
        ct[0 * 64 + lane] = mu[c]; ct[1 * 64 + lane] = mu[256 + c]; ct[2 * 64 + lane] = mu[512 + c]; ct[3 * 64 + lane] = mu[768 + lane]; ct[4 * 64 + lane] = mu[832 + lane];
        ct[5 * 64 + lane] = INP(I_CW0)[l * 256 + c]; ct[6 * 64 + lane] = INP(I_CA0)[l * 256 + c]; ct[7 * 64 + lane] = INP(I_CKK)[l * 256 + c]; ct[8 * 64 + lane] = INP(I_CKA)[l * 256 + c];
        ct[9 * 64 + lane] = INP(I_CRK)[l * 256 + c]; ct[10 * 64 + lane] = INP(I_CGNW)[l * 256 + c]; ct[11 * 64 + lane] = INP(I_CGNB)[l * 256 + c]; ct[12 * 64 + lane] = l > 0 ? INP(I_CV0)[(l - 1) * 256 + c] : 0.f;
        ct[13 * 64 + lane] = mu[512 + lane]; ct[14 * 64 + lane] = mu[512 + lane + 64]; ct[15 * 64 + lane] = mu[512 + lane + 128]; ct[16 * 64 + lane] = mu[512 + lane + 192]; }
}
template <int MODE>
__device__ __forceinline__ void chunk(LAS unsigned char* lds0, const int l, const int b, const int h, const int t0, unsigned char* gz, unsigned char* gz2, float* bong, const bf16* P, bf16* VF, bf16* OB, const int tid0) {
    const int c = h * 64 + (tid0 & 63);
    {
        unsigned lb_ = 0u; int tid_l = tid0; asm volatile("" : "+v"(lb_), "+v"(tid_l));
        const int tid = tid_l, lane = tid & 63, wave = __builtin_amdgcn_readfirstlane(tid >> 6);
        LAS unsigned char* lds = lds0 + lb_;
        LAS bf16* TAB = (LAS bf16*)(lds + O_TAB); const LAS unsigned* TABW = (const LAS unsigned*)(lds + O_TAB);
        LAS bf16* scr = (LAS bf16*)(lds + O_SCR + wave * 1024);
        LAS float* CUM = (LAS float*)(lds + O_CUM);
        LAS float* TOT = (LAS float*)(lds + O_TOT);
        LAS float* GAM = (LAS float*)(lds + O_GAM);
        LAS float* MABF = (LAS float*)(lds + O_MABF);
        LAS float* YF = (LAS float*)(lds + O_YF);
        LAS float* BON = (LAS float*)(lds + O_BON);
        const LAS float* CT = (const LAS float*)(lds + O_CT);
#define CTV(k) CT[(k) * 64 + lane]
        { const float* cw2 = INP(I_CW2) + (size_t)l * 32 * 256; const float* ca2 = INP(I_CA2) + (size_t)l * 32 * 256; const float* cg2 = INP(I_CG2) + (size_t)l * 64 * 256;
          float tw[4], ta[4], tg[8];
#pragma unroll
          for (int u = 0; u < 4; ++u) { const int i = tid + u * NTHR; tw[u] = cw2[(i >> 6) * 256 + h * 64 + (i & 63)]; ta[u] = ca2[(i >> 6) * 256 + h * 64 + (i & 63)]; }
#pragma unroll
          for (int u = 0; u < 8; ++u) { const int i = tid + u * NTHR; tg[u] = cg2[(i >> 6) * 256 + h * 64 + (i & 63)]; }
          float t2[2], t1[8];
          if (l > 0) { const float* cv1 = INP(I_CV1) + (size_t)(l - 1) * 256 * 16; const float* cv2 = INP(I_CV2) + (size_t)(l - 1) * 16 * 256;
#pragma unroll
            for (int u = 0; u < 2; ++u) { const int i = tid + u * NTHR; t2[u] = cv2[(i >> 6) * 256 + h * 64 + (i & 63)]; }
#pragma unroll
            for (int u = 0; u < 8; ++u) t1[u] = cv1[tid + u * NTHR]; }
#define PIX(i) ((((i) >> 7) * 64 + ((i) & 63)) * 2 + (((i) >> 6) & 1))
#pragma unroll
          for (int u = 0; u < 4; ++u) { const int i = tid + u * NTHR; TAB[PIX(i)] = (bf16)f2bf(tw[u]); TAB[2048 + PIX(i)] = (bf16)f2bf(ta[u]); }
#pragma unroll
          for (int u = 0; u < 8; ++u) { const int i = tid + u * NTHR; TAB[4096 + PIX(i)] = (bf16)f2bf(tg[u]); }
          if (l > 0) {
#pragma unroll
            for (int u = 0; u < 2; ++u) { const int i = tid + u * NTHR; TAB[8192 + PIX(i)] = (bf16)f2bf(t2[u]); }
#pragma unroll
            for (int u = 0; u < 8; ++u) { const int i = tid + u * NTHR; const int cc = i >> 4, qq = i & 15; TAB[9216 + ((cc >> 1) * 16 + qq) * 2 + (cc & 1)] = (bf16)f2bf(t1[u]); } } }
#undef PIX
        float Xr[9];
#pragma unroll
        for (int j = 0; j < 9; ++j) { const int t = t0 + wave * 8 - 1 + j; Xr[j] = t >= 0 ? bf2f(P[((size_t)b * T + t) * PP + C_C + 768 + lane]) : 0.f; }
        __syncthreads();
        { float run = 0.f;
#pragma unroll
            for (int q = 0; q < 8; ++q) {
                const float xx = Xr[q + 1] + (Xr[q] - Xr[q + 1]) * CTV(3);
                scr[lane] = (bf16)f2bf(tanhf_(xx));
                asm volatile("s_waitcnt lgkmcnt(0)" ::: "memory");
                float wsum = CTV(5); { float w1 = 0.f; const LAS unsigned* sw = (const LAS unsigned*)scr;
#pragma unroll
                for (int p = 0; p < 16; p += 2) { wsum = dot2(sw[p], TABW[p * 64 + lane], wsum); w1 = dot2(sw[p + 1], TABW[(p + 1) * 64 + lane], w1); }
                wsum += w1; }
                run += -__expf(-softplusf_(-wsum) - 0.5f); CUM[(wave * 8 + q) * 64 + lane] = run;
                asm volatile("s_waitcnt lgkmcnt(0)" ::: "memory");
            }
            TOT[wave * 64 + lane] = run; }
        __syncthreads();
        float offs = 0.f, cumL = 0.f;
#pragma unroll
        for (int w2 = 0; w2 < 8; ++w2) { const float tw = TOT[w2 * 64 + lane]; offs += (w2 < wave) ? tw : 0.f; cumL += tw; }
        if (wave == 0) GAM[lane] = __expf(cumL);
#define LO_(x) __uint_as_float((x) << 16)
#define HI_(x) __uint_as_float((x) & 0xffff0000u)
#define RAW_LOAD(rk, vx, gg, v4a, v4b, vfv, tok) do { const int t_ = (tok); const bool ok_ = t_ >= 0; const size_t m_ = (size_t)b * T + (ok_ ? t_ : 0); const bf16* row_ = P + m_ * PP + C_C; \
            rk = ok_ ? ((unsigned)row_[c] | ((unsigned)row_[256 + c] << 16)) : 0u; vx = ok_ ? ((unsigned)row_[512 + c] | ((unsigned)row_[768 + lane] << 16)) : 0u; gg = ok_ ? (unsigned)row_[832 + lane] : 0u; \
            if (l > 0) { v4a = ok_ ? ((unsigned)row_[512 + lane] | ((unsigned)row_[512 + lane + 64] << 16)) : 0u; v4b = ok_ ? ((unsigned)row_[512 + lane + 128] | ((unsigned)row_[512 + lane + 192] << 16)) : 0u; vfv = (unsigned)VF[m_ * 256 + c]; } } while (0)
        unsigned pRK, pVX, pGG, pVa = 0u, pVb = 0u, pVF = 0u, cRK, cVX, cGG, cVa = 0u, cVb = 0u, cVF = 0u;
        RAW_LOAD(pRK, pVX, pGG, pVa, pVb, pVF, t0 + wave * 8 - 1); RAW_LOAD(cRK, cVX, cGG, cVa, cVb, cVF, t0 + wave * 8);
#pragma unroll 1
        for (int q = 0; q < 8; ++q) {
            const int tt = wave * 8 + q; const size_t m = (size_t)b * T + t0 + tt;
            unsigned nRK, nVX, nGG, nVa = 0u, nVb = 0u, nVF = 0u;
            RAW_LOAD(nRK, nVX, nGG, nVa, nVb, nVF, (q < 7) ? (t0 + tt + 1) : (t0 + tt));
            const float r = LO_(cRK) + (LO_(pRK) - LO_(cRK)) * CTV(0), k = HI_(cRK) + (HI_(pRK) - HI_(cRK)) * CTV(1); float v = LO_(cVX) + (LO_(pVX) - LO_(cVX)) * CTV(2);
            const float xx = HI_(cVX) + (HI_(pVX) - HI_(cVX)) * CTV(3), xg = LO_(cGG) + (LO_(pGG) - LO_(cGG)) * CTV(4);
            scr[lane] = (bf16)f2bf(lane < 32 ? tanhf_(xx) : xx); scr[64 + lane] = (bf16)f2bf(sigmoidf_(xg));
            LAS bf16* vsc = scr + 128;
            if (l > 0) {
                vsc[lane] = (bf16)f2bf(LO_(cVa) + (LO_(pVa) - LO_(cVa)) * CTV(13)); vsc[lane + 64] = (bf16)f2bf(HI_(cVa) + (HI_(pVa) - HI_(cVa)) * CTV(14));
                vsc[lane + 128] = (bf16)f2bf(LO_(cVb) + (LO_(pVb) - LO_(cVb)) * CTV(15)); vsc[lane + 192] = (bf16)f2bf(HI_(cVb) + (HI_(pVb) - HI_(cVb)) * CTV(16));
            }
            asm volatile("s_waitcnt lgkmcnt(0)" ::: "memory");
            float wsum = CTV(5), asum = CTV(6), gsum = 0.f; { float w1 = 0.f, a1 = 0.f, g1 = 0.f; const LAS unsigned* sw = (const LAS unsigned*)scr;
#pragma unroll
            for (int p = 0; p < 16; p += 2) { wsum = dot2(sw[p], TABW[p * 64 + lane], wsum); w1 = dot2(sw[p + 1], TABW[(p + 1) * 64 + lane], w1);
                asum = dot2(sw[16 + p], TABW[1024 + p * 64 + lane], asum); a1 = dot2(sw[17 + p], TABW[1024 + (p + 1) * 64 + lane], a1); }
#pragma unroll
            for (int p = 0; p < 32; p += 2) { gsum = dot2(sw[32 + p], TABW[2048 + p * 64 + lane], gsum); g1 = dot2(sw[33 + p], TABW[2048 + (p + 1) * 64 + lane], g1); }
            wsum += w1; asum += a1; gsum += g1; }
            if (l > 0) {
                const int qq = lane & 15, part = lane >> 4; float s = 0.f; { float s1 = 0.f; const LAS unsigned* sv = (const LAS unsigned*)vsc;
#pragma unroll
                for (int p = 0; p < 32; p += 2) { s = dot2(sv[part * 32 + p], TABW[4608 + (part * 32 + p) * 16 + qq], s); s1 = dot2(sv[part * 32 + p + 1], TABW[4608 + (part * 32 + p + 1) * 16 + qq], s1); }
                s += s1; }
                s += __shfl_xor(s, 16); s += __shfl_xor(s, 32);
                float vl = CTV(12);
#pragma unroll
                for (int q2 = 0; q2 < 16; ++q2) vl += __shfl(s, q2) * bf2f(TAB[8192 + ((q2 >> 1) * 64 + lane) * 2 + (q2 & 1)]);
                const float vf = LO_(cVF); v = v + (vf - v) * sigmoidf_(vl);
            }
            VF[m * 256 + c] = (bf16)f2bf(v);
            const float wlog = -softplusf_(-wsum) - 0.5f, asig = sigmoidf_(asum), lw = -__expf(wlog);
            float kk = k * CTV(7); const float n2 = wave_sum(kk * kk); kk = kk * __builtin_amdgcn_rsqf(fmaxf(n2, 1e-24f));
            const float kmod = k * (1.f + (asig - 1.f) * CTV(8));
            const float bon = wave_sum(r * kmod * CTV(9));
            const float cum = offs + CUM[tt * 64 + lane], cumx = cum - lw;
            const float ah = -kk * __expf(cumx), rh = r * __expf(cum), ei = __expf(-cum), bb = kk * asig, bc = bb * ei, kc = kmod * ei, ee = __expf(cumL - cum), bt = bb * ee, kt = kmod * ee;
            const int no = (tt * LS + lane) * 2, to = (lane * LS + tt) * 2;
            *(LAS bf16*)(lds + O_AHN + no) = (bf16)f2bf(ah); *(LAS bf16*)(lds + O_RHN + no) = (bf16)f2bf(rh);
            *(LAS bf16*)(lds + O_BCN + no) = (bf16)f2bf(bc); *(LAS bf16*)(lds + O_KCN + no) = (bf16)f2bf(kc); ((bf16*)(gz2 + 16384))[tt * 64 + lane] = (bf16)f2bf(gsum);
            *(LAS bf16*)(lds + O_AHT + to) = (bf16)f2bf(ah); *(LAS bf16*)(lds + O_BTT + to) = (bf16)f2bf(bt);
            *(LAS bf16*)(lds + O_KTT + to) = (bf16)f2bf(kt); *(LAS bf16*)(lds + O_VT + to) = (bf16)f2bf(v);
            if (lane == 0) bong[tt] = bon;
            asm volatile("s_waitcnt lgkmcnt(0)" ::: "memory");
            pRK = cRK; pVX = cVX; pGG = cGG; pVa = cVa; pVb = cVb; cRK = nRK; cVX = nVX; cGG = nGG; cVa = nVa; cVb = nVb; cVF = nVF;
        }
#undef RAW_LOAD
        __syncthreads();
        { f4 acc[2];
            RW_ZERO(acc); mm64(acc, lds, O_AHN, O_BCN, wave, lane);
#pragma unroll
            for (int cI = 0; cI < 2; ++cI) { const int col = ((wave & 1) * 2 + cI) * 16 + (lane & 15), row = (wave >> 1) * 16 + 4 * (lane >> 4);
#pragma unroll
                for (int e = 0; e < 4; ++e) MABF[(row + e) * 64 + col] = (col < row + e) ? acc[cI][e] : 0.f; }
            RW_ZERO(acc); mm64(acc, lds, O_AHN, O_KCN, wave, lane); storeN<1>(lds, O_MAK, acc, wave, lane);
            { f4 accb[2]; RW_ZERO(accb); mm64(accb, lds, O_RHN, O_BCN, wave, lane); f4 accc[2]; RW_ZERO(accc); mm64(accc, lds, O_RHN, O_KCN, wave, lane);
                storeN<2>(lds, O_MRB, accb, wave, lane); storeN<2>(lds, O_MRK, accc, wave, lane); }
        }
        __syncthreads();
        {
            const int cS = wave * 8 + (lane >> 3), tS = lane & 7;
            float xs[8];
#pragma unroll
            for (int k = 0; k < 8; ++k) xs[k] = 0.f;
#pragma unroll
            for (int i = 1; i < 64; ++i) {
                float part = 0.f;
#pragma unroll
                for (int k = 0; k < (i + 7) / 8; ++k) { const float mv = MABF[i * 64 + tS + 8 * k]; part += ((tS + 8 * k) < i ? mv : 0.f) * xs[k]; }
                part += __builtin_bit_cast(float, __builtin_amdgcn_update_dpp(0, __builtin_bit_cast(int, part), 0xB1, 0xF, 0xF, true));
                part += __builtin_bit_cast(float, __builtin_amdgcn_update_dpp(0, __builtin_bit_cast(int, part), 0x4E, 0xF, 0xF, true));
                part += __builtin_bit_cast(float, __builtin_amdgcn_update_dpp(0, __builtin_bit_cast(int, part), 0x141, 0xF, 0xF, true));
                const float xi = MABF[i * 64 + cS] + part;
                xs[i >> 3] = (tS == (i & 7)) ? xi : xs[i >> 3];
            }
#pragma unroll
            for (int k = 0; k < 8; ++k) { const int i = tS + 8 * k; *(LAS bf16*)(lds + O_TINV + (i * LS + cS) * 2) = (bf16)f2bf(i == cS ? 1.f : xs[k]); }
        }
        __syncthreads();
        { f4 acc[2]; RW_ZERO(acc); mm64(acc, lds, O_MAK, O_VT, wave, lane); storeT(lds, O_MVT, acc, wave, lane); }
        __syncthreads();
        if (MODE == 1) {
            { f4 acc[2]; RW_ZERO(acc); mm64(acc, lds, O_TINV, O_AHT, wave, lane); storeT(lds, O_UT, acc, wave, lane); }
            { f4 acc[2]; RW_ZERO(acc); mm64(acc, lds, O_TINV, O_MVT, wave, lane); storeT(lds, O_MAK, acc, wave, lane); }
            __syncthreads();
            f4 agm[2], azm[2], ar2[2], ay0[2];
            RW_ZERO(agm); mm64(agm, lds, O_BTT, O_UT, wave, lane);
#pragma unroll
            for (int cI = 0; cI < 2; ++cI) { const int col = ((wave & 1) * 2 + cI) * 16 + (lane & 15), row = (wave >> 1) * 16 + 4 * (lane >> 4);
#pragma unroll
                for (int e = 0; e < 4; ++e) if (col == row + e) agm[cI][e] += GAM[col]; }
            RW_ZERO(azm); mm64(azm, lds, O_BTT, O_MAK, wave, lane); mm64(azm, lds, O_KTT, O_VT, wave, lane);
            RW_ZERO(ar2); mm64(ar2, lds, O_MRB, O_UT, wave, lane);
#pragma unroll
            for (int cI = 0; cI < 2; ++cI) { const int col = ((wave & 1) * 2 + cI) * 16 + (lane & 15), row = (wave >> 1) * 16 + 4 * (lane >> 4);
#pragma unroll
                for (int e = 0; e < 4; ++e) ar2[cI][e] += bf2f(*(const LAS bf16*)(lds + O_RHN + ((row + e) * LS + col) * 2)); }
            RW_ZERO(ay0); mm64(ay0, lds, O_MRB, O_MAK, wave, lane); mm64(ay0, lds, O_MRK, O_VT, wave, lane);
            __syncthreads();
            storeN<0>(lds, O_AHN, agm, wave, lane); storeT(lds, O_RHN, azm, wave, lane); storeN<0>(lds, O_BCN, ar2, wave, lane); storeT(lds, O_KCN, ay0, wave, lane);
            __syncthreads();
            { const int io = ((tid >> 3) * LS + (tid & 7) * 8) * 2;
              ((u32x4*)gz)[tid] = *(const LAS u32x4*)(lds + O_AHN + io); ((u32x4*)(gz + 8192))[tid] = *(const LAS u32x4*)(lds + O_RHN + io);
              ((u32x4*)gz2)[tid] = *(const LAS u32x4*)(lds + O_BCN + io); ((u32x4*)(gz2 + 8192))[tid] = *(const LAS u32x4*)(lds + O_KCN + io); }
        } else {
            { f4 acc[2]; RW_ZERO(acc); mm64(acc, lds, O_TINV, O_AHT, wave, lane); storeN<0>(lds, O_A2N, acc, wave, lane); }
            __syncthreads();
            { f4 acc[2]; RW_ZERO(acc); mm64(acc, lds, O_TINV, O_MVT, wave, lane); mm64(acc, lds, O_A2N, O_STT, wave, lane); storeT(lds, O_UT, acc, wave, lane); }
            __syncthreads();
            f4 yacc[2]; RW_ZERO(yacc);
            mm64(yacc, lds, O_RHN, O_STT, wave, lane); mm64(yacc, lds, O_MRB, O_UT, wave, lane); mm64(yacc, lds, O_MRK, O_VT, wave, lane);
            __syncthreads();
#pragma unroll
            for (int cI = 0; cI < 2; ++cI) { const int col = ((wave & 1) * 2 + cI) * 16 + (lane & 15), row = (wave >> 1) * 16 + 4 * (lane >> 4);
#pragma unroll
                for (int e = 0; e < 4; ++e) YF[(row + e) * 64 + col] = yacc[cI][e]; }
            __syncthreads();
            { unsigned gcur = (unsigned)OB[((size_t)b * T + t0 + wave * 8) * 1024 + 512 + c];
#pragma unroll 1
            for (int q = 0; q < 8; ++q) {
                const int tt = wave * 8 + q; const size_t m = (size_t)b * T + t0 + tt;
                const unsigned gnxt = (unsigned)OB[(m + (q < 7 ? 1 : 0)) * 1024 + 512 + c];
                const float y = YF[tt * 64 + lane]; const float mean = wave_sum(y) * (1.f / 64.f); const float dy = y - mean; const float var = wave_sum(dy * dy) * (1.f / 64.f);
                const float yn = dy * rsqrtf(var + 64e-5f) * CTV(10) + CTV(11);
                const float vv = bf2f(*(const LAS bf16*)(lds + O_VT + (lane * LS + tt) * 2)), gg = LO_(gcur);
                OB[m * 1024 + 512 + c] = (bf16)f2bf((yn + BON[tt] * vv) * gg);
                gcur = gnxt;
            } }
        }
        __syncthreads();
#undef CTV
#undef LO_
#undef HI_
    }
}

__device__ __forceinline__ void chunk_out(LAS unsigned char* lds0, const int b, const int h, const int t0, const unsigned char* gz, const unsigned char* gz2, const float* bong, const bf16* VF, bf16* OB, const int tid0) {
    unsigned lb_ = 0u; int tid_l = tid0; asm volatile("" : "+v"(lb_), "+v"(tid_l));
    LAS unsigned char* lds = lds0 + lb_; const int tid = tid_l, lane = tid & 63, wave = __builtin_amdgcn_readfirstlane(tid >> 6);
    const int c = h * 64 + lane;
    const LAS float* CT = (const LAS float*)(lds + O_CT);
    LAS float* YF = (LAS float*)(lds + O_YF);
    const int io = ((tid >> 3) * LS + (tid & 7) * 8) * 2;
    const u32x4 sv = ((const u32x4*)gz)[tid], rv = ((const u32x4*)gz2)[tid];
    u32x2 yv[2];
#pragma unroll
    for (int k = 0; k < 2; ++k) { const int col = ((wave & 1) * 2 + k) * 16 + (lane & 15), row = (wave >> 1) * 16 + 4 * (lane >> 4); yv[k] = *(const u32x2*)(gz2 + 8192 + (col * 64 + row) * 2); }
    float gq[8], vq[8], bq[8];
#pragma unroll
    for (int q = 0; q < 8; ++q) { const int tt = wave * 8 + q; const size_t m = (size_t)b * T + t0 + tt;
        gq[q] = bf2f(((const bf16*)(gz2 + 16384))[tt * 64 + lane]); vq[q] = bf2f(VF[m * 256 + c]); bq[q] = bong[tt]; }
    *(LAS u32x4*)(lds + O_STT + io) = sv; *(LAS u32x4*)(lds + O_AHN + io) = rv;
    __syncthreads();
    f4 acc[2];
#pragma unroll
    for (int k = 0; k < 2; ++k) acc[k] = (f4){__uint_as_float(yv[k].x << 16), __uint_as_float(yv[k].x & 0xffff0000u), __uint_as_float(yv[k].y << 16), __uint_as_float(yv[k].y & 0xffff0000u)};
    mm64(acc, lds, O_AHN, O_STT, wave, lane);
#pragma unroll
    for (int cI = 0; cI < 2; ++cI) { const int col = ((wave & 1) * 2 + cI) * 16 + (lane & 15), row = (wave >> 1) * 16 + 4 * (lane >> 4);
#pragma unroll
        for (int e = 0; e < 4; ++e) YF[(row + e) * 64 + col] = acc[cI][e]; }
    __syncthreads();
#pragma unroll
    for (int q = 0; q < 8; ++q) { const int tt = wave * 8 + q; const size_t m = (size_t)b * T + t0 + tt;
        const float y = YF[tt * 64 + lane]; const float mean = wave_sum(y) * (1.f / 64.f); const float dy = y - mean; const float var = wave_sum(dy * dy) * (1.f / 64.f);
        const float yn = dy * rsqrtf(var + 64e-5f) * CT[10 * 64 + lane] + CT[11 * 64 + lane];
        OB[m * 1024 + 512 + c] = (bf16)f2bf((yn + bq[q] * vq[q]) * gq[q]); }
    __syncthreads();
}

__device__ __forceinline__ void carry(LAS unsigned char* lds0, unsigned char* gzc  , const int tid0) {
    f4 stacc[2]; RW_ZERO(stacc);
    { unsigned lb_ = 0u; asm volatile("" : "+v"(lb_)); LAS unsigned char* lds = lds0 + lb_; for (int i = tid0; i < MB / 4; i += NTHR) ((LAS unsigned*)(lds + O_STT))[i] = 0u; }
    u32x4 gnx = ((const u32x4*)gzc)[tid0];
    u32x2 znx[2];
    { const int lane = tid0 & 63, wave = tid0 >> 6;
#pragma unroll
      for (int k = 0; k < 2; ++k) { const int col = ((wave & 1) * 2 + k) * 16 + (lane & 15), row = (wave >> 1) * 16 + 4 * (lane >> 4); znx[k] = *(const u32x2*)(gzc + 8192 + (col * 64 + row) * 2); } }
#pragma unroll 1
    for (int cI = 0; cI < T / 64; ++cI) {
        unsigned lb_ = 0u; int tid_l = tid0; asm volatile("" : "+v"(lb_), "+v"(tid_l));
        LAS unsigned char* lds = lds0 + lb_; const int tid = tid_l, lane = tid & 63, wave = __builtin_amdgcn_readfirstlane(tid >> 6);
        unsigned char* rec = gzc + (size_t)cI * 16384;
        const int io = ((tid >> 3) * LS + (tid & 7) * 8) * 2;
        *(LAS u32x4*)(lds + O_AHN + io) = gnx;
        u32x2 zv[2]; zv[0] = znx[0]; zv[1] = znx[1];
        if (cI + 1 < T / 64) { gnx = ((const u32x4*)(rec + 16384))[tid];
#pragma unroll
            for (int k = 0; k < 2; ++k) { const int col = ((wave & 1) * 2 + k) * 16 + (lane & 15), row = (wave >> 1) * 16 + 4 * (lane >> 4); znx[k] = *(const u32x2*)(rec + 16384 + 8192 + (col * 64 + row) * 2); } }
        __syncthreads();
        ((u32x4*)rec)[tid] = *(const LAS u32x4*)(lds + O_STT + io);
        f4 acc[2];
#pragma unroll
        for (int k = 0; k < 2; ++k) acc[k] = (f4){__uint_as_float(zv[k].x << 16), __uint_as_float(zv[k].x & 0xffff0000u), __uint_as_float(zv[k].y << 16), __uint_as_float(zv[k].y & 0xffff0000u)};
        mm64(acc, lds, O_AHN, O_STT, wave, lane);
        __syncthreads();
        storeT(lds, O_STT, acc, wave, lane);
    }
}
}

namespace mb {
using rw::LS; using rw::MB; using rw::f4; using rw::mm64; using rw::storeN; using rw::bf16x8;
constexpr int O_CN = 0, O_BN = MB, O_BT = 2 * MB, O_XT0 = 3 * MB, O_XW0 = 5 * MB, O_CS0 = 7 * MB, O_HN0 = 9 * MB, O_SC0 = 11 * MB, O_SM = 13 * MB, O_YF = O_XW0;
static_assert(O_SM + 2048 <= LDS_BYTES - 576, "mamba LDS map");
__device__ __forceinline__ void chain(LAS unsigned char* lds0, const int l, const int b, const int gI, const bf16* P, bf16* OB, const int tid0, const int lane0, const int wave0) {
    const int tid = tid0, lane = lane0, wave = wave0;
    LAS unsigned char* const& lds = lds0;
    const float* cwp = INP(I_DCW) + (size_t)l * 4 * 512; const float* cbp = INP(I_DCB) + (size_t)l * 512;
    const int cc = tid & 255, sub = tid >> 8;
    const int col = cc < 128 ? (gI * 128 + cc) : (cc < 192 ? (256 + gI * 64 + (cc - 128)) : (384 + gI * 64 + (cc - 192)));
    const float cw0 = cwp[col], cw1 = cwp[512 + col], cw2 = cwp[1024 + col], cw3 = cwp[1536 + col], cb = cbp[col];
    f4 hacc[2][2];
#pragma unroll
    for (int hh = 0; hh < 2; ++hh) { hacc[hh][0] = (f4){0.f, 0.f, 0.f, 0.f}; hacc[hh][1] = (f4){0.f, 0.f, 0.f, 0.f}; }
    for (int i = tid; i < 2 * MB / 4; i += NTHR) ((LAS unsigned*)(lds0 + O_HN0))[i] = 0u;
    const float dtb0 = INP(I_DDTB)[l * 4 + gI * 2], dtb1 = INP(I_DDTB)[l * 4 + gI * 2 + 1];
    const float nA0 = -__expf(INP(I_DALOG)[l * 4 + gI * 2]), nA1 = -__expf(INP(I_DALOG)[l * 4 + gI * 2 + 1]);
    const float dsk0 = INP(I_DSKIP)[l * 4 + gI * 2], dsk1 = INP(I_DSKIP)[l * 4 + gI * 2 + 1];
    const float nw0 = INP(I_DNW)[l * 256 + gI * 128 + lane], nw1 = INP(I_DNW)[l * 256 + gI * 128 + 64 + lane];
#pragma unroll 1
    for (int t0 = 0; t0 < T; t0 += 64) {
        unsigned lb_ = 0u; int tid_l = tid0; asm volatile("" : "+v"(lb_), "+v"(tid_l));
        const int tid = tid_l, lane = tid & 63, wave = __builtin_amdgcn_readfirstlane(tid >> 6);
        LAS unsigned char* lds = lds0 + lb_;
        LAS float* SM = (LAS float*)(lds + O_SM);
        LAS float* YF = (LAS float*)(lds + O_YF);
        if (wave < 2) {
            const size_t m = (size_t)b * T + t0 + lane;
            const float dt = softplusf_(bf2f(P[m * PP + C_DT + gI * 2 + wave]) + (wave == 0 ? dtb0 : dtb1));
            float cs = dt * (wave == 0 ? nA0 : nA1);
#pragma unroll
            for (int o = 1; o < 64; o <<= 1) { const float y = __shfl_up(cs, o); if (lane >= o) cs += y; }
            const float cL = __shfl(cs, 63);
            SM[wave * 64 + lane] = dt; SM[128 + wave * 64 + lane] = cs; SM[256 + wave * 64 + lane] = __expf(cL - cs) * dt; SM[384 + wave * 64 + lane] = __expf(cs);
        }
        __syncthreads();
        { float h0, h1, h2, cur[8], nxt[8];
          { const int tb = t0 + sub * 32; h0 = tb >= 3 ? bf2f(P[((size_t)b * T + tb - 3) * PP + C_DX + col]) : 0.f; h1 = tb >= 2 ? bf2f(P[((size_t)b * T + tb - 2) * PP + C_DX + col]) : 0.f; h2 = tb >= 1 ? bf2f(P[((size_t)b * T + tb - 1) * PP + C_DX + col]) : 0.f;
#pragma unroll
            for (int j = 0; j < 8; ++j) cur[j] = bf2f(P[((size_t)b * T + tb + j) * PP + C_DX + col]); }
#pragma unroll 1
          for (int g8 = 0; g8 < 4; ++g8) {
            const int tb = t0 + sub * 32 + g8 * 8 + (g8 < 3 ? 8 : 0);
#pragma unroll
            for (int j = 0; j < 8; ++j) nxt[j] = bf2f(P[((size_t)b * T + tb + j) * PP + C_DX + col]);
#pragma unroll
            for (int j = 0; j < 8; ++j) {
                const int tt = sub * 32 + g8 * 8 + j;
                const float a = siluf_(cb + cw3 * cur[j] + cw2 * h2 + cw1 * h1 + cw0 * h0);
                h0 = h1; h1 = h2; h2 = cur[j];
                if (cc < 128) { const int hh = cc >> 6, p = cc & 63;
                    *(LAS bf16*)(lds + O_XT0 + hh * MB + (p * LS + tt) * 2) = (bf16)f2bf(a); *(LAS bf16*)(lds + O_XW0 + hh * MB + (p * LS + tt) * 2) = (bf16)f2bf(a * SM[256 + hh * 64 + tt]); }
                else if (cc < 192) { const int n = cc - 128; *(LAS bf16*)(lds + O_BN + (tt * LS + n) * 2) = (bf16)f2bf(a); *(LAS bf16*)(lds + O_BT + (n * LS + tt) * 2) = (bf16)f2bf(a); }
                else { const int n = cc - 192; *(LAS bf16*)(lds + O_CN + (tt * LS + n) * 2) = (bf16)f2bf(a);
                    *(LAS bf16*)(lds + O_CS0 + (tt * LS + n) * 2) = (bf16)f2bf(a * SM[384 + tt]); *(LAS bf16*)(lds + O_CS0 + MB + (tt * LS + n) * 2) = (bf16)f2bf(a * SM[384 + 64 + tt]); }
            }
#pragma unroll
            for (int j = 0; j < 8; ++j) cur[j] = nxt[j];
          } }
        __syncthreads();
        { f4 acc[2]; acc[0] = (f4){0.f, 0.f, 0.f, 0.f}; acc[1] = (f4){0.f, 0.f, 0.f, 0.f}; mm64(acc, lds, O_CN, O_BN, wave, lane);
#pragma unroll
            for (int hh = 0; hh < 2; ++hh) { f4 sc[2];
#pragma unroll
                for (int cI = 0; cI < 2; ++cI) { const int s = ((wave & 1) * 2 + cI) * 16 + (lane & 15), row = (wave >> 1) * 16 + 4 * (lane >> 4);
                    const float cs = SM[128 + hh * 64 + s], ds = SM[hh * 64 + s];
#pragma unroll
                    for (int e = 0; e < 4; ++e) { const float ct = SM[128 + hh * 64 + row + e]; sc[cI][e] = (s <= row + e) ? acc[cI][e] * __expf(ct - cs) * ds : 0.f; } }
                storeN<0>(lds, O_SC0 + hh * MB, sc, wave, lane); } }
        __syncthreads();
        f4 yacc[2][2];
#pragma unroll
        for (int hh = 0; hh < 2; ++hh) {
            yacc[hh][0] = (f4){0.f, 0.f, 0.f, 0.f}; yacc[hh][1] = (f4){0.f, 0.f, 0.f, 0.f};
            mm64(yacc[hh], lds, O_SC0 + hh * MB, O_XT0 + hh * MB, wave, lane); mm64(yacc[hh], lds, O_CS0 + hh * MB, O_HN0 + hh * MB, wave, lane);
            const float gL = SM[384 + hh * 64 + 63]; hacc[hh][0] = hacc[hh][0] * gL; hacc[hh][1] = hacc[hh][1] * gL;
            mm64(hacc[hh], lds, O_XW0 + hh * MB, O_BT, wave, lane);
        }
        __syncthreads();
#pragma unroll
        for (int hh = 0; hh < 2; ++hh) {
#pragma unroll
            for (int cI = 0; cI < 2; ++cI) { const int colp = ((wave & 1) * 2 + cI) * 16 + (lane & 15), row = (wave >> 1) * 16 + 4 * (lane >> 4);
#pragma unroll
                for (int e = 0; e < 4; ++e) YF[(row + e) * 128 + hh * 64 + colp] = yacc[hh][cI][e]; }
            storeN<0>(lds, O_HN0 + hh * MB, hacc[hh], wave, lane);
        }
        __syncthreads();
#pragma unroll
        for (int q = 0; q < 8; ++q) {
            const int tt = wave * 8 + q; const size_t m = (size_t)b * T + t0 + tt;
            const float x0 = bf2f(*(const LAS bf16*)(lds + O_XT0 + (lane * LS + tt) * 2)), x1 = bf2f(*(const LAS bf16*)(lds + O_XT0 + MB + (lane * LS + tt) * 2));
            const int c0 = gI * 128 + lane, c1 = c0 + 64;
            const float z0 = bf2f(P[m * PP + C_DZ + c0]), z1 = bf2f(P[m * PP + C_DZ + c1]);
            const float y0 = (YF[tt * 128 + lane] + dsk0 * x0) * siluf_(z0), y1 = (YF[tt * 128 + 64 + lane] + dsk1 * x1) * siluf_(z1);
            const float ss = wave_sum(y0 * y0 + y1 * y1); const float rs = rsqrtf(ss * (1.f / 128.f) + 1e-5f);
            OB[m * 1024 + 768 + c0] = (bf16)f2bf(y0 * rs * nw0); OB[m * 1024 + 768 + c1] = (bf16)f2bf(y1 * rs * nw1);
        }
        __syncthreads();
    }
}
}

namespace bsp {
typedef short bf16x8 __attribute__((ext_vector_type(8)));
typedef float f4 __attribute__((ext_vector_type(4)));
constexpr int HS = 129;
constexpr int O_HIST = 0;
constexpr int O_V = 66048;
constexpr int VS = 272;
constexpr int O_KB = O_V + 2 * 32 * VS * 2;
constexpr int KBUF = 20480;
static_assert(O_KB + 2 * KBUF <= LDS_BYTES - 600, "mixer B LDS map");
__device__ __forceinline__ unsigned okey(float s) { int q = (int)(s * 262144.f + 8388608.f); q = q < 1 ? 1 : (q > 16777215 ? 16777215 : q); return (unsigned)q << 8; }
__device__ __forceinline__ f4 idx_tile(const bf16* Pb, const int kt, const bf16x8 (&qi)[4][2], const float (&wq)[4], const int lane) {
    const bf16* kr = Pb + (size_t)(kt * 16 + (lane & 15)) * PP + C_IK + (lane >> 4) * 8;
    const bf16x8 a0 = *(const bf16x8*)kr, a1 = *(const bf16x8*)(kr + 32);
    f4 s = (f4){0.f, 0.f, 0.f, 0.f};
#pragma unroll
    for (int h = 0; h < 4; ++h) { f4 t = (f4){0.f, 0.f, 0.f, 0.f};
        t = __builtin_amdgcn_mfma_f32_16x16x32_bf16(a0, qi[h][0], t, 0, 0, 0); t = __builtin_amdgcn_mfma_f32_16x16x32_bf16(a1, qi[h][1], t, 0, 0, 0);
#pragma unroll
        for (int e = 0; e < 4; ++e) s[e] += wq[h] * fmaxf(t[e], 0.f); }
    return s;
}

__device__ __forceinline__ void item(LAS unsigned char* lds0, const int bb, const int qb, const bf16* P, bf16* OB, const int tid0, const int pm) {
    unsigned lb_ = 0u; int tid_l = tid0; asm volatile("" : "+v"(lb_), "+v"(tid_l));
    LAS unsigned char* lds = lds0 + lb_; const int tid = tid_l, lane = tid & 63, wave = __builtin_amdgcn_readfirstlane(tid >> 6);
    const bf16* Pb = P + (size_t)bb * T * PP;
    const int ql = wave * 16 + (lane & 15), tq = qb * 128 + ql, g = lane >> 4;
    const bf16* prow = Pb + (size_t)tq * PP;
    bf16x8 qi[4][2]; float wq[4];
#pragma unroll
    for (int h = 0; h < 4; ++h) { qi[h][0] = *(const bf16x8*)(prow + C_IQ + h * 64 + g * 8); qi[h][1] = *(const bf16x8*)(prow + C_IQ + h * 64 + 32 + g * 8); wq[h] = bf2f(prow[C_IW + h]) * 0.0625f; }
    LAS unsigned* hist = (LAS unsigned*)(lds + O_HIST) + ql * HS;
    const int nkt = (qb + 1) * 8;
    unsigned prefix = 0u; int needk = 256;
#pragma unroll 1
    for (int rr = 0; rr < (pm == 102 ? 2 : 1); ++rr) { prefix = 0u; needk = 256;
#pragma unroll 1
    for (int pass = 0; pass < 3; ++pass) {
        for (int i = lane; i < 16 * HS; i += 64) ((LAS unsigned*)(lds + O_HIST) + wave * 16 * HS)[i] = 0u;
        asm volatile("s_waitcnt lgkmcnt(0)" ::: "memory");
        const int shp = 32 - 8 * pass, shb = 24 - 8 * pass;
        float flo = 0.f, fhi = 0.f;
        if (pass > 0) { const float stepw = (pass == 1) ? 65536.f : 256.f; flo = ((float)prefix * stepw - 2.f) * (1.f / 262144.f) - 32.f; fhi = (((float)prefix + 1.f) * stepw + 2.f) * (1.f / 262144.f) - 32.f; }
        bf16x8 ka[4][2], kn[4][2];
#pragma unroll
        for (int u = 0; u < 4; ++u) { const bf16* kr = Pb + (size_t)(u * 16 + (lane & 15)) * PP + C_IK + g * 8; ka[u][0] = *(const bf16x8*)kr; ka[u][1] = *(const bf16x8*)(kr + 32); }
#pragma unroll 1
        for (int kt4 = 0; kt4 < nkt; kt4 += 4) {
            { const int ktn = (kt4 + 4 < nkt) ? kt4 + 4 : kt4;
#pragma unroll
              for (int u = 0; u < 4; ++u) { const bf16* kr = Pb + (size_t)((ktn + u) * 16 + (lane & 15)) * PP + C_IK + g * 8; kn[u][0] = *(const bf16x8*)kr; kn[u][1] = *(const bf16x8*)(kr + 32); } }
#pragma unroll
            for (int u = 0; u < 4; ++u) {
                f4 s = (f4){0.f, 0.f, 0.f, 0.f};
#pragma unroll
                for (int h = 0; h < 4; ++h) { f4 t = (f4){0.f, 0.f, 0.f, 0.f};
                    t = __builtin_amdgcn_mfma_f32_16x16x32_bf16(ka[u][0], qi[h][0], t, 0, 0, 0); t = __builtin_amdgcn_mfma_f32_16x16x32_bf16(ka[u][1], qi[h][1], t, 0, 0, 0);
#pragma unroll
                    for (int e = 0; e < 4; ++e) s[e] += wq[h] * fmaxf(t[e], 0.f); }
                if (pass == 0) {
#pragma unroll
                    for (int e = 0; e < 4; ++e) { const int key = (kt4 + u) * 16 + 4 * g + e;
                        if (key <= tq) { const unsigned bin = okey(s[e]) >> 24; __hip_atomic_fetch_add(hist + (bin >> 1), (bin & 1u) ? 0x10000u : 1u, __ATOMIC_RELAXED, __HIP_MEMORY_SCOPE_WORKGROUP); } }
                } else {
#pragma unroll
                    for (int e = 0; e < 4; ++e) { const int key = (kt4 + u) * 16 + 4 * g + e;
                        if (s[e] >= flo && s[e] <= fhi && key <= tq) { const unsigned k32 = okey(s[e]);
                            if ((k32 >> shp) == prefix) { const unsigned bin = (k32 >> shb) & 255u; __hip_atomic_fetch_add(hist + (bin >> 1), (bin & 1u) ? 0x10000u : 1u, __ATOMIC_RELAXED, __HIP_MEMORY_SCOPE_WORKGROUP); } } }
                }
            }
#pragma unroll
            for (int u = 0; u < 4; ++u) { ka[u][0] = kn[u][0]; ka[u][1] = kn[u][1]; }
        }
        asm volatile("s_waitcnt lgkmcnt(0)" ::: "memory");
        int cum = 0; unsigned bsel = 0u; int above = 0;
        for (int wd = 127; wd >= 0; --wd) { const unsigned v = hist[wd]; const int hi = (int)(v >> 16), lo = (int)(v & 0xffffu);
            if (cum + hi >= needk) { bsel = (unsigned)(2 * wd + 1); above = cum; break; } cum += hi;
            if (cum + lo >= needk) { bsel = (unsigned)(2 * wd); above = cum; break; } cum += lo; }
        prefix = (prefix << 8) | bsel; needk -= above;
        asm volatile("s_waitcnt lgkmcnt(0)" ::: "memory");
    }
    }
    unsigned thr = prefix; int cidx = 1 << 20;
    bool tie = false;
    if (tq < 256) thr = 0u;
    else { const unsigned v = hist[(prefix & 255u) >> 1]; const int ceq = (prefix & 1u) ? (int)(v >> 16) : (int)(v & 0xffffu); tie = needk < ceq; }
    if (__any(tie)) {
        int cbin = 0, rem = needk;
#pragma unroll 1
        for (int ip = 0; ip < 2; ++ip) {
            for (int i = g; i < HS; i += 4) hist[i] = 0u;
            asm volatile("s_waitcnt lgkmcnt(0)" ::: "memory");
#pragma unroll 1
            for (int kt = 0; kt < nkt; ++kt) {
                const f4 s = idx_tile(Pb, kt, qi, wq, lane);
#pragma unroll
                for (int e = 0; e < 4; ++e) { const int key = kt * 16 + 4 * g + e; const unsigned k32 = okey(s[e]);
                    const bool in = tie && key <= tq && (k32 >> 8) == prefix && (ip == 0 || (key >> 4) == cbin);
                    if (in) { const unsigned bin = ip == 0 ? (unsigned)(key >> 4) : (unsigned)(key & 15); __hip_atomic_fetch_add(hist + (bin >> 1), (bin & 1u) ? 0x10000u : 1u, __ATOMIC_RELAXED, __HIP_MEMORY_SCOPE_WORKGROUP); } }
            }
            asm volatile("s_waitcnt lgkmcnt(0)" ::: "memory");
            int cum = 0, bs = 0, below = 0;
            for (int wd = 0; wd < 128; ++wd) { const unsigned vv = hist[wd]; const int lo = (int)(vv & 0xffffu), hi = (int)(vv >> 16);
                if (cum + lo >= rem) { bs = 2 * wd; below = cum; break; } cum += lo;
                if (cum + hi >= rem) { bs = 2 * wd + 1; below = cum; break; } cum += hi; }
            if (ip == 0) { cbin = bs; rem -= below; } else if (tie) cidx = cbin * 16 + bs;
            asm volatile("s_waitcnt lgkmcnt(0)" ::: "memory");
        }
    }
    __syncthreads();
#pragma unroll
    for (int h = 0; h < 4; ++h) { *(LAS bf16x8*)(lds + O_HIST + wave * 8192 + ((h * 2 + 0) * 64 + lane) * 16) = qi[h][0]; *(LAS bf16x8*)(lds + O_HIST + wave * 8192 + ((h * 2 + 1) * 64 + lane) * 16) = qi[h][1]; }
    bf16x8 qa[4][2];
#pragma unroll
    for (int h = 0; h < 4; ++h) { qa[h][0] = *(const bf16x8*)(prow + C_BQ + h * 64 + g * 8); qa[h][1] = *(const bf16x8*)(prow + C_BQ + h * 64 + 32 + g * 8); }
    f4 oacc[4][4]; float mrun[4], lrun[4];
#pragma unroll
    for (int h = 0; h < 4; ++h) { mrun[h] = -INFINITY; lrun[h] = 0.f;
#pragma unroll
        for (int dt = 0; dt < 4; ++dt) oacc[h][dt] = (f4){0.f, 0.f, 0.f, 0.f}; }
#pragma unroll 1
    for (int rr = 0; rr < (pm == 103 ? 2 : 1); ++rr) {
#pragma unroll
    for (int h = 0; h < 4; ++h) { mrun[h] = -INFINITY; lrun[h] = 0.f;
#pragma unroll
        for (int dt = 0; dt < 4; ++dt) oacc[h][dt] = (f4){0.f, 0.f, 0.f, 0.f}; }
    const int nst = (qb + 1) * 4;
    const int vkey = tid >> 4, vch = tid & 15;
    u32x4 vpre0 = *(const u32x4*)(Pb + (size_t)vkey * PP + C_BV + vch * 8), vpre1 = *(const u32x4*)(Pb + (size_t)vkey * PP + C_BV + 128 + vch * 8);
    const unsigned vrd = (unsigned)(unsigned long)lds + (unsigned)(O_V + (4 * g + ((lane >> 2) & 3)) * (VS * 2) + (lane & 3) * 8);
    __syncthreads();
    {   const unsigned kb = (unsigned)O_KB;
#pragma unroll
        for (int jj = 0; jj < 3; ++jj) { const int j = wave + 8 * jj;
            if (j < 16) { const int S = j * 64 + lane, r = S >> 5, p = S & 31;
                __builtin_amdgcn_global_load_lds((const unsigned*)(Pb + (size_t)r * PP + C_BK + ((p ^ (r & 15)) << 3)), (LAS unsigned*)(lds + kb + j * 1024), 16, 0, 0); }
            else if (j < 20) { const int S = (j - 16) * 64 + lane, r = S >> 3, p = S & 7;
                __builtin_amdgcn_global_load_lds((const unsigned*)(Pb + (size_t)r * PP + C_IK + ((p ^ (r & 7)) << 3)), (LAS unsigned*)(lds + kb + 16384 + (j - 16) * 1024), 16, 0, 0); } } }
#pragma unroll 1
    for (int st = 0; st < nst; ++st) {
        const int key0 = st * 32; const unsigned vbuf = (unsigned)(st & 1) * (32 * VS * 2);
        unsigned qio = (unsigned)(O_HIST + wave * 8192 + lane * 16); asm volatile("" : "+v"(qio));
        { LAS bf16* VL = (LAS bf16*)(lds + O_V + vbuf); *(LAS u32x4*)(VL + vkey * VS + vch * 8) = vpre0; *(LAS u32x4*)(VL + vkey * VS + 128 + vch * 8) = vpre1; }
        asm volatile("s_waitcnt vmcnt(0)" ::: "memory");
        __syncthreads();
        if (st + 1 < nst) {
            const int kn0 = key0 + 32; const unsigned kb = (unsigned)(O_KB + ((st + 1) & 1) * KBUF);
#pragma unroll
            for (int jj = 0; jj < 3; ++jj) { const int j = wave + 8 * jj;
                if (j < 16) { const int S = j * 64 + lane, r = S >> 5, p = S & 31;
                    __builtin_amdgcn_global_load_lds((const unsigned*)(Pb + (size_t)(kn0 + r) * PP + C_BK + ((p ^ (r & 15)) << 3)), (LAS unsigned*)(lds + kb + j * 1024), 16, 0, 0); }
                else if (j < 20) { const int S = (j - 16) * 64 + lane, r = S >> 3, p = S & 7;
                    __builtin_amdgcn_global_load_lds((const unsigned*)(Pb + (size_t)(kn0 + r) * PP + C_IK + ((p ^ (r & 7)) << 3)), (LAS unsigned*)(lds + kb + 16384 + (j - 16) * 1024), 16, 0, 0); } }
        }
        const unsigned kbc = (unsigned)(O_KB + (st & 1) * KBUF);
#define KQ_(h, k2, ks) (*(const LAS bf16x8*)(lds + kbc + (k2 * 16 + (lane & 15)) * 512 + ((((h) * 8 + (ks) * 4 + g) ^ (lane & 15)) << 4)))
#define KI_(k2, ks) (*(const LAS bf16x8*)(lds + kbc + 16384 + (k2 * 16 + (lane & 15)) * 128 + ((((ks) * 4 + g) ^ (lane & 7)) << 4)))
        bool sel[2][4];
#pragma unroll
        for (int k2 = 0; k2 < 2; ++k2) { f4 s = (f4){0.f, 0.f, 0.f, 0.f};
#pragma unroll
            for (int h = 0; h < 4; ++h) { f4 t = (f4){0.f, 0.f, 0.f, 0.f};
                const bf16x8 qh0 = *(const LAS bf16x8*)(lds + qio + ((h * 2 + 0) * 64) * 16), qh1 = *(const LAS bf16x8*)(lds + qio + ((h * 2 + 1) * 64) * 16);
                t = __builtin_amdgcn_mfma_f32_16x16x32_bf16(KI_(k2, 0), qh0, t, 0, 0, 0); t = __builtin_amdgcn_mfma_f32_16x16x32_bf16(KI_(k2, 1), qh1, t, 0, 0, 0);
#pragma unroll
                for (int e = 0; e < 4; ++e) s[e] += wq[h] * fmaxf(t[e], 0.f); }
#pragma unroll
            for (int e = 0; e < 4; ++e) { const int key = key0 + k2 * 16 + 4 * g + e; const unsigned k24 = okey(s[e]) >> 8;
                sel[k2][e] = key <= tq && (k24 > thr || (k24 == thr && key <= cidx)); } }
#pragma unroll
        for (int h = 0; h < 4; ++h) {
            if (h == 2 && st + 1 < nst) { vpre0 = *(const u32x4*)(Pb + (size_t)(key0 + 32 + vkey) * PP + C_BV + vch * 8); vpre1 = *(const u32x4*)(Pb + (size_t)(key0 + 32 + vkey) * PP + C_BV + 128 + vch * 8); }
            f4 sc[2];
#pragma unroll
            for (int k2 = 0; k2 < 2; ++k2) { f4 t = (f4){0.f, 0.f, 0.f, 0.f};
                t = __builtin_amdgcn_mfma_f32_16x16x32_bf16(KQ_(h, k2, 0), qa[h][0], t, 0, 0, 0); t = __builtin_amdgcn_mfma_f32_16x16x32_bf16(KQ_(h, k2, 1), qa[h][1], t, 0, 0, 0);
#pragma unroll
                for (int e = 0; e < 4; ++e) sc[k2][e] = sel[k2][e] ? t[e] * 0.125f : -INFINITY; }
            float mx = fmaxf(fmaxf(fmaxf(sc[0][0], sc[0][1]), fmaxf(sc[0][2], sc[0][3])), fmaxf(fmaxf(sc[1][0], sc[1][1]), fmaxf(sc[1][2], sc[1][3])));
            mx = fmaxf(mx, __shfl_xor(mx, 16)); mx = fmaxf(mx, __shfl_xor(mx, 32));
            const float mnew = fmaxf(mrun[h], mx), msafe = (mnew == -INFINITY) ? 0.f : mnew;
            const float corr = __expf(mrun[h] - msafe); mrun[h] = mnew;
            float p[8]; float ps = 0.f;
#pragma unroll
            for (int e = 0; e < 4; ++e) { p[e] = __expf(sc[0][e] - msafe); p[4 + e] = __expf(sc[1][e] - msafe); ps += p[e] + p[4 + e]; }
            lrun[h] = lrun[h] * corr + ps;
            union { bf16x8 v; unsigned u[4]; } pb;
            pb.u[0] = pg8::cvt_pk_bf16(p[0], p[1]); pb.u[1] = pg8::cvt_pk_bf16(p[2], p[3]); pb.u[2] = pg8::cvt_pk_bf16(p[4], p[5]); pb.u[3] = pg8::cvt_pk_bf16(p[6], p[7]);
            union { bf16x8 v; u32x2 h2[2]; } vf[4];
            const unsigned va = vrd + vbuf + (unsigned)(h * 128);
            asm volatile("ds_read_b64_tr_b16 %0, %8\n\tds_read_b64_tr_b16 %1, %8 offset:%9\n\tds_read_b64_tr_b16 %2, %8 offset:32\n\tds_read_b64_tr_b16 %3, %8 offset:%10\n\t"
                         "ds_read_b64_tr_b16 %4, %8 offset:64\n\tds_read_b64_tr_b16 %5, %8 offset:%11\n\tds_read_b64_tr_b16 %6, %8 offset:96\n\tds_read_b64_tr_b16 %7, %8 offset:%12\n\ts_waitcnt lgkmcnt(0)"
                         : "=&v"(vf[0].h2[0]), "=&v"(vf[0].h2[1]), "=&v"(vf[1].h2[0]), "=&v"(vf[1].h2[1]), "=&v"(vf[2].h2[0]), "=&v"(vf[2].h2[1]), "=&v"(vf[3].h2[0]), "=&v"(vf[3].h2[1])
                         : "v"(va), "i"(16 * VS * 2), "i"(16 * VS * 2 + 32), "i"(16 * VS * 2 + 64), "i"(16 * VS * 2 + 96) : "memory");
            __builtin_amdgcn_sched_barrier(0);
#pragma unroll
            for (int dt = 0; dt < 4; ++dt) { oacc[h][dt] = oacc[h][dt] * corr; oacc[h][dt] = __builtin_amdgcn_mfma_f32_16x16x32_bf16(vf[dt].v, pb.v, oacc[h][dt], 0, 0, 0); }
        }
    }
    __syncthreads();
    }
#undef KQ_
#undef KI_
    const size_t m = (size_t)bb * T + tq;
#pragma unroll
    for (int h = 0; h < 4; ++h) { float l = lrun[h]; l += __shfl_xor(l, 16); l += __shfl_xor(l, 32); const float inv = 1.f / l;
#pragma unroll
        for (int dt = 0; dt < 4; ++dt) { u32x2 w; w.x = pk2(oacc[h][dt][0] * inv, oacc[h][dt][1] * inv); w.y = pk2(oacc[h][dt][2] * inv, oacc[h][dt][3] * inv);
            *(u32x2*)(OB + m * 1024 + 256 + h * 64 + dt * 16 + 4 * g) = w; } }
    __syncthreads();
}
}

namespace awin {
typedef short bf16x8 __attribute__((ext_vector_type(8)));
typedef float f4 __attribute__((ext_vector_type(4)));
constexpr int EXS = 66;
constexpr int O_EX = 0;
constexpr int VSW = 72;
constexpr int O_VW = 101376;
__device__ __forceinline__ void item(LAS unsigned char* lds0, const int bb, const int blk, const int h, const bf16* P, bf16* OB, const int tid0) {
    unsigned lb_ = 0u; int tid_l = tid0; asm volatile("" : "+v"(lb_), "+v"(tid_l));
    LAS unsigned char* lds = lds0 + lb_; const int tid = tid_l, lane = tid & 63, wave = __builtin_amdgcn_readfirstlane(tid >> 6);
    const bf16* Pb = P + (size_t)bb * T * PP; const int start = blk * 128, g = lane >> 4, ln = lane & 15;
    LAS float* EX = (LAS float*)(lds + O_EX);
    LAS bf16* VW = (LAS bf16*)(lds + O_VW + wave * 4608);
#pragma unroll 1
    for (int s4 = 0; s4 < 4; ++s4) {
        const int st = wave * 4 + s4;
        const int grp = st < 8 ? 0 : (st < 16 ? 1 : 2);
        const int dil = grp == 0 ? 1 : (grp == 1 ? 4 : 16), win = grp == 0 ? 128 : (grp == 1 ? 512 : 2048);
        const int r = grp == 0 ? 0 : (grp == 1 ? ((st - 8) >> 1) : (st - 16)), a0 = grp == 0 ? 16 * st : (grp == 1 ? ((st - 8) & 1) * 16 : 0), nqc = grp == 0 ? 128 : (grp == 1 ? 32 : 8);
        const int a = a0 + ln; const bool qok = a < nqc; const int ql = (qok ? a : (nqc - 1)) * dil + r, tq = start + ql;
        const bf16* qp = Pb + (size_t)tq * PP + C_AQ + grp * 256 + h * 64 + g * 8;
        const bf16x8 q0 = *(const bf16x8*)qp, q1 = *(const bf16x8*)(qp + 32);
        bf16x8 kf[10][2];
#pragma unroll
        for (int kt = 0; kt < 10; ++kt) { int pos = start - win + (a0 + 16 * kt + ln) * dil + r; pos = pos < 0 ? 0 : (pos > T - 1 ? T - 1 : pos);
            const bf16* kp = Pb + (size_t)pos * PP + C_AK + grp * 256 + h * 64 + g * 8; kf[kt][0] = *(const bf16x8*)kp; kf[kt][1] = *(const bf16x8*)(kp + 32); }
        f4 sc[10]; float mx = -INFINITY;
#pragma unroll
        for (int kt = 0; kt < 10; ++kt) { f4 t = (f4){0.f, 0.f, 0.f, 0.f};
            t = __builtin_amdgcn_mfma_f32_16x16x32_bf16(kf[kt][0], q0, t, 0, 0, 0); t = __builtin_amdgcn_mfma_f32_16x16x32_bf16(kf[kt][1], q1, t, 0, 0, 0);
#pragma unroll
            for (int e = 0; e < 4; ++e) { const int c = a0 + 16 * kt + 4 * g + e; const int pos = start - win + c * dil + r;
                const bool ok = qok && c >= a && c <= a + 128 && pos >= 0;
                sc[kt][e] = ok ? t[e] * 0.125f : -INFINITY; mx = fmaxf(mx, sc[kt][e]); } }
        mx = fmaxf(mx, __shfl_xor(mx, 16)); mx = fmaxf(mx, __shfl_xor(mx, 32));
        const float msafe = (mx == -INFINITY) ? 0.f : mx; float lsum = 0.f;
#pragma unroll
        for (int kt = 0; kt < 10; ++kt)
#pragma unroll
            for (int e = 0; e < 4; ++e) { sc[kt][e] = __expf(sc[kt][e] - msafe); lsum += sc[kt][e]; }
        lsum += __shfl_xor(lsum, 16); lsum += __shfl_xor(lsum, 32);
        f4 oacc[4];
#pragma unroll
        for (int dt = 0; dt < 4; ++dt) oacc[dt] = (f4){0.f, 0.f, 0.f, 0.f};
#pragma unroll
        for (int s5 = 0; s5 < 5; ++s5) {
            int pos = start - win + (a0 + 32 * s5 + (lane >> 1)) * dil + r; pos = pos < 0 ? 0 : (pos > T - 1 ? T - 1 : pos);
            const u32x4* vp = (const u32x4*)(Pb + (size_t)pos * PP + C_AV + grp * 256 + h * 64 + (lane & 1) * 32);
            const u32x4 v0 = vp[0], v1 = vp[1], v2 = vp[2], v3 = vp[3];
            LAS u32x4* vd = (LAS u32x4*)(VW + (lane >> 1) * VSW + (lane & 1) * 32);
            asm volatile("s_waitcnt lgkmcnt(0)" ::: "memory");
            vd[0] = v0; vd[1] = v1; vd[2] = v2; vd[3] = v3;
            asm volatile("s_waitcnt lgkmcnt(0)" ::: "memory");
            bf16x8 pb;
#pragma unroll
            for (int e = 0; e < 4; ++e) { pb[e] = (short)f2bf(sc[2 * s5][e]); pb[4 + e] = (short)f2bf(sc[2 * s5 + 1][e]); }
#pragma unroll
            for (int dt = 0; dt < 4; ++dt) { bf16x8 vf; const LAS bf16* vb = VW + (4 * g) * VSW + dt * 16 + ln;
#pragma unroll
                for (int e = 0; e < 4; ++e) { vf[e] = (short)vb[e * VSW]; vf[4 + e] = (short)vb[(16 + e) * VSW]; }
                oacc[dt] = __builtin_amdgcn_mfma_f32_16x16x32_bf16(vf, pb, oacc[dt], 0, 0, 0); }
        }
        if (qok) { LAS float* ex = EX + (grp * 128 + ql) * EXS;
#pragma unroll
            for (int dt = 0; dt < 4; ++dt) { ex[dt * 16 + 4 * g + 0] = oacc[dt][0]; ex[dt * 16 + 4 * g + 1] = oacc[dt][1]; ex[dt * 16 + 4 * g + 2] = oacc[dt][2]; ex[dt * 16 + 4 * g + 3] = oacc[dt][3]; }
            if (g == 0) { ex[64] = mx; ex[65] = lsum; } }
    }
    __syncthreads();
    { const int ql = tid >> 2, d0 = (tid & 3) * 16;
      const LAS float* e0 = EX + (0 * 128 + ql) * EXS; const LAS float* e1 = EX + (1 * 128 + ql) * EXS; const LAS float* e2 = EX + (2 * 128 + ql) * EXS;
      const float m0 = e0[64], m1 = e1[64], m2 = e2[64], M = fmaxf(m0, fmaxf(m1, m2));
      const float w0 = __expf(m0 - M), w1 = __expf(m1 - M), w2 = __expf(m2 - M); const float inv = 1.f / (w0 * e0[65] + w1 * e1[65] + w2 * e2[65]);
      unsigned pk[8];
#pragma unroll
      for (int j = 0; j < 8; ++j) { const float x0 = (w0 * e0[d0 + 2 * j] + w1 * e1[d0 + 2 * j] + w2 * e2[d0 + 2 * j]) * inv, x1 = (w0 * e0[d0 + 2 * j + 1] + w1 * e1[d0 + 2 * j + 1] + w2 * e2[d0 + 2 * j + 1]) * inv; pk[j] = pk2(x0, x1); }
      u32x4* op = (u32x4*)(OB + ((size_t)bb * T + start + ql) * 1024 + h * 64 + d0);
      op[0] = (u32x4){pk[0], pk[1], pk[2], pk[3]}; op[1] = (u32x4){pk[4], pk[5], pk[6], pk[7]}; }
    __syncthreads();
}
}

template <int SP>
__device__ __forceinline__ void phase_body(const int l_in, LAS unsigned char* lds) {
    int tid_ = threadIdx.x, bid_ = blockIdx.x, l_ = l_in, G_ = gridDim.x; asm volatile("" : "+v"(tid_), "+s"(bid_), "+s"(l_), "+s"(G_));
    const int tid = tid_, lane = tid & 63, wave = __builtin_amdgcn_readfirstlane(tid >> 6), l = l_;
    const int G = G_, bid = bid_;
    const int gw = bid * NWAVES + wave, NGW = G * NWAVES;
    unsigned char* ws = (unsigned char*)gptr(ldptr(lds, 36));
    int* ctl = (int*)(ws + WS_CTL);
    bf16* XB = (bf16*)(ws + WS_XB); bf16* OB = (bf16*)(ws + WS_O); bf16* VF = (bf16*)(ws + WS_VF); bf16* P = (bf16*)(ws + WS_P);
    bf16* GS = (bf16*)(ws + WS_GS); bf16* MG = (bf16*)(ws + WS_MERGED); bf16* XS = (bf16*)(ws + WS_XS); bf16* HB = (bf16*)(ws + WS_H);
    bf16* WGU = (bf16*)(ws + WS_WGU); bf16* WD = (bf16*)(ws + WS_WD);
    float* X = (float*)gptr(ldptr(lds, 35));
    int* tok_e = (int*)(ws + WS_ROUTE); float* tok_g = (float*)(ws + WS_ROUTE + 256 * 1024); int* tok_rank = (int*)(ws + WS_ROUTE + 512 * 1024); int* tok_slot = (int*)(ws + WS_ROUTE + 768 * 1024);
    (void)ctl; (void)XB; (void)OB; (void)VF; (void)P; (void)GS; (void)MG; (void)XS; (void)HB; (void)WGU; (void)WD; (void)X; (void)tok_e; (void)tok_g; (void)tok_rank; (void)tok_slot; (void)gw; (void)NGW; (void)lane;
    {
        bf16* WinT = (bf16*)(ws + WS_WINT) + (size_t)l * 5120 * 1024; bf16* WgT = (bf16*)(ws + WS_WGT) + (size_t)l * 4096 * 1024;
        bf16* WbrT = (bf16*)(ws + WS_WBRT) + (size_t)l * 1024 * 1024; bf16* WoutT = (bf16*)(ws + WS_WOUTT) + (size_t)l * 1024 * 1024;
        float* WrT = (float*)(ws + WS_WRT) + (size_t)l * 36 * 1024;
        int* cnt = ctl + CW_CNT + l * 64;

        if constexpr (SP == -1) {
            LAS float* scr = (LAS float*)(lds + wave * 16384);
#pragma unroll 1
            for (int job = 0; job < NL * 11; ++job) {
                const int ll = job / 11, jk = job % 11;
                if (jk < 5) {
                    const float* W = INP(I_WIN) + (size_t)ll * 1024 * INW;
                    const int sc0 = jk == 0 ? 0 : (jk == 1 ? 3396 : (jk == 2 ? 3392 : (jk == 3 ? 5060 : 5064)));
                    const int snc = jk == 0 ? 3392 : (jk == 1 ? 1664 : (jk == 4 ? 4096 : 4));
                    const int sr0 = jk == 0 ? 0 : (jk == 1 ? 3392 : (jk == 2 ? 5056 : (jk == 3 ? 5060 : 0)));
                    bf16* dst = jk == 4 ? (bf16*)(ws + WS_WGT) + (size_t)ll * 4096 * 1024 : (bf16*)(ws + WS_WINT) + (size_t)ll * 5120 * 1024;
                    const int nbn = (snc + 31) / 32, nit = 16 * nbn;
#pragma unroll 1
                    for (int it = gw; it < nit; it += NGW) transpose_item(W, INW, sc0, snc, dst, 1024, sr0, 0, it / nbn, it % nbn, scr, lane);
                } else if (jk < 9) {
                    const int n = jk - 5; const float* Wb = INP(I_WBR) + ((size_t)ll * 4 + n) * 256 * 1024;
#pragma unroll 1
                    for (int it = gw; it < 4 * 32; it += NGW) transpose_item(Wb, 1024, 0, 1024, (bf16*)(ws + WS_WBRT) + (size_t)ll * 1024 * 1024, 1024, 0, n * 256, it / 32, it % 32, scr, lane);
                } else if (jk == 9) {
                    const float* Wo = INP(I_WOUT) + (size_t)ll * 1024 * 1024;
#pragma unroll 1
                    for (int it = gw; it < 16 * 32; it += NGW) transpose_item(Wo, 1024, 0, 1024, (bf16*)(ws + WS_WOUTT) + (size_t)ll * 1024 * 1024, 1024, 0, 0, it / 32, it % 32, scr, lane);
                } else {
                    bf16* wi = (bf16*)(ws + WS_WINT) + (size_t)ll * 5120 * 1024;
#pragma unroll 1
                    for (int i = gw * 64 + lane; i < 56 * 1024 / 8; i += NGW * 64) ((u32x4*)(wi + (size_t)5064 * 1024))[i] = (u32x4){0u, 0u, 0u, 0u};
                    float* wr = (float*)(ws + WS_WRT) + (size_t)ll * 36 * 1024; const float* rg = INP(I_RG) + (size_t)ll * 1024 * 4; const float* re = INP(I_RE) + (size_t)ll * 1024 * 32;
#pragma unroll 1
                    for (int i = gw * 64 + lane; i < 36 * 1024; i += NGW * 64) { const int o = i / 1024, k = i % 1024; wr[i] = o < 4 ? rg[k * 4 + o] : re[k * 32 + (o - 4)]; }
                }
            }
            for (int m = gw; m < M; m += NGW) {
                const f32x4* xr = (const f32x4*)(INP(I_X) + (size_t)m * D) + lane;
#pragma unroll
                for (int j = 0; j < 4; ++j) { const f32x4 v = xr[64 * j]; ((f32x4*)(X + (size_t)m * D))[lane + 64 * j] = v;
                    u32x2 w; w.x = pk2(v[0], v[1]); w.y = pk2(v[2], v[3]); ((u32x2*)(XB + (size_t)m * D))[lane + 64 * j] = w; }
            }
        }
        else if constexpr (SP == 0) {
            pg8::Gemm g{XB, WinT, 1024, 1024, 1024}; pg8::StaticOrder S; S.init(M, PP, G, bid, 1024, 1024);
            EpiStoreBf16 E{P, PP, 0, PP};
            pg8::gemm_phase<EpiStoreBf16, pg8::StaticOrder>(lds, g, S, E);
        }
        else if constexpr (SP == 12) {
            if (bid < 32) rw::carry(lds, ws + WS_RW + (size_t)bid * 64 * 16384, tid);
        }
        else if constexpr (SP == 13) {
            unsigned char* GZ = ws + WS_RW;
            const int h = bid & 3, k = bid >> 2;
            rw::build_ct(lds, l, h, lane, wave); __syncthreads();
#pragma unroll 1
            for (int idx = k; idx < 512; idx += (G >> 2)) { const int b = idx >> 6, cI = idx & 63; const size_t ci_ = (size_t)((b * 4 + h) * 64 + cI);
                rw::chunk_out(lds, b, h, cI * 64, GZ + ci_ * 16384, ws + WS_RW2 + ci_ * 24576, (const float*)(ws + WS_BONG) + ci_ * 64, VF, OB, tid); }
        }
        else if constexpr (SP == 15) {
            unsigned char* GZ = ws + WS_RW;
            int* qctr = ctl + CW_Q + l * 64;
            int cur_h = -1;
#pragma unroll 1
            for (;;) {
                unsigned so = (unsigned)(LDS_BYTES - 584); asm volatile("" : "+v"(so));
                volatile LAS int* slot = (volatile LAS int*)(lds + so);
                int tid = threadIdx.x; asm volatile("" : "+v"(tid));
                const int lane = tid & 63, wave = __builtin_amdgcn_readfirstlane(tid >> 6);
                __syncthreads();
                if (tid == 0) *slot = atomicAdd(qctr, 1);
                __syncthreads();
                const int it = __builtin_amdgcn_readfirstlane(*slot);
                if (it >= 3344) break;
                if (it < 16) { mb::chain(lds, l, it >> 1, it & 1, P, OB, tid, lane, wave); }
                else if (it < 272) { const int j = it - 16; bsp::item(lds, j & 7, 31 - (j >> 3), P, OB, tid, (int)(unsigned)ldptr(lds, 37)); }
                else if (it < 2320) { const int j = it - 272, h = j >> 9, idx = j & 511, b = idx >> 6, cI = idx & 63;
                    if (h != cur_h) { rw::build_ct(lds, l, h, lane, wave); cur_h = h; __syncthreads(); }
                    { const size_t ci_ = (size_t)((b * 4 + h) * 64 + cI); rw::chunk<1>(lds, l, b, h, cI * 64, GZ + ci_ * 16384, ws + WS_RW2 + ci_ * 24576, (float*)(ws + WS_BONG) + ci_ * 64, P, VF, OB, tid); } }
                else { const int j = it - 2320; awin::item(lds, j >> 7, (j >> 2) & 31, j & 3, P, OB, tid); }
            }
        }
        else if constexpr (SP == 4) {
            if (bid < 32) { rw::carry(lds, ws + WS_RW + (size_t)bid * 64 * 16384, tid); __syncthreads(); }
            pg8::Gemm g{XB, WgT, 1024, 1024, 1024}; SkewOrder S{M / 256, 16, (M / 256) * 16, bid, 1024, 1024};
            EpiStoreBf16 E{GS, 4096, 1, 4096};
            pg8::gemm_phase<EpiStoreBf16, SkewOrder>(lds, g, S, E);
        }
        else if constexpr (SP == 5) {
            pg8::Gemm g{OB, WbrT, 1024, 1024, 256}; BranchOrder S{M / 256, 4, G, bid};
            EpiBranch E{GS, MG};
            pg8::gemm_phase<EpiBranch, BranchOrder>(lds, g, S, E);
        }
        else if constexpr (SP == 6) {
            pg8::Gemm g{MG, WoutT, 1024, 1024, 1024}; pg8::StaticOrder S; S.init(M, 1024, G, bid, 1024, 1024);
            EpiResid E{X};
            pg8::gemm_phase<EpiResid, pg8::StaticOrder>(lds, g, S, E);
        }
        else if constexpr (SP == 7) {
            const float* g1 = INP(I_LN1G) + l * 1024; const float* b1 = INP(I_LN1B) + l * 1024;
            const float* rgb = INP(I_RGB) + l * 4; const float* reb = INP(I_REB) + l * 32;
            f32x4 vn[4];
#pragma unroll
            for (int j = 0; j < 4; ++j) vn[j] = ((const f32x4*)(X + (size_t)gw * D))[lane + 64 * j];
#pragma unroll 1
            for (int m = gw; m < M; m += NGW) {
                f32x4 v[4]; float s = 0.f; f32x4* xr = (f32x4*)(X + (size_t)m * D) + lane;
#pragma unroll
                for (int j = 0; j < 4; ++j) { v[j] = vn[j]; s += (v[j][0] + v[j][1]) + (v[j][2] + v[j][3]); }
                { const int mnx = (m + NGW < M) ? m + NGW : m;
#pragma unroll
                  for (int j = 0; j < 4; ++j) vn[j] = ((const f32x4*)(X + (size_t)mnx * D))[lane + 64 * j]; }
                const float mean = wave_sum(s) * (1.f / D); float s2 = 0.f;
#pragma unroll
                for (int j = 0; j < 4; ++j) { v[j] = v[j] - mean; s2 += (v[j][0] * v[j][0] + v[j][1] * v[j][1]) + (v[j][2] * v[j][2] + v[j][3] * v[j][3]); }
                const float rstd = rsqrtf(wave_sum(s2) * (1.f / D) + LN_EPS);
#pragma unroll
                for (int j = 0; j < 4; ++j) { const f32x4 gg = ((const f32x4*)g1)[lane + 64 * j], bb = ((const f32x4*)b1)[lane + 64 * j]; v[j] = v[j] * rstd * gg + bb; xr[64 * j] = v[j];
                    u32x2 w; w.x = pk2(v[j][0], v[j][1]); w.y = pk2(v[j][2], v[j][3]); ((u32x2*)(XB + (size_t)m * D))[lane + 64 * j] = w; }
                float mylg = 0.f;
#pragma unroll 1
                for (int o4 = 0; o4 < 36; o4 += 4) { float a4[4];
#pragma unroll
                    for (int u = 0; u < 4; ++u) { float a = 0.f;
#pragma unroll
                        for (int j = 0; j < 4; ++j) { const f32x4 wv = ((const f32x4*)(WrT + (o4 + u) * 1024))[lane + 64 * j]; a += v[j][0] * wv[0] + v[j][1] * wv[1] + v[j][2] * wv[2] + v[j][3] * wv[3]; }
                        a4[u] = a; }
#pragma unroll
                    for (int sft = 1; sft < 64; sft <<= 1) {
#pragma unroll
                        for (int u = 0; u < 4; ++u) a4[u] += __shfl_xor(a4[u], sft); }
#pragma unroll
                    for (int u = 0; u < 4; ++u) mylg = (lane == o4 + u) ? a4[u] : mylg; }
                mylg += lane < 4 ? rgb[lane & 3] : (lane < 36 ? reb[(lane - 4) & 31] : 0.f);
                float gl[4]; float gm = -INFINITY; int gs = 0;
#pragma unroll
                for (int o = 0; o < 4; ++o) { gl[o] = __shfl(mylg, o); if (gl[o] > gm) { gm = gl[o]; gs = o; } }
                float gden = 0.f;
#pragma unroll
                for (int o = 0; o < 4; ++o) gden += __expf(gl[o] - gm);
                const float pg = 1.f / gden;
                float el[8];
#pragma unroll
                for (int o = 0; o < 8; ++o) el[o] = __shfl(mylg, 4 + gs * 8 + o);
                int e1 = 0; float m1 = el[0];
#pragma unroll
                for (int o = 1; o < 8; ++o) if (el[o] > m1) { m1 = el[o]; e1 = o; }
                int e2 = -1; float m2 = -INFINITY;
#pragma unroll
                for (int o = 0; o < 8; ++o) if (o != e1 && el[o] > m2) { m2 = el[o]; e2 = o; }
                const float r2 = __expf(m2 - m1); const float ga = pg / (1.f + r2), gb = pg * r2 / (1.f + r2);
                if (lane == 0) {
                    const int E1 = gs * 8 + e1, E2 = gs * 8 + e2;
                    tok_e[m * 2] = E1; tok_e[m * 2 + 1] = E2; tok_g[m * 2] = ga; tok_g[m * 2 + 1] = gb;
                    tok_rank[m * 2] = atomicAdd(&cnt[E1], 1); tok_rank[m * 2 + 1] = atomicAdd(&cnt[E2], 1);
                }
            }
        }
        else if constexpr (SP == 14) {
            LAS float* scr = (LAS float*)(lds + wave * 16384);
            const float* eg = INP(I_EG) + (size_t)l * NEXP * 1024 * 512; const float* eu = INP(I_EU) + (size_t)l * NEXP * 1024 * 512; const float* ed = INP(I_ED) + (size_t)l * NEXP * 512 * 1024;
            for (int it = gw; it < NEXP * 2 * 4 * 64; it += NGW) {
                const int e = it / 512, r = it % 512, half = r / 256, ct = (r % 256) / 64, q = r % 64, kb = q / 4, nb = q % 4;
                const float* W = (half ? eu : eg) + (size_t)e * 1024 * 512;
                transpose_item(W, 512, ct * 128, 128, WGU + (size_t)e * 1024 * 1024, 1024, ct * 256 + half * 128, 0, kb, nb, scr, lane);
            }
            for (int it = gw; it < NEXP * 8 * 32; it += NGW) {
                const int e = it / 256, q = it % 256, kb = q / 32, nb = q % 32;
                transpose_item(ed + (size_t)e * 512 * 1024, 1024, 0, 1024, WD + (size_t)e * 1024 * 512, 512, 0, 0, kb, nb, scr, lane);
            }
        }
        else if constexpr (SP == 8 || SP == 9 || SP == 10) {
            unsigned tbo = MISC_OFF; asm volatile("" : "+v"(tbo));
            volatile LAS int* tb = (volatile LAS int*)(lds + tbo);
            if (tid == 0) { int acc = 0; for (int e = 0; e < 32; ++e) { const int c = __hip_atomic_load(&cnt[e], __ATOMIC_RELAXED, __HIP_MEMORY_SCOPE_AGENT); tb[e] = acc; tb[33 + e] = acc; acc += (c + 255) >> 8; } tb[32] = acc; }
            __syncthreads();
            if constexpr (SP == 8) {
                for (int m = gw; m < M; m += NGW) {
#pragma unroll
                    for (int k = 0; k < 2; ++k) { const int e = tok_e[m * 2 + k]; const int slot = tb[33 + e] * 256 + tok_rank[m * 2 + k];
                        const u32x4* src = (const u32x4*)(XB + (size_t)m * D); u32x4* dst = (u32x4*)(XS + (size_t)slot * D);
                        dst[lane] = src[lane]; dst[lane + 64] = src[lane + 64];
                        if (lane == 0) tok_slot[m * 2 + k] = slot; }
                }
            } else if constexpr (SP == 9) {
                pg8::Gemm g{XS, WGU, 1024, 1024, 1024}; MoeOrder S{tb, G, bid, (size_t)1024 * 2, (size_t)1024 * 1024 * 2, (size_t)256 * 1024 * 2};
                EpiSwiglu E{HB};
                pg8::gemm_phase<EpiSwiglu, MoeOrder>(lds, g, S, E);
            } else {
                pg8::Gemm g{HB, WD, 512, 512, 512}; MoeOrder S{tb, G, bid, (size_t)512 * 2, (size_t)1024 * 512 * 2, (size_t)256 * 512 * 2};
                EpiStoreBf16 E{XS, 1024, 0, 1024};
                pg8::gemm_phase<EpiStoreBf16, MoeOrder>(lds, g, S, E);
            }
        }
        else if constexpr (SP == 11) {
            const float* g2 = INP(I_LN2G) + l * 1024; const float* b2 = INP(I_LN2B) + l * 1024;
            f32x4 xn[4]; u32x2 y1n[4], y2n[4]; float gan, gbn;
#define LN2_LOAD(mm) do { const int s1_ = tok_slot[(mm) * 2], s2_ = tok_slot[(mm) * 2 + 1]; gan = tok_g[(mm) * 2]; gbn = tok_g[(mm) * 2 + 1]; \
                _Pragma("unroll") for (int j = 0; j < 4; ++j) { xn[j] = ((const f32x4*)(X + (size_t)(mm) * D))[lane + 64 * j]; y1n[j] = ((const u32x2*)(XS + (size_t)s1_ * D))[lane + 64 * j]; y2n[j] = ((const u32x2*)(XS + (size_t)s2_ * D))[lane + 64 * j]; } } while (0)
            LN2_LOAD(gw);
#pragma unroll 1
            for (int m = gw; m < M; m += NGW) {
                const float ga = gan, gb = gbn;
                f32x4 v[4]; float s = 0.f; f32x4* xr = (f32x4*)(X + (size_t)m * D) + lane;
                u32x2 y1c[4], y2c[4];
#pragma unroll
                for (int j = 0; j < 4; ++j) { v[j] = xn[j] * ALPHA; y1c[j] = y1n[j]; y2c[j] = y2n[j]; }
                { const int mnx = (m + NGW < M) ? m + NGW : m; LN2_LOAD(mnx); }
#pragma unroll
                for (int j = 0; j < 4; ++j) { const u32x2 y1 = y1c[j], y2 = y2c[j];
                    v[j][0] += ga * __uint_as_float(y1.x << 16) + gb * __uint_as_float(y2.x << 16); v[j][1] += ga * __uint_as_float(y1.x & 0xffff0000u) + gb * __uint_as_float(y2.x & 0xffff0000u);
                    v[j][2] += ga * __uint_as_float(y1.y << 16) + gb * __uint_as_float(y2.y << 16); v[j][3] += ga * __uint_as_float(y1.y & 0xffff0000u) + gb * __uint_as_float(y2.y & 0xffff0000u);
                    s += (v[j][0] + v[j][1]) + (v[j][2] + v[j][3]); }
                const float mean = wave_sum(s) * (1.f / D); float s2 = 0.f;
#pragma unroll
                for (int j = 0; j < 4; ++j) { v[j] = v[j] - mean; s2 += (v[j][0] * v[j][0] + v[j][1] * v[j][1]) + (v[j][2] * v[j][2] + v[j][3] * v[j][3]); }
                const float rstd = rsqrtf(wave_sum(s2) * (1.f / D) + LN_EPS);
#pragma unroll
                for (int j = 0; j < 4; ++j) { const f32x4 gg = ((const f32x4*)g2)[lane + 64 * j], bb = ((const f32x4*)b2)[lane + 64 * j]; v[j] = v[j] * rstd * gg + bb; xr[64 * j] = v[j];
                    u32x2 w; w.x = pk2(v[j][0], v[j][1]); w.y = pk2(v[j][2], v[j][3]); ((u32x2*)(XB + (size_t)m * D))[lane + 64 * j] = w; }
            }
        }
    }
}

template <int SP>
__global__ void __launch_bounds__(NTHR, 2) k_phase(Args args, int l) {
    extern __shared__ __attribute__((aligned(16))) unsigned char lds_raw[];
    ptr_table_fill(args, (LAS unsigned char*)lds_raw);
    phase_body<SP>(l, (LAS unsigned char*)lds_raw);
}


#define XB_TMO      128
#define XB_XCNT(j)  (256  + 64 * (j))
#define XB_XSUB(j)  (1280 + 64 * (j))
#define XB_XGEN(j)  (2304 + 64 * (j))
#define XB_TOP      3328
#define XB_TOPGEN   3392
#define XCD_BAR_WORDS 3456
#define XB_SPIN_CAP (1u << 22)
__device__ __forceinline__ unsigned xb_ld(unsigned* p)              { return __hip_atomic_load(p, __ATOMIC_RELAXED, __HIP_MEMORY_SCOPE_AGENT); }
__device__ __forceinline__ unsigned xb_add(unsigned* p, unsigned v) { return __hip_atomic_fetch_add(p, v, __ATOMIC_RELAXED, __HIP_MEMORY_SCOPE_AGENT); }
__device__ __forceinline__ unsigned xb_xcc_id() { return (unsigned)__builtin_amdgcn_s_getreg((3 << 11) | 20) & 0xFu; }
#define XB_SPIN(cond, bar) do { unsigned _sp = 0; while (cond) { __builtin_amdgcn_s_sleep(1); \
    if ((++_sp & 255u) == 0u) { if (xb_ld(&(bar)[XB_TMO])) break; if (_sp > XB_SPIN_CAP) { atomicAdd(&(bar)[XB_TMO], 1u); break; } } } } while (0)
__device__ __forceinline__ void xcd_barrier_complete(unsigned* bar, unsigned x, unsigned& nloc, unsigned& nx) {
    const unsigned G = gridDim.x;
    unsigned sum, cnt, mine, sp = 0u;
    for (;;) {
        sum = 0u; cnt = 0u; mine = 0u;
#pragma unroll
        for (unsigned j = 0; j < 16; ++j) { const unsigned c = xb_ld(&bar[XB_XCNT(j)]); sum += c; cnt += (c > 0u) ? 1u : 0u; mine = (j == x) ? c : mine; }
        if (sum == G) break;
        __builtin_amdgcn_s_sleep(1);
        if ((++sp & 255u) == 0u) { if (xb_ld(&bar[XB_TMO])) break; if (sp > XB_SPIN_CAP) { atomicAdd(&bar[XB_TMO], 1u); break; } }
    }
    nloc = mine > 0u ? mine : 1u; nx = cnt > 0u ? cnt : 1u;
}
__device__ __forceinline__ void xcd_barrier(unsigned* bar, LAS unsigned char* lds) {
    asm volatile("s_waitcnt vmcnt(0)" ::: "memory");
    __syncthreads();
    int tid_ = threadIdx.x; asm volatile("" : "+v"(tid_));
    if (tid_ == 0) {
        unsigned so = (unsigned)(LDS_BYTES - 576); asm volatile("" : "+v"(so));
        volatile LAS unsigned* st = (volatile LAS unsigned*)(lds + so);
        __builtin_amdgcn_s_waitcnt(0);
        const unsigned x = xb_xcc_id();
        unsigned nloc = st[0], nx = st[1];
        if (nloc == 0u) { xcd_barrier_complete(bar, x, nloc, nx); st[0] = nloc; st[1] = nx; }
        const unsigned old = xb_add(&bar[XB_XSUB(x)], 1u);
        const unsigned gen = old / nloc;
        if (old + 1u == (gen + 1u) * nloc) {
            __builtin_amdgcn_fence(__ATOMIC_RELEASE, "agent");
            asm volatile("s_waitcnt vmcnt(0)" ::: "memory");
            const unsigned og = xb_add(&bar[XB_TOP], 1u);
            const unsigned tg = og / nx;
            if (og + 1u == (tg + 1u) * nx) xb_add(&bar[XB_TOPGEN], 1u);
            else XB_SPIN(xb_ld(&bar[XB_TOPGEN]) == tg, bar);
            __builtin_amdgcn_fence(__ATOMIC_ACQUIRE, "agent");
            xb_add(&bar[XB_XGEN(x)], 1u);
            asm volatile("s_waitcnt vmcnt(0)" ::: "memory");
        } else {
            XB_SPIN(xb_ld(&bar[XB_XGEN(x)]) == gen, bar);
            __builtin_amdgcn_fence(__ATOMIC_ACQUIRE, "agent");
            asm volatile("s_waitcnt vmcnt(0)" ::: "memory");
        }
    }
    __syncthreads();
}
namespace cg = cooperative_groups;
__global__ void __launch_bounds__(NTHR, 2) fwd_all(Args args) {
    extern __shared__ __attribute__((aligned(16))) unsigned char lds_raw[];
    LAS unsigned char* lds = (LAS unsigned char*)lds_raw;
    unsigned* bar = (unsigned*)(args.ws + WS_CTL) + CW_BAR;
    if (threadIdx.x == 0) { ((volatile LAS unsigned*)(lds + LDS_BYTES - 576))[0] = 0u; ((volatile LAS unsigned*)(lds + LDS_BYTES - 576))[1] = 0u; (void)xb_add(&bar[XB_XCNT(xb_xcc_id())], 1u); }
    ptr_table_fill(args, lds);
    const int probe = args.ph_lo;
    { constexpr int l = 0;
#pragma unroll 1
      for (int r_ = 0; r_ < ((probe == -1) ? 2 : 1); ++r_) { phase_body<-1>(l, lds); __syncthreads(); } }
    cg::this_grid().sync();
#define GRID_BAR() do { unsigned* bar_ = (unsigned*)gptr(ldptr(lds, 36)) + CW_BAR; xcd_barrier(bar_, lds); } while (0)
#define RUN(SP) do { _Pragma("unroll 1") for (int r_ = 0; r_ < ((probe == (SP)) ? 2 : 1); ++r_) { phase_body<SP>(l, lds); __syncthreads(); } } while (0)
#define ONCE(SP) do { phase_body<SP>(l, lds); __syncthreads(); } while (0)
#define LAYER() \
        RUN(0); GRID_BAR(); \
        ONCE(15); GRID_BAR(); \
        ONCE(4); GRID_BAR(); \
        RUN(13); GRID_BAR(); \
        RUN(5); GRID_BAR(); \
        ONCE(6); GRID_BAR(); \
        ONCE(7); RUN(14); GRID_BAR(); \
        RUN(8); GRID_BAR(); \
        RUN(9); GRID_BAR(); \
        RUN(10); GRID_BAR(); \
        ONCE(11); GRID_BAR();
    { constexpr int l = 0; LAYER() }
    { constexpr int l = 1; LAYER() }
#undef LAYER
#undef RUN
#undef ONCE
#undef GRID_BAR
}

template <int SP> static void launch_phase(const Args& a, int l, int grid, hipStream_t stream) {
    static bool attr = false;
    if (!attr) { (void)hipFuncSetAttribute((const void*)k_phase<SP>, hipFuncAttributeMaxDynamicSharedMemorySize, LDS_BYTES); attr = true; }
    hipLaunchKernelGGL(k_phase<SP>, dim3(grid), dim3(NTHR), LDS_BYTES, stream, a, l);
}

extern "C" void kernel_launch(void* const* d_in, const int* in_sizes, int n_in, void* d_out, int out_size, void* d_ws, size_t ws_size, hipStream_t stream) {
    static int grid = 0;
    if (grid == 0) {
        if (n_in != 35 || out_size != M * D || ws_size < WS_END) { fprintf(stderr, "kernel_launch: unexpected problem (n_in %d out %d ws %zu)\n", n_in, out_size, ws_size); grid = -1; return; }
        int dev = 0, cus = 0, per_cu = 0;
        (void)hipGetDevice(&dev); (void)hipDeviceGetAttribute(&cus, hipDeviceAttributeMultiprocessorCount, dev);
#if N_LAUNCH_MODE == 1
        (void)hipFuncSetAttribute((const void*)fwd_all, hipFuncAttributeMaxDynamicSharedMemorySize, LDS_BYTES);
        if (hipOccupancyMaxActiveBlocksPerMultiprocessor(&per_cu, (const void*)fwd_all, NTHR, LDS_BYTES) != hipSuccess || per_cu < 1) { fprintf(stderr, "kernel_launch: occupancy query says %d blocks/CU\n", per_cu); grid = -1; return; }
#endif
        (void)per_cu;
        grid = cus;
        if (grid != 256) { fprintf(stderr, "kernel_launch: built for 256 CUs, found %d\n", cus); grid = -1; return; }
    }
    if (grid < 0) return;
    (void)hipMemsetAsync((char*)d_ws + WS_CTL, 0, CTL_BYTES, stream);
    Args a{};
    for (int i = 0; i < 35; ++i) a.in[i] = (const float*)d_in[i];
    a.out = (float*)d_out; a.ws = (unsigned char*)d_ws;
#if N_LAUNCH_MODE == 1
    a.ph_lo = PROBE_REPS;
    void* kargs[] = {(void*)&a};
    hipError_t e = hipLaunchCooperativeKernel((const void*)fwd_all, dim3(grid), dim3(NTHR), kargs, LDS_BYTES, stream);
    if (e != hipSuccess) fprintf(stderr, "cooperative launch failed: %s\n", hipGetErrorString(e));
#else
    launch_phase<-1>(a, 0, grid, stream);
    for (int l = 0; l < NL; ++l) {
        launch_phase<0>(a, l, grid, stream); launch_phase<15>(a, l, grid, stream); launch_phase<4>(a, l, grid, stream); launch_phase<13>(a, l, grid, stream);
        launch_phase<5>(a, l, grid, stream); launch_phase<6>(a, l, grid, stream); launch_phase<7>(a, l, grid, stream); launch_phase<14>(a, l, grid, stream);
        launch_phase<8>(a, l, grid, stream); launch_phase<9>(a, l, grid, stream); launch_phase<10>(a, l, grid, stream); launch_phase<11>(a, l, grid, stream);
    }
#endif
}
```

```cpp
#include <hip/hip_runtime.h>
#include <cstdio>
#include <cstdint>
#include <hip/hip_cooperative_groups.h>

#ifndef PROBE_REPS
#define PROBE_REPS -100
#endif
#ifndef N_LAUNCH_MODE
#define N_LAUNCH_MODE 1
#endif

namespace pg8 {
#define PG8_LAS __attribute__((address_space(3)))
typedef unsigned short bf16_t;
typedef short bf16x8 __attribute__((ext_vector_type(8)));
typedef float f32x4 __attribute__((ext_vector_type(4)));
typedef unsigned u32x4 __attribute__((ext_vector_type(4)));
constexpr int BM = 256, BK = 64, HALF = 128, HTB = HALF * BK * 2, STAGE_BYTES = 8 * HTB, NXCD = 8, WGM = 8;

__host__ __device__ __forceinline__ int lds_byte(int r, int c) { const int st = (r >> 4) * 2 + (c >> 5), rr = r & 15, cc = c & 31, ob = rr * 64 + cc * 2; return st * 1024 + (ob ^ (((ob >> 9) & 1) << 5)); }
__host__ __device__ __forceinline__ void stage_rc(int b, int& R, int& C) { const int st = b / 1024, sb = b % 1024, swz = sb ^ (((sb >> 9) & 1) << 5); R = (st >> 1) * 16 + swz / 64; C = (st & 1) * 32 + (swz % 64) / 2; }
__host__ __device__ __forceinline__ int perm32(int rho) { const int n = rho >> 4, i = rho & 15; return 8 * (i >> 2) + 4 * n + (i & 3); }

struct Unit { int pm, pn, aux; size_t aoff, boff; };
struct Gemm { const bf16_t* A; const bf16_t* Bt; int lda, ldb, K; };

__device__ __forceinline__ void tile_of(int L, int nM, int nN, int& pm, int& pn) {
    const int nwg = nM * nN; int wgid = L;
    { const int q = nwg / NXCD, r = nwg % NXCD, xcd = wgid % NXCD, off = wgid / NXCD; wgid = (xcd < r ? xcd * (q + 1) : r * (q + 1) + (xcd - r) * q) + off; }
    const int nig = WGM * nN, gid = wgid / nig, fm = gid * WGM, gsz = (nM - fm) < WGM ? (nM - fm) : WGM;
    pm = fm + ((wgid % nig) % gsz); pn = (wgid % nig) / gsz;
}
struct StaticOrder {
    int nM, nN, nwg, G, c, lda, ldb;
    __device__ void init(int M, int N, int G_, int c_, int lda_, int ldb_) { nM = M / BM; nN = N / BM; nwg = nM * nN; G = G_; c = c_; lda = lda_; ldb = ldb_; }
    __device__ bool next(int i, Unit& u) const {
        const long L = (long)i * G + c; if (L >= nwg) return false;
        tile_of((int)L, nM, nN, u.pm, u.pn); u.aux = 0;
        u.aoff = (size_t)u.pm * BM * lda * 2; u.boff = (size_t)u.pn * BM * ldb * 2; return true;
    }
};

__device__ __forceinline__ unsigned cvt_pk_bf16(float lo, float hi) { unsigned r; asm volatile("s_nop 1\n\tv_cvt_pk_bf16_f32 %0, %1, %2" : "=v"(r) : "v"(lo), "v"(hi)); return r; }
__device__ __forceinline__ void epi_mfma_settle(const f32x4 (&acc)[2][2][4][2]) {
    asm volatile("s_nop 11" :: "v"(acc[1][0][0][0]), "v"(acc[1][0][0][1]), "v"(acc[1][0][1][0]), "v"(acc[1][0][1][1]), "v"(acc[1][0][2][0]), "v"(acc[1][0][2][1]), "v"(acc[1][0][3][0]), "v"(acc[1][0][3][1]),
                                "v"(acc[1][1][0][0]), "v"(acc[1][1][0][1]), "v"(acc[1][1][1][0]), "v"(acc[1][1][1][1]), "v"(acc[1][1][2][0]), "v"(acc[1][1][2][1]), "v"(acc[1][1][3][0]), "v"(acc[1][1][3][1]) : "memory"); }

template <class Epi, class Sched, bool ALIGN_EPI = true, bool SP2 = true>
__device__ __forceinline__ void gemm_phase(PG8_LAS unsigned char* lds, const Gemm g, const Sched& S, const Epi& E) {
    int tid_ = threadIdx.x; asm volatile("" : "+v"(tid_));
    const int tid = tid_, wid = __builtin_amdgcn_readfirstlane(tid >> 6), lane = tid & 63, wr = wid >> 2, wc = wid & 3, fr = lane & 15, fq = lane >> 4;
    const int K = g.K, nt = K / BK;
    unsigned voffA[2], voffB[2];
#pragma unroll
    for (int i = 0; i < 2; ++i) { int R, C; stage_rc(tid * 16 + i * 8192, R, C); const int Rb = Epi::PERM ? ((R & ~31) + perm32(R & 31)) : R;
        voffA[i] = (unsigned)(R * g.lda + C) * 2u; voffB[i] = (unsigned)(Rb * g.ldb + C) * 2u; }
    const size_t kstep = (size_t)(BK * 2);
    const size_t hstepA = (size_t)HALF * g.lda * 2, hstepB = (size_t)HALF * g.ldb * 2;
    const unsigned ldsw = (unsigned)wid * 1024u;
    const int aoff = lds_byte(wr * 64 + fr, fq * 8), boff = lds_byte(wc * 32 + fr, fq * 8);
#define PG8_SA(b, h) (((b) * 2 + (h)) * HTB)
#define PG8_SB(b, h) ((4 + (b) * 2 + (h)) * HTB)
#define PG8_STAGE(bufoff, gbase, voff) do { _Pragma("unroll") for (int _i = 0; _i < 2; ++_i) \
        __builtin_amdgcn_global_load_lds((const unsigned*)((const char*)(gbase) + (voff)[_i]), (PG8_LAS unsigned*)(lds + (bufoff) + ldsw + _i * 8192), 16, 0, 0); } while (0)
#define PG8_LDA(dst, b, h) do { _Pragma("unroll") for (int m = 0; m < 4; ++m) _Pragma("unroll") for (int k = 0; k < 2; ++k) dst[m][k] = *(const PG8_LAS bf16x8*)(lds + PG8_SA(b, h) + aoff + m * 2048 + k * 1024); } while (0)
#define PG8_LDB(dst, b, h) do { _Pragma("unroll") for (int n = 0; n < 2; ++n) _Pragma("unroll") for (int k = 0; k < 2; ++k) dst[n][k] = *(const PG8_LAS bf16x8*)(lds + PG8_SB(b, h) + boff + n * 2048 + k * 1024); } while (0)
#define PG8_MMA(ai, bj, At, Bt) do { __builtin_amdgcn_s_setprio(1); _Pragma("unroll") for (int m = 0; m < 4; ++m) _Pragma("unroll") for (int n = 0; n < 2; ++n) _Pragma("unroll") for (int k = 0; k < 2; ++k) \
        acc[ai][bj][m][n] = __builtin_amdgcn_mfma_f32_16x16x32_bf16(Bt[n][k], At[m][k], acc[ai][bj][m][n], 0, 0, 0); __builtin_amdgcn_s_setprio(0); } while (0)
#define PG8_WAIT_V(n) asm volatile("s_waitcnt vmcnt(" #n ")" ::: "memory")
#define PG8_WAIT_L(n) asm volatile("s_waitcnt lgkmcnt(" #n ")" ::: "memory")
#define PG8_BAR __builtin_amdgcn_s_barrier()
#define PG8_SCHED __builtin_amdgcn_sched_barrier(0)
    Unit cur, nxt; int ui = 0;
    if (!S.next(0, cur)) return;
    f32x4 acc[2][2][4][2];
#pragma unroll
    for (int a = 0; a < 2; ++a)
#pragma unroll
        for (int b = 0; b < 2; ++b)
#pragma unroll
            for (int m = 0; m < 4; ++m)
#pragma unroll
                for (int n = 0; n < 2; ++n) acc[a][b][m][n] = (f32x4){0.f, 0.f, 0.f, 0.f};
    bf16x8 At[4][2], B0[2][2], B1[2][2];
    const char* cA = (const char*)g.A + cur.aoff; const char* cB = (const char*)g.Bt + cur.boff;
    if constexpr (SP2) {
        PG8_STAGE(PG8_SB(0, 0), cB, voffB); PG8_STAGE(PG8_SB(0, 1), cB + hstepB, voffB); PG8_STAGE(PG8_SA(0, 0), cA, voffA); PG8_STAGE(PG8_SA(0, 1), cA + hstepA, voffA);
        if (wr == 1) PG8_BAR;
        PG8_WAIT_V(2); PG8_BAR;
        PG8_STAGE(PG8_SB(1, 0), cB + kstep, voffB); PG8_STAGE(PG8_SA(1, 0), cA + kstep, voffA); PG8_STAGE(PG8_SB(1, 1), cB + hstepB + kstep, voffB);
        PG8_WAIT_V(6); PG8_BAR;
    } else {
        PG8_STAGE(PG8_SB(0, 0), cB, voffB); PG8_STAGE(PG8_SA(0, 0), cA, voffA); PG8_STAGE(PG8_SB(0, 1), cB + hstepB, voffB); PG8_STAGE(PG8_SA(0, 1), cA + hstepA, voffA);
        if (wr == 1) PG8_BAR;
        PG8_WAIT_V(4); PG8_BAR;
        PG8_STAGE(PG8_SB(1, 0), cB + kstep, voffB); PG8_STAGE(PG8_SA(1, 0), cA + kstep, voffA); PG8_STAGE(PG8_SB(1, 1), cB + hstepB + kstep, voffB);
        PG8_WAIT_V(6); PG8_BAR;
    }
    for (;;) {
        const bool has_next = S.next(ui + 1, nxt);
        const char* nA = has_next ? (const char*)g.A + nxt.aoff : cA; const char* nB = has_next ? (const char*)g.Bt + nxt.boff : cB;
#pragma unroll 1
        for (int t = 0; t < nt; t += 2) {
            const bool last = (t == nt - 2);
            const char* a1 = cA + (size_t)(t + 1) * kstep;
            const char* a2 = last ? nA : cA + (size_t)(t + 2) * kstep; const char* b2 = last ? nB : cB + (size_t)(t + 2) * kstep;
            const char* a3 = a2 + kstep; const char* b3 = b2 + kstep;
            if constexpr (SP2) {
            PG8_LDB(B0, 0, 0); PG8_LDB(B1, 0, 1); PG8_SCHED; PG8_LDA(At, 0, 0); PG8_STAGE(PG8_SA(1, 1), a1 + hstepA, voffA);
            PG8_WAIT_V(8); PG8_WAIT_L(0); PG8_BAR; PG8_MMA(0, 0, At, B0); PG8_MMA(0, 1, At, B1); PG8_BAR; PG8_SCHED;
            PG8_LDA(At, 0, 1); PG8_STAGE(PG8_SB(0, 0), b2, voffB); PG8_STAGE(PG8_SB(0, 1), b2 + hstepB, voffB); PG8_STAGE(PG8_SA(0, 0), a2, voffA);
            PG8_WAIT_V(8); PG8_WAIT_L(0); PG8_BAR; PG8_MMA(1, 0, At, B0); PG8_MMA(1, 1, At, B1); PG8_BAR; PG8_SCHED;
            PG8_LDB(B0, 1, 0); PG8_LDB(B1, 1, 1); PG8_SCHED; PG8_LDA(At, 1, 0); PG8_STAGE(PG8_SA(0, 1), a2 + hstepA, voffA);
            PG8_WAIT_V(8); PG8_WAIT_L(0); PG8_BAR; PG8_MMA(0, 0, At, B0); PG8_MMA(0, 1, At, B1); PG8_BAR; PG8_SCHED;
            PG8_LDA(At, 1, 1); PG8_STAGE(PG8_SB(1, 0), b3, voffB); PG8_STAGE(PG8_SB(1, 1), b3 + hstepB, voffB); PG8_STAGE(PG8_SA(1, 0), a3, voffA);
            PG8_WAIT_V(8); PG8_WAIT_L(0); PG8_BAR; PG8_MMA(1, 0, At, B0); PG8_MMA(1, 1, At, B1); PG8_BAR; PG8_SCHED;
            } else {
            PG8_LDB(B0, 0, 0); PG8_SCHED; PG8_LDA(At, 0, 0); PG8_STAGE(PG8_SA(1, 1), a1 + hstepA, voffA);
            PG8_WAIT_L(8); PG8_BAR; PG8_WAIT_L(0); PG8_MMA(0, 0, At, B0); PG8_BAR; PG8_SCHED;
            PG8_LDB(B1, 0, 1); PG8_STAGE(PG8_SB(0, 0), b2, voffB);
            PG8_BAR; PG8_WAIT_L(0); PG8_MMA(0, 1, At, B1); PG8_BAR;
            PG8_LDA(At, 0, 1); PG8_STAGE(PG8_SA(0, 0), a2, voffA);
            PG8_BAR; PG8_WAIT_L(0); PG8_MMA(1, 0, At, B0); PG8_BAR; PG8_SCHED;
            PG8_STAGE(PG8_SB(0, 1), b2 + hstepB, voffB);
            PG8_WAIT_V(6); PG8_BAR; PG8_MMA(1, 1, At, B1); PG8_BAR;
            PG8_LDB(B0, 1, 0); PG8_SCHED; PG8_LDA(At, 1, 0); PG8_STAGE(PG8_SA(0, 1), a2 + hstepA, voffA);
            PG8_WAIT_L(8); PG8_BAR; PG8_WAIT_L(0); PG8_MMA(0, 0, At, B0); PG8_BAR; PG8_SCHED;
            PG8_LDB(B1, 1, 1); PG8_STAGE(PG8_SB(1, 0), b3, voffB);
            PG8_BAR; PG8_WAIT_L(0); PG8_MMA(0, 1, At, B1); PG8_BAR;
            PG8_LDA(At, 1, 1); PG8_STAGE(PG8_SA(1, 0), a3, voffA);
            PG8_BAR; PG8_WAIT_L(0); PG8_MMA(1, 0, At, B0); PG8_BAR; PG8_SCHED;
            PG8_STAGE(PG8_SB(1, 1), b3 + hstepB, voffB);
            PG8_WAIT_V(6); PG8_BAR; PG8_MMA(1, 1, At, B1); PG8_BAR;
            }
        }
        if constexpr (ALIGN_EPI) { if (wr == 0) PG8_BAR; }
        E(acc, cur, wr, wc, fr, fq);
        if (!has_next) break;
#pragma unroll
        for (int a = 0; a < 2; ++a)
#pragma unroll
            for (int b = 0; b < 2; ++b)
#pragma unroll
                for (int m = 0; m < 4; ++m)
#pragma unroll
                    for (int n = 0; n < 2; ++n) acc[a][b][m][n] = (f32x4){0.f, 0.f, 0.f, 0.f};
        cur = nxt; cA = nA; cB = nB; ++ui;
        if constexpr (ALIGN_EPI) { if (wr == 1) PG8_BAR; }
    }
    PG8_WAIT_V(0);
    if constexpr (!ALIGN_EPI) { if (wr == 0) PG8_BAR; }
    PG8_BAR;
#undef PG8_SA
#undef PG8_SB
#undef PG8_STAGE
#undef PG8_LDA
#undef PG8_LDB
#undef PG8_MMA
#undef PG8_WAIT_V
#undef PG8_WAIT_L
#undef PG8_BAR
#undef PG8_SCHED
}
}

#define LAS __attribute__((address_space(3)))
typedef unsigned short bf16;
typedef float f32x4 __attribute__((ext_vector_type(4)));
typedef unsigned u32x4 __attribute__((ext_vector_type(4)));
typedef unsigned u32x2 __attribute__((ext_vector_type(2)));

constexpr int NB = 8, T = 4096, D = 1024, M = NB * T, NL = 2;
constexpr int INW = 9160;
constexpr int PP = 5120;
constexpr int C_AQ = 0, C_AK = 768, C_AV = 1536, C_BQ = 2304, C_BK = 2560, C_BV = 2816, C_IQ = 3072, C_IK = 3328, C_C = 3392, C_DZ = 4288, C_DX = 4544, C_IW = 5056, C_DT = 5060, C_END = 5064;
constexpr int NEXP = 32, DEXP = 512;
constexpr int CAP = 73728;
constexpr float LN_EPS = 1e-5f;
constexpr float ALPHA = 1.4142135623730951f;

constexpr size_t MiB = 1u << 20;
constexpr size_t WS_CTL = 0, CTL_BYTES = 1 * MiB;
constexpr size_t WS_WINT = 2 * MiB;
constexpr size_t WS_WGT = 22 * MiB;
constexpr size_t WS_WBRT = 38 * MiB;
constexpr size_t WS_WOUTT = 42 * MiB;
constexpr size_t WS_WRT = 46 * MiB;
constexpr size_t WS_ROUTE = 47 * MiB;
constexpr size_t WS_XB = 48 * MiB;
constexpr size_t WS_O = 112 * MiB;
constexpr size_t WS_VF = 176 * MiB;
constexpr size_t WS_P = 192 * MiB;
constexpr size_t WS_GS = 192 * MiB;
constexpr size_t WS_MERGED = 448 * MiB;
constexpr size_t WS_XS = 192 * MiB;
constexpr size_t WS_H = 336 * MiB;
constexpr size_t WS_WGU = 408 * MiB;
constexpr size_t WS_WD = 472 * MiB;
constexpr size_t WS_RW = 512 * MiB;
constexpr size_t WS_RW2 = 544 * MiB;
constexpr size_t WS_BONG = 46 * MiB + 512 * 1024;
constexpr size_t WS_END = 592 * MiB;
constexpr int CW_CNT = 64, CW_Q = 256, CW_BAR = 4096;

constexpr int RING_BYTES = 131072, MISC_OFF = RING_BYTES, LDS_BYTES = 147456;
constexpr int NWAVES = 8, NTHR = 512;

__device__ __forceinline__ float bf2f(bf16 v) { return __uint_as_float(((unsigned)v) << 16); }
__device__ __forceinline__ unsigned pk2(float lo, float hi) { unsigned r; asm volatile("s_nop 1\n\tv_cvt_pk_bf16_f32 %0, %1, %2" : "=v"(r) : "v"(lo), "v"(hi)); return r; }
__device__ __forceinline__ unsigned f2bf(float f) { unsigned u = __float_as_uint(f); return (u + 0x7fffu + ((u >> 16) & 1u)) >> 16; }
#define DPP_ADD(v, ctrl) v += __builtin_bit_cast(float, __builtin_amdgcn_update_dpp(0, __builtin_bit_cast(int, v), ctrl, 0xF, 0xF, true))
#define DPP_MAX(v, ctrl) v = fmaxf(v, __builtin_bit_cast(float, __builtin_amdgcn_update_dpp(0, __builtin_bit_cast(int, v), ctrl, 0xF, 0xF, true)))
__device__ __forceinline__ float wave_sum(float v) {
    DPP_ADD(v, 0xB1); DPP_ADD(v, 0x4E); DPP_ADD(v, 0x141); DPP_ADD(v, 0x140);
    v += __shfl_xor(v, 16); v += __shfl_xor(v, 32);
    return v;
}
__device__ __forceinline__ float wave_max(float v) {
    DPP_MAX(v, 0xB1); DPP_MAX(v, 0x4E); DPP_MAX(v, 0x141); DPP_MAX(v, 0x140);
    v = fmaxf(v, __shfl_xor(v, 16)); v = fmaxf(v, __shfl_xor(v, 32));
    return v;
}
__device__ __forceinline__ float sigmoid_div_(float x) { return 1.f / (1.f + __expf(-x)); }
__device__ __forceinline__ float sigmoidf_(float x) { return __builtin_amdgcn_rcpf(1.f + __expf(-x)); }
__device__ __forceinline__ float softplusf_(float x) { return x > 20.f ? x : __logf(1.f + __expf(x)); }
__device__ __forceinline__ float tanhf_(float x) { const float e = __expf(-2.f * fabsf(x)); const float t = (1.f - e) * __builtin_amdgcn_rcpf(1.f + e); return x < 0.f ? -t : t; }
__device__ __forceinline__ float siluf_(float x) { return x * __builtin_amdgcn_rcpf(1.f + __expf(-x)); }

struct Args { const float* in[35]; float* out; unsigned char* ws; int ph_lo, ph_hi; };
enum { I_X = 0, I_WIN, I_CMU, I_CW0, I_CW2, I_CA0, I_CA2, I_CG2, I_CKK, I_CKA, I_CRK, I_CGNW, I_CGNB, I_CV0, I_CV1, I_CV2, I_DCW, I_DCB, I_DDTB, I_DALOG, I_DSKIP, I_DNW,
       I_WBR, I_WOUT, I_LN1G, I_LN1B, I_RG, I_RGB, I_RE, I_REB, I_EG, I_EU, I_ED, I_LN2G, I_LN2B };

__device__ __forceinline__ void transpose_item(const float* W, int ldn, int c0, int ncols, bf16* dst, int dld, int r0, int dk0, int kb, int nb, LAS float* scr, int lane) {
    const int k0 = 64 * kb, n0 = 32 * nb;
    const bool okn = (n0 + (lane & 31)) < ncols;
    float tv[32];
#pragma unroll
    for (int i = 0; i < 32; ++i) { const int kk = 2 * i + (lane >> 5); tv[i] = okn ? W[(size_t)(k0 + kk) * ldn + c0 + n0 + (lane & 31)] : 0.f; }
#pragma unroll
    for (int i = 0; i < 32; ++i) { const int kk = 2 * i + (lane >> 5); scr[kk * 33 + (lane & 31)] = tv[i]; }
    asm volatile("s_waitcnt lgkmcnt(0)" ::: "memory");
    const int c = lane & 7;
#pragma unroll
    for (int j = 0; j < 4; ++j) { const int n = (lane >> 3) + 8 * j; const LAS float* s = scr + (8 * c) * 33 + n;
        u32x4 o; o.x = pk2(s[0 * 33], s[1 * 33]); o.y = pk2(s[2 * 33], s[3 * 33]); o.z = pk2(s[4 * 33], s[5 * 33]); o.w = pk2(s[6 * 33], s[7 * 33]);
        if (n0 + n < ncols) *(u32x4*)(dst + (size_t)(r0 + n0 + n) * dld + dk0 + k0 + 8 * c) = o; }
    asm volatile("s_waitcnt lgkmcnt(0)" ::: "memory");
}

struct EpiStoreBf16 {
    static constexpr bool PERM = true;
    bf16* O; int ldc; int act; int ncols;
    __device__ __forceinline__ void operator()(const pg8::f32x4 (&acc)[2][2][4][2], const pg8::Unit& u, int wr, int wc, int fr, int fq) const {
        pg8::epi_mfma_settle(acc);
        const int row0 = u.pm * 256 + wr * 64 + fr; const int col0 = u.pn * 256 + wc * 32 + 8 * fq;
#pragma unroll
        for (int ai = 0; ai < 2; ++ai)
#pragma unroll
            for (int m = 0; m < 4; ++m) { bf16* rowp = O + (size_t)(row0 + ai * 128 + m * 16) * ldc + col0;
#pragma unroll
                for (int bj = 0; bj < 2; ++bj) { pg8::f32x4 v0 = acc[ai][bj][m][0], v1 = acc[ai][bj][m][1];
                    if (act == 1) {
#pragma unroll
                        for (int j = 0; j < 4; ++j) { v0[j] = sigmoidf_(v0[j]); v1[j] = sigmoidf_(v1[j]); } }
                    u32x4 w; w.x = pg8::cvt_pk_bf16(v0[0], v0[1]); w.y = pg8::cvt_pk_bf16(v0[2], v0[3]); w.z = pg8::cvt_pk_bf16(v1[0], v1[1]); w.w = pg8::cvt_pk_bf16(v1[2], v1[3]);
                    if (col0 + bj * 128 < ncols) *(u32x4*)(rowp + bj * 128) = w; } }
    }
};
struct EpiBranch {
    static constexpr bool PERM = true;
    const bf16* GS; bf16* MG;
    __device__ __forceinline__ void operator()(const pg8::f32x4 (&acc)[2][2][4][2], const pg8::Unit& u, int wr, int wc, int fr, int fq) const {
        pg8::epi_mfma_settle(acc);
        const int n = u.aux;
        const bf16* gbase = GS + (size_t)(u.pm * 256 + wr * 64 + fr) * 4096 + n * 1024 + u.pn * 256 + wc * 32 + 8 * fq;
        bf16* mbase = MG + (size_t)(u.pm * 256 + wr * 64 + fr) * 1024 + u.pn * 256 + wc * 32 + 8 * fq;
#pragma unroll
        for (int ai = 0; ai < 2; ++ai)
#pragma unroll
            for (int m = 0; m < 4; ++m) {
#pragma unroll
                for (int bj = 0; bj < 2; ++bj) {
                    const u32x4 gv = *(const u32x4*)(gbase + (size_t)(ai * 128 + m * 16) * 4096 + bj * 128);
                    bf16* mp = mbase + (size_t)(ai * 128 + m * 16) * 1024 + bj * 128;
                    u32x4 ov = (u32x4){0u, 0u, 0u, 0u}; if (n != 0) ov = *(const u32x4*)mp;
                    const pg8::f32x4 a0 = acc[ai][bj][m][0], a1 = acc[ai][bj][m][1];
                    u32x4 w;
                    w.x = pg8::cvt_pk_bf16(a0[0] * __uint_as_float(gv.x << 16) + __uint_as_float(ov.x << 16), a0[1] * __uint_as_float(gv.x & 0xffff0000u) + __uint_as_float(ov.x & 0xffff0000u));
                    w.y = pg8::cvt_pk_bf16(a0[2] * __uint_as_float(gv.y << 16) + __uint_as_float(ov.y << 16), a0[3] * __uint_as_float(gv.y & 0xffff0000u) + __uint_as_float(ov.y & 0xffff0000u));
                    w.z = pg8::cvt_pk_bf16(a1[0] * __uint_as_float(gv.z << 16) + __uint_as_float(ov.z << 16), a1[1] * __uint_as_float(gv.z & 0xffff0000u) + __uint_as_float(ov.z & 0xffff0000u));
                    w.w = pg8::cvt_pk_bf16(a1[2] * __uint_as_float(gv.w << 16) + __uint_as_float(ov.w << 16), a1[3] * __uint_as_float(gv.w & 0xffff0000u) + __uint_as_float(ov.w & 0xffff0000u));
                    *(u32x4*)mp = w; asm volatile("" ::: "memory"); } }
    }
};
struct EpiResid {
    static constexpr bool PERM = false;
    float* X;
    __device__ __forceinline__ void operator()(const pg8::f32x4 (&acc)[2][2][4][2], const pg8::Unit& u, int wr, int wc, int fr, int fq) const {
        pg8::epi_mfma_settle(acc);
        const int row0 = u.pm * 256 + wr * 64 + fr, col0 = u.pn * 256 + wc * 32 + 4 * fq;
#pragma unroll
        for (int ai = 0; ai < 2; ++ai)
#pragma unroll
            for (int m = 0; m < 4; ++m) { float* rowp = X + (size_t)(row0 + ai * 128 + m * 16) * D + col0;
#pragma unroll
                for (int bj = 0; bj < 2; ++bj)
#pragma unroll
                    for (int n = 0; n < 2; ++n) { pg8::f32x4* p = (pg8::f32x4*)(rowp + bj * 128 + n * 16); *p = *p * ALPHA + acc[ai][bj][m][n]; } }
    }
};
struct EpiSwiglu {
    static constexpr bool PERM = true;
    bf16* H;
    __device__ __forceinline__ void operator()(const pg8::f32x4 (&acc)[2][2][4][2], const pg8::Unit& u, int wr, int wc, int fr, int fq) const {
        pg8::epi_mfma_settle(acc);
        const int row0 = u.pm * 256 + wr * 64 + fr; const int col0 = u.pn * 128 + wc * 32 + 8 * fq;
#pragma unroll
        for (int ai = 0; ai < 2; ++ai)
#pragma unroll
            for (int m = 0; m < 4; ++m) { bf16* rowp = H + (size_t)(row0 + ai * 128 + m * 16) * DEXP + col0;
                float v[8];
#pragma unroll
                for (int j = 0; j < 4; ++j) { v[j] = siluf_(acc[ai][0][m][0][j]) * acc[ai][1][m][0][j]; v[4 + j] = siluf_(acc[ai][0][m][1][j]) * acc[ai][1][m][1][j]; }
                u32x4 w; w.x = pg8::cvt_pk_bf16(v[0], v[1]); w.y = pg8::cvt_pk_bf16(v[2], v[3]); w.z = pg8::cvt_pk_bf16(v[4], v[5]); w.w = pg8::cvt_pk_bf16(v[6], v[7]);
                *(u32x4*)rowp = w; }
    }
};

struct SkewOrder {
    int nM, nN, nwg, c, lda, ldb;
    __device__ bool next(int i, pg8::Unit& u) const {
        long L;
        if (i < 5) L = (long)i * 256 + c; else { if (c < 32) return false; L = 1280 + (long)(i - 5) * 224 + (c - 32); }
        if (L >= nwg) return false;
        pg8::tile_of((int)L, nM, nN, u.pm, u.pn); u.aux = 0;
        u.aoff = (size_t)u.pm * 256 * lda * 2; u.boff = (size_t)u.pn * 256 * ldb * 2; return true;
    }
};
struct BranchOrder {
    int nM, nN, G, c;
    __device__ bool next(int i, pg8::Unit& u) const {
        const int tl = (i >> 2) * G + c; if (tl >= nM * nN) return false;
        pg8::tile_of(tl, nM, nN, u.pm, u.pn); u.aux = i & 3;
        u.aoff = ((size_t)u.pm * 256 * 1024 + (size_t)u.aux * 256) * 2; u.boff = ((size_t)u.pn * 256 * 1024 + (size_t)u.aux * 256) * 2; return true;
    }
};
struct MoeOrder {
    const volatile LAS int* tb; int G, c; size_t a_rowbytes, b_expbytes, b_tilebytes;
    __device__ bool next(int i, pg8::Unit& u) const {
        const int L = i * G + c; const int total = __builtin_amdgcn_readfirstlane(tb[32]) * 4; if (L >= total) return false;
        int e = 0;
#pragma unroll 1
        for (int k = 0; k < 32; ++k) if (L >= tb[k + 1] * 4) e = k + 1;
        const int nte = tb[e + 1] - tb[e]; const int r = L - tb[e] * 4; const int ct = r / nte, rt = r % nte;
        u.pm = __builtin_amdgcn_readfirstlane(tb[33 + e] + rt); u.pn = __builtin_amdgcn_readfirstlane(ct); u.aux = __builtin_amdgcn_readfirstlane(e);
        u.aoff = (size_t)u.pm * 256 * a_rowbytes; u.boff = (size_t)u.aux * b_expbytes + (size_t)u.pn * b_tilebytes; return true;
    }
};

constexpr int PTR_OFF = LDS_BYTES - 512;
__device__ __forceinline__ void ptr_table_fill(const Args& args, LAS unsigned char* lds) {
    if (threadIdx.x == 0) {
        volatile LAS unsigned long long* t = (volatile LAS unsigned long long*)(lds + PTR_OFF);
#define PT_(i) t[i] = (unsigned long long)args.in[i];
        PT_(0) PT_(1) PT_(2) PT_(3) PT_(4) PT_(5) PT_(6) PT_(7) PT_(8) PT_(9) PT_(10) PT_(11) PT_(12) PT_(13) PT_(14) PT_(15) PT_(16) PT_(17) PT_(18) PT_(19)
        PT_(20) PT_(21) PT_(22) PT_(23) PT_(24) PT_(25) PT_(26) PT_(27) PT_(28) PT_(29) PT_(30) PT_(31) PT_(32) PT_(33) PT_(34)
#undef PT_
        t[35] = (unsigned long long)args.out; t[36] = (unsigned long long)args.ws; t[37] = (unsigned long long)(unsigned)args.ph_lo;
    }
    __syncthreads();
}
__device__ __forceinline__ unsigned long long ldptr(LAS unsigned char* lds, int i) {
    unsigned a = (unsigned)(PTR_OFF + 8 * i); asm volatile("" : "+v"(a));
    const volatile LAS unsigned* t = (const volatile LAS unsigned*)(lds + a);
    const unsigned lo = __builtin_amdgcn_readfirstlane(t[0]), hi = __builtin_amdgcn_readfirstlane(t[1]);
    return ((unsigned long long)hi << 32) | lo;
}
__device__ __forceinline__ void* gptr(unsigned long long v) { return (void*)(__attribute__((address_space(1))) void*)v; }
#define INP(i) ((const float*)gptr(ldptr(lds, (i))))
namespace rw {
typedef short bf16x8 __attribute__((ext_vector_type(8)));
typedef float f4 __attribute__((ext_vector_type(4)));
constexpr int LS = 72;
constexpr int MB = 64 * LS * 2;
constexpr int O_AHN = 0, O_RHN = MB, O_BCN = 2 * MB, O_KCN = 3 * MB, O_AHT = 4 * MB, O_BTT = 5 * MB, O_KTT = 6 * MB, O_VT = 7 * MB, O_STT = 8 * MB,
              O_MAK = 9 * MB, O_MRB = 10 * MB, O_MRK = 11 * MB, O_TINV = 12 * MB, O_MABF = 13 * MB, O_GAM = 13 * MB + 16384, O_CT = O_GAM + 256, O_BON = O_CT + 4608, O_END = O_BON + 256;
constexpr int O_MVT = O_BCN, O_A2N = O_AHN, O_UT = O_KCN, O_YF = O_AHT;
constexpr int O_TAB = O_MAK, O_SCR = O_TAB + 26624, O_TOT = O_SCR + 8 * 1024, O_CUM = O_TOT + 2048;
static_assert(O_CUM + 16384 <= O_GAM && O_END <= LDS_BYTES - 576, "rwkv LDS map");

__device__ __forceinline__ bf16x8 ldfrag(const LAS unsigned char* lds, int off, int r0, int ks, int lane) {
    return *(const LAS bf16x8*)(lds + off + ((r0 + (lane & 15)) * LS + ks * 32 + (lane >> 4) * 8) * 2);
}
__device__ __forceinline__ void mm64(f4 (&acc)[2], const LAS unsigned char* lds, int offA, int offBt, int w, int lane) {
    const int tr = w >> 1; const bf16x8 a0 = ldfrag(lds, offA, tr * 16, 0, lane), a1 = ldfrag(lds, offA, tr * 16, 1, lane);
#pragma unroll
    for (int c = 0; c < 2; ++c) { const int tc = (w & 1) * 2 + c; const bf16x8 b0 = ldfrag(lds, offBt, tc * 16, 0, lane), b1 = ldfrag(lds, offBt, tc * 16, 1, lane);
        acc[c] = __builtin_amdgcn_mfma_f32_16x16x32_bf16(a0, b0, acc[c], 0, 0, 0); acc[c] = __builtin_amdgcn_mfma_f32_16x16x32_bf16(a1, b1, acc[c], 0, 0, 0); }
}
__device__ __forceinline__ void storeT(LAS unsigned char* lds, int off, const f4 (&acc)[2], int w, int lane) {
    asm volatile("s_nop 11" :: "v"(acc[0]), "v"(acc[1]));
#pragma unroll
    for (int c = 0; c < 2; ++c) { const int col = ((w & 1) * 2 + c) * 16 + (lane & 15), row = (w >> 1) * 16 + 4 * (lane >> 4);
        u32x2 v; v.x = pk2(acc[c][0], acc[c][1]); v.y = pk2(acc[c][2], acc[c][3]); *(LAS u32x2*)(lds + off + (col * LS + row) * 2) = v; }
}
template <int MASK  >
__device__ __forceinline__ void storeN(LAS unsigned char* lds, int off, const f4 (&acc)[2], int w, int lane) {
    asm volatile("s_nop 11" :: "v"(acc[0]), "v"(acc[1]));
#pragma unroll
    for (int c = 0; c < 2; ++c) { const int col = ((w & 1) * 2 + c) * 16 + (lane & 15), row = (w >> 1) * 16 + 4 * (lane >> 4);
#pragma unroll
        for (int e = 0; e < 4; ++e) { float x = acc[c][e]; if (MASK == 1) x = (col < row + e) ? x : 0.f; if (MASK == 2) x = (col <= row + e) ? x : 0.f;
            *(LAS bf16*)(lds + off + ((row + e) * LS + col) * 2) = (bf16)f2bf(x); } }
}
typedef __bf16 bf2v __attribute__((ext_vector_type(2)));
__device__ __forceinline__ float dot2(unsigned x, unsigned y, float c) { return __builtin_amdgcn_fdot2_f32_bf16(__builtin_bit_cast(bf2v, x), __builtin_bit_cast(bf2v, y), c, false); }
#define RW_ZERO(a) do { a[0] = (f4){0.f, 0.f, 0.f, 0.f}; a[1] = (f4){0.f, 0.f, 0.f, 0.f}; } while (0)

__device__ __forceinline__ void build_ct(LAS unsigned char* lds0, const int l, const int h, const int lane, const int wave) {
    LAS unsigned char* const& lds = lds0; const int c = h * 64 + lane;
    const float* mu = INP(I_CMU) + (size_t)l * 896;
    if (wave == 0) { LAS float* ct = (LAS float*)(lds0 + O_CT);
        ct[0 * 64 + lane] = mu[c]; ct[1 * 64 + lane] = mu[256 + c]; ct[2 * 64 + lane] = mu[512 + c]; ct[3 * 64 + lane] = mu[768 + lane]; ct[4 * 64 + lane] = mu[832 + lane];
        ct[5 * 64 + lane] = INP(I_CW0)[l * 256 + c]; ct[6 * 64 + lane] = INP(I_CA0)[l * 256 + c]; ct[7 * 64 + lane] = INP(I_CKK)[l * 256 + c]; ct[8 * 64 + lane] = INP(I_CKA)[l * 256 + c];
        ct[9 * 64 + lane] = INP(I_CRK)[l * 256 + c]; ct[10 * 64 + lane] = INP(I_CGNW)[l * 256 + c]; ct[11 * 64 + lane] = INP(I_CGNB)[l * 256 + c]; ct[12 * 64 + lane] = l > 0 ? INP(I_CV0)[(l - 1) * 256 + c] : 0.f;
        ct[13 * 64 + lane] = mu[512 + lane]; ct[14 * 64 + lane] = mu[512 + lane + 64]; ct[15 * 64 + lane] = mu[512 + lane + 128]; ct[16 * 64 + lane] = mu[512 + lane + 192]; }
}
template <int MODE>
__device__ __forceinline__ void chunk(LAS unsigned char* lds0, const int l, const int b, const int h, const int t0, unsigned char* gz, unsigned char* gz2, float* bong, const bf16* P, bf16* VF, bf16* OB, const int tid0) {
    const int c = h * 64 + (tid0 & 63);
    {
        unsigned lb_ = 0u; int tid_l = tid0; asm volatile("" : "+v"(lb_), "+v"(tid_l));
        const int tid = tid_l, lane = tid & 63, wave = __builtin_amdgcn_readfirstlane(tid >> 6);
        LAS unsigned char* lds = lds0 + lb_;
        LAS bf16* TAB = (LAS bf16*)(lds + O_TAB); const LAS unsigned* TABW = (const LAS unsigned*)(lds + O_TAB);
        LAS bf16* scr = (LAS bf16*)(lds + O_SCR + wave * 1024);
        LAS float* CUM = (LAS float*)(lds + O_CUM);
        LAS float* TOT = (LAS float*)(lds + O_TOT);
        LAS float* GAM = (LAS float*)(lds + O_GAM);
        LAS float* MABF = (LAS float*)(lds + O_MABF);
        LAS float* YF = (LAS float*)(lds + O_YF);
        LAS float* BON = (LAS float*)(lds + O_BON);
        const LAS float* CT = (const LAS float*)(lds + O_CT);
#define CTV(k) CT[(k) * 64 + lane]
        { const float* cw2 = INP(I_CW2) + (size_t)l * 32 * 256; const float* ca2 = INP(I_CA2) + (size_t)l * 32 * 256; const float* cg2 = INP(I_CG2) + (size_t)l * 64 * 256;
          float tw[4], ta[4], tg[8];
#pragma unroll
          for (int u = 0; u < 4; ++u) { const int i = tid + u * NTHR; tw[u] = cw2[(i >> 6) * 256 + h * 64 + (i & 63)]; ta[u] = ca2[(i >> 6) * 256 + h * 64 + (i & 63)]; }
#pragma unroll
          for (int u = 0; u < 8; ++u) { const int i = tid + u * NTHR; tg[u] = cg2[(i >> 6) * 256 + h * 64 + (i & 63)]; }
          float t2[2], t1[8];
          if (l > 0) { const float* cv1 = INP(I_CV1) + (size_t)(l - 1) * 256 * 16; const float* cv2 = INP(I_CV2) + (size_t)(l - 1) * 16 * 256;
#pragma unroll
            for (int u = 0; u < 2; ++u) { const int i = tid + u * NTHR; t2[u] = cv2[(i >> 6) * 256 + h * 64 + (i & 63)]; }
#pragma unroll
            for (int u = 0; u < 8; ++u) t1[u] = cv1[tid + u * NTHR]; }
#define PIX(i) ((((i) >> 7) * 64 + ((i) & 63)) * 2 + (((i) >> 6) & 1))
#pragma unroll
          for (int u = 0; u < 4; ++u) { const int i = tid + u * NTHR; TAB[PIX(i)] = (bf16)f2bf(tw[u]); TAB[2048 + PIX(i)] = (bf16)f2bf(ta[u]); }
#pragma unroll
          for (int u = 0; u < 8; ++u) { const int i = tid + u * NTHR; TAB[4096 + PIX(i)] = (bf16)f2bf(tg[u]); }
          if (l > 0) {
#pragma unroll
            for (int u = 0; u < 2; ++u) { const int i = tid + u * NTHR; TAB[8192 + PIX(i)] = (bf16)f2bf(t2[u]); }
#pragma unroll
            for (int u = 0; u < 8; ++u) { const int i = tid + u * NTHR; const int cc = i >> 4, qq = i & 15; TAB[9216 + ((cc >> 1) * 16 + qq) * 2 + (cc & 1)] = (bf16)f2bf(t1[u]); } } }
#undef PIX
        float Xr[9];
#pragma unroll
        for (int j = 0; j < 9; ++j) { const int t = t0 + wave * 8 - 1 + j; Xr[j] = t >= 0 ? bf2f(P[((size_t)b * T + t) * PP + C_C + 768 + lane]) : 0.f; }
        __syncthreads();
        { float run = 0.f;
#pragma unroll
            for (int q = 0; q < 8; ++q) {
                const float xx = Xr[q + 1] + (Xr[q] - Xr[q + 1]) * CTV(3);
                scr[lane] = (bf16)f2bf(tanhf_(xx));
                asm volatile("s_waitcnt lgkmcnt(0)" ::: "memory");
                float wsum = CTV(5); { float w1 = 0.f; const LAS unsigned* sw = (const LAS unsigned*)scr;
#pragma unroll
                for (int p = 0; p < 16; p += 2) { wsum = dot2(sw[p], TABW[p * 64 + lane], wsum); w1 = dot2(sw[p + 1], TABW[(p + 1) * 64 + lane], w1); }
                wsum += w1; }
                run += -__expf(-softplusf_(-wsum) - 0.5f); CUM[(wave * 8 + q) * 64 + lane] = run;
                asm volatile("s_waitcnt lgkmcnt(0)" ::: "memory");
            }
            TOT[wave * 64 + lane] = run; }
        __syncthreads();
        float offs = 0.f, cumL = 0.f;
#pragma unroll
        for (int w2 = 0; w2 < 8; ++w2) { const float tw = TOT[w2 * 64 + lane]; offs += (w2 < wave) ? tw : 0.f; cumL += tw; }
        if (wave == 0) GAM[lane] = __expf(cumL);
#define LO_(x) __uint_as_float((x) << 16)
#define HI_(x) __uint_as_float((x) & 0xffff0000u)
#define RAW_LOAD(rk, vx, gg, v4a, v4b, vfv, tok) do { const int t_ = (tok); const bool ok_ = t_ >= 0; const size_t m_ = (size_t)b * T + (ok_ ? t_ : 0); const bf16* row_ = P + m_ * PP + C_C; \
            rk = ok_ ? ((unsigned)row_[c] | ((unsigned)row_[256 + c] << 16)) : 0u; vx = ok_ ? ((unsigned)row_[512 + c] | ((unsigned)row_[768 + lane] << 16)) : 0u; gg = ok_ ? (unsigned)row_[832 + lane] : 0u; \
            if (l > 0) { v4a = ok_ ? ((unsigned)row_[512 + lane] | ((unsigned)row_[512 + lane + 64] << 16)) : 0u; v4b = ok_ ? ((unsigned)row_[512 + lane + 128] | ((unsigned)row_[512 + lane + 192] << 16)) : 0u; vfv = (unsigned)VF[m_ * 256 + c]; } } while (0)
        unsigned pRK, pVX, pGG, pVa = 0u, pVb = 0u, pVF = 0u, cRK, cVX, cGG, cVa = 0u, cVb = 0u, cVF = 0u;
        RAW_LOAD(pRK, pVX, pGG, pVa, pVb, pVF, t0 + wave * 8 - 1); RAW_LOAD(cRK, cVX, cGG, cVa, cVb, cVF, t0 + wave * 8);
#pragma unroll 1
        for (int q = 0; q < 8; ++q) {
            const int tt = wave * 8 + q; const size_t m = (size_t)b * T + t0 + tt;
            unsigned nRK, nVX, nGG, nVa = 0u, nVb = 0u, nVF = 0u;
            RAW_LOAD(nRK, nVX, nGG, nVa, nVb, nVF, (q < 7) ? (t0 + tt + 1) : (t0 + tt));
            const float r = LO_(cRK) + (LO_(pRK) - LO_(cRK)) * CTV(0), k = HI_(cRK) + (HI_(pRK) - HI_(cRK)) * CTV(1); float v = LO_(cVX) + (LO_(pVX) - LO_(cVX)) * CTV(2);
            const float xx = HI_(cVX) + (HI_(pVX) - HI_(cVX)) * CTV(3), xg = LO_(cGG) + (LO_(pGG) - LO_(cGG)) * CTV(4);
            scr[lane] = (bf16)f2bf(lane < 32 ? tanhf_(xx) : xx); scr[64 + lane] = (bf16)f2bf(sigmoidf_(xg));
            LAS bf16* vsc = scr + 128;
            if (l > 0) {
                vsc[lane] = (bf16)f2bf(LO_(cVa) + (LO_(pVa) - LO_(cVa)) * CTV(13)); vsc[lane + 64] = (bf16)f2bf(HI_(cVa) + (HI_(pVa) - HI_(cVa)) * CTV(14));
                vsc[lane + 128] = (bf16)f2bf(LO_(cVb) + (LO_(pVb) - LO_(cVb)) * CTV(15)); vsc[lane + 192] = (bf16)f2bf(HI_(cVb) + (HI_(pVb) - HI_(cVb)) * CTV(16));
            }
            asm volatile("s_waitcnt lgkmcnt(0)" ::: "memory");
            float wsum = CTV(5), asum = CTV(6), gsum = 0.f; { float w1 = 0.f, a1 = 0.f, g1 = 0.f; const LAS unsigned* sw = (const LAS unsigned*)scr;
#pragma unroll
            for (int p = 0; p < 16; p += 2) { wsum = dot2(sw[p], TABW[p * 64 + lane], wsum); w1 = dot2(sw[p + 1], TABW[(p + 1) * 64 + lane], w1);
                asum = dot2(sw[16 + p], TABW[1024 + p * 64 + lane], asum); a1 = dot2(sw[17 + p], TABW[1024 + (p + 1) * 64 + lane], a1); }
#pragma unroll
            for (int p = 0; p < 32; p += 2) { gsum = dot2(sw[32 + p], TABW[2048 + p * 64 + lane], gsum); g1 = dot2(sw[33 + p], TABW[2048 + (p + 1) * 64 + lane], g1); }
            wsum += w1; asum += a1; gsum += g1; }
            if (l > 0) {
                const int qq = lane & 15, part = lane >> 4; float s = 0.f; { float s1 = 0.f; const LAS unsigned* sv = (const LAS unsigned*)vsc;
#pragma unroll
                for (int p = 0; p < 32; p += 2) { s = dot2(sv[part * 32 + p], TABW[4608 + (part * 32 + p) * 16 + qq], s); s1 = dot2(sv[part * 32 + p + 1], TABW[4608 + (part * 32 + p + 1) * 16 + qq], s1); }
                s += s1; }
                s += __shfl_xor(s, 16); s += __shfl_xor(s, 32);
                float vl = CTV(12);
#pragma unroll
                for (int q2 = 0; q2 < 16; ++q2) vl += __shfl(s, q2) * bf2f(TAB[8192 + ((q2 >> 1) * 64 + lane) * 2 + (q2 & 1)]);
                const float vf = LO_(cVF); v = v + (vf - v) * sigmoidf_(vl);
            }
            VF[m * 256 + c] = (bf16)f2bf(v);
            const float wlog = -softplusf_(-wsum) - 0.5f, asig = sigmoidf_(asum), lw = -__expf(wlog);
            float kk = k * CTV(7); const float n2 = wave_sum(kk * kk); kk = kk * __builtin_amdgcn_rsqf(fmaxf(n2, 1e-24f));
            const float kmod = k * (1.f + (asig - 1.f) * CTV(8));
            const float bon = wave_sum(r * kmod * CTV(9));
            const float cum = offs + CUM[tt * 64 + lane], cumx = cum - lw;
            const float ah = -kk * __expf(cumx), rh = r * __expf(cum), ei = __expf(-cum), bb = kk * asig, bc = bb * ei, kc = kmod * ei, ee = __expf(cumL - cum), bt = bb * ee, kt = kmod * ee;
            const int no = (tt * LS + lane) * 2, to = (lane * LS + tt) * 2;
            *(LAS bf16*)(lds + O_AHN + no) = (bf16)f2bf(ah); *(LAS bf16*)(lds + O_RHN + no) = (bf16)f2bf(rh);
            *(LAS bf16*)(lds + O_BCN + no) = (bf16)f2bf(bc); *(LAS bf16*)(lds + O_KCN + no) = (bf16)f2bf(kc); ((bf16*)(gz2 + 16384))[tt * 64 + lane] = (bf16)f2bf(gsum);
            *(LAS bf16*)(lds + O_AHT + to) = (bf16)f2bf(ah); *(LAS bf16*)(lds + O_BTT + to) = (bf16)f2bf(bt);
            *(LAS bf16*)(lds + O_KTT + to) = (bf16)f2bf(kt); *(LAS bf16*)(lds + O_VT + to) = (bf16)f2bf(v);
            if (lane == 0) bong[tt] = bon;
            asm volatile("s_waitcnt lgkmcnt(0)" ::: "memory");
            pRK = cRK; pVX = cVX; pGG = cGG; pVa = cVa; pVb = cVb; cRK = nRK; cVX = nVX; cGG = nGG; cVa = nVa; cVb = nVb; cVF = nVF;
        }
#undef RAW_LOAD
        __syncthreads();
        { f4 acc[2];
            RW_ZERO(acc); mm64(acc, lds, O_AHN, O_BCN, wave, lane);
#pragma unroll
            for (int cI = 0; cI < 2; ++cI) { const int col = ((wave & 1) * 2 + cI) * 16 + (lane & 15), row = (wave >> 1) * 16 + 4 * (lane >> 4);
#pragma unroll
                for (int e = 0; e < 4; ++e) MABF[(row + e) * 64 + col] = (col < row + e) ? acc[cI][e] : 0.f; }
            RW_ZERO(acc); mm64(acc, lds, O_AHN, O_KCN, wave, lane); storeN<1>(lds, O_MAK, acc, wave, lane);
            { f4 accb[2]; RW_ZERO(accb); mm64(accb, lds, O_RHN, O_BCN, wave, lane); f4 accc[2]; RW_ZERO(accc); mm64(accc, lds, O_RHN, O_KCN, wave, lane);
                storeN<2>(lds, O_MRB, accb, wave, lane); storeN<2>(lds, O_MRK, accc, wave, lane); }
        }
        __syncthreads();
        {
            const int cS = wave * 8 + (lane >> 3), tS = lane & 7;
            float xs[8];
#pragma unroll
            for (int k = 0; k < 8; ++k) xs[k] = 0.f;
#pragma unroll
            for (int i = 1; i < 64; ++i) {
                float part = 0.f;
#pragma unroll
                for (int k = 0; k < (i + 7) / 8; ++k) { const float mv = MABF[i * 64 + tS + 8 * k]; part += ((tS + 8 * k) < i ? mv : 0.f) * xs[k]; }
                part += __builtin_bit_cast(float, __builtin_amdgcn_update_dpp(0, __builtin_bit_cast(int, part), 0xB1, 0xF, 0xF, true));
                part += __builtin_bit_cast(float, __builtin_amdgcn_update_dpp(0, __builtin_bit_cast(int, part), 0x4E, 0xF, 0xF, true));
                part += __builtin_bit_cast(float, __builtin_amdgcn_update_dpp(0, __builtin_bit_cast(int, part), 0x141, 0xF, 0xF, true));
                const float xi = MABF[i * 64 + cS] + part;
                xs[i >> 3] = (tS == (i & 7)) ? xi : xs[i >> 3];
            }
#pragma unroll
            for (int k = 0; k < 8; ++k) { const int i = tS + 8 * k; *(LAS bf16*)(lds + O_TINV + (i * LS + cS) * 2) = (bf16)f2bf(i == cS ? 1.f : xs[k]); }
        }
        __syncthreads();
        { f4 acc[2]; RW_ZERO(acc); mm64(acc, lds, O_MAK, O_VT, wave, lane); storeT(lds, O_MVT, acc, wave, lane); }
        __syncthreads();
        if (MODE == 1) {
            { f4 acc[2]; RW_ZERO(acc); mm64(acc, lds, O_TINV, O_AHT, wave, lane); storeT(lds, O_UT, acc, wave, lane); }
            { f4 acc[2]; RW_ZERO(acc); mm64(acc, lds, O_TINV, O_MVT, wave, lane); storeT(lds, O_MAK, acc, wave, lane); }
            __syncthreads();
            f4 agm[2], azm[2], ar2[2], ay0[2];
            RW_ZERO(agm); mm64(agm, lds, O_BTT, O_UT, wave, lane);
#pragma unroll
            for (int cI = 0; cI < 2; ++cI) { const int col = ((wave & 1) * 2 + cI) * 16 + (lane & 15), row = (wave >> 1) * 16 + 4 * (lane >> 4);
#pragma unroll
                for (int e = 0; e < 4; ++e) if (col == row + e) agm[cI][e] += GAM[col]; }
            RW_ZERO(azm); mm64(azm, lds, O_BTT, O_MAK, wave, lane); mm64(azm, lds, O_KTT, O_VT, wave, lane);
            RW_ZERO(ar2); mm64(ar2, lds, O_MRB, O_UT, wave, lane);
#pragma unroll
            for (int cI = 0; cI < 2; ++cI) { const int col = ((wave & 1) * 2 + cI) * 16 + (lane & 15), row = (wave >> 1) * 16 + 4 * (lane >> 4);
#pragma unroll
                for (int e = 0; e < 4; ++e) ar2[cI][e] += bf2f(*(const LAS bf16*)(lds + O_RHN + ((row + e) * LS + col) * 2)); }
            RW_ZERO(ay0); mm64(ay0, lds, O_MRB, O_MAK, wave, lane); mm64(ay0, lds, O_MRK, O_VT, wave, lane);
            __syncthreads();
            storeN<0>(lds, O_AHN, agm, wave, lane); storeT(lds, O_RHN, azm, wave, lane); storeN<0>(lds, O_BCN, ar2, wave, lane); storeT(lds, O_KCN, ay0, wave, lane);
            __syncthreads();
            { const int io = ((tid >> 3) * LS + (tid & 7) * 8) * 2;
              ((u32x4*)gz)[tid] = *(const LAS u32x4*)(lds + O_AHN + io); ((u32x4*)(gz + 8192))[tid] = *(const LAS u32x4*)(lds + O_RHN + io);
              ((u32x4*)gz2)[tid] = *(const LAS u32x4*)(lds + O_BCN + io); ((u32x4*)(gz2 + 8192))[tid] = *(const LAS u32x4*)(lds + O_KCN + io); }
        } else {
            { f4 acc[2]; RW_ZERO(acc); mm64(acc, lds, O_TINV, O_AHT, wave, lane); storeN<0>(lds, O_A2N, acc, wave, lane); }
            __syncthreads();
            { f4 acc[2]; RW_ZERO(acc); mm64(acc, lds, O_TINV, O_MVT, wave, lane); mm64(acc, lds, O_A2N, O_STT, wave, lane); storeT(lds, O_UT, acc, wave, lane); }
            __syncthreads();
            f4 yacc[2]; RW_ZERO(yacc);
            mm64(yacc, lds, O_RHN, O_STT, wave, lane); mm64(yacc, lds, O_MRB, O_UT, wave, lane); mm64(yacc, lds, O_MRK, O_VT, wave, lane);
            __syncthreads();
#pragma unroll
            for (int cI = 0; cI < 2; ++cI) { const int col = ((wave & 1) * 2 + cI) * 16 + (lane & 15), row = (wave >> 1) * 16 + 4 * (lane >> 4);
#pragma unroll
                for (int e = 0; e < 4; ++e) YF[(row + e) * 64 + col] = yacc[cI][e]; }
            __syncthreads();
            { unsigned gcur = (unsigned)OB[((size_t)b * T + t0 + wave * 8) * 1024 + 512 + c];
#pragma unroll 1
            for (int q = 0; q < 8; ++q) {
                const int tt = wave * 8 + q; const size_t m = (size_t)b * T + t0 + tt;
                const unsigned gnxt = (unsigned)OB[(m + (q < 7 ? 1 : 0)) * 1024 + 512 + c];
                const float y = YF[tt * 64 + lane]; const float mean = wave_sum(y) * (1.f / 64.f); const float dy = y - mean; const float var = wave_sum(dy * dy) * (1.f / 64.f);
                const float yn = dy * rsqrtf(var + 64e-5f) * CTV(10) + CTV(11);
                const float vv = bf2f(*(const LAS bf16*)(lds + O_VT + (lane * LS + tt) * 2)), gg = LO_(gcur);
                OB[m * 1024 + 512 + c] = (bf16)f2bf((yn + BON[tt] * vv) * gg);
                gcur = gnxt;
            } }
        }
        __syncthreads();
#undef CTV
#undef LO_
#undef HI_
    }
}

__device__ __forceinline__ void chunk_out(LAS unsigned char* lds0, const int b, const int h, const int t0, const unsigned char* gz, const unsigned char* gz2, const float* bong, const bf16* VF, bf16* OB, const int tid0) {
    unsigned lb_ = 0u; int tid_l = tid0; asm volatile("" : "+v"(lb_), "+v"(tid_l));
    LAS unsigned char* lds = lds0 + lb_; const int tid = tid_l, lane = tid & 63, wave = __builtin_amdgcn_readfirstlane(tid >> 6);
    const int c = h * 64 + lane;
    const LAS float* CT = (const LAS float*)(lds + O_CT);
    LAS float* YF = (LAS float*)(lds + O_YF);
    const int io = ((tid >> 3) * LS + (tid & 7) * 8) * 2;
    const u32x4 sv = ((const u32x4*)gz)[tid], rv = ((const u32x4*)gz2)[tid];
    u32x2 yv[2];
#pragma unroll
    for (int k = 0; k < 2; ++k) { const int col = ((wave & 1) * 2 + k) * 16 + (lane & 15), row = (wave >> 1) * 16 + 4 * (lane >> 4); yv[k] = *(const u32x2*)(gz2 + 8192 + (col * 64 + row) * 2); }
    float gq[8], vq[8], bq[8];
#pragma unroll
    for (int q = 0; q < 8; ++q) { const int tt = wave * 8 + q; const size_t m = (size_t)b * T + t0 + tt;
        gq[q] = bf2f(((const bf16*)(gz2 + 16384))[tt * 64 + lane]); vq[q] = bf2f(VF[m * 256 + c]); bq[q] = bong[tt]; }
    *(LAS u32x4*)(lds + O_STT + io) = sv; *(LAS u32x4*)(lds + O_AHN + io) = rv;
    __syncthreads();
    f4 acc[2];
#pragma unroll
    for (int k = 0; k < 2; ++k) acc[k] = (f4){__uint_as_float(yv[k].x << 16), __uint_as_float(yv[k].x & 0xffff0000u), __uint_as_float(yv[k].y << 16), __uint_as_float(yv[k].y & 0xffff0000u)};
    mm64(acc, lds, O_AHN, O_STT, wave, lane);
#pragma unroll
    for (int cI = 0; cI < 2; ++cI) { const int col = ((wave & 1) * 2 + cI) * 16 + (lane & 15), row = (wave >> 1) * 16 + 4 * (lane >> 4);
#pragma unroll
        for (int e = 0; e < 4; ++e) YF[(row + e) * 64 + col] = acc[cI][e]; }
    __syncthreads();
#pragma unroll
    for (int q = 0; q < 8; ++q) { const int tt = wave * 8 + q; const size_t m = (size_t)b * T + t0 + tt;
        const float y = YF[tt * 64 + lane]; const float mean = wave_sum(y) * (1.f / 64.f); const float dy = y - mean; const float var = wave_sum(dy * dy) * (1.f / 64.f);
        const float yn = dy * rsqrtf(var + 64e-5f) * CT[10 * 64 + lane] + CT[11 * 64 + lane];
        OB[m * 1024 + 512 + c] = (bf16)f2bf((yn + bq[q] * vq[q]) * gq[q]); }
    __syncthreads();
}

__device__ __forceinline__ void carry(LAS unsigned char* lds0, unsigned char* gzc  , const int tid0) {
    f4 stacc[2]; RW_ZERO(stacc);
    { unsigned lb_ = 0u; asm volatile("" : "+v"(lb_)); LAS unsigned char* lds = lds0 + lb_; for (int i = tid0; i < MB / 4; i += NTHR) ((LAS unsigned*)(lds + O_STT))[i] = 0u; }
    u32x4 gnx = ((const u32x4*)gzc)[tid0];
    u32x2 znx[2];
    { const int lane = tid0 & 63, wave = tid0 >> 6;
#pragma unroll
      for (int k = 0; k < 2; ++k) { const int col = ((wave & 1) * 2 + k) * 16 + (lane & 15), row = (wave >> 1) * 16 + 4 * (lane >> 4); znx[k] = *(const u32x2*)(gzc + 8192 + (col * 64 + row) * 2); } }
#pragma unroll 1
    for (int cI = 0; cI < T / 64; ++cI) {
        unsigned lb_ = 0u; int tid_l = tid0; asm volatile("" : "+v"(lb_), "+v"(tid_l));
        LAS unsigned char* lds = lds0 + lb_; const int tid = tid_l, lane = tid & 63, wave = __builtin_amdgcn_readfirstlane(tid >> 6);
        unsigned char* rec = gzc + (size_t)cI * 16384;
        const int io = ((tid >> 3) * LS + (tid & 7) * 8) * 2;
        *(LAS u32x4*)(lds + O_AHN + io) = gnx;
        u32x2 zv[2]; zv[0] = znx[0]; zv[1] = znx[1];
        if (cI + 1 < T / 64) { gnx = ((const u32x4*)(rec + 16384))[tid];
#pragma unroll
            for (int k = 0; k < 2; ++k) { const int col = ((wave & 1) * 2 + k) * 16 + (lane & 15), row = (wave >> 1) * 16 + 4 * (lane >> 4); znx[k] = *(const u32x2*)(rec + 16384 + 8192 + (col * 64 + row) * 2); } }
        __syncthreads();
        ((u32x4*)rec)[tid] = *(const LAS u32x4*)(lds + O_STT + io);
        f4 acc[2];
#pragma unroll
        for (int k = 0; k < 2; ++k) acc[k] = (f4){__uint_as_float(zv[k].x << 16), __uint_as_float(zv[k].x & 0xffff0000u), __uint_as_float(zv[k].y << 16), __uint_as_float(zv[k].y & 0xffff0000u)};
        mm64(acc, lds, O_AHN, O_STT, wave, lane);
        __syncthreads();
        storeT(lds, O_STT, acc, wave, lane);
    }
}
}

namespace mb {
using rw::LS; using rw::MB; using rw::f4; using rw::mm64; using rw::storeN; using rw::bf16x8;
constexpr int O_CN = 0, O_BN = MB, O_BT = 2 * MB, O_XT0 = 3 * MB, O_XW0 = 5 * MB, O_CS0 = 7 * MB, O_HN0 = 9 * MB, O_SC0 = 11 * MB, O_SM = 13 * MB, O_YF = O_XW0;
static_assert(O_SM + 2048 <= LDS_BYTES - 576, "mamba LDS map");
__device__ __forceinline__ void chain(LAS unsigned char* lds0, const int l, const int b, const int gI, const bf16* P, bf16* OB, const int tid0, const int lane0, const int wave0) {
    const int tid = tid0, lane = lane0, wave = wave0;
    LAS unsigned char* const& lds = lds0;
    const float* cwp = INP(I_DCW) + (size_t)l * 4 * 512; const float* cbp = INP(I_DCB) + (size_t)l * 512;
    const int cc = tid & 255, sub = tid >> 8;
    const int col = cc < 128 ? (gI * 128 + cc) : (cc < 192 ? (256 + gI * 64 + (cc - 128)) : (384 + gI * 64 + (cc - 192)));
    const float cw0 = cwp[col], cw1 = cwp[512 + col], cw2 = cwp[1024 + col], cw3 = cwp[1536 + col], cb = cbp[col];
    f4 hacc[2][2];
#pragma unroll
    for (int hh = 0; hh < 2; ++hh) { hacc[hh][0] = (f4){0.f, 0.f, 0.f, 0.f}; hacc[hh][1] = (f4){0.f, 0.f, 0.f, 0.f}; }
    for (int i = tid; i < 2 * MB / 4; i += NTHR) ((LAS unsigned*)(lds0 + O_HN0))[i] = 0u;
    const float dtb0 = INP(I_DDTB)[l * 4 + gI * 2], dtb1 = INP(I_DDTB)[l * 4 + gI * 2 + 1];
    const float nA0 = -__expf(INP(I_DALOG)[l * 4 + gI * 2]), nA1 = -__expf(INP(I_DALOG)[l * 4 + gI * 2 + 1]);
    const float dsk0 = INP(I_DSKIP)[l * 4 + gI * 2], dsk1 = INP(I_DSKIP)[l * 4 + gI * 2 + 1];
    const float nw0 = INP(I_DNW)[l * 256 + gI * 128 + lane], nw1 = INP(I_DNW)[l * 256 + gI * 128 + 64 + lane];
#pragma unroll 1
    for (int t0 = 0; t0 < T; t0 += 64) {
        unsigned lb_ = 0u; int tid_l = tid0; asm volatile("" : "+v"(lb_), "+v"(tid_l));
        const int tid = tid_l, lane = tid & 63, wave = __builtin_amdgcn_readfirstlane(tid >> 6);
        LAS unsigned char* lds = lds0 + lb_;
        LAS float* SM = (LAS float*)(lds + O_SM);
        LAS float* YF = (LAS float*)(lds + O_YF);
        if (wave < 2) {
            const size_t m = (size_t)b * T + t0 + lane;
            const float dt = softplusf_(bf2f(P[m * PP + C_DT + gI * 2 + wave]) + (wave == 0 ? dtb0 : dtb1));
            float cs = dt * (wave == 0 ? nA0 : nA1);
#pragma unroll
            for (int o = 1; o < 64; o <<= 1) { const float y = __shfl_up(cs, o); if (lane >= o) cs += y; }
            const float cL = __shfl(cs, 63);
            SM[wave * 64 + lane] = dt; SM[128 + wave * 64 + lane] = cs; SM[256 + wave * 64 + lane] = __expf(cL - cs) * dt; SM[384 + wave * 64 + lane] = __expf(cs);
        }
        __syncthreads();
        { float h0, h1, h2, cur[8], nxt[8];
          { const int tb = t0 + sub * 32; h0 = tb >= 3 ? bf2f(P[((size_t)b * T + tb - 3) * PP + C_DX + col]) : 0.f; h1 = tb >= 2 ? bf2f(P[((size_t)b * T + tb - 2) * PP + C_DX + col]) : 0.f; h2 = tb >= 1 ? bf2f(P[((size_t)b * T + tb - 1) * PP + C_DX + col]) : 0.f;
#pragma unroll
            for (int j = 0; j < 8; ++j) cur[j] = bf2f(P[((size_t)b * T + tb + j) * PP + C_DX + col]); }
#pragma unroll 1
          for (int g8 = 0; g8 < 4; ++g8) {
            const int tb = t0 + sub * 32 + g8 * 8 + (g8 < 3 ? 8 : 0);
#pragma unroll
            for (int j = 0; j < 8; ++j) nxt[j] = bf2f(P[((size_t)b * T + tb + j) * PP + C_DX + col]);
#pragma unroll
            for (int j = 0; j < 8; ++j) {
                const int tt = sub * 32 + g8 * 8 + j;
                const float a = siluf_(cb + cw3 * cur[j] + cw2 * h2 + cw1 * h1 + cw0 * h0);
                h0 = h1; h1 = h2; h2 = cur[j];
                if (cc < 128) { const int hh = cc >> 6, p = cc & 63;
                    *(LAS bf16*)(lds + O_XT0 + hh * MB + (p * LS + tt) * 2) = (bf16)f2bf(a); *(LAS bf16*)(lds + O_XW0 + hh * MB + (p * LS + tt) * 2) = (bf16)f2bf(a * SM[256 + hh * 64 + tt]); }
                else if (cc < 192) { const int n = cc - 128; *(LAS bf16*)(lds + O_BN + (tt * LS + n) * 2) = (bf16)f2bf(a); *(LAS bf16*)(lds + O_BT + (n * LS + tt) * 2) = (bf16)f2bf(a); }
                else { const int n = cc - 192; *(LAS bf16*)(lds + O_CN + (tt * LS + n) * 2) = (bf16)f2bf(a);
                    *(LAS bf16*)(lds + O_CS0 + (tt * LS + n) * 2) = (bf16)f2bf(a * SM[384 + tt]); *(LAS bf16*)(lds + O_CS0 + MB + (tt * LS + n) * 2) = (bf16)f2bf(a * SM[384 + 64 + tt]); }
            }
#pragma unroll
            for (int j = 0; j < 8; ++j) cur[j] = nxt[j];
          } }
        __syncthreads();
        { f4 acc[2]; acc[0] = (f4){0.f, 0.f, 0.f, 0.f}; acc[1] = (f4){0.f, 0.f, 0.f, 0.f}; mm64(acc, lds, O_CN, O_BN, wave, lane);
#pragma unroll
            for (int hh = 0; hh < 2; ++hh) { f4 sc[2];
#pragma unroll
                for (int cI = 0; cI < 2; ++cI) { const int s = ((wave & 1) * 2 + cI) * 16 + (lane & 15), row = (wave >> 1) * 16 + 4 * (lane >> 4);
                    const float cs = SM[128 + hh * 64 + s], ds = SM[hh * 64 + s];
#pragma unroll
                    for (int e = 0; e < 4; ++e) { const float ct = SM[128 + hh * 64 + row + e]; sc[cI][e] = (s <= row + e) ? acc[cI][e] * __expf(ct - cs) * ds : 0.f; } }
                storeN<0>(lds, O_SC0 + hh * MB, sc, wave, lane); } }
        __syncthreads();
        f4 yacc[2][2];
#pragma unroll
        for (int hh = 0; hh < 2; ++hh) {
            yacc[hh][0] = (f4){0.f, 0.f, 0.f, 0.f}; yacc[hh][1] = (f4){0.f, 0.f, 0.f, 0.f};
            mm64(yacc[hh], lds, O_SC0 + hh * MB, O_XT0 + hh * MB, wave, lane); mm64(yacc[hh], lds, O_CS0 + hh * MB, O_HN0 + hh * MB, wave, lane);
            const float gL = SM[384 + hh * 64 + 63]; hacc[hh][0] = hacc[hh][0] * gL; hacc[hh][1] = hacc[hh][1] * gL;
            mm64(hacc[hh], lds, O_XW0 + hh * MB, O_BT, wave, lane);
        }
        __syncthreads();
#pragma unroll
        for (int hh = 0; hh < 2; ++hh) {
#pragma unroll
            for (int cI = 0; cI < 2; ++cI) { const int colp = ((wave & 1) * 2 + cI) * 16 + (lane & 15), row = (wave >> 1) * 16 + 4 * (lane >> 4);
#pragma unroll
                for (int e = 0; e < 4; ++e) YF[(row + e) * 128 + hh * 64 + colp] = yacc[hh][cI][e]; }
            storeN<0>(lds, O_HN0 + hh * MB, hacc[hh], wave, lane);
        }
        __syncthreads();
#pragma unroll
        for (int q = 0; q < 8; ++q) {
            const int tt = wave * 8 + q; const size_t m = (size_t)b * T + t0 + tt;
            const float x0 = bf2f(*(const LAS bf16*)(lds + O_XT0 + (lane * LS + tt) * 2)), x1 = bf2f(*(const LAS bf16*)(lds + O_XT0 + MB + (lane * LS + tt) * 2));
            const int c0 = gI * 128 + lane, c1 = c0 + 64;
            const float z0 = bf2f(P[m * PP + C_DZ + c0]), z1 = bf2f(P[m * PP + C_DZ + c1]);
            const float y0 = (YF[tt * 128 + lane] + dsk0 * x0) * siluf_(z0), y1 = (YF[tt * 128 + 64 + lane] + dsk1 * x1) * siluf_(z1);
            const float ss = wave_sum(y0 * y0 + y1 * y1); const float rs = rsqrtf(ss * (1.f / 128.f) + 1e-5f);
            OB[m * 1024 + 768 + c0] = (bf16)f2bf(y0 * rs * nw0); OB[m * 1024 + 768 + c1] = (bf16)f2bf(y1 * rs * nw1);
        }
        __syncthreads();
    }
}
}

namespace bsp {
typedef short bf16x8 __attribute__((ext_vector_type(8)));
typedef float f4 __attribute__((ext_vector_type(4)));
constexpr int HS = 129;
constexpr int O_HIST = 0;
constexpr int O_V = 66048;
constexpr int VS = 272;
constexpr int O_KB = O_V + 2 * 32 * VS * 2;
constexpr int KBUF = 20480;
static_assert(O_KB + 2 * KBUF <= LDS_BYTES - 600, "mixer B LDS map");
__device__ __forceinline__ float relu_(float x) { return __int_as_float(max(__float_as_int(x), 0)); }
__device__ __forceinline__ unsigned okey(float s) { int q = (int)(s * 262144.f + 8388608.f); q = q < 1 ? 1 : (q > 16777215 ? 16777215 : q); return (unsigned)q << 8; }
__device__ __forceinline__ f4 idx_tile(const bf16* Pb, const int kt, const bf16x8 (&qi)[4][2], const float (&wq)[4], const int lane) {
    const bf16* kr = Pb + (size_t)(kt * 16 + (lane & 15)) * PP + C_IK + (lane >> 4) * 8;
    const bf16x8 a0 = *(const bf16x8*)kr, a1 = *(const bf16x8*)(kr + 32);
    f4 s = (f4){0.f, 0.f, 0.f, 0.f};
#pragma unroll
    for (int h = 0; h < 4; ++h) { f4 t = (f4){0.f, 0.f, 0.f, 0.f};
        t = __builtin_amdgcn_mfma_f32_16x16x32_bf16(a0, qi[h][0], t, 0, 0, 0); t = __builtin_amdgcn_mfma_f32_16x16x32_bf16(a1, qi[h][1], t, 0, 0, 0);
#pragma unroll
        for (int e = 0; e < 4; ++e) s[e] += wq[h] * relu_(t[e]); }
    return s;
}

__device__ __forceinline__ void item(LAS unsigned char* lds0, const int bb, const int qb, const bf16* P, bf16* OB, const int tid0, const int pm) {
    unsigned lb_ = 0u; int tid_l = tid0; asm volatile("" : "+v"(lb_), "+v"(tid_l));
    LAS unsigned char* lds = lds0 + lb_; const int tid = tid_l, lane = tid & 63, wave = __builtin_amdgcn_readfirstlane(tid >> 6);
    const bf16* Pb = P + (size_t)bb * T * PP;
    const int ql = wave * 16 + (lane & 15), tq = qb * 128 + ql, g = lane >> 4;
    const bf16* prow = Pb + (size_t)tq * PP;
    bf16x8 qi[4][2]; float wq[4];
#pragma unroll
    for (int h = 0; h < 4; ++h) { qi[h][0] = *(const bf16x8*)(prow + C_IQ + h * 64 + g * 8); qi[h][1] = *(const bf16x8*)(prow + C_IQ + h * 64 + 32 + g * 8); wq[h] = bf2f(prow[C_IW + h]) * 0.0625f; }
    LAS unsigned* hist = (LAS unsigned*)(lds + O_HIST) + ql * HS;
    const int nkt = (qb + 1) * 8;
    unsigned prefix = 0u; int needk = 256;
#pragma unroll 1
    for (int rr = 0; rr < (pm == 102 ? 2 : 1); ++rr) { prefix = 0u; needk = 256;
#pragma unroll 1
    for (int pass = 0; pass < 3; ++pass) {
        for (int i = lane; i < 16 * HS; i += 64) ((LAS unsigned*)(lds + O_HIST) + wave * 16 * HS)[i] = 0u;
        asm volatile("s_waitcnt lgkmcnt(0)" ::: "memory");
        const int shp = 32 - 8 * pass, shb = 24 - 8 * pass;
        float flo = 0.f, fhi = 0.f;
        if (pass > 0) { const float stepw = (pass == 1) ? 65536.f : 256.f; flo = ((float)prefix * stepw - 2.f) * (1.f / 262144.f) - 32.f; fhi = (((float)prefix + 1.f) * stepw + 2.f) * (1.f / 262144.f) - 32.f; }
        bf16x8 ka[4][2], kn[4][2];
#pragma unroll
        for (int u = 0; u < 4; ++u) { const bf16* kr = Pb + (size_t)(u * 16 + (lane & 15)) * PP + C_IK + g * 8; ka[u][0] = *(const bf16x8*)kr; ka[u][1] = *(const bf16x8*)(kr + 32); }
#pragma unroll 1
        for (int kt4 = 0; kt4 < nkt; kt4 += 4) {
            { const int ktn = (kt4 + 4 < nkt) ? kt4 + 4 : kt4;
#pragma unroll
              for (int u = 0; u < 4; ++u) { const bf16* kr = Pb + (size_t)((ktn + u) * 16 + (lane & 15)) * PP + C_IK + g * 8; kn[u][0] = *(const bf16x8*)kr; kn[u][1] = *(const bf16x8*)(kr + 32); } }
#pragma unroll
            for (int u = 0; u < 4; ++u) {
                f4 s = (f4){0.f, 0.f, 0.f, 0.f};
#pragma unroll
                for (int h = 0; h < 4; ++h) { f4 t = (f4){0.f, 0.f, 0.f, 0.f};
                    t = __builtin_amdgcn_mfma_f32_16x16x32_bf16(ka[u][0], qi[h][0], t, 0, 0, 0); t = __builtin_amdgcn_mfma_f32_16x16x32_bf16(ka[u][1], qi[h][1], t, 0, 0, 0);
#pragma unroll
                    for (int e = 0; e < 4; ++e) s[e] += wq[h] * relu_(t[e]); }
                if (pass == 0) {
#pragma unroll
                    for (int e = 0; e < 4; ++e) { const int key = (kt4 + u) * 16 + 4 * g + e;
                        if (key <= tq) { const unsigned bin = okey(s[e]) >> 24; __hip_atomic_fetch_add(hist + (bin >> 1), (bin & 1u) ? 0x10000u : 1u, __ATOMIC_RELAXED, __HIP_MEMORY_SCOPE_WORKGROUP); } }
                } else {
#pragma unroll
                    for (int e = 0; e < 4; ++e) { const int key = (kt4 + u) * 16 + 4 * g + e;
                        if (s[e] >= flo && s[e] <= fhi && key <= tq) { const unsigned k32 = okey(s[e]);
                            if ((k32 >> shp) == prefix) { const unsigned bin = (k32 >> shb) & 255u; __hip_atomic_fetch_add(hist + (bin >> 1), (bin & 1u) ? 0x10000u : 1u, __ATOMIC_RELAXED, __HIP_MEMORY_SCOPE_WORKGROUP); } } }
                }
            }
#pragma unroll
            for (int u = 0; u < 4; ++u) { ka[u][0] = kn[u][0]; ka[u][1] = kn[u][1]; }
        }
        asm volatile("s_waitcnt lgkmcnt(0)" ::: "memory");
        int cum = 0; unsigned bsel = 0u; int above = 0;
        for (int wd = 127; wd >= 0; --wd) { const unsigned v = hist[wd]; const int hi = (int)(v >> 16), lo = (int)(v & 0xffffu);
            if (cum + hi >= needk) { bsel = (unsigned)(2 * wd + 1); above = cum; break; } cum += hi;
            if (cum + lo >= needk) { bsel = (unsigned)(2 * wd); above = cum; break; } cum += lo; }
        prefix = (prefix << 8) | bsel; needk -= above;
        asm volatile("s_waitcnt lgkmcnt(0)" ::: "memory");
    }
    }
    unsigned thr = prefix; int cidx = 1 << 20;
    bool tie = false;
    if (tq < 256) thr = 0u;
    else { const unsigned v = hist[(prefix & 255u) >> 1]; const int ceq = (prefix & 1u) ? (int)(v >> 16) : (int)(v & 0xffffu); tie = needk < ceq; }
    if (__any(tie)) {
        int cbin = 0, rem = needk;
#pragma unroll 1
        for (int ip = 0; ip < 2; ++ip) {
            for (int i = g; i < HS; i += 4) hist[i] = 0u;
            asm volatile("s_waitcnt lgkmcnt(0)" ::: "memory");
#pragma unroll 1
            for (int kt = 0; kt < nkt; ++kt) {
                const f4 s = idx_tile(Pb, kt, qi, wq, lane);
#pragma unroll
                for (int e = 0; e < 4; ++e) { const int key = kt * 16 + 4 * g + e; const unsigned k32 = okey(s[e]);
                    const bool in = tie && key <= tq && (k32 >> 8) == prefix && (ip == 0 || (key >> 4) == cbin);
                    if (in) { const unsigned bin = ip == 0 ? (unsigned)(key >> 4) : (unsigned)(key & 15); __hip_atomic_fetch_add(hist + (bin >> 1), (bin & 1u) ? 0x10000u : 1u, __ATOMIC_RELAXED, __HIP_MEMORY_SCOPE_WORKGROUP); } }
            }
            asm volatile("s_waitcnt lgkmcnt(0)" ::: "memory");
            int cum = 0, bs = 0, below = 0;
            for (int wd = 0; wd < 128; ++wd) { const unsigned vv = hist[wd]; const int lo = (int)(vv & 0xffffu), hi = (int)(vv >> 16);
                if (cum + lo >= rem) { bs = 2 * wd; below = cum; break; } cum += lo;
                if (cum + hi >= rem) { bs = 2 * wd + 1; below = cum; break; } cum += hi; }
            if (ip == 0) { cbin = bs; rem -= below; } else if (tie) cidx = cbin * 16 + bs;
            asm volatile("s_waitcnt lgkmcnt(0)" ::: "memory");
        }
    }
    __syncthreads();
#pragma unroll
    for (int h = 0; h < 4; ++h) { *(LAS bf16x8*)(lds + O_HIST + wave * 8192 + ((h * 2 + 0) * 64 + lane) * 16) = qi[h][0]; *(LAS bf16x8*)(lds + O_HIST + wave * 8192 + ((h * 2 + 1) * 64 + lane) * 16) = qi[h][1]; }
    bf16x8 qa[4][2];
#pragma unroll
    for (int h = 0; h < 4; ++h) { qa[h][0] = *(const bf16x8*)(prow + C_BQ + h * 64 + g * 8); qa[h][1] = *(const bf16x8*)(prow + C_BQ + h * 64 + 32 + g * 8); }
    f4 oacc[4][4]; float mrun[4], lrun[4];
#pragma unroll
    for (int h = 0; h < 4; ++h) { mrun[h] = -INFINITY; lrun[h] = 0.f;
#pragma unroll
        for (int dt = 0; dt < 4; ++dt) oacc[h][dt] = (f4){0.f, 0.f, 0.f, 0.f}; }
#pragma unroll 1
    for (int rr = 0; rr < (pm == 103 ? 2 : 1); ++rr) {
#pragma unroll
    for (int h = 0; h < 4; ++h) { mrun[h] = -INFINITY; lrun[h] = 0.f;
#pragma unroll
        for (int dt = 0; dt < 4; ++dt) oacc[h][dt] = (f4){0.f, 0.f, 0.f, 0.f}; }
    const int nst = (qb + 1) * 4;
    const int vkey = tid >> 4, vch = tid & 15;
    u32x4 vpre0 = *(const u32x4*)(Pb + (size_t)vkey * PP + C_BV + vch * 8), vpre1 = *(const u32x4*)(Pb + (size_t)vkey * PP + C_BV + 128 + vch * 8);
    const unsigned vrd = (unsigned)(unsigned long)lds + (unsigned)(O_V + (4 * g + ((lane >> 2) & 3)) * (VS * 2) + (lane & 3) * 8);
    __syncthreads();
    {   const unsigned kb = (unsigned)O_KB;
#pragma unroll
        for (int jj = 0; jj < 3; ++jj) { const int j = wave + 8 * jj;
            if (j < 16) { const int S = j * 64 + lane, r = S >> 5, p = S & 31;
                __builtin_amdgcn_global_load_lds((const unsigned*)(Pb + (size_t)r * PP + C_BK + ((p ^ (r & 15)) << 3)), (LAS unsigned*)(lds + kb + j * 1024), 16, 0, 0); }
            else if (j < 20) { const int S = (j - 16) * 64 + lane, r = S >> 3, p = S & 7;
                __builtin_amdgcn_global_load_lds((const unsigned*)(Pb + (size_t)r * PP + C_IK + ((p ^ (r & 7)) << 3)), (LAS unsigned*)(lds + kb + 16384 + (j - 16) * 1024), 16, 0, 0); } } }
#pragma unroll 1
    for (int st = 0; st < nst; ++st) {
        const int key0 = st * 32; const unsigned vbuf = (unsigned)(st & 1) * (32 * VS * 2);
        unsigned qio = (unsigned)(O_HIST + wave * 8192 + lane * 16); asm volatile("" : "+v"(qio));
        { LAS bf16* VL = (LAS bf16*)(lds + O_V + vbuf); *(LAS u32x4*)(VL + vkey * VS + vch * 8) = vpre0; *(LAS u32x4*)(VL + vkey * VS + 128 + vch * 8) = vpre1; }
        asm volatile("s_waitcnt vmcnt(0)" ::: "memory");
        __syncthreads();
        if (st + 1 < nst) {
            const int kn0 = key0 + 32; const unsigned kb = (unsigned)(O_KB + ((st + 1) & 1) * KBUF);
#pragma unroll
            for (int jj = 0; jj < 3; ++jj) { const int j = wave + 8 * jj;
                if (j < 16) { const int S = j * 64 + lane, r = S >> 5, p = S & 31;
                    __builtin_amdgcn_global_load_lds((const unsigned*)(Pb + (size_t)(kn0 + r) * PP + C_BK + ((p ^ (r & 15)) << 3)), (LAS unsigned*)(lds + kb + j * 1024), 16, 0, 0); }
                else if (j < 20) { const int S = (j - 16) * 64 + lane, r = S >> 3, p = S & 7;
                    __builtin_amdgcn_global_load_lds((const unsigned*)(Pb + (size_t)(kn0 + r) * PP + C_IK + ((p ^ (r & 7)) << 3)), (LAS unsigned*)(lds + kb + 16384 + (j - 16) * 1024), 16, 0, 0); } }
        }
        const unsigned kbc = (unsigned)(O_KB + (st & 1) * KBUF);
#define KQ_(h, k2, ks) (*(const LAS bf16x8*)(lds + kbc + (k2 * 16 + (lane & 15)) * 512 + ((((h) * 8 + (ks) * 4 + g) ^ (lane & 15)) << 4)))
#define KI_(k2, ks) (*(const LAS bf16x8*)(lds + kbc + 16384 + (k2 * 16 + (lane & 15)) * 128 + ((((ks) * 4 + g) ^ (lane & 7)) << 4)))
        bool sel[2][4];
#pragma unroll
        for (int k2 = 0; k2 < 2; ++k2) { f4 s = (f4){0.f, 0.f, 0.f, 0.f};
#pragma unroll
            for (int h = 0; h < 4; ++h) { f4 t = (f4){0.f, 0.f, 0.f, 0.f};
                const bf16x8 qh0 = *(const LAS bf16x8*)(lds + qio + ((h * 2 + 0) * 64) * 16), qh1 = *(const LAS bf16x8*)(lds + qio + ((h * 2 + 1) * 64) * 16);
                t = __builtin_amdgcn_mfma_f32_16x16x32_bf16(KI_(k2, 0), qh0, t, 0, 0, 0); t = __builtin_amdgcn_mfma_f32_16x16x32_bf16(KI_(k2, 1), qh1, t, 0, 0, 0);
#pragma unroll
                for (int e = 0; e < 4; ++e) s[e] += wq[h] * relu_(t[e]); }
#pragma unroll
            for (int e = 0; e < 4; ++e) { const int key = key0 + k2 * 16 + 4 * g + e; const unsigned k24 = okey(s[e]) >> 8;
                sel[k2][e] = key <= tq && (k24 > thr || (k24 == thr && key <= cidx)); } }
#pragma unroll
        for (int h = 0; h < 4; ++h) {
            if (h == 2 && st + 1 < nst) { vpre0 = *(const u32x4*)(Pb + (size_t)(key0 + 32 + vkey) * PP + C_BV + vch * 8); vpre1 = *(const u32x4*)(Pb + (size_t)(key0 + 32 + vkey) * PP + C_BV + 128 + vch * 8); }
            f4 sc[2];
#pragma unroll
            for (int k2 = 0; k2 < 2; ++k2) { f4 t = (f4){0.f, 0.f, 0.f, 0.f};
                t = __builtin_amdgcn_mfma_f32_16x16x32_bf16(KQ_(h, k2, 0), qa[h][0], t, 0, 0, 0); t = __builtin_amdgcn_mfma_f32_16x16x32_bf16(KQ_(h, k2, 1), qa[h][1], t, 0, 0, 0);
#pragma unroll
                for (int e = 0; e < 4; ++e) sc[k2][e] = sel[k2][e] ? t[e] * 0.125f : -INFINITY; }
            float mx = fmaxf(fmaxf(fmaxf(sc[0][0], sc[0][1]), fmaxf(sc[0][2], sc[0][3])), fmaxf(fmaxf(sc[1][0], sc[1][1]), fmaxf(sc[1][2], sc[1][3])));
            mx = fmaxf(mx, __shfl_xor(mx, 16)); mx = fmaxf(mx, __shfl_xor(mx, 32));
            const float mnew = fmaxf(mrun[h], mx), msafe = (mnew == -INFINITY) ? 0.f : mnew;
            const float corr = __expf(mrun[h] - msafe); mrun[h] = mnew;
            float p[8]; float ps = 0.f;
#pragma unroll
            for (int e = 0; e < 4; ++e) { p[e] = __expf(sc[0][e] - msafe); p[4 + e] = __expf(sc[1][e] - msafe); ps += p[e] + p[4 + e]; }
            lrun[h] = lrun[h] * corr + ps;
            union { bf16x8 v; unsigned u[4]; } pb;
            pb.u[0] = pg8::cvt_pk_bf16(p[0], p[1]); pb.u[1] = pg8::cvt_pk_bf16(p[2], p[3]); pb.u[2] = pg8::cvt_pk_bf16(p[4], p[5]); pb.u[3] = pg8::cvt_pk_bf16(p[6], p[7]);
            union { bf16x8 v; u32x2 h2[2]; } vf[4];
            const unsigned va = vrd + vbuf + (unsigned)(h * 128);
            asm volatile("ds_read_b64_tr_b16 %0, %8\n\tds_read_b64_tr_b16 %1, %8 offset:%9\n\tds_read_b64_tr_b16 %2, %8 offset:32\n\tds_read_b64_tr_b16 %3, %8 offset:%10\n\t"
                         "ds_read_b64_tr_b16 %4, %8 offset:64\n\tds_read_b64_tr_b16 %5, %8 offset:%11\n\tds_read_b64_tr_b16 %6, %8 offset:96\n\tds_read_b64_tr_b16 %7, %8 offset:%12\n\ts_waitcnt lgkmcnt(0)"
                         : "=&v"(vf[0].h2[0]), "=&v"(vf[0].h2[1]), "=&v"(vf[1].h2[0]), "=&v"(vf[1].h2[1]), "=&v"(vf[2].h2[0]), "=&v"(vf[2].h2[1]), "=&v"(vf[3].h2[0]), "=&v"(vf[3].h2[1])
                         : "v"(va), "i"(16 * VS * 2), "i"(16 * VS * 2 + 32), "i"(16 * VS * 2 + 64), "i"(16 * VS * 2 + 96) : "memory");
            __builtin_amdgcn_sched_barrier(0);
#pragma unroll
            for (int dt = 0; dt < 4; ++dt) { oacc[h][dt] = oacc[h][dt] * corr; oacc[h][dt] = __builtin_amdgcn_mfma_f32_16x16x32_bf16(vf[dt].v, pb.v, oacc[h][dt], 0, 0, 0); }
        }
    }
    __syncthreads();
    }
#undef KQ_
#undef KI_
    const size_t m = (size_t)bb * T + tq;
#pragma unroll
    for (int h = 0; h < 4; ++h) { float l = lrun[h]; l += __shfl_xor(l, 16); l += __shfl_xor(l, 32); const float inv = 1.f / l;
#pragma unroll
        for (int dt = 0; dt < 4; ++dt) { u32x2 w; w.x = pk2(oacc[h][dt][0] * inv, oacc[h][dt][1] * inv); w.y = pk2(oacc[h][dt][2] * inv, oacc[h][dt][3] * inv);
            *(u32x2*)(OB + m * 1024 + 256 + h * 64 + dt * 16 + 4 * g) = w; } }
    __syncthreads();
}
}

namespace awin {
typedef short bf16x8 __attribute__((ext_vector_type(8)));
typedef float f4 __attribute__((ext_vector_type(4)));
constexpr int EXS = 66;
constexpr int O_EX = 0;
constexpr int VSW = 72;
constexpr int O_VW = 101376;
__device__ __forceinline__ void item(LAS unsigned char* lds0, const int bb, const int blk, const int h, const bf16* P, bf16* OB, const int tid0) {
    unsigned lb_ = 0u; int tid_l = tid0; asm volatile("" : "+v"(lb_), "+v"(tid_l));
    LAS unsigned char* lds = lds0 + lb_; const int tid = tid_l, lane = tid & 63, wave = __builtin_amdgcn_readfirstlane(tid >> 6);
    const bf16* Pb = P + (size_t)bb * T * PP; const int start = blk * 128, g = lane >> 4, ln = lane & 15;
    LAS float* EX = (LAS float*)(lds + O_EX);
    LAS bf16* VW = (LAS bf16*)(lds + O_VW + wave * 4608);
#pragma unroll 1
    for (int s4 = 0; s4 < 4; ++s4) {
        const int st = wave * 4 + s4;
        const int grp = st < 8 ? 0 : (st < 16 ? 1 : 2);
        const int dil = grp == 0 ? 1 : (grp == 1 ? 4 : 16), win = grp == 0 ? 128 : (grp == 1 ? 512 : 2048);
        const int r = grp == 0 ? 0 : (grp == 1 ? ((st - 8) >> 1) : (st - 16)), a0 = grp == 0 ? 16 * st : (grp == 1 ? ((st - 8) & 1) * 16 : 0), nqc = grp == 0 ? 128 : (grp == 1 ? 32 : 8);
        const int a = a0 + ln; const bool qok = a < nqc; const int ql = (qok ? a : (nqc - 1)) * dil + r, tq = start + ql;
        const bf16* qp = Pb + (size_t)tq * PP + C_AQ + grp * 256 + h * 64 + g * 8;
        const bf16x8 q0 = *(const bf16x8*)qp, q1 = *(const bf16x8*)(qp + 32);
        bf16x8 kf[10][2];
#pragma unroll
        for (int kt = 0; kt < 10; ++kt) { int pos = start - win + (a0 + 16 * kt + ln) * dil + r; pos = pos < 0 ? 0 : (pos > T - 1 ? T - 1 : pos);
            const bf16* kp = Pb + (size_t)pos * PP + C_AK + grp * 256 + h * 64 + g * 8; kf[kt][0] = *(const bf16x8*)kp; kf[kt][1] = *(const bf16x8*)(kp + 32); }
        f4 sc[10]; float mx = -INFINITY;
#pragma unroll
        for (int kt = 0; kt < 10; ++kt) { f4 t = (f4){0.f, 0.f, 0.f, 0.f};
            t = __builtin_amdgcn_mfma_f32_16x16x32_bf16(kf[kt][0], q0, t, 0, 0, 0); t = __builtin_amdgcn_mfma_f32_16x16x32_bf16(kf[kt][1], q1, t, 0, 0, 0);
#pragma unroll
            for (int e = 0; e < 4; ++e) { const int c = a0 + 16 * kt + 4 * g + e; const int pos = start - win + c * dil + r;
                const bool ok = qok && c >= a && c <= a + 128 && pos >= 0;
                sc[kt][e] = ok ? t[e] * 0.125f : -INFINITY; mx = fmaxf(mx, sc[kt][e]); } }
        mx = fmaxf(mx, __shfl_xor(mx, 16)); mx = fmaxf(mx, __shfl_xor(mx, 32));
        const float msafe = (mx == -INFINITY) ? 0.f : mx; float lsum = 0.f;
#pragma unroll
        for (int kt = 0; kt < 10; ++kt)
#pragma unroll
            for (int e = 0; e < 4; ++e) { sc[kt][e] = __expf(sc[kt][e] - msafe); lsum += sc[kt][e]; }
        lsum += __shfl_xor(lsum, 16); lsum += __shfl_xor(lsum, 32);
        f4 oacc[4];
#pragma unroll
        for (int dt = 0; dt < 4; ++dt) oacc[dt] = (f4){0.f, 0.f, 0.f, 0.f};
#pragma unroll
        for (int s5 = 0; s5 < 5; ++s5) {
            int pos = start - win + (a0 + 32 * s5 + (lane >> 1)) * dil + r; pos = pos < 0 ? 0 : (pos > T - 1 ? T - 1 : pos);
            const u32x4* vp = (const u32x4*)(Pb + (size_t)pos * PP + C_AV + grp * 256 + h * 64 + (lane & 1) * 32);
            const u32x4 v0 = vp[0], v1 = vp[1], v2 = vp[2], v3 = vp[3];
            LAS u32x4* vd = (LAS u32x4*)(VW + (lane >> 1) * VSW + (lane & 1) * 32);
            asm volatile("s_waitcnt lgkmcnt(0)" ::: "memory");
            vd[0] = v0; vd[1] = v1; vd[2] = v2; vd[3] = v3;
            asm volatile("s_waitcnt lgkmcnt(0)" ::: "memory");
            bf16x8 pb;
#pragma unroll
            for (int e = 0; e < 4; ++e) { pb[e] = (short)f2bf(sc[2 * s5][e]); pb[4 + e] = (short)f2bf(sc[2 * s5 + 1][e]); }
#pragma unroll
            for (int dt = 0; dt < 4; ++dt) { bf16x8 vf; const LAS bf16* vb = VW + (4 * g) * VSW + dt * 16 + ln;
#pragma unroll
                for (int e = 0; e < 4; ++e) { vf[e] = (short)vb[e * VSW]; vf[4 + e] = (short)vb[(16 + e) * VSW]; }
                oacc[dt] = __builtin_amdgcn_mfma_f32_16x16x32_bf16(vf, pb, oacc[dt], 0, 0, 0); }
        }
        if (qok) { LAS float* ex = EX + (grp * 128 + ql) * EXS;
#pragma unroll
            for (int dt = 0; dt < 4; ++dt) { ex[dt * 16 + 4 * g + 0] = oacc[dt][0]; ex[dt * 16 + 4 * g + 1] = oacc[dt][1]; ex[dt * 16 + 4 * g + 2] = oacc[dt][2]; ex[dt * 16 + 4 * g + 3] = oacc[dt][3]; }
            if (g == 0) { ex[64] = mx; ex[65] = lsum; } }
    }
    __syncthreads();
    { const int ql = tid >> 2, d0 = (tid & 3) * 16;
      const LAS float* e0 = EX + (0 * 128 + ql) * EXS; const LAS float* e1 = EX + (1 * 128 + ql) * EXS; const LAS float* e2 = EX + (2 * 128 + ql) * EXS;
      const float m0 = e0[64], m1 = e1[64], m2 = e2[64], M = fmaxf(m0, fmaxf(m1, m2));
      const float w0 = __expf(m0 - M), w1 = __expf(m1 - M), w2 = __expf(m2 - M); const float inv = 1.f / (w0 * e0[65] + w1 * e1[65] + w2 * e2[65]);
      unsigned pk[8];
#pragma unroll
      for (int j = 0; j < 8; ++j) { const float x0 = (w0 * e0[d0 + 2 * j] + w1 * e1[d0 + 2 * j] + w2 * e2[d0 + 2 * j]) * inv, x1 = (w0 * e0[d0 + 2 * j + 1] + w1 * e1[d0 + 2 * j + 1] + w2 * e2[d0 + 2 * j + 1]) * inv; pk[j] = pk2(x0, x1); }
      u32x4* op = (u32x4*)(OB + ((size_t)bb * T + start + ql) * 1024 + h * 64 + d0);
      op[0] = (u32x4){pk[0], pk[1], pk[2], pk[3]}; op[1] = (u32x4){pk[4], pk[5], pk[6], pk[7]}; }
    __syncthreads();
}
}

template <int SP>
__device__ __forceinline__ void phase_body(const int l_in, LAS unsigned char* lds) {
    int tid_ = threadIdx.x, bid_ = blockIdx.x, l_ = l_in, G_ = gridDim.x; asm volatile("" : "+v"(tid_), "+s"(bid_), "+s"(l_), "+s"(G_));
    const int tid = tid_, lane = tid & 63, wave = __builtin_amdgcn_readfirstlane(tid >> 6), l = l_;
    const int G = G_, bid = bid_;
    const int gw = bid * NWAVES + wave, NGW = G * NWAVES;
    unsigned char* ws = (unsigned char*)gptr(ldptr(lds, 36));
    int* ctl = (int*)(ws + WS_CTL);
    bf16* XB = (bf16*)(ws + WS_XB); bf16* OB = (bf16*)(ws + WS_O); bf16* VF = (bf16*)(ws + WS_VF); bf16* P = (bf16*)(ws + WS_P);
    bf16* GS = (bf16*)(ws + WS_GS); bf16* MG = (bf16*)(ws + WS_MERGED); bf16* XS = (bf16*)(ws + WS_XS); bf16* HB = (bf16*)(ws + WS_H);
    bf16* WGU = (bf16*)(ws + WS_WGU); bf16* WD = (bf16*)(ws + WS_WD);
    float* X = (float*)gptr(ldptr(lds, 35));
    int* tok_e = (int*)(ws + WS_ROUTE); float* tok_g = (float*)(ws + WS_ROUTE + 256 * 1024); int* tok_rank = (int*)(ws + WS_ROUTE + 512 * 1024); int* tok_slot = (int*)(ws + WS_ROUTE + 768 * 1024);
    (void)ctl; (void)XB; (void)OB; (void)VF; (void)P; (void)GS; (void)MG; (void)XS; (void)HB; (void)WGU; (void)WD; (void)X; (void)tok_e; (void)tok_g; (void)tok_rank; (void)tok_slot; (void)gw; (void)NGW; (void)lane;
    {
        bf16* WinT = (bf16*)(ws + WS_WINT) + (size_t)l * 5120 * 1024; bf16* WgT = (bf16*)(ws + WS_WGT) + (size_t)l * 4096 * 1024;
        bf16* WbrT = (bf16*)(ws + WS_WBRT) + (size_t)l * 1024 * 1024; bf16* WoutT = (bf16*)(ws + WS_WOUTT) + (size_t)l * 1024 * 1024;
        float* WrT = (float*)(ws + WS_WRT) + (size_t)l * 36 * 1024;
        int* cnt = ctl + CW_CNT + l * 64;

        if constexpr (SP == -1) {
            LAS float* scr = (LAS float*)(lds + wave * 16384);
#pragma unroll 1
            for (int job = 0; job < NL * 11; ++job) {
                const int ll = job / 11, jk = job % 11;
                if (jk < 5) {
                    const float* W = INP(I_WIN) + (size_t)ll * 1024 * INW;
                    const int sc0 = jk == 0 ? 0 : (jk == 1 ? 3396 : (jk == 2 ? 3392 : (jk == 3 ? 5060 : 5064)));
                    const int snc = jk == 0 ? 3392 : (jk == 1 ? 1664 : (jk == 4 ? 4096 : 4));
                    const int sr0 = jk == 0 ? 0 : (jk == 1 ? 3392 : (jk == 2 ? 5056 : (jk == 3 ? 5060 : 0)));
                    bf16* dst = jk == 4 ? (bf16*)(ws + WS_WGT) + (size_t)ll * 4096 * 1024 : (bf16*)(ws + WS_WINT) + (size_t)ll * 5120 * 1024;
                    const int nbn = (snc + 31) / 32, nit = 16 * nbn;
#pragma unroll 1
                    for (int it = gw; it < nit; it += NGW) transpose_item(W, INW, sc0, snc, dst, 1024, sr0, 0, it / nbn, it % nbn, scr, lane);
                } else if (jk < 9) {
                    const int n = jk - 5; const float* Wb = INP(I_WBR) + ((size_t)ll * 4 + n) * 256 * 1024;
#pragma unroll 1
                    for (int it = gw; it < 4 * 32; it += NGW) transpose_item(Wb, 1024, 0, 1024, (bf16*)(ws + WS_WBRT) + (size_t)ll * 1024 * 1024, 1024, 0, n * 256, it / 32, it % 32, scr, lane);
                } else if (jk == 9) {
                    const float* Wo = INP(I_WOUT) + (size_t)ll * 1024 * 1024;
#pragma unroll 1
                    for (int it = gw; it < 16 * 32; it += NGW) transpose_item(Wo, 1024, 0, 1024, (bf16*)(ws + WS_WOUTT) + (size_t)ll * 1024 * 1024, 1024, 0, 0, it / 32, it % 32, scr, lane);
                } else {
                    bf16* wi = (bf16*)(ws + WS_WINT) + (size_t)ll * 5120 * 1024;
#pragma unroll 1
                    for (int i = gw * 64 + lane; i < 56 * 1024 / 8; i += NGW * 64) ((u32x4*)(wi + (size_t)5064 * 1024))[i] = (u32x4){0u, 0u, 0u, 0u};
                    float* wr = (float*)(ws + WS_WRT) + (size_t)ll * 36 * 1024; const float* rg = INP(I_RG) + (size_t)ll * 1024 * 4; const float* re = INP(I_RE) + (size_t)ll * 1024 * 32;
#pragma unroll 1
                    for (int i = gw * 64 + lane; i < 36 * 1024; i += NGW * 64) { const int o = i / 1024, k = i % 1024; wr[i] = o < 4 ? rg[k * 4 + o] : re[k * 32 + (o - 4)]; }
                }
            }
            for (int m = gw; m < M; m += NGW) {
                const f32x4* xr = (const f32x4*)(INP(I_X) + (size_t)m * D) + lane;
#pragma unroll
                for (int j = 0; j < 4; ++j) { const f32x4 v = xr[64 * j]; ((f32x4*)(X + (size_t)m * D))[lane + 64 * j] = v;
                    u32x2 w; w.x = pk2(v[0], v[1]); w.y = pk2(v[2], v[3]); ((u32x2*)(XB + (size_t)m * D))[lane + 64 * j] = w; }
            }
        }
        else if constexpr (SP == 0) {
            pg8::Gemm g{XB, WinT, 1024, 1024, 1024}; pg8::StaticOrder S; S.init(M, PP, G, bid, 1024, 1024);
            EpiStoreBf16 E{P, PP, 0, PP};
            pg8::gemm_phase<EpiStoreBf16, pg8::StaticOrder>(lds, g, S, E);
        }
        else if constexpr (SP == 12) {
            if (bid < 32) rw::carry(lds, ws + WS_RW + (size_t)bid * 64 * 16384, tid);
        }
        else if constexpr (SP == 13) {
            unsigned char* GZ = ws + WS_RW;
            const int h = bid & 3, k = bid >> 2;
            rw::build_ct(lds, l, h, lane, wave); __syncthreads();
#pragma unroll 1
            for (int idx = k; idx < 512; idx += (G >> 2)) { const int b = idx >> 6, cI = idx & 63; const size_t ci_ = (size_t)((b * 4 + h) * 64 + cI);
                rw::chunk_out(lds, b, h, cI * 64, GZ + ci_ * 16384, ws + WS_RW2 + ci_ * 24576, (const float*)(ws + WS_BONG) + ci_ * 64, VF, OB, tid); }
        }
        else if constexpr (SP == 15) {
            unsigned char* GZ = ws + WS_RW;
            int* qctr = ctl + CW_Q + l * 64;
            int cur_h = -1;
#pragma unroll 1
            for (;;) {
                unsigned so = (unsigned)(LDS_BYTES - 584); asm volatile("" : "+v"(so));
                volatile LAS int* slot = (volatile LAS int*)(lds + so);
                int tid = threadIdx.x; asm volatile("" : "+v"(tid));
                const int lane = tid & 63, wave = __builtin_amdgcn_readfirstlane(tid >> 6);
                __syncthreads();
                if (tid == 0) *slot = atomicAdd(qctr, 1);
                __syncthreads();
                const int it = __builtin_amdgcn_readfirstlane(*slot);
                if (it >= 3344) break;
                if (it < 16) { mb::chain(lds, l, it >> 1, it & 1, P, OB, tid, lane, wave); }
                else if (it < 272) { const int j = it - 16; bsp::item(lds, j & 7, 31 - (j >> 3), P, OB, tid, (int)(unsigned)ldptr(lds, 37)); }
                else if (it < 2320) { const int j = it - 272, h = j >> 9, idx = j & 511, b = idx >> 6, cI = idx & 63;
                    if (h != cur_h) { rw::build_ct(lds, l, h, lane, wave); cur_h = h; __syncthreads(); }
                    { const size_t ci_ = (size_t)((b * 4 + h) * 64 + cI); rw::chunk<1>(lds, l, b, h, cI * 64, GZ + ci_ * 16384, ws + WS_RW2 + ci_ * 24576, (float*)(ws + WS_BONG) + ci_ * 64, P, VF, OB, tid); } }
                else { const int j = it - 2320; awin::item(lds, j >> 7, (j >> 2) & 31, j & 3, P, OB, tid); }
            }
        }
        else if constexpr (SP == 4) {
            if (bid < 32) { rw::carry(lds, ws + WS_RW + (size_t)bid * 64 * 16384, tid); __syncthreads(); }
            pg8::Gemm g{XB, WgT, 1024, 1024, 1024}; SkewOrder S{M / 256, 16, (M / 256) * 16, bid, 1024, 1024};
            EpiStoreBf16 E{GS, 4096, 1, 4096};
            pg8::gemm_phase<EpiStoreBf16, SkewOrder>(lds, g, S, E);
        }
        else if constexpr (SP == 5) {
            pg8::Gemm g{OB, WbrT, 1024, 1024, 256}; BranchOrder S{M / 256, 4, G, bid};
            EpiBranch E{GS, MG};
            pg8::gemm_phase<EpiBranch, BranchOrder>(lds, g, S, E);
        }
        else if constexpr (SP == 6) {
            pg8::Gemm g{MG, WoutT, 1024, 1024, 1024}; pg8::StaticOrder S; S.init(M, 1024, G, bid, 1024, 1024);
            EpiResid E{X};
            pg8::gemm_phase<EpiResid, pg8::StaticOrder>(lds, g, S, E);
        }
        else if constexpr (SP == 7) {
            const float* g1 = INP(I_LN1G) + l * 1024; const float* b1 = INP(I_LN1B) + l * 1024;
            const float* rgb = INP(I_RGB) + l * 4; const float* reb = INP(I_REB) + l * 32;
            f32x4 vn[4];
#pragma unroll
            for (int j = 0; j < 4; ++j) vn[j] = ((const f32x4*)(X + (size_t)gw * D))[lane + 64 * j];
#pragma unroll 1
            for (int m = gw; m < M; m += NGW) {
                f32x4 v[4]; float s = 0.f; f32x4* xr = (f32x4*)(X + (size_t)m * D) + lane;
#pragma unroll
                for (int j = 0; j < 4; ++j) { v[j] = vn[j]; s += (v[j][0] + v[j][1]) + (v[j][2] + v[j][3]); }
                { const int mnx = (m + NGW < M) ? m + NGW : m;
#pragma unroll
                  for (int j = 0; j < 4; ++j) vn[j] = ((const f32x4*)(X + (size_t)mnx * D))[lane + 64 * j]; }
                const float mean = wave_sum(s) * (1.f / D); float s2 = 0.f;
#pragma unroll
                for (int j = 0; j < 4; ++j) { v[j] = v[j] - mean; s2 += (v[j][0] * v[j][0] + v[j][1] * v[j][1]) + (v[j][2] * v[j][2] + v[j][3] * v[j][3]); }
                const float rstd = rsqrtf(wave_sum(s2) * (1.f / D) + LN_EPS);
#pragma unroll
                for (int j = 0; j < 4; ++j) { const f32x4 gg = ((const f32x4*)g1)[lane + 64 * j], bb = ((const f32x4*)b1)[lane + 64 * j]; v[j] = v[j] * rstd * gg + bb; xr[64 * j] = v[j];
                    u32x2 w; w.x = pk2(v[j][0], v[j][1]); w.y = pk2(v[j][2], v[j][3]); ((u32x2*)(XB + (size_t)m * D))[lane + 64 * j] = w; }
                float mylg = 0.f;
#pragma unroll 1
                for (int o4 = 0; o4 < 36; o4 += 4) { float a4[4];
#pragma unroll
                    for (int u = 0; u < 4; ++u) { float a = 0.f;
#pragma unroll
                        for (int j = 0; j < 4; ++j) { const f32x4 wv = ((const f32x4*)(WrT + (o4 + u) * 1024))[lane + 64 * j]; a += v[j][0] * wv[0] + v[j][1] * wv[1] + v[j][2] * wv[2] + v[j][3] * wv[3]; }
                        a4[u] = a; }
#pragma unroll
                    for (int sft = 1; sft < 64; sft <<= 1) {
#pragma unroll
                        for (int u = 0; u < 4; ++u) a4[u] += __shfl_xor(a4[u], sft); }
#pragma unroll
                    for (int u = 0; u < 4; ++u) mylg = (lane == o4 + u) ? a4[u] : mylg; }
                mylg += lane < 4 ? rgb[lane & 3] : (lane < 36 ? reb[(lane - 4) & 31] : 0.f);
                float gl[4]; float gm = -INFINITY; int gs = 0;
#pragma unroll
                for (int o = 0; o < 4; ++o) { gl[o] = __shfl(mylg, o); if (gl[o] > gm) { gm = gl[o]; gs = o; } }
                float gden = 0.f;
#pragma unroll
                for (int o = 0; o < 4; ++o) gden += __expf(gl[o] - gm);
                const float pg = 1.f / gden;
                float el[8];
#pragma unroll
                for (int o = 0; o < 8; ++o) el[o] = __shfl(mylg, 4 + gs * 8 + o);
                int e1 = 0; float m1 = el[0];
#pragma unroll
                for (int o = 1; o < 8; ++o) if (el[o] > m1) { m1 = el[o]; e1 = o; }
                int e2 = -1; float m2 = -INFINITY;
#pragma unroll
                for (int o = 0; o < 8; ++o) if (o != e1 && el[o] > m2) { m2 = el[o]; e2 = o; }
                const float r2 = __expf(m2 - m1); const float ga = pg / (1.f + r2), gb = pg * r2 / (1.f + r2);
                if (lane == 0) {
                    const int E1 = gs * 8 + e1, E2 = gs * 8 + e2;
                    tok_e[m * 2] = E1; tok_e[m * 2 + 1] = E2; tok_g[m * 2] = ga; tok_g[m * 2 + 1] = gb;
                    tok_rank[m * 2] = atomicAdd(&cnt[E1], 1); tok_rank[m * 2 + 1] = atomicAdd(&cnt[E2], 1);
                }
            }
        }
        else if constexpr (SP == 14) {
            LAS float* scr = (LAS float*)(lds + wave * 16384);
            const float* eg = INP(I_EG) + (size_t)l * NEXP * 1024 * 512; const float* eu = INP(I_EU) + (size_t)l * NEXP * 1024 * 512; const float* ed = INP(I_ED) + (size_t)l * NEXP * 512 * 1024;
            for (int it = gw; it < NEXP * 2 * 4 * 64; it += NGW) {
                const int e = it / 512, r = it % 512, half = r / 256, ct = (r % 256) / 64, q = r % 64, kb = q / 4, nb = q % 4;
                const float* W = (half ? eu : eg) + (size_t)e * 1024 * 512;
                transpose_item(W, 512, ct * 128, 128, WGU + (size_t)e * 1024 * 1024, 1024, ct * 256 + half * 128, 0, kb, nb, scr, lane);
            }
            for (int it = gw; it < NEXP * 8 * 32; it += NGW) {
                const int e = it / 256, q = it % 256, kb = q / 32, nb = q % 32;
                transpose_item(ed + (size_t)e * 512 * 1024, 1024, 0, 1024, WD + (size_t)e * 1024 * 512, 512, 0, 0, kb, nb, scr, lane);
            }
        }
        else if constexpr (SP == 8 || SP == 9 || SP == 10) {
            unsigned tbo = MISC_OFF; asm volatile("" : "+v"(tbo));
            volatile LAS int* tb = (volatile LAS int*)(lds + tbo);
            if (tid == 0) { int acc = 0; for (int e = 0; e < 32; ++e) { const int c = __hip_atomic_load(&cnt[e], __ATOMIC_RELAXED, __HIP_MEMORY_SCOPE_AGENT); tb[e] = acc; tb[33 + e] = acc; acc += (c + 255) >> 8; } tb[32] = acc; }
            __syncthreads();
            if constexpr (SP == 8) {
                for (int m = gw; m < M; m += NGW) {
#pragma unroll
                    for (int k = 0; k < 2; ++k) { const int e = tok_e[m * 2 + k]; const int slot = tb[33 + e] * 256 + tok_rank[m * 2 + k];
                        const u32x4* src = (const u32x4*)(XB + (size_t)m * D); u32x4* dst = (u32x4*)(XS + (size_t)slot * D);
                        dst[lane] = src[lane]; dst[lane + 64] = src[lane + 64];
                        if (lane == 0) tok_slot[m * 2 + k] = slot; }
                }
            } else if constexpr (SP == 9) {
                pg8::Gemm g{XS, WGU, 1024, 1024, 1024}; MoeOrder S{tb, G, bid, (size_t)1024 * 2, (size_t)1024 * 1024 * 2, (size_t)256 * 1024 * 2};
                EpiSwiglu E{HB};
                pg8::gemm_phase<EpiSwiglu, MoeOrder>(lds, g, S, E);
            } else {
                pg8::Gemm g{HB, WD, 512, 512, 512}; MoeOrder S{tb, G, bid, (size_t)512 * 2, (size_t)1024 * 512 * 2, (size_t)256 * 512 * 2};
                EpiStoreBf16 E{XS, 1024, 0, 1024};
                pg8::gemm_phase<EpiStoreBf16, MoeOrder>(lds, g, S, E);
            }
        }
        else if constexpr (SP == 11) {
            const float* g2 = INP(I_LN2G) + l * 1024; const float* b2 = INP(I_LN2B) + l * 1024;
            f32x4 xn[4]; u32x2 y1n[4], y2n[4]; float gan, gbn;
#define LN2_LOAD(mm) do { const int s1_ = tok_slot[(mm) * 2], s2_ = tok_slot[(mm) * 2 + 1]; gan = tok_g[(mm) * 2]; gbn = tok_g[(mm) * 2 + 1]; \
                _Pragma("unroll") for (int j = 0; j < 4; ++j) { xn[j] = ((const f32x4*)(X + (size_t)(mm) * D))[lane + 64 * j]; y1n[j] = ((const u32x2*)(XS + (size_t)s1_ * D))[lane + 64 * j]; y2n[j] = ((const u32x2*)(XS + (size_t)s2_ * D))[lane + 64 * j]; } } while (0)
            LN2_LOAD(gw);
#pragma unroll 1
            for (int m = gw; m < M; m += NGW) {
                const float ga = gan, gb = gbn;
                f32x4 v[4]; float s = 0.f; f32x4* xr = (f32x4*)(X + (size_t)m * D) + lane;
                u32x2 y1c[4], y2c[4];
#pragma unroll
                for (int j = 0; j < 4; ++j) { v[j] = xn[j] * ALPHA; y1c[j] = y1n[j]; y2c[j] = y2n[j]; }
                { const int mnx = (m + NGW < M) ? m + NGW : m; LN2_LOAD(mnx); }
#pragma unroll
                for (int j = 0; j < 4; ++j) { const u32x2 y1 = y1c[j], y2 = y2c[j];
                    v[j][0] += ga * __uint_as_float(y1.x << 16) + gb * __uint_as_float(y2.x << 16); v[j][1] += ga * __uint_as_float(y1.x & 0xffff0000u) + gb * __uint_as_float(y2.x & 0xffff0000u);
                    v[j][2] += ga * __uint_as_float(y1.y << 16) + gb * __uint_as_float(y2.y << 16); v[j][3] += ga * __uint_as_float(y1.y & 0xffff0000u) + gb * __uint_as_float(y2.y & 0xffff0000u);
                    s += (v[j][0] + v[j][1]) + (v[j][2] + v[j][3]); }
                const float mean = wave_sum(s) * (1.f / D); float s2 = 0.f;
#pragma unroll
                for (int j = 0; j < 4; ++j) { v[j] = v[j] - mean; s2 += (v[j][0] * v[j][0] + v[j][1] * v[j][1]) + (v[j][2] * v[j][2] + v[j][3] * v[j][3]); }
                const float rstd = rsqrtf(wave_sum(s2) * (1.f / D) + LN_EPS);
#pragma unroll
                for (int j = 0; j < 4; ++j) { const f32x4 gg = ((const f32x4*)g2)[lane + 64 * j], bb = ((const f32x4*)b2)[lane + 64 * j]; v[j] = v[j] * rstd * gg + bb; xr[64 * j] = v[j];
                    u32x2 w; w.x = pk2(v[j][0], v[j][1]); w.y = pk2(v[j][2], v[j][3]); ((u32x2*)(XB + (size_t)m * D))[lane + 64 * j] = w; }
            }
        }
    }
}

template <int SP>
__global__ void __launch_bounds__(NTHR, 2) k_phase(Args args, int l) {
    extern __shared__ __attribute__((aligned(16))) unsigned char lds_raw[];
    ptr_table_fill(args, (LAS unsigned char*)lds_raw);
    phase_body<SP>(l, (LAS unsigned char*)lds_raw);
}


#define XB_TMO      128
#define XB_XCNT(j)  (256  + 64 * (j))
#define XB_XSUB(j)  (1280 + 64 * (j))
#define XB_XGEN(j)  (2304 + 64 * (j))
#define XB_TOP      3328
#define XB_TOPGEN   3392
#define XCD_BAR_WORDS 3456
#define XB_SPIN_CAP (1u << 22)
__device__ __forceinline__ unsigned xb_ld(unsigned* p)              { return __hip_atomic_load(p, __ATOMIC_RELAXED, __HIP_MEMORY_SCOPE_AGENT); }
__device__ __forceinline__ unsigned xb_add(unsigned* p, unsigned v) { return __hip_atomic_fetch_add(p, v, __ATOMIC_RELAXED, __HIP_MEMORY_SCOPE_AGENT); }
__device__ __forceinline__ unsigned xb_xcc_id() { return (unsigned)__builtin_amdgcn_s_getreg((3 << 11) | 20) & 0xFu; }
#define XB_SPIN(cond, bar) do { unsigned _sp = 0; while (cond) { __builtin_amdgcn_s_sleep(1); \
    if ((++_sp & 255u) == 0u) { if (xb_ld(&(bar)[XB_TMO])) break; if (_sp > XB_SPIN_CAP) { atomicAdd(&(bar)[XB_TMO], 1u); break; } } } } while (0)
__device__ __forceinline__ void xcd_barrier_complete(unsigned* bar, unsigned x, unsigned& nloc, unsigned& nx) {
    const unsigned G = gridDim.x;
    unsigned sum, cnt, mine, sp = 0u;
    for (;;) {
        sum = 0u; cnt = 0u; mine = 0u;
#pragma unroll
        for (unsigned j = 0; j < 16; ++j) { const unsigned c = xb_ld(&bar[XB_XCNT(j)]); sum += c; cnt += (c > 0u) ? 1u : 0u; mine = (j == x) ? c : mine; }
        if (sum == G) break;
        __builtin_amdgcn_s_sleep(1);
        if ((++sp & 255u) == 0u) { if (xb_ld(&bar[XB_TMO])) break; if (sp > XB_SPIN_CAP) { atomicAdd(&bar[XB_TMO], 1u); break; } }
    }
    nloc = mine > 0u ? mine : 1u; nx = cnt > 0u ? cnt : 1u;
}
__device__ __forceinline__ void xcd_barrier(unsigned* bar, LAS unsigned char* lds) {
    asm volatile("s_waitcnt vmcnt(0)" ::: "memory");
    __syncthreads();
    int tid_ = threadIdx.x; asm volatile("" : "+v"(tid_));
    if (tid_ == 0) {
        unsigned so = (unsigned)(LDS_BYTES - 576); asm volatile("" : "+v"(so));
        volatile LAS unsigned* st = (volatile LAS unsigned*)(lds + so);
        __builtin_amdgcn_s_waitcnt(0);
        const unsigned x = xb_xcc_id();
        unsigned nloc = st[0], nx = st[1];
        if (nloc == 0u) { xcd_barrier_complete(bar, x, nloc, nx); st[0] = nloc; st[1] = nx; }
        const unsigned old = xb_add(&bar[XB_XSUB(x)], 1u);
        const unsigned gen = old / nloc;
        if (old + 1u == (gen + 1u) * nloc) {
            __builtin_amdgcn_fence(__ATOMIC_RELEASE, "agent");
            asm volatile("s_waitcnt vmcnt(0)" ::: "memory");
            const unsigned og = xb_add(&bar[XB_TOP], 1u);
            const unsigned tg = og / nx;
            if (og + 1u == (tg + 1u) * nx) xb_add(&bar[XB_TOPGEN], 1u);
            else XB_SPIN(xb_ld(&bar[XB_TOPGEN]) == tg, bar);
            __builtin_amdgcn_fence(__ATOMIC_ACQUIRE, "agent");
            xb_add(&bar[XB_XGEN(x)], 1u);
            asm volatile("s_waitcnt vmcnt(0)" ::: "memory");
        } else {
            XB_SPIN(xb_ld(&bar[XB_XGEN(x)]) == gen, bar);
            __builtin_amdgcn_fence(__ATOMIC_ACQUIRE, "agent");
            asm volatile("s_waitcnt vmcnt(0)" ::: "memory");
        }
    }
    __syncthreads();
}
namespace cg = cooperative_groups;
__global__ void __launch_bounds__(NTHR, 2) fwd_all(Args args) {
    extern __shared__ __attribute__((aligned(16))) unsigned char lds_raw[];
    LAS unsigned char* lds = (LAS unsigned char*)lds_raw;
    unsigned* bar = (unsigned*)(args.ws + WS_CTL) + CW_BAR;
    if (threadIdx.x == 0) { ((volatile LAS unsigned*)(lds + LDS_BYTES - 576))[0] = 0u; ((volatile LAS unsigned*)(lds + LDS_BYTES - 576))[1] = 0u; (void)xb_add(&bar[XB_XCNT(xb_xcc_id())], 1u); }
    ptr_table_fill(args, lds);
    const int probe = args.ph_lo;
    { constexpr int l = 0;
#pragma unroll 1
      for (int r_ = 0; r_ < ((probe == -1) ? 2 : 1); ++r_) { phase_body<-1>(l, lds); __syncthreads(); } }
    cg::this_grid().sync();
#define GRID_BAR() do { unsigned* bar_ = (unsigned*)gptr(ldptr(lds, 36)) + CW_BAR; xcd_barrier(bar_, lds); } while (0)
#define RUN(SP) do { _Pragma("unroll 1") for (int r_ = 0; r_ < ((probe == (SP)) ? 2 : 1); ++r_) { phase_body<SP>(l, lds); __syncthreads(); } } while (0)
#define ONCE(SP) do { phase_body<SP>(l, lds); __syncthreads(); } while (0)
#define LAYER() \
        RUN(0); GRID_BAR(); \
        ONCE(15); GRID_BAR(); \
        ONCE(4); GRID_BAR(); \
        RUN(13); GRID_BAR(); \
        RUN(5); GRID_BAR(); \
        ONCE(6); GRID_BAR(); \
        ONCE(7); RUN(14); GRID_BAR(); \
        RUN(8); GRID_BAR(); \
        RUN(9); GRID_BAR(); \
        RUN(10); GRID_BAR(); \
        ONCE(11); GRID_BAR();
    { constexpr int l = 0; LAYER() }
    { constexpr int l = 1; LAYER() }
#undef LAYER
#undef RUN
#undef ONCE
#undef GRID_BAR
}

template <int SP> static void launch_phase(const Args& a, int l, int grid, hipStream_t stream) {
    static bool attr = false;
    if (!attr) { (void)hipFuncSetAttribute((const void*)k_phase<SP>, hipFuncAttributeMaxDynamicSharedMemorySize, LDS_BYTES); attr = true; }
    hipLaunchKernelGGL(k_phase<SP>, dim3(grid), dim3(NTHR), LDS_BYTES, stream, a, l);
}

extern "C" void kernel_launch(void* const* d_in, const int* in_sizes, int n_in, void* d_out, int out_size, void* d_ws, size_t ws_size, hipStream_t stream) {
    static int grid = 0;
    if (grid == 0) {
        if (n_in != 35 || out_size != M * D || ws_size < WS_END) { fprintf(stderr, "kernel_launch: unexpected problem (n_in %d out %d ws %zu)\n", n_in, out_size, ws_size); grid = -1; return; }
        int dev = 0, cus = 0, per_cu = 0;
        (void)hipGetDevice(&dev); (void)hipDeviceGetAttribute(&cus, hipDeviceAttributeMultiprocessorCount, dev);
#if N_LAUNCH_MODE == 1
        (void)hipFuncSetAttribute((const void*)fwd_all, hipFuncAttributeMaxDynamicSharedMemorySize, LDS_BYTES);
        if (hipOccupancyMaxActiveBlocksPerMultiprocessor(&per_cu, (const void*)fwd_all, NTHR, LDS_BYTES) != hipSuccess || per_cu < 1) { fprintf(stderr, "kernel_launch: occupancy query says %d blocks/CU\n", per_cu); grid = -1; return; }
#endif
        (void)per_cu;
        grid = cus;
        if (grid != 256) { fprintf(stderr, "kernel_launch: built for 256 CUs, found %d\n", cus); grid = -1; return; }
    }
    if (grid < 0) return;
    (void)hipMemsetAsync((char*)d_ws + WS_CTL, 0, CTL_BYTES, stream);
    Args a{};
    for (int i = 0; i < 35; ++i) a.in[i] = (const float*)d_in[i];
    a.out = (float*)d_out; a.ws = (unsigned char*)d_ws;
#if N_LAUNCH_MODE == 1
    a.ph_lo = PROBE_REPS;
    void* kargs[] = {(void*)&a};
    hipError_t e = hipLaunchCooperativeKernel((const void*)fwd_all, dim3(grid), dim3(NTHR), kargs, LDS_BYTES, stream);
    if (e != hipSuccess) fprintf(stderr, "cooperative launch failed: %s\n", hipGetErrorString(e));
#else
    launch_phase<-1>(a, 0, grid, stream);
    for (int l = 0; l < NL; ++l) {
        launch_phase<0>(a, l, grid, stream); launch_phase<15>(a, l, grid, stream); launch_phase<4>(a, l, grid, stream); launch_phase<13>(a, l, grid, stream);
        launch_phase<5>(a, l, grid, stream); launch_phase<6>(a, l, grid, stream); launch_phase<7>(a, l, grid, stream); launch_phase<14>(a, l, grid, stream);
        launch_phase<8>(a, l, grid, stream); launch_phase<9>(a, l, grid, stream); launch_phase<10>(a, l, grid, stream); launch_phase<11>(a, l, grid, stream);
    }
#endif
}
```

```cpp
#include <hip/hip_runtime.h>
#include <type_traits>
#include <cstdio>
#include <cstdint>
#include <hip/hip_cooperative_groups.h>

#ifndef PROBE_REPS
#define PROBE_REPS -100
#endif
#ifndef N_LAUNCH_MODE
#define N_LAUNCH_MODE 1
#endif

namespace pg8 {
#define PG8_LAS __attribute__((address_space(3)))
typedef unsigned short bf16_t;
typedef short bf16x8 __attribute__((ext_vector_type(8)));
typedef float f32x4 __attribute__((ext_vector_type(4)));
typedef unsigned u32x4 __attribute__((ext_vector_type(4)));
constexpr int BM = 256, BK = 64, HALF = 128, HTB = HALF * BK * 2, STAGE_BYTES = 8 * HTB, NXCD = 8, WGM = 8;

__host__ __device__ __forceinline__ int lds_byte(int r, int c) { const int st = (r >> 4) * 2 + (c >> 5), rr = r & 15, cc = c & 31, ob = rr * 64 + cc * 2; return st * 1024 + (ob ^ (((ob >> 9) & 1) << 5)); }
__host__ __device__ __forceinline__ void stage_rc(int b, int& R, int& C) { const int st = b / 1024, sb = b % 1024, swz = sb ^ (((sb >> 9) & 1) << 5); R = (st >> 1) * 16 + swz / 64; C = (st & 1) * 32 + (swz % 64) / 2; }
__host__ __device__ __forceinline__ int perm32(int rho) { const int n = rho >> 4, i = rho & 15; return 8 * (i >> 2) + 4 * n + (i & 3); }

struct Unit { int pm, pn, aux; size_t aoff, boff; };
struct Gemm { const bf16_t* A; const bf16_t* Bt; int lda, ldb, K; };

__device__ __forceinline__ void tile_of(int L, int nM, int nN, int& pm, int& pn) {
    const int nwg = nM * nN; int wgid = L;
    { const int q = nwg / NXCD, r = nwg % NXCD, xcd = wgid % NXCD, off = wgid / NXCD; wgid = (xcd < r ? xcd * (q + 1) : r * (q + 1) + (xcd - r) * q) + off; }
    const int nig = WGM * nN, gid = wgid / nig, fm = gid * WGM, gsz = (nM - fm) < WGM ? (nM - fm) : WGM;
    pm = fm + ((wgid % nig) % gsz); pn = (wgid % nig) / gsz;
}
struct StaticOrder {
    int nM, nN, nwg, G, c, lda, ldb;
    __device__ void init(int M, int N, int G_, int c_, int lda_, int ldb_) { nM = M / BM; nN = N / BM; nwg = nM * nN; G = G_; c = c_; lda = lda_; ldb = ldb_; }
    __device__ bool next(int i, Unit& u) const {
        const long L = (long)i * G + c; if (L >= nwg) return false;
        tile_of((int)L, nM, nN, u.pm, u.pn); u.aux = 0;
        u.aoff = (size_t)u.pm * BM * lda * 2; u.boff = (size_t)u.pn * BM * ldb * 2; return true;
    }
};

__device__ __forceinline__ unsigned cvt_pk_bf16(float lo, float hi) { typedef __bf16 b2_ __attribute__((ext_vector_type(2))); typedef float f2_ __attribute__((ext_vector_type(2))); return __builtin_bit_cast(unsigned, __builtin_convertvector((f2_){lo, hi}, b2_)); }
__device__ __forceinline__ void epi_mfma_settle(const f32x4 (&acc)[2][2][4][2]) {
    asm volatile("s_nop 11" :: "v"(acc[1][0][0][0]), "v"(acc[1][0][0][1]), "v"(acc[1][0][1][0]), "v"(acc[1][0][1][1]), "v"(acc[1][0][2][0]), "v"(acc[1][0][2][1]), "v"(acc[1][0][3][0]), "v"(acc[1][0][3][1]),
                                "v"(acc[1][1][0][0]), "v"(acc[1][1][0][1]), "v"(acc[1][1][1][0]), "v"(acc[1][1][1][1]), "v"(acc[1][1][2][0]), "v"(acc[1][1][2][1]), "v"(acc[1][1][3][0]), "v"(acc[1][1][3][1]) : "memory"); }

template <class Epi, class Sched, bool ALIGN_EPI = true, bool SP2 = true>
__device__ __forceinline__ void gemm_phase(PG8_LAS unsigned char* lds, const Gemm g, const Sched& S, const Epi& E) {
    int tid_ = threadIdx.x; asm volatile("" : "+v"(tid_));
    const int tid = tid_, wid = __builtin_amdgcn_readfirstlane(tid >> 6), lane = tid & 63, wr = wid >> 2, wc = wid & 3, fr = lane & 15, fq = lane >> 4;
    const int K = g.K, nt = K / BK;
    unsigned voffA[2], voffB[2];
#pragma unroll
    for (int i = 0; i < 2; ++i) { int R, C; stage_rc(tid * 16 + i * 8192, R, C); const int Rb = Epi::PERM ? ((R & ~31) + perm32(R & 31)) : R;
        voffA[i] = (unsigned)(R * g.lda + C) * 2u; voffB[i] = (unsigned)(Rb * g.ldb + C) * 2u; }
    const size_t kstep = (size_t)(BK * 2);
    const size_t hstepA = (size_t)HALF * g.lda * 2, hstepB = (size_t)HALF * g.ldb * 2;
    const unsigned ldsw = (unsigned)wid * 1024u;
    const int aoff = lds_byte(wr * 64 + fr, fq * 8), boff = lds_byte(wc * 32 + fr, fq * 8);
#define PG8_SA(b, h) (((b) * 2 + (h)) * HTB)
#define PG8_SB(b, h) ((4 + (b) * 2 + (h)) * HTB)
#define PG8_STAGE(bufoff, gbase, voff) do { _Pragma("unroll") for (int _i = 0; _i < 2; ++_i) \
        __builtin_amdgcn_global_load_lds((const unsigned*)((const char*)(gbase) + (voff)[_i]), (PG8_LAS unsigned*)(lds + (bufoff) + ldsw + _i * 8192), 16, 0, 0); } while (0)
#define PG8_LDA(dst, b, h) do { _Pragma("unroll") for (int m = 0; m < 4; ++m) _Pragma("unroll") for (int k = 0; k < 2; ++k) dst[m][k] = *(const PG8_LAS bf16x8*)(lds + PG8_SA(b, h) + aoff + m * 2048 + k * 1024); } while (0)
#define PG8_LDB(dst, b, h) do { _Pragma("unroll") for (int n = 0; n < 2; ++n) _Pragma("unroll") for (int k = 0; k < 2; ++k) dst[n][k] = *(const PG8_LAS bf16x8*)(lds + PG8_SB(b, h) + boff + n * 2048 + k * 1024); } while (0)
#define PG8_MMA(ai, bj, At, Bt) do { __builtin_amdgcn_s_setprio(1); _Pragma("unroll") for (int m = 0; m < 4; ++m) _Pragma("unroll") for (int n = 0; n < 2; ++n) _Pragma("unroll") for (int k = 0; k < 2; ++k) \
        acc[ai][bj][m][n] = __builtin_amdgcn_mfma_f32_16x16x32_bf16(Bt[n][k], At[m][k], acc[ai][bj][m][n], 0, 0, 0); __builtin_amdgcn_s_setprio(0); } while (0)
#define PG8_WAIT_V(n) asm volatile("s_waitcnt vmcnt(" #n ")" ::: "memory")
#define PG8_WAIT_L(n) asm volatile("s_waitcnt lgkmcnt(" #n ")" ::: "memory")
#define PG8_BAR __builtin_amdgcn_s_barrier()
#define PG8_SCHED __builtin_amdgcn_sched_barrier(0)
    Unit cur, nxt; int ui = 0;
    if (!S.next(0, cur)) return;
    f32x4 acc[2][2][4][2];
#pragma unroll
    for (int a = 0; a < 2; ++a)
#pragma unroll
        for (int b = 0; b < 2; ++b)
#pragma unroll
            for (int m = 0; m < 4; ++m)
#pragma unroll
                for (int n = 0; n < 2; ++n) acc[a][b][m][n] = (f32x4){0.f, 0.f, 0.f, 0.f};
    bf16x8 At[4][2], B0[2][2], B1[2][2];
    const char* cA = (const char*)g.A + cur.aoff; const char* cB = (const char*)g.Bt + cur.boff;
    if constexpr (SP2) {
        PG8_STAGE(PG8_SB(0, 0), cB, voffB); PG8_STAGE(PG8_SB(0, 1), cB + hstepB, voffB); PG8_STAGE(PG8_SA(0, 0), cA, voffA); PG8_STAGE(PG8_SA(0, 1), cA + hstepA, voffA);
        if (wr == 1) PG8_BAR;
        PG8_WAIT_V(2); PG8_BAR;
        PG8_STAGE(PG8_SB(1, 0), cB + kstep, voffB); PG8_STAGE(PG8_SA(1, 0), cA + kstep, voffA); PG8_STAGE(PG8_SB(1, 1), cB + hstepB + kstep, voffB);
        PG8_WAIT_V(6); PG8_BAR;
    } else {
        PG8_STAGE(PG8_SB(0, 0), cB, voffB); PG8_STAGE(PG8_SA(0, 0), cA, voffA); PG8_STAGE(PG8_SB(0, 1), cB + hstepB, voffB); PG8_STAGE(PG8_SA(0, 1), cA + hstepA, voffA);
        if (wr == 1) PG8_BAR;
        PG8_WAIT_V(4); PG8_BAR;
        PG8_STAGE(PG8_SB(1, 0), cB + kstep, voffB); PG8_STAGE(PG8_SA(1, 0), cA + kstep, voffA); PG8_STAGE(PG8_SB(1, 1), cB + hstepB + kstep, voffB);
        PG8_WAIT_V(6); PG8_BAR;
    }
    for (;;) {
        const bool has_next = S.next(ui + 1, nxt);
        const char* nA = has_next ? (const char*)g.A + nxt.aoff : cA; const char* nB = has_next ? (const char*)g.Bt + nxt.boff : cB;
#pragma unroll 1
        for (int t = 0; t < nt; t += 2) {
            const bool last = (t == nt - 2);
            const char* a1 = cA + (size_t)(t + 1) * kstep;
            const char* a2 = last ? nA : cA + (size_t)(t + 2) * kstep; const char* b2 = last ? nB : cB + (size_t)(t + 2) * kstep;
            const char* a3 = a2 + kstep; const char* b3 = b2 + kstep;
            if constexpr (SP2) {
            PG8_LDB(B0, 0, 0); PG8_LDB(B1, 0, 1); PG8_SCHED; PG8_LDA(At, 0, 0); PG8_STAGE(PG8_SA(1, 1), a1 + hstepA, voffA);
            PG8_WAIT_V(8); PG8_WAIT_L(0); PG8_BAR; PG8_MMA(0, 0, At, B0); PG8_MMA(0, 1, At, B1); PG8_BAR; PG8_SCHED;
            PG8_LDA(At, 0, 1); PG8_STAGE(PG8_SB(0, 0), b2, voffB); PG8_STAGE(PG8_SB(0, 1), b2 + hstepB, voffB); PG8_STAGE(PG8_SA(0, 0), a2, voffA);
            PG8_WAIT_V(8); PG8_WAIT_L(0); PG8_BAR; PG8_MMA(1, 0, At, B0); PG8_MMA(1, 1, At, B1); PG8_BAR; PG8_SCHED;
            PG8_LDB(B0, 1, 0); PG8_LDB(B1, 1, 1); PG8_SCHED; PG8_LDA(At, 1, 0); PG8_STAGE(PG8_SA(0, 1), a2 + hstepA, voffA);
            PG8_WAIT_V(8); PG8_WAIT_L(0); PG8_BAR; PG8_MMA(0, 0, At, B0); PG8_MMA(0, 1, At, B1); PG8_BAR; PG8_SCHED;
            PG8_LDA(At, 1, 1); PG8_STAGE(PG8_SB(1, 0), b3, voffB); PG8_STAGE(PG8_SB(1, 1), b3 + hstepB, voffB); PG8_STAGE(PG8_SA(1, 0), a3, voffA);
            PG8_WAIT_V(8); PG8_WAIT_L(0); PG8_BAR; PG8_MMA(1, 0, At, B0); PG8_MMA(1, 1, At, B1); PG8_BAR; PG8_SCHED;
            } else {
            PG8_LDB(B0, 0, 0); PG8_SCHED; PG8_LDA(At, 0, 0); PG8_STAGE(PG8_SA(1, 1), a1 + hstepA, voffA);
            PG8_WAIT_L(8); PG8_BAR; PG8_WAIT_L(0); PG8_MMA(0, 0, At, B0); PG8_BAR; PG8_SCHED;
            PG8_LDB(B1, 0, 1); PG8_STAGE(PG8_SB(0, 0), b2, voffB);
            PG8_BAR; PG8_WAIT_L(0); PG8_MMA(0, 1, At, B1); PG8_BAR;
            PG8_LDA(At, 0, 1); PG8_STAGE(PG8_SA(0, 0), a2, voffA);
            PG8_BAR; PG8_WAIT_L(0); PG8_MMA(1, 0, At, B0); PG8_BAR; PG8_SCHED;
            PG8_STAGE(PG8_SB(0, 1), b2 + hstepB, voffB);
            PG8_WAIT_V(6); PG8_BAR; PG8_MMA(1, 1, At, B1); PG8_BAR;
            PG8_LDB(B0, 1, 0); PG8_SCHED; PG8_LDA(At, 1, 0); PG8_STAGE(PG8_SA(0, 1), a2 + hstepA, voffA);
            PG8_WAIT_L(8); PG8_BAR; PG8_WAIT_L(0); PG8_MMA(0, 0, At, B0); PG8_BAR; PG8_SCHED;
            PG8_LDB(B1, 1, 1); PG8_STAGE(PG8_SB(1, 0), b3, voffB);
            PG8_BAR; PG8_WAIT_L(0); PG8_MMA(0, 1, At, B1); PG8_BAR;
            PG8_LDA(At, 1, 1); PG8_STAGE(PG8_SA(1, 0), a3, voffA);
            PG8_BAR; PG8_WAIT_L(0); PG8_MMA(1, 0, At, B0); PG8_BAR; PG8_SCHED;
            PG8_STAGE(PG8_SB(1, 1), b3 + hstepB, voffB);
            PG8_WAIT_V(6); PG8_BAR; PG8_MMA(1, 1, At, B1); PG8_BAR;
            }
        }
        if constexpr (ALIGN_EPI) { if (wr == 0) PG8_BAR; }
        E(acc, cur, wr, wc, fr, fq);
        if (!has_next) break;
#pragma unroll
        for (int a = 0; a < 2; ++a)
#pragma unroll
            for (int b = 0; b < 2; ++b)
#pragma unroll
                for (int m = 0; m < 4; ++m)
#pragma unroll
                    for (int n = 0; n < 2; ++n) acc[a][b][m][n] = (f32x4){0.f, 0.f, 0.f, 0.f};
        cur = nxt; cA = nA; cB = nB; ++ui;
        if constexpr (ALIGN_EPI) { if (wr == 1) PG8_BAR; }
    }
    PG8_WAIT_V(0);
    if constexpr (!ALIGN_EPI) { if (wr == 0) PG8_BAR; }
    PG8_BAR;
#undef PG8_SA
#undef PG8_SB
#undef PG8_STAGE
#undef PG8_LDA
#undef PG8_LDB
#undef PG8_MMA
#undef PG8_WAIT_V
#undef PG8_WAIT_L
#undef PG8_BAR
#undef PG8_SCHED
}
}

#define LAS __attribute__((address_space(3)))
typedef unsigned short bf16;
typedef float f32x4 __attribute__((ext_vector_type(4)));
typedef unsigned u32x4 __attribute__((ext_vector_type(4)));
typedef unsigned u32x2 __attribute__((ext_vector_type(2)));

constexpr int NB = 8, T = 4096, D = 1024, M = NB * T, NL = 2;
constexpr int INW = 9160;
constexpr int PP = 5120;
constexpr int C_AQ = 0, C_AK = 768, C_AV = 1536, C_BQ = 2304, C_BK = 2560, C_BV = 2816, C_IQ = 3072, C_IK = 3328, C_C = 3392, C_DZ = 4288, C_DX = 4544, C_IW = 5056, C_DT = 5060, C_END = 5064;
constexpr int NEXP = 32, DEXP = 512;
constexpr int CAP = 73728;
constexpr float LN_EPS = 1e-5f;
constexpr float ALPHA = 1.4142135623730951f;

constexpr size_t MiB = 1u << 20;
constexpr size_t WS_CTL = 0, CTL_BYTES = 1 * MiB;
constexpr size_t WS_WINT = 2 * MiB;
constexpr size_t WS_WGT = 22 * MiB;
constexpr size_t WS_WBRT = 38 * MiB;
constexpr size_t WS_WOUTT = 42 * MiB;
constexpr size_t WS_WRT = 46 * MiB;
constexpr size_t WS_ROUTE = 47 * MiB;
constexpr size_t WS_XB = 48 * MiB;
constexpr size_t WS_O = 112 * MiB;
constexpr size_t WS_VF = 176 * MiB;
constexpr size_t WS_P = 192 * MiB;
constexpr size_t WS_GS = 192 * MiB;
constexpr size_t WS_MERGED = 448 * MiB;
constexpr size_t WS_XS = 192 * MiB;
constexpr size_t WS_H = 336 * MiB;
constexpr size_t WS_WGU = 408 * MiB;
constexpr size_t WS_WD = 472 * MiB;
constexpr size_t WS_RW = 512 * MiB;
constexpr size_t WS_RW2 = 544 * MiB;
constexpr size_t WS_BONG = 46 * MiB + 512 * 1024;
constexpr size_t WS_END = 592 * MiB;
constexpr int CW_CNT = 64, CW_Q = 256, CW_BAR = 4096;

constexpr int RING_BYTES = 131072, MISC_OFF = RING_BYTES, LDS_BYTES = 147456;
constexpr int NWAVES = 8, NTHR = 512;

__device__ __forceinline__ float bf2f(bf16 v) { return __uint_as_float(((unsigned)v) << 16); }
__device__ __forceinline__ unsigned pk2(float lo, float hi) { return pg8::cvt_pk_bf16(lo, hi); }
__device__ __forceinline__ unsigned f2bf(float f) { unsigned u = __float_as_uint(f); return (u + 0x7fffu + ((u >> 16) & 1u)) >> 16; }
#define DPP_ADD(v, ctrl) v += __builtin_bit_cast(float, __builtin_amdgcn_update_dpp(0, __builtin_bit_cast(int, v), ctrl, 0xF, 0xF, true))
#define DPP_MAX(v, ctrl) v = fmaxf(v, __builtin_bit_cast(float, __builtin_amdgcn_update_dpp(0, __builtin_bit_cast(int, v), ctrl, 0xF, 0xF, true)))
__device__ __forceinline__ float wave_sum(float v) {
    DPP_ADD(v, 0xB1); DPP_ADD(v, 0x4E); DPP_ADD(v, 0x141); DPP_ADD(v, 0x140);
    v += __shfl_xor(v, 16); v += __shfl_xor(v, 32);
    return v;
}
__device__ __forceinline__ float wave_max(float v) {
    DPP_MAX(v, 0xB1); DPP_MAX(v, 0x4E); DPP_MAX(v, 0x141); DPP_MAX(v, 0x140);
    v = fmaxf(v, __shfl_xor(v, 16)); v = fmaxf(v, __shfl_xor(v, 32));
    return v;
}
__device__ __forceinline__ float sigmoid_div_(float x) { return 1.f / (1.f + __expf(-x)); }
__device__ __forceinline__ float sigmoidf_(float x) { return __builtin_amdgcn_rcpf(1.f + __expf(-x)); }
__device__ __forceinline__ float softplusf_(float x) { return x > 20.f ? x : __logf(1.f + __expf(x)); }
__device__ __forceinline__ float tanhf_(float x) { const float e = __expf(-2.f * fabsf(x)); const float t = (1.f - e) * __builtin_amdgcn_rcpf(1.f + e); return x < 0.f ? -t : t; }
__device__ __forceinline__ float siluf_(float x) { return x * __builtin_amdgcn_rcpf(1.f + __expf(-x)); }

struct Args { const float* in[35]; float* out; unsigned char* ws; int ph_lo, ph_hi; };
enum { I_X = 0, I_WIN, I_CMU, I_CW0, I_CW2, I_CA0, I_CA2, I_CG2, I_CKK, I_CKA, I_CRK, I_CGNW, I_CGNB, I_CV0, I_CV1, I_CV2, I_DCW, I_DCB, I_DDTB, I_DALOG, I_DSKIP, I_DNW,
       I_WBR, I_WOUT, I_LN1G, I_LN1B, I_RG, I_RGB, I_RE, I_REB, I_EG, I_EU, I_ED, I_LN2G, I_LN2B };

__device__ __forceinline__ void transpose_item(const float* W, int ldn, int c0, int ncols, bf16* dst, int dld, int r0, int dk0, int kb, int nb, LAS float* scr, int lane) {
    const int k0 = 64 * kb, n0 = 32 * nb;
    const bool okn = (n0 + (lane & 31)) < ncols;
    float tv[32];
#pragma unroll
    for (int i = 0; i < 32; ++i) { const int kk = 2 * i + (lane >> 5); tv[i] = okn ? W[(size_t)(k0 + kk) * ldn + c0 + n0 + (lane & 31)] : 0.f; }
#pragma unroll
    for (int i = 0; i < 32; ++i) { const int kk = 2 * i + (lane >> 5); scr[kk * 33 + (lane & 31)] = tv[i]; }
    asm volatile("s_waitcnt lgkmcnt(0)" ::: "memory");
    const int c = lane & 7;
#pragma unroll
    for (int j = 0; j < 4; ++j) { const int n = (lane >> 3) + 8 * j; const LAS float* s = scr + (8 * c) * 33 + n;
        u32x4 o; o.x = pk2(s[0 * 33], s[1 * 33]); o.y = pk2(s[2 * 33], s[3 * 33]); o.z = pk2(s[4 * 33], s[5 * 33]); o.w = pk2(s[6 * 33], s[7 * 33]);
        if (n0 + n < ncols) *(u32x4*)(dst + (size_t)(r0 + n0 + n) * dld + dk0 + k0 + 8 * c) = o; }
    asm volatile("s_waitcnt lgkmcnt(0)" ::: "memory");
}

struct EpiStoreBf16 {
    static constexpr bool PERM = true;
    bf16* O; int ldc; int act; int ncols;
    __device__ __forceinline__ void operator()(const pg8::f32x4 (&acc)[2][2][4][2], const pg8::Unit& u, int wr, int wc, int fr, int fq) const {
        pg8::epi_mfma_settle(acc);
        const int row0 = u.pm * 256 + wr * 64 + fr; const int col0 = u.pn * 256 + wc * 32 + 8 * fq;
#pragma unroll
        for (int ai = 0; ai < 2; ++ai)
#pragma unroll
            for (int m = 0; m < 4; ++m) { bf16* rowp = O + (size_t)(row0 + ai * 128 + m * 16) * ldc + col0;
#pragma unroll
                for (int bj = 0; bj < 2; ++bj) { pg8::f32x4 v0 = acc[ai][bj][m][0], v1 = acc[ai][bj][m][1];
                    if (act == 1) {
#pragma unroll
                        for (int j = 0; j < 4; ++j) { v0[j] = sigmoidf_(v0[j]); v1[j] = sigmoidf_(v1[j]); } }
                    u32x4 w; w.x = pg8::cvt_pk_bf16(v0[0], v0[1]); w.y = pg8::cvt_pk_bf16(v0[2], v0[3]); w.z = pg8::cvt_pk_bf16(v1[0], v1[1]); w.w = pg8::cvt_pk_bf16(v1[2], v1[3]);
                    if (col0 + bj * 128 < ncols) *(u32x4*)(rowp + bj * 128) = w; } }
    }
};
struct EpiBranch {
    static constexpr bool PERM = true;
    const bf16* GS; bf16* MG;
    __device__ __forceinline__ void operator()(const pg8::f32x4 (&acc)[2][2][4][2], const pg8::Unit& u, int wr, int wc, int fr, int fq) const {
        pg8::epi_mfma_settle(acc);
        const int n = u.aux;
        const bf16* gbase = GS + (size_t)(u.pm * 256 + wr * 64 + fr) * 4096 + n * 1024 + u.pn * 256 + wc * 32 + 8 * fq;
        bf16* mbase = MG + (size_t)(u.pm * 256 + wr * 64 + fr) * 1024 + u.pn * 256 + wc * 32 + 8 * fq;
#pragma unroll
        for (int ai = 0; ai < 2; ++ai)
#pragma unroll
            for (int m = 0; m < 4; ++m) {
#pragma unroll
                for (int bj = 0; bj < 2; ++bj) {
                    const u32x4 gv = *(const u32x4*)(gbase + (size_t)(ai * 128 + m * 16) * 4096 + bj * 128);
                    bf16* mp = mbase + (size_t)(ai * 128 + m * 16) * 1024 + bj * 128;
                    u32x4 ov = (u32x4){0u, 0u, 0u, 0u}; if (n != 0) ov = *(const u32x4*)mp;
                    const pg8::f32x4 a0 = acc[ai][bj][m][0], a1 = acc[ai][bj][m][1];
                    u32x4 w;
                    w.x = pg8::cvt_pk_bf16(a0[0] * __uint_as_float(gv.x << 16) + __uint_as_float(ov.x << 16), a0[1] * __uint_as_float(gv.x & 0xffff0000u) + __uint_as_float(ov.x & 0xffff0000u));
                    w.y = pg8::cvt_pk_bf16(a0[2] * __uint_as_float(gv.y << 16) + __uint_as_float(ov.y << 16), a0[3] * __uint_as_float(gv.y & 0xffff0000u) + __uint_as_float(ov.y & 0xffff0000u));
                    w.z = pg8::cvt_pk_bf16(a1[0] * __uint_as_float(gv.z << 16) + __uint_as_float(ov.z << 16), a1[1] * __uint_as_float(gv.z & 0xffff0000u) + __uint_as_float(ov.z & 0xffff0000u));
                    w.w = pg8::cvt_pk_bf16(a1[2] * __uint_as_float(gv.w << 16) + __uint_as_float(ov.w << 16), a1[3] * __uint_as_float(gv.w & 0xffff0000u) + __uint_as_float(ov.w & 0xffff0000u));
                    *(u32x4*)mp = w; asm volatile("" ::: "memory"); } }
    }
};
struct EpiResid {
    static constexpr bool PERM = false;
    float* X;
    __device__ __forceinline__ void operator()(const pg8::f32x4 (&acc)[2][2][4][2], const pg8::Unit& u, int wr, int wc, int fr, int fq) const {
        pg8::epi_mfma_settle(acc);
        const int row0 = u.pm * 256 + wr * 64 + fr, col0 = u.pn * 256 + wc * 32 + 4 * fq;
#pragma unroll
        for (int ai = 0; ai < 2; ++ai)
#pragma unroll
            for (int m = 0; m < 4; ++m) { float* rowp = X + (size_t)(row0 + ai * 128 + m * 16) * D + col0;
#pragma unroll
                for (int bj = 0; bj < 2; ++bj)
#pragma unroll
                    for (int n = 0; n < 2; ++n) { pg8::f32x4* p = (pg8::f32x4*)(rowp + bj * 128 + n * 16); *p = *p * ALPHA + acc[ai][bj][m][n]; } }
    }
};
struct EpiSwiglu {
    static constexpr bool PERM = true;
    bf16* H;
    __device__ __forceinline__ void operator()(const pg8::f32x4 (&acc)[2][2][4][2], const pg8::Unit& u, int wr, int wc, int fr, int fq) const {
        pg8::epi_mfma_settle(acc);
        const int row0 = u.pm * 256 + wr * 64 + fr; const int col0 = u.pn * 128 + wc * 32 + 8 * fq;
#pragma unroll
        for (int ai = 0; ai < 2; ++ai)
#pragma unroll
            for (int m = 0; m < 4; ++m) { bf16* rowp = H + (size_t)(row0 + ai * 128 + m * 16) * DEXP + col0;
                float v[8];
#pragma unroll
                for (int j = 0; j < 4; ++j) { v[j] = siluf_(acc[ai][0][m][0][j]) * acc[ai][1][m][0][j]; v[4 + j] = siluf_(acc[ai][0][m][1][j]) * acc[ai][1][m][1][j]; }
                u32x4 w; w.x = pg8::cvt_pk_bf16(v[0], v[1]); w.y = pg8::cvt_pk_bf16(v[2], v[3]); w.z = pg8::cvt_pk_bf16(v[4], v[5]); w.w = pg8::cvt_pk_bf16(v[6], v[7]);
                *(u32x4*)rowp = w; }
    }
};

struct SkewOrder {
    int nM, nN, nwg, c, lda, ldb;
    __device__ bool next(int i, pg8::Unit& u) const {
        long L;
        if (i < 5) L = (long)i * 256 + c; else { if (c < 32) return false; L = 1280 + (long)(i - 5) * 224 + (c - 32); }
        if (L >= nwg) return false;
        pg8::tile_of((int)L, nM, nN, u.pm, u.pn); u.aux = 0;
        u.aoff = (size_t)u.pm * 256 * lda * 2; u.boff = (size_t)u.pn * 256 * ldb * 2; return true;
    }
};
struct BranchOrder {
    int nM, nN, G, c;
    __device__ bool next(int i, pg8::Unit& u) const {
        const int tl = (i >> 2) * G + c; if (tl >= nM * nN) return false;
        pg8::tile_of(tl, nM, nN, u.pm, u.pn); u.aux = i & 3;
        u.aoff = ((size_t)u.pm * 256 * 1024 + (size_t)u.aux * 256) * 2; u.boff = ((size_t)u.pn * 256 * 1024 + (size_t)u.aux * 256) * 2; return true;
    }
};
struct MoeOrder {
    const volatile LAS int* tb; int G, c; size_t a_rowbytes, b_expbytes, b_tilebytes;
    __device__ bool next(int i, pg8::Unit& u) const {
        const int L = i * G + c; const int total = __builtin_amdgcn_readfirstlane(tb[32]) * 4; if (L >= total) return false;
        int e = 0;
#pragma unroll 1
        for (int k = 0; k < 32; ++k) if (L >= tb[k + 1] * 4) e = k + 1;
        const int nte = tb[e + 1] - tb[e]; const int r = L - tb[e] * 4; const int ct = r / nte, rt = r % nte;
        u.pm = __builtin_amdgcn_readfirstlane(tb[33 + e] + rt); u.pn = __builtin_amdgcn_readfirstlane(ct); u.aux = __builtin_amdgcn_readfirstlane(e);
        u.aoff = (size_t)u.pm * 256 * a_rowbytes; u.boff = (size_t)u.aux * b_expbytes + (size_t)u.pn * b_tilebytes; return true;
    }
};

constexpr int PTR_OFF = LDS_BYTES - 512;
__device__ __forceinline__ void ptr_table_fill(const Args& args, LAS unsigned char* lds) {
    if (threadIdx.x == 0) {
        volatile LAS unsigned long long* t = (volatile LAS unsigned long long*)(lds + PTR_OFF);
#define PT_(i) t[i] = (unsigned long long)args.in[i];
        PT_(0) PT_(1) PT_(2) PT_(3) PT_(4) PT_(5) PT_(6) PT_(7) PT_(8) PT_(9) PT_(10) PT_(11) PT_(12) PT_(13) PT_(14) PT_(15) PT_(16) PT_(17) PT_(18) PT_(19)
        PT_(20) PT_(21) PT_(22) PT_(23) PT_(24) PT_(25) PT_(26) PT_(27) PT_(28) PT_(29) PT_(30) PT_(31) PT_(32) PT_(33) PT_(34)
#undef PT_
        t[35] = (unsigned long long)args.out; t[36] = (unsigned long long)args.ws; t[37] = (unsigned long long)(unsigned)args.ph_lo;
    }
    __syncthreads();
}
__device__ __forceinline__ unsigned long long ldptr(LAS unsigned char* lds, int i) {
    unsigned a = (unsigned)(PTR_OFF + 8 * i); asm volatile("" : "+v"(a));
    const volatile LAS unsigned* t = (const volatile LAS unsigned*)(lds + a);
    const unsigned lo = __builtin_amdgcn_readfirstlane(t[0]), hi = __builtin_amdgcn_readfirstlane(t[1]);
    return ((unsigned long long)hi << 32) | lo;
}
__device__ __forceinline__ void* gptr(unsigned long long v) { return (void*)(__attribute__((address_space(1))) void*)v; }
#define INP(i) ((const float*)gptr(ldptr(lds, (i))))
namespace rw {
typedef short bf16x8 __attribute__((ext_vector_type(8)));
typedef float f4 __attribute__((ext_vector_type(4)));
constexpr int LS = 72;
constexpr int MB = 64 * LS * 2;
constexpr int O_AHN = 0, O_RHN = MB, O_BCN = 2 * MB, O_KCN = 3 * MB, O_AHT = 4 * MB, O_BTT = 5 * MB, O_KTT = 6 * MB, O_VT = 7 * MB, O_STT = 8 * MB,
              O_MAK = 9 * MB, O_MRB = 10 * MB, O_MRK = 11 * MB, O_TINV = 12 * MB, O_MABF = 13 * MB, O_GAM = 13 * MB + 16384, O_CT = O_GAM + 256, O_BON = O_CT + 4608, O_END = O_BON + 256;
constexpr int O_MVT = O_BCN, O_A2N = O_AHN, O_UT = O_KCN, O_YF = O_AHT;
constexpr int O_TAB = O_MAK, O_SCR = O_TAB + 26624, O_TOT = O_SCR + 8 * 1024, O_CUM = O_TOT + 2048;
static_assert(O_CUM + 16384 <= O_GAM && O_END <= LDS_BYTES - 576, "rwkv LDS map");

__device__ __forceinline__ bf16x8 ldfrag(const LAS unsigned char* lds, int off, int r0, int ks, int lane) {
    return *(const LAS bf16x8*)(lds + off + ((r0 + (lane & 15)) * LS + ks * 32 + (lane >> 4) * 8) * 2);
}
__device__ __forceinline__ void mm64(f4 (&acc)[2], const LAS unsigned char* lds, int offA, int offBt, int w, int lane) {
    const int tr = w >> 1; const bf16x8 a0 = ldfrag(lds, offA, tr * 16, 0, lane), a1 = ldfrag(lds, offA, tr * 16, 1, lane);
#pragma unroll
    for (int c = 0; c < 2; ++c) { const int tc = (w & 1) * 2 + c; const bf16x8 b0 = ldfrag(lds, offBt, tc * 16, 0, lane), b1 = ldfrag(lds, offBt, tc * 16, 1, lane);
        acc[c] = __builtin_amdgcn_mfma_f32_16x16x32_bf16(a0, b0, acc[c], 0, 0, 0); acc[c] = __builtin_amdgcn_mfma_f32_16x16x32_bf16(a1, b1, acc[c], 0, 0, 0); }
}
__device__ __forceinline__ void storeT(LAS unsigned char* lds, int off, const f4 (&acc)[2], int w, int lane) {
    asm volatile("s_nop 11" :: "v"(acc[0]), "v"(acc[1]));
#pragma unroll
    for (int c = 0; c < 2; ++c) { const int col = ((w & 1) * 2 + c) * 16 + (lane & 15), row = (w >> 1) * 16 + 4 * (lane >> 4);
        u32x2 v; v.x = pk2(acc[c][0], acc[c][1]); v.y = pk2(acc[c][2], acc[c][3]); *(LAS u32x2*)(lds + off + (col * LS + row) * 2) = v; }
}
template <int MASK  >
__device__ __forceinline__ void storeN(LAS unsigned char* lds, int off, const f4 (&acc)[2], int w, int lane) {
    asm volatile("s_nop 11" :: "v"(acc[0]), "v"(acc[1]));
#pragma unroll
    for (int c = 0; c < 2; ++c) { const int col = ((w & 1) * 2 + c) * 16 + (lane & 15), row = (w >> 1) * 16 + 4 * (lane >> 4);
#pragma unroll
        for (int e = 0; e < 4; ++e) { float x = acc[c][e]; if (MASK == 1) x = (col < row + e) ? x : 0.f; if (MASK == 2) x = (col <= row + e) ? x : 0.f;
            *(LAS bf16*)(lds + off + ((row + e) * LS + col) * 2) = (bf16)f2bf(x); } }
}
typedef __bf16 bf2v __attribute__((ext_vector_type(2)));
__device__ __forceinline__ float dot2(unsigned x, unsigned y, float c) { return __builtin_amdgcn_fdot2_f32_bf16(__builtin_bit_cast(bf2v, x), __builtin_bit_cast(bf2v, y), c, false); }
#define RW_ZERO(a) do { a[0] = (f4){0.f, 0.f, 0.f, 0.f}; a[1] = (f4){0.f, 0.f, 0.f, 0.f}; } while (0)

__device__ __forceinline__ void build_ct(LAS unsigned char* lds0, const int l, const int h, const int lane, const int wave) {
    LAS unsigned char* const& lds = lds0; const int c = h * 64 + lane;
    const float* mu = INP(I_CMU) + (size_t)l * 896;
    if (wave == 0) { LAS float* ct = (LAS float*)(lds0 + O_CT);
        ct[0 * 64 + lane] = mu[c]; ct[1 * 64 + lane] = mu[256 + c]; ct[2 * 64 + lane] = mu[512 + c]; ct[3 * 64 + lane] = mu[768 + lane]; ct[4 * 64 + lane] = mu[832 + lane];
        ct[5 * 64 + lane] = INP(I_CW0)[l * 256 + c]; ct[6 * 64 + lane] = INP(I_CA0)[l * 256 + c]; ct[7 * 64 + lane] = INP(I_CKK)[l * 256 + c]; ct[8 * 64 + lane] = INP(I_CKA)[l * 256 + c];
        ct[9 * 64 + lane] = INP(I_CRK)[l * 256 + c]; ct[10 * 64 + lane] = INP(I_CGNW)[l * 256 + c]; ct[11 * 64 + lane] = INP(I_CGNB)[l * 256 + c]; ct[12 * 64 + lane] = l > 0 ? INP(I_CV0)[(l - 1) * 256 + c] : 0.f;
        ct[13 * 64 + lane] = mu[512 + lane]; ct[14 * 64 + lane] = mu[512 + lane + 64]; ct[15 * 64 + lane] = mu[512 + lane + 128]; ct[16 * 64 + lane] = mu[512 + lane + 192]; }
}
template <int MODE>
__device__ __forceinline__ void chunk(LAS unsigned char* lds0, const int l, const int b, const int h, const int t0, unsigned char* gz, unsigned char* gz2, float* bong, const bf16* P, bf16* VF, bf16* OB, const int tid0) {
    const int c = h * 64 + (tid0 & 63);
    {
        unsigned lb_ = 0u; int tid_l = tid0; asm volatile("" : "+v"(lb_), "+v"(tid_l));
        const int tid = tid_l, lane = tid & 63, wave = __builtin_amdgcn_readfirstlane(tid >> 6);
        LAS unsigned char* lds = lds0 + lb_;
        LAS bf16* TAB = (LAS bf16*)(lds + O_TAB); const LAS unsigned* TABW = (const LAS unsigned*)(lds + O_TAB);
        LAS bf16* scr = (LAS bf16*)(lds + O_SCR + wave * 1024);
        LAS float* CUM = (LAS float*)(lds + O_CUM);
        LAS float* TOT = (LAS float*)(lds + O_TOT);
        LAS float* GAM = (LAS float*)(lds + O_GAM);
        LAS float* MABF = (LAS float*)(lds + O_MABF);
        LAS float* YF = (LAS float*)(lds + O_YF);
        LAS float* BON = (LAS float*)(lds + O_BON);
        const LAS float* CT = (const LAS float*)(lds + O_CT);
#define CTV(k) CT[(k) * 64 + lane]
        { const float* cw2 = INP(I_CW2) + (size_t)l * 32 * 256; const float* ca2 = INP(I_CA2) + (size_t)l * 32 * 256; const float* cg2 = INP(I_CG2) + (size_t)l * 64 * 256;
          float tw[4], ta[4], tg[8];
#pragma unroll
          for (int u = 0; u < 4; ++u) { const int i = tid + u * NTHR; tw[u] = cw2[(i >> 6) * 256 + h * 64 + (i & 63)]; ta[u] = ca2[(i >> 6) * 256 + h * 64 + (i & 63)]; }
#pragma unroll
          for (int u = 0; u < 8; ++u) { const int i = tid + u * NTHR; tg[u] = cg2[(i >> 6) * 256 + h * 64 + (i & 63)]; }
          float t2[2], t1[8];
          if (l > 0) { const float* cv1 = INP(I_CV1) + (size_t)(l - 1) * 256 * 16; const float* cv2 = INP(I_CV2) + (size_t)(l - 1) * 16 * 256;
#pragma unroll
            for (int u = 0; u < 2; ++u) { const int i = tid + u * NTHR; t2[u] = cv2[(i >> 6) * 256 + h * 64 + (i & 63)]; }
#pragma unroll
            for (int u = 0; u < 8; ++u) t1[u] = cv1[tid + u * NTHR]; }
#define PIX(i) ((((i) >> 7) * 64 + ((i) & 63)) * 2 + (((i) >> 6) & 1))
#pragma unroll
          for (int u = 0; u < 4; ++u) { const int i = tid + u * NTHR; TAB[PIX(i)] = (bf16)f2bf(tw[u]); TAB[2048 + PIX(i)] = (bf16)f2bf(ta[u]); }
#pragma unroll
          for (int u = 0; u < 8; ++u) { const int i = tid + u * NTHR; TAB[4096 + PIX(i)] = (bf16)f2bf(tg[u]); }
          if (l > 0) {
#pragma unroll
            for (int u = 0; u < 2; ++u) { const int i = tid + u * NTHR; TAB[8192 + PIX(i)] = (bf16)f2bf(t2[u]); }
#pragma unroll
            for (int u = 0; u < 8; ++u) { const int i = tid + u * NTHR; const int cc = i >> 4, qq = i & 15; TAB[9216 + ((cc >> 1) * 16 + qq) * 2 + (cc & 1)] = (bf16)f2bf(t1[u]); } } }
#undef PIX
        float Xr[9];
#pragma unroll
        for (int j = 0; j < 9; ++j) { const int t = t0 + wave * 8 - 1 + j; Xr[j] = t >= 0 ? bf2f(P[((size_t)b * T + t) * PP + C_C + 768 + lane]) : 0.f; }
        __syncthreads();
        { float run = 0.f;
#pragma unroll
            for (int q = 0; q < 8; ++q) {
                const float xx = Xr[q + 1] + (Xr[q] - Xr[q + 1]) * CTV(3);
                scr[lane] = (bf16)f2bf(tanhf_(xx));
                asm volatile("s_waitcnt lgkmcnt(0)" ::: "memory");
                float wsum = CTV(5); { float w1 = 0.f; const LAS unsigned* sw = (const LAS unsigned*)scr;
#pragma unroll
                for (int p = 0; p < 16; p += 2) { wsum = dot2(sw[p], TABW[p * 64 + lane], wsum); w1 = dot2(sw[p + 1], TABW[(p + 1) * 64 + lane], w1); }
                wsum += w1; }
                run += -0.6065306597f * sigmoidf_(wsum); CUM[(wave * 8 + q) * 64 + lane] = run;
                asm volatile("s_waitcnt lgkmcnt(0)" ::: "memory");
            }
            TOT[wave * 64 + lane] = run; }
        __syncthreads();
        float offs = 0.f, cumL = 0.f;
#pragma unroll
        for (int w2 = 0; w2 < 8; ++w2) { const float tw = TOT[w2 * 64 + lane]; offs += (w2 < wave) ? tw : 0.f; cumL += tw; }
        if (wave == 0) GAM[lane] = __expf(cumL);
#define LO_(x) __uint_as_float((x) << 16)
#define HI_(x) __uint_as_float((x) & 0xffff0000u)
#define RAW_LOAD(rk, vx, gg, v4a, v4b, vfv, tok) do { const int t_ = (tok); const bool ok_ = t_ >= 0; const size_t m_ = (size_t)b * T + (ok_ ? t_ : 0); const bf16* row_ = P + m_ * PP + C_C; \
            rk = ok_ ? ((unsigned)row_[c] | ((unsigned)row_[256 + c] << 16)) : 0u; vx = ok_ ? ((unsigned)row_[512 + c] | ((unsigned)row_[768 + lane] << 16)) : 0u; gg = ok_ ? (unsigned)row_[832 + lane] : 0u; \
            if (l > 0) { v4a = ok_ ? ((unsigned)row_[512 + lane] | ((unsigned)row_[512 + lane + 64] << 16)) : 0u; v4b = ok_ ? ((unsigned)row_[512 + lane + 128] | ((unsigned)row_[512 + lane + 192] << 16)) : 0u; vfv = (unsigned)VF[m_ * 256 + c]; } } while (0)
        unsigned pRK, pVX, pGG, pVa = 0u, pVb = 0u, pVF = 0u, cRK, cVX, cGG, cVa = 0u, cVb = 0u, cVF = 0u;
        RAW_LOAD(pRK, pVX, pGG, pVa, pVb, pVF, t0 + wave * 8 - 1); RAW_LOAD(cRK, cVX, cGG, cVa, cVb, cVF, t0 + wave * 8);
#pragma unroll 1
        for (int q = 0; q < 8; ++q) {
            const int tt = wave * 8 + q; const size_t m = (size_t)b * T + t0 + tt;
            unsigned nRK, nVX, nGG, nVa = 0u, nVb = 0u, nVF = 0u;
            RAW_LOAD(nRK, nVX, nGG, nVa, nVb, nVF, (q < 7) ? (t0 + tt + 1) : (t0 + tt));
            const float r = LO_(cRK) + (LO_(pRK) - LO_(cRK)) * CTV(0), k = HI_(cRK) + (HI_(pRK) - HI_(cRK)) * CTV(1); float v = LO_(cVX) + (LO_(pVX) - LO_(cVX)) * CTV(2);
            const float xx = HI_(cVX) + (HI_(pVX) - HI_(cVX)) * CTV(3), xg = LO_(cGG) + (LO_(pGG) - LO_(cGG)) * CTV(4);
            scr[lane] = (bf16)f2bf(lane < 32 ? tanhf_(xx) : xx); scr[64 + lane] = (bf16)f2bf(sigmoidf_(xg));
            LAS bf16* vsc = scr + 128;
            if (l > 0) {
                vsc[lane] = (bf16)f2bf(LO_(cVa) + (LO_(pVa) - LO_(cVa)) * CTV(13)); vsc[lane + 64] = (bf16)f2bf(HI_(cVa) + (HI_(pVa) - HI_(cVa)) * CTV(14));
                vsc[lane + 128] = (bf16)f2bf(LO_(cVb) + (LO_(pVb) - LO_(cVb)) * CTV(15)); vsc[lane + 192] = (bf16)f2bf(HI_(cVb) + (HI_(pVb) - HI_(cVb)) * CTV(16));
            }
            asm volatile("s_waitcnt lgkmcnt(0)" ::: "memory");
            float wsum = CTV(5), asum = CTV(6), gsum = 0.f; { float w1 = 0.f, a1 = 0.f, g1 = 0.f; const LAS unsigned* sw = (const LAS unsigned*)scr;
#pragma unroll
            for (int p = 0; p < 16; p += 2) { wsum = dot2(sw[p], TABW[p * 64 + lane], wsum); w1 = dot2(sw[p + 1], TABW[(p + 1) * 64 + lane], w1);
                asum = dot2(sw[16 + p], TABW[1024 + p * 64 + lane], asum); a1 = dot2(sw[17 + p], TABW[1024 + (p + 1) * 64 + lane], a1); }
#pragma unroll
            for (int p = 0; p < 32; p += 2) { gsum = dot2(sw[32 + p], TABW[2048 + p * 64 + lane], gsum); g1 = dot2(sw[33 + p], TABW[2048 + (p + 1) * 64 + lane], g1); }
            wsum += w1; asum += a1; gsum += g1; }
            if (l > 0) {
                const int qq = lane & 15, part = lane >> 4; float s = 0.f; { float s1 = 0.f; const LAS unsigned* sv = (const LAS unsigned*)vsc;
#pragma unroll
                for (int p = 0; p < 32; p += 2) { s = dot2(sv[part * 32 + p], TABW[4608 + (part * 32 + p) * 16 + qq], s); s1 = dot2(sv[part * 32 + p + 1], TABW[4608 + (part * 32 + p + 1) * 16 + qq], s1); }
                s += s1; }
                s += __shfl_xor(s, 16); s += __shfl_xor(s, 32);
                float vl = CTV(12);
#pragma unroll
                for (int q2 = 0; q2 < 16; ++q2) vl += __shfl(s, q2) * bf2f(TAB[8192 + ((q2 >> 1) * 64 + lane) * 2 + (q2 & 1)]);
                const float vf = LO_(cVF); v = v + (vf - v) * sigmoidf_(vl);
            }
            if (MODE < 5) VF[m * 256 + c] = (bf16)f2bf(v);
            const float asig = sigmoidf_(asum), lw = -0.6065306597f * sigmoidf_(wsum);
            float kk = k * CTV(7); const float n2 = wave_sum(kk * kk); kk = kk * __builtin_amdgcn_rsqf(fmaxf(n2, 1e-24f));
            const float kmod = k * (1.f + (asig - 1.f) * CTV(8));
            const float bon = wave_sum(r * kmod * CTV(9));
            const float cum = offs + CUM[tt * 64 + lane], cumx = cum - lw;
            const float ah = -kk * __expf(cumx), rh = r * __expf(cum), ei = __expf(-cum), bb = kk * asig, bc = bb * ei, kc = kmod * ei, ee = __expf(cumL - cum), bt = bb * ee, kt = kmod * ee;
            const int no = (tt * LS + lane) * 2, to = (lane * LS + tt) * 2;
            *(LAS bf16*)(lds + O_AHN + no) = (bf16)f2bf(ah); *(LAS bf16*)(lds + O_RHN + no) = (bf16)f2bf(rh);
            *(LAS bf16*)(lds + O_BCN + no) = (bf16)f2bf(bc); *(LAS bf16*)(lds + O_KCN + no) = (bf16)f2bf(kc); if (MODE < 5) ((bf16*)(gz2 + 16384))[tt * 64 + lane] = (bf16)f2bf(gsum);
            *(LAS bf16*)(lds + O_AHT + to) = (bf16)f2bf(ah); *(LAS bf16*)(lds + O_BTT + to) = (bf16)f2bf(bt);
            *(LAS bf16*)(lds + O_KTT + to) = (bf16)f2bf(kt); *(LAS bf16*)(lds + O_VT + to) = (bf16)f2bf(v);
            if (MODE < 5 && lane == 0) bong[tt] = bon;
            asm volatile("s_waitcnt lgkmcnt(0)" ::: "memory");
            pRK = cRK; pVX = cVX; pGG = cGG; pVa = cVa; pVb = cVb; cRK = nRK; cVX = nVX; cGG = nGG; cVa = nVa; cVb = nVb; cVF = nVF;
        }
#undef RAW_LOAD
        __syncthreads();
        if (MODE == 6) return;
        { f4 acc[2];
            RW_ZERO(acc); mm64(acc, lds, O_AHN, O_BCN, wave, lane);
#pragma unroll
            for (int cI = 0; cI < 2; ++cI) { const int col = ((wave & 1) * 2 + cI) * 16 + (lane & 15), row = (wave >> 1) * 16 + 4 * (lane >> 4);
#pragma unroll
                for (int e = 0; e < 4; ++e) MABF[(row + e) * 64 + col] = (col < row + e) ? acc[cI][e] : 0.f; }
            RW_ZERO(acc); mm64(acc, lds, O_AHN, O_KCN, wave, lane); storeN<1>(lds, O_MAK, acc, wave, lane);
            { f4 accb[2]; RW_ZERO(accb); mm64(accb, lds, O_RHN, O_BCN, wave, lane); f4 accc[2]; RW_ZERO(accc); mm64(accc, lds, O_RHN, O_KCN, wave, lane);
                storeN<2>(lds, O_MRB, accb, wave, lane); storeN<2>(lds, O_MRK, accc, wave, lane); }
        }
        __syncthreads();
        {
            const int cS = wave * 8 + (lane >> 3), tS = lane & 7;
            float xs[8];
#pragma unroll
            for (int k = 0; k < 8; ++k) xs[k] = 0.f;
#pragma unroll
            for (int i = 1; i < 64; ++i) {
                float part = 0.f;
#pragma unroll
                for (int k = 0; k < (i + 7) / 8; ++k) { const float mv = MABF[i * 64 + tS + 8 * k]; part += ((tS + 8 * k) < i ? mv : 0.f) * xs[k]; }
                part += __builtin_bit_cast(float, __builtin_amdgcn_update_dpp(0, __builtin_bit_cast(int, part), 0xB1, 0xF, 0xF, true));
                part += __builtin_bit_cast(float, __builtin_amdgcn_update_dpp(0, __builtin_bit_cast(int, part), 0x4E, 0xF, 0xF, true));
                part += __builtin_bit_cast(float, __builtin_amdgcn_update_dpp(0, __builtin_bit_cast(int, part), 0x141, 0xF, 0xF, true));
                const float xi = MABF[i * 64 + cS] + part;
                xs[i >> 3] = (tS == (i & 7)) ? xi : xs[i >> 3];
            }
#pragma unroll
            for (int k = 0; k < 8; ++k) { const int i = tS + 8 * k; *(LAS bf16*)(lds + O_TINV + (i * LS + cS) * 2) = (bf16)f2bf(i == cS ? 1.f : xs[k]); }
        }
        __syncthreads();
        { f4 acc[2]; RW_ZERO(acc); mm64(acc, lds, O_MAK, O_VT, wave, lane); storeT(lds, O_MVT, acc, wave, lane); }
        __syncthreads();
        if (MODE == 1 || MODE == 5) {
            { f4 acc[2]; RW_ZERO(acc); mm64(acc, lds, O_TINV, O_AHT, wave, lane); storeT(lds, O_UT, acc, wave, lane); }
            { f4 acc[2]; RW_ZERO(acc); mm64(acc, lds, O_TINV, O_MVT, wave, lane); storeT(lds, O_MAK, acc, wave, lane); }
            __syncthreads();
            f4 agm[2], azm[2], ar2[2], ay0[2];
            RW_ZERO(agm); mm64(agm, lds, O_BTT, O_UT, wave, lane);
#pragma unroll
            for (int cI = 0; cI < 2; ++cI) { const int col = ((wave & 1) * 2 + cI) * 16 + (lane & 15), row = (wave >> 1) * 16 + 4 * (lane >> 4);
#pragma unroll
                for (int e = 0; e < 4; ++e) if (col == row + e) agm[cI][e] += GAM[col]; }
            RW_ZERO(azm); mm64(azm, lds, O_BTT, O_MAK, wave, lane); mm64(azm, lds, O_KTT, O_VT, wave, lane);
            RW_ZERO(ar2); mm64(ar2, lds, O_MRB, O_UT, wave, lane);
#pragma unroll
            for (int cI = 0; cI < 2; ++cI) { const int col = ((wave & 1) * 2 + cI) * 16 + (lane & 15), row = (wave >> 1) * 16 + 4 * (lane >> 4);
#pragma unroll
                for (int e = 0; e < 4; ++e) ar2[cI][e] += bf2f(*(const LAS bf16*)(lds + O_RHN + ((row + e) * LS + col) * 2)); }
            RW_ZERO(ay0); mm64(ay0, lds, O_MRB, O_MAK, wave, lane); mm64(ay0, lds, O_MRK, O_VT, wave, lane);
            __syncthreads();
            storeN<0>(lds, O_AHN, agm, wave, lane); storeT(lds, O_RHN, azm, wave, lane); storeN<0>(lds, O_BCN, ar2, wave, lane); storeT(lds, O_KCN, ay0, wave, lane);
            __syncthreads();
            if (MODE == 1) { const int io = ((tid >> 3) * LS + (tid & 7) * 8) * 2;
              ((u32x4*)gz)[tid] = *(const LAS u32x4*)(lds + O_AHN + io); ((u32x4*)(gz + 8192))[tid] = *(const LAS u32x4*)(lds + O_RHN + io);
              ((u32x4*)gz2)[tid] = *(const LAS u32x4*)(lds + O_BCN + io); ((u32x4*)(gz2 + 8192))[tid] = *(const LAS u32x4*)(lds + O_KCN + io); }
        } else {
            { f4 acc[2]; RW_ZERO(acc); mm64(acc, lds, O_TINV, O_AHT, wave, lane); storeN<0>(lds, O_A2N, acc, wave, lane); }
            __syncthreads();
            { f4 acc[2]; RW_ZERO(acc); mm64(acc, lds, O_TINV, O_MVT, wave, lane); mm64(acc, lds, O_A2N, O_STT, wave, lane); storeT(lds, O_UT, acc, wave, lane); }
            __syncthreads();
            f4 yacc[2]; RW_ZERO(yacc);
            mm64(yacc, lds, O_RHN, O_STT, wave, lane); mm64(yacc, lds, O_MRB, O_UT, wave, lane); mm64(yacc, lds, O_MRK, O_VT, wave, lane);
            __syncthreads();
#pragma unroll
            for (int cI = 0; cI < 2; ++cI) { const int col = ((wave & 1) * 2 + cI) * 16 + (lane & 15), row = (wave >> 1) * 16 + 4 * (lane >> 4);
#pragma unroll
                for (int e = 0; e < 4; ++e) YF[(row + e) * 64 + col] = yacc[cI][e]; }
            __syncthreads();
            { unsigned gcur = (unsigned)OB[((size_t)b * T + t0 + wave * 8) * 1024 + 512 + c];
#pragma unroll 1
            for (int q = 0; q < 8; ++q) {
                const int tt = wave * 8 + q; const size_t m = (size_t)b * T + t0 + tt;
                const unsigned gnxt = (unsigned)OB[(m + (q < 7 ? 1 : 0)) * 1024 + 512 + c];
                const float y = YF[tt * 64 + lane]; const float mean = wave_sum(y) * (1.f / 64.f); const float dy = y - mean; const float var = wave_sum(dy * dy) * (1.f / 64.f);
                const float yn = dy * rsqrtf(var + 64e-5f) * CTV(10) + CTV(11);
                const float vv = bf2f(*(const LAS bf16*)(lds + O_VT + (lane * LS + tt) * 2)), gg = LO_(gcur);
                OB[m * 1024 + 512 + c] = (bf16)f2bf((yn + BON[tt] * vv) * gg);
                gcur = gnxt;
            } }
        }
        __syncthreads();
#undef CTV
#undef LO_
#undef HI_
    }
}

__device__ __forceinline__ void chunk_out(LAS unsigned char* lds0, const int b, const int h, const int t0, const unsigned char* gz, const unsigned char* gz2, const float* bong, const bf16* VF, bf16* OB, const int tid0) {
    unsigned lb_ = 0u; int tid_l = tid0; asm volatile("" : "+v"(lb_), "+v"(tid_l));
    LAS unsigned char* lds = lds0 + lb_; const int tid = tid_l, lane = tid & 63, wave = __builtin_amdgcn_readfirstlane(tid >> 6);
    const int c = h * 64 + lane;
    const LAS float* CT = (const LAS float*)(lds + O_CT);
    LAS float* YF = (LAS float*)(lds + O_YF);
    const int io = ((tid >> 3) * LS + (tid & 7) * 8) * 2;
    const u32x4 sv = ((const u32x4*)gz)[tid], rv = ((const u32x4*)gz2)[tid];
    u32x2 yv[2];
#pragma unroll
    for (int k = 0; k < 2; ++k) { const int col = ((wave & 1) * 2 + k) * 16 + (lane & 15), row = (wave >> 1) * 16 + 4 * (lane >> 4); yv[k] = *(const u32x2*)(gz2 + 8192 + (col * 64 + row) * 2); }
    float gq[8], vq[8], bq[8];
#pragma unroll
    for (int q = 0; q < 8; ++q) { const int tt = wave * 8 + q; const size_t m = (size_t)b * T + t0 + tt;
        gq[q] = bf2f(((const bf16*)(gz2 + 16384))[tt * 64 + lane]); vq[q] = bf2f(VF[m * 256 + c]); bq[q] = bong[tt]; }
    *(LAS u32x4*)(lds + O_STT + io) = sv; *(LAS u32x4*)(lds + O_AHN + io) = rv;
    __syncthreads();
    f4 acc[2];
#pragma unroll
    for (int k = 0; k < 2; ++k) acc[k] = (f4){__uint_as_float(yv[k].x << 16), __uint_as_float(yv[k].x & 0xffff0000u), __uint_as_float(yv[k].y << 16), __uint_as_float(yv[k].y & 0xffff0000u)};
    mm64(acc, lds, O_AHN, O_STT, wave, lane);
#pragma unroll
    for (int cI = 0; cI < 2; ++cI) { const int col = ((wave & 1) * 2 + cI) * 16 + (lane & 15), row = (wave >> 1) * 16 + 4 * (lane >> 4);
#pragma unroll
        for (int e = 0; e < 4; ++e) YF[(row + e) * 64 + col] = acc[cI][e]; }
    __syncthreads();
#pragma unroll
    for (int q = 0; q < 8; ++q) { const int tt = wave * 8 + q; const size_t m = (size_t)b * T + t0 + tt;
        const float y = YF[tt * 64 + lane]; const float mean = wave_sum(y) * (1.f / 64.f); const float dy = y - mean; const float var = wave_sum(dy * dy) * (1.f / 64.f);
        const float yn = dy * rsqrtf(var + 64e-5f) * CT[10 * 64 + lane] + CT[11 * 64 + lane];
        OB[m * 1024 + 512 + c] = (bf16)f2bf((yn + bq[q] * vq[q]) * gq[q]); }
    __syncthreads();
}

__device__ __forceinline__ void carry(LAS unsigned char* lds0, unsigned char* gzc  , const int tid0) {
    f4 stacc[2]; RW_ZERO(stacc);
    { unsigned lb_ = 0u; asm volatile("" : "+v"(lb_)); LAS unsigned char* lds = lds0 + lb_; for (int i = tid0; i < MB / 4; i += NTHR) ((LAS unsigned*)(lds + O_STT))[i] = 0u; }
    u32x4 gnx = ((const u32x4*)gzc)[tid0];
    u32x2 znx[2];
    { const int lane = tid0 & 63, wave = tid0 >> 6;
#pragma unroll
      for (int k = 0; k < 2; ++k) { const int col = ((wave & 1) * 2 + k) * 16 + (lane & 15), row = (wave >> 1) * 16 + 4 * (lane >> 4); znx[k] = *(const u32x2*)(gzc + 8192 + (col * 64 + row) * 2); } }
#pragma unroll 1
    for (int cI = 0; cI < T / 64; ++cI) {
        unsigned lb_ = 0u; int tid_l = tid0; asm volatile("" : "+v"(lb_), "+v"(tid_l));
        LAS unsigned char* lds = lds0 + lb_; const int tid = tid_l, lane = tid & 63, wave = __builtin_amdgcn_readfirstlane(tid >> 6);
        unsigned char* rec = gzc + (size_t)cI * 16384;
        const int io = ((tid >> 3) * LS + (tid & 7) * 8) * 2;
        *(LAS u32x4*)(lds + O_AHN + io) = gnx;
        u32x2 zv[2]; zv[0] = znx[0]; zv[1] = znx[1];
        if (cI + 1 < T / 64) { gnx = ((const u32x4*)(rec + 16384))[tid];
#pragma unroll
            for (int k = 0; k < 2; ++k) { const int col = ((wave & 1) * 2 + k) * 16 + (lane & 15), row = (wave >> 1) * 16 + 4 * (lane >> 4); znx[k] = *(const u32x2*)(rec + 16384 + 8192 + (col * 64 + row) * 2); } }
        __syncthreads();
        ((u32x4*)rec)[tid] = *(const LAS u32x4*)(lds + O_STT + io);
        f4 acc[2];
#pragma unroll
        for (int k = 0; k < 2; ++k) acc[k] = (f4){__uint_as_float(zv[k].x << 16), __uint_as_float(zv[k].x & 0xffff0000u), __uint_as_float(zv[k].y << 16), __uint_as_float(zv[k].y & 0xffff0000u)};
        mm64(acc, lds, O_AHN, O_STT, wave, lane);
        __syncthreads();
        storeT(lds, O_STT, acc, wave, lane);
    }
}
}

namespace mb {
using rw::LS; using rw::MB; using rw::f4; using rw::mm64; using rw::storeN; using rw::bf16x8;
constexpr int O_CN = 0, O_BN = MB, O_BT = 2 * MB, O_XT0 = 3 * MB, O_XW0 = 5 * MB, O_CS0 = 7 * MB, O_HN0 = 9 * MB, O_SC0 = 11 * MB, O_SM = 13 * MB, O_YF = O_XW0;
static_assert(O_SM + 2048 <= LDS_BYTES - 576, "mamba LDS map");
__device__ __forceinline__ void chain(LAS unsigned char* lds0, const int l, const int b, const int gI, const bf16* P, bf16* OB, const int tid0, const int lane0, const int wave0) {
    const int tid = tid0, lane = lane0, wave = wave0;
    LAS unsigned char* const& lds = lds0;
    const float* cwp = INP(I_DCW) + (size_t)l * 4 * 512; const float* cbp = INP(I_DCB) + (size_t)l * 512;
    const int cc = tid & 255, sub = tid >> 8;
    const int col = cc < 128 ? (gI * 128 + cc) : (cc < 192 ? (256 + gI * 64 + (cc - 128)) : (384 + gI * 64 + (cc - 192)));
    const float cw0 = cwp[col], cw1 = cwp[512 + col], cw2 = cwp[1024 + col], cw3 = cwp[1536 + col], cb = cbp[col];
    f4 hacc[2][2];
#pragma unroll
    for (int hh = 0; hh < 2; ++hh) { hacc[hh][0] = (f4){0.f, 0.f, 0.f, 0.f}; hacc[hh][1] = (f4){0.f, 0.f, 0.f, 0.f}; }
    for (int i = tid; i < 2 * MB / 4; i += NTHR) ((LAS unsigned*)(lds0 + O_HN0))[i] = 0u;
    const float dtb0 = INP(I_DDTB)[l * 4 + gI * 2], dtb1 = INP(I_DDTB)[l * 4 + gI * 2 + 1];
    const float nA0 = -__expf(INP(I_DALOG)[l * 4 + gI * 2]), nA1 = -__expf(INP(I_DALOG)[l * 4 + gI * 2 + 1]);
    const float dsk0 = INP(I_DSKIP)[l * 4 + gI * 2], dsk1 = INP(I_DSKIP)[l * 4 + gI * 2 + 1];
    const float nw0 = INP(I_DNW)[l * 256 + gI * 128 + lane], nw1 = INP(I_DNW)[l * 256 + gI * 128 + 64 + lane];
#pragma unroll 1
    for (int t0 = 0; t0 < T; t0 += 64) {
        unsigned lb_ = 0u; int tid_l = tid0; asm volatile("" : "+v"(lb_), "+v"(tid_l));
        const int tid = tid_l, lane = tid & 63, wave = __builtin_amdgcn_readfirstlane(tid >> 6);
        LAS unsigned char* lds = lds0 + lb_;
        LAS float* SM = (LAS float*)(lds + O_SM);
        LAS float* YF = (LAS float*)(lds + O_YF);
        if (wave < 2) {
            const size_t m = (size_t)b * T + t0 + lane;
            const float dt = softplusf_(bf2f(P[m * PP + C_DT + gI * 2 + wave]) + (wave == 0 ? dtb0 : dtb1));
            float cs = dt * (wave == 0 ? nA0 : nA1);
#pragma unroll
            for (int o = 1; o < 64; o <<= 1) { const float y = __shfl_up(cs, o); if (lane >= o) cs += y; }
            const float cL = __shfl(cs, 63);
            SM[wave * 64 + lane] = dt; SM[128 + wave * 64 + lane] = cs; SM[256 + wave * 64 + lane] = __expf(cL - cs) * dt; SM[384 + wave * 64 + lane] = __expf(cs);
        }
        __syncthreads();
        { float h0, h1, h2, cur[8], nxt[8];
          { const int tb = t0 + sub * 32; h0 = tb >= 3 ? bf2f(P[((size_t)b * T + tb - 3) * PP + C_DX + col]) : 0.f; h1 = tb >= 2 ? bf2f(P[((size_t)b * T + tb - 2) * PP + C_DX + col]) : 0.f; h2 = tb >= 1 ? bf2f(P[((size_t)b * T + tb - 1) * PP + C_DX + col]) : 0.f;
#pragma unroll
            for (int j = 0; j < 8; ++j) cur[j] = bf2f(P[((size_t)b * T + tb + j) * PP + C_DX + col]); }
#pragma unroll 1
          for (int g8 = 0; g8 < 4; ++g8) {
            const int tb = t0 + sub * 32 + g8 * 8 + (g8 < 3 ? 8 : 0);
#pragma unroll
            for (int j = 0; j < 8; ++j) nxt[j] = bf2f(P[((size_t)b * T + tb + j) * PP + C_DX + col]);
#pragma unroll
            for (int j = 0; j < 8; ++j) {
                const int tt = sub * 32 + g8 * 8 + j;
                const float a = siluf_(cb + cw3 * cur[j] + cw2 * h2 + cw1 * h1 + cw0 * h0);
                h0 = h1; h1 = h2; h2 = cur[j];
                if (cc < 128) { const int hh = cc >> 6, p = cc & 63;
                    *(LAS bf16*)(lds + O_XT0 + hh * MB + (p * LS + tt) * 2) = (bf16)f2bf(a); *(LAS bf16*)(lds + O_XW0 + hh * MB + (p * LS + tt) * 2) = (bf16)f2bf(a * SM[256 + hh * 64 + tt]); }
                else if (cc < 192) { const int n = cc - 128; *(LAS bf16*)(lds + O_BN + (tt * LS + n) * 2) = (bf16)f2bf(a); *(LAS bf16*)(lds + O_BT + (n * LS + tt) * 2) = (bf16)f2bf(a); }
                else { const int n = cc - 192; *(LAS bf16*)(lds + O_CN + (tt * LS + n) * 2) = (bf16)f2bf(a);
                    *(LAS bf16*)(lds + O_CS0 + (tt * LS + n) * 2) = (bf16)f2bf(a * SM[384 + tt]); *(LAS bf16*)(lds + O_CS0 + MB + (tt * LS + n) * 2) = (bf16)f2bf(a * SM[384 + 64 + tt]); }
            }
#pragma unroll
            for (int j = 0; j < 8; ++j) cur[j] = nxt[j];
          } }
        __syncthreads();
        { f4 acc[2]; acc[0] = (f4){0.f, 0.f, 0.f, 0.f}; acc[1] = (f4){0.f, 0.f, 0.f, 0.f}; mm64(acc, lds, O_CN, O_BN, wave, lane);
#pragma unroll
            for (int hh = 0; hh < 2; ++hh) { f4 sc[2];
#pragma unroll
                for (int cI = 0; cI < 2; ++cI) { const int s = ((wave & 1) * 2 + cI) * 16 + (lane & 15), row = (wave >> 1) * 16 + 4 * (lane >> 4);
                    const float cs = SM[128 + hh * 64 + s], ds = SM[hh * 64 + s];
#pragma unroll
                    for (int e = 0; e < 4; ++e) { const float ct = SM[128 + hh * 64 + row + e]; sc[cI][e] = (s <= row + e) ? acc[cI][e] * __expf(ct - cs) * ds : 0.f; } }
                storeN<0>(lds, O_SC0 + hh * MB, sc, wave, lane); } }
        __syncthreads();
        f4 yacc[2][2];
#pragma unroll
        for (int hh = 0; hh < 2; ++hh) {
            yacc[hh][0] = (f4){0.f, 0.f, 0.f, 0.f}; yacc[hh][1] = (f4){0.f, 0.f, 0.f, 0.f};
            mm64(yacc[hh], lds, O_SC0 + hh * MB, O_XT0 + hh * MB, wave, lane); mm64(yacc[hh], lds, O_CS0 + hh * MB, O_HN0 + hh * MB, wave, lane);
            const float gL = SM[384 + hh * 64 + 63]; hacc[hh][0] = hacc[hh][0] * gL; hacc[hh][1] = hacc[hh][1] * gL;
            mm64(hacc[hh], lds, O_XW0 + hh * MB, O_BT, wave, lane);
        }
        __syncthreads();
#pragma unroll
        for (int hh = 0; hh < 2; ++hh) {
#pragma unroll
            for (int cI = 0; cI < 2; ++cI) { const int colp = ((wave & 1) * 2 + cI) * 16 + (lane & 15), row = (wave >> 1) * 16 + 4 * (lane >> 4);
#pragma unroll
                for (int e = 0; e < 4; ++e) YF[(row + e) * 128 + hh * 64 + colp] = yacc[hh][cI][e]; }
            storeN<0>(lds, O_HN0 + hh * MB, hacc[hh], wave, lane);
        }
        __syncthreads();
#pragma unroll
        for (int q = 0; q < 8; ++q) {
            const int tt = wave * 8 + q; const size_t m = (size_t)b * T + t0 + tt;
            const float x0 = bf2f(*(const LAS bf16*)(lds + O_XT0 + (lane * LS + tt) * 2)), x1 = bf2f(*(const LAS bf16*)(lds + O_XT0 + MB + (lane * LS + tt) * 2));
            const int c0 = gI * 128 + lane, c1 = c0 + 64;
            const float z0 = bf2f(P[m * PP + C_DZ + c0]), z1 = bf2f(P[m * PP + C_DZ + c1]);
            const float y0 = (YF[tt * 128 + lane] + dsk0 * x0) * siluf_(z0), y1 = (YF[tt * 128 + 64 + lane] + dsk1 * x1) * siluf_(z1);
            const float ss = wave_sum(y0 * y0 + y1 * y1); const float rs = rsqrtf(ss * (1.f / 128.f) + 1e-5f);
            OB[m * 1024 + 768 + c0] = (bf16)f2bf(y0 * rs * nw0); OB[m * 1024 + 768 + c1] = (bf16)f2bf(y1 * rs * nw1);
        }
        __syncthreads();
    }
}
}

namespace bsp {
typedef short bf16x8 __attribute__((ext_vector_type(8)));
typedef float f4 __attribute__((ext_vector_type(4)));
constexpr int HS = 129;
constexpr int O_HIST = 0;
constexpr int O_V = 66048;
constexpr int VS = 272;
constexpr int O_KB = O_V + 2 * 32 * VS * 2;
constexpr int KBUF = 20480;
static_assert(O_KB + 2 * KBUF <= LDS_BYTES - 600, "mixer B LDS map");
__device__ __forceinline__ float relu_(float x) { return __int_as_float(max(__float_as_int(x), 0)); }
__device__ __forceinline__ int qkey(float s) { int q = (int)__builtin_fmaf(s, 262144.f, 8388608.f); return q < 1 ? 1 : (q > 16777215 ? 16777215 : q); }
__device__ __forceinline__ unsigned okey(float s) { return (unsigned)qkey(s) << 8; }
__device__ __forceinline__ int f2o(float f) { const int b = __float_as_int(f); return b ^ ((b >> 31) & 0x7fffffff); }
__device__ __forceinline__ float o2f(int o) { return __int_as_float(o ^ ((o >> 31) & 0x7fffffff)); }
__device__ __forceinline__ float fthr(const unsigned Q) {
    const int Qc = (int)(Q < 2u ? 2u : (Q > 16777215u ? 16777215u : Q));
    long long lo = f2o(-64.f), hi = f2o(64.f);
#pragma unroll 1
    for (int i = 0; i < 33; ++i) { const int mid = (int)((lo + hi) >> 1); if (qkey(o2f(mid)) >= Qc) hi = mid; else lo = mid; }
    const float r = o2f((int)hi);
    return Q < 2u ? -INFINITY : (Q > 16777215u ? INFINITY : r);
}
__device__ __forceinline__ void hist_add(const unsigned addr, const unsigned v) { asm volatile("ds_add_u32 %0, %1" :: "v"(addr), "v"(v) : "memory"); }
__device__ __forceinline__ f4 idx_tile(const bf16* Pb, const int kt, const bf16x8 (&qi)[4][2], const float (&wq)[4], const int lane) {
    const bf16* kr = Pb + (size_t)(kt * 16 + (lane & 15)) * PP + C_IK + (lane >> 4) * 8;
    const bf16x8 a0 = *(const bf16x8*)kr, a1 = *(const bf16x8*)(kr + 32);
    f4 s = (f4){0.f, 0.f, 0.f, 0.f};
#pragma unroll
    for (int h = 0; h < 4; ++h) { f4 t = (f4){0.f, 0.f, 0.f, 0.f};
        t = __builtin_amdgcn_mfma_f32_16x16x32_bf16(a0, qi[h][0], t, 0, 0, 0); t = __builtin_amdgcn_mfma_f32_16x16x32_bf16(a1, qi[h][1], t, 0, 0, 0);
#pragma unroll
        for (int e = 0; e < 4; ++e) s[e] += wq[h] * relu_(t[e]); }
    return s;
}

__device__ __forceinline__ void item(LAS unsigned char* lds0, const int bb, const int qb, const bf16* P, bf16* OB, const int tid0, const int pm) {
    unsigned lb_ = 0u; int tid_l = tid0; asm volatile("" : "+v"(lb_), "+v"(tid_l));
    LAS unsigned char* lds = lds0 + lb_; const int tid = tid_l, lane = tid & 63, wave = __builtin_amdgcn_readfirstlane(tid >> 6);
    const bf16* Pb = P + (size_t)bb * T * PP;
    const int ql = wave * 16 + (lane & 15), tq = qb * 128 + ql, g = lane >> 4;
    const bf16* prow = Pb + (size_t)tq * PP;
    bf16x8 qi[4][2]; float wq[4];
#pragma unroll
    for (int h = 0; h < 4; ++h) { qi[h][0] = *(const bf16x8*)(prow + C_IQ + h * 64 + g * 8); qi[h][1] = *(const bf16x8*)(prow + C_IQ + h * 64 + 32 + g * 8); wq[h] = bf2f(prow[C_IW + h]) * 0.0625f; }
    LAS unsigned* hist = (LAS unsigned*)(lds + O_HIST) + ql * HS;
    const unsigned histb = (unsigned)(size_t)hist;
    const int nkt = (qb + 1) * 8;
    unsigned prefix = 0u; int needk = 256;
#pragma unroll 1
    for (int rr = 0; rr < (pm == 102 ? 2 : 1); ++rr) { prefix = 0u; needk = 256;
#pragma unroll 1
    for (int pass = 0; pass < 3; ++pass) {
        for (int i = lane; i < 16 * HS; i += 64) ((LAS unsigned*)(lds + O_HIST) + wave * 16 * HS)[i] = 0u;
        asm volatile("s_waitcnt lgkmcnt(0)" ::: "memory");
        const int shp = 32 - 8 * pass, shb = 24 - 8 * pass;
        float flo = 0.f, fhi = 0.f;
        if (pass > 0) { const float stepw = (pass == 1) ? 65536.f : 256.f; flo = ((float)prefix * stepw - 2.f) * (1.f / 262144.f) - 32.f; fhi = (((float)prefix + 1.f) * stepw + 2.f) * (1.f / 262144.f) - 32.f; }
        const int nsteps = pm >= 300 ? 0 : nkt >> 2;
#define RDX_DMA(stepi, bufi) do { const int st_ = (stepi) < nsteps ? (stepi) : (nsteps - 1); const int S_ = wave * 64 + lane, r_ = S_ >> 3, p_ = S_ & 7; \
            __builtin_amdgcn_global_load_lds((const unsigned*)(Pb + (size_t)(st_ * 64 + r_) * PP + C_IK + ((p_ ^ (r_ & 7)) << 3)), (LAS unsigned*)(lds + O_V + (bufi) * 8192 + wave * 1024), 16, 0, 0); } while (0)
        asm volatile("s_waitcnt vmcnt(0) lgkmcnt(0)" ::: "memory"); __builtin_amdgcn_s_barrier();
        RDX_DMA(0, 0); RDX_DMA(1, 1); RDX_DMA(2, 2);
        float dummy = 0.f;
        auto steps = [&](auto VARc) { constexpr int VAR = decltype(VARc)::value;
#pragma unroll 1
        for (int stp = 0; stp < nsteps; ++stp) {
            if constexpr (VAR != 4) {
            asm volatile("s_waitcnt vmcnt(2)" ::: "memory");
            __builtin_amdgcn_s_barrier();
            RDX_DMA(stp + 3, (stp + 3) & 3); }
            const unsigned kbr = (unsigned)(O_V + (stp & 3) * 8192);
            const int kt4 = stp * 4;
#pragma unroll
            for (int u = 0; u < 4; ++u) {
                bf16x8 ka0, ka1;
                if constexpr (VAR != 4) { ka0 = *(const LAS bf16x8*)(lds + kbr + (u * 16 + (lane & 15)) * 128 + (((0 + g) ^ (lane & 7)) << 4));
                ka1 = *(const LAS bf16x8*)(lds + kbr + (u * 16 + (lane & 15)) * 128 + (((4 + g) ^ (lane & 7)) << 4)); }
                else { ka0 = qi[u][0]; ka1 = qi[u][1]; }
                f4 s = (f4){0.f, 0.f, 0.f, 0.f};
                if constexpr (VAR == 3) { const f4 ta = __builtin_bit_cast(f4, ka0), tb = __builtin_bit_cast(f4, ka1); s = ta + tb; }
                else {
#pragma unroll
                for (int h = 0; h < 4; ++h) { f4 t = (f4){0.f, 0.f, 0.f, 0.f};
                    if constexpr (VAR == 2) { t = __builtin_bit_cast(f4, h & 1 ? ka1 : ka0); }
                    else { t = __builtin_amdgcn_mfma_f32_16x16x32_bf16(ka0, qi[h][0], t, 0, 0, 0); t = __builtin_amdgcn_mfma_f32_16x16x32_bf16(ka1, qi[h][1], t, 0, 0, 0); }
#pragma unroll
                    for (int e = 0; e < 4; ++e) s[e] += wq[h] * relu_(t[e]); } }
                if constexpr (VAR >= 1 && VAR <= 3) { dummy += s[0] + s[1] + s[2] + s[3]; } else {
                if (pass == 0) {
#pragma unroll
                    for (int e = 0; e < 4; ++e) { const int key = (kt4 + u) * 16 + 4 * g + e;
                        if (key <= tq) { const unsigned bin = okey(s[e]) >> 24; hist_add(histb + ((bin >> 1) << 2), (bin & 1u) ? 0x10000u : 1u); } }
                } else {
#pragma unroll
                    for (int e = 0; e < 4; ++e) { const int key = (kt4 + u) * 16 + 4 * g + e;
                        if (s[e] >= flo && s[e] <= fhi && key <= tq) { const unsigned k32 = okey(s[e]);
                            if ((k32 >> shp) == prefix) { const unsigned bin = (k32 >> shb) & 255u; hist_add(histb + ((bin >> 1) << 2), (bin & 1u) ? 0x10000u : 1u); } } }
                } }
            }
        }
        };
        if (pm == 201) steps(std::integral_constant<int, 1>{}); else if (pm == 202) steps(std::integral_constant<int, 2>{}); else if (pm == 203) steps(std::integral_constant<int, 3>{});
        else if (pm == 204) steps(std::integral_constant<int, 4>{}); else steps(std::integral_constant<int, 0>{});
        if (dummy == 12345.678f) hist_add(histb, 1u);
        asm volatile("s_waitcnt vmcnt(0)" ::: "memory");
#undef RDX_DMA
        asm volatile("s_waitcnt lgkmcnt(0)" ::: "memory");
        int cum = 0; unsigned bsel = 0u; int above = 0;
        for (int wd = 127; wd >= 0; --wd) { const unsigned v = hist[wd]; const int hi = (int)(v >> 16), lo = (int)(v & 0xffffu);
            if (cum + hi >= needk) { bsel = (unsigned)(2 * wd + 1); above = cum; break; } cum += hi;
            if (cum + lo >= needk) { bsel = (unsigned)(2 * wd); above = cum; break; } cum += lo; }
        prefix = (prefix << 8) | bsel; needk -= above;
        asm volatile("s_waitcnt lgkmcnt(0)" ::: "memory");
    }
    }
    if (pm >= 200 && pm < 300) { __syncthreads(); return; }
    unsigned thr = prefix; int need = needk;
    bool tie = false;
    if (tq < 256) { thr = 0u; need = 1 << 20; }
    else { const unsigned v = hist[(prefix & 255u) >> 1]; const int ceq = (prefix & 1u) ? (int)(v >> 16) : (int)(v & 0xffffu); tie = needk < ceq; }
    __syncthreads();
    const bool anytie = __any(tie);
    const float sB = fthr(thr);
    unsigned cn = (unsigned)(need > 0xffff ? 0xffff : need) << 16;
    constexpr int O_TC = O_KB + 2 * KBUF + 2048;
    if (g == 0) { *(LAS unsigned*)(lds + O_TC + ql * 8) = thr; *(LAS unsigned*)(lds + O_TC + ql * 8 + 4) = cn; }
    const int tqmin = qb * 128 + wave * 16;
#pragma unroll
    for (int h = 0; h < 4; ++h) { *(LAS bf16x8*)(lds + O_HIST + wave * 8192 + ((h * 2 + 0) * 64 + lane) * 16) = qi[h][0]; *(LAS bf16x8*)(lds + O_HIST + wave * 8192 + ((h * 2 + 1) * 64 + lane) * 16) = qi[h][1]; }
    constexpr int O_WQ = O_KB + 2 * KBUF;
    if (g == 0) {
#pragma unroll
        for (int h = 0; h < 4; ++h) *(LAS float*)(lds + O_WQ + ((wave * 4 + h) * 16 + (lane & 15)) * 4) = wq[h]; }
    bf16x8 qa[4][2];
#pragma unroll
    for (int h = 0; h < 4; ++h) { qa[h][0] = *(const bf16x8*)(prow + C_BQ + h * 64 + g * 8); qa[h][1] = *(const bf16x8*)(prow + C_BQ + h * 64 + 32 + g * 8); }
    f4 oacc[4][4]; float mrun[4], lrun[4];
#pragma unroll
    for (int h = 0; h < 4; ++h) { mrun[h] = -INFINITY; lrun[h] = 0.f;
#pragma unroll
        for (int dt = 0; dt < 4; ++dt) oacc[h][dt] = (f4){0.f, 0.f, 0.f, 0.f}; }
#pragma unroll 1
    for (int rr = 0; rr < (pm == 103 ? 2 : 1); ++rr) {
#pragma unroll
    for (int h = 0; h < 4; ++h) { mrun[h] = -INFINITY; lrun[h] = 0.f;
#pragma unroll
        for (int dt = 0; dt < 4; ++dt) oacc[h][dt] = (f4){0.f, 0.f, 0.f, 0.f}; }
    const int nst = (qb + 1) * 4;
    const int vkey = tid >> 4, vch = tid & 15;
    u32x4 vpre0 = *(const u32x4*)(Pb + (size_t)vkey * PP + C_BV + vch * 8), vpre1 = *(const u32x4*)(Pb + (size_t)vkey * PP + C_BV + 128 + vch * 8);
    const unsigned vrd = (unsigned)(unsigned long)lds + (unsigned)(O_V + (4 * g + ((lane >> 2) & 3)) * (VS * 2) + (lane & 3) * 8);
    __syncthreads();
    const int kr_ = 2 * wave + (lane >> 5), kir_ = wave * 8 + (lane >> 3);
    const bf16* kbase = Pb + (size_t)kr_ * PP + C_BK + (((lane & 31) ^ (kr_ & 15)) << 3);
    const bf16* kibase = Pb + (size_t)kir_ * PP + C_IK + (((lane & 7) ^ (kir_ & 7)) << 3);
#define K_DMA(key_first, kbo) do { const bf16* s0_ = kbase + (size_t)(key_first) * PP; \
        __builtin_amdgcn_global_load_lds((const unsigned*)s0_, (LAS unsigned*)(lds + (kbo) + wave * 1024), 16, 0, 0); \
        __builtin_amdgcn_global_load_lds((const unsigned*)(s0_ + (size_t)16 * PP), (LAS unsigned*)(lds + (kbo) + (wave + 8) * 1024), 16, 0, 0); \
        if (wave < 4) __builtin_amdgcn_global_load_lds((const unsigned*)(kibase + (size_t)(key_first) * PP), (LAS unsigned*)(lds + (kbo) + 16384 + wave * 1024), 16, 0, 0); } while (0)
    K_DMA(0, (unsigned)O_KB);
#pragma unroll 1
    for (int st = 0; st < nst; ++st) {
        const int key0 = st * 32; const unsigned vbuf = (unsigned)(st & 1) * (32 * VS * 2);
        unsigned qio = (unsigned)(O_HIST + wave * 8192 + lane * 16); asm volatile("" : "+v"(qio));
        unsigned wqo = (unsigned)(O_WQ + wave * 256 + (lane & 15) * 4); asm volatile("" : "+v"(wqo));
        unsigned tco = (unsigned)(O_TC + (wave * 16 + (lane & 15)) * 8); asm volatile("" : "+v"(tco));
        { LAS bf16* VL = (LAS bf16*)(lds + O_V + vbuf); *(LAS u32x4*)(VL + vkey * VS + vch * 8) = vpre0; *(LAS u32x4*)(VL + vkey * VS + 128 + vch * 8) = vpre1; }
        asm volatile("s_waitcnt vmcnt(0)" ::: "memory");
        __syncthreads();
        if (st + 1 < nst) K_DMA(key0 + 32, (unsigned)(O_KB + ((st + 1) & 1) * KBUF));
        const unsigned kbc = (unsigned)(O_KB + (st & 1) * KBUF);
#define KQ_(h, k2, ks) (*(const LAS bf16x8*)(lds + kbc + (k2 * 16 + (lane & 15)) * 512 + ((((h) * 8 + (ks) * 4 + g) ^ (lane & 15)) << 4)))
#define KI_(k2, ks) (*(const LAS bf16x8*)(lds + kbc + 16384 + (k2 * 16 + (lane & 15)) * 128 + ((((ks) * 4 + g) ^ (lane & 7)) << 4)))
        const bool active = key0 <= tqmin + 15;
        bool sel[2][4] = {{false, false, false, false}, {false, false, false, false}};
        if (active && pm == 305) {
#pragma unroll
            for (int k2 = 0; k2 < 2; ++k2)
#pragma unroll
                for (int e = 0; e < 4; ++e) sel[k2][e] = (key0 + k2 * 16 + 4 * g + e) <= tq;
        } else if (active) {
            unsigned eqm = 0u;
            const bool plain = !anytie && key0 + 31 <= tqmin;
#pragma unroll
            for (int k2 = 0; k2 < 2; ++k2) { f4 s = (f4){0.f, 0.f, 0.f, 0.f};
#pragma unroll
                for (int h = 0; h < 4; ++h) { f4 t = (f4){0.f, 0.f, 0.f, 0.f};
                    const bf16x8 qh0 = *(const LAS bf16x8*)(lds + qio + ((h * 2 + 0) * 64) * 16), qh1 = *(const LAS bf16x8*)(lds + qio + ((h * 2 + 1) * 64) * 16);
                    t = __builtin_amdgcn_mfma_f32_16x16x32_bf16(KI_(k2, 0), qh0, t, 0, 0, 0); t = __builtin_amdgcn_mfma_f32_16x16x32_bf16(KI_(k2, 1), qh1, t, 0, 0, 0);
                    const float wqh = *(const LAS float*)(lds + wqo + h * 64);
#pragma unroll
                    for (int e = 0; e < 4; ++e) s[e] += wqh * relu_(t[e]); }
                if (plain) {
#pragma unroll
                    for (int e = 0; e < 4; ++e) sel[k2][e] = s[e] >= sB;
                } else {
                    const unsigned thr_ = *(const LAS unsigned*)(lds + tco);
#pragma unroll
                    for (int e = 0; e < 4; ++e) { const int key = key0 + k2 * 16 + 4 * g + e, tq_ = tqmin + (lane & 15); const unsigned k24 = (unsigned)qkey(s[e]);
                        sel[k2][e] = (key <= tq_) & (k24 > thr_); if ((key <= tq_) & (k24 == thr_)) eqm |= 1u << (k2 * 4 + e); }
                } }
            if (!plain) {
                if (anytie && __any(eqm != 0u)) {
                    const unsigned pk = (unsigned)__popc(eqm & 15u) | ((unsigned)__popc(eqm >> 4) << 8);
                    const unsigned p0 = (unsigned)__shfl((int)pk, lane & 15), p1 = (unsigned)__shfl((int)pk, (lane & 15) + 16), p2 = (unsigned)__shfl((int)pk, (lane & 15) + 32), p3 = (unsigned)__shfl((int)pk, (lane & 15) + 48);
                    const unsigned tot = p0 + p1 + p2 + p3, below = (g > 0 ? p0 : 0u) + (g > 1 ? p1 : 0u) + (g > 2 ? p2 : 0u);
                    const unsigned cn_ = *(const LAS unsigned*)(lds + tco + 4); const int cnt = (int)(cn_ & 0xffffu), need_ = (int)(cn_ >> 16); const int base0 = cnt + (int)(below & 255u), base1 = cnt + (int)(tot & 255u) + (int)(below >> 8);
#pragma unroll
                    for (int k2 = 0; k2 < 2; ++k2)
#pragma unroll
                        for (int e = 0; e < 4; ++e) { const unsigned bit = 1u << (k2 * 4 + e);
                            const int rank = (k2 ? base1 : base0) + __popc(eqm & (bit - 1u) & (k2 ? 0xf0u : 0x0fu));
                            sel[k2][e] = sel[k2][e] | (((eqm & bit) != 0u) & (rank < need_)); }
                    *(LAS unsigned*)(lds + tco + 4) = cn_ + (tot & 255u) + (tot >> 8);
                } else {
#pragma unroll
                    for (int k2 = 0; k2 < 2; ++k2)
#pragma unroll
                        for (int e = 0; e < 4; ++e) sel[k2][e] = sel[k2][e] | ((eqm & (1u << (k2 * 4 + e))) != 0u);
                }
            }
        }
#pragma unroll
        for (int h = 0; h < 4; ++h) {
            if (h == 2 && st + 1 < nst) { vpre0 = *(const u32x4*)(Pb + (size_t)(key0 + 32 + vkey) * PP + C_BV + vch * 8); vpre1 = *(const u32x4*)(Pb + (size_t)(key0 + 32 + vkey) * PP + C_BV + 128 + vch * 8); }
            if (active) {
            f4 sc[2];
#pragma unroll
            for (int k2 = 0; k2 < 2; ++k2) { f4 t = (f4){0.f, 0.f, 0.f, 0.f};
                t = __builtin_amdgcn_mfma_f32_16x16x32_bf16(KQ_(h, k2, 0), qa[h][0], t, 0, 0, 0); t = __builtin_amdgcn_mfma_f32_16x16x32_bf16(KQ_(h, k2, 1), qa[h][1], t, 0, 0, 0);
#pragma unroll
                for (int e = 0; e < 4; ++e) sc[k2][e] = sel[k2][e] ? t[e] * (0.125f * 1.4426950408889634f) : -INFINITY; }
            float mx = fmaxf(fmaxf(fmaxf(sc[0][0], sc[0][1]), fmaxf(sc[0][2], sc[0][3])), fmaxf(fmaxf(sc[1][0], sc[1][1]), fmaxf(sc[1][2], sc[1][3])));
            mx = fmaxf(mx, __shfl_xor(mx, 16)); mx = fmaxf(mx, __shfl_xor(mx, 32));
            const float mnew = fmaxf(mrun[h], mx), msafe = (mnew == -INFINITY) ? 0.f : mnew;
            const bool resc = __any(mnew != mrun[h]);
            const float corr = __builtin_amdgcn_exp2f(mrun[h] - msafe); mrun[h] = mnew;
            float p[8]; float ps = 0.f;
#pragma unroll
            for (int e = 0; e < 4; ++e) { p[e] = __builtin_amdgcn_exp2f(sc[0][e] - msafe); p[4 + e] = __builtin_amdgcn_exp2f(sc[1][e] - msafe); ps += p[e] + p[4 + e]; }
            lrun[h] = lrun[h] * corr + ps;
            union { bf16x8 v; unsigned u[4]; } pb;
            pb.u[0] = pg8::cvt_pk_bf16(p[0], p[1]); pb.u[1] = pg8::cvt_pk_bf16(p[2], p[3]); pb.u[2] = pg8::cvt_pk_bf16(p[4], p[5]); pb.u[3] = pg8::cvt_pk_bf16(p[6], p[7]);
            union { bf16x8 v; u32x2 h2[2]; } vf[4];
            const unsigned va = vrd + vbuf + (unsigned)(h * 128);
            asm volatile("ds_read_b64_tr_b16 %0, %8\n\tds_read_b64_tr_b16 %1, %8 offset:%9\n\tds_read_b64_tr_b16 %2, %8 offset:32\n\tds_read_b64_tr_b16 %3, %8 offset:%10\n\t"
                         "ds_read_b64_tr_b16 %4, %8 offset:64\n\tds_read_b64_tr_b16 %5, %8 offset:%11\n\tds_read_b64_tr_b16 %6, %8 offset:96\n\tds_read_b64_tr_b16 %7, %8 offset:%12\n\ts_waitcnt lgkmcnt(0)"
                         : "=&v"(vf[0].h2[0]), "=&v"(vf[0].h2[1]), "=&v"(vf[1].h2[0]), "=&v"(vf[1].h2[1]), "=&v"(vf[2].h2[0]), "=&v"(vf[2].h2[1]), "=&v"(vf[3].h2[0]), "=&v"(vf[3].h2[1])
                         : "v"(va), "i"(16 * VS * 2), "i"(16 * VS * 2 + 32), "i"(16 * VS * 2 + 64), "i"(16 * VS * 2 + 96) : "memory");
            __builtin_amdgcn_sched_barrier(0);
            if (resc) {
#pragma unroll
                for (int dt = 0; dt < 4; ++dt) oacc[h][dt] = oacc[h][dt] * corr; }
#pragma unroll
            for (int dt = 0; dt < 4; ++dt) oacc[h][dt] = __builtin_amdgcn_mfma_f32_16x16x32_bf16(vf[dt].v, pb.v, oacc[h][dt], 0, 0, 0);
            }
        }
    }
    __syncthreads();
    }
#undef KQ_
#undef KI_
#undef K_DMA
    const size_t m = (size_t)bb * T + tqmin + (lane & 15);
    if (pm < 300)
#pragma unroll
    for (int h = 0; h < 4; ++h) { float l = lrun[h]; l += __shfl_xor(l, 16); l += __shfl_xor(l, 32); const float inv = 1.f / l;
#pragma unroll
        for (int dt = 0; dt < 4; ++dt) { u32x2 w; w.x = pk2(oacc[h][dt][0] * inv, oacc[h][dt][1] * inv); w.y = pk2(oacc[h][dt][2] * inv, oacc[h][dt][3] * inv);
            *(u32x2*)(OB + m * 1024 + 256 + h * 64 + dt * 16 + 4 * g) = w; } }
    __syncthreads();
}
}

namespace awin {
typedef short bf16x8 __attribute__((ext_vector_type(8)));
typedef float f4 __attribute__((ext_vector_type(4)));
constexpr int EXS = 66;
constexpr int O_EX = 0;
constexpr int VSW = 72;
constexpr int O_VW = 101376;
__device__ __forceinline__ void item(LAS unsigned char* lds0, const int bb, const int blk, const int h, const bf16* P, bf16* OB, const int tid0) {
    unsigned lb_ = 0u; int tid_l = tid0; asm volatile("" : "+v"(lb_), "+v"(tid_l));
    LAS unsigned char* lds = lds0 + lb_; const int tid = tid_l, lane = tid & 63, wave = __builtin_amdgcn_readfirstlane(tid >> 6);
    const bf16* Pb = P + (size_t)bb * T * PP; const int start = blk * 128, g = lane >> 4, ln = lane & 15;
    LAS float* EX = (LAS float*)(lds + O_EX);
    LAS bf16* VW = (LAS bf16*)(lds + O_VW + wave * 4608);
#pragma unroll 1
    for (int s4 = 0; s4 < 4; ++s4) {
        const int st = wave * 4 + s4;
        const int grp = st < 8 ? 0 : (st < 16 ? 1 : 2);
        const int dil = grp == 0 ? 1 : (grp == 1 ? 4 : 16), win = grp == 0 ? 128 : (grp == 1 ? 512 : 2048);
        const int r = grp == 0 ? 0 : (grp == 1 ? ((st - 8) >> 1) : (st - 16)), a0 = grp == 0 ? 16 * st : (grp == 1 ? ((st - 8) & 1) * 16 : 0), nqc = grp == 0 ? 128 : (grp == 1 ? 32 : 8);
        const int a = a0 + ln; const bool qok = a < nqc; const int ql = (qok ? a : (nqc - 1)) * dil + r, tq = start + ql;
        const bf16* qp = Pb + (size_t)tq * PP + C_AQ + grp * 256 + h * 64 + g * 8;
        const bf16x8 q0 = *(const bf16x8*)qp, q1 = *(const bf16x8*)(qp + 32);
        bf16x8 kf[10][2];
#pragma unroll
        for (int kt = 0; kt < 10; ++kt) { int pos = start - win + (a0 + 16 * kt + ln) * dil + r; pos = pos < 0 ? 0 : (pos > T - 1 ? T - 1 : pos);
            const bf16* kp = Pb + (size_t)pos * PP + C_AK + grp * 256 + h * 64 + g * 8; kf[kt][0] = *(const bf16x8*)kp; kf[kt][1] = *(const bf16x8*)(kp + 32); }
        f4 sc[10]; float mx = -INFINITY;
#pragma unroll
        for (int kt = 0; kt < 10; ++kt) { f4 t = (f4){0.f, 0.f, 0.f, 0.f};
            t = __builtin_amdgcn_mfma_f32_16x16x32_bf16(kf[kt][0], q0, t, 0, 0, 0); t = __builtin_amdgcn_mfma_f32_16x16x32_bf16(kf[kt][1], q1, t, 0, 0, 0);
#pragma unroll
            for (int e = 0; e < 4; ++e) { const int c = a0 + 16 * kt + 4 * g + e; const int pos = start - win + c * dil + r;
                const bool ok = qok && c >= a && c <= a + 128 && pos >= 0;
                sc[kt][e] = ok ? t[e] * 0.125f : -INFINITY; mx = fmaxf(mx, sc[kt][e]); } }
        mx = fmaxf(mx, __shfl_xor(mx, 16)); mx = fmaxf(mx, __shfl_xor(mx, 32));
        const float msafe = (mx == -INFINITY) ? 0.f : mx; float lsum = 0.f;
#pragma unroll
        for (int kt = 0; kt < 10; ++kt)
#pragma unroll
            for (int e = 0; e < 4; ++e) { sc[kt][e] = __expf(sc[kt][e] - msafe); lsum += sc[kt][e]; }
        lsum += __shfl_xor(lsum, 16); lsum += __shfl_xor(lsum, 32);
        f4 oacc[4];
#pragma unroll
        for (int dt = 0; dt < 4; ++dt) oacc[dt] = (f4){0.f, 0.f, 0.f, 0.f};
#pragma unroll
        for (int s5 = 0; s5 < 5; ++s5) {
            int pos = start - win + (a0 + 32 * s5 + (lane >> 1)) * dil + r; pos = pos < 0 ? 0 : (pos > T - 1 ? T - 1 : pos);
            const u32x4* vp = (const u32x4*)(Pb + (size_t)pos * PP + C_AV + grp * 256 + h * 64 + (lane & 1) * 32);
            const u32x4 v0 = vp[0], v1 = vp[1], v2 = vp[2], v3 = vp[3];
            LAS u32x4* vd = (LAS u32x4*)(VW + (lane >> 1) * VSW + (lane & 1) * 32);
            asm volatile("s_waitcnt lgkmcnt(0)" ::: "memory");
            vd[0] = v0; vd[1] = v1; vd[2] = v2; vd[3] = v3;
            asm volatile("s_waitcnt lgkmcnt(0)" ::: "memory");
            bf16x8 pb;
#pragma unroll
            for (int e = 0; e < 4; ++e) { pb[e] = (short)f2bf(sc[2 * s5][e]); pb[4 + e] = (short)f2bf(sc[2 * s5 + 1][e]); }
#pragma unroll
            for (int dt = 0; dt < 4; ++dt) { bf16x8 vf; const LAS bf16* vb = VW + (4 * g) * VSW + dt * 16 + ln;
#pragma unroll
                for (int e = 0; e < 4; ++e) { vf[e] = (short)vb[e * VSW]; vf[4 + e] = (short)vb[(16 + e) * VSW]; }
                oacc[dt] = __builtin_amdgcn_mfma_f32_16x16x32_bf16(vf, pb, oacc[dt], 0, 0, 0); }
        }
        if (qok) { LAS float* ex = EX + (grp * 128 + ql) * EXS;
#pragma unroll
            for (int dt = 0; dt < 4; ++dt) { ex[dt * 16 + 4 * g + 0] = oacc[dt][0]; ex[dt * 16 + 4 * g + 1] = oacc[dt][1]; ex[dt * 16 + 4 * g + 2] = oacc[dt][2]; ex[dt * 16 + 4 * g + 3] = oacc[dt][3]; }
            if (g == 0) { ex[64] = mx; ex[65] = lsum; } }
    }
    __syncthreads();
    { const int ql = tid >> 2, d0 = (tid & 3) * 16;
      const LAS float* e0 = EX + (0 * 128 + ql) * EXS; const LAS float* e1 = EX + (1 * 128 + ql) * EXS; const LAS float* e2 = EX + (2 * 128 + ql) * EXS;
      const float m0 = e0[64], m1 = e1[64], m2 = e2[64], M = fmaxf(m0, fmaxf(m1, m2));
      const float w0 = __expf(m0 - M), w1 = __expf(m1 - M), w2 = __expf(m2 - M); const float inv = 1.f / (w0 * e0[65] + w1 * e1[65] + w2 * e2[65]);
      unsigned pk[8];
#pragma unroll
      for (int j = 0; j < 8; ++j) { const float x0 = (w0 * e0[d0 + 2 * j] + w1 * e1[d0 + 2 * j] + w2 * e2[d0 + 2 * j]) * inv, x1 = (w0 * e0[d0 + 2 * j + 1] + w1 * e1[d0 + 2 * j + 1] + w2 * e2[d0 + 2 * j + 1]) * inv; pk[j] = pk2(x0, x1); }
      u32x4* op = (u32x4*)(OB + ((size_t)bb * T + start + ql) * 1024 + h * 64 + d0);
      op[0] = (u32x4){pk[0], pk[1], pk[2], pk[3]}; op[1] = (u32x4){pk[4], pk[5], pk[6], pk[7]}; }
    __syncthreads();
}
}

template <int SP>
__device__ __forceinline__ void phase_body(const int l_in, LAS unsigned char* lds) {
    int tid_ = threadIdx.x, bid_ = blockIdx.x, l_ = l_in, G_ = gridDim.x; asm volatile("" : "+v"(tid_), "+s"(bid_), "+s"(l_), "+s"(G_));
    const int tid = tid_, lane = tid & 63, wave = __builtin_amdgcn_readfirstlane(tid >> 6), l = l_;
    const int G = G_, bid = bid_;
    const int gw = bid * NWAVES + wave, NGW = G * NWAVES;
    unsigned char* ws = (unsigned char*)gptr(ldptr(lds, 36));
    int* ctl = (int*)(ws + WS_CTL);
    bf16* XB = (bf16*)(ws + WS_XB); bf16* OB = (bf16*)(ws + WS_O); bf16* VF = (bf16*)(ws + WS_VF); bf16* P = (bf16*)(ws + WS_P);
    bf16* GS = (bf16*)(ws + WS_GS); bf16* MG = (bf16*)(ws + WS_MERGED); bf16* XS = (bf16*)(ws + WS_XS); bf16* HB = (bf16*)(ws + WS_H);
    bf16* WGU = (bf16*)(ws + WS_WGU); bf16* WD = (bf16*)(ws + WS_WD);
    float* X = (float*)gptr(ldptr(lds, 35));
    int* tok_e = (int*)(ws + WS_ROUTE); float* tok_g = (float*)(ws + WS_ROUTE + 256 * 1024); int* tok_rank = (int*)(ws + WS_ROUTE + 512 * 1024); int* tok_slot = (int*)(ws + WS_ROUTE + 768 * 1024);
    (void)ctl; (void)XB; (void)OB; (void)VF; (void)P; (void)GS; (void)MG; (void)XS; (void)HB; (void)WGU; (void)WD; (void)X; (void)tok_e; (void)tok_g; (void)tok_rank; (void)tok_slot; (void)gw; (void)NGW; (void)lane;
    {
        bf16* WinT = (bf16*)(ws + WS_WINT) + (size_t)l * 5120 * 1024; bf16* WgT = (bf16*)(ws + WS_WGT) + (size_t)l * 4096 * 1024;
        bf16* WbrT = (bf16*)(ws + WS_WBRT) + (size_t)l * 1024 * 1024; bf16* WoutT = (bf16*)(ws + WS_WOUTT) + (size_t)l * 1024 * 1024;
        float* WrT = (float*)(ws + WS_WRT) + (size_t)l * 36 * 1024;
        int* cnt = ctl + CW_CNT + l * 64;

        if constexpr (SP == -1) {
            LAS float* scr = (LAS float*)(lds + wave * 16384);
#pragma unroll 1
            for (int job = 0; job < NL * 11; ++job) {
                const int ll = job / 11, jk = job % 11;
                if (jk < 5) {
                    const float* W = INP(I_WIN) + (size_t)ll * 1024 * INW;
                    const int sc0 = jk == 0 ? 0 : (jk == 1 ? 3396 : (jk == 2 ? 3392 : (jk == 3 ? 5060 : 5064)));
                    const int snc = jk == 0 ? 3392 : (jk == 1 ? 1664 : (jk == 4 ? 4096 : 4));
                    const int sr0 = jk == 0 ? 0 : (jk == 1 ? 3392 : (jk == 2 ? 5056 : (jk == 3 ? 5060 : 0)));
                    bf16* dst = jk == 4 ? (bf16*)(ws + WS_WGT) + (size_t)ll * 4096 * 1024 : (bf16*)(ws + WS_WINT) + (size_t)ll * 5120 * 1024;
                    const int nbn = (snc + 31) / 32, nit = 16 * nbn;
#pragma unroll 1
                    for (int it = gw; it < nit; it += NGW) transpose_item(W, INW, sc0, snc, dst, 1024, sr0, 0, it / nbn, it % nbn, scr, lane);
                } else if (jk < 9) {
                    const int n = jk - 5; const float* Wb = INP(I_WBR) + ((size_t)ll * 4 + n) * 256 * 1024;
#pragma unroll 1
                    for (int it = gw; it < 4 * 32; it += NGW) transpose_item(Wb, 1024, 0, 1024, (bf16*)(ws + WS_WBRT) + (size_t)ll * 1024 * 1024, 1024, 0, n * 256, it / 32, it % 32, scr, lane);
                } else if (jk == 9) {
                    const float* Wo = INP(I_WOUT) + (size_t)ll * 1024 * 1024;
#pragma unroll 1
                    for (int it = gw; it < 16 * 32; it += NGW) transpose_item(Wo, 1024, 0, 1024, (bf16*)(ws + WS_WOUTT) + (size_t)ll * 1024 * 1024, 1024, 0, 0, it / 32, it % 32, scr, lane);
                } else {
                    bf16* wi = (bf16*)(ws + WS_WINT) + (size_t)ll * 5120 * 1024;
#pragma unroll 1
                    for (int i = gw * 64 + lane; i < 56 * 1024 / 8; i += NGW * 64) ((u32x4*)(wi + (size_t)5064 * 1024))[i] = (u32x4){0u, 0u, 0u, 0u};
                    float* wr = (float*)(ws + WS_WRT) + (size_t)ll * 36 * 1024; const float* rg = INP(I_RG) + (size_t)ll * 1024 * 4; const float* re = INP(I_RE) + (size_t)ll * 1024 * 32;
#pragma unroll 1
                    for (int i = gw * 64 + lane; i < 36 * 1024; i += NGW * 64) { const int o = i / 1024, k = i % 1024; wr[i] = o < 4 ? rg[k * 4 + o] : re[k * 32 + (o - 4)]; }
                }
            }
            for (int m = gw; m < M; m += NGW) {
                const f32x4* xr = (const f32x4*)(INP(I_X) + (size_t)m * D) + lane;
#pragma unroll
                for (int j = 0; j < 4; ++j) { const f32x4 v = xr[64 * j]; ((f32x4*)(X + (size_t)m * D))[lane + 64 * j] = v;
                    u32x2 w; w.x = pk2(v[0], v[1]); w.y = pk2(v[2], v[3]); ((u32x2*)(XB + (size_t)m * D))[lane + 64 * j] = w; }
            }
        }
        else if constexpr (SP == 0) {
            pg8::Gemm g{XB, WinT, 1024, 1024, 1024}; pg8::StaticOrder S; S.init(M, PP, G, bid, 1024, 1024);
            EpiStoreBf16 E{P, PP, 0, PP};
            pg8::gemm_phase<EpiStoreBf16, pg8::StaticOrder>(lds, g, S, E);
        }
        else if constexpr (SP == 12) {
            if (bid < 32) rw::carry(lds, ws + WS_RW + (size_t)bid * 64 * 16384, tid);
        }
        else if constexpr (SP == 13) {
            unsigned char* GZ = ws + WS_RW;
            const int h = bid & 3, k = bid >> 2;
            rw::build_ct(lds, l, h, lane, wave); __syncthreads();
#pragma unroll 1
            for (int idx = k; idx < 512; idx += (G >> 2)) { const int b = idx >> 6, cI = idx & 63; const size_t ci_ = (size_t)((b * 4 + h) * 64 + cI);
                rw::chunk_out(lds, b, h, cI * 64, GZ + ci_ * 16384, ws + WS_RW2 + ci_ * 24576, (const float*)(ws + WS_BONG) + ci_ * 64, VF, OB, tid); }
        }
        else if constexpr (SP == 15 || SP == 19) {
            unsigned char* GZ = ws + WS_RW;
            int* qctr = ctl + CW_Q + l * 64 + (SP == 19 ? 16 : 0);
            int cur_h = -1;
#pragma unroll 1
            for (;;) {
                unsigned so = (unsigned)(LDS_BYTES - 584); asm volatile("" : "+v"(so));
                volatile LAS int* slot = (volatile LAS int*)(lds + so);
                int tid = threadIdx.x; asm volatile("" : "+v"(tid));
                const int lane = tid & 63, wave = __builtin_amdgcn_readfirstlane(tid >> 6);
                __syncthreads();
                if (tid == 0) *slot = atomicAdd(qctr, 1);
                __syncthreads();
                const int it = __builtin_amdgcn_readfirstlane(*slot);
                if (it >= 3344) break;
                if (it < 16) { mb::chain(lds, l, it >> 1, it & 1, P, OB, tid, lane, wave); }
                else if (it < 272) { const int j = it - 16; bsp::item(lds, j & 7, 31 - (j >> 3), P, OB, tid, (int)(unsigned)ldptr(lds, 37)); }
                else if (it < 2320) { const int j = it - 272, h = j >> 9, idx = j & 511, b = idx >> 6, cI = idx & 63;
                    if (h != cur_h) { rw::build_ct(lds, l, h, lane, wave); cur_h = h; __syncthreads(); }
                    { const size_t ci_ = (size_t)((b * 4 + h) * 64 + cI); rw::chunk<(SP == 19 ? 5 : 1)>(lds, l, b, h, cI * 64, GZ + ci_ * 16384, ws + WS_RW2 + ci_ * 24576, (float*)(ws + WS_BONG) + ci_ * 64, P, VF, OB, tid); } }
                else { const int j = it - 2320; awin::item(lds, j >> 7, (j >> 2) & 31, j & 3, P, OB, tid); }
            }
        }
        else if constexpr (SP == 17 || SP == 18) {
            unsigned char* GZ = ws + WS_RW; int cur_h = -1;
#pragma unroll 1
            for (int k = 0; k < 8; ++k) { const int j = bid + 256 * k, h = j >> 9, idx = j & 511, b = idx >> 6, cI = idx & 63;
                if (h != cur_h) { rw::build_ct(lds, l, h, lane, wave); cur_h = h; __syncthreads(); }
                const size_t ci_ = (size_t)((b * 4 + h) * 64 + cI); rw::chunk<(SP == 17 ? 5 : 6)>(lds, l, b, h, cI * 64, GZ + ci_ * 16384, ws + WS_RW2 + ci_ * 24576, (float*)(ws + WS_BONG) + ci_ * 64, P, VF, OB, tid); }
        }
        else if constexpr (SP == 16) {
            bsp::item(lds, bid & 7, 31 - (bid >> 3), P, OB, tid, (int)(unsigned)ldptr(lds, 37) == 125 ? 300 : ((int)(unsigned)ldptr(lds, 37) == 126 ? 305 : (int)(unsigned)ldptr(lds, 37) + 80));
        }
        else if constexpr (SP == 4) {
            if (bid < 32) { rw::carry(lds, ws + WS_RW + (size_t)bid * 64 * 16384, tid); __syncthreads(); }
            pg8::Gemm g{XB, WgT, 1024, 1024, 1024}; SkewOrder S{M / 256, 16, (M / 256) * 16, bid, 1024, 1024};
            EpiStoreBf16 E{GS, 4096, 1, 4096};
            pg8::gemm_phase<EpiStoreBf16, SkewOrder>(lds, g, S, E);
        }
        else if constexpr (SP == 5) {
            pg8::Gemm g{OB, WbrT, 1024, 1024, 256}; BranchOrder S{M / 256, 4, G, bid};
            EpiBranch E{GS, MG};
            pg8::gemm_phase<EpiBranch, BranchOrder>(lds, g, S, E);
        }
        else if constexpr (SP == 6) {
            pg8::Gemm g{MG, WoutT, 1024, 1024, 1024}; pg8::StaticOrder S; S.init(M, 1024, G, bid, 1024, 1024);
            EpiResid E{X};
            pg8::gemm_phase<EpiResid, pg8::StaticOrder>(lds, g, S, E);
        }
        else if constexpr (SP == 7) {
            const float* g1 = INP(I_LN1G) + l * 1024; const float* b1 = INP(I_LN1B) + l * 1024;
            const float* rgb = INP(I_RGB) + l * 4; const float* reb = INP(I_REB) + l * 32;
            f32x4 vn[4];
#pragma unroll
            for (int j = 0; j < 4; ++j) vn[j] = ((const f32x4*)(X + (size_t)gw * D))[lane + 64 * j];
#pragma unroll 1
            for (int m = gw; m < M; m += NGW) {
                f32x4 v[4]; float s = 0.f; f32x4* xr = (f32x4*)(X + (size_t)m * D) + lane;
#pragma unroll
                for (int j = 0; j < 4; ++j) { v[j] = vn[j]; s += (v[j][0] + v[j][1]) + (v[j][2] + v[j][3]); }
                { const int mnx = (m + NGW < M) ? m + NGW : m;
#pragma unroll
                  for (int j = 0; j < 4; ++j) vn[j] = ((const f32x4*)(X + (size_t)mnx * D))[lane + 64 * j]; }
                const float mean = wave_sum(s) * (1.f / D); float s2 = 0.f;
#pragma unroll
                for (int j = 0; j < 4; ++j) { v[j] = v[j] - mean; s2 += (v[j][0] * v[j][0] + v[j][1] * v[j][1]) + (v[j][2] * v[j][2] + v[j][3] * v[j][3]); }
                const float rstd = rsqrtf(wave_sum(s2) * (1.f / D) + LN_EPS);
#pragma unroll
                for (int j = 0; j < 4; ++j) { const f32x4 gg = ((const f32x4*)g1)[lane + 64 * j], bb = ((const f32x4*)b1)[lane + 64 * j]; v[j] = v[j] * rstd * gg + bb; xr[64 * j] = v[j];
                    u32x2 w; w.x = pk2(v[j][0], v[j][1]); w.y = pk2(v[j][2], v[j][3]); ((u32x2*)(XB + (size_t)m * D))[lane + 64 * j] = w; }
                float mylg = 0.f;
#pragma unroll 1
                for (int o4 = 0; o4 < 36; o4 += 4) { float a4[4];
#pragma unroll
                    for (int u = 0; u < 4; ++u) { float a = 0.f;
#pragma unroll
                        for (int j = 0; j < 4; ++j) { const f32x4 wv = ((const f32x4*)(WrT + (o4 + u) * 1024))[lane + 64 * j]; a += v[j][0] * wv[0] + v[j][1] * wv[1] + v[j][2] * wv[2] + v[j][3] * wv[3]; }
                        a4[u] = a; }
#pragma unroll
                    for (int sft = 1; sft < 64; sft <<= 1) {
#pragma unroll
                        for (int u = 0; u < 4; ++u) a4[u] += __shfl_xor(a4[u], sft); }
#pragma unroll
                    for (int u = 0; u < 4; ++u) mylg = (lane == o4 + u) ? a4[u] : mylg; }
                mylg += lane < 4 ? rgb[lane & 3] : (lane < 36 ? reb[(lane - 4) & 31] : 0.f);
                float gl[4]; float gm = -INFINITY; int gs = 0;
#pragma unroll
                for (int o = 0; o < 4; ++o) { gl[o] = __shfl(mylg, o); if (gl[o] > gm) { gm = gl[o]; gs = o; } }
                float gden = 0.f;
#pragma unroll
                for (int o = 0; o < 4; ++o) gden += __expf(gl[o] - gm);
                const float pg = 1.f / gden;
                float el[8];
#pragma unroll
                for (int o = 0; o < 8; ++o) el[o] = __shfl(mylg, 4 + gs * 8 + o);
                int e1 = 0; float m1 = el[0];
#pragma unroll
                for (int o = 1; o < 8; ++o) if (el[o] > m1) { m1 = el[o]; e1 = o; }
                int e2 = -1; float m2 = -INFINITY;
#pragma unroll
                for (int o = 0; o < 8; ++o) if (o != e1 && el[o] > m2) { m2 = el[o]; e2 = o; }
                const float r2 = __expf(m2 - m1); const float ga = pg / (1.f + r2), gb = pg * r2 / (1.f + r2);
                if (lane == 0) {
                    const int E1 = gs * 8 + e1, E2 = gs * 8 + e2;
                    tok_e[m * 2] = E1; tok_e[m * 2 + 1] = E2; tok_g[m * 2] = ga; tok_g[m * 2 + 1] = gb;
                    tok_rank[m * 2] = atomicAdd(&cnt[E1], 1); tok_rank[m * 2 + 1] = atomicAdd(&cnt[E2], 1);
                }
            }
        }
        else if constexpr (SP == 14) {
            LAS float* scr = (LAS float*)(lds + wave * 16384);
            const float* eg = INP(I_EG) + (size_t)l * NEXP * 1024 * 512; const float* eu = INP(I_EU) + (size_t)l * NEXP * 1024 * 512; const float* ed = INP(I_ED) + (size_t)l * NEXP * 512 * 1024;
            for (int it = gw; it < NEXP * 2 * 4 * 64; it += NGW) {
                const int e = it / 512, r = it % 512, half = r / 256, ct = (r % 256) / 64, q = r % 64, kb = q / 4, nb = q % 4;
                const float* W = (half ? eu : eg) + (size_t)e * 1024 * 512;
                transpose_item(W, 512, ct * 128, 128, WGU + (size_t)e * 1024 * 1024, 1024, ct * 256 + half * 128, 0, kb, nb, scr, lane);
            }
            for (int it = gw; it < NEXP * 8 * 32; it += NGW) {
                const int e = it / 256, q = it % 256, kb = q / 32, nb = q % 32;
                transpose_item(ed + (size_t)e * 512 * 1024, 1024, 0, 1024, WD + (size_t)e * 1024 * 512, 512, 0, 0, kb, nb, scr, lane);
            }
        }
        else if constexpr (SP == 8 || SP == 9 || SP == 10) {
            unsigned tbo = MISC_OFF; asm volatile("" : "+v"(tbo));
            volatile LAS int* tb = (volatile LAS int*)(lds + tbo);
            if (tid == 0) { int acc = 0; for (int e = 0; e < 32; ++e) { const int c = __hip_atomic_load(&cnt[e], __ATOMIC_RELAXED, __HIP_MEMORY_SCOPE_AGENT); tb[e] = acc; tb[33 + e] = acc; acc += (c + 255) >> 8; } tb[32] = acc; }
            __syncthreads();
            if constexpr (SP == 8) {
                for (int m = gw; m < M; m += NGW) {
#pragma unroll
                    for (int k = 0; k < 2; ++k) { const int e = tok_e[m * 2 + k]; const int slot = tb[33 + e] * 256 + tok_rank[m * 2 + k];
                        const u32x4* src = (const u32x4*)(XB + (size_t)m * D); u32x4* dst = (u32x4*)(XS + (size_t)slot * D);
                        dst[lane] = src[lane]; dst[lane + 64] = src[lane + 64];
                        if (lane == 0) tok_slot[m * 2 + k] = slot; }
                }
            } else if constexpr (SP == 9) {
                pg8::Gemm g{XS, WGU, 1024, 1024, 1024}; MoeOrder S{tb, G, bid, (size_t)1024 * 2, (size_t)1024 * 1024 * 2, (size_t)256 * 1024 * 2};
                EpiSwiglu E{HB};
                pg8::gemm_phase<EpiSwiglu, MoeOrder>(lds, g, S, E);
            } else {
                pg8::Gemm g{HB, WD, 512, 512, 512}; MoeOrder S{tb, G, bid, (size_t)512 * 2, (size_t)1024 * 512 * 2, (size_t)256 * 512 * 2};
                EpiStoreBf16 E{XS, 1024, 0, 1024};
                pg8::gemm_phase<EpiStoreBf16, MoeOrder>(lds, g, S, E);
            }
        }
        else if constexpr (SP == 11) {
            const float* g2 = INP(I_LN2G) + l * 1024; const float* b2 = INP(I_LN2B) + l * 1024;
            f32x4 xn[4]; u32x2 y1n[4], y2n[4]; float gan, gbn;
#define LN2_LOAD(mm) do { const int s1_ = tok_slot[(mm) * 2], s2_ = tok_slot[(mm) * 2 + 1]; gan = tok_g[(mm) * 2]; gbn = tok_g[(mm) * 2 + 1]; \
                _Pragma("unroll") for (int j = 0; j < 4; ++j) { xn[j] = ((const f32x4*)(X + (size_t)(mm) * D))[lane + 64 * j]; y1n[j] = ((const u32x2*)(XS + (size_t)s1_ * D))[lane + 64 * j]; y2n[j] = ((const u32x2*)(XS + (size_t)s2_ * D))[lane + 64 * j]; } } while (0)
            LN2_LOAD(gw);
#pragma unroll 1
            for (int m = gw; m < M; m += NGW) {
                const float ga = gan, gb = gbn;
                f32x4 v[4]; float s = 0.f; f32x4* xr = (f32x4*)(X + (size_t)m * D) + lane;
                u32x2 y1c[4], y2c[4];
#pragma unroll
                for (int j = 0; j < 4; ++j) { v[j] = xn[j] * ALPHA; y1c[j] = y1n[j]; y2c[j] = y2n[j]; }
                { const int mnx = (m + NGW < M) ? m + NGW : m; LN2_LOAD(mnx); }
#pragma unroll
                for (int j = 0; j < 4; ++j) { const u32x2 y1 = y1c[j], y2 = y2c[j];
                    v[j][0] += ga * __uint_as_float(y1.x << 16) + gb * __uint_as_float(y2.x << 16); v[j][1] += ga * __uint_as_float(y1.x & 0xffff0000u) + gb * __uint_as_float(y2.x & 0xffff0000u);
                    v[j][2] += ga * __uint_as_float(y1.y << 16) + gb * __uint_as_float(y2.y << 16); v[j][3] += ga * __uint_as_float(y1.y & 0xffff0000u) + gb * __uint_as_float(y2.y & 0xffff0000u);
                    s += (v[j][0] + v[j][1]) + (v[j][2] + v[j][3]); }
                const float mean = wave_sum(s) * (1.f / D); float s2 = 0.f;
#pragma unroll
                for (int j = 0; j < 4; ++j) { v[j] = v[j] - mean; s2 += (v[j][0] * v[j][0] + v[j][1] * v[j][1]) + (v[j][2] * v[j][2] + v[j][3] * v[j][3]); }
                const float rstd = rsqrtf(wave_sum(s2) * (1.f / D) + LN_EPS);
#pragma unroll
                for (int j = 0; j < 4; ++j) { const f32x4 gg = ((const f32x4*)g2)[lane + 64 * j], bb = ((const f32x4*)b2)[lane + 64 * j]; v[j] = v[j] * rstd * gg + bb; xr[64 * j] = v[j];
                    u32x2 w; w.x = pk2(v[j][0], v[j][1]); w.y = pk2(v[j][2], v[j][3]); ((u32x2*)(XB + (size_t)m * D))[lane + 64 * j] = w; }
            }
        }
    }
}

template <int SP>
__global__ void __launch_bounds__(NTHR, 2) k_phase(Args args, int l) {
    extern __shared__ __attribute__((aligned(16))) unsigned char lds_raw[];
    ptr_table_fill(args, (LAS unsigned char*)lds_raw);
    phase_body<SP>(l, (LAS unsigned char*)lds_raw);
}


#define XB_TMO      128
#define XB_XCNT(j)  (256  + 64 * (j))
#define XB_XSUB(j)  (1280 + 64 * (j))
#define XB_XGEN(j)  (2304 + 64 * (j))
#define XB_TOP      3328
#define XB_TOPGEN   3392
#define XCD_BAR_WORDS 3456
#define XB_SPIN_CAP (1u << 22)
__device__ __forceinline__ unsigned xb_ld(unsigned* p)              { return __hip_atomic_load(p, __ATOMIC_RELAXED, __HIP_MEMORY_SCOPE_AGENT); }
__device__ __forceinline__ unsigned xb_add(unsigned* p, unsigned v) { return __hip_atomic_fetch_add(p, v, __ATOMIC_RELAXED, __HIP_MEMORY_SCOPE_AGENT); }
__device__ __forceinline__ unsigned xb_xcc_id() { return (unsigned)__builtin_amdgcn_s_getreg((3 << 11) | 20) & 0xFu; }
#define XB_SPIN(cond, bar) do { unsigned _sp = 0; while (cond) { __builtin_amdgcn_s_sleep(1); \
    if ((++_sp & 255u) == 0u) { if (xb_ld(&(bar)[XB_TMO])) break; if (_sp > XB_SPIN_CAP) { atomicAdd(&(bar)[XB_TMO], 1u); break; } } } } while (0)
__device__ __forceinline__ void xcd_barrier_complete(unsigned* bar, unsigned x, unsigned& nloc, unsigned& nx) {
    const unsigned G = gridDim.x;
    unsigned sum, cnt, mine, sp = 0u;
    for (;;) {
        sum = 0u; cnt = 0u; mine = 0u;
#pragma unroll
        for (unsigned j = 0; j < 16; ++j) { const unsigned c = xb_ld(&bar[XB_XCNT(j)]); sum += c; cnt += (c > 0u) ? 1u : 0u; mine = (j == x) ? c : mine; }
        if (sum == G) break;
        __builtin_amdgcn_s_sleep(1);
        if ((++sp & 255u) == 0u) { if (xb_ld(&bar[XB_TMO])) break; if (sp > XB_SPIN_CAP) { atomicAdd(&bar[XB_TMO], 1u); break; } }
    }
    nloc = mine > 0u ? mine : 1u; nx = cnt > 0u ? cnt : 1u;
}
__device__ __forceinline__ void xcd_barrier(unsigned* bar, LAS unsigned char* lds) {
    asm volatile("s_waitcnt vmcnt(0)" ::: "memory");
    __syncthreads();
    int tid_ = threadIdx.x; asm volatile("" : "+v"(tid_));
    if (tid_ == 0) {
        unsigned so = (unsigned)(LDS_BYTES - 576); asm volatile("" : "+v"(so));
        volatile LAS unsigned* st = (volatile LAS unsigned*)(lds + so);
        __builtin_amdgcn_s_waitcnt(0);
        const unsigned x = xb_xcc_id();
        unsigned nloc = st[0], nx = st[1];
        if (nloc == 0u) { xcd_barrier_complete(bar, x, nloc, nx); st[0] = nloc; st[1] = nx; }
        const unsigned old = xb_add(&bar[XB_XSUB(x)], 1u);
        const unsigned gen = old / nloc;
        if (old + 1u == (gen + 1u) * nloc) {
            __builtin_amdgcn_fence(__ATOMIC_RELEASE, "agent");
            asm volatile("s_waitcnt vmcnt(0)" ::: "memory");
            const unsigned og = xb_add(&bar[XB_TOP], 1u);
            const unsigned tg = og / nx;
            if (og + 1u == (tg + 1u) * nx) xb_add(&bar[XB_TOPGEN], 1u);
            else XB_SPIN(xb_ld(&bar[XB_TOPGEN]) == tg, bar);
            __builtin_amdgcn_fence(__ATOMIC_ACQUIRE, "agent");
            xb_add(&bar[XB_XGEN(x)], 1u);
            asm volatile("s_waitcnt vmcnt(0)" ::: "memory");
        } else {
            XB_SPIN(xb_ld(&bar[XB_XGEN(x)]) == gen, bar);
            __builtin_amdgcn_fence(__ATOMIC_ACQUIRE, "agent");
            asm volatile("s_waitcnt vmcnt(0)" ::: "memory");
        }
    }
    __syncthreads();
}
namespace cg = cooperative_groups;
__global__ void __launch_bounds__(NTHR, 2) fwd_all(Args args) {
    extern __shared__ __attribute__((aligned(16))) unsigned char lds_raw[];
    LAS unsigned char* lds = (LAS unsigned char*)lds_raw;
    unsigned* bar = (unsigned*)(args.ws + WS_CTL) + CW_BAR;
    if (threadIdx.x == 0) { ((volatile LAS unsigned*)(lds + LDS_BYTES - 576))[0] = 0u; ((volatile LAS unsigned*)(lds + LDS_BYTES - 576))[1] = 0u; (void)xb_add(&bar[XB_XCNT(xb_xcc_id())], 1u); }
    ptr_table_fill(args, lds);
    const int probe = args.ph_lo;
    { constexpr int l = 0;
#pragma unroll 1
      for (int r_ = 0; r_ < ((probe == -1) ? 2 : 1); ++r_) { phase_body<-1>(l, lds); __syncthreads(); } }
    cg::this_grid().sync();
#define GRID_BAR() do { unsigned* bar_ = (unsigned*)gptr(ldptr(lds, 36)) + CW_BAR; xcd_barrier(bar_, lds); } while (0)
#define RUN(SP) do { _Pragma("unroll 1") for (int r_ = 0; r_ < ((probe == (SP)) ? 2 : 1); ++r_) { phase_body<SP>(l, lds); __syncthreads(); } } while (0)
#define ONCE(SP) do { phase_body<SP>(l, lds); __syncthreads(); } while (0)
#define LAYER() \
        RUN(0); GRID_BAR(); \
        ONCE(15); GRID_BAR(); \
        if (probe == 132) { ONCE(19); GRID_BAR(); } \
        if (probe == 130) { ONCE(17); GRID_BAR(); } \
        if (probe == 131) { ONCE(18); GRID_BAR(); } \
        if (probe >= 120 && probe < 130) { ONCE(16); GRID_BAR(); } \
        ONCE(4); GRID_BAR(); \
        RUN(13); GRID_BAR(); \
        RUN(5); GRID_BAR(); \
        ONCE(6); GRID_BAR(); \
        ONCE(7); RUN(14); GRID_BAR(); \
        RUN(8); GRID_BAR(); \
        RUN(9); GRID_BAR(); \
        RUN(10); GRID_BAR(); \
        ONCE(11); GRID_BAR();
    { constexpr int l = 0; LAYER() }
    { constexpr int l = 1; LAYER() }
#undef LAYER
#undef RUN
#undef ONCE
#undef GRID_BAR
}

template <int SP> static void launch_phase(const Args& a, int l, int grid, hipStream_t stream) {
    static bool attr = false;
    if (!attr) { (void)hipFuncSetAttribute((const void*)k_phase<SP>, hipFuncAttributeMaxDynamicSharedMemorySize, LDS_BYTES); attr = true; }
    hipLaunchKernelGGL(k_phase<SP>, dim3(grid), dim3(NTHR), LDS_BYTES, stream, a, l);
}

extern "C" void kernel_launch(void* const* d_in, const int* in_sizes, int n_in, void* d_out, int out_size, void* d_ws, size_t ws_size, hipStream_t stream) {
    static int grid = 0;
    if (grid == 0) {
        if (n_in != 35 || out_size != M * D || ws_size < WS_END) { fprintf(stderr, "kernel_launch: unexpected problem (n_in %d out %d ws %zu)\n", n_in, out_size, ws_size); grid = -1; return; }
        int dev = 0, cus = 0, per_cu = 0;
        (void)hipGetDevice(&dev); (void)hipDeviceGetAttribute(&cus, hipDeviceAttributeMultiprocessorCount, dev);
#if N_LAUNCH_MODE == 1
        (void)hipFuncSetAttribute((const void*)fwd_all, hipFuncAttributeMaxDynamicSharedMemorySize, LDS_BYTES);
        if (hipOccupancyMaxActiveBlocksPerMultiprocessor(&per_cu, (const void*)fwd_all, NTHR, LDS_BYTES) != hipSuccess || per_cu < 1) { fprintf(stderr, "kernel_launch: occupancy query says %d blocks/CU\n", per_cu); grid = -1; return; }
#endif
        (void)per_cu;
        grid = cus;
        if (grid != 256) { fprintf(stderr, "kernel_launch: built for 256 CUs, found %d\n", cus); grid = -1; return; }
    }
    if (grid < 0) return;
    (void)hipMemsetAsync((char*)d_ws + WS_CTL, 0, CTL_BYTES, stream);
    Args a{};
    for (int i = 0; i < 35; ++i) a.in[i] = (const float*)d_in[i];
    a.out = (float*)d_out; a.ws = (unsigned char*)d_ws;
#if N_LAUNCH_MODE == 1
    a.ph_lo = PROBE_REPS;
    void* kargs[] = {(void*)&a};
    hipError_t e = hipLaunchCooperativeKernel((const void*)fwd_all, dim3(grid), dim3(NTHR), kargs, LDS_BYTES, stream);
    if (e != hipSuccess) fprintf(stderr, "cooperative launch failed: %s\n", hipGetErrorString(e));
#else
    launch_phase<-1>(a, 0, grid, stream);
    for (int l = 0; l < NL; ++l) {
        launch_phase<0>(a, l, grid, stream); launch_phase<15>(a, l, grid, stream); launch_phase<4>(a, l, grid, stream); launch_phase<13>(a, l, grid, stream);
        launch_phase<5>(a, l, grid, stream); launch_phase<6>(a, l, grid, stream); launch_phase<7>(a, l, grid, stream); launch_phase<14>(a, l, grid, stream);
        launch_phase<8>(a, l, grid, stream); launch_phase<9>(a, l, grid, stream); launch_phase<10>(a, l, grid, stream); launch_phase<11>(a, l, grid, stream);
    }
#endif
}
```

```cpp
#include <hip/hip_runtime.h>
#include <type_traits>
#include <cstdio>
#include <cstdint>
#include <hip/hip_cooperative_groups.h>

#ifndef PROBE_REPS
#define PROBE_REPS -100
#endif
#ifndef N_LAUNCH_MODE
#define N_LAUNCH_MODE 1
#endif

namespace pg8 {
#define PG8_LAS __attribute__((address_space(3)))
typedef unsigned short bf16_t;
typedef short bf16x8 __attribute__((ext_vector_type(8)));
typedef float f32x4 __attribute__((ext_vector_type(4)));
typedef unsigned u32x4 __attribute__((ext_vector_type(4)));
constexpr int BM = 256, BK = 64, HALF = 128, HTB = HALF * BK * 2, STAGE_BYTES = 8 * HTB, NXCD = 8, WGM = 8;

__host__ __device__ __forceinline__ int lds_byte(int r, int c) { const int st = (r >> 4) * 2 + (c >> 5), rr = r & 15, cc = c & 31, ob = rr * 64 + cc * 2; return st * 1024 + (ob ^ (((ob >> 9) & 1) << 5)); }
__host__ __device__ __forceinline__ void stage_rc(int b, int& R, int& C) { const int st = b / 1024, sb = b % 1024, swz = sb ^ (((sb >> 9) & 1) << 5); R = (st >> 1) * 16 + swz / 64; C = (st & 1) * 32 + (swz % 64) / 2; }
__host__ __device__ __forceinline__ int perm32(int rho) { const int n = rho >> 4, i = rho & 15; return 8 * (i >> 2) + 4 * n + (i & 3); }

struct Unit { int pm, pn, aux; size_t aoff, boff; };
struct Gemm { const bf16_t* A; const bf16_t* Bt; int lda, ldb, K; };

__device__ __forceinline__ void tile_of(int L, int nM, int nN, int& pm, int& pn) {
    const int nwg = nM * nN; int wgid = L;
    { const int q = nwg / NXCD, r = nwg % NXCD, xcd = wgid % NXCD, off = wgid / NXCD; wgid = (xcd < r ? xcd * (q + 1) : r * (q + 1) + (xcd - r) * q) + off; }
    const int nig = WGM * nN, gid = wgid / nig, fm = gid * WGM, gsz = (nM - fm) < WGM ? (nM - fm) : WGM;
    pm = fm + ((wgid % nig) % gsz); pn = (wgid % nig) / gsz;
}
struct StaticOrder {
    int nM, nN, nwg, G, c, lda, ldb;
    __device__ void init(int M, int N, int G_, int c_, int lda_, int ldb_) { nM = M / BM; nN = N / BM; nwg = nM * nN; G = G_; c = c_; lda = lda_; ldb = ldb_; }
    __device__ bool next(int i, Unit& u) const {
        const long L = (long)i * G + c; if (L >= nwg) return false;
        tile_of((int)L, nM, nN, u.pm, u.pn); u.aux = 0;
        u.aoff = (size_t)u.pm * BM * lda * 2; u.boff = (size_t)u.pn * BM * ldb * 2; return true;
    }
};

__device__ __forceinline__ unsigned cvt_pk_bf16(float lo, float hi) { typedef __bf16 b2_ __attribute__((ext_vector_type(2))); typedef float f2_ __attribute__((ext_vector_type(2))); return __builtin_bit_cast(unsigned, __builtin_convertvector((f2_){lo, hi}, b2_)); }
__device__ __forceinline__ void epi_mfma_settle(const f32x4 (&acc)[2][2][4][2]) {
    asm volatile("s_nop 11" :: "v"(acc[1][0][0][0]), "v"(acc[1][0][0][1]), "v"(acc[1][0][1][0]), "v"(acc[1][0][1][1]), "v"(acc[1][0][2][0]), "v"(acc[1][0][2][1]), "v"(acc[1][0][3][0]), "v"(acc[1][0][3][1]),
                                "v"(acc[1][1][0][0]), "v"(acc[1][1][0][1]), "v"(acc[1][1][1][0]), "v"(acc[1][1][1][1]), "v"(acc[1][1][2][0]), "v"(acc[1][1][2][1]), "v"(acc[1][1][3][0]), "v"(acc[1][1][3][1]) : "memory"); }

template <class Epi, class Sched, bool ALIGN_EPI = true, bool SP2 = true>
__device__ __forceinline__ void gemm_phase(PG8_LAS unsigned char* lds, const Gemm g, const Sched& S, const Epi& E) {
    int tid_ = threadIdx.x; asm volatile("" : "+v"(tid_));
    const int tid = tid_, wid = __builtin_amdgcn_readfirstlane(tid >> 6), lane = tid & 63, wr = wid >> 2, wc = wid & 3, fr = lane & 15, fq = lane >> 4;
    const int K = g.K, nt = K / BK;
    unsigned voffA[2], voffB[2];
#pragma unroll
    for (int i = 0; i < 2; ++i) { int R, C; stage_rc(tid * 16 + i * 8192, R, C); const int Rb = Epi::PERM ? ((R & ~31) + perm32(R & 31)) : R;
        voffA[i] = (unsigned)(R * g.lda + C) * 2u; voffB[i] = (unsigned)(Rb * g.ldb + C) * 2u; }
    const size_t kstep = (size_t)(BK * 2);
    const size_t hstepA = (size_t)HALF * g.lda * 2, hstepB = (size_t)HALF * g.ldb * 2;
    const unsigned ldsw = (unsigned)wid * 1024u;
    const int aoff = lds_byte(wr * 64 + fr, fq * 8), boff = lds_byte(wc * 32 + fr, fq * 8);
#define PG8_SA(b, h) (((b) * 2 + (h)) * HTB)
#define PG8_SB(b, h) ((4 + (b) * 2 + (h)) * HTB)
#define PG8_STAGE(bufoff, gbase, voff) do { _Pragma("unroll") for (int _i = 0; _i < 2; ++_i) \
        __builtin_amdgcn_global_load_lds((const unsigned*)((const char*)(gbase) + (voff)[_i]), (PG8_LAS unsigned*)(lds + (bufoff) + ldsw + _i * 8192), 16, 0, 0); } while (0)
#define PG8_LDA(dst, b, h) do { _Pragma("unroll") for (int m = 0; m < 4; ++m) _Pragma("unroll") for (int k = 0; k < 2; ++k) dst[m][k] = *(const PG8_LAS bf16x8*)(lds + PG8_SA(b, h) + aoff + m * 2048 + k * 1024); } while (0)
#define PG8_LDB(dst, b, h) do { _Pragma("unroll") for (int n = 0; n < 2; ++n) _Pragma("unroll") for (int k = 0; k < 2; ++k) dst[n][k] = *(const PG8_LAS bf16x8*)(lds + PG8_SB(b, h) + boff + n * 2048 + k * 1024); } while (0)
#define PG8_MMA(ai, bj, At, Bt) do { __builtin_amdgcn_s_setprio(1); _Pragma("unroll") for (int m = 0; m < 4; ++m) _Pragma("unroll") for (int n = 0; n < 2; ++n) _Pragma("unroll") for (int k = 0; k < 2; ++k) \
        acc[ai][bj][m][n] = __builtin_amdgcn_mfma_f32_16x16x32_bf16(Bt[n][k], At[m][k], acc[ai][bj][m][n], 0, 0, 0); __builtin_amdgcn_s_setprio(0); } while (0)
#define PG8_WAIT_V(n) asm volatile("s_waitcnt vmcnt(" #n ")" ::: "memory")
#define PG8_WAIT_L(n) asm volatile("s_waitcnt lgkmcnt(" #n ")" ::: "memory")
#define PG8_BAR __builtin_amdgcn_s_barrier()
#define PG8_SCHED __builtin_amdgcn_sched_barrier(0)
    Unit cur, nxt; int ui = 0;
    if (!S.next(0, cur)) return;
    f32x4 acc[2][2][4][2];
#pragma unroll
    for (int a = 0; a < 2; ++a)
#pragma unroll
        for (int b = 0; b < 2; ++b)
#pragma unroll
            for (int m = 0; m < 4; ++m)
#pragma unroll
                for (int n = 0; n < 2; ++n) acc[a][b][m][n] = (f32x4){0.f, 0.f, 0.f, 0.f};
    bf16x8 At[4][2], B0[2][2], B1[2][2];
    const char* cA = (const char*)g.A + cur.aoff; const char* cB = (const char*)g.Bt + cur.boff;
    if constexpr (SP2) {
        PG8_STAGE(PG8_SB(0, 0), cB, voffB); PG8_STAGE(PG8_SB(0, 1), cB + hstepB, voffB); PG8_STAGE(PG8_SA(0, 0), cA, voffA); PG8_STAGE(PG8_SA(0, 1), cA + hstepA, voffA);
        if (wr == 1) PG8_BAR;
        PG8_WAIT_V(2); PG8_BAR;
        PG8_STAGE(PG8_SB(1, 0), cB + kstep, voffB); PG8_STAGE(PG8_SA(1, 0), cA + kstep, voffA); PG8_STAGE(PG8_SB(1, 1), cB + hstepB + kstep, voffB);
        PG8_WAIT_V(6); PG8_BAR;
    } else {
        PG8_STAGE(PG8_SB(0, 0), cB, voffB); PG8_STAGE(PG8_SA(0, 0), cA, voffA); PG8_STAGE(PG8_SB(0, 1), cB + hstepB, voffB); PG8_STAGE(PG8_SA(0, 1), cA + hstepA, voffA);
        if (wr == 1) PG8_BAR;
        PG8_WAIT_V(4); PG8_BAR;
        PG8_STAGE(PG8_SB(1, 0), cB + kstep, voffB); PG8_STAGE(PG8_SA(1, 0), cA + kstep, voffA); PG8_STAGE(PG8_SB(1, 1), cB + hstepB + kstep, voffB);
        PG8_WAIT_V(6); PG8_BAR;
    }
    for (;;) {
        const bool has_next = S.next(ui + 1, nxt);
        const char* nA = has_next ? (const char*)g.A + nxt.aoff : cA; const char* nB = has_next ? (const char*)g.Bt + nxt.boff : cB;
#pragma unroll 1
        for (int t = 0; t < nt; t += 2) {
            const bool last = (t == nt - 2);
            const char* a1 = cA + (size_t)(t + 1) * kstep;
            const char* a2 = last ? nA : cA + (size_t)(t + 2) * kstep; const char* b2 = last ? nB : cB + (size_t)(t + 2) * kstep;
            const char* a3 = a2 + kstep; const char* b3 = b2 + kstep;
            if constexpr (SP2) {
            PG8_LDB(B0, 0, 0); PG8_LDB(B1, 0, 1); PG8_SCHED; PG8_LDA(At, 0, 0); PG8_STAGE(PG8_SA(1, 1), a1 + hstepA, voffA);
            PG8_WAIT_V(8); PG8_WAIT_L(0); PG8_BAR; PG8_MMA(0, 0, At, B0); PG8_MMA(0, 1, At, B1); PG8_BAR; PG8_SCHED;
            PG8_LDA(At, 0, 1); PG8_STAGE(PG8_SB(0, 0), b2, voffB); PG8_STAGE(PG8_SB(0, 1), b2 + hstepB, voffB); PG8_STAGE(PG8_SA(0, 0), a2, voffA);
            PG8_WAIT_V(8); PG8_WAIT_L(0); PG8_BAR; PG8_MMA(1, 0, At, B0); PG8_MMA(1, 1, At, B1); PG8_BAR; PG8_SCHED;
            PG8_LDB(B0, 1, 0); PG8_LDB(B1, 1, 1); PG8_SCHED; PG8_LDA(At, 1, 0); PG8_STAGE(PG8_SA(0, 1), a2 + hstepA, voffA);
            PG8_WAIT_V(8); PG8_WAIT_L(0); PG8_BAR; PG8_MMA(0, 0, At, B0); PG8_MMA(0, 1, At, B1); PG8_BAR; PG8_SCHED;
            PG8_LDA(At, 1, 1); PG8_STAGE(PG8_SB(1, 0), b3, voffB); PG8_STAGE(PG8_SB(1, 1), b3 + hstepB, voffB); PG8_STAGE(PG8_SA(1, 0), a3, voffA);
            PG8_WAIT_V(8); PG8_WAIT_L(0); PG8_BAR; PG8_MMA(1, 0, At, B0); PG8_MMA(1, 1, At, B1); PG8_BAR; PG8_SCHED;
            } else {
            PG8_LDB(B0, 0, 0); PG8_SCHED; PG8_LDA(At, 0, 0); PG8_STAGE(PG8_SA(1, 1), a1 + hstepA, voffA);
            PG8_WAIT_L(8); PG8_BAR; PG8_WAIT_L(0); PG8_MMA(0, 0, At, B0); PG8_BAR; PG8_SCHED;
            PG8_LDB(B1, 0, 1); PG8_STAGE(PG8_SB(0, 0), b2, voffB);
            PG8_BAR; PG8_WAIT_L(0); PG8_MMA(0, 1, At, B1); PG8_BAR;
            PG8_LDA(At, 0, 1); PG8_STAGE(PG8_SA(0, 0), a2, voffA);
            PG8_BAR; PG8_WAIT_L(0); PG8_MMA(1, 0, At, B0); PG8_BAR; PG8_SCHED;
            PG8_STAGE(PG8_SB(0, 1), b2 + hstepB, voffB);
            PG8_WAIT_V(6); PG8_BAR; PG8_MMA(1, 1, At, B1); PG8_BAR;
            PG8_LDB(B0, 1, 0); PG8_SCHED; PG8_LDA(At, 1, 0); PG8_STAGE(PG8_SA(0, 1), a2 + hstepA, voffA);
            PG8_WAIT_L(8); PG8_BAR; PG8_WAIT_L(0); PG8_MMA(0, 0, At, B0); PG8_BAR; PG8_SCHED;
            PG8_LDB(B1, 1, 1); PG8_STAGE(PG8_SB(1, 0), b3, voffB);
            PG8_BAR; PG8_WAIT_L(0); PG8_MMA(0, 1, At, B1); PG8_BAR;
            PG8_LDA(At, 1, 1); PG8_STAGE(PG8_SA(1, 0), a3, voffA);
            PG8_BAR; PG8_WAIT_L(0); PG8_MMA(1, 0, At, B0); PG8_BAR; PG8_SCHED;
            PG8_STAGE(PG8_SB(1, 1), b3 + hstepB, voffB);
            PG8_WAIT_V(6); PG8_BAR; PG8_MMA(1, 1, At, B1); PG8_BAR;
            }
        }
        if constexpr (ALIGN_EPI) { if (wr == 0) PG8_BAR; }
        E(acc, cur, wr, wc, fr, fq);
        if (!has_next) break;
#pragma unroll
        for (int a = 0; a < 2; ++a)
#pragma unroll
            for (int b = 0; b < 2; ++b)
#pragma unroll
                for (int m = 0; m < 4; ++m)
#pragma unroll
                    for (int n = 0; n < 2; ++n) acc[a][b][m][n] = (f32x4){0.f, 0.f, 0.f, 0.f};
        cur = nxt; cA = nA; cB = nB; ++ui;
        if constexpr (ALIGN_EPI) { if (wr == 1) PG8_BAR; }
    }
    PG8_WAIT_V(0);
    if constexpr (!ALIGN_EPI) { if (wr == 0) PG8_BAR; }
    PG8_BAR;
#undef PG8_SA
#undef PG8_SB
#undef PG8_STAGE
#undef PG8_LDA
#undef PG8_LDB
#undef PG8_MMA
#undef PG8_WAIT_V
#undef PG8_WAIT_L
#undef PG8_BAR
#undef PG8_SCHED
}
}

#define LAS __attribute__((address_space(3)))
typedef unsigned short bf16;
typedef float f32x4 __attribute__((ext_vector_type(4)));
typedef unsigned u32x4 __attribute__((ext_vector_type(4)));
typedef unsigned u32x2 __attribute__((ext_vector_type(2)));

constexpr int NB = 8, T = 4096, D = 1024, M = NB * T, NL = 2;
constexpr int INW = 9160;
constexpr int PP = 5120;
constexpr int C_AQ = 0, C_AK = 768, C_AV = 1536, C_BQ = 2304, C_BK = 2560, C_BV = 2816, C_IQ = 3072, C_IK = 3328, C_C = 3392, C_DZ = 4288, C_DX = 4544, C_IW = 5056, C_DT = 5060, C_END = 5064;
constexpr int NEXP = 32, DEXP = 512;
constexpr int CAP = 73728;
constexpr float LN_EPS = 1e-5f;
constexpr float ALPHA = 1.4142135623730951f;

constexpr size_t MiB = 1u << 20;
constexpr size_t WS_CTL = 0, CTL_BYTES = 1 * MiB;
constexpr size_t WS_WINT = 2 * MiB;
constexpr size_t WS_WGT = 22 * MiB;
constexpr size_t WS_WBRT = 38 * MiB;
constexpr size_t WS_WOUTT = 42 * MiB;
constexpr size_t WS_WRT = 46 * MiB;
constexpr size_t WS_ROUTE = 47 * MiB;
constexpr size_t WS_XB = 48 * MiB;
constexpr size_t WS_O = 112 * MiB;
constexpr size_t WS_VF = 176 * MiB;
constexpr size_t WS_P = 192 * MiB;
constexpr size_t WS_GS = 192 * MiB;
constexpr size_t WS_MERGED = 448 * MiB;
constexpr size_t WS_XS = 192 * MiB;
constexpr size_t WS_H = 336 * MiB;
constexpr size_t WS_WGU = 408 * MiB;
constexpr size_t WS_WD = 472 * MiB;
constexpr size_t WS_RW = 512 * MiB;
constexpr size_t WS_RW2 = 544 * MiB;
constexpr size_t WS_BONG = 46 * MiB + 512 * 1024;
constexpr size_t WS_END = 592 * MiB;
constexpr int CW_CNT = 64, CW_Q = 256, CW_BAR = 4096;

constexpr int RING_BYTES = 131072, MISC_OFF = RING_BYTES, LDS_BYTES = 147456;
constexpr int NWAVES = 8, NTHR = 512;

__device__ __forceinline__ float bf2f(bf16 v) { return __uint_as_float(((unsigned)v) << 16); }
__device__ __forceinline__ unsigned pk2(float lo, float hi) { return pg8::cvt_pk_bf16(lo, hi); }
__device__ __forceinline__ unsigned f2bf(float f) { unsigned u = __float_as_uint(f); return (u + 0x7fffu + ((u >> 16) & 1u)) >> 16; }
#define DPP_ADD(v, ctrl) v += __builtin_bit_cast(float, __builtin_amdgcn_update_dpp(0, __builtin_bit_cast(int, v), ctrl, 0xF, 0xF, true))
#define DPP_MAX(v, ctrl) v = fmaxf(v, __builtin_bit_cast(float, __builtin_amdgcn_update_dpp(0, __builtin_bit_cast(int, v), ctrl, 0xF, 0xF, true)))
__device__ __forceinline__ float wave_sum(float v) {
    DPP_ADD(v, 0xB1); DPP_ADD(v, 0x4E); DPP_ADD(v, 0x141); DPP_ADD(v, 0x140);
    v += __shfl_xor(v, 16); v += __shfl_xor(v, 32);
    return v;
}
__device__ __forceinline__ float wave_max(float v) {
    DPP_MAX(v, 0xB1); DPP_MAX(v, 0x4E); DPP_MAX(v, 0x141); DPP_MAX(v, 0x140);
    v = fmaxf(v, __shfl_xor(v, 16)); v = fmaxf(v, __shfl_xor(v, 32));
    return v;
}
__device__ __forceinline__ float sigmoid_div_(float x) { return 1.f / (1.f + __expf(-x)); }
__device__ __forceinline__ float sigmoidf_(float x) { return __builtin_amdgcn_rcpf(1.f + __expf(-x)); }
__device__ __forceinline__ float softplusf_(float x) { return x > 20.f ? x : __logf(1.f + __expf(x)); }
__device__ __forceinline__ float tanhf_(float x) { const float e = __expf(-2.f * fabsf(x)); const float t = (1.f - e) * __builtin_amdgcn_rcpf(1.f + e); return x < 0.f ? -t : t; }
__device__ __forceinline__ float siluf_(float x) { return x * __builtin_amdgcn_rcpf(1.f + __expf(-x)); }

struct Args { const float* in[35]; float* out; unsigned char* ws; int ph_lo, ph_hi; };
enum { I_X = 0, I_WIN, I_CMU, I_CW0, I_CW2, I_CA0, I_CA2, I_CG2, I_CKK, I_CKA, I_CRK, I_CGNW, I_CGNB, I_CV0, I_CV1, I_CV2, I_DCW, I_DCB, I_DDTB, I_DALOG, I_DSKIP, I_DNW,
       I_WBR, I_WOUT, I_LN1G, I_LN1B, I_RG, I_RGB, I_RE, I_REB, I_EG, I_EU, I_ED, I_LN2G, I_LN2B };

__device__ __forceinline__ void transpose_item(const float* W, int ldn, int c0, int ncols, bf16* dst, int dld, int r0, int dk0, int kb, int nb, LAS float* scr, int lane) {
    const int k0 = 64 * kb, n0 = 32 * nb;
    const bool okn = (n0 + (lane & 31)) < ncols;
    float tv[32];
#pragma unroll
    for (int i = 0; i < 32; ++i) { const int kk = 2 * i + (lane >> 5); tv[i] = okn ? W[(size_t)(k0 + kk) * ldn + c0 + n0 + (lane & 31)] : 0.f; }
#pragma unroll
    for (int i = 0; i < 32; ++i) { const int kk = 2 * i + (lane >> 5); scr[kk * 33 + (lane & 31)] = tv[i]; }
    asm volatile("s_waitcnt lgkmcnt(0)" ::: "memory");
    const int c = lane & 7;
#pragma unroll
    for (int j = 0; j < 4; ++j) { const int n = (lane >> 3) + 8 * j; const LAS float* s = scr + (8 * c) * 33 + n;
        u32x4 o; o.x = pk2(s[0 * 33], s[1 * 33]); o.y = pk2(s[2 * 33], s[3 * 33]); o.z = pk2(s[4 * 33], s[5 * 33]); o.w = pk2(s[6 * 33], s[7 * 33]);
        if (n0 + n < ncols) *(u32x4*)(dst + (size_t)(r0 + n0 + n) * dld + dk0 + k0 + 8 * c) = o; }
    asm volatile("s_waitcnt lgkmcnt(0)" ::: "memory");
}

struct EpiStoreBf16 {
    static constexpr bool PERM = true;
    bf16* O; int ldc; int act; int ncols;
    __device__ __forceinline__ void operator()(const pg8::f32x4 (&acc)[2][2][4][2], const pg8::Unit& u, int wr, int wc, int fr, int fq) const {
        pg8::epi_mfma_settle(acc);
        const int row0 = u.pm * 256 + wr * 64 + fr; const int col0 = u.pn * 256 + wc * 32 + 8 * fq;
#pragma unroll
        for (int ai = 0; ai < 2; ++ai)
#pragma unroll
            for (int m = 0; m < 4; ++m) { bf16* rowp = O + (size_t)(row0 + ai * 128 + m * 16) * ldc + col0;
#pragma unroll
                for (int bj = 0; bj < 2; ++bj) { pg8::f32x4 v0 = acc[ai][bj][m][0], v1 = acc[ai][bj][m][1];
                    if (act == 1) {
#pragma unroll
                        for (int j = 0; j < 4; ++j) { v0[j] = sigmoidf_(v0[j]); v1[j] = sigmoidf_(v1[j]); } }
                    u32x4 w; w.x = pg8::cvt_pk_bf16(v0[0], v0[1]); w.y = pg8::cvt_pk_bf16(v0[2], v0[3]); w.z = pg8::cvt_pk_bf16(v1[0], v1[1]); w.w = pg8::cvt_pk_bf16(v1[2], v1[3]);
                    if (col0 + bj * 128 < ncols) *(u32x4*)(rowp + bj * 128) = w; } }
    }
};
struct EpiBranch {
    static constexpr bool PERM = true;
    const bf16* GS; bf16* MG;
    __device__ __forceinline__ void operator()(const pg8::f32x4 (&acc)[2][2][4][2], const pg8::Unit& u, int wr, int wc, int fr, int fq) const {
        pg8::epi_mfma_settle(acc);
        const int n = u.aux;
        const bf16* gbase = GS + (size_t)(u.pm * 256 + wr * 64 + fr) * 4096 + n * 1024 + u.pn * 256 + wc * 32 + 8 * fq;
        bf16* mbase = MG + (size_t)(u.pm * 256 + wr * 64 + fr) * 1024 + u.pn * 256 + wc * 32 + 8 * fq;
#pragma unroll
        for (int ai = 0; ai < 2; ++ai)
#pragma unroll
            for (int m = 0; m < 4; ++m) {
#pragma unroll
                for (int bj = 0; bj < 2; ++bj) {
                    const u32x4 gv = *(const u32x4*)(gbase + (size_t)(ai * 128 + m * 16) * 4096 + bj * 128);
                    bf16* mp = mbase + (size_t)(ai * 128 + m * 16) * 1024 + bj * 128;
                    u32x4 ov = (u32x4){0u, 0u, 0u, 0u}; if (n != 0) ov = *(const u32x4*)mp;
                    const pg8::f32x4 a0 = acc[ai][bj][m][0], a1 = acc[ai][bj][m][1];
                    u32x4 w;
                    w.x = pg8::cvt_pk_bf16(a0[0] * __uint_as_float(gv.x << 16) + __uint_as_float(ov.x << 16), a0[1] * __uint_as_float(gv.x & 0xffff0000u) + __uint_as_float(ov.x & 0xffff0000u));
                    w.y = pg8::cvt_pk_bf16(a0[2] * __uint_as_float(gv.y << 16) + __uint_as_float(ov.y << 16), a0[3] * __uint_as_float(gv.y & 0xffff0000u) + __uint_as_float(ov.y & 0xffff0000u));
                    w.z = pg8::cvt_pk_bf16(a1[0] * __uint_as_float(gv.z << 16) + __uint_as_float(ov.z << 16), a1[1] * __uint_as_float(gv.z & 0xffff0000u) + __uint_as_float(ov.z & 0xffff0000u));
                    w.w = pg8::cvt_pk_bf16(a1[2] * __uint_as_float(gv.w << 16) + __uint_as_float(ov.w << 16), a1[3] * __uint_as_float(gv.w & 0xffff0000u) + __uint_as_float(ov.w & 0xffff0000u));
                    *(u32x4*)mp = w; asm volatile("" ::: "memory"); } }
    }
};
struct EpiResid {
    static constexpr bool PERM = false;
    float* X;
    __device__ __forceinline__ void operator()(const pg8::f32x4 (&acc)[2][2][4][2], const pg8::Unit& u, int wr, int wc, int fr, int fq) const {
        pg8::epi_mfma_settle(acc);
        const int row0 = u.pm * 256 + wr * 64 + fr, col0 = u.pn * 256 + wc * 32 + 4 * fq;
#pragma unroll
        for (int ai = 0; ai < 2; ++ai)
#pragma unroll
            for (int m = 0; m < 4; ++m) { float* rowp = X + (size_t)(row0 + ai * 128 + m * 16) * D + col0;
#pragma unroll
                for (int bj = 0; bj < 2; ++bj)
#pragma unroll
                    for (int n = 0; n < 2; ++n) { pg8::f32x4* p = (pg8::f32x4*)(rowp + bj * 128 + n * 16); *p = *p * ALPHA + acc[ai][bj][m][n]; } }
    }
};
struct EpiSwiglu {
    static constexpr bool PERM = true;
    bf16* H;
    __device__ __forceinline__ void operator()(const pg8::f32x4 (&acc)[2][2][4][2], const pg8::Unit& u, int wr, int wc, int fr, int fq) const {
        pg8::epi_mfma_settle(acc);
        const int row0 = u.pm * 256 + wr * 64 + fr; const int col0 = u.pn * 128 + wc * 32 + 8 * fq;
#pragma unroll
        for (int ai = 0; ai < 2; ++ai)
#pragma unroll
            for (int m = 0; m < 4; ++m) { bf16* rowp = H + (size_t)(row0 + ai * 128 + m * 16) * DEXP + col0;
                float v[8];
#pragma unroll
                for (int j = 0; j < 4; ++j) { v[j] = siluf_(acc[ai][0][m][0][j]) * acc[ai][1][m][0][j]; v[4 + j] = siluf_(acc[ai][0][m][1][j]) * acc[ai][1][m][1][j]; }
                u32x4 w; w.x = pg8::cvt_pk_bf16(v[0], v[1]); w.y = pg8::cvt_pk_bf16(v[2], v[3]); w.z = pg8::cvt_pk_bf16(v[4], v[5]); w.w = pg8::cvt_pk_bf16(v[6], v[7]);
                *(u32x4*)rowp = w; }
    }
};

struct SkewOrder {
    int nM, nN, nwg, c, lda, ldb;
    __device__ bool next(int i, pg8::Unit& u) const {
        long L;
        if (i < 5) L = (long)i * 256 + c; else { if (c < 32) return false; L = 1280 + (long)(i - 5) * 224 + (c - 32); }
        if (L >= nwg) return false;
        pg8::tile_of((int)L, nM, nN, u.pm, u.pn); u.aux = 0;
        u.aoff = (size_t)u.pm * 256 * lda * 2; u.boff = (size_t)u.pn * 256 * ldb * 2; return true;
    }
};
struct BranchOrder {
    int nM, nN, G, c;
    __device__ bool next(int i, pg8::Unit& u) const {
        const int tl = (i >> 2) * G + c; if (tl >= nM * nN) return false;
        pg8::tile_of(tl, nM, nN, u.pm, u.pn); u.aux = i & 3;
        u.aoff = ((size_t)u.pm * 256 * 1024 + (size_t)u.aux * 256) * 2; u.boff = ((size_t)u.pn * 256 * 1024 + (size_t)u.aux * 256) * 2; return true;
    }
};
struct MoeOrder {
    const volatile LAS int* tb; int G, c; size_t a_rowbytes, b_expbytes, b_tilebytes;
    __device__ bool next(int i, pg8::Unit& u) const {
        const int L = i * G + c; const int total = __builtin_amdgcn_readfirstlane(tb[32]) * 4; if (L >= total) return false;
        int e = 0;
#pragma unroll 1
        for (int k = 0; k < 32; ++k) if (L >= tb[k + 1] * 4) e = k + 1;
        const int nte = tb[e + 1] - tb[e]; const int r = L - tb[e] * 4; const int ct = r / nte, rt = r % nte;
        u.pm = __builtin_amdgcn_readfirstlane(tb[33 + e] + rt); u.pn = __builtin_amdgcn_readfirstlane(ct); u.aux = __builtin_amdgcn_readfirstlane(e);
        u.aoff = (size_t)u.pm * 256 * a_rowbytes; u.boff = (size_t)u.aux * b_expbytes + (size_t)u.pn * b_tilebytes; return true;
    }
};

constexpr int PTR_OFF = LDS_BYTES - 512;
__device__ __forceinline__ void ptr_table_fill(const Args& args, LAS unsigned char* lds) {
    if (threadIdx.x == 0) {
        volatile LAS unsigned long long* t = (volatile LAS unsigned long long*)(lds + PTR_OFF);
#define PT_(i) t[i] = (unsigned long long)args.in[i];
        PT_(0) PT_(1) PT_(2) PT_(3) PT_(4) PT_(5) PT_(6) PT_(7) PT_(8) PT_(9) PT_(10) PT_(11) PT_(12) PT_(13) PT_(14) PT_(15) PT_(16) PT_(17) PT_(18) PT_(19)
        PT_(20) PT_(21) PT_(22) PT_(23) PT_(24) PT_(25) PT_(26) PT_(27) PT_(28) PT_(29) PT_(30) PT_(31) PT_(32) PT_(33) PT_(34)
#undef PT_
        t[35] = (unsigned long long)args.out; t[36] = (unsigned long long)args.ws; t[37] = (unsigned long long)(unsigned)args.ph_lo;
    }
    __syncthreads();
}
__device__ __forceinline__ unsigned long long ldptr(LAS unsigned char* lds, int i) {
    unsigned a = (unsigned)(PTR_OFF + 8 * i); asm volatile("" : "+v"(a));
    const volatile LAS unsigned* t = (const volatile LAS unsigned*)(lds + a);
    const unsigned lo = __builtin_amdgcn_readfirstlane(t[0]), hi = __builtin_amdgcn_readfirstlane(t[1]);
    return ((unsigned long long)hi << 32) | lo;
}
__device__ __forceinline__ void* gptr(unsigned long long v) { return (void*)(__attribute__((address_space(1))) void*)v; }
#define INP(i) ((const float*)gptr(ldptr(lds, (i))))
namespace rw {
typedef short bf16x8 __attribute__((ext_vector_type(8)));
typedef float f4 __attribute__((ext_vector_type(4)));
constexpr int LS = 72;
constexpr int MB = 64 * LS * 2;
constexpr int O_AHN = 0, O_RHN = MB, O_BCN = 2 * MB, O_KCN = 3 * MB, O_AHT = 4 * MB, O_BTT = 5 * MB, O_KTT = 6 * MB, O_VT = 7 * MB, O_STT = 8 * MB,
              O_MAK = 9 * MB, O_MRB = 10 * MB, O_MRK = 11 * MB, O_TINV = 12 * MB, O_MABF = 13 * MB, O_GAM = 13 * MB + 16384, O_CT = O_GAM + 256, O_BON = O_CT + 4608, O_END = O_BON + 256;
constexpr int O_MVT = O_BCN, O_A2N = O_AHN, O_UT = O_KCN, O_YF = O_AHT;
constexpr int O_TAB = O_MAK, O_SCR = O_TAB + 26624, O_TOT = O_SCR + 8 * 1024, O_CUM = O_TOT + 2048;
static_assert(O_CUM + 16384 <= O_GAM && O_END <= LDS_BYTES - 576, "rwkv LDS map");

__device__ __forceinline__ bf16x8 ldfrag(const LAS unsigned char* lds, int off, int r0, int ks, int lane) {
    return *(const LAS bf16x8*)(lds + off + ((r0 + (lane & 15)) * LS + ks * 32 + (lane >> 4) * 8) * 2);
}
__device__ __forceinline__ void mm64(f4 (&acc)[2], const LAS unsigned char* lds, int offA, int offBt, int w, int lane) {
    const int tr = w >> 1; const bf16x8 a0 = ldfrag(lds, offA, tr * 16, 0, lane), a1 = ldfrag(lds, offA, tr * 16, 1, lane);
#pragma unroll
    for (int c = 0; c < 2; ++c) { const int tc = (w & 1) * 2 + c; const bf16x8 b0 = ldfrag(lds, offBt, tc * 16, 0, lane), b1 = ldfrag(lds, offBt, tc * 16, 1, lane);
        acc[c] = __builtin_amdgcn_mfma_f32_16x16x32_bf16(a0, b0, acc[c], 0, 0, 0); acc[c] = __builtin_amdgcn_mfma_f32_16x16x32_bf16(a1, b1, acc[c], 0, 0, 0); }
}
__device__ __forceinline__ void storeT(LAS unsigned char* lds, int off, const f4 (&acc)[2], int w, int lane) {
    asm volatile("s_nop 11" :: "v"(acc[0]), "v"(acc[1]));
#pragma unroll
    for (int c = 0; c < 2; ++c) { const int col = ((w & 1) * 2 + c) * 16 + (lane & 15), row = (w >> 1) * 16 + 4 * (lane >> 4);
        u32x2 v; v.x = pk2(acc[c][0], acc[c][1]); v.y = pk2(acc[c][2], acc[c][3]); *(LAS u32x2*)(lds + off + (col * LS + row) * 2) = v; }
}
template <int MASK  >
__device__ __forceinline__ void storeN(LAS unsigned char* lds, int off, const f4 (&acc)[2], int w, int lane) {
    asm volatile("s_nop 11" :: "v"(acc[0]), "v"(acc[1]));
#pragma unroll
    for (int c = 0; c < 2; ++c) { const int col = ((w & 1) * 2 + c) * 16 + (lane & 15), row = (w >> 1) * 16 + 4 * (lane >> 4);
#pragma unroll
        for (int e = 0; e < 4; ++e) { float x = acc[c][e]; if (MASK == 1) x = (col < row + e) ? x : 0.f; if (MASK == 2) x = (col <= row + e) ? x : 0.f;
            *(LAS bf16*)(lds + off + ((row + e) * LS + col) * 2) = (bf16)f2bf(x); } }
}
typedef __bf16 bf2v __attribute__((ext_vector_type(2)));
__device__ __forceinline__ float dot2(unsigned x, unsigned y, float c) { return __builtin_amdgcn_fdot2_f32_bf16(__builtin_bit_cast(bf2v, x), __builtin_bit_cast(bf2v, y), c, false); }
#define RW_ZERO(a) do { a[0] = (f4){0.f, 0.f, 0.f, 0.f}; a[1] = (f4){0.f, 0.f, 0.f, 0.f}; } while (0)

__device__ __forceinline__ void build_ct(LAS unsigned char* lds0, const int l, const int h, const int lane, const int wave) {
    LAS unsigned char* const& lds = lds0; const int c = h * 64 + lane;
    const float* mu = INP(I_CMU) + (size_t)l * 896;
    if (wave == 0) { LAS float* ct = (LAS float*)(lds0 + O_CT);
        ct[0 * 64 + lane] = mu[c]; ct[1 * 64 + lane] = mu[256 + c]; ct[2 * 64 + lane] = mu[512 + c]; ct[3 * 64 + lane] = mu[768 + lane]; ct[4 * 64 + lane] = mu[832 + lane];
        ct[5 * 64 + lane] = INP(I_CW0)[l * 256 + c]; ct[6 * 64 + lane] = INP(I_CA0)[l * 256 + c]; ct[7 * 64 + lane] = INP(I_CKK)[l * 256 + c]; ct[8 * 64 + lane] = INP(I_CKA)[l * 256 + c];
        ct[9 * 64 + lane] = INP(I_CRK)[l * 256 + c]; ct[10 * 64 + lane] = INP(I_CGNW)[l * 256 + c]; ct[11 * 64 + lane] = INP(I_CGNB)[l * 256 + c]; ct[12 * 64 + lane] = l > 0 ? INP(I_CV0)[(l - 1) * 256 + c] : 0.f;
        ct[13 * 64 + lane] = mu[512 + lane]; ct[14 * 64 + lane] = mu[512 + lane + 64]; ct[15 * 64 + lane] = mu[512 + lane + 128]; ct[16 * 64 + lane] = mu[512 + lane + 192]; }
}
template <int MODE>
__device__ __forceinline__ void chunk(LAS unsigned char* lds0, const int l, const int b, const int h, const int t0, unsigned char* gz, unsigned char* gz2, float* bong, const bf16* P, bf16* VF, bf16* OB, const int tid0) {
    const int c = h * 64 + (tid0 & 63);
    {
        unsigned lb_ = 0u; int tid_l = tid0; asm volatile("" : "+v"(lb_), "+v"(tid_l));
        const int tid = tid_l, lane = tid & 63, wave = __builtin_amdgcn_readfirstlane(tid >> 6);
        LAS unsigned char* lds = lds0 + lb_;
        LAS bf16* TAB = (LAS bf16*)(lds + O_TAB); const LAS unsigned* TABW = (const LAS unsigned*)(lds + O_TAB);
        LAS bf16* scr = (LAS bf16*)(lds + O_SCR + wave * 1024);
        LAS float* CUM = (LAS float*)(lds + O_CUM);
        LAS float* TOT = (LAS float*)(lds + O_TOT);
        LAS float* GAM = (LAS float*)(lds + O_GAM);
        LAS float* MABF = (LAS float*)(lds + O_MABF);
        LAS float* YF = (LAS float*)(lds + O_YF);
        LAS float* BON = (LAS float*)(lds + O_BON);
        const LAS float* CT = (const LAS float*)(lds + O_CT);
#define CTV(k) CT[(k) * 64 + lane]
        LAS float* ASF = (LAS float*)(lds + O_TAB);
        LAS bf16* GSF = (LAS bf16*)(lds + O_STT);
        { const float* cw2 = INP(I_CW2) + (size_t)l * 32 * 256; const float* ca2 = INP(I_CA2) + (size_t)l * 32 * 256; const float* cg2 = INP(I_CG2) + (size_t)l * 64 * 256;
          float twa[8], tg[8];
#pragma unroll
          for (int u = 0; u < 8; ++u) { const int i = tid + u * NTHR, mm = i >> 6, cc = i & 63;
              twa[u] = mm < 32 ? cw2[mm * 256 + h * 64 + cc] : ca2[(mm - 32) * 256 + h * 64 + cc]; tg[u] = cg2[mm * 256 + h * 64 + cc]; }
          float t2[2], t1[8];
          if (l > 0) { const float* cv1 = INP(I_CV1) + (size_t)(l - 1) * 256 * 16; const float* cv2 = INP(I_CV2) + (size_t)(l - 1) * 16 * 256;
#pragma unroll
            for (int u = 0; u < 2; ++u) { const int i = tid + u * NTHR; t2[u] = cv2[(i >> 6) * 256 + h * 64 + (i & 63)]; }
#pragma unroll
            for (int u = 0; u < 8; ++u) t1[u] = cv1[tid + u * NTHR]; }
#pragma unroll
          for (int u = 0; u < 8; ++u) { const int i = tid + u * NTHR, mm = i >> 6, cc = i & 63;
              *(LAS bf16*)(lds + O_BCN + (cc * LS + mm) * 2) = (bf16)f2bf(twa[u]); *(LAS bf16*)(lds + O_KCN + (cc * LS + mm) * 2) = (bf16)f2bf(tg[u]); }
#define PIX(i) ((((i) >> 7) * 64 + ((i) & 63)) * 2 + (((i) >> 6) & 1))
          if (l > 0) {
#pragma unroll
            for (int u = 0; u < 2; ++u) { const int i = tid + u * NTHR; TAB[8192 + PIX(i)] = (bf16)f2bf(t2[u]); }
#pragma unroll
            for (int u = 0; u < 8; ++u) { const int i = tid + u * NTHR; const int cc = i >> 4, qq = i & 15; TAB[9216 + ((cc >> 1) * 16 + qq) * 2 + (cc & 1)] = (bf16)f2bf(t1[u]); } } }
#undef PIX
        { float Xr[9], Xg[9];
#pragma unroll
          for (int j = 0; j < 9; ++j) { const int t = t0 + wave * 8 - 1 + j; const bf16* row_ = P + ((size_t)b * T + (t >= 0 ? t : 0)) * PP + C_C;
              Xr[j] = t >= 0 ? bf2f(row_[768 + lane]) : 0.f; Xg[j] = t >= 0 ? bf2f(row_[832 + lane]) : 0.f; }
#pragma unroll
          for (int q = 0; q < 8; ++q) { const int tt = wave * 8 + q;
              const float xx = Xr[q + 1] + (Xr[q] - Xr[q + 1]) * CTV(3), xg = Xg[q + 1] + (Xg[q] - Xg[q + 1]) * CTV(4);
              *(LAS bf16*)(lds + O_AHN + (tt * LS + lane) * 2) = (bf16)f2bf(lane < 32 ? tanhf_(xx) : xx);
              *(LAS bf16*)(lds + O_RHN + (tt * LS + lane) * 2) = (bf16)f2bf(sigmoidf_(xg)); } }
        __syncthreads();
        { const int tr = wave >> 1;
          const bf16x8 a0 = ldfrag(lds, O_AHN, tr * 16, 0, lane), a1 = ldfrag(lds, O_AHN, tr * 16, 1, lane), g0 = ldfrag(lds, O_RHN, tr * 16, 0, lane), g1 = ldfrag(lds, O_RHN, tr * 16, 1, lane);
#pragma unroll
          for (int cI = 0; cI < 2; ++cI) { const int tc = (wave & 1) * 2 + cI;
              const bf16x8 b0 = ldfrag(lds, O_BCN, tc * 16, 0, lane), b1 = ldfrag(lds, O_BCN, tc * 16, 1, lane), c0 = ldfrag(lds, O_KCN, tc * 16, 0, lane), c1 = ldfrag(lds, O_KCN, tc * 16, 1, lane);
              const f4 z = (f4){0.f, 0.f, 0.f, 0.f};
              const f4 aw = __builtin_amdgcn_mfma_f32_16x16x32_bf16(a0, b0, z, 0, 0, 0), aa = __builtin_amdgcn_mfma_f32_16x16x32_bf16(a1, b1, z, 0, 0, 0);
              f4 ag = __builtin_amdgcn_mfma_f32_16x16x32_bf16(g0, c0, z, 0, 0, 0); ag = __builtin_amdgcn_mfma_f32_16x16x32_bf16(g1, c1, ag, 0, 0, 0);
              const int col = tc * 16 + (lane & 15), row = tr * 16 + 4 * (lane >> 4);
#pragma unroll
              for (int e = 0; e < 4; ++e) { CUM[(row + e) * 64 + col] = aw[e]; ASF[(row + e) * 64 + col] = aa[e]; GSF[(row + e) * 64 + col] = (bf16)f2bf(ag[e]); } } }
        __syncthreads();
        { float run = 0.f;
#pragma unroll
            for (int q = 0; q < 8; ++q) { const int tt = wave * 8 + q;
                const float wsum = CTV(5) + CUM[tt * 64 + lane];
                run += -0.6065306597f * sigmoidf_(wsum); CUM[tt * 64 + lane] = run; }
            TOT[wave * 64 + lane] = run; }
        __syncthreads();
        float offs = 0.f, cumL = 0.f;
#pragma unroll
        for (int w2 = 0; w2 < 8; ++w2) { const float tw = TOT[w2 * 64 + lane]; offs += (w2 < wave) ? tw : 0.f; cumL += tw; }
        if (wave == 0) GAM[lane] = __expf(cumL);
#define LO_(x) __uint_as_float((x) << 16)
#define HI_(x) __uint_as_float((x) & 0xffff0000u)
#define RAW_LOAD(rk, vx, v4a, v4b, vfv, tok) do { const int t_ = (tok); const bool ok_ = t_ >= 0; const size_t m_ = (size_t)b * T + (ok_ ? t_ : 0); const bf16* row_ = P + m_ * PP + C_C; \
            rk = ok_ ? ((unsigned)row_[c] | ((unsigned)row_[256 + c] << 16)) : 0u; vx = ok_ ? (unsigned)row_[512 + c] : 0u; \
            if (l > 0) { v4a = ok_ ? ((unsigned)row_[512 + lane] | ((unsigned)row_[512 + lane + 64] << 16)) : 0u; v4b = ok_ ? ((unsigned)row_[512 + lane + 128] | ((unsigned)row_[512 + lane + 192] << 16)) : 0u; vfv = (unsigned)VF[m_ * 256 + c]; } } while (0)
        unsigned pRK, pVX, pVa = 0u, pVb = 0u, pVF = 0u, cRK, cVX, cVa = 0u, cVb = 0u, cVF = 0u;
        RAW_LOAD(pRK, pVX, pVa, pVb, pVF, t0 + wave * 8 - 1); RAW_LOAD(cRK, cVX, cVa, cVb, cVF, t0 + wave * 8);
#pragma unroll 1
        for (int q = 0; q < 8; ++q) {
            const int tt = wave * 8 + q; const size_t m = (size_t)b * T + t0 + tt;
            unsigned nRK, nVX, nVa = 0u, nVb = 0u, nVF = 0u;
            RAW_LOAD(nRK, nVX, nVa, nVb, nVF, (q < 7) ? (t0 + tt + 1) : (t0 + tt));
            const float r = LO_(cRK) + (LO_(pRK) - LO_(cRK)) * CTV(0), k = HI_(cRK) + (HI_(pRK) - HI_(cRK)) * CTV(1); float v = LO_(cVX) + (LO_(pVX) - LO_(cVX)) * CTV(2);
            const float asum = CTV(6) + ASF[tt * 64 + lane]; const unsigned gbits = (unsigned)GSF[tt * 64 + lane];
            const float cq = CUM[tt * 64 + lane], cprev = q > 0 ? CUM[(tt - 1) * 64 + lane] : 0.f;
            if (l > 0) {
                LAS bf16* vsc = scr + 128;
                vsc[lane] = (bf16)f2bf(LO_(cVa) + (LO_(pVa) - LO_(cVa)) * CTV(13)); vsc[lane + 64] = (bf16)f2bf(HI_(cVa) + (HI_(pVa) - HI_(cVa)) * CTV(14));
                vsc[lane + 128] = (bf16)f2bf(LO_(cVb) + (LO_(pVb) - LO_(cVb)) * CTV(15)); vsc[lane + 192] = (bf16)f2bf(HI_(cVb) + (HI_(pVb) - HI_(cVb)) * CTV(16));
                asm volatile("s_waitcnt lgkmcnt(0)" ::: "memory");
                const int qq = lane & 15, part = lane >> 4; float s = 0.f; { float s1 = 0.f; const LAS unsigned* sv = (const LAS unsigned*)vsc;
#pragma unroll
                for (int p = 0; p < 32; p += 2) { s = dot2(sv[part * 32 + p], TABW[4608 + (part * 32 + p) * 16 + qq], s); s1 = dot2(sv[part * 32 + p + 1], TABW[4608 + (part * 32 + p + 1) * 16 + qq], s1); }
                s += s1; }
                s += __shfl_xor(s, 16); s += __shfl_xor(s, 32);
                float vl = CTV(12);
#pragma unroll
                for (int q2 = 0; q2 < 16; ++q2) vl += __shfl(s, q2) * bf2f(TAB[8192 + ((q2 >> 1) * 64 + lane) * 2 + (q2 & 1)]);
                const float vf = LO_(cVF); v = v + (vf - v) * sigmoidf_(vl);
            }
            if (MODE < 5) VF[m * 256 + c] = (bf16)f2bf(v);
            const float asig = sigmoidf_(asum), lw = cq - cprev;
            float kk = k * CTV(7); const float n2 = wave_sum(kk * kk); kk = kk * __builtin_amdgcn_rsqf(fmaxf(n2, 1e-24f));
            const float kmod = k * (1.f + (asig - 1.f) * CTV(8));
            const float bon = wave_sum(r * kmod * CTV(9));
            const float cum = offs + cq, cumx = cum - lw;
            const float ah = -kk * __expf(cumx), rh = r * __expf(cum), ei = __expf(-cum), bb = kk * asig, bc = bb * ei, kc = kmod * ei, ee = __expf(cumL - cum), bt = bb * ee, kt = kmod * ee;
            const int no = (tt * LS + lane) * 2, to = (lane * LS + tt) * 2;
            *(LAS bf16*)(lds + O_AHN + no) = (bf16)f2bf(ah); *(LAS bf16*)(lds + O_RHN + no) = (bf16)f2bf(rh);
            *(LAS bf16*)(lds + O_BCN + no) = (bf16)f2bf(bc); *(LAS bf16*)(lds + O_KCN + no) = (bf16)f2bf(kc); if (MODE < 5) ((bf16*)(gz2 + 16384))[tt * 64 + lane] = (bf16)gbits;
            *(LAS bf16*)(lds + O_AHT + to) = (bf16)f2bf(ah); *(LAS bf16*)(lds + O_BTT + to) = (bf16)f2bf(bt);
            *(LAS bf16*)(lds + O_KTT + to) = (bf16)f2bf(kt); *(LAS bf16*)(lds + O_VT + to) = (bf16)f2bf(v);
            if (MODE < 5 && lane == 0) bong[tt] = bon;
            asm volatile("s_waitcnt lgkmcnt(0)" ::: "memory");
            pRK = cRK; pVX = cVX; pVa = cVa; pVb = cVb; cRK = nRK; cVX = nVX; cVa = nVa; cVb = nVb; cVF = nVF;
        }
#undef RAW_LOAD
        __syncthreads();
        if (MODE == 6) return;
        { f4 acc[2];
            RW_ZERO(acc); mm64(acc, lds, O_AHN, O_BCN, wave, lane);
#pragma unroll
            for (int cI = 0; cI < 2; ++cI) { const int col = ((wave & 1) * 2 + cI) * 16 + (lane & 15), row = (wave >> 1) * 16 + 4 * (lane >> 4);
#pragma unroll
                for (int e = 0; e < 4; ++e) MABF[(row + e) * 64 + col] = (col < row + e) ? acc[cI][e] : 0.f; }
            RW_ZERO(acc); mm64(acc, lds, O_AHN, O_KCN, wave, lane); storeN<1>(lds, O_MAK, acc, wave, lane);
            { f4 accb[2]; RW_ZERO(accb); mm64(accb, lds, O_RHN, O_BCN, wave, lane); f4 accc[2]; RW_ZERO(accc); mm64(accc, lds, O_RHN, O_KCN, wave, lane);
                storeN<2>(lds, O_MRB, accb, wave, lane); storeN<2>(lds, O_MRK, accc, wave, lane); }
        }
        __syncthreads();
        {
            const int cS = wave * 8 + (lane >> 3), tS = lane & 7;
            float xs[8];
#pragma unroll
            for (int k = 0; k < 8; ++k) xs[k] = 0.f;
#pragma unroll
            for (int i = 1; i < 64; ++i) {
                float part = 0.f;
#pragma unroll
                for (int k = 0; k < (i + 7) / 8; ++k) { const float mv = MABF[i * 64 + tS + 8 * k]; part += ((tS + 8 * k) < i ? mv : 0.f) * xs[k]; }
                part += __builtin_bit_cast(float, __builtin_amdgcn_update_dpp(0, __builtin_bit_cast(int, part), 0xB1, 0xF, 0xF, true));
                part += __builtin_bit_cast(float, __builtin_amdgcn_update_dpp(0, __builtin_bit_cast(int, part), 0x4E, 0xF, 0xF, true));
                part += __builtin_bit_cast(float, __builtin_amdgcn_update_dpp(0, __builtin_bit_cast(int, part), 0x141, 0xF, 0xF, true));
                const float xi = MABF[i * 64 + cS] + part;
                xs[i >> 3] = (tS == (i & 7)) ? xi : xs[i >> 3];
            }
#pragma unroll
            for (int k = 0; k < 8; ++k) { const int i = tS + 8 * k; *(LAS bf16*)(lds + O_TINV + (i * LS + cS) * 2) = (bf16)f2bf(i == cS ? 1.f : xs[k]); }
        }
        __syncthreads();
        { f4 acc[2]; RW_ZERO(acc); mm64(acc, lds, O_MAK, O_VT, wave, lane); storeT(lds, O_MVT, acc, wave, lane); }
        __syncthreads();
        if (MODE == 1 || MODE == 5) {
            { f4 acc[2]; RW_ZERO(acc); mm64(acc, lds, O_TINV, O_AHT, wave, lane); storeT(lds, O_UT, acc, wave, lane); }
            { f4 acc[2]; RW_ZERO(acc); mm64(acc, lds, O_TINV, O_MVT, wave, lane); storeT(lds, O_MAK, acc, wave, lane); }
            __syncthreads();
            f4 agm[2], azm[2], ar2[2], ay0[2];
            RW_ZERO(agm); mm64(agm, lds, O_BTT, O_UT, wave, lane);
#pragma unroll
            for (int cI = 0; cI < 2; ++cI) { const int col = ((wave & 1) * 2 + cI) * 16 + (lane & 15), row = (wave >> 1) * 16 + 4 * (lane >> 4);
#pragma unroll
                for (int e = 0; e < 4; ++e) if (col == row + e) agm[cI][e] += GAM[col]; }
            RW_ZERO(azm); mm64(azm, lds, O_BTT, O_MAK, wave, lane); mm64(azm, lds, O_KTT, O_VT, wave, lane);
            RW_ZERO(ar2); mm64(ar2, lds, O_MRB, O_UT, wave, lane);
#pragma unroll
            for (int cI = 0; cI < 2; ++cI) { const int col = ((wave & 1) * 2 + cI) * 16 + (lane & 15), row = (wave >> 1) * 16 + 4 * (lane >> 4);
#pragma unroll
                for (int e = 0; e < 4; ++e) ar2[cI][e] += bf2f(*(const LAS bf16*)(lds + O_RHN + ((row + e) * LS + col) * 2)); }
            RW_ZERO(ay0); mm64(ay0, lds, O_MRB, O_MAK, wave, lane); mm64(ay0, lds, O_MRK, O_VT, wave, lane);
            __syncthreads();
            storeN<0>(lds, O_AHN, agm, wave, lane); storeT(lds, O_RHN, azm, wave, lane); storeN<0>(lds, O_BCN, ar2, wave, lane); storeT(lds, O_KCN, ay0, wave, lane);
            __syncthreads();
            if (MODE == 1) { const int io = ((tid >> 3) * LS + (tid & 7) * 8) * 2;
              ((u32x4*)gz)[tid] = *(const LAS u32x4*)(lds + O_AHN + io); ((u32x4*)(gz + 8192))[tid] = *(const LAS u32x4*)(lds + O_RHN + io);
              ((u32x4*)gz2)[tid] = *(const LAS u32x4*)(lds + O_BCN + io); ((u32x4*)(gz2 + 8192))[tid] = *(const LAS u32x4*)(lds + O_KCN + io); }
        } else {
            { f4 acc[2]; RW_ZERO(acc); mm64(acc, lds, O_TINV, O_AHT, wave, lane); storeN<0>(lds, O_A2N, acc, wave, lane); }
            __syncthreads();
            { f4 acc[2]; RW_ZERO(acc); mm64(acc, lds, O_TINV, O_MVT, wave, lane); mm64(acc, lds, O_A2N, O_STT, wave, lane); storeT(lds, O_UT, acc, wave, lane); }
            __syncthreads();
            f4 yacc[2]; RW_ZERO(yacc);
            mm64(yacc, lds, O_RHN, O_STT, wave, lane); mm64(yacc, lds, O_MRB, O_UT, wave, lane); mm64(yacc, lds, O_MRK, O_VT, wave, lane);
            __syncthreads();
#pragma unroll
            for (int cI = 0; cI < 2; ++cI) { const int col = ((wave & 1) * 2 + cI) * 16 + (lane & 15), row = (wave >> 1) * 16 + 4 * (lane >> 4);
#pragma unroll
                for (int e = 0; e < 4; ++e) YF[(row + e) * 64 + col] = yacc[cI][e]; }
            __syncthreads();
            { unsigned gcur = (unsigned)OB[((size_t)b * T + t0 + wave * 8) * 1024 + 512 + c];
#pragma unroll 1
            for (int q = 0; q < 8; ++q) {
                const int tt = wave * 8 + q; const size_t m = (size_t)b * T + t0 + tt;
                const unsigned gnxt = (unsigned)OB[(m + (q < 7 ? 1 : 0)) * 1024 + 512 + c];
                const float y = YF[tt * 64 + lane]; const float mean = wave_sum(y) * (1.f / 64.f); const float dy = y - mean; const float var = wave_sum(dy * dy) * (1.f / 64.f);
                const float yn = dy * rsqrtf(var + 64e-5f) * CTV(10) + CTV(11);
                const float vv = bf2f(*(const LAS bf16*)(lds + O_VT + (lane * LS + tt) * 2)), gg = LO_(gcur);
                OB[m * 1024 + 512 + c] = (bf16)f2bf((yn + BON[tt] * vv) * gg);
                gcur = gnxt;
            } }
        }
        __syncthreads();
#undef CTV
#undef LO_
#undef HI_
    }
}

__device__ __forceinline__ void chunk_out(LAS unsigned char* lds0, const int b, const int h, const int t0, const unsigned char* gz, const unsigned char* gz2, const float* bong, const bf16* VF, bf16* OB, const int tid0) {
    unsigned lb_ = 0u; int tid_l = tid0; asm volatile("" : "+v"(lb_), "+v"(tid_l));
    LAS unsigned char* lds = lds0 + lb_; const int tid = tid_l, lane = tid & 63, wave = __builtin_amdgcn_readfirstlane(tid >> 6);
    const int c = h * 64 + lane;
    const LAS float* CT = (const LAS float*)(lds + O_CT);
    LAS float* YF = (LAS float*)(lds + O_YF);
    const int io = ((tid >> 3) * LS + (tid & 7) * 8) * 2;
    const u32x4 sv = ((const u32x4*)gz)[tid], rv = ((const u32x4*)gz2)[tid];
    u32x2 yv[2];
#pragma unroll
    for (int k = 0; k < 2; ++k) { const int col = ((wave & 1) * 2 + k) * 16 + (lane & 15), row = (wave >> 1) * 16 + 4 * (lane >> 4); yv[k] = *(const u32x2*)(gz2 + 8192 + (col * 64 + row) * 2); }
    float gq[8], vq[8], bq[8];
#pragma unroll
    for (int q = 0; q < 8; ++q) { const int tt = wave * 8 + q; const size_t m = (size_t)b * T + t0 + tt;
        gq[q] = bf2f(((const bf16*)(gz2 + 16384))[tt * 64 + lane]); vq[q] = bf2f(VF[m * 256 + c]); bq[q] = bong[tt]; }
    *(LAS u32x4*)(lds + O_STT + io) = sv; *(LAS u32x4*)(lds + O_AHN + io) = rv;
    __syncthreads();
    f4 acc[2];
#pragma unroll
    for (int k = 0; k < 2; ++k) acc[k] = (f4){__uint_as_float(yv[k].x << 16), __uint_as_float(yv[k].x & 0xffff0000u), __uint_as_float(yv[k].y << 16), __uint_as_float(yv[k].y & 0xffff0000u)};
    mm64(acc, lds, O_AHN, O_STT, wave, lane);
#pragma unroll
    for (int cI = 0; cI < 2; ++cI) { const int col = ((wave & 1) * 2 + cI) * 16 + (lane & 15), row = (wave >> 1) * 16 + 4 * (lane >> 4);
#pragma unroll
        for (int e = 0; e < 4; ++e) YF[(row + e) * 64 + col] = acc[cI][e]; }
    __syncthreads();
#pragma unroll
    for (int q = 0; q < 8; ++q) { const int tt = wave * 8 + q; const size_t m = (size_t)b * T + t0 + tt;
        const float y = YF[tt * 64 + lane]; const float mean = wave_sum(y) * (1.f / 64.f); const float dy = y - mean; const float var = wave_sum(dy * dy) * (1.f / 64.f);
        const float yn = dy * rsqrtf(var + 64e-5f) * CT[10 * 64 + lane] + CT[11 * 64 + lane];
        OB[m * 1024 + 512 + c] = (bf16)f2bf((yn + bq[q] * vq[q]) * gq[q]); }
    __syncthreads();
}

__device__ __forceinline__ void carry(LAS unsigned char* lds0, unsigned char* gzc  , const int tid0) {
    f4 stacc[2]; RW_ZERO(stacc);
    { unsigned lb_ = 0u; asm volatile("" : "+v"(lb_)); LAS unsigned char* lds = lds0 + lb_; for (int i = tid0; i < MB / 4; i += NTHR) ((LAS unsigned*)(lds + O_STT))[i] = 0u; }
    u32x4 gnx = ((const u32x4*)gzc)[tid0];
    u32x2 znx[2];
    { const int lane = tid0 & 63, wave = tid0 >> 6;
#pragma unroll
      for (int k = 0; k < 2; ++k) { const int col = ((wave & 1) * 2 + k) * 16 + (lane & 15), row = (wave >> 1) * 16 + 4 * (lane >> 4); znx[k] = *(const u32x2*)(gzc + 8192 + (col * 64 + row) * 2); } }
#pragma unroll 1
    for (int cI = 0; cI < T / 64; ++cI) {
        unsigned lb_ = 0u; int tid_l = tid0; asm volatile("" : "+v"(lb_), "+v"(tid_l));
        LAS unsigned char* lds = lds0 + lb_; const int tid = tid_l, lane = tid & 63, wave = __builtin_amdgcn_readfirstlane(tid >> 6);
        unsigned char* rec = gzc + (size_t)cI * 16384;
        const int io = ((tid >> 3) * LS + (tid & 7) * 8) * 2;
        *(LAS u32x4*)(lds + O_AHN + io) = gnx;
        u32x2 zv[2]; zv[0] = znx[0]; zv[1] = znx[1];
        if (cI + 1 < T / 64) { gnx = ((const u32x4*)(rec + 16384))[tid];
#pragma unroll
            for (int k = 0; k < 2; ++k) { const int col = ((wave & 1) * 2 + k) * 16 + (lane & 15), row = (wave >> 1) * 16 + 4 * (lane >> 4); znx[k] = *(const u32x2*)(rec + 16384 + 8192 + (col * 64 + row) * 2); } }
        __syncthreads();
        ((u32x4*)rec)[tid] = *(const LAS u32x4*)(lds + O_STT + io);
        f4 acc[2];
#pragma unroll
        for (int k = 0; k < 2; ++k) acc[k] = (f4){__uint_as_float(zv[k].x << 16), __uint_as_float(zv[k].x & 0xffff0000u), __uint_as_float(zv[k].y << 16), __uint_as_float(zv[k].y & 0xffff0000u)};
        mm64(acc, lds, O_AHN, O_STT, wave, lane);
        __syncthreads();
        storeT(lds, O_STT, acc, wave, lane);
    }
}
}

namespace mb {
using rw::LS; using rw::MB; using rw::f4; using rw::mm64; using rw::storeN; using rw::bf16x8;
constexpr int O_CN = 0, O_BN = MB, O_BT = 2 * MB, O_XT0 = 3 * MB, O_XW0 = 5 * MB, O_CS0 = 7 * MB, O_HN0 = 9 * MB, O_SC0 = 11 * MB, O_SM = 13 * MB, O_YF = O_XW0;
static_assert(O_SM + 2048 <= LDS_BYTES - 576, "mamba LDS map");
__device__ __forceinline__ void chain(LAS unsigned char* lds0, const int l, const int b, const int gI, const bf16* P, bf16* OB, const int tid0, const int lane0, const int wave0) {
    const int tid = tid0, lane = lane0, wave = wave0;
    LAS unsigned char* const& lds = lds0;
    const float* cwp = INP(I_DCW) + (size_t)l * 4 * 512; const float* cbp = INP(I_DCB) + (size_t)l * 512;
    const int cc = tid & 255, sub = tid >> 8;
    const int col = cc < 128 ? (gI * 128 + cc) : (cc < 192 ? (256 + gI * 64 + (cc - 128)) : (384 + gI * 64 + (cc - 192)));
    const float cw0 = cwp[col], cw1 = cwp[512 + col], cw2 = cwp[1024 + col], cw3 = cwp[1536 + col], cb = cbp[col];
    f4 hacc[2][2];
#pragma unroll
    for (int hh = 0; hh < 2; ++hh) { hacc[hh][0] = (f4){0.f, 0.f, 0.f, 0.f}; hacc[hh][1] = (f4){0.f, 0.f, 0.f, 0.f}; }
    for (int i = tid; i < 2 * MB / 4; i += NTHR) ((LAS unsigned*)(lds0 + O_HN0))[i] = 0u;
    const float dtb0 = INP(I_DDTB)[l * 4 + gI * 2], dtb1 = INP(I_DDTB)[l * 4 + gI * 2 + 1];
    const float nA0 = -__expf(INP(I_DALOG)[l * 4 + gI * 2]), nA1 = -__expf(INP(I_DALOG)[l * 4 + gI * 2 + 1]);
    const float dsk0 = INP(I_DSKIP)[l * 4 + gI * 2], dsk1 = INP(I_DSKIP)[l * 4 + gI * 2 + 1];
    const float nw0 = INP(I_DNW)[l * 256 + gI * 128 + lane], nw1 = INP(I_DNW)[l * 256 + gI * 128 + 64 + lane];
#pragma unroll 1
    for (int t0 = 0; t0 < T; t0 += 64) {
        unsigned lb_ = 0u; int tid_l = tid0; asm volatile("" : "+v"(lb_), "+v"(tid_l));
        const int tid = tid_l, lane = tid & 63, wave = __builtin_amdgcn_readfirstlane(tid >> 6);
        LAS unsigned char* lds = lds0 + lb_;
        LAS float* SM = (LAS float*)(lds + O_SM);
        LAS float* YF = (LAS float*)(lds + O_YF);
        if (wave < 2) {
            const size_t m = (size_t)b * T + t0 + lane;
            const float dt = softplusf_(bf2f(P[m * PP + C_DT + gI * 2 + wave]) + (wave == 0 ? dtb0 : dtb1));
            float cs = dt * (wave == 0 ? nA0 : nA1);
#pragma unroll
            for (int o = 1; o < 64; o <<= 1) { const float y = __shfl_up(cs, o); if (lane >= o) cs += y; }
            const float cL = __shfl(cs, 63);
            SM[wave * 64 + lane] = dt; SM[128 + wave * 64 + lane] = cs; SM[256 + wave * 64 + lane] = __expf(cL - cs) * dt; SM[384 + wave * 64 + lane] = __expf(cs);
        }
        __syncthreads();
        { float h0, h1, h2, cur[8], nxt[8];
          { const int tb = t0 + sub * 32; h0 = tb >= 3 ? bf2f(P[((size_t)b * T + tb - 3) * PP + C_DX + col]) : 0.f; h1 = tb >= 2 ? bf2f(P[((size_t)b * T + tb - 2) * PP + C_DX + col]) : 0.f; h2 = tb >= 1 ? bf2f(P[((size_t)b * T + tb - 1) * PP + C_DX + col]) : 0.f;
#pragma unroll
            for (int j = 0; j < 8; ++j) cur[j] = bf2f(P[((size_t)b * T + tb + j) * PP + C_DX + col]); }
#pragma unroll 1
          for (int g8 = 0; g8 < 4; ++g8) {
            const int tb = t0 + sub * 32 + g8 * 8 + (g8 < 3 ? 8 : 0);
#pragma unroll
            for (int j = 0; j < 8; ++j) nxt[j] = bf2f(P[((size_t)b * T + tb + j) * PP + C_DX + col]);
#pragma unroll
            for (int j = 0; j < 8; ++j) {
                const int tt = sub * 32 + g8 * 8 + j;
                const float a = siluf_(cb + cw3 * cur[j] + cw2 * h2 + cw1 * h1 + cw0 * h0);
                h0 = h1; h1 = h2; h2 = cur[j];
                if (cc < 128) { const int hh = cc >> 6, p = cc & 63;
                    *(LAS bf16*)(lds + O_XT0 + hh * MB + (p * LS + tt) * 2) = (bf16)f2bf(a); *(LAS bf16*)(lds + O_XW0 + hh * MB + (p * LS + tt) * 2) = (bf16)f2bf(a * SM[256 + hh * 64 + tt]); }
                else if (cc < 192) { const int n = cc - 128; *(LAS bf16*)(lds + O_BN + (tt * LS + n) * 2) = (bf16)f2bf(a); *(LAS bf16*)(lds + O_BT + (n * LS + tt) * 2) = (bf16)f2bf(a); }
                else { const int n = cc - 192; *(LAS bf16*)(lds + O_CN + (tt * LS + n) * 2) = (bf16)f2bf(a);
                    *(LAS bf16*)(lds + O_CS0 + (tt * LS + n) * 2) = (bf16)f2bf(a * SM[384 + tt]); *(LAS bf16*)(lds + O_CS0 + MB + (tt * LS + n) * 2) = (bf16)f2bf(a * SM[384 + 64 + tt]); }
            }
#pragma unroll
            for (int j = 0; j < 8; ++j) cur[j] = nxt[j];
          } }
        __syncthreads();
        { f4 acc[2]; acc[0] = (f4){0.f, 0.f, 0.f, 0.f}; acc[1] = (f4){0.f, 0.f, 0.f, 0.f}; mm64(acc, lds, O_CN, O_BN, wave, lane);
#pragma unroll
            for (int hh = 0; hh < 2; ++hh) { f4 sc[2];
#pragma unroll
                for (int cI = 0; cI < 2; ++cI) { const int s = ((wave & 1) * 2 + cI) * 16 + (lane & 15), row = (wave >> 1) * 16 + 4 * (lane >> 4);
                    const float cs = SM[128 + hh * 64 + s], ds = SM[hh * 64 + s];
#pragma unroll
                    for (int e = 0; e < 4; ++e) { const float ct = SM[128 + hh * 64 + row + e]; sc[cI][e] = (s <= row + e) ? acc[cI][e] * __expf(ct - cs) * ds : 0.f; } }
                storeN<0>(lds, O_SC0 + hh * MB, sc, wave, lane); } }
        __syncthreads();
        f4 yacc[2][2];
#pragma unroll
        for (int hh = 0; hh < 2; ++hh) {
            yacc[hh][0] = (f4){0.f, 0.f, 0.f, 0.f}; yacc[hh][1] = (f4){0.f, 0.f, 0.f, 0.f};
            mm64(yacc[hh], lds, O_SC0 + hh * MB, O_XT0 + hh * MB, wave, lane); mm64(yacc[hh], lds, O_CS0 + hh * MB, O_HN0 + hh * MB, wave, lane);
            const float gL = SM[384 + hh * 64 + 63]; hacc[hh][0] = hacc[hh][0] * gL; hacc[hh][1] = hacc[hh][1] * gL;
            mm64(hacc[hh], lds, O_XW0 + hh * MB, O_BT, wave, lane);
        }
        __syncthreads();
#pragma unroll
        for (int hh = 0; hh < 2; ++hh) {
#pragma unroll
            for (int cI = 0; cI < 2; ++cI) { const int colp = ((wave & 1) * 2 + cI) * 16 + (lane & 15), row = (wave >> 1) * 16 + 4 * (lane >> 4);
#pragma unroll
                for (int e = 0; e < 4; ++e) YF[(row + e) * 128 + hh * 64 + colp] = yacc[hh][cI][e]; }
            storeN<0>(lds, O_HN0 + hh * MB, hacc[hh], wave, lane);
        }
        __syncthreads();
#pragma unroll
        for (int q = 0; q < 8; ++q) {
            const int tt = wave * 8 + q; const size_t m = (size_t)b * T + t0 + tt;
            const float x0 = bf2f(*(const LAS bf16*)(lds + O_XT0 + (lane * LS + tt) * 2)), x1 = bf2f(*(const LAS bf16*)(lds + O_XT0 + MB + (lane * LS + tt) * 2));
            const int c0 = gI * 128 + lane, c1 = c0 + 64;
            const float z0 = bf2f(P[m * PP + C_DZ + c0]), z1 = bf2f(P[m * PP + C_DZ + c1]);
            const float y0 = (YF[tt * 128 + lane] + dsk0 * x0) * siluf_(z0), y1 = (YF[tt * 128 + 64 + lane] + dsk1 * x1) * siluf_(z1);
            const float ss = wave_sum(y0 * y0 + y1 * y1); const float rs = rsqrtf(ss * (1.f / 128.f) + 1e-5f);
            OB[m * 1024 + 768 + c0] = (bf16)f2bf(y0 * rs * nw0); OB[m * 1024 + 768 + c1] = (bf16)f2bf(y1 * rs * nw1);
        }
        __syncthreads();
    }
}
}

namespace bsp {
typedef short bf16x8 __attribute__((ext_vector_type(8)));
typedef float f4 __attribute__((ext_vector_type(4)));
constexpr int HS = 129;
constexpr int O_HIST = 0;
constexpr int O_V = 66048;
constexpr int VS = 272;
constexpr int O_KB = O_V + 2 * 32 * VS * 2;
constexpr int KBUF = 20480;
static_assert(O_KB + 2 * KBUF <= LDS_BYTES - 600, "mixer B LDS map");
__device__ __forceinline__ float relu_(float x) { return __int_as_float(max(__float_as_int(x), 0)); }
__device__ __forceinline__ int qkey(float s) { int q = (int)__builtin_fmaf(s, 262144.f, 8388608.f); return q < 1 ? 1 : (q > 16777215 ? 16777215 : q); }
__device__ __forceinline__ unsigned okey(float s) { return (unsigned)qkey(s) << 8; }
__device__ __forceinline__ int f2o(float f) { const int b = __float_as_int(f); return b ^ ((b >> 31) & 0x7fffffff); }
__device__ __forceinline__ float o2f(int o) { return __int_as_float(o ^ ((o >> 31) & 0x7fffffff)); }
__device__ __forceinline__ float fthr(const unsigned Q) {
    const int Qc = (int)(Q < 2u ? 2u : (Q > 16777215u ? 16777215u : Q));
    long long lo = f2o(-64.f), hi = f2o(64.f);
#pragma unroll 1
    for (int i = 0; i < 33; ++i) { const int mid = (int)((lo + hi) >> 1); if (qkey(o2f(mid)) >= Qc) hi = mid; else lo = mid; }
    const float r = o2f((int)hi);
    return Q < 2u ? -INFINITY : (Q > 16777215u ? INFINITY : r);
}
__device__ __forceinline__ void hist_add(const unsigned addr, const unsigned v) { asm volatile("ds_add_u32 %0, %1" :: "v"(addr), "v"(v) : "memory"); }
__device__ __forceinline__ f4 idx_tile(const bf16* Pb, const int kt, const bf16x8 (&qi)[4][2], const float (&wq)[4], const int lane) {
    const bf16* kr = Pb + (size_t)(kt * 16 + (lane & 15)) * PP + C_IK + (lane >> 4) * 8;
    const bf16x8 a0 = *(const bf16x8*)kr, a1 = *(const bf16x8*)(kr + 32);
    f4 s = (f4){0.f, 0.f, 0.f, 0.f};
#pragma unroll
    for (int h = 0; h < 4; ++h) { f4 t = (f4){0.f, 0.f, 0.f, 0.f};
        t = __builtin_amdgcn_mfma_f32_16x16x32_bf16(a0, qi[h][0], t, 0, 0, 0); t = __builtin_amdgcn_mfma_f32_16x16x32_bf16(a1, qi[h][1], t, 0, 0, 0);
#pragma unroll
        for (int e = 0; e < 4; ++e) s[e] += wq[h] * relu_(t[e]); }
    return s;
}

__device__ __forceinline__ void item(LAS unsigned char* lds0, const int bb, const int qb, const bf16* P, bf16* OB, const int tid0, const int pm) {
    unsigned lb_ = 0u; int tid_l = tid0; asm volatile("" : "+v"(lb_), "+v"(tid_l));
    LAS unsigned char* lds = lds0 + lb_; const int tid = tid_l, lane = tid & 63, wave = __builtin_amdgcn_readfirstlane(tid >> 6);
    const bf16* Pb = P + (size_t)bb * T * PP;
    const int ql = wave * 16 + (lane & 15), tq = qb * 128 + ql, g = lane >> 4;
    const bf16* prow = Pb + (size_t)tq * PP;
    bf16x8 qi[4][2]; float wq[4];
#pragma unroll
    for (int h = 0; h < 4; ++h) { qi[h][0] = *(const bf16x8*)(prow + C_IQ + h * 64 + g * 8); qi[h][1] = *(const bf16x8*)(prow + C_IQ + h * 64 + 32 + g * 8); wq[h] = bf2f(prow[C_IW + h]) * 0.0625f; }
    LAS unsigned* hist = (LAS unsigned*)(lds + O_HIST) + ql * HS;
    const unsigned histb = (unsigned)(size_t)hist;
    const int nkt = (qb + 1) * 8;
    unsigned prefix = 0u; int needk = 256;
#pragma unroll 1
    for (int rr = 0; rr < (pm == 102 ? 2 : 1); ++rr) { prefix = 0u; needk = 256;
#pragma unroll 1
    for (int pass = 0; pass < 3; ++pass) {
        for (int i = lane; i < 16 * HS; i += 64) ((LAS unsigned*)(lds + O_HIST) + wave * 16 * HS)[i] = 0u;
        asm volatile("s_waitcnt lgkmcnt(0)" ::: "memory");
        const int shp = 32 - 8 * pass, shb = 24 - 8 * pass;
        float flo = 0.f, fhi = 0.f;
        if (pass > 0) { const float stepw = (pass == 1) ? 65536.f : 256.f; flo = ((float)prefix * stepw - 2.f) * (1.f / 262144.f) - 32.f; fhi = (((float)prefix + 1.f) * stepw + 2.f) * (1.f / 262144.f) - 32.f; }
        const int nsteps = pm >= 300 ? 0 : nkt >> 2;
#define RDX_DMA(stepi, bufi) do { const int st_ = (stepi) < nsteps ? (stepi) : (nsteps - 1); const int S_ = wave * 64 + lane, r_ = S_ >> 3, p_ = S_ & 7; \
            __builtin_amdgcn_global_load_lds((const unsigned*)(Pb + (size_t)(st_ * 64 + r_) * PP + C_IK + ((p_ ^ (r_ & 7)) << 3)), (LAS unsigned*)(lds + O_V + (bufi) * 8192 + wave * 1024), 16, 0, 0); } while (0)
        asm volatile("s_waitcnt vmcnt(0) lgkmcnt(0)" ::: "memory"); __builtin_amdgcn_s_barrier();
        RDX_DMA(0, 0); RDX_DMA(1, 1); RDX_DMA(2, 2);
        float dummy = 0.f;
        auto steps = [&](auto VARc) { constexpr int VAR = decltype(VARc)::value;
#pragma unroll 1
        for (int stp = 0; stp < nsteps; ++stp) {
            if constexpr (VAR != 4) {
            asm volatile("s_waitcnt vmcnt(2)" ::: "memory");
            __builtin_amdgcn_s_barrier();
            RDX_DMA(stp + 3, (stp + 3) & 3); }
            const unsigned kbr = (unsigned)(O_V + (stp & 3) * 8192);
            const int kt4 = stp * 4;
#pragma unroll
            for (int u = 0; u < 4; ++u) {
                bf16x8 ka0, ka1;
                if constexpr (VAR != 4) { ka0 = *(const LAS bf16x8*)(lds + kbr + (u * 16 + (lane & 15)) * 128 + (((0 + g) ^ (lane & 7)) << 4));
                ka1 = *(const LAS bf16x8*)(lds + kbr + (u * 16 + (lane & 15)) * 128 + (((4 + g) ^ (lane & 7)) << 4)); }
                else { ka0 = qi[u][0]; ka1 = qi[u][1]; }
                f4 s = (f4){0.f, 0.f, 0.f, 0.f};
                if constexpr (VAR == 3) { const f4 ta = __builtin_bit_cast(f4, ka0), tb = __builtin_bit_cast(f4, ka1); s = ta + tb; }
                else {
#pragma unroll
                for (int h = 0; h < 4; ++h) { f4 t = (f4){0.f, 0.f, 0.f, 0.f};
                    if constexpr (VAR == 2) { t = __builtin_bit_cast(f4, h & 1 ? ka1 : ka0); }
                    else { t = __builtin_amdgcn_mfma_f32_16x16x32_bf16(ka0, qi[h][0], t, 0, 0, 0); t = __builtin_amdgcn_mfma_f32_16x16x32_bf16(ka1, qi[h][1], t, 0, 0, 0); }
#pragma unroll
                    for (int e = 0; e < 4; ++e) s[e] += wq[h] * relu_(t[e]); } }
                if constexpr (VAR >= 1 && VAR <= 3) { dummy += s[0] + s[1] + s[2] + s[3]; } else {
                if (pass == 0) {
#pragma unroll
                    for (int e = 0; e < 4; ++e) { const int key = (kt4 + u) * 16 + 4 * g + e;
                        if (key <= tq) { const unsigned bin = okey(s[e]) >> 24; hist_add(histb + ((bin >> 1) << 2), (bin & 1u) ? 0x10000u : 1u); } }
                } else {
#pragma unroll
                    for (int e = 0; e < 4; ++e) { const int key = (kt4 + u) * 16 + 4 * g + e;
                        if (s[e] >= flo && s[e] <= fhi && key <= tq) { const unsigned k32 = okey(s[e]);
                            if ((k32 >> shp) == prefix) { const unsigned bin = (k32 >> shb) & 255u; hist_add(histb + ((bin >> 1) << 2), (bin & 1u) ? 0x10000u : 1u); } } }
                } }
            }
        }
        };
        if (pm == 201) steps(std::integral_constant<int, 1>{}); else if (pm == 202) steps(std::integral_constant<int, 2>{}); else if (pm == 203) steps(std::integral_constant<int, 3>{});
        else if (pm == 204) steps(std::integral_constant<int, 4>{}); else steps(std::integral_constant<int, 0>{});
        if (dummy == 12345.678f) hist_add(histb, 1u);
        asm volatile("s_waitcnt vmcnt(0)" ::: "memory");
#undef RDX_DMA
        asm volatile("s_waitcnt lgkmcnt(0)" ::: "memory");
        int cum = 0; unsigned bsel = 0u; int above = 0;
        for (int wd = 127; wd >= 0; --wd) { const unsigned v = hist[wd]; const int hi = (int)(v >> 16), lo = (int)(v & 0xffffu);
            if (cum + hi >= needk) { bsel = (unsigned)(2 * wd + 1); above = cum; break; } cum += hi;
            if (cum + lo >= needk) { bsel = (unsigned)(2 * wd); above = cum; break; } cum += lo; }
        prefix = (prefix << 8) | bsel; needk -= above;
        asm volatile("s_waitcnt lgkmcnt(0)" ::: "memory");
    }
    }
    if (pm >= 200 && pm < 300) { __syncthreads(); return; }
    unsigned thr = prefix; int need = needk;
    bool tie = false;
    if (tq < 256) { thr = 0u; need = 1 << 20; }
    else { const unsigned v = hist[(prefix & 255u) >> 1]; const int ceq = (prefix & 1u) ? (int)(v >> 16) : (int)(v & 0xffffu); tie = needk < ceq; }
    __syncthreads();
    const bool anytie = __any(tie);
    const float sB = fthr(thr);
    unsigned cn = (unsigned)(need > 0xffff ? 0xffff : need) << 16;
    constexpr int O_TC = O_KB + 2 * KBUF + 2048;
    if (g == 0) { *(LAS unsigned*)(lds + O_TC + ql * 8) = thr; *(LAS unsigned*)(lds + O_TC + ql * 8 + 4) = cn; }
    const int tqmin = qb * 128 + wave * 16;
#pragma unroll
    for (int h = 0; h < 4; ++h) { *(LAS bf16x8*)(lds + O_HIST + wave * 8192 + ((h * 2 + 0) * 64 + lane) * 16) = qi[h][0]; *(LAS bf16x8*)(lds + O_HIST + wave * 8192 + ((h * 2 + 1) * 64 + lane) * 16) = qi[h][1]; }
    constexpr int O_WQ = O_KB + 2 * KBUF;
    if (g == 0) {
#pragma unroll
        for (int h = 0; h < 4; ++h) *(LAS float*)(lds + O_WQ + ((wave * 4 + h) * 16 + (lane & 15)) * 4) = wq[h]; }
    bf16x8 qa[4][2];
#pragma unroll
    for (int h = 0; h < 4; ++h) { qa[h][0] = *(const bf16x8*)(prow + C_BQ + h * 64 + g * 8); qa[h][1] = *(const bf16x8*)(prow + C_BQ + h * 64 + 32 + g * 8); }
    f4 oacc[4][4]; float mrun[4], lrun[4];
#pragma unroll
    for (int h = 0; h < 4; ++h) { mrun[h] = -INFINITY; lrun[h] = 0.f;
#pragma unroll
        for (int dt = 0; dt < 4; ++dt) oacc[h][dt] = (f4){0.f, 0.f, 0.f, 0.f}; }
#pragma unroll 1
    for (int rr = 0; rr < (pm == 103 ? 2 : 1); ++rr) {
#pragma unroll
    for (int h = 0; h < 4; ++h) { mrun[h] = -INFINITY; lrun[h] = 0.f;
#pragma unroll
        for (int dt = 0; dt < 4; ++dt) oacc[h][dt] = (f4){0.f, 0.f, 0.f, 0.f}; }
    const int nst = (qb + 1) * 4;
    const int vkey = tid >> 4, vch = tid & 15;
    u32x4 vpre0 = *(const u32x4*)(Pb + (size_t)vkey * PP + C_BV + vch * 8), vpre1 = *(const u32x4*)(Pb + (size_t)vkey * PP + C_BV + 128 + vch * 8);
    const unsigned vrd = (unsigned)(unsigned long)lds + (unsigned)(O_V + (4 * g + ((lane >> 2) & 3)) * (VS * 2) + (lane & 3) * 8);
    __syncthreads();
    const int kr_ = 2 * wave + (lane >> 5), kir_ = wave * 8 + (lane >> 3);
    const bf16* kbase = Pb + (size_t)kr_ * PP + C_BK + (((lane & 31) ^ (kr_ & 15)) << 3);
    const bf16* kibase = Pb + (size_t)kir_ * PP + C_IK + (((lane & 7) ^ (kir_ & 7)) << 3);
#define K_DMA(key_first, kbo) do { const bf16* s0_ = kbase + (size_t)(key_first) * PP; \
        __builtin_amdgcn_global_load_lds((const unsigned*)s0_, (LAS unsigned*)(lds + (kbo) + wave * 1024), 16, 0, 0); \
        __builtin_amdgcn_global_load_lds((const unsigned*)(s0_ + (size_t)16 * PP), (LAS unsigned*)(lds + (kbo) + (wave + 8) * 1024), 16, 0, 0); \
        if (wave < 4) __builtin_amdgcn_global_load_lds((const unsigned*)(kibase + (size_t)(key_first) * PP), (LAS unsigned*)(lds + (kbo) + 16384 + wave * 1024), 16, 0, 0); } while (0)
    K_DMA(0, (unsigned)O_KB);
#pragma unroll 1
    for (int st = 0; st < nst; ++st) {
        const int key0 = st * 32; const unsigned vbuf = (unsigned)(st & 1) * (32 * VS * 2);
        unsigned qio = (unsigned)(O_HIST + wave * 8192 + lane * 16); asm volatile("" : "+v"(qio));
        unsigned wqo = (unsigned)(O_WQ + wave * 256 + (lane & 15) * 4); asm volatile("" : "+v"(wqo));
        unsigned tco = (unsigned)(O_TC + (wave * 16 + (lane & 15)) * 8); asm volatile("" : "+v"(tco));
        { LAS bf16* VL = (LAS bf16*)(lds + O_V + vbuf); *(LAS u32x4*)(VL + vkey * VS + vch * 8) = vpre0; *(LAS u32x4*)(VL + vkey * VS + 128 + vch * 8) = vpre1; }
        asm volatile("s_waitcnt vmcnt(0)" ::: "memory");
        __syncthreads();
        if (st + 1 < nst) K_DMA(key0 + 32, (unsigned)(O_KB + ((st + 1) & 1) * KBUF));
        const unsigned kbc = (unsigned)(O_KB + (st & 1) * KBUF);
#define KQ_(h, k2, ks) (*(const LAS bf16x8*)(lds + kbc + (k2 * 16 + (lane & 15)) * 512 + ((((h) * 8 + (ks) * 4 + g) ^ (lane & 15)) << 4)))
#define KI_(k2, ks) (*(const LAS bf16x8*)(lds + kbc + 16384 + (k2 * 16 + (lane & 15)) * 128 + ((((ks) * 4 + g) ^ (lane & 7)) << 4)))
        const bool active = key0 <= tqmin + 15;
        bool sel[2][4] = {{false, false, false, false}, {false, false, false, false}};
        if (active && pm == 305) {
#pragma unroll
            for (int k2 = 0; k2 < 2; ++k2)
#pragma unroll
                for (int e = 0; e < 4; ++e) sel[k2][e] = (key0 + k2 * 16 + 4 * g + e) <= tq;
        } else if (active) {
            unsigned eqm = 0u;
            const bool plain = !anytie && key0 + 31 <= tqmin;
#pragma unroll
            for (int k2 = 0; k2 < 2; ++k2) { f4 s = (f4){0.f, 0.f, 0.f, 0.f};
#pragma unroll
                for (int h = 0; h < 4; ++h) { f4 t = (f4){0.f, 0.f, 0.f, 0.f};
                    const bf16x8 qh0 = *(const LAS bf16x8*)(lds + qio + ((h * 2 + 0) * 64) * 16), qh1 = *(const LAS bf16x8*)(lds + qio + ((h * 2 + 1) * 64) * 16);
                    t = __builtin_amdgcn_mfma_f32_16x16x32_bf16(KI_(k2, 0), qh0, t, 0, 0, 0); t = __builtin_amdgcn_mfma_f32_16x16x32_bf16(KI_(k2, 1), qh1, t, 0, 0, 0);
                    const float wqh = *(const LAS float*)(lds + wqo + h * 64);
#pragma unroll
                    for (int e = 0; e < 4; ++e) s[e] += wqh * relu_(t[e]); }
                if (plain) {
#pragma unroll
                    for (int e = 0; e < 4; ++e) sel[k2][e] = s[e] >= sB;
                } else {
                    const unsigned thr_ = *(const LAS unsigned*)(lds + tco);
#pragma unroll
                    for (int e = 0; e < 4; ++e) { const int key = key0 + k2 * 16 + 4 * g + e, tq_ = tqmin + (lane & 15); const unsigned k24 = (unsigned)qkey(s[e]);
                        sel[k2][e] = (key <= tq_) & (k24 > thr_); if ((key <= tq_) & (k24 == thr_)) eqm |= 1u << (k2 * 4 + e); }
                } }
            if (!plain) {
                if (anytie && __any(eqm != 0u)) {
                    const unsigned pk = (unsigned)__popc(eqm & 15u) | ((unsigned)__popc(eqm >> 4) << 8);
                    const unsigned p0 = (unsigned)__shfl((int)pk, lane & 15), p1 = (unsigned)__shfl((int)pk, (lane & 15) + 16), p2 = (unsigned)__shfl((int)pk, (lane & 15) + 32), p3 = (unsigned)__shfl((int)pk, (lane & 15) + 48);
                    const unsigned tot = p0 + p1 + p2 + p3, below = (g > 0 ? p0 : 0u) + (g > 1 ? p1 : 0u) + (g > 2 ? p2 : 0u);
                    const unsigned cn_ = *(const LAS unsigned*)(lds + tco + 4); const int cnt = (int)(cn_ & 0xffffu), need_ = (int)(cn_ >> 16); const int base0 = cnt + (int)(below & 255u), base1 = cnt + (int)(tot & 255u) + (int)(below >> 8);
#pragma unroll
                    for (int k2 = 0; k2 < 2; ++k2)
#pragma unroll
                        for (int e = 0; e < 4; ++e) { const unsigned bit = 1u << (k2 * 4 + e);
                            const int rank = (k2 ? base1 : base0) + __popc(eqm & (bit - 1u) & (k2 ? 0xf0u : 0x0fu));
                            sel[k2][e] = sel[k2][e] | (((eqm & bit) != 0u) & (rank < need_)); }
                    *(LAS unsigned*)(lds + tco + 4) = cn_ + (tot & 255u) + (tot >> 8);
                } else {
#pragma unroll
                    for (int k2 = 0; k2 < 2; ++k2)
#pragma unroll
                        for (int e = 0; e < 4; ++e) sel[k2][e] = sel[k2][e] | ((eqm & (1u << (k2 * 4 + e))) != 0u);
                }
            }
        }
#pragma unroll
        for (int h = 0; h < 4; ++h) {
            if (h == 2 && st + 1 < nst) { vpre0 = *(const u32x4*)(Pb + (size_t)(key0 + 32 + vkey) * PP + C_BV + vch * 8); vpre1 = *(const u32x4*)(Pb + (size_t)(key0 + 32 + vkey) * PP + C_BV + 128 + vch * 8); }
            if (active) {
            f4 sc[2];
#pragma unroll
            for (int k2 = 0; k2 < 2; ++k2) { f4 t = (f4){0.f, 0.f, 0.f, 0.f};
                t = __builtin_amdgcn_mfma_f32_16x16x32_bf16(KQ_(h, k2, 0), qa[h][0], t, 0, 0, 0); t = __builtin_amdgcn_mfma_f32_16x16x32_bf16(KQ_(h, k2, 1), qa[h][1], t, 0, 0, 0);
#pragma unroll
                for (int e = 0; e < 4; ++e) sc[k2][e] = sel[k2][e] ? t[e] * (0.125f * 1.4426950408889634f) : -INFINITY; }
            float mx = fmaxf(fmaxf(fmaxf(sc[0][0], sc[0][1]), fmaxf(sc[0][2], sc[0][3])), fmaxf(fmaxf(sc[1][0], sc[1][1]), fmaxf(sc[1][2], sc[1][3])));
            mx = fmaxf(mx, __shfl_xor(mx, 16)); mx = fmaxf(mx, __shfl_xor(mx, 32));
            const float mnew = fmaxf(mrun[h], mx), msafe = (mnew == -INFINITY) ? 0.f : mnew;
            const bool resc = __any(mnew != mrun[h]);
            const float corr = __builtin_amdgcn_exp2f(mrun[h] - msafe); mrun[h] = mnew;
            float p[8]; float ps = 0.f;
#pragma unroll
            for (int e = 0; e < 4; ++e) { p[e] = __builtin_amdgcn_exp2f(sc[0][e] - msafe); p[4 + e] = __builtin_amdgcn_exp2f(sc[1][e] - msafe); ps += p[e] + p[4 + e]; }
            lrun[h] = lrun[h] * corr + ps;
            union { bf16x8 v; unsigned u[4]; } pb;
            pb.u[0] = pg8::cvt_pk_bf16(p[0], p[1]); pb.u[1] = pg8::cvt_pk_bf16(p[2], p[3]); pb.u[2] = pg8::cvt_pk_bf16(p[4], p[5]); pb.u[3] = pg8::cvt_pk_bf16(p[6], p[7]);
            union { bf16x8 v; u32x2 h2[2]; } vf[4];
            const unsigned va = vrd + vbuf + (unsigned)(h * 128);
            asm volatile("ds_read_b64_tr_b16 %0, %8\n\tds_read_b64_tr_b16 %1, %8 offset:%9\n\tds_read_b64_tr_b16 %2, %8 offset:32\n\tds_read_b64_tr_b16 %3, %8 offset:%10\n\t"
                         "ds_read_b64_tr_b16 %4, %8 offset:64\n\tds_read_b64_tr_b16 %5, %8 offset:%11\n\tds_read_b64_tr_b16 %6, %8 offset:96\n\tds_read_b64_tr_b16 %7, %8 offset:%12\n\ts_waitcnt lgkmcnt(0)"
                         : "=&v"(vf[0].h2[0]), "=&v"(vf[0].h2[1]), "=&v"(vf[1].h2[0]), "=&v"(vf[1].h2[1]), "=&v"(vf[2].h2[0]), "=&v"(vf[2].h2[1]), "=&v"(vf[3].h2[0]), "=&v"(vf[3].h2[1])
                         : "v"(va), "i"(16 * VS * 2), "i"(16 * VS * 2 + 32), "i"(16 * VS * 2 + 64), "i"(16 * VS * 2 + 96) : "memory");
            __builtin_amdgcn_sched_barrier(0);
            if (resc) {
#pragma unroll
                for (int dt = 0; dt < 4; ++dt) oacc[h][dt] = oacc[h][dt] * corr; }
#pragma unroll
            for (int dt = 0; dt < 4; ++dt) oacc[h][dt] = __builtin_amdgcn_mfma_f32_16x16x32_bf16(vf[dt].v, pb.v, oacc[h][dt], 0, 0, 0);
            }
        }
    }
    __syncthreads();
    }
#undef KQ_
#undef KI_
#undef K_DMA
    const size_t m = (size_t)bb * T + tqmin + (lane & 15);
    if (pm < 300)
#pragma unroll
    for (int h = 0; h < 4; ++h) { float l = lrun[h]; l += __shfl_xor(l, 16); l += __shfl_xor(l, 32); const float inv = 1.f / l;
#pragma unroll
        for (int dt = 0; dt < 4; ++dt) { u32x2 w; w.x = pk2(oacc[h][dt][0] * inv, oacc[h][dt][1] * inv); w.y = pk2(oacc[h][dt][2] * inv, oacc[h][dt][3] * inv);
            *(u32x2*)(OB + m * 1024 + 256 + h * 64 + dt * 16 + 4 * g) = w; } }
    __syncthreads();
}
}

namespace awin {
typedef short bf16x8 __attribute__((ext_vector_type(8)));
typedef float f4 __attribute__((ext_vector_type(4)));
constexpr int EXS = 66;
constexpr int O_EX = 0;
constexpr int VSW = 72;
constexpr int O_VW = 101376;
__device__ __forceinline__ void item(LAS unsigned char* lds0, const int bb, const int blk, const int h, const bf16* P, bf16* OB, const int tid0) {
    unsigned lb_ = 0u; int tid_l = tid0; asm volatile("" : "+v"(lb_), "+v"(tid_l));
    LAS unsigned char* lds = lds0 + lb_; const int tid = tid_l, lane = tid & 63, wave = __builtin_amdgcn_readfirstlane(tid >> 6);
    const bf16* Pb = P + (size_t)bb * T * PP; const int start = blk * 128, g = lane >> 4, ln = lane & 15;
    LAS float* EX = (LAS float*)(lds + O_EX);
    LAS bf16* VW = (LAS bf16*)(lds + O_VW + wave * 4608);
#pragma unroll 1
    for (int s4 = 0; s4 < 4; ++s4) {
        const int st = wave * 4 + s4;
        const int grp = st < 8 ? 0 : (st < 16 ? 1 : 2);
        const int dil = grp == 0 ? 1 : (grp == 1 ? 4 : 16), win = grp == 0 ? 128 : (grp == 1 ? 512 : 2048);
        const int r = grp == 0 ? 0 : (grp == 1 ? ((st - 8) >> 1) : (st - 16)), a0 = grp == 0 ? 16 * st : (grp == 1 ? ((st - 8) & 1) * 16 : 0), nqc = grp == 0 ? 128 : (grp == 1 ? 32 : 8);
        const int a = a0 + ln; const bool qok = a < nqc; const int ql = (qok ? a : (nqc - 1)) * dil + r, tq = start + ql;
        const bf16* qp = Pb + (size_t)tq * PP + C_AQ + grp * 256 + h * 64 + g * 8;
        const bf16x8 q0 = *(const bf16x8*)qp, q1 = *(const bf16x8*)(qp + 32);
        bf16x8 kf[10][2];
#pragma unroll
        for (int kt = 0; kt < 10; ++kt) { int pos = start - win + (a0 + 16 * kt + ln) * dil + r; pos = pos < 0 ? 0 : (pos > T - 1 ? T - 1 : pos);
            const bf16* kp = Pb + (size_t)pos * PP + C_AK + grp * 256 + h * 64 + g * 8; kf[kt][0] = *(const bf16x8*)kp; kf[kt][1] = *(const bf16x8*)(kp + 32); }
        f4 sc[10]; float mx = -INFINITY;
#pragma unroll
        for (int kt = 0; kt < 10; ++kt) { f4 t = (f4){0.f, 0.f, 0.f, 0.f};
            t = __builtin_amdgcn_mfma_f32_16x16x32_bf16(kf[kt][0], q0, t, 0, 0, 0); t = __builtin_amdgcn_mfma_f32_16x16x32_bf16(kf[kt][1], q1, t, 0, 0, 0);
#pragma unroll
            for (int e = 0; e < 4; ++e) { const int c = a0 + 16 * kt + 4 * g + e; const int pos = start - win + c * dil + r;
                const bool ok = qok && c >= a && c <= a + 128 && pos >= 0;
                sc[kt][e] = ok ? t[e] * 0.125f : -INFINITY; mx = fmaxf(mx, sc[kt][e]); } }
        mx = fmaxf(mx, __shfl_xor(mx, 16)); mx = fmaxf(mx, __shfl_xor(mx, 32));
        const float msafe = (mx == -INFINITY) ? 0.f : mx; float lsum = 0.f;
#pragma unroll
        for (int kt = 0; kt < 10; ++kt)
#pragma unroll
            for (int e = 0; e < 4; ++e) { sc[kt][e] = __expf(sc[kt][e] - msafe); lsum += sc[kt][e]; }
        lsum += __shfl_xor(lsum, 16); lsum += __shfl_xor(lsum, 32);
        f4 oacc[4];
#pragma unroll
        for (int dt = 0; dt < 4; ++dt) oacc[dt] = (f4){0.f, 0.f, 0.f, 0.f};
#pragma unroll
        for (int s5 = 0; s5 < 5; ++s5) {
            int pos = start - win + (a0 + 32 * s5 + (lane >> 1)) * dil + r; pos = pos < 0 ? 0 : (pos > T - 1 ? T - 1 : pos);
            const u32x4* vp = (const u32x4*)(Pb + (size_t)pos * PP + C_AV + grp * 256 + h * 64 + (lane & 1) * 32);
            const u32x4 v0 = vp[0], v1 = vp[1], v2 = vp[2], v3 = vp[3];
            LAS u32x4* vd = (LAS u32x4*)(VW + (lane >> 1) * VSW + (lane & 1) * 32);
            asm volatile("s_waitcnt lgkmcnt(0)" ::: "memory");
            vd[0] = v0; vd[1] = v1; vd[2] = v2; vd[3] = v3;
            asm volatile("s_waitcnt lgkmcnt(0)" ::: "memory");
            bf16x8 pb;
#pragma unroll
            for (int e = 0; e < 4; ++e) { pb[e] = (short)f2bf(sc[2 * s5][e]); pb[4 + e] = (short)f2bf(sc[2 * s5 + 1][e]); }
#pragma unroll
            for (int dt = 0; dt < 4; ++dt) { bf16x8 vf; const LAS bf16* vb = VW + (4 * g) * VSW + dt * 16 + ln;
#pragma unroll
                for (int e = 0; e < 4; ++e) { vf[e] = (short)vb[e * VSW]; vf[4 + e] = (short)vb[(16 + e) * VSW]; }
                oacc[dt] = __builtin_amdgcn_mfma_f32_16x16x32_bf16(vf, pb, oacc[dt], 0, 0, 0); }
        }
        if (qok) { LAS float* ex = EX + (grp * 128 + ql) * EXS;
#pragma unroll
            for (int dt = 0; dt < 4; ++dt) { ex[dt * 16 + 4 * g + 0] = oacc[dt][0]; ex[dt * 16 + 4 * g + 1] = oacc[dt][1]; ex[dt * 16 + 4 * g + 2] = oacc[dt][2]; ex[dt * 16 + 4 * g + 3] = oacc[dt][3]; }
            if (g == 0) { ex[64] = mx; ex[65] = lsum; } }
    }
    __syncthreads();
    { const int ql = tid >> 2, d0 = (tid & 3) * 16;
      const LAS float* e0 = EX + (0 * 128 + ql) * EXS; const LAS float* e1 = EX + (1 * 128 + ql) * EXS; const LAS float* e2 = EX + (2 * 128 + ql) * EXS;
      const float m0 = e0[64], m1 = e1[64], m2 = e2[64], M = fmaxf(m0, fmaxf(m1, m2));
      const float w0 = __expf(m0 - M), w1 = __expf(m1 - M), w2 = __expf(m2 - M); const float inv = 1.f / (w0 * e0[65] + w1 * e1[65] + w2 * e2[65]);
      unsigned pk[8];
#pragma unroll
      for (int j = 0; j < 8; ++j) { const float x0 = (w0 * e0[d0 + 2 * j] + w1 * e1[d0 + 2 * j] + w2 * e2[d0 + 2 * j]) * inv, x1 = (w0 * e0[d0 + 2 * j + 1] + w1 * e1[d0 + 2 * j + 1] + w2 * e2[d0 + 2 * j + 1]) * inv; pk[j] = pk2(x0, x1); }
      u32x4* op = (u32x4*)(OB + ((size_t)bb * T + start + ql) * 1024 + h * 64 + d0);
      op[0] = (u32x4){pk[0], pk[1], pk[2], pk[3]}; op[1] = (u32x4){pk[4], pk[5], pk[6], pk[7]}; }
    __syncthreads();
}
}

template <int SP>
__device__ __forceinline__ void phase_body(const int l_in, LAS unsigned char* lds) {
    int tid_ = threadIdx.x, bid_ = blockIdx.x, l_ = l_in, G_ = gridDim.x; asm volatile("" : "+v"(tid_), "+s"(bid_), "+s"(l_), "+s"(G_));
    const int tid = tid_, lane = tid & 63, wave = __builtin_amdgcn_readfirstlane(tid >> 6), l = l_;
    const int G = G_, bid = bid_;
    const int gw = bid * NWAVES + wave, NGW = G * NWAVES;
    unsigned char* ws = (unsigned char*)gptr(ldptr(lds, 36));
    int* ctl = (int*)(ws + WS_CTL);
    bf16* XB = (bf16*)(ws + WS_XB); bf16* OB = (bf16*)(ws + WS_O); bf16* VF = (bf16*)(ws + WS_VF); bf16* P = (bf16*)(ws + WS_P);
    bf16* GS = (bf16*)(ws + WS_GS); bf16* MG = (bf16*)(ws + WS_MERGED); bf16* XS = (bf16*)(ws + WS_XS); bf16* HB = (bf16*)(ws + WS_H);
    bf16* WGU = (bf16*)(ws + WS_WGU); bf16* WD = (bf16*)(ws + WS_WD);
    float* X = (float*)gptr(ldptr(lds, 35));
    int* tok_e = (int*)(ws + WS_ROUTE); float* tok_g = (float*)(ws + WS_ROUTE + 256 * 1024); int* tok_rank = (int*)(ws + WS_ROUTE + 512 * 1024); int* tok_slot = (int*)(ws + WS_ROUTE + 768 * 1024);
    (void)ctl; (void)XB; (void)OB; (void)VF; (void)P; (void)GS; (void)MG; (void)XS; (void)HB; (void)WGU; (void)WD; (void)X; (void)tok_e; (void)tok_g; (void)tok_rank; (void)tok_slot; (void)gw; (void)NGW; (void)lane;
    {
        bf16* WinT = (bf16*)(ws + WS_WINT) + (size_t)l * 5120 * 1024; bf16* WgT = (bf16*)(ws + WS_WGT) + (size_t)l * 4096 * 1024;
        bf16* WbrT = (bf16*)(ws + WS_WBRT) + (size_t)l * 1024 * 1024; bf16* WoutT = (bf16*)(ws + WS_WOUTT) + (size_t)l * 1024 * 1024;
        float* WrT = (float*)(ws + WS_WRT) + (size_t)l * 36 * 1024;
        int* cnt = ctl + CW_CNT + l * 64;

        if constexpr (SP == -1) {
            LAS float* scr = (LAS float*)(lds + wave * 16384);
#pragma unroll 1
            for (int job = 0; job < NL * 11; ++job) {
                const int ll = job / 11, jk = job % 11;
                if (jk < 5) {
                    const float* W = INP(I_WIN) + (size_t)ll * 1024 * INW;
                    const int sc0 = jk == 0 ? 0 : (jk == 1 ? 3396 : (jk == 2 ? 3392 : (jk == 3 ? 5060 : 5064)));
                    const int snc = jk == 0 ? 3392 : (jk == 1 ? 1664 : (jk == 4 ? 4096 : 4));
                    const int sr0 = jk == 0 ? 0 : (jk == 1 ? 3392 : (jk == 2 ? 5056 : (jk == 3 ? 5060 : 0)));
                    bf16* dst = jk == 4 ? (bf16*)(ws + WS_WGT) + (size_t)ll * 4096 * 1024 : (bf16*)(ws + WS_WINT) + (size_t)ll * 5120 * 1024;
                    const int nbn = (snc + 31) / 32, nit = 16 * nbn;
#pragma unroll 1
                    for (int it = gw; it < nit; it += NGW) transpose_item(W, INW, sc0, snc, dst, 1024, sr0, 0, it / nbn, it % nbn, scr, lane);
                } else if (jk < 9) {
                    const int n = jk - 5; const float* Wb = INP(I_WBR) + ((size_t)ll * 4 + n) * 256 * 1024;
#pragma unroll 1
                    for (int it = gw; it < 4 * 32; it += NGW) transpose_item(Wb, 1024, 0, 1024, (bf16*)(ws + WS_WBRT) + (size_t)ll * 1024 * 1024, 1024, 0, n * 256, it / 32, it % 32, scr, lane);
                } else if (jk == 9) {
                    const float* Wo = INP(I_WOUT) + (size_t)ll * 1024 * 1024;
#pragma unroll 1
                    for (int it = gw; it < 16 * 32; it += NGW) transpose_item(Wo, 1024, 0, 1024, (bf16*)(ws + WS_WOUTT) + (size_t)ll * 1024 * 1024, 1024, 0, 0, it / 32, it % 32, scr, lane);
                } else {
                    bf16* wi = (bf16*)(ws + WS_WINT) + (size_t)ll * 5120 * 1024;
#pragma unroll 1
                    for (int i = gw * 64 + lane; i < 56 * 1024 / 8; i += NGW * 64) ((u32x4*)(wi + (size_t)5064 * 1024))[i] = (u32x4){0u, 0u, 0u, 0u};
                    float* wr = (float*)(ws + WS_WRT) + (size_t)ll * 36 * 1024; const float* rg = INP(I_RG) + (size_t)ll * 1024 * 4; const float* re = INP(I_RE) + (size_t)ll * 1024 * 32;
#pragma unroll 1
                    for (int i = gw * 64 + lane; i < 36 * 1024; i += NGW * 64) { const int o = i / 1024, k = i % 1024; wr[i] = o < 4 ? rg[k * 4 + o] : re[k * 32 + (o - 4)]; }
                }
            }
            for (int m = gw; m < M; m += NGW) {
                const f32x4* xr = (const f32x4*)(INP(I_X) + (size_t)m * D) + lane;
#pragma unroll
                for (int j = 0; j < 4; ++j) { const f32x4 v = xr[64 * j]; ((f32x4*)(X + (size_t)m * D))[lane + 64 * j] = v;
                    u32x2 w; w.x = pk2(v[0], v[1]); w.y = pk2(v[2], v[3]); ((u32x2*)(XB + (size_t)m * D))[lane + 64 * j] = w; }
            }
        }
        else if constexpr (SP == 0) {
            pg8::Gemm g{XB, WinT, 1024, 1024, 1024}; pg8::StaticOrder S; S.init(M, PP, G, bid, 1024, 1024);
            EpiStoreBf16 E{P, PP, 0, PP};
            pg8::gemm_phase<EpiStoreBf16, pg8::StaticOrder>(lds, g, S, E);
        }
        else if constexpr (SP == 12) {
            if (bid < 32) rw::carry(lds, ws + WS_RW + (size_t)bid * 64 * 16384, tid);
        }
        else if constexpr (SP == 13) {
            unsigned char* GZ = ws + WS_RW;
            const int h = bid & 3, k = bid >> 2;
            rw::build_ct(lds, l, h, lane, wave); __syncthreads();
#pragma unroll 1
            for (int idx = k; idx < 512; idx += (G >> 2)) { const int b = idx >> 6, cI = idx & 63; const size_t ci_ = (size_t)((b * 4 + h) * 64 + cI);
                rw::chunk_out(lds, b, h, cI * 64, GZ + ci_ * 16384, ws + WS_RW2 + ci_ * 24576, (const float*)(ws + WS_BONG) + ci_ * 64, VF, OB, tid); }
        }
        else if constexpr (SP == 15 || SP == 19) {
            unsigned char* GZ = ws + WS_RW;
            int* qctr = ctl + CW_Q + l * 64 + (SP == 19 ? 16 : 0);
            int cur_h = -1;
#pragma unroll 1
            for (;;) {
                unsigned so = (unsigned)(LDS_BYTES - 584); asm volatile("" : "+v"(so));
                volatile LAS int* slot = (volatile LAS int*)(lds + so);
                int tid = threadIdx.x; asm volatile("" : "+v"(tid));
                const int lane = tid & 63, wave = __builtin_amdgcn_readfirstlane(tid >> 6);
                __syncthreads();
                if (tid == 0) *slot = atomicAdd(qctr, 1);
                __syncthreads();
                const int it = __builtin_amdgcn_readfirstlane(*slot);
                if (it >= 3344) break;
                if (it < 16) { mb::chain(lds, l, it >> 1, it & 1, P, OB, tid, lane, wave); }
                else if (it < 272) { const int j = it - 16; bsp::item(lds, j & 7, 31 - (j >> 3), P, OB, tid, (int)(unsigned)ldptr(lds, 37)); }
                else if (it < 2320) { const int j = it - 272, h = j >> 9, idx = j & 511, b = idx >> 6, cI = idx & 63;
                    if (h != cur_h) { rw::build_ct(lds, l, h, lane, wave); cur_h = h; __syncthreads(); }
                    { const size_t ci_ = (size_t)((b * 4 + h) * 64 + cI); rw::chunk<(SP == 19 ? 5 : 1)>(lds, l, b, h, cI * 64, GZ + ci_ * 16384, ws + WS_RW2 + ci_ * 24576, (float*)(ws + WS_BONG) + ci_ * 64, P, VF, OB, tid); } }
                else { const int j = it - 2320; awin::item(lds, j >> 7, (j >> 2) & 31, j & 3, P, OB, tid); }
            }
        }
        else if constexpr (SP == 17 || SP == 18) {
            unsigned char* GZ = ws + WS_RW; int cur_h = -1;
#pragma unroll 1
            for (int k = 0; k < 8; ++k) { const int j = bid + 256 * k, h = j >> 9, idx = j & 511, b = idx >> 6, cI = idx & 63;
                if (h != cur_h) { rw::build_ct(lds, l, h, lane, wave); cur_h = h; __syncthreads(); }
                const size_t ci_ = (size_t)((b * 4 + h) * 64 + cI); rw::chunk<(SP == 17 ? 5 : 6)>(lds, l, b, h, cI * 64, GZ + ci_ * 16384, ws + WS_RW2 + ci_ * 24576, (float*)(ws + WS_BONG) + ci_ * 64, P, VF, OB, tid); }
        }
        else if constexpr (SP == 16) {
            bsp::item(lds, bid & 7, 31 - (bid >> 3), P, OB, tid, (int)(unsigned)ldptr(lds, 37) == 125 ? 300 : ((int)(unsigned)ldptr(lds, 37) == 126 ? 305 : (int)(unsigned)ldptr(lds, 37) + 80));
        }
        else if constexpr (SP == 4) {
            if (bid < 32) { rw::carry(lds, ws + WS_RW + (size_t)bid * 64 * 16384, tid); __syncthreads(); }
            pg8::Gemm g{XB, WgT, 1024, 1024, 1024}; SkewOrder S{M / 256, 16, (M / 256) * 16, bid, 1024, 1024};
            EpiStoreBf16 E{GS, 4096, 1, 4096};
            pg8::gemm_phase<EpiStoreBf16, SkewOrder>(lds, g, S, E);
        }
        else if constexpr (SP == 5) {
            pg8::Gemm g{OB, WbrT, 1024, 1024, 256}; BranchOrder S{M / 256, 4, G, bid};
            EpiBranch E{GS, MG};
            pg8::gemm_phase<EpiBranch, BranchOrder>(lds, g, S, E);
        }
        else if constexpr (SP == 6) {
            pg8::Gemm g{MG, WoutT, 1024, 1024, 1024}; pg8::StaticOrder S; S.init(M, 1024, G, bid, 1024, 1024);
            EpiResid E{X};
            pg8::gemm_phase<EpiResid, pg8::StaticOrder>(lds, g, S, E);
        }
        else if constexpr (SP == 7) {
            const float* g1 = INP(I_LN1G) + l * 1024; const float* b1 = INP(I_LN1B) + l * 1024;
            const float* rgb = INP(I_RGB) + l * 4; const float* reb = INP(I_REB) + l * 32;
            f32x4 vn[4];
#pragma unroll
            for (int j = 0; j < 4; ++j) vn[j] = ((const f32x4*)(X + (size_t)gw * D))[lane + 64 * j];
#pragma unroll 1
            for (int m = gw; m < M; m += NGW) {
                f32x4 v[4]; float s = 0.f; f32x4* xr = (f32x4*)(X + (size_t)m * D) + lane;
#pragma unroll
                for (int j = 0; j < 4; ++j) { v[j] = vn[j]; s += (v[j][0] + v[j][1]) + (v[j][2] + v[j][3]); }
                { const int mnx = (m + NGW < M) ? m + NGW : m;
#pragma unroll
                  for (int j = 0; j < 4; ++j) vn[j] = ((const f32x4*)(X + (size_t)mnx * D))[lane + 64 * j]; }
                const float mean = wave_sum(s) * (1.f / D); float s2 = 0.f;
#pragma unroll
                for (int j = 0; j < 4; ++j) { v[j] = v[j] - mean; s2 += (v[j][0] * v[j][0] + v[j][1] * v[j][1]) + (v[j][2] * v[j][2] + v[j][3] * v[j][3]); }
                const float rstd = rsqrtf(wave_sum(s2) * (1.f / D) + LN_EPS);
#pragma unroll
                for (int j = 0; j < 4; ++j) { const f32x4 gg = ((const f32x4*)g1)[lane + 64 * j], bb = ((const f32x4*)b1)[lane + 64 * j]; v[j] = v[j] * rstd * gg + bb; xr[64 * j] = v[j];
                    u32x2 w; w.x = pk2(v[j][0], v[j][1]); w.y = pk2(v[j][2], v[j][3]); ((u32x2*)(XB + (size_t)m * D))[lane + 64 * j] = w; }
                float mylg = 0.f;
#pragma unroll 1
                for (int o4 = 0; o4 < 36; o4 += 4) { float a4[4];
#pragma unroll
                    for (int u = 0; u < 4; ++u) { float a = 0.f;
#pragma unroll
                        for (int j = 0; j < 4; ++j) { const f32x4 wv = ((const f32x4*)(WrT + (o4 + u) * 1024))[lane + 64 * j]; a += v[j][0] * wv[0] + v[j][1] * wv[1] + v[j][2] * wv[2] + v[j][3] * wv[3]; }
                        a4[u] = a; }
#pragma unroll
                    for (int sft = 1; sft < 64; sft <<= 1) {
#pragma unroll
                        for (int u = 0; u < 4; ++u) a4[u] += __shfl_xor(a4[u], sft); }
#pragma unroll
                    for (int u = 0; u < 4; ++u) mylg = (lane == o4 + u) ? a4[u] : mylg; }
                mylg += lane < 4 ? rgb[lane & 3] : (lane < 36 ? reb[(lane - 4) & 31] : 0.f);
                float gl[4]; float gm = -INFINITY; int gs = 0;
#pragma unroll
                for (int o = 0; o < 4; ++o) { gl[o] = __shfl(mylg, o); if (gl[o] > gm) { gm = gl[o]; gs = o; } }
                float gden = 0.f;
#pragma unroll
                for (int o = 0; o < 4; ++o) gden += __expf(gl[o] - gm);
                const float pg = 1.f / gden;
                float el[8];
#pragma unroll
                for (int o = 0; o < 8; ++o) el[o] = __shfl(mylg, 4 + gs * 8 + o);
                int e1 = 0; float m1 = el[0];
#pragma unroll
                for (int o = 1; o < 8; ++o) if (el[o] > m1) { m1 = el[o]; e1 = o; }
                int e2 = -1; float m2 = -INFINITY;
#pragma unroll
                for (int o = 0; o < 8; ++o) if (o != e1 && el[o] > m2) { m2 = el[o]; e2 = o; }
                const float r2 = __expf(m2 - m1); const float ga = pg / (1.f + r2), gb = pg * r2 / (1.f + r2);
                if (lane == 0) {
                    const int E1 = gs * 8 + e1, E2 = gs * 8 + e2;
                    tok_e[m * 2] = E1; tok_e[m * 2 + 1] = E2; tok_g[m * 2] = ga; tok_g[m * 2 + 1] = gb;
                    tok_rank[m * 2] = atomicAdd(&cnt[E1], 1); tok_rank[m * 2 + 1] = atomicAdd(&cnt[E2], 1);
                }
            }
        }
        else if constexpr (SP == 14) {
            LAS float* scr = (LAS float*)(lds + wave * 16384);
            const float* eg = INP(I_EG) + (size_t)l * NEXP * 1024 * 512; const float* eu = INP(I_EU) + (size_t)l * NEXP * 1024 * 512; const float* ed = INP(I_ED) + (size_t)l * NEXP * 512 * 1024;
            for (int it = gw; it < NEXP * 2 * 4 * 64; it += NGW) {
                const int e = it / 512, r = it % 512, half = r / 256, ct = (r % 256) / 64, q = r % 64, kb = q / 4, nb = q % 4;
                const float* W = (half ? eu : eg) + (size_t)e * 1024 * 512;
                transpose_item(W, 512, ct * 128, 128, WGU + (size_t)e * 1024 * 1024, 1024, ct * 256 + half * 128, 0, kb, nb, scr, lane);
            }
            for (int it = gw; it < NEXP * 8 * 32; it += NGW) {
                const int e = it / 256, q = it % 256, kb = q / 32, nb = q % 32;
                transpose_item(ed + (size_t)e * 512 * 1024, 1024, 0, 1024, WD + (size_t)e * 1024 * 512, 512, 0, 0, kb, nb, scr, lane);
            }
        }
        else if constexpr (SP == 8 || SP == 9 || SP == 10) {
            unsigned tbo = MISC_OFF; asm volatile("" : "+v"(tbo));
            volatile LAS int* tb = (volatile LAS int*)(lds + tbo);
            if (tid == 0) { int acc = 0; for (int e = 0; e < 32; ++e) { const int c = __hip_atomic_load(&cnt[e], __ATOMIC_RELAXED, __HIP_MEMORY_SCOPE_AGENT); tb[e] = acc; tb[33 + e] = acc; acc += (c + 255) >> 8; } tb[32] = acc; }
            __syncthreads();
            if constexpr (SP == 8) {
                for (int m = gw; m < M; m += NGW) {
#pragma unroll
                    for (int k = 0; k < 2; ++k) { const int e = tok_e[m * 2 + k]; const int slot = tb[33 + e] * 256 + tok_rank[m * 2 + k];
                        const u32x4* src = (const u32x4*)(XB + (size_t)m * D); u32x4* dst = (u32x4*)(XS + (size_t)slot * D);
                        dst[lane] = src[lane]; dst[lane + 64] = src[lane + 64];
                        if (lane == 0) tok_slot[m * 2 + k] = slot; }
                }
            } else if constexpr (SP == 9) {
                pg8::Gemm g{XS, WGU, 1024, 1024, 1024}; MoeOrder S{tb, G, bid, (size_t)1024 * 2, (size_t)1024 * 1024 * 2, (size_t)256 * 1024 * 2};
                EpiSwiglu E{HB};
                pg8::gemm_phase<EpiSwiglu, MoeOrder>(lds, g, S, E);
            } else {
                pg8::Gemm g{HB, WD, 512, 512, 512}; MoeOrder S{tb, G, bid, (size_t)512 * 2, (size_t)1024 * 512 * 2, (size_t)256 * 512 * 2};
                EpiStoreBf16 E{XS, 1024, 0, 1024};
                pg8::gemm_phase<EpiStoreBf16, MoeOrder>(lds, g, S, E);
            }
        }
        else if constexpr (SP == 11) {
            const float* g2 = INP(I_LN2G) + l * 1024; const float* b2 = INP(I_LN2B) + l * 1024;
            f32x4 xn[4]; u32x2 y1n[4], y2n[4]; float gan, gbn;
#define LN2_LOAD(mm) do { const int s1_ = tok_slot[(mm) * 2], s2_ = tok_slot[(mm) * 2 + 1]; gan = tok_g[(mm) * 2]; gbn = tok_g[(mm) * 2 + 1]; \
                _Pragma("unroll") for (int j = 0; j < 4; ++j) { xn[j] = ((const f32x4*)(X + (size_t)(mm) * D))[lane + 64 * j]; y1n[j] = ((const u32x2*)(XS + (size_t)s1_ * D))[lane + 64 * j]; y2n[j] = ((const u32x2*)(XS + (size_t)s2_ * D))[lane + 64 * j]; } } while (0)
            LN2_LOAD(gw);
#pragma unroll 1
            for (int m = gw; m < M; m += NGW) {
                const float ga = gan, gb = gbn;
                f32x4 v[4]; float s = 0.f; f32x4* xr = (f32x4*)(X + (size_t)m * D) + lane;
                u32x2 y1c[4], y2c[4];
#pragma unroll
                for (int j = 0; j < 4; ++j) { v[j] = xn[j] * ALPHA; y1c[j] = y1n[j]; y2c[j] = y2n[j]; }
                { const int mnx = (m + NGW < M) ? m + NGW : m; LN2_LOAD(mnx); }
#pragma unroll
                for (int j = 0; j < 4; ++j) { const u32x2 y1 = y1c[j], y2 = y2c[j];
                    v[j][0] += ga * __uint_as_float(y1.x << 16) + gb * __uint_as_float(y2.x << 16); v[j][1] += ga * __uint_as_float(y1.x & 0xffff0000u) + gb * __uint_as_float(y2.x & 0xffff0000u);
                    v[j][2] += ga * __uint_as_float(y1.y << 16) + gb * __uint_as_float(y2.y << 16); v[j][3] += ga * __uint_as_float(y1.y & 0xffff0000u) + gb * __uint_as_float(y2.y & 0xffff0000u);
                    s += (v[j][0] + v[j][1]) + (v[j][2] + v[j][3]); }
                const float mean = wave_sum(s) * (1.f / D); float s2 = 0.f;
#pragma unroll
                for (int j = 0; j < 4; ++j) { v[j] = v[j] - mean; s2 += (v[j][0] * v[j][0] + v[j][1] * v[j][1]) + (v[j][2] * v[j][2] + v[j][3] * v[j][3]); }
                const float rstd = rsqrtf(wave_sum(s2) * (1.f / D) + LN_EPS);
#pragma unroll
                for (int j = 0; j < 4; ++j) { const f32x4 gg = ((const f32x4*)g2)[lane + 64 * j], bb = ((const f32x4*)b2)[lane + 64 * j]; v[j] = v[j] * rstd * gg + bb; xr[64 * j] = v[j];
                    u32x2 w; w.x = pk2(v[j][0], v[j][1]); w.y = pk2(v[j][2], v[j][3]); ((u32x2*)(XB + (size_t)m * D))[lane + 64 * j] = w; }
            }
        }
    }
}

template <int SP>
__global__ void __launch_bounds__(NTHR, 2) k_phase(Args args, int l) {
    extern __shared__ __attribute__((aligned(16))) unsigned char lds_raw[];
    ptr_table_fill(args, (LAS unsigned char*)lds_raw);
    phase_body<SP>(l, (LAS unsigned char*)lds_raw);
}


#define XB_TMO      128
#define XB_XCNT(j)  (256  + 64 * (j))
#define XB_XSUB(j)  (1280 + 64 * (j))
#define XB_XGEN(j)  (2304 + 64 * (j))
#define XB_TOP      3328
#define XB_TOPGEN   3392
#define XCD_BAR_WORDS 3456
#define XB_SPIN_CAP (1u << 22)
__device__ __forceinline__ unsigned xb_ld(unsigned* p)              { return __hip_atomic_load(p, __ATOMIC_RELAXED, __HIP_MEMORY_SCOPE_AGENT); }
__device__ __forceinline__ unsigned xb_add(unsigned* p, unsigned v) { return __hip_atomic_fetch_add(p, v, __ATOMIC_RELAXED, __HIP_MEMORY_SCOPE_AGENT); }
__device__ __forceinline__ unsigned xb_xcc_id() { return (unsigned)__builtin_amdgcn_s_getreg((3 << 11) | 20) & 0xFu; }
#define XB_SPIN(cond, bar) do { unsigned _sp = 0; while (cond) { __builtin_amdgcn_s_sleep(1); \
    if ((++_sp & 255u) == 0u) { if (xb_ld(&(bar)[XB_TMO])) break; if (_sp > XB_SPIN_CAP) { atomicAdd(&(bar)[XB_TMO], 1u); break; } } } } while (0)
__device__ __forceinline__ void xcd_barrier_complete(unsigned* bar, unsigned x, unsigned& nloc, unsigned& nx) {
    const unsigned G = gridDim.x;
    unsigned sum, cnt, mine, sp = 0u;
    for (;;) {
        sum = 0u; cnt = 0u; mine = 0u;
#pragma unroll
        for (unsigned j = 0; j < 16; ++j) { const unsigned c = xb_ld(&bar[XB_XCNT(j)]); sum += c; cnt += (c > 0u) ? 1u : 0u; mine = (j == x) ? c : mine; }
        if (sum == G) break;
        __builtin_amdgcn_s_sleep(1);
        if ((++sp & 255u) == 0u) { if (xb_ld(&bar[XB_TMO])) break; if (sp > XB_SPIN_CAP) { atomicAdd(&bar[XB_TMO], 1u); break; } }
    }
    nloc = mine > 0u ? mine : 1u; nx = cnt > 0u ? cnt : 1u;
}
__device__ __forceinline__ void xcd_barrier(unsigned* bar, LAS unsigned char* lds) {
    asm volatile("s_waitcnt vmcnt(0)" ::: "memory");
    __syncthreads();
    int tid_ = threadIdx.x; asm volatile("" : "+v"(tid_));
    if (tid_ == 0) {
        unsigned so = (unsigned)(LDS_BYTES - 576); asm volatile("" : "+v"(so));
        volatile LAS unsigned* st = (volatile LAS unsigned*)(lds + so);
        __builtin_amdgcn_s_waitcnt(0);
        const unsigned x = xb_xcc_id();
        unsigned nloc = st[0], nx = st[1];
        if (nloc == 0u) { xcd_barrier_complete(bar, x, nloc, nx); st[0] = nloc; st[1] = nx; }
        const unsigned old = xb_add(&bar[XB_XSUB(x)], 1u);
        const unsigned gen = old / nloc;
        if (old + 1u == (gen + 1u) * nloc) {
            __builtin_amdgcn_fence(__ATOMIC_RELEASE, "agent");
            asm volatile("s_waitcnt vmcnt(0)" ::: "memory");
            const unsigned og = xb_add(&bar[XB_TOP], 1u);
            const unsigned tg = og / nx;
            if (og + 1u == (tg + 1u) * nx) xb_add(&bar[XB_TOPGEN], 1u);
            else XB_SPIN(xb_ld(&bar[XB_TOPGEN]) == tg, bar);
            __builtin_amdgcn_fence(__ATOMIC_ACQUIRE, "agent");
            xb_add(&bar[XB_XGEN(x)], 1u);
            asm volatile("s_waitcnt vmcnt(0)" ::: "memory");
        } else {
            XB_SPIN(xb_ld(&bar[XB_XGEN(x)]) == gen, bar);
            __builtin_amdgcn_fence(__ATOMIC_ACQUIRE, "agent");
            asm volatile("s_waitcnt vmcnt(0)" ::: "memory");
        }
    }
    __syncthreads();
}
namespace cg = cooperative_groups;
__global__ void __launch_bounds__(NTHR, 2) fwd_all(Args args) {
    extern __shared__ __attribute__((aligned(16))) unsigned char lds_raw[];
    LAS unsigned char* lds = (LAS unsigned char*)lds_raw;
    unsigned* bar = (unsigned*)(args.ws + WS_CTL) + CW_BAR;
    if (threadIdx.x == 0) { ((volatile LAS unsigned*)(lds + LDS_BYTES - 576))[0] = 0u; ((volatile LAS unsigned*)(lds + LDS_BYTES - 576))[1] = 0u; (void)xb_add(&bar[XB_XCNT(xb_xcc_id())], 1u); }
    ptr_table_fill(args, lds);
    const int probe = args.ph_lo;
    { constexpr int l = 0;
#pragma unroll 1
      for (int r_ = 0; r_ < ((probe == -1) ? 2 : 1); ++r_) { phase_body<-1>(l, lds); __syncthreads(); } }
    cg::this_grid().sync();
#define GRID_BAR() do { unsigned* bar_ = (unsigned*)gptr(ldptr(lds, 36)) + CW_BAR; xcd_barrier(bar_, lds); } while (0)
#define RUN(SP) do { _Pragma("unroll 1") for (int r_ = 0; r_ < ((probe == (SP)) ? 2 : 1); ++r_) { phase_body<SP>(l, lds); __syncthreads(); } } while (0)
#define ONCE(SP) do { phase_body<SP>(l, lds); __syncthreads(); } while (0)
#define LAYER() \
        RUN(0); GRID_BAR(); \
        ONCE(15); GRID_BAR(); \
        if (probe == 132) { ONCE(19); GRID_BAR(); } \
        if (probe == 130) { ONCE(17); GRID_BAR(); } \
        if (probe == 131) { ONCE(18); GRID_BAR(); } \
        if (probe >= 119 && probe < 130) { ONCE(16); GRID_BAR(); } \
        ONCE(4); GRID_BAR(); \
        RUN(13); GRID_BAR(); \
        RUN(5); GRID_BAR(); \
        ONCE(6); GRID_BAR(); \
        ONCE(7); RUN(14); GRID_BAR(); \
        RUN(8); GRID_BAR(); \
        RUN(9); GRID_BAR(); \
        RUN(10); GRID_BAR(); \
        ONCE(11); GRID_BAR();
    { constexpr int l = 0; LAYER() }
    { constexpr int l = 1; LAYER() }
#undef LAYER
#undef RUN
#undef ONCE
#undef GRID_BAR
}

template <int SP> static void launch_phase(const Args& a, int l, int grid, hipStream_t stream) {
    static bool attr = false;
    if (!attr) { (void)hipFuncSetAttribute((const void*)k_phase<SP>, hipFuncAttributeMaxDynamicSharedMemorySize, LDS_BYTES); attr = true; }
    hipLaunchKernelGGL(k_phase<SP>, dim3(grid), dim3(NTHR), LDS_BYTES, stream, a, l);
}

extern "C" void kernel_launch(void* const* d_in, const int* in_sizes, int n_in, void* d_out, int out_size, void* d_ws, size_t ws_size, hipStream_t stream) {
    static int grid = 0;
    if (grid == 0) {
        if (n_in != 35 || out_size != M * D || ws_size < WS_END) { fprintf(stderr, "kernel_launch: unexpected problem (n_in %d out %d ws %zu)\n", n_in, out_size, ws_size); grid = -1; return; }
        int dev = 0, cus = 0, per_cu = 0;
        (void)hipGetDevice(&dev); (void)hipDeviceGetAttribute(&cus, hipDeviceAttributeMultiprocessorCount, dev);
#if N_LAUNCH_MODE == 1
        (void)hipFuncSetAttribute((const void*)fwd_all, hipFuncAttributeMaxDynamicSharedMemorySize, LDS_BYTES);
        if (hipOccupancyMaxActiveBlocksPerMultiprocessor(&per_cu, (const void*)fwd_all, NTHR, LDS_BYTES) != hipSuccess || per_cu < 1) { fprintf(stderr, "kernel_launch: occupancy query says %d blocks/CU\n", per_cu); grid = -1; return; }
#endif
        (void)per_cu;
        grid = cus;
        if (grid != 256) { fprintf(stderr, "kernel_launch: built for 256 CUs, found %d\n", cus); grid = -1; return; }
    }
    if (grid < 0) return;
    (void)hipMemsetAsync((char*)d_ws + WS_CTL, 0, CTL_BYTES, stream);
    Args a{};
    for (int i = 0; i < 35; ++i) a.in[i] = (const float*)d_in[i];
    a.out = (float*)d_out; a.ws = (unsigned char*)d_ws;
#if N_LAUNCH_MODE == 1
    a.ph_lo = PROBE_REPS;
    void* kargs[] = {(void*)&a};
    hipError_t e = hipLaunchCooperativeKernel((const void*)fwd_all, dim3(grid), dim3(NTHR), kargs, LDS_BYTES, stream);
    if (e != hipSuccess) fprintf(stderr, "cooperative launch failed: %s\n", hipGetErrorString(e));
#else
    launch_phase<-1>(a, 0, grid, stream);
    for (int l = 0; l < NL; ++l) {
        launch_phase<0>(a, l, grid, stream); launch_phase<15>(a, l, grid, stream); launch_phase<4>(a, l, grid, stream); launch_phase<13>(a, l, grid, stream);
        launch_phase<5>(a, l, grid, stream); launch_phase<6>(a, l, grid, stream); launch_phase<7>(a, l, grid, stream); launch_phase<14>(a, l, grid, stream);
        launch_phase<8>(a, l, grid, stream); launch_phase<9>(a, l, grid, stream); launch_phase<10>(a, l, grid, stream); launch_phase<11>(a, l, grid, stream);
    }
#endif
}
```

```cpp
#include <hip/hip_runtime.h>
#include <type_traits>
#include <cstdio>
#include <cstdint>
#include <hip/hip_cooperative_groups.h>

#ifndef PROBE_REPS
#define PROBE_REPS -100
#endif
#ifndef N_LAUNCH_MODE
#define N_LAUNCH_MODE 1
#endif

namespace pg8 {
#define PG8_LAS __attribute__((address_space(3)))
typedef unsigned short bf16_t;
typedef short bf16x8 __attribute__((ext_vector_type(8)));
typedef float f32x4 __attribute__((ext_vector_type(4)));
typedef unsigned u32x4 __attribute__((ext_vector_type(4)));
constexpr int BM = 256, BK = 64, HALF = 128, HTB = HALF * BK * 2, STAGE_BYTES = 8 * HTB, NXCD = 8, WGM = 8;

__host__ __device__ __forceinline__ int lds_byte(int r, int c) { const int st = (r >> 4) * 2 + (c >> 5), rr = r & 15, cc = c & 31, ob = rr * 64 + cc * 2; return st * 1024 + (ob ^ (((ob >> 9) & 1) << 5)); }
__host__ __device__ __forceinline__ void stage_rc(int b, int& R, int& C) { const int st = b / 1024, sb = b % 1024, swz = sb ^ (((sb >> 9) & 1) << 5); R = (st >> 1) * 16 + swz / 64; C = (st & 1) * 32 + (swz % 64) / 2; }
__host__ __device__ __forceinline__ int perm32(int rho) { const int n = rho >> 4, i = rho & 15; return 8 * (i >> 2) + 4 * n + (i & 3); }

struct Unit { int pm, pn, aux; size_t aoff, boff; };
struct Gemm { const bf16_t* A; const bf16_t* Bt; int lda, ldb, K; };

__device__ __forceinline__ void tile_of(int L, int nM, int nN, int& pm, int& pn) {
    const int nwg = nM * nN; int wgid = L;
    { const int q = nwg / NXCD, r = nwg % NXCD, xcd = wgid % NXCD, off = wgid / NXCD; wgid = (xcd < r ? xcd * (q + 1) : r * (q + 1) + (xcd - r) * q) + off; }
    const int nig = WGM * nN, gid = wgid / nig, fm = gid * WGM, gsz = (nM - fm) < WGM ? (nM - fm) : WGM;
    pm = fm + ((wgid % nig) % gsz); pn = (wgid % nig) / gsz;
}
struct StaticOrder {
    int nM, nN, nwg, G, c, lda, ldb;
    __device__ void init(int M, int N, int G_, int c_, int lda_, int ldb_) { nM = M / BM; nN = N / BM; nwg = nM * nN; G = G_; c = c_; lda = lda_; ldb = ldb_; }
    __device__ bool next(int i, Unit& u) const {
        const long L = (long)i * G + c; if (L >= nwg) return false;
        tile_of((int)L, nM, nN, u.pm, u.pn); u.aux = 0;
        u.aoff = (size_t)u.pm * BM * lda * 2; u.boff = (size_t)u.pn * BM * ldb * 2; return true;
    }
};

__device__ __forceinline__ unsigned cvt_pk_bf16(float lo, float hi) { typedef __bf16 b2_ __attribute__((ext_vector_type(2))); typedef float f2_ __attribute__((ext_vector_type(2))); return __builtin_bit_cast(unsigned, __builtin_convertvector((f2_){lo, hi}, b2_)); }
__device__ __forceinline__ void epi_mfma_settle(const f32x4 (&acc)[2][2][4][2]) {
    asm volatile("s_nop 11" :: "v"(acc[1][0][0][0]), "v"(acc[1][0][0][1]), "v"(acc[1][0][1][0]), "v"(acc[1][0][1][1]), "v"(acc[1][0][2][0]), "v"(acc[1][0][2][1]), "v"(acc[1][0][3][0]), "v"(acc[1][0][3][1]),
                                "v"(acc[1][1][0][0]), "v"(acc[1][1][0][1]), "v"(acc[1][1][1][0]), "v"(acc[1][1][1][1]), "v"(acc[1][1][2][0]), "v"(acc[1][1][2][1]), "v"(acc[1][1][3][0]), "v"(acc[1][1][3][1]) : "memory"); }

template <class Epi, class Sched, bool ALIGN_EPI = true, bool SP2 = true>
__device__ __forceinline__ void gemm_phase(PG8_LAS unsigned char* lds, const Gemm g, const Sched& S, const Epi& E) {
    int tid_ = threadIdx.x; asm volatile("" : "+v"(tid_));
    const int tid = tid_, wid = __builtin_amdgcn_readfirstlane(tid >> 6), lane = tid & 63, wr = wid >> 2, wc = wid & 3, fr = lane & 15, fq = lane >> 4;
    const int K = g.K, nt = K / BK;
    unsigned voffA[2], voffB[2];
#pragma unroll
    for (int i = 0; i < 2; ++i) { int R, C; stage_rc(tid * 16 + i * 8192, R, C); const int Rb = Epi::PERM ? ((R & ~31) + perm32(R & 31)) : R;
        voffA[i] = (unsigned)(R * g.lda + C) * 2u; voffB[i] = (unsigned)(Rb * g.ldb + C) * 2u; }
    const size_t kstep = (size_t)(BK * 2);
    const size_t hstepA = (size_t)HALF * g.lda * 2, hstepB = (size_t)HALF * g.ldb * 2;
    const unsigned ldsw = (unsigned)wid * 1024u;
    const int aoff = lds_byte(wr * 64 + fr, fq * 8), boff = lds_byte(wc * 32 + fr, fq * 8);
#define PG8_SA(b, h) (((b) * 2 + (h)) * HTB)
#define PG8_SB(b, h) ((4 + (b) * 2 + (h)) * HTB)
#define PG8_STAGE(bufoff, gbase, voff) do { _Pragma("unroll") for (int _i = 0; _i < 2; ++_i) \
        __builtin_amdgcn_global_load_lds((const unsigned*)((const char*)(gbase) + (voff)[_i]), (PG8_LAS unsigned*)(lds + (bufoff) + ldsw + _i * 8192), 16, 0, 0); } while (0)
#define PG8_LDA(dst, b, h) do { _Pragma("unroll") for (int m = 0; m < 4; ++m) _Pragma("unroll") for (int k = 0; k < 2; ++k) dst[m][k] = *(const PG8_LAS bf16x8*)(lds + PG8_SA(b, h) + aoff + m * 2048 + k * 1024); } while (0)
#define PG8_LDB(dst, b, h) do { _Pragma("unroll") for (int n = 0; n < 2; ++n) _Pragma("unroll") for (int k = 0; k < 2; ++k) dst[n][k] = *(const PG8_LAS bf16x8*)(lds + PG8_SB(b, h) + boff + n * 2048 + k * 1024); } while (0)
#define PG8_MMA(ai, bj, At, Bt) do { __builtin_amdgcn_s_setprio(1); _Pragma("unroll") for (int m = 0; m < 4; ++m) _Pragma("unroll") for (int n = 0; n < 2; ++n) _Pragma("unroll") for (int k = 0; k < 2; ++k) \
        acc[ai][bj][m][n] = __builtin_amdgcn_mfma_f32_16x16x32_bf16(Bt[n][k], At[m][k], acc[ai][bj][m][n], 0, 0, 0); __builtin_amdgcn_s_setprio(0); } while (0)
#define PG8_WAIT_V(n) asm volatile("s_waitcnt vmcnt(" #n ")" ::: "memory")
#define PG8_WAIT_L(n) asm volatile("s_waitcnt lgkmcnt(" #n ")" ::: "memory")
#define PG8_BAR __builtin_amdgcn_s_barrier()
#define PG8_SCHED __builtin_amdgcn_sched_barrier(0)
    Unit cur, nxt; int ui = 0;
    if (!S.next(0, cur)) return;
    f32x4 acc[2][2][4][2];
#pragma unroll
    for (int a = 0; a < 2; ++a)
#pragma unroll
        for (int b = 0; b < 2; ++b)
#pragma unroll
            for (int m = 0; m < 4; ++m)
#pragma unroll
                for (int n = 0; n < 2; ++n) acc[a][b][m][n] = (f32x4){0.f, 0.f, 0.f, 0.f};
    bf16x8 At[4][2], B0[2][2], B1[2][2];
    const char* cA = (const char*)g.A + cur.aoff; const char* cB = (const char*)g.Bt + cur.boff;
    if constexpr (SP2) {
        PG8_STAGE(PG8_SB(0, 0), cB, voffB); PG8_STAGE(PG8_SB(0, 1), cB + hstepB, voffB); PG8_STAGE(PG8_SA(0, 0), cA, voffA); PG8_STAGE(PG8_SA(0, 1), cA + hstepA, voffA);
        if (wr == 1) PG8_BAR;
        PG8_WAIT_V(2); PG8_BAR;
        PG8_STAGE(PG8_SB(1, 0), cB + kstep, voffB); PG8_STAGE(PG8_SA(1, 0), cA + kstep, voffA); PG8_STAGE(PG8_SB(1, 1), cB + hstepB + kstep, voffB);
        PG8_WAIT_V(6); PG8_BAR;
    } else {
        PG8_STAGE(PG8_SB(0, 0), cB, voffB); PG8_STAGE(PG8_SA(0, 0), cA, voffA); PG8_STAGE(PG8_SB(0, 1), cB + hstepB, voffB); PG8_STAGE(PG8_SA(0, 1), cA + hstepA, voffA);
        if (wr == 1) PG8_BAR;
        PG8_WAIT_V(4); PG8_BAR;
        PG8_STAGE(PG8_SB(1, 0), cB + kstep, voffB); PG8_STAGE(PG8_SA(1, 0), cA + kstep, voffA); PG8_STAGE(PG8_SB(1, 1), cB + hstepB + kstep, voffB);
        PG8_WAIT_V(6); PG8_BAR;
    }
    for (;;) {
        const bool has_next = S.next(ui + 1, nxt);
        const char* nA = has_next ? (const char*)g.A + nxt.aoff : cA; const char* nB = has_next ? (const char*)g.Bt + nxt.boff : cB;
#pragma unroll 1
        for (int t = 0; t < nt; t += 2) {
            const bool last = (t == nt - 2);
            const char* a1 = cA + (size_t)(t + 1) * kstep;
            const char* a2 = last ? nA : cA + (size_t)(t + 2) * kstep; const char* b2 = last ? nB : cB + (size_t)(t + 2) * kstep;
            const char* a3 = a2 + kstep; const char* b3 = b2 + kstep;
            if constexpr (SP2) {
            PG8_LDB(B0, 0, 0); PG8_LDB(B1, 0, 1); PG8_SCHED; PG8_LDA(At, 0, 0); PG8_STAGE(PG8_SA(1, 1), a1 + hstepA, voffA);
            PG8_WAIT_V(8); PG8_WAIT_L(0); PG8_BAR; PG8_MMA(0, 0, At, B0); PG8_MMA(0, 1, At, B1); PG8_BAR; PG8_SCHED;
            PG8_LDA(At, 0, 1); PG8_STAGE(PG8_SB(0, 0), b2, voffB); PG8_STAGE(PG8_SB(0, 1), b2 + hstepB, voffB); PG8_STAGE(PG8_SA(0, 0), a2, voffA);
            PG8_WAIT_V(8); PG8_WAIT_L(0); PG8_BAR; PG8_MMA(1, 0, At, B0); PG8_MMA(1, 1, At, B1); PG8_BAR; PG8_SCHED;
            PG8_LDB(B0, 1, 0); PG8_LDB(B1, 1, 1); PG8_SCHED; PG8_LDA(At, 1, 0); PG8_STAGE(PG8_SA(0, 1), a2 + hstepA, voffA);
            PG8_WAIT_V(8); PG8_WAIT_L(0); PG8_BAR; PG8_MMA(0, 0, At, B0); PG8_MMA(0, 1, At, B1); PG8_BAR; PG8_SCHED;
            PG8_LDA(At, 1, 1); PG8_STAGE(PG8_SB(1, 0), b3, voffB); PG8_STAGE(PG8_SB(1, 1), b3 + hstepB, voffB); PG8_STAGE(PG8_SA(1, 0), a3, voffA);
            PG8_WAIT_V(8); PG8_WAIT_L(0); PG8_BAR; PG8_MMA(1, 0, At, B0); PG8_MMA(1, 1, At, B1); PG8_BAR; PG8_SCHED;
            } else {
            PG8_LDB(B0, 0, 0); PG8_SCHED; PG8_LDA(At, 0, 0); PG8_STAGE(PG8_SA(1, 1), a1 + hstepA, voffA);
            PG8_WAIT_L(8); PG8_BAR; PG8_WAIT_L(0); PG8_MMA(0, 0, At, B0); PG8_BAR; PG8_SCHED;
            PG8_LDB(B1, 0, 1); PG8_STAGE(PG8_SB(0, 0), b2, voffB);
            PG8_BAR; PG8_WAIT_L(0); PG8_MMA(0, 1, At, B1); PG8_BAR;
            PG8_LDA(At, 0, 1); PG8_STAGE(PG8_SA(0, 0), a2, voffA);
            PG8_BAR; PG8_WAIT_L(0); PG8_MMA(1, 0, At, B0); PG8_BAR; PG8_SCHED;
            PG8_STAGE(PG8_SB(0, 1), b2 + hstepB, voffB);
            PG8_WAIT_V(6); PG8_BAR; PG8_MMA(1, 1, At, B1); PG8_BAR;
            PG8_LDB(B0, 1, 0); PG8_SCHED; PG8_LDA(At, 1, 0); PG8_STAGE(PG8_SA(0, 1), a2 + hstepA, voffA);
            PG8_WAIT_L(8); PG8_BAR; PG8_WAIT_L(0); PG8_MMA(0, 0, At, B0); PG8_BAR; PG8_SCHED;
            PG8_LDB(B1, 1, 1); PG8_STAGE(PG8_SB(1, 0), b3, voffB);
            PG8_BAR; PG8_WAIT_L(0); PG8_MMA(0, 1, At, B1); PG8_BAR;
            PG8_LDA(At, 1, 1); PG8_STAGE(PG8_SA(1, 0), a3, voffA);
            PG8_BAR; PG8_WAIT_L(0); PG8_MMA(1, 0, At, B0); PG8_BAR; PG8_SCHED;
            PG8_STAGE(PG8_SB(1, 1), b3 + hstepB, voffB);
            PG8_WAIT_V(6); PG8_BAR; PG8_MMA(1, 1, At, B1); PG8_BAR;
            }
        }
        if constexpr (ALIGN_EPI) { if (wr == 0) PG8_BAR; }
        E(acc, cur, wr, wc, fr, fq);
        if (!has_next) break;
#pragma unroll
        for (int a = 0; a < 2; ++a)
#pragma unroll
            for (int b = 0; b < 2; ++b)
#pragma unroll
                for (int m = 0; m < 4; ++m)
#pragma unroll
                    for (int n = 0; n < 2; ++n) acc[a][b][m][n] = (f32x4){0.f, 0.f, 0.f, 0.f};
        cur = nxt; cA = nA; cB = nB; ++ui;
        if constexpr (ALIGN_EPI) { if (wr == 1) PG8_BAR; }
    }
    PG8_WAIT_V(0);
    if constexpr (!ALIGN_EPI) { if (wr == 0) PG8_BAR; }
    PG8_BAR;
#undef PG8_SA
#undef PG8_SB
#undef PG8_STAGE
#undef PG8_LDA
#undef PG8_LDB
#undef PG8_MMA
#undef PG8_WAIT_V
#undef PG8_WAIT_L
#undef PG8_BAR
#undef PG8_SCHED
}
}

#define LAS __attribute__((address_space(3)))
typedef unsigned short bf16;
typedef float f32x4 __attribute__((ext_vector_type(4)));
typedef unsigned u32x4 __attribute__((ext_vector_type(4)));
typedef unsigned u32x2 __attribute__((ext_vector_type(2)));

constexpr int NB = 8, T = 4096, D = 1024, M = NB * T, NL = 2;
constexpr int INW = 9160;
constexpr int PP = 5120;
constexpr int C_AQ = 0, C_AK = 768, C_AV = 1536, C_BQ = 2304, C_BK = 2560, C_BV = 2816, C_IQ = 3072, C_IK = 3328, C_C = 3392, C_DZ = 4288, C_DX = 4544, C_IW = 5056, C_DT = 5060, C_END = 5064;
constexpr int NEXP = 32, DEXP = 512;
constexpr int CAP = 73728;
constexpr float LN_EPS = 1e-5f;
constexpr float ALPHA = 1.4142135623730951f;

constexpr size_t MiB = 1u << 20;
constexpr size_t WS_CTL = 0, CTL_BYTES = 1 * MiB;
constexpr size_t WS_WINT = 2 * MiB;
constexpr size_t WS_WGT = 22 * MiB;
constexpr size_t WS_WBRT = 38 * MiB;
constexpr size_t WS_WOUTT = 42 * MiB;
constexpr size_t WS_WRT = 46 * MiB;
constexpr size_t WS_ROUTE = 47 * MiB;
constexpr size_t WS_XB = 48 * MiB;
constexpr size_t WS_O = 112 * MiB;
constexpr size_t WS_VF = 176 * MiB;
constexpr size_t WS_P = 192 * MiB;
constexpr size_t WS_GS = 192 * MiB;
constexpr size_t WS_MERGED = 448 * MiB;
constexpr size_t WS_XS = 192 * MiB;
constexpr size_t WS_H = 336 * MiB;
constexpr size_t WS_WGU = 408 * MiB;
constexpr size_t WS_WD = 472 * MiB;
constexpr size_t WS_RW = 512 * MiB;
constexpr size_t WS_RW2 = 544 * MiB;
constexpr size_t WS_BONG = 46 * MiB + 512 * 1024;
constexpr size_t WS_END = 592 * MiB;
constexpr int CW_CNT = 64, CW_Q = 256, CW_BAR = 4096;

constexpr int RING_BYTES = 131072, MISC_OFF = RING_BYTES, LDS_BYTES = 147456;
constexpr int NWAVES = 8, NTHR = 512;

__device__ __forceinline__ float bf2f(bf16 v) { return __uint_as_float(((unsigned)v) << 16); }
__device__ __forceinline__ unsigned pk2(float lo, float hi) { return pg8::cvt_pk_bf16(lo, hi); }
__device__ __forceinline__ unsigned f2bf(float f) { unsigned u = __float_as_uint(f); return (u + 0x7fffu + ((u >> 16) & 1u)) >> 16; }
#define DPP_ADD(v, ctrl) v += __builtin_bit_cast(float, __builtin_amdgcn_update_dpp(0, __builtin_bit_cast(int, v), ctrl, 0xF, 0xF, true))
#define DPP_MAX(v, ctrl) v = fmaxf(v, __builtin_bit_cast(float, __builtin_amdgcn_update_dpp(0, __builtin_bit_cast(int, v), ctrl, 0xF, 0xF, true)))
__device__ __forceinline__ float wave_sum(float v) {
    DPP_ADD(v, 0xB1); DPP_ADD(v, 0x4E); DPP_ADD(v, 0x141); DPP_ADD(v, 0x140);
    v += __shfl_xor(v, 16); v += __shfl_xor(v, 32);
    return v;
}
__device__ __forceinline__ float wave_max(float v) {
    DPP_MAX(v, 0xB1); DPP_MAX(v, 0x4E); DPP_MAX(v, 0x141); DPP_MAX(v, 0x140);
    v = fmaxf(v, __shfl_xor(v, 16)); v = fmaxf(v, __shfl_xor(v, 32));
    return v;
}
__device__ __forceinline__ float sigmoid_div_(float x) { return 1.f / (1.f + __expf(-x)); }
__device__ __forceinline__ float sigmoidf_(float x) { return __builtin_amdgcn_rcpf(1.f + __expf(-x)); }
__device__ __forceinline__ float softplusf_(float x) { return x > 20.f ? x : __logf(1.f + __expf(x)); }
__device__ __forceinline__ float tanhf_(float x) { const float e = __expf(-2.f * fabsf(x)); const float t = (1.f - e) * __builtin_amdgcn_rcpf(1.f + e); return x < 0.f ? -t : t; }
__device__ __forceinline__ float siluf_(float x) { return x * __builtin_amdgcn_rcpf(1.f + __expf(-x)); }

struct Args { const float* in[35]; float* out; unsigned char* ws; int ph_lo, ph_hi; };
enum { I_X = 0, I_WIN, I_CMU, I_CW0, I_CW2, I_CA0, I_CA2, I_CG2, I_CKK, I_CKA, I_CRK, I_CGNW, I_CGNB, I_CV0, I_CV1, I_CV2, I_DCW, I_DCB, I_DDTB, I_DALOG, I_DSKIP, I_DNW,
       I_WBR, I_WOUT, I_LN1G, I_LN1B, I_RG, I_RGB, I_RE, I_REB, I_EG, I_EU, I_ED, I_LN2G, I_LN2B };

__device__ __forceinline__ void transpose_item(const float* W, int ldn, int c0, int ncols, bf16* dst, int dld, int r0, int dk0, int kb, int nb, LAS float* scr, int lane) {
    const int k0 = 64 * kb, n0 = 32 * nb;
    const bool okn = (n0 + (lane & 31)) < ncols;
    float tv[32];
#pragma unroll
    for (int i = 0; i < 32; ++i) { const int kk = 2 * i + (lane >> 5); tv[i] = okn ? W[(size_t)(k0 + kk) * ldn + c0 + n0 + (lane & 31)] : 0.f; }
#pragma unroll
    for (int i = 0; i < 32; ++i) { const int kk = 2 * i + (lane >> 5); scr[kk * 33 + (lane & 31)] = tv[i]; }
    asm volatile("s_waitcnt lgkmcnt(0)" ::: "memory");
    const int c = lane & 7;
#pragma unroll
    for (int j = 0; j < 4; ++j) { const int n = (lane >> 3) + 8 * j; const LAS float* s = scr + (8 * c) * 33 + n;
        u32x4 o; o.x = pk2(s[0 * 33], s[1 * 33]); o.y = pk2(s[2 * 33], s[3 * 33]); o.z = pk2(s[4 * 33], s[5 * 33]); o.w = pk2(s[6 * 33], s[7 * 33]);
        if (n0 + n < ncols) *(u32x4*)(dst + (size_t)(r0 + n0 + n) * dld + dk0 + k0 + 8 * c) = o; }
    asm volatile("s_waitcnt lgkmcnt(0)" ::: "memory");
}

struct EpiStoreBf16 {
    static constexpr bool PERM = true;
    bf16* O; int ldc; int act; int ncols;
    __device__ __forceinline__ void operator()(const pg8::f32x4 (&acc)[2][2][4][2], const pg8::Unit& u, int wr, int wc, int fr, int fq) const {
        pg8::epi_mfma_settle(acc);
        const int row0 = u.pm * 256 + wr * 64 + fr; const int col0 = u.pn * 256 + wc * 32 + 8 * fq;
#pragma unroll
        for (int ai = 0; ai < 2; ++ai)
#pragma unroll
            for (int m = 0; m < 4; ++m) { bf16* rowp = O + (size_t)(row0 + ai * 128 + m * 16) * ldc + col0;
#pragma unroll
                for (int bj = 0; bj < 2; ++bj) { pg8::f32x4 v0 = acc[ai][bj][m][0], v1 = acc[ai][bj][m][1];
                    if (act == 1) {
#pragma unroll
                        for (int j = 0; j < 4; ++j) { v0[j] = sigmoidf_(v0[j]); v1[j] = sigmoidf_(v1[j]); } }
                    u32x4 w; w.x = pg8::cvt_pk_bf16(v0[0], v0[1]); w.y = pg8::cvt_pk_bf16(v0[2], v0[3]); w.z = pg8::cvt_pk_bf16(v1[0], v1[1]); w.w = pg8::cvt_pk_bf16(v1[2], v1[3]);
                    if (col0 + bj * 128 < ncols) *(u32x4*)(rowp + bj * 128) = w; } }
    }
};
struct EpiBranch {
    static constexpr bool PERM = true;
    const bf16* GS; bf16* MG;
    __device__ __forceinline__ void operator()(const pg8::f32x4 (&acc)[2][2][4][2], const pg8::Unit& u, int wr, int wc, int fr, int fq) const {
        pg8::epi_mfma_settle(acc);
        const int n = u.aux;
        const bf16* gbase = GS + (size_t)(u.pm * 256 + wr * 64 + fr) * 4096 + n * 1024 + u.pn * 256 + wc * 32 + 8 * fq;
        bf16* mbase = MG + (size_t)(u.pm * 256 + wr * 64 + fr) * 1024 + u.pn * 256 + wc * 32 + 8 * fq;
#pragma unroll
        for (int ai = 0; ai < 2; ++ai)
#pragma unroll
            for (int m = 0; m < 4; ++m) {
#pragma unroll
                for (int bj = 0; bj < 2; ++bj) {
                    const u32x4 gv = *(const u32x4*)(gbase + (size_t)(ai * 128 + m * 16) * 4096 + bj * 128);
                    bf16* mp = mbase + (size_t)(ai * 128 + m * 16) * 1024 + bj * 128;
                    u32x4 ov = (u32x4){0u, 0u, 0u, 0u}; if (n != 0) ov = *(const u32x4*)mp;
                    const pg8::f32x4 a0 = acc[ai][bj][m][0], a1 = acc[ai][bj][m][1];
                    u32x4 w;
                    w.x = pg8::cvt_pk_bf16(a0[0] * __uint_as_float(gv.x << 16) + __uint_as_float(ov.x << 16), a0[1] * __uint_as_float(gv.x & 0xffff0000u) + __uint_as_float(ov.x & 0xffff0000u));
                    w.y = pg8::cvt_pk_bf16(a0[2] * __uint_as_float(gv.y << 16) + __uint_as_float(ov.y << 16), a0[3] * __uint_as_float(gv.y & 0xffff0000u) + __uint_as_float(ov.y & 0xffff0000u));
                    w.z = pg8::cvt_pk_bf16(a1[0] * __uint_as_float(gv.z << 16) + __uint_as_float(ov.z << 16), a1[1] * __uint_as_float(gv.z & 0xffff0000u) + __uint_as_float(ov.z & 0xffff0000u));
                    w.w = pg8::cvt_pk_bf16(a1[2] * __uint_as_float(gv.w << 16) + __uint_as_float(ov.w << 16), a1[3] * __uint_as_float(gv.w & 0xffff0000u) + __uint_as_float(ov.w & 0xffff0000u));
                    *(u32x4*)mp = w; asm volatile("" ::: "memory"); } }
    }
};
struct EpiResid {
    static constexpr bool PERM = false;
    float* X;
    __device__ __forceinline__ void operator()(const pg8::f32x4 (&acc)[2][2][4][2], const pg8::Unit& u, int wr, int wc, int fr, int fq) const {
        pg8::epi_mfma_settle(acc);
        const int row0 = u.pm * 256 + wr * 64 + fr, col0 = u.pn * 256 + wc * 32 + 4 * fq;
#pragma unroll
        for (int ai = 0; ai < 2; ++ai)
#pragma unroll
            for (int m = 0; m < 4; ++m) { float* rowp = X + (size_t)(row0 + ai * 128 + m * 16) * D + col0;
#pragma unroll
                for (int bj = 0; bj < 2; ++bj)
#pragma unroll
                    for (int n = 0; n < 2; ++n) { pg8::f32x4* p = (pg8::f32x4*)(rowp + bj * 128 + n * 16); *p = *p * ALPHA + acc[ai][bj][m][n]; } }
    }
};
struct EpiSwiglu {
    static constexpr bool PERM = true;
    bf16* H;
    __device__ __forceinline__ void operator()(const pg8::f32x4 (&acc)[2][2][4][2], const pg8::Unit& u, int wr, int wc, int fr, int fq) const {
        pg8::epi_mfma_settle(acc);
        const int row0 = u.pm * 256 + wr * 64 + fr; const int col0 = u.pn * 128 + wc * 32 + 8 * fq;
#pragma unroll
        for (int ai = 0; ai < 2; ++ai)
#pragma unroll
            for (int m = 0; m < 4; ++m) { bf16* rowp = H + (size_t)(row0 + ai * 128 + m * 16) * DEXP + col0;
                float v[8];
#pragma unroll
                for (int j = 0; j < 4; ++j) { v[j] = siluf_(acc[ai][0][m][0][j]) * acc[ai][1][m][0][j]; v[4 + j] = siluf_(acc[ai][0][m][1][j]) * acc[ai][1][m][1][j]; }
                u32x4 w; w.x = pg8::cvt_pk_bf16(v[0], v[1]); w.y = pg8::cvt_pk_bf16(v[2], v[3]); w.z = pg8::cvt_pk_bf16(v[4], v[5]); w.w = pg8::cvt_pk_bf16(v[6], v[7]);
                *(u32x4*)rowp = w; }
    }
};

struct SkewOrder {
    int nM, nN, nwg, c, lda, ldb;
    __device__ bool next(int i, pg8::Unit& u) const {
        long L;
        if (i < 5) L = (long)i * 256 + c; else { if (c < 32) return false; L = 1280 + (long)(i - 5) * 224 + (c - 32); }
        if (L >= nwg) return false;
        pg8::tile_of((int)L, nM, nN, u.pm, u.pn); u.aux = 0;
        u.aoff = (size_t)u.pm * 256 * lda * 2; u.boff = (size_t)u.pn * 256 * ldb * 2; return true;
    }
};
struct BranchOrder {
    int nM, nN, G, c;
    __device__ bool next(int i, pg8::Unit& u) const {
        const int tl = (i >> 2) * G + c; if (tl >= nM * nN) return false;
        pg8::tile_of(tl, nM, nN, u.pm, u.pn); u.aux = i & 3;
        u.aoff = ((size_t)u.pm * 256 * 1024 + (size_t)u.aux * 256) * 2; u.boff = ((size_t)u.pn * 256 * 1024 + (size_t)u.aux * 256) * 2; return true;
    }
};
struct MoeOrder {
    const volatile LAS int* tb; int G, c; size_t a_rowbytes, b_expbytes, b_tilebytes;
    __device__ bool next(int i, pg8::Unit& u) const {
        const int L = i * G + c; const int total = __builtin_amdgcn_readfirstlane(tb[32]) * 4; if (L >= total) return false;
        int e = 0;
#pragma unroll 1
        for (int k = 0; k < 32; ++k) if (L >= tb[k + 1] * 4) e = k + 1;
        const int nte = tb[e + 1] - tb[e]; const int r = L - tb[e] * 4; const int ct = r / nte, rt = r % nte;
        u.pm = __builtin_amdgcn_readfirstlane(tb[33 + e] + rt); u.pn = __builtin_amdgcn_readfirstlane(ct); u.aux = __builtin_amdgcn_readfirstlane(e);
        u.aoff = (size_t)u.pm * 256 * a_rowbytes; u.boff = (size_t)u.aux * b_expbytes + (size_t)u.pn * b_tilebytes; return true;
    }
};

constexpr int PTR_OFF = LDS_BYTES - 512;
__device__ __forceinline__ void ptr_table_fill(const Args& args, LAS unsigned char* lds) {
    if (threadIdx.x == 0) {
        volatile LAS unsigned long long* t = (volatile LAS unsigned long long*)(lds + PTR_OFF);
#define PT_(i) t[i] = (unsigned long long)args.in[i];
        PT_(0) PT_(1) PT_(2) PT_(3) PT_(4) PT_(5) PT_(6) PT_(7) PT_(8) PT_(9) PT_(10) PT_(11) PT_(12) PT_(13) PT_(14) PT_(15) PT_(16) PT_(17) PT_(18) PT_(19)
        PT_(20) PT_(21) PT_(22) PT_(23) PT_(24) PT_(25) PT_(26) PT_(27) PT_(28) PT_(29) PT_(30) PT_(31) PT_(32) PT_(33) PT_(34)
#undef PT_
        t[35] = (unsigned long long)args.out; t[36] = (unsigned long long)args.ws; t[37] = (unsigned long long)(unsigned)args.ph_lo;
    }
    __syncthreads();
}
__device__ __forceinline__ unsigned long long ldptr(LAS unsigned char* lds, int i) {
    unsigned a = (unsigned)(PTR_OFF + 8 * i); asm volatile("" : "+v"(a));
    const volatile LAS unsigned* t = (const volatile LAS unsigned*)(lds + a);
    const unsigned lo = __builtin_amdgcn_readfirstlane(t[0]), hi = __builtin_amdgcn_readfirstlane(t[1]);
    return ((unsigned long long)hi << 32) | lo;
}
__device__ __forceinline__ void* gptr(unsigned long long v) { return (void*)(__attribute__((address_space(1))) void*)v; }
#define INP(i) ((const float*)gptr(ldptr(lds, (i))))
namespace rw {
typedef short bf16x8 __attribute__((ext_vector_type(8)));
typedef float f4 __attribute__((ext_vector_type(4)));
constexpr int LS = 72;
constexpr int MB = 64 * LS * 2;
constexpr int O_AHN = 0, O_RHN = MB, O_BCN = 2 * MB, O_KCN = 3 * MB, O_AHT = 4 * MB, O_BTT = 5 * MB, O_KTT = 6 * MB, O_VT = 7 * MB, O_STT = 8 * MB,
              O_MAK = 9 * MB, O_MRB = 10 * MB, O_MRK = 11 * MB, O_TINV = 12 * MB, O_MABF = 13 * MB, O_GAM = 13 * MB + 16384, O_CT = O_GAM + 256, O_BON = O_CT + 4608, O_END = O_BON + 256;
constexpr int O_MVT = O_BCN, O_A2N = O_AHN, O_UT = O_KCN, O_YF = O_AHT;
constexpr int O_TAB = O_MAK, O_SCR = O_TAB + 26624, O_TOT = O_SCR + 8 * 1024, O_CUM = O_TOT + 2048;
static_assert(O_CUM + 16384 <= O_GAM && O_END <= LDS_BYTES - 576, "rwkv LDS map");

__device__ __forceinline__ bf16x8 ldfrag(const LAS unsigned char* lds, int off, int r0, int ks, int lane) {
    return *(const LAS bf16x8*)(lds + off + ((r0 + (lane & 15)) * LS + ks * 32 + (lane >> 4) * 8) * 2);
}
__device__ __forceinline__ void mm64(f4 (&acc)[2], const LAS unsigned char* lds, int offA, int offBt, int w, int lane) {
    const int tr = w >> 1; const bf16x8 a0 = ldfrag(lds, offA, tr * 16, 0, lane), a1 = ldfrag(lds, offA, tr * 16, 1, lane);
#pragma unroll
    for (int c = 0; c < 2; ++c) { const int tc = (w & 1) * 2 + c; const bf16x8 b0 = ldfrag(lds, offBt, tc * 16, 0, lane), b1 = ldfrag(lds, offBt, tc * 16, 1, lane);
        acc[c] = __builtin_amdgcn_mfma_f32_16x16x32_bf16(a0, b0, acc[c], 0, 0, 0); acc[c] = __builtin_amdgcn_mfma_f32_16x16x32_bf16(a1, b1, acc[c], 0, 0, 0); }
}
__device__ __forceinline__ void storeT(LAS unsigned char* lds, int off, const f4 (&acc)[2], int w, int lane) {
    asm volatile("s_nop 11" :: "v"(acc[0]), "v"(acc[1]));
#pragma unroll
    for (int c = 0; c < 2; ++c) { const int col = ((w & 1) * 2 + c) * 16 + (lane & 15), row = (w >> 1) * 16 + 4 * (lane >> 4);
        u32x2 v; v.x = pk2(acc[c][0], acc[c][1]); v.y = pk2(acc[c][2], acc[c][3]); *(LAS u32x2*)(lds + off + (col * LS + row) * 2) = v; }
}
template <int MASK  >
__device__ __forceinline__ void storeN(LAS unsigned char* lds, int off, const f4 (&acc)[2], int w, int lane) {
    asm volatile("s_nop 11" :: "v"(acc[0]), "v"(acc[1]));
#pragma unroll
    for (int c = 0; c < 2; ++c) { const int col = ((w & 1) * 2 + c) * 16 + (lane & 15), row = (w >> 1) * 16 + 4 * (lane >> 4);
#pragma unroll
        for (int e = 0; e < 4; ++e) { float x = acc[c][e]; if (MASK == 1) x = (col < row + e) ? x : 0.f; if (MASK == 2) x = (col <= row + e) ? x : 0.f;
            *(LAS bf16*)(lds + off + ((row + e) * LS + col) * 2) = (bf16)f2bf(x); } }
}
typedef __bf16 bf2v __attribute__((ext_vector_type(2)));
__device__ __forceinline__ float dot2(unsigned x, unsigned y, float c) { return __builtin_amdgcn_fdot2_f32_bf16(__builtin_bit_cast(bf2v, x), __builtin_bit_cast(bf2v, y), c, false); }
#define RW_ZERO(a) do { a[0] = (f4){0.f, 0.f, 0.f, 0.f}; a[1] = (f4){0.f, 0.f, 0.f, 0.f}; } while (0)

__device__ __forceinline__ void build_ct(LAS unsigned char* lds0, const int l, const int h, const int lane, const int wave) {
    LAS unsigned char* const& lds = lds0; const int c = h * 64 + lane;
    const float* mu = INP(I_CMU) + (size_t)l * 896;
    if (wave == 0) { LAS float* ct = (LAS float*)(lds0 + O_CT);
        ct[0 * 64 + lane] = mu[c]; ct[1 * 64 + lane] = mu[256 + c]; ct[2 * 64 + lane] = mu[512 + c]; ct[3 * 64 + lane] = mu[768 + lane]; ct[4 * 64 + lane] = mu[832 + lane];
        ct[5 * 64 + lane] = INP(I_CW0)[l * 256 + c]; ct[6 * 64 + lane] = INP(I_CA0)[l * 256 + c]; ct[7 * 64 + lane] = INP(I_CKK)[l * 256 + c]; ct[8 * 64 + lane] = INP(I_CKA)[l * 256 + c];
        ct[9 * 64 + lane] = INP(I_CRK)[l * 256 + c]; ct[10 * 64 + lane] = INP(I_CGNW)[l * 256 + c]; ct[11 * 64 + lane] = INP(I_CGNB)[l * 256 + c]; ct[12 * 64 + lane] = l > 0 ? INP(I_CV0)[(l - 1) * 256 + c] : 0.f;
        ct[13 * 64 + lane] = mu[512 + lane]; ct[14 * 64 + lane] = mu[512 + lane + 64]; ct[15 * 64 + lane] = mu[512 + lane + 128]; ct[16 * 64 + lane] = mu[512 + lane + 192]; }
}
template <int MODE>
__device__ __forceinline__ void chunk(LAS unsigned char* lds0, const int l, const int b, const int h, const int t0, unsigned char* gz, unsigned char* gz2, float* bong, const bf16* P, bf16* VF, bf16* OB, const int tid0) {
    const int c = h * 64 + (tid0 & 63);
    {
        unsigned lb_ = 0u; int tid_l = tid0; asm volatile("" : "+v"(lb_), "+v"(tid_l));
        const int tid = tid_l, lane = tid & 63, wave = __builtin_amdgcn_readfirstlane(tid >> 6);
        LAS unsigned char* lds = lds0 + lb_;
        LAS bf16* TAB = (LAS bf16*)(lds + O_TAB); const LAS unsigned* TABW = (const LAS unsigned*)(lds + O_TAB);
        LAS bf16* scr = (LAS bf16*)(lds + O_SCR + wave * 1024);
        LAS float* CUM = (LAS float*)(lds + O_CUM);
        LAS float* TOT = (LAS float*)(lds + O_TOT);
        LAS float* GAM = (LAS float*)(lds + O_GAM);
        LAS float* MABF = (LAS float*)(lds + O_MABF);
        LAS float* YF = (LAS float*)(lds + O_YF);
        LAS float* BON = (LAS float*)(lds + O_BON);
        const LAS float* CT = (const LAS float*)(lds + O_CT);
#define CTV(k) CT[(k) * 64 + lane]
        LAS float* ASF = (LAS float*)(lds + O_TAB);
        LAS bf16* GSF = (LAS bf16*)(lds + O_STT);
        float Xr[9], Xg[9]; unsigned RK[9], VX[9], Va[9], Vb[9];
        { const float* cw2 = INP(I_CW2) + (size_t)l * 32 * 256; const float* ca2 = INP(I_CA2) + (size_t)l * 32 * 256; const float* cg2 = INP(I_CG2) + (size_t)l * 64 * 256;
          float twa[8], tg[8];
#pragma unroll
          for (int u = 0; u < 8; ++u) { const int i = tid + u * NTHR, mm = i >> 6, cc = i & 63;
              twa[u] = mm < 32 ? cw2[mm * 256 + h * 64 + cc] : ca2[(mm - 32) * 256 + h * 64 + cc]; tg[u] = cg2[mm * 256 + h * 64 + cc]; }
          float t2[2], t1[8];
          if (l > 0) { const float* cv1 = INP(I_CV1) + (size_t)(l - 1) * 256 * 16; const float* cv2 = INP(I_CV2) + (size_t)(l - 1) * 16 * 256;
#pragma unroll
            for (int u = 0; u < 2; ++u) { const int i = tid + u * NTHR; t2[u] = cv2[(i >> 6) * 256 + h * 64 + (i & 63)]; }
#pragma unroll
            for (int u = 0; u < 8; ++u) t1[u] = cv1[tid + u * NTHR]; }
#pragma unroll
          for (int j = 0; j < 9; ++j) { const int t = t0 + wave * 8 - 1 + j; const bool ok_ = t >= 0; const size_t m_ = (size_t)b * T + (ok_ ? t : 0); const bf16* row_ = P + m_ * PP + C_C;
              Xr[j] = ok_ ? bf2f(row_[768 + lane]) : 0.f; Xg[j] = ok_ ? bf2f(row_[832 + lane]) : 0.f;
              RK[j] = ok_ ? ((unsigned)row_[c] | ((unsigned)row_[256 + c] << 16)) : 0u; VX[j] = ok_ ? (unsigned)row_[512 + c] : 0u;
              if (l > 0) { Va[j] = ok_ ? ((unsigned)row_[512 + lane] | ((unsigned)row_[512 + lane + 64] << 16)) : 0u; Vb[j] = ok_ ? ((unsigned)row_[512 + lane + 128] | ((unsigned)row_[512 + lane + 192] << 16)) : 0u;
                  if (j > 0) VX[j] |= (unsigned)VF[m_ * 256 + c] << 16; } }
#pragma unroll
          for (int u = 0; u < 8; ++u) { const int i = tid + u * NTHR, mm = i >> 6, cc = i & 63;
              *(LAS bf16*)(lds + O_BCN + (cc * LS + mm) * 2) = (bf16)f2bf(twa[u]); *(LAS bf16*)(lds + O_KCN + (cc * LS + mm) * 2) = (bf16)f2bf(tg[u]); }
#define PIX(i) ((((i) >> 7) * 64 + ((i) & 63)) * 2 + (((i) >> 6) & 1))
          if (l > 0) {
#pragma unroll
            for (int u = 0; u < 2; ++u) { const int i = tid + u * NTHR; TAB[8192 + PIX(i)] = (bf16)f2bf(t2[u]); }
#pragma unroll
            for (int u = 0; u < 8; ++u) { const int i = tid + u * NTHR; const int cc = i >> 4, qq = i & 15; TAB[9216 + ((cc >> 1) * 16 + qq) * 2 + (cc & 1)] = (bf16)f2bf(t1[u]); } } }
#undef PIX
        {
#pragma unroll
          for (int q = 0; q < 8; ++q) { const int tt = wave * 8 + q;
              const float xx = Xr[q + 1] + (Xr[q] - Xr[q + 1]) * CTV(3), xg = Xg[q + 1] + (Xg[q] - Xg[q + 1]) * CTV(4);
              *(LAS bf16*)(lds + O_AHN + (tt * LS + lane) * 2) = (bf16)f2bf(lane < 32 ? tanhf_(xx) : xx);
              *(LAS bf16*)(lds + O_RHN + (tt * LS + lane) * 2) = (bf16)f2bf(sigmoidf_(xg)); } }
        __syncthreads();
        { const int tr = wave >> 1;
          const bf16x8 a0 = ldfrag(lds, O_AHN, tr * 16, 0, lane), a1 = ldfrag(lds, O_AHN, tr * 16, 1, lane), g0 = ldfrag(lds, O_RHN, tr * 16, 0, lane), g1 = ldfrag(lds, O_RHN, tr * 16, 1, lane);
#pragma unroll
          for (int cI = 0; cI < 2; ++cI) { const int tc = (wave & 1) * 2 + cI;
              const bf16x8 b0 = ldfrag(lds, O_BCN, tc * 16, 0, lane), b1 = ldfrag(lds, O_BCN, tc * 16, 1, lane), c0 = ldfrag(lds, O_KCN, tc * 16, 0, lane), c1 = ldfrag(lds, O_KCN, tc * 16, 1, lane);
              const f4 z = (f4){0.f, 0.f, 0.f, 0.f};
              const f4 aw = __builtin_amdgcn_mfma_f32_16x16x32_bf16(a0, b0, z, 0, 0, 0), aa = __builtin_amdgcn_mfma_f32_16x16x32_bf16(a1, b1, z, 0, 0, 0);
              f4 ag = __builtin_amdgcn_mfma_f32_16x16x32_bf16(g0, c0, z, 0, 0, 0); ag = __builtin_amdgcn_mfma_f32_16x16x32_bf16(g1, c1, ag, 0, 0, 0);
              const int col = tc * 16 + (lane & 15), row = tr * 16 + 4 * (lane >> 4);
#pragma unroll
              for (int e = 0; e < 4; ++e) { CUM[(row + e) * 64 + col] = aw[e]; ASF[(row + e) * 64 + col] = aa[e]; GSF[(row + e) * 64 + col] = (bf16)f2bf(ag[e]); } } }
        __syncthreads();
        { float run = 0.f;
#pragma unroll
            for (int q = 0; q < 8; ++q) { const int tt = wave * 8 + q;
                const float wsum = CTV(5) + CUM[tt * 64 + lane];
                run += -0.6065306597f * sigmoidf_(wsum); CUM[tt * 64 + lane] = run; }
            TOT[wave * 64 + lane] = run; }
        __syncthreads();
        float offs = 0.f, cumL = 0.f;
#pragma unroll
        for (int w2 = 0; w2 < 8; ++w2) { const float tw = TOT[w2 * 64 + lane]; offs += (w2 < wave) ? tw : 0.f; cumL += tw; }
        if (wave == 0) GAM[lane] = __expf(cumL);
#define LO_(x) __uint_as_float((x) << 16)
#define HI_(x) __uint_as_float((x) & 0xffff0000u)
#pragma unroll
        for (int q = 0; q < 8; ++q) {
            const int tt = wave * 8 + q; const size_t m = (size_t)b * T + t0 + tt;
            const unsigned pRK = RK[q], cRK = RK[q + 1], pVX = VX[q], cVX = VX[q + 1], pVa = Va[q], cVa = Va[q + 1], pVb = Vb[q], cVb = Vb[q + 1];
            const float r = LO_(cRK) + (LO_(pRK) - LO_(cRK)) * CTV(0), k = HI_(cRK) + (HI_(pRK) - HI_(cRK)) * CTV(1); float v = LO_(cVX) + (LO_(pVX) - LO_(cVX)) * CTV(2);
            const float asum = CTV(6) + ASF[tt * 64 + lane]; const unsigned gbits = (unsigned)GSF[tt * 64 + lane];
            const float cq = CUM[tt * 64 + lane], cprev = q > 0 ? CUM[(tt - 1) * 64 + lane] : 0.f;
            if (l > 0) {
                LAS bf16* vsc = scr + 128;
                vsc[lane] = (bf16)f2bf(LO_(cVa) + (LO_(pVa) - LO_(cVa)) * CTV(13)); vsc[lane + 64] = (bf16)f2bf(HI_(cVa) + (HI_(pVa) - HI_(cVa)) * CTV(14));
                vsc[lane + 128] = (bf16)f2bf(LO_(cVb) + (LO_(pVb) - LO_(cVb)) * CTV(15)); vsc[lane + 192] = (bf16)f2bf(HI_(cVb) + (HI_(pVb) - HI_(cVb)) * CTV(16));
                asm volatile("s_waitcnt lgkmcnt(0)" ::: "memory");
                const int qq = lane & 15, part = lane >> 4; float s = 0.f; { float s1 = 0.f; const LAS unsigned* sv = (const LAS unsigned*)vsc;
#pragma unroll
                for (int p = 0; p < 32; p += 2) { s = dot2(sv[part * 32 + p], TABW[4608 + (part * 32 + p) * 16 + qq], s); s1 = dot2(sv[part * 32 + p + 1], TABW[4608 + (part * 32 + p + 1) * 16 + qq], s1); }
                s += s1; }
                s += __shfl_xor(s, 16); s += __shfl_xor(s, 32);
                float vl = CTV(12);
#pragma unroll
                for (int q2 = 0; q2 < 16; ++q2) vl += __shfl(s, q2) * bf2f(TAB[8192 + ((q2 >> 1) * 64 + lane) * 2 + (q2 & 1)]);
                const float vf = HI_(cVX); v = v + (vf - v) * sigmoidf_(vl);
            }
            if (MODE < 5) VF[m * 256 + c] = (bf16)f2bf(v);
            const float asig = sigmoidf_(asum), lw = cq - cprev;
            float kk = k * CTV(7); const float n2 = wave_sum(kk * kk); kk = kk * __builtin_amdgcn_rsqf(fmaxf(n2, 1e-24f));
            const float kmod = k * (1.f + (asig - 1.f) * CTV(8));
            const float bon = wave_sum(r * kmod * CTV(9));
            const float cum = offs + cq, cumx = cum - lw;
            const float ah = -kk * __expf(cumx), rh = r * __expf(cum), ei = __expf(-cum), bb = kk * asig, bc = bb * ei, kc = kmod * ei, ee = __expf(cumL - cum), bt = bb * ee, kt = kmod * ee;
            const int no = (tt * LS + lane) * 2, to = (lane * LS + tt) * 2;
            *(LAS bf16*)(lds + O_AHN + no) = (bf16)f2bf(ah); *(LAS bf16*)(lds + O_RHN + no) = (bf16)f2bf(rh);
            *(LAS bf16*)(lds + O_BCN + no) = (bf16)f2bf(bc); *(LAS bf16*)(lds + O_KCN + no) = (bf16)f2bf(kc); if (MODE < 5) ((bf16*)(gz2 + 16384))[tt * 64 + lane] = (bf16)gbits;
            *(LAS bf16*)(lds + O_AHT + to) = (bf16)f2bf(ah); *(LAS bf16*)(lds + O_BTT + to) = (bf16)f2bf(bt);
            *(LAS bf16*)(lds + O_KTT + to) = (bf16)f2bf(kt); *(LAS bf16*)(lds + O_VT + to) = (bf16)f2bf(v);
            if (MODE < 5 && lane == 0) bong[tt] = bon;
            asm volatile("s_waitcnt lgkmcnt(0)" ::: "memory");
        }
        __syncthreads();
        if (MODE == 6) return;
        { f4 acc[2];
            RW_ZERO(acc); mm64(acc, lds, O_AHN, O_BCN, wave, lane);
#pragma unroll
            for (int cI = 0; cI < 2; ++cI) { const int col = ((wave & 1) * 2 + cI) * 16 + (lane & 15), row = (wave >> 1) * 16 + 4 * (lane >> 4);
#pragma unroll
                for (int e = 0; e < 4; ++e) MABF[(row + e) * 64 + col] = (col < row + e) ? acc[cI][e] : 0.f; }
            RW_ZERO(acc); mm64(acc, lds, O_AHN, O_KCN, wave, lane); storeN<1>(lds, O_MAK, acc, wave, lane);
            { f4 accb[2]; RW_ZERO(accb); mm64(accb, lds, O_RHN, O_BCN, wave, lane); f4 accc[2]; RW_ZERO(accc); mm64(accc, lds, O_RHN, O_KCN, wave, lane);
                storeN<2>(lds, O_MRB, accb, wave, lane); storeN<2>(lds, O_MRK, accc, wave, lane); }
        }
        __syncthreads();
        {
            const int cS = wave * 8 + (lane >> 3), tS = lane & 7;
            float xs[8];
#pragma unroll
            for (int k = 0; k < 8; ++k) xs[k] = 0.f;
#pragma unroll
            for (int i = 1; i < 64; ++i) {
                float part = 0.f;
#pragma unroll
                for (int k = 0; k < (i + 7) / 8; ++k) { const float mv = MABF[i * 64 + tS + 8 * k]; part += ((tS + 8 * k) < i ? mv : 0.f) * xs[k]; }
                part += __builtin_bit_cast(float, __builtin_amdgcn_update_dpp(0, __builtin_bit_cast(int, part), 0xB1, 0xF, 0xF, true));
                part += __builtin_bit_cast(float, __builtin_amdgcn_update_dpp(0, __builtin_bit_cast(int, part), 0x4E, 0xF, 0xF, true));
                part += __builtin_bit_cast(float, __builtin_amdgcn_update_dpp(0, __builtin_bit_cast(int, part), 0x141, 0xF, 0xF, true));
                const float xi = MABF[i * 64 + cS] + part;
                xs[i >> 3] = (tS == (i & 7)) ? xi : xs[i >> 3];
            }
#pragma unroll
            for (int k = 0; k < 8; ++k) { const int i = tS + 8 * k; *(LAS bf16*)(lds + O_TINV + (i * LS + cS) * 2) = (bf16)f2bf(i == cS ? 1.f : xs[k]); }
        }
        __syncthreads();
        { f4 acc[2]; RW_ZERO(acc); mm64(acc, lds, O_MAK, O_VT, wave, lane); storeT(lds, O_MVT, acc, wave, lane); }
        __syncthreads();
        if (MODE == 1 || MODE == 5) {
            { f4 acc[2]; RW_ZERO(acc); mm64(acc, lds, O_TINV, O_AHT, wave, lane); storeT(lds, O_UT, acc, wave, lane); }
            { f4 acc[2]; RW_ZERO(acc); mm64(acc, lds, O_TINV, O_MVT, wave, lane); storeT(lds, O_MAK, acc, wave, lane); }
            __syncthreads();
            f4 agm[2], azm[2], ar2[2], ay0[2];
            RW_ZERO(agm); mm64(agm, lds, O_BTT, O_UT, wave, lane);
#pragma unroll
            for (int cI = 0; cI < 2; ++cI) { const int col = ((wave & 1) * 2 + cI) * 16 + (lane & 15), row = (wave >> 1) * 16 + 4 * (lane >> 4);
#pragma unroll
                for (int e = 0; e < 4; ++e) if (col == row + e) agm[cI][e] += GAM[col]; }
            RW_ZERO(azm); mm64(azm, lds, O_BTT, O_MAK, wave, lane); mm64(azm, lds, O_KTT, O_VT, wave, lane);
            RW_ZERO(ar2); mm64(ar2, lds, O_MRB, O_UT, wave, lane);
#pragma unroll
            for (int cI = 0; cI < 2; ++cI) { const int col = ((wave & 1) * 2 + cI) * 16 + (lane & 15), row = (wave >> 1) * 16 + 4 * (lane >> 4);
#pragma unroll
                for (int e = 0; e < 4; ++e) ar2[cI][e] += bf2f(*(const LAS bf16*)(lds + O_RHN + ((row + e) * LS + col) * 2)); }
            RW_ZERO(ay0); mm64(ay0, lds, O_MRB, O_MAK, wave, lane); mm64(ay0, lds, O_MRK, O_VT, wave, lane);
            __syncthreads();
            storeN<0>(lds, O_AHN, agm, wave, lane); storeT(lds, O_RHN, azm, wave, lane); storeN<0>(lds, O_BCN, ar2, wave, lane); storeT(lds, O_KCN, ay0, wave, lane);
            __syncthreads();
            if (MODE == 1) { const int io = ((tid >> 3) * LS + (tid & 7) * 8) * 2;
              ((u32x4*)gz)[tid] = *(const LAS u32x4*)(lds + O_AHN + io); ((u32x4*)(gz + 8192))[tid] = *(const LAS u32x4*)(lds + O_RHN + io);
              ((u32x4*)gz2)[tid] = *(const LAS u32x4*)(lds + O_BCN + io); ((u32x4*)(gz2 + 8192))[tid] = *(const LAS u32x4*)(lds + O_KCN + io); }
        } else {
            { f4 acc[2]; RW_ZERO(acc); mm64(acc, lds, O_TINV, O_AHT, wave, lane); storeN<0>(lds, O_A2N, acc, wave, lane); }
            __syncthreads();
            { f4 acc[2]; RW_ZERO(acc); mm64(acc, lds, O_TINV, O_MVT, wave, lane); mm64(acc, lds, O_A2N, O_STT, wave, lane); storeT(lds, O_UT, acc, wave, lane); }
            __syncthreads();
            f4 yacc[2]; RW_ZERO(yacc);
            mm64(yacc, lds, O_RHN, O_STT, wave, lane); mm64(yacc, lds, O_MRB, O_UT, wave, lane); mm64(yacc, lds, O_MRK, O_VT, wave, lane);
            __syncthreads();
#pragma unroll
            for (int cI = 0; cI < 2; ++cI) { const int col = ((wave & 1) * 2 + cI) * 16 + (lane & 15), row = (wave >> 1) * 16 + 4 * (lane >> 4);
#pragma unroll
                for (int e = 0; e < 4; ++e) YF[(row + e) * 64 + col] = yacc[cI][e]; }
            __syncthreads();
            { unsigned gcur = (unsigned)OB[((size_t)b * T + t0 + wave * 8) * 1024 + 512 + c];
#pragma unroll 1
            for (int q = 0; q < 8; ++q) {
                const int tt = wave * 8 + q; const size_t m = (size_t)b * T + t0 + tt;
                const unsigned gnxt = (unsigned)OB[(m + (q < 7 ? 1 : 0)) * 1024 + 512 + c];
                const float y = YF[tt * 64 + lane]; const float mean = wave_sum(y) * (1.f / 64.f); const float dy = y - mean; const float var = wave_sum(dy * dy) * (1.f / 64.f);
                const float yn = dy * rsqrtf(var + 64e-5f) * CTV(10) + CTV(11);
                const float vv = bf2f(*(const LAS bf16*)(lds + O_VT + (lane * LS + tt) * 2)), gg = LO_(gcur);
                OB[m * 1024 + 512 + c] = (bf16)f2bf((yn + BON[tt] * vv) * gg);
                gcur = gnxt;
            } }
        }
        __syncthreads();
#undef CTV
#undef LO_
#undef HI_
    }
}

__device__ __forceinline__ void chunk_out(LAS unsigned char* lds0, const int b, const int h, const int t0, const unsigned char* gz, const unsigned char* gz2, const float* bong, const bf16* VF, bf16* OB, const int tid0) {
    unsigned lb_ = 0u; int tid_l = tid0; asm volatile("" : "+v"(lb_), "+v"(tid_l));
    LAS unsigned char* lds = lds0 + lb_; const int tid = tid_l, lane = tid & 63, wave = __builtin_amdgcn_readfirstlane(tid >> 6);
    const int c = h * 64 + lane;
    const LAS float* CT = (const LAS float*)(lds + O_CT);
    LAS float* YF = (LAS float*)(lds + O_YF);
    const int io = ((tid >> 3) * LS + (tid & 7) * 8) * 2;
    const u32x4 sv = ((const u32x4*)gz)[tid], rv = ((const u32x4*)gz2)[tid];
    u32x2 yv[2];
#pragma unroll
    for (int k = 0; k < 2; ++k) { const int col = ((wave & 1) * 2 + k) * 16 + (lane & 15), row = (wave >> 1) * 16 + 4 * (lane >> 4); yv[k] = *(const u32x2*)(gz2 + 8192 + (col * 64 + row) * 2); }
    float gq[8], vq[8], bq[8];
#pragma unroll
    for (int q = 0; q < 8; ++q) { const int tt = wave * 8 + q; const size_t m = (size_t)b * T + t0 + tt;
        gq[q] = bf2f(((const bf16*)(gz2 + 16384))[tt * 64 + lane]); vq[q] = bf2f(VF[m * 256 + c]); bq[q] = bong[tt]; }
    *(LAS u32x4*)(lds + O_STT + io) = sv; *(LAS u32x4*)(lds + O_AHN + io) = rv;
    __syncthreads();
    f4 acc[2];
#pragma unroll
    for (int k = 0; k < 2; ++k) acc[k] = (f4){__uint_as_float(yv[k].x << 16), __uint_as_float(yv[k].x & 0xffff0000u), __uint_as_float(yv[k].y << 16), __uint_as_float(yv[k].y & 0xffff0000u)};
    mm64(acc, lds, O_AHN, O_STT, wave, lane);
#pragma unroll
    for (int cI = 0; cI < 2; ++cI) { const int col = ((wave & 1) * 2 + cI) * 16 + (lane & 15), row = (wave >> 1) * 16 + 4 * (lane >> 4);
#pragma unroll
        for (int e = 0; e < 4; ++e) YF[(row + e) * 64 + col] = acc[cI][e]; }
    __syncthreads();
#pragma unroll
    for (int q = 0; q < 8; ++q) { const int tt = wave * 8 + q; const size_t m = (size_t)b * T + t0 + tt;
        const float y = YF[tt * 64 + lane]; const float mean = wave_sum(y) * (1.f / 64.f); const float dy = y - mean; const float var = wave_sum(dy * dy) * (1.f / 64.f);
        const float yn = dy * rsqrtf(var + 64e-5f) * CT[10 * 64 + lane] + CT[11 * 64 + lane];
        OB[m * 1024 + 512 + c] = (bf16)f2bf((yn + bq[q] * vq[q]) * gq[q]); }
    __syncthreads();
}

__device__ __forceinline__ void carry(LAS unsigned char* lds0, unsigned char* gzc  , const int tid0) {
    f4 stacc[2]; RW_ZERO(stacc);
    { unsigned lb_ = 0u; asm volatile("" : "+v"(lb_)); LAS unsigned char* lds = lds0 + lb_; for (int i = tid0; i < MB / 4; i += NTHR) ((LAS unsigned*)(lds + O_STT))[i] = 0u; }
    u32x4 gnx = ((const u32x4*)gzc)[tid0];
    u32x2 znx[2];
    { const int lane = tid0 & 63, wave = tid0 >> 6;
#pragma unroll
      for (int k = 0; k < 2; ++k) { const int col = ((wave & 1) * 2 + k) * 16 + (lane & 15), row = (wave >> 1) * 16 + 4 * (lane >> 4); znx[k] = *(const u32x2*)(gzc + 8192 + (col * 64 + row) * 2); } }
#pragma unroll 1
    for (int cI = 0; cI < T / 64; ++cI) {
        unsigned lb_ = 0u; int tid_l = tid0; asm volatile("" : "+v"(lb_), "+v"(tid_l));
        LAS unsigned char* lds = lds0 + lb_; const int tid = tid_l, lane = tid & 63, wave = __builtin_amdgcn_readfirstlane(tid >> 6);
        unsigned char* rec = gzc + (size_t)cI * 16384;
        const int io = ((tid >> 3) * LS + (tid & 7) * 8) * 2;
        *(LAS u32x4*)(lds + O_AHN + io) = gnx;
        u32x2 zv[2]; zv[0] = znx[0]; zv[1] = znx[1];
        if (cI + 1 < T / 64) { gnx = ((const u32x4*)(rec + 16384))[tid];
#pragma unroll
            for (int k = 0; k < 2; ++k) { const int col = ((wave & 1) * 2 + k) * 16 + (lane & 15), row = (wave >> 1) * 16 + 4 * (lane >> 4); znx[k] = *(const u32x2*)(rec + 16384 + 8192 + (col * 64 + row) * 2); } }
        __syncthreads();
        ((u32x4*)rec)[tid] = *(const LAS u32x4*)(lds + O_STT + io);
        f4 acc[2];
#pragma unroll
        for (int k = 0; k < 2; ++k) acc[k] = (f4){__uint_as_float(zv[k].x << 16), __uint_as_float(zv[k].x & 0xffff0000u), __uint_as_float(zv[k].y << 16), __uint_as_float(zv[k].y & 0xffff0000u)};
        mm64(acc, lds, O_AHN, O_STT, wave, lane);
        __syncthreads();
        storeT(lds, O_STT, acc, wave, lane);
    }
}
}

namespace mb {
using rw::LS; using rw::MB; using rw::f4; using rw::mm64; using rw::storeN; using rw::bf16x8;
constexpr int O_CN = 0, O_BN = MB, O_BT = 2 * MB, O_XT0 = 3 * MB, O_XW0 = 5 * MB, O_CS0 = 7 * MB, O_HN0 = 9 * MB, O_SC0 = 11 * MB, O_SM = 13 * MB, O_YF = O_XW0;
static_assert(O_SM + 2048 <= LDS_BYTES - 576, "mamba LDS map");
__device__ __forceinline__ void chain(LAS unsigned char* lds0, const int l, const int b, const int gI, const bf16* P, bf16* OB, const int tid0, const int lane0, const int wave0) {
    const int tid = tid0, lane = lane0, wave = wave0;
    LAS unsigned char* const& lds = lds0;
    const float* cwp = INP(I_DCW) + (size_t)l * 4 * 512; const float* cbp = INP(I_DCB) + (size_t)l * 512;
    const int cc = tid & 255, sub = tid >> 8;
    const int col = cc < 128 ? (gI * 128 + cc) : (cc < 192 ? (256 + gI * 64 + (cc - 128)) : (384 + gI * 64 + (cc - 192)));
    const float cw0 = cwp[col], cw1 = cwp[512 + col], cw2 = cwp[1024 + col], cw3 = cwp[1536 + col], cb = cbp[col];
    f4 hacc[2][2];
#pragma unroll
    for (int hh = 0; hh < 2; ++hh) { hacc[hh][0] = (f4){0.f, 0.f, 0.f, 0.f}; hacc[hh][1] = (f4){0.f, 0.f, 0.f, 0.f}; }
    for (int i = tid; i < 2 * MB / 4; i += NTHR) ((LAS unsigned*)(lds0 + O_HN0))[i] = 0u;
    const float dtb0 = INP(I_DDTB)[l * 4 + gI * 2], dtb1 = INP(I_DDTB)[l * 4 + gI * 2 + 1];
    const float nA0 = -__expf(INP(I_DALOG)[l * 4 + gI * 2]), nA1 = -__expf(INP(I_DALOG)[l * 4 + gI * 2 + 1]);
    const float dsk0 = INP(I_DSKIP)[l * 4 + gI * 2], dsk1 = INP(I_DSKIP)[l * 4 + gI * 2 + 1];
    const float nw0 = INP(I_DNW)[l * 256 + gI * 128 + lane], nw1 = INP(I_DNW)[l * 256 + gI * 128 + 64 + lane];
#pragma unroll 1
    for (int t0 = 0; t0 < T; t0 += 64) {
        unsigned lb_ = 0u; int tid_l = tid0; asm volatile("" : "+v"(lb_), "+v"(tid_l));
        const int tid = tid_l, lane = tid & 63, wave = __builtin_amdgcn_readfirstlane(tid >> 6);
        LAS unsigned char* lds = lds0 + lb_;
        LAS float* SM = (LAS float*)(lds + O_SM);
        LAS float* YF = (LAS float*)(lds + O_YF);
        if (wave < 2) {
            const size_t m = (size_t)b * T + t0 + lane;
            const float dt = softplusf_(bf2f(P[m * PP + C_DT + gI * 2 + wave]) + (wave == 0 ? dtb0 : dtb1));
            float cs = dt * (wave == 0 ? nA0 : nA1);
#pragma unroll
            for (int o = 1; o < 64; o <<= 1) { const float y = __shfl_up(cs, o); if (lane >= o) cs += y; }
            const float cL = __shfl(cs, 63);
            SM[wave * 64 + lane] = dt; SM[128 + wave * 64 + lane] = cs; SM[256 + wave * 64 + lane] = __expf(cL - cs) * dt; SM[384 + wave * 64 + lane] = __expf(cs);
        }
        __syncthreads();
        { float h0, h1, h2, cur[8], nxt[8];
          { const int tb = t0 + sub * 32; h0 = tb >= 3 ? bf2f(P[((size_t)b * T + tb - 3) * PP + C_DX + col]) : 0.f; h1 = tb >= 2 ? bf2f(P[((size_t)b * T + tb - 2) * PP + C_DX + col]) : 0.f; h2 = tb >= 1 ? bf2f(P[((size_t)b * T + tb - 1) * PP + C_DX + col]) : 0.f;
#pragma unroll
            for (int j = 0; j < 8; ++j) cur[j] = bf2f(P[((size_t)b * T + tb + j) * PP + C_DX + col]); }
#pragma unroll 1
          for (int g8 = 0; g8 < 4; ++g8) {
            const int tb = t0 + sub * 32 + g8 * 8 + (g8 < 3 ? 8 : 0);
#pragma unroll
            for (int j = 0; j < 8; ++j) nxt[j] = bf2f(P[((size_t)b * T + tb + j) * PP + C_DX + col]);
#pragma unroll
            for (int j = 0; j < 8; ++j) {
                const int tt = sub * 32 + g8 * 8 + j;
                const float a = siluf_(cb + cw3 * cur[j] + cw2 * h2 + cw1 * h1 + cw0 * h0);
                h0 = h1; h1 = h2; h2 = cur[j];
                if (cc < 128) { const int hh = cc >> 6, p = cc & 63;
                    *(LAS bf16*)(lds + O_XT0 + hh * MB + (p * LS + tt) * 2) = (bf16)f2bf(a); *(LAS bf16*)(lds + O_XW0 + hh * MB + (p * LS + tt) * 2) = (bf16)f2bf(a * SM[256 + hh * 64 + tt]); }
                else if (cc < 192) { const int n = cc - 128; *(LAS bf16*)(lds + O_BN + (tt * LS + n) * 2) = (bf16)f2bf(a); *(LAS bf16*)(lds + O_BT + (n * LS + tt) * 2) = (bf16)f2bf(a); }
                else { const int n = cc - 192; *(LAS bf16*)(lds + O_CN + (tt * LS + n) * 2) = (bf16)f2bf(a);
                    *(LAS bf16*)(lds + O_CS0 + (tt * LS + n) * 2) = (bf16)f2bf(a * SM[384 + tt]); *(LAS bf16*)(lds + O_CS0 + MB + (tt * LS + n) * 2) = (bf16)f2bf(a * SM[384 + 64 + tt]); }
            }
#pragma unroll
            for (int j = 0; j < 8; ++j) cur[j] = nxt[j];
          } }
        __syncthreads();
        { f4 acc[2]; acc[0] = (f4){0.f, 0.f, 0.f, 0.f}; acc[1] = (f4){0.f, 0.f, 0.f, 0.f}; mm64(acc, lds, O_CN, O_BN, wave, lane);
#pragma unroll
            for (int hh = 0; hh < 2; ++hh) { f4 sc[2];
#pragma unroll
                for (int cI = 0; cI < 2; ++cI) { const int s = ((wave & 1) * 2 + cI) * 16 + (lane & 15), row = (wave >> 1) * 16 + 4 * (lane >> 4);
                    const float cs = SM[128 + hh * 64 + s], ds = SM[hh * 64 + s];
#pragma unroll
                    for (int e = 0; e < 4; ++e) { const float ct = SM[128 + hh * 64 + row + e]; sc[cI][e] = (s <= row + e) ? acc[cI][e] * __expf(ct - cs) * ds : 0.f; } }
                storeN<0>(lds, O_SC0 + hh * MB, sc, wave, lane); } }
        __syncthreads();
        f4 yacc[2][2];
#pragma unroll
        for (int hh = 0; hh < 2; ++hh) {
            yacc[hh][0] = (f4){0.f, 0.f, 0.f, 0.f}; yacc[hh][1] = (f4){0.f, 0.f, 0.f, 0.f};
            mm64(yacc[hh], lds, O_SC0 + hh * MB, O_XT0 + hh * MB, wave, lane); mm64(yacc[hh], lds, O_CS0 + hh * MB, O_HN0 + hh * MB, wave, lane);
            const float gL = SM[384 + hh * 64 + 63]; hacc[hh][0] = hacc[hh][0] * gL; hacc[hh][1] = hacc[hh][1] * gL;
            mm64(hacc[hh], lds, O_XW0 + hh * MB, O_BT, wave, lane);
        }
        __syncthreads();
#pragma unroll
        for (int hh = 0; hh < 2; ++hh) {
#pragma unroll
            for (int cI = 0; cI < 2; ++cI) { const int colp = ((wave & 1) * 2 + cI) * 16 + (lane & 15), row = (wave >> 1) * 16 + 4 * (lane >> 4);
#pragma unroll
                for (int e = 0; e < 4; ++e) YF[(row + e) * 128 + hh * 64 + colp] = yacc[hh][cI][e]; }
            storeN<0>(lds, O_HN0 + hh * MB, hacc[hh], wave, lane);
        }
        __syncthreads();
#pragma unroll
        for (int q = 0; q < 8; ++q) {
            const int tt = wave * 8 + q; const size_t m = (size_t)b * T + t0 + tt;
            const float x0 = bf2f(*(const LAS bf16*)(lds + O_XT0 + (lane * LS + tt) * 2)), x1 = bf2f(*(const LAS bf16*)(lds + O_XT0 + MB + (lane * LS + tt) * 2));
            const int c0 = gI * 128 + lane, c1 = c0 + 64;
            const float z0 = bf2f(P[m * PP + C_DZ + c0]), z1 = bf2f(P[m * PP + C_DZ + c1]);
            const float y0 = (YF[tt * 128 + lane] + dsk0 * x0) * siluf_(z0), y1 = (YF[tt * 128 + 64 + lane] + dsk1 * x1) * siluf_(z1);
            const float ss = wave_sum(y0 * y0 + y1 * y1); const float rs = rsqrtf(ss * (1.f / 128.f) + 1e-5f);
            OB[m * 1024 + 768 + c0] = (bf16)f2bf(y0 * rs * nw0); OB[m * 1024 + 768 + c1] = (bf16)f2bf(y1 * rs * nw1);
        }
        __syncthreads();
    }
}
}

namespace bsp {
typedef short bf16x8 __attribute__((ext_vector_type(8)));
typedef float f4 __attribute__((ext_vector_type(4)));
constexpr int HS = 129;
constexpr int O_HIST = 0;
constexpr int O_V = 66048;
constexpr int VS = 272;
constexpr int O_KB = O_V + 2 * 32 * VS * 2;
constexpr int KBUF = 20480;
static_assert(O_KB + 2 * KBUF <= LDS_BYTES - 600, "mixer B LDS map");
__device__ __forceinline__ float relu_(float x) { return __int_as_float(max(__float_as_int(x), 0)); }
__device__ __forceinline__ int qkey(float s) { int q = (int)__builtin_fmaf(s, 262144.f, 8388608.f); return q < 1 ? 1 : (q > 16777215 ? 16777215 : q); }
__device__ __forceinline__ unsigned okey(float s) { return (unsigned)qkey(s) << 8; }
__device__ __forceinline__ int f2o(float f) { const int b = __float_as_int(f); return b ^ ((b >> 31) & 0x7fffffff); }
__device__ __forceinline__ float o2f(int o) { return __int_as_float(o ^ ((o >> 31) & 0x7fffffff)); }
__device__ __forceinline__ float fthr(const unsigned Q) {
    const int Qc = (int)(Q < 2u ? 2u : (Q > 16777215u ? 16777215u : Q));
    long long lo = f2o(-64.f), hi = f2o(64.f);
#pragma unroll 1
    for (int i = 0; i < 33; ++i) { const int mid = (int)((lo + hi) >> 1); if (qkey(o2f(mid)) >= Qc) hi = mid; else lo = mid; }
    const float r = o2f((int)hi);
    return Q < 2u ? -INFINITY : (Q > 16777215u ? INFINITY : r);
}
__device__ __forceinline__ void hist_add(const unsigned addr, const unsigned v) { asm volatile("ds_add_u32 %0, %1" :: "v"(addr), "v"(v) : "memory"); }
__device__ __forceinline__ f4 idx_tile(const bf16* Pb, const int kt, const bf16x8 (&qi)[4][2], const float (&wq)[4], const int lane) {
    const bf16* kr = Pb + (size_t)(kt * 16 + (lane & 15)) * PP + C_IK + (lane >> 4) * 8;
    const bf16x8 a0 = *(const bf16x8*)kr, a1 = *(const bf16x8*)(kr + 32);
    f4 s = (f4){0.f, 0.f, 0.f, 0.f};
#pragma unroll
    for (int h = 0; h < 4; ++h) { f4 t = (f4){0.f, 0.f, 0.f, 0.f};
        t = __builtin_amdgcn_mfma_f32_16x16x32_bf16(a0, qi[h][0], t, 0, 0, 0); t = __builtin_amdgcn_mfma_f32_16x16x32_bf16(a1, qi[h][1], t, 0, 0, 0);
#pragma unroll
        for (int e = 0; e < 4; ++e) s[e] += wq[h] * relu_(t[e]); }
    return s;
}

__device__ __forceinline__ void item(LAS unsigned char* lds0, const int bb, const int qb, const bf16* P, bf16* OB, const int tid0, const int pm) {
    unsigned lb_ = 0u; int tid_l = tid0; asm volatile("" : "+v"(lb_), "+v"(tid_l));
    LAS unsigned char* lds = lds0 + lb_; const int tid = tid_l, lane = tid & 63, wave = __builtin_amdgcn_readfirstlane(tid >> 6);
    const bf16* Pb = P + (size_t)bb * T * PP;
    const int ql = wave * 16 + (lane & 15), tq = qb * 128 + ql, g = lane >> 4;
    const bf16* prow = Pb + (size_t)tq * PP;
    bf16x8 qi[4][2]; float wq[4];
#pragma unroll
    for (int h = 0; h < 4; ++h) { qi[h][0] = *(const bf16x8*)(prow + C_IQ + h * 64 + g * 8); qi[h][1] = *(const bf16x8*)(prow + C_IQ + h * 64 + 32 + g * 8); wq[h] = bf2f(prow[C_IW + h]) * 0.0625f; }
    LAS unsigned* hist = (LAS unsigned*)(lds + O_HIST) + ql * HS;
    const unsigned histb = (unsigned)(size_t)hist;
    const int nkt = (qb + 1) * 8;
    unsigned prefix = 0u; int needk = 256;
#pragma unroll 1
    for (int rr = 0; rr < (pm == 102 ? 2 : 1); ++rr) { prefix = 0u; needk = 256;
#pragma unroll 1
    for (int pass = 0; pass < 3; ++pass) {
        for (int i = lane; i < 16 * HS; i += 64) ((LAS unsigned*)(lds + O_HIST) + wave * 16 * HS)[i] = 0u;
        asm volatile("s_waitcnt lgkmcnt(0)" ::: "memory");
        const int shp = 32 - 8 * pass, shb = 24 - 8 * pass;
        float flo = 0.f, fhi = 0.f;
        if (pass > 0) { const float stepw = (pass == 1) ? 65536.f : 256.f; flo = ((float)prefix * stepw - 2.f) * (1.f / 262144.f) - 32.f; fhi = (((float)prefix + 1.f) * stepw + 2.f) * (1.f / 262144.f) - 32.f; }
        const int nsteps = pm >= 300 ? 0 : nkt >> 2;
#define RDX_DMA(stepi, bufi) do { const int st_ = (stepi) < nsteps ? (stepi) : (nsteps - 1); const int S_ = wave * 64 + lane, r_ = S_ >> 3, p_ = S_ & 7; \
            __builtin_amdgcn_global_load_lds((const unsigned*)(Pb + (size_t)(st_ * 64 + r_) * PP + C_IK + ((p_ ^ (r_ & 7)) << 3)), (LAS unsigned*)(lds + O_V + (bufi) * 8192 + wave * 1024), 16, 0, 0); } while (0)
        asm volatile("s_waitcnt vmcnt(0) lgkmcnt(0)" ::: "memory"); __builtin_amdgcn_s_barrier();
        RDX_DMA(0, 0); RDX_DMA(1, 1); RDX_DMA(2, 2);
        float dummy = 0.f;
        auto steps = [&](auto VARc) { constexpr int VAR = decltype(VARc)::value;
#pragma unroll 1
        for (int stp = 0; stp < nsteps; ++stp) {
            if constexpr (VAR != 4) {
            asm volatile("s_waitcnt vmcnt(2)" ::: "memory");
            __builtin_amdgcn_s_barrier();
            RDX_DMA(stp + 3, (stp + 3) & 3); }
            const unsigned kbr = (unsigned)(O_V + (stp & 3) * 8192);
            const int kt4 = stp * 4;
#pragma unroll
            for (int u = 0; u < 4; ++u) {
                bf16x8 ka0, ka1;
                if constexpr (VAR != 4) { ka0 = *(const LAS bf16x8*)(lds + kbr + (u * 16 + (lane & 15)) * 128 + (((0 + g) ^ (lane & 7)) << 4));
                ka1 = *(const LAS bf16x8*)(lds + kbr + (u * 16 + (lane & 15)) * 128 + (((4 + g) ^ (lane & 7)) << 4)); }
                else { ka0 = qi[u][0]; ka1 = qi[u][1]; }
                f4 s = (f4){0.f, 0.f, 0.f, 0.f};
                if constexpr (VAR == 3) { const f4 ta = __builtin_bit_cast(f4, ka0), tb = __builtin_bit_cast(f4, ka1); s = ta + tb; }
                else {
#pragma unroll
                for (int h = 0; h < 4; ++h) { f4 t = (f4){0.f, 0.f, 0.f, 0.f};
                    if constexpr (VAR == 2) { t = __builtin_bit_cast(f4, h & 1 ? ka1 : ka0); }
                    else { t = __builtin_amdgcn_mfma_f32_16x16x32_bf16(ka0, qi[h][0], t, 0, 0, 0); t = __builtin_amdgcn_mfma_f32_16x16x32_bf16(ka1, qi[h][1], t, 0, 0, 0); }
#pragma unroll
                    for (int e = 0; e < 4; ++e) s[e] += wq[h] * relu_(t[e]); } }
                if constexpr (VAR >= 1 && VAR <= 3) { dummy += s[0] + s[1] + s[2] + s[3]; } else {
                if (pass == 0) {
#pragma unroll
                    for (int e = 0; e < 4; ++e) { const int key = (kt4 + u) * 16 + 4 * g + e;
                        if (key <= tq) { const unsigned bin = okey(s[e]) >> 24; hist_add(histb + ((bin >> 1) << 2), (bin & 1u) ? 0x10000u : 1u); } }
                } else {
#pragma unroll
                    for (int e = 0; e < 4; ++e) { const int key = (kt4 + u) * 16 + 4 * g + e;
                        if (s[e] >= flo && s[e] <= fhi && key <= tq) { const unsigned k32 = okey(s[e]);
                            if ((k32 >> shp) == prefix) { const unsigned bin = (k32 >> shb) & 255u; hist_add(histb + ((bin >> 1) << 2), (bin & 1u) ? 0x10000u : 1u); } } }
                } }
            }
        }
        };
        if (pm == 201) steps(std::integral_constant<int, 1>{}); else if (pm == 202) steps(std::integral_constant<int, 2>{}); else if (pm == 203) steps(std::integral_constant<int, 3>{});
        else if (pm == 204) steps(std::integral_constant<int, 4>{}); else steps(std::integral_constant<int, 0>{});
        if (dummy == 12345.678f) hist_add(histb, 1u);
        asm volatile("s_waitcnt vmcnt(0)" ::: "memory");
#undef RDX_DMA
        asm volatile("s_waitcnt lgkmcnt(0)" ::: "memory");
        int cum = 0; unsigned bsel = 0u; int above = 0;
        for (int wd = 127; wd >= 0; --wd) { const unsigned v = hist[wd]; const int hi = (int)(v >> 16), lo = (int)(v & 0xffffu);
            if (cum + hi >= needk) { bsel = (unsigned)(2 * wd + 1); above = cum; break; } cum += hi;
            if (cum + lo >= needk) { bsel = (unsigned)(2 * wd); above = cum; break; } cum += lo; }
        prefix = (prefix << 8) | bsel; needk -= above;
        asm volatile("s_waitcnt lgkmcnt(0)" ::: "memory");
    }
    }
    if (pm >= 200 && pm < 300) { __syncthreads(); return; }
    unsigned thr = prefix; int need = needk;
    bool tie = false;
    if (tq < 256) { thr = 0u; need = 1 << 20; }
    else { const unsigned v = hist[(prefix & 255u) >> 1]; const int ceq = (prefix & 1u) ? (int)(v >> 16) : (int)(v & 0xffffu); tie = needk < ceq; }
    __syncthreads();
    const bool anytie = __any(tie);
    const float sB = fthr(thr);
    unsigned cn = (unsigned)(need > 0xffff ? 0xffff : need) << 16;
    constexpr int O_TC = O_KB + 2 * KBUF + 2048;
    if (g == 0) { *(LAS unsigned*)(lds + O_TC + ql * 8) = thr; *(LAS unsigned*)(lds + O_TC + ql * 8 + 4) = cn; }
    const int tqmin = qb * 128 + wave * 16;
#pragma unroll
    for (int h = 0; h < 4; ++h) { *(LAS bf16x8*)(lds + O_HIST + wave * 8192 + ((h * 2 + 0) * 64 + lane) * 16) = qi[h][0]; *(LAS bf16x8*)(lds + O_HIST + wave * 8192 + ((h * 2 + 1) * 64 + lane) * 16) = qi[h][1]; }
    constexpr int O_WQ = O_KB + 2 * KBUF;
    if (g == 0) {
#pragma unroll
        for (int h = 0; h < 4; ++h) *(LAS float*)(lds + O_WQ + ((wave * 4 + h) * 16 + (lane & 15)) * 4) = wq[h]; }
    bf16x8 qa[4][2];
#pragma unroll
    for (int h = 0; h < 4; ++h) { qa[h][0] = *(const bf16x8*)(prow + C_BQ + h * 64 + g * 8); qa[h][1] = *(const bf16x8*)(prow + C_BQ + h * 64 + 32 + g * 8); }
    f4 oacc[4][4]; float mrun[4], lrun[4];
#pragma unroll
    for (int h = 0; h < 4; ++h) { mrun[h] = -INFINITY; lrun[h] = 0.f;
#pragma unroll
        for (int dt = 0; dt < 4; ++dt) oacc[h][dt] = (f4){0.f, 0.f, 0.f, 0.f}; }
#pragma unroll 1
    for (int rr = 0; rr < (pm == 103 ? 2 : 1); ++rr) {
#pragma unroll
    for (int h = 0; h < 4; ++h) { mrun[h] = -INFINITY; lrun[h] = 0.f;
#pragma unroll
        for (int dt = 0; dt < 4; ++dt) oacc[h][dt] = (f4){0.f, 0.f, 0.f, 0.f}; }
    const int nst = (qb + 1) * 4;
    const int vkey = tid >> 4, vch = tid & 15;
    u32x4 vpre0 = *(const u32x4*)(Pb + (size_t)vkey * PP + C_BV + vch * 8), vpre1 = *(const u32x4*)(Pb + (size_t)vkey * PP + C_BV + 128 + vch * 8);
    const unsigned vrd = (unsigned)(unsigned long)lds + (unsigned)(O_V + (4 * g + ((lane >> 2) & 3)) * (VS * 2) + (lane & 3) * 8);
    __syncthreads();
    const int kr_ = 2 * wave + (lane >> 5), kir_ = wave * 8 + (lane >> 3);
    const bf16* kbase = Pb + (size_t)kr_ * PP + C_BK + (((lane & 31) ^ (kr_ & 15)) << 3);
    const bf16* kibase = Pb + (size_t)kir_ * PP + C_IK + (((lane & 7) ^ (kir_ & 7)) << 3);
#define K_DMA(key_first, kbo) do { const bf16* s0_ = kbase + (size_t)(key_first) * PP; \
        __builtin_amdgcn_global_load_lds((const unsigned*)s0_, (LAS unsigned*)(lds + (kbo) + wave * 1024), 16, 0, 0); \
        __builtin_amdgcn_global_load_lds((const unsigned*)(s0_ + (size_t)16 * PP), (LAS unsigned*)(lds + (kbo) + (wave + 8) * 1024), 16, 0, 0); \
        if (wave < 4) __builtin_amdgcn_global_load_lds((const unsigned*)(kibase + (size_t)(key_first) * PP), (LAS unsigned*)(lds + (kbo) + 16384 + wave * 1024), 16, 0, 0); } while (0)
    K_DMA(0, (unsigned)O_KB);
#pragma unroll 1
    for (int st = 0; st < nst; ++st) {
        const int key0 = st * 32; const unsigned vbuf = (unsigned)(st & 1) * (32 * VS * 2);
        unsigned qio = (unsigned)(O_HIST + wave * 8192 + lane * 16); asm volatile("" : "+v"(qio));
        unsigned wqo = (unsigned)(O_WQ + wave * 256 + (lane & 15) * 4); asm volatile("" : "+v"(wqo));
        unsigned tco = (unsigned)(O_TC + (wave * 16 + (lane & 15)) * 8); asm volatile("" : "+v"(tco));
        { LAS bf16* VL = (LAS bf16*)(lds + O_V + vbuf); *(LAS u32x4*)(VL + vkey * VS + vch * 8) = vpre0; *(LAS u32x4*)(VL + vkey * VS + 128 + vch * 8) = vpre1; }
        asm volatile("s_waitcnt vmcnt(0)" ::: "memory");
        __syncthreads();
        if (st + 1 < nst) K_DMA(key0 + 32, (unsigned)(O_KB + ((st + 1) & 1) * KBUF));
        const unsigned kbc = (unsigned)(O_KB + (st & 1) * KBUF);
#define KQ_(h, k2, ks) (*(const LAS bf16x8*)(lds + kbc + (k2 * 16 + (lane & 15)) * 512 + ((((h) * 8 + (ks) * 4 + g) ^ (lane & 15)) << 4)))
#define KI_(k2, ks) (*(const LAS bf16x8*)(lds + kbc + 16384 + (k2 * 16 + (lane & 15)) * 128 + ((((ks) * 4 + g) ^ (lane & 7)) << 4)))
        const bool active = key0 <= tqmin + 15;
        bool sel[2][4] = {{false, false, false, false}, {false, false, false, false}};
        if (active && pm == 305) {
#pragma unroll
            for (int k2 = 0; k2 < 2; ++k2)
#pragma unroll
                for (int e = 0; e < 4; ++e) sel[k2][e] = (key0 + k2 * 16 + 4 * g + e) <= tq;
        } else if (active) {
            unsigned eqm = 0u;
            const bool plain = !anytie && key0 + 31 <= tqmin;
#pragma unroll
            for (int k2 = 0; k2 < 2; ++k2) { f4 s = (f4){0.f, 0.f, 0.f, 0.f};
#pragma unroll
                for (int h = 0; h < 4; ++h) { f4 t = (f4){0.f, 0.f, 0.f, 0.f};
                    const bf16x8 qh0 = *(const LAS bf16x8*)(lds + qio + ((h * 2 + 0) * 64) * 16), qh1 = *(const LAS bf16x8*)(lds + qio + ((h * 2 + 1) * 64) * 16);
                    t = __builtin_amdgcn_mfma_f32_16x16x32_bf16(KI_(k2, 0), qh0, t, 0, 0, 0); t = __builtin_amdgcn_mfma_f32_16x16x32_bf16(KI_(k2, 1), qh1, t, 0, 0, 0);
                    const float wqh = *(const LAS float*)(lds + wqo + h * 64);
#pragma unroll
                    for (int e = 0; e < 4; ++e) s[e] += wqh * relu_(t[e]); }
                if (plain) {
#pragma unroll
                    for (int e = 0; e < 4; ++e) sel[k2][e] = s[e] >= sB;
                } else {
                    const unsigned thr_ = *(const LAS unsigned*)(lds + tco);
#pragma unroll
                    for (int e = 0; e < 4; ++e) { const int key = key0 + k2 * 16 + 4 * g + e, tq_ = tqmin + (lane & 15); const unsigned k24 = (unsigned)qkey(s[e]);
                        sel[k2][e] = (key <= tq_) & (k24 > thr_); if ((key <= tq_) & (k24 == thr_)) eqm |= 1u << (k2 * 4 + e); }
                } }
            if (!plain) {
                if (anytie && __any(eqm != 0u)) {
                    const unsigned pk = (unsigned)__popc(eqm & 15u) | ((unsigned)__popc(eqm >> 4) << 8);
                    const unsigned p0 = (unsigned)__shfl((int)pk, lane & 15), p1 = (unsigned)__shfl((int)pk, (lane & 15) + 16), p2 = (unsigned)__shfl((int)pk, (lane & 15) + 32), p3 = (unsigned)__shfl((int)pk, (lane & 15) + 48);
                    const unsigned tot = p0 + p1 + p2 + p3, below = (g > 0 ? p0 : 0u) + (g > 1 ? p1 : 0u) + (g > 2 ? p2 : 0u);
                    const unsigned cn_ = *(const LAS unsigned*)(lds + tco + 4); const int cnt = (int)(cn_ & 0xffffu), need_ = (int)(cn_ >> 16); const int base0 = cnt + (int)(below & 255u), base1 = cnt + (int)(tot & 255u) + (int)(below >> 8);
#pragma unroll
                    for (int k2 = 0; k2 < 2; ++k2)
#pragma unroll
                        for (int e = 0; e < 4; ++e) { const unsigned bit = 1u << (k2 * 4 + e);
                            const int rank = (k2 ? base1 : base0) + __popc(eqm & (bit - 1u) & (k2 ? 0xf0u : 0x0fu));
                            sel[k2][e] = sel[k2][e] | (((eqm & bit) != 0u) & (rank < need_)); }
                    *(LAS unsigned*)(lds + tco + 4) = cn_ + (tot & 255u) + (tot >> 8);
                } else {
#pragma unroll
                    for (int k2 = 0; k2 < 2; ++k2)
#pragma unroll
                        for (int e = 0; e < 4; ++e) sel[k2][e] = sel[k2][e] | ((eqm & (1u << (k2 * 4 + e))) != 0u);
                }
            }
        }
#pragma unroll
        for (int h = 0; h < 4; ++h) {
            if (h == 2 && st + 1 < nst) { vpre0 = *(const u32x4*)(Pb + (size_t)(key0 + 32 + vkey) * PP + C_BV + vch * 8); vpre1 = *(const u32x4*)(Pb + (size_t)(key0 + 32 + vkey) * PP + C_BV + 128 + vch * 8); }
            if (active) {
            f4 sc[2];
#pragma unroll
            for (int k2 = 0; k2 < 2; ++k2) { f4 t = (f4){0.f, 0.f, 0.f, 0.f};
                t = __builtin_amdgcn_mfma_f32_16x16x32_bf16(KQ_(h, k2, 0), qa[h][0], t, 0, 0, 0); t = __builtin_amdgcn_mfma_f32_16x16x32_bf16(KQ_(h, k2, 1), qa[h][1], t, 0, 0, 0);
#pragma unroll
                for (int e = 0; e < 4; ++e) sc[k2][e] = sel[k2][e] ? t[e] * (0.125f * 1.4426950408889634f) : -INFINITY; }
            float mx = fmaxf(fmaxf(fmaxf(sc[0][0], sc[0][1]), fmaxf(sc[0][2], sc[0][3])), fmaxf(fmaxf(sc[1][0], sc[1][1]), fmaxf(sc[1][2], sc[1][3])));
            mx = fmaxf(mx, __shfl_xor(mx, 16)); mx = fmaxf(mx, __shfl_xor(mx, 32));
            const float mnew = fmaxf(mrun[h], mx), msafe = (mnew == -INFINITY) ? 0.f : mnew;
            const bool resc = __any(mnew != mrun[h]);
            const float corr = __builtin_amdgcn_exp2f(mrun[h] - msafe); mrun[h] = mnew;
            float p[8]; float ps = 0.f;
#pragma unroll
            for (int e = 0; e < 4; ++e) { p[e] = __builtin_amdgcn_exp2f(sc[0][e] - msafe); p[4 + e] = __builtin_amdgcn_exp2f(sc[1][e] - msafe); ps += p[e] + p[4 + e]; }
            lrun[h] = lrun[h] * corr + ps;
            union { bf16x8 v; unsigned u[4]; } pb;
            pb.u[0] = pg8::cvt_pk_bf16(p[0], p[1]); pb.u[1] = pg8::cvt_pk_bf16(p[2], p[3]); pb.u[2] = pg8::cvt_pk_bf16(p[4], p[5]); pb.u[3] = pg8::cvt_pk_bf16(p[6], p[7]);
            union { bf16x8 v; u32x2 h2[2]; } vf[4];
            const unsigned va = vrd + vbuf + (unsigned)(h * 128);
            asm volatile("ds_read_b64_tr_b16 %0, %8\n\tds_read_b64_tr_b16 %1, %8 offset:%9\n\tds_read_b64_tr_b16 %2, %8 offset:32\n\tds_read_b64_tr_b16 %3, %8 offset:%10\n\t"
                         "ds_read_b64_tr_b16 %4, %8 offset:64\n\tds_read_b64_tr_b16 %5, %8 offset:%11\n\tds_read_b64_tr_b16 %6, %8 offset:96\n\tds_read_b64_tr_b16 %7, %8 offset:%12\n\ts_waitcnt lgkmcnt(0)"
                         : "=&v"(vf[0].h2[0]), "=&v"(vf[0].h2[1]), "=&v"(vf[1].h2[0]), "=&v"(vf[1].h2[1]), "=&v"(vf[2].h2[0]), "=&v"(vf[2].h2[1]), "=&v"(vf[3].h2[0]), "=&v"(vf[3].h2[1])
                         : "v"(va), "i"(16 * VS * 2), "i"(16 * VS * 2 + 32), "i"(16 * VS * 2 + 64), "i"(16 * VS * 2 + 96) : "memory");
            __builtin_amdgcn_sched_barrier(0);
            if (resc) {
#pragma unroll
                for (int dt = 0; dt < 4; ++dt) oacc[h][dt] = oacc[h][dt] * corr; }
#pragma unroll
            for (int dt = 0; dt < 4; ++dt) oacc[h][dt] = __builtin_amdgcn_mfma_f32_16x16x32_bf16(vf[dt].v, pb.v, oacc[h][dt], 0, 0, 0);
            }
        }
    }
    __syncthreads();
    }
#undef KQ_
#undef KI_
#undef K_DMA
    const size_t m = (size_t)bb * T + tqmin + (lane & 15);
    if (pm < 300)
#pragma unroll
    for (int h = 0; h < 4; ++h) { float l = lrun[h]; l += __shfl_xor(l, 16); l += __shfl_xor(l, 32); const float inv = 1.f / l;
#pragma unroll
        for (int dt = 0; dt < 4; ++dt) { u32x2 w; w.x = pk2(oacc[h][dt][0] * inv, oacc[h][dt][1] * inv); w.y = pk2(oacc[h][dt][2] * inv, oacc[h][dt][3] * inv);
            *(u32x2*)(OB + m * 1024 + 256 + h * 64 + dt * 16 + 4 * g) = w; } }
    __syncthreads();
}
}

namespace awin {
typedef short bf16x8 __attribute__((ext_vector_type(8)));
typedef float f4 __attribute__((ext_vector_type(4)));
constexpr int EXS = 66;
constexpr int O_EX = 0;
constexpr int VSW = 72;
constexpr int O_VW = 101376;
__device__ __forceinline__ void item(LAS unsigned char* lds0, const int bb, const int blk, const int h, const bf16* P, bf16* OB, const int tid0) {
    unsigned lb_ = 0u; int tid_l = tid0; asm volatile("" : "+v"(lb_), "+v"(tid_l));
    LAS unsigned char* lds = lds0 + lb_; const int tid = tid_l, lane = tid & 63, wave = __builtin_amdgcn_readfirstlane(tid >> 6);
    const bf16* Pb = P + (size_t)bb * T * PP; const int start = blk * 128, g = lane >> 4, ln = lane & 15;
    LAS float* EX = (LAS float*)(lds + O_EX);
    LAS bf16* VW = (LAS bf16*)(lds + O_VW + wave * 4608);
#pragma unroll 1
    for (int s4 = 0; s4 < 4; ++s4) {
        const int st = wave * 4 + s4;
        const int grp = st < 8 ? 0 : (st < 16 ? 1 : 2);
        const int dil = grp == 0 ? 1 : (grp == 1 ? 4 : 16), win = grp == 0 ? 128 : (grp == 1 ? 512 : 2048);
        const int r = grp == 0 ? 0 : (grp == 1 ? ((st - 8) >> 1) : (st - 16)), a0 = grp == 0 ? 16 * st : (grp == 1 ? ((st - 8) & 1) * 16 : 0), nqc = grp == 0 ? 128 : (grp == 1 ? 32 : 8);
        const int a = a0 + ln; const bool qok = a < nqc; const int ql = (qok ? a : (nqc - 1)) * dil + r, tq = start + ql;
        const bf16* qp = Pb + (size_t)tq * PP + C_AQ + grp * 256 + h * 64 + g * 8;
        const bf16x8 q0 = *(const bf16x8*)qp, q1 = *(const bf16x8*)(qp + 32);
        bf16x8 kf[10][2];
#pragma unroll
        for (int kt = 0; kt < 10; ++kt) { int pos = start - win + (a0 + 16 * kt + ln) * dil + r; pos = pos < 0 ? 0 : (pos > T - 1 ? T - 1 : pos);
            const bf16* kp = Pb + (size_t)pos * PP + C_AK + grp * 256 + h * 64 + g * 8; kf[kt][0] = *(const bf16x8*)kp; kf[kt][1] = *(const bf16x8*)(kp + 32); }
        f4 sc[10]; float mx = -INFINITY;
#pragma unroll
        for (int kt = 0; kt < 10; ++kt) { f4 t = (f4){0.f, 0.f, 0.f, 0.f};
            t = __builtin_amdgcn_mfma_f32_16x16x32_bf16(kf[kt][0], q0, t, 0, 0, 0); t = __builtin_amdgcn_mfma_f32_16x16x32_bf16(kf[kt][1], q1, t, 0, 0, 0);
#pragma unroll
            for (int e = 0; e < 4; ++e) { const int c = a0 + 16 * kt + 4 * g + e; const int pos = start - win + c * dil + r;
                const bool ok = qok && c >= a && c <= a + 128 && pos >= 0;
                sc[kt][e] = ok ? t[e] * 0.125f : -INFINITY; mx = fmaxf(mx, sc[kt][e]); } }
        mx = fmaxf(mx, __shfl_xor(mx, 16)); mx = fmaxf(mx, __shfl_xor(mx, 32));
        const float msafe = (mx == -INFINITY) ? 0.f : mx; float lsum = 0.f;
#pragma unroll
        for (int kt = 0; kt < 10; ++kt)
#pragma unroll
            for (int e = 0; e < 4; ++e) { sc[kt][e] = __expf(sc[kt][e] - msafe); lsum += sc[kt][e]; }
        lsum += __shfl_xor(lsum, 16); lsum += __shfl_xor(lsum, 32);
        f4 oacc[4];
#pragma unroll
        for (int dt = 0; dt < 4; ++dt) oacc[dt] = (f4){0.f, 0.f, 0.f, 0.f};
#pragma unroll
        for (int s5 = 0; s5 < 5; ++s5) {
            int pos = start - win + (a0 + 32 * s5 + (lane >> 1)) * dil + r; pos = pos < 0 ? 0 : (pos > T - 1 ? T - 1 : pos);
            const u32x4* vp = (const u32x4*)(Pb + (size_t)pos * PP + C_AV + grp * 256 + h * 64 + (lane & 1) * 32);
            const u32x4 v0 = vp[0], v1 = vp[1], v2 = vp[2], v3 = vp[3];
            LAS u32x4* vd = (LAS u32x4*)(VW + (lane >> 1) * VSW + (lane & 1) * 32);
            asm volatile("s_waitcnt lgkmcnt(0)" ::: "memory");
            vd[0] = v0; vd[1] = v1; vd[2] = v2; vd[3] = v3;
            asm volatile("s_waitcnt lgkmcnt(0)" ::: "memory");
            bf16x8 pb;
#pragma unroll
            for (int e = 0; e < 4; ++e) { pb[e] = (short)f2bf(sc[2 * s5][e]); pb[4 + e] = (short)f2bf(sc[2 * s5 + 1][e]); }
#pragma unroll
            for (int dt = 0; dt < 4; ++dt) { bf16x8 vf; const LAS bf16* vb = VW + (4 * g) * VSW + dt * 16 + ln;
#pragma unroll
                for (int e = 0; e < 4; ++e) { vf[e] = (short)vb[e * VSW]; vf[4 + e] = (short)vb[(16 + e) * VSW]; }
                oacc[dt] = __builtin_amdgcn_mfma_f32_16x16x32_bf16(vf, pb, oacc[dt], 0, 0, 0); }
        }
        if (qok) { LAS float* ex = EX + (grp * 128 + ql) * EXS;
#pragma unroll
            for (int dt = 0; dt < 4; ++dt) { ex[dt * 16 + 4 * g + 0] = oacc[dt][0]; ex[dt * 16 + 4 * g + 1] = oacc[dt][1]; ex[dt * 16 + 4 * g + 2] = oacc[dt][2]; ex[dt * 16 + 4 * g + 3] = oacc[dt][3]; }
            if (g == 0) { ex[64] = mx; ex[65] = lsum; } }
    }
    __syncthreads();
    { const int ql = tid >> 2, d0 = (tid & 3) * 16;
      const LAS float* e0 = EX + (0 * 128 + ql) * EXS; const LAS float* e1 = EX + (1 * 128 + ql) * EXS; const LAS float* e2 = EX + (2 * 128 + ql) * EXS;
      const float m0 = e0[64], m1 = e1[64], m2 = e2[64], M = fmaxf(m0, fmaxf(m1, m2));
      const float w0 = __expf(m0 - M), w1 = __expf(m1 - M), w2 = __expf(m2 - M); const float inv = 1.f / (w0 * e0[65] + w1 * e1[65] + w2 * e2[65]);
      unsigned pk[8];
#pragma unroll
      for (int j = 0; j < 8; ++j) { const float x0 = (w0 * e0[d0 + 2 * j] + w1 * e1[d0 + 2 * j] + w2 * e2[d0 + 2 * j]) * inv, x1 = (w0 * e0[d0 + 2 * j + 1] + w1 * e1[d0 + 2 * j + 1] + w2 * e2[d0 + 2 * j + 1]) * inv; pk[j] = pk2(x0, x1); }
      u32x4* op = (u32x4*)(OB + ((size_t)bb * T + start + ql) * 1024 + h * 64 + d0);
      op[0] = (u32x4){pk[0], pk[1], pk[2], pk[3]}; op[1] = (u32x4){pk[4], pk[5], pk[6], pk[7]}; }
    __syncthreads();
}
}

template <int SP>
__device__ __forceinline__ void phase_body(const int l_in, LAS unsigned char* lds) {
    int tid_ = threadIdx.x, bid_ = blockIdx.x, l_ = l_in, G_ = gridDim.x; asm volatile("" : "+v"(tid_), "+s"(bid_), "+s"(l_), "+s"(G_));
    const int tid = tid_, lane = tid & 63, wave = __builtin_amdgcn_readfirstlane(tid >> 6), l = l_;
    const int G = G_, bid = bid_;
    const int gw = bid * NWAVES + wave, NGW = G * NWAVES;
    unsigned char* ws = (unsigned char*)gptr(ldptr(lds, 36));
    int* ctl = (int*)(ws + WS_CTL);
    bf16* XB = (bf16*)(ws + WS_XB); bf16* OB = (bf16*)(ws + WS_O); bf16* VF = (bf16*)(ws + WS_VF); bf16* P = (bf16*)(ws + WS_P);
    bf16* GS = (bf16*)(ws + WS_GS); bf16* MG = (bf16*)(ws + WS_MERGED); bf16* XS = (bf16*)(ws + WS_XS); bf16* HB = (bf16*)(ws + WS_H);
    bf16* WGU = (bf16*)(ws + WS_WGU); bf16* WD = (bf16*)(ws + WS_WD);
    float* X = (float*)gptr(ldptr(lds, 35));
    int* tok_e = (int*)(ws + WS_ROUTE); float* tok_g = (float*)(ws + WS_ROUTE + 256 * 1024); int* tok_rank = (int*)(ws + WS_ROUTE + 512 * 1024); int* tok_slot = (int*)(ws + WS_ROUTE + 768 * 1024);
    (void)ctl; (void)XB; (void)OB; (void)VF; (void)P; (void)GS; (void)MG; (void)XS; (void)HB; (void)WGU; (void)WD; (void)X; (void)tok_e; (void)tok_g; (void)tok_rank; (void)tok_slot; (void)gw; (void)NGW; (void)lane;
    {
        bf16* WinT = (bf16*)(ws + WS_WINT) + (size_t)l * 5120 * 1024; bf16* WgT = (bf16*)(ws + WS_WGT) + (size_t)l * 4096 * 1024;
        bf16* WbrT = (bf16*)(ws + WS_WBRT) + (size_t)l * 1024 * 1024; bf16* WoutT = (bf16*)(ws + WS_WOUTT) + (size_t)l * 1024 * 1024;
        float* WrT = (float*)(ws + WS_WRT) + (size_t)l * 36 * 1024;
        int* cnt = ctl + CW_CNT + l * 64;

        if constexpr (SP == -1) {
            LAS float* scr = (LAS float*)(lds + wave * 16384);
#pragma unroll 1
            for (int job = 0; job < NL * 11; ++job) {
                const int ll = job / 11, jk = job % 11;
                if (jk < 5) {
                    const float* W = INP(I_WIN) + (size_t)ll * 1024 * INW;
                    const int sc0 = jk == 0 ? 0 : (jk == 1 ? 3396 : (jk == 2 ? 3392 : (jk == 3 ? 5060 : 5064)));
                    const int snc = jk == 0 ? 3392 : (jk == 1 ? 1664 : (jk == 4 ? 4096 : 4));
                    const int sr0 = jk == 0 ? 0 : (jk == 1 ? 3392 : (jk == 2 ? 5056 : (jk == 3 ? 5060 : 0)));
                    bf16* dst = jk == 4 ? (bf16*)(ws + WS_WGT) + (size_t)ll * 4096 * 1024 : (bf16*)(ws + WS_WINT) + (size_t)ll * 5120 * 1024;
                    const int nbn = (snc + 31) / 32, nit = 16 * nbn;
#pragma unroll 1
                    for (int it = gw; it < nit; it += NGW) transpose_item(W, INW, sc0, snc, dst, 1024, sr0, 0, it / nbn, it % nbn, scr, lane);
                } else if (jk < 9) {
                    const int n = jk - 5; const float* Wb = INP(I_WBR) + ((size_t)ll * 4 + n) * 256 * 1024;
#pragma unroll 1
                    for (int it = gw; it < 4 * 32; it += NGW) transpose_item(Wb, 1024, 0, 1024, (bf16*)(ws + WS_WBRT) + (size_t)ll * 1024 * 1024, 1024, 0, n * 256, it / 32, it % 32, scr, lane);
                } else if (jk == 9) {
                    const float* Wo = INP(I_WOUT) + (size_t)ll * 1024 * 1024;
#pragma unroll 1
                    for (int it = gw; it < 16 * 32; it += NGW) transpose_item(Wo, 1024, 0, 1024, (bf16*)(ws + WS_WOUTT) + (size_t)ll * 1024 * 1024, 1024, 0, 0, it / 32, it % 32, scr, lane);
                } else {
                    bf16* wi = (bf16*)(ws + WS_WINT) + (size_t)ll * 5120 * 1024;
#pragma unroll 1
                    for (int i = gw * 64 + lane; i < 56 * 1024 / 8; i += NGW * 64) ((u32x4*)(wi + (size_t)5064 * 1024))[i] = (u32x4){0u, 0u, 0u, 0u};
                    float* wr = (float*)(ws + WS_WRT) + (size_t)ll * 36 * 1024; const float* rg = INP(I_RG) + (size_t)ll * 1024 * 4; const float* re = INP(I_RE) + (size_t)ll * 1024 * 32;
#pragma unroll 1
                    for (int i = gw * 64 + lane; i < 36 * 1024; i += NGW * 64) { const int o = i / 1024, k = i % 1024; wr[i] = o < 4 ? rg[k * 4 + o] : re[k * 32 + (o - 4)]; }
                }
            }
            for (int m = gw; m < M; m += NGW) {
                const f32x4* xr = (const f32x4*)(INP(I_X) + (size_t)m * D) + lane;
#pragma unroll
                for (int j = 0; j < 4; ++j) { const f32x4 v = xr[64 * j]; ((f32x4*)(X + (size_t)m * D))[lane + 64 * j] = v;
                    u32x2 w; w.x = pk2(v[0], v[1]); w.y = pk2(v[2], v[3]); ((u32x2*)(XB + (size_t)m * D))[lane + 64 * j] = w; }
            }
        }
        else if constexpr (SP == 0) {
            pg8::Gemm g{XB, WinT, 1024, 1024, 1024}; pg8::StaticOrder S; S.init(M, PP, G, bid, 1024, 1024);
            EpiStoreBf16 E{P, PP, 0, PP};
            pg8::gemm_phase<EpiStoreBf16, pg8::StaticOrder>(lds, g, S, E);
        }
        else if constexpr (SP == 12) {
            if (bid < 32) rw::carry(lds, ws + WS_RW + (size_t)bid * 64 * 16384, tid);
        }
        else if constexpr (SP == 13) {
            unsigned char* GZ = ws + WS_RW;
            const int h = bid & 3, k = bid >> 2;
            rw::build_ct(lds, l, h, lane, wave); __syncthreads();
#pragma unroll 1
            for (int idx = k; idx < 512; idx += (G >> 2)) { const int b = idx >> 6, cI = idx & 63; const size_t ci_ = (size_t)((b * 4 + h) * 64 + cI);
                rw::chunk_out(lds, b, h, cI * 64, GZ + ci_ * 16384, ws + WS_RW2 + ci_ * 24576, (const float*)(ws + WS_BONG) + ci_ * 64, VF, OB, tid); }
        }
        else if constexpr (SP == 15 || SP == 19) {
            unsigned char* GZ = ws + WS_RW;
            int* qctr = ctl + CW_Q + l * 64 + (SP == 19 ? 16 : 0);
            int cur_h = -1;
#pragma unroll 1
            for (;;) {
                unsigned so = (unsigned)(LDS_BYTES - 584); asm volatile("" : "+v"(so));
                volatile LAS int* slot = (volatile LAS int*)(lds + so);
                int tid = threadIdx.x; asm volatile("" : "+v"(tid));
                const int lane = tid & 63, wave = __builtin_amdgcn_readfirstlane(tid >> 6);
                __syncthreads();
                if (tid == 0) *slot = atomicAdd(qctr, 1);
                __syncthreads();
                const int it = __builtin_amdgcn_readfirstlane(*slot);
                if (it >= 3344) break;
                if (it < 16) { mb::chain(lds, l, it >> 1, it & 1, P, OB, tid, lane, wave); }
                else if (it < 272) { const int j = it - 16; bsp::item(lds, j & 7, 31 - (j >> 3), P, OB, tid, (int)(unsigned)ldptr(lds, 37)); }
                else if (it < 2320) { const int j = it - 272, h = j >> 9, idx = j & 511, b = idx >> 6, cI = idx & 63;
                    if (h != cur_h) { rw::build_ct(lds, l, h, lane, wave); cur_h = h; __syncthreads(); }
                    { const size_t ci_ = (size_t)((b * 4 + h) * 64 + cI); rw::chunk<(SP == 19 ? 5 : 1)>(lds, l, b, h, cI * 64, GZ + ci_ * 16384, ws + WS_RW2 + ci_ * 24576, (float*)(ws + WS_BONG) + ci_ * 64, P, VF, OB, tid); } }
                else { const int j = it - 2320; awin::item(lds, j >> 7, (j >> 2) & 31, j & 3, P, OB, tid); }
            }
        }
        else if constexpr (SP == 17 || SP == 18) {
            unsigned char* GZ = ws + WS_RW; int cur_h = -1;
#pragma unroll 1
            for (int k = 0; k < 8; ++k) { const int j = bid + 256 * k, h = j >> 9, idx = j & 511, b = idx >> 6, cI = idx & 63;
                if (h != cur_h) { rw::build_ct(lds, l, h, lane, wave); cur_h = h; __syncthreads(); }
                const size_t ci_ = (size_t)((b * 4 + h) * 64 + cI); rw::chunk<(SP == 17 ? 5 : 6)>(lds, l, b, h, cI * 64, GZ + ci_ * 16384, ws + WS_RW2 + ci_ * 24576, (float*)(ws + WS_BONG) + ci_ * 64, P, VF, OB, tid); }
        }
        else if constexpr (SP == 16) {
            bsp::item(lds, bid & 7, 31 - (bid >> 3), P, OB, tid, (int)(unsigned)ldptr(lds, 37) == 125 ? 300 : ((int)(unsigned)ldptr(lds, 37) == 126 ? 305 : (int)(unsigned)ldptr(lds, 37) + 80));
        }
        else if constexpr (SP == 4) {
            if (bid < 32) { rw::carry(lds, ws + WS_RW + (size_t)bid * 64 * 16384, tid); __syncthreads(); }
            pg8::Gemm g{XB, WgT, 1024, 1024, 1024}; SkewOrder S{M / 256, 16, (M / 256) * 16, bid, 1024, 1024};
            EpiStoreBf16 E{GS, 4096, 1, 4096};
            pg8::gemm_phase<EpiStoreBf16, SkewOrder>(lds, g, S, E);
        }
        else if constexpr (SP == 5) {
            pg8::Gemm g{OB, WbrT, 1024, 1024, 256}; BranchOrder S{M / 256, 4, G, bid};
            EpiBranch E{GS, MG};
            pg8::gemm_phase<EpiBranch, BranchOrder>(lds, g, S, E);
        }
        else if constexpr (SP == 6) {
            pg8::Gemm g{MG, WoutT, 1024, 1024, 1024}; pg8::StaticOrder S; S.init(M, 1024, G, bid, 1024, 1024);
            EpiResid E{X};
            pg8::gemm_phase<EpiResid, pg8::StaticOrder>(lds, g, S, E);
        }
        else if constexpr (SP == 7) {
            const float* g1 = INP(I_LN1G) + l * 1024; const float* b1 = INP(I_LN1B) + l * 1024;
            const float* rgb = INP(I_RGB) + l * 4; const float* reb = INP(I_REB) + l * 32;
            f32x4 vn[4];
#pragma unroll
            for (int j = 0; j < 4; ++j) vn[j] = ((const f32x4*)(X + (size_t)gw * D))[lane + 64 * j];
#pragma unroll 1
            for (int m = gw; m < M; m += NGW) {
                f32x4 v[4]; float s = 0.f; f32x4* xr = (f32x4*)(X + (size_t)m * D) + lane;
#pragma unroll
                for (int j = 0; j < 4; ++j) { v[j] = vn[j]; s += (v[j][0] + v[j][1]) + (v[j][2] + v[j][3]); }
                { const int mnx = (m + NGW < M) ? m + NGW : m;
#pragma unroll
                  for (int j = 0; j < 4; ++j) vn[j] = ((const f32x4*)(X + (size_t)mnx * D))[lane + 64 * j]; }
                const float mean = wave_sum(s) * (1.f / D); float s2 = 0.f;
#pragma unroll
                for (int j = 0; j < 4; ++j) { v[j] = v[j] - mean; s2 += (v[j][0] * v[j][0] + v[j][1] * v[j][1]) + (v[j][2] * v[j][2] + v[j][3] * v[j][3]); }
                const float rstd = rsqrtf(wave_sum(s2) * (1.f / D) + LN_EPS);
#pragma unroll
                for (int j = 0; j < 4; ++j) { const f32x4 gg = ((const f32x4*)g1)[lane + 64 * j], bb = ((const f32x4*)b1)[lane + 64 * j]; v[j] = v[j] * rstd * gg + bb; xr[64 * j] = v[j];
                    u32x2 w; w.x = pk2(v[j][0], v[j][1]); w.y = pk2(v[j][2], v[j][3]); ((u32x2*)(XB + (size_t)m * D))[lane + 64 * j] = w; }
                float mylg = 0.f;
#pragma unroll 1
                for (int o4 = 0; o4 < 36; o4 += 4) { float a4[4];
#pragma unroll
                    for (int u = 0; u < 4; ++u) { float a = 0.f;
#pragma unroll
                        for (int j = 0; j < 4; ++j) { const f32x4 wv = ((const f32x4*)(WrT + (o4 + u) * 1024))[lane + 64 * j]; a += v[j][0] * wv[0] + v[j][1] * wv[1] + v[j][2] * wv[2] + v[j][3] * wv[3]; }
                        a4[u] = a; }
#pragma unroll
                    for (int sft = 1; sft < 64; sft <<= 1) {
#pragma unroll
                        for (int u = 0; u < 4; ++u) a4[u] += __shfl_xor(a4[u], sft); }
#pragma unroll
                    for (int u = 0; u < 4; ++u) mylg = (lane == o4 + u) ? a4[u] : mylg; }
                mylg += lane < 4 ? rgb[lane & 3] : (lane < 36 ? reb[(lane - 4) & 31] : 0.f);
                float gl[4]; float gm = -INFINITY; int gs = 0;
#pragma unroll
                for (int o = 0; o < 4; ++o) { gl[o] = __shfl(mylg, o); if (gl[o] > gm) { gm = gl[o]; gs = o; } }
                float gden = 0.f;
#pragma unroll
                for (int o = 0; o < 4; ++o) gden += __expf(gl[o] - gm);
                const float pg = 1.f / gden;
                float el[8];
#pragma unroll
                for (int o = 0; o < 8; ++o) el[o] = __shfl(mylg, 4 + gs * 8 + o);
                int e1 = 0; float m1 = el[0];
#pragma unroll
                for (int o = 1; o < 8; ++o) if (el[o] > m1) { m1 = el[o]; e1 = o; }
                int e2 = -1; float m2 = -INFINITY;
#pragma unroll
                for (int o = 0; o < 8; ++o) if (o != e1 && el[o] > m2) { m2 = el[o]; e2 = o; }
                const float r2 = __expf(m2 - m1); const float ga = pg / (1.f + r2), gb = pg * r2 / (1.f + r2);
                if (lane == 0) {
                    const int E1 = gs * 8 + e1, E2 = gs * 8 + e2;
                    tok_e[m * 2] = E1; tok_e[m * 2 + 1] = E2; tok_g[m * 2] = ga; tok_g[m * 2 + 1] = gb;
                    tok_rank[m * 2] = atomicAdd(&cnt[E1], 1); tok_rank[m * 2 + 1] = atomicAdd(&cnt[E2], 1);
                }
            }
        }
        else if constexpr (SP == 14) {
            LAS float* scr = (LAS float*)(lds + wave * 16384);
            const float* eg = INP(I_EG) + (size_t)l * NEXP * 1024 * 512; const float* eu = INP(I_EU) + (size_t)l * NEXP * 1024 * 512; const float* ed = INP(I_ED) + (size_t)l * NEXP * 512 * 1024;
            for (int it = gw; it < NEXP * 2 * 4 * 64; it += NGW) {
                const int e = it / 512, r = it % 512, half = r / 256, ct = (r % 256) / 64, q = r % 64, kb = q / 4, nb = q % 4;
                const float* W = (half ? eu : eg) + (size_t)e * 1024 * 512;
                transpose_item(W, 512, ct * 128, 128, WGU + (size_t)e * 1024 * 1024, 1024, ct * 256 + half * 128, 0, kb, nb, scr, lane);
            }
            for (int it = gw; it < NEXP * 8 * 32; it += NGW) {
                const int e = it / 256, q = it % 256, kb = q / 32, nb = q % 32;
                transpose_item(ed + (size_t)e * 512 * 1024, 1024, 0, 1024, WD + (size_t)e * 1024 * 512, 512, 0, 0, kb, nb, scr, lane);
            }
        }
        else if constexpr (SP == 8 || SP == 9 || SP == 10) {
            unsigned tbo = MISC_OFF; asm volatile("" : "+v"(tbo));
            volatile LAS int* tb = (volatile LAS int*)(lds + tbo);
            if (tid == 0) { int acc = 0; for (int e = 0; e < 32; ++e) { const int c = __hip_atomic_load(&cnt[e], __ATOMIC_RELAXED, __HIP_MEMORY_SCOPE_AGENT); tb[e] = acc; tb[33 + e] = acc; acc += (c + 255) >> 8; } tb[32] = acc; }
            __syncthreads();
            if constexpr (SP == 8) {
                for (int m = gw; m < M; m += NGW) {
#pragma unroll
                    for (int k = 0; k < 2; ++k) { const int e = tok_e[m * 2 + k]; const int slot = tb[33 + e] * 256 + tok_rank[m * 2 + k];
                        const u32x4* src = (const u32x4*)(XB + (size_t)m * D); u32x4* dst = (u32x4*)(XS + (size_t)slot * D);
                        dst[lane] = src[lane]; dst[lane + 64] = src[lane + 64];
                        if (lane == 0) tok_slot[m * 2 + k] = slot; }
                }
            } else if constexpr (SP == 9) {
                pg8::Gemm g{XS, WGU, 1024, 1024, 1024}; MoeOrder S{tb, G, bid, (size_t)1024 * 2, (size_t)1024 * 1024 * 2, (size_t)256 * 1024 * 2};
                EpiSwiglu E{HB};
                pg8::gemm_phase<EpiSwiglu, MoeOrder>(lds, g, S, E);
            } else {
                pg8::Gemm g{HB, WD, 512, 512, 512}; MoeOrder S{tb, G, bid, (size_t)512 * 2, (size_t)1024 * 512 * 2, (size_t)256 * 512 * 2};
                EpiStoreBf16 E{XS, 1024, 0, 1024};
                pg8::gemm_phase<EpiStoreBf16, MoeOrder>(lds, g, S, E);
            }
        }
        else if constexpr (SP == 11) {
            const float* g2 = INP(I_LN2G) + l * 1024; const float* b2 = INP(I_LN2B) + l * 1024;
            f32x4 xn[4]; u32x2 y1n[4], y2n[4]; float gan, gbn;
#define LN2_LOAD(mm) do { const int s1_ = tok_slot[(mm) * 2], s2_ = tok_slot[(mm) * 2 + 1]; gan = tok_g[(mm) * 2]; gbn = tok_g[(mm) * 2 + 1]; \
                _Pragma("unroll") for (int j = 0; j < 4; ++j) { xn[j] = ((const f32x4*)(X + (size_t)(mm) * D))[lane + 64 * j]; y1n[j] = ((const u32x2*)(XS + (size_t)s1_ * D))[lane + 64 * j]; y2n[j] = ((const u32x2*)(XS + (size_t)s2_ * D))[lane + 64 * j]; } } while (0)
            LN2_LOAD(gw);
#pragma unroll 1
            for (int m = gw; m < M; m += NGW) {
                const float ga = gan, gb = gbn;
                f32x4 v[4]; float s = 0.f; f32x4* xr = (f32x4*)(X + (size_t)m * D) + lane;
                u32x2 y1c[4], y2c[4];
#pragma unroll
                for (int j = 0; j < 4; ++j) { v[j] = xn[j] * ALPHA; y1c[j] = y1n[j]; y2c[j] = y2n[j]; }
                { const int mnx = (m + NGW < M) ? m + NGW : m; LN2_LOAD(mnx); }
#pragma unroll
                for (int j = 0; j < 4; ++j) { const u32x2 y1 = y1c[j], y2 = y2c[j];
                    v[j][0] += ga * __uint_as_float(y1.x << 16) + gb * __uint_as_float(y2.x << 16); v[j][1] += ga * __uint_as_float(y1.x & 0xffff0000u) + gb * __uint_as_float(y2.x & 0xffff0000u);
                    v[j][2] += ga * __uint_as_float(y1.y << 16) + gb * __uint_as_float(y2.y << 16); v[j][3] += ga * __uint_as_float(y1.y & 0xffff0000u) + gb * __uint_as_float(y2.y & 0xffff0000u);
                    s += (v[j][0] + v[j][1]) + (v[j][2] + v[j][3]); }
                const float mean = wave_sum(s) * (1.f / D); float s2 = 0.f;
#pragma unroll
                for (int j = 0; j < 4; ++j) { v[j] = v[j] - mean; s2 += (v[j][0] * v[j][0] + v[j][1] * v[j][1]) + (v[j][2] * v[j][2] + v[j][3] * v[j][3]); }
                const float rstd = rsqrtf(wave_sum(s2) * (1.f / D) + LN_EPS);
#pragma unroll
                for (int j = 0; j < 4; ++j) { const f32x4 gg = ((const f32x4*)g2)[lane + 64 * j], bb = ((const f32x4*)b2)[lane + 64 * j]; v[j] = v[j] * rstd * gg + bb; xr[64 * j] = v[j];
                    u32x2 w; w.x = pk2(v[j][0], v[j][1]); w.y = pk2(v[j][2], v[j][3]); ((u32x2*)(XB + (size_t)m * D))[lane + 64 * j] = w; }
            }
        }
    }
}

template <int SP>
__global__ void __launch_bounds__(NTHR, 2) k_phase(Args args, int l) {
    extern __shared__ __attribute__((aligned(16))) unsigned char lds_raw[];
    ptr_table_fill(args, (LAS unsigned char*)lds_raw);
    phase_body<SP>(l, (LAS unsigned char*)lds_raw);
}


#define XB_TMO      128
#define XB_XCNT(j)  (256  + 64 * (j))
#define XB_XSUB(j)  (1280 + 64 * (j))
#define XB_XGEN(j)  (2304 + 64 * (j))
#define XB_TOP      3328
#define XB_TOPGEN   3392
#define XCD_BAR_WORDS 3456
#define XB_SPIN_CAP (1u << 22)
__device__ __forceinline__ unsigned xb_ld(unsigned* p)              { return __hip_atomic_load(p, __ATOMIC_RELAXED, __HIP_MEMORY_SCOPE_AGENT); }
__device__ __forceinline__ unsigned xb_add(unsigned* p, unsigned v) { return __hip_atomic_fetch_add(p, v, __ATOMIC_RELAXED, __HIP_MEMORY_SCOPE_AGENT); }
__device__ __forceinline__ unsigned xb_xcc_id() { return (unsigned)__builtin_amdgcn_s_getreg((3 << 11) | 20) & 0xFu; }
#define XB_SPIN(cond, bar) do { unsigned _sp = 0; while (cond) { __builtin_amdgcn_s_sleep(1); \
    if ((++_sp & 255u) == 0u) { if (xb_ld(&(bar)[XB_TMO])) break; if (_sp > XB_SPIN_CAP) { atomicAdd(&(bar)[XB_TMO], 1u); break; } } } } while (0)
__device__ __forceinline__ void xcd_barrier_complete(unsigned* bar, unsigned x, unsigned& nloc, unsigned& nx) {
    const unsigned G = gridDim.x;
    unsigned sum, cnt, mine, sp = 0u;
    for (;;) {
        sum = 0u; cnt = 0u; mine = 0u;
#pragma unroll
        for (unsigned j = 0; j < 16; ++j) { const unsigned c = xb_ld(&bar[XB_XCNT(j)]); sum += c; cnt += (c > 0u) ? 1u : 0u; mine = (j == x) ? c : mine; }
        if (sum == G) break;
        __builtin_amdgcn_s_sleep(1);
        if ((++sp & 255u) == 0u) { if (xb_ld(&bar[XB_TMO])) break; if (sp > XB_SPIN_CAP) { atomicAdd(&bar[XB_TMO], 1u); break; } }
    }
    nloc = mine > 0u ? mine : 1u; nx = cnt > 0u ? cnt : 1u;
}
__device__ __forceinline__ void xcd_barrier(unsigned* bar, LAS unsigned char* lds) {
    asm volatile("s_waitcnt vmcnt(0)" ::: "memory");
    __syncthreads();
    int tid_ = threadIdx.x; asm volatile("" : "+v"(tid_));
    if (tid_ == 0) {
        unsigned so = (unsigned)(LDS_BYTES - 576); asm volatile("" : "+v"(so));
        volatile LAS unsigned* st = (volatile LAS unsigned*)(lds + so);
        __builtin_amdgcn_s_waitcnt(0);
        const unsigned x = xb_xcc_id();
        unsigned nloc = st[0], nx = st[1];
        if (nloc == 0u) { xcd_barrier_complete(bar, x, nloc, nx); st[0] = nloc; st[1] = nx; }
        const unsigned old = xb_add(&bar[XB_XSUB(x)], 1u);
        const unsigned gen = old / nloc;
        if (old + 1u == (gen + 1u) * nloc) {
            __builtin_amdgcn_fence(__ATOMIC_RELEASE, "agent");
            asm volatile("s_waitcnt vmcnt(0)" ::: "memory");
            const unsigned og = xb_add(&bar[XB_TOP], 1u);
            const unsigned tg = og / nx;
            if (og + 1u == (tg + 1u) * nx) xb_add(&bar[XB_TOPGEN], 1u);
            else XB_SPIN(xb_ld(&bar[XB_TOPGEN]) == tg, bar);
            __builtin_amdgcn_fence(__ATOMIC_ACQUIRE, "agent");
            xb_add(&bar[XB_XGEN(x)], 1u);
            asm volatile("s_waitcnt vmcnt(0)" ::: "memory");
        } else {
            XB_SPIN(xb_ld(&bar[XB_XGEN(x)]) == gen, bar);
            __builtin_amdgcn_fence(__ATOMIC_ACQUIRE, "agent");
            asm volatile("s_waitcnt vmcnt(0)" ::: "memory");
        }
    }
    __syncthreads();
}
namespace cg = cooperative_groups;
__global__ void __launch_bounds__(NTHR, 2) fwd_all(Args args) {
    extern __shared__ __attribute__((aligned(16))) unsigned char lds_raw[];
    LAS unsigned char* lds = (LAS unsigned char*)lds_raw;
    unsigned* bar = (unsigned*)(args.ws + WS_CTL) + CW_BAR;
    if (threadIdx.x == 0) { ((volatile LAS unsigned*)(lds + LDS_BYTES - 576))[0] = 0u; ((volatile LAS unsigned*)(lds + LDS_BYTES - 576))[1] = 0u; (void)xb_add(&bar[XB_XCNT(xb_xcc_id())], 1u); }
    ptr_table_fill(args, lds);
    const int probe = args.ph_lo;
    { constexpr int l = 0;
#pragma unroll 1
      for (int r_ = 0; r_ < ((probe == -1) ? 2 : 1); ++r_) { phase_body<-1>(l, lds); __syncthreads(); } }
    cg::this_grid().sync();
#define GRID_BAR() do { unsigned* bar_ = (unsigned*)gptr(ldptr(lds, 36)) + CW_BAR; xcd_barrier(bar_, lds); } while (0)
#define RUN(SP) do { _Pragma("unroll 1") for (int r_ = 0; r_ < ((probe == (SP)) ? 2 : 1); ++r_) { phase_body<SP>(l, lds); __syncthreads(); } } while (0)
#define ONCE(SP) do { phase_body<SP>(l, lds); __syncthreads(); } while (0)
#define LAYER() \
        RUN(0); GRID_BAR(); \
        ONCE(15); GRID_BAR(); \
        if (probe == 132) { ONCE(19); GRID_BAR(); } \
        if (probe == 130) { ONCE(17); GRID_BAR(); } \
        if (probe == 131) { ONCE(18); GRID_BAR(); } \
        if (probe >= 119 && probe < 130) { ONCE(16); GRID_BAR(); } \
        ONCE(4); GRID_BAR(); \
        RUN(13); GRID_BAR(); \
        RUN(5); GRID_BAR(); \
        ONCE(6); GRID_BAR(); \
        ONCE(7); RUN(14); GRID_BAR(); \
        RUN(8); GRID_BAR(); \
        RUN(9); GRID_BAR(); \
        RUN(10); GRID_BAR(); \
        ONCE(11); GRID_BAR();
    { constexpr int l = 0; LAYER() }
    { constexpr int l = 1; LAYER() }
#undef LAYER
#undef RUN
#undef ONCE
#undef GRID_BAR
}

template <int SP> static void launch_phase(const Args& a, int l, int grid, hipStream_t stream) {
    static bool attr = false;
    if (!attr) { (void)hipFuncSetAttribute((const void*)k_phase<SP>, hipFuncAttributeMaxDynamicSharedMemorySize, LDS_BYTES); attr = true; }
    hipLaunchKernelGGL(k_phase<SP>, dim3(grid), dim3(NTHR), LDS_BYTES, stream, a, l);
}

extern "C" void kernel_launch(void* const* d_in, const int* in_sizes, int n_in, void* d_out, int out_size, void* d_ws, size_t ws_size, hipStream_t stream) {
    static int grid = 0;
    if (grid == 0) {
        if (n_in != 35 || out_size != M * D || ws_size < WS_END) { fprintf(stderr, "kernel_launch: unexpected problem (n_in %d out %d ws %zu)\n", n_in, out_size, ws_size); grid = -1; return; }
        int dev = 0, cus = 0, per_cu = 0;
        (void)hipGetDevice(&dev); (void)hipDeviceGetAttribute(&cus, hipDeviceAttributeMultiprocessorCount, dev);
#if N_LAUNCH_MODE == 1
        (void)hipFuncSetAttribute((const void*)fwd_all, hipFuncAttributeMaxDynamicSharedMemorySize, LDS_BYTES);
        if (hipOccupancyMaxActiveBlocksPerMultiprocessor(&per_cu, (const void*)fwd_all, NTHR, LDS_BYTES) != hipSuccess || per_cu < 1) { fprintf(stderr, "kernel_launch: occupancy query says %d blocks/CU\n", per_cu); grid = -1; return; }
#endif
        (void)per_cu;
        grid = cus;
        if (grid != 256) { fprintf(stderr, "kernel_launch: built for 256 CUs, found %d\n", cus); grid = -1; return; }
    }
    if (grid < 0) return;
    (void)hipMemsetAsync((char*)d_ws + WS_CTL, 0, CTL_BYTES, stream);
    Args a{};
    for (int i = 0; i < 35; ++i) a.in[i] = (const float*)d_in[i];
    a.out = (float*)d_out; a.ws = (unsigned char*)d_ws;
#if N_LAUNCH_MODE == 1
    a.ph_lo = PROBE_REPS;
    void* kargs[] = {(void*)&a};
    hipError_t e = hipLaunchCooperativeKernel((const void*)fwd_all, dim3(grid), dim3(NTHR), kargs, LDS_BYTES, stream);
    if (e != hipSuccess) fprintf(stderr, "cooperative launch failed: %s\n", hipGetErrorString(e));
#else
    launch_phase<-1>(a, 0, grid, stream);
    for (int l = 0; l < NL; ++l) {
        launch_phase<0>(a, l, grid, stream); launch_phase<15>(a, l, grid, stream); launch_phase<4>(a, l, grid, stream); launch_phase<13>(a, l, grid, stream);
        launch_phase<5>(a, l, grid, stream); launch_phase<6>(a, l, grid, stream); launch_phase<7>(a, l, grid, stream); launch_phase<14>(a, l, grid, stream);
        launch_phase<8>(a, l, grid, stream); launch_phase<9>(a, l, grid, stream); launch_phase<10>(a, l, grid, stream); launch_phase<11>(a, l, grid, stream);
    }
#endif
}
```

```cpp
#include <hip/hip_runtime.h>
#include <type_traits>
#include <cstdio>
#include <cstdint>
#include <hip/hip_cooperative_groups.h>

#ifndef PROBE_REPS
#define PROBE_REPS -100
#endif
#ifndef N_LAUNCH_MODE
#define N_LAUNCH_MODE 1
#endif

namespace pg8 {
#define PG8_LAS __attribute__((address_space(3)))
typedef unsigned short bf16_t;
typedef short bf16x8 __attribute__((ext_vector_type(8)));
typedef float f32x4 __attribute__((ext_vector_type(4)));
typedef unsigned u32x4 __attribute__((ext_vector_type(4)));
constexpr int BM = 256, BK = 64, HALF = 128, HTB = HALF * BK * 2, STAGE_BYTES = 8 * HTB, NXCD = 8, WGM = 8;

__host__ __device__ __forceinline__ int lds_byte(int r, int c) { const int st = (r >> 4) * 2 + (c >> 5), rr = r & 15, cc = c & 31, ob = rr * 64 + cc * 2; return st * 1024 + (ob ^ (((ob >> 9) & 1) << 5)); }
__host__ __device__ __forceinline__ void stage_rc(int b, int& R, int& C) { const int st = b / 1024, sb = b % 1024, swz = sb ^ (((sb >> 9) & 1) << 5); R = (st >> 1) * 16 + swz / 64; C = (st & 1) * 32 + (swz % 64) / 2; }
__host__ __device__ __forceinline__ int perm32(int rho) { const int n = rho >> 4, i = rho & 15; return 8 * (i >> 2) + 4 * n + (i & 3); }

struct Unit { int pm, pn, aux; size_t aoff, boff; };
struct Gemm { const bf16_t* A; const bf16_t* Bt; int lda, ldb, K; };

__device__ __forceinline__ void tile_of(int L, int nM, int nN, int& pm, int& pn) {
    const int nwg = nM * nN; int wgid = L;
    { const int q = nwg / NXCD, r = nwg % NXCD, xcd = wgid % NXCD, off = wgid / NXCD; wgid = (xcd < r ? xcd * (q + 1) : r * (q + 1) + (xcd - r) * q) + off; }
    const int nig = WGM * nN, gid = wgid / nig, fm = gid * WGM, gsz = (nM - fm) < WGM ? (nM - fm) : WGM;
    pm = fm + ((wgid % nig) % gsz); pn = (wgid % nig) / gsz;
}
struct StaticOrder {
    int nM, nN, nwg, G, c, lda, ldb;
    __device__ void init(int M, int N, int G_, int c_, int lda_, int ldb_) { nM = M / BM; nN = N / BM; nwg = nM * nN; G = G_; c = c_; lda = lda_; ldb = ldb_; }
    __device__ bool next(int i, Unit& u) const {
        const long L = (long)i * G + c; if (L >= nwg) return false;
        tile_of((int)L, nM, nN, u.pm, u.pn); u.aux = 0;
        u.aoff = (size_t)u.pm * BM * lda * 2; u.boff = (size_t)u.pn * BM * ldb * 2; return true;
    }
};

__device__ __forceinline__ unsigned cvt_pk_bf16(float lo, float hi) { typedef __bf16 b2_ __attribute__((ext_vector_type(2))); typedef float f2_ __attribute__((ext_vector_type(2))); return __builtin_bit_cast(unsigned, __builtin_convertvector((f2_){lo, hi}, b2_)); }
__device__ __forceinline__ void epi_mfma_settle(const f32x4 (&acc)[2][2][4][2]) {
    asm volatile("s_nop 11" :: "v"(acc[1][0][0][0]), "v"(acc[1][0][0][1]), "v"(acc[1][0][1][0]), "v"(acc[1][0][1][1]), "v"(acc[1][0][2][0]), "v"(acc[1][0][2][1]), "v"(acc[1][0][3][0]), "v"(acc[1][0][3][1]),
                                "v"(acc[1][1][0][0]), "v"(acc[1][1][0][1]), "v"(acc[1][1][1][0]), "v"(acc[1][1][1][1]), "v"(acc[1][1][2][0]), "v"(acc[1][1][2][1]), "v"(acc[1][1][3][0]), "v"(acc[1][1][3][1]) : "memory"); }

template <class Epi, class Sched, bool ALIGN_EPI = true, bool SP2 = true>
__device__ __forceinline__ void gemm_phase(PG8_LAS unsigned char* lds, const Gemm g, const Sched& S, const Epi& E) {
    int tid_ = threadIdx.x; asm volatile("" : "+v"(tid_));
    const int tid = tid_, wid = __builtin_amdgcn_readfirstlane(tid >> 6), lane = tid & 63, wr = wid >> 2, wc = wid & 3, fr = lane & 15, fq = lane >> 4;
    const int K = g.K, nt = K / BK;
    unsigned voffA[2], voffB[2];
#pragma unroll
    for (int i = 0; i < 2; ++i) { int R, C; stage_rc(tid * 16 + i * 8192, R, C); const int Rb = Epi::PERM ? ((R & ~31) + perm32(R & 31)) : R;
        voffA[i] = (unsigned)(R * g.lda + C) * 2u; voffB[i] = (unsigned)(Rb * g.ldb + C) * 2u; }
    const size_t kstep = (size_t)(BK * 2);
    const size_t hstepA = (size_t)HALF * g.lda * 2, hstepB = (size_t)HALF * g.ldb * 2;
    const unsigned ldsw = (unsigned)wid * 1024u;
    const int aoff = lds_byte(wr * 64 + fr, fq * 8), boff = lds_byte(wc * 32 + fr, fq * 8);
#define PG8_SA(b, h) (((b) * 2 + (h)) * HTB)
#define PG8_SB(b, h) ((4 + (b) * 2 + (h)) * HTB)
#define PG8_STAGE(bufoff, gbase, voff) do { _Pragma("unroll") for (int _i = 0; _i < 2; ++_i) \
        __builtin_amdgcn_global_load_lds((const unsigned*)((const char*)(gbase) + (voff)[_i]), (PG8_LAS unsigned*)(lds + (bufoff) + ldsw + _i * 8192), 16, 0, 0); } while (0)
#define PG8_LDA(dst, b, h) do { _Pragma("unroll") for (int m = 0; m < 4; ++m) _Pragma("unroll") for (int k = 0; k < 2; ++k) dst[m][k] = *(const PG8_LAS bf16x8*)(lds + PG8_SA(b, h) + aoff + m * 2048 + k * 1024); } while (0)
#define PG8_LDB(dst, b, h) do { _Pragma("unroll") for (int n = 0; n < 2; ++n) _Pragma("unroll") for (int k = 0; k < 2; ++k) dst[n][k] = *(const PG8_LAS bf16x8*)(lds + PG8_SB(b, h) + boff + n * 2048 + k * 1024); } while (0)
#define PG8_MMA(ai, bj, At, Bt) do { __builtin_amdgcn_s_setprio(1); _Pragma("unroll") for (int m = 0; m < 4; ++m) _Pragma("unroll") for (int n = 0; n < 2; ++n) _Pragma("unroll") for (int k = 0; k < 2; ++k) \
        acc[ai][bj][m][n] = __builtin_amdgcn_mfma_f32_16x16x32_bf16(Bt[n][k], At[m][k], acc[ai][bj][m][n], 0, 0, 0); __builtin_amdgcn_s_setprio(0); } while (0)
#define PG8_WAIT_V(n) asm volatile("s_waitcnt vmcnt(" #n ")" ::: "memory")
#define PG8_WAIT_L(n) asm volatile("s_waitcnt lgkmcnt(" #n ")" ::: "memory")
#define PG8_BAR __builtin_amdgcn_s_barrier()
#define PG8_SCHED __builtin_amdgcn_sched_barrier(0)
    Unit cur, nxt; int ui = 0;
    if (!S.next(0, cur)) return;
    f32x4 acc[2][2][4][2];
#pragma unroll
    for (int a = 0; a < 2; ++a)
#pragma unroll
        for (int b = 0; b < 2; ++b)
#pragma unroll
            for (int m = 0; m < 4; ++m)
#pragma unroll
                for (int n = 0; n < 2; ++n) acc[a][b][m][n] = (f32x4){0.f, 0.f, 0.f, 0.f};
    bf16x8 At[4][2], B0[2][2], B1[2][2];
    const char* cA = (const char*)g.A + cur.aoff; const char* cB = (const char*)g.Bt + cur.boff;
    if constexpr (SP2) {
        PG8_STAGE(PG8_SB(0, 0), cB, voffB); PG8_STAGE(PG8_SB(0, 1), cB + hstepB, voffB); PG8_STAGE(PG8_SA(0, 0), cA, voffA); PG8_STAGE(PG8_SA(0, 1), cA + hstepA, voffA);
        if (wr == 1) PG8_BAR;
        PG8_WAIT_V(2); PG8_BAR;
        PG8_STAGE(PG8_SB(1, 0), cB + kstep, voffB); PG8_STAGE(PG8_SA(1, 0), cA + kstep, voffA); PG8_STAGE(PG8_SB(1, 1), cB + hstepB + kstep, voffB);
        PG8_WAIT_V(6); PG8_BAR;
    } else {
        PG8_STAGE(PG8_SB(0, 0), cB, voffB); PG8_STAGE(PG8_SA(0, 0), cA, voffA); PG8_STAGE(PG8_SB(0, 1), cB + hstepB, voffB); PG8_STAGE(PG8_SA(0, 1), cA + hstepA, voffA);
        if (wr == 1) PG8_BAR;
        PG8_WAIT_V(4); PG8_BAR;
        PG8_STAGE(PG8_SB(1, 0), cB + kstep, voffB); PG8_STAGE(PG8_SA(1, 0), cA + kstep, voffA); PG8_STAGE(PG8_SB(1, 1), cB + hstepB + kstep, voffB);
        PG8_WAIT_V(6); PG8_BAR;
    }
    for (;;) {
        const bool has_next = S.next(ui + 1, nxt);
        const char* nA = has_next ? (const char*)g.A + nxt.aoff : cA; const char* nB = has_next ? (const char*)g.Bt + nxt.boff : cB;
#pragma unroll 1
        for (int t = 0; t < nt; t += 2) {
            const bool last = (t == nt - 2);
            const char* a1 = cA + (size_t)(t + 1) * kstep;
            const char* a2 = last ? nA : cA + (size_t)(t + 2) * kstep; const char* b2 = last ? nB : cB + (size_t)(t + 2) * kstep;
            const char* a3 = a2 + kstep; const char* b3 = b2 + kstep;
            if constexpr (SP2) {
            PG8_LDB(B0, 0, 0); PG8_LDB(B1, 0, 1); PG8_SCHED; PG8_LDA(At, 0, 0); PG8_STAGE(PG8_SA(1, 1), a1 + hstepA, voffA);
            PG8_WAIT_V(8); PG8_WAIT_L(0); PG8_BAR; PG8_MMA(0, 0, At, B0); PG8_MMA(0, 1, At, B1); PG8_BAR; PG8_SCHED;
            PG8_LDA(At, 0, 1); PG8_STAGE(PG8_SB(0, 0), b2, voffB); PG8_STAGE(PG8_SB(0, 1), b2 + hstepB, voffB); PG8_STAGE(PG8_SA(0, 0), a2, voffA);
            PG8_WAIT_V(8); PG8_WAIT_L(0); PG8_BAR; PG8_MMA(1, 0, At, B0); PG8_MMA(1, 1, At, B1); PG8_BAR; PG8_SCHED;
            PG8_LDB(B0, 1, 0); PG8_LDB(B1, 1, 1); PG8_SCHED; PG8_LDA(At, 1, 0); PG8_STAGE(PG8_SA(0, 1), a2 + hstepA, voffA);
            PG8_WAIT_V(8); PG8_WAIT_L(0); PG8_BAR; PG8_MMA(0, 0, At, B0); PG8_MMA(0, 1, At, B1); PG8_BAR; PG8_SCHED;
            PG8_LDA(At, 1, 1); PG8_STAGE(PG8_SB(1, 0), b3, voffB); PG8_STAGE(PG8_SB(1, 1), b3 + hstepB, voffB); PG8_STAGE(PG8_SA(1, 0), a3, voffA);
            PG8_WAIT_V(8); PG8_WAIT_L(0); PG8_BAR; PG8_MMA(1, 0, At, B0); PG8_MMA(1, 1, At, B1); PG8_BAR; PG8_SCHED;
            } else {
            PG8_LDB(B0, 0, 0); PG8_SCHED; PG8_LDA(At, 0, 0); PG8_STAGE(PG8_SA(1, 1), a1 + hstepA, voffA);
            PG8_WAIT_L(8); PG8_BAR; PG8_WAIT_L(0); PG8_MMA(0, 0, At, B0); PG8_BAR; PG8_SCHED;
            PG8_LDB(B1, 0, 1); PG8_STAGE(PG8_SB(0, 0), b2, voffB);
            PG8_BAR; PG8_WAIT_L(0); PG8_MMA(0, 1, At, B1); PG8_BAR;
            PG8_LDA(At, 0, 1); PG8_STAGE(PG8_SA(0, 0), a2, voffA);
            PG8_BAR; PG8_WAIT_L(0); PG8_MMA(1, 0, At, B0); PG8_BAR; PG8_SCHED;
            PG8_STAGE(PG8_SB(0, 1), b2 + hstepB, voffB);
            PG8_WAIT_V(6); PG8_BAR; PG8_MMA(1, 1, At, B1); PG8_BAR;
            PG8_LDB(B0, 1, 0); PG8_SCHED; PG8_LDA(At, 1, 0); PG8_STAGE(PG8_SA(0, 1), a2 + hstepA, voffA);
            PG8_WAIT_L(8); PG8_BAR; PG8_WAIT_L(0); PG8_MMA(0, 0, At, B0); PG8_BAR; PG8_SCHED;
            PG8_LDB(B1, 1, 1); PG8_STAGE(PG8_SB(1, 0), b3, voffB);
            PG8_BAR; PG8_WAIT_L(0); PG8_MMA(0, 1, At, B1); PG8_BAR;
            PG8_LDA(At, 1, 1); PG8_STAGE(PG8_SA(1, 0), a3, voffA);
            PG8_BAR; PG8_WAIT_L(0); PG8_MMA(1, 0, At, B0); PG8_BAR; PG8_SCHED;
            PG8_STAGE(PG8_SB(1, 1), b3 + hstepB, voffB);
            PG8_WAIT_V(6); PG8_BAR; PG8_MMA(1, 1, At, B1); PG8_BAR;
            }
        }
        if constexpr (ALIGN_EPI) { if (wr == 0) PG8_BAR; }
        E(acc, cur, wr, wc, fr, fq);
        if (!has_next) break;
#pragma unroll
        for (int a = 0; a < 2; ++a)
#pragma unroll
            for (int b = 0; b < 2; ++b)
#pragma unroll
                for (int m = 0; m < 4; ++m)
#pragma unroll
                    for (int n = 0; n < 2; ++n) acc[a][b][m][n] = (f32x4){0.f, 0.f, 0.f, 0.f};
        cur = nxt; cA = nA; cB = nB; ++ui;
        if constexpr (ALIGN_EPI) { if (wr == 1) PG8_BAR; }
    }
    PG8_WAIT_V(0);
    if constexpr (!ALIGN_EPI) { if (wr == 0) PG8_BAR; }
    PG8_BAR;
#undef PG8_SA
#undef PG8_SB
#undef PG8_STAGE
#undef PG8_LDA
#undef PG8_LDB
#undef PG8_MMA
#undef PG8_WAIT_V
#undef PG8_WAIT_L
#undef PG8_BAR
#undef PG8_SCHED
}
}

#define LAS __attribute__((address_space(3)))
typedef unsigned short bf16;
typedef float f32x4 __attribute__((ext_vector_type(4)));
typedef unsigned u32x4 __attribute__((ext_vector_type(4)));
typedef unsigned u32x2 __attribute__((ext_vector_type(2)));

constexpr int NB = 8, T = 4096, D = 1024, M = NB * T, NL = 2;
constexpr int INW = 9160;
constexpr int PP = 5120;
constexpr int C_AQ = 0, C_AK = 768, C_AV = 1536, C_BQ = 2304, C_BK = 2560, C_BV = 2816, C_IQ = 3072, C_IK = 3328, C_C = 3392, C_DZ = 4288, C_DX = 4544, C_IW = 5056, C_DT = 5060, C_END = 5064;
constexpr int NEXP = 32, DEXP = 512;
constexpr int CAP = 73728;
constexpr float LN_EPS = 1e-5f;
constexpr float ALPHA = 1.4142135623730951f;

constexpr size_t MiB = 1u << 20;
constexpr size_t WS_CTL = 0, CTL_BYTES = 1 * MiB;
constexpr size_t WS_WINT = 2 * MiB;
constexpr size_t WS_WGT = 22 * MiB;
constexpr size_t WS_WBRT = 38 * MiB;
constexpr size_t WS_WOUTT = 42 * MiB;
constexpr size_t WS_WRT = 46 * MiB;
constexpr size_t WS_ROUTE = 47 * MiB;
constexpr size_t WS_XB = 48 * MiB;
constexpr size_t WS_O = 112 * MiB;
constexpr size_t WS_VF = 176 * MiB;
constexpr size_t WS_P = 192 * MiB;
constexpr size_t WS_GS = 192 * MiB;
constexpr size_t WS_MERGED = 448 * MiB;
constexpr size_t WS_XS = 192 * MiB;
constexpr size_t WS_H = 336 * MiB;
constexpr size_t WS_WGU = 408 * MiB;
constexpr size_t WS_WD = 472 * MiB;
constexpr size_t WS_RW = 512 * MiB;
constexpr size_t WS_RW2 = 544 * MiB;
constexpr size_t WS_BONG = 46 * MiB + 512 * 1024;
constexpr size_t WS_END = 592 * MiB;
constexpr int CW_CNT = 64, CW_Q = 256, CW_BAR = 4096;

constexpr int RING_BYTES = 131072, MISC_OFF = RING_BYTES, LDS_BYTES = 147456;
constexpr int NWAVES = 8, NTHR = 512;

__device__ __forceinline__ float bf2f(bf16 v) { return __uint_as_float(((unsigned)v) << 16); }
__device__ __forceinline__ unsigned pk2(float lo, float hi) { return pg8::cvt_pk_bf16(lo, hi); }
__device__ __forceinline__ unsigned f2bf(float f) { unsigned u = __float_as_uint(f); return (u + 0x7fffu + ((u >> 16) & 1u)) >> 16; }
#define DPP_ADD(v, ctrl) v += __builtin_bit_cast(float, __builtin_amdgcn_update_dpp(0, __builtin_bit_cast(int, v), ctrl, 0xF, 0xF, true))
#define DPP_MAX(v, ctrl) v = fmaxf(v, __builtin_bit_cast(float, __builtin_amdgcn_update_dpp(0, __builtin_bit_cast(int, v), ctrl, 0xF, 0xF, true)))
__device__ __forceinline__ float wave_sum(float v) {
    DPP_ADD(v, 0xB1); DPP_ADD(v, 0x4E); DPP_ADD(v, 0x141); DPP_ADD(v, 0x140);
    v += __shfl_xor(v, 16); v += __shfl_xor(v, 32);
    return v;
}
__device__ __forceinline__ float wave_max(float v) {
    DPP_MAX(v, 0xB1); DPP_MAX(v, 0x4E); DPP_MAX(v, 0x141); DPP_MAX(v, 0x140);
    v = fmaxf(v, __shfl_xor(v, 16)); v = fmaxf(v, __shfl_xor(v, 32));
    return v;
}
__device__ __forceinline__ float sigmoid_div_(float x) { return 1.f / (1.f + __expf(-x)); }
__device__ __forceinline__ float sigmoidf_(float x) { return __builtin_amdgcn_rcpf(1.f + __expf(-x)); }
__device__ __forceinline__ float softplusf_(float x) { return x > 20.f ? x : __logf(1.f + __expf(x)); }
__device__ __forceinline__ float tanhf_(float x) { const float e = __expf(-2.f * fabsf(x)); const float t = (1.f - e) * __builtin_amdgcn_rcpf(1.f + e); return x < 0.f ? -t : t; }
__device__ __forceinline__ float siluf_(float x) { return x * __builtin_amdgcn_rcpf(1.f + __expf(-x)); }

struct Args { const float* in[35]; float* out; unsigned char* ws; int ph_lo, ph_hi; };
enum { I_X = 0, I_WIN, I_CMU, I_CW0, I_CW2, I_CA0, I_CA2, I_CG2, I_CKK, I_CKA, I_CRK, I_CGNW, I_CGNB, I_CV0, I_CV1, I_CV2, I_DCW, I_DCB, I_DDTB, I_DALOG, I_DSKIP, I_DNW,
       I_WBR, I_WOUT, I_LN1G, I_LN1B, I_RG, I_RGB, I_RE, I_REB, I_EG, I_EU, I_ED, I_LN2G, I_LN2B };

__device__ __forceinline__ void transpose_item(const float* W, int ldn, int c0, int ncols, bf16* dst, int dld, int r0, int dk0, int kb, int nb, LAS float* scr, int lane) {
    const int k0 = 64 * kb, n0 = 32 * nb;
    const bool okn = (n0 + (lane & 31)) < ncols;
    float tv[32];
#pragma unroll
    for (int i = 0; i < 32; ++i) { const int kk = 2 * i + (lane >> 5); tv[i] = okn ? W[(size_t)(k0 + kk) * ldn + c0 + n0 + (lane & 31)] : 0.f; }
#pragma unroll
    for (int i = 0; i < 32; ++i) { const int kk = 2 * i + (lane >> 5); scr[kk * 33 + (lane & 31)] = tv[i]; }
    asm volatile("s_waitcnt lgkmcnt(0)" ::: "memory");
    const int c = lane & 7;
#pragma unroll
    for (int j = 0; j < 4; ++j) { const int n = (lane >> 3) + 8 * j; const LAS float* s = scr + (8 * c) * 33 + n;
        u32x4 o; o.x = pk2(s[0 * 33], s[1 * 33]); o.y = pk2(s[2 * 33], s[3 * 33]); o.z = pk2(s[4 * 33], s[5 * 33]); o.w = pk2(s[6 * 33], s[7 * 33]);
        if (n0 + n < ncols) *(u32x4*)(dst + (size_t)(r0 + n0 + n) * dld + dk0 + k0 + 8 * c) = o; }
    asm volatile("s_waitcnt lgkmcnt(0)" ::: "memory");
}

struct EpiStoreBf16 {
    static constexpr bool PERM = true;
    bf16* O; int ldc; int act; int ncols;
    __device__ __forceinline__ void operator()(const pg8::f32x4 (&acc)[2][2][4][2], const pg8::Unit& u, int wr, int wc, int fr, int fq) const {
        pg8::epi_mfma_settle(acc);
        const int row0 = u.pm * 256 + wr * 64 + fr; const int col0 = u.pn * 256 + wc * 32 + 8 * fq;
#pragma unroll
        for (int ai = 0; ai < 2; ++ai)
#pragma unroll
            for (int m = 0; m < 4; ++m) { bf16* rowp = O + (size_t)(row0 + ai * 128 + m * 16) * ldc + col0;
#pragma unroll
                for (int bj = 0; bj < 2; ++bj) { pg8::f32x4 v0 = acc[ai][bj][m][0], v1 = acc[ai][bj][m][1];
                    if (act == 1) {
#pragma unroll
                        for (int j = 0; j < 4; ++j) { v0[j] = sigmoidf_(v0[j]); v1[j] = sigmoidf_(v1[j]); } }
                    u32x4 w; w.x = pg8::cvt_pk_bf16(v0[0], v0[1]); w.y = pg8::cvt_pk_bf16(v0[2], v0[3]); w.z = pg8::cvt_pk_bf16(v1[0], v1[1]); w.w = pg8::cvt_pk_bf16(v1[2], v1[3]);
                    if (col0 + bj * 128 < ncols) *(u32x4*)(rowp + bj * 128) = w; } }
    }
};
struct EpiBranch {
    static constexpr bool PERM = true;
    const bf16* GS; bf16* MG;
    __device__ __forceinline__ void operator()(const pg8::f32x4 (&acc)[2][2][4][2], const pg8::Unit& u, int wr, int wc, int fr, int fq) const {
        pg8::epi_mfma_settle(acc);
        const int n = u.aux;
        const bf16* gbase = GS + (size_t)(u.pm * 256 + wr * 64 + fr) * 4096 + n * 1024 + u.pn * 256 + wc * 32 + 8 * fq;
        bf16* mbase = MG + (size_t)(u.pm * 256 + wr * 64 + fr) * 1024 + u.pn * 256 + wc * 32 + 8 * fq;
#pragma unroll
        for (int ai = 0; ai < 2; ++ai)
#pragma unroll
            for (int m = 0; m < 4; ++m) {
#pragma unroll
                for (int bj = 0; bj < 2; ++bj) {
                    const u32x4 gv = *(const u32x4*)(gbase + (size_t)(ai * 128 + m * 16) * 4096 + bj * 128);
                    bf16* mp = mbase + (size_t)(ai * 128 + m * 16) * 1024 + bj * 128;
                    u32x4 ov = (u32x4){0u, 0u, 0u, 0u}; if (n != 0) ov = *(const u32x4*)mp;
                    const pg8::f32x4 a0 = acc[ai][bj][m][0], a1 = acc[ai][bj][m][1];
                    u32x4 w;
                    w.x = pg8::cvt_pk_bf16(a0[0] * __uint_as_float(gv.x << 16) + __uint_as_float(ov.x << 16), a0[1] * __uint_as_float(gv.x & 0xffff0000u) + __uint_as_float(ov.x & 0xffff0000u));
                    w.y = pg8::cvt_pk_bf16(a0[2] * __uint_as_float(gv.y << 16) + __uint_as_float(ov.y << 16), a0[3] * __uint_as_float(gv.y & 0xffff0000u) + __uint_as_float(ov.y & 0xffff0000u));
                    w.z = pg8::cvt_pk_bf16(a1[0] * __uint_as_float(gv.z << 16) + __uint_as_float(ov.z << 16), a1[1] * __uint_as_float(gv.z & 0xffff0000u) + __uint_as_float(ov.z & 0xffff0000u));
                    w.w = pg8::cvt_pk_bf16(a1[2] * __uint_as_float(gv.w << 16) + __uint_as_float(ov.w << 16), a1[3] * __uint_as_float(gv.w & 0xffff0000u) + __uint_as_float(ov.w & 0xffff0000u));
                    *(u32x4*)mp = w; asm volatile("" ::: "memory"); } }
    }
};
struct EpiResid {
    static constexpr bool PERM = false;
    float* X;
    __device__ __forceinline__ void operator()(const pg8::f32x4 (&acc)[2][2][4][2], const pg8::Unit& u, int wr, int wc, int fr, int fq) const {
        pg8::epi_mfma_settle(acc);
        const int row0 = u.pm * 256 + wr * 64 + fr, col0 = u.pn * 256 + wc * 32 + 4 * fq;
#pragma unroll
        for (int ai = 0; ai < 2; ++ai)
#pragma unroll
            for (int m = 0; m < 4; ++m) { float* rowp = X + (size_t)(row0 + ai * 128 + m * 16) * D + col0;
#pragma unroll
                for (int bj = 0; bj < 2; ++bj)
#pragma unroll
                    for (int n = 0; n < 2; ++n) { pg8::f32x4* p = (pg8::f32x4*)(rowp + bj * 128 + n * 16); *p = *p * ALPHA + acc[ai][bj][m][n]; } }
    }
};
struct EpiSwiglu {
    static constexpr bool PERM = true;
    bf16* H;
    __device__ __forceinline__ void operator()(const pg8::f32x4 (&acc)[2][2][4][2], const pg8::Unit& u, int wr, int wc, int fr, int fq) const {
        pg8::epi_mfma_settle(acc);
        const int row0 = u.pm * 256 + wr * 64 + fr; const int col0 = u.pn * 128 + wc * 32 + 8 * fq;
#pragma unroll
        for (int ai = 0; ai < 2; ++ai)
#pragma unroll
            for (int m = 0; m < 4; ++m) { bf16* rowp = H + (size_t)(row0 + ai * 128 + m * 16) * DEXP + col0;
                float v[8];
#pragma unroll
                for (int j = 0; j < 4; ++j) { v[j] = siluf_(acc[ai][0][m][0][j]) * acc[ai][1][m][0][j]; v[4 + j] = siluf_(acc[ai][0][m][1][j]) * acc[ai][1][m][1][j]; }
                u32x4 w; w.x = pg8::cvt_pk_bf16(v[0], v[1]); w.y = pg8::cvt_pk_bf16(v[2], v[3]); w.z = pg8::cvt_pk_bf16(v[4], v[5]); w.w = pg8::cvt_pk_bf16(v[6], v[7]);
                *(u32x4*)rowp = w; }
    }
};

struct SkewOrder {
    int nM, nN, nwg, c, lda, ldb;
    __device__ bool next(int i, pg8::Unit& u) const {
        long L;
        if (i < 5) L = (long)i * 256 + c; else { if (c < 32) return false; L = 1280 + (long)(i - 5) * 224 + (c - 32); }
        if (L >= nwg) return false;
        pg8::tile_of((int)L, nM, nN, u.pm, u.pn); u.aux = 0;
        u.aoff = (size_t)u.pm * 256 * lda * 2; u.boff = (size_t)u.pn * 256 * ldb * 2; return true;
    }
};
struct BranchOrder {
    int nM, nN, G, c;
    __device__ bool next(int i, pg8::Unit& u) const {
        const int tl = (i >> 2) * G + c; if (tl >= nM * nN) return false;
        pg8::tile_of(tl, nM, nN, u.pm, u.pn); u.aux = i & 3;
        u.aoff = ((size_t)u.pm * 256 * 1024 + (size_t)u.aux * 256) * 2; u.boff = ((size_t)u.pn * 256 * 1024 + (size_t)u.aux * 256) * 2; return true;
    }
};
struct MoeOrder {
    const volatile LAS int* tb; int G, c; size_t a_rowbytes, b_expbytes, b_tilebytes;
    __device__ bool next(int i, pg8::Unit& u) const {
        const int L = i * G + c; const int total = __builtin_amdgcn_readfirstlane(tb[32]) * 4; if (L >= total) return false;
        int e = 0;
#pragma unroll 1
        for (int k = 0; k < 32; ++k) if (L >= tb[k + 1] * 4) e = k + 1;
        const int nte = tb[e + 1] - tb[e]; const int r = L - tb[e] * 4; const int ct = r / nte, rt = r % nte;
        u.pm = __builtin_amdgcn_readfirstlane(tb[33 + e] + rt); u.pn = __builtin_amdgcn_readfirstlane(ct); u.aux = __builtin_amdgcn_readfirstlane(e);
        u.aoff = (size_t)u.pm * 256 * a_rowbytes; u.boff = (size_t)u.aux * b_expbytes + (size_t)u.pn * b_tilebytes; return true;
    }
};

constexpr int PTR_OFF = LDS_BYTES - 512;
__device__ __forceinline__ void ptr_table_fill(const Args& args, LAS unsigned char* lds) {
    if (threadIdx.x == 0) {
        volatile LAS unsigned long long* t = (volatile LAS unsigned long long*)(lds + PTR_OFF);
#define PT_(i) t[i] = (unsigned long long)args.in[i];
        PT_(0) PT_(1) PT_(2) PT_(3) PT_(4) PT_(5) PT_(6) PT_(7) PT_(8) PT_(9) PT_(10) PT_(11) PT_(12) PT_(13) PT_(14) PT_(15) PT_(16) PT_(17) PT_(18) PT_(19)
        PT_(20) PT_(21) PT_(22) PT_(23) PT_(24) PT_(25) PT_(26) PT_(27) PT_(28) PT_(29) PT_(30) PT_(31) PT_(32) PT_(33) PT_(34)
#undef PT_
        t[35] = (unsigned long long)args.out; t[36] = (unsigned long long)args.ws; t[37] = (unsigned long long)(unsigned)args.ph_lo;
    }
    __syncthreads();
}
__device__ __forceinline__ unsigned long long ldptr(LAS unsigned char* lds, int i) {
    unsigned a = (unsigned)(PTR_OFF + 8 * i); asm volatile("" : "+v"(a));
    const volatile LAS unsigned* t = (const volatile LAS unsigned*)(lds + a);
    const unsigned lo = __builtin_amdgcn_readfirstlane(t[0]), hi = __builtin_amdgcn_readfirstlane(t[1]);
    return ((unsigned long long)hi << 32) | lo;
}
__device__ __forceinline__ void* gptr(unsigned long long v) { return (void*)(__attribute__((address_space(1))) void*)v; }
#define INP(i) ((const float*)gptr(ldptr(lds, (i))))
namespace rw {
typedef short bf16x8 __attribute__((ext_vector_type(8)));
typedef float f4 __attribute__((ext_vector_type(4)));
constexpr int LS = 72;
constexpr int MB = 64 * LS * 2;
constexpr int O_AHN = 0, O_RHN = MB, O_BCN = 2 * MB, O_KCN = 3 * MB, O_AHT = 4 * MB, O_BTT = 5 * MB, O_KTT = 6 * MB, O_VT = 7 * MB, O_STT = 8 * MB,
              O_MAK = 9 * MB, O_MRB = 10 * MB, O_MRK = 11 * MB, O_TINV = 12 * MB, O_MABF = 13 * MB, O_GAM = 13 * MB + 16384, O_CT = O_GAM + 256, O_BON = O_CT + 4608, O_END = O_BON + 256;
constexpr int O_MVT = O_BCN, O_A2N = O_AHN, O_UT = O_KCN, O_YF = O_AHT;
constexpr int O_TAB = O_MAK, O_SCR = O_TAB + 26624, O_TOT = O_SCR + 8 * 1024, O_CUM = O_TOT + 2048;
static_assert(O_CUM + 16384 <= O_GAM && O_END <= LDS_BYTES - 576, "rwkv LDS map");

__device__ __forceinline__ bf16x8 ldfrag(const LAS unsigned char* lds, int off, int r0, int ks, int lane) {
    return *(const LAS bf16x8*)(lds + off + ((r0 + (lane & 15)) * LS + ks * 32 + (lane >> 4) * 8) * 2);
}
__device__ __forceinline__ void mm64(f4 (&acc)[2], const LAS unsigned char* lds, int offA, int offBt, int w, int lane) {
    const int tr = w >> 1; const bf16x8 a0 = ldfrag(lds, offA, tr * 16, 0, lane), a1 = ldfrag(lds, offA, tr * 16, 1, lane);
#pragma unroll
    for (int c = 0; c < 2; ++c) { const int tc = (w & 1) * 2 + c; const bf16x8 b0 = ldfrag(lds, offBt, tc * 16, 0, lane), b1 = ldfrag(lds, offBt, tc * 16, 1, lane);
        acc[c] = __builtin_amdgcn_mfma_f32_16x16x32_bf16(a0, b0, acc[c], 0, 0, 0); acc[c] = __builtin_amdgcn_mfma_f32_16x16x32_bf16(a1, b1, acc[c], 0, 0, 0); }
}
__device__ __forceinline__ void storeT(LAS unsigned char* lds, int off, const f4 (&acc)[2], int w, int lane) {
    asm volatile("s_nop 11" :: "v"(acc[0]), "v"(acc[1]));
#pragma unroll
    for (int c = 0; c < 2; ++c) { const int col = ((w & 1) * 2 + c) * 16 + (lane & 15), row = (w >> 1) * 16 + 4 * (lane >> 4);
        u32x2 v; v.x = pk2(acc[c][0], acc[c][1]); v.y = pk2(acc[c][2], acc[c][3]); *(LAS u32x2*)(lds + off + (col * LS + row) * 2) = v; }
}
template <int MASK  >
__device__ __forceinline__ void storeN(LAS unsigned char* lds, int off, const f4 (&acc)[2], int w, int lane) {
    asm volatile("s_nop 11" :: "v"(acc[0]), "v"(acc[1]));
#pragma unroll
    for (int c = 0; c < 2; ++c) { const int col = ((w & 1) * 2 + c) * 16 + (lane & 15), row = (w >> 1) * 16 + 4 * (lane >> 4);
#pragma unroll
        for (int e = 0; e < 4; ++e) { float x = acc[c][e]; if (MASK == 1) x = (col < row + e) ? x : 0.f; if (MASK == 2) x = (col <= row + e) ? x : 0.f;
            *(LAS bf16*)(lds + off + ((row + e) * LS + col) * 2) = (bf16)f2bf(x); } }
}
typedef __bf16 bf2v __attribute__((ext_vector_type(2)));
__device__ __forceinline__ float dot2(unsigned x, unsigned y, float c) { return __builtin_amdgcn_fdot2_f32_bf16(__builtin_bit_cast(bf2v, x), __builtin_bit_cast(bf2v, y), c, false); }
#define RW_ZERO(a) do { a[0] = (f4){0.f, 0.f, 0.f, 0.f}; a[1] = (f4){0.f, 0.f, 0.f, 0.f}; } while (0)

__device__ __forceinline__ void build_ct(LAS unsigned char* lds0, const int l, const int h, const int lane, const int wave) {
    LAS unsigned char* const& lds = lds0; const int c = h * 64 + lane;
    const float* mu = INP(I_CMU) + (size_t)l * 896;
    if (wave == 0) { LAS float* ct = (LAS float*)(lds0 + O_CT);
        ct[0 * 64 + lane] = mu[c]; ct[1 * 64 + lane] = mu[256 + c]; ct[2 * 64 + lane] = mu[512 + c]; ct[3 * 64 + lane] = mu[768 + lane]; ct[4 * 64 + lane] = mu[832 + lane];
        ct[5 * 64 + lane] = INP(I_CW0)[l * 256 + c]; ct[6 * 64 + lane] = INP(I_CA0)[l * 256 + c]; ct[7 * 64 + lane] = INP(I_CKK)[l * 256 + c]; ct[8 * 64 + lane] = INP(I_CKA)[l * 256 + c];
        ct[9 * 64 + lane] = INP(I_CRK)[l * 256 + c]; ct[10 * 64 + lane] = INP(I_CGNW)[l * 256 + c]; ct[11 * 64 + lane] = INP(I_CGNB)[l * 256 + c]; ct[12 * 64 + lane] = l > 0 ? INP(I_CV0)[(l - 1) * 256 + c] : 0.f;
        ct[13 * 64 + lane] = mu[512 + lane]; ct[14 * 64 + lane] = mu[512 + lane + 64]; ct[15 * 64 + lane] = mu[512 + lane + 128]; ct[16 * 64 + lane] = mu[512 + lane + 192]; }
}
template <int MODE>
__device__ __forceinline__ void chunk(LAS unsigned char* lds0, const int l, const int b, const int h, const int t0, unsigned char* gz, unsigned char* gz2, float* bong, const bf16* P, bf16* VF, bf16* OB, const int tid0) {
    const int c = h * 64 + (tid0 & 63);
    {
        unsigned lb_ = 0u; int tid_l = tid0; asm volatile("" : "+v"(lb_), "+v"(tid_l));
        const int tid = tid_l, lane = tid & 63, wave = __builtin_amdgcn_readfirstlane(tid >> 6);
        LAS unsigned char* lds = lds0 + lb_;
        LAS bf16* TAB = (LAS bf16*)(lds + O_TAB); const LAS unsigned* TABW = (const LAS unsigned*)(lds + O_TAB);
        LAS bf16* scr = (LAS bf16*)(lds + O_SCR + wave * 1024);
        LAS float* CUM = (LAS float*)(lds + O_CUM);
        LAS float* TOT = (LAS float*)(lds + O_TOT);
        LAS float* GAM = (LAS float*)(lds + O_GAM);
        LAS float* MABF = (LAS float*)(lds + O_MABF);
        LAS float* YF = (LAS float*)(lds + O_YF);
        LAS float* BON = (LAS float*)(lds + O_BON);
        const LAS float* CT = (const LAS float*)(lds + O_CT);
#define CTV(k) CT[(k) * 64 + lane]
        LAS float* ASF = (LAS float*)(lds + O_TAB);
        LAS bf16* GSF = (LAS bf16*)(lds + O_STT);
        float Xr[9], Xg[9]; unsigned RK[9], VX[9], Va[9], Vb[9];
        { const float* cw2 = INP(I_CW2) + (size_t)l * 32 * 256; const float* ca2 = INP(I_CA2) + (size_t)l * 32 * 256; const float* cg2 = INP(I_CG2) + (size_t)l * 64 * 256;
          float twa[8], tg[8];
#pragma unroll
          for (int u = 0; u < 8; ++u) { const int i = tid + u * NTHR, mm = i >> 6, cc = i & 63;
              twa[u] = mm < 32 ? cw2[mm * 256 + h * 64 + cc] : ca2[(mm - 32) * 256 + h * 64 + cc]; tg[u] = cg2[mm * 256 + h * 64 + cc]; }
          float t2[2], t1[8];
          if (l > 0) { const float* cv1 = INP(I_CV1) + (size_t)(l - 1) * 256 * 16; const float* cv2 = INP(I_CV2) + (size_t)(l - 1) * 16 * 256;
#pragma unroll
            for (int u = 0; u < 2; ++u) { const int i = tid + u * NTHR; t2[u] = cv2[(i >> 6) * 256 + h * 64 + (i & 63)]; }
#pragma unroll
            for (int u = 0; u < 8; ++u) t1[u] = cv1[tid + u * NTHR]; }
#pragma unroll
          for (int j = 0; j < 9; ++j) { const int t = t0 + wave * 8 - 1 + j; const bool ok_ = t >= 0; const size_t m_ = (size_t)b * T + (ok_ ? t : 0); const bf16* row_ = P + m_ * PP + C_C;
              Xr[j] = ok_ ? bf2f(row_[768 + lane]) : 0.f; Xg[j] = ok_ ? bf2f(row_[832 + lane]) : 0.f;
              RK[j] = ok_ ? ((unsigned)row_[c] | ((unsigned)row_[256 + c] << 16)) : 0u; VX[j] = ok_ ? (unsigned)row_[512 + c] : 0u;
              if (l > 0) { Va[j] = ok_ ? ((unsigned)row_[512 + lane] | ((unsigned)row_[512 + lane + 64] << 16)) : 0u; Vb[j] = ok_ ? ((unsigned)row_[512 + lane + 128] | ((unsigned)row_[512 + lane + 192] << 16)) : 0u;
                  if (j > 0) VX[j] |= (unsigned)VF[m_ * 256 + c] << 16; } }
#pragma unroll
          for (int u = 0; u < 8; ++u) { const int i = tid + u * NTHR, mm = i >> 6, cc = i & 63;
              *(LAS bf16*)(lds + O_BCN + (cc * LS + mm) * 2) = (bf16)f2bf(twa[u]); *(LAS bf16*)(lds + O_KCN + (cc * LS + mm) * 2) = (bf16)f2bf(tg[u]); }
#define PIX(i) ((((i) >> 7) * 64 + ((i) & 63)) * 2 + (((i) >> 6) & 1))
          if (l > 0) {
#pragma unroll
            for (int u = 0; u < 2; ++u) { const int i = tid + u * NTHR; TAB[8192 + PIX(i)] = (bf16)f2bf(t2[u]); }
#pragma unroll
            for (int u = 0; u < 8; ++u) { const int i = tid + u * NTHR; const int cc = i >> 4, qq = i & 15; TAB[9216 + ((cc >> 1) * 16 + qq) * 2 + (cc & 1)] = (bf16)f2bf(t1[u]); } } }
#undef PIX
        {
#pragma unroll
          for (int q = 0; q < 8; ++q) { const int tt = wave * 8 + q;
              const float xx = Xr[q + 1] + (Xr[q] - Xr[q + 1]) * CTV(3), xg = Xg[q + 1] + (Xg[q] - Xg[q + 1]) * CTV(4);
              *(LAS bf16*)(lds + O_AHN + (tt * LS + lane) * 2) = (bf16)f2bf(lane < 32 ? tanhf_(xx) : xx);
              *(LAS bf16*)(lds + O_RHN + (tt * LS + lane) * 2) = (bf16)f2bf(sigmoidf_(xg)); } }
        __syncthreads();
        { const int tr = wave >> 1;
          const bf16x8 a0 = ldfrag(lds, O_AHN, tr * 16, 0, lane), a1 = ldfrag(lds, O_AHN, tr * 16, 1, lane), g0 = ldfrag(lds, O_RHN, tr * 16, 0, lane), g1 = ldfrag(lds, O_RHN, tr * 16, 1, lane);
#pragma unroll
          for (int cI = 0; cI < 2; ++cI) { const int tc = (wave & 1) * 2 + cI;
              const bf16x8 b0 = ldfrag(lds, O_BCN, tc * 16, 0, lane), b1 = ldfrag(lds, O_BCN, tc * 16, 1, lane), c0 = ldfrag(lds, O_KCN, tc * 16, 0, lane), c1 = ldfrag(lds, O_KCN, tc * 16, 1, lane);
              const f4 z = (f4){0.f, 0.f, 0.f, 0.f};
              const f4 aw = __builtin_amdgcn_mfma_f32_16x16x32_bf16(a0, b0, z, 0, 0, 0), aa = __builtin_amdgcn_mfma_f32_16x16x32_bf16(a1, b1, z, 0, 0, 0);
              f4 ag = __builtin_amdgcn_mfma_f32_16x16x32_bf16(g0, c0, z, 0, 0, 0); ag = __builtin_amdgcn_mfma_f32_16x16x32_bf16(g1, c1, ag, 0, 0, 0);
              const int col = tc * 16 + (lane & 15), row = tr * 16 + 4 * (lane >> 4);
#pragma unroll
              for (int e = 0; e < 4; ++e) { CUM[(row + e) * 64 + col] = aw[e]; ASF[(row + e) * 64 + col] = aa[e]; GSF[(row + e) * 64 + col] = (bf16)f2bf(ag[e]); } } }
        __syncthreads();
        { float run = 0.f;
#pragma unroll
            for (int q = 0; q < 8; ++q) { const int tt = wave * 8 + q;
                const float wsum = CTV(5) + CUM[tt * 64 + lane];
                run += -0.6065306597f * sigmoidf_(wsum); CUM[tt * 64 + lane] = run; }
            TOT[wave * 64 + lane] = run; }
        __syncthreads();
        float offs = 0.f, cumL = 0.f;
#pragma unroll
        for (int w2 = 0; w2 < 8; ++w2) { const float tw = TOT[w2 * 64 + lane]; offs += (w2 < wave) ? tw : 0.f; cumL += tw; }
        if (wave == 0) GAM[lane] = __expf(cumL);
#define LO_(x) __uint_as_float((x) << 16)
#define HI_(x) __uint_as_float((x) & 0xffff0000u)
#pragma unroll
        for (int q = 0; q < 8; ++q) {
            const int tt = wave * 8 + q; const size_t m = (size_t)b * T + t0 + tt;
            const unsigned pRK = RK[q], cRK = RK[q + 1], pVX = VX[q], cVX = VX[q + 1], pVa = Va[q], cVa = Va[q + 1], pVb = Vb[q], cVb = Vb[q + 1];
            const float r = LO_(cRK) + (LO_(pRK) - LO_(cRK)) * CTV(0), k = HI_(cRK) + (HI_(pRK) - HI_(cRK)) * CTV(1); float v = LO_(cVX) + (LO_(pVX) - LO_(cVX)) * CTV(2);
            const float asum = CTV(6) + ASF[tt * 64 + lane]; const unsigned gbits = (unsigned)GSF[tt * 64 + lane];
            const float cq = CUM[tt * 64 + lane], cprev = q > 0 ? CUM[(tt - 1) * 64 + lane] : 0.f;
            if (l > 0) {
                LAS bf16* vsc = scr + 128;
                vsc[lane] = (bf16)f2bf(LO_(cVa) + (LO_(pVa) - LO_(cVa)) * CTV(13)); vsc[lane + 64] = (bf16)f2bf(HI_(cVa) + (HI_(pVa) - HI_(cVa)) * CTV(14));
                vsc[lane + 128] = (bf16)f2bf(LO_(cVb) + (LO_(pVb) - LO_(cVb)) * CTV(15)); vsc[lane + 192] = (bf16)f2bf(HI_(cVb) + (HI_(pVb) - HI_(cVb)) * CTV(16));
                asm volatile("s_waitcnt lgkmcnt(0)" ::: "memory");
                const int qq = lane & 15, part = lane >> 4; float s = 0.f; { float s1 = 0.f; const LAS unsigned* sv = (const LAS unsigned*)vsc;
#pragma unroll
                for (int p = 0; p < 32; p += 2) { s = dot2(sv[part * 32 + p], TABW[4608 + (part * 32 + p) * 16 + qq], s); s1 = dot2(sv[part * 32 + p + 1], TABW[4608 + (part * 32 + p + 1) * 16 + qq], s1); }
                s += s1; }
                s += __shfl_xor(s, 16); s += __shfl_xor(s, 32);
                float vl = CTV(12);
#pragma unroll
                for (int q2 = 0; q2 < 16; ++q2) vl += __shfl(s, q2) * bf2f(TAB[8192 + ((q2 >> 1) * 64 + lane) * 2 + (q2 & 1)]);
                const float vf = HI_(cVX); v = v + (vf - v) * sigmoidf_(vl);
            }
            if (MODE < 5) VF[m * 256 + c] = (bf16)f2bf(v);
            const float asig = sigmoidf_(asum), lw = cq - cprev;
            float kk = k * CTV(7); const float n2 = wave_sum(kk * kk); kk = kk * __builtin_amdgcn_rsqf(fmaxf(n2, 1e-24f));
            const float kmod = k * (1.f + (asig - 1.f) * CTV(8));
            const float bon = wave_sum(r * kmod * CTV(9));
            const float cum = offs + cq, cumx = cum - lw;
            const float ah = -kk * __expf(cumx), rh = r * __expf(cum), ei = __expf(-cum), bb = kk * asig, bc = bb * ei, kc = kmod * ei, ee = __expf(cumL - cum), bt = bb * ee, kt = kmod * ee;
            const int no = (tt * LS + lane) * 2, to = (lane * LS + tt) * 2;
            *(LAS bf16*)(lds + O_AHN + no) = (bf16)f2bf(ah); *(LAS bf16*)(lds + O_RHN + no) = (bf16)f2bf(rh);
            *(LAS bf16*)(lds + O_BCN + no) = (bf16)f2bf(bc); *(LAS bf16*)(lds + O_KCN + no) = (bf16)f2bf(kc); if (MODE < 5) ((bf16*)(gz2 + 16384))[tt * 64 + lane] = (bf16)gbits;
            *(LAS bf16*)(lds + O_AHT + to) = (bf16)f2bf(ah); *(LAS bf16*)(lds + O_BTT + to) = (bf16)f2bf(bt);
            *(LAS bf16*)(lds + O_KTT + to) = (bf16)f2bf(kt); *(LAS bf16*)(lds + O_VT + to) = (bf16)f2bf(v);
            if (MODE < 5 && lane == 0) bong[tt] = bon;
            asm volatile("s_waitcnt lgkmcnt(0)" ::: "memory");
        }
        __syncthreads();
        if (MODE == 6) return;
        { f4 acc[2];
            RW_ZERO(acc); mm64(acc, lds, O_AHN, O_BCN, wave, lane);
#pragma unroll
            for (int cI = 0; cI < 2; ++cI) { const int col = ((wave & 1) * 2 + cI) * 16 + (lane & 15), row = (wave >> 1) * 16 + 4 * (lane >> 4);
#pragma unroll
                for (int e = 0; e < 4; ++e) MABF[(row + e) * 64 + col] = (col < row + e) ? acc[cI][e] : 0.f; }
            RW_ZERO(acc); mm64(acc, lds, O_AHN, O_KCN, wave, lane); storeN<1>(lds, O_MAK, acc, wave, lane);
            { f4 accb[2]; RW_ZERO(accb); mm64(accb, lds, O_RHN, O_BCN, wave, lane); f4 accc[2]; RW_ZERO(accc); mm64(accc, lds, O_RHN, O_KCN, wave, lane);
                storeN<2>(lds, O_MRB, accb, wave, lane); storeN<2>(lds, O_MRK, accc, wave, lane); }
        }
        __syncthreads();
        {
            const int cS = wave * 8 + (lane >> 3), tS = lane & 7;
            float xs[8];
#pragma unroll
            for (int k = 0; k < 8; ++k) xs[k] = 0.f;
#pragma unroll
            for (int i = 1; i < 64; ++i) {
                float part = 0.f;
#pragma unroll
                for (int k = 0; k < (i + 7) / 8; ++k) { const float mv = MABF[i * 64 + tS + 8 * k]; part += ((tS + 8 * k) < i ? mv : 0.f) * xs[k]; }
                part += __builtin_bit_cast(float, __builtin_amdgcn_update_dpp(0, __builtin_bit_cast(int, part), 0xB1, 0xF, 0xF, true));
                part += __builtin_bit_cast(float, __builtin_amdgcn_update_dpp(0, __builtin_bit_cast(int, part), 0x4E, 0xF, 0xF, true));
                part += __builtin_bit_cast(float, __builtin_amdgcn_update_dpp(0, __builtin_bit_cast(int, part), 0x141, 0xF, 0xF, true));
                const float xi = MABF[i * 64 + cS] + part;
                xs[i >> 3] = (tS == (i & 7)) ? xi : xs[i >> 3];
            }
#pragma unroll
            for (int k = 0; k < 8; ++k) { const int i = tS + 8 * k; *(LAS bf16*)(lds + O_TINV + (i * LS + cS) * 2) = (bf16)f2bf(i == cS ? 1.f : xs[k]); }
        }
        __syncthreads();
        { f4 acc[2]; RW_ZERO(acc); mm64(acc, lds, O_MAK, O_VT, wave, lane); storeT(lds, O_MVT, acc, wave, lane); }
        __syncthreads();
        if (MODE == 1 || MODE == 5) {
            { f4 acc[2]; RW_ZERO(acc); mm64(acc, lds, O_TINV, O_AHT, wave, lane); storeT(lds, O_UT, acc, wave, lane); }
            { f4 acc[2]; RW_ZERO(acc); mm64(acc, lds, O_TINV, O_MVT, wave, lane); storeT(lds, O_MAK, acc, wave, lane); }
            __syncthreads();
            f4 agm[2], azm[2], ar2[2], ay0[2];
            RW_ZERO(agm); mm64(agm, lds, O_BTT, O_UT, wave, lane);
#pragma unroll
            for (int cI = 0; cI < 2; ++cI) { const int col = ((wave & 1) * 2 + cI) * 16 + (lane & 15), row = (wave >> 1) * 16 + 4 * (lane >> 4);
#pragma unroll
                for (int e = 0; e < 4; ++e) if (col == row + e) agm[cI][e] += GAM[col]; }
            RW_ZERO(azm); mm64(azm, lds, O_BTT, O_MAK, wave, lane); mm64(azm, lds, O_KTT, O_VT, wave, lane);
            RW_ZERO(ar2); mm64(ar2, lds, O_MRB, O_UT, wave, lane);
#pragma unroll
            for (int cI = 0; cI < 2; ++cI) { const int col = ((wave & 1) * 2 + cI) * 16 + (lane & 15), row = (wave >> 1) * 16 + 4 * (lane >> 4);
#pragma unroll
                for (int e = 0; e < 4; ++e) ar2[cI][e] += bf2f(*(const LAS bf16*)(lds + O_RHN + ((row + e) * LS + col) * 2)); }
            RW_ZERO(ay0); mm64(ay0, lds, O_MRB, O_MAK, wave, lane); mm64(ay0, lds, O_MRK, O_VT, wave, lane);
            __syncthreads();
            storeN<0>(lds, O_AHN, agm, wave, lane); storeT(lds, O_RHN, azm, wave, lane); storeN<0>(lds, O_BCN, ar2, wave, lane); storeT(lds, O_KCN, ay0, wave, lane);
            __syncthreads();
            if (MODE == 1) { const int io = ((tid >> 3) * LS + (tid & 7) * 8) * 2;
              ((u32x4*)gz)[tid] = *(const LAS u32x4*)(lds + O_AHN + io); ((u32x4*)(gz + 8192))[tid] = *(const LAS u32x4*)(lds + O_RHN + io);
              ((u32x4*)gz2)[tid] = *(const LAS u32x4*)(lds + O_BCN + io); ((u32x4*)(gz2 + 8192))[tid] = *(const LAS u32x4*)(lds + O_KCN + io); }
        } else {
            { f4 acc[2]; RW_ZERO(acc); mm64(acc, lds, O_TINV, O_AHT, wave, lane); storeN<0>(lds, O_A2N, acc, wave, lane); }
            __syncthreads();
            { f4 acc[2]; RW_ZERO(acc); mm64(acc, lds, O_TINV, O_MVT, wave, lane); mm64(acc, lds, O_A2N, O_STT, wave, lane); storeT(lds, O_UT, acc, wave, lane); }
            __syncthreads();
            f4 yacc[2]; RW_ZERO(yacc);
            mm64(yacc, lds, O_RHN, O_STT, wave, lane); mm64(yacc, lds, O_MRB, O_UT, wave, lane); mm64(yacc, lds, O_MRK, O_VT, wave, lane);
            __syncthreads();
#pragma unroll
            for (int cI = 0; cI < 2; ++cI) { const int col = ((wave & 1) * 2 + cI) * 16 + (lane & 15), row = (wave >> 1) * 16 + 4 * (lane >> 4);
#pragma unroll
                for (int e = 0; e < 4; ++e) YF[(row + e) * 64 + col] = yacc[cI][e]; }
            __syncthreads();
            { unsigned gcur = (unsigned)OB[((size_t)b * T + t0 + wave * 8) * 1024 + 512 + c];
#pragma unroll 1
            for (int q = 0; q < 8; ++q) {
                const int tt = wave * 8 + q; const size_t m = (size_t)b * T + t0 + tt;
                const unsigned gnxt = (unsigned)OB[(m + (q < 7 ? 1 : 0)) * 1024 + 512 + c];
                const float y = YF[tt * 64 + lane]; const float mean = wave_sum(y) * (1.f / 64.f); const float dy = y - mean; const float var = wave_sum(dy * dy) * (1.f / 64.f);
                const float yn = dy * rsqrtf(var + 64e-5f) * CTV(10) + CTV(11);
                const float vv = bf2f(*(const LAS bf16*)(lds + O_VT + (lane * LS + tt) * 2)), gg = LO_(gcur);
                OB[m * 1024 + 512 + c] = (bf16)f2bf((yn + BON[tt] * vv) * gg);
                gcur = gnxt;
            } }
        }
        __syncthreads();
#undef CTV
#undef LO_
#undef HI_
    }
}

__device__ __forceinline__ void chunk_out(LAS unsigned char* lds0, const int b, const int h, const int t0, const unsigned char* gz, const unsigned char* gz2, const float* bong, const bf16* VF, bf16* OB, const int tid0) {
    unsigned lb_ = 0u; int tid_l = tid0; asm volatile("" : "+v"(lb_), "+v"(tid_l));
    LAS unsigned char* lds = lds0 + lb_; const int tid = tid_l, lane = tid & 63, wave = __builtin_amdgcn_readfirstlane(tid >> 6);
    const int c = h * 64 + lane;
    const LAS float* CT = (const LAS float*)(lds + O_CT);
    LAS float* YF = (LAS float*)(lds + O_YF);
    const int io = ((tid >> 3) * LS + (tid & 7) * 8) * 2;
    const u32x4 sv = ((const u32x4*)gz)[tid], rv = ((const u32x4*)gz2)[tid];
    u32x2 yv[2];
#pragma unroll
    for (int k = 0; k < 2; ++k) { const int col = ((wave & 1) * 2 + k) * 16 + (lane & 15), row = (wave >> 1) * 16 + 4 * (lane >> 4); yv[k] = *(const u32x2*)(gz2 + 8192 + (col * 64 + row) * 2); }
    float gq[8], vq[8], bq[8];
#pragma unroll
    for (int q = 0; q < 8; ++q) { const int tt = wave * 8 + q; const size_t m = (size_t)b * T + t0 + tt;
        gq[q] = bf2f(((const bf16*)(gz2 + 16384))[tt * 64 + lane]); vq[q] = bf2f(VF[m * 256 + c]); bq[q] = bong[tt]; }
    *(LAS u32x4*)(lds + O_STT + io) = sv; *(LAS u32x4*)(lds + O_AHN + io) = rv;
    __syncthreads();
    f4 acc[2];
#pragma unroll
    for (int k = 0; k < 2; ++k) acc[k] = (f4){__uint_as_float(yv[k].x << 16), __uint_as_float(yv[k].x & 0xffff0000u), __uint_as_float(yv[k].y << 16), __uint_as_float(yv[k].y & 0xffff0000u)};
    mm64(acc, lds, O_AHN, O_STT, wave, lane);
#pragma unroll
    for (int cI = 0; cI < 2; ++cI) { const int col = ((wave & 1) * 2 + cI) * 16 + (lane & 15), row = (wave >> 1) * 16 + 4 * (lane >> 4);
#pragma unroll
        for (int e = 0; e < 4; ++e) YF[(row + e) * 64 + col] = acc[cI][e]; }
    __syncthreads();
#pragma unroll
    for (int q = 0; q < 8; ++q) { const int tt = wave * 8 + q; const size_t m = (size_t)b * T + t0 + tt;
        const float y = YF[tt * 64 + lane]; const float mean = wave_sum(y) * (1.f / 64.f); const float dy = y - mean; const float var = wave_sum(dy * dy) * (1.f / 64.f);
        const float yn = dy * rsqrtf(var + 64e-5f) * CT[10 * 64 + lane] + CT[11 * 64 + lane];
        OB[m * 1024 + 512 + c] = (bf16)f2bf((yn + bq[q] * vq[q]) * gq[q]); }
    __syncthreads();
}

__device__ __forceinline__ void carry(LAS unsigned char* lds0, unsigned char* gzc  , const int tid0) {
    f4 stacc[2]; RW_ZERO(stacc);
    { unsigned lb_ = 0u; asm volatile("" : "+v"(lb_)); LAS unsigned char* lds = lds0 + lb_; for (int i = tid0; i < MB / 4; i += NTHR) ((LAS unsigned*)(lds + O_STT))[i] = 0u; }
    u32x4 gnx = ((const u32x4*)gzc)[tid0];
    u32x2 znx[2];
    { const int lane = tid0 & 63, wave = tid0 >> 6;
#pragma unroll
      for (int k = 0; k < 2; ++k) { const int col = ((wave & 1) * 2 + k) * 16 + (lane & 15), row = (wave >> 1) * 16 + 4 * (lane >> 4); znx[k] = *(const u32x2*)(gzc + 8192 + (col * 64 + row) * 2); } }
#pragma unroll 1
    for (int cI = 0; cI < T / 64; ++cI) {
        unsigned lb_ = 0u; int tid_l = tid0; asm volatile("" : "+v"(lb_), "+v"(tid_l));
        LAS unsigned char* lds = lds0 + lb_; const int tid = tid_l, lane = tid & 63, wave = __builtin_amdgcn_readfirstlane(tid >> 6);
        unsigned char* rec = gzc + (size_t)cI * 16384;
        const int io = ((tid >> 3) * LS + (tid & 7) * 8) * 2;
        *(LAS u32x4*)(lds + O_AHN + io) = gnx;
        u32x2 zv[2]; zv[0] = znx[0]; zv[1] = znx[1];
        if (cI + 1 < T / 64) { gnx = ((const u32x4*)(rec + 16384))[tid];
#pragma unroll
            for (int k = 0; k < 2; ++k) { const int col = ((wave & 1) * 2 + k) * 16 + (lane & 15), row = (wave >> 1) * 16 + 4 * (lane >> 4); znx[k] = *(const u32x2*)(rec + 16384 + 8192 + (col * 64 + row) * 2); } }
        __syncthreads();
        ((u32x4*)rec)[tid] = *(const LAS u32x4*)(lds + O_STT + io);
        f4 acc[2];
#pragma unroll
        for (int k = 0; k < 2; ++k) acc[k] = (f4){__uint_as_float(zv[k].x << 16), __uint_as_float(zv[k].x & 0xffff0000u), __uint_as_float(zv[k].y << 16), __uint_as_float(zv[k].y & 0xffff0000u)};
        mm64(acc, lds, O_AHN, O_STT, wave, lane);
        __syncthreads();
        storeT(lds, O_STT, acc, wave, lane);
    }
}
}

namespace mb {
using rw::LS; using rw::MB; using rw::f4; using rw::mm64; using rw::storeN; using rw::bf16x8;
constexpr int O_CN = 0, O_BN = MB, O_BT = 2 * MB, O_XT0 = 3 * MB, O_XW0 = 5 * MB, O_CS0 = 7 * MB, O_HN0 = 9 * MB, O_SC0 = 11 * MB, O_SM = 13 * MB, O_YF = O_XW0;
static_assert(O_SM + 2048 <= LDS_BYTES - 576, "mamba LDS map");
__device__ __forceinline__ void chain(LAS unsigned char* lds0, const int l, const int b, const int gI, const bf16* P, bf16* OB, const int tid0, const int lane0, const int wave0) {
    const int tid = tid0, lane = lane0, wave = wave0;
    LAS unsigned char* const& lds = lds0;
    const float* cwp = INP(I_DCW) + (size_t)l * 4 * 512; const float* cbp = INP(I_DCB) + (size_t)l * 512;
    const int cc = tid & 255, sub = tid >> 8;
    const int col = cc < 128 ? (gI * 128 + cc) : (cc < 192 ? (256 + gI * 64 + (cc - 128)) : (384 + gI * 64 + (cc - 192)));
    const float cw0 = cwp[col], cw1 = cwp[512 + col], cw2 = cwp[1024 + col], cw3 = cwp[1536 + col], cb = cbp[col];
    f4 hacc[2][2];
#pragma unroll
    for (int hh = 0; hh < 2; ++hh) { hacc[hh][0] = (f4){0.f, 0.f, 0.f, 0.f}; hacc[hh][1] = (f4){0.f, 0.f, 0.f, 0.f}; }
    for (int i = tid; i < 2 * MB / 4; i += NTHR) ((LAS unsigned*)(lds0 + O_HN0))[i] = 0u;
    const float dtb0 = INP(I_DDTB)[l * 4 + gI * 2], dtb1 = INP(I_DDTB)[l * 4 + gI * 2 + 1];
    const float nA0 = -__expf(INP(I_DALOG)[l * 4 + gI * 2]), nA1 = -__expf(INP(I_DALOG)[l * 4 + gI * 2 + 1]);
    const float dsk0 = INP(I_DSKIP)[l * 4 + gI * 2], dsk1 = INP(I_DSKIP)[l * 4 + gI * 2 + 1];
    const float nw0 = INP(I_DNW)[l * 256 + gI * 128 + lane], nw1 = INP(I_DNW)[l * 256 + gI * 128 + 64 + lane];
#pragma unroll 1
    for (int t0 = 0; t0 < T; t0 += 64) {
        unsigned lb_ = 0u; int tid_l = tid0; asm volatile("" : "+v"(lb_), "+v"(tid_l));
        const int tid = tid_l, lane = tid & 63, wave = __builtin_amdgcn_readfirstlane(tid >> 6);
        LAS unsigned char* lds = lds0 + lb_;
        LAS float* SM = (LAS float*)(lds + O_SM);
        LAS float* YF = (LAS float*)(lds + O_YF);
        if (wave < 2) {
            const size_t m = (size_t)b * T + t0 + lane;
            const float dt = softplusf_(bf2f(P[m * PP + C_DT + gI * 2 + wave]) + (wave == 0 ? dtb0 : dtb1));
            float cs = dt * (wave == 0 ? nA0 : nA1);
#pragma unroll
            for (int o = 1; o < 64; o <<= 1) { const float y = __shfl_up(cs, o); if (lane >= o) cs += y; }
            const float cL = __shfl(cs, 63);
            SM[wave * 64 + lane] = dt; SM[128 + wave * 64 + lane] = cs; SM[256 + wave * 64 + lane] = __expf(cL - cs) * dt; SM[384 + wave * 64 + lane] = __expf(cs);
        }
        __syncthreads();
        { float h0, h1, h2, cur[8], nxt[8];
          { const int tb = t0 + sub * 32; h0 = tb >= 3 ? bf2f(P[((size_t)b * T + tb - 3) * PP + C_DX + col]) : 0.f; h1 = tb >= 2 ? bf2f(P[((size_t)b * T + tb - 2) * PP + C_DX + col]) : 0.f; h2 = tb >= 1 ? bf2f(P[((size_t)b * T + tb - 1) * PP + C_DX + col]) : 0.f;
#pragma unroll
            for (int j = 0; j < 8; ++j) cur[j] = bf2f(P[((size_t)b * T + tb + j) * PP + C_DX + col]); }
#pragma unroll 1
          for (int g8 = 0; g8 < 4; ++g8) {
            const int tb = t0 + sub * 32 + g8 * 8 + (g8 < 3 ? 8 : 0);
#pragma unroll
            for (int j = 0; j < 8; ++j) nxt[j] = bf2f(P[((size_t)b * T + tb + j) * PP + C_DX + col]);
#pragma unroll
            for (int j = 0; j < 8; ++j) {
                const int tt = sub * 32 + g8 * 8 + j;
                const float a = siluf_(cb + cw3 * cur[j] + cw2 * h2 + cw1 * h1 + cw0 * h0);
                h0 = h1; h1 = h2; h2 = cur[j];
                if (cc < 128) { const int hh = cc >> 6, p = cc & 63;
                    *(LAS bf16*)(lds + O_XT0 + hh * MB + (p * LS + tt) * 2) = (bf16)f2bf(a); *(LAS bf16*)(lds + O_XW0 + hh * MB + (p * LS + tt) * 2) = (bf16)f2bf(a * SM[256 + hh * 64 + tt]); }
                else if (cc < 192) { const int n = cc - 128; *(LAS bf16*)(lds + O_BN + (tt * LS + n) * 2) = (bf16)f2bf(a); *(LAS bf16*)(lds + O_BT + (n * LS + tt) * 2) = (bf16)f2bf(a); }
                else { const int n = cc - 192; *(LAS bf16*)(lds + O_CN + (tt * LS + n) * 2) = (bf16)f2bf(a);
                    *(LAS bf16*)(lds + O_CS0 + (tt * LS + n) * 2) = (bf16)f2bf(a * SM[384 + tt]); *(LAS bf16*)(lds + O_CS0 + MB + (tt * LS + n) * 2) = (bf16)f2bf(a * SM[384 + 64 + tt]); }
            }
#pragma unroll
            for (int j = 0; j < 8; ++j) cur[j] = nxt[j];
          } }
        __syncthreads();
        { f4 acc[2]; acc[0] = (f4){0.f, 0.f, 0.f, 0.f}; acc[1] = (f4){0.f, 0.f, 0.f, 0.f}; mm64(acc, lds, O_CN, O_BN, wave, lane);
#pragma unroll
            for (int hh = 0; hh < 2; ++hh) { f4 sc[2];
#pragma unroll
                for (int cI = 0; cI < 2; ++cI) { const int s = ((wave & 1) * 2 + cI) * 16 + (lane & 15), row = (wave >> 1) * 16 + 4 * (lane >> 4);
                    const float cs = SM[128 + hh * 64 + s], ds = SM[hh * 64 + s];
#pragma unroll
                    for (int e = 0; e < 4; ++e) { const float ct = SM[128 + hh * 64 + row + e]; sc[cI][e] = (s <= row + e) ? acc[cI][e] * __expf(ct - cs) * ds : 0.f; } }
                storeN<0>(lds, O_SC0 + hh * MB, sc, wave, lane); } }
        __syncthreads();
        f4 yacc[2][2];
#pragma unroll
        for (int hh = 0; hh < 2; ++hh) {
            yacc[hh][0] = (f4){0.f, 0.f, 0.f, 0.f}; yacc[hh][1] = (f4){0.f, 0.f, 0.f, 0.f};
            mm64(yacc[hh], lds, O_SC0 + hh * MB, O_XT0 + hh * MB, wave, lane); mm64(yacc[hh], lds, O_CS0 + hh * MB, O_HN0 + hh * MB, wave, lane);
            const float gL = SM[384 + hh * 64 + 63]; hacc[hh][0] = hacc[hh][0] * gL; hacc[hh][1] = hacc[hh][1] * gL;
            mm64(hacc[hh], lds, O_XW0 + hh * MB, O_BT, wave, lane);
        }
        __syncthreads();
#pragma unroll
        for (int hh = 0; hh < 2; ++hh) {
#pragma unroll
            for (int cI = 0; cI < 2; ++cI) { const int colp = ((wave & 1) * 2 + cI) * 16 + (lane & 15), row = (wave >> 1) * 16 + 4 * (lane >> 4);
#pragma unroll
                for (int e = 0; e < 4; ++e) YF[(row + e) * 128 + hh * 64 + colp] = yacc[hh][cI][e]; }
            storeN<0>(lds, O_HN0 + hh * MB, hacc[hh], wave, lane);
        }
        __syncthreads();
#pragma unroll
        for (int q = 0; q < 8; ++q) {
            const int tt = wave * 8 + q; const size_t m = (size_t)b * T + t0 + tt;
            const float x0 = bf2f(*(const LAS bf16*)(lds + O_XT0 + (lane * LS + tt) * 2)), x1 = bf2f(*(const LAS bf16*)(lds + O_XT0 + MB + (lane * LS + tt) * 2));
            const int c0 = gI * 128 + lane, c1 = c0 + 64;
            const float z0 = bf2f(P[m * PP + C_DZ + c0]), z1 = bf2f(P[m * PP + C_DZ + c1]);
            const float y0 = (YF[tt * 128 + lane] + dsk0 * x0) * siluf_(z0), y1 = (YF[tt * 128 + 64 + lane] + dsk1 * x1) * siluf_(z1);
            const float ss = wave_sum(y0 * y0 + y1 * y1); const float rs = rsqrtf(ss * (1.f / 128.f) + 1e-5f);
            OB[m * 1024 + 768 + c0] = (bf16)f2bf(y0 * rs * nw0); OB[m * 1024 + 768 + c1] = (bf16)f2bf(y1 * rs * nw1);
        }
        __syncthreads();
    }
}
}

namespace bsp {
typedef short bf16x8 __attribute__((ext_vector_type(8)));
typedef float f4 __attribute__((ext_vector_type(4)));
constexpr int HS = 129;
constexpr int O_HIST = 0;
constexpr int O_V = 66048;
constexpr int VS = 272;
constexpr int O_KB = O_V + 2 * 32 * VS * 2;
constexpr int KBUF = 20480;
static_assert(O_KB + 2 * KBUF <= LDS_BYTES - 600, "mixer B LDS map");
__device__ __forceinline__ float relu_(float x) { return __int_as_float(max(__float_as_int(x), 0)); }
__device__ __forceinline__ int qkey(float s) { int q = (int)__builtin_fmaf(s, 262144.f, 8388608.f); return q < 1 ? 1 : (q > 16777215 ? 16777215 : q); }
__device__ __forceinline__ unsigned okey(float s) { return (unsigned)qkey(s) << 8; }
__device__ __forceinline__ int f2o(float f) { const int b = __float_as_int(f); return b ^ ((b >> 31) & 0x7fffffff); }
__device__ __forceinline__ float o2f(int o) { return __int_as_float(o ^ ((o >> 31) & 0x7fffffff)); }
__device__ __forceinline__ float fthr(const unsigned Q) {
    const int Qc = (int)(Q < 2u ? 2u : (Q > 16777215u ? 16777215u : Q));
    long long lo = f2o(-64.f), hi = f2o(64.f);
#pragma unroll 1
    for (int i = 0; i < 33; ++i) { const int mid = (int)((lo + hi) >> 1); if (qkey(o2f(mid)) >= Qc) hi = mid; else lo = mid; }
    const float r = o2f((int)hi);
    return Q < 2u ? -INFINITY : (Q > 16777215u ? INFINITY : r);
}
__device__ __forceinline__ void hist_add(const unsigned addr, const unsigned v) { asm volatile("ds_add_u32 %0, %1" :: "v"(addr), "v"(v) : "memory"); }
__device__ __forceinline__ f4 idx_tile(const bf16* Pb, const int kt, const bf16x8 (&qi)[4][2], const float (&wq)[4], const int lane) {
    const bf16* kr = Pb + (size_t)(kt * 16 + (lane & 15)) * PP + C_IK + (lane >> 4) * 8;
    const bf16x8 a0 = *(const bf16x8*)kr, a1 = *(const bf16x8*)(kr + 32);
    f4 s = (f4){0.f, 0.f, 0.f, 0.f};
#pragma unroll
    for (int h = 0; h < 4; ++h) { f4 t = (f4){0.f, 0.f, 0.f, 0.f};
        t = __builtin_amdgcn_mfma_f32_16x16x32_bf16(a0, qi[h][0], t, 0, 0, 0); t = __builtin_amdgcn_mfma_f32_16x16x32_bf16(a1, qi[h][1], t, 0, 0, 0);
#pragma unroll
        for (int e = 0; e < 4; ++e) s[e] += wq[h] * relu_(t[e]); }
    return s;
}

__device__ __forceinline__ void item(LAS unsigned char* lds0, const int bb, const int qb, const bf16* P, bf16* OB, const int tid0, const int pm) {
    unsigned lb_ = 0u; int tid_l = tid0; asm volatile("" : "+v"(lb_), "+v"(tid_l));
    LAS unsigned char* lds = lds0 + lb_; const int tid = tid_l, lane = tid & 63, wave = __builtin_amdgcn_readfirstlane(tid >> 6);
    const bf16* Pb = P + (size_t)bb * T * PP;
    const int ql = wave * 16 + (lane & 15), tq = qb * 128 + ql, g = lane >> 4;
    const bf16* prow = Pb + (size_t)tq * PP;
    bf16x8 qi[4][2]; float wq[4];
#pragma unroll
    for (int h = 0; h < 4; ++h) { qi[h][0] = *(const bf16x8*)(prow + C_IQ + h * 64 + g * 8); qi[h][1] = *(const bf16x8*)(prow + C_IQ + h * 64 + 32 + g * 8); wq[h] = bf2f(prow[C_IW + h]) * 0.0625f; }
    LAS unsigned* hist = (LAS unsigned*)(lds + O_HIST) + ql * HS;
    const unsigned histb = (unsigned)(size_t)hist;
    const int nkt = (qb + 1) * 8;
    unsigned prefix = 0u; int needk = 256;
#pragma unroll 1
    for (int rr = 0; rr < (pm == 102 ? 2 : 1); ++rr) { prefix = 0u; needk = 256;
#pragma unroll 1
    for (int pass = 0; pass < 3; ++pass) {
        for (int i = lane; i < 16 * HS; i += 64) ((LAS unsigned*)(lds + O_HIST) + wave * 16 * HS)[i] = 0u;
        asm volatile("s_waitcnt lgkmcnt(0)" ::: "memory");
        const int shp = 32 - 8 * pass, shb = 24 - 8 * pass;
        float flo = 0.f, fhi = 0.f;
        if (pass > 0) { const float stepw = (pass == 1) ? 65536.f : 256.f; flo = ((float)prefix * stepw - 2.f) * (1.f / 262144.f) - 32.f; fhi = (((float)prefix + 1.f) * stepw + 2.f) * (1.f / 262144.f) - 32.f; }
        if (prefix == 0u) flo = -INFINITY; if (pass == 2 && prefix == 0xffffu) fhi = INFINITY;
        const int nsteps = pm >= 300 ? 0 : nkt >> 2;
#define RDX_DMA(stepi, bufi) do { const int st_ = (stepi) < nsteps ? (stepi) : (nsteps - 1); const int S_ = wave * 64 + lane, r_ = S_ >> 3, p_ = S_ & 7; \
            __builtin_amdgcn_global_load_lds((const unsigned*)(Pb + (size_t)(st_ * 64 + r_) * PP + C_IK + ((p_ ^ (r_ & 7)) << 3)), (LAS unsigned*)(lds + O_V + (bufi) * 8192 + wave * 1024), 16, 0, 0); } while (0)
        asm volatile("s_waitcnt vmcnt(0) lgkmcnt(0)" ::: "memory"); __builtin_amdgcn_s_barrier();
        RDX_DMA(0, 0); RDX_DMA(1, 1); RDX_DMA(2, 2);
        typedef float f2 __attribute__((ext_vector_type(2)));
        auto steps = [&](auto PVc) { constexpr int PV = decltype(PVc)::value;
            f2 w2[4];
#pragma unroll
            for (int h = 0; h < 4; ++h) w2[h] = (f2){wq[h], wq[h]};
            const int tqmin_ = qb * 128 + wave * 16;
#pragma unroll 1
            for (int stp = 0; stp < nsteps; ++stp) {
                asm volatile("s_waitcnt vmcnt(2)" ::: "memory");
                __builtin_amdgcn_s_barrier();
                RDX_DMA(stp + 3, (stp + 3) & 3);
                const unsigned kbr = (unsigned)(O_V + (stp & 3) * 8192);
                const bool edge = stp >= nsteps - 2;
#pragma unroll
                for (int u = 0; u < 4; ++u) {
                    const int k0 = (stp * 4 + u) * 16;
                    if (edge && k0 > tqmin_ + 15) continue;
                    const bf16x8 ka0 = *(const LAS bf16x8*)(lds + kbr + (u * 16 + (lane & 15)) * 128 + (((0 + g) ^ (lane & 7)) << 4));
                    const bf16x8 ka1 = *(const LAS bf16x8*)(lds + kbr + (u * 16 + (lane & 15)) * 128 + (((4 + g) ^ (lane & 7)) << 4));
                    f2 s01 = (f2){0.f, 0.f}, s23 = (f2){0.f, 0.f};
#pragma unroll
                    for (int h = 0; h < 4; ++h) { f4 t = (f4){0.f, 0.f, 0.f, 0.f};
                        t = __builtin_amdgcn_mfma_f32_16x16x32_bf16(ka0, qi[h][0], t, 0, 0, 0); t = __builtin_amdgcn_mfma_f32_16x16x32_bf16(ka1, qi[h][1], t, 0, 0, 0);
                        s01 += w2[h] * (f2){relu_(t[0]), relu_(t[1])}; s23 += w2[h] * (f2){relu_(t[2]), relu_(t[3])}; }
                    const float sv[4] = {s01.x, s01.y, s23.x, s23.y};
                    if constexpr (PV == 0) {
#pragma unroll
                        for (int e = 0; e < 4; ++e) { const unsigned q = (unsigned)qkey(sv[e]); unsigned val = (q & 0x10000u) ? 0x10000u : 1u;
                            if (edge) val = (k0 + 4 * g + e <= tq) ? val : 0u;
                            hist_add(histb + ((q >> 17) << 2), val); }
                    } else if constexpr (PV == 1) {
#pragma unroll
                        for (int e = 0; e < 4; ++e) { const unsigned q = (unsigned)qkey(sv[e]); bool mt = (q >> 16) == prefix; if (edge) mt = mt & (k0 + 4 * g + e <= tq);
                            const unsigned val = mt ? ((q & 0x100u) ? 0x10000u : 1u) : 0u;
                            hist_add(histb + (((q >> 9) & 127u) << 2), val); }
                    } else {
                        bool in[4]; bool anyl = false;
#pragma unroll
                        for (int e = 0; e < 4; ++e) { in[e] = (sv[e] >= flo) & (sv[e] <= fhi); anyl = anyl | in[e]; }
                        if (__any(anyl)) {
#pragma unroll
                            for (int e = 0; e < 4; ++e) { const unsigned q = (unsigned)qkey(sv[e]); bool mt = in[e] & ((q >> 8) == prefix); if (edge) mt = mt & (k0 + 4 * g + e <= tq);
                                const unsigned val = mt ? ((q & 1u) ? 0x10000u : 1u) : 0u;
                                hist_add(histb + (((q >> 1) & 127u) << 2), val); }
                        }
                    }
                }
            }
        };
        if (pass == 0) steps(std::integral_constant<int, 0>{}); else if (pass == 1) steps(std::integral_constant<int, 1>{}); else steps(std::integral_constant<int, 2>{});
        asm volatile("s_waitcnt vmcnt(0)" ::: "memory");
#undef RDX_DMA
        asm volatile("s_waitcnt lgkmcnt(0)" ::: "memory");
        int cum = 0; unsigned bsel = 0u; int above = 0;
        for (int wd = 127; wd >= 0; --wd) { const unsigned v = hist[wd]; const int hi = (int)(v >> 16), lo = (int)(v & 0xffffu);
            if (cum + hi >= needk) { bsel = (unsigned)(2 * wd + 1); above = cum; break; } cum += hi;
            if (cum + lo >= needk) { bsel = (unsigned)(2 * wd); above = cum; break; } cum += lo; }
        prefix = (prefix << 8) | bsel; needk -= above;
        asm volatile("s_waitcnt lgkmcnt(0)" ::: "memory");
    }
    }
    if (pm >= 200 && pm < 300) { __syncthreads(); return; }
    unsigned thr = prefix; int need = needk;
    bool tie = false;
    if (tq < 256) { thr = 0u; need = 1 << 20; }
    else { const unsigned v = hist[(prefix & 255u) >> 1]; const int ceq = (prefix & 1u) ? (int)(v >> 16) : (int)(v & 0xffffu); tie = needk < ceq; }
    __syncthreads();
    const bool anytie = __any(tie);
    const float sB = fthr(thr);
    unsigned cn = (unsigned)(need > 0xffff ? 0xffff : need) << 16;
    constexpr int O_TC = O_KB + 2 * KBUF + 2048;
    if (g == 0) { *(LAS unsigned*)(lds + O_TC + ql * 8) = thr; *(LAS unsigned*)(lds + O_TC + ql * 8 + 4) = cn; }
    const int tqmin = qb * 128 + wave * 16;
#pragma unroll
    for (int h = 0; h < 4; ++h) { *(LAS bf16x8*)(lds + O_HIST + wave * 8192 + ((h * 2 + 0) * 64 + lane) * 16) = qi[h][0]; *(LAS bf16x8*)(lds + O_HIST + wave * 8192 + ((h * 2 + 1) * 64 + lane) * 16) = qi[h][1]; }
    constexpr int O_WQ = O_KB + 2 * KBUF;
    if (g == 0) {
#pragma unroll
        for (int h = 0; h < 4; ++h) *(LAS float*)(lds + O_WQ + ((wave * 4 + h) * 16 + (lane & 15)) * 4) = wq[h]; }
    bf16x8 qa[4][2];
#pragma unroll
    for (int h = 0; h < 4; ++h) { qa[h][0] = *(const bf16x8*)(prow + C_BQ + h * 64 + g * 8); qa[h][1] = *(const bf16x8*)(prow + C_BQ + h * 64 + 32 + g * 8); }
    f4 oacc[4][4]; float mrun[4], lrun[4];
#pragma unroll
    for (int h = 0; h < 4; ++h) { mrun[h] = -INFINITY; lrun[h] = 0.f;
#pragma unroll
        for (int dt = 0; dt < 4; ++dt) oacc[h][dt] = (f4){0.f, 0.f, 0.f, 0.f}; }
#pragma unroll 1
    for (int rr = 0; rr < (pm == 103 ? 2 : 1); ++rr) {
#pragma unroll
    for (int h = 0; h < 4; ++h) { mrun[h] = -INFINITY; lrun[h] = 0.f;
#pragma unroll
        for (int dt = 0; dt < 4; ++dt) oacc[h][dt] = (f4){0.f, 0.f, 0.f, 0.f}; }
    const int nst = (qb + 1) * 4;
    const int vkey = tid >> 4, vch = tid & 15;
    u32x4 vpre0 = *(const u32x4*)(Pb + (size_t)vkey * PP + C_BV + vch * 8), vpre1 = *(const u32x4*)(Pb + (size_t)vkey * PP + C_BV + 128 + vch * 8);
    const unsigned vrd = (unsigned)(unsigned long)lds + (unsigned)(O_V + (4 * g + ((lane >> 2) & 3)) * (VS * 2) + (lane & 3) * 8);
    __syncthreads();
    const int kr_ = 2 * wave + (lane >> 5), kir_ = wave * 8 + (lane >> 3);
    const bf16* kbase = Pb + (size_t)kr_ * PP + C_BK + (((lane & 31) ^ (kr_ & 15)) << 3);
    const bf16* kibase = Pb + (size_t)kir_ * PP + C_IK + (((lane & 7) ^ (kir_ & 7)) << 3);
#define K_DMA(key_first, kbo) do { const bf16* s0_ = kbase + (size_t)(key_first) * PP; \
        __builtin_amdgcn_global_load_lds((const unsigned*)s0_, (LAS unsigned*)(lds + (kbo) + wave * 1024), 16, 0, 0); \
        __builtin_amdgcn_global_load_lds((const unsigned*)(s0_ + (size_t)16 * PP), (LAS unsigned*)(lds + (kbo) + (wave + 8) * 1024), 16, 0, 0); \
        if (wave < 4) __builtin_amdgcn_global_load_lds((const unsigned*)(kibase + (size_t)(key_first) * PP), (LAS unsigned*)(lds + (kbo) + 16384 + wave * 1024), 16, 0, 0); } while (0)
    K_DMA(0, (unsigned)O_KB);
#pragma unroll 1
    for (int st = 0; st < nst; ++st) {
        const int key0 = st * 32; const unsigned vbuf = (unsigned)(st & 1) * (32 * VS * 2);
        unsigned qio = (unsigned)(O_HIST + wave * 8192 + lane * 16); asm volatile("" : "+v"(qio));
        unsigned wqo = (unsigned)(O_WQ + wave * 256 + (lane & 15) * 4); asm volatile("" : "+v"(wqo));
        unsigned tco = (unsigned)(O_TC + (wave * 16 + (lane & 15)) * 8); asm volatile("" : "+v"(tco));
        { LAS bf16* VL = (LAS bf16*)(lds + O_V + vbuf); *(LAS u32x4*)(VL + vkey * VS + vch * 8) = vpre0; *(LAS u32x4*)(VL + vkey * VS + 128 + vch * 8) = vpre1; }
        asm volatile("s_waitcnt vmcnt(0)" ::: "memory");
        __syncthreads();
        if (st + 1 < nst) K_DMA(key0 + 32, (unsigned)(O_KB + ((st + 1) & 1) * KBUF));
        const unsigned kbc = (unsigned)(O_KB + (st & 1) * KBUF);
#define KQ_(h, k2, ks) (*(const LAS bf16x8*)(lds + kbc + (k2 * 16 + (lane & 15)) * 512 + ((((h) * 8 + (ks) * 4 + g) ^ (lane & 15)) << 4)))
#define KI_(k2, ks) (*(const LAS bf16x8*)(lds + kbc + 16384 + (k2 * 16 + (lane & 15)) * 128 + ((((ks) * 4 + g) ^ (lane & 7)) << 4)))
        const bool active = key0 <= tqmin + 15;
        bool sel[2][4] = {{false, false, false, false}, {false, false, false, false}};
        if (active && pm == 305) {
#pragma unroll
            for (int k2 = 0; k2 < 2; ++k2)
#pragma unroll
                for (int e = 0; e < 4; ++e) sel[k2][e] = (key0 + k2 * 16 + 4 * g + e) <= tq;
        } else if (active) {
            unsigned eqm = 0u;
            const bool plain = !anytie && key0 + 31 <= tqmin;
#pragma unroll
            for (int k2 = 0; k2 < 2; ++k2) { f4 s = (f4){0.f, 0.f, 0.f, 0.f};
#pragma unroll
                for (int h = 0; h < 4; ++h) { f4 t = (f4){0.f, 0.f, 0.f, 0.f};
                    const bf16x8 qh0 = *(const LAS bf16x8*)(lds + qio + ((h * 2 + 0) * 64) * 16), qh1 = *(const LAS bf16x8*)(lds + qio + ((h * 2 + 1) * 64) * 16);
                    t = __builtin_amdgcn_mfma_f32_16x16x32_bf16(KI_(k2, 0), qh0, t, 0, 0, 0); t = __builtin_amdgcn_mfma_f32_16x16x32_bf16(KI_(k2, 1), qh1, t, 0, 0, 0);
                    const float wqh = *(const LAS float*)(lds + wqo + h * 64);
#pragma unroll
                    for (int e = 0; e < 4; ++e) s[e] += wqh * relu_(t[e]); }
                if (plain) {
#pragma unroll
                    for (int e = 0; e < 4; ++e) sel[k2][e] = s[e] >= sB;
                } else {
                    const unsigned thr_ = *(const LAS unsigned*)(lds + tco);
#pragma unroll
                    for (int e = 0; e < 4; ++e) { const int key = key0 + k2 * 16 + 4 * g + e, tq_ = tqmin + (lane & 15); const unsigned k24 = (unsigned)qkey(s[e]);
                        sel[k2][e] = (key <= tq_) & (k24 > thr_); if ((key <= tq_) & (k24 == thr_)) eqm |= 1u << (k2 * 4 + e); }
                } }
            if (!plain) {
                if (anytie && __any(eqm != 0u)) {
                    const unsigned pk = (unsigned)__popc(eqm & 15u) | ((unsigned)__popc(eqm >> 4) << 8);
                    const unsigned p0 = (unsigned)__shfl((int)pk, lane & 15), p1 = (unsigned)__shfl((int)pk, (lane & 15) + 16), p2 = (unsigned)__shfl((int)pk, (lane & 15) + 32), p3 = (unsigned)__shfl((int)pk, (lane & 15) + 48);
                    const unsigned tot = p0 + p1 + p2 + p3, below = (g > 0 ? p0 : 0u) + (g > 1 ? p1 : 0u) + (g > 2 ? p2 : 0u);
                    const unsigned cn_ = *(const LAS unsigned*)(lds + tco + 4); const int cnt = (int)(cn_ & 0xffffu), need_ = (int)(cn_ >> 16); const int base0 = cnt + (int)(below & 255u), base1 = cnt + (int)(tot & 255u) + (int)(below >> 8);
#pragma unroll
                    for (int k2 = 0; k2 < 2; ++k2)
#pragma unroll
                        for (int e = 0; e < 4; ++e) { const unsigned bit = 1u << (k2 * 4 + e);
                            const int rank = (k2 ? base1 : base0) + __popc(eqm & (bit - 1u) & (k2 ? 0xf0u : 0x0fu));
                            sel[k2][e] = sel[k2][e] | (((eqm & bit) != 0u) & (rank < need_)); }
                    *(LAS unsigned*)(lds + tco + 4) = cn_ + (tot & 255u) + (tot >> 8);
                } else {
#pragma unroll
                    for (int k2 = 0; k2 < 2; ++k2)
#pragma unroll
                        for (int e = 0; e < 4; ++e) sel[k2][e] = sel[k2][e] | ((eqm & (1u << (k2 * 4 + e))) != 0u);
                }
            }
        }
#pragma unroll
        for (int h = 0; h < 4; ++h) {
            if (h == 2 && st + 1 < nst) { vpre0 = *(const u32x4*)(Pb + (size_t)(key0 + 32 + vkey) * PP + C_BV + vch * 8); vpre1 = *(const u32x4*)(Pb + (size_t)(key0 + 32 + vkey) * PP + C_BV + 128 + vch * 8); }
            if (active) {
            f4 sc[2];
#pragma unroll
            for (int k2 = 0; k2 < 2; ++k2) { f4 t = (f4){0.f, 0.f, 0.f, 0.f};
                t = __builtin_amdgcn_mfma_f32_16x16x32_bf16(KQ_(h, k2, 0), qa[h][0], t, 0, 0, 0); t = __builtin_amdgcn_mfma_f32_16x16x32_bf16(KQ_(h, k2, 1), qa[h][1], t, 0, 0, 0);
#pragma unroll
                for (int e = 0; e < 4; ++e) sc[k2][e] = sel[k2][e] ? t[e] * (0.125f * 1.4426950408889634f) : -INFINITY; }
            float mx = fmaxf(fmaxf(fmaxf(sc[0][0], sc[0][1]), fmaxf(sc[0][2], sc[0][3])), fmaxf(fmaxf(sc[1][0], sc[1][1]), fmaxf(sc[1][2], sc[1][3])));
            mx = fmaxf(mx, __shfl_xor(mx, 16)); mx = fmaxf(mx, __shfl_xor(mx, 32));
            const float mnew = fmaxf(mrun[h], mx), msafe = (mnew == -INFINITY) ? 0.f : mnew;
            const bool resc = __any(mnew != mrun[h]);
            const float corr = __builtin_amdgcn_exp2f(mrun[h] - msafe); mrun[h] = mnew;
            float p[8]; float ps = 0.f;
#pragma unroll
            for (int e = 0; e < 4; ++e) { p[e] = __builtin_amdgcn_exp2f(sc[0][e] - msafe); p[4 + e] = __builtin_amdgcn_exp2f(sc[1][e] - msafe); ps += p[e] + p[4 + e]; }
            lrun[h] = lrun[h] * corr + ps;
            union { bf16x8 v; unsigned u[4]; } pb;
            pb.u[0] = pg8::cvt_pk_bf16(p[0], p[1]); pb.u[1] = pg8::cvt_pk_bf16(p[2], p[3]); pb.u[2] = pg8::cvt_pk_bf16(p[4], p[5]); pb.u[3] = pg8::cvt_pk_bf16(p[6], p[7]);
            union { bf16x8 v; u32x2 h2[2]; } vf[4];
            const unsigned va = vrd + vbuf + (unsigned)(h * 128);
            asm volatile("ds_read_b64_tr_b16 %0, %8\n\tds_read_b64_tr_b16 %1, %8 offset:%9\n\tds_read_b64_tr_b16 %2, %8 offset:32\n\tds_read_b64_tr_b16 %3, %8 offset:%10\n\t"
                         "ds_read_b64_tr_b16 %4, %8 offset:64\n\tds_read_b64_tr_b16 %5, %8 offset:%11\n\tds_read_b64_tr_b16 %6, %8 offset:96\n\tds_read_b64_tr_b16 %7, %8 offset:%12\n\ts_waitcnt lgkmcnt(0)"
                         : "=&v"(vf[0].h2[0]), "=&v"(vf[0].h2[1]), "=&v"(vf[1].h2[0]), "=&v"(vf[1].h2[1]), "=&v"(vf[2].h2[0]), "=&v"(vf[2].h2[1]), "=&v"(vf[3].h2[0]), "=&v"(vf[3].h2[1])
                         : "v"(va), "i"(16 * VS * 2), "i"(16 * VS * 2 + 32), "i"(16 * VS * 2 + 64), "i"(16 * VS * 2 + 96) : "memory");
            __builtin_amdgcn_sched_barrier(0);
            if (resc) {
#pragma unroll
                for (int dt = 0; dt < 4; ++dt) oacc[h][dt] = oacc[h][dt] * corr; }
#pragma unroll
            for (int dt = 0; dt < 4; ++dt) oacc[h][dt] = __builtin_amdgcn_mfma_f32_16x16x32_bf16(vf[dt].v, pb.v, oacc[h][dt], 0, 0, 0);
            }
        }
    }
    __syncthreads();
    }
#undef KQ_
#undef KI_
#undef K_DMA
    const size_t m = (size_t)bb * T + tqmin + (lane & 15);
    if (pm < 300)
#pragma unroll
    for (int h = 0; h < 4; ++h) { float l = lrun[h]; l += __shfl_xor(l, 16); l += __shfl_xor(l, 32); const float inv = 1.f / l;
#pragma unroll
        for (int dt = 0; dt < 4; ++dt) { u32x2 w; w.x = pk2(oacc[h][dt][0] * inv, oacc[h][dt][1] * inv); w.y = pk2(oacc[h][dt][2] * inv, oacc[h][dt][3] * inv);
            *(u32x2*)(OB + m * 1024 + 256 + h * 64 + dt * 16 + 4 * g) = w; } }
    __syncthreads();
}
}

namespace awin {
typedef short bf16x8 __attribute__((ext_vector_type(8)));
typedef float f4 __attribute__((ext_vector_type(4)));
constexpr int EXS = 66;
constexpr int O_EX = 0;
constexpr int VSW = 72;
constexpr int O_VW = 101376;
__device__ __forceinline__ void item(LAS unsigned char* lds0, const int bb, const int blk, const int h, const bf16* P, bf16* OB, const int tid0) {
    unsigned lb_ = 0u; int tid_l = tid0; asm volatile("" : "+v"(lb_), "+v"(tid_l));
    LAS unsigned char* lds = lds0 + lb_; const int tid = tid_l, lane = tid & 63, wave = __builtin_amdgcn_readfirstlane(tid >> 6);
    const bf16* Pb = P + (size_t)bb * T * PP; const int start = blk * 128, g = lane >> 4, ln = lane & 15;
    LAS float* EX = (LAS float*)(lds + O_EX);
    LAS bf16* VW = (LAS bf16*)(lds + O_VW + wave * 4608);
#pragma unroll 1
    for (int s4 = 0; s4 < 4; ++s4) {
        const int st = wave * 4 + s4;
        const int grp = st < 8 ? 0 : (st < 16 ? 1 : 2);
        const int dil = grp == 0 ? 1 : (grp == 1 ? 4 : 16), win = grp == 0 ? 128 : (grp == 1 ? 512 : 2048);
        const int r = grp == 0 ? 0 : (grp == 1 ? ((st - 8) >> 1) : (st - 16)), a0 = grp == 0 ? 16 * st : (grp == 1 ? ((st - 8) & 1) * 16 : 0), nqc = grp == 0 ? 128 : (grp == 1 ? 32 : 8);
        const int a = a0 + ln; const bool qok = a < nqc; const int ql = (qok ? a : (nqc - 1)) * dil + r, tq = start + ql;
        const bf16* qp = Pb + (size_t)tq * PP + C_AQ + grp * 256 + h * 64 + g * 8;
        const bf16x8 q0 = *(const bf16x8*)qp, q1 = *(const bf16x8*)(qp + 32);
        bf16x8 kf[10][2];
#pragma unroll
        for (int kt = 0; kt < 10; ++kt) { int pos = start - win + (a0 + 16 * kt + ln) * dil + r; pos = pos < 0 ? 0 : (pos > T - 1 ? T - 1 : pos);
            const bf16* kp = Pb + (size_t)pos * PP + C_AK + grp * 256 + h * 64 + g * 8; kf[kt][0] = *(const bf16x8*)kp; kf[kt][1] = *(const bf16x8*)(kp + 32); }
        f4 sc[10]; float mx = -INFINITY;
#pragma unroll
        for (int kt = 0; kt < 10; ++kt) { f4 t = (f4){0.f, 0.f, 0.f, 0.f};
            t = __builtin_amdgcn_mfma_f32_16x16x32_bf16(kf[kt][0], q0, t, 0, 0, 0); t = __builtin_amdgcn_mfma_f32_16x16x32_bf16(kf[kt][1], q1, t, 0, 0, 0);
#pragma unroll
            for (int e = 0; e < 4; ++e) { const int c = a0 + 16 * kt + 4 * g + e; const int pos = start - win + c * dil + r;
                const bool ok = qok && c >= a && c <= a + 128 && pos >= 0;
                sc[kt][e] = ok ? t[e] * 0.125f : -INFINITY; mx = fmaxf(mx, sc[kt][e]); } }
        mx = fmaxf(mx, __shfl_xor(mx, 16)); mx = fmaxf(mx, __shfl_xor(mx, 32));
        const float msafe = (mx == -INFINITY) ? 0.f : mx; float lsum = 0.f;
#pragma unroll
        for (int kt = 0; kt < 10; ++kt)
#pragma unroll
            for (int e = 0; e < 4; ++e) { sc[kt][e] = __expf(sc[kt][e] - msafe); lsum += sc[kt][e]; }
        lsum += __shfl_xor(lsum, 16); lsum += __shfl_xor(lsum, 32);
        f4 oacc[4];
#pragma unroll
        for (int dt = 0; dt < 4; ++dt) oacc[dt] = (f4){0.f, 0.f, 0.f, 0.f};
#pragma unroll
        for (int s5 = 0; s5 < 5; ++s5) {
            int pos = start - win + (a0 + 32 * s5 + (lane >> 1)) * dil + r; pos = pos < 0 ? 0 : (pos > T - 1 ? T - 1 : pos);
            const u32x4* vp = (const u32x4*)(Pb + (size_t)pos * PP + C_AV + grp * 256 + h * 64 + (lane & 1) * 32);
            const u32x4 v0 = vp[0], v1 = vp[1], v2 = vp[2], v3 = vp[3];
            LAS u32x4* vd = (LAS u32x4*)(VW + (lane >> 1) * VSW + (lane & 1) * 32);
            asm volatile("s_waitcnt lgkmcnt(0)" ::: "memory");
            vd[0] = v0; vd[1] = v1; vd[2] = v2; vd[3] = v3;
            asm volatile("s_waitcnt lgkmcnt(0)" ::: "memory");
            bf16x8 pb;
#pragma unroll
            for (int e = 0; e < 4; ++e) { pb[e] = (short)f2bf(sc[2 * s5][e]); pb[4 + e] = (short)f2bf(sc[2 * s5 + 1][e]); }
#pragma unroll
            for (int dt = 0; dt < 4; ++dt) { bf16x8 vf; const LAS bf16* vb = VW + (4 * g) * VSW + dt * 16 + ln;
#pragma unroll
                for (int e = 0; e < 4; ++e) { vf[e] = (short)vb[e * VSW]; vf[4 + e] = (short)vb[(16 + e) * VSW]; }
                oacc[dt] = __builtin_amdgcn_mfma_f32_16x16x32_bf16(vf, pb, oacc[dt], 0, 0, 0); }
        }
        if (qok) { LAS float* ex = EX + (grp * 128 + ql) * EXS;
#pragma unroll
            for (int dt = 0; dt < 4; ++dt) { ex[dt * 16 + 4 * g + 0] = oacc[dt][0]; ex[dt * 16 + 4 * g + 1] = oacc[dt][1]; ex[dt * 16 + 4 * g + 2] = oacc[dt][2]; ex[dt * 16 + 4 * g + 3] = oacc[dt][3]; }
            if (g == 0) { ex[64] = mx; ex[65] = lsum; } }
    }
    __syncthreads();
    { const int ql = tid >> 2, d0 = (tid & 3) * 16;
      const LAS float* e0 = EX + (0 * 128 + ql) * EXS; const LAS float* e1 = EX + (1 * 128 + ql) * EXS; const LAS float* e2 = EX + (2 * 128 + ql) * EXS;
      const float m0 = e0[64], m1 = e1[64], m2 = e2[64], M = fmaxf(m0, fmaxf(m1, m2));
      const float w0 = __expf(m0 - M), w1 = __expf(m1 - M), w2 = __expf(m2 - M); const float inv = 1.f / (w0 * e0[65] + w1 * e1[65] + w2 * e2[65]);
      unsigned pk[8];
#pragma unroll
      for (int j = 0; j < 8; ++j) { const float x0 = (w0 * e0[d0 + 2 * j] + w1 * e1[d0 + 2 * j] + w2 * e2[d0 + 2 * j]) * inv, x1 = (w0 * e0[d0 + 2 * j + 1] + w1 * e1[d0 + 2 * j + 1] + w2 * e2[d0 + 2 * j + 1]) * inv; pk[j] = pk2(x0, x1); }
      u32x4* op = (u32x4*)(OB + ((size_t)bb * T + start + ql) * 1024 + h * 64 + d0);
      op[0] = (u32x4){pk[0], pk[1], pk[2], pk[3]}; op[1] = (u32x4){pk[4], pk[5], pk[6], pk[7]}; }
    __syncthreads();
}
}

template <int SP>
__device__ __forceinline__ void phase_body(const int l_in, LAS unsigned char* lds) {
    int tid_ = threadIdx.x, bid_ = blockIdx.x, l_ = l_in, G_ = gridDim.x; asm volatile("" : "+v"(tid_), "+s"(bid_), "+s"(l_), "+s"(G_));
    const int tid = tid_, lane = tid & 63, wave = __builtin_amdgcn_readfirstlane(tid >> 6), l = l_;
    const int G = G_, bid = bid_;
    const int gw = bid * NWAVES + wave, NGW = G * NWAVES;
    unsigned char* ws = (unsigned char*)gptr(ldptr(lds, 36));
    int* ctl = (int*)(ws + WS_CTL);
    bf16* XB = (bf16*)(ws + WS_XB); bf16* OB = (bf16*)(ws + WS_O); bf16* VF = (bf16*)(ws + WS_VF); bf16* P = (bf16*)(ws + WS_P);
    bf16* GS = (bf16*)(ws + WS_GS); bf16* MG = (bf16*)(ws + WS_MERGED); bf16* XS = (bf16*)(ws + WS_XS); bf16* HB = (bf16*)(ws + WS_H);
    bf16* WGU = (bf16*)(ws + WS_WGU); bf16* WD = (bf16*)(ws + WS_WD);
    float* X = (float*)gptr(ldptr(lds, 35));
    int* tok_e = (int*)(ws + WS_ROUTE); float* tok_g = (float*)(ws + WS_ROUTE + 256 * 1024); int* tok_rank = (int*)(ws + WS_ROUTE + 512 * 1024); int* tok_slot = (int*)(ws + WS_ROUTE + 768 * 1024);
    (void)ctl; (void)XB; (void)OB; (void)VF; (void)P; (void)GS; (void)MG; (void)XS; (void)HB; (void)WGU; (void)WD; (void)X; (void)tok_e; (void)tok_g; (void)tok_rank; (void)tok_slot; (void)gw; (void)NGW; (void)lane;
    {
        bf16* WinT = (bf16*)(ws + WS_WINT) + (size_t)l * 5120 * 1024; bf16* WgT = (bf16*)(ws + WS_WGT) + (size_t)l * 4096 * 1024;
        bf16* WbrT = (bf16*)(ws + WS_WBRT) + (size_t)l * 1024 * 1024; bf16* WoutT = (bf16*)(ws + WS_WOUTT) + (size_t)l * 1024 * 1024;
        float* WrT = (float*)(ws + WS_WRT) + (size_t)l * 36 * 1024;
        int* cnt = ctl + CW_CNT + l * 64;

        if constexpr (SP == -1) {
            LAS float* scr = (LAS float*)(lds + wave * 16384);
#pragma unroll 1
            for (int job = 0; job < NL * 11; ++job) {
                const int ll = job / 11, jk = job % 11;
                if (jk < 5) {
                    const float* W = INP(I_WIN) + (size_t)ll * 1024 * INW;
                    const int sc0 = jk == 0 ? 0 : (jk == 1 ? 3396 : (jk == 2 ? 3392 : (jk == 3 ? 5060 : 5064)));
                    const int snc = jk == 0 ? 3392 : (jk == 1 ? 1664 : (jk == 4 ? 4096 : 4));
                    const int sr0 = jk == 0 ? 0 : (jk == 1 ? 3392 : (jk == 2 ? 5056 : (jk == 3 ? 5060 : 0)));
                    bf16* dst = jk == 4 ? (bf16*)(ws + WS_WGT) + (size_t)ll * 4096 * 1024 : (bf16*)(ws + WS_WINT) + (size_t)ll * 5120 * 1024;
                    const int nbn = (snc + 31) / 32, nit = 16 * nbn;
#pragma unroll 1
                    for (int it = gw; it < nit; it += NGW) transpose_item(W, INW, sc0, snc, dst, 1024, sr0, 0, it / nbn, it % nbn, scr, lane);
                } else if (jk < 9) {
                    const int n = jk - 5; const float* Wb = INP(I_WBR) + ((size_t)ll * 4 + n) * 256 * 1024;
#pragma unroll 1
                    for (int it = gw; it < 4 * 32; it += NGW) transpose_item(Wb, 1024, 0, 1024, (bf16*)(ws + WS_WBRT) + (size_t)ll * 1024 * 1024, 1024, 0, n * 256, it / 32, it % 32, scr, lane);
                } else if (jk == 9) {
                    const float* Wo = INP(I_WOUT) + (size_t)ll * 1024 * 1024;
#pragma unroll 1
                    for (int it = gw; it < 16 * 32; it += NGW) transpose_item(Wo, 1024, 0, 1024, (bf16*)(ws + WS_WOUTT) + (size_t)ll * 1024 * 1024, 1024, 0, 0, it / 32, it % 32, scr, lane);
                } else {
                    bf16* wi = (bf16*)(ws + WS_WINT) + (size_t)ll * 5120 * 1024;
#pragma unroll 1
                    for (int i = gw * 64 + lane; i < 56 * 1024 / 8; i += NGW * 64) ((u32x4*)(wi + (size_t)5064 * 1024))[i] = (u32x4){0u, 0u, 0u, 0u};
                    float* wr = (float*)(ws + WS_WRT) + (size_t)ll * 36 * 1024; const float* rg = INP(I_RG) + (size_t)ll * 1024 * 4; const float* re = INP(I_RE) + (size_t)ll * 1024 * 32;
#pragma unroll 1
                    for (int i = gw * 64 + lane; i < 36 * 1024; i += NGW * 64) { const int o = i / 1024, k = i % 1024; wr[i] = o < 4 ? rg[k * 4 + o] : re[k * 32 + (o - 4)]; }
                }
            }
            for (int m = gw; m < M; m += NGW) {
                const f32x4* xr = (const f32x4*)(INP(I_X) + (size_t)m * D) + lane;
#pragma unroll
                for (int j = 0; j < 4; ++j) { const f32x4 v = xr[64 * j]; ((f32x4*)(X + (size_t)m * D))[lane + 64 * j] = v;
                    u32x2 w; w.x = pk2(v[0], v[1]); w.y = pk2(v[2], v[3]); ((u32x2*)(XB + (size_t)m * D))[lane + 64 * j] = w; }
            }
        }
        else if constexpr (SP == 0) {
            pg8::Gemm g{XB, WinT, 1024, 1024, 1024}; pg8::StaticOrder S; S.init(M, PP, G, bid, 1024, 1024);
            EpiStoreBf16 E{P, PP, 0, PP};
            pg8::gemm_phase<EpiStoreBf16, pg8::StaticOrder>(lds, g, S, E);
        }
        else if constexpr (SP == 12) {
            if (bid < 32) rw::carry(lds, ws + WS_RW + (size_t)bid * 64 * 16384, tid);
        }
        else if constexpr (SP == 13) {
            unsigned char* GZ = ws + WS_RW;
            const int h = bid & 3, k = bid >> 2;
            rw::build_ct(lds, l, h, lane, wave); __syncthreads();
#pragma unroll 1
            for (int idx = k; idx < 512; idx += (G >> 2)) { const int b = idx >> 6, cI = idx & 63; const size_t ci_ = (size_t)((b * 4 + h) * 64 + cI);
                rw::chunk_out(lds, b, h, cI * 64, GZ + ci_ * 16384, ws + WS_RW2 + ci_ * 24576, (const float*)(ws + WS_BONG) + ci_ * 64, VF, OB, tid); }
        }
        else if constexpr (SP == 15 || SP == 19) {
            unsigned char* GZ = ws + WS_RW;
            int* qctr = ctl + CW_Q + l * 64 + (SP == 19 ? 16 : 0);
            int cur_h = -1;
#pragma unroll 1
            for (;;) {
                unsigned so = (unsigned)(LDS_BYTES - 584); asm volatile("" : "+v"(so));
                volatile LAS int* slot = (volatile LAS int*)(lds + so);
                int tid = threadIdx.x; asm volatile("" : "+v"(tid));
                const int lane = tid & 63, wave = __builtin_amdgcn_readfirstlane(tid >> 6);
                __syncthreads();
                if (tid == 0) *slot = atomicAdd(qctr, 1);
                __syncthreads();
                const int it = __builtin_amdgcn_readfirstlane(*slot);
                if (it >= 3344) break;
                if (it < 16) { mb::chain(lds, l, it >> 1, it & 1, P, OB, tid, lane, wave); }
                else if (it < 272) { const int j = it - 16; bsp::item(lds, j & 7, 31 - (j >> 3), P, OB, tid, (int)(unsigned)ldptr(lds, 37)); }
                else if (it < 2320) { const int j = it - 272, h = j >> 9, idx = j & 511, b = idx >> 6, cI = idx & 63;
                    if (h != cur_h) { rw::build_ct(lds, l, h, lane, wave); cur_h = h; __syncthreads(); }
                    { const size_t ci_ = (size_t)((b * 4 + h) * 64 + cI); rw::chunk<(SP == 19 ? 5 : 1)>(lds, l, b, h, cI * 64, GZ + ci_ * 16384, ws + WS_RW2 + ci_ * 24576, (float*)(ws + WS_BONG) + ci_ * 64, P, VF, OB, tid); } }
                else { const int j = it - 2320; awin::item(lds, j >> 7, (j >> 2) & 31, j & 3, P, OB, tid); }
            }
        }
        else if constexpr (SP == 17 || SP == 18) {
            unsigned char* GZ = ws + WS_RW; int cur_h = -1;
#pragma unroll 1
            for (int k = 0; k < 8; ++k) { const int j = bid + 256 * k, h = j >> 9, idx = j & 511, b = idx >> 6, cI = idx & 63;
                if (h != cur_h) { rw::build_ct(lds, l, h, lane, wave); cur_h = h; __syncthreads(); }
                const size_t ci_ = (size_t)((b * 4 + h) * 64 + cI); rw::chunk<(SP == 17 ? 5 : 6)>(lds, l, b, h, cI * 64, GZ + ci_ * 16384, ws + WS_RW2 + ci_ * 24576, (float*)(ws + WS_BONG) + ci_ * 64, P, VF, OB, tid); }
        }
        else if constexpr (SP == 16) {
            bsp::item(lds, bid & 7, 31 - (bid >> 3), P, OB, tid, (int)(unsigned)ldptr(lds, 37) == 125 ? 300 : ((int)(unsigned)ldptr(lds, 37) == 126 ? 305 : (int)(unsigned)ldptr(lds, 37) + 80));
        }
        else if constexpr (SP == 4) {
            if (bid < 32) { rw::carry(lds, ws + WS_RW + (size_t)bid * 64 * 16384, tid); __syncthreads(); }
            pg8::Gemm g{XB, WgT, 1024, 1024, 1024}; SkewOrder S{M / 256, 16, (M / 256) * 16, bid, 1024, 1024};
            EpiStoreBf16 E{GS, 4096, 1, 4096};
            pg8::gemm_phase<EpiStoreBf16, SkewOrder>(lds, g, S, E);
        }
        else if constexpr (SP == 5) {
            pg8::Gemm g{OB, WbrT, 1024, 1024, 256}; BranchOrder S{M / 256, 4, G, bid};
            EpiBranch E{GS, MG};
            pg8::gemm_phase<EpiBranch, BranchOrder>(lds, g, S, E);
        }
        else if constexpr (SP == 6) {
            pg8::Gemm g{MG, WoutT, 1024, 1024, 1024}; pg8::StaticOrder S; S.init(M, 1024, G, bid, 1024, 1024);
            EpiResid E{X};
            pg8::gemm_phase<EpiResid, pg8::StaticOrder>(lds, g, S, E);
        }
        else if constexpr (SP == 7) {
            const float* g1 = INP(I_LN1G) + l * 1024; const float* b1 = INP(I_LN1B) + l * 1024;
            const float* rgb = INP(I_RGB) + l * 4; const float* reb = INP(I_REB) + l * 32;
            f32x4 vn[4];
#pragma unroll
            for (int j = 0; j < 4; ++j) vn[j] = ((const f32x4*)(X + (size_t)gw * D))[lane + 64 * j];
#pragma unroll 1
            for (int m = gw; m < M; m += NGW) {
                f32x4 v[4]; float s = 0.f; f32x4* xr = (f32x4*)(X + (size_t)m * D) + lane;
#pragma unroll
                for (int j = 0; j < 4; ++j) { v[j] = vn[j]; s += (v[j][0] + v[j][1]) + (v[j][2] + v[j][3]); }
                { const int mnx = (m + NGW < M) ? m + NGW : m;
#pragma unroll
                  for (int j = 0; j < 4; ++j) vn[j] = ((const f32x4*)(X + (size_t)mnx * D))[lane + 64 * j]; }
                const float mean = wave_sum(s) * (1.f / D); float s2 = 0.f;
#pragma unroll
                for (int j = 0; j < 4; ++j) { v[j] = v[j] - mean; s2 += (v[j][0] * v[j][0] + v[j][1] * v[j][1]) + (v[j][2] * v[j][2] + v[j][3] * v[j][3]); }
                const float rstd = rsqrtf(wave_sum(s2) * (1.f / D) + LN_EPS);
#pragma unroll
                for (int j = 0; j < 4; ++j) { const f32x4 gg = ((const f32x4*)g1)[lane + 64 * j], bb = ((const f32x4*)b1)[lane + 64 * j]; v[j] = v[j] * rstd * gg + bb; xr[64 * j] = v[j];
                    u32x2 w; w.x = pk2(v[j][0], v[j][1]); w.y = pk2(v[j][2], v[j][3]); ((u32x2*)(XB + (size_t)m * D))[lane + 64 * j] = w; }
                float mylg = 0.f;
#pragma unroll 1
                for (int o4 = 0; o4 < 36; o4 += 4) { float a4[4];
#pragma unroll
                    for (int u = 0; u < 4; ++u) { float a = 0.f;
#pragma unroll
                        for (int j = 0; j < 4; ++j) { const f32x4 wv = ((const f32x4*)(WrT + (o4 + u) * 1024))[lane + 64 * j]; a += v[j][0] * wv[0] + v[j][1] * wv[1] + v[j][2] * wv[2] + v[j][3] * wv[3]; }
                        a4[u] = a; }
#pragma unroll
                    for (int sft = 1; sft < 64; sft <<= 1) {
#pragma unroll
                        for (int u = 0; u < 4; ++u) a4[u] += __shfl_xor(a4[u], sft); }
#pragma unroll
                    for (int u = 0; u < 4; ++u) mylg = (lane == o4 + u) ? a4[u] : mylg; }
                mylg += lane < 4 ? rgb[lane & 3] : (lane < 36 ? reb[(lane - 4) & 31] : 0.f);
                float gl[4]; float gm = -INFINITY; int gs = 0;
#pragma unroll
                for (int o = 0; o < 4; ++o) { gl[o] = __shfl(mylg, o); if (gl[o] > gm) { gm = gl[o]; gs = o; } }
                float gden = 0.f;
#pragma unroll
                for (int o = 0; o < 4; ++o) gden += __expf(gl[o] - gm);
                const float pg = 1.f / gden;
                float el[8];
#pragma unroll
                for (int o = 0; o < 8; ++o) el[o] = __shfl(mylg, 4 + gs * 8 + o);
                int e1 = 0; float m1 = el[0];
#pragma unroll
                for (int o = 1; o < 8; ++o) if (el[o] > m1) { m1 = el[o]; e1 = o; }
                int e2 = -1; float m2 = -INFINITY;
#pragma unroll
                for (int o = 0; o < 8; ++o) if (o != e1 && el[o] > m2) { m2 = el[o]; e2 = o; }
                const float r2 = __expf(m2 - m1); const float ga = pg / (1.f + r2), gb = pg * r2 / (1.f + r2);
                if (lane == 0) {
                    const int E1 = gs * 8 + e1, E2 = gs * 8 + e2;
                    tok_e[m * 2] = E1; tok_e[m * 2 + 1] = E2; tok_g[m * 2] = ga; tok_g[m * 2 + 1] = gb;
                    tok_rank[m * 2] = atomicAdd(&cnt[E1], 1); tok_rank[m * 2 + 1] = atomicAdd(&cnt[E2], 1);
                }
            }
        }
        else if constexpr (SP == 14) {
            LAS float* scr = (LAS float*)(lds + wave * 16384);
            const float* eg = INP(I_EG) + (size_t)l * NEXP * 1024 * 512; const float* eu = INP(I_EU) + (size_t)l * NEXP * 1024 * 512; const float* ed = INP(I_ED) + (size_t)l * NEXP * 512 * 1024;
            for (int it = gw; it < NEXP * 2 * 4 * 64; it += NGW) {
                const int e = it / 512, r = it % 512, half = r / 256, ct = (r % 256) / 64, q = r % 64, kb = q / 4, nb = q % 4;
                const float* W = (half ? eu : eg) + (size_t)e * 1024 * 512;
                transpose_item(W, 512, ct * 128, 128, WGU + (size_t)e * 1024 * 1024, 1024, ct * 256 + half * 128, 0, kb, nb, scr, lane);
            }
            for (int it = gw; it < NEXP * 8 * 32; it += NGW) {
                const int e = it / 256, q = it % 256, kb = q / 32, nb = q % 32;
                transpose_item(ed + (size_t)e * 512 * 1024, 1024, 0, 1024, WD + (size_t)e * 1024 * 512, 512, 0, 0, kb, nb, scr, lane);
            }
        }
        else if constexpr (SP == 8 || SP == 9 || SP == 10) {
            unsigned tbo = MISC_OFF; asm volatile("" : "+v"(tbo));
            volatile LAS int* tb = (volatile LAS int*)(lds + tbo);
            if (tid == 0) { int acc = 0; for (int e = 0; e < 32; ++e) { const int c = __hip_atomic_load(&cnt[e], __ATOMIC_RELAXED, __HIP_MEMORY_SCOPE_AGENT); tb[e] = acc; tb[33 + e] = acc; acc += (c + 255) >> 8; } tb[32] = acc; }
            __syncthreads();
            if constexpr (SP == 8) {
                for (int m = gw; m < M; m += NGW) {
#pragma unroll
                    for (int k = 0; k < 2; ++k) { const int e = tok_e[m * 2 + k]; const int slot = tb[33 + e] * 256 + tok_rank[m * 2 + k];
                        const u32x4* src = (const u32x4*)(XB + (size_t)m * D); u32x4* dst = (u32x4*)(XS + (size_t)slot * D);
                        dst[lane] = src[lane]; dst[lane + 64] = src[lane + 64];
                        if (lane == 0) tok_slot[m * 2 + k] = slot; }
                }
            } else if constexpr (SP == 9) {
                pg8::Gemm g{XS, WGU, 1024, 1024, 1024}; MoeOrder S{tb, G, bid, (size_t)1024 * 2, (size_t)1024 * 1024 * 2, (size_t)256 * 1024 * 2};
                EpiSwiglu E{HB};
                pg8::gemm_phase<EpiSwiglu, MoeOrder>(lds, g, S, E);
            } else {
                pg8::Gemm g{HB, WD, 512, 512, 512}; MoeOrder S{tb, G, bid, (size_t)512 * 2, (size_t)1024 * 512 * 2, (size_t)256 * 512 * 2};
                EpiStoreBf16 E{XS, 1024, 0, 1024};
                pg8::gemm_phase<EpiStoreBf16, MoeOrder>(lds, g, S, E);
            }
        }
        else if constexpr (SP == 11) {
            const float* g2 = INP(I_LN2G) + l * 1024; const float* b2 = INP(I_LN2B) + l * 1024;
            f32x4 xn[4]; u32x2 y1n[4], y2n[4]; float gan, gbn;
#define LN2_LOAD(mm) do { const int s1_ = tok_slot[(mm) * 2], s2_ = tok_slot[(mm) * 2 + 1]; gan = tok_g[(mm) * 2]; gbn = tok_g[(mm) * 2 + 1]; \
                _Pragma("unroll") for (int j = 0; j < 4; ++j) { xn[j] = ((const f32x4*)(X + (size_t)(mm) * D))[lane + 64 * j]; y1n[j] = ((const u32x2*)(XS + (size_t)s1_ * D))[lane + 64 * j]; y2n[j] = ((const u32x2*)(XS + (size_t)s2_ * D))[lane + 64 * j]; } } while (0)
            LN2_LOAD(gw);
#pragma unroll 1
            for (int m = gw; m < M; m += NGW) {
                const float ga = gan, gb = gbn;
                f32x4 v[4]; float s = 0.f; f32x4* xr = (f32x4*)(X + (size_t)m * D) + lane;
                u32x2 y1c[4], y2c[4];
#pragma unroll
                for (int j = 0; j < 4; ++j) { v[j] = xn[j] * ALPHA; y1c[j] = y1n[j]; y2c[j] = y2n[j]; }
                { const int mnx = (m + NGW < M) ? m + NGW : m; LN2_LOAD(mnx); }
#pragma unroll
                for (int j = 0; j < 4; ++j) { const u32x2 y1 = y1c[j], y2 = y2c[j];
                    v[j][0] += ga * __uint_as_float(y1.x << 16) + gb * __uint_as_float(y2.x << 16); v[j][1] += ga * __uint_as_float(y1.x & 0xffff0000u) + gb * __uint_as_float(y2.x & 0xffff0000u);
                    v[j][2] += ga * __uint_as_float(y1.y << 16) + gb * __uint_as_float(y2.y << 16); v[j][3] += ga * __uint_as_float(y1.y & 0xffff0000u) + gb * __uint_as_float(y2.y & 0xffff0000u);
                    s += (v[j][0] + v[j][1]) + (v[j][2] + v[j][3]); }
                const float mean = wave_sum(s) * (1.f / D); float s2 = 0.f;
#pragma unroll
                for (int j = 0; j < 4; ++j) { v[j] = v[j] - mean; s2 += (v[j][0] * v[j][0] + v[j][1] * v[j][1]) + (v[j][2] * v[j][2] + v[j][3] * v[j][3]); }
                const float rstd = rsqrtf(wave_sum(s2) * (1.f / D) + LN_EPS);
#pragma unroll
                for (int j = 0; j < 4; ++j) { const f32x4 gg = ((const f32x4*)g2)[lane + 64 * j], bb = ((const f32x4*)b2)[lane + 64 * j]; v[j] = v[j] * rstd * gg + bb; xr[64 * j] = v[j];
                    u32x2 w; w.x = pk2(v[j][0], v[j][1]); w.y = pk2(v[j][2], v[j][3]); ((u32x2*)(XB + (size_t)m * D))[lane + 64 * j] = w; }
            }
        }
    }
}

template <int SP>
__global__ void __launch_bounds__(NTHR, 2) k_phase(Args args, int l) {
    extern __shared__ __attribute__((aligned(16))) unsigned char lds_raw[];
    ptr_table_fill(args, (LAS unsigned char*)lds_raw);
    phase_body<SP>(l, (LAS unsigned char*)lds_raw);
}


#define XB_TMO      128
#define XB_XCNT(j)  (256  + 64 * (j))
#define XB_XSUB(j)  (1280 + 64 * (j))
#define XB_XGEN(j)  (2304 + 64 * (j))
#define XB_TOP      3328
#define XB_TOPGEN   3392
#define XCD_BAR_WORDS 3456
#define XB_SPIN_CAP (1u << 22)
__device__ __forceinline__ unsigned xb_ld(unsigned* p)              { return __hip_atomic_load(p, __ATOMIC_RELAXED, __HIP_MEMORY_SCOPE_AGENT); }
__device__ __forceinline__ unsigned xb_add(unsigned* p, unsigned v) { return __hip_atomic_fetch_add(p, v, __ATOMIC_RELAXED, __HIP_MEMORY_SCOPE_AGENT); }
__device__ __forceinline__ unsigned xb_xcc_id() { return (unsigned)__builtin_amdgcn_s_getreg((3 << 11) | 20) & 0xFu; }
#define XB_SPIN(cond, bar) do { unsigned _sp = 0; while (cond) { __builtin_amdgcn_s_sleep(1); \
    if ((++_sp & 255u) == 0u) { if (xb_ld(&(bar)[XB_TMO])) break; if (_sp > XB_SPIN_CAP) { atomicAdd(&(bar)[XB_TMO], 1u); break; } } } } while (0)
__device__ __forceinline__ void xcd_barrier_complete(unsigned* bar, unsigned x, unsigned& nloc, unsigned& nx) {
    const unsigned G = gridDim.x;
    unsigned sum, cnt, mine, sp = 0u;
    for (;;) {
        sum = 0u; cnt = 0u; mine = 0u;
#pragma unroll
        for (unsigned j = 0; j < 16; ++j) { const unsigned c = xb_ld(&bar[XB_XCNT(j)]); sum += c; cnt += (c > 0u) ? 1u : 0u; mine = (j == x) ? c : mine; }
        if (sum == G) break;
        __builtin_amdgcn_s_sleep(1);
        if ((++sp & 255u) == 0u) { if (xb_ld(&bar[XB_TMO])) break; if (sp > XB_SPIN_CAP) { atomicAdd(&bar[XB_TMO], 1u); break; } }
    }
    nloc = mine > 0u ? mine : 1u; nx = cnt > 0u ? cnt : 1u;
}
__device__ __forceinline__ void xcd_barrier(unsigned* bar, LAS unsigned char* lds) {
    asm volatile("s_waitcnt vmcnt(0)" ::: "memory");
    __syncthreads();
    int tid_ = threadIdx.x; asm volatile("" : "+v"(tid_));
    if (tid_ == 0) {
        unsigned so = (unsigned)(LDS_BYTES - 576); asm volatile("" : "+v"(so));
        volatile LAS unsigned* st = (volatile LAS unsigned*)(lds + so);
        __builtin_amdgcn_s_waitcnt(0);
        const unsigned x = xb_xcc_id();
        unsigned nloc = st[0], nx = st[1];
        if (nloc == 0u) { xcd_barrier_complete(bar, x, nloc, nx); st[0] = nloc; st[1] = nx; }
        const unsigned old = xb_add(&bar[XB_XSUB(x)], 1u);
        const unsigned gen = old / nloc;
        if (old + 1u == (gen + 1u) * nloc) {
            __builtin_amdgcn_fence(__ATOMIC_RELEASE, "agent");
            asm volatile("s_waitcnt vmcnt(0)" ::: "memory");
            const unsigned og = xb_add(&bar[XB_TOP], 1u);
            const unsigned tg = og / nx;
            if (og + 1u == (tg + 1u) * nx) xb_add(&bar[XB_TOPGEN], 1u);
            else XB_SPIN(xb_ld(&bar[XB_TOPGEN]) == tg, bar);
            __builtin_amdgcn_fence(__ATOMIC_ACQUIRE, "agent");
            xb_add(&bar[XB_XGEN(x)], 1u);
            asm volatile("s_waitcnt vmcnt(0)" ::: "memory");
        } else {
            XB_SPIN(xb_ld(&bar[XB_XGEN(x)]) == gen, bar);
            __builtin_amdgcn_fence(__ATOMIC_ACQUIRE, "agent");
            asm volatile("s_waitcnt vmcnt(0)" ::: "memory");
        }
    }
    __syncthreads();
}
namespace cg = cooperative_groups;
__global__ void __launch_bounds__(NTHR, 2) fwd_all(Args args) {
    extern __shared__ __attribute__((aligned(16))) unsigned char lds_raw[];
    LAS unsigned char* lds = (LAS unsigned char*)lds_raw;
    unsigned* bar = (unsigned*)(args.ws + WS_CTL) + CW_BAR;
    if (threadIdx.x == 0) { ((volatile LAS unsigned*)(lds + LDS_BYTES - 576))[0] = 0u; ((volatile LAS unsigned*)(lds + LDS_BYTES - 576))[1] = 0u; (void)xb_add(&bar[XB_XCNT(xb_xcc_id())], 1u); }
    ptr_table_fill(args, lds);
    const int probe = args.ph_lo;
    { constexpr int l = 0;
#pragma unroll 1
      for (int r_ = 0; r_ < ((probe == -1) ? 2 : 1); ++r_) { phase_body<-1>(l, lds); __syncthreads(); } }
    cg::this_grid().sync();
#define GRID_BAR() do { unsigned* bar_ = (unsigned*)gptr(ldptr(lds, 36)) + CW_BAR; xcd_barrier(bar_, lds); } while (0)
#define RUN(SP) do { _Pragma("unroll 1") for (int r_ = 0; r_ < ((probe == (SP)) ? 2 : 1); ++r_) { phase_body<SP>(l, lds); __syncthreads(); } } while (0)
#define ONCE(SP) do { phase_body<SP>(l, lds); __syncthreads(); } while (0)
#define LAYER() \
        RUN(0); GRID_BAR(); \
        ONCE(15); GRID_BAR(); \
        if (probe == 132) { ONCE(19); GRID_BAR(); } \
        if (probe == 130) { ONCE(17); GRID_BAR(); } \
        if (probe == 131) { ONCE(18); GRID_BAR(); } \
        if (probe >= 119 && probe < 130) { ONCE(16); GRID_BAR(); } \
        ONCE(4); GRID_BAR(); \
        RUN(13); GRID_BAR(); \
        RUN(5); GRID_BAR(); \
        ONCE(6); GRID_BAR(); \
        ONCE(7); RUN(14); GRID_BAR(); \
        RUN(8); GRID_BAR(); \
        RUN(9); GRID_BAR(); \
        RUN(10); GRID_BAR(); \
        ONCE(11); GRID_BAR();
    { constexpr int l = 0; LAYER() }
    { constexpr int l = 1; LAYER() }
#undef LAYER
#undef RUN
#undef ONCE
#undef GRID_BAR
}

template <int SP> static void launch_phase(const Args& a, int l, int grid, hipStream_t stream) {
    static bool attr = false;
    if (!attr) { (void)hipFuncSetAttribute((const void*)k_phase<SP>, hipFuncAttributeMaxDynamicSharedMemorySize, LDS_BYTES); attr = true; }
    hipLaunchKernelGGL(k_phase<SP>, dim3(grid), dim3(NTHR), LDS_BYTES, stream, a, l);
}

extern "C" void kernel_launch(void* const* d_in, const int* in_sizes, int n_in, void* d_out, int out_size, void* d_ws, size_t ws_size, hipStream_t stream) {
    static int grid = 0;
    if (grid == 0) {
        if (n_in != 35 || out_size != M * D || ws_size < WS_END) { fprintf(stderr, "kernel_launch: unexpected problem (n_in %d out %d ws %zu)\n", n_in, out_size, ws_size); grid = -1; return; }
        int dev = 0, cus = 0, per_cu = 0;
        (void)hipGetDevice(&dev); (void)hipDeviceGetAttribute(&cus, hipDeviceAttributeMultiprocessorCount, dev);
#if N_LAUNCH_MODE == 1
        (void)hipFuncSetAttribute((const void*)fwd_all, hipFuncAttributeMaxDynamicSharedMemorySize, LDS_BYTES);
        if (hipOccupancyMaxActiveBlocksPerMultiprocessor(&per_cu, (const void*)fwd_all, NTHR, LDS_BYTES) != hipSuccess || per_cu < 1) { fprintf(stderr, "kernel_launch: occupancy query says %d blocks/CU\n", per_cu); grid = -1; return; }
#endif
        (void)per_cu;
        grid = cus;
        if (grid != 256) { fprintf(stderr, "kernel_launch: built for 256 CUs, found %d\n", cus); grid = -1; return; }
    }
    if (grid < 0) return;
    (void)hipMemsetAsync((char*)d_ws + WS_CTL, 0, CTL_BYTES, stream);
    Args a{};
    for (int i = 0; i < 35; ++i) a.in[i] = (const float*)d_in[i];
    a.out = (float*)d_out; a.ws = (unsigned char*)d_ws;
#if N_LAUNCH_MODE == 1
    a.ph_lo = PROBE_REPS;
    void* kargs[] = {(void*)&a};
    hipError_t e = hipLaunchCooperativeKernel((const void*)fwd_all, dim3(grid), dim3(NTHR), kargs, LDS_BYTES, stream);
    if (e != hipSuccess) fprintf(stderr, "cooperative launch failed: %s\n", hipGetErrorString(e));
#else
    launch_phase<-1>(a, 0, grid, stream);
    for (int l = 0; l < NL; ++l) {
        launch_phase<0>(a, l, grid, stream); launch_phase<15>(a, l, grid, stream); launch_phase<4>(a, l, grid, stream); launch_phase<13>(a, l, grid, stream);
        launch_phase<5>(a, l, grid, stream); launch_phase<6>(a, l, grid, stream); launch_phase<7>(a, l, grid, stream); launch_phase<14>(a, l, grid, stream);
        launch_phase<8>(a, l, grid, stream); launch_phase<9>(a, l, grid, stream); launch_phase<10>(a, l, grid, stream); launch_phase<11>(a, l, grid, stream);
    }
#endif
}
```

```cpp
#include <hip/hip_runtime.h>
#include <type_traits>
#include <cstdio>
#include <cstdint>
#include <hip/hip_cooperative_groups.h>

#ifndef PROBE_REPS
#define PROBE_REPS -100
#endif
#ifndef N_LAUNCH_MODE
#define N_LAUNCH_MODE 1
#endif

namespace pg8 {
#define PG8_LAS __attribute__((address_space(3)))
typedef unsigned short bf16_t;
typedef short bf16x8 __attribute__((ext_vector_type(8)));
typedef float f32x4 __attribute__((ext_vector_type(4)));
typedef unsigned u32x4 __attribute__((ext_vector_type(4)));
constexpr int BM = 256, BK = 64, HALF = 128, HTB = HALF * BK * 2, STAGE_BYTES = 8 * HTB, NXCD = 8, WGM = 8;

__host__ __device__ __forceinline__ int lds_byte(int r, int c) { const int st = (r >> 4) * 2 + (c >> 5), rr = r & 15, cc = c & 31, ob = rr * 64 + cc * 2; return st * 1024 + (ob ^ (((ob >> 9) & 1) << 5)); }
__host__ __device__ __forceinline__ void stage_rc(int b, int& R, int& C) { const int st = b / 1024, sb = b % 1024, swz = sb ^ (((sb >> 9) & 1) << 5); R = (st >> 1) * 16 + swz / 64; C = (st & 1) * 32 + (swz % 64) / 2; }
__host__ __device__ __forceinline__ int perm32(int rho) { const int n = rho >> 4, i = rho & 15; return 8 * (i >> 2) + 4 * n + (i & 3); }

struct Unit { int pm, pn, aux; size_t aoff, boff; };
struct Gemm { const bf16_t* A; const bf16_t* Bt; int lda, ldb, K; };

__device__ __forceinline__ void tile_of(int L, int nM, int nN, int& pm, int& pn) {
    const int nwg = nM * nN; int wgid = L;
    { const int q = nwg / NXCD, r = nwg % NXCD, xcd = wgid % NXCD, off = wgid / NXCD; wgid = (xcd < r ? xcd * (q + 1) : r * (q + 1) + (xcd - r) * q) + off; }
    const int nig = WGM * nN, gid = wgid / nig, fm = gid * WGM, gsz = (nM - fm) < WGM ? (nM - fm) : WGM;
    pm = fm + ((wgid % nig) % gsz); pn = (wgid % nig) / gsz;
}
struct StaticOrder {
    int nM, nN, nwg, G, c, lda, ldb;
    __device__ void init(int M, int N, int G_, int c_, int lda_, int ldb_) { nM = M / BM; nN = N / BM; nwg = nM * nN; G = G_; c = c_; lda = lda_; ldb = ldb_; }
    __device__ bool next(int i, Unit& u) const {
        const long L = (long)i * G + c; if (L >= nwg) return false;
        tile_of((int)L, nM, nN, u.pm, u.pn); u.aux = 0;
        u.aoff = (size_t)u.pm * BM * lda * 2; u.boff = (size_t)u.pn * BM * ldb * 2; return true;
    }
};

__device__ __forceinline__ unsigned cvt_pk_bf16(float lo, float hi) { typedef __bf16 b2_ __attribute__((ext_vector_type(2))); typedef float f2_ __attribute__((ext_vector_type(2))); return __builtin_bit_cast(unsigned, __builtin_convertvector((f2_){lo, hi}, b2_)); }
__device__ __forceinline__ void epi_mfma_settle(const f32x4 (&acc)[2][2][4][2]) {
    asm volatile("s_nop 11" :: "v"(acc[1][0][0][0]), "v"(acc[1][0][0][1]), "v"(acc[1][0][1][0]), "v"(acc[1][0][1][1]), "v"(acc[1][0][2][0]), "v"(acc[1][0][2][1]), "v"(acc[1][0][3][0]), "v"(acc[1][0][3][1]),
                                "v"(acc[1][1][0][0]), "v"(acc[1][1][0][1]), "v"(acc[1][1][1][0]), "v"(acc[1][1][1][1]), "v"(acc[1][1][2][0]), "v"(acc[1][1][2][1]), "v"(acc[1][1][3][0]), "v"(acc[1][1][3][1]) : "memory"); }

template <class Epi, class Sched, bool ALIGN_EPI = true, bool SP2 = true>
__device__ __forceinline__ void gemm_phase(PG8_LAS unsigned char* lds, const Gemm g, const Sched& S, const Epi& E) {
    int tid_ = threadIdx.x; asm volatile("" : "+v"(tid_));
    const int tid = tid_, wid = __builtin_amdgcn_readfirstlane(tid >> 6), lane = tid & 63, wr = wid >> 2, wc = wid & 3, fr = lane & 15, fq = lane >> 4;
    const int K = g.K, nt = K / BK;
    unsigned voffA[2], voffB[2];
#pragma unroll
    for (int i = 0; i < 2; ++i) { int R, C; stage_rc(tid * 16 + i * 8192, R, C); const int Rb = Epi::PERM ? ((R & ~31) + perm32(R & 31)) : R;
        voffA[i] = (unsigned)(R * g.lda + C) * 2u; voffB[i] = (unsigned)(Rb * g.ldb + C) * 2u; }
    const size_t kstep = (size_t)(BK * 2);
    const size_t hstepA = (size_t)HALF * g.lda * 2, hstepB = (size_t)HALF * g.ldb * 2;
    const unsigned ldsw = (unsigned)wid * 1024u;
    const int aoff = lds_byte(wr * 64 + fr, fq * 8), boff = lds_byte(wc * 32 + fr, fq * 8);
#define PG8_SA(b, h) (((b) * 2 + (h)) * HTB)
#define PG8_SB(b, h) ((4 + (b) * 2 + (h)) * HTB)
#define PG8_STAGE(bufoff, gbase, voff) do { _Pragma("unroll") for (int _i = 0; _i < 2; ++_i) \
        __builtin_amdgcn_global_load_lds((const unsigned*)((const char*)(gbase) + (voff)[_i]), (PG8_LAS unsigned*)(lds + (bufoff) + ldsw + _i * 8192), 16, 0, 0); } while (0)
#define PG8_LDA(dst, b, h) do { _Pragma("unroll") for (int m = 0; m < 4; ++m) _Pragma("unroll") for (int k = 0; k < 2; ++k) dst[m][k] = *(const PG8_LAS bf16x8*)(lds + PG8_SA(b, h) + aoff + m * 2048 + k * 1024); } while (0)
#define PG8_LDB(dst, b, h) do { _Pragma("unroll") for (int n = 0; n < 2; ++n) _Pragma("unroll") for (int k = 0; k < 2; ++k) dst[n][k] = *(const PG8_LAS bf16x8*)(lds + PG8_SB(b, h) + boff + n * 2048 + k * 1024); } while (0)
#define PG8_MMA(ai, bj, At, Bt) do { __builtin_amdgcn_s_setprio(1); _Pragma("unroll") for (int m = 0; m < 4; ++m) _Pragma("unroll") for (int n = 0; n < 2; ++n) _Pragma("unroll") for (int k = 0; k < 2; ++k) \
        acc[ai][bj][m][n] = __builtin_amdgcn_mfma_f32_16x16x32_bf16(Bt[n][k], At[m][k], acc[ai][bj][m][n], 0, 0, 0); __builtin_amdgcn_s_setprio(0); } while (0)
#define PG8_WAIT_V(n) asm volatile("s_waitcnt vmcnt(" #n ")" ::: "memory")
#define PG8_WAIT_L(n) asm volatile("s_waitcnt lgkmcnt(" #n ")" ::: "memory")
#define PG8_BAR __builtin_amdgcn_s_barrier()
#define PG8_SCHED __builtin_amdgcn_sched_barrier(0)
    Unit cur, nxt; int ui = 0;
    if (!S.next(0, cur)) return;
    f32x4 acc[2][2][4][2];
#pragma unroll
    for (int a = 0; a < 2; ++a)
#pragma unroll
        for (int b = 0; b < 2; ++b)
#pragma unroll
            for (int m = 0; m < 4; ++m)
#pragma unroll
                for (int n = 0; n < 2; ++n) acc[a][b][m][n] = (f32x4){0.f, 0.f, 0.f, 0.f};
    bf16x8 At[4][2], B0[2][2], B1[2][2];
    const char* cA = (const char*)g.A + cur.aoff; const char* cB = (const char*)g.Bt + cur.boff;
    if constexpr (SP2) {
        PG8_STAGE(PG8_SB(0, 0), cB, voffB); PG8_STAGE(PG8_SB(0, 1), cB + hstepB, voffB); PG8_STAGE(PG8_SA(0, 0), cA, voffA); PG8_STAGE(PG8_SA(0, 1), cA + hstepA, voffA);
        if (wr == 1) PG8_BAR;
        PG8_WAIT_V(2); PG8_BAR;
        PG8_STAGE(PG8_SB(1, 0), cB + kstep, voffB); PG8_STAGE(PG8_SA(1, 0), cA + kstep, voffA); PG8_STAGE(PG8_SB(1, 1), cB + hstepB + kstep, voffB);
        PG8_WAIT_V(6); PG8_BAR;
    } else {
        PG8_STAGE(PG8_SB(0, 0), cB, voffB); PG8_STAGE(PG8_SA(0, 0), cA, voffA); PG8_STAGE(PG8_SB(0, 1), cB + hstepB, voffB); PG8_STAGE(PG8_SA(0, 1), cA + hstepA, voffA);
        if (wr == 1) PG8_BAR;
        PG8_WAIT_V(4); PG8_BAR;
        PG8_STAGE(PG8_SB(1, 0), cB + kstep, voffB); PG8_STAGE(PG8_SA(1, 0), cA + kstep, voffA); PG8_STAGE(PG8_SB(1, 1), cB + hstepB + kstep, voffB);
        PG8_WAIT_V(6); PG8_BAR;
    }
    for (;;) {
        const bool has_next = S.next(ui + 1, nxt);
        const char* nA = has_next ? (const char*)g.A + nxt.aoff : cA; const char* nB = has_next ? (const char*)g.Bt + nxt.boff : cB;
#pragma unroll 1
        for (int t = 0; t < nt; t += 2) {
            const bool last = (t == nt - 2);
            const char* a1 = cA + (size_t)(t + 1) * kstep;
            const char* a2 = last ? nA : cA + (size_t)(t + 2) * kstep; const char* b2 = last ? nB : cB + (size_t)(t + 2) * kstep;
            const char* a3 = a2 + kstep; const char* b3 = b2 + kstep;
            if constexpr (SP2) {
            PG8_LDB(B0, 0, 0); PG8_LDB(B1, 0, 1); PG8_SCHED; PG8_LDA(At, 0, 0); PG8_STAGE(PG8_SA(1, 1), a1 + hstepA, voffA);
            PG8_WAIT_V(8); PG8_WAIT_L(0); PG8_BAR; PG8_MMA(0, 0, At, B0); PG8_MMA(0, 1, At, B1); PG8_BAR; PG8_SCHED;
            PG8_LDA(At, 0, 1); PG8_STAGE(PG8_SB(0, 0), b2, voffB); PG8_STAGE(PG8_SB(0, 1), b2 + hstepB, voffB); PG8_STAGE(PG8_SA(0, 0), a2, voffA);
            PG8_WAIT_V(8); PG8_WAIT_L(0); PG8_BAR; PG8_MMA(1, 0, At, B0); PG8_MMA(1, 1, At, B1); PG8_BAR; PG8_SCHED;
            PG8_LDB(B0, 1, 0); PG8_LDB(B1, 1, 1); PG8_SCHED; PG8_LDA(At, 1, 0); PG8_STAGE(PG8_SA(0, 1), a2 + hstepA, voffA);
            PG8_WAIT_V(8); PG8_WAIT_L(0); PG8_BAR; PG8_MMA(0, 0, At, B0); PG8_MMA(0, 1, At, B1); PG8_BAR; PG8_SCHED;
            PG8_LDA(At, 1, 1); PG8_STAGE(PG8_SB(1, 0), b3, voffB); PG8_STAGE(PG8_SB(1, 1), b3 + hstepB, voffB); PG8_STAGE(PG8_SA(1, 0), a3, voffA);
            PG8_WAIT_V(8); PG8_WAIT_L(0); PG8_BAR; PG8_MMA(1, 0, At, B0); PG8_MMA(1, 1, At, B1); PG8_BAR; PG8_SCHED;
            } else {
            PG8_LDB(B0, 0, 0); PG8_SCHED; PG8_LDA(At, 0, 0); PG8_STAGE(PG8_SA(1, 1), a1 + hstepA, voffA);
            PG8_WAIT_L(8); PG8_BAR; PG8_WAIT_L(0); PG8_MMA(0, 0, At, B0); PG8_BAR; PG8_SCHED;
            PG8_LDB(B1, 0, 1); PG8_STAGE(PG8_SB(0, 0), b2, voffB);
            PG8_BAR; PG8_WAIT_L(0); PG8_MMA(0, 1, At, B1); PG8_BAR;
            PG8_LDA(At, 0, 1); PG8_STAGE(PG8_SA(0, 0), a2, voffA);
            PG8_BAR; PG8_WAIT_L(0); PG8_MMA(1, 0, At, B0); PG8_BAR; PG8_SCHED;
            PG8_STAGE(PG8_SB(0, 1), b2 + hstepB, voffB);
            PG8_WAIT_V(6); PG8_BAR; PG8_MMA(1, 1, At, B1); PG8_BAR;
            PG8_LDB(B0, 1, 0); PG8_SCHED; PG8_LDA(At, 1, 0); PG8_STAGE(PG8_SA(0, 1), a2 + hstepA, voffA);
            PG8_WAIT_L(8); PG8_BAR; PG8_WAIT_L(0); PG8_MMA(0, 0, At, B0); PG8_BAR; PG8_SCHED;
            PG8_LDB(B1, 1, 1); PG8_STAGE(PG8_SB(1, 0), b3, voffB);
            PG8_BAR; PG8_WAIT_L(0); PG8_MMA(0, 1, At, B1); PG8_BAR;
            PG8_LDA(At, 1, 1); PG8_STAGE(PG8_SA(1, 0), a3, voffA);
            PG8_BAR; PG8_WAIT_L(0); PG8_MMA(1, 0, At, B0); PG8_BAR; PG8_SCHED;
            PG8_STAGE(PG8_SB(1, 1), b3 + hstepB, voffB);
            PG8_WAIT_V(6); PG8_BAR; PG8_MMA(1, 1, At, B1); PG8_BAR;
            }
        }
        if constexpr (ALIGN_EPI) { if (wr == 0) PG8_BAR; }
        E(acc, cur, wr, wc, fr, fq);
        if (!has_next) break;
#pragma unroll
        for (int a = 0; a < 2; ++a)
#pragma unroll
            for (int b = 0; b < 2; ++b)
#pragma unroll
                for (int m = 0; m < 4; ++m)
#pragma unroll
                    for (int n = 0; n < 2; ++n) acc[a][b][m][n] = (f32x4){0.f, 0.f, 0.f, 0.f};
        cur = nxt; cA = nA; cB = nB; ++ui;
        if constexpr (ALIGN_EPI) { if (wr == 1) PG8_BAR; }
    }
    PG8_WAIT_V(0);
    if constexpr (!ALIGN_EPI) { if (wr == 0) PG8_BAR; }
    PG8_BAR;
#undef PG8_SA
#undef PG8_SB
#undef PG8_STAGE
#undef PG8_LDA
#undef PG8_LDB
#undef PG8_MMA
#undef PG8_WAIT_V
#undef PG8_WAIT_L
#undef PG8_BAR
#undef PG8_SCHED
}
}

#define LAS __attribute__((address_space(3)))
typedef unsigned short bf16;
typedef float f32x4 __attribute__((ext_vector_type(4)));
typedef unsigned u32x4 __attribute__((ext_vector_type(4)));
typedef unsigned u32x2 __attribute__((ext_vector_type(2)));

constexpr int NB = 8, T = 4096, D = 1024, M = NB * T, NL = 2;
constexpr int INW = 9160;
constexpr int PP = 5120;
constexpr int C_AQ = 0, C_AK = 768, C_AV = 1536, C_BQ = 2304, C_BK = 2560, C_BV = 2816, C_IQ = 3072, C_IK = 3328, C_C = 3392, C_DZ = 4288, C_DX = 4544, C_IW = 5056, C_DT = 5060, C_END = 5064;
constexpr int NEXP = 32, DEXP = 512;
constexpr int CAP = 73728;
constexpr float LN_EPS = 1e-5f;
constexpr float ALPHA = 1.4142135623730951f;

constexpr size_t MiB = 1u << 20;
constexpr size_t WS_CTL = 0, CTL_BYTES = 1 * MiB;
constexpr size_t WS_WINT = 2 * MiB;
constexpr size_t WS_WGT = 22 * MiB;
constexpr size_t WS_WBRT = 38 * MiB;
constexpr size_t WS_WOUTT = 42 * MiB;
constexpr size_t WS_WRT = 46 * MiB;
constexpr size_t WS_ROUTE = 47 * MiB;
constexpr size_t WS_XB = 48 * MiB;
constexpr size_t WS_O = 112 * MiB;
constexpr size_t WS_VF = 176 * MiB;
constexpr size_t WS_P = 192 * MiB;
constexpr size_t WS_GS = 192 * MiB;
constexpr size_t WS_MERGED = 448 * MiB;
constexpr size_t WS_XS = 192 * MiB;
constexpr size_t WS_H = 336 * MiB;
constexpr size_t WS_WGU = 408 * MiB;
constexpr size_t WS_WD = 472 * MiB;
constexpr size_t WS_RW = 512 * MiB;
constexpr size_t WS_RW2 = 544 * MiB;
constexpr size_t WS_BONG = 46 * MiB + 512 * 1024;
constexpr size_t WS_END = 592 * MiB;
constexpr int CW_CNT = 64, CW_Q = 256, CW_BAR = 4096;

constexpr int RING_BYTES = 131072, MISC_OFF = RING_BYTES, LDS_BYTES = 147456;
constexpr int NWAVES = 8, NTHR = 512;

__device__ __forceinline__ float bf2f(bf16 v) { return __uint_as_float(((unsigned)v) << 16); }
__device__ __forceinline__ unsigned pk2(float lo, float hi) { return pg8::cvt_pk_bf16(lo, hi); }
__device__ __forceinline__ unsigned f2bf(float f) { unsigned u = __float_as_uint(f); return (u + 0x7fffu + ((u >> 16) & 1u)) >> 16; }
#define DPP_ADD(v, ctrl) v += __builtin_bit_cast(float, __builtin_amdgcn_update_dpp(0, __builtin_bit_cast(int, v), ctrl, 0xF, 0xF, true))
#define DPP_MAX(v, ctrl) v = fmaxf(v, __builtin_bit_cast(float, __builtin_amdgcn_update_dpp(0, __builtin_bit_cast(int, v), ctrl, 0xF, 0xF, true)))
__device__ __forceinline__ float wave_sum(float v) {
    DPP_ADD(v, 0xB1); DPP_ADD(v, 0x4E); DPP_ADD(v, 0x141); DPP_ADD(v, 0x140);
    v += __shfl_xor(v, 16); v += __shfl_xor(v, 32);
    return v;
}
__device__ __forceinline__ float wave_max(float v) {
    DPP_MAX(v, 0xB1); DPP_MAX(v, 0x4E); DPP_MAX(v, 0x141); DPP_MAX(v, 0x140);
    v = fmaxf(v, __shfl_xor(v, 16)); v = fmaxf(v, __shfl_xor(v, 32));
    return v;
}
__device__ __forceinline__ float sigmoid_div_(float x) { return 1.f / (1.f + __expf(-x)); }
__device__ __forceinline__ float sigmoidf_(float x) { return __builtin_amdgcn_rcpf(1.f + __expf(-x)); }
__device__ __forceinline__ float softplusf_(float x) { return x > 20.f ? x : __logf(1.f + __expf(x)); }
__device__ __forceinline__ float tanhf_(float x) { const float e = __expf(-2.f * fabsf(x)); const float t = (1.f - e) * __builtin_amdgcn_rcpf(1.f + e); return x < 0.f ? -t : t; }
__device__ __forceinline__ float siluf_(float x) { return x * __builtin_amdgcn_rcpf(1.f + __expf(-x)); }

struct Args { const float* in[35]; float* out; unsigned char* ws; int ph_lo, ph_hi; };
enum { I_X = 0, I_WIN, I_CMU, I_CW0, I_CW2, I_CA0, I_CA2, I_CG2, I_CKK, I_CKA, I_CRK, I_CGNW, I_CGNB, I_CV0, I_CV1, I_CV2, I_DCW, I_DCB, I_DDTB, I_DALOG, I_DSKIP, I_DNW,
       I_WBR, I_WOUT, I_LN1G, I_LN1B, I_RG, I_RGB, I_RE, I_REB, I_EG, I_EU, I_ED, I_LN2G, I_LN2B };

__device__ __forceinline__ void transpose_item(const float* W, int ldn, int c0, int ncols, bf16* dst, int dld, int r0, int dk0, int kb, int nb, LAS float* scr, int lane) {
    const int k0 = 64 * kb, n0 = 32 * nb;
    const bool okn = (n0 + (lane & 31)) < ncols;
    float tv[32];
#pragma unroll
    for (int i = 0; i < 32; ++i) { const int kk = 2 * i + (lane >> 5); tv[i] = okn ? W[(size_t)(k0 + kk) * ldn + c0 + n0 + (lane & 31)] : 0.f; }
#pragma unroll
    for (int i = 0; i < 32; ++i) { const int kk = 2 * i + (lane >> 5); scr[kk * 33 + (lane & 31)] = tv[i]; }
    asm volatile("s_waitcnt lgkmcnt(0)" ::: "memory");
    const int c = lane & 7;
#pragma unroll
    for (int j = 0; j < 4; ++j) { const int n = (lane >> 3) + 8 * j; const LAS float* s = scr + (8 * c) * 33 + n;
        u32x4 o; o.x = pk2(s[0 * 33], s[1 * 33]); o.y = pk2(s[2 * 33], s[3 * 33]); o.z = pk2(s[4 * 33], s[5 * 33]); o.w = pk2(s[6 * 33], s[7 * 33]);
        if (n0 + n < ncols) *(u32x4*)(dst + (size_t)(r0 + n0 + n) * dld + dk0 + k0 + 8 * c) = o; }
    asm volatile("s_waitcnt lgkmcnt(0)" ::: "memory");
}

struct EpiStoreBf16 {
    static constexpr bool PERM = true;
    bf16* O; int ldc; int act; int ncols;
    __device__ __forceinline__ void operator()(const pg8::f32x4 (&acc)[2][2][4][2], const pg8::Unit& u, int wr, int wc, int fr, int fq) const {
        pg8::epi_mfma_settle(acc);
        const int row0 = u.pm * 256 + wr * 64 + fr; const int col0 = u.pn * 256 + wc * 32 + 8 * fq;
#pragma unroll
        for (int ai = 0; ai < 2; ++ai)
#pragma unroll
            for (int m = 0; m < 4; ++m) { bf16* rowp = O + (size_t)(row0 + ai * 128 + m * 16) * ldc + col0;
#pragma unroll
                for (int bj = 0; bj < 2; ++bj) { pg8::f32x4 v0 = acc[ai][bj][m][0], v1 = acc[ai][bj][m][1];
                    if (act == 1) {
#pragma unroll
                        for (int j = 0; j < 4; ++j) { v0[j] = sigmoidf_(v0[j]); v1[j] = sigmoidf_(v1[j]); } }
                    u32x4 w; w.x = pg8::cvt_pk_bf16(v0[0], v0[1]); w.y = pg8::cvt_pk_bf16(v0[2], v0[3]); w.z = pg8::cvt_pk_bf16(v1[0], v1[1]); w.w = pg8::cvt_pk_bf16(v1[2], v1[3]);
                    if (col0 + bj * 128 < ncols) *(u32x4*)(rowp + bj * 128) = w; } }
    }
};
struct EpiBranch {
    static constexpr bool PERM = true;
    const bf16* GS; bf16* MG;
    __device__ __forceinline__ void operator()(const pg8::f32x4 (&acc)[2][2][4][2], const pg8::Unit& u, int wr, int wc, int fr, int fq) const {
        pg8::epi_mfma_settle(acc);
        const int n = u.aux;
        const bf16* gbase = GS + (size_t)(u.pm * 256 + wr * 64 + fr) * 4096 + n * 1024 + u.pn * 256 + wc * 32 + 8 * fq;
        bf16* mbase = MG + (size_t)(u.pm * 256 + wr * 64 + fr) * 1024 + u.pn * 256 + wc * 32 + 8 * fq;
#pragma unroll
        for (int ai = 0; ai < 2; ++ai)
#pragma unroll
            for (int m = 0; m < 4; ++m) {
#pragma unroll
                for (int bj = 0; bj < 2; ++bj) {
                    const u32x4 gv = *(const u32x4*)(gbase + (size_t)(ai * 128 + m * 16) * 4096 + bj * 128);
                    bf16* mp = mbase + (size_t)(ai * 128 + m * 16) * 1024 + bj * 128;
                    u32x4 ov = (u32x4){0u, 0u, 0u, 0u}; if (n != 0) ov = *(const u32x4*)mp;
                    const pg8::f32x4 a0 = acc[ai][bj][m][0], a1 = acc[ai][bj][m][1];
                    u32x4 w;
                    w.x = pg8::cvt_pk_bf16(a0[0] * __uint_as_float(gv.x << 16) + __uint_as_float(ov.x << 16), a0[1] * __uint_as_float(gv.x & 0xffff0000u) + __uint_as_float(ov.x & 0xffff0000u));
                    w.y = pg8::cvt_pk_bf16(a0[2] * __uint_as_float(gv.y << 16) + __uint_as_float(ov.y << 16), a0[3] * __uint_as_float(gv.y & 0xffff0000u) + __uint_as_float(ov.y & 0xffff0000u));
                    w.z = pg8::cvt_pk_bf16(a1[0] * __uint_as_float(gv.z << 16) + __uint_as_float(ov.z << 16), a1[1] * __uint_as_float(gv.z & 0xffff0000u) + __uint_as_float(ov.z & 0xffff0000u));
                    w.w = pg8::cvt_pk_bf16(a1[2] * __uint_as_float(gv.w << 16) + __uint_as_float(ov.w << 16), a1[3] * __uint_as_float(gv.w & 0xffff0000u) + __uint_as_float(ov.w & 0xffff0000u));
                    *(u32x4*)mp = w; asm volatile("" ::: "memory"); } }
    }
};
struct EpiResid {
    static constexpr bool PERM = false;
    float* X;
    __device__ __forceinline__ void operator()(const pg8::f32x4 (&acc)[2][2][4][2], const pg8::Unit& u, int wr, int wc, int fr, int fq) const {
        pg8::epi_mfma_settle(acc);
        const int row0 = u.pm * 256 + wr * 64 + fr, col0 = u.pn * 256 + wc * 32 + 4 * fq;
#pragma unroll
        for (int ai = 0; ai < 2; ++ai)
#pragma unroll
            for (int m = 0; m < 4; ++m) { float* rowp = X + (size_t)(row0 + ai * 128 + m * 16) * D + col0;
#pragma unroll
                for (int bj = 0; bj < 2; ++bj)
#pragma unroll
                    for (int n = 0; n < 2; ++n) { pg8::f32x4* p = (pg8::f32x4*)(rowp + bj * 128 + n * 16); *p = *p * ALPHA + acc[ai][bj][m][n]; } }
    }
};
struct EpiSwiglu {
    static constexpr bool PERM = true;
    bf16* H;
    __device__ __forceinline__ void operator()(const pg8::f32x4 (&acc)[2][2][4][2], const pg8::Unit& u, int wr, int wc, int fr, int fq) const {
        pg8::epi_mfma_settle(acc);
        const int row0 = u.pm * 256 + wr * 64 + fr; const int col0 = u.pn * 128 + wc * 32 + 8 * fq;
#pragma unroll
        for (int ai = 0; ai < 2; ++ai)
#pragma unroll
            for (int m = 0; m < 4; ++m) { bf16* rowp = H + (size_t)(row0 + ai * 128 + m * 16) * DEXP + col0;
                float v[8];
#pragma unroll
                for (int j = 0; j < 4; ++j) { v[j] = siluf_(acc[ai][0][m][0][j]) * acc[ai][1][m][0][j]; v[4 + j] = siluf_(acc[ai][0][m][1][j]) * acc[ai][1][m][1][j]; }
                u32x4 w; w.x = pg8::cvt_pk_bf16(v[0], v[1]); w.y = pg8::cvt_pk_bf16(v[2], v[3]); w.z = pg8::cvt_pk_bf16(v[4], v[5]); w.w = pg8::cvt_pk_bf16(v[6], v[7]);
                *(u32x4*)rowp = w; }
    }
};

struct SkewOrder {
    int nM, nN, nwg, c, lda, ldb;
    __device__ bool next(int i, pg8::Unit& u) const {
        long L;
        if (i < 5) L = (long)i * 256 + c; else { if (c < 32) return false; L = 1280 + (long)(i - 5) * 224 + (c - 32); }
        if (L >= nwg) return false;
        pg8::tile_of((int)L, nM, nN, u.pm, u.pn); u.aux = 0;
        u.aoff = (size_t)u.pm * 256 * lda * 2; u.boff = (size_t)u.pn * 256 * ldb * 2; return true;
    }
};
struct BranchOrder {
    int nM, nN, G, c;
    __device__ bool next(int i, pg8::Unit& u) const {
        const int tl = (i >> 2) * G + c; if (tl >= nM * nN) return false;
        pg8::tile_of(tl, nM, nN, u.pm, u.pn); u.aux = i & 3;
        u.aoff = ((size_t)u.pm * 256 * 1024 + (size_t)u.aux * 256) * 2; u.boff = ((size_t)u.pn * 256 * 1024 + (size_t)u.aux * 256) * 2; return true;
    }
};
struct MoeOrder {
    const volatile LAS int* tb; int G, c; size_t a_rowbytes, b_expbytes, b_tilebytes;
    __device__ bool next(int i, pg8::Unit& u) const {
        const int L = i * G + c; const int total = __builtin_amdgcn_readfirstlane(tb[32]) * 4; if (L >= total) return false;
        int e = 0;
#pragma unroll 1
        for (int k = 0; k < 32; ++k) if (L >= tb[k + 1] * 4) e = k + 1;
        const int nte = tb[e + 1] - tb[e]; const int r = L - tb[e] * 4; const int ct = r / nte, rt = r % nte;
        u.pm = __builtin_amdgcn_readfirstlane(tb[33 + e] + rt); u.pn = __builtin_amdgcn_readfirstlane(ct); u.aux = __builtin_amdgcn_readfirstlane(e);
        u.aoff = (size_t)u.pm * 256 * a_rowbytes; u.boff = (size_t)u.aux * b_expbytes + (size_t)u.pn * b_tilebytes; return true;
    }
};

constexpr int PTR_OFF = LDS_BYTES - 512;
__device__ __forceinline__ void ptr_table_fill(const Args& args, LAS unsigned char* lds) {
    if (threadIdx.x == 0) {
        volatile LAS unsigned long long* t = (volatile LAS unsigned long long*)(lds + PTR_OFF);
#define PT_(i) t[i] = (unsigned long long)args.in[i];
        PT_(0) PT_(1) PT_(2) PT_(3) PT_(4) PT_(5) PT_(6) PT_(7) PT_(8) PT_(9) PT_(10) PT_(11) PT_(12) PT_(13) PT_(14) PT_(15) PT_(16) PT_(17) PT_(18) PT_(19)
        PT_(20) PT_(21) PT_(22) PT_(23) PT_(24) PT_(25) PT_(26) PT_(27) PT_(28) PT_(29) PT_(30) PT_(31) PT_(32) PT_(33) PT_(34)
#undef PT_
        t[35] = (unsigned long long)args.out; t[36] = (unsigned long long)args.ws; t[37] = (unsigned long long)(unsigned)args.ph_lo;
    }
    __syncthreads();
}
__device__ __forceinline__ unsigned long long ldptr(LAS unsigned char* lds, int i) {
    unsigned a = (unsigned)(PTR_OFF + 8 * i); asm volatile("" : "+v"(a));
    const volatile LAS unsigned* t = (const volatile LAS unsigned*)(lds + a);
    const unsigned lo = __builtin_amdgcn_readfirstlane(t[0]), hi = __builtin_amdgcn_readfirstlane(t[1]);
    return ((unsigned long long)hi << 32) | lo;
}
__device__ __forceinline__ void* gptr(unsigned long long v) { return (void*)(__attribute__((address_space(1))) void*)v; }
#define INP(i) ((const float*)gptr(ldptr(lds, (i))))
namespace rw {
typedef short bf16x8 __attribute__((ext_vector_type(8)));
typedef float f4 __attribute__((ext_vector_type(4)));
constexpr int LS = 72;
constexpr int MB = 64 * LS * 2;
constexpr int O_AHN = 0, O_RHN = MB, O_BCN = 2 * MB, O_KCN = 3 * MB, O_AHT = 4 * MB, O_BTT = 5 * MB, O_KTT = 6 * MB, O_VT = 7 * MB, O_STT = 8 * MB,
              O_MAK = 9 * MB, O_MRB = 10 * MB, O_MRK = 11 * MB, O_TINV = 12 * MB, O_MABF = 13 * MB, O_GAM = 13 * MB + 16384, O_CT = O_GAM + 256, O_BON = O_CT + 4608, O_END = O_BON + 256;
constexpr int O_MVT = O_BCN, O_A2N = O_AHN, O_UT = O_KCN, O_YF = O_AHT;
constexpr int O_TAB = O_MAK, O_SCR = O_TAB + 26624, O_TOT = O_SCR + 8 * 1024, O_CUM = O_TOT + 2048;
static_assert(O_CUM + 16384 <= O_GAM && O_END <= LDS_BYTES - 576, "rwkv LDS map");

__device__ __forceinline__ bf16x8 ldfrag(const LAS unsigned char* lds, int off, int r0, int ks, int lane) {
    return *(const LAS bf16x8*)(lds + off + ((r0 + (lane & 15)) * LS + ks * 32 + (lane >> 4) * 8) * 2);
}
__device__ __forceinline__ void mm64(f4 (&acc)[2], const LAS unsigned char* lds, int offA, int offBt, int w, int lane) {
    const int tr = w >> 1; const bf16x8 a0 = ldfrag(lds, offA, tr * 16, 0, lane), a1 = ldfrag(lds, offA, tr * 16, 1, lane);
#pragma unroll
    for (int c = 0; c < 2; ++c) { const int tc = (w & 1) * 2 + c; const bf16x8 b0 = ldfrag(lds, offBt, tc * 16, 0, lane), b1 = ldfrag(lds, offBt, tc * 16, 1, lane);
        acc[c] = __builtin_amdgcn_mfma_f32_16x16x32_bf16(a0, b0, acc[c], 0, 0, 0); acc[c] = __builtin_amdgcn_mfma_f32_16x16x32_bf16(a1, b1, acc[c], 0, 0, 0); }
}
__device__ __forceinline__ void storeT(LAS unsigned char* lds, int off, const f4 (&acc)[2], int w, int lane) {
    asm volatile("s_nop 11" :: "v"(acc[0]), "v"(acc[1]));
#pragma unroll
    for (int c = 0; c < 2; ++c) { const int col = ((w & 1) * 2 + c) * 16 + (lane & 15), row = (w >> 1) * 16 + 4 * (lane >> 4);
        u32x2 v; v.x = pk2(acc[c][0], acc[c][1]); v.y = pk2(acc[c][2], acc[c][3]); *(LAS u32x2*)(lds + off + (col * LS + row) * 2) = v; }
}
template <int MASK  >
__device__ __forceinline__ void storeN(LAS unsigned char* lds, int off, const f4 (&acc)[2], int w, int lane) {
    asm volatile("s_nop 11" :: "v"(acc[0]), "v"(acc[1]));
#pragma unroll
    for (int c = 0; c < 2; ++c) { const int col = ((w & 1) * 2 + c) * 16 + (lane & 15), row = (w >> 1) * 16 + 4 * (lane >> 4);
#pragma unroll
        for (int e = 0; e < 4; ++e) { float x = acc[c][e]; if (MASK == 1) x = (col < row + e) ? x : 0.f; if (MASK == 2) x = (col <= row + e) ? x : 0.f;
            *(LAS bf16*)(lds + off + ((row + e) * LS + col) * 2) = (bf16)f2bf(x); } }
}
typedef __bf16 bf2v __attribute__((ext_vector_type(2)));
__device__ __forceinline__ float dot2(unsigned x, unsigned y, float c) { return __builtin_amdgcn_fdot2_f32_bf16(__builtin_bit_cast(bf2v, x), __builtin_bit_cast(bf2v, y), c, false); }
#define RW_ZERO(a) do { a[0] = (f4){0.f, 0.f, 0.f, 0.f}; a[1] = (f4){0.f, 0.f, 0.f, 0.f}; } while (0)

__device__ __forceinline__ void build_ct(LAS unsigned char* lds0, const int l, const int h, const int lane, const int wave) {
    LAS unsigned char* const& lds = lds0; const int c = h * 64 + lane;
    const float* mu = INP(I_CMU) + (size_t)l * 896;
    if (wave == 0) { LAS float* ct = (LAS float*)(lds0 + O_CT);
        ct[0 * 64 + lane] = mu[c]; ct[1 * 64 + lane] = mu[256 + c]; ct[2 * 64 + lane] = mu[512 + c]; ct[3 * 64 + lane] = mu[768 + lane]; ct[4 * 64 + lane] = mu[832 + lane];
        ct[5 * 64 + lane] = INP(I_CW0)[l * 256 + c]; ct[6 * 64 + lane] = INP(I_CA0)[l * 256 + c]; ct[7 * 64 + lane] = INP(I_CKK)[l * 256 + c]; ct[8 * 64 + lane] = INP(I_CKA)[l * 256 + c];
        ct[9 * 64 + lane] = INP(I_CRK)[l * 256 + c]; ct[10 * 64 + lane] = INP(I_CGNW)[l * 256 + c]; ct[11 * 64 + lane] = INP(I_CGNB)[l * 256 + c]; ct[12 * 64 + lane] = l > 0 ? INP(I_CV0)[(l - 1) * 256 + c] : 0.f;
        ct[13 * 64 + lane] = mu[512 + lane]; ct[14 * 64 + lane] = mu[512 + lane + 64]; ct[15 * 64 + lane] = mu[512 + lane + 128]; ct[16 * 64 + lane] = mu[512 + lane + 192]; }
}
template <int MODE>
__device__ __forceinline__ void chunk(LAS unsigned char* lds0, const int l, const int b, const int h, const int t0, unsigned char* gz, unsigned char* gz2, float* bong, const bf16* P, bf16* VF, bf16* OB, const int tid0) {
    const int c = h * 64 + (tid0 & 63);
    {
        unsigned lb_ = 0u; int tid_l = tid0; asm volatile("" : "+v"(lb_), "+v"(tid_l));
        const int tid = tid_l, lane = tid & 63, wave = __builtin_amdgcn_readfirstlane(tid >> 6);
        LAS unsigned char* lds = lds0 + lb_;
        LAS bf16* TAB = (LAS bf16*)(lds + O_TAB); const LAS unsigned* TABW = (const LAS unsigned*)(lds + O_TAB);
        LAS bf16* scr = (LAS bf16*)(lds + O_SCR + wave * 1024);
        LAS float* CUM = (LAS float*)(lds + O_CUM);
        LAS float* TOT = (LAS float*)(lds + O_TOT);
        LAS float* GAM = (LAS float*)(lds + O_GAM);
        LAS float* MABF = (LAS float*)(lds + O_MABF);
        LAS float* YF = (LAS float*)(lds + O_YF);
        LAS float* BON = (LAS float*)(lds + O_BON);
        const LAS float* CT = (const LAS float*)(lds + O_CT);
#define CTV(k) CT[(k) * 64 + lane]
        LAS float* ASF = (LAS float*)(lds + O_TAB);
        LAS bf16* GSF = (LAS bf16*)(lds + O_STT);
        float Xr[9], Xg[9]; unsigned RK[9], VX[9], Va[9], Vb[9];
        { const float* cw2 = INP(I_CW2) + (size_t)l * 32 * 256; const float* ca2 = INP(I_CA2) + (size_t)l * 32 * 256; const float* cg2 = INP(I_CG2) + (size_t)l * 64 * 256;
          float twa[8], tg[8];
#pragma unroll
          for (int u = 0; u < 8; ++u) { const int i = tid + u * NTHR, mm = i >> 6, cc = i & 63;
              twa[u] = mm < 32 ? cw2[mm * 256 + h * 64 + cc] : ca2[(mm - 32) * 256 + h * 64 + cc]; tg[u] = cg2[mm * 256 + h * 64 + cc]; }
          float t2[2], t1[8];
          if (l > 0) { const float* cv1 = INP(I_CV1) + (size_t)(l - 1) * 256 * 16; const float* cv2 = INP(I_CV2) + (size_t)(l - 1) * 16 * 256;
#pragma unroll
            for (int u = 0; u < 2; ++u) { const int i = tid + u * NTHR; t2[u] = cv2[(i >> 6) * 256 + h * 64 + (i & 63)]; }
#pragma unroll
            for (int u = 0; u < 8; ++u) t1[u] = cv1[tid + u * NTHR]; }
#pragma unroll
          for (int j = 0; j < 9; ++j) { const int t = t0 + wave * 8 - 1 + j; const bool ok_ = t >= 0; const size_t m_ = (size_t)b * T + (ok_ ? t : 0); const bf16* row_ = P + m_ * PP + C_C;
              Xr[j] = ok_ ? bf2f(row_[768 + lane]) : 0.f; Xg[j] = ok_ ? bf2f(row_[832 + lane]) : 0.f;
              RK[j] = ok_ ? ((unsigned)row_[c] | ((unsigned)row_[256 + c] << 16)) : 0u; VX[j] = ok_ ? (unsigned)row_[512 + c] : 0u;
              if (l > 0) { Va[j] = ok_ ? ((unsigned)row_[512 + lane] | ((unsigned)row_[512 + lane + 64] << 16)) : 0u; Vb[j] = ok_ ? ((unsigned)row_[512 + lane + 128] | ((unsigned)row_[512 + lane + 192] << 16)) : 0u;
                  if (j > 0) VX[j] |= (unsigned)VF[m_ * 256 + c] << 16; } }
#pragma unroll
          for (int u = 0; u < 8; ++u) { const int i = tid + u * NTHR, mm = i >> 6, cc = i & 63;
              *(LAS bf16*)(lds + O_BCN + (cc * LS + mm) * 2) = (bf16)f2bf(twa[u]); *(LAS bf16*)(lds + O_KCN + (cc * LS + mm) * 2) = (bf16)f2bf(tg[u]); }
#define PIX(i) ((((i) >> 7) * 64 + ((i) & 63)) * 2 + (((i) >> 6) & 1))
          if (l > 0) {
#pragma unroll
            for (int u = 0; u < 2; ++u) { const int i = tid + u * NTHR; TAB[8192 + PIX(i)] = (bf16)f2bf(t2[u]); }
#pragma unroll
            for (int u = 0; u < 8; ++u) { const int i = tid + u * NTHR; const int cc = i >> 4, qq = i & 15; TAB[9216 + ((cc >> 1) * 16 + qq) * 2 + (cc & 1)] = (bf16)f2bf(t1[u]); } } }
#undef PIX
        {
#pragma unroll
          for (int q = 0; q < 8; ++q) { const int tt = wave * 8 + q;
              const float xx = Xr[q + 1] + (Xr[q] - Xr[q + 1]) * CTV(3), xg = Xg[q + 1] + (Xg[q] - Xg[q + 1]) * CTV(4);
              *(LAS bf16*)(lds + O_AHN + (tt * LS + lane) * 2) = (bf16)f2bf(lane < 32 ? tanhf_(xx) : xx);
              *(LAS bf16*)(lds + O_RHN + (tt * LS + lane) * 2) = (bf16)f2bf(sigmoidf_(xg)); } }
        __syncthreads();
        { const int tr = wave >> 1;
          const bf16x8 a0 = ldfrag(lds, O_AHN, tr * 16, 0, lane), a1 = ldfrag(lds, O_AHN, tr * 16, 1, lane), g0 = ldfrag(lds, O_RHN, tr * 16, 0, lane), g1 = ldfrag(lds, O_RHN, tr * 16, 1, lane);
#pragma unroll
          for (int cI = 0; cI < 2; ++cI) { const int tc = (wave & 1) * 2 + cI;
              const bf16x8 b0 = ldfrag(lds, O_BCN, tc * 16, 0, lane), b1 = ldfrag(lds, O_BCN, tc * 16, 1, lane), c0 = ldfrag(lds, O_KCN, tc * 16, 0, lane), c1 = ldfrag(lds, O_KCN, tc * 16, 1, lane);
              const f4 z = (f4){0.f, 0.f, 0.f, 0.f};
              const f4 aw = __builtin_amdgcn_mfma_f32_16x16x32_bf16(a0, b0, z, 0, 0, 0), aa = __builtin_amdgcn_mfma_f32_16x16x32_bf16(a1, b1, z, 0, 0, 0);
              f4 ag = __builtin_amdgcn_mfma_f32_16x16x32_bf16(g0, c0, z, 0, 0, 0); ag = __builtin_amdgcn_mfma_f32_16x16x32_bf16(g1, c1, ag, 0, 0, 0);
              const int col = tc * 16 + (lane & 15), row = tr * 16 + 4 * (lane >> 4);
#pragma unroll
              for (int e = 0; e < 4; ++e) { CUM[(row + e) * 64 + col] = aw[e]; ASF[(row + e) * 64 + col] = aa[e]; GSF[(row + e) * 64 + col] = (bf16)f2bf(ag[e]); } } }
        __syncthreads();
        { float run = 0.f;
#pragma unroll
            for (int q = 0; q < 8; ++q) { const int tt = wave * 8 + q;
                const float wsum = CTV(5) + CUM[tt * 64 + lane];
                run += -0.6065306597f * sigmoidf_(wsum); CUM[tt * 64 + lane] = run; }
            TOT[wave * 64 + lane] = run; }
        __syncthreads();
        float offs = 0.f, cumL = 0.f;
#pragma unroll
        for (int w2 = 0; w2 < 8; ++w2) { const float tw = TOT[w2 * 64 + lane]; offs += (w2 < wave) ? tw : 0.f; cumL += tw; }
        if (wave == 0) GAM[lane] = __expf(cumL);
#define LO_(x) __uint_as_float((x) << 16)
#define HI_(x) __uint_as_float((x) & 0xffff0000u)
#pragma unroll
        for (int q = 0; q < 8; ++q) {
            const int tt = wave * 8 + q; const size_t m = (size_t)b * T + t0 + tt;
            const unsigned pRK = RK[q], cRK = RK[q + 1], pVX = VX[q], cVX = VX[q + 1], pVa = Va[q], cVa = Va[q + 1], pVb = Vb[q], cVb = Vb[q + 1];
            const float r = LO_(cRK) + (LO_(pRK) - LO_(cRK)) * CTV(0), k = HI_(cRK) + (HI_(pRK) - HI_(cRK)) * CTV(1); float v = LO_(cVX) + (LO_(pVX) - LO_(cVX)) * CTV(2);
            const float asum = CTV(6) + ASF[tt * 64 + lane]; const unsigned gbits = (unsigned)GSF[tt * 64 + lane];
            const float cq = CUM[tt * 64 + lane], cprev = q > 0 ? CUM[(tt - 1) * 64 + lane] : 0.f;
            if (l > 0) {
                LAS bf16* vsc = scr + 128;
                vsc[lane] = (bf16)f2bf(LO_(cVa) + (LO_(pVa) - LO_(cVa)) * CTV(13)); vsc[lane + 64] = (bf16)f2bf(HI_(cVa) + (HI_(pVa) - HI_(cVa)) * CTV(14));
                vsc[lane + 128] = (bf16)f2bf(LO_(cVb) + (LO_(pVb) - LO_(cVb)) * CTV(15)); vsc[lane + 192] = (bf16)f2bf(HI_(cVb) + (HI_(pVb) - HI_(cVb)) * CTV(16));
                asm volatile("s_waitcnt lgkmcnt(0)" ::: "memory");
                const int qq = lane & 15, part = lane >> 4; float s = 0.f; { float s1 = 0.f; const LAS unsigned* sv = (const LAS unsigned*)vsc;
#pragma unroll
                for (int p = 0; p < 32; p += 2) { s = dot2(sv[part * 32 + p], TABW[4608 + (part * 32 + p) * 16 + qq], s); s1 = dot2(sv[part * 32 + p + 1], TABW[4608 + (part * 32 + p + 1) * 16 + qq], s1); }
                s += s1; }
                s += __shfl_xor(s, 16); s += __shfl_xor(s, 32);
                float vl = CTV(12);
#pragma unroll
                for (int q2 = 0; q2 < 16; ++q2) vl += __shfl(s, q2) * bf2f(TAB[8192 + ((q2 >> 1) * 64 + lane) * 2 + (q2 & 1)]);
                const float vf = HI_(cVX); v = v + (vf - v) * sigmoidf_(vl);
            }
            if (MODE < 5) VF[m * 256 + c] = (bf16)f2bf(v);
            const float asig = sigmoidf_(asum), lw = cq - cprev;
            float kk = k * CTV(7); const float n2 = wave_sum(kk * kk); kk = kk * __builtin_amdgcn_rsqf(fmaxf(n2, 1e-24f));
            const float kmod = k * (1.f + (asig - 1.f) * CTV(8));
            const float bon = wave_sum(r * kmod * CTV(9));
            const float cum = offs + cq, cumx = cum - lw;
            const float ah = -kk * __expf(cumx), rh = r * __expf(cum), ei = __expf(-cum), bb = kk * asig, bc = bb * ei, kc = kmod * ei, ee = __expf(cumL - cum), bt = bb * ee, kt = kmod * ee;
            const int no = (tt * LS + lane) * 2, to = (lane * LS + tt) * 2;
            *(LAS bf16*)(lds + O_AHN + no) = (bf16)f2bf(ah); *(LAS bf16*)(lds + O_RHN + no) = (bf16)f2bf(rh);
            *(LAS bf16*)(lds + O_BCN + no) = (bf16)f2bf(bc); *(LAS bf16*)(lds + O_KCN + no) = (bf16)f2bf(kc); if (MODE < 5) ((bf16*)(gz2 + 16384))[tt * 64 + lane] = (bf16)gbits;
            *(LAS bf16*)(lds + O_AHT + to) = (bf16)f2bf(ah); *(LAS bf16*)(lds + O_BTT + to) = (bf16)f2bf(bt);
            *(LAS bf16*)(lds + O_KTT + to) = (bf16)f2bf(kt); *(LAS bf16*)(lds + O_VT + to) = (bf16)f2bf(v);
            if (MODE < 5 && lane == 0) bong[tt] = bon;
            asm volatile("s_waitcnt lgkmcnt(0)" ::: "memory");
        }
        __syncthreads();
        if (MODE == 6) return;
        { f4 acc[2];
            RW_ZERO(acc); mm64(acc, lds, O_AHN, O_BCN, wave, lane);
#pragma unroll
            for (int cI = 0; cI < 2; ++cI) { const int col = ((wave & 1) * 2 + cI) * 16 + (lane & 15), row = (wave >> 1) * 16 + 4 * (lane >> 4);
#pragma unroll
                for (int e = 0; e < 4; ++e) MABF[(row + e) * 64 + col] = (col < row + e) ? acc[cI][e] : 0.f; }
            RW_ZERO(acc); mm64(acc, lds, O_AHN, O_KCN, wave, lane); storeN<1>(lds, O_MAK, acc, wave, lane);
            { f4 accb[2]; RW_ZERO(accb); mm64(accb, lds, O_RHN, O_BCN, wave, lane); f4 accc[2]; RW_ZERO(accc); mm64(accc, lds, O_RHN, O_KCN, wave, lane);
                storeN<2>(lds, O_MRB, accb, wave, lane); storeN<2>(lds, O_MRK, accc, wave, lane); }
        }
        __syncthreads();
        {
            const int cS = wave * 8 + (lane >> 3), tS = lane & 7;
            float xs[8];
#pragma unroll
            for (int k = 0; k < 8; ++k) xs[k] = 0.f;
#pragma unroll
            for (int i = 1; i < 64; ++i) {
                float part = 0.f;
#pragma unroll
                for (int k = 0; k < (i + 7) / 8; ++k) { const float mv = MABF[i * 64 + tS + 8 * k]; part += ((tS + 8 * k) < i ? mv : 0.f) * xs[k]; }
                part += __builtin_bit_cast(float, __builtin_amdgcn_update_dpp(0, __builtin_bit_cast(int, part), 0xB1, 0xF, 0xF, true));
                part += __builtin_bit_cast(float, __builtin_amdgcn_update_dpp(0, __builtin_bit_cast(int, part), 0x4E, 0xF, 0xF, true));
                part += __builtin_bit_cast(float, __builtin_amdgcn_update_dpp(0, __builtin_bit_cast(int, part), 0x141, 0xF, 0xF, true));
                const float xi = MABF[i * 64 + cS] + part;
                xs[i >> 3] = (tS == (i & 7)) ? xi : xs[i >> 3];
            }
#pragma unroll
            for (int k = 0; k < 8; ++k) { const int i = tS + 8 * k; *(LAS bf16*)(lds + O_TINV + (i * LS + cS) * 2) = (bf16)f2bf(i == cS ? 1.f : xs[k]); }
        }
        __syncthreads();
        { f4 acc[2]; RW_ZERO(acc); mm64(acc, lds, O_MAK, O_VT, wave, lane); storeT(lds, O_MVT, acc, wave, lane); }
        __syncthreads();
        if (MODE == 1 || MODE == 5) {
            { f4 acc[2]; RW_ZERO(acc); mm64(acc, lds, O_TINV, O_AHT, wave, lane); storeT(lds, O_UT, acc, wave, lane); }
            { f4 acc[2]; RW_ZERO(acc); mm64(acc, lds, O_TINV, O_MVT, wave, lane); storeT(lds, O_MAK, acc, wave, lane); }
            __syncthreads();
            f4 agm[2], azm[2], ar2[2], ay0[2];
            RW_ZERO(agm); mm64(agm, lds, O_BTT, O_UT, wave, lane);
#pragma unroll
            for (int cI = 0; cI < 2; ++cI) { const int col = ((wave & 1) * 2 + cI) * 16 + (lane & 15), row = (wave >> 1) * 16 + 4 * (lane >> 4);
#pragma unroll
                for (int e = 0; e < 4; ++e) if (col == row + e) agm[cI][e] += GAM[col]; }
            RW_ZERO(azm); mm64(azm, lds, O_BTT, O_MAK, wave, lane); mm64(azm, lds, O_KTT, O_VT, wave, lane);
            RW_ZERO(ar2); mm64(ar2, lds, O_MRB, O_UT, wave, lane);
#pragma unroll
            for (int cI = 0; cI < 2; ++cI) { const int col = ((wave & 1) * 2 + cI) * 16 + (lane & 15), row = (wave >> 1) * 16 + 4 * (lane >> 4);
#pragma unroll
                for (int e = 0; e < 4; ++e) ar2[cI][e] += bf2f(*(const LAS bf16*)(lds + O_RHN + ((row + e) * LS + col) * 2)); }
            RW_ZERO(ay0); mm64(ay0, lds, O_MRB, O_MAK, wave, lane); mm64(ay0, lds, O_MRK, O_VT, wave, lane);
            __syncthreads();
            storeN<0>(lds, O_AHN, agm, wave, lane); storeT(lds, O_RHN, azm, wave, lane); storeN<0>(lds, O_BCN, ar2, wave, lane); storeT(lds, O_KCN, ay0, wave, lane);
            __syncthreads();
            if (MODE == 1) { const int io = ((tid >> 3) * LS + (tid & 7) * 8) * 2;
              ((u32x4*)gz)[tid] = *(const LAS u32x4*)(lds + O_AHN + io); ((u32x4*)(gz + 8192))[tid] = *(const LAS u32x4*)(lds + O_RHN + io);
              ((u32x4*)gz2)[tid] = *(const LAS u32x4*)(lds + O_BCN + io); ((u32x4*)(gz2 + 8192))[tid] = *(const LAS u32x4*)(lds + O_KCN + io); }
        } else {
            { f4 acc[2]; RW_ZERO(acc); mm64(acc, lds, O_TINV, O_AHT, wave, lane); storeN<0>(lds, O_A2N, acc, wave, lane); }
            __syncthreads();
            { f4 acc[2]; RW_ZERO(acc); mm64(acc, lds, O_TINV, O_MVT, wave, lane); mm64(acc, lds, O_A2N, O_STT, wave, lane); storeT(lds, O_UT, acc, wave, lane); }
            __syncthreads();
            f4 yacc[2]; RW_ZERO(yacc);
            mm64(yacc, lds, O_RHN, O_STT, wave, lane); mm64(yacc, lds, O_MRB, O_UT, wave, lane); mm64(yacc, lds, O_MRK, O_VT, wave, lane);
            __syncthreads();
#pragma unroll
            for (int cI = 0; cI < 2; ++cI) { const int col = ((wave & 1) * 2 + cI) * 16 + (lane & 15), row = (wave >> 1) * 16 + 4 * (lane >> 4);
#pragma unroll
                for (int e = 0; e < 4; ++e) YF[(row + e) * 64 + col] = yacc[cI][e]; }
            __syncthreads();
            { unsigned gcur = (unsigned)OB[((size_t)b * T + t0 + wave * 8) * 1024 + 512 + c];
#pragma unroll 1
            for (int q = 0; q < 8; ++q) {
                const int tt = wave * 8 + q; const size_t m = (size_t)b * T + t0 + tt;
                const unsigned gnxt = (unsigned)OB[(m + (q < 7 ? 1 : 0)) * 1024 + 512 + c];
                const float y = YF[tt * 64 + lane]; const float mean = wave_sum(y) * (1.f / 64.f); const float dy = y - mean; const float var = wave_sum(dy * dy) * (1.f / 64.f);
                const float yn = dy * rsqrtf(var + 64e-5f) * CTV(10) + CTV(11);
                const float vv = bf2f(*(const LAS bf16*)(lds + O_VT + (lane * LS + tt) * 2)), gg = LO_(gcur);
                OB[m * 1024 + 512 + c] = (bf16)f2bf((yn + BON[tt] * vv) * gg);
                gcur = gnxt;
            } }
        }
        __syncthreads();
#undef CTV
#undef LO_
#undef HI_
    }
}

__device__ __forceinline__ void chunk_out(LAS unsigned char* lds0, const int b, const int h, const int t0, const unsigned char* gz, const unsigned char* gz2, const float* bong, const bf16* VF, bf16* OB, const int tid0) {
    unsigned lb_ = 0u; int tid_l = tid0; asm volatile("" : "+v"(lb_), "+v"(tid_l));
    LAS unsigned char* lds = lds0 + lb_; const int tid = tid_l, lane = tid & 63, wave = __builtin_amdgcn_readfirstlane(tid >> 6);
    const int c = h * 64 + lane;
    const LAS float* CT = (const LAS float*)(lds + O_CT);
    LAS float* YF = (LAS float*)(lds + O_YF);
    const int io = ((tid >> 3) * LS + (tid & 7) * 8) * 2;
    const u32x4 sv = ((const u32x4*)gz)[tid], rv = ((const u32x4*)gz2)[tid];
    u32x2 yv[2];
#pragma unroll
    for (int k = 0; k < 2; ++k) { const int col = ((wave & 1) * 2 + k) * 16 + (lane & 15), row = (wave >> 1) * 16 + 4 * (lane >> 4); yv[k] = *(const u32x2*)(gz2 + 8192 + (col * 64 + row) * 2); }
    float gq[8], vq[8], bq[8];
#pragma unroll
    for (int q = 0; q < 8; ++q) { const int tt = wave * 8 + q; const size_t m = (size_t)b * T + t0 + tt;
        gq[q] = bf2f(((const bf16*)(gz2 + 16384))[tt * 64 + lane]); vq[q] = bf2f(VF[m * 256 + c]); bq[q] = bong[tt]; }
    *(LAS u32x4*)(lds + O_STT + io) = sv; *(LAS u32x4*)(lds + O_AHN + io) = rv;
    __syncthreads();
    f4 acc[2];
#pragma unroll
    for (int k = 0; k < 2; ++k) acc[k] = (f4){__uint_as_float(yv[k].x << 16), __uint_as_float(yv[k].x & 0xffff0000u), __uint_as_float(yv[k].y << 16), __uint_as_float(yv[k].y & 0xffff0000u)};
    mm64(acc, lds, O_AHN, O_STT, wave, lane);
#pragma unroll
    for (int cI = 0; cI < 2; ++cI) { const int col = ((wave & 1) * 2 + cI) * 16 + (lane & 15), row = (wave >> 1) * 16 + 4 * (lane >> 4);
#pragma unroll
        for (int e = 0; e < 4; ++e) YF[(row + e) * 64 + col] = acc[cI][e]; }
    __syncthreads();
#pragma unroll
    for (int q = 0; q < 8; ++q) { const int tt = wave * 8 + q; const size_t m = (size_t)b * T + t0 + tt;
        const float y = YF[tt * 64 + lane]; const float mean = wave_sum(y) * (1.f / 64.f); const float dy = y - mean; const float var = wave_sum(dy * dy) * (1.f / 64.f);
        const float yn = dy * rsqrtf(var + 64e-5f) * CT[10 * 64 + lane] + CT[11 * 64 + lane];
        OB[m * 1024 + 512 + c] = (bf16)f2bf((yn + bq[q] * vq[q]) * gq[q]); }
    __syncthreads();
}

__device__ __forceinline__ void carry(LAS unsigned char* lds0, unsigned char* gzc  , const int tid0) {
    f4 stacc[2]; RW_ZERO(stacc);
    { unsigned lb_ = 0u; asm volatile("" : "+v"(lb_)); LAS unsigned char* lds = lds0 + lb_; for (int i = tid0; i < MB / 4; i += NTHR) ((LAS unsigned*)(lds + O_STT))[i] = 0u; }
    u32x4 gnx = ((const u32x4*)gzc)[tid0];
    u32x2 znx[2];
    { const int lane = tid0 & 63, wave = tid0 >> 6;
#pragma unroll
      for (int k = 0; k < 2; ++k) { const int col = ((wave & 1) * 2 + k) * 16 + (lane & 15), row = (wave >> 1) * 16 + 4 * (lane >> 4); znx[k] = *(const u32x2*)(gzc + 8192 + (col * 64 + row) * 2); } }
#pragma unroll 1
    for (int cI = 0; cI < T / 64; ++cI) {
        unsigned lb_ = 0u; int tid_l = tid0; asm volatile("" : "+v"(lb_), "+v"(tid_l));
        LAS unsigned char* lds = lds0 + lb_; const int tid = tid_l, lane = tid & 63, wave = __builtin_amdgcn_readfirstlane(tid >> 6);
        unsigned char* rec = gzc + (size_t)cI * 16384;
        const int io = ((tid >> 3) * LS + (tid & 7) * 8) * 2;
        *(LAS u32x4*)(lds + O_AHN + io) = gnx;
        u32x2 zv[2]; zv[0] = znx[0]; zv[1] = znx[1];
        if (cI + 1 < T / 64) { gnx = ((const u32x4*)(rec + 16384))[tid];
#pragma unroll
            for (int k = 0; k < 2; ++k) { const int col = ((wave & 1) * 2 + k) * 16 + (lane & 15), row = (wave >> 1) * 16 + 4 * (lane >> 4); znx[k] = *(const u32x2*)(rec + 16384 + 8192 + (col * 64 + row) * 2); } }
        __syncthreads();
        ((u32x4*)rec)[tid] = *(const LAS u32x4*)(lds + O_STT + io);
        f4 acc[2];
#pragma unroll
        for (int k = 0; k < 2; ++k) acc[k] = (f4){__uint_as_float(zv[k].x << 16), __uint_as_float(zv[k].x & 0xffff0000u), __uint_as_float(zv[k].y << 16), __uint_as_float(zv[k].y & 0xffff0000u)};
        mm64(acc, lds, O_AHN, O_STT, wave, lane);
        __syncthreads();
        storeT(lds, O_STT, acc, wave, lane);
    }
}
}

namespace mb {
using rw::LS; using rw::MB; using rw::f4; using rw::mm64; using rw::storeN; using rw::bf16x8;
constexpr int O_CN = 0, O_BN = MB, O_BT = 2 * MB, O_XT0 = 3 * MB, O_XW0 = 5 * MB, O_CS0 = 7 * MB, O_HN0 = 9 * MB, O_SC0 = 11 * MB, O_SM = 13 * MB, O_YF = O_XW0;
static_assert(O_SM + 2048 <= LDS_BYTES - 576, "mamba LDS map");
__device__ __forceinline__ void chain(LAS unsigned char* lds0, const int l, const int b, const int gI, const bf16* P, bf16* OB, const int tid0, const int lane0, const int wave0) {
    const int tid = tid0, lane = lane0, wave = wave0;
    LAS unsigned char* const& lds = lds0;
    const float* cwp = INP(I_DCW) + (size_t)l * 4 * 512; const float* cbp = INP(I_DCB) + (size_t)l * 512;
    const int cc = tid & 255, sub = tid >> 8;
    const int col = cc < 128 ? (gI * 128 + cc) : (cc < 192 ? (256 + gI * 64 + (cc - 128)) : (384 + gI * 64 + (cc - 192)));
    const float cw0 = cwp[col], cw1 = cwp[512 + col], cw2 = cwp[1024 + col], cw3 = cwp[1536 + col], cb = cbp[col];
    f4 hacc[2][2];
#pragma unroll
    for (int hh = 0; hh < 2; ++hh) { hacc[hh][0] = (f4){0.f, 0.f, 0.f, 0.f}; hacc[hh][1] = (f4){0.f, 0.f, 0.f, 0.f}; }
    for (int i = tid; i < 2 * MB / 4; i += NTHR) ((LAS unsigned*)(lds0 + O_HN0))[i] = 0u;
    const float dtb0 = INP(I_DDTB)[l * 4 + gI * 2], dtb1 = INP(I_DDTB)[l * 4 + gI * 2 + 1];
    const float nA0 = -__expf(INP(I_DALOG)[l * 4 + gI * 2]), nA1 = -__expf(INP(I_DALOG)[l * 4 + gI * 2 + 1]);
    const float dsk0 = INP(I_DSKIP)[l * 4 + gI * 2], dsk1 = INP(I_DSKIP)[l * 4 + gI * 2 + 1];
    const float nw0 = INP(I_DNW)[l * 256 + gI * 128 + lane], nw1 = INP(I_DNW)[l * 256 + gI * 128 + 64 + lane];
#pragma unroll 1
    for (int t0 = 0; t0 < T; t0 += 64) {
        unsigned lb_ = 0u; int tid_l = tid0; asm volatile("" : "+v"(lb_), "+v"(tid_l));
        const int tid = tid_l, lane = tid & 63, wave = __builtin_amdgcn_readfirstlane(tid >> 6);
        LAS unsigned char* lds = lds0 + lb_;
        LAS float* SM = (LAS float*)(lds + O_SM);
        LAS float* YF = (LAS float*)(lds + O_YF);
        if (wave < 2) {
            const size_t m = (size_t)b * T + t0 + lane;
            const float dt = softplusf_(bf2f(P[m * PP + C_DT + gI * 2 + wave]) + (wave == 0 ? dtb0 : dtb1));
            float cs = dt * (wave == 0 ? nA0 : nA1);
#pragma unroll
            for (int o = 1; o < 64; o <<= 1) { const float y = __shfl_up(cs, o); if (lane >= o) cs += y; }
            const float cL = __shfl(cs, 63);
            SM[wave * 64 + lane] = dt; SM[128 + wave * 64 + lane] = cs; SM[256 + wave * 64 + lane] = __expf(cL - cs) * dt; SM[384 + wave * 64 + lane] = __expf(cs);
        }
        __syncthreads();
        { float h0, h1, h2, cur[8], nxt[8];
          { const int tb = t0 + sub * 32; h0 = tb >= 3 ? bf2f(P[((size_t)b * T + tb - 3) * PP + C_DX + col]) : 0.f; h1 = tb >= 2 ? bf2f(P[((size_t)b * T + tb - 2) * PP + C_DX + col]) : 0.f; h2 = tb >= 1 ? bf2f(P[((size_t)b * T + tb - 1) * PP + C_DX + col]) : 0.f;
#pragma unroll
            for (int j = 0; j < 8; ++j) cur[j] = bf2f(P[((size_t)b * T + tb + j) * PP + C_DX + col]); }
#pragma unroll 1
          for (int g8 = 0; g8 < 4; ++g8) {
            const int tb = t0 + sub * 32 + g8 * 8 + (g8 < 3 ? 8 : 0);
#pragma unroll
            for (int j = 0; j < 8; ++j) nxt[j] = bf2f(P[((size_t)b * T + tb + j) * PP + C_DX + col]);
#pragma unroll
            for (int j = 0; j < 8; ++j) {
                const int tt = sub * 32 + g8 * 8 + j;
                const float a = siluf_(cb + cw3 * cur[j] + cw2 * h2 + cw1 * h1 + cw0 * h0);
                h0 = h1; h1 = h2; h2 = cur[j];
                if (cc < 128) { const int hh = cc >> 6, p = cc & 63;
                    *(LAS bf16*)(lds + O_XT0 + hh * MB + (p * LS + tt) * 2) = (bf16)f2bf(a); *(LAS bf16*)(lds + O_XW0 + hh * MB + (p * LS + tt) * 2) = (bf16)f2bf(a * SM[256 + hh * 64 + tt]); }
                else if (cc < 192) { const int n = cc - 128; *(LAS bf16*)(lds + O_BN + (tt * LS + n) * 2) = (bf16)f2bf(a); *(LAS bf16*)(lds + O_BT + (n * LS + tt) * 2) = (bf16)f2bf(a); }
                else { const int n = cc - 192; *(LAS bf16*)(lds + O_CN + (tt * LS + n) * 2) = (bf16)f2bf(a);
                    *(LAS bf16*)(lds + O_CS0 + (tt * LS + n) * 2) = (bf16)f2bf(a * SM[384 + tt]); *(LAS bf16*)(lds + O_CS0 + MB + (tt * LS + n) * 2) = (bf16)f2bf(a * SM[384 + 64 + tt]); }
            }
#pragma unroll
            for (int j = 0; j < 8; ++j) cur[j] = nxt[j];
          } }
        __syncthreads();
        { f4 acc[2]; acc[0] = (f4){0.f, 0.f, 0.f, 0.f}; acc[1] = (f4){0.f, 0.f, 0.f, 0.f}; mm64(acc, lds, O_CN, O_BN, wave, lane);
#pragma unroll
            for (int hh = 0; hh < 2; ++hh) { f4 sc[2];
#pragma unroll
                for (int cI = 0; cI < 2; ++cI) { const int s = ((wave & 1) * 2 + cI) * 16 + (lane & 15), row = (wave >> 1) * 16 + 4 * (lane >> 4);
                    const float cs = SM[128 + hh * 64 + s], ds = SM[hh * 64 + s];
#pragma unroll
                    for (int e = 0; e < 4; ++e) { const float ct = SM[128 + hh * 64 + row + e]; sc[cI][e] = (s <= row + e) ? acc[cI][e] * __expf(ct - cs) * ds : 0.f; } }
                storeN<0>(lds, O_SC0 + hh * MB, sc, wave, lane); } }
        __syncthreads();
        f4 yacc[2][2];
#pragma unroll
        for (int hh = 0; hh < 2; ++hh) {
            yacc[hh][0] = (f4){0.f, 0.f, 0.f, 0.f}; yacc[hh][1] = (f4){0.f, 0.f, 0.f, 0.f};
            mm64(yacc[hh], lds, O_SC0 + hh * MB, O_XT0 + hh * MB, wave, lane); mm64(yacc[hh], lds, O_CS0 + hh * MB, O_HN0 + hh * MB, wave, lane);
            const float gL = SM[384 + hh * 64 + 63]; hacc[hh][0] = hacc[hh][0] * gL; hacc[hh][1] = hacc[hh][1] * gL;
            mm64(hacc[hh], lds, O_XW0 + hh * MB, O_BT, wave, lane);
        }
        __syncthreads();
#pragma unroll
        for (int hh = 0; hh < 2; ++hh) {
#pragma unroll
            for (int cI = 0; cI < 2; ++cI) { const int colp = ((wave & 1) * 2 + cI) * 16 + (lane & 15), row = (wave >> 1) * 16 + 4 * (lane >> 4);
#pragma unroll
                for (int e = 0; e < 4; ++e) YF[(row + e) * 128 + hh * 64 + colp] = yacc[hh][cI][e]; }
            storeN<0>(lds, O_HN0 + hh * MB, hacc[hh], wave, lane);
        }
        __syncthreads();
#pragma unroll
        for (int q = 0; q < 8; ++q) {
            const int tt = wave * 8 + q; const size_t m = (size_t)b * T + t0 + tt;
            const float x0 = bf2f(*(const LAS bf16*)(lds + O_XT0 + (lane * LS + tt) * 2)), x1 = bf2f(*(const LAS bf16*)(lds + O_XT0 + MB + (lane * LS + tt) * 2));
            const int c0 = gI * 128 + lane, c1 = c0 + 64;
            const float z0 = bf2f(P[m * PP + C_DZ + c0]), z1 = bf2f(P[m * PP + C_DZ + c1]);
            const float y0 = (YF[tt * 128 + lane] + dsk0 * x0) * siluf_(z0), y1 = (YF[tt * 128 + 64 + lane] + dsk1 * x1) * siluf_(z1);
            const float ss = wave_sum(y0 * y0 + y1 * y1); const float rs = rsqrtf(ss * (1.f / 128.f) + 1e-5f);
            OB[m * 1024 + 768 + c0] = (bf16)f2bf(y0 * rs * nw0); OB[m * 1024 + 768 + c1] = (bf16)f2bf(y1 * rs * nw1);
        }
        __syncthreads();
    }
}
}

namespace bsp {
typedef short bf16x8 __attribute__((ext_vector_type(8)));
typedef float f4 __attribute__((ext_vector_type(4)));
constexpr int HS = 129;
constexpr int O_HIST = 0;
constexpr int O_V = 66048;
constexpr int VS = 272;
constexpr int O_KB = O_V + 2 * 32 * VS * 2;
constexpr int KBUF = 20480;
static_assert(O_KB + 2 * KBUF <= LDS_BYTES - 600, "mixer B LDS map");
__device__ __forceinline__ float relu_(float x) { return __int_as_float(max(__float_as_int(x), 0)); }
__device__ __forceinline__ int qkey(float s) { int q = (int)__builtin_fmaf(s, 262144.f, 8388608.f); return q < 1 ? 1 : (q > 16777215 ? 16777215 : q); }
__device__ __forceinline__ unsigned okey(float s) { return (unsigned)qkey(s) << 8; }
__device__ __forceinline__ int f2o(float f) { const int b = __float_as_int(f); return b ^ ((b >> 31) & 0x7fffffff); }
__device__ __forceinline__ float o2f(int o) { return __int_as_float(o ^ ((o >> 31) & 0x7fffffff)); }
__device__ __forceinline__ float fthr(const unsigned Q) {
    const int Qc = (int)(Q < 2u ? 2u : (Q > 16777215u ? 16777215u : Q));
    long long lo = f2o(-64.f), hi = f2o(64.f);
#pragma unroll 1
    for (int i = 0; i < 33; ++i) { const int mid = (int)((lo + hi) >> 1); if (qkey(o2f(mid)) >= Qc) hi = mid; else lo = mid; }
    const float r = o2f((int)hi);
    return Q < 2u ? -INFINITY : (Q > 16777215u ? INFINITY : r);
}
__device__ __forceinline__ void hist_add(const unsigned addr, const unsigned v) { asm volatile("ds_add_u32 %0, %1" :: "v"(addr), "v"(v) : "memory"); }
__device__ __forceinline__ f4 idx_tile(const bf16* Pb, const int kt, const bf16x8 (&qi)[4][2], const float (&wq)[4], const int lane) {
    const bf16* kr = Pb + (size_t)(kt * 16 + (lane & 15)) * PP + C_IK + (lane >> 4) * 8;
    const bf16x8 a0 = *(const bf16x8*)kr, a1 = *(const bf16x8*)(kr + 32);
    f4 s = (f4){0.f, 0.f, 0.f, 0.f};
#pragma unroll
    for (int h = 0; h < 4; ++h) { f4 t = (f4){0.f, 0.f, 0.f, 0.f};
        t = __builtin_amdgcn_mfma_f32_16x16x32_bf16(a0, qi[h][0], t, 0, 0, 0); t = __builtin_amdgcn_mfma_f32_16x16x32_bf16(a1, qi[h][1], t, 0, 0, 0);
#pragma unroll
        for (int e = 0; e < 4; ++e) s[e] += wq[h] * relu_(t[e]); }
    return s;
}

__device__ __forceinline__ void item(LAS unsigned char* lds0, const int bb, const int qb, const bf16* P, bf16* OB, const int tid0, const int pm) {
    unsigned lb_ = 0u; int tid_l = tid0; asm volatile("" : "+v"(lb_), "+v"(tid_l));
    LAS unsigned char* lds = lds0 + lb_; const int tid = tid_l, lane = tid & 63, wave = __builtin_amdgcn_readfirstlane(tid >> 6);
    const bf16* Pb = P + (size_t)bb * T * PP;
    const int ql = wave * 16 + (lane & 15), tq = qb * 128 + ql, g = lane >> 4;
    const bf16* prow = Pb + (size_t)tq * PP;
    bf16x8 qi[4][2]; float wq[4];
#pragma unroll
    for (int h = 0; h < 4; ++h) { qi[h][0] = *(const bf16x8*)(prow + C_IQ + h * 64 + g * 8); qi[h][1] = *(const bf16x8*)(prow + C_IQ + h * 64 + 32 + g * 8); wq[h] = bf2f(prow[C_IW + h]) * 0.0625f; }
    LAS unsigned* hist = (LAS unsigned*)(lds + O_HIST) + ql * HS;
    const unsigned histb = (unsigned)(size_t)hist;
    const int nkt = (qb + 1) * 8;
    unsigned prefix = 0u; int needk = 256;
#pragma unroll 1
    for (int rr = 0; rr < (pm == 102 ? 2 : 1); ++rr) { prefix = 0u; needk = 256;
#pragma unroll 1
    for (int pass = 0; pass < 3; ++pass) {
        for (int i = lane; i < 16 * HS; i += 64) ((LAS unsigned*)(lds + O_HIST) + wave * 16 * HS)[i] = 0u;
        asm volatile("s_waitcnt lgkmcnt(0)" ::: "memory");
        const int shp = 32 - 8 * pass, shb = 24 - 8 * pass;
        float flo = 0.f, fhi = 0.f;
        if (pass > 0) { const float stepw = (pass == 1) ? 65536.f : 256.f; flo = ((float)prefix * stepw - 2.f) * (1.f / 262144.f) - 32.f; fhi = (((float)prefix + 1.f) * stepw + 2.f) * (1.f / 262144.f) - 32.f; }
        if (prefix == 0u) flo = -INFINITY; if (pass == 2 && prefix == 0xffffu) fhi = INFINITY;
        const int nsteps = pm >= 300 ? 0 : nkt >> 2;
#define RDX_DMA(stepi, bufi) do { const int st_ = (stepi) < nsteps ? (stepi) : (nsteps - 1); const int S_ = wave * 64 + lane, r_ = S_ >> 3, p_ = S_ & 7; \
            __builtin_amdgcn_global_load_lds((const unsigned*)(Pb + (size_t)(st_ * 64 + r_) * PP + C_IK + ((p_ ^ (r_ & 7)) << 3)), (LAS unsigned*)(lds + O_V + (bufi) * 8192 + wave * 1024), 16, 0, 0); } while (0)
        asm volatile("s_waitcnt vmcnt(0) lgkmcnt(0)" ::: "memory"); __builtin_amdgcn_s_barrier();
        RDX_DMA(0, 0); RDX_DMA(1, 1); RDX_DMA(2, 2);
        typedef float f2 __attribute__((ext_vector_type(2)));
        auto steps = [&](auto PVc) { constexpr int PV = decltype(PVc)::value;
            f2 w2[4];
#pragma unroll
            for (int h = 0; h < 4; ++h) w2[h] = (f2){wq[h], wq[h]};
            const int tqmin_ = qb * 128 + wave * 16;
#pragma unroll 1
            for (int stp = 0; stp < nsteps; ++stp) {
                asm volatile("s_waitcnt vmcnt(2)" ::: "memory");
                __builtin_amdgcn_s_barrier();
                RDX_DMA(stp + 3, (stp + 3) & 3);
                const unsigned kbr = (unsigned)(O_V + (stp & 3) * 8192);
                const bool edge = stp >= nsteps - 2;
                auto score = [&](const int u, f2& s01, f2& s23) __attribute__((always_inline)) {
                    const bf16x8 ka0 = *(const LAS bf16x8*)(lds + kbr + (u * 16 + (lane & 15)) * 128 + (((0 + g) ^ (lane & 7)) << 4));
                    const bf16x8 ka1 = *(const LAS bf16x8*)(lds + kbr + (u * 16 + (lane & 15)) * 128 + (((4 + g) ^ (lane & 7)) << 4));
                    s01 = (f2){0.f, 0.f}; s23 = (f2){0.f, 0.f};
#pragma unroll
                    for (int h = 0; h < 4; ++h) { f4 t = (f4){0.f, 0.f, 0.f, 0.f};
                        t = __builtin_amdgcn_mfma_f32_16x16x32_bf16(ka0, qi[h][0], t, 0, 0, 0); t = __builtin_amdgcn_mfma_f32_16x16x32_bf16(ka1, qi[h][1], t, 0, 0, 0);
                        s01 += w2[h] * (f2){relu_(t[0]), relu_(t[1])}; s23 += w2[h] * (f2){relu_(t[2]), relu_(t[3])}; } };
                auto count = [&](const int u, const f2 s01, const f2 s23, auto EDc) __attribute__((always_inline)) { constexpr bool ED = decltype(EDc)::value;
                    const int k0 = (stp * 4 + u) * 16; const float sv[4] = {s01.x, s01.y, s23.x, s23.y};
                    if constexpr (PV == 0) {
#pragma unroll
                        for (int e = 0; e < 4; ++e) { const unsigned q = (unsigned)qkey(sv[e]); unsigned val = (q & 0x10000u) ? 0x10000u : 1u;
                            if (ED) val = (k0 + 4 * g + e <= tq) ? val : 0u;
                            hist_add(histb + ((q >> 17) << 2), val); }
                    } else if constexpr (PV == 1) {
#pragma unroll
                        for (int e = 0; e < 4; ++e) { const unsigned q = (unsigned)qkey(sv[e]); bool mt = (q >> 16) == prefix; if (ED) mt = mt & (k0 + 4 * g + e <= tq);
                            const unsigned val = mt ? ((q & 0x100u) ? 0x10000u : 1u) : 0u;
                            hist_add(histb + (((q >> 9) & 127u) << 2), val); }
                    } else {
#pragma unroll
                        for (int e = 0; e < 4; ++e) { const unsigned q = (unsigned)qkey(sv[e]); bool mt = (sv[e] >= flo) & (sv[e] <= fhi) & ((q >> 8) == prefix); if (ED) mt = mt & (k0 + 4 * g + e <= tq);
                            const unsigned val = mt ? ((q & 1u) ? 0x10000u : 1u) : 0u;
                            hist_add(histb + (((q >> 1) & 127u) << 2), val); }
                    } };
                if (!edge) {
                    f2 sa[4], sb[4];
#pragma unroll
                    for (int u = 0; u < 4; ++u) score(u, sa[u], sb[u]);
                    if constexpr (PV < 2) {
#pragma unroll
                        for (int u = 0; u < 4; ++u) count(u, sa[u], sb[u], std::false_type{});
                    } else {
                        bool anyl = false;
#pragma unroll
                        for (int u = 0; u < 4; ++u) { anyl = anyl | ((sa[u].x >= flo) & (sa[u].x <= fhi)) | ((sa[u].y >= flo) & (sa[u].y <= fhi)) | ((sb[u].x >= flo) & (sb[u].x <= fhi)) | ((sb[u].y >= flo) & (sb[u].y <= fhi)); }
                        if (__any(anyl)) {
#pragma unroll
                            for (int u = 0; u < 4; ++u) count(u, sa[u], sb[u], std::false_type{});
                        }
                    }
                } else {
#pragma unroll
                    for (int u = 0; u < 4; ++u) {
                        if ((stp * 4 + u) * 16 > tqmin_ + 15) continue;
                        f2 s01, s23; score(u, s01, s23); count(u, s01, s23, std::true_type{}); }
                }
            }
        };
        if (pass == 0) steps(std::integral_constant<int, 0>{}); else if (pass == 1) steps(std::integral_constant<int, 1>{}); else steps(std::integral_constant<int, 2>{});
        asm volatile("s_waitcnt vmcnt(0)" ::: "memory");
#undef RDX_DMA
        asm volatile("s_waitcnt lgkmcnt(0)" ::: "memory");
        int cum = 0; unsigned bsel = 0u; int above = 0;
        for (int wd = 127; wd >= 0; --wd) { const unsigned v = hist[wd]; const int hi = (int)(v >> 16), lo = (int)(v & 0xffffu);
            if (cum + hi >= needk) { bsel = (unsigned)(2 * wd + 1); above = cum; break; } cum += hi;
            if (cum + lo >= needk) { bsel = (unsigned)(2 * wd); above = cum; break; } cum += lo; }
        prefix = (prefix << 8) | bsel; needk -= above;
        asm volatile("s_waitcnt lgkmcnt(0)" ::: "memory");
    }
    }
    if (pm >= 200 && pm < 300) { __syncthreads(); return; }
    unsigned thr = prefix; int need = needk;
    bool tie = false;
    if (tq < 256) { thr = 0u; need = 1 << 20; }
    else { const unsigned v = hist[(prefix & 255u) >> 1]; const int ceq = (prefix & 1u) ? (int)(v >> 16) : (int)(v & 0xffffu); tie = needk < ceq; }
    __syncthreads();
    const bool anytie = __any(tie);
    const float sB = fthr(thr);
    unsigned cn = (unsigned)(need > 0xffff ? 0xffff : need) << 16;
    constexpr int O_TC = O_KB + 2 * KBUF + 2048;
    if (g == 0) { *(LAS unsigned*)(lds + O_TC + ql * 8) = thr; *(LAS unsigned*)(lds + O_TC + ql * 8 + 4) = cn; }
    const int tqmin = qb * 128 + wave * 16;
#pragma unroll
    for (int h = 0; h < 4; ++h) { *(LAS bf16x8*)(lds + O_HIST + wave * 8192 + ((h * 2 + 0) * 64 + lane) * 16) = qi[h][0]; *(LAS bf16x8*)(lds + O_HIST + wave * 8192 + ((h * 2 + 1) * 64 + lane) * 16) = qi[h][1]; }
    constexpr int O_WQ = O_KB + 2 * KBUF;
    if (g == 0) {
#pragma unroll
        for (int h = 0; h < 4; ++h) *(LAS float*)(lds + O_WQ + ((wave * 4 + h) * 16 + (lane & 15)) * 4) = wq[h]; }
    bf16x8 qa[4][2];
#pragma unroll
    for (int h = 0; h < 4; ++h) { qa[h][0] = *(const bf16x8*)(prow + C_BQ + h * 64 + g * 8); qa[h][1] = *(const bf16x8*)(prow + C_BQ + h * 64 + 32 + g * 8); }
    f4 oacc[4][4]; float mrun[4], lrun[4];
#pragma unroll
    for (int h = 0; h < 4; ++h) { mrun[h] = -INFINITY; lrun[h] = 0.f;
#pragma unroll
        for (int dt = 0; dt < 4; ++dt) oacc[h][dt] = (f4){0.f, 0.f, 0.f, 0.f}; }
#pragma unroll 1
    for (int rr = 0; rr < (pm == 103 ? 2 : 1); ++rr) {
#pragma unroll
    for (int h = 0; h < 4; ++h) { mrun[h] = -INFINITY; lrun[h] = 0.f;
#pragma unroll
        for (int dt = 0; dt < 4; ++dt) oacc[h][dt] = (f4){0.f, 0.f, 0.f, 0.f}; }
    const int nst = (qb + 1) * 4;
    const int vkey = tid >> 4, vch = tid & 15;
    u32x4 vpre0 = *(const u32x4*)(Pb + (size_t)vkey * PP + C_BV + vch * 8), vpre1 = *(const u32x4*)(Pb + (size_t)vkey * PP + C_BV + 128 + vch * 8);
    const unsigned vrd = (unsigned)(unsigned long)lds + (unsigned)(O_V + (4 * g + ((lane >> 2) & 3)) * (VS * 2) + (lane & 3) * 8);
    __syncthreads();
    const int kr_ = 2 * wave + (lane >> 5), kir_ = wave * 8 + (lane >> 3);
    const bf16* kbase = Pb + (size_t)kr_ * PP + C_BK + (((lane & 31) ^ (kr_ & 15)) << 3);
    const bf16* kibase = Pb + (size_t)kir_ * PP + C_IK + (((lane & 7) ^ (kir_ & 7)) << 3);
#define K_DMA(key_first, kbo) do { const bf16* s0_ = kbase + (size_t)(key_first) * PP; \
        __builtin_amdgcn_global_load_lds((const unsigned*)s0_, (LAS unsigned*)(lds + (kbo) + wave * 1024), 16, 0, 0); \
        __builtin_amdgcn_global_load_lds((const unsigned*)(s0_ + (size_t)16 * PP), (LAS unsigned*)(lds + (kbo) + (wave + 8) * 1024), 16, 0, 0); \
        if (wave < 4) __builtin_amdgcn_global_load_lds((const unsigned*)(kibase + (size_t)(key_first) * PP), (LAS unsigned*)(lds + (kbo) + 16384 + wave * 1024), 16, 0, 0); } while (0)
    K_DMA(0, (unsigned)O_KB);
#pragma unroll 1
    for (int st = 0; st < nst; ++st) {
        const int key0 = st * 32; const unsigned vbuf = (unsigned)(st & 1) * (32 * VS * 2);
        unsigned qio = (unsigned)(O_HIST + wave * 8192 + lane * 16); asm volatile("" : "+v"(qio));
        unsigned wqo = (unsigned)(O_WQ + wave * 256 + (lane & 15) * 4); asm volatile("" : "+v"(wqo));
        unsigned tco = (unsigned)(O_TC + (wave * 16 + (lane & 15)) * 8); asm volatile("" : "+v"(tco));
        { LAS bf16* VL = (LAS bf16*)(lds + O_V + vbuf); *(LAS u32x4*)(VL + vkey * VS + vch * 8) = vpre0; *(LAS u32x4*)(VL + vkey * VS + 128 + vch * 8) = vpre1; }
        asm volatile("s_waitcnt vmcnt(0)" ::: "memory");
        __syncthreads();
        if (st + 1 < nst) K_DMA(key0 + 32, (unsigned)(O_KB + ((st + 1) & 1) * KBUF));
        const unsigned kbc = (unsigned)(O_KB + (st & 1) * KBUF);
#define KQ_(h, k2, ks) (*(const LAS bf16x8*)(lds + kbc + (k2 * 16 + (lane & 15)) * 512 + ((((h) * 8 + (ks) * 4 + g) ^ (lane & 15)) << 4)))
#define KI_(k2, ks) (*(const LAS bf16x8*)(lds + kbc + 16384 + (k2 * 16 + (lane & 15)) * 128 + ((((ks) * 4 + g) ^ (lane & 7)) << 4)))
        const bool active = key0 <= tqmin + 15;
        bool sel[2][4] = {{false, false, false, false}, {false, false, false, false}};
        if (active && pm == 305) {
#pragma unroll
            for (int k2 = 0; k2 < 2; ++k2)
#pragma unroll
                for (int e = 0; e < 4; ++e) sel[k2][e] = (key0 + k2 * 16 + 4 * g + e) <= tq;
        } else if (active) {
            unsigned eqm = 0u;
            const bool plain = !anytie && key0 + 31 <= tqmin;
#pragma unroll
            for (int k2 = 0; k2 < 2; ++k2) { f4 s = (f4){0.f, 0.f, 0.f, 0.f};
#pragma unroll
                for (int h = 0; h < 4; ++h) { f4 t = (f4){0.f, 0.f, 0.f, 0.f};
                    const bf16x8 qh0 = *(const LAS bf16x8*)(lds + qio + ((h * 2 + 0) * 64) * 16), qh1 = *(const LAS bf16x8*)(lds + qio + ((h * 2 + 1) * 64) * 16);
                    t = __builtin_amdgcn_mfma_f32_16x16x32_bf16(KI_(k2, 0), qh0, t, 0, 0, 0); t = __builtin_amdgcn_mfma_f32_16x16x32_bf16(KI_(k2, 1), qh1, t, 0, 0, 0);
                    const float wqh = *(const LAS float*)(lds + wqo + h * 64);
#pragma unroll
                    for (int e = 0; e < 4; ++e) s[e] += wqh * relu_(t[e]); }
                if (plain) {
#pragma unroll
                    for (int e = 0; e < 4; ++e) sel[k2][e] = s[e] >= sB;
                } else {
                    const unsigned thr_ = *(const LAS unsigned*)(lds + tco);
#pragma unroll
                    for (int e = 0; e < 4; ++e) { const int key = key0 + k2 * 16 + 4 * g + e, tq_ = tqmin + (lane & 15); const unsigned k24 = (unsigned)qkey(s[e]);
                        sel[k2][e] = (key <= tq_) & (k24 > thr_); if ((key <= tq_) & (k24 == thr_)) eqm |= 1u << (k2 * 4 + e); }
                } }
            if (!plain) {
                if (anytie && __any(eqm != 0u)) {
                    const unsigned pk = (unsigned)__popc(eqm & 15u) | ((unsigned)__popc(eqm >> 4) << 8);
                    const unsigned p0 = (unsigned)__shfl((int)pk, lane & 15), p1 = (unsigned)__shfl((int)pk, (lane & 15) + 16), p2 = (unsigned)__shfl((int)pk, (lane & 15) + 32), p3 = (unsigned)__shfl((int)pk, (lane & 15) + 48);
                    const unsigned tot = p0 + p1 + p2 + p3, below = (g > 0 ? p0 : 0u) + (g > 1 ? p1 : 0u) + (g > 2 ? p2 : 0u);
                    const unsigned cn_ = *(const LAS unsigned*)(lds + tco + 4); const int cnt = (int)(cn_ & 0xffffu), need_ = (int)(cn_ >> 16); const int base0 = cnt + (int)(below & 255u), base1 = cnt + (int)(tot & 255u) + (int)(below >> 8);
#pragma unroll
                    for (int k2 = 0; k2 < 2; ++k2)
#pragma unroll
                        for (int e = 0; e < 4; ++e) { const unsigned bit = 1u << (k2 * 4 + e);
                            const int rank = (k2 ? base1 : base0) + __popc(eqm & (bit - 1u) & (k2 ? 0xf0u : 0x0fu));
                            sel[k2][e] = sel[k2][e] | (((eqm & bit) != 0u) & (rank < need_)); }
                    *(LAS unsigned*)(lds + tco + 4) = cn_ + (tot & 255u) + (tot >> 8);
                } else {
#pragma unroll
                    for (int k2 = 0; k2 < 2; ++k2)
#pragma unroll
                        for (int e = 0; e < 4; ++e) sel[k2][e] = sel[k2][e] | ((eqm & (1u << (k2 * 4 + e))) != 0u);
                }
            }
        }
#pragma unroll
        for (int h = 0; h < 4; ++h) {
            if (h == 2 && st + 1 < nst) { vpre0 = *(const u32x4*)(Pb + (size_t)(key0 + 32 + vkey) * PP + C_BV + vch * 8); vpre1 = *(const u32x4*)(Pb + (size_t)(key0 + 32 + vkey) * PP + C_BV + 128 + vch * 8); }
            if (active) {
            f4 sc[2];
#pragma unroll
            for (int k2 = 0; k2 < 2; ++k2) { f4 t = (f4){0.f, 0.f, 0.f, 0.f};
                t = __builtin_amdgcn_mfma_f32_16x16x32_bf16(KQ_(h, k2, 0), qa[h][0], t, 0, 0, 0); t = __builtin_amdgcn_mfma_f32_16x16x32_bf16(KQ_(h, k2, 1), qa[h][1], t, 0, 0, 0);
#pragma unroll
                for (int e = 0; e < 4; ++e) sc[k2][e] = sel[k2][e] ? t[e] * (0.125f * 1.4426950408889634f) : -INFINITY; }
            float mx = fmaxf(fmaxf(fmaxf(sc[0][0], sc[0][1]), fmaxf(sc[0][2], sc[0][3])), fmaxf(fmaxf(sc[1][0], sc[1][1]), fmaxf(sc[1][2], sc[1][3])));
            mx = fmaxf(mx, __shfl_xor(mx, 16)); mx = fmaxf(mx, __shfl_xor(mx, 32));
            const float mnew = fmaxf(mrun[h], mx), msafe = (mnew == -INFINITY) ? 0.f : mnew;
            const bool resc = __any(mnew != mrun[h]);
            const float corr = __builtin_amdgcn_exp2f(mrun[h] - msafe); mrun[h] = mnew;
            float p[8]; float ps = 0.f;
#pragma unroll
            for (int e = 0; e < 4; ++e) { p[e] = __builtin_amdgcn_exp2f(sc[0][e] - msafe); p[4 + e] = __builtin_amdgcn_exp2f(sc[1][e] - msafe); ps += p[e] + p[4 + e]; }
            lrun[h] = lrun[h] * corr + ps;
            union { bf16x8 v; unsigned u[4]; } pb;
            pb.u[0] = pg8::cvt_pk_bf16(p[0], p[1]); pb.u[1] = pg8::cvt_pk_bf16(p[2], p[3]); pb.u[2] = pg8::cvt_pk_bf16(p[4], p[5]); pb.u[3] = pg8::cvt_pk_bf16(p[6], p[7]);
            union { bf16x8 v; u32x2 h2[2]; } vf[4];
            const unsigned va = vrd + vbuf + (unsigned)(h * 128);
            asm volatile("ds_read_b64_tr_b16 %0, %8\n\tds_read_b64_tr_b16 %1, %8 offset:%9\n\tds_read_b64_tr_b16 %2, %8 offset:32\n\tds_read_b64_tr_b16 %3, %8 offset:%10\n\t"
                         "ds_read_b64_tr_b16 %4, %8 offset:64\n\tds_read_b64_tr_b16 %5, %8 offset:%11\n\tds_read_b64_tr_b16 %6, %8 offset:96\n\tds_read_b64_tr_b16 %7, %8 offset:%12\n\ts_waitcnt lgkmcnt(0)"
                         : "=&v"(vf[0].h2[0]), "=&v"(vf[0].h2[1]), "=&v"(vf[1].h2[0]), "=&v"(vf[1].h2[1]), "=&v"(vf[2].h2[0]), "=&v"(vf[2].h2[1]), "=&v"(vf[3].h2[0]), "=&v"(vf[3].h2[1])
                         : "v"(va), "i"(16 * VS * 2), "i"(16 * VS * 2 + 32), "i"(16 * VS * 2 + 64), "i"(16 * VS * 2 + 96) : "memory");
            __builtin_amdgcn_sched_barrier(0);
            if (resc) {
#pragma unroll
                for (int dt = 0; dt < 4; ++dt) oacc[h][dt] = oacc[h][dt] * corr; }
#pragma unroll
            for (int dt = 0; dt < 4; ++dt) oacc[h][dt] = __builtin_amdgcn_mfma_f32_16x16x32_bf16(vf[dt].v, pb.v, oacc[h][dt], 0, 0, 0);
            }
        }
    }
    __syncthreads();
    }
#undef KQ_
#undef KI_
#undef K_DMA
    const size_t m = (size_t)bb * T + tqmin + (lane & 15);
    if (pm < 300)
#pragma unroll
    for (int h = 0; h < 4; ++h) { float l = lrun[h]; l += __shfl_xor(l, 16); l += __shfl_xor(l, 32); const float inv = 1.f / l;
#pragma unroll
        for (int dt = 0; dt < 4; ++dt) { u32x2 w; w.x = pk2(oacc[h][dt][0] * inv, oacc[h][dt][1] * inv); w.y = pk2(oacc[h][dt][2] * inv, oacc[h][dt][3] * inv);
            *(u32x2*)(OB + m * 1024 + 256 + h * 64 + dt * 16 + 4 * g) = w; } }
    __syncthreads();
}
}

namespace awin {
typedef short bf16x8 __attribute__((ext_vector_type(8)));
typedef float f4 __attribute__((ext_vector_type(4)));
constexpr int EXS = 66;
constexpr int O_EX = 0;
constexpr int VSW = 72;
constexpr int O_VW = 101376;
__device__ __forceinline__ void item(LAS unsigned char* lds0, const int bb, const int blk, const int h, const bf16* P, bf16* OB, const int tid0) {
    unsigned lb_ = 0u; int tid_l = tid0; asm volatile("" : "+v"(lb_), "+v"(tid_l));
    LAS unsigned char* lds = lds0 + lb_; const int tid = tid_l, lane = tid & 63, wave = __builtin_amdgcn_readfirstlane(tid >> 6);
    const bf16* Pb = P + (size_t)bb * T * PP; const int start = blk * 128, g = lane >> 4, ln = lane & 15;
    LAS float* EX = (LAS float*)(lds + O_EX);
    LAS bf16* VW = (LAS bf16*)(lds + O_VW + wave * 4608);
#pragma unroll 1
    for (int s4 = 0; s4 < 4; ++s4) {
        const int st = wave * 4 + s4;
        const int grp = st < 8 ? 0 : (st < 16 ? 1 : 2);
        const int dil = grp == 0 ? 1 : (grp == 1 ? 4 : 16), win = grp == 0 ? 128 : (grp == 1 ? 512 : 2048);
        const int r = grp == 0 ? 0 : (grp == 1 ? ((st - 8) >> 1) : (st - 16)), a0 = grp == 0 ? 16 * st : (grp == 1 ? ((st - 8) & 1) * 16 : 0), nqc = grp == 0 ? 128 : (grp == 1 ? 32 : 8);
        const int a = a0 + ln; const bool qok = a < nqc; const int ql = (qok ? a : (nqc - 1)) * dil + r, tq = start + ql;
        const bf16* qp = Pb + (size_t)tq * PP + C_AQ + grp * 256 + h * 64 + g * 8;
        const bf16x8 q0 = *(const bf16x8*)qp, q1 = *(const bf16x8*)(qp + 32);
        bf16x8 kf[10][2];
#pragma unroll
        for (int kt = 0; kt < 10; ++kt) { int pos = start - win + (a0 + 16 * kt + ln) * dil + r; pos = pos < 0 ? 0 : (pos > T - 1 ? T - 1 : pos);
            const bf16* kp = Pb + (size_t)pos * PP + C_AK + grp * 256 + h * 64 + g * 8; kf[kt][0] = *(const bf16x8*)kp; kf[kt][1] = *(const bf16x8*)(kp + 32); }
        f4 sc[10]; float mx = -INFINITY;
#pragma unroll
        for (int kt = 0; kt < 10; ++kt) { f4 t = (f4){0.f, 0.f, 0.f, 0.f};
            t = __builtin_amdgcn_mfma_f32_16x16x32_bf16(kf[kt][0], q0, t, 0, 0, 0); t = __builtin_amdgcn_mfma_f32_16x16x32_bf16(kf[kt][1], q1, t, 0, 0, 0);
#pragma unroll
            for (int e = 0; e < 4; ++e) { const int c = a0 + 16 * kt + 4 * g + e; const int pos = start - win + c * dil + r;
                const bool ok = qok && c >= a && c <= a + 128 && pos >= 0;
                sc[kt][e] = ok ? t[e] * 0.125f : -INFINITY; mx = fmaxf(mx, sc[kt][e]); } }
        mx = fmaxf(mx, __shfl_xor(mx, 16)); mx = fmaxf(mx, __shfl_xor(mx, 32));
        const float msafe = (mx == -INFINITY) ? 0.f : mx; float lsum = 0.f;
#pragma unroll
        for (int kt = 0; kt < 10; ++kt)
#pragma unroll
            for (int e = 0; e < 4; ++e) { sc[kt][e] = __expf(sc[kt][e] - msafe); lsum += sc[kt][e]; }
        lsum += __shfl_xor(lsum, 16); lsum += __shfl_xor(lsum, 32);
        f4 oacc[4];
#pragma unroll
        for (int dt = 0; dt < 4; ++dt) oacc[dt] = (f4){0.f, 0.f, 0.f, 0.f};
#pragma unroll
        for (int s5 = 0; s5 < 5; ++s5) {
            int pos = start - win + (a0 + 32 * s5 + (lane >> 1)) * dil + r; pos = pos < 0 ? 0 : (pos > T - 1 ? T - 1 : pos);
            const u32x4* vp = (const u32x4*)(Pb + (size_t)pos * PP + C_AV + grp * 256 + h * 64 + (lane & 1) * 32);
            const u32x4 v0 = vp[0], v1 = vp[1], v2 = vp[2], v3 = vp[3];
            LAS u32x4* vd = (LAS u32x4*)(VW + (lane >> 1) * VSW + (lane & 1) * 32);
            asm volatile("s_waitcnt lgkmcnt(0)" ::: "memory");
            vd[0] = v0; vd[1] = v1; vd[2] = v2; vd[3] = v3;
            asm volatile("s_waitcnt lgkmcnt(0)" ::: "memory");
            bf16x8 pb;
#pragma unroll
            for (int e = 0; e < 4; ++e) { pb[e] = (short)f2bf(sc[2 * s5][e]); pb[4 + e] = (short)f2bf(sc[2 * s5 + 1][e]); }
#pragma unroll
            for (int dt = 0; dt < 4; ++dt) { bf16x8 vf; const LAS bf16* vb = VW + (4 * g) * VSW + dt * 16 + ln;
#pragma unroll
                for (int e = 0; e < 4; ++e) { vf[e] = (short)vb[e * VSW]; vf[4 + e] = (short)vb[(16 + e) * VSW]; }
                oacc[dt] = __builtin_amdgcn_mfma_f32_16x16x32_bf16(vf, pb, oacc[dt], 0, 0, 0); }
        }
        if (qok) { LAS float* ex = EX + (grp * 128 + ql) * EXS;
#pragma unroll
            for (int dt = 0; dt < 4; ++dt) { ex[dt * 16 + 4 * g + 0] = oacc[dt][0]; ex[dt * 16 + 4 * g + 1] = oacc[dt][1]; ex[dt * 16 + 4 * g + 2] = oacc[dt][2]; ex[dt * 16 + 4 * g + 3] = oacc[dt][3]; }
            if (g == 0) { ex[64] = mx; ex[65] = lsum; } }
    }
    __syncthreads();
    { const int ql = tid >> 2, d0 = (tid & 3) * 16;
      const LAS float* e0 = EX + (0 * 128 + ql) * EXS; const LAS float* e1 = EX + (1 * 128 + ql) * EXS; const LAS float* e2 = EX + (2 * 128 + ql) * EXS;
      const float m0 = e0[64], m1 = e1[64], m2 = e2[64], M = fmaxf(m0, fmaxf(m1, m2));
      const float w0 = __expf(m0 - M), w1 = __expf(m1 - M), w2 = __expf(m2 - M); const float inv = 1.f / (w0 * e0[65] + w1 * e1[65] + w2 * e2[65]);
      unsigned pk[8];
#pragma unroll
      for (int j = 0; j < 8; ++j) { const float x0 = (w0 * e0[d0 + 2 * j] + w1 * e1[d0 + 2 * j] + w2 * e2[d0 + 2 * j]) * inv, x1 = (w0 * e0[d0 + 2 * j + 1] + w1 * e1[d0 + 2 * j + 1] + w2 * e2[d0 + 2 * j + 1]) * inv; pk[j] = pk2(x0, x1); }
      u32x4* op = (u32x4*)(OB + ((size_t)bb * T + start + ql) * 1024 + h * 64 + d0);
      op[0] = (u32x4){pk[0], pk[1], pk[2], pk[3]}; op[1] = (u32x4){pk[4], pk[5], pk[6], pk[7]}; }
    __syncthreads();
}
}

template <int SP>
__device__ __forceinline__ void phase_body(const int l_in, LAS unsigned char* lds) {
    int tid_ = threadIdx.x, bid_ = blockIdx.x, l_ = l_in, G_ = gridDim.x; asm volatile("" : "+v"(tid_), "+s"(bid_), "+s"(l_), "+s"(G_));
    const int tid = tid_, lane = tid & 63, wave = __builtin_amdgcn_readfirstlane(tid >> 6), l = l_;
    const int G = G_, bid = bid_;
    const int gw = bid * NWAVES + wave, NGW = G * NWAVES;
    unsigned char* ws = (unsigned char*)gptr(ldptr(lds, 36));
    int* ctl = (int*)(ws + WS_CTL);
    bf16* XB = (bf16*)(ws + WS_XB); bf16* OB = (bf16*)(ws + WS_O); bf16* VF = (bf16*)(ws + WS_VF); bf16* P = (bf16*)(ws + WS_P);
    bf16* GS = (bf16*)(ws + WS_GS); bf16* MG = (bf16*)(ws + WS_MERGED); bf16* XS = (bf16*)(ws + WS_XS); bf16* HB = (bf16*)(ws + WS_H);
    bf16* WGU = (bf16*)(ws + WS_WGU); bf16* WD = (bf16*)(ws + WS_WD);
    float* X = (float*)gptr(ldptr(lds, 35));
    int* tok_e = (int*)(ws + WS_ROUTE); float* tok_g = (float*)(ws + WS_ROUTE + 256 * 1024); int* tok_rank = (int*)(ws + WS_ROUTE + 512 * 1024); int* tok_slot = (int*)(ws + WS_ROUTE + 768 * 1024);
    (void)ctl; (void)XB; (void)OB; (void)VF; (void)P; (void)GS; (void)MG; (void)XS; (void)HB; (void)WGU; (void)WD; (void)X; (void)tok_e; (void)tok_g; (void)tok_rank; (void)tok_slot; (void)gw; (void)NGW; (void)lane;
    {
        bf16* WinT = (bf16*)(ws + WS_WINT) + (size_t)l * 5120 * 1024; bf16* WgT = (bf16*)(ws + WS_WGT) + (size_t)l * 4096 * 1024;
        bf16* WbrT = (bf16*)(ws + WS_WBRT) + (size_t)l * 1024 * 1024; bf16* WoutT = (bf16*)(ws + WS_WOUTT) + (size_t)l * 1024 * 1024;
        float* WrT = (float*)(ws + WS_WRT) + (size_t)l * 36 * 1024;
        int* cnt = ctl + CW_CNT + l * 64;

        if constexpr (SP == -1) {
            LAS float* scr = (LAS float*)(lds + wave * 16384);
#pragma unroll 1
            for (int job = 0; job < NL * 11; ++job) {
                const int ll = job / 11, jk = job % 11;
                if (jk < 5) {
                    const float* W = INP(I_WIN) + (size_t)ll * 1024 * INW;
                    const int sc0 = jk == 0 ? 0 : (jk == 1 ? 3396 : (jk == 2 ? 3392 : (jk == 3 ? 5060 : 5064)));
                    const int snc = jk == 0 ? 3392 : (jk == 1 ? 1664 : (jk == 4 ? 4096 : 4));
                    const int sr0 = jk == 0 ? 0 : (jk == 1 ? 3392 : (jk == 2 ? 5056 : (jk == 3 ? 5060 : 0)));
                    bf16* dst = jk == 4 ? (bf16*)(ws + WS_WGT) + (size_t)ll * 4096 * 1024 : (bf16*)(ws + WS_WINT) + (size_t)ll * 5120 * 1024;
                    const int nbn = (snc + 31) / 32, nit = 16 * nbn;
#pragma unroll 1
                    for (int it = gw; it < nit; it += NGW) transpose_item(W, INW, sc0, snc, dst, 1024, sr0, 0, it / nbn, it % nbn, scr, lane);
                } else if (jk < 9) {
                    const int n = jk - 5; const float* Wb = INP(I_WBR) + ((size_t)ll * 4 + n) * 256 * 1024;
#pragma unroll 1
                    for (int it = gw; it < 4 * 32; it += NGW) transpose_item(Wb, 1024, 0, 1024, (bf16*)(ws + WS_WBRT) + (size_t)ll * 1024 * 1024, 1024, 0, n * 256, it / 32, it % 32, scr, lane);
                } else if (jk == 9) {
                    const float* Wo = INP(I_WOUT) + (size_t)ll * 1024 * 1024;
#pragma unroll 1
                    for (int it = gw; it < 16 * 32; it += NGW) transpose_item(Wo, 1024, 0, 1024, (bf16*)(ws + WS_WOUTT) + (size_t)ll * 1024 * 1024, 1024, 0, 0, it / 32, it % 32, scr, lane);
                } else {
                    bf16* wi = (bf16*)(ws + WS_WINT) + (size_t)ll * 5120 * 1024;
#pragma unroll 1
                    for (int i = gw * 64 + lane; i < 56 * 1024 / 8; i += NGW * 64) ((u32x4*)(wi + (size_t)5064 * 1024))[i] = (u32x4){0u, 0u, 0u, 0u};
                    float* wr = (float*)(ws + WS_WRT) + (size_t)ll * 36 * 1024; const float* rg = INP(I_RG) + (size_t)ll * 1024 * 4; const float* re = INP(I_RE) + (size_t)ll * 1024 * 32;
#pragma unroll 1
                    for (int i = gw * 64 + lane; i < 36 * 1024; i += NGW * 64) { const int o = i / 1024, k = i % 1024; wr[i] = o < 4 ? rg[k * 4 + o] : re[k * 32 + (o - 4)]; }
                }
            }
            for (int m = gw; m < M; m += NGW) {
                const f32x4* xr = (const f32x4*)(INP(I_X) + (size_t)m * D) + lane;
#pragma unroll
                for (int j = 0; j < 4; ++j) { const f32x4 v = xr[64 * j]; ((f32x4*)(X + (size_t)m * D))[lane + 64 * j] = v;
                    u32x2 w; w.x = pk2(v[0], v[1]); w.y = pk2(v[2], v[3]); ((u32x2*)(XB + (size_t)m * D))[lane + 64 * j] = w; }
            }
        }
        else if constexpr (SP == 0) {
            pg8::Gemm g{XB, WinT, 1024, 1024, 1024}; pg8::StaticOrder S; S.init(M, PP, G, bid, 1024, 1024);
            EpiStoreBf16 E{P, PP, 0, PP};
            pg8::gemm_phase<EpiStoreBf16, pg8::StaticOrder>(lds, g, S, E);
        }
        else if constexpr (SP == 12) {
            if (bid < 32) rw::carry(lds, ws + WS_RW + (size_t)bid * 64 * 16384, tid);
        }
        else if constexpr (SP == 13) {
            unsigned char* GZ = ws + WS_RW;
            const int h = bid & 3, k = bid >> 2;
            rw::build_ct(lds, l, h, lane, wave); __syncthreads();
#pragma unroll 1
            for (int idx = k; idx < 512; idx += (G >> 2)) { const int b = idx >> 6, cI = idx & 63; const size_t ci_ = (size_t)((b * 4 + h) * 64 + cI);
                rw::chunk_out(lds, b, h, cI * 64, GZ + ci_ * 16384, ws + WS_RW2 + ci_ * 24576, (const float*)(ws + WS_BONG) + ci_ * 64, VF, OB, tid); }
        }
        else if constexpr (SP == 15 || SP == 19) {
            unsigned char* GZ = ws + WS_RW;
            int* qctr = ctl + CW_Q + l * 64 + (SP == 19 ? 16 : 0);
            int cur_h = -1;
#pragma unroll 1
            for (;;) {
                unsigned so = (unsigned)(LDS_BYTES - 584); asm volatile("" : "+v"(so));
                volatile LAS int* slot = (volatile LAS int*)(lds + so);
                int tid = threadIdx.x; asm volatile("" : "+v"(tid));
                const int lane = tid & 63, wave = __builtin_amdgcn_readfirstlane(tid >> 6);
                __syncthreads();
                if (tid == 0) *slot = atomicAdd(qctr, 1);
                __syncthreads();
                const int it = __builtin_amdgcn_readfirstlane(*slot);
                if (it >= 3344) break;
                if (it < 16) { mb::chain(lds, l, it >> 1, it & 1, P, OB, tid, lane, wave); }
                else if (it < 272) { const int j = it - 16; bsp::item(lds, j & 7, 31 - (j >> 3), P, OB, tid, (int)(unsigned)ldptr(lds, 37)); }
                else if (it < 2320) { const int j = it - 272, h = j >> 9, idx = j & 511, b = idx >> 6, cI = idx & 63;
                    if (h != cur_h) { rw::build_ct(lds, l, h, lane, wave); cur_h = h; __syncthreads(); }
                    { const size_t ci_ = (size_t)((b * 4 + h) * 64 + cI); rw::chunk<(SP == 19 ? 5 : 1)>(lds, l, b, h, cI * 64, GZ + ci_ * 16384, ws + WS_RW2 + ci_ * 24576, (float*)(ws + WS_BONG) + ci_ * 64, P, VF, OB, tid); } }
                else { const int j = it - 2320; awin::item(lds, j >> 7, (j >> 2) & 31, j & 3, P, OB, tid); }
            }
        }
        else if constexpr (SP == 17 || SP == 18) {
            unsigned char* GZ = ws + WS_RW; int cur_h = -1;
#pragma unroll 1
            for (int k = 0; k < 8; ++k) { const int j = bid + 256 * k, h = j >> 9, idx = j & 511, b = idx >> 6, cI = idx & 63;
                if (h != cur_h) { rw::build_ct(lds, l, h, lane, wave); cur_h = h; __syncthreads(); }
                const size_t ci_ = (size_t)((b * 4 + h) * 64 + cI); rw::chunk<(SP == 17 ? 5 : 6)>(lds, l, b, h, cI * 64, GZ + ci_ * 16384, ws + WS_RW2 + ci_ * 24576, (float*)(ws + WS_BONG) + ci_ * 64, P, VF, OB, tid); }
        }
        else if constexpr (SP == 16) {
            bsp::item(lds, bid & 7, 31 - (bid >> 3), P, OB, tid, (int)(unsigned)ldptr(lds, 37) == 125 ? 300 : ((int)(unsigned)ldptr(lds, 37) == 126 ? 305 : (int)(unsigned)ldptr(lds, 37) + 80));
        }
        else if constexpr (SP == 4) {
            if (bid < 32) { rw::carry(lds, ws + WS_RW + (size_t)bid * 64 * 16384, tid); __syncthreads(); }
            pg8::Gemm g{XB, WgT, 1024, 1024, 1024}; SkewOrder S{M / 256, 16, (M / 256) * 16, bid, 1024, 1024};
            EpiStoreBf16 E{GS, 4096, 1, 4096};
            pg8::gemm_phase<EpiStoreBf16, SkewOrder>(lds, g, S, E);
        }
        else if constexpr (SP == 5) {
            pg8::Gemm g{OB, WbrT, 1024, 1024, 256}; BranchOrder S{M / 256, 4, G, bid};
            EpiBranch E{GS, MG};
            pg8::gemm_phase<EpiBranch, BranchOrder>(lds, g, S, E);
        }
        else if constexpr (SP == 6) {
            pg8::Gemm g{MG, WoutT, 1024, 1024, 1024}; pg8::StaticOrder S; S.init(M, 1024, G, bid, 1024, 1024);
            EpiResid E{X};
            pg8::gemm_phase<EpiResid, pg8::StaticOrder>(lds, g, S, E);
        }
        else if constexpr (SP == 7) {
            const float* g1 = INP(I_LN1G) + l * 1024; const float* b1 = INP(I_LN1B) + l * 1024;
            const float* rgb = INP(I_RGB) + l * 4; const float* reb = INP(I_REB) + l * 32;
            f32x4 vn[4];
#pragma unroll
            for (int j = 0; j < 4; ++j) vn[j] = ((const f32x4*)(X + (size_t)gw * D))[lane + 64 * j];
#pragma unroll 1
            for (int m = gw; m < M; m += NGW) {
                f32x4 v[4]; float s = 0.f; f32x4* xr = (f32x4*)(X + (size_t)m * D) + lane;
#pragma unroll
                for (int j = 0; j < 4; ++j) { v[j] = vn[j]; s += (v[j][0] + v[j][1]) + (v[j][2] + v[j][3]); }
                { const int mnx = (m + NGW < M) ? m + NGW : m;
#pragma unroll
                  for (int j = 0; j < 4; ++j) vn[j] = ((const f32x4*)(X + (size_t)mnx * D))[lane + 64 * j]; }
                const float mean = wave_sum(s) * (1.f / D); float s2 = 0.f;
#pragma unroll
                for (int j = 0; j < 4; ++j) { v[j] = v[j] - mean; s2 += (v[j][0] * v[j][0] + v[j][1] * v[j][1]) + (v[j][2] * v[j][2] + v[j][3] * v[j][3]); }
                const float rstd = rsqrtf(wave_sum(s2) * (1.f / D) + LN_EPS);
#pragma unroll
                for (int j = 0; j < 4; ++j) { const f32x4 gg = ((const f32x4*)g1)[lane + 64 * j], bb = ((const f32x4*)b1)[lane + 64 * j]; v[j] = v[j] * rstd * gg + bb; xr[64 * j] = v[j];
                    u32x2 w; w.x = pk2(v[j][0], v[j][1]); w.y = pk2(v[j][2], v[j][3]); ((u32x2*)(XB + (size_t)m * D))[lane + 64 * j] = w; }
                float mylg = 0.f;
#pragma unroll 1
                for (int o4 = 0; o4 < 36; o4 += 4) { float a4[4];
#pragma unroll
                    for (int u = 0; u < 4; ++u) { float a = 0.f;
#pragma unroll
                        for (int j = 0; j < 4; ++j) { const f32x4 wv = ((const f32x4*)(WrT + (o4 + u) * 1024))[lane + 64 * j]; a += v[j][0] * wv[0] + v[j][1] * wv[1] + v[j][2] * wv[2] + v[j][3] * wv[3]; }
                        a4[u] = a; }
#pragma unroll
                    for (int sft = 1; sft < 64; sft <<= 1) {
#pragma unroll
                        for (int u = 0; u < 4; ++u) a4[u] += __shfl_xor(a4[u], sft); }
#pragma unroll
                    for (int u = 0; u < 4; ++u) mylg = (lane == o4 + u) ? a4[u] : mylg; }
                mylg += lane < 4 ? rgb[lane & 3] : (lane < 36 ? reb[(lane - 4) & 31] : 0.f);
                float gl[4]; float gm = -INFINITY; int gs = 0;
#pragma unroll
                for (int o = 0; o < 4; ++o) { gl[o] = __shfl(mylg, o); if (gl[o] > gm) { gm = gl[o]; gs = o; } }
                float gden = 0.f;
#pragma unroll
                for (int o = 0; o < 4; ++o) gden += __expf(gl[o] - gm);
                const float pg = 1.f / gden;
                float el[8];
#pragma unroll
                for (int o = 0; o < 8; ++o) el[o] = __shfl(mylg, 4 + gs * 8 + o);
                int e1 = 0; float m1 = el[0];
#pragma unroll
                for (int o = 1; o < 8; ++o) if (el[o] > m1) { m1 = el[o]; e1 = o; }
                int e2 = -1; float m2 = -INFINITY;
#pragma unroll
                for (int o = 0; o < 8; ++o) if (o != e1 && el[o] > m2) { m2 = el[o]; e2 = o; }
                const float r2 = __expf(m2 - m1); const float ga = pg / (1.f + r2), gb = pg * r2 / (1.f + r2);
                if (lane == 0) {
                    const int E1 = gs * 8 + e1, E2 = gs * 8 + e2;
                    tok_e[m * 2] = E1; tok_e[m * 2 + 1] = E2; tok_g[m * 2] = ga; tok_g[m * 2 + 1] = gb;
                    tok_rank[m * 2] = atomicAdd(&cnt[E1], 1); tok_rank[m * 2 + 1] = atomicAdd(&cnt[E2], 1);
                }
            }
        }
        else if constexpr (SP == 14) {
            LAS float* scr = (LAS float*)(lds + wave * 16384);
            const float* eg = INP(I_EG) + (size_t)l * NEXP * 1024 * 512; const float* eu = INP(I_EU) + (size_t)l * NEXP * 1024 * 512; const float* ed = INP(I_ED) + (size_t)l * NEXP * 512 * 1024;
            for (int it = gw; it < NEXP * 2 * 4 * 64; it += NGW) {
                const int e = it / 512, r = it % 512, half = r / 256, ct = (r % 256) / 64, q = r % 64, kb = q / 4, nb = q % 4;
                const float* W = (half ? eu : eg) + (size_t)e * 1024 * 512;
                transpose_item(W, 512, ct * 128, 128, WGU + (size_t)e * 1024 * 1024, 1024, ct * 256 + half * 128, 0, kb, nb, scr, lane);
            }
            for (int it = gw; it < NEXP * 8 * 32; it += NGW) {
                const int e = it / 256, q = it % 256, kb = q / 32, nb = q % 32;
                transpose_item(ed + (size_t)e * 512 * 1024, 1024, 0, 1024, WD + (size_t)e * 1024 * 512, 512, 0, 0, kb, nb, scr, lane);
            }
        }
        else if constexpr (SP == 8 || SP == 9 || SP == 10) {
            unsigned tbo = MISC_OFF; asm volatile("" : "+v"(tbo));
            volatile LAS int* tb = (volatile LAS int*)(lds + tbo);
            if (tid == 0) { int acc = 0; for (int e = 0; e < 32; ++e) { const int c = __hip_atomic_load(&cnt[e], __ATOMIC_RELAXED, __HIP_MEMORY_SCOPE_AGENT); tb[e] = acc; tb[33 + e] = acc; acc += (c + 255) >> 8; } tb[32] = acc; }
            __syncthreads();
            if constexpr (SP == 8) {
                for (int m = gw; m < M; m += NGW) {
#pragma unroll
                    for (int k = 0; k < 2; ++k) { const int e = tok_e[m * 2 + k]; const int slot = tb[33 + e] * 256 + tok_rank[m * 2 + k];
                        const u32x4* src = (const u32x4*)(XB + (size_t)m * D); u32x4* dst = (u32x4*)(XS + (size_t)slot * D);
                        dst[lane] = src[lane]; dst[lane + 64] = src[lane + 64];
                        if (lane == 0) tok_slot[m * 2 + k] = slot; }
                }
            } else if constexpr (SP == 9) {
                pg8::Gemm g{XS, WGU, 1024, 1024, 1024}; MoeOrder S{tb, G, bid, (size_t)1024 * 2, (size_t)1024 * 1024 * 2, (size_t)256 * 1024 * 2};
                EpiSwiglu E{HB};
                pg8::gemm_phase<EpiSwiglu, MoeOrder>(lds, g, S, E);
            } else {
                pg8::Gemm g{HB, WD, 512, 512, 512}; MoeOrder S{tb, G, bid, (size_t)512 * 2, (size_t)1024 * 512 * 2, (size_t)256 * 512 * 2};
                EpiStoreBf16 E{XS, 1024, 0, 1024};
                pg8::gemm_phase<EpiStoreBf16, MoeOrder>(lds, g, S, E);
            }
        }
        else if constexpr (SP == 11) {
            const float* g2 = INP(I_LN2G) + l * 1024; const float* b2 = INP(I_LN2B) + l * 1024;
            f32x4 xn[4]; u32x2 y1n[4], y2n[4]; float gan, gbn;
#define LN2_LOAD(mm) do { const int s1_ = tok_slot[(mm) * 2], s2_ = tok_slot[(mm) * 2 + 1]; gan = tok_g[(mm) * 2]; gbn = tok_g[(mm) * 2 + 1]; \
                _Pragma("unroll") for (int j = 0; j < 4; ++j) { xn[j] = ((const f32x4*)(X + (size_t)(mm) * D))[lane + 64 * j]; y1n[j] = ((const u32x2*)(XS + (size_t)s1_ * D))[lane + 64 * j]; y2n[j] = ((const u32x2*)(XS + (size_t)s2_ * D))[lane + 64 * j]; } } while (0)
            LN2_LOAD(gw);
#pragma unroll 1
            for (int m = gw; m < M; m += NGW) {
                const float ga = gan, gb = gbn;
                f32x4 v[4]; float s = 0.f; f32x4* xr = (f32x4*)(X + (size_t)m * D) + lane;
                u32x2 y1c[4], y2c[4];
#pragma unroll
                for (int j = 0; j < 4; ++j) { v[j] = xn[j] * ALPHA; y1c[j] = y1n[j]; y2c[j] = y2n[j]; }
                { const int mnx = (m + NGW < M) ? m + NGW : m; LN2_LOAD(mnx); }
#pragma unroll
                for (int j = 0; j < 4; ++j) { const u32x2 y1 = y1c[j], y2 = y2c[j];
                    v[j][0] += ga * __uint_as_float(y1.x << 16) + gb * __uint_as_float(y2.x << 16); v[j][1] += ga * __uint_as_float(y1.x & 0xffff0000u) + gb * __uint_as_float(y2.x & 0xffff0000u);
                    v[j][2] += ga * __uint_as_float(y1.y << 16) + gb * __uint_as_float(y2.y << 16); v[j][3] += ga * __uint_as_float(y1.y & 0xffff0000u) + gb * __uint_as_float(y2.y & 0xffff0000u);
                    s += (v[j][0] + v[j][1]) + (v[j][2] + v[j][3]); }
                const float mean = wave_sum(s) * (1.f / D); float s2 = 0.f;
#pragma unroll
                for (int j = 0; j < 4; ++j) { v[j] = v[j] - mean; s2 += (v[j][0] * v[j][0] + v[j][1] * v[j][1]) + (v[j][2] * v[j][2] + v[j][3] * v[j][3]); }
                const float rstd = rsqrtf(wave_sum(s2) * (1.f / D) + LN_EPS);
#pragma unroll
                for (int j = 0; j < 4; ++j) { const f32x4 gg = ((const f32x4*)g2)[lane + 64 * j], bb = ((const f32x4*)b2)[lane + 64 * j]; v[j] = v[j] * rstd * gg + bb; xr[64 * j] = v[j];
                    u32x2 w; w.x = pk2(v[j][0], v[j][1]); w.y = pk2(v[j][2], v[j][3]); ((u32x2*)(XB + (size_t)m * D))[lane + 64 * j] = w; }
            }
        }
    }
}

template <int SP>
__global__ void __launch_bounds__(NTHR, 2) k_phase(Args args, int l) {
    extern __shared__ __attribute__((aligned(16))) unsigned char lds_raw[];
    ptr_table_fill(args, (LAS unsigned char*)lds_raw);
    phase_body<SP>(l, (LAS unsigned char*)lds_raw);
}


#define XB_TMO      128
#define XB_XCNT(j)  (256  + 64 * (j))
#define XB_XSUB(j)  (1280 + 64 * (j))
#define XB_XGEN(j)  (2304 + 64 * (j))
#define XB_TOP      3328
#define XB_TOPGEN   3392
#define XCD_BAR_WORDS 3456
#define XB_SPIN_CAP (1u << 22)
__device__ __forceinline__ unsigned xb_ld(unsigned* p)              { return __hip_atomic_load(p, __ATOMIC_RELAXED, __HIP_MEMORY_SCOPE_AGENT); }
__device__ __forceinline__ unsigned xb_add(unsigned* p, unsigned v) { return __hip_atomic_fetch_add(p, v, __ATOMIC_RELAXED, __HIP_MEMORY_SCOPE_AGENT); }
__device__ __forceinline__ unsigned xb_xcc_id() { return (unsigned)__builtin_amdgcn_s_getreg((3 << 11) | 20) & 0xFu; }
#define XB_SPIN(cond, bar) do { unsigned _sp = 0; while (cond) { __builtin_amdgcn_s_sleep(1); \
    if ((++_sp & 255u) == 0u) { if (xb_ld(&(bar)[XB_TMO])) break; if (_sp > XB_SPIN_CAP) { atomicAdd(&(bar)[XB_TMO], 1u); break; } } } } while (0)
__device__ __forceinline__ void xcd_barrier_complete(unsigned* bar, unsigned x, unsigned& nloc, unsigned& nx) {
    const unsigned G = gridDim.x;
    unsigned sum, cnt, mine, sp = 0u;
    for (;;) {
        sum = 0u; cnt = 0u; mine = 0u;
#pragma unroll
        for (unsigned j = 0; j < 16; ++j) { const unsigned c = xb_ld(&bar[XB_XCNT(j)]); sum += c; cnt += (c > 0u) ? 1u : 0u; mine = (j == x) ? c : mine; }
        if (sum == G) break;
        __builtin_amdgcn_s_sleep(1);
        if ((++sp & 255u) == 0u) { if (xb_ld(&bar[XB_TMO])) break; if (sp > XB_SPIN_CAP) { atomicAdd(&bar[XB_TMO], 1u); break; } }
    }
    nloc = mine > 0u ? mine : 1u; nx = cnt > 0u ? cnt : 1u;
}
__device__ __forceinline__ void xcd_barrier(unsigned* bar, LAS unsigned char* lds) {
    asm volatile("s_waitcnt vmcnt(0)" ::: "memory");
    __syncthreads();
    int tid_ = threadIdx.x; asm volatile("" : "+v"(tid_));
    if (tid_ == 0) {
        unsigned so = (unsigned)(LDS_BYTES - 576); asm volatile("" : "+v"(so));
        volatile LAS unsigned* st = (volatile LAS unsigned*)(lds + so);
        __builtin_amdgcn_s_waitcnt(0);
        const unsigned x = xb_xcc_id();
        unsigned nloc = st[0], nx = st[1];
        if (nloc == 0u) { xcd_barrier_complete(bar, x, nloc, nx); st[0] = nloc; st[1] = nx; }
        const unsigned old = xb_add(&bar[XB_XSUB(x)], 1u);
        const unsigned gen = old / nloc;
        if (old + 1u == (gen + 1u) * nloc) {
            __builtin_amdgcn_fence(__ATOMIC_RELEASE, "agent");
            asm volatile("s_waitcnt vmcnt(0)" ::: "memory");
            const unsigned og = xb_add(&bar[XB_TOP], 1u);
            const unsigned tg = og / nx;
            if (og + 1u == (tg + 1u) * nx) xb_add(&bar[XB_TOPGEN], 1u);
            else XB_SPIN(xb_ld(&bar[XB_TOPGEN]) == tg, bar);
            __builtin_amdgcn_fence(__ATOMIC_ACQUIRE, "agent");
            xb_add(&bar[XB_XGEN(x)], 1u);
            asm volatile("s_waitcnt vmcnt(0)" ::: "memory");
        } else {
            XB_SPIN(xb_ld(&bar[XB_XGEN(x)]) == gen, bar);
            __builtin_amdgcn_fence(__ATOMIC_ACQUIRE, "agent");
            asm volatile("s_waitcnt vmcnt(0)" ::: "memory");
        }
    }
    __syncthreads();
}
namespace cg = cooperative_groups;
__global__ void __launch_bounds__(NTHR, 2) fwd_all(Args args) {
    extern __shared__ __attribute__((aligned(16))) unsigned char lds_raw[];
    LAS unsigned char* lds = (LAS unsigned char*)lds_raw;
    unsigned* bar = (unsigned*)(args.ws + WS_CTL) + CW_BAR;
    if (threadIdx.x == 0) { ((volatile LAS unsigned*)(lds + LDS_BYTES - 576))[0] = 0u; ((volatile LAS unsigned*)(lds + LDS_BYTES - 576))[1] = 0u; (void)xb_add(&bar[XB_XCNT(xb_xcc_id())], 1u); }
    ptr_table_fill(args, lds);
    const int probe = args.ph_lo;
    { constexpr int l = 0;
#pragma unroll 1
      for (int r_ = 0; r_ < ((probe == -1) ? 2 : 1); ++r_) { phase_body<-1>(l, lds); __syncthreads(); } }
    cg::this_grid().sync();
#define GRID_BAR() do { unsigned* bar_ = (unsigned*)gptr(ldptr(lds, 36)) + CW_BAR; xcd_barrier(bar_, lds); } while (0)
#define RUN(SP) do { _Pragma("unroll 1") for (int r_ = 0; r_ < ((probe == (SP)) ? 2 : 1); ++r_) { phase_body<SP>(l, lds); __syncthreads(); } } while (0)
#define ONCE(SP) do { phase_body<SP>(l, lds); __syncthreads(); } while (0)
#define LAYER() \
        RUN(0); GRID_BAR(); \
        ONCE(15); GRID_BAR(); \
        if (probe == 132) { ONCE(19); GRID_BAR(); } \
        if (probe == 130) { ONCE(17); GRID_BAR(); } \
        if (probe == 131) { ONCE(18); GRID_BAR(); } \
        if (probe >= 119 && probe < 130) { ONCE(16); GRID_BAR(); } \
        ONCE(4); GRID_BAR(); \
        RUN(13); GRID_BAR(); \
        RUN(5); GRID_BAR(); \
        ONCE(6); GRID_BAR(); \
        ONCE(7); RUN(14); GRID_BAR(); \
        RUN(8); GRID_BAR(); \
        RUN(9); GRID_BAR(); \
        RUN(10); GRID_BAR(); \
        ONCE(11); GRID_BAR();
    { constexpr int l = 0; LAYER() }
    { constexpr int l = 1; LAYER() }
#undef LAYER
#undef RUN
#undef ONCE
#undef GRID_BAR
}

template <int SP> static void launch_phase(const Args& a, int l, int grid, hipStream_t stream) {
    static bool attr = false;
    if (!attr) { (void)hipFuncSetAttribute((const void*)k_phase<SP>, hipFuncAttributeMaxDynamicSharedMemorySize, LDS_BYTES); attr = true; }
    hipLaunchKernelGGL(k_phase<SP>, dim3(grid), dim3(NTHR), LDS_BYTES, stream, a, l);
}

extern "C" void kernel_launch(void* const* d_in, const int* in_sizes, int n_in, void* d_out, int out_size, void* d_ws, size_t ws_size, hipStream_t stream) {
    static int grid = 0;
    if (grid == 0) {
        if (n_in != 35 || out_size != M * D || ws_size < WS_END) { fprintf(stderr, "kernel_launch: unexpected problem (n_in %d out %d ws %zu)\n", n_in, out_size, ws_size); grid = -1; return; }
        int dev = 0, cus = 0, per_cu = 0;
        (void)hipGetDevice(&dev); (void)hipDeviceGetAttribute(&cus, hipDeviceAttributeMultiprocessorCount, dev);
#if N_LAUNCH_MODE == 1
        (void)hipFuncSetAttribute((const void*)fwd_all, hipFuncAttributeMaxDynamicSharedMemorySize, LDS_BYTES);
        if (hipOccupancyMaxActiveBlocksPerMultiprocessor(&per_cu, (const void*)fwd_all, NTHR, LDS_BYTES) != hipSuccess || per_cu < 1) { fprintf(stderr, "kernel_launch: occupancy query says %d blocks/CU\n", per_cu); grid = -1; return; }
#endif
        (void)per_cu;
        grid = cus;
        if (grid != 256) { fprintf(stderr, "kernel_launch: built for 256 CUs, found %d\n", cus); grid = -1; return; }
    }
    if (grid < 0) return;
    (void)hipMemsetAsync((char*)d_ws + WS_CTL, 0, CTL_BYTES, stream);
    Args a{};
    for (int i = 0; i < 35; ++i) a.in[i] = (const float*)d_in[i];
    a.out = (float*)d_out; a.ws = (unsigned char*)d_ws;
#if N_LAUNCH_MODE == 1
    a.ph_lo = PROBE_REPS;
    void* kargs[] = {(void*)&a};
    hipError_t e = hipLaunchCooperativeKernel((const void*)fwd_all, dim3(grid), dim3(NTHR), kargs, LDS_BYTES, stream);
    if (e != hipSuccess) fprintf(stderr, "cooperative launch failed: %s\n", hipGetErrorString(e));
#else
    launch_phase<-1>(a, 0, grid, stream);
    for (int l = 0; l < NL; ++l) {
        launch_phase<0>(a, l, grid, stream); launch_phase<15>(a, l, grid, stream); launch_phase<4>(a, l, grid, stream); launch_phase<13>(a, l, grid, stream);
        launch_phase<5>(a, l, grid, stream); launch_phase<6>(a, l, grid, stream); launch_phase<7>(a, l, grid, stream); launch_phase<14>(a, l, grid, stream);
        launch_phase<8>(a, l, grid, stream); launch_phase<9>(a, l, grid, stream); launch_phase<10>(a, l, grid, stream); launch_phase<11>(a, l, grid, stream);
    }
#endif
}
```

```cpp
#include <hip/hip_runtime.h>
#include <type_traits>
#include <cstdio>
#include <cstdint>
#include <hip/hip_cooperative_groups.h>

#ifndef PROBE_REPS
#define PROBE_REPS -100
#endif
#ifndef N_LAUNCH_MODE
#define N_LAUNCH_MODE 1
#endif

namespace pg8 {
#define PG8_LAS __attribute__((address_space(3)))
typedef unsigned short bf16_t;
typedef short bf16x8 __attribute__((ext_vector_type(8)));
typedef float f32x4 __attribute__((ext_vector_type(4)));
typedef unsigned u32x4 __attribute__((ext_vector_type(4)));
constexpr int BM = 256, BK = 64, HALF = 128, HTB = HALF * BK * 2, STAGE_BYTES = 8 * HTB, NXCD = 8, WGM = 8;

__host__ __device__ __forceinline__ int lds_byte(int r, int c) { const int st = (r >> 4) * 2 + (c >> 5), rr = r & 15, cc = c & 31, ob = rr * 64 + cc * 2; return st * 1024 + (ob ^ (((ob >> 9) & 1) << 5)); }
__host__ __device__ __forceinline__ void stage_rc(int b, int& R, int& C) { const int st = b / 1024, sb = b % 1024, swz = sb ^ (((sb >> 9) & 1) << 5); R = (st >> 1) * 16 + swz / 64; C = (st & 1) * 32 + (swz % 64) / 2; }
__host__ __device__ __forceinline__ int perm32(int rho) { const int n = rho >> 4, i = rho & 15; return 8 * (i >> 2) + 4 * n + (i & 3); }

struct Unit { int pm, pn, aux; size_t aoff, boff; };
struct Gemm { const bf16_t* A; const bf16_t* Bt; int lda, ldb, K; };

__device__ __forceinline__ void tile_of(int L, int nM, int nN, int& pm, int& pn) {
    const int nwg = nM * nN; int wgid = L;
    { const int q = nwg / NXCD, r = nwg % NXCD, xcd = wgid % NXCD, off = wgid / NXCD; wgid = (xcd < r ? xcd * (q + 1) : r * (q + 1) + (xcd - r) * q) + off; }
    const int nig = WGM * nN, gid = wgid / nig, fm = gid * WGM, gsz = (nM - fm) < WGM ? (nM - fm) : WGM;
    pm = fm + ((wgid % nig) % gsz); pn = (wgid % nig) / gsz;
}
struct StaticOrder {
    int nM, nN, nwg, G, c, lda, ldb;
    __device__ void init(int M, int N, int G_, int c_, int lda_, int ldb_) { nM = M / BM; nN = N / BM; nwg = nM * nN; G = G_; c = c_; lda = lda_; ldb = ldb_; }
    __device__ bool next(int i, Unit& u) const {
        const long L = (long)i * G + c; if (L >= nwg) return false;
        tile_of((int)L, nM, nN, u.pm, u.pn); u.aux = 0;
        u.aoff = (size_t)u.pm * BM * lda * 2; u.boff = (size_t)u.pn * BM * ldb * 2; return true;
    }
};

__device__ __forceinline__ unsigned cvt_pk_bf16(float lo, float hi) { typedef __bf16 b2_ __attribute__((ext_vector_type(2))); typedef float f2_ __attribute__((ext_vector_type(2))); return __builtin_bit_cast(unsigned, __builtin_convertvector((f2_){lo, hi}, b2_)); }
__device__ __forceinline__ void epi_mfma_settle(const f32x4 (&acc)[2][2][4][2]) {
    asm volatile("s_nop 11" :: "v"(acc[1][0][0][0]), "v"(acc[1][0][0][1]), "v"(acc[1][0][1][0]), "v"(acc[1][0][1][1]), "v"(acc[1][0][2][0]), "v"(acc[1][0][2][1]), "v"(acc[1][0][3][0]), "v"(acc[1][0][3][1]),
                                "v"(acc[1][1][0][0]), "v"(acc[1][1][0][1]), "v"(acc[1][1][1][0]), "v"(acc[1][1][1][1]), "v"(acc[1][1][2][0]), "v"(acc[1][1][2][1]), "v"(acc[1][1][3][0]), "v"(acc[1][1][3][1]) : "memory"); }

template <class Epi, class Sched, bool ALIGN_EPI = true, bool SP2 = true>
__device__ __forceinline__ void gemm_phase(PG8_LAS unsigned char* lds, const Gemm g, const Sched& S, const Epi& E) {
    int tid_ = threadIdx.x; asm volatile("" : "+v"(tid_));
    const int tid = tid_, wid = __builtin_amdgcn_readfirstlane(tid >> 6), lane = tid & 63, wr = wid >> 2, wc = wid & 3, fr = lane & 15, fq = lane >> 4;
    const int K = g.K, nt = K / BK;
    unsigned voffA[2], voffB[2];
#pragma unroll
    for (int i = 0; i < 2; ++i) { int R, C; stage_rc(tid * 16 + i * 8192, R, C); const int Rb = Epi::PERM ? ((R & ~31) + perm32(R & 31)) : R;
        voffA[i] = (unsigned)(R * g.lda + C) * 2u; voffB[i] = (unsigned)(Rb * g.ldb + C) * 2u; }
    const size_t kstep = (size_t)(BK * 2);
    const size_t hstepA = (size_t)HALF * g.lda * 2, hstepB = (size_t)HALF * g.ldb * 2;
    const unsigned ldsw = (unsigned)wid * 1024u;
    const int aoff = lds_byte(wr * 64 + fr, fq * 8), boff = lds_byte(wc * 32 + fr, fq * 8);
#define PG8_SA(b, h) (((b) * 2 + (h)) * HTB)
#define PG8_SB(b, h) ((4 + (b) * 2 + (h)) * HTB)
#define PG8_STAGE(bufoff, gbase, voff) do { _Pragma("unroll") for (int _i = 0; _i < 2; ++_i) \
        __builtin_amdgcn_global_load_lds((const unsigned*)((const char*)(gbase) + (voff)[_i]), (PG8_LAS unsigned*)(lds + (bufoff) + ldsw + _i * 8192), 16, 0, 0); } while (0)
#define PG8_LDA(dst, b, h) do { _Pragma("unroll") for (int m = 0; m < 4; ++m) _Pragma("unroll") for (int k = 0; k < 2; ++k) dst[m][k] = *(const PG8_LAS bf16x8*)(lds + PG8_SA(b, h) + aoff + m * 2048 + k * 1024); } while (0)
#define PG8_LDB(dst, b, h) do { _Pragma("unroll") for (int n = 0; n < 2; ++n) _Pragma("unroll") for (int k = 0; k < 2; ++k) dst[n][k] = *(const PG8_LAS bf16x8*)(lds + PG8_SB(b, h) + boff + n * 2048 + k * 1024); } while (0)
#define PG8_MMA(ai, bj, At, Bt) do { __builtin_amdgcn_s_setprio(1); _Pragma("unroll") for (int m = 0; m < 4; ++m) _Pragma("unroll") for (int n = 0; n < 2; ++n) _Pragma("unroll") for (int k = 0; k < 2; ++k) \
        acc[ai][bj][m][n] = __builtin_amdgcn_mfma_f32_16x16x32_bf16(Bt[n][k], At[m][k], acc[ai][bj][m][n], 0, 0, 0); __builtin_amdgcn_s_setprio(0); } while (0)
#define PG8_WAIT_V(n) asm volatile("s_waitcnt vmcnt(" #n ")" ::: "memory")
#define PG8_WAIT_L(n) asm volatile("s_waitcnt lgkmcnt(" #n ")" ::: "memory")
#define PG8_BAR __builtin_amdgcn_s_barrier()
#define PG8_SCHED __builtin_amdgcn_sched_barrier(0)
    Unit cur, nxt; int ui = 0;
    if (!S.next(0, cur)) return;
    f32x4 acc[2][2][4][2];
#pragma unroll
    for (int a = 0; a < 2; ++a)
#pragma unroll
        for (int b = 0; b < 2; ++b)
#pragma unroll
            for (int m = 0; m < 4; ++m)
#pragma unroll
                for (int n = 0; n < 2; ++n) acc[a][b][m][n] = (f32x4){0.f, 0.f, 0.f, 0.f};
    bf16x8 At[4][2], B0[2][2], B1[2][2];
    const char* cA = (const char*)g.A + cur.aoff; const char* cB = (const char*)g.Bt + cur.boff;
    if constexpr (SP2) {
        PG8_STAGE(PG8_SB(0, 0), cB, voffB); PG8_STAGE(PG8_SB(0, 1), cB + hstepB, voffB); PG8_STAGE(PG8_SA(0, 0), cA, voffA); PG8_STAGE(PG8_SA(0, 1), cA + hstepA, voffA);
        if (wr == 1) PG8_BAR;
        PG8_WAIT_V(2); PG8_BAR;
        PG8_STAGE(PG8_SB(1, 0), cB + kstep, voffB); PG8_STAGE(PG8_SA(1, 0), cA + kstep, voffA); PG8_STAGE(PG8_SB(1, 1), cB + hstepB + kstep, voffB);
        PG8_WAIT_V(6); PG8_BAR;
    } else {
        PG8_STAGE(PG8_SB(0, 0), cB, voffB); PG8_STAGE(PG8_SA(0, 0), cA, voffA); PG8_STAGE(PG8_SB(0, 1), cB + hstepB, voffB); PG8_STAGE(PG8_SA(0, 1), cA + hstepA, voffA);
        if (wr == 1) PG8_BAR;
        PG8_WAIT_V(4); PG8_BAR;
        PG8_STAGE(PG8_SB(1, 0), cB + kstep, voffB); PG8_STAGE(PG8_SA(1, 0), cA + kstep, voffA); PG8_STAGE(PG8_SB(1, 1), cB + hstepB + kstep, voffB);
        PG8_WAIT_V(6); PG8_BAR;
    }
    for (;;) {
        const bool has_next = S.next(ui + 1, nxt);
        const char* nA = has_next ? (const char*)g.A + nxt.aoff : cA; const char* nB = has_next ? (const char*)g.Bt + nxt.boff : cB;
#pragma unroll 1
        for (int t = 0; t < nt; t += 2) {
            const bool last = (t == nt - 2);
            const char* a1 = cA + (size_t)(t + 1) * kstep;
            const char* a2 = last ? nA : cA + (size_t)(t + 2) * kstep; const char* b2 = last ? nB : cB + (size_t)(t + 2) * kstep;
            const char* a3 = a2 + kstep; const char* b3 = b2 + kstep;
            if constexpr (SP2) {
            PG8_LDB(B0, 0, 0); PG8_LDB(B1, 0, 1); PG8_SCHED; PG8_LDA(At, 0, 0); PG8_STAGE(PG8_SA(1, 1), a1 + hstepA, voffA);
            PG8_WAIT_V(8); PG8_WAIT_L(0); PG8_BAR; PG8_MMA(0, 0, At, B0); PG8_MMA(0, 1, At, B1); PG8_BAR; PG8_SCHED;
            PG8_LDA(At, 0, 1); PG8_STAGE(PG8_SB(0, 0), b2, voffB); PG8_STAGE(PG8_SB(0, 1), b2 + hstepB, voffB); PG8_STAGE(PG8_SA(0, 0), a2, voffA);
            PG8_WAIT_V(8); PG8_WAIT_L(0); PG8_BAR; PG8_MMA(1, 0, At, B0); PG8_MMA(1, 1, At, B1); PG8_BAR; PG8_SCHED;
            PG8_LDB(B0, 1, 0); PG8_LDB(B1, 1, 1); PG8_SCHED; PG8_LDA(At, 1, 0); PG8_STAGE(PG8_SA(0, 1), a2 + hstepA, voffA);
            PG8_WAIT_V(8); PG8_WAIT_L(0); PG8_BAR; PG8_MMA(0, 0, At, B0); PG8_MMA(0, 1, At, B1); PG8_BAR; PG8_SCHED;
            PG8_LDA(At, 1, 1); PG8_STAGE(PG8_SB(1, 0), b3, voffB); PG8_STAGE(PG8_SB(1, 1), b3 + hstepB, voffB); PG8_STAGE(PG8_SA(1, 0), a3, voffA);
            PG8_WAIT_V(8); PG8_WAIT_L(0); PG8_BAR; PG8_MMA(1, 0, At, B0); PG8_MMA(1, 1, At, B1); PG8_BAR; PG8_SCHED;
            } else {
            PG8_LDB(B0, 0, 0); PG8_SCHED; PG8_LDA(At, 0, 0); PG8_STAGE(PG8_SA(1, 1), a1 + hstepA, voffA);
            PG8_WAIT_L(8); PG8_BAR; PG8_WAIT_L(0); PG8_MMA(0, 0, At, B0); PG8_BAR; PG8_SCHED;
            PG8_LDB(B1, 0, 1); PG8_STAGE(PG8_SB(0, 0), b2, voffB);
            PG8_BAR; PG8_WAIT_L(0); PG8_MMA(0, 1, At, B1); PG8_BAR;
            PG8_LDA(At, 0, 1); PG8_STAGE(PG8_SA(0, 0), a2, voffA);
            PG8_BAR; PG8_WAIT_L(0); PG8_MMA(1, 0, At, B0); PG8_BAR; PG8_SCHED;
            PG8_STAGE(PG8_SB(0, 1), b2 + hstepB, voffB);
            PG8_WAIT_V(6); PG8_BAR; PG8_MMA(1, 1, At, B1); PG8_BAR;
            PG8_LDB(B0, 1, 0); PG8_SCHED; PG8_LDA(At, 1, 0); PG8_STAGE(PG8_SA(0, 1), a2 + hstepA, voffA);
            PG8_WAIT_L(8); PG8_BAR; PG8_WAIT_L(0); PG8_MMA(0, 0, At, B0); PG8_BAR; PG8_SCHED;
            PG8_LDB(B1, 1, 1); PG8_STAGE(PG8_SB(1, 0), b3, voffB);
            PG8_BAR; PG8_WAIT_L(0); PG8_MMA(0, 1, At, B1); PG8_BAR;
            PG8_LDA(At, 1, 1); PG8_STAGE(PG8_SA(1, 0), a3, voffA);
            PG8_BAR; PG8_WAIT_L(0); PG8_MMA(1, 0, At, B0); PG8_BAR; PG8_SCHED;
            PG8_STAGE(PG8_SB(1, 1), b3 + hstepB, voffB);
            PG8_WAIT_V(6); PG8_BAR; PG8_MMA(1, 1, At, B1); PG8_BAR;
            }
        }
        if constexpr (ALIGN_EPI) { if (wr == 0) PG8_BAR; }
        E(acc, cur, wr, wc, fr, fq);
        if (!has_next) break;
#pragma unroll
        for (int a = 0; a < 2; ++a)
#pragma unroll
            for (int b = 0; b < 2; ++b)
#pragma unroll
                for (int m = 0; m < 4; ++m)
#pragma unroll
                    for (int n = 0; n < 2; ++n) acc[a][b][m][n] = (f32x4){0.f, 0.f, 0.f, 0.f};
        cur = nxt; cA = nA; cB = nB; ++ui;
        if constexpr (ALIGN_EPI) { if (wr == 1) PG8_BAR; }
    }
    PG8_WAIT_V(0);
    if constexpr (!ALIGN_EPI) { if (wr == 0) PG8_BAR; }
    PG8_BAR;
#undef PG8_SA
#undef PG8_SB
#undef PG8_STAGE
#undef PG8_LDA
#undef PG8_LDB
#undef PG8_MMA
#undef PG8_WAIT_V
#undef PG8_WAIT_L
#undef PG8_BAR
#undef PG8_SCHED
}
}

#define LAS __attribute__((address_space(3)))
typedef unsigned short bf16;
typedef float f32x4 __attribute__((ext_vector_type(4)));
typedef unsigned u32x4 __attribute__((ext_vector_type(4)));
typedef unsigned u32x2 __attribute__((ext_vector_type(2)));

constexpr int NB = 8, T = 4096, D = 1024, M = NB * T, NL = 2;
constexpr int INW = 9160;
constexpr int PP = 5120;
constexpr int C_AQ = 0, C_AK = 768, C_AV = 1536, C_BQ = 2304, C_BK = 2560, C_BV = 2816, C_IQ = 3072, C_IK = 3328, C_C = 3392, C_DZ = 4288, C_DX = 4544, C_IW = 5056, C_DT = 5060, C_END = 5064;
constexpr int NEXP = 32, DEXP = 512;
constexpr int CAP = 73728;
constexpr float LN_EPS = 1e-5f;
constexpr float ALPHA = 1.4142135623730951f;

constexpr size_t MiB = 1u << 20;
constexpr size_t WS_CTL = 0, CTL_BYTES = 1 * MiB;
constexpr size_t WS_WINT = 2 * MiB;
constexpr size_t WS_WGT = 22 * MiB;
constexpr size_t WS_WBRT = 38 * MiB;
constexpr size_t WS_WOUTT = 42 * MiB;
constexpr size_t WS_WRT = 46 * MiB;
constexpr size_t WS_LORA = WS_WRT + 288 * 1024;
constexpr size_t WS_ROUTE = 47 * MiB;
constexpr size_t WS_XB = 48 * MiB;
constexpr size_t WS_O = 112 * MiB;
constexpr size_t WS_VF = 176 * MiB;
constexpr size_t WS_P = 192 * MiB;
constexpr size_t WS_GS = 192 * MiB;
constexpr size_t WS_MERGED = 448 * MiB;
constexpr size_t WS_XS = 192 * MiB;
constexpr size_t WS_H = 336 * MiB;
constexpr size_t WS_WGU = 408 * MiB;
constexpr size_t WS_WD = 472 * MiB;
constexpr size_t WS_RW = 512 * MiB;
constexpr size_t WS_RW2 = 544 * MiB;
constexpr size_t WS_BONG = 46 * MiB + 512 * 1024;
constexpr size_t WS_END = 592 * MiB;
constexpr int CW_CNT = 64, CW_Q = 256, CW_BAR = 4096;

constexpr int RING_BYTES = 131072, MISC_OFF = RING_BYTES, LDS_BYTES = 147456;
constexpr int NWAVES = 8, NTHR = 512;

__device__ __forceinline__ float bf2f(bf16 v) { return __uint_as_float(((unsigned)v) << 16); }
__device__ __forceinline__ unsigned pk2(float lo, float hi) { return pg8::cvt_pk_bf16(lo, hi); }
__device__ __forceinline__ unsigned f2bf(float f) { unsigned u = __float_as_uint(f); return (u + 0x7fffu + ((u >> 16) & 1u)) >> 16; }
#define DPP_ADD(v, ctrl) v += __builtin_bit_cast(float, __builtin_amdgcn_update_dpp(0, __builtin_bit_cast(int, v), ctrl, 0xF, 0xF, true))
#define DPP_MAX(v, ctrl) v = fmaxf(v, __builtin_bit_cast(float, __builtin_amdgcn_update_dpp(0, __builtin_bit_cast(int, v), ctrl, 0xF, 0xF, true)))
__device__ __forceinline__ float wave_sum(float v) {
    DPP_ADD(v, 0xB1); DPP_ADD(v, 0x4E); DPP_ADD(v, 0x141); DPP_ADD(v, 0x140);
    { const auto r = __builtin_amdgcn_permlane16_swap(__float_as_uint(v), __float_as_uint(v), false, false); v = __uint_as_float(r[0]) + __uint_as_float(r[1]); }
    { const auto r = __builtin_amdgcn_permlane32_swap(__float_as_uint(v), __float_as_uint(v), false, false); v = __uint_as_float(r[0]) + __uint_as_float(r[1]); }
    return v;
}
__device__ __forceinline__ float wave_max(float v) {
    DPP_MAX(v, 0xB1); DPP_MAX(v, 0x4E); DPP_MAX(v, 0x141); DPP_MAX(v, 0x140);
    { const auto r = __builtin_amdgcn_permlane16_swap(__float_as_uint(v), __float_as_uint(v), false, false); v = fmaxf(__uint_as_float(r[0]), __uint_as_float(r[1])); }
    { const auto r = __builtin_amdgcn_permlane32_swap(__float_as_uint(v), __float_as_uint(v), false, false); v = fmaxf(__uint_as_float(r[0]), __uint_as_float(r[1])); }
    return v;
}
__device__ __forceinline__ float sigmoid_div_(float x) { return 1.f / (1.f + __expf(-x)); }
__device__ __forceinline__ float sigmoidf_(float x) { return __builtin_amdgcn_rcpf(1.f + __expf(-x)); }
__device__ __forceinline__ float softplusf_(float x) { return x > 20.f ? x : __logf(1.f + __expf(x)); }
__device__ __forceinline__ float tanhf_(float x) { const float e = __expf(-2.f * fabsf(x)); const float t = (1.f - e) * __builtin_amdgcn_rcpf(1.f + e); return x < 0.f ? -t : t; }
__device__ __forceinline__ float siluf_(float x) { return x * __builtin_amdgcn_rcpf(1.f + __expf(-x)); }

struct Args { const float* in[35]; float* out; unsigned char* ws; int ph_lo, ph_hi; };
enum { I_X = 0, I_WIN, I_CMU, I_CW0, I_CW2, I_CA0, I_CA2, I_CG2, I_CKK, I_CKA, I_CRK, I_CGNW, I_CGNB, I_CV0, I_CV1, I_CV2, I_DCW, I_DCB, I_DDTB, I_DALOG, I_DSKIP, I_DNW,
       I_WBR, I_WOUT, I_LN1G, I_LN1B, I_RG, I_RGB, I_RE, I_REB, I_EG, I_EU, I_ED, I_LN2G, I_LN2B };

__device__ __forceinline__ void transpose_item(const float* W, int ldn, int c0, int ncols, bf16* dst, int dld, int r0, int dk0, int kb, int nb, LAS float* scr, int lane) {
    const int k0 = 64 * kb, n0 = 32 * nb;
    const bool okn = (n0 + (lane & 31)) < ncols;
    float tv[32];
#pragma unroll
    for (int i = 0; i < 32; ++i) { const int kk = 2 * i + (lane >> 5); tv[i] = okn ? W[(size_t)(k0 + kk) * ldn + c0 + n0 + (lane & 31)] : 0.f; }
#pragma unroll
    for (int i = 0; i < 32; ++i) { const int kk = 2 * i + (lane >> 5); scr[kk * 33 + (lane & 31)] = tv[i]; }
    asm volatile("s_waitcnt lgkmcnt(0)" ::: "memory");
    const int c = lane & 7;
#pragma unroll
    for (int j = 0; j < 4; ++j) { const int n = (lane >> 3) + 8 * j; const LAS float* s = scr + (8 * c) * 33 + n;
        u32x4 o; o.x = pk2(s[0 * 33], s[1 * 33]); o.y = pk2(s[2 * 33], s[3 * 33]); o.z = pk2(s[4 * 33], s[5 * 33]); o.w = pk2(s[6 * 33], s[7 * 33]);
        if (n0 + n < ncols) *(u32x4*)(dst + (size_t)(r0 + n0 + n) * dld + dk0 + k0 + 8 * c) = o; }
    asm volatile("s_waitcnt lgkmcnt(0)" ::: "memory");
}

struct EpiStoreBf16 {
    static constexpr bool PERM = true;
    bf16* O; int ldc; int act; int ncols;
    __device__ __forceinline__ void operator()(const pg8::f32x4 (&acc)[2][2][4][2], const pg8::Unit& u, int wr, int wc, int fr, int fq) const {
        pg8::epi_mfma_settle(acc);
        const int row0 = u.pm * 256 + wr * 64 + fr; const int col0 = u.pn * 256 + wc * 32 + 8 * fq;
#pragma unroll
        for (int ai = 0; ai < 2; ++ai)
#pragma unroll
            for (int m = 0; m < 4; ++m) { bf16* rowp = O + (size_t)(row0 + ai * 128 + m * 16) * ldc + col0;
#pragma unroll
                for (int bj = 0; bj < 2; ++bj) { pg8::f32x4 v0 = acc[ai][bj][m][0], v1 = acc[ai][bj][m][1];
                    if (act == 1) {
#pragma unroll
                        for (int j = 0; j < 4; ++j) { v0[j] = sigmoidf_(v0[j]); v1[j] = sigmoidf_(v1[j]); } }
                    u32x4 w; w.x = pg8::cvt_pk_bf16(v0[0], v0[1]); w.y = pg8::cvt_pk_bf16(v0[2], v0[3]); w.z = pg8::cvt_pk_bf16(v1[0], v1[1]); w.w = pg8::cvt_pk_bf16(v1[2], v1[3]);
                    if (col0 + bj * 128 < ncols) *(u32x4*)(rowp + bj * 128) = w; } }
    }
};
struct EpiBranch {
    static constexpr bool PERM = true;
    const bf16* GS; bf16* MG;
    __device__ __forceinline__ void operator()(const pg8::f32x4 (&acc)[2][2][4][2], const pg8::Unit& u, int wr, int wc, int fr, int fq) const {
        pg8::epi_mfma_settle(acc);
        const int n = u.aux;
        const bf16* gbase = GS + (size_t)(u.pm * 256 + wr * 64 + fr) * 4096 + n * 1024 + u.pn * 256 + wc * 32 + 8 * fq;
        bf16* mbase = MG + (size_t)(u.pm * 256 + wr * 64 + fr) * 1024 + u.pn * 256 + wc * 32 + 8 * fq;
#pragma unroll
        for (int ai = 0; ai < 2; ++ai)
#pragma unroll
            for (int m = 0; m < 4; ++m) {
#pragma unroll
                for (int bj = 0; bj < 2; ++bj) {
                    const u32x4 gv = *(const u32x4*)(gbase + (size_t)(ai * 128 + m * 16) * 4096 + bj * 128);
                    bf16* mp = mbase + (size_t)(ai * 128 + m * 16) * 1024 + bj * 128;
                    u32x4 ov = (u32x4){0u, 0u, 0u, 0u}; if (n != 0) ov = *(const u32x4*)mp;
                    const pg8::f32x4 a0 = acc[ai][bj][m][0], a1 = acc[ai][bj][m][1];
                    u32x4 w;
                    w.x = pg8::cvt_pk_bf16(a0[0] * __uint_as_float(gv.x << 16) + __uint_as_float(ov.x << 16), a0[1] * __uint_as_float(gv.x & 0xffff0000u) + __uint_as_float(ov.x & 0xffff0000u));
                    w.y = pg8::cvt_pk_bf16(a0[2] * __uint_as_float(gv.y << 16) + __uint_as_float(ov.y << 16), a0[3] * __uint_as_float(gv.y & 0xffff0000u) + __uint_as_float(ov.y & 0xffff0000u));
                    w.z = pg8::cvt_pk_bf16(a1[0] * __uint_as_float(gv.z << 16) + __uint_as_float(ov.z << 16), a1[1] * __uint_as_float(gv.z & 0xffff0000u) + __uint_as_float(ov.z & 0xffff0000u));
                    w.w = pg8::cvt_pk_bf16(a1[2] * __uint_as_float(gv.w << 16) + __uint_as_float(ov.w << 16), a1[3] * __uint_as_float(gv.w & 0xffff0000u) + __uint_as_float(ov.w & 0xffff0000u));
                    *(u32x4*)mp = w; asm volatile("" ::: "memory"); } }
    }
};
struct EpiResid {
    static constexpr bool PERM = false;
    float* X; const float* Xin; const bf16* Xbin;
    __device__ __forceinline__ void operator()(const pg8::f32x4 (&acc)[2][2][4][2], const pg8::Unit& u, int wr, int wc, int fr, int fq) const {
        pg8::epi_mfma_settle(acc);
        const int row0 = u.pm * 256 + wr * 64 + fr, col0 = u.pn * 256 + wc * 32 + 4 * fq;
#pragma unroll
        for (int ai = 0; ai < 2; ++ai)
#pragma unroll
            for (int m = 0; m < 4; ++m) { const size_t ro = (size_t)(row0 + ai * 128 + m * 16) * D + col0;
#pragma unroll
                for (int bj = 0; bj < 2; ++bj)
#pragma unroll
                    for (int n = 0; n < 2; ++n) { pg8::f32x4 xi;
                        if (Xbin) { const u32x2 xb = *(const u32x2*)(Xbin + ro + bj * 128 + n * 16); xi = (pg8::f32x4){__uint_as_float(xb.x << 16), __uint_as_float(xb.x & 0xffff0000u), __uint_as_float(xb.y << 16), __uint_as_float(xb.y & 0xffff0000u)}; }
                        else xi = *(const pg8::f32x4*)(Xin + ro + bj * 128 + n * 16);
                        *(pg8::f32x4*)(X + ro + bj * 128 + n * 16) = xi * ALPHA + acc[ai][bj][m][n]; } }
    }
};
struct EpiSwiglu {
    static constexpr bool PERM = true;
    bf16* H;
    __device__ __forceinline__ void operator()(const pg8::f32x4 (&acc)[2][2][4][2], const pg8::Unit& u, int wr, int wc, int fr, int fq) const {
        pg8::epi_mfma_settle(acc);
        const int row0 = u.pm * 256 + wr * 64 + fr; const int col0 = u.pn * 128 + wc * 32 + 8 * fq;
#pragma unroll
        for (int ai = 0; ai < 2; ++ai)
#pragma unroll
            for (int m = 0; m < 4; ++m) { bf16* rowp = H + (size_t)(row0 + ai * 128 + m * 16) * DEXP + col0;
                float v[8];
#pragma unroll
                for (int j = 0; j < 4; ++j) { v[j] = siluf_(acc[ai][0][m][0][j]) * acc[ai][1][m][0][j]; v[4 + j] = siluf_(acc[ai][0][m][1][j]) * acc[ai][1][m][1][j]; }
                u32x4 w; w.x = pg8::cvt_pk_bf16(v[0], v[1]); w.y = pg8::cvt_pk_bf16(v[2], v[3]); w.z = pg8::cvt_pk_bf16(v[4], v[5]); w.w = pg8::cvt_pk_bf16(v[6], v[7]);
                *(u32x4*)rowp = w; }
    }
};

struct SkewOrder {
    int nM, nN, nwg, c, lda, ldb;
    __device__ bool next(int i, pg8::Unit& u) const {
        long L;
        if (i < 5) L = (long)i * 256 + c; else { if (c < 32) return false; L = 1280 + (long)(i - 5) * 224 + (c - 32); }
        if (L >= nwg) return false;
        pg8::tile_of((int)L, nM, nN, u.pm, u.pn); u.aux = 0;
        u.aoff = (size_t)u.pm * 256 * lda * 2; u.boff = (size_t)u.pn * 256 * ldb * 2; return true;
    }
};
struct BranchOrder {
    int nM, nN, G, c;
    __device__ bool next(int i, pg8::Unit& u) const {
        const int tl = (i >> 2) * G + c; if (tl >= nM * nN) return false;
        pg8::tile_of(tl, nM, nN, u.pm, u.pn); u.aux = i & 3;
        u.aoff = ((size_t)u.pm * 256 * 1024 + (size_t)u.aux * 256) * 2; u.boff = ((size_t)u.pn * 256 * 1024 + (size_t)u.aux * 256) * 2; return true;
    }
};
struct MoeOrder {
    const volatile LAS int* tb; int G, c; size_t a_rowbytes, b_expbytes, b_tilebytes;
    __device__ bool next(int i, pg8::Unit& u) const {
        const int L = i * G + c; const int total = __builtin_amdgcn_readfirstlane(tb[32]) * 4; if (L >= total) return false;
        int e = 0;
#pragma unroll 1
        for (int k = 0; k < 32; ++k) if (L >= tb[k + 1] * 4) e = k + 1;
        const int nte = tb[e + 1] - tb[e]; const int r = L - tb[e] * 4; const int ct = r / nte, rt = r % nte;
        u.pm = __builtin_amdgcn_readfirstlane(tb[33 + e] + rt); u.pn = __builtin_amdgcn_readfirstlane(ct); u.aux = __builtin_amdgcn_readfirstlane(e);
        u.aoff = (size_t)u.pm * 256 * a_rowbytes; u.boff = (size_t)u.aux * b_expbytes + (size_t)u.pn * b_tilebytes; return true;
    }
};

constexpr int PTR_OFF = LDS_BYTES - 512;
__device__ __forceinline__ void ptr_table_fill(const Args& args, LAS unsigned char* lds) {
    if (threadIdx.x == 0) {
        volatile LAS unsigned long long* t = (volatile LAS unsigned long long*)(lds + PTR_OFF);
#define PT_(i) t[i] = (unsigned long long)args.in[i];
        PT_(0) PT_(1) PT_(2) PT_(3) PT_(4) PT_(5) PT_(6) PT_(7) PT_(8) PT_(9) PT_(10) PT_(11) PT_(12) PT_(13) PT_(14) PT_(15) PT_(16) PT_(17) PT_(18) PT_(19)
        PT_(20) PT_(21) PT_(22) PT_(23) PT_(24) PT_(25) PT_(26) PT_(27) PT_(28) PT_(29) PT_(30) PT_(31) PT_(32) PT_(33) PT_(34)
#undef PT_
        t[35] = (unsigned long long)args.out; t[36] = (unsigned long long)args.ws; t[37] = (unsigned long long)(unsigned)args.ph_lo;
    }
    __syncthreads();
}
__device__ __forceinline__ unsigned long long ldptr(LAS unsigned char* lds, int i) {
    unsigned a = (unsigned)(PTR_OFF + 8 * i); asm volatile("" : "+v"(a));
    const volatile LAS unsigned* t = (const volatile LAS unsigned*)(lds + a);
    const unsigned lo = __builtin_amdgcn_readfirstlane(t[0]), hi = __builtin_amdgcn_readfirstlane(t[1]);
    return ((unsigned long long)hi << 32) | lo;
}
__device__ __forceinline__ void* gptr(unsigned long long v) { return (void*)(__attribute__((address_space(1))) void*)v; }
#define INP(i) ((const float*)gptr(ldptr(lds, (i))))
namespace rw {
typedef short bf16x8 __attribute__((ext_vector_type(8)));
typedef float f4 __attribute__((ext_vector_type(4)));
constexpr int LS = 72;
constexpr int MB = 64 * LS * 2;
constexpr int O_AHN = 0, O_RHN = MB, O_BCN = 2 * MB, O_KCN = 3 * MB, O_AHT = 4 * MB, O_BTT = 5 * MB, O_KTT = 6 * MB, O_VT = 7 * MB, O_STT = 8 * MB,
              O_MAK = 9 * MB, O_MRB = 10 * MB, O_MRK = 11 * MB, O_TINV = 12 * MB, O_MABF = 13 * MB, O_GAM = 13 * MB + 16384, O_CT = O_GAM + 256, O_BON = O_CT + 4608, O_END = O_BON + 256;
constexpr int O_MVT = O_BCN, O_A2N = O_AHN, O_UT = O_KCN, O_YF = O_AHT;
constexpr int O_TAB = O_MAK, O_SCR = O_TAB + 26624, O_TOT = O_SCR + 8 * 1024, O_CUM = O_TOT + 2048;
static_assert(O_CUM + 16384 <= O_GAM && O_END <= LDS_BYTES - 576, "rwkv LDS map");

__device__ __forceinline__ bf16x8 ldfrag(const LAS unsigned char* lds, int off, int r0, int ks, int lane) {
    return *(const LAS bf16x8*)(lds + off + ((r0 + (lane & 15)) * LS + ks * 32 + (lane >> 4) * 8) * 2);
}
__device__ __forceinline__ void mm64(f4 (&acc)[2], const LAS unsigned char* lds, int offA, int offBt, int w, int lane) {
    const int tr = w >> 1; const bf16x8 a0 = ldfrag(lds, offA, tr * 16, 0, lane), a1 = ldfrag(lds, offA, tr * 16, 1, lane);
#pragma unroll
    for (int c = 0; c < 2; ++c) { const int tc = (w & 1) * 2 + c; const bf16x8 b0 = ldfrag(lds, offBt, tc * 16, 0, lane), b1 = ldfrag(lds, offBt, tc * 16, 1, lane);
        acc[c] = __builtin_amdgcn_mfma_f32_16x16x32_bf16(a0, b0, acc[c], 0, 0, 0); acc[c] = __builtin_amdgcn_mfma_f32_16x16x32_bf16(a1, b1, acc[c], 0, 0, 0); }
}
__device__ __forceinline__ void storeT(LAS unsigned char* lds, int off, const f4 (&acc)[2], int w, int lane) {
    asm volatile("s_nop 11" :: "v"(acc[0]), "v"(acc[1]));
#pragma unroll
    for (int c = 0; c < 2; ++c) { const int col = ((w & 1) * 2 + c) * 16 + (lane & 15), row = (w >> 1) * 16 + 4 * (lane >> 4);
        u32x2 v; v.x = pk2(acc[c][0], acc[c][1]); v.y = pk2(acc[c][2], acc[c][3]); *(LAS u32x2*)(lds + off + (col * LS + row) * 2) = v; }
}
template <int MASK  >
__device__ __forceinline__ void storeN(LAS unsigned char* lds, int off, const f4 (&acc)[2], int w, int lane) {
    asm volatile("s_nop 11" :: "v"(acc[0]), "v"(acc[1]));
#pragma unroll
    for (int c = 0; c < 2; ++c) { const int col = ((w & 1) * 2 + c) * 16 + (lane & 15), row = (w >> 1) * 16 + 4 * (lane >> 4);
#pragma unroll
        for (int e = 0; e < 4; ++e) { float x = acc[c][e]; if (MASK == 1) x = (col < row + e) ? x : 0.f; if (MASK == 2) x = (col <= row + e) ? x : 0.f;
            *(LAS bf16*)(lds + off + ((row + e) * LS + col) * 2) = (bf16)f2bf(x); } }
}
typedef __bf16 bf2v __attribute__((ext_vector_type(2)));
__device__ __forceinline__ float dot2(unsigned x, unsigned y, float c) { return __builtin_amdgcn_fdot2_f32_bf16(__builtin_bit_cast(bf2v, x), __builtin_bit_cast(bf2v, y), c, false); }
#define RW_ZERO(a) do { a[0] = (f4){0.f, 0.f, 0.f, 0.f}; a[1] = (f4){0.f, 0.f, 0.f, 0.f}; } while (0)

__device__ __forceinline__ void build_ct(LAS unsigned char* lds0, const int l, const int h, const int lane, const int wave) {
    LAS unsigned char* const& lds = lds0; const int c = h * 64 + lane;
    const float* mu = INP(I_CMU) + (size_t)l * 896;
    if (wave == 0) { LAS float* ct = (LAS float*)(lds0 + O_CT);
        ct[0 * 64 + lane] = mu[c]; ct[1 * 64 + lane] = mu[256 + c]; ct[2 * 64 + lane] = mu[512 + c]; ct[3 * 64 + lane] = mu[768 + lane]; ct[4 * 64 + lane] = mu[832 + lane];
        ct[5 * 64 + lane] = INP(I_CW0)[l * 256 + c]; ct[6 * 64 + lane] = INP(I_CA0)[l * 256 + c]; ct[7 * 64 + lane] = INP(I_CKK)[l * 256 + c]; ct[8 * 64 + lane] = INP(I_CKA)[l * 256 + c];
        ct[9 * 64 + lane] = INP(I_CRK)[l * 256 + c]; ct[10 * 64 + lane] = INP(I_CGNW)[l * 256 + c]; ct[11 * 64 + lane] = INP(I_CGNB)[l * 256 + c]; ct[12 * 64 + lane] = l > 0 ? INP(I_CV0)[(l - 1) * 256 + c] : 0.f;
        ct[13 * 64 + lane] = mu[512 + lane]; ct[14 * 64 + lane] = mu[512 + lane + 64]; ct[15 * 64 + lane] = mu[512 + lane + 128]; ct[16 * 64 + lane] = mu[512 + lane + 192]; }
}
template <int MODE>
__device__ __forceinline__ void chunk(LAS unsigned char* lds0, const int l, const int b, const int h, const int t0, unsigned char* gz, unsigned char* gz2, float* bong, const bf16* P, bf16* VF, bf16* OB, const int tid0, int* qctr, int& nxt) {
    const int c = h * 64 + (tid0 & 63);
    {
        unsigned lb_ = 0u; int tid_l = tid0; asm volatile("" : "+v"(lb_), "+v"(tid_l));
        const int tid = tid_l, lane = tid & 63, wave = __builtin_amdgcn_readfirstlane(tid >> 6);
        LAS unsigned char* lds = lds0 + lb_;
        LAS bf16* TAB = (LAS bf16*)(lds + O_TAB); const LAS unsigned* TABW = (const LAS unsigned*)(lds + O_TAB);
        LAS bf16* scr = (LAS bf16*)(lds + O_SCR + wave * 1024);
        LAS float* CUM = (LAS float*)(lds + O_CUM);
        LAS float* TOT = (LAS float*)(lds + O_TOT);
        LAS float* GAM = (LAS float*)(lds + O_GAM);
        LAS float* MABF = (LAS float*)(lds + O_MABF);
        LAS float* YF = (LAS float*)(lds + O_YF);
        LAS float* BON = (LAS float*)(lds + O_BON);
        const LAS float* CT = (const LAS float*)(lds + O_CT);
#define CTV(k) CT[(k) * 64 + lane]
        LAS float* ASF = (LAS float*)(lds + O_TAB);
        LAS bf16* GSF = (LAS bf16*)(lds + O_STT);
        float Xr[9], Xg[9]; unsigned RK[9], VX[9], Va[9], Vb[9];
        { const float* cw2 = INP(I_CW2) + (size_t)l * 32 * 256; const float* ca2 = INP(I_CA2) + (size_t)l * 32 * 256; const float* cg2 = INP(I_CG2) + (size_t)l * 64 * 256;
          (void)cw2; (void)ca2; (void)cg2;
          const u32x4* img = (const u32x4*)((const unsigned char*)gptr(ldptr(lds, 36)) + WS_LORA + (size_t)(l * 4 + h) * 18432);
          u32x4 ti[3];
#pragma unroll
          for (int u = 0; u < 3; ++u) { const int pi = tid + u * NTHR; ti[u] = pi < 1152 ? img[pi] : (u32x4){0u, 0u, 0u, 0u}; }
          float t2[2], t1[8];
          if (l > 0) { const float* cv1 = INP(I_CV1) + (size_t)(l - 1) * 256 * 16; const float* cv2 = INP(I_CV2) + (size_t)(l - 1) * 16 * 256;
#pragma unroll
            for (int u = 0; u < 2; ++u) { const int i = tid + u * NTHR; t2[u] = cv2[(i >> 6) * 256 + h * 64 + (i & 63)]; }
#pragma unroll
            for (int u = 0; u < 8; ++u) t1[u] = cv1[tid + u * NTHR]; }
#pragma unroll
          for (int j = 0; j < 9; ++j) { const int t = t0 + wave * 8 - 1 + j; const bool ok_ = t >= 0; const size_t m_ = (size_t)b * T + (ok_ ? t : 0); const bf16* row_ = P + m_ * PP + C_C;
              Xr[j] = ok_ ? bf2f(row_[768 + lane]) : 0.f; Xg[j] = ok_ ? bf2f(row_[832 + lane]) : 0.f;
              RK[j] = ok_ ? ((unsigned)row_[c] | ((unsigned)row_[256 + c] << 16)) : 0u; VX[j] = ok_ ? (unsigned)row_[512 + c] : 0u;
              if (l > 0) { Va[j] = ok_ ? ((unsigned)row_[512 + lane] | ((unsigned)row_[512 + lane + 64] << 16)) : 0u; Vb[j] = ok_ ? ((unsigned)row_[512 + lane + 128] | ((unsigned)row_[512 + lane + 192] << 16)) : 0u;
                  if (j > 0) VX[j] |= (unsigned)VF[m_ * 256 + c] << 16; } }
#pragma unroll
          for (int u = 0; u < 3; ++u) { const int pi = tid + u * NTHR; if (pi < 1152) *(LAS u32x4*)(lds + O_BCN + pi * 16) = ti[u]; }
#define PIX(i) ((((i) >> 7) * 64 + ((i) & 63)) * 2 + (((i) >> 6) & 1))
          if (l > 0) {
#pragma unroll
            for (int u = 0; u < 2; ++u) { const int i = tid + u * NTHR; TAB[8192 + PIX(i)] = (bf16)f2bf(t2[u]); }
#pragma unroll
            for (int u = 0; u < 8; ++u) { const int i = tid + u * NTHR; const int cc = i >> 4, qq = i & 15; TAB[9216 + ((cc >> 1) * 16 + qq) * 2 + (cc & 1)] = (bf16)f2bf(t1[u]); } } }
#undef PIX
        {
#pragma unroll
          for (int q = 0; q < 8; ++q) { const int tt = wave * 8 + q;
              const float xx = Xr[q + 1] + (Xr[q] - Xr[q + 1]) * CTV(3), xg = Xg[q + 1] + (Xg[q] - Xg[q + 1]) * CTV(4);
              *(LAS bf16*)(lds + O_AHN + (tt * LS + lane) * 2) = (bf16)f2bf(lane < 32 ? tanhf_(xx) : xx);
              *(LAS bf16*)(lds + O_RHN + (tt * LS + lane) * 2) = (bf16)f2bf(sigmoidf_(xg)); } }
        __syncthreads();
        { const int tr = wave >> 1;
          const bf16x8 a0 = ldfrag(lds, O_AHN, tr * 16, 0, lane), a1 = ldfrag(lds, O_AHN, tr * 16, 1, lane), g0 = ldfrag(lds, O_RHN, tr * 16, 0, lane), g1 = ldfrag(lds, O_RHN, tr * 16, 1, lane);
#pragma unroll
          for (int cI = 0; cI < 2; ++cI) { const int tc = (wave & 1) * 2 + cI;
              const bf16x8 b0 = ldfrag(lds, O_BCN, tc * 16, 0, lane), b1 = ldfrag(lds, O_BCN, tc * 16, 1, lane), c0 = ldfrag(lds, O_KCN, tc * 16, 0, lane), c1 = ldfrag(lds, O_KCN, tc * 16, 1, lane);
              const f4 z = (f4){0.f, 0.f, 0.f, 0.f};
              const f4 aw = __builtin_amdgcn_mfma_f32_16x16x32_bf16(a0, b0, z, 0, 0, 0), aa = __builtin_amdgcn_mfma_f32_16x16x32_bf16(a1, b1, z, 0, 0, 0);
              f4 ag = __builtin_amdgcn_mfma_f32_16x16x32_bf16(g0, c0, z, 0, 0, 0); ag = __builtin_amdgcn_mfma_f32_16x16x32_bf16(g1, c1, ag, 0, 0, 0);
              const int col = tc * 16 + (lane & 15), row = tr * 16 + 4 * (lane >> 4);
#pragma unroll
              for (int e = 0; e < 4; ++e) { CUM[(row + e) * 64 + col] = aw[e]; ASF[(row + e) * 64 + col] = aa[e]; GSF[(row + e) * 64 + col] = (bf16)f2bf(ag[e]); } } }
        __syncthreads();
        { float run = 0.f;
#pragma unroll
            for (int q = 0; q < 8; ++q) { const int tt = wave * 8 + q;
                const float wsum = CTV(5) + CUM[tt * 64 + lane];
                run += -0.6065306597f * sigmoidf_(wsum); CUM[tt * 64 + lane] = run; }
            TOT[wave * 64 + lane] = run; }
        __syncthreads();
        float offs = 0.f, cumL = 0.f;
#pragma unroll
        for (int w2 = 0; w2 < 8; ++w2) { const float tw = TOT[w2 * 64 + lane]; offs += (w2 < wave) ? tw : 0.f; cumL += tw; }
        if (wave == 0) GAM[lane] = __expf(cumL);
#define LO_(x) __uint_as_float((x) << 16)
#define HI_(x) __uint_as_float((x) & 0xffff0000u)
#pragma unroll
        for (int q = 0; q < 8; ++q) {
            const int tt = wave * 8 + q; const size_t m = (size_t)b * T + t0 + tt;
            const unsigned pRK = RK[q], cRK = RK[q + 1], pVX = VX[q], cVX = VX[q + 1], pVa = Va[q], cVa = Va[q + 1], pVb = Vb[q], cVb = Vb[q + 1];
            const float r = LO_(cRK) + (LO_(pRK) - LO_(cRK)) * CTV(0), k = HI_(cRK) + (HI_(pRK) - HI_(cRK)) * CTV(1); float v = LO_(cVX) + (LO_(pVX) - LO_(cVX)) * CTV(2);
            const float asum = CTV(6) + ASF[tt * 64 + lane]; const unsigned gbits = (unsigned)GSF[tt * 64 + lane];
            const float cq = CUM[tt * 64 + lane], cprev = q > 0 ? CUM[(tt - 1) * 64 + lane] : 0.f;
            if (l > 0) {
                LAS bf16* vsc = scr + 128;
                vsc[lane] = (bf16)f2bf(LO_(cVa) + (LO_(pVa) - LO_(cVa)) * CTV(13)); vsc[lane + 64] = (bf16)f2bf(HI_(cVa) + (HI_(pVa) - HI_(cVa)) * CTV(14));
                vsc[lane + 128] = (bf16)f2bf(LO_(cVb) + (LO_(pVb) - LO_(cVb)) * CTV(15)); vsc[lane + 192] = (bf16)f2bf(HI_(cVb) + (HI_(pVb) - HI_(cVb)) * CTV(16));
                asm volatile("s_waitcnt lgkmcnt(0)" ::: "memory");
                const int qq = lane & 15, part = lane >> 4; float s = 0.f; { float s1 = 0.f; const LAS unsigned* sv = (const LAS unsigned*)vsc;
#pragma unroll
                for (int p = 0; p < 32; p += 2) { s = dot2(sv[part * 32 + p], TABW[4608 + (part * 32 + p) * 16 + qq], s); s1 = dot2(sv[part * 32 + p + 1], TABW[4608 + (part * 32 + p + 1) * 16 + qq], s1); }
                s += s1; }
                s += __shfl_xor(s, 16); s += __shfl_xor(s, 32);
                float vl = CTV(12);
#pragma unroll
                for (int q2 = 0; q2 < 16; ++q2) vl += __shfl(s, q2) * bf2f(TAB[8192 + ((q2 >> 1) * 64 + lane) * 2 + (q2 & 1)]);
                const float vf = HI_(cVX); v = v + (vf - v) * sigmoidf_(vl);
            }
            if (MODE < 5) VF[m * 256 + c] = (bf16)f2bf(v);
            const float asig = sigmoidf_(asum), lw = cq - cprev;
            float kk = k * CTV(7); const float n2 = wave_sum(kk * kk); kk = kk * __builtin_amdgcn_rsqf(fmaxf(n2, 1e-24f));
            const float kmod = k * (1.f + (asig - 1.f) * CTV(8));
            const float bon = wave_sum(r * kmod * CTV(9));
            const float cum = offs + cq, cumx = cum - lw;
            const float ah = -kk * __expf(cumx), rh = r * __expf(cum), ei = __expf(-cum), bb = kk * asig, bc = bb * ei, kc = kmod * ei, ee = __expf(cumL - cum), bt = bb * ee, kt = kmod * ee;
            const int no = (tt * LS + lane) * 2, to = (lane * LS + tt) * 2;
            *(LAS bf16*)(lds + O_AHN + no) = (bf16)f2bf(ah); *(LAS bf16*)(lds + O_RHN + no) = (bf16)f2bf(rh);
            *(LAS bf16*)(lds + O_BCN + no) = (bf16)f2bf(bc); *(LAS bf16*)(lds + O_KCN + no) = (bf16)f2bf(kc); if (MODE < 5) ((bf16*)(gz2 + 16384))[tt * 64 + lane] = (bf16)gbits;
            *(LAS bf16*)(lds + O_AHT + to) = (bf16)f2bf(ah); *(LAS bf16*)(lds + O_BTT + to) = (bf16)f2bf(bt);
            *(LAS bf16*)(lds + O_KTT + to) = (bf16)f2bf(kt); *(LAS bf16*)(lds + O_VT + to) = (bf16)f2bf(v);
            if (MODE < 5 && lane == 0) bong[tt] = bon;
            asm volatile("s_waitcnt lgkmcnt(0)" ::: "memory");
        }
        __syncthreads();
        if (MODE == 6) return;
        { f4 acc[2];
            RW_ZERO(acc); mm64(acc, lds, O_AHN, O_BCN, wave, lane);
#pragma unroll
            for (int cI = 0; cI < 2; ++cI) { const int col = ((wave & 1) * 2 + cI) * 16 + (lane & 15), row = (wave >> 1) * 16 + 4 * (lane >> 4);
#pragma unroll
                for (int e = 0; e < 4; ++e) MABF[(row + e) * 64 + col] = (col < row + e) ? acc[cI][e] : 0.f; }
            RW_ZERO(acc); mm64(acc, lds, O_AHN, O_KCN, wave, lane); storeN<1>(lds, O_MAK, acc, wave, lane);
            { f4 accb[2]; RW_ZERO(accb); mm64(accb, lds, O_RHN, O_BCN, wave, lane); f4 accc[2]; RW_ZERO(accc); mm64(accc, lds, O_RHN, O_KCN, wave, lane);
                storeN<2>(lds, O_MRB, accb, wave, lane); storeN<2>(lds, O_MRK, accc, wave, lane); }
        }
        __syncthreads();
        {
            const int cS = wave * 8 + (lane >> 3), tS = lane & 7;
            float xs[8];
#pragma unroll
            for (int k = 0; k < 8; ++k) xs[k] = 0.f;
#pragma unroll
            for (int i = 1; i < 64; ++i) {
                float part = 0.f;
#pragma unroll
                for (int k = 0; k < (i + 7) / 8; ++k) { const float mv = MABF[i * 64 + tS + 8 * k]; part += ((tS + 8 * k) < i ? mv : 0.f) * xs[k]; }
                part += __builtin_bit_cast(float, __builtin_amdgcn_update_dpp(0, __builtin_bit_cast(int, part), 0xB1, 0xF, 0xF, true));
                part += __builtin_bit_cast(float, __builtin_amdgcn_update_dpp(0, __builtin_bit_cast(int, part), 0x4E, 0xF, 0xF, true));
                part += __builtin_bit_cast(float, __builtin_amdgcn_update_dpp(0, __builtin_bit_cast(int, part), 0x141, 0xF, 0xF, true));
                const float xi = MABF[i * 64 + cS] + part;
                xs[i >> 3] = (tS == (i & 7)) ? xi : xs[i >> 3];
            }
#pragma unroll
            for (int k = 0; k < 8; ++k) { const int i = tS + 8 * k; *(LAS bf16*)(lds + O_TINV + (i * LS + cS) * 2) = (bf16)f2bf(i == cS ? 1.f : xs[k]); }
        }
        __syncthreads();
        { f4 acc[2]; RW_ZERO(acc); mm64(acc, lds, O_MAK, O_VT, wave, lane); storeT(lds, O_MVT, acc, wave, lane); }
        __syncthreads();
        if (MODE == 1 || MODE == 5) {
            { f4 acc[2]; RW_ZERO(acc); mm64(acc, lds, O_TINV, O_AHT, wave, lane); storeT(lds, O_UT, acc, wave, lane); }
            { f4 acc[2]; RW_ZERO(acc); mm64(acc, lds, O_TINV, O_MVT, wave, lane); storeT(lds, O_MAK, acc, wave, lane); }
            __syncthreads();
            if (tid == 0) nxt = atomicAdd(qctr, 1);
            f4 agm[2], azm[2], ar2[2], ay0[2];
            RW_ZERO(agm); mm64(agm, lds, O_BTT, O_UT, wave, lane);
#pragma unroll
            for (int cI = 0; cI < 2; ++cI) { const int col = ((wave & 1) * 2 + cI) * 16 + (lane & 15), row = (wave >> 1) * 16 + 4 * (lane >> 4);
#pragma unroll
                for (int e = 0; e < 4; ++e) if (col == row + e) agm[cI][e] += GAM[col]; }
            RW_ZERO(azm); mm64(azm, lds, O_BTT, O_MAK, wave, lane); mm64(azm, lds, O_KTT, O_VT, wave, lane);
            RW_ZERO(ar2); mm64(ar2, lds, O_MRB, O_UT, wave, lane);
#pragma unroll
            for (int cI = 0; cI < 2; ++cI) { const int col = ((wave & 1) * 2 + cI) * 16 + (lane & 15), row = (wave >> 1) * 16 + 4 * (lane >> 4);
#pragma unroll
                for (int e = 0; e < 4; ++e) ar2[cI][e] += bf2f(*(const LAS bf16*)(lds + O_RHN + ((row + e) * LS + col) * 2)); }
            RW_ZERO(ay0); mm64(ay0, lds, O_MRB, O_MAK, wave, lane); mm64(ay0, lds, O_MRK, O_VT, wave, lane);
            __syncthreads();
            storeN<0>(lds, O_AHN, agm, wave, lane); storeT(lds, O_RHN, azm, wave, lane); storeN<0>(lds, O_BCN, ar2, wave, lane); storeT(lds, O_KCN, ay0, wave, lane);
            __syncthreads();
            if (MODE == 1) { const int io = ((tid >> 3) * LS + (tid & 7) * 8) * 2;
              ((u32x4*)gz)[tid] = *(const LAS u32x4*)(lds + O_AHN + io); ((u32x4*)(gz + 8192))[tid] = *(const LAS u32x4*)(lds + O_RHN + io);
              ((u32x4*)gz2)[tid] = *(const LAS u32x4*)(lds + O_BCN + io); ((u32x4*)(gz2 + 8192))[tid] = *(const LAS u32x4*)(lds + O_KCN + io); }
        } else {
            { f4 acc[2]; RW_ZERO(acc); mm64(acc, lds, O_TINV, O_AHT, wave, lane); storeN<0>(lds, O_A2N, acc, wave, lane); }
            __syncthreads();
            { f4 acc[2]; RW_ZERO(acc); mm64(acc, lds, O_TINV, O_MVT, wave, lane); mm64(acc, lds, O_A2N, O_STT, wave, lane); storeT(lds, O_UT, acc, wave, lane); }
            __syncthreads();
            f4 yacc[2]; RW_ZERO(yacc);
            mm64(yacc, lds, O_RHN, O_STT, wave, lane); mm64(yacc, lds, O_MRB, O_UT, wave, lane); mm64(yacc, lds, O_MRK, O_VT, wave, lane);
            __syncthreads();
#pragma unroll
            for (int cI = 0; cI < 2; ++cI) { const int col = ((wave & 1) * 2 + cI) * 16 + (lane & 15), row = (wave >> 1) * 16 + 4 * (lane >> 4);
#pragma unroll
                for (int e = 0; e < 4; ++e) YF[(row + e) * 64 + col] = yacc[cI][e]; }
            __syncthreads();
            { unsigned gcur = (unsigned)OB[((size_t)b * T + t0 + wave * 8) * 1024 + 512 + c];
#pragma unroll 1
            for (int q = 0; q < 8; ++q) {
                const int tt = wave * 8 + q; const size_t m = (size_t)b * T + t0 + tt;
                const unsigned gnxt = (unsigned)OB[(m + (q < 7 ? 1 : 0)) * 1024 + 512 + c];
                const float y = YF[tt * 64 + lane]; const float mean = wave_sum(y) * (1.f / 64.f); const float dy = y - mean; const float var = wave_sum(dy * dy) * (1.f / 64.f);
                const float yn = dy * rsqrtf(var + 64e-5f) * CTV(10) + CTV(11);
                const float vv = bf2f(*(const LAS bf16*)(lds + O_VT + (lane * LS + tt) * 2)), gg = LO_(gcur);
                OB[m * 1024 + 512 + c] = (bf16)f2bf((yn + BON[tt] * vv) * gg);
                gcur = gnxt;
            } }
        }
        __syncthreads();
#undef CTV
#undef LO_
#undef HI_
    }
}

__device__ __forceinline__ void chunk_out(LAS unsigned char* lds0, const int b, const int h, const int t0, const unsigned char* gz, const unsigned char* gz2, const float* bong, const bf16* VF, bf16* OB, const int tid0) {
    unsigned lb_ = 0u; int tid_l = tid0; asm volatile("" : "+v"(lb_), "+v"(tid_l));
    LAS unsigned char* lds = lds0 + lb_; const int tid = tid_l, lane = tid & 63, wave = __builtin_amdgcn_readfirstlane(tid >> 6);
    const int c = h * 64 + lane;
    const LAS float* CT = (const LAS float*)(lds + O_CT);
    LAS float* YF = (LAS float*)(lds + O_YF);
    const int io = ((tid >> 3) * LS + (tid & 7) * 8) * 2;
    const u32x4 sv = ((const u32x4*)gz)[tid], rv = ((const u32x4*)gz2)[tid];
    u32x2 yv[2];
#pragma unroll
    for (int k = 0; k < 2; ++k) { const int col = ((wave & 1) * 2 + k) * 16 + (lane & 15), row = (wave >> 1) * 16 + 4 * (lane >> 4); yv[k] = *(const u32x2*)(gz2 + 8192 + (col * 64 + row) * 2); }
    float gq[8], vq[8], bq[8];
#pragma unroll
    for (int q = 0; q < 8; ++q) { const int tt = wave * 8 + q; const size_t m = (size_t)b * T + t0 + tt;
        gq[q] = bf2f(((const bf16*)(gz2 + 16384))[tt * 64 + lane]); vq[q] = bf2f(VF[m * 256 + c]); bq[q] = bong[tt]; }
    *(LAS u32x4*)(lds + O_STT + io) = sv; *(LAS u32x4*)(lds + O_AHN + io) = rv;
    __syncthreads();
    f4 acc[2];
#pragma unroll
    for (int k = 0; k < 2; ++k) acc[k] = (f4){__uint_as_float(yv[k].x << 16), __uint_as_float(yv[k].x & 0xffff0000u), __uint_as_float(yv[k].y << 16), __uint_as_float(yv[k].y & 0xffff0000u)};
    mm64(acc, lds, O_AHN, O_STT, wave, lane);
#pragma unroll
    for (int cI = 0; cI < 2; ++cI) { const int col = ((wave & 1) * 2 + cI) * 16 + (lane & 15), row = (wave >> 1) * 16 + 4 * (lane >> 4);
#pragma unroll
        for (int e = 0; e < 4; ++e) YF[(row + e) * 64 + col] = acc[cI][e]; }
    __syncthreads();
#pragma unroll
    for (int q = 0; q < 8; ++q) { const int tt = wave * 8 + q; const size_t m = (size_t)b * T + t0 + tt;
        const float y = YF[tt * 64 + lane]; const float mean = wave_sum(y) * (1.f / 64.f); const float dy = y - mean; const float var = wave_sum(dy * dy) * (1.f / 64.f);
        const float yn = dy * rsqrtf(var + 64e-5f) * CT[10 * 64 + lane] + CT[11 * 64 + lane];
        OB[m * 1024 + 512 + c] = (bf16)f2bf((yn + bq[q] * vq[q]) * gq[q]); }
    __syncthreads();
}

__device__ __forceinline__ void carry(LAS unsigned char* lds0, unsigned char* gzc  , const int tid0) {
    f4 stacc[2]; RW_ZERO(stacc);
    { unsigned lb_ = 0u; asm volatile("" : "+v"(lb_)); LAS unsigned char* lds = lds0 + lb_; for (int i = tid0; i < MB / 4; i += NTHR) ((LAS unsigned*)(lds + O_STT))[i] = 0u; }
    u32x4 gnx = ((const u32x4*)gzc)[tid0];
    u32x2 znx[2];
    { const int lane = tid0 & 63, wave = tid0 >> 6;
#pragma unroll
      for (int k = 0; k < 2; ++k) { const int col = ((wave & 1) * 2 + k) * 16 + (lane & 15), row = (wave >> 1) * 16 + 4 * (lane >> 4); znx[k] = *(const u32x2*)(gzc + 8192 + (col * 64 + row) * 2); } }
#pragma unroll 1
    for (int cI = 0; cI < T / 64; ++cI) {
        unsigned lb_ = 0u; int tid_l = tid0; asm volatile("" : "+v"(lb_), "+v"(tid_l));
        LAS unsigned char* lds = lds0 + lb_; const int tid = tid_l, lane = tid & 63, wave = __builtin_amdgcn_readfirstlane(tid >> 6);
        unsigned char* rec = gzc + (size_t)cI * 16384;
        const int io = ((tid >> 3) * LS + (tid & 7) * 8) * 2;
        *(LAS u32x4*)(lds + O_AHN + io) = gnx;
        u32x2 zv[2]; zv[0] = znx[0]; zv[1] = znx[1];
        if (cI + 1 < T / 64) { gnx = ((const u32x4*)(rec + 16384))[tid];
#pragma unroll
            for (int k = 0; k < 2; ++k) { const int col = ((wave & 1) * 2 + k) * 16 + (lane & 15), row = (wave >> 1) * 16 + 4 * (lane >> 4); znx[k] = *(const u32x2*)(rec + 16384 + 8192 + (col * 64 + row) * 2); } }
        __syncthreads();
        ((u32x4*)rec)[tid] = *(const LAS u32x4*)(lds + O_STT + io);
        f4 acc[2];
#pragma unroll
        for (int k = 0; k < 2; ++k) acc[k] = (f4){__uint_as_float(zv[k].x << 16), __uint_as_float(zv[k].x & 0xffff0000u), __uint_as_float(zv[k].y << 16), __uint_as_float(zv[k].y & 0xffff0000u)};
        mm64(acc, lds, O_AHN, O_STT, wave, lane);
        __syncthreads();
        storeT(lds, O_STT, acc, wave, lane);
    }
}
}

namespace mb {
using rw::LS; using rw::MB; using rw::f4; using rw::mm64; using rw::storeN; using rw::bf16x8;
constexpr int O_CN = 0, O_BN = MB, O_BT = 2 * MB, O_XT0 = 3 * MB, O_XW0 = 5 * MB, O_CS0 = 7 * MB, O_HN0 = 9 * MB, O_SC0 = 11 * MB, O_SM = 13 * MB, O_YF = O_XW0;
static_assert(O_SM + 2048 <= LDS_BYTES - 576, "mamba LDS map");
__device__ __forceinline__ void chain(LAS unsigned char* lds0, const int l, const int b, const int gI, const bf16* P, bf16* OB, const int tid0, const int lane0, const int wave0) {
    const int tid = tid0, lane = lane0, wave = wave0;
    LAS unsigned char* const& lds = lds0;
    const float* cwp = INP(I_DCW) + (size_t)l * 4 * 512; const float* cbp = INP(I_DCB) + (size_t)l * 512;
    const int cc = tid & 255, sub = tid >> 8;
    const int col = cc < 128 ? (gI * 128 + cc) : (cc < 192 ? (256 + gI * 64 + (cc - 128)) : (384 + gI * 64 + (cc - 192)));
    const float cw0 = cwp[col], cw1 = cwp[512 + col], cw2 = cwp[1024 + col], cw3 = cwp[1536 + col], cb = cbp[col];
    f4 hacc[2][2];
#pragma unroll
    for (int hh = 0; hh < 2; ++hh) { hacc[hh][0] = (f4){0.f, 0.f, 0.f, 0.f}; hacc[hh][1] = (f4){0.f, 0.f, 0.f, 0.f}; }
    for (int i = tid; i < 2 * MB / 4; i += NTHR) ((LAS unsigned*)(lds0 + O_HN0))[i] = 0u;
    const float dtb0 = INP(I_DDTB)[l * 4 + gI * 2], dtb1 = INP(I_DDTB)[l * 4 + gI * 2 + 1];
    const float nA0 = -__expf(INP(I_DALOG)[l * 4 + gI * 2]), nA1 = -__expf(INP(I_DALOG)[l * 4 + gI * 2 + 1]);
    const float dsk0 = INP(I_DSKIP)[l * 4 + gI * 2], dsk1 = INP(I_DSKIP)[l * 4 + gI * 2 + 1];
    const float nw0 = INP(I_DNW)[l * 256 + gI * 128 + lane], nw1 = INP(I_DNW)[l * 256 + gI * 128 + 64 + lane];
    constexpr int O_RA = O_SC0, O_RB = O_SM + 2048;
    static_assert(35 * 512 <= 2 * MB && O_RB + 35 * 512 <= LDS_BYTES - 600, "mamba raw images");
    u32x4 NXr[5]; unsigned ND = 0u;
#define MB_LOAD(tc) do { const int tc_ = (tc); \
        _Pragma("unroll") for (int k = 0; k < 5; ++k) { const int pi = tid + k * NTHR, r = pi >> 5, sp = pi & 31, t_ = tc_ - 3 + r; \
            const int scol = sp < 16 ? gI * 128 + sp * 8 : (sp < 24 ? 256 + gI * 64 + (sp - 16) * 8 : 384 + gI * 64 + (sp - 24) * 8); \
            NXr[k] = (pi < 2144 && t_ >= 0) ? *(const u32x4*)(P + ((size_t)b * T + t_) * PP + C_DX + scol) : (u32x4){0u, 0u, 0u, 0u}; } \
        if (wave < 2) ND = (unsigned)P[((size_t)b * T + tc_ + lane) * PP + C_DT + gI * 2 + wave]; } while (0)
    MB_LOAD(0);
#pragma unroll 1
    for (int t0 = 0; t0 < T; t0 += 64) {
        unsigned lb_ = 0u; int tid_l = tid0; asm volatile("" : "+v"(lb_), "+v"(tid_l));
        const int tid = tid_l, lane = tid & 63, wave = __builtin_amdgcn_readfirstlane(tid >> 6);
        LAS unsigned char* lds = lds0 + lb_;
        const unsigned CD = ND;
#pragma unroll
        for (int k = 0; k < 5; ++k) { const int pi = tid + k * NTHR, r = pi >> 5, sp = pi & 31;
            if (pi < 2144) { if (r < 35) *(LAS u32x4*)(lds + O_RA + r * 512 + sp * 16) = NXr[k]; if (r >= 32) *(LAS u32x4*)(lds + O_RB + (r - 32) * 512 + sp * 16) = NXr[k]; } }
        if (t0 + 64 < T) MB_LOAD(t0 + 64);
        unsigned CZ[8];
#pragma unroll
        for (int q = 0; q < 8; ++q) { const size_t m_ = (size_t)b * T + t0 + wave * 8 + q; CZ[q] = (unsigned)P[m_ * PP + C_DZ + gI * 128 + lane] | ((unsigned)P[m_ * PP + C_DZ + gI * 128 + 64 + lane] << 16); }
        LAS float* SM = (LAS float*)(lds + O_SM);
        LAS float* YF = (LAS float*)(lds + O_YF);
        if (wave < 2) {
            const size_t m = (size_t)b * T + t0 + lane;
            const float dt = softplusf_(bf2f((bf16)CD) + (wave == 0 ? dtb0 : dtb1));
            float cs = dt * (wave == 0 ? nA0 : nA1);
#pragma unroll
            for (int o = 1; o < 64; o <<= 1) { const float y = __shfl_up(cs, o); if (lane >= o) cs += y; }
            const float cL = __shfl(cs, 63);
            SM[wave * 64 + lane] = dt; SM[128 + wave * 64 + lane] = cs; SM[256 + wave * 64 + lane] = __expf(cL - cs) * dt; SM[384 + wave * 64 + lane] = __expf(cs);
        }
        __syncthreads();
        { const unsigned xb_ = (unsigned)((sub ? O_RB : O_RA) + cc * 2);
#pragma unroll 1
          for (int g8 = 0; g8 < 4; ++g8) {
            float xv[11]; const unsigned xa = xb_ + (unsigned)(g8 * 8 * 512);
#pragma unroll
            for (int r = 0; r < 11; ++r) xv[r] = bf2f(*(const LAS bf16*)(lds + xa + r * 512));
#pragma unroll
            for (int j = 0; j < 8; ++j) {
                const int tt = sub * 32 + g8 * 8 + j;
                const float a = siluf_(cb + cw3 * xv[j + 3] + cw2 * xv[j + 2] + cw1 * xv[j + 1] + cw0 * xv[j]);
                if (cc < 128) { const int hh = cc >> 6, p = cc & 63;
                    *(LAS bf16*)(lds + O_XT0 + hh * MB + (p * LS + tt) * 2) = (bf16)f2bf(a); *(LAS bf16*)(lds + O_XW0 + hh * MB + (p * LS + tt) * 2) = (bf16)f2bf(a * SM[256 + hh * 64 + tt]); }
                else if (cc < 192) { const int n = cc - 128; *(LAS bf16*)(lds + O_BN + (tt * LS + n) * 2) = (bf16)f2bf(a); *(LAS bf16*)(lds + O_BT + (n * LS + tt) * 2) = (bf16)f2bf(a); }
                else { const int n = cc - 192; *(LAS bf16*)(lds + O_CN + (tt * LS + n) * 2) = (bf16)f2bf(a);
                    *(LAS bf16*)(lds + O_CS0 + (tt * LS + n) * 2) = (bf16)f2bf(a * SM[384 + tt]); *(LAS bf16*)(lds + O_CS0 + MB + (tt * LS + n) * 2) = (bf16)f2bf(a * SM[384 + 64 + tt]); }
            }
          } }
        __syncthreads();
        { f4 acc[2]; acc[0] = (f4){0.f, 0.f, 0.f, 0.f}; acc[1] = (f4){0.f, 0.f, 0.f, 0.f}; mm64(acc, lds, O_CN, O_BN, wave, lane);
#pragma unroll
            for (int hh = 0; hh < 2; ++hh) { f4 sc[2];
#pragma unroll
                for (int cI = 0; cI < 2; ++cI) { const int s = ((wave & 1) * 2 + cI) * 16 + (lane & 15), row = (wave >> 1) * 16 + 4 * (lane >> 4);
                    const float cs = SM[128 + hh * 64 + s], ds = SM[hh * 64 + s];
#pragma unroll
                    for (int e = 0; e < 4; ++e) { const float ct = SM[128 + hh * 64 + row + e]; sc[cI][e] = (s <= row + e) ? acc[cI][e] * __expf(ct - cs) * ds : 0.f; } }
                storeN<0>(lds, O_SC0 + hh * MB, sc, wave, lane); } }
        __syncthreads();
        f4 yacc[2][2];
#pragma unroll
        for (int hh = 0; hh < 2; ++hh) {
            yacc[hh][0] = (f4){0.f, 0.f, 0.f, 0.f}; yacc[hh][1] = (f4){0.f, 0.f, 0.f, 0.f};
            mm64(yacc[hh], lds, O_SC0 + hh * MB, O_XT0 + hh * MB, wave, lane); mm64(yacc[hh], lds, O_CS0 + hh * MB, O_HN0 + hh * MB, wave, lane);
            const float gL = SM[384 + hh * 64 + 63]; hacc[hh][0] = hacc[hh][0] * gL; hacc[hh][1] = hacc[hh][1] * gL;
            mm64(hacc[hh], lds, O_XW0 + hh * MB, O_BT, wave, lane);
        }
        __syncthreads();
#pragma unroll
        for (int hh = 0; hh < 2; ++hh) {
#pragma unroll
            for (int cI = 0; cI < 2; ++cI) { const int colp = ((wave & 1) * 2 + cI) * 16 + (lane & 15), row = (wave >> 1) * 16 + 4 * (lane >> 4);
#pragma unroll
                for (int e = 0; e < 4; ++e) YF[(row + e) * 128 + hh * 64 + colp] = yacc[hh][cI][e]; }
            storeN<0>(lds, O_HN0 + hh * MB, hacc[hh], wave, lane);
        }
        __syncthreads();
#pragma unroll
        for (int q = 0; q < 8; ++q) {
            const int tt = wave * 8 + q; const size_t m = (size_t)b * T + t0 + tt;
            const float x0 = bf2f(*(const LAS bf16*)(lds + O_XT0 + (lane * LS + tt) * 2)), x1 = bf2f(*(const LAS bf16*)(lds + O_XT0 + MB + (lane * LS + tt) * 2));
            const int c0 = gI * 128 + lane, c1 = c0 + 64;
            const float z0 = __uint_as_float(CZ[q] << 16), z1 = __uint_as_float(CZ[q] & 0xffff0000u);
            const float y0 = (YF[tt * 128 + lane] + dsk0 * x0) * siluf_(z0), y1 = (YF[tt * 128 + 64 + lane] + dsk1 * x1) * siluf_(z1);
            const float ss = wave_sum(y0 * y0 + y1 * y1); const float rs = rsqrtf(ss * (1.f / 128.f) + 1e-5f);
            OB[m * 1024 + 768 + c0] = (bf16)f2bf(y0 * rs * nw0); OB[m * 1024 + 768 + c1] = (bf16)f2bf(y1 * rs * nw1);
        }
        __syncthreads();
    }
#undef MB_LOAD
}
}

namespace bsp {
typedef short bf16x8 __attribute__((ext_vector_type(8)));
typedef float f4 __attribute__((ext_vector_type(4)));
constexpr int HS = 129;
constexpr int O_HIST = 0;
constexpr int O_V = 66048;
constexpr int VS = 272;
constexpr int O_KB = O_V + 2 * 32 * VS * 2;
constexpr int KBUF = 20480;
static_assert(O_KB + 2 * KBUF <= LDS_BYTES - 600, "mixer B LDS map");
__device__ __forceinline__ float relu_(float x) { return __int_as_float(max(__float_as_int(x), 0)); }
__device__ __forceinline__ int qkey(float s) { int q = (int)__builtin_fmaf(s, 262144.f, 8388608.f); return q < 1 ? 1 : (q > 16777215 ? 16777215 : q); }
__device__ __forceinline__ unsigned okey(float s) { return (unsigned)qkey(s) << 8; }
__device__ __forceinline__ int f2o(float f) { const int b = __float_as_int(f); return b ^ ((b >> 31) & 0x7fffffff); }
__device__ __forceinline__ float o2f(int o) { return __int_as_float(o ^ ((o >> 31) & 0x7fffffff)); }
__device__ __forceinline__ float fthr(const unsigned Q) {
    const int Qc = (int)(Q < 2u ? 2u : (Q > 16777215u ? 16777215u : Q));
    long long lo = f2o(-64.f), hi = f2o(64.f);
#pragma unroll 1
    for (int i = 0; i < 33; ++i) { const int mid = (int)((lo + hi) >> 1); if (qkey(o2f(mid)) >= Qc) hi = mid; else lo = mid; }
    const float r = o2f((int)hi);
    return Q < 2u ? -INFINITY : (Q > 16777215u ? INFINITY : r);
}
__device__ __forceinline__ void hist_add(const unsigned addr, const unsigned v) { asm volatile("ds_add_u32 %0, %1" :: "v"(addr), "v"(v) : "memory"); }
__device__ __forceinline__ f4 idx_tile(const bf16* Pb, const int kt, const bf16x8 (&qi)[4][2], const float (&wq)[4], const int lane) {
    const bf16* kr = Pb + (size_t)(kt * 16 + (lane & 15)) * PP + C_IK + (lane >> 4) * 8;
    const bf16x8 a0 = *(const bf16x8*)kr, a1 = *(const bf16x8*)(kr + 32);
    f4 s = (f4){0.f, 0.f, 0.f, 0.f};
#pragma unroll
    for (int h = 0; h < 4; ++h) { f4 t = (f4){0.f, 0.f, 0.f, 0.f};
        t = __builtin_amdgcn_mfma_f32_16x16x32_bf16(a0, qi[h][0], t, 0, 0, 0); t = __builtin_amdgcn_mfma_f32_16x16x32_bf16(a1, qi[h][1], t, 0, 0, 0);
#pragma unroll
        for (int e = 0; e < 4; ++e) s[e] += wq[h] * relu_(t[e]); }
    return s;
}

__device__ __forceinline__ void item(LAS unsigned char* lds0, const int bb, const int qb, const bf16* P, bf16* OB, const int tid0, const int pm, int* qctr, int& nxt) {
    unsigned lb_ = 0u; int tid_l = tid0; asm volatile("" : "+v"(lb_), "+v"(tid_l));
    LAS unsigned char* lds = lds0 + lb_; const int tid = tid_l, lane = tid & 63, wave = __builtin_amdgcn_readfirstlane(tid >> 6);
    const bf16* Pb = P + (size_t)bb * T * PP;
    const int ql = wave * 16 + (lane & 15), tq = qb * 128 + ql, g = lane >> 4;
    const bf16* prow = Pb + (size_t)tq * PP;
    bf16x8 qi[4][2]; float wq[4];
#pragma unroll
    for (int h = 0; h < 4; ++h) { qi[h][0] = *(const bf16x8*)(prow + C_IQ + h * 64 + g * 8); qi[h][1] = *(const bf16x8*)(prow + C_IQ + h * 64 + 32 + g * 8); wq[h] = bf2f(prow[C_IW + h]) * 0.0625f; }
    LAS unsigned* hist = (LAS unsigned*)(lds + O_HIST) + ql * HS;
    const unsigned histb = (unsigned)(size_t)hist;
    const int nkt = (qb + 1) * 8;
    unsigned prefix = 0u; int needk = 256;
#pragma unroll 1
    for (int rr = 0; rr < (pm == 102 ? 2 : 1); ++rr) { prefix = 0u; needk = 256;
#pragma unroll 1
    for (int pass = 0; pass < 3; ++pass) {
        for (int i = lane; i < 16 * HS; i += 64) ((LAS unsigned*)(lds + O_HIST) + wave * 16 * HS)[i] = 0u;
        asm volatile("s_waitcnt lgkmcnt(0)" ::: "memory");
        const int shp = 32 - 8 * pass, shb = 24 - 8 * pass;
        float flo = 0.f, fhi = 0.f;
        if (pass > 0) { const float stepw = (pass == 1) ? 65536.f : 256.f; flo = ((float)prefix * stepw - 2.f) * (1.f / 262144.f) - 32.f; fhi = (((float)prefix + 1.f) * stepw + 2.f) * (1.f / 262144.f) - 32.f; }
        if (prefix == 0u) flo = -INFINITY; if (pass == 2 && prefix == 0xffffu) fhi = INFINITY;
        const int nsteps = pm >= 300 ? 0 : nkt >> 3;
#define RDX_DMA(stepi, bufi) do { const int st_ = (stepi) < nsteps ? (stepi) : (nsteps - 1); \
            _Pragma("unroll") for (int jj_ = 0; jj_ < 2; ++jj_) { const int S_ = (wave + 8 * jj_) * 64 + lane, r_ = S_ >> 3, p_ = S_ & 7; \
            __builtin_amdgcn_global_load_lds((const unsigned*)(Pb + (size_t)(st_ * 128 + r_) * PP + C_IK + ((p_ ^ (r_ & 7)) << 3)), (LAS unsigned*)(lds + O_V + (bufi) * 16384 + (wave + 8 * jj_) * 1024), 16, 0, 0); } } while (0)
        asm volatile("s_waitcnt vmcnt(0) lgkmcnt(0)" ::: "memory"); __builtin_amdgcn_s_barrier();
        RDX_DMA(0, 0); RDX_DMA(1, 1); RDX_DMA(2, 2);
        typedef float f2 __attribute__((ext_vector_type(2)));
        auto steps = [&](auto PVc) { constexpr int PV = decltype(PVc)::value;
            f2 w2[4];
#pragma unroll
            for (int h = 0; h < 4; ++h) w2[h] = (f2){wq[h], wq[h]};
            const int tqmin_ = qb * 128 + wave * 16;
#pragma unroll 1
            for (int stp = 0; stp < nsteps; ++stp) {
                asm volatile("s_waitcnt vmcnt(4)" ::: "memory");
                __builtin_amdgcn_s_barrier();
                RDX_DMA(stp + 3, (stp + 3) & 3);
                const unsigned kbr = (unsigned)(O_V + (stp & 3) * 16384);
                const bool edge = stp >= nsteps - 1;
                auto score = [&](const int u, f2& s01, f2& s23) __attribute__((always_inline)) {
                    const bf16x8 ka0 = *(const LAS bf16x8*)(lds + kbr + (u * 16 + (lane & 15)) * 128 + (((0 + g) ^ (lane & 7)) << 4));
                    const bf16x8 ka1 = *(const LAS bf16x8*)(lds + kbr + (u * 16 + (lane & 15)) * 128 + (((4 + g) ^ (lane & 7)) << 4));
                    s01 = (f2){0.f, 0.f}; s23 = (f2){0.f, 0.f};
#pragma unroll
                    for (int h = 0; h < 4; ++h) { f4 t = (f4){0.f, 0.f, 0.f, 0.f};
                        t = __builtin_amdgcn_mfma_f32_16x16x32_bf16(ka0, qi[h][0], t, 0, 0, 0); t = __builtin_amdgcn_mfma_f32_16x16x32_bf16(ka1, qi[h][1], t, 0, 0, 0);
                        s01 += w2[h] * (f2){relu_(t[0]), relu_(t[1])}; s23 += w2[h] * (f2){relu_(t[2]), relu_(t[3])}; } };
                auto count = [&](const int u, const f2 s01, const f2 s23, auto EDc) __attribute__((always_inline)) { constexpr bool ED = decltype(EDc)::value;
                    const int k0 = (stp * 8 + u) * 16; const float sv[4] = {s01.x, s01.y, s23.x, s23.y};
                    if constexpr (PV == 0) {
#pragma unroll
                        for (int e = 0; e < 4; ++e) { const unsigned q = (unsigned)qkey(sv[e]); unsigned val = (q & 0x10000u) ? 0x10000u : 1u;
                            if (ED) val = (k0 + 4 * g + e <= tq) ? val : 0u;
                            hist_add(histb + ((q >> 17) << 2), val); }
                    } else if constexpr (PV == 1) {
#pragma unroll
                        for (int e = 0; e < 4; ++e) { const unsigned q = (unsigned)qkey(sv[e]); bool mt = (q >> 16) == prefix; if (ED) mt = mt & (k0 + 4 * g + e <= tq);
                            const unsigned val = mt ? ((q & 0x100u) ? 0x10000u : 1u) : 0u;
                            hist_add(histb + (((q >> 9) & 127u) << 2), val); }
                    } else {
#pragma unroll
                        for (int e = 0; e < 4; ++e) { const unsigned q = (unsigned)qkey(sv[e]); bool mt = (sv[e] >= flo) & (sv[e] <= fhi) & ((q >> 8) == prefix); if (ED) mt = mt & (k0 + 4 * g + e <= tq);
                            const unsigned val = mt ? ((q & 1u) ? 0x10000u : 1u) : 0u;
                            hist_add(histb + (((q >> 1) & 127u) << 2), val); }
                    } };
                if (!edge) {
                    f2 sa[8], sb[8];
#pragma unroll
                    for (int u = 0; u < 8; ++u) score(u, sa[u], sb[u]);
                    if constexpr (PV < 2) {
#pragma unroll
                        for (int u = 0; u < 8; ++u) count(u, sa[u], sb[u], std::false_type{});
                    } else {
#pragma unroll
                        for (int u = 0; u < 8; ++u) { const bool inl = ((sa[u].x >= flo) & (sa[u].x <= fhi)) | ((sa[u].y >= flo) & (sa[u].y <= fhi)) | ((sb[u].x >= flo) & (sb[u].x <= fhi)) | ((sb[u].y >= flo) & (sb[u].y <= fhi));
                            if (__any(inl)) count(u, sa[u], sb[u], std::false_type{}); }
                    }
                } else {
#pragma unroll
                    for (int u = 0; u < 8; ++u) {
                        if ((stp * 8 + u) * 16 > tqmin_ + 15) continue;
                        f2 s01, s23; score(u, s01, s23); count(u, s01, s23, std::true_type{}); }
                }
            }
        };
        if (pass == 0) steps(std::integral_constant<int, 0>{}); else if (pass == 1) steps(std::integral_constant<int, 1>{}); else steps(std::integral_constant<int, 2>{});
        asm volatile("s_waitcnt vmcnt(0)" ::: "memory");
#undef RDX_DMA
        asm volatile("s_waitcnt lgkmcnt(0)" ::: "memory");
        int cum = 0; unsigned bsel = 0u; int above = 0;
#pragma unroll 1
        for (int w4 = 31; w4 >= 0; --w4) { unsigned vw[4];
#pragma unroll
            for (int k = 0; k < 4; ++k) vw[k] = hist[w4 * 4 + 3 - k];
            bool done = false;
#pragma unroll
            for (int k = 0; k < 4; ++k) { const int wd = w4 * 4 + 3 - k; const int hi = (int)(vw[k] >> 16), lo = (int)(vw[k] & 0xffffu);
                if (!done) { if (cum + hi >= needk) { bsel = (unsigned)(2 * wd + 1); above = cum; done = true; }
                    else { cum += hi; if (cum + lo >= needk) { bsel = (unsigned)(2 * wd); above = cum; done = true; } else cum += lo; } } }
            if (done) break; }
        prefix = (prefix << 8) | bsel; needk -= above;
        asm volatile("s_waitcnt lgkmcnt(0)" ::: "memory");
    }
    }
    if (pm >= 200 && pm < 300) { __syncthreads(); return; }
    unsigned thr = prefix; int need = needk;
    bool tie = false;
    if (tq < 256) { thr = 0u; need = 1 << 20; }
    else { const unsigned v = hist[(prefix & 255u) >> 1]; const int ceq = (prefix & 1u) ? (int)(v >> 16) : (int)(v & 0xffffu); tie = needk < ceq; }
    __syncthreads();
    const bool anytie = __any(tie);
    const float sB = fthr(thr);
    unsigned cn = (unsigned)(need > 0xffff ? 0xffff : need) << 16;
    constexpr int O_TC = O_KB + 2 * KBUF + 2048;
    if (g == 0) { *(LAS unsigned*)(lds + O_TC + ql * 8) = thr; *(LAS unsigned*)(lds + O_TC + ql * 8 + 4) = cn; }
    const int tqmin = qb * 128 + wave * 16;
#pragma unroll
    for (int h = 0; h < 4; ++h) { *(LAS bf16x8*)(lds + O_HIST + wave * 8192 + ((h * 2 + 0) * 64 + lane) * 16) = qi[h][0]; *(LAS bf16x8*)(lds + O_HIST + wave * 8192 + ((h * 2 + 1) * 64 + lane) * 16) = qi[h][1]; }
    constexpr int O_WQ = O_KB + 2 * KBUF;
    if (g == 0) {
#pragma unroll
        for (int h = 0; h < 4; ++h) *(LAS float*)(lds + O_WQ + ((wave * 4 + h) * 16 + (lane & 15)) * 4) = wq[h]; }
    bf16x8 qa[4][2];
#pragma unroll
    for (int h = 0; h < 4; ++h) { qa[h][0] = *(const bf16x8*)(prow + C_BQ + h * 64 + g * 8); qa[h][1] = *(const bf16x8*)(prow + C_BQ + h * 64 + 32 + g * 8); }
    f4 oacc[4][4]; float mrun[4], lrun[4];
#pragma unroll
    for (int h = 0; h < 4; ++h) { mrun[h] = -INFINITY; lrun[h] = 0.f;
#pragma unroll
        for (int dt = 0; dt < 4; ++dt) oacc[h][dt] = (f4){0.f, 0.f, 0.f, 0.f}; }
#pragma unroll 1
    for (int rr = 0; rr < (pm == 103 ? 2 : 1); ++rr) {
#pragma unroll
    for (int h = 0; h < 4; ++h) { mrun[h] = -INFINITY; lrun[h] = 0.f;
#pragma unroll
        for (int dt = 0; dt < 4; ++dt) oacc[h][dt] = (f4){0.f, 0.f, 0.f, 0.f}; }
    const int nst = (qb + 1) * 4;
    const int vkey = tid >> 4, vch = tid & 15;
    u32x4 vpre0 = *(const u32x4*)(Pb + (size_t)vkey * PP + C_BV + vch * 8), vpre1 = *(const u32x4*)(Pb + (size_t)vkey * PP + C_BV + 128 + vch * 8);
    const unsigned vrd = (unsigned)(unsigned long)lds + (unsigned)(O_V + (4 * g + ((lane >> 2) & 3)) * (VS * 2) + (lane & 3) * 8);
    __syncthreads();
    const int kr_ = 2 * wave + (lane >> 5), kir_ = wave * 8 + (lane >> 3);
    const bf16* kbase = Pb + (size_t)kr_ * PP + C_BK + (((lane & 31) ^ (kr_ & 15)) << 3);
    const bf16* kibase = Pb + (size_t)kir_ * PP + C_IK + (((lane & 7) ^ (kir_ & 7)) << 3);
#define K_DMA(key_first, kbo) do { const bf16* s0_ = kbase + (size_t)(key_first) * PP; \
        __builtin_amdgcn_global_load_lds((const unsigned*)s0_, (LAS unsigned*)(lds + (kbo) + wave * 1024), 16, 0, 0); \
        __builtin_amdgcn_global_load_lds((const unsigned*)(s0_ + (size_t)16 * PP), (LAS unsigned*)(lds + (kbo) + (wave + 8) * 1024), 16, 0, 0); \
        if (wave < 4) __builtin_amdgcn_global_load_lds((const unsigned*)(kibase + (size_t)(key_first) * PP), (LAS unsigned*)(lds + (kbo) + 16384 + wave * 1024), 16, 0, 0); } while (0)
    K_DMA(0, (unsigned)O_KB);
#pragma unroll 1
    for (int st = 0; st < nst; ++st) {
        const int key0 = st * 32; const unsigned vbuf = (unsigned)(st & 1) * (32 * VS * 2);
        unsigned qio = (unsigned)(O_HIST + wave * 8192 + lane * 16); asm volatile("" : "+v"(qio));
        unsigned wqo = (unsigned)(O_WQ + wave * 256 + (lane & 15) * 4); asm volatile("" : "+v"(wqo));
        unsigned tco = (unsigned)(O_TC + (wave * 16 + (lane & 15)) * 8); asm volatile("" : "+v"(tco));
        { LAS bf16* VL = (LAS bf16*)(lds + O_V + vbuf); *(LAS u32x4*)(VL + vkey * VS + vch * 8) = vpre0; *(LAS u32x4*)(VL + vkey * VS + 128 + vch * 8) = vpre1; }
        asm volatile("s_waitcnt vmcnt(0)" ::: "memory");
        __syncthreads();
        if (st + 1 < nst) K_DMA(key0 + 32, (unsigned)(O_KB + ((st + 1) & 1) * KBUF));
        const unsigned kbc = (unsigned)(O_KB + (st & 1) * KBUF);
#define KQ_(h, k2, ks) (*(const LAS bf16x8*)(lds + kbc + (k2 * 16 + (lane & 15)) * 512 + ((((h) * 8 + (ks) * 4 + g) ^ (lane & 15)) << 4)))
#define KI_(k2, ks) (*(const LAS bf16x8*)(lds + kbc + 16384 + (k2 * 16 + (lane & 15)) * 128 + ((((ks) * 4 + g) ^ (lane & 7)) << 4)))
        const bool active = key0 <= tqmin + 15;
        bool sel[2][4] = {{false, false, false, false}, {false, false, false, false}};
        if (active && pm == 305) {
#pragma unroll
            for (int k2 = 0; k2 < 2; ++k2)
#pragma unroll
                for (int e = 0; e < 4; ++e) sel[k2][e] = (key0 + k2 * 16 + 4 * g + e) <= tq;
        } else if (active) {
            unsigned eqm = 0u;
            const bool plain = !anytie && key0 + 31 <= tqmin;
#pragma unroll
            for (int k2 = 0; k2 < 2; ++k2) { f4 s = (f4){0.f, 0.f, 0.f, 0.f};
#pragma unroll
                for (int h = 0; h < 4; ++h) { f4 t = (f4){0.f, 0.f, 0.f, 0.f};
                    const bf16x8 qh0 = *(const LAS bf16x8*)(lds + qio + ((h * 2 + 0) * 64) * 16), qh1 = *(const LAS bf16x8*)(lds + qio + ((h * 2 + 1) * 64) * 16);
                    t = __builtin_amdgcn_mfma_f32_16x16x32_bf16(KI_(k2, 0), qh0, t, 0, 0, 0); t = __builtin_amdgcn_mfma_f32_16x16x32_bf16(KI_(k2, 1), qh1, t, 0, 0, 0);
                    const float wqh = *(const LAS float*)(lds + wqo + h * 64);
#pragma unroll
                    for (int e = 0; e < 4; ++e) s[e] += wqh * relu_(t[e]); }
                if (plain) {
#pragma unroll
                    for (int e = 0; e < 4; ++e) sel[k2][e] = s[e] >= sB;
                } else {
                    const unsigned thr_ = *(const LAS unsigned*)(lds + tco);
#pragma unroll
                    for (int e = 0; e < 4; ++e) { const int key = key0 + k2 * 16 + 4 * g + e, tq_ = tqmin + (lane & 15); const unsigned k24 = (unsigned)qkey(s[e]);
                        sel[k2][e] = (key <= tq_) & (k24 > thr_); if ((key <= tq_) & (k24 == thr_)) eqm |= 1u << (k2 * 4 + e); }
                } }
            if (!plain) {
                if (anytie && __any(eqm != 0u)) {
                    const unsigned pk = (unsigned)__popc(eqm & 15u) | ((unsigned)__popc(eqm >> 4) << 8);
                    const unsigned p0 = (unsigned)__shfl((int)pk, lane & 15), p1 = (unsigned)__shfl((int)pk, (lane & 15) + 16), p2 = (unsigned)__shfl((int)pk, (lane & 15) + 32), p3 = (unsigned)__shfl((int)pk, (lane & 15) + 48);
                    const unsigned tot = p0 + p1 + p2 + p3, below = (g > 0 ? p0 : 0u) + (g > 1 ? p1 : 0u) + (g > 2 ? p2 : 0u);
                    const unsigned cn_ = *(const LAS unsigned*)(lds + tco + 4); const int cnt = (int)(cn_ & 0xffffu), need_ = (int)(cn_ >> 16); const int base0 = cnt + (int)(below & 255u), base1 = cnt + (int)(tot & 255u) + (int)(below >> 8);
#pragma unroll
                    for (int k2 = 0; k2 < 2; ++k2)
#pragma unroll
                        for (int e = 0; e < 4; ++e) { const unsigned bit = 1u << (k2 * 4 + e);
                            const int rank = (k2 ? base1 : base0) + __popc(eqm & (bit - 1u) & (k2 ? 0xf0u : 0x0fu));
                            sel[k2][e] = sel[k2][e] | (((eqm & bit) != 0u) & (rank < need_)); }
                    *(LAS unsigned*)(lds + tco + 4) = cn_ + (tot & 255u) + (tot >> 8);
                } else {
#pragma unroll
                    for (int k2 = 0; k2 < 2; ++k2)
#pragma unroll
                        for (int e = 0; e < 4; ++e) sel[k2][e] = sel[k2][e] | ((eqm & (1u << (k2 * 4 + e))) != 0u);
                }
            }
        }
#pragma unroll
        for (int h = 0; h < 4; ++h) {
            if (h == 2 && st + 1 < nst) { vpre0 = *(const u32x4*)(Pb + (size_t)(key0 + 32 + vkey) * PP + C_BV + vch * 8); vpre1 = *(const u32x4*)(Pb + (size_t)(key0 + 32 + vkey) * PP + C_BV + 128 + vch * 8); }
            if (active) {
            f4 sc[2];
#pragma unroll
            for (int k2 = 0; k2 < 2; ++k2) { f4 t = (f4){0.f, 0.f, 0.f, 0.f};
                t = __builtin_amdgcn_mfma_f32_16x16x32_bf16(KQ_(h, k2, 0), qa[h][0], t, 0, 0, 0); t = __builtin_amdgcn_mfma_f32_16x16x32_bf16(KQ_(h, k2, 1), qa[h][1], t, 0, 0, 0);
#pragma unroll
                for (int e = 0; e < 4; ++e) sc[k2][e] = sel[k2][e] ? t[e] * (0.125f * 1.4426950408889634f) : -INFINITY; }
            float mx = fmaxf(fmaxf(fmaxf(sc[0][0], sc[0][1]), fmaxf(sc[0][2], sc[0][3])), fmaxf(fmaxf(sc[1][0], sc[1][1]), fmaxf(sc[1][2], sc[1][3])));
            {
                const auto r16 = __builtin_amdgcn_permlane16_swap(__float_as_uint(mx), __float_as_uint(mx), false, false); mx = __builtin_amdgcn_fmed3f(__uint_as_float(r16[0]), __uint_as_float(r16[1]), INFINITY);
                const auto r32 = __builtin_amdgcn_permlane32_swap(__float_as_uint(mx), __float_as_uint(mx), false, false); mx = __builtin_amdgcn_fmed3f(__uint_as_float(r32[0]), __uint_as_float(r32[1]), INFINITY); }
            const float mnew = fmaxf(mrun[h], mx), msafe = (mnew == -INFINITY) ? 0.f : mnew;
            const bool resc = __any(mnew != mrun[h]);
            const float corr = __builtin_amdgcn_exp2f(mrun[h] - msafe); mrun[h] = mnew;
            float p[8]; float ps = 0.f;
#pragma unroll
            for (int e = 0; e < 4; ++e) { p[e] = __builtin_amdgcn_exp2f(sc[0][e] - msafe); p[4 + e] = __builtin_amdgcn_exp2f(sc[1][e] - msafe); ps += p[e] + p[4 + e]; }
            lrun[h] = lrun[h] * corr + ps;
            union { bf16x8 v; unsigned u[4]; } pb;
            pb.u[0] = pg8::cvt_pk_bf16(p[0], p[1]); pb.u[1] = pg8::cvt_pk_bf16(p[2], p[3]); pb.u[2] = pg8::cvt_pk_bf16(p[4], p[5]); pb.u[3] = pg8::cvt_pk_bf16(p[6], p[7]);
            union { bf16x8 v; u32x2 h2[2]; } vf[4];
            const unsigned va = vrd + vbuf + (unsigned)(h * 128);
            asm volatile("ds_read_b64_tr_b16 %0, %8\n\tds_read_b64_tr_b16 %1, %8 offset:%9\n\tds_read_b64_tr_b16 %2, %8 offset:32\n\tds_read_b64_tr_b16 %3, %8 offset:%10\n\t"
                         "ds_read_b64_tr_b16 %4, %8 offset:64\n\tds_read_b64_tr_b16 %5, %8 offset:%11\n\tds_read_b64_tr_b16 %6, %8 offset:96\n\tds_read_b64_tr_b16 %7, %8 offset:%12\n\ts_waitcnt lgkmcnt(0)"
                         : "=&v"(vf[0].h2[0]), "=&v"(vf[0].h2[1]), "=&v"(vf[1].h2[0]), "=&v"(vf[1].h2[1]), "=&v"(vf[2].h2[0]), "=&v"(vf[2].h2[1]), "=&v"(vf[3].h2[0]), "=&v"(vf[3].h2[1])
                         : "v"(va), "i"(16 * VS * 2), "i"(16 * VS * 2 + 32), "i"(16 * VS * 2 + 64), "i"(16 * VS * 2 + 96) : "memory");
            __builtin_amdgcn_sched_barrier(0);
            if (resc) {
#pragma unroll
                for (int dt = 0; dt < 4; ++dt) oacc[h][dt] = oacc[h][dt] * corr; }
#pragma unroll
            for (int dt = 0; dt < 4; ++dt) oacc[h][dt] = __builtin_amdgcn_mfma_f32_16x16x32_bf16(vf[dt].v, pb.v, oacc[h][dt], 0, 0, 0);
            }
        }
    }
    __syncthreads();
    }
#undef KQ_
#undef KI_
#undef K_DMA
    if (tid == 0) nxt = atomicAdd(qctr, 1);
    const size_t m = (size_t)bb * T + tqmin + (lane & 15);
    if (pm < 300)
#pragma unroll
    for (int h = 0; h < 4; ++h) { float l = lrun[h]; l += __shfl_xor(l, 16); l += __shfl_xor(l, 32); const float inv = 1.f / l;
#pragma unroll
        for (int dt = 0; dt < 4; ++dt) { u32x2 w; w.x = pk2(oacc[h][dt][0] * inv, oacc[h][dt][1] * inv); w.y = pk2(oacc[h][dt][2] * inv, oacc[h][dt][3] * inv);
            *(u32x2*)(OB + m * 1024 + 256 + h * 64 + dt * 16 + 4 * g) = w; } }
    __syncthreads();
}
}

namespace awin {
typedef short bf16x8 __attribute__((ext_vector_type(8)));
typedef float f4 __attribute__((ext_vector_type(4)));
constexpr int EXS = 66;
constexpr int O_EX = 0;
constexpr int VSW = 72;
constexpr int O_VW = 101376;
__device__ __forceinline__ void item(LAS unsigned char* lds0, const int bb, const int blk, const int h, const bf16* P, bf16* OB, const int tid0, int* qctr, int& nxt) {
    unsigned lb_ = 0u; int tid_l = tid0; asm volatile("" : "+v"(lb_), "+v"(tid_l));
    LAS unsigned char* lds = lds0 + lb_; const int tid = tid_l, lane = tid & 63, wave = __builtin_amdgcn_readfirstlane(tid >> 6);
    const bf16* Pb = P + (size_t)bb * T * PP; const int start = blk * 128, g = lane >> 4, ln = lane & 15;
    LAS float* EX = (LAS float*)(lds + O_EX);
    LAS bf16* VW = (LAS bf16*)(lds + O_VW + wave * 4608);
#pragma unroll 1
    for (int s4 = 0; s4 < 4; ++s4) {
        const int st = wave * 4 + s4;
        const int grp = st < 8 ? 0 : (st < 16 ? 1 : 2);
        const int dil = grp == 0 ? 1 : (grp == 1 ? 4 : 16), win = grp == 0 ? 128 : (grp == 1 ? 512 : 2048);
        const int r = grp == 0 ? 0 : (grp == 1 ? ((st - 8) >> 1) : (st - 16)), a0 = grp == 0 ? 16 * st : (grp == 1 ? ((st - 8) & 1) * 16 : 0), nqc = grp == 0 ? 128 : (grp == 1 ? 32 : 8);
        const int a = a0 + ln; const bool qok = a < nqc; const int ql = (qok ? a : (nqc - 1)) * dil + r, tq = start + ql;
        const bf16* qp = Pb + (size_t)tq * PP + C_AQ + grp * 256 + h * 64 + g * 8;
        const bf16x8 q0 = *(const bf16x8*)qp, q1 = *(const bf16x8*)(qp + 32);
        bf16x8 kf[10][2];
#pragma unroll
        for (int kt = 0; kt < 10; ++kt) { int pos = start - win + (a0 + 16 * kt + ln) * dil + r; pos = pos < 0 ? 0 : (pos > T - 1 ? T - 1 : pos);
            const bf16* kp = Pb + (size_t)pos * PP + C_AK + grp * 256 + h * 64 + g * 8; kf[kt][0] = *(const bf16x8*)kp; kf[kt][1] = *(const bf16x8*)(kp + 32); }
        f4 sc[10]; float mx = -INFINITY;
#pragma unroll
        for (int kt = 0; kt < 10; ++kt) { f4 t = (f4){0.f, 0.f, 0.f, 0.f};
            t = __builtin_amdgcn_mfma_f32_16x16x32_bf16(kf[kt][0], q0, t, 0, 0, 0); t = __builtin_amdgcn_mfma_f32_16x16x32_bf16(kf[kt][1], q1, t, 0, 0, 0);
#pragma unroll
            for (int e = 0; e < 4; ++e) { const int c = a0 + 16 * kt + 4 * g + e; const int pos = start - win + c * dil + r;
                const bool ok = qok && c >= a && c <= a + 128 && pos >= 0;
                sc[kt][e] = ok ? t[e] * 0.125f : -INFINITY; mx = fmaxf(mx, sc[kt][e]); } }
        u32x4 vv[5][4];
#pragma unroll
        for (int s5 = 0; s5 < 5; ++s5) {
            int pos = start - win + (a0 + 32 * s5 + (lane >> 1)) * dil + r; pos = pos < 0 ? 0 : (pos > T - 1 ? T - 1 : pos);
            const u32x4* vp = (const u32x4*)(Pb + (size_t)pos * PP + C_AV + grp * 256 + h * 64 + (lane & 1) * 32);
            vv[s5][0] = vp[0]; vv[s5][1] = vp[1]; vv[s5][2] = vp[2]; vv[s5][3] = vp[3]; }
        mx = fmaxf(mx, __shfl_xor(mx, 16)); mx = fmaxf(mx, __shfl_xor(mx, 32));
        const float msafe = (mx == -INFINITY) ? 0.f : mx; float lsum = 0.f;
#pragma unroll
        for (int kt = 0; kt < 10; ++kt)
#pragma unroll
            for (int e = 0; e < 4; ++e) { sc[kt][e] = __expf(sc[kt][e] - msafe); lsum += sc[kt][e]; }
        lsum += __shfl_xor(lsum, 16); lsum += __shfl_xor(lsum, 32);
        f4 oacc[4];
#pragma unroll
        for (int dt = 0; dt < 4; ++dt) oacc[dt] = (f4){0.f, 0.f, 0.f, 0.f};
#pragma unroll
        for (int s5 = 0; s5 < 5; ++s5) {
            const u32x4 v0 = vv[s5][0], v1 = vv[s5][1], v2 = vv[s5][2], v3 = vv[s5][3];
            LAS u32x4* vd = (LAS u32x4*)(VW + (lane >> 1) * VSW + (lane & 1) * 32);
            asm volatile("s_waitcnt lgkmcnt(0)" ::: "memory");
            vd[0] = v0; vd[1] = v1; vd[2] = v2; vd[3] = v3;
            asm volatile("s_waitcnt lgkmcnt(0)" ::: "memory");
            bf16x8 pb;
#pragma unroll
            for (int e = 0; e < 4; ++e) { pb[e] = (short)f2bf(sc[2 * s5][e]); pb[4 + e] = (short)f2bf(sc[2 * s5 + 1][e]); }
            {
                union { bf16x8 v; u32x2 h2[2]; } vf[4];
                const unsigned va = (unsigned)(unsigned long)VW + (unsigned)((4 * g + ((lane >> 2) & 3)) * (VSW * 2) + (lane & 3) * 8);
                asm volatile("ds_read_b64_tr_b16 %0, %8\n\tds_read_b64_tr_b16 %1, %8 offset:%9\n\tds_read_b64_tr_b16 %2, %8 offset:32\n\tds_read_b64_tr_b16 %3, %8 offset:%10\n\t"
                             "ds_read_b64_tr_b16 %4, %8 offset:64\n\tds_read_b64_tr_b16 %5, %8 offset:%11\n\tds_read_b64_tr_b16 %6, %8 offset:96\n\tds_read_b64_tr_b16 %7, %8 offset:%12\n\ts_waitcnt lgkmcnt(0)"
                             : "=&v"(vf[0].h2[0]), "=&v"(vf[0].h2[1]), "=&v"(vf[1].h2[0]), "=&v"(vf[1].h2[1]), "=&v"(vf[2].h2[0]), "=&v"(vf[2].h2[1]), "=&v"(vf[3].h2[0]), "=&v"(vf[3].h2[1])
                             : "v"(va), "i"(16 * VSW * 2), "i"(16 * VSW * 2 + 32), "i"(16 * VSW * 2 + 64), "i"(16 * VSW * 2 + 96) : "memory");
#pragma unroll
                for (int dt = 0; dt < 4; ++dt) oacc[dt] = __builtin_amdgcn_mfma_f32_16x16x32_bf16(vf[dt].v, pb, oacc[dt], 0, 0, 0); }
        }
        if (qok) { LAS float* ex = EX + (grp * 128 + ql) * EXS;
#pragma unroll
            for (int dt = 0; dt < 4; ++dt) { ex[dt * 16 + 4 * g + 0] = oacc[dt][0]; ex[dt * 16 + 4 * g + 1] = oacc[dt][1]; ex[dt * 16 + 4 * g + 2] = oacc[dt][2]; ex[dt * 16 + 4 * g + 3] = oacc[dt][3]; }
            if (g == 0) { ex[64] = mx; ex[65] = lsum; } }
    }
    __syncthreads();
    if (tid == 0) nxt = atomicAdd(qctr, 1);
    { const int ql = tid >> 2, d0 = (tid & 3) * 16;
      const LAS float* e0 = EX + (0 * 128 + ql) * EXS; const LAS float* e1 = EX + (1 * 128 + ql) * EXS; const LAS float* e2 = EX + (2 * 128 + ql) * EXS;
      const float m0 = e0[64], m1 = e1[64], m2 = e2[64], M = fmaxf(m0, fmaxf(m1, m2));
      const float w0 = __expf(m0 - M), w1 = __expf(m1 - M), w2 = __expf(m2 - M); const float inv = 1.f / (w0 * e0[65] + w1 * e1[65] + w2 * e2[65]);
      unsigned pk[8];
#pragma unroll
      for (int j = 0; j < 8; ++j) { const float x0 = (w0 * e0[d0 + 2 * j] + w1 * e1[d0 + 2 * j] + w2 * e2[d0 + 2 * j]) * inv, x1 = (w0 * e0[d0 + 2 * j + 1] + w1 * e1[d0 + 2 * j + 1] + w2 * e2[d0 + 2 * j + 1]) * inv; pk[j] = pk2(x0, x1); }
      u32x4* op = (u32x4*)(OB + ((size_t)bb * T + start + ql) * 1024 + h * 64 + d0);
      op[0] = (u32x4){pk[0], pk[1], pk[2], pk[3]}; op[1] = (u32x4){pk[4], pk[5], pk[6], pk[7]}; }
    __syncthreads();
}
}

template <int SP>
__device__ __forceinline__ void phase_body(const int l_in, LAS unsigned char* lds) {
    int tid_ = threadIdx.x, bid_ = blockIdx.x, l_ = l_in, G_ = gridDim.x; asm volatile("" : "+v"(tid_), "+s"(bid_), "+s"(l_), "+s"(G_));
    const int tid = tid_, lane = tid & 63, wave = __builtin_amdgcn_readfirstlane(tid >> 6), l = l_;
    const int G = G_, bid = bid_;
    const int gw = bid * NWAVES + wave, NGW = G * NWAVES;
    unsigned char* ws = (unsigned char*)gptr(ldptr(lds, 36));
    int* ctl = (int*)(ws + WS_CTL);
    bf16* XB = (bf16*)(ws + WS_XB); bf16* OB = (bf16*)(ws + WS_O); bf16* VF = (bf16*)(ws + WS_VF); bf16* P = (bf16*)(ws + WS_P);
    bf16* GS = (bf16*)(ws + WS_GS); bf16* MG = (bf16*)(ws + WS_MERGED); bf16* XS = (bf16*)(ws + WS_XS); bf16* HB = (bf16*)(ws + WS_H);
    bf16* WGU = (bf16*)(ws + WS_WGU); bf16* WD = (bf16*)(ws + WS_WD);
    float* X = (float*)gptr(ldptr(lds, 35));
    int* tok_e = (int*)(ws + WS_ROUTE); float* tok_g = (float*)(ws + WS_ROUTE + 256 * 1024); int* tok_rank = (int*)(ws + WS_ROUTE + 512 * 1024); int* tok_slot = (int*)(ws + WS_ROUTE + 768 * 1024);
    (void)ctl; (void)XB; (void)OB; (void)VF; (void)P; (void)GS; (void)MG; (void)XS; (void)HB; (void)WGU; (void)WD; (void)X; (void)tok_e; (void)tok_g; (void)tok_rank; (void)tok_slot; (void)gw; (void)NGW; (void)lane;
    {
        bf16* WinT = (bf16*)(ws + WS_WINT) + (size_t)l * 5120 * 1024; bf16* WgT = (bf16*)(ws + WS_WGT) + (size_t)l * 4096 * 1024;
        bf16* WbrT = (bf16*)(ws + WS_WBRT) + (size_t)l * 1024 * 1024; bf16* WoutT = (bf16*)(ws + WS_WOUTT) + (size_t)l * 1024 * 1024;
        float* WrT = (float*)(ws + WS_WRT) + (size_t)l * 36 * 1024;
        int* cnt = ctl + CW_CNT + l * 64;

        if constexpr (SP == -1) {
            LAS float* scr = (LAS float*)(lds + wave * 16384);
#pragma unroll 1
            for (int job = 0; job < NL * 11; ++job) {
                const int ll = job / 11, jk = job % 11;
                const int gwr = (gw + job * 187) % NGW;
                if (jk < 5) {
                    const float* W = INP(I_WIN) + (size_t)ll * 1024 * INW;
                    const int sc0 = jk == 0 ? 0 : (jk == 1 ? 3396 : (jk == 2 ? 3392 : (jk == 3 ? 5060 : 5064)));
                    const int snc = jk == 0 ? 3392 : (jk == 1 ? 1664 : (jk == 4 ? 4096 : 4));
                    const int sr0 = jk == 0 ? 0 : (jk == 1 ? 3392 : (jk == 2 ? 5056 : (jk == 3 ? 5060 : 0)));
                    bf16* dst = jk == 4 ? (bf16*)(ws + WS_WGT) + (size_t)ll * 4096 * 1024 : (bf16*)(ws + WS_WINT) + (size_t)ll * 5120 * 1024;
                    const int nbn = (snc + 31) / 32, nit = 16 * nbn;
#pragma unroll 1
                    for (int it = gwr; it < nit; it += NGW) transpose_item(W, INW, sc0, snc, dst, 1024, sr0, 0, it / nbn, it % nbn, scr, lane);
                } else if (jk < 9) {
                    const int n = jk - 5; const float* Wb = INP(I_WBR) + ((size_t)ll * 4 + n) * 256 * 1024;
#pragma unroll 1
                    for (int it = gwr; it < 4 * 32; it += NGW) transpose_item(Wb, 1024, 0, 1024, (bf16*)(ws + WS_WBRT) + (size_t)ll * 1024 * 1024, 1024, 0, n * 256, it / 32, it % 32, scr, lane);
                } else if (jk == 9) {
                    const float* Wo = INP(I_WOUT) + (size_t)ll * 1024 * 1024;
#pragma unroll 1
                    for (int it = gwr; it < 16 * 32; it += NGW) transpose_item(Wo, 1024, 0, 1024, (bf16*)(ws + WS_WOUTT) + (size_t)ll * 1024 * 1024, 1024, 0, 0, it / 32, it % 32, scr, lane);
                } else {
                    bf16* wi = (bf16*)(ws + WS_WINT) + (size_t)ll * 5120 * 1024;
#pragma unroll 1
                    for (int i = gwr * 64 + lane; i < 56 * 1024 / 8; i += NGW * 64) ((u32x4*)(wi + (size_t)5064 * 1024))[i] = (u32x4){0u, 0u, 0u, 0u};
                    float* wr = (float*)(ws + WS_WRT) + (size_t)ll * 36 * 1024; const float* rg = INP(I_RG) + (size_t)ll * 1024 * 4; const float* re = INP(I_RE) + (size_t)ll * 1024 * 32;
#pragma unroll 1
                    for (int i = gwr * 64 + lane; i < 36 * 1024; i += NGW * 64) { const int o = i / 1024, k = i % 1024; wr[i] = o < 4 ? rg[k * 4 + o] : re[k * 32 + (o - 4)]; }
                }
            }
            { bf16* img = (bf16*)(ws + WS_LORA);
#pragma unroll 1
              for (int i = gw * 64 + lane; i < NL * 4 * 2 * 4096; i += NGW * 64) { const int lh = i >> 13, tbl = (i >> 12) & 1, mm = (i >> 6) & 63, cc = i & 63, ll = lh >> 2, hh = lh & 3;
                  const float w = tbl ? INP(I_CG2)[((size_t)ll * 64 + mm) * 256 + hh * 64 + cc] : (mm < 32 ? INP(I_CW2)[((size_t)ll * 32 + mm) * 256 + hh * 64 + cc] : INP(I_CA2)[((size_t)ll * 32 + (mm - 32)) * 256 + hh * 64 + cc]);
                  img[(size_t)(lh * 2 + tbl) * 4608 + cc * 72 + mm] = (bf16)f2bf(w); } }
            for (int m = gw; m < M; m += NGW) {
                const f32x4* xr = (const f32x4*)(INP(I_X) + (size_t)m * D) + lane;
#pragma unroll
                for (int j = 0; j < 4; ++j) { const f32x4 v = xr[64 * j];
                    u32x2 w; w.x = pk2(v[0], v[1]); w.y = pk2(v[2], v[3]); ((u32x2*)(XB + (size_t)m * D))[lane + 64 * j] = w; }
            }
        }
        else if constexpr (SP == 0) {
            pg8::Gemm g{XB, WinT, 1024, 1024, 1024}; pg8::StaticOrder S; S.init(M, PP, G, bid, 1024, 1024);
            EpiStoreBf16 E{P, PP, 0, PP};
            pg8::gemm_phase<EpiStoreBf16, pg8::StaticOrder>(lds, g, S, E);
        }
        else if constexpr (SP == 12) {
            if (bid < 32) rw::carry(lds, ws + WS_RW + (size_t)bid * 64 * 16384, tid);
        }
        else if constexpr (SP == 13) {
            unsigned char* GZ = ws + WS_RW;
            const int h = bid & 3, k = bid >> 2;
            rw::build_ct(lds, l, h, lane, wave); __syncthreads();
#pragma unroll 1
            for (int idx = k; idx < 512; idx += (G >> 2)) { const int b = idx >> 6, cI = idx & 63; const size_t ci_ = (size_t)((b * 4 + h) * 64 + cI);
                rw::chunk_out(lds, b, h, cI * 64, GZ + ci_ * 16384, ws + WS_RW2 + ci_ * 24576, (const float*)(ws + WS_BONG) + ci_ * 64, VF, OB, tid); }
        }
        else if constexpr (SP == 15) {
            unsigned char* GZ = ws + WS_RW;
            int* qctr = ctl + CW_Q + l * 64;
            int cur_h = -1; int nxt = -1;
#pragma unroll 1
            for (;;) {
                unsigned so = (unsigned)(LDS_BYTES - 584); asm volatile("" : "+v"(so));
                volatile LAS int* slot = (volatile LAS int*)(lds + so);
                int tid = threadIdx.x; asm volatile("" : "+v"(tid));
                const int lane = tid & 63, wave = __builtin_amdgcn_readfirstlane(tid >> 6);
                __syncthreads();
                if (tid == 0) *slot = nxt >= 0 ? nxt : atomicAdd(qctr, 1);
                __syncthreads();
                const int it = __builtin_amdgcn_readfirstlane(*slot);
                if (it >= 3344) break;
                nxt = -1;
                if (it < 16) { mb::chain(lds, l, it >> 1, it & 1, P, OB, tid, lane, wave); }
                else if (it < 272) { const int j = it - 16; bsp::item(lds, j & 7, 31 - (j >> 3), P, OB, tid, (int)(unsigned)ldptr(lds, 37), qctr, nxt); }
                else if (it < 2320) { const int j = it - 272, h = j >> 9, idx = j & 511, b = idx >> 6, cI = idx & 63;
                    if (h != cur_h) { rw::build_ct(lds, l, h, lane, wave); cur_h = h; __syncthreads(); }
                    { const size_t ci_ = (size_t)((b * 4 + h) * 64 + cI); rw::chunk<1>(lds, l, b, h, cI * 64, GZ + ci_ * 16384, ws + WS_RW2 + ci_ * 24576, (float*)(ws + WS_BONG) + ci_ * 64, P, VF, OB, tid, qctr, nxt); } }
                else { const int j = it - 2320; awin::item(lds, j >> 7, (j >> 2) & 31, j & 3, P, OB, tid, qctr, nxt); }
            }
        }
        else if constexpr (SP == 4) {
            if (bid < 32) { rw::carry(lds, ws + WS_RW + (size_t)bid * 64 * 16384, tid); __syncthreads(); }
            pg8::Gemm g{XB, WgT, 1024, 1024, 1024}; SkewOrder S{M / 256, 16, (M / 256) * 16, bid, 1024, 1024};
            EpiStoreBf16 E{GS, 4096, 1, 4096};
            pg8::gemm_phase<EpiStoreBf16, SkewOrder>(lds, g, S, E);
        }
        else if constexpr (SP == 5) {
            pg8::Gemm g{OB, WbrT, 1024, 1024, 256}; BranchOrder S{M / 256, 4, G, bid};
            EpiBranch E{GS, MG};
            pg8::gemm_phase<EpiBranch, BranchOrder>(lds, g, S, E);
        }
        else if constexpr (SP == 6) {
            pg8::Gemm g{MG, WoutT, 1024, 1024, 1024}; pg8::StaticOrder S; S.init(M, 1024, G, bid, 1024, 1024);
            EpiResid E{X, INP(I_X), l == 0 ? (const bf16*)nullptr : (const bf16*)XB};
            pg8::gemm_phase<EpiResid, pg8::StaticOrder>(lds, g, S, E);
        }
        else if constexpr (SP == 7) {
            const float* g1 = INP(I_LN1G) + l * 1024; const float* b1 = INP(I_LN1B) + l * 1024;
            const float* rgb = INP(I_RGB) + l * 4; const float* reb = INP(I_REB) + l * 32;
            const float rbias = lane < 4 ? rgb[lane & 3] : (lane < 36 ? reb[(lane - 4) & 31] : 0.f);
            f32x4 g1r[4];
#pragma unroll
            for (int j = 0; j < 4; ++j) g1r[j] = ((const f32x4*)g1)[lane + 64 * j];
            f32x4 vn[4];
#pragma unroll
            for (int j = 0; j < 4; ++j) vn[j] = ((const f32x4*)(X + (size_t)gw * D))[lane + 64 * j];
#pragma unroll 1
            for (int m = gw; m < M; m += NGW) {
                f32x4 v[4]; float s = 0.f;
#pragma unroll
                for (int j = 0; j < 4; ++j) { v[j] = vn[j]; s += (v[j][0] + v[j][1]) + (v[j][2] + v[j][3]); }
                { const int mnx = (m + NGW < M) ? m + NGW : m;
#pragma unroll
                  for (int j = 0; j < 4; ++j) vn[j] = ((const f32x4*)(X + (size_t)mnx * D))[lane + 64 * j]; }
                const float mean = wave_sum(s) * (1.f / D); float s2 = 0.f;
#pragma unroll
                for (int j = 0; j < 4; ++j) { v[j] = v[j] - mean; s2 += (v[j][0] * v[j][0] + v[j][1] * v[j][1]) + (v[j][2] * v[j][2] + v[j][3] * v[j][3]); }
                const float rstd = rsqrtf(wave_sum(s2) * (1.f / D) + LN_EPS);
#pragma unroll
                for (int j = 0; j < 4; ++j) { const f32x4 gg = g1r[j], bb = ((const f32x4*)b1)[lane + 64 * j]; v[j] = v[j] * rstd * gg + bb;
                    u32x2 w; w.x = pk2(v[j][0], v[j][1]); w.y = pk2(v[j][2], v[j][3]); ((u32x2*)(XB + (size_t)m * D))[lane + 64 * j] = w; }
                float mylg = 0.f;
                typedef float f2r __attribute__((ext_vector_type(2)));
                f32x4 wA[4][4], wB[4][4];
#define RT_LOAD(W_, o4_) do { _Pragma("unroll") for (int u = 0; u < 4; ++u) _Pragma("unroll") for (int j = 0; j < 4; ++j) W_[u][j] = ((const f32x4*)(WrT + ((o4_) + u) * 1024))[lane + 64 * j]; } while (0)
#define RT_COMP(W_, o4_) do { float a4[4]; \
                    _Pragma("unroll") for (int u = 0; u < 4; ++u) { f2r a2 = (f2r){0.f, 0.f}; \
                        _Pragma("unroll") for (int j = 0; j < 4; ++j) { a2 += (f2r){v[j][0], v[j][1]} * (f2r){W_[u][j][0], W_[u][j][1]}; a2 += (f2r){v[j][2], v[j][3]} * (f2r){W_[u][j][2], W_[u][j][3]}; } \
                        a4[u] = a2.x + a2.y; } \
                    _Pragma("unroll") for (int u = 0; u < 4; ++u) a4[u] = wave_sum(a4[u]); \
                    _Pragma("unroll") for (int u = 0; u < 4; ++u) mylg = (lane == (o4_) + u) ? a4[u] : mylg; } while (0)
                RT_LOAD(wA, 0);
#pragma unroll 1
                for (int o8 = 0; o8 < 32; o8 += 8) { RT_LOAD(wB, o8 + 4); RT_COMP(wA, o8); RT_LOAD(wA, o8 + 8); RT_COMP(wB, o8 + 4); }
                RT_COMP(wA, 32);
#undef RT_LOAD
#undef RT_COMP
                mylg += rbias;
                float gl[4]; float gm = -INFINITY; int gs = 0;
#pragma unroll
                for (int o = 0; o < 4; ++o) { gl[o] = __shfl(mylg, o); if (gl[o] > gm) { gm = gl[o]; gs = o; } }
                float gden = 0.f;
#pragma unroll
                for (int o = 0; o < 4; ++o) gden += __expf(gl[o] - gm);
                const float pg = 1.f / gden;
                float el[8];
#pragma unroll
                for (int o = 0; o < 8; ++o) el[o] = __shfl(mylg, 4 + gs * 8 + o);
                int e1 = 0; float m1 = el[0];
#pragma unroll
                for (int o = 1; o < 8; ++o) if (el[o] > m1) { m1 = el[o]; e1 = o; }
                int e2 = -1; float m2 = -INFINITY;
#pragma unroll
                for (int o = 0; o < 8; ++o) if (o != e1 && el[o] > m2) { m2 = el[o]; e2 = o; }
                const float r2 = __expf(m2 - m1); const float ga = pg / (1.f + r2), gb = pg * r2 / (1.f + r2);
                if (lane == 0) {
                    const int E1 = gs * 8 + e1, E2 = gs * 8 + e2;
                    tok_e[m * 2] = E1; tok_e[m * 2 + 1] = E2; tok_g[m * 2] = ga; tok_g[m * 2 + 1] = gb;
                    tok_rank[m * 2] = atomicAdd(&cnt[E1], 1); tok_rank[m * 2 + 1] = atomicAdd(&cnt[E2], 1);
                }
            }
        }
        else if constexpr (SP == 14) {
            LAS float* scr = (LAS float*)(lds + wave * 16384);
            const float* eg = INP(I_EG) + (size_t)l * NEXP * 1024 * 512; const float* eu = INP(I_EU) + (size_t)l * NEXP * 1024 * 512; const float* ed = INP(I_ED) + (size_t)l * NEXP * 512 * 1024;
            for (int it = gw; it < NEXP * 2 * 4 * 64; it += NGW) {
                const int e = it / 512, r = it % 512, half = r / 256, ct = (r % 256) / 64, q = r % 64, kb = q / 4, nb = q % 4;
                const float* W = (half ? eu : eg) + (size_t)e * 1024 * 512;
                transpose_item(W, 512, ct * 128, 128, WGU + (size_t)e * 1024 * 1024, 1024, ct * 256 + half * 128, 0, kb, nb, scr, lane);
            }
            for (int it = gw; it < NEXP * 8 * 32; it += NGW) {
                const int e = it / 256, q = it % 256, kb = q / 32, nb = q % 32;
                transpose_item(ed + (size_t)e * 512 * 1024, 1024, 0, 1024, WD + (size_t)e * 1024 * 512, 512, 0, 0, kb, nb, scr, lane);
            }
        }
        else if constexpr (SP == 8 || SP == 9 || SP == 10) {
            unsigned tbo = MISC_OFF; asm volatile("" : "+v"(tbo));
            volatile LAS int* tb = (volatile LAS int*)(lds + tbo);
            if (tid == 0) { int acc = 0; for (int e = 0; e < 32; ++e) { const int c = __hip_atomic_load(&cnt[e], __ATOMIC_RELAXED, __HIP_MEMORY_SCOPE_AGENT); tb[e] = acc; tb[33 + e] = acc; acc += (c + 255) >> 8; } tb[32] = acc; }
            __syncthreads();
            if constexpr (SP == 8) {
                for (int m = gw; m < M; m += NGW) {
#pragma unroll
                    for (int k = 0; k < 2; ++k) { const int e = tok_e[m * 2 + k]; const int slot = tb[33 + e] * 256 + tok_rank[m * 2 + k];
                        const u32x4* src = (const u32x4*)(XB + (size_t)m * D); u32x4* dst = (u32x4*)(XS + (size_t)slot * D);
                        dst[lane] = src[lane]; dst[lane + 64] = src[lane + 64];
                        if (lane == 0) tok_slot[m * 2 + k] = slot; }
                }
            } else if constexpr (SP == 9) {
                pg8::Gemm g{XS, WGU, 1024, 1024, 1024}; MoeOrder S{tb, G, bid, (size_t)1024 * 2, (size_t)1024 * 1024 * 2, (size_t)256 * 1024 * 2};
                EpiSwiglu E{HB};
                pg8::gemm_phase<EpiSwiglu, MoeOrder>(lds, g, S, E);
            } else {
                pg8::Gemm g{HB, WD, 512, 512, 512}; MoeOrder S{tb, G, bid, (size_t)512 * 2, (size_t)1024 * 512 * 2, (size_t)256 * 512 * 2};
                EpiStoreBf16 E{XS, 1024, 0, 1024};
                pg8::gemm_phase<EpiStoreBf16, MoeOrder>(lds, g, S, E);
            }
        }
        else if constexpr (SP == 11) {
            const float* g2 = INP(I_LN2G) + l * 1024; const float* b2 = INP(I_LN2B) + l * 1024;
            f32x4 g2r[4], b2r[4];
#pragma unroll
            for (int j = 0; j < 4; ++j) { g2r[j] = ((const f32x4*)g2)[lane + 64 * j]; b2r[j] = ((const f32x4*)b2)[lane + 64 * j]; }
            u32x2 xn[4], y1n[4], y2n[4]; float gan, gbn;
            int s1n, s2n; float gan2, gbn2;
#define LN2_SLOT(mm) do { s1n = tok_slot[(mm) * 2]; s2n = tok_slot[(mm) * 2 + 1]; gan2 = tok_g[(mm) * 2]; gbn2 = tok_g[(mm) * 2 + 1]; } while (0)
#define LN2_LOAD(mm) do { const int s1_ = s1n, s2_ = s2n; gan = gan2; gbn = gbn2; \
                _Pragma("unroll") for (int j = 0; j < 4; ++j) { xn[j] = ((const u32x2*)(XB + (size_t)(mm) * D))[lane + 64 * j]; y1n[j] = ((const u32x2*)(XS + (size_t)s1_ * D))[lane + 64 * j]; y2n[j] = ((const u32x2*)(XS + (size_t)s2_ * D))[lane + 64 * j]; } } while (0)
            LN2_SLOT(gw);
            LN2_LOAD(gw);
            { const int m1 = (gw + NGW < M) ? gw + NGW : gw; LN2_SLOT(m1); }
#pragma unroll 1
            for (int m = gw; m < M; m += NGW) {
                const float ga = gan, gb = gbn;
                f32x4 v[4]; float s = 0.f; f32x4* xr = (f32x4*)(X + (size_t)m * D) + lane;
                u32x2 y1c[4], y2c[4];
#pragma unroll
                for (int j = 0; j < 4; ++j) { v[j] = (f32x4){__uint_as_float(xn[j].x << 16), __uint_as_float(xn[j].x & 0xffff0000u), __uint_as_float(xn[j].y << 16), __uint_as_float(xn[j].y & 0xffff0000u)} * ALPHA; y1c[j] = y1n[j]; y2c[j] = y2n[j]; }
                { const int mnx = (m + NGW < M) ? m + NGW : m; LN2_LOAD(mnx);
                  const int mn2 = (m + 2 * NGW < M) ? m + 2 * NGW : mnx; LN2_SLOT(mn2); }
#pragma unroll
                for (int j = 0; j < 4; ++j) { const u32x2 y1 = y1c[j], y2 = y2c[j];
                    v[j][0] += ga * __uint_as_float(y1.x << 16) + gb * __uint_as_float(y2.x << 16); v[j][1] += ga * __uint_as_float(y1.x & 0xffff0000u) + gb * __uint_as_float(y2.x & 0xffff0000u);
                    v[j][2] += ga * __uint_as_float(y1.y << 16) + gb * __uint_as_float(y2.y << 16); v[j][3] += ga * __uint_as_float(y1.y & 0xffff0000u) + gb * __uint_as_float(y2.y & 0xffff0000u);
                    s += (v[j][0] + v[j][1]) + (v[j][2] + v[j][3]); }
                const float mean = wave_sum(s) * (1.f / D); float s2 = 0.f;
#pragma unroll
                for (int j = 0; j < 4; ++j) { v[j] = v[j] - mean; s2 += (v[j][0] * v[j][0] + v[j][1] * v[j][1]) + (v[j][2] * v[j][2] + v[j][3] * v[j][3]); }
                const float rstd = rsqrtf(wave_sum(s2) * (1.f / D) + LN_EPS);
#pragma unroll
                for (int j = 0; j < 4; ++j) { const f32x4 gg = g2r[j], bb = b2r[j]; v[j] = v[j] * rstd * gg + bb; if (l + 1 == NL) xr[64 * j] = v[j];
                    if (l + 1 < NL) { u32x2 w; w.x = pk2(v[j][0], v[j][1]); w.y = pk2(v[j][2], v[j][3]); ((u32x2*)(XB + (size_t)m * D))[lane + 64 * j] = w; } }
            }
        }
    }
}

template <int SP>
__global__ void __launch_bounds__(NTHR, 2) k_phase(Args args, int l) {
    extern __shared__ __attribute__((aligned(16))) unsigned char lds_raw[];
    ptr_table_fill(args, (LAS unsigned char*)lds_raw);
    phase_body<SP>(l, (LAS unsigned char*)lds_raw);
}


#define XB_TMO      128
#define XB_XCNT(j)  (256  + 64 * (j))
#define XB_XSUB(j)  (1280 + 64 * (j))
#define XB_XGEN(j)  (2304 + 64 * (j))
#define XB_TOP      3328
#define XB_TOPGEN   3392
#define XCD_BAR_WORDS 3456
#define XB_SPIN_CAP (1u << 22)
__device__ __forceinline__ unsigned xb_ld(unsigned* p)              { return __hip_atomic_load(p, __ATOMIC_RELAXED, __HIP_MEMORY_SCOPE_AGENT); }
__device__ __forceinline__ unsigned xb_add(unsigned* p, unsigned v) { return __hip_atomic_fetch_add(p, v, __ATOMIC_RELAXED, __HIP_MEMORY_SCOPE_AGENT); }
__device__ __forceinline__ unsigned xb_xcc_id() { return (unsigned)__builtin_amdgcn_s_getreg((3 << 11) | 20) & 0xFu; }
#define XB_SPIN(cond, bar) do { unsigned _sp = 0; while (cond) { __builtin_amdgcn_s_sleep(1); \
    if ((++_sp & 255u) == 0u) { if (xb_ld(&(bar)[XB_TMO])) break; if (_sp > XB_SPIN_CAP) { atomicAdd(&(bar)[XB_TMO], 1u); break; } } } } while (0)
__device__ __forceinline__ void xcd_barrier_complete(unsigned* bar, unsigned x, unsigned& nloc, unsigned& nx) {
    const unsigned G = gridDim.x;
    unsigned sum, cnt, mine, sp = 0u;
    for (;;) {
        sum = 0u; cnt = 0u; mine = 0u;
#pragma unroll
        for (unsigned j = 0; j < 16; ++j) { const unsigned c = xb_ld(&bar[XB_XCNT(j)]); sum += c; cnt += (c > 0u) ? 1u : 0u; mine = (j == x) ? c : mine; }
        if (sum == G) break;
        __builtin_amdgcn_s_sleep(1);
        if ((++sp & 255u) == 0u) { if (xb_ld(&bar[XB_TMO])) break; if (sp > XB_SPIN_CAP) { atomicAdd(&bar[XB_TMO], 1u); break; } }
    }
    nloc = mine > 0u ? mine : 1u; nx = cnt > 0u ? cnt : 1u;
}
__device__ __forceinline__ void xcd_barrier(unsigned* bar, LAS unsigned char* lds) {
    asm volatile("s_waitcnt vmcnt(0)" ::: "memory");
    __syncthreads();
    int tid_ = threadIdx.x; asm volatile("" : "+v"(tid_));
    if (tid_ == 0) {
        unsigned so = (unsigned)(LDS_BYTES - 576); asm volatile("" : "+v"(so));
        volatile LAS unsigned* st = (volatile LAS unsigned*)(lds + so);
        __builtin_amdgcn_s_waitcnt(0);
        const unsigned x = xb_xcc_id();
        unsigned nloc = st[0], nx = st[1];
        if (nloc == 0u) { xcd_barrier_complete(bar, x, nloc, nx); st[0] = nloc; st[1] = nx; }
        const unsigned old = xb_add(&bar[XB_XSUB(x)], 1u);
        const unsigned gen = old / nloc;
        if (old + 1u == (gen + 1u) * nloc) {
            __builtin_amdgcn_fence(__ATOMIC_RELEASE, "agent");
            asm volatile("s_waitcnt vmcnt(0)" ::: "memory");
            const unsigned og = xb_add(&bar[XB_TOP], 1u);
            const unsigned tg = og / nx;
            if (og + 1u == (tg + 1u) * nx) xb_add(&bar[XB_TOPGEN], 1u);
            else XB_SPIN(xb_ld(&bar[XB_TOPGEN]) == tg, bar);
            __builtin_amdgcn_fence(__ATOMIC_ACQUIRE, "agent");
            xb_add(&bar[XB_XGEN(x)], 1u);
            asm volatile("s_waitcnt vmcnt(0)" ::: "memory");
        } else {
            XB_SPIN(xb_ld(&bar[XB_XGEN(x)]) == gen, bar);
            __builtin_amdgcn_fence(__ATOMIC_ACQUIRE, "agent");
            asm volatile("s_waitcnt vmcnt(0)" ::: "memory");
        }
    }
    __syncthreads();
}
namespace cg = cooperative_groups;
__global__ void __launch_bounds__(NTHR, 2) fwd_all(Args args) {
    extern __shared__ __attribute__((aligned(16))) unsigned char lds_raw[];
    LAS unsigned char* lds = (LAS unsigned char*)lds_raw;
    unsigned* bar = (unsigned*)(args.ws + WS_CTL) + CW_BAR;
    if (threadIdx.x == 0) { ((volatile LAS unsigned*)(lds + LDS_BYTES - 576))[0] = 0u; ((volatile LAS unsigned*)(lds + LDS_BYTES - 576))[1] = 0u; (void)xb_add(&bar[XB_XCNT(xb_xcc_id())], 1u); }
    ptr_table_fill(args, lds);
    const int probe = args.ph_lo;
    { constexpr int l = 0;
#pragma unroll 1
      for (int r_ = 0; r_ < ((probe == -1) ? 2 : 1); ++r_) { phase_body<-1>(l, lds); __syncthreads(); } }
    cg::this_grid().sync();
#define GRID_BAR() do { unsigned* bar_ = (unsigned*)gptr(ldptr(lds, 36)) + CW_BAR; xcd_barrier(bar_, lds); } while (0)
#define RUN(SP) do { _Pragma("unroll 1") for (int r_ = 0; r_ < ((probe == (SP)) ? 2 : 1); ++r_) { phase_body<SP>(l, lds); __syncthreads(); } } while (0)
#define ONCE(SP) do { phase_body<SP>(l, lds); __syncthreads(); } while (0)
#define LAYER() \
        RUN(0); GRID_BAR(); \
        ONCE(15); GRID_BAR(); \
        ONCE(4); GRID_BAR(); \
        RUN(13); GRID_BAR(); \
        RUN(5); GRID_BAR(); \
        ONCE(6); GRID_BAR(); \
        ONCE(7); RUN(14); GRID_BAR(); \
        RUN(8); GRID_BAR(); \
        RUN(9); GRID_BAR(); \
        RUN(10); GRID_BAR(); \
        ONCE(11); GRID_BAR();
    { constexpr int l = 0; LAYER() }
    { constexpr int l = 1; LAYER() }
#undef LAYER
#undef RUN
#undef ONCE
#undef GRID_BAR
}

template <int SP> static void launch_phase(const Args& a, int l, int grid, hipStream_t stream) {
    static bool attr = false;
    if (!attr) { (void)hipFuncSetAttribute((const void*)k_phase<SP>, hipFuncAttributeMaxDynamicSharedMemorySize, LDS_BYTES); attr = true; }
    hipLaunchKernelGGL(k_phase<SP>, dim3(grid), dim3(NTHR), LDS_BYTES, stream, a, l);
}

extern "C" void kernel_launch(void* const* d_in, const int* in_sizes, int n_in, void* d_out, int out_size, void* d_ws, size_t ws_size, hipStream_t stream) {
    static int grid = 0;
    if (grid == 0) {
        if (n_in != 35 || out_size != M * D || ws_size < WS_END) { fprintf(stderr, "kernel_launch: unexpected problem (n_in %d out %d ws %zu)\n", n_in, out_size, ws_size); grid = -1; return; }
        int dev = 0, cus = 0, per_cu = 0;
        (void)hipGetDevice(&dev); (void)hipDeviceGetAttribute(&cus, hipDeviceAttributeMultiprocessorCount, dev);
#if N_LAUNCH_MODE == 1
        (void)hipFuncSetAttribute((const void*)fwd_all, hipFuncAttributeMaxDynamicSharedMemorySize, LDS_BYTES);
        if (hipOccupancyMaxActiveBlocksPerMultiprocessor(&per_cu, (const void*)fwd_all, NTHR, LDS_BYTES) != hipSuccess || per_cu < 1) { fprintf(stderr, "kernel_launch: occupancy query says %d blocks/CU\n", per_cu); grid = -1; return; }
#endif
        (void)per_cu;
        grid = cus;
        if (grid != 256) { fprintf(stderr, "kernel_launch: built for 256 CUs, found %d\n", cus); grid = -1; return; }
    }
    if (grid < 0) return;
    (void)hipMemsetAsync((char*)d_ws + WS_CTL, 0, CTL_BYTES, stream);
    Args a{};
    for (int i = 0; i < 35; ++i) a.in[i] = (const float*)d_in[i];
    a.out = (float*)d_out; a.ws = (unsigned char*)d_ws;
#if N_LAUNCH_MODE == 1
    a.ph_lo = PROBE_REPS;
    void* kargs[] = {(void*)&a};
    hipError_t e = hipLaunchCooperativeKernel((const void*)fwd_all, dim3(grid), dim3(NTHR), kargs, LDS_BYTES, stream);
    if (e != hipSuccess) fprintf(stderr, "cooperative launch failed: %s\n", hipGetErrorString(e));
#else
    launch_phase<-1>(a, 0, grid, stream);
    for (int l = 0; l < NL; ++l) {
        launch_phase<0>(a, l, grid, stream); launch_phase<15>(a, l, grid, stream); launch_phase<4>(a, l, grid, stream); launch_phase<13>(a, l, grid, stream);
        launch_phase<5>(a, l, grid, stream); launch_phase<6>(a, l, grid, stream); launch_phase<7>(a, l, grid, stream); launch_phase<14>(a, l, grid, stream);
        launch_phase<8>(a, l, grid, stream); launch_phase<9>(a, l, grid, stream); launch_phase<10>(a, l, grid, stream); launch_phase<11>(a, l, grid, stream);
    }
#endif
}
```
